# Optimizing an MI355X kernel written in HIP

```python
import jax, jax.numpy as jnp
from jax import lax
import numpy as np

D_MODEL = 1024
BATCH = 4
SEQ = 4096
DEPTH = 2
DEC_BATCH = 32
DEC_SEQ = 64
PAST_LEN = 1024

CHUNK = 64
N_META = 16
MIX_W = D_MODEL
CONV_W = MIX_W // 4
CONV_K = 3
MLA_HEADS = 8
QK_NOPE = 64
QK_ROPE = 32
V_DIM = 64
MLA_W = MLA_HEADS * V_DIM
Q_LORA = 256
KV_LORA = 128
RWKV_HEAD = 64
RWKV_W = MIX_W - CONV_W - MLA_W
RWKV_HEADS = RWKV_W // RWKV_HEAD
DECAY_LORA = 64
ICLR_LORA = 64
SHIFT_W = 3 * RWKV_W + DECAY_LORA + ICLR_LORA
IN_SPLITS = (CONV_W, CONV_W, CONV_W, CONV_W, Q_LORA, KV_LORA, QK_ROPE, MLA_W, SHIFT_W, RWKV_W)
IN_TOTAL = sum(IN_SPLITS)
IN_OFFSETS = tuple(np.cumsum(IN_SPLITS)[:-1].tolist())
RWKV_OFFSETS = (RWKV_W, 2 * RWKV_W, 3 * RWKV_W, 3 * RWKV_W + DECAY_LORA)
ROPE_BASE = 10000.0
RMS_EPS = 1e-6
GN_EPS = 64e-5
QBLOCK = 128
NEG = -1e30
FAR_CHUNK = 2 ** 30

kernel_name = 'hybrid_conv_mla_rwkv7_stream_step'


def rmsnorm(x, g):
    xf = x.astype(jnp.float32)
    y = xf * lax.rsqrt(jnp.mean(xf * xf, axis=-1, keepdims=True) + RMS_EPS)
    return (y * g.astype(jnp.float32)).astype(x.dtype)


def rope(x, pos):
    half = x.shape[-1] // 2
    inv = ROPE_BASE ** (-jnp.arange(half, dtype=jnp.float32) * 2.0 / x.shape[-1])
    ang = pos.astype(jnp.float32)[:, None] * inv[None, :]
    cos = jnp.cos(ang)[None, :, None, :]
    sin = jnp.sin(ang)[None, :, None, :]
    xf = x.astype(jnp.float32)
    x1, x2 = xf[..., :half], xf[..., half:]
    return jnp.concatenate([x1 * cos - x2 * sin, x1 * sin + x2 * cos], axis=-1).astype(x.dtype)


def chunk_attention(q_nope, q_rope, k_nope, k_rope, v, q_chunk, k_chunk):
    scale = (QK_NOPE + QK_ROPE) ** -0.5

    def block(args):
        qn, qr, qc = args
        s = (jnp.einsum('bqhd,bkhd->bhqk', qn, k_nope).astype(jnp.float32)
             + jnp.einsum('bqhr,bkr->bhqk', qr, k_rope).astype(jnp.float32)) * scale
        vis = k_chunk[None, :] <= qc[:, None]
        s = jnp.where(vis[None, None], s, NEG)
        p = jax.nn.softmax(s, axis=-1).astype(v.dtype)
        return jnp.einsum('bhqk,bkhd->bqhd', p, v)

    b, sq = q_nope.shape[:2]
    if sq <= QBLOCK:
        return block((q_nope, q_rope, q_chunk))
    nb = -(-sq // QBLOCK)
    pad = nb * QBLOCK - sq

    def blocks(t):
        t = jnp.pad(t, ((0, 0), (0, pad), (0, 0), (0, 0)))
        return jnp.moveaxis(t.reshape(b, nb, QBLOCK, *t.shape[2:]), 1, 0)

    qc = jnp.pad(q_chunk, (0, pad), constant_values=FAR_CHUNK).reshape(nb, QBLOCK)
    out = lax.map(block, (blocks(q_nope), blocks(q_rope), qc))
    out = jnp.moveaxis(out, 0, 1).reshape(b, nb * QBLOCK, *out.shape[3:])
    return out[:, :sq]


def rwkv7_scan(r, w, k, v, kk, a, s0):
    def step(s, inp):
        r_t, w_t, k_t, v_t, kk_t, a_t = inp
        sa = jnp.einsum('bhvk,bhk->bhv', s, -kk_t)
        s = (s * w_t[:, :, None, :] + sa[..., None] * (kk_t * a_t)[:, :, None, :]
             + v_t[..., None] * k_t[:, :, None, :])
        return s, jnp.einsum('bhvk,bhk->bhv', s, r_t)

    xs = tuple(jnp.moveaxis(t, 1, 0) for t in (r, w, k, v, kk, a))
    s, ys = lax.scan(step, s0, xs)
    return jnp.moveaxis(ys, 0, 1), s


def hybrid_layer(x, pos, q_chunk, past_chunk, ckv_past, krope_past, conv_st, shift_st, wkv_st,
                 norm_g, w_in, conv_w, q_norm_g, w_uq, kv_norm_g, w_ukv, shift_mu,
                 decay_w0, decay_w2, iclr_a0, iclr_a2, key_kk, key_ka, bonus_rk,
                 lnx_w, lnx_b, w_out):
    b, t = x.shape[:2]
    h = rmsnorm(x, norm_g)
    z = h @ w_in
    xin, bg, cg, ga, cq, ckv, kr, gb, zc, gc = jnp.split(z, IN_OFFSETS, axis=-1)

    u = cg * xin
    u_ext = jnp.concatenate([conv_st.astype(u.dtype), u], axis=1)
    conv = sum(conv_w[j] * u_ext[:, j:j + t] for j in range(CONV_K))
    y_a = bg * conv * jax.nn.silu(ga)
    new_conv = u_ext[:, -(CONV_K - 1):]

    q = (rmsnorm(cq, q_norm_g) @ w_uq).reshape(b, t, MLA_HEADS, QK_NOPE + QK_ROPE)
    q_nope = q[..., :QK_NOPE]
    q_rope = rope(q[..., QK_NOPE:], pos)
    ckv_n = rmsnorm(ckv, kv_norm_g)
    kr_r = rope(kr[:, :, None, :], pos)[:, :, 0]
    ckv_all = jnp.concatenate([ckv_past.astype(ckv_n.dtype), ckv_n], axis=1)
    kr_all = jnp.concatenate([krope_past.astype(kr_r.dtype), kr_r], axis=1)
    sk = ckv_all.shape[1]
    kv = (ckv_all @ w_ukv).reshape(b, sk, MLA_HEADS, QK_NOPE + V_DIM)
    k_chunk = jnp.concatenate([past_chunk, q_chunk])
    o = chunk_attention(q_nope, q_rope, kv[..., :QK_NOPE], kr_all, kv[..., QK_NOPE:],
                        q_chunk, k_chunk)
    y_b = o.reshape(b, t, MLA_W) * jax.nn.silu(gb)

    prev = jnp.concatenate([shift_st[:, None].astype(zc.dtype), zc[:, :-1]], axis=1)
    zs = zc + (prev - zc) * shift_mu
    r, k, v, wl, al = jnp.split(zs, RWKV_OFFSETS, axis=-1)
    w_log = -jax.nn.softplus(-(decay_w0 + jnp.tanh(wl) @ decay_w2).astype(jnp.float32)) - 0.5
    decay = jnp.exp(-jnp.exp(w_log))
    a = jax.nn.sigmoid((iclr_a0 + al @ iclr_a2).astype(jnp.float32))
    heads = lambda m: m.astype(jnp.float32).reshape(b, t, RWKV_HEADS, RWKV_HEAD)
    per_head = lambda p: p.astype(jnp.float32).reshape(RWKV_HEADS, RWKV_HEAD)
    r, k, v, decay, a = heads(r), heads(k), heads(v), heads(decay), heads(a)
    kk = k * per_head(key_kk)
    kk = kk / jnp.maximum(jnp.sqrt(jnp.sum(kk * kk, axis=-1, keepdims=True)), 1e-12)
    k = k * (1.0 + (a - 1.0) * per_head(key_ka))
    ys, s_new = rwkv7_scan(r, decay, k, v, kk, a, wkv_st.astype(jnp.float32))
    mu = jnp.mean(ys, axis=-1, keepdims=True)
    var = jnp.mean(jnp.square(ys - mu), axis=-1, keepdims=True)
    yn = (ys - mu) * lax.rsqrt(var + GN_EPS) * per_head(lnx_w) + per_head(lnx_b)
    yn = yn + jnp.sum(r * k * per_head(bonus_rk), axis=-1, keepdims=True) * v
    y_c = yn.reshape(b, t, RWKV_W).astype(x.dtype) * jax.nn.silu(gc)
    new_shift = zc[:, -1]

    y = jnp.concatenate([y_a, y_b, y_c], axis=-1) @ w_out
    return x + y, ckv_n, kr_r, new_conv, new_shift, s_new.astype(wkv_st.dtype)


def setup_inputs(seed: int = 0) -> dict:
    key = jax.random.key(seed)
    ks = jax.random.split(key, 32)
    f32 = jnp.float32
    nrm = lambda kk, shape, s: jax.random.normal(kk, shape, f32) * s
    return {
        'x_prompt': nrm(ks[0], (BATCH, SEQ, D_MODEL), 1.0),
        'x_sample': nrm(ks[1], (DEC_BATCH, DEC_SEQ, D_MODEL), 1.0),
        'cache_ckv': nrm(ks[2], (DEPTH, DEC_BATCH, PAST_LEN, KV_LORA), 1.0),
        'cache_krope': nrm(ks[3], (DEPTH, DEC_BATCH, PAST_LEN, QK_ROPE), 1.0),
        'state_conv': nrm(ks[4], (DEPTH, DEC_BATCH, CONV_K - 1, CONV_W), 1.0),
        'state_shift': nrm(ks[5], (DEPTH, DEC_BATCH, SHIFT_W), 1.0),
        'state_wkv': nrm(ks[6], (DEPTH, DEC_BATCH, RWKV_HEADS, RWKV_HEAD, RWKV_HEAD), 0.5),
        'meta_tokens': nrm(ks[7], (N_META, D_MODEL), 1.0),
        'norm_g': 1.0 + nrm(ks[8], (DEPTH, D_MODEL), 0.02),
        'w_in': nrm(ks[9], (DEPTH, D_MODEL, IN_TOTAL), D_MODEL ** -0.5),
        'conv_w': nrm(ks[10], (DEPTH, CONV_K, CONV_W), CONV_K ** -0.5),
        'q_norm_g': 1.0 + nrm(ks[11], (DEPTH, Q_LORA), 0.02),
        'w_uq': nrm(ks[12], (DEPTH, Q_LORA, MLA_HEADS * (QK_NOPE + QK_ROPE)), Q_LORA ** -0.5),
        'kv_norm_g': 1.0 + nrm(ks[13], (DEPTH, KV_LORA), 0.02),
        'w_ukv': nrm(ks[14], (DEPTH, KV_LORA, MLA_HEADS * (QK_NOPE + V_DIM)), KV_LORA ** -0.5),
        'shift_mu': jax.random.uniform(ks[15], (DEPTH, SHIFT_W), f32),
        'decay_w0': -1.0 + nrm(ks[16], (DEPTH, RWKV_W), 0.5),
        'decay_w2': nrm(ks[17], (DEPTH, DECAY_LORA, RWKV_W), 0.1 * DECAY_LORA ** -0.5),
        'iclr_a0': nrm(ks[18], (DEPTH, RWKV_W), 0.1),
        'iclr_a2': nrm(ks[19], (DEPTH, ICLR_LORA, RWKV_W), 0.1 * ICLR_LORA ** -0.5),
        'key_kk': 0.85 + nrm(ks[20], (DEPTH, RWKV_W), 0.05),
        'key_ka': 1.0 + nrm(ks[21], (DEPTH, RWKV_W), 0.05),
        'bonus_rk': nrm(ks[22], (DEPTH, RWKV_W), 0.1),
        'lnx_w': 1.0 + nrm(ks[23], (DEPTH, RWKV_W), 0.02),
        'lnx_b': nrm(ks[24], (DEPTH, RWKV_W), 0.02),
        'w_out': nrm(ks[25], (DEPTH, MIX_W, D_MODEL), (2.0 * DEPTH * MIX_W) ** -0.5),
        'final_g': 1.0 + nrm(ks[26], (D_MODEL,), 0.02),
    }


def stack_states(outs):
    return tuple(jnp.stack([o[i] for o in outs]) for i in range(5))


def reference(x_prompt, x_sample, cache_ckv, cache_krope, state_conv, state_shift, state_wkv,
              meta_tokens, norm_g, w_in, conv_w, q_norm_g, w_uq, kv_norm_g, w_ukv, shift_mu,
              decay_w0, decay_w2, iclr_a0, iclr_a2, key_kk, key_ka, bonus_rk, lnx_w, lnx_b,
              w_out, final_g):
    dt = x_prompt.dtype
    bp = x_prompt.shape[0]
    meta = jnp.broadcast_to(meta_tokens.astype(dt)[None], (bp, N_META, D_MODEL))
    hp = jnp.concatenate([meta, x_prompt], axis=1)
    tp = hp.shape[1]
    pos_p = jnp.arange(tp, dtype=jnp.int32)
    chunk_p = jnp.where(pos_p < N_META, -1, (pos_p - N_META) // CHUNK).astype(jnp.int32)
    past_chunk_p = jnp.zeros((0,), jnp.int32)
    ckv0 = jnp.zeros((bp, 0, KV_LORA), dt)
    kr0 = jnp.zeros((bp, 0, QK_ROPE), dt)
    conv0 = jnp.zeros((bp, CONV_K - 1, CONV_W), dt)
    shift0 = jnp.zeros((bp, SHIFT_W), dt)
    wkv0 = jnp.zeros((bp, RWKV_HEADS, RWKV_HEAD, RWKV_HEAD), dt)

    hs = x_sample
    ts = x_sample.shape[1]
    past = cache_ckv.shape[2]
    pos_s = past + jnp.arange(ts, dtype=jnp.int32)
    chunk_s = jnp.full((ts,), past // CHUNK, jnp.int32)
    past_chunk_s = jnp.arange(past, dtype=jnp.int32) // CHUNK

    outs_p, outs_s = [], []
    for l in range(DEPTH):
        lw = tuple(p[l] for p in (norm_g, w_in, conv_w, q_norm_g, w_uq, kv_norm_g, w_ukv,
                                   shift_mu, decay_w0, decay_w2, iclr_a0, iclr_a2, key_kk,
                                   key_ka, bonus_rk, lnx_w, lnx_b, w_out))
        hp, *st_p = hybrid_layer(hp, pos_p, chunk_p, past_chunk_p, ckv0, kr0, conv0, shift0,
                                 wkv0, *lw)
        hs, *st_s = hybrid_layer(hs, pos_s, chunk_s, past_chunk_s, cache_ckv[l], cache_krope[l],
                                 state_conv[l], state_shift[l], state_wkv[l], *lw)
        outs_p.append(st_p)
        outs_s.append(st_s)

    y_prompt = rmsnorm(hp[:, N_META:], final_g)
    y_sample = rmsnorm(hs, final_g)
    ckv_p, kr_p, conv_p, shift_p, wkv_p = stack_states(outs_p)
    ckv_s, kr_s, conv_s, shift_s, wkv_s = stack_states(outs_s)
    return (y_prompt, y_sample, ckv_p, kr_p, conv_p, shift_p, wkv_p,
            ckv_s, kr_s, conv_s, shift_s, wkv_s)
```

```cpp
#include <hip/hip_runtime.h>
#include <cstdio>
#include <cstdint>
#include <type_traits>

typedef unsigned short bf16_t;
typedef short bf16x8 __attribute__((ext_vector_type(8)));
typedef float f32x4 __attribute__((ext_vector_type(4)));
typedef float f32x16 __attribute__((ext_vector_type(16)));
#define DEV __device__ __forceinline__
#define LAUNDER(x) asm volatile("" : "+v"(x))

constexpr int D = 1024;
constexpr int PT = 4112;
constexpr int NPR = 4 * PT;
constexpr int NSM = 32 * 64;
constexpr int NT = NPR + NSM;
constexpr int NTP = 18560;
constexpr int ZL = 1792;
constexpr int ZE = 1312;
constexpr int ZE_CQ = 0, ZE_CKV = 256, ZE_KR = 384, ZE_ZC = 416;
constexpr int ZL_XIN = 0, ZL_BG = 256, ZL_CG = 512, ZL_GA = 768, ZL_GB = 1024, ZL_GC = 1536;
constexpr int INP = 3200;
constexpr int KVR = 16512;
constexpr int NRW_P = 4 * 65 * 4;
constexpr int NRW = NRW_P + 32 * 4;
constexpr int RW_BYTES = 49152;
constexpr float RMS_EPS = 1e-6f;
constexpr float GN_EPS = 64e-5f;
constexpr int LDS_BYTES = 79872;

struct Prm {
  const float *x_prompt, *x_sample, *cache_ckv, *cache_krope, *state_conv, *state_shift, *state_wkv, *meta, *norm_g, *w_in,
      *conv_w, *q_norm_g, *w_uq, *kv_norm_g, *w_ukv, *shift_mu, *decay_w0, *decay_w2, *iclr_a0, *iclr_a2, *key_kk, *key_ka,
      *bonus_rk, *lnx_w, *lnx_b, *w_out, *final_g;
  float *y_prompt, *y_sample, *ckv_p, *kr_p, *conv_p, *shift_p, *wkv_p, *ckv_s, *kr_s, *conv_s, *shift_s, *wkv_s;
  unsigned* ctl;
  bf16_t *Wb_in, *Wb_uq, *Wb_ukv, *Wb_out, *dw2T, *ia2T;
  float *ropec, *ropes, *ssq_x, *ssq_q, *ssq_kv, *rkb, *xmeta;
  bf16_t *zE, *zL, *xb, *Kn, *Vt, *Kr;
  char* rw;
};

DEV float bf2f(bf16_t b) { return __uint_as_float((unsigned)b << 16); }
DEV float bflo(unsigned u) { return __uint_as_float(u << 16); }
DEV float bfhi(unsigned u) { return __uint_as_float(u & 0xffff0000u); }
typedef __bf16 hbf16x2_t __attribute__((ext_vector_type(2)));
typedef float hf32x2_t __attribute__((ext_vector_type(2)));
DEV unsigned pk2(float a, float b) { hf32x2_t f = {a, b}; hbf16x2_t r = __builtin_convertvector(f, hbf16x2_t); return __builtin_bit_cast(unsigned, r); }
DEV bf16_t f2bf(float f) { return (bf16_t)(pk2(f, 0.f) & 0xffffu); }
DEV uint2 pk4(float a, float b, float c, float d) { uint2 r; r.x = pk2(a, b); r.y = pk2(c, d); return r; }
DEV float sigmoid_(float x) { return 1.f / (1.f + __expf(-x)); }
DEV float silu_(float x) { return x / (1.f + __expf(-x)); }
DEV float wave_sum(float v) {
#pragma unroll
  for (int o = 1; o < 64; o <<= 1) v += __shfl_xor(v, o);
  return v;
}
DEV f32x16 mfma32(bf16x8 a, bf16x8 b, f32x16 c) { return __builtin_amdgcn_mfma_f32_32x32x16_bf16(a, b, c, 0, 0, 0); }
DEV f32x4 mfma16(bf16x8 a, bf16x8 b, f32x4 c) { return __builtin_amdgcn_mfma_f32_16x16x32_bf16(a, b, c, 0, 0, 0); }
DEV bf16x8 mk8(unsigned a, unsigned b, unsigned c, unsigned d) { uint4 u; u.x = a; u.y = b; u.z = c; u.w = d; return __builtin_bit_cast(bf16x8, u); }
DEV bf16x8 mk8(uint4 u) { return __builtin_bit_cast(bf16x8, u); }
DEV f32x16 zero16() { f32x16 z; for (int i = 0; i < 16; ++i) z[i] = 0.f; return z; }

DEV float* xrow_ptr(const Prm& p, int R) {
  if (R < NPR) { int s = R / PT, q = R - s * PT; return q < 16 ? p.xmeta + (size_t)(s * 16 + q) * D : p.y_prompt + ((size_t)s * 4096 + (q - 16)) * D; }
  return p.y_sample + (size_t)(R - NPR) * D;
}
DEV const float* xin_ptr(const Prm& p, int R) {
  if (R < NPR) { int s = R / PT, q = R - s * PT; return q < 16 ? p.meta + (size_t)q * D : p.x_prompt + ((size_t)s * 4096 + (q - 16)) * D; }
  return p.x_sample + (size_t)(R - NPR) * D;
}
DEV int pos_of(int R) { return R < NPR ? R % PT : 1024 + ((R - NPR) & 63); }

DEV int win_src_col(int n) {
  if (n < 1024) return n;
  if (n < 1536) return 1440 + (n - 1024);
  if (n < 1792) return 2848 + (n - 1536);
  if (n < 2208) return 1024 + (n - 1792);
  if (n < 3104) return 1952 + (n - 2208);
  return -1;
}
DEV int perm32(int rho) { const int n = rho >> 4, i = rho & 15; return 8 * (i >> 2) + 4 * n + (i & 3); }
template <bool PERM, bool P32>
DEV void conv_weight_tile(const float* __restrict__ src, int K, int N, int Npad, bf16_t* __restrict__ dst, const float* __restrict__ sk, float cst, int l, int item, float* T  , int tid) {
  const int ntn = Npad / 64, ntk = K / 64;
  const int r = item, kt = r / ntn, nt = r - kt * ntn;
  const int k0 = kt * 64, n0 = nt * 64;
  {
    const int nslot = n0 + (tid & 15) * 4;
    const int nn = P32 ? (nslot & ~31) + perm32(nslot & 31) : nslot;
    const int sn = PERM ? win_src_col(nn) : (nn < N ? nn : -1);
#pragma unroll
    for (int i = 0; i < 4; ++i) {
      const int k = (tid >> 4) + 16 * i;
      float4 v = make_float4(0.f, 0.f, 0.f, 0.f);
      if (sn >= 0) {
        v = *(const float4*)(src + ((size_t)l * K + k0 + k) * N + sn);
        const float s = (sk ? sk[l * K + k0 + k] : 1.f) * cst;
        v.x *= s; v.y *= s; v.z *= s; v.w *= s;
      }
      float* t = T + k * 65 + (tid & 15) * 4;
      t[0] = v.x; t[1] = v.y; t[2] = v.z; t[3] = v.w;
    }
  }
  __syncthreads();
  {
    const int n = tid >> 2, kc = tid & 3;
    float v[16];
#pragma unroll
    for (int j = 0; j < 16; ++j) v[j] = T[(16 * kc + j) * 65 + n];
    uint4 o0, o1;
    o0.x = pk2(v[0], v[1]); o0.y = pk2(v[2], v[3]); o0.z = pk2(v[4], v[5]); o0.w = pk2(v[6], v[7]);
    o1.x = pk2(v[8], v[9]); o1.y = pk2(v[10], v[11]); o1.z = pk2(v[12], v[13]); o1.w = pk2(v[14], v[15]);
    bf16_t* d = dst + ((size_t)l * Npad + n0 + n) * K + k0 + 16 * kc;
    *(uint4*)d = o0; *(uint4*)(d + 8) = o1;
  }
  __syncthreads();
}
constexpr int WT0 = 16 * 50, WT1 = WT0 + 16 * 16, WT2 = WT1 + 4 * 12, WT3 = WT2 + 2 * 16, WT4 = WT3 + 4, NWT = WT4 + 4;
DEV void conv_weights_item(const Prm& p, int l, int it, char* lds) {
  float* T = (float*)lds;
  int tid = threadIdx.x; LAUNDER(tid);
  if (it < WT0) conv_weight_tile<true, true>(p.w_in, 1024, 3104, INP, p.Wb_in, p.norm_g, 1.f, l, it, T, tid);
  else if (it < WT1) conv_weight_tile<false, true>(p.w_out, 1024, 1024, 1024, p.Wb_out, nullptr, 1.f, l, it - WT0, T, tid);
  else if (it < WT2) conv_weight_tile<false, false>(p.w_uq, 256, 768, 768, p.Wb_uq, p.q_norm_g, 0.10206207261596575f * 1.4426950408889634f, l, it - WT1, T, tid);
  else if (it < WT3) conv_weight_tile<false, false>(p.w_ukv, 128, 1024, 1024, p.Wb_ukv, nullptr, 1.f, l, it - WT2, T, tid);
  else if (it < WT4) conv_weight_tile<false, false>(p.decay_w2, 64, 256, 256, p.dw2T, nullptr, 1.f, l, it - WT3, T, tid);
  else conv_weight_tile<false, false>(p.iclr_a2, 64, 256, 256, p.ia2T, nullptr, 1.f, l, it - WT4, T, tid);
}
DEV void phase0(const Prm& p, char* lds) {
  int tid = threadIdx.x; LAUNDER(tid);
  const int lane = tid & 63, wv = tid >> 6;
  const int gw = blockIdx.x * 4 + wv, NW = gridDim.x * 4;
  const int gt = blockIdx.x * 256 + tid, NTH = gridDim.x * 256;
  for (int R = gw; R < NT; R += NW) {
    const float* src = xin_ptr(p, R);
    float ss = 0.f;
#pragma unroll
    for (int j = 0; j < 4; ++j) {
      const float4 v = ((const float4*)src)[lane + 64 * j];
      ss += v.x * v.x + v.y * v.y + v.z * v.z + v.w * v.w;
      ((uint2*)(p.xb + (size_t)R * D))[lane + 64 * j] = pk4(v.x, v.y, v.z, v.w);
    }
    ss = wave_sum(ss);
    if (lane == 0) p.ssq_x[R] = ss;
  }
  for (int i = gt; i < 6 * NTP; i += NTH) p.ssq_x[NTP + i] = 0.f;
  for (int it = blockIdx.x; it < NWT; it += gridDim.x) conv_weights_item(p, 0, it, lds);
  for (int i = gt; i < PT * 16; i += NTH) {
    const int pos = i >> 4, j = i & 15;
    const float inv = powf(10000.f, -(float)j * 2.0f / 32.f);
    const float ang = (float)pos * inv;
    double a = (double)ang;
    a -= 6.283185307179586476925 * rint(a * 0.15915494309189533577);
    p.ropec[i] = (float)cos(a);
    p.ropes[i] = (float)sin(a);
  }
}

#define LAS3 __attribute__((address_space(3)))
#define RAW_BARRIER() { asm volatile("" ::: "memory"); __builtin_amdgcn_s_barrier(); asm volatile("" ::: "memory"); }
DEV int lds_byte(int r, int c) { const int st = (r >> 4) * 2 + (c >> 5), rr = r & 15, cc = c & 31, ob = rr * 64 + cc * 2; return st * 1024 + (ob ^ (((ob >> 9) & 1) << 5)); }
template <class Epi, int NB = 8>
DEV int gemm_tile(const bf16_t* __restrict__ A, int lda, const bf16_t* __restrict__ Bt, int ldb, int K, int m0, int n0, char* lds, const Epi& epi, unsigned* nctr = nullptr) {
  int tid = threadIdx.x; LAUNDER(tid);
  const int lane = tid & 63, w = __builtin_amdgcn_readfirstlane(tid >> 6), wr = w >> 1, wc = w & 1;
  const int fr = lane & 15, fq = lane >> 4;
  const int sb = lane * 16, swz = sb ^ (((sb >> 9) & 1) << 5), rl = swz >> 6, cl = (swz & 63) >> 1;
  const bf16_t* ga[4]; const bf16_t* gb[4];
#pragma unroll
  for (int i = 0; i < 4; ++i) {
    const int st = 4 * w + i, r = (st >> 1) * 16 + rl, c = (st & 1) * 32 + cl;
    ga[i] = A + (size_t)(m0 + r) * lda + c;
    gb[i] = Bt + (size_t)(n0 + r) * ldb + c;
  }
  const int nk = K / 64;
#define GSTAGE(S, KT) { _Pragma("unroll") for (int i = 0; i < 4; ++i) { \
      __builtin_amdgcn_global_load_lds((const unsigned*)(ga[i] + (KT) * 64), (LAS3 unsigned*)(lds + (S) * 32768 + (4 * w + i) * 1024 + lane * 16), 16, 0, 0); \
      if (2 * w + (i >> 1) < NB) __builtin_amdgcn_global_load_lds((const unsigned*)(gb[i] + (KT) * 64), (LAS3 unsigned*)(lds + (S) * 32768 + 16384 + (4 * w + i) * 1024 + lane * 16), 16, 0, 0); } }
  f32x4 acc[4][4];
#pragma unroll
  for (int i = 0; i < 4; ++i)
#pragma unroll
    for (int j = 0; j < 4; ++j) acc[i][j] = (f32x4){0.f, 0.f, 0.f, 0.f};
  int offA[2], offB[2];
#pragma unroll
  for (int kh = 0; kh < 2; ++kh) { offA[kh] = lds_byte(wr * 64 + fr, kh * 32 + fq * 8); offB[kh] = lds_byte(wc * 64 + fr, kh * 32 + fq * 8); }
  GSTAGE(0, 0)
  if (nk > 1) GSTAGE(1, 1)
  for (int kt = 0; kt < nk; ++kt) {
    const int s = kt & 1;
    if (kt + 1 < nk) { if (2 * w < NB) asm volatile("s_waitcnt vmcnt(8)" ::: "memory"); else asm volatile("s_waitcnt vmcnt(4)" ::: "memory"); }
    else asm volatile("s_waitcnt vmcnt(0)" ::: "memory");
    RAW_BARRIER()
    const char* ia = lds + s * 32768;
    const char* ib = ia + 16384;
    bf16x8 af[2][4], bfv[2][4];
#pragma unroll
    for (int kh = 0; kh < 2; ++kh) {
#pragma unroll
      for (int mi = 0; mi < 4; ++mi) af[kh][mi] = *(const bf16x8*)(ia + offA[kh] + mi * 2048);
#pragma unroll
      for (int ni = 0; ni < (NB < 4 ? NB : 4); ++ni) bfv[kh][ni] = *(const bf16x8*)(ib + offB[kh] + ni * 2048);
    }
    asm volatile("s_waitcnt lgkmcnt(0)" ::: "memory");
    RAW_BARRIER()
    if (kt + 2 < nk) GSTAGE(s, kt + 2)
    __builtin_amdgcn_sched_barrier(0);
    if (NB == 8 || wc == 0) {
#pragma unroll
      for (int kh = 0; kh < 2; ++kh)
#pragma unroll
        for (int mi = 0; mi < 4; ++mi)
#pragma unroll
          for (int ni = 0; ni < (NB < 4 ? NB : 4); ++ni) acc[mi][ni] = mfma16(bfv[kh][ni], af[kh][mi], acc[mi][ni]);
    }
  }
  __syncthreads();
#undef GSTAGE
  int tk = 0x7fffffff; if (nctr && tid == 0) tk = (int)atomicAdd(nctr, 1u);
  if (NB == 8 || wc == 0) epi(acc, m0 + wr * 64, n0 + wc * 64, fr, fq);
  return tk;
}

DEV int lds_byte32(int r, int c) { const int rr = r & 15, ob = rr * 64 + c * 2; return (r >> 4) * 1024 + (ob ^ (((ob >> 9) & 1) << 5)); }
template <class Epi>
DEV void gemm_tile_big(const bf16_t* __restrict__ A, int lda, const bf16_t* __restrict__ Bt, int ldb, int K, int m0, int n0, char* lds, const Epi& epi) {
  int tid = threadIdx.x; LAUNDER(tid);
  const int lane = tid & 63, w = __builtin_amdgcn_readfirstlane(tid >> 6), wr = w >> 1, wc = w & 1;
  const int fr = lane & 15, fq = lane >> 4;
  const int sb = lane * 16, swz = sb ^ (((sb >> 9) & 1) << 5), rl = swz >> 6, cl = (swz & 63) >> 1;
  const bf16_t* ga[4]; const bf16_t* gb[2];
#pragma unroll
  for (int i = 0; i < 4; ++i) ga[i] = A + (size_t)(m0 + (4 * w + i) * 16 + rl) * lda + cl;
#pragma unroll
  for (int i = 0; i < 2; ++i) gb[i] = Bt + (size_t)(n0 + (2 * w + i) * 16 + rl) * ldb + cl;
  const int nk = K / 32;
#define GSTAGE3(S, KT) { _Pragma("unroll") for (int i = 0; i < 4; ++i) \
      __builtin_amdgcn_global_load_lds((const unsigned*)(ga[i] + (KT) * 32), (LAS3 unsigned*)(lds + (S) * 24576 + (4 * w + i) * 1024 + lane * 16), 16, 0, 0); \
    _Pragma("unroll") for (int i = 0; i < 2; ++i) \
      __builtin_amdgcn_global_load_lds((const unsigned*)(gb[i] + (KT) * 32), (LAS3 unsigned*)(lds + (S) * 24576 + 16384 + (2 * w + i) * 1024 + lane * 16), 16, 0, 0); }
  f32x4 acc[8][4];
#pragma unroll
  for (int i = 0; i < 8; ++i)
#pragma unroll
    for (int j = 0; j < 4; ++j) acc[i][j] = (f32x4){0.f, 0.f, 0.f, 0.f};
  const int offA = lds_byte32(wr * 128 + fr, fq * 8), offB = 16384 + lds_byte32(wc * 64 + fr, fq * 8);
  GSTAGE3(0, 0)
  if (nk > 1) GSTAGE3(1, 1)
  int s = 0;
  for (int kt = 0; kt < nk; ++kt) {
    if (kt + 1 < nk) asm volatile("s_waitcnt vmcnt(6)" ::: "memory"); else asm volatile("s_waitcnt vmcnt(0)" ::: "memory");
    RAW_BARRIER()
    if (kt + 2 < nk) { const int s2 = s + 2 >= 3 ? s - 1 : s + 2; GSTAGE3(s2, kt + 2) }
    const char* im = lds + s * 24576;
    bf16x8 af[8], bfv[4];
#pragma unroll
    for (int ni = 0; ni < 4; ++ni) bfv[ni] = *(const bf16x8*)(im + offB + ni * 1024);
#pragma unroll
    for (int mi = 0; mi < 8; ++mi) af[mi] = *(const bf16x8*)(im + offA + mi * 1024);
#pragma unroll
    for (int mi = 0; mi < 8; ++mi)
#pragma unroll
      for (int ni = 0; ni < 4; ++ni) acc[mi][ni] = mfma16(bfv[ni], af[mi], acc[mi][ni]);
    s = s + 1 >= 3 ? 0 : s + 1;
  }
  __syncthreads();
#undef GSTAGE3
  epi(acc, m0 + wr * 128, n0 + wc * 64, fr, fq);
}

struct EpiIn {
  const Prm& p; int L;
  template <int MI>
  DEV void operator()(f32x4 (&acc)[MI][4], int mb, int nb, int fr, int fq) const {
#pragma unroll
    for (int mi = 0; mi < MI; ++mi) {
      const int m = mb + 16 * mi + fr;
      const bool ok = m < NT;
      const float rstd = rsqrtf(p.ssq_x[L * NTP + m] * (1.f / 1024.f) + RMS_EPS);
      float sq = 0.f;
#pragma unroll
      for (int g = 0; g < 2; ++g) {
        const int n0 = nb + 32 * g;
        if (n0 >= 3104) continue;
        bf16_t* dst = n0 < ZL ? p.zL + (size_t)m * ZL + n0 : p.zE + (size_t)m * ZE + (n0 - ZL);
        float v[8];
#pragma unroll
        for (int j = 0; j < 4; ++j) { v[j] = acc[mi][2 * g][j] * rstd; v[4 + j] = acc[mi][2 * g + 1][j] * rstd; }
#pragma unroll
        for (int j = 0; j < 8; ++j) sq += v[j] * v[j];
        if (ok) { uint4 o; o.x = pk2(v[0], v[1]); o.y = pk2(v[2], v[3]); o.z = pk2(v[4], v[5]); o.w = pk2(v[6], v[7]); *(uint4*)(dst + 8 * fq) = o; }
      }
      if (nb >= ZL && nb < ZL + 384) {
        sq += __shfl_xor(sq, 16); sq += __shfl_xor(sq, 32);
        if (fq == 0 && ok) atomicAdd((nb < ZL + 256 ? p.ssq_q : p.ssq_kv) + L * NTP + m, sq);
      }
    }
  }
};
struct EpiQ {
  const Prm& p; int L;
  DEV void operator()(f32x4 (&acc)[4][4], int mb, int nb, int fr, int fq) const {
    bf16_t* Qb = (bf16_t*)p.y_prompt;
#pragma unroll
    for (int mi = 0; mi < 4; ++mi) {
      const int m = mb + 16 * mi + fr;
      const bool ok = m < NT;
      const float rstd = rsqrtf(p.ssq_q[L * NTP + m] * (1.f / 256.f) + RMS_EPS);
      const int pos = pos_of(ok ? m : 0);
#pragma unroll
      for (int np = 0; np < 2; ++np) {
        const int n0 = nb + 32 * np;
        float v[2][4];
#pragma unroll
        for (int h2 = 0; h2 < 2; ++h2)
#pragma unroll
          for (int j = 0; j < 4; ++j) v[h2][j] = acc[mi][2 * np + h2][j] * rstd;
        if (((n0 >> 5) % 3) == 2) {
#pragma unroll
          for (int j = 0; j < 4; ++j) {
            const int c = 4 * fq + j;
            const float cs = p.ropec[pos * 16 + c], sn = p.ropes[pos * 16 + c];
            const float x1 = v[0][j], x2 = v[1][j];
            v[0][j] = x1 * cs - x2 * sn; v[1][j] = x1 * sn + x2 * cs;
          }
        }
        if (ok) {
          *(uint2*)(Qb + (size_t)m * 768 + n0 + 4 * fq) = pk4(v[0][0], v[0][1], v[0][2], v[0][3]);
          *(uint2*)(Qb + (size_t)m * 768 + n0 + 16 + 4 * fq) = pk4(v[1][0], v[1][1], v[1][2], v[1][3]);
        }
      }
    }
  }
};
struct EpiOut {
  const Prm& p; int L;
  DEV void operator()(f32x4 (&acc)[4][4], int mb, int nb, int fr, int fq) const {
#pragma unroll
    for (int mi = 0; mi < 4; ++mi) {
      const int m = mb + 16 * mi + fr;
      const bool ok = m < NT;
      bf16_t* xr = p.xb + (size_t)(ok ? m : 0) * D;
      float ss = 0.f;
#pragma unroll
      for (int g = 0; g < 2; ++g) {
        const int col = nb + 32 * g + 8 * fq;
        const uint4 xi = *(const uint4*)(xr + col);
        float v[8] = {bflo(xi.x), bfhi(xi.x), bflo(xi.y), bfhi(xi.y), bflo(xi.z), bfhi(xi.z), bflo(xi.w), bfhi(xi.w)};
#pragma unroll
        for (int j = 0; j < 4; ++j) { v[j] += acc[mi][2 * g][j]; v[4 + j] += acc[mi][2 * g + 1][j]; }
#pragma unroll
        for (int j = 0; j < 8; ++j) ss += v[j] * v[j];
        if (ok) { uint4 o; o.x = pk2(v[0], v[1]); o.y = pk2(v[2], v[3]); o.z = pk2(v[4], v[5]); o.w = pk2(v[6], v[7]); *(uint4*)(xr + col) = o; }
      }
      ss += __shfl_xor(ss, 16); ss += __shfl_xor(ss, 32);
      if (fq == 0 && ok) atomicAdd(p.ssq_x + (L + 1) * NTP + m, ss);
    }
  }
};

DEV void kv_prep_row(const Prm& p, int L, int R, int half, bool valid, bf16_t* At_row  ) {
  const int Rl = valid ? R : 0;
  const bf16_t* zr = p.zE + (size_t)Rl * ZE;
  const float rstd = rsqrtf(p.ssq_kv[L * NTP + Rl] * (1.f / 128.f) + RMS_EPS);
  float* outc; float* outk;
  if (Rl < NPR) { const int s = Rl / PT, q = Rl - s * PT; outc = p.ckv_p + (((size_t)L * 4 + s) * PT + q) * 128; outk = p.kr_p + (((size_t)L * 4 + s) * PT + q) * 32; }
  else { const int j = Rl - NPR; outc = p.ckv_s + ((size_t)L * NSM + j) * 128; outk = p.kr_s + ((size_t)L * NSM + j) * 32; }
  const float* g = p.kv_norm_g + L * 128 + 64 * half;
#pragma unroll
  for (int c8 = 0; c8 < 8; ++c8) {
    const uint4 u = *(const uint4*)(zr + ZE_CKV + 64 * half + 8 * c8);
    const float4 g0 = *(const float4*)(g + 8 * c8), g1 = *(const float4*)(g + 8 * c8 + 4);
    float4 y0, y1;
    y0.x = bflo(u.x) * rstd * g0.x; y0.y = bfhi(u.x) * rstd * g0.y; y0.z = bflo(u.y) * rstd * g0.z; y0.w = bfhi(u.y) * rstd * g0.w;
    y1.x = bflo(u.z) * rstd * g1.x; y1.y = bfhi(u.z) * rstd * g1.y; y1.z = bflo(u.w) * rstd * g1.z; y1.w = bfhi(u.w) * rstd * g1.w;
    if (valid) { *(float4*)(outc + 64 * half + 8 * c8) = y0; *(float4*)(outc + 64 * half + 8 * c8 + 4) = y1; }
    if (At_row) { uint4 o; o.x = pk2(y0.x, y0.y); o.y = pk2(y0.z, y0.w); o.z = pk2(y1.x, y1.y); o.w = pk2(y1.z, y1.w); *(uint4*)(At_row + 64 * half + 8 * c8) = o; }
    if (c8 & 1) __builtin_amdgcn_sched_barrier(0);
  }
  if (half == 0) {
    const int pos = pos_of(Rl);
#pragma unroll
    for (int c8 = 0; c8 < 2; ++c8) {
      const uint4 u = *(const uint4*)(zr + ZE_KR + 8 * c8), v = *(const uint4*)(zr + ZE_KR + 16 + 8 * c8);
      const float x1[8] = {bflo(u.x), bfhi(u.x), bflo(u.y), bfhi(u.y), bflo(u.z), bfhi(u.z), bflo(u.w), bfhi(u.w)};
      const float x2[8] = {bflo(v.x), bfhi(v.x), bflo(v.y), bfhi(v.y), bflo(v.z), bfhi(v.z), bflo(v.w), bfhi(v.w)};
      float y1[8], y2[8];
#pragma unroll
      for (int e = 0; e < 8; ++e) {
        const float cs = p.ropec[pos * 16 + 8 * c8 + e], sn = p.ropes[pos * 16 + 8 * c8 + e];
        y1[e] = x1[e] * cs - x2[e] * sn; y2[e] = x1[e] * sn + x2[e] * cs;
      }
      if (valid) {
        float4 o;
        o.x = y1[0]; o.y = y1[1]; o.z = y1[2]; o.w = y1[3]; *(float4*)(outk + 8 * c8) = o;
        o.x = y1[4]; o.y = y1[5]; o.z = y1[6]; o.w = y1[7]; *(float4*)(outk + 8 * c8 + 4) = o;
        o.x = y2[0]; o.y = y2[1]; o.z = y2[2]; o.w = y2[3]; *(float4*)(outk + 16 + 8 * c8) = o;
        o.x = y2[4]; o.y = y2[5]; o.z = y2[6]; o.w = y2[7]; *(float4*)(outk + 16 + 8 * c8 + 4) = o;
        if (Rl < NPR) {
          uint4 q; q.x = pk2(y1[0], y1[1]); q.y = pk2(y1[2], y1[3]); q.z = pk2(y1[4], y1[5]); q.w = pk2(y1[6], y1[7]); *(uint4*)(p.Kr + (size_t)Rl * 32 + 8 * c8) = q;
          q.x = pk2(y2[0], y2[1]); q.y = pk2(y2[2], y2[3]); q.z = pk2(y2[4], y2[5]); q.w = pk2(y2[6], y2[7]); *(uint4*)(p.Kr + (size_t)Rl * 32 + 16 + 8 * c8) = q;
        }
      }
    }
  }
}
DEV void kvproj_item(const Prm& p, int L, int mt, char* lds) {
  int tid = threadIdx.x; LAUNDER(tid);
  const int lane = tid & 63, w = __builtin_amdgcn_readfirstlane(tid >> 6), wr = w >> 1, wc = w & 1, l31 = lane & 31, hh = lane >> 5;
  bf16_t* At = (bf16_t*)lds;
  bf16_t* Bs = At + 128 * 136;
  {
    const int r = tid >> 1, half = tid & 1, R = mt * 128 + r;
    kv_prep_row(p, L, R, half, R < NPR, At + r * 136);
  }
  for (int h = 0; h < 8; ++h) {
    __syncthreads();
    {
      const bf16_t* wsrc = p.Wb_ukv + ((size_t)L * 1024 + h * 128) * 128;
#pragma unroll
      for (int i = 0; i < 8; ++i) { const int id = tid + 256 * i, row = id >> 4, cc = id & 15; *(uint4*)(Bs + row * 136 + cc * 8) = *(const uint4*)(wsrc + row * 128 + cc * 8); }
    }
    __syncthreads();
    f32x16 acc[2][2];
#pragma unroll
    for (int i = 0; i < 2; ++i)
#pragma unroll
      for (int j = 0; j < 2; ++j) acc[i][j] = zero16();
    const bf16_t* as = At + (wr * 64 + l31) * 136 + hh * 8;
    const bf16_t* bs = Bs + (wc * 64 + l31) * 136 + hh * 8;
    if (wc == 0) {
#pragma unroll 2
      for (int ks = 0; ks < 8; ++ks) {
        const bf16x8 a0 = *(const bf16x8*)(as + ks * 16), a1 = *(const bf16x8*)(as + 32 * 136 + ks * 16);
        const bf16x8 b0 = *(const bf16x8*)(bs + ks * 16), b1 = *(const bf16x8*)(bs + 32 * 136 + ks * 16);
        acc[0][0] = mfma32(b0, a0, acc[0][0]); acc[0][1] = mfma32(b1, a0, acc[0][1]);
        acc[1][0] = mfma32(b0, a1, acc[1][0]); acc[1][1] = mfma32(b1, a1, acc[1][1]);
      }
#pragma unroll
      for (int i = 0; i < 2; ++i) {
        const int KRr = mt * 128 + wr * 64 + 32 * i + l31;
#pragma unroll
        for (int j = 0; j < 2; ++j)
#pragma unroll
          for (int G = 0; G < 4; ++G)
            *(uint2*)(p.Kn + ((size_t)KRr * 8 + h) * 64 + 32 * j + 8 * G + 4 * hh) = pk4(acc[i][j][4 * G], acc[i][j][4 * G + 1], acc[i][j][4 * G + 2], acc[i][j][4 * G + 3]);
      }
    } else {
#pragma unroll 2
      for (int ks = 0; ks < 8; ++ks) {
        const bf16x8 a0 = *(const bf16x8*)(as + ks * 16), a1 = *(const bf16x8*)(as + 32 * 136 + ks * 16);
        const bf16x8 b0 = *(const bf16x8*)(bs + ks * 16), b1 = *(const bf16x8*)(bs + 32 * 136 + ks * 16);
        acc[0][0] = mfma32(a0, b0, acc[0][0]); acc[0][1] = mfma32(a0, b1, acc[0][1]);
        acc[1][0] = mfma32(a1, b0, acc[1][0]); acc[1][1] = mfma32(a1, b1, acc[1][1]);
      }
#pragma unroll
      for (int j = 0; j < 2; ++j) {
        const int d = 32 * j + l31;
#pragma unroll
        for (int i = 0; i < 2; ++i)
#pragma unroll
          for (int G = 0; G < 4; ++G) {
            const int KRr = mt * 128 + wr * 64 + 32 * i + 8 * G + 4 * hh;
            *(uint2*)(p.Vt + ((size_t)h * 64 + d) * KVR + KRr) = pk4(acc[i][j][4 * G], acc[i][j][4 * G + 1], acc[i][j][4 * G + 2], acc[i][j][4 * G + 3]);
          }
      }
    }
  }
  __syncthreads();
}
DEV void sample_prep_item(const Prm& p, int L, int it) {
  int tid = threadIdx.x; LAUNDER(tid);
  const int R = NPR + it * 128 + (tid >> 1);
  kv_prep_row(p, L, R, tid & 1, true, nullptr);
}
DEV void shift_item(const Prm& p, int L, int st) {
  int tid0 = threadIdx.x; LAUNDER(tid0);
  if (tid0 < 224) {
    const int R = st < 4 ? st * PT + (PT - 1) : NPR + (st - 4) * 64 + 63;
    const uint2 u = *(const uint2*)(p.zE + (size_t)R * ZE + ZE_ZC + 4 * tid0);
    float4 v; v.x = bflo(u.x); v.y = bfhi(u.x); v.z = bflo(u.y); v.w = bfhi(u.y);
    float* dst = st < 4 ? p.shift_p + ((size_t)L * 4 + st) * 896 : p.shift_s + ((size_t)L * 32 + (st - 4)) * 896;
    *(float4*)(dst + 4 * tid0) = v;
  }
}

template <bool SAMPLE>
DEV int attn_body(const Prm& p, int L, int sb, int head, int qt, char* lds, unsigned* nctr = nullptr) {
  int tid = threadIdx.x; LAUNDER(tid);
  const int lane = tid & 63, w = __builtin_amdgcn_readfirstlane(tid >> 6), l31 = lane & 31, hh = lane >> 5;
  bf16_t* Ks = (bf16_t*)lds;
  bf16_t* Vs = Ks + (SAMPLE ? 1 : 2) * 64 * 104;
  bf16_t* Cs = Vs + (SAMPLE ? 1 : 2) * 64 * 72;
  bf16_t* Wl = Cs + 64 * 136;
  const bf16_t* Qb = (const bf16_t*)p.y_prompt;
  bf16_t* mix = p.zE;
  int Rq0, ntiles, lastvis; bool wact, rowvalid;
  if (SAMPLE) { Rq0 = NPR + 64 * sb; ntiles = 17; lastvis = 16; wact = w < 2; rowvalid = wact; }
  else if (qt >= 0) { Rq0 = sb * PT + 16 + 128 * qt; ntiles = 2 * qt + 3; lastvis = 1 + 2 * qt + (w >> 1); wact = true; rowvalid = true; }
  else { Rq0 = sb * PT; ntiles = 1; lastvis = 0; wact = (w == 0); rowvalid = wact && l31 < 16; }
  const int myrow = Rq0 + 32 * w + l31;
  const int Rld = rowvalid ? myrow : Rq0;
  bf16x8 qf[6];
  {
    const bf16_t* qp = Qb + (size_t)Rld * 768 + head * 96 + hh * 8;
#pragma unroll
    for (int ks = 0; ks < 6; ++ks) qf[ks] = *(const bf16x8*)(qp + 16 * ks);
  }
  float m_run = -1e30f, l_run = 0.f;
  f32x16 o0 = zero16(), o1 = zero16();

  uint4 a_kn0, a_kn1, a_kr, a_vt0, a_vt1, b_kn0, b_kn1, b_kr, b_vt0, b_vt1;
  a_kn0 = a_kn1 = a_kr = a_vt0 = a_vt1 = b_kn0 = b_kn1 = b_kr = b_vt0 = b_vt1 = make_uint4(0, 0, 0, 0);
#define PLOADX(S, TI) { const int KR0 = sb * PT + ((TI) == 0 ? 0 : 16 + 64 * ((TI) - 1)); \
    S##_kn0 = *(const uint4*)(p.Kn + ((size_t)(KR0 + (tid >> 3)) * 8 + head) * 64 + (tid & 7) * 8); \
    S##_kn1 = *(const uint4*)(p.Kn + ((size_t)(KR0 + 32 + (tid >> 3)) * 8 + head) * 64 + (tid & 7) * 8); \
    S##_kr = *(const uint4*)(p.Kr + (size_t)(KR0 + (tid >> 2)) * 32 + (tid & 3) * 8); \
    S##_vt0 = *(const uint4*)(p.Vt + ((size_t)head * 64 + (tid >> 3)) * KVR + KR0 + (tid & 7) * 8); \
    S##_vt1 = *(const uint4*)(p.Vt + ((size_t)head * 64 + 32 + (tid >> 3)) * KVR + KR0 + (tid & 7) * 8); }
#define PWRITEX(S, BUF) { bf16_t* kb_ = Ks + (BUF) * 64 * 104; bf16_t* vb_ = Vs + (BUF) * 64 * 72; \
    *(uint4*)(kb_ + (tid >> 3) * 104 + (tid & 7) * 8) = S##_kn0; *(uint4*)(kb_ + (32 + (tid >> 3)) * 104 + (tid & 7) * 8) = S##_kn1; \
    *(uint4*)(kb_ + (tid >> 2) * 104 + 64 + (tid & 3) * 8) = S##_kr; \
    *(uint4*)(vb_ + (tid >> 3) * 72 + (tid & 7) * 8) = S##_vt0; *(uint4*)(vb_ + (32 + (tid >> 3)) * 72 + (tid & 7) * 8) = S##_vt1; }
  float4 pc0, pc1, pc2, pc3, pc4, pc5, pc6, pc7, pk0, pk1;
  pc0 = pc1 = pc2 = pc3 = pc4 = pc5 = pc6 = pc7 = pk0 = pk1 = make_float4(0.f, 0.f, 0.f, 0.f);
  if (SAMPLE) {
    const bf16_t* wsrc = p.Wb_ukv + ((size_t)L * 1024 + head * 128) * 128;
#pragma unroll
    for (int i = 0; i < 8; ++i) { const int id = tid + 256 * i, row = id >> 4, cc = id & 15; *(uint4*)(Wl + row * 136 + cc * 8) = *(const uint4*)(wsrc + row * 128 + cc * 8); }
  }
#define SLOAD(TI) { const float* csrc; const float* ksrc; \
    if ((TI) < 16) { csrc = p.cache_ckv + (((size_t)L * 32 + sb) * 1024 + 64 * (TI)) * 128; ksrc = p.cache_krope + (((size_t)L * 32 + sb) * 1024 + 64 * (TI)) * 32; } \
    else { csrc = p.ckv_s + ((size_t)L * NSM + 64 * sb) * 128; ksrc = p.kr_s + ((size_t)L * NSM + 64 * sb) * 32; } \
    const float* cb_ = csrc + (tid >> 5) * 128 + (tid & 31) * 4; \
    pc0 = *(const float4*)(cb_); pc1 = *(const float4*)(cb_ + 8 * 128); pc2 = *(const float4*)(cb_ + 16 * 128); pc3 = *(const float4*)(cb_ + 24 * 128); \
    pc4 = *(const float4*)(cb_ + 32 * 128); pc5 = *(const float4*)(cb_ + 40 * 128); pc6 = *(const float4*)(cb_ + 48 * 128); pc7 = *(const float4*)(cb_ + 56 * 128); \
    const float* kb2_ = ksrc + (tid >> 3) * 32 + (tid & 7) * 4; pk0 = *(const float4*)(kb2_); pk1 = *(const float4*)(kb2_ + 32 * 32); }
#define SWRITE(BUF) { bf16_t* cd_ = Cs + (tid >> 5) * 136 + (tid & 31) * 4; \
    *(uint2*)(cd_) = pk4(pc0.x, pc0.y, pc0.z, pc0.w); *(uint2*)(cd_ + 8 * 136) = pk4(pc1.x, pc1.y, pc1.z, pc1.w); \
    *(uint2*)(cd_ + 16 * 136) = pk4(pc2.x, pc2.y, pc2.z, pc2.w); *(uint2*)(cd_ + 24 * 136) = pk4(pc3.x, pc3.y, pc3.z, pc3.w); \
    *(uint2*)(cd_ + 32 * 136) = pk4(pc4.x, pc4.y, pc4.z, pc4.w); *(uint2*)(cd_ + 40 * 136) = pk4(pc5.x, pc5.y, pc5.z, pc5.w); \
    *(uint2*)(cd_ + 48 * 136) = pk4(pc6.x, pc6.y, pc6.z, pc6.w); *(uint2*)(cd_ + 56 * 136) = pk4(pc7.x, pc7.y, pc7.z, pc7.w); \
    }
#define SWRITEK(BUF) { bf16_t* kd_ = Ks + (BUF) * 64 * 104 + (tid >> 3) * 104 + 64 + (tid & 7) * 4; \
    *(uint2*)(kd_) = pk4(pk0.x, pk0.y, pk0.z, pk0.w); *(uint2*)(kd_ + 32 * 104) = pk4(pk1.x, pk1.y, pk1.z, pk1.w); }
  auto sexpand = [&](int buf) {
    const int a = w & 1, b = w >> 1;
    const bf16_t* cp = Cs + (32 * b + l31) * 136 + hh * 8;
    const bf16_t* wkp = Wl + (32 * a + l31) * 136 + hh * 8;
    const bf16_t* wvp = wkp + 64 * 136;
    f32x16 ka = zero16(), va = zero16();
#pragma unroll
    for (int ks = 0; ks < 8; ++ks) {
      const bf16x8 cf = *(const bf16x8*)(cp + 16 * ks);
      ka = mfma32(*(const bf16x8*)(wkp + 16 * ks), cf, ka);
      va = mfma32(cf, *(const bf16x8*)(wvp + 16 * ks), va);
    }
    bf16_t* kb = Ks + buf * 64 * 104; bf16_t* vb = Vs + buf * 64 * 72;
#pragma unroll
    for (int G = 0; G < 4; ++G) {
      *(uint2*)(kb + (32 * b + l31) * 104 + 32 * a + 8 * G + 4 * hh) = pk4(ka[4 * G], ka[4 * G + 1], ka[4 * G + 2], ka[4 * G + 3]);
      *(uint2*)(vb + (32 * a + l31) * 72 + 32 * b + 8 * G + 4 * hh) = pk4(va[4 * G], va[4 * G + 1], va[4 * G + 2], va[4 * G + 3]);
    }
  };
  auto compute_t = [&](auto masked_c, int buf) {
    constexpr bool MASKED = decltype(masked_c)::value;
    const bf16_t* kb = Ks + buf * 64 * 104 + l31 * 104 + hh * 8;
    const bf16_t* vb = Vs + buf * 64 * 72 + l31 * 72 + 4 * hh;
    f32x16 s0 = zero16(), s1 = zero16();
#pragma unroll
    for (int ks = 0; ks < 6; ++ks) {
      const bf16x8 k0 = *(const bf16x8*)(kb + 16 * ks), k1 = *(const bf16x8*)(kb + 32 * 104 + 16 * ks);
      s0 = mfma32(k0, qf[ks], s0); s1 = mfma32(k1, qf[ks], s1);
    }
    if (!SAMPLE && MASKED) {
#pragma unroll
      for (int r = 8; r < 16; ++r) s0[r] = -1e30f;
#pragma unroll
      for (int r = 0; r < 16; ++r) s1[r] = -1e30f;
    }
    float mx = s0[0];
#pragma unroll
    for (int r = 1; r < 16; ++r) mx = fmaxf(mx, s0[r]);
#pragma unroll
    for (int r = 0; r < 16; ++r) mx = fmaxf(mx, s1[r]);
    mx = fmaxf(mx, __shfl_xor(mx, 32));
    const float mnew = fmaxf(m_run, mx);
    const float alpha = __builtin_amdgcn_exp2f(m_run - mnew);
    m_run = mnew;
    float ps = 0.f;
#pragma unroll
    for (int r = 0; r < 16; ++r) { s0[r] = __builtin_amdgcn_exp2f(s0[r] - mnew); ps += s0[r]; }
#pragma unroll
    for (int r = 0; r < 16; ++r) { s1[r] = __builtin_amdgcn_exp2f(s1[r] - mnew); ps += s1[r]; }
    l_run = l_run * alpha + ps;
#pragma unroll
    for (int r = 0; r < 16; ++r) { o0[r] *= alpha; o1[r] *= alpha; }
    const bf16x8 pf0 = mk8(pk2(s0[0], s0[1]), pk2(s0[2], s0[3]), pk2(s0[4], s0[5]), pk2(s0[6], s0[7]));
    const bf16x8 pf1 = mk8(pk2(s0[8], s0[9]), pk2(s0[10], s0[11]), pk2(s0[12], s0[13]), pk2(s0[14], s0[15]));
    const bf16x8 pf2 = mk8(pk2(s1[0], s1[1]), pk2(s1[2], s1[3]), pk2(s1[4], s1[5]), pk2(s1[6], s1[7]));
    const bf16x8 pf3 = mk8(pk2(s1[8], s1[9]), pk2(s1[10], s1[11]), pk2(s1[12], s1[13]), pk2(s1[14], s1[15]));
#define PV_STEP(S, PF) { const uint2 a0 = *(const uint2*)(vb + 16 * S), b0 = *(const uint2*)(vb + 16 * S + 8); \
      const uint2 a1 = *(const uint2*)(vb + 32 * 72 + 16 * S), b1 = *(const uint2*)(vb + 32 * 72 + 16 * S + 8); \
      o0 = mfma32(mk8(a0.x, a0.y, b0.x, b0.y), PF, o0); o1 = mfma32(mk8(a1.x, a1.y, b1.x, b1.y), PF, o1); }
    PV_STEP(0, pf0) PV_STEP(1, pf1) PV_STEP(2, pf2) PV_STEP(3, pf3)
#undef PV_STEP
  };

  auto compute = [&](int ti, int buf) { if (!SAMPLE && ti == 0) compute_t(std::true_type{}, buf); else compute_t(std::false_type{}, buf); };
  if (SAMPLE) {
    SLOAD(0)
    for (int ti = 0; ti < ntiles; ++ti) {
      const int buf = 0;
      SWRITE(buf)
      __syncthreads();
      SWRITEK(buf)
      { const int tn = ti + 1 < ntiles ? ti + 1 : ti; SLOAD(tn) }
      sexpand(buf);
      __syncthreads();
      if (wact) compute(ti, buf);
    }
    __syncthreads();
  } else {
    const int tl = ntiles - 1;
    PLOADX(a, 0) PLOADX(b, (1 < tl ? 1 : tl))
    PWRITEX(a, 0) __syncthreads();
    int ti = 0;
    for (; ti + 1 < ntiles; ti += 2) {
      { const int tn = ti + 2 < tl ? ti + 2 : tl; PLOADX(a, tn) }
      compute(ti, 0);
      PWRITEX(b, 1)
      __syncthreads();
      { const int tn = ti + 3 < tl ? ti + 3 : tl; PLOADX(b, tn) }
      compute(ti + 1, 1);
      PWRITEX(a, 0)
      __syncthreads();
    }
    if (wact && ti <= lastvis) compute(ti, 0);
    __syncthreads();
  }
  int tk = 0x7fffffff; if (nctr && tid == 0) tk = (int)atomicAdd(nctr, 1u);
  const float lt = l_run + __shfl_xor(l_run, 32);
  if (rowvalid) {
    const float inv = 1.f / lt;
    const bf16_t* gbp = p.zL + (size_t)myrow * ZL + ZL_GB + 64 * head;
    bf16_t* op = mix + (size_t)myrow * D + 256 + 64 * head;
#pragma unroll
    for (int G = 0; G < 4; ++G) {
      const int d = 8 * G + 4 * hh;
      const uint2 g0 = *(const uint2*)(gbp + d), g1 = *(const uint2*)(gbp + 32 + d);
      *(uint2*)(op + d) = pk4(o0[4 * G] * inv * silu_(bflo(g0.x)), o0[4 * G + 1] * inv * silu_(bfhi(g0.x)), o0[4 * G + 2] * inv * silu_(bflo(g0.y)), o0[4 * G + 3] * inv * silu_(bfhi(g0.y)));
      *(uint2*)(op + 32 + d) = pk4(o1[4 * G] * inv * silu_(bflo(g1.x)), o1[4 * G + 1] * inv * silu_(bfhi(g1.x)), o1[4 * G + 2] * inv * silu_(bflo(g1.y)), o1[4 * G + 3] * inv * silu_(bfhi(g1.y)));
    }
  }
  return tk;
}
DEV void attn_item(const Prm& p, int L, int id, char* lds) {
  if (id < 1024) { const int qt = 31 - (id >> 5), sh = id & 31; attn_body<false>(p, L, sh >> 3, sh & 7, qt, lds); }
  else if (id < 1280) { const int j = id - 1024; attn_body<true>(p, L, j >> 3, j & 7, 0, lds); }
  else { const int j = id - 1280; attn_body<false>(p, L, j >> 3, j & 7, -1, lds); }
}

DEV void conv_item(const Prm& p, int L, int item) {
  int tid = threadIdx.x; LAUNDER(tid);
  bf16_t* mix = p.zE;
  const int c0 = (tid & 31) * 8;
  float w0[8], w1[8], w2[8];
#pragma unroll
  for (int e = 0; e < 8; ++e) { w0[e] = p.conv_w[(L * 3 + 0) * 256 + c0 + e]; w1[e] = p.conv_w[(L * 3 + 1) * 256 + c0 + e]; w2[e] = p.conv_w[(L * 3 + 2) * 256 + c0 + e]; }
  for (int it = 0; it < 4; ++it) {
    const int R = item * 32 + it * 8 + (tid >> 5);
    if (R >= NT) continue;
    int q, T; const float* st; float* so;
    if (R < NPR) { const int s = R / PT; q = R - s * PT; T = PT; st = nullptr; so = p.conv_p + ((size_t)L * 4 + s) * 512; }
    else { const int b = (R - NPR) >> 6; q = (R - NPR) & 63; T = 64; st = p.state_conv + ((size_t)L * 32 + b) * 512; so = p.conv_s + ((size_t)L * 32 + b) * 512; }
    float u[3][8];
#pragma unroll
    for (int dlt = 0; dlt < 3; ++dlt) {
      const int t = q - 2 + dlt;
      if (t >= 0) {
        const bf16_t* zr = p.zL + (size_t)(R - 2 + dlt) * ZL;
        const uint4 xi = *(const uint4*)(zr + ZL_XIN + c0), cg = *(const uint4*)(zr + ZL_CG + c0);
        u[dlt][0] = bflo(xi.x) * bflo(cg.x); u[dlt][1] = bfhi(xi.x) * bfhi(cg.x); u[dlt][2] = bflo(xi.y) * bflo(cg.y); u[dlt][3] = bfhi(xi.y) * bfhi(cg.y);
        u[dlt][4] = bflo(xi.z) * bflo(cg.z); u[dlt][5] = bfhi(xi.z) * bfhi(cg.z); u[dlt][6] = bflo(xi.w) * bflo(cg.w); u[dlt][7] = bfhi(xi.w) * bfhi(cg.w);
      } else if (st) {
        const float* sr = st + (t + 2) * 256 + c0;
#pragma unroll
        for (int e = 0; e < 8; ++e) u[dlt][e] = sr[e];
      } else {
#pragma unroll
        for (int e = 0; e < 8; ++e) u[dlt][e] = 0.f;
      }
    }
    const bf16_t* zr = p.zL + (size_t)R * ZL;
    const uint4 bg = *(const uint4*)(zr + ZL_BG + c0), ga = *(const uint4*)(zr + ZL_GA + c0);
    const float bgf[8] = {bflo(bg.x), bfhi(bg.x), bflo(bg.y), bfhi(bg.y), bflo(bg.z), bfhi(bg.z), bflo(bg.w), bfhi(bg.w)};
    const float gaf[8] = {bflo(ga.x), bfhi(ga.x), bflo(ga.y), bfhi(ga.y), bflo(ga.z), bfhi(ga.z), bflo(ga.w), bfhi(ga.w)};
    float y[8];
#pragma unroll
    for (int e = 0; e < 8; ++e) y[e] = bgf[e] * (w0[e] * u[0][e] + w1[e] * u[1][e] + w2[e] * u[2][e]) * silu_(gaf[e]);
    uint4 o; o.x = pk2(y[0], y[1]); o.y = pk2(y[2], y[3]); o.z = pk2(y[4], y[5]); o.w = pk2(y[6], y[7]);
    *(uint4*)(mix + (size_t)R * D + c0) = o;
    if (q >= T - 2) {
      float* d = so + (q - (T - 2)) * 256 + c0;
#pragma unroll
      for (int e = 0; e < 8; ++e) d[e] = u[2][e];
    }
  }
}

DEV int kperm_addr(int m, int kin) {
  const int mt = m >> 4, ml = m & 15, s = kin >> 5, q = (kin >> 4) & 1, g = (kin >> 2) & 3, e = kin & 3;
  return (((mt * 2 + s) * 64 + ml + 16 * g) * 8) + 4 * q + e;
}
DEV int clay_addr(int x, int v) {
  const int xt = x >> 4, g = (x >> 2) & 3, rr = x & 3, vt = v >> 4, l16 = v & 15;
  return ((xt * 4 + vt) * 64 + 16 * g + l16) * 4 + rr;
}
DEV void mm64(const bf16_t* first, const bf16_t* second, int l31, int hh, f32x16 (&acc)[2][2]) {
#pragma unroll
  for (int ks = 0; ks < 4; ++ks) {
    const bf16x8 f0 = *(const bf16x8*)(first + l31 * 72 + ks * 16 + hh * 8), f1 = *(const bf16x8*)(first + (32 + l31) * 72 + ks * 16 + hh * 8);
    const bf16x8 s0 = *(const bf16x8*)(second + l31 * 72 + ks * 16 + hh * 8), s1 = *(const bf16x8*)(second + (32 + l31) * 72 + ks * 16 + hh * 8);
    acc[0][0] = mfma32(f0, s0, acc[0][0]); acc[0][1] = mfma32(f0, s1, acc[0][1]);
    acc[1][0] = mfma32(f1, s0, acc[1][0]); acc[1][1] = mfma32(f1, s1, acc[1][1]);
  }
}
DEV void mm64x32(const bf16_t* first, const bf16_t* second_rows, int l31, int hh, f32x16 (&acc)[2]) {
#pragma unroll
  for (int ks = 0; ks < 4; ++ks) {
    const bf16x8 f0 = *(const bf16x8*)(first + l31 * 72 + ks * 16 + hh * 8), f1 = *(const bf16x8*)(first + (32 + l31) * 72 + ks * 16 + hh * 8);
    const bf16x8 s0 = *(const bf16x8*)(second_rows + l31 * 72 + ks * 16 + hh * 8);
    acc[0] = mfma32(f0, s0, acc[0]); acc[1] = mfma32(f1, s0, acc[1]);
  }
}

DEV void mmq(const bf16_t* first_rows, const bf16_t* second_rows, int l31, int hh, f32x16& acc) {
#pragma unroll
  for (int ks = 0; ks < 4; ++ks) {
    const bf16x8 f0 = *(const bf16x8*)(first_rows + l31 * 72 + ks * 16 + hh * 8);
    const bf16x8 s0 = *(const bf16x8*)(second_rows + l31 * 72 + ks * 16 + hh * 8);
    acc = mfma32(f0, s0, acc);
  }
}
enum { SH_FULL = 0, SH_UP = 1, SH_LO = 2 };
template <int SH> DEV constexpr bool tile_nz(int tx, int ty) { return SH == SH_FULL || (SH == SH_UP ? tx <= ty : tx >= ty); }
struct Acc64 { f32x16 t[2][2]; };
struct Frag64 { bf16x8 f[4][2]; };
template <int SS> DEV bf16x8 pack8(const f32x16& v) {
  return mk8(pk2(v[8 * SS], v[8 * SS + 1]), pk2(v[8 * SS + 2], v[8 * SS + 3]), pk2(v[8 * SS + 4], v[8 * SS + 5]), pk2(v[8 * SS + 6], v[8 * SS + 7]));
}
template <int SH> DEV void to_frag(const Acc64& X, Frag64& F) {
#pragma unroll
  for (int t = 0; t < 2; ++t) {
    if (tile_nz<SH>(0, t)) { F.f[0][t] = pack8<0>(X.t[0][t]); F.f[1][t] = pack8<1>(X.t[0][t]); }
    if (tile_nz<SH>(1, t)) { F.f[2][t] = pack8<0>(X.t[1][t]); F.f[3][t] = pack8<1>(X.t[1][t]); }
  }
}
template <int SH> DEV void zero_acc(Acc64& X) {
#pragma unroll
  for (int a = 0; a < 2; ++a)
#pragma unroll
    for (int b = 0; b < 2; ++b) if (tile_nz<SH>(a, b)) X.t[a][b] = zero16();
}
template <int SHA, int SHB> DEV void prod_ff(const Frag64& A, const Frag64& B, Acc64& D) {
#pragma unroll
  for (int tm = 0; tm < 2; ++tm)
#pragma unroll
    for (int tn = 0; tn < 2; ++tn)
#pragma unroll
      for (int s = 0; s < 4; ++s)
        if (tile_nz<SHA>(s >> 1, tm) && tile_nz<SHB>(s >> 1, tn)) D.t[tm][tn] = mfma32(A.f[s][tm], B.f[s][tn], D.t[tm][tn]);
}
template <int SHA, int SHB, int SHD> DEV void prod_ff_frag(const Frag64& A, const Frag64& B, Frag64& Fo) {
#pragma unroll
  for (int tm = 0; tm < 2; ++tm)
#pragma unroll
    for (int tn = 0; tn < 2; ++tn)
      if (tile_nz<SHD>(tm, tn)) {
        f32x16 acc = zero16();
#pragma unroll
        for (int s = 0; s < 4; ++s)
          if (tile_nz<SHA>(s >> 1, tm) && tile_nz<SHB>(s >> 1, tn)) acc = mfma32(A.f[s][tm], B.f[s][tn], acc);
        Fo.f[2 * tm][tn] = pack8<0>(acc); Fo.f[2 * tm + 1][tn] = pack8<1>(acc);
      }
}
DEV bf16x8 nat_frag(const bf16_t* S, int row, int s, int hh) { return *(const bf16x8*)(S + row * 72 + 16 * s + 8 * hh); }
DEV bf16x8 perm_frag(const bf16_t* S, int row, int s, int hh) {
  const uint2 a = *(const uint2*)(S + row * 72 + 16 * s + 4 * hh), b = *(const uint2*)(S + row * 72 + 16 * s + 8 + 4 * hh);
  return mk8(a.x, a.y, b.x, b.y);
}
template <int SH, int MODE> DEV void gram(const bf16_t* F, const bf16_t* G, int l31, int hh, Acc64& D) {
  zero_acc<SH>(D);
#pragma unroll
  for (int s = 0; s < 4; ++s) {
    bf16x8 ff[2], gg[2];
#pragma unroll
    for (int t = 0; t < 2; ++t) { ff[t] = nat_frag(F, 32 * t + l31, s, hh); gg[t] = nat_frag(G, 32 * t + l31, s, hh); }
#pragma unroll
    for (int tx = 0; tx < 2; ++tx)
#pragma unroll
      for (int ty = 0; ty < 2; ++ty) if (tile_nz<SH>(tx, ty)) D.t[tx][ty] = mfma32(ff[tx], gg[ty], D.t[tx][ty]);
  }
#pragma unroll
  for (int t = 0; t < 2; ++t)
#pragma unroll
    for (int r = 0; r < 16; ++r) {
      const int x = (r & 3) + 8 * (r >> 2) + 4 * hh, y = l31;
      const bool keep = MODE == 0 ? (x < y) : (MODE == 1 ? (y < x) : (x <= y));
      if (!keep) D.t[t][t][r] = 0.f;
    }
}
template <int SHA> DEV void prod_fm_frag(const Frag64& A, const bf16_t* Mem, int l31, int hh, Frag64& Fo) {
#pragma unroll
  for (int tm = 0; tm < 2; ++tm)
#pragma unroll
    for (int tn = 0; tn < 2; ++tn) {
      f32x16 acc = zero16();
#pragma unroll
      for (int s = 0; s < 4; ++s) if (tile_nz<SHA>(s >> 1, tm)) acc = mfma32(A.f[s][tm], perm_frag(Mem, 32 * tn + l31, s, hh), acc);
      Fo.f[2 * tm][tn] = pack8<0>(acc); Fo.f[2 * tm + 1][tn] = pack8<1>(acc);
    }
}
template <int SHA> DEV void prod_fm(const Frag64& A, const bf16_t* Mem, int l31, int hh, Acc64& D) {
#pragma unroll
  for (int s = 0; s < 4; ++s) {
    bf16x8 mm[2];
#pragma unroll
    for (int t = 0; t < 2; ++t) mm[t] = perm_frag(Mem, 32 * t + l31, s, hh);
#pragma unroll
    for (int tm = 0; tm < 2; ++tm)
#pragma unroll
      for (int tn = 0; tn < 2; ++tn) if (tile_nz<SHA>(s >> 1, tm)) D.t[tm][tn] = mfma32(A.f[s][tm], mm[tn], D.t[tm][tn]);
  }
}
DEV void r1_item(const Prm& p, int L, int idx, char* lds) {
  int tid = threadIdx.x; LAUNDER(tid);
  const int w = __builtin_amdgcn_readfirstlane(tid >> 6);
  int lane = tid & 63, l31 = lane & 31, hh = lane >> 5;
  const int cw = w & 1, tw = w >> 1;
  bf16_t* S0 = (bf16_t*)lds;
  bf16_t* S1 = S0 + 4608; bf16_t* S2 = S1 + 4608; bf16_t* S3 = S2 + 4608; bf16_t* S4 = S3 + 4608; bf16_t* S5 = S4 + 4608; bf16_t* S6 = S5 + 4608; bf16_t* S7 = S6 + 4608;
  float* misc = (float*)(S7 + 4608);
  float* Ef = (float*)S4;
  bool prompt; int st, c, hd;
  if (idx < NRW_P) { prompt = true; st = idx / 260; const int rem = idx - st * 260; c = rem >> 2; hd = rem & 3; }
  else { prompt = false; const int j = idx - NRW_P; st = j >> 2; hd = j & 3; c = 0; }
  char* rwp = p.rw + (size_t)idx * RW_BYTES;
  const float* mu = p.shift_mu + L * 896;
  const int i1 = tid >> 2, m0 = (tid & 3) * 16;
  int R1; bool valid1, hasprev1;
  if (prompt) { const int pp = 64 * c - 48 + i1; valid1 = pp >= 0; R1 = st * PT + (valid1 ? pp : 0); hasprev1 = pp >= 1; }
  else { R1 = NPR + 64 * st + i1; valid1 = true; hasprev1 = i1 >= 1; }
  const bf16_t* zr1 = p.zE + (size_t)R1 * ZE + ZE_ZC;
  const int ti0 = 32 * tw + l31;
  int R; bool valid, hasprev;
  if (prompt) { const int pp = 64 * c - 48 + ti0; valid = pp >= 0; R = st * PT + (valid ? pp : 0); hasprev = pp >= 1; }
  else { R = NPR + 64 * st + ti0; valid = true; hasprev = ti0 >= 1; }
  const bf16_t* zr = p.zE + (size_t)R * ZE + ZE_ZC;
  const int chb = 64 * hd + 32 * cw + 4 * hh;
  uint4 la[2][2], lap[2][2]; uint2 lb[3][4], lbp[3][4];
  {
    const bf16_t* sh0 = p.zE + (size_t)(NT + (prompt ? 32 : st)) * ZE + ZE_ZC;
    const bf16_t* zp1 = hasprev1 ? zr1 - ZE : sh0;
    const bf16_t* zp = hasprev ? zr - ZE : sh0;
#pragma unroll
    for (int part = 0; part < 2; ++part)
#pragma unroll
      for (int h8 = 0; h8 < 2; ++h8) { const int col = 768 + 64 * part + m0 + 8 * h8; la[part][h8] = *(const uint4*)(zr1 + col); lap[part][h8] = *(const uint4*)(zp1 + col); }
#pragma unroll
    for (int part = 0; part < 3; ++part)
#pragma unroll
      for (int G = 0; G < 4; ++G) { const int col = 256 * part + chb + 8 * G; lb[part][G] = *(const uint2*)(zr + col); lbp[part][G] = *(const uint2*)(zp + col); }
    const bf16_t* dsrc = p.dw2T + ((size_t)L * 256 + hd * 64 + i1) * 64 + m0;
    const bf16_t* isrc = p.ia2T + ((size_t)L * 256 + hd * 64 + i1) * 64 + m0;
    const uint4 d0 = *(const uint4*)dsrc, d1 = *(const uint4*)(dsrc + 8), e0 = *(const uint4*)isrc, e1 = *(const uint4*)(isrc + 8);
    __builtin_amdgcn_sched_barrier(0);
    *(uint4*)(S2 + i1 * 72 + m0) = d0; *(uint4*)(S2 + i1 * 72 + m0 + 8) = d1;
    *(uint4*)(S3 + i1 * 72 + m0) = e0; *(uint4*)(S3 + i1 * 72 + m0 + 8) = e1;
  }
  {
    float* prm = misc + 384;
#pragma unroll
    for (int q2 = 0; q2 < 2; ++q2) {
      const int ix = tid + 256 * q2, wh = ix >> 6, chp = ix & 63;
      const float* sp = wh == 0 ? p.decay_w0 : wh == 1 ? p.iclr_a0 : wh == 2 ? p.key_kk : wh == 3 ? p.key_ka : wh == 4 ? p.bonus_rk : nullptr;
      prm[ix] = sp ? sp[L * 256 + hd * 64 + chp] : mu[256 * (wh - 5) + 64 * hd + chp];
    }
  }
#pragma unroll
  for (int part = 0; part < 2; ++part) {
#pragma unroll
    for (int h8 = 0; h8 < 2; ++h8) {
      const int col = 768 + 64 * part + m0 + 8 * h8;
      const uint4 u = la[part][h8], v = lap[part][h8];
      const float cur[8] = {bflo(u.x), bfhi(u.x), bflo(u.y), bfhi(u.y), bflo(u.z), bfhi(u.z), bflo(u.w), bfhi(u.w)};
      float prv[8] = {bflo(v.x), bfhi(v.x), bflo(v.y), bfhi(v.y), bflo(v.z), bfhi(v.z), bflo(v.w), bfhi(v.w)};
      float o[8];
#pragma unroll
      for (int e = 0; e < 8; ++e) { float z = cur[e] + (prv[e] - cur[e]) * mu[col + e]; if (!valid1) z = 0.f; o[e] = part == 0 ? (1.f - 2.f / (__expf(2.f * z) + 1.f)) : z; }
      uint4 a; a.x = pk2(o[0], o[1]); a.y = pk2(o[2], o[3]); a.z = pk2(o[4], o[5]); a.w = pk2(o[6], o[7]);
      *(uint4*)((part == 0 ? S0 : S1) + i1 * 72 + m0 + 8 * h8) = a;
    }
  }
  __syncthreads();
  f32x16 accw = zero16(), acca = zero16();
#pragma unroll
  for (int ks = 0; ks < 4; ++ks) {
    const bf16x8 fw = *(const bf16x8*)(S2 + (32 * cw + l31) * 72 + ks * 16 + hh * 8), fa = *(const bf16x8*)(S3 + (32 * cw + l31) * 72 + ks * 16 + hh * 8);
    const bf16x8 sw = *(const bf16x8*)(S0 + (32 * tw + l31) * 72 + ks * 16 + hh * 8), sa = *(const bf16x8*)(S1 + (32 * tw + l31) * 72 + ks * 16 + hh * 8);
    accw = mfma32(fw, sw, accw); acca = mfma32(fa, sa, acca);
  }
  int ti = ti0;
  float e_[16];
  float ssq = 0.f;
#pragma unroll
  for (int G = 0; G < 4; ++G) {
    const int ch = chb + 8 * G, col = 256 + ch;
    const uint2 u = lb[1][G], v = lbp[1][G];
    const float cur[4] = {bflo(u.x), bfhi(u.x), bflo(u.y), bfhi(u.y)};
    float prv[4] = {bflo(v.x), bfhi(v.x), bflo(v.y), bfhi(v.y)};
    const int chq = 32 * cw + 8 * G + 4 * hh;
    const float4 kkw = *(const float4*)(misc + 384 + 128 + chq), w0 = *(const float4*)(misc + 384 + chq), m4 = *(const float4*)(misc + 384 + 384 + chq);
    const float kkv[4] = {kkw.x, kkw.y, kkw.z, kkw.w}, w0v[4] = {w0.x, w0.y, w0.z, w0.w}, muv[4] = {m4.x, m4.y, m4.z, m4.w};
#pragma unroll
    for (int e = 0; e < 4; ++e) {
      float z = cur[e] + (prv[e] - cur[e]) * muv[e];
      if (!valid) z = 0.f;
      const float kkr = z * kkv[e];
      ssq += kkr * kkr;
      e_[4 * G + e] = valid ? 0.6065306597126334f * sigmoid_(w0v[e] + accw[4 * G + e]) : 0.f;
    }
  }
  ssq += __shfl_xor(ssq, 32);
  if (hh == 0) misc[(cw * 64 + ti) * 2] = ssq;
#pragma unroll
  for (int G = 0; G < 4; ++G)
#pragma unroll
    for (int e = 0; e < 4; ++e) Ef[ti * 65 + 32 * cw + 8 * G + 4 * hh + e] = e_[4 * G + e];
  __syncthreads();
  {
    const int ch = tid & 63, seg = tid >> 6;
    float run = 0.f;
#pragma unroll
    for (int t = 0; t < 16; ++t) { run += Ef[(16 * seg + t) * 65 + ch]; Ef[(16 * seg + t) * 65 + ch] = run; }
    __syncthreads();
    float off = 0.f;
    for (int s2 = 0; s2 < seg; ++s2) off += Ef[(16 * s2 + 15) * 65 + ch];
    __syncthreads();
#pragma unroll
    for (int t = 0; t < 16; ++t) Ef[(16 * seg + t) * 65 + ch] += off;
    if (seg == 3) { const float cC = Ef[63 * 65 + ch]; misc[320 + ch] = cC; misc[256 + ch] = __expf(-cC); }
    __syncthreads();
  }
  float cc_[16];
#pragma unroll
  for (int G = 0; G < 4; ++G)
#pragma unroll
    for (int e = 0; e < 4; ++e) cc_[4 * G + e] = Ef[ti * 65 + 32 * cw + 8 * G + 4 * hh + e];
  const float kinv = 1.f / fmaxf(sqrtf(misc[ti * 2] + misc[(64 + ti) * 2]), 1e-12f);
  __syncthreads();
  LAUNDER(ti); LAUNDER(hh);
  uint2 vpk[4];
  float rk = 0.f;
#pragma unroll
  for (int G = 0; G < 4; ++G) {
    const int ch = chb + 8 * G, chl = 32 * cw + 8 * G + 4 * hh;
    float zs[3][4];
#pragma unroll
    for (int part = 0; part < 3; ++part) {
      const int col = 256 * part + ch;
      const uint2 u = lb[part][G], v = lbp[part][G];
      const float cur[4] = {bflo(u.x), bfhi(u.x), bflo(u.y), bfhi(u.y)};
      float prv[4] = {bflo(v.x), bfhi(v.x), bflo(v.y), bfhi(v.y)};
      const float4 m4 = *(const float4*)(misc + 384 + 320 + 64 * part + chl);
      const float muv[4] = {m4.x, m4.y, m4.z, m4.w};
#pragma unroll
      for (int e = 0; e < 4; ++e) { float z = cur[e] + (prv[e] - cur[e]) * muv[e]; zs[part][e] = valid ? z : 0.f; }
    }
    vpk[G] = pk4(zs[2][0], zs[2][1], zs[2][2], zs[2][3]);
    const float4 a04 = *(const float4*)(misc + 384 + 64 + chl), kk4 = *(const float4*)(misc + 384 + 128 + chl), ka4 = *(const float4*)(misc + 384 + 192 + chl), bo4 = *(const float4*)(misc + 384 + 256 + chl);
    const float a0v[4] = {a04.x, a04.y, a04.z, a04.w}, kkv[4] = {kk4.x, kk4.y, kk4.z, kk4.w}, kav[4] = {ka4.x, ka4.y, ka4.z, ka4.w}, bov[4] = {bo4.x, bo4.y, bo4.z, bo4.w};
    float at[4], rt[4], bt[4], kt[4], bh[4], kh[4];
#pragma unroll
    for (int e = 0; e < 4; ++e) {
      const int r = 4 * G + e;
      const float al = sigmoid_(a0v[e] + acca[r]);
      const float kk = zs[1][e] * kkv[e] * kinv;
      const float km = zs[1][e] * (1.f + (al - 1.f) * kav[e]);
      rk += zs[0][e] * km * bov[e];
      const float gC = misc[256 + chl + e];
      const float cprev = cc_[r] - e_[r];
      const float ea = __expf(-cprev), er = __expf(-cc_[r]), ek = __builtin_amdgcn_rcpf(er), eh = ek * gC;
      const float b = kk * al;
      at[e] = -kk * ea; rt[e] = zs[0][e] * er; bt[e] = b * ek; kt[e] = km * ek; bh[e] = b * eh; kh[e] = km * eh;
    }
    *(uint2*)(S0 + ti * 72 + chl) = pk4(at[0], at[1], at[2], at[3]);
    *(uint2*)(S1 + ti * 72 + chl) = pk4(rt[0], rt[1], rt[2], rt[3]);
    *(uint2*)(S2 + ti * 72 + chl) = pk4(bt[0], bt[1], bt[2], bt[3]);
    *(uint2*)(S3 + ti * 72 + chl) = pk4(kt[0], kt[1], kt[2], kt[3]);
#pragma unroll
    for (int e = 0; e < 4; ++e) { S4[(chl + e) * 72 + ti] = f2bf(at[e]); S5[(chl + e) * 72 + ti] = f2bf(bh[e]); S6[(chl + e) * 72 + ti] = f2bf(kh[e]); S7[(chl + e) * 72 + ti] = f2bf(zs[2][e]); }
    *(uint2*)(rwp + 40960 + (ti * 64 + chl) * 2) = vpk[G];
  }
  rk += __shfl_xor(rk, 32);
  if (hh == 0) misc[(cw * 64 + ti) * 2 + 1] = rk;
  __syncthreads();
  if (valid && cw == 0 && hh == 0) p.rkb[(size_t)R * 4 + hd] = misc[ti * 2 + 1] + misc[(64 + ti) * 2 + 1];
  LAUNDER(l31); LAUNDER(hh); LAUNDER(lane);
  {
    Acc64 T;
    {
      Acc64 Mx, MTx;
      gram<SH_UP, 0>(S2, S0, l31, hh, Mx);
      gram<SH_LO, 1>(S0, S2, l31, hh, MTx);
      Frag64 fM, fMT, fT;
      to_frag<SH_UP>(Mx, fM); to_frag<SH_LO>(MTx, fMT);
      T = Mx;
#pragma unroll
      for (int t = 0; t < 2; ++t)
#pragma unroll
        for (int r = 0; r < 16; ++r) if ((r & 3) + 8 * (r >> 2) + 4 * hh == l31) T.t[t][t][r] += 1.f;
      T.t[1][0] = zero16();
      for (int r = 0; r < 5; ++r) {
        Frag64 fM2, fMT2;
        prod_ff_frag<SH_LO, SH_UP, SH_UP>(fMT, fM, fM2);
        prod_ff_frag<SH_UP, SH_LO, SH_LO>(fM, fMT, fMT2);
#pragma unroll
        for (int s = 0; s < 4; ++s)
#pragma unroll
          for (int t = 0; t < 2; ++t) { if (tile_nz<SH_UP>(s >> 1, t)) fM.f[s][t] = fM2.f[s][t]; if (tile_nz<SH_LO>(s >> 1, t)) fMT.f[s][t] = fMT2.f[s][t]; }
        to_frag<SH_UP>(T, fT);
        prod_ff<SH_LO, SH_UP>(fMT, fT, T);
      }
    }
    Frag64 fT;
    to_frag<SH_UP>(T, fT);
    if (w < 2) {
      Frag64 fW;
      prod_fm_frag<SH_UP>(fT, S4, l31, hh, fW);
      Acc64 O; zero_acc<SH_FULL>(O);
      if (w == 0) {
        prod_fm<SH_FULL>(fW, S5, l31, hh, O);
#pragma unroll
        for (int tx = 0; tx < 2; ++tx)
#pragma unroll
          for (int ty = 0; ty < 2; ++ty)
#pragma unroll
            for (int G = 0; G < 4; ++G) {
              const int x0 = 32 * tx + 8 * G + 4 * hh, y = 32 * ty + l31;
              float v[4];
#pragma unroll
              for (int e = 0; e < 4; ++e) { v[e] = O.t[tx][ty][4 * G + e]; if (x0 + e == y) v[e] += misc[256 + y]; }
              *(uint2*)(rwp + 0 + kperm_addr(y, x0) * 2) = pk4(v[0], v[1], v[2], v[3]);
            }
      } else {
        Acc64 Nb; gram<SH_UP, 2>(S2, S1, l31, hh, Nb);
        Frag64 fN; to_frag<SH_UP>(Nb, fN);
        prod_ff<SH_FULL, SH_UP>(fW, fN, O);
#pragma unroll
        for (int tx = 0; tx < 2; ++tx)
#pragma unroll
          for (int ty = 0; ty < 2; ++ty)
#pragma unroll
            for (int G = 0; G < 4; ++G) {
              const int x0 = 32 * tx + 8 * G + 4 * hh, y = 32 * ty + l31;
              const uint2 rr = *(const uint2*)(S1 + y * 72 + x0);
              *(uint2*)(rwp + 8192 + kperm_addr(y, x0) * 2) = pk4(O.t[tx][ty][4 * G] + bflo(rr.x), O.t[tx][ty][4 * G + 1] + bfhi(rr.x), O.t[tx][ty][4 * G + 2] + bflo(rr.y), O.t[tx][ty][4 * G + 3] + bfhi(rr.y));
            }
      }
    } else {
      Frag64 fX;
      {
        Acc64 Nk; gram<SH_LO, 1>(S0, S3, l31, hh, Nk);
        Frag64 fNk; to_frag<SH_LO>(Nk, fNk);
        prod_ff_frag<SH_UP, SH_LO, SH_LO>(fT, fNk, fX);
      }
      if (w == 2) {
        Acc64 Z; zero_acc<SH_FULL>(Z);
        prod_fm<SH_LO>(fX, S5, l31, hh, Z);
#pragma unroll
        for (int tx = 0; tx < 2; ++tx)
#pragma unroll
          for (int ty = 0; ty < 2; ++ty)
#pragma unroll
            for (int G = 0; G < 4; ++G) {
              const int x0 = 32 * tx + 8 * G + 4 * hh, y = 32 * ty + l31;
              const uint2 kk2 = *(const uint2*)(S6 + y * 72 + x0);
              Z.t[tx][ty][4 * G] += bflo(kk2.x); Z.t[tx][ty][4 * G + 1] += bfhi(kk2.x); Z.t[tx][ty][4 * G + 2] += bflo(kk2.y); Z.t[tx][ty][4 * G + 3] += bfhi(kk2.y);
            }
        Frag64 fZ; to_frag<SH_FULL>(Z, fZ);
        Acc64 Q; zero_acc<SH_FULL>(Q);
        prod_fm<SH_FULL>(fZ, S7, l31, hh, Q);
#pragma unroll
        for (int tx = 0; tx < 2; ++tx)
#pragma unroll
          for (int ty = 0; ty < 2; ++ty)
#pragma unroll
            for (int G = 0; G < 4; ++G)
              *(uint2*)(rwp + 16384 + clay_addr(32 * tx + 8 * G + 4 * hh, 32 * ty + l31) * 2) = pk4(Q.t[tx][ty][4 * G], Q.t[tx][ty][4 * G + 1], Q.t[tx][ty][4 * G + 2], Q.t[tx][ty][4 * G + 3]);
      } else {
        Acc64 H; gram<SH_UP, 2>(S3, S1, l31, hh, H);
        {
          Acc64 Nb; gram<SH_UP, 2>(S2, S1, l31, hh, Nb);
          Frag64 fN; to_frag<SH_UP>(Nb, fN);
          prod_ff<SH_LO, SH_UP>(fX, fN, H);
        }
        Frag64 fH; to_frag<SH_UP>(H, fH);
        Acc64 Y; zero_acc<SH_FULL>(Y);
        prod_fm<SH_UP>(fH, S7, l31, hh, Y);
#pragma unroll
        for (int tx = 0; tx < 2; ++tx)
#pragma unroll
          for (int ty = 0; ty < 2; ++ty)
#pragma unroll
            for (int G = 0; G < 4; ++G)
              *(uint2*)(rwp + 24576 + clay_addr(32 * tx + 8 * G + 4 * hh, 32 * ty + l31) * 2) = pk4(Y.t[tx][ty][4 * G], Y.t[tx][ty][4 * G + 1], Y.t[tx][ty][4 * G + 2], Y.t[tx][ty][4 * G + 3]);
      }
    }
  }
  __syncthreads();
}

DEV void r2_wave(const Prm& p, int L, int wi, int lane) {
  bool prompt; int st, hd, vt;
  if (wi < 64) { prompt = true; st = wi >> 4; hd = (wi >> 2) & 3; vt = wi & 3; }
  else { prompt = false; const int j = wi - 64; st = j >> 4; hd = (j >> 2) & 3; vt = j & 3; }
  const int nch = prompt ? 65 : 1;
  const int idx0 = prompt ? st * 260 + hd : NRW_P + st * 4 + hd;
  const int l16 = lane & 15, g = lane >> 4;
  f32x4 acc[4];
  float* outp;
  if (prompt) {
#pragma unroll
    for (int mt = 0; mt < 4; ++mt) acc[mt] = (f32x4){0.f, 0.f, 0.f, 0.f};
    outp = p.wkv_p + ((((size_t)L * 4 + st) * 4 + hd) * 64 + 16 * vt + l16) * 64;
  } else {
    const float* sp = p.state_wkv + ((((size_t)L * 32 + st) * 4 + hd) * 64 + 16 * vt + l16) * 64;
#pragma unroll
    for (int mt = 0; mt < 4; ++mt) acc[mt] = *(const f32x4*)(sp + 16 * mt + 4 * g);
    outp = p.wkv_s + ((((size_t)L * 32 + st) * 4 + hd) * 64 + 16 * vt + l16) * 64;
  }
  const char* rw0 = p.rw + (size_t)idx0 * RW_BYTES;
  uint4 pf[3][8]; uint2 qv[3][4];
#pragma unroll
  for (int k = 0; k < 3; ++k) {
    const int cc = k < nch ? k : nch - 1;
    const char* src = rw0 + (size_t)cc * 4 * RW_BYTES;
#pragma unroll
    for (int i = 0; i < 8; ++i) pf[k][i] = *(const uint4*)(src + (i * 64 + lane) * 16);
#pragma unroll
    for (int mt = 0; mt < 4; ++mt) qv[k][mt] = *(const uint2*)(src + 16384 + ((mt * 4 + vt) * 64 + lane) * 8);
  }
  for (int c0 = 0; c0 < nch; c0 += 3) {
#pragma unroll
    for (int k = 0; k < 3; ++k) {
      const int c = c0 + k;
      if (c < nch) {
        char* cur = (char*)rw0 + (size_t)c * 4 * RW_BYTES;
        uint4 bfr[2];
#pragma unroll
        for (int s = 0; s < 2; ++s) {
          bfr[s].x = pk2(acc[2 * s][0], acc[2 * s][1]); bfr[s].y = pk2(acc[2 * s][2], acc[2 * s][3]);
          bfr[s].z = pk2(acc[2 * s + 1][0], acc[2 * s + 1][1]); bfr[s].w = pk2(acc[2 * s + 1][2], acc[2 * s + 1][3]);
          *(uint4*)(cur + 32768 + ((vt * 2 + s) * 64 + lane) * 16) = bfr[s];
        }
#pragma unroll
        for (int mt = 0; mt < 4; ++mt) {
          f32x4 a = {bflo(qv[k][mt].x), bfhi(qv[k][mt].x), bflo(qv[k][mt].y), bfhi(qv[k][mt].y)};
#pragma unroll
          for (int s = 0; s < 2; ++s) a = mfma16(mk8(pf[k][mt * 2 + s]), mk8(bfr[s]), a);
          acc[mt] = a;
        }
        const int cn = c + 3 < nch ? c + 3 : nch - 1;
        const char* src = rw0 + (size_t)cn * 4 * RW_BYTES;
#pragma unroll
        for (int i = 0; i < 8; ++i) pf[k][i] = *(const uint4*)(src + (i * 64 + lane) * 16);
#pragma unroll
        for (int mt = 0; mt < 4; ++mt) qv[k][mt] = *(const uint2*)(src + 16384 + ((mt * 4 + vt) * 64 + lane) * 8);
      }
    }
  }
#pragma unroll
  for (int mt = 0; mt < 4; ++mt) *(f32x4*)(outp + 16 * mt + 4 * g) = acc[mt];
}

DEV void r3_wave(const Prm& p, int L, int idx, int lane, float* Y  ) {
  LAUNDER(lane);
  bool prompt; int st, c, hd;
  if (idx < NRW_P) { prompt = true; st = idx / 260; const int rem = idx - st * 260; c = rem >> 2; hd = rem & 3; }
  else { prompt = false; const int j = idx - NRW_P; st = j >> 2; hd = j & 3; c = 0; }
  const char* rwp = p.rw + (size_t)idx * RW_BYTES;
  const int l16 = lane & 15, g = lane >> 4;
  bf16_t* mix = p.zE;
  uint4 sf[4][2];
#pragma unroll
  for (int vt = 0; vt < 4; ++vt)
#pragma unroll
    for (int s = 0; s < 2; ++s) sf[vt][s] = *(const uint4*)(rwp + 32768 + ((vt * 2 + s) * 64 + lane) * 16);
  const float lw[4] = {p.lnx_w[L * 256 + hd * 64 + l16], p.lnx_w[L * 256 + hd * 64 + 16 + l16], p.lnx_w[L * 256 + hd * 64 + 32 + l16], p.lnx_w[L * 256 + hd * 64 + 48 + l16]};
  const float lb[4] = {p.lnx_b[L * 256 + hd * 64 + l16], p.lnx_b[L * 256 + hd * 64 + 16 + l16], p.lnx_b[L * 256 + hd * 64 + 32 + l16], p.lnx_b[L * 256 + hd * 64 + 48 + l16]};
#pragma unroll
  for (int it = 0; it < 4; ++it) {
    f32x4 y[4];
    const uint4 gf0 = *(const uint4*)(rwp + 8192 + ((it * 2 + 0) * 64 + lane) * 16), gf1 = *(const uint4*)(rwp + 8192 + ((it * 2 + 1) * 64 + lane) * 16);
#pragma unroll
    for (int vt = 0; vt < 4; ++vt) {
      const uint2 q = *(const uint2*)(rwp + 24576 + ((it * 4 + vt) * 64 + lane) * 8);
      f32x4 a = {bflo(q.x), bfhi(q.x), bflo(q.y), bfhi(q.y)};
      a = mfma16(mk8(gf0), mk8(sf[vt][0]), a);
      a = mfma16(mk8(gf1), mk8(sf[vt][1]), a);
      y[vt] = a;
    }
    __builtin_amdgcn_sched_barrier(0);
#pragma unroll
    for (int rr = 0; rr < 4; ++rr) {
      const int i = 16 * it + 4 * g + rr;
      float s1 = y[0][rr] + y[1][rr] + y[2][rr] + y[3][rr];
      s1 += __shfl_xor(s1, 1); s1 += __shfl_xor(s1, 2); s1 += __shfl_xor(s1, 4); s1 += __shfl_xor(s1, 8);
      const float mean = s1 * (1.f / 64.f);
      const float d0 = y[0][rr] - mean, d1 = y[1][rr] - mean, d2 = y[2][rr] - mean, d3 = y[3][rr] - mean;
      float s2 = d0 * d0 + d1 * d1 + d2 * d2 + d3 * d3;
      s2 += __shfl_xor(s2, 1); s2 += __shfl_xor(s2, 2); s2 += __shfl_xor(s2, 4); s2 += __shfl_xor(s2, 8);
      const float rstd = rsqrtf(s2 * (1.f / 64.f) + GN_EPS);
      Y[i * 68 + l16] = d0 * rstd * lw[0] + lb[0];
      Y[i * 68 + 16 + l16] = d1 * rstd * lw[1] + lb[1];
      Y[i * 68 + 32 + l16] = d2 * rstd * lw[2] + lb[2];
      Y[i * 68 + 48 + l16] = d3 * rstd * lw[3] + lb[3];
    }
  }
  asm volatile("s_waitcnt lgkmcnt(0)" ::: "memory");
  __builtin_amdgcn_wave_barrier();
  const int vc = (lane & 7) * 8;
#pragma unroll
  for (int ps = 0; ps < 8; ++ps) {
    const int i = 8 * ps + (lane >> 3);
    int R; bool valid;
    if (prompt) { const int pp = 64 * c - 48 + i; valid = pp >= 0; R = st * PT + (valid ? pp : 0); }
    else { R = NPR + 64 * st + i; valid = true; }
    if (valid) {
      const float4 y0 = *(const float4*)(Y + i * 68 + vc), y1 = *(const float4*)(Y + i * 68 + vc + 4);
      const float rkbv = p.rkb[(size_t)R * 4 + hd];
      const uint4 vv = *(const uint4*)(rwp + 40960 + (i * 64 + vc) * 2);
      const uint4 gc = *(const uint4*)(p.zL + (size_t)R * ZL + ZL_GC + hd * 64 + vc);
      uint4 o;
      o.x = pk2((y0.x + rkbv * bflo(vv.x)) * silu_(bflo(gc.x)), (y0.y + rkbv * bfhi(vv.x)) * silu_(bfhi(gc.x)));
      o.y = pk2((y0.z + rkbv * bflo(vv.y)) * silu_(bflo(gc.y)), (y0.w + rkbv * bfhi(vv.y)) * silu_(bfhi(gc.y)));
      o.z = pk2((y1.x + rkbv * bflo(vv.z)) * silu_(bflo(gc.z)), (y1.y + rkbv * bfhi(vv.z)) * silu_(bfhi(gc.z)));
      o.w = pk2((y1.z + rkbv * bflo(vv.w)) * silu_(bflo(gc.w)), (y1.w + rkbv * bfhi(vv.w)) * silu_(bfhi(gc.w)));
      *(uint4*)(mix + (size_t)R * D + 768 + hd * 64 + vc) = o;
    }
  }
  asm volatile("s_waitcnt lgkmcnt(0)" ::: "memory");
  __builtin_amdgcn_wave_barrier();
}

DEV void final_norm(const Prm& p) {
  int tid_ = threadIdx.x; LAUNDER(tid_);
  const int lane = tid_ & 63, gw = blockIdx.x * 4 + (tid_ >> 6), NW = gridDim.x * 4;
  for (int R = gw; R < NT; R += NW) {
    if (R < NPR && (R % PT) < 16) continue;
    float* yr = xrow_ptr(p, R);
    const bf16_t* xr = p.xb + (size_t)R * D;
    const float rstd = rsqrtf(p.ssq_x[2 * NTP + R] * (1.f / 1024.f) + RMS_EPS);
#pragma unroll
    for (int j = 0; j < 2; ++j) {
      const uint4 u = ((const uint4*)xr)[lane + 64 * j];
      const float4 g0 = ((const float4*)p.final_g)[2 * (lane + 64 * j)], g1 = ((const float4*)p.final_g)[2 * (lane + 64 * j) + 1];
      float4 o0, o1;
      o0.x = bflo(u.x) * rstd * g0.x; o0.y = bfhi(u.x) * rstd * g0.y; o0.z = bflo(u.y) * rstd * g0.z; o0.w = bfhi(u.y) * rstd * g0.w;
      o1.x = bflo(u.z) * rstd * g1.x; o1.y = bfhi(u.z) * rstd * g1.y; o1.z = bflo(u.w) * rstd * g1.z; o1.w = bfhi(u.w) * rstd * g1.w;
      ((float4*)yr)[2 * (lane + 64 * j)] = o0; ((float4*)yr)[2 * (lane + 64 * j) + 1] = o1;
    }
  }
}

#define XB_TMO      128
#define XB_XCNT(j)  (256  + 64 * (j))
#define XB_XSUB(j)  (1280 + 64 * (j))
#define XB_XGEN(j)  (2304 + 64 * (j))
#define XB_TOP      3328
#define XB_TOPGEN   3392
#define XCD_BAR_WORDS 3456
#define XB_SPIN_CAP (1u << 20)
#define LAS __attribute__((address_space(3)))
DEV unsigned xb_ld(unsigned* p) { return __hip_atomic_load(p, __ATOMIC_RELAXED, __HIP_MEMORY_SCOPE_AGENT); }
DEV unsigned xb_add(unsigned* p, unsigned v) { return __hip_atomic_fetch_add(p, v, __ATOMIC_RELAXED, __HIP_MEMORY_SCOPE_AGENT); }
DEV unsigned xb_xcc_id() { return (unsigned)__builtin_amdgcn_s_getreg((3 << 11) | 20) & 0xFu; }
#define XB_SPIN(cond, bar) do { unsigned _sp = 0; while (cond) { __builtin_amdgcn_s_sleep(1); \
    if ((++_sp & 255u) == 0u) { if (xb_ld(&(bar)[XB_TMO])) break; if (_sp > XB_SPIN_CAP) { atomicAdd(&(bar)[XB_TMO], 1u); break; } } } } while (0)
struct XcdBarrier { unsigned* bar; unsigned x; volatile LAS unsigned* st; };
DEV XcdBarrier xcd_barrier_post(unsigned* bar, volatile LAS unsigned* st) {
  XcdBarrier b; b.bar = bar; b.x = xb_xcc_id(); b.st = st;
  if (threadIdx.x == 0) (void)xb_add(&bar[XB_XCNT(b.x)], 1u);
  return b;
}
DEV void xcd_barrier_complete(unsigned* bar, unsigned x, unsigned& nloc, unsigned& nx) {
  const unsigned G = gridDim.x * gridDim.y * gridDim.z;
  unsigned sum, cnt, mine, sp = 0u;
  for (;;) {
    sum = 0u; cnt = 0u; mine = 0u;
#pragma unroll
    for (unsigned j = 0; j < 16; ++j) { const unsigned c = xb_ld(&bar[XB_XCNT(j)]); sum += c; cnt += (c > 0u) ? 1u : 0u; mine = (j == x) ? c : mine; }
    if (sum == G) break;
    __builtin_amdgcn_s_sleep(1);
    if ((++sp & 255u) == 0u) { if (xb_ld(&bar[XB_TMO])) break; if (sp > XB_SPIN_CAP) { atomicAdd(&bar[XB_TMO], 1u); break; } }
  }
  nloc = mine > 0u ? mine : 1u; nx = cnt > 0u ? cnt : 1u;
}
DEV void xcd_barrier(const XcdBarrier& b) {
  asm volatile("s_waitcnt vmcnt(0)" ::: "memory");
  __syncthreads();
  if (threadIdx.x == 0) {
    unsigned* bar = b.bar;
    __builtin_amdgcn_s_waitcnt(0);
    unsigned nloc = b.st[0], nx = b.st[1];
    if (nloc == 0u) { xcd_barrier_complete(bar, b.x, nloc, nx); b.st[0] = nloc; b.st[1] = nx; }
    const unsigned old = xb_add(&bar[XB_XSUB(b.x)], 1u);
    const unsigned gen = old / nloc;
    if (old + 1u == (gen + 1u) * nloc) {
      __builtin_amdgcn_fence(__ATOMIC_RELEASE, "agent");
      asm volatile("s_waitcnt vmcnt(0)" ::: "memory");
      const unsigned og = xb_add(&bar[XB_TOP], 1u);
      const unsigned tg = og / nx;
      if (og + 1u == (tg + 1u) * nx) xb_add(&bar[XB_TOPGEN], 1u);
      else XB_SPIN(xb_ld(&bar[XB_TOPGEN]) == tg, bar);
      __builtin_amdgcn_fence(__ATOMIC_ACQUIRE, "agent");
      xb_add(&bar[XB_XGEN(b.x)], 1u);
      asm volatile("s_waitcnt vmcnt(0)" ::: "memory");
    } else {
      XB_SPIN(xb_ld(&bar[XB_XGEN(b.x)]) == gen, bar);
      __builtin_amdgcn_fence(__ATOMIC_ACQUIRE, "agent");
      asm volatile("s_waitcnt vmcnt(0)" ::: "memory");
    }
  }
  __syncthreads();
}

#define QCTR(ph, L) (3584 + 64 * (2 * (ph) + (L)))
#define R2DONE(L) (3520 + 16 * (L))
DEV int next_item(unsigned* ctr, char* lds) {
  volatile int* slot = (volatile int*)(lds + LDS_BYTES - 8);
  __syncthreads();
  if (threadIdx.x == 0) *slot = (int)atomicAdd(ctr, 1u);
  __syncthreads();
  return *slot;
}
#define QXC(ph, L, x) (4096 + (((ph) * 2 + (L)) * 8 + (x)) * 16)
DEV int xq_next(unsigned* ctl, int ph, int L, int C, int N, int& k, int home, char* lds) {
  volatile int* slot = (volatile int*)(lds + LDS_BYTES - 8);
  __syncthreads();
  if (threadIdx.x == 0) {
    int res = -1, kk = k;
    while (kk < 8) {
      const int x = (home + kk) & 7, base = x * C;
      int size = N - base; size = size < C ? size : C;
      if (size > 0) { const int idx = (int)atomicAdd(ctl + QXC(ph, L, x), 1u); if (idx < size) { res = base + idx; break; } }
      ++kk;
    }
    slot[0] = res; slot[1] = kk;
  }
  __syncthreads();
  k = slot[1];
  return slot[0];
}
DEV int q_publish(int ticket, char* lds) {
  volatile int* slot = (volatile int*)(lds + LDS_BYTES - 8);
  __syncthreads();
  if (threadIdx.x == 0) *slot = ticket;
  __syncthreads();
  return *slot;
}
DEV int xq_resolve(unsigned* ctl, int ph, int L, int C, int N, int& k, int home, int ticket, char* lds) {
  volatile int* slot = (volatile int*)(lds + LDS_BYTES - 8);
  __syncthreads();
  if (threadIdx.x == 0) {
    int res = -1, kk = k;
    if (kk < 8) {
      const int x = (home + kk) & 7, base = x * C;
      int size = N - base; size = size < C ? size : C;
      if (ticket < size) res = base + ticket;
      else {
        ++kk;
        while (kk < 8) {
          const int x2 = (home + kk) & 7, base2 = x2 * C;
          int size2 = N - base2; size2 = size2 < C ? size2 : C;
          if (size2 > 0) { const int idx = (int)atomicAdd(ctl + QXC(ph, L, x2), 1u); if (idx < size2) { res = base2 + idx; break; } }
          ++kk;
        }
      }
    }
    slot[0] = res; slot[1] = kk;
  }
  __syncthreads();
  k = slot[1];
  return slot[0];
}
DEV unsigned* xq_ctr(unsigned* ctl, int ph, int L, int k, int home) { return k < 8 ? ctl + QXC(ph, L, (home + k) & 7) : nullptr; }
DEV int take_ticket(unsigned* nctr) { int tk = 0x7fffffff; if (nctr && threadIdx.x == 0) tk = (int)atomicAdd(nctr, 1u); return tk; }
DEV void shift_rows_item(const Prm& p, int L, int b) {
  int tid0 = threadIdx.x; LAUNDER(tid0);
  if (tid0 < 224) {
    float4 v = make_float4(0.f, 0.f, 0.f, 0.f);
    if (b < 32) v = *(const float4*)(p.state_shift + ((size_t)L * 32 + b) * 896 + 4 * tid0);
    *(uint2*)(p.zE + (size_t)(NT + b) * ZE + ZE_ZC + 4 * tid0) = pk4(v.x, v.y, v.z, v.w);
  }
}
constexpr int N_ATT = 1312;
DEV void run_p1(const Prm& p, int L, char* lds) {
  const EpiIn epi{p, L};
  const int home = (int)(xb_xcc_id() & 7u);
  int k = 0;
  constexpr int N = 145 * 24, C = (N + 7) / 8;
  int t = take_ticket(xq_ctr(p.ctl, 0, L, k, home));
  for (;;) {
    const int i = xq_resolve(p.ctl, 0, L, C, N, k, home, t, lds);
    if (i < 0) break;
    int mt, nt;
    if (i < 18 * 192) { const int b = i / 192, r = i - b * 192; nt = r >> 3; mt = 8 * b + (r & 7); } else { nt = i - 18 * 192; mt = 144; }
    t = gemm_tile(p.xb, D, p.Wb_in + (size_t)L * INP * 1024, 1024, 1024, mt * 128, nt * 128, lds, epi, xq_ctr(p.ctl, 0, L, k, home));
  }
  unsigned* ctr = p.ctl + QCTR(3, L);
  t = take_ticket(ctr);
  for (;;) {
    const int mt = q_publish(t, lds);
    if (mt >= 145 + 33) break;
    if (mt >= 145) { t = take_ticket(ctr); shift_rows_item(p, L, mt - 145); continue; }
    t = gemm_tile<EpiIn, 2>(p.xb, D, p.Wb_in + (size_t)L * INP * 1024, 1024, 1024, mt * 128, 24 * 128, lds, epi, ctr);
  }
}
DEV void run_p2(const Prm& p, int L, char* lds) {
  const EpiQ epq{p, L};
  constexpr int N1 = NRW, N2 = N1 + 129, N3 = N2 + 145 * 6, N4 = N3 + 16, N5 = N4 + 36;
  const int N6 = L == 0 ? N5 + NWT : N5;
  unsigned* ctr = p.ctl + QCTR(0, L);
  for (;;) {
    const int id = next_item(ctr, lds);
    if (id >= N6) break;
    if (id >= N5) { conv_weights_item(p, 1, id - N5, lds); continue; }
    if (id < N1) r1_item(p, L, id, lds);
    else if (id < N2) kvproj_item(p, L, id - N1, lds);
    else if (id < N3) { const int t = id - N2, mt = t / 6, nt = t - mt * 6; gemm_tile(p.zE + ZE_CQ, ZE, p.Wb_uq + (size_t)L * 768 * 256, 256, 256, mt * 128, nt * 128, lds, epq); }
    else if (id < N4) sample_prep_item(p, L, id - N3);
    else shift_item(p, L, id - N4);
  }
}
DEV void run_p3(const Prm& p, int L, char* lds) {
  int tid_ = threadIdx.x; LAUNDER(tid_);
  const int lane = tid_ & 63, w = __builtin_amdgcn_readfirstlane(tid_ >> 6);
  {
    int ndone = 0;
    for (int wi = blockIdx.x * 4 + w; wi < 576; wi += gridDim.x * 4) { r2_wave(p, L, wi, lane); ++ndone; }
    if (blockIdx.x * 4 < 576) {
      asm volatile("s_waitcnt vmcnt(0)" ::: "memory");
      __syncthreads();
      if (threadIdx.x == 0) {
        int tot = 0;
        for (int wi = blockIdx.x * 4; wi < 576; wi += gridDim.x * 4) tot += (576 - wi) < 4 ? (576 - wi) : 4;
        __builtin_amdgcn_fence(__ATOMIC_RELEASE, "agent");
        asm volatile("s_waitcnt vmcnt(0)" ::: "memory");
        __hip_atomic_fetch_add(p.ctl + R2DONE(L), (unsigned)tot, __ATOMIC_RELAXED, __HIP_MEMORY_SCOPE_AGENT);
      }
    }
    (void)ndone;
  }
  unsigned* ctr = p.ctl + QCTR(1, L);
  for (;;) {
    const int q = next_item(ctr, lds);
    if (q >= 256) break;
    attn_item(p, L, 1024 + q, lds);
  }
  {
    const int home = (int)(xb_xcc_id() & 7u);
    int k = 0;
    int tx = take_ticket(xq_ctr(p.ctl, 2, L, k, home));
    for (;;) {
      const int i = xq_resolve(p.ctl, 2, L, 128, 1024, k, home, tx, lds);
      if (i < 0) break;
      const int x = i >> 7, j = i & 127, qt = 31 - (j >> 2), pair = 4 * x + (j & 3);
      tx = attn_body<false>(p, L, pair >> 3, pair & 7, qt, lds, xq_ctr(p.ctl, 2, L, k, home));
    }
  }
  unsigned* ctr2 = p.ctl + QCTR(2, L);
  constexpr int NC = (NT + 31) / 32, NQ2 = 32 + NC + NRW / 4;
  bool r2_seen = false;
  for (;;) {
    const int q = next_item(ctr2, lds);
    if (q >= NQ2) break;
    if (q < 32) attn_item(p, L, 1280 + q, lds);
    else if (q < 32 + NC) conv_item(p, L, q - 32);
    else {
      if (!r2_seen) {
        if (threadIdx.x == 0) {
          unsigned sp = 0;
          while (__hip_atomic_load(p.ctl + R2DONE(L), __ATOMIC_RELAXED, __HIP_MEMORY_SCOPE_AGENT) < 576u) {
            __builtin_amdgcn_s_sleep(2);
            if (++sp > (1u << 22)) { atomicAdd(&p.ctl[XB_TMO], 1u); break; }
          }
          __builtin_amdgcn_fence(__ATOMIC_ACQUIRE, "agent");
          asm volatile("s_waitcnt vmcnt(0)" ::: "memory");
        }
        __syncthreads();
        r2_seen = true;
      }
      r3_wave(p, L, (q - 32 - NC) * 4 + w, lane, (float*)(lds + w * 17408));
    }
  }
}
DEV void run_p4(const Prm& p, int L, char* lds) {
  const EpiOut epo{p, L};
  const int home = (int)(xb_xcc_id() & 7u);
  int k = 0;
  int t = take_ticket(xq_ctr(p.ctl, 1, L, k, home));
  for (;;) {
    const int i = xq_resolve(p.ctl, 1, L, 128, 1024, k, home, t, lds);
    if (i < 0) break;
    t = gemm_tile(p.zE  , D, p.Wb_out + (size_t)L * 1024 * 1024, 1024, 1024, (i >> 3) * 128, (i & 7) * 128, lds, epo, xq_ctr(p.ctl, 1, L, k, home));
  }
  unsigned* ctr = p.ctl + QCTR(3, L) + 16;
  t = take_ticket(ctr);
  for (;;) {
    const int h = q_publish(t, lds);
    if (h >= 17 * 16) break;
    const int mt = 128 + (h >> 4), r = h & 15;
    t = gemm_tile<EpiOut, 4>(p.zE, D, p.Wb_out + (size_t)L * 1024 * 1024, 1024, 1024, mt * 128, (r >> 1) * 128 + (r & 1) * 64, lds, epo, ctr);
  }
}

__global__ void __launch_bounds__(256, 2) mega(Prm p) {
  extern __shared__ __attribute__((aligned(16))) char lds[];
  volatile LAS unsigned* st = (volatile LAS unsigned*)(lds + LDS_BYTES - 16);
  if (threadIdx.x == 0) { st[0] = 0u; st[1] = 0u; st[2] = 0u; st[3] = 0u; }
  __syncthreads();
  const XcdBarrier xb = xcd_barrier_post(p.ctl, st);
  phase0(p, lds);
  xcd_barrier(xb);
  for (int L = 0; L < 2; ++L) {
    run_p1(p, L, lds); xcd_barrier(xb);
    run_p2(p, L, lds); xcd_barrier(xb);
    run_p3(p, L, lds); xcd_barrier(xb);
    run_p4(p, L, lds); xcd_barrier(xb);
  }
  final_norm(p);
}

static size_t al256(size_t x) { return (x + 255) & ~(size_t)255; }
extern "C" void kernel_launch(void* const* d_in, const int* in_sizes, int n_in, void* d_out, int out_size, void* d_ws, size_t ws_size, hipStream_t stream) {
  Prm p{};
  const float* const* in = (const float* const*)d_in;
  p.x_prompt = in[0]; p.x_sample = in[1]; p.cache_ckv = in[2]; p.cache_krope = in[3]; p.state_conv = in[4]; p.state_shift = in[5]; p.state_wkv = in[6];
  p.meta = in[7]; p.norm_g = in[8]; p.w_in = in[9]; p.conv_w = in[10]; p.q_norm_g = in[11]; p.w_uq = in[12]; p.kv_norm_g = in[13]; p.w_ukv = in[14];
  p.shift_mu = in[15]; p.decay_w0 = in[16]; p.decay_w2 = in[17]; p.iclr_a0 = in[18]; p.iclr_a2 = in[19]; p.key_kk = in[20]; p.key_ka = in[21];
  p.bonus_rk = in[22]; p.lnx_w = in[23]; p.lnx_b = in[24]; p.w_out = in[25]; p.final_g = in[26];
  float* o = (float*)d_out;
  p.y_prompt = o; o += (size_t)4 * 4096 * 1024;
  p.y_sample = o; o += (size_t)32 * 64 * 1024;
  p.ckv_p = o; o += (size_t)2 * 4 * PT * 128;
  p.kr_p = o; o += (size_t)2 * 4 * PT * 32;
  p.conv_p = o; o += 2 * 4 * 2 * 256;
  p.shift_p = o; o += 2 * 4 * 896;
  p.wkv_p = o; o += 2 * 4 * 4 * 64 * 64;
  p.ckv_s = o; o += (size_t)2 * 32 * 64 * 128;
  p.kr_s = o; o += 2 * 32 * 64 * 32;
  p.conv_s = o; o += 2 * 32 * 2 * 256;
  p.shift_s = o; o += 2 * 32 * 896;
  p.wkv_s = o; o += 2 * 32 * 4 * 64 * 64;
  char* w = (char*)d_ws; size_t off = 0;
  auto take = [&](size_t bytes) { char* r = w + off; off = al256(off + bytes); return r; };
  p.ctl = (unsigned*)take(65536);
  p.Wb_in = (bf16_t*)take((size_t)2 * INP * 1024 * 2);
  p.Wb_uq = (bf16_t*)take((size_t)2 * 768 * 256 * 2);
  p.Wb_ukv = (bf16_t*)take((size_t)2 * 1024 * 128 * 2);
  p.Wb_out = (bf16_t*)take((size_t)2 * 1024 * 1024 * 2);
  p.dw2T = (bf16_t*)take((size_t)2 * 256 * 64 * 2);
  p.ia2T = (bf16_t*)take((size_t)2 * 256 * 64 * 2);
  p.ropec = (float*)take((size_t)PT * 16 * 4);
  p.ropes = (float*)take((size_t)PT * 16 * 4);
  p.ssq_x = (float*)take((size_t)7 * NTP * 4);
  p.ssq_q = p.ssq_x + 3 * NTP; p.ssq_kv = p.ssq_x + 5 * NTP;
  p.rkb = (float*)take((size_t)NTP * 4 * 4);
  p.xmeta = (float*)take((size_t)64 * 1024 * 4);
  p.zE = (bf16_t*)take((size_t)NTP * ZE * 2);
  p.zL = (bf16_t*)take((size_t)NTP * ZL * 2);
  p.xb = (bf16_t*)take((size_t)(NTP + 128) * D * 2);
  p.Kn = (bf16_t*)take((size_t)KVR * 512 * 2);
  p.Vt = (bf16_t*)take((size_t)512 * KVR * 2);
  p.Kr = (bf16_t*)take((size_t)KVR * 32 * 2);
  p.rw = take((size_t)NRW * RW_BYTES);
  static int grid = 0;
  if (grid == 0) {
    if (off > ws_size) { fprintf(stderr, "kernel_launch: workspace too small: need %zu have %zu\n", off, ws_size); grid = -1; return; }
    int dev = 0, cus = 0, per_cu = 0;
    (void)hipGetDevice(&dev);
    (void)hipDeviceGetAttribute(&cus, hipDeviceAttributeMultiprocessorCount, dev);
    (void)hipFuncSetAttribute((const void*)mega, hipFuncAttributeMaxDynamicSharedMemorySize, LDS_BYTES);
    (void)hipOccupancyMaxActiveBlocksPerMultiprocessor(&per_cu, (const void*)mega, 256, LDS_BYTES);
    if (per_cu > 2) per_cu = 2;
    if (per_cu < 1) { fprintf(stderr, "kernel_launch: occupancy query returned %d\n", per_cu); per_cu = 1; }
    grid = cus * per_cu;
  }
  if (grid < 0) return;
  (void)hipMemsetAsync(p.ctl, 0, 8192 * 4, stream);
  void* args[] = {&p};
  hipError_t e = hipLaunchCooperativeKernel((const void*)mega, dim3(grid), dim3(256), args, LDS_BYTES, stream);
  if (e != hipSuccess) fprintf(stderr, "cooperative launch failed: %s (grid %d)\n", hipGetErrorString(e), grid);
}
```

```cpp
#include <hip/hip_runtime.h>
#include <cstdio>
#include <cstdint>
#include <type_traits>

typedef unsigned short bf16_t;
typedef short bf16x8 __attribute__((ext_vector_type(8)));
typedef float f32x4 __attribute__((ext_vector_type(4)));
typedef float f32x16 __attribute__((ext_vector_type(16)));
#define DEV __device__ __forceinline__
#define LAUNDER(x) asm volatile("" : "+v"(x))

constexpr int D = 1024;
constexpr int PT = 4112;
constexpr int NPR = 4 * PT;
constexpr int NSM = 32 * 64;
constexpr int NT = NPR + NSM;
constexpr int NTP = 18560;
constexpr int ZL = 1792;
constexpr int ZE = 1312;
constexpr int ZE_CQ = 0, ZE_CKV = 256, ZE_KR = 384, ZE_ZC = 416;
constexpr int ZL_XIN = 0, ZL_BG = 256, ZL_CG = 512, ZL_GA = 768, ZL_GB = 1024, ZL_GC = 1536;
constexpr int INP = 3200;
constexpr int KVR = 16512;
constexpr int NRW_P = 4 * 65 * 4;
constexpr int NRW = NRW_P + 32 * 4;
constexpr int RW_BYTES = 49152;
constexpr float RMS_EPS = 1e-6f;
constexpr float GN_EPS = 64e-5f;
constexpr int LDS_BYTES = 79872;

struct Prm {
  const float *x_prompt, *x_sample, *cache_ckv, *cache_krope, *state_conv, *state_shift, *state_wkv, *meta, *norm_g, *w_in,
      *conv_w, *q_norm_g, *w_uq, *kv_norm_g, *w_ukv, *shift_mu, *decay_w0, *decay_w2, *iclr_a0, *iclr_a2, *key_kk, *key_ka,
      *bonus_rk, *lnx_w, *lnx_b, *w_out, *final_g;
  float *y_prompt, *y_sample, *ckv_p, *kr_p, *conv_p, *shift_p, *wkv_p, *ckv_s, *kr_s, *conv_s, *shift_s, *wkv_s;
  unsigned* ctl;
  bf16_t *Wb_in, *Wb_uq, *Wb_ukv, *Wb_out, *dw2T, *ia2T;
  float *ropec, *ropes, *ssq_x, *ssq_q, *ssq_kv, *rkb, *xmeta;
  bf16_t *zE, *zL, *xb, *Kn, *Vt, *Kr;
  char* rw;
};

DEV float bf2f(bf16_t b) { return __uint_as_float((unsigned)b << 16); }
DEV float bflo(unsigned u) { return __uint_as_float(u << 16); }
DEV float bfhi(unsigned u) { return __uint_as_float(u & 0xffff0000u); }
typedef __bf16 hbf16x2_t __attribute__((ext_vector_type(2)));
typedef float hf32x2_t __attribute__((ext_vector_type(2)));
DEV unsigned pk2(float a, float b) { hf32x2_t f = {a, b}; hbf16x2_t r = __builtin_convertvector(f, hbf16x2_t); return __builtin_bit_cast(unsigned, r); }
DEV bf16_t f2bf(float f) { return (bf16_t)(pk2(f, 0.f) & 0xffffu); }
DEV uint2 pk4(float a, float b, float c, float d) { uint2 r; r.x = pk2(a, b); r.y = pk2(c, d); return r; }
DEV float sigmoid_(float x) { return 1.f / (1.f + __expf(-x)); }
DEV float silu_(float x) { return x / (1.f + __expf(-x)); }
DEV float wave_sum(float v) {
#pragma unroll
  for (int o = 1; o < 64; o <<= 1) v += __shfl_xor(v, o);
  return v;
}
DEV f32x16 mfma32(bf16x8 a, bf16x8 b, f32x16 c) { return __builtin_amdgcn_mfma_f32_32x32x16_bf16(a, b, c, 0, 0, 0); }
DEV f32x4 mfma16(bf16x8 a, bf16x8 b, f32x4 c) { return __builtin_amdgcn_mfma_f32_16x16x32_bf16(a, b, c, 0, 0, 0); }
DEV bf16x8 mk8(unsigned a, unsigned b, unsigned c, unsigned d) { uint4 u; u.x = a; u.y = b; u.z = c; u.w = d; return __builtin_bit_cast(bf16x8, u); }
DEV bf16x8 mk8(uint4 u) { return __builtin_bit_cast(bf16x8, u); }
DEV f32x16 zero16() { f32x16 z; for (int i = 0; i < 16; ++i) z[i] = 0.f; return z; }

DEV float* xrow_ptr(const Prm& p, int R) {
  if (R < NPR) { int s = R / PT, q = R - s * PT; return q < 16 ? p.xmeta + (size_t)(s * 16 + q) * D : p.y_prompt + ((size_t)s * 4096 + (q - 16)) * D; }
  return p.y_sample + (size_t)(R - NPR) * D;
}
DEV const float* xin_ptr(const Prm& p, int R) {
  if (R < NPR) { int s = R / PT, q = R - s * PT; return q < 16 ? p.meta + (size_t)q * D : p.x_prompt + ((size_t)s * 4096 + (q - 16)) * D; }
  return p.x_sample + (size_t)(R - NPR) * D;
}
DEV int pos_of(int R) { return R < NPR ? R % PT : 1024 + ((R - NPR) & 63); }

DEV int win_src_col(int n) {
  if (n < 1024) return n;
  if (n < 1536) return 1440 + (n - 1024);
  if (n < 1792) return 2848 + (n - 1536);
  if (n < 2208) return 1024 + (n - 1792);
  if (n < 3104) return 1952 + (n - 2208);
  return -1;
}
DEV int perm32(int rho) { const int n = rho >> 4, i = rho & 15; return 8 * (i >> 2) + 4 * n + (i & 3); }
template <bool PERM, bool P32>
DEV void conv_weight_tile(const float* __restrict__ src, int K, int N, int Npad, bf16_t* __restrict__ dst, const float* __restrict__ sk, float cst, int l, int item, float* T  , int tid) {
  const int ntn = Npad / 64, ntk = K / 64;
  const int r = item, kt = r / ntn, nt = r - kt * ntn;
  const int k0 = kt * 64, n0 = nt * 64;
  {
    const int nslot = n0 + (tid & 15) * 4;
    const int nn = P32 ? (nslot & ~31) + perm32(nslot & 31) : nslot;
    const int sn = PERM ? win_src_col(nn) : (nn < N ? nn : -1);
#pragma unroll
    for (int i = 0; i < 4; ++i) {
      const int k = (tid >> 4) + 16 * i;
      float4 v = make_float4(0.f, 0.f, 0.f, 0.f);
      if (sn >= 0) {
        v = *(const float4*)(src + ((size_t)l * K + k0 + k) * N + sn);
        const float s = (sk ? sk[l * K + k0 + k] : 1.f) * cst;
        v.x *= s; v.y *= s; v.z *= s; v.w *= s;
      }
      float* t = T + k * 65 + (tid & 15) * 4;
      t[0] = v.x; t[1] = v.y; t[2] = v.z; t[3] = v.w;
    }
  }
  __syncthreads();
  {
    const int n = tid >> 2, kc = tid & 3;
    float v[16];
#pragma unroll
    for (int j = 0; j < 16; ++j) v[j] = T[(16 * kc + j) * 65 + n];
    uint4 o0, o1;
    o0.x = pk2(v[0], v[1]); o0.y = pk2(v[2], v[3]); o0.z = pk2(v[4], v[5]); o0.w = pk2(v[6], v[7]);
    o1.x = pk2(v[8], v[9]); o1.y = pk2(v[10], v[11]); o1.z = pk2(v[12], v[13]); o1.w = pk2(v[14], v[15]);
    bf16_t* d = dst + ((size_t)l * Npad + n0 + n) * K + k0 + 16 * kc;
    *(uint4*)d = o0; *(uint4*)(d + 8) = o1;
  }
  __syncthreads();
}
constexpr int WT0 = 16 * 50, WT1 = WT0 + 16 * 16, WT2 = WT1 + 4 * 12, WT3 = WT2 + 2 * 16, WT4 = WT3 + 4, NWT = WT4 + 4;
DEV void conv_weights_item(const Prm& p, int l, int it, char* lds) {
  float* T = (float*)lds;
  int tid = threadIdx.x; LAUNDER(tid);
  if (it < WT0) conv_weight_tile<true, true>(p.w_in, 1024, 3104, INP, p.Wb_in, p.norm_g, 1.f, l, it, T, tid);
  else if (it < WT1) conv_weight_tile<false, true>(p.w_out, 1024, 1024, 1024, p.Wb_out, nullptr, 1.f, l, it - WT0, T, tid);
  else if (it < WT2) conv_weight_tile<false, false>(p.w_uq, 256, 768, 768, p.Wb_uq, p.q_norm_g, 0.10206207261596575f * 1.4426950408889634f, l, it - WT1, T, tid);
  else if (it < WT3) conv_weight_tile<false, false>(p.w_ukv, 128, 1024, 1024, p.Wb_ukv, nullptr, 1.f, l, it - WT2, T, tid);
  else if (it < WT4) conv_weight_tile<false, false>(p.decay_w2, 64, 256, 256, p.dw2T, nullptr, 1.f, l, it - WT3, T, tid);
  else conv_weight_tile<false, false>(p.iclr_a2, 64, 256, 256, p.ia2T, nullptr, 1.f, l, it - WT4, T, tid);
}
DEV void phase0(const Prm& p, char* lds) {
  int tid = threadIdx.x; LAUNDER(tid);
  const int lane = tid & 63, wv = tid >> 6;
  const int gw = blockIdx.x * 4 + wv, NW = gridDim.x * 4;
  const int gt = blockIdx.x * 256 + tid, NTH = gridDim.x * 256;
  for (int R = gw; R < NT; R += NW) {
    const float* src = xin_ptr(p, R);
    float ss = 0.f;
#pragma unroll
    for (int j = 0; j < 4; ++j) {
      const float4 v = ((const float4*)src)[lane + 64 * j];
      ss += v.x * v.x + v.y * v.y + v.z * v.z + v.w * v.w;
      ((uint2*)(p.xb + (size_t)R * D))[lane + 64 * j] = pk4(v.x, v.y, v.z, v.w);
    }
    ss = wave_sum(ss);
    if (lane == 0) p.ssq_x[R] = ss;
  }
  for (int i = gt; i < 6 * NTP; i += NTH) p.ssq_x[NTP + i] = 0.f;
  for (int it = blockIdx.x; it < NWT; it += gridDim.x) conv_weights_item(p, 0, it, lds);
  for (int i = gt; i < PT * 16; i += NTH) {
    const int pos = i >> 4, j = i & 15;
    const float inv = powf(10000.f, -(float)j * 2.0f / 32.f);
    const float ang = (float)pos * inv;
    double a = (double)ang;
    a -= 6.283185307179586476925 * rint(a * 0.15915494309189533577);
    p.ropec[i] = (float)cos(a);
    p.ropes[i] = (float)sin(a);
  }
}

#define LAS3 __attribute__((address_space(3)))
#define RAW_BARRIER() { asm volatile("" ::: "memory"); __builtin_amdgcn_s_barrier(); asm volatile("" ::: "memory"); }
DEV int lds_byte(int r, int c) { const int st = (r >> 4) * 2 + (c >> 5), rr = r & 15, cc = c & 31, ob = rr * 64 + cc * 2; return st * 1024 + (ob ^ (((ob >> 9) & 1) << 5)); }
template <class Epi, int NB = 8>
DEV int gemm_tile(const bf16_t* __restrict__ A, int lda, const bf16_t* __restrict__ Bt, int ldb, int K, int m0, int n0, char* lds, const Epi& epi, unsigned* nctr = nullptr) {
  int tid = threadIdx.x; LAUNDER(tid);
  const int lane = tid & 63, w = __builtin_amdgcn_readfirstlane(tid >> 6), wr = w >> 1, wc = w & 1;
  const int fr = lane & 15, fq = lane >> 4;
  const int sb = lane * 16, swz = sb ^ (((sb >> 9) & 1) << 5), rl = swz >> 6, cl = (swz & 63) >> 1;
  const bf16_t* ga[4]; const bf16_t* gb[4];
#pragma unroll
  for (int i = 0; i < 4; ++i) {
    const int st = 4 * w + i, r = (st >> 1) * 16 + rl, c = (st & 1) * 32 + cl;
    ga[i] = A + (size_t)(m0 + r) * lda + c;
    gb[i] = Bt + (size_t)(n0 + r) * ldb + c;
  }
  const int nk = K / 64;
#define GSTAGE(S, KT) { _Pragma("unroll") for (int i = 0; i < 4; ++i) { \
      __builtin_amdgcn_global_load_lds((const unsigned*)(ga[i] + (KT) * 64), (LAS3 unsigned*)(lds + (S) * 32768 + (4 * w + i) * 1024 + lane * 16), 16, 0, 0); \
      if (2 * w + (i >> 1) < NB) __builtin_amdgcn_global_load_lds((const unsigned*)(gb[i] + (KT) * 64), (LAS3 unsigned*)(lds + (S) * 32768 + 16384 + (4 * w + i) * 1024 + lane * 16), 16, 0, 0); } }
  f32x4 acc[4][4];
#pragma unroll
  for (int i = 0; i < 4; ++i)
#pragma unroll
    for (int j = 0; j < 4; ++j) acc[i][j] = (f32x4){0.f, 0.f, 0.f, 0.f};
  int offA[2], offB[2];
#pragma unroll
  for (int kh = 0; kh < 2; ++kh) { offA[kh] = lds_byte(wr * 64 + fr, kh * 32 + fq * 8); offB[kh] = lds_byte(wc * 64 + fr, kh * 32 + fq * 8); }
  GSTAGE(0, 0)
  if (nk > 1) GSTAGE(1, 1)
  for (int kt = 0; kt < nk; ++kt) {
    const int s = kt & 1;
    if (kt + 1 < nk) { if (2 * w < NB) asm volatile("s_waitcnt vmcnt(8)" ::: "memory"); else asm volatile("s_waitcnt vmcnt(4)" ::: "memory"); }
    else asm volatile("s_waitcnt vmcnt(0)" ::: "memory");
    RAW_BARRIER()
    const char* ia = lds + s * 32768;
    const char* ib = ia + 16384;
    bf16x8 af[2][4], bfv[2][4];
#pragma unroll
    for (int kh = 0; kh < 2; ++kh) {
#pragma unroll
      for (int mi = 0; mi < 4; ++mi) af[kh][mi] = *(const bf16x8*)(ia + offA[kh] + mi * 2048);
#pragma unroll
      for (int ni = 0; ni < (NB < 4 ? NB : 4); ++ni) bfv[kh][ni] = *(const bf16x8*)(ib + offB[kh] + ni * 2048);
    }
    asm volatile("s_waitcnt lgkmcnt(0)" ::: "memory");
    RAW_BARRIER()
    if (kt + 2 < nk) GSTAGE(s, kt + 2)
    __builtin_amdgcn_sched_barrier(0);
    if (NB == 8 || wc == 0) {
#pragma unroll
      for (int kh = 0; kh < 2; ++kh)
#pragma unroll
        for (int mi = 0; mi < 4; ++mi)
#pragma unroll
          for (int ni = 0; ni < (NB < 4 ? NB : 4); ++ni) acc[mi][ni] = mfma16(bfv[kh][ni], af[kh][mi], acc[mi][ni]);
    }
  }
  __syncthreads();
#undef GSTAGE
  int tk = 0x7fffffff; if (nctr && tid == 0) tk = (int)atomicAdd(nctr, 1u);
  if (NB == 8 || wc == 0) epi(acc, m0 + wr * 64, n0 + wc * 64, fr, fq);
  return tk;
}

DEV int lds_byte32(int r, int c) { const int rr = r & 15, ob = rr * 64 + c * 2; return (r >> 4) * 1024 + (ob ^ (((ob >> 9) & 1) << 5)); }
template <class Epi>
DEV void gemm_tile_big(const bf16_t* __restrict__ A, int lda, const bf16_t* __restrict__ Bt, int ldb, int K, int m0, int n0, char* lds, const Epi& epi) {
  int tid = threadIdx.x; LAUNDER(tid);
  const int lane = tid & 63, w = __builtin_amdgcn_readfirstlane(tid >> 6), wr = w >> 1, wc = w & 1;
  const int fr = lane & 15, fq = lane >> 4;
  const int sb = lane * 16, swz = sb ^ (((sb >> 9) & 1) << 5), rl = swz >> 6, cl = (swz & 63) >> 1;
  const bf16_t* ga[4]; const bf16_t* gb[2];
#pragma unroll
  for (int i = 0; i < 4; ++i) ga[i] = A + (size_t)(m0 + (4 * w + i) * 16 + rl) * lda + cl;
#pragma unroll
  for (int i = 0; i < 2; ++i) gb[i] = Bt + (size_t)(n0 + (2 * w + i) * 16 + rl) * ldb + cl;
  const int nk = K / 32;
#define GSTAGE3(S, KT) { _Pragma("unroll") for (int i = 0; i < 4; ++i) \
      __builtin_amdgcn_global_load_lds((const unsigned*)(ga[i] + (KT) * 32), (LAS3 unsigned*)(lds + (S) * 24576 + (4 * w + i) * 1024 + lane * 16), 16, 0, 0); \
    _Pragma("unroll") for (int i = 0; i < 2; ++i) \
      __builtin_amdgcn_global_load_lds((const unsigned*)(gb[i] + (KT) * 32), (LAS3 unsigned*)(lds + (S) * 24576 + 16384 + (2 * w + i) * 1024 + lane * 16), 16, 0, 0); }
  f32x4 acc[8][4];
#pragma unroll
  for (int i = 0; i < 8; ++i)
#pragma unroll
    for (int j = 0; j < 4; ++j) acc[i][j] = (f32x4){0.f, 0.f, 0.f, 0.f};
  const int offA = lds_byte32(wr * 128 + fr, fq * 8), offB = 16384 + lds_byte32(wc * 64 + fr, fq * 8);
  GSTAGE3(0, 0)
  if (nk > 1) GSTAGE3(1, 1)
  int s = 0;
  for (int kt = 0; kt < nk; ++kt) {
    if (kt + 1 < nk) asm volatile("s_waitcnt vmcnt(6)" ::: "memory"); else asm volatile("s_waitcnt vmcnt(0)" ::: "memory");
    RAW_BARRIER()
    if (kt + 2 < nk) { const int s2 = s + 2 >= 3 ? s - 1 : s + 2; GSTAGE3(s2, kt + 2) }
    const char* im = lds + s * 24576;
    bf16x8 af[8], bfv[4];
#pragma unroll
    for (int ni = 0; ni < 4; ++ni) bfv[ni] = *(const bf16x8*)(im + offB + ni * 1024);
#pragma unroll
    for (int mi = 0; mi < 8; ++mi) af[mi] = *(const bf16x8*)(im + offA + mi * 1024);
#pragma unroll
    for (int mi = 0; mi < 8; ++mi)
#pragma unroll
      for (int ni = 0; ni < 4; ++ni) acc[mi][ni] = mfma16(bfv[ni], af[mi], acc[mi][ni]);
    s = s + 1 >= 3 ? 0 : s + 1;
  }
  __syncthreads();
#undef GSTAGE3
  epi(acc, m0 + wr * 128, n0 + wc * 64, fr, fq);
}

struct EpiIn {
  const Prm& p; int L;
  template <int MI>
  DEV void operator()(f32x4 (&acc)[MI][4], int mb, int nb, int fr, int fq) const {
#pragma unroll
    for (int mi = 0; mi < MI; ++mi) {
      const int m = mb + 16 * mi + fr;
      const bool ok = m < NT;
      const float rstd = rsqrtf(p.ssq_x[L * NTP + m] * (1.f / 1024.f) + RMS_EPS);
      float sq = 0.f;
#pragma unroll
      for (int g = 0; g < 2; ++g) {
        const int n0 = nb + 32 * g;
        if (n0 >= 3104) continue;
        bf16_t* dst = n0 < ZL ? p.zL + (size_t)m * ZL + n0 : p.zE + (size_t)m * ZE + (n0 - ZL);
        float v[8];
#pragma unroll
        for (int j = 0; j < 4; ++j) { v[j] = acc[mi][2 * g][j] * rstd; v[4 + j] = acc[mi][2 * g + 1][j] * rstd; }
#pragma unroll
        for (int j = 0; j < 8; ++j) sq += v[j] * v[j];
        if (ok) { uint4 o; o.x = pk2(v[0], v[1]); o.y = pk2(v[2], v[3]); o.z = pk2(v[4], v[5]); o.w = pk2(v[6], v[7]); *(uint4*)(dst + 8 * fq) = o; }
      }
      if (nb >= ZL && nb < ZL + 384) {
        sq += __shfl_xor(sq, 16); sq += __shfl_xor(sq, 32);
        if (fq == 0 && ok) atomicAdd((nb < ZL + 256 ? p.ssq_q : p.ssq_kv) + L * NTP + m, sq);
      }
    }
  }
};
struct EpiQ {
  const Prm& p; int L;
  DEV void operator()(f32x4 (&acc)[4][4], int mb, int nb, int fr, int fq) const {
    bf16_t* Qb = (bf16_t*)p.y_prompt;
#pragma unroll
    for (int mi = 0; mi < 4; ++mi) {
      const int m = mb + 16 * mi + fr;
      const bool ok = m < NT;
      const float rstd = rsqrtf(p.ssq_q[L * NTP + m] * (1.f / 256.f) + RMS_EPS);
      const int pos = pos_of(ok ? m : 0);
#pragma unroll
      for (int np = 0; np < 2; ++np) {
        const int n0 = nb + 32 * np;
        float v[2][4];
#pragma unroll
        for (int h2 = 0; h2 < 2; ++h2)
#pragma unroll
          for (int j = 0; j < 4; ++j) v[h2][j] = acc[mi][2 * np + h2][j] * rstd;
        if (((n0 >> 5) % 3) == 2) {
#pragma unroll
          for (int j = 0; j < 4; ++j) {
            const int c = 4 * fq + j;
            const float cs = p.ropec[pos * 16 + c], sn = p.ropes[pos * 16 + c];
            const float x1 = v[0][j], x2 = v[1][j];
            v[0][j] = x1 * cs - x2 * sn; v[1][j] = x1 * sn + x2 * cs;
          }
        }
        if (ok) {
          *(uint2*)(Qb + (size_t)m * 768 + n0 + 4 * fq) = pk4(v[0][0], v[0][1], v[0][2], v[0][3]);
          *(uint2*)(Qb + (size_t)m * 768 + n0 + 16 + 4 * fq) = pk4(v[1][0], v[1][1], v[1][2], v[1][3]);
        }
      }
    }
  }
};
struct EpiOut {
  const Prm& p; int L;
  DEV void operator()(f32x4 (&acc)[4][4], int mb, int nb, int fr, int fq) const {
#pragma unroll
    for (int mi = 0; mi < 4; ++mi) {
      const int m = mb + 16 * mi + fr;
      const bool ok = m < NT;
      bf16_t* xr = p.xb + (size_t)(ok ? m : 0) * D;
      float ss = 0.f;
#pragma unroll
      for (int g = 0; g < 2; ++g) {
        const int col = nb + 32 * g + 8 * fq;
        const uint4 xi = *(const uint4*)(xr + col);
        float v[8] = {bflo(xi.x), bfhi(xi.x), bflo(xi.y), bfhi(xi.y), bflo(xi.z), bfhi(xi.z), bflo(xi.w), bfhi(xi.w)};
#pragma unroll
        for (int j = 0; j < 4; ++j) { v[j] += acc[mi][2 * g][j]; v[4 + j] += acc[mi][2 * g + 1][j]; }
#pragma unroll
        for (int j = 0; j < 8; ++j) ss += v[j] * v[j];
        if (ok) { uint4 o; o.x = pk2(v[0], v[1]); o.y = pk2(v[2], v[3]); o.z = pk2(v[4], v[5]); o.w = pk2(v[6], v[7]); *(uint4*)(xr + col) = o; }
      }
      ss += __shfl_xor(ss, 16); ss += __shfl_xor(ss, 32);
      if (fq == 0 && ok) atomicAdd(p.ssq_x + (L + 1) * NTP + m, ss);
    }
  }
};

DEV void kv_prep_row(const Prm& p, int L, int R, int half, bool valid, bf16_t* At_row  ) {
  const int Rl = valid ? R : 0;
  const bf16_t* zr = p.zE + (size_t)Rl * ZE;
  const float rstd = rsqrtf(p.ssq_kv[L * NTP + Rl] * (1.f / 128.f) + RMS_EPS);
  float* outc; float* outk;
  if (Rl < NPR) { const int s = Rl / PT, q = Rl - s * PT; outc = p.ckv_p + (((size_t)L * 4 + s) * PT + q) * 128; outk = p.kr_p + (((size_t)L * 4 + s) * PT + q) * 32; }
  else { const int j = Rl - NPR; outc = p.ckv_s + ((size_t)L * NSM + j) * 128; outk = p.kr_s + ((size_t)L * NSM + j) * 32; }
  const float* g = p.kv_norm_g + L * 128 + 64 * half;
#pragma unroll
  for (int c8 = 0; c8 < 8; ++c8) {
    const uint4 u = *(const uint4*)(zr + ZE_CKV + 64 * half + 8 * c8);
    const float4 g0 = *(const float4*)(g + 8 * c8), g1 = *(const float4*)(g + 8 * c8 + 4);
    float4 y0, y1;
    y0.x = bflo(u.x) * rstd * g0.x; y0.y = bfhi(u.x) * rstd * g0.y; y0.z = bflo(u.y) * rstd * g0.z; y0.w = bfhi(u.y) * rstd * g0.w;
    y1.x = bflo(u.z) * rstd * g1.x; y1.y = bfhi(u.z) * rstd * g1.y; y1.z = bflo(u.w) * rstd * g1.z; y1.w = bfhi(u.w) * rstd * g1.w;
    if (valid) { *(float4*)(outc + 64 * half + 8 * c8) = y0; *(float4*)(outc + 64 * half + 8 * c8 + 4) = y1; }
    if (At_row) { uint4 o; o.x = pk2(y0.x, y0.y); o.y = pk2(y0.z, y0.w); o.z = pk2(y1.x, y1.y); o.w = pk2(y1.z, y1.w); *(uint4*)(At_row + 64 * half + 8 * c8) = o; }
    if (c8 & 1) __builtin_amdgcn_sched_barrier(0);
  }
  if (half == 0) {
    const int pos = pos_of(Rl);
#pragma unroll
    for (int c8 = 0; c8 < 2; ++c8) {
      const uint4 u = *(const uint4*)(zr + ZE_KR + 8 * c8), v = *(const uint4*)(zr + ZE_KR + 16 + 8 * c8);
      const float x1[8] = {bflo(u.x), bfhi(u.x), bflo(u.y), bfhi(u.y), bflo(u.z), bfhi(u.z), bflo(u.w), bfhi(u.w)};
      const float x2[8] = {bflo(v.x), bfhi(v.x), bflo(v.y), bfhi(v.y), bflo(v.z), bfhi(v.z), bflo(v.w), bfhi(v.w)};
      float y1[8], y2[8];
#pragma unroll
      for (int e = 0; e < 8; ++e) {
        const float cs = p.ropec[pos * 16 + 8 * c8 + e], sn = p.ropes[pos * 16 + 8 * c8 + e];
        y1[e] = x1[e] * cs - x2[e] * sn; y2[e] = x1[e] * sn + x2[e] * cs;
      }
      if (valid) {
        float4 o;
        o.x = y1[0]; o.y = y1[1]; o.z = y1[2]; o.w = y1[3]; *(float4*)(outk + 8 * c8) = o;
        o.x = y1[4]; o.y = y1[5]; o.z = y1[6]; o.w = y1[7]; *(float4*)(outk + 8 * c8 + 4) = o;
        o.x = y2[0]; o.y = y2[1]; o.z = y2[2]; o.w = y2[3]; *(float4*)(outk + 16 + 8 * c8) = o;
        o.x = y2[4]; o.y = y2[5]; o.z = y2[6]; o.w = y2[7]; *(float4*)(outk + 16 + 8 * c8 + 4) = o;
        if (Rl < NPR) {
          uint4 q; q.x = pk2(y1[0], y1[1]); q.y = pk2(y1[2], y1[3]); q.z = pk2(y1[4], y1[5]); q.w = pk2(y1[6], y1[7]); *(uint4*)(p.Kr + (size_t)Rl * 32 + 8 * c8) = q;
          q.x = pk2(y2[0], y2[1]); q.y = pk2(y2[2], y2[3]); q.z = pk2(y2[4], y2[5]); q.w = pk2(y2[6], y2[7]); *(uint4*)(p.Kr + (size_t)Rl * 32 + 16 + 8 * c8) = q;
        }
      }
    }
  }
}
DEV void kvproj_item(const Prm& p, int L, int mt, char* lds) {
  int tid = threadIdx.x; LAUNDER(tid);
  const int lane = tid & 63, w = __builtin_amdgcn_readfirstlane(tid >> 6), wr = w >> 1, wc = w & 1, l31 = lane & 31, hh = lane >> 5;
  bf16_t* At = (bf16_t*)lds;
  bf16_t* Bs = At + 128 * 136;
  {
    const int r = tid >> 1, half = tid & 1, R = mt * 128 + r;
    kv_prep_row(p, L, R, half, R < NPR, At + r * 136);
  }
  for (int h = 0; h < 8; ++h) {
    __syncthreads();
    {
      const bf16_t* wsrc = p.Wb_ukv + ((size_t)L * 1024 + h * 128) * 128;
#pragma unroll
      for (int i = 0; i < 8; ++i) { const int id = tid + 256 * i, row = id >> 4, cc = id & 15; *(uint4*)(Bs + row * 136 + cc * 8) = *(const uint4*)(wsrc + row * 128 + cc * 8); }
    }
    __syncthreads();
    f32x16 acc[2][2];
#pragma unroll
    for (int i = 0; i < 2; ++i)
#pragma unroll
      for (int j = 0; j < 2; ++j) acc[i][j] = zero16();
    const bf16_t* as = At + (wr * 64 + l31) * 136 + hh * 8;
    const bf16_t* bs = Bs + (wc * 64 + l31) * 136 + hh * 8;
    if (wc == 0) {
#pragma unroll 2
      for (int ks = 0; ks < 8; ++ks) {
        const bf16x8 a0 = *(const bf16x8*)(as + ks * 16), a1 = *(const bf16x8*)(as + 32 * 136 + ks * 16);
        const bf16x8 b0 = *(const bf16x8*)(bs + ks * 16), b1 = *(const bf16x8*)(bs + 32 * 136 + ks * 16);
        acc[0][0] = mfma32(b0, a0, acc[0][0]); acc[0][1] = mfma32(b1, a0, acc[0][1]);
        acc[1][0] = mfma32(b0, a1, acc[1][0]); acc[1][1] = mfma32(b1, a1, acc[1][1]);
      }
#pragma unroll
      for (int i = 0; i < 2; ++i) {
        const int KRr = mt * 128 + wr * 64 + 32 * i + l31;
#pragma unroll
        for (int j = 0; j < 2; ++j)
#pragma unroll
          for (int G = 0; G < 4; ++G)
            *(uint2*)(p.Kn + ((size_t)KRr * 8 + h) * 64 + 32 * j + 8 * G + 4 * hh) = pk4(acc[i][j][4 * G], acc[i][j][4 * G + 1], acc[i][j][4 * G + 2], acc[i][j][4 * G + 3]);
      }
    } else {
#pragma unroll 2
      for (int ks = 0; ks < 8; ++ks) {
        const bf16x8 a0 = *(const bf16x8*)(as + ks * 16), a1 = *(const bf16x8*)(as + 32 * 136 + ks * 16);
        const bf16x8 b0 = *(const bf16x8*)(bs + ks * 16), b1 = *(const bf16x8*)(bs + 32 * 136 + ks * 16);
        acc[0][0] = mfma32(a0, b0, acc[0][0]); acc[0][1] = mfma32(a0, b1, acc[0][1]);
        acc[1][0] = mfma32(a1, b0, acc[1][0]); acc[1][1] = mfma32(a1, b1, acc[1][1]);
      }
#pragma unroll
      for (int j = 0; j < 2; ++j) {
        const int d = 32 * j + l31;
#pragma unroll
        for (int i = 0; i < 2; ++i)
#pragma unroll
          for (int G = 0; G < 4; ++G) {
            const int KRr = mt * 128 + wr * 64 + 32 * i + 16 * (G >> 1) + 8 * hh + 4 * (G & 1);
            *(uint2*)(p.Vt + ((size_t)h * 64 + d) * KVR + KRr) = pk4(acc[i][j][4 * G], acc[i][j][4 * G + 1], acc[i][j][4 * G + 2], acc[i][j][4 * G + 3]);
          }
      }
    }
  }
  __syncthreads();
}
DEV void sample_prep_item(const Prm& p, int L, int it) {
  int tid = threadIdx.x; LAUNDER(tid);
  const int R = NPR + it * 128 + (tid >> 1);
  kv_prep_row(p, L, R, tid & 1, true, nullptr);
}
DEV void shift_item(const Prm& p, int L, int st) {
  int tid0 = threadIdx.x; LAUNDER(tid0);
  if (tid0 < 224) {
    const int R = st < 4 ? st * PT + (PT - 1) : NPR + (st - 4) * 64 + 63;
    const uint2 u = *(const uint2*)(p.zE + (size_t)R * ZE + ZE_ZC + 4 * tid0);
    float4 v; v.x = bflo(u.x); v.y = bfhi(u.x); v.z = bflo(u.y); v.w = bfhi(u.y);
    float* dst = st < 4 ? p.shift_p + ((size_t)L * 4 + st) * 896 : p.shift_s + ((size_t)L * 32 + (st - 4)) * 896;
    *(float4*)(dst + 4 * tid0) = v;
  }
}

template <bool SAMPLE>
DEV int attn_body(const Prm& p, int L, int sb, int head, int qt, char* lds, unsigned* nctr = nullptr) {
  int tid = threadIdx.x; LAUNDER(tid);
  const int lane = tid & 63, w = __builtin_amdgcn_readfirstlane(tid >> 6), l31 = lane & 31, hh = lane >> 5;
  bf16_t* Ks = (bf16_t*)lds;
  bf16_t* Vs = Ks + (SAMPLE ? 1 : 2) * 64 * 104;
  bf16_t* Cs = Vs + (SAMPLE ? 1 : 2) * 64 * 72;
  bf16_t* Wl = Cs + 64 * 136;
  const bf16_t* Qb = (const bf16_t*)p.y_prompt;
  bf16_t* mix = p.zE;
  int Rq0, ntiles, lastvis; bool wact, rowvalid;
  if (SAMPLE) { Rq0 = NPR + 64 * sb; ntiles = 17; lastvis = 16; wact = w < 2; rowvalid = wact; }
  else if (qt >= 0) { Rq0 = sb * PT + 16 + 128 * qt; ntiles = 2 * qt + 3; lastvis = 1 + 2 * qt + (w >> 1); wact = true; rowvalid = true; }
  else { Rq0 = sb * PT; ntiles = 1; lastvis = 0; wact = (w == 0); rowvalid = wact && l31 < 16; }
  const int myrow = Rq0 + 32 * w + l31;
  const int Rld = rowvalid ? myrow : Rq0;
  bf16x8 qf[6];
  {
    const bf16_t* qp = Qb + (size_t)Rld * 768 + head * 96 + hh * 8;
#pragma unroll
    for (int ks = 0; ks < 6; ++ks) qf[ks] = *(const bf16x8*)(qp + 16 * ks);
  }
  float m_run = -1e30f, l_run = 0.f;
  f32x16 o0 = zero16(), o1 = zero16();

  uint4 a_kn0, a_kn1, a_kr, a_vt0, a_vt1;
  a_kn0 = a_kn1 = a_kr = a_vt0 = a_vt1 = make_uint4(0, 0, 0, 0);
#define PLOADX(S, TI) { const int KR0 = sb * PT + ((TI) == 0 ? 0 : 16 + 64 * ((TI) - 1)); \
    S##_kn0 = *(const uint4*)(p.Kn + ((size_t)(KR0 + (tid >> 3)) * 8 + head) * 64 + (tid & 7) * 8); \
    S##_kn1 = *(const uint4*)(p.Kn + ((size_t)(KR0 + 32 + (tid >> 3)) * 8 + head) * 64 + (tid & 7) * 8); \
    S##_kr = *(const uint4*)(p.Kr + (size_t)(KR0 + (tid >> 2)) * 32 + (tid & 3) * 8); \
    S##_vt0 = *(const uint4*)(p.Vt + ((size_t)head * 64 + (tid >> 3)) * KVR + KR0 + (tid & 7) * 8); \
    S##_vt1 = *(const uint4*)(p.Vt + ((size_t)head * 64 + 32 + (tid >> 3)) * KVR + KR0 + (tid & 7) * 8); }
#define PWRITEX(S, BUF) { bf16_t* kb_ = Ks + (BUF) * 64 * 104; bf16_t* vb_ = Vs + (BUF) * 64 * 72; \
    *(uint4*)(kb_ + (tid >> 3) * 104 + (tid & 7) * 8) = S##_kn0; *(uint4*)(kb_ + (32 + (tid >> 3)) * 104 + (tid & 7) * 8) = S##_kn1; \
    *(uint4*)(kb_ + (tid >> 2) * 104 + 64 + (tid & 3) * 8) = S##_kr; \
    *(uint4*)(vb_ + (tid >> 3) * 72 + (tid & 7) * 8) = S##_vt0; *(uint4*)(vb_ + (32 + (tid >> 3)) * 72 + (tid & 7) * 8) = S##_vt1; }
  float4 pc0, pc1, pc2, pc3, pc4, pc5, pc6, pc7, pk0, pk1;
  pc0 = pc1 = pc2 = pc3 = pc4 = pc5 = pc6 = pc7 = pk0 = pk1 = make_float4(0.f, 0.f, 0.f, 0.f);
  if (SAMPLE) {
    const bf16_t* wsrc = p.Wb_ukv + ((size_t)L * 1024 + head * 128) * 128;
#pragma unroll
    for (int i = 0; i < 8; ++i) { const int id = tid + 256 * i, row = id >> 4, cc = id & 15; *(uint4*)(Wl + row * 136 + cc * 8) = *(const uint4*)(wsrc + row * 128 + cc * 8); }
  }
#define SLOAD(TI) { const float* csrc; const float* ksrc; \
    if ((TI) < 16) { csrc = p.cache_ckv + (((size_t)L * 32 + sb) * 1024 + 64 * (TI)) * 128; ksrc = p.cache_krope + (((size_t)L * 32 + sb) * 1024 + 64 * (TI)) * 32; } \
    else { csrc = p.ckv_s + ((size_t)L * NSM + 64 * sb) * 128; ksrc = p.kr_s + ((size_t)L * NSM + 64 * sb) * 32; } \
    const float* cb_ = csrc + (tid >> 5) * 128 + (tid & 31) * 4; \
    pc0 = *(const float4*)(cb_); pc1 = *(const float4*)(cb_ + 8 * 128); pc2 = *(const float4*)(cb_ + 16 * 128); pc3 = *(const float4*)(cb_ + 24 * 128); \
    pc4 = *(const float4*)(cb_ + 32 * 128); pc5 = *(const float4*)(cb_ + 40 * 128); pc6 = *(const float4*)(cb_ + 48 * 128); pc7 = *(const float4*)(cb_ + 56 * 128); \
    const float* kb2_ = ksrc + (tid >> 3) * 32 + (tid & 7) * 4; pk0 = *(const float4*)(kb2_); pk1 = *(const float4*)(kb2_ + 32 * 32); }
#define SWRITE(BUF) { bf16_t* cd_ = Cs + (tid >> 5) * 136 + (tid & 31) * 4; \
    *(uint2*)(cd_) = pk4(pc0.x, pc0.y, pc0.z, pc0.w); *(uint2*)(cd_ + 8 * 136) = pk4(pc1.x, pc1.y, pc1.z, pc1.w); \
    *(uint2*)(cd_ + 16 * 136) = pk4(pc2.x, pc2.y, pc2.z, pc2.w); *(uint2*)(cd_ + 24 * 136) = pk4(pc3.x, pc3.y, pc3.z, pc3.w); \
    *(uint2*)(cd_ + 32 * 136) = pk4(pc4.x, pc4.y, pc4.z, pc4.w); *(uint2*)(cd_ + 40 * 136) = pk4(pc5.x, pc5.y, pc5.z, pc5.w); \
    *(uint2*)(cd_ + 48 * 136) = pk4(pc6.x, pc6.y, pc6.z, pc6.w); *(uint2*)(cd_ + 56 * 136) = pk4(pc7.x, pc7.y, pc7.z, pc7.w); \
    }
#define SWRITEK(BUF) { bf16_t* kd_ = Ks + (BUF) * 64 * 104 + (tid >> 3) * 104 + 64 + (tid & 7) * 4; \
    *(uint2*)(kd_) = pk4(pk0.x, pk0.y, pk0.z, pk0.w); *(uint2*)(kd_ + 32 * 104) = pk4(pk1.x, pk1.y, pk1.z, pk1.w); }
  auto sexpand = [&](int buf) {
    const int a = w & 1, b = w >> 1;
    const bf16_t* cp = Cs + (32 * b + l31) * 136 + hh * 8;
    const bf16_t* wkp = Wl + (32 * a + l31) * 136 + hh * 8;
    const bf16_t* wvp = wkp + 64 * 136;
    f32x16 ka = zero16(), va = zero16();
#pragma unroll
    for (int ks = 0; ks < 8; ++ks) {
      const bf16x8 cf = *(const bf16x8*)(cp + 16 * ks);
      ka = mfma32(*(const bf16x8*)(wkp + 16 * ks), cf, ka);
      va = mfma32(cf, *(const bf16x8*)(wvp + 16 * ks), va);
    }
    bf16_t* kb = Ks + buf * 64 * 104; bf16_t* vb = Vs + buf * 64 * 72;
#pragma unroll
    for (int G = 0; G < 4; ++G) {
      *(uint2*)(kb + (32 * b + l31) * 104 + 32 * a + 8 * G + 4 * hh) = pk4(ka[4 * G], ka[4 * G + 1], ka[4 * G + 2], ka[4 * G + 3]);
      *(uint2*)(vb + (32 * a + l31) * 72 + 32 * b + 8 * G + 4 * hh) = pk4(va[4 * G], va[4 * G + 1], va[4 * G + 2], va[4 * G + 3]);
    }
  };
  const int x7 = (l31 >> 1) & 7, x3 = (l31 >> 2) & 3, xv = (l31 >> 1) & 7;
#define KFRAG(SP, KS, SUB) (SAMPLE ? *(const bf16x8*)((const bf16_t*)(SP) + (l31 + 32 * (SUB)) * 104 + hh * 8 + 16 * (KS)) \
    : ((KS) < 4 ? *(const bf16x8*)((SP) + (l31 + 32 * (SUB)) * 128 + (((2 * (KS) + hh) ^ x7) << 4)) \
                : *(const bf16x8*)((SP) + 8192 + (l31 + 32 * (SUB)) * 64 + (((2 * ((KS) - 4) + hh) ^ x3) << 4))))
#define VHALF(SP, C, SUB) (SAMPLE ? *(const uint2*)((const bf16_t*)(SP) + 64 * 104 + (l31 + 32 * (SUB)) * 72 + 4 * hh + 8 * (C)) \
    : *(const uint2*)((SP) + 12288 + (l31 + 32 * (SUB)) * 128 + 8 * hh + ((((C)) ^ xv) << 4)))
  auto compute_t = [&](auto masked_c, const char* sp) {
    constexpr bool MASKED = decltype(masked_c)::value;
    f32x16 s0 = zero16(), s1 = zero16();
#pragma unroll
    for (int ks = 0; ks < 6; ++ks) {
      const bf16x8 k0 = KFRAG(sp, ks, 0), k1 = KFRAG(sp, ks, 1);
      s0 = mfma32(k0, qf[ks], s0); s1 = mfma32(k1, qf[ks], s1);
    }
    if (!SAMPLE && MASKED) {
#pragma unroll
      for (int r = 8; r < 16; ++r) s0[r] = -1e30f;
#pragma unroll
      for (int r = 0; r < 16; ++r) s1[r] = -1e30f;
    }
    float mx = s0[0];
#pragma unroll
    for (int r = 1; r < 16; ++r) mx = fmaxf(mx, s0[r]);
#pragma unroll
    for (int r = 0; r < 16; ++r) mx = fmaxf(mx, s1[r]);
    mx = fmaxf(mx, __shfl_xor(mx, 32));
    const float mnew = fmaxf(m_run, mx);
    const float alpha = __builtin_amdgcn_exp2f(m_run - mnew);
    m_run = mnew;
    float ps = 0.f;
#pragma unroll
    for (int r = 0; r < 16; ++r) { s0[r] = __builtin_amdgcn_exp2f(s0[r] - mnew); ps += s0[r]; }
#pragma unroll
    for (int r = 0; r < 16; ++r) { s1[r] = __builtin_amdgcn_exp2f(s1[r] - mnew); ps += s1[r]; }
    l_run = l_run * alpha + ps;
#pragma unroll
    for (int r = 0; r < 16; ++r) { o0[r] *= alpha; o1[r] *= alpha; }
    const bf16x8 pf0 = mk8(pk2(s0[0], s0[1]), pk2(s0[2], s0[3]), pk2(s0[4], s0[5]), pk2(s0[6], s0[7]));
    const bf16x8 pf1 = mk8(pk2(s0[8], s0[9]), pk2(s0[10], s0[11]), pk2(s0[12], s0[13]), pk2(s0[14], s0[15]));
    const bf16x8 pf2 = mk8(pk2(s1[0], s1[1]), pk2(s1[2], s1[3]), pk2(s1[4], s1[5]), pk2(s1[6], s1[7]));
    const bf16x8 pf3 = mk8(pk2(s1[8], s1[9]), pk2(s1[10], s1[11]), pk2(s1[12], s1[13]), pk2(s1[14], s1[15]));
#define PV_STEP(S, PF) { bf16x8 v0_, v1_; \
      if (SAMPLE) { const uint2 a0 = VHALF(sp, 2 * S, 0), b0 = VHALF(sp, 2 * S + 1, 0), a1 = VHALF(sp, 2 * S, 1), b1 = VHALF(sp, 2 * S + 1, 1); \
        v0_ = mk8(a0.x, a0.y, b0.x, b0.y); v1_ = mk8(a1.x, a1.y, b1.x, b1.y); } \
      else { v0_ = *(const bf16x8*)(sp + 12288 + l31 * 128 + (((2 * S + hh) ^ xv) << 4)); v1_ = *(const bf16x8*)(sp + 12288 + (l31 + 32) * 128 + (((2 * S + hh) ^ xv) << 4)); } \
      o0 = mfma32(v0_, PF, o0); o1 = mfma32(v1_, PF, o1); }
    PV_STEP(0, pf0) PV_STEP(1, pf1) PV_STEP(2, pf2) PV_STEP(3, pf3)
  };
  bf16x8 qf7 = mk8(0u, 0u, 0u, 0u);
  const bf16x8 kone = mk8(hh == 0 ? 0x3F80u : 0u, 0u, 0u, 0u);
  auto freeze = [&]() {
    const float mf = bflo(pk2(m_run, 0.f));
    const float fac = __builtin_amdgcn_exp2f(m_run - mf);
    l_run *= fac;
#pragma unroll
    for (int r = 0; r < 16; ++r) { o0[r] *= fac; o1[r] *= fac; }
    qf7 = mk8(hh == 0 ? (pk2(-mf, 0.f) & 0xffffu) : 0u, 0u, 0u, 0u);
  };
  auto compute_f = [&](const char* sp) {
    f32x16 s0 = mfma32(kone, qf7, zero16()), s1 = mfma32(kone, qf7, zero16());
#pragma unroll
    for (int ks = 0; ks < 6; ++ks) {
      const bf16x8 k0 = KFRAG(sp, ks, 0), k1 = KFRAG(sp, ks, 1);
      s0 = mfma32(k0, qf[ks], s0); s1 = mfma32(k1, qf[ks], s1);
    }
    float ps = 0.f;
#pragma unroll
    for (int r = 0; r < 16; ++r) { s0[r] = __builtin_amdgcn_exp2f(s0[r]); ps += s0[r]; }
#pragma unroll
    for (int r = 0; r < 16; ++r) { s1[r] = __builtin_amdgcn_exp2f(s1[r]); ps += s1[r]; }
    l_run += ps;
    const bf16x8 pf0 = mk8(pk2(s0[0], s0[1]), pk2(s0[2], s0[3]), pk2(s0[4], s0[5]), pk2(s0[6], s0[7]));
    const bf16x8 pf1 = mk8(pk2(s0[8], s0[9]), pk2(s0[10], s0[11]), pk2(s0[12], s0[13]), pk2(s0[14], s0[15]));
    const bf16x8 pf2 = mk8(pk2(s1[0], s1[1]), pk2(s1[2], s1[3]), pk2(s1[4], s1[5]), pk2(s1[6], s1[7]));
    const bf16x8 pf3 = mk8(pk2(s1[8], s1[9]), pk2(s1[10], s1[11]), pk2(s1[12], s1[13]), pk2(s1[14], s1[15]));
    PV_STEP(0, pf0) PV_STEP(1, pf1) PV_STEP(2, pf2) PV_STEP(3, pf3)
#undef PV_STEP
  };

  if (SAMPLE) {
    SLOAD(0)
    for (int ti = 0; ti < ntiles; ++ti) {
      const int buf = 0;
      SWRITE(buf)
      __syncthreads();
      SWRITEK(buf)
      { const int tn = ti + 1 < ntiles ? ti + 1 : ti; SLOAD(tn) }
      sexpand(buf);
      __syncthreads();
      if (wact) { if (ti == 0) { compute_t(std::false_type{}, (const char*)Ks); freeze(); } else compute_f((const char*)Ks); }
    }
    __syncthreads();
  } else {
    const int l8 = lane >> 3, c8 = lane & 7;
    unsigned kn_o0, kn_o1, kr_o, vt_o0, vt_o1;
    { const int r = 8 * (2 * w) + l8; kn_o0 = (unsigned)((r * 8 + head) * 64 + ((c8 ^ ((r >> 1) & 7)) * 8)); }
    { const int r = 8 * (2 * w + 1) + l8; kn_o1 = (unsigned)((r * 8 + head) * 64 + ((c8 ^ ((r >> 1) & 7)) * 8)); }
    { const int r = 16 * w + (lane >> 2); kr_o = (unsigned)(r * 32 + (((lane & 3) ^ ((r >> 2) & 3)) * 8)); }
    { const int d = 8 * (2 * w) + l8; vt_o0 = (unsigned)((head * 64 + d) * KVR + ((c8 ^ ((d >> 1) & 7)) * 8)); }
    { const int d = 8 * (2 * w + 1) + l8; vt_o1 = (unsigned)((head * 64 + d) * KVR + ((c8 ^ ((d >> 1) & 7)) * 8)); }
#define GLDS16(G, Lp) __builtin_amdgcn_global_load_lds((const unsigned*)(G), (LAS3 unsigned*)(Lp), 16, 0, 0)
#define PDMA(TI, STG) { const int KR0 = sb * PT + ((TI) == 0 ? 0 : 16 + 64 * ((TI) - 1)); char* sb_ = lds + (STG) * 20480 + lane * 16; \
      const bf16_t* kn_ = p.Kn + (size_t)KR0 * 512; const bf16_t* kr_ = p.Kr + (size_t)KR0 * 32; const bf16_t* vt_ = p.Vt + KR0; \
      GLDS16(kn_ + kn_o0, sb_ + (2 * w) * 1024); GLDS16(kn_ + kn_o1, sb_ + (2 * w + 1) * 1024); GLDS16(kr_ + kr_o, sb_ + 8192 + w * 1024); \
      GLDS16(vt_ + vt_o0, sb_ + 12288 + (2 * w) * 1024); GLDS16(vt_ + vt_o1, sb_ + 12288 + (2 * w + 1) * 1024); }
    PDMA(0, 0)
    if (ntiles > 1) PDMA(1, 1)
    int stg = 0, stg2 = 2;
    for (int ti = 0; ti < ntiles; ++ti) {
      if (ti + 1 < ntiles) asm volatile("s_waitcnt vmcnt(5)" ::: "memory"); else asm volatile("s_waitcnt vmcnt(0)" ::: "memory");
      RAW_BARRIER()
      if (ti + 2 < ntiles) PDMA(ti + 2, stg2)
      const char* sp = lds + stg * 20480;
      if (ti == 0) { if (wact) compute_t(std::true_type{}, sp); }
      else if (ti == 1) { compute_t(std::false_type{}, sp); freeze(); }
      else if (ti <= lastvis) compute_f(sp);
      stg = stg == 2 ? 0 : stg + 1; stg2 = stg2 == 2 ? 0 : stg2 + 1;
    }
    __syncthreads();
#undef PDMA
#undef GLDS16
  }
  int tk = 0x7fffffff; if (nctr && tid == 0) tk = (int)atomicAdd(nctr, 1u);
  const float lt = l_run + __shfl_xor(l_run, 32);
  if (rowvalid) {
    const float inv = 1.f / lt;
    const bf16_t* gbp = p.zL + (size_t)myrow * ZL + ZL_GB + 64 * head;
    bf16_t* op = mix + (size_t)myrow * D + 256 + 64 * head;
#pragma unroll
    for (int G = 0; G < 4; ++G) {
      const int d = 8 * G + 4 * hh;
      const uint2 g0 = *(const uint2*)(gbp + d), g1 = *(const uint2*)(gbp + 32 + d);
      *(uint2*)(op + d) = pk4(o0[4 * G] * inv * silu_(bflo(g0.x)), o0[4 * G + 1] * inv * silu_(bfhi(g0.x)), o0[4 * G + 2] * inv * silu_(bflo(g0.y)), o0[4 * G + 3] * inv * silu_(bfhi(g0.y)));
      *(uint2*)(op + 32 + d) = pk4(o1[4 * G] * inv * silu_(bflo(g1.x)), o1[4 * G + 1] * inv * silu_(bfhi(g1.x)), o1[4 * G + 2] * inv * silu_(bflo(g1.y)), o1[4 * G + 3] * inv * silu_(bfhi(g1.y)));
    }
  }
  return tk;
}
DEV void attn_item(const Prm& p, int L, int id, char* lds) {
  if (id < 1024) { const int qt = 31 - (id >> 5), sh = id & 31; attn_body<false>(p, L, sh >> 3, sh & 7, qt, lds); }
  else if (id < 1280) { const int j = id - 1024; attn_body<true>(p, L, j >> 3, j & 7, 0, lds); }
  else { const int j = id - 1280; attn_body<false>(p, L, j >> 3, j & 7, -1, lds); }
}

DEV void conv_item(const Prm& p, int L, int item) {
  int tid = threadIdx.x; LAUNDER(tid);
  bf16_t* mix = p.zE;
  const int c0 = (tid & 31) * 8;
  float w0[8], w1[8], w2[8];
#pragma unroll
  for (int e = 0; e < 8; ++e) { w0[e] = p.conv_w[(L * 3 + 0) * 256 + c0 + e]; w1[e] = p.conv_w[(L * 3 + 1) * 256 + c0 + e]; w2[e] = p.conv_w[(L * 3 + 2) * 256 + c0 + e]; }
  for (int it = 0; it < 4; ++it) {
    const int R = item * 32 + it * 8 + (tid >> 5);
    if (R >= NT) continue;
    int q, T; const float* st; float* so;
    if (R < NPR) { const int s = R / PT; q = R - s * PT; T = PT; st = nullptr; so = p.conv_p + ((size_t)L * 4 + s) * 512; }
    else { const int b = (R - NPR) >> 6; q = (R - NPR) & 63; T = 64; st = p.state_conv + ((size_t)L * 32 + b) * 512; so = p.conv_s + ((size_t)L * 32 + b) * 512; }
    float u[3][8];
#pragma unroll
    for (int dlt = 0; dlt < 3; ++dlt) {
      const int t = q - 2 + dlt;
      if (t >= 0) {
        const bf16_t* zr = p.zL + (size_t)(R - 2 + dlt) * ZL;
        const uint4 xi = *(const uint4*)(zr + ZL_XIN + c0), cg = *(const uint4*)(zr + ZL_CG + c0);
        u[dlt][0] = bflo(xi.x) * bflo(cg.x); u[dlt][1] = bfhi(xi.x) * bfhi(cg.x); u[dlt][2] = bflo(xi.y) * bflo(cg.y); u[dlt][3] = bfhi(xi.y) * bfhi(cg.y);
        u[dlt][4] = bflo(xi.z) * bflo(cg.z); u[dlt][5] = bfhi(xi.z) * bfhi(cg.z); u[dlt][6] = bflo(xi.w) * bflo(cg.w); u[dlt][7] = bfhi(xi.w) * bfhi(cg.w);
      } else if (st) {
        const float* sr = st + (t + 2) * 256 + c0;
#pragma unroll
        for (int e = 0; e < 8; ++e) u[dlt][e] = sr[e];
      } else {
#pragma unroll
        for (int e = 0; e < 8; ++e) u[dlt][e] = 0.f;
      }
    }
    const bf16_t* zr = p.zL + (size_t)R * ZL;
    const uint4 bg = *(const uint4*)(zr + ZL_BG + c0), ga = *(const uint4*)(zr + ZL_GA + c0);
    const float bgf[8] = {bflo(bg.x), bfhi(bg.x), bflo(bg.y), bfhi(bg.y), bflo(bg.z), bfhi(bg.z), bflo(bg.w), bfhi(bg.w)};
    const float gaf[8] = {bflo(ga.x), bfhi(ga.x), bflo(ga.y), bfhi(ga.y), bflo(ga.z), bfhi(ga.z), bflo(ga.w), bfhi(ga.w)};
    float y[8];
#pragma unroll
    for (int e = 0; e < 8; ++e) y[e] = bgf[e] * (w0[e] * u[0][e] + w1[e] * u[1][e] + w2[e] * u[2][e]) * silu_(gaf[e]);
    uint4 o; o.x = pk2(y[0], y[1]); o.y = pk2(y[2], y[3]); o.z = pk2(y[4], y[5]); o.w = pk2(y[6], y[7]);
    *(uint4*)(mix + (size_t)R * D + c0) = o;
    if (q >= T - 2) {
      float* d = so + (q - (T - 2)) * 256 + c0;
#pragma unroll
      for (int e = 0; e < 8; ++e) d[e] = u[2][e];
    }
  }
}

DEV int kperm_addr(int m, int kin) {
  const int mt = m >> 4, ml = m & 15, s = kin >> 5, q = (kin >> 4) & 1, g = (kin >> 2) & 3, e = kin & 3;
  return (((mt * 2 + s) * 64 + ml + 16 * g) * 8) + 4 * q + e;
}
DEV int clay_addr(int x, int v) {
  const int xt = x >> 4, g = (x >> 2) & 3, rr = x & 3, vt = v >> 4, l16 = v & 15;
  return ((xt * 4 + vt) * 64 + 16 * g + l16) * 4 + rr;
}
DEV void mm64(const bf16_t* first, const bf16_t* second, int l31, int hh, f32x16 (&acc)[2][2]) {
#pragma unroll
  for (int ks = 0; ks < 4; ++ks) {
    const bf16x8 f0 = *(const bf16x8*)(first + l31 * 72 + ks * 16 + hh * 8), f1 = *(const bf16x8*)(first + (32 + l31) * 72 + ks * 16 + hh * 8);
    const bf16x8 s0 = *(const bf16x8*)(second + l31 * 72 + ks * 16 + hh * 8), s1 = *(const bf16x8*)(second + (32 + l31) * 72 + ks * 16 + hh * 8);
    acc[0][0] = mfma32(f0, s0, acc[0][0]); acc[0][1] = mfma32(f0, s1, acc[0][1]);
    acc[1][0] = mfma32(f1, s0, acc[1][0]); acc[1][1] = mfma32(f1, s1, acc[1][1]);
  }
}
DEV void mm64x32(const bf16_t* first, const bf16_t* second_rows, int l31, int hh, f32x16 (&acc)[2]) {
#pragma unroll
  for (int ks = 0; ks < 4; ++ks) {
    const bf16x8 f0 = *(const bf16x8*)(first + l31 * 72 + ks * 16 + hh * 8), f1 = *(const bf16x8*)(first + (32 + l31) * 72 + ks * 16 + hh * 8);
    const bf16x8 s0 = *(const bf16x8*)(second_rows + l31 * 72 + ks * 16 + hh * 8);
    acc[0] = mfma32(f0, s0, acc[0]); acc[1] = mfma32(f1, s0, acc[1]);
  }
}

DEV void mmq(const bf16_t* first_rows, const bf16_t* second_rows, int l31, int hh, f32x16& acc) {
#pragma unroll
  for (int ks = 0; ks < 4; ++ks) {
    const bf16x8 f0 = *(const bf16x8*)(first_rows + l31 * 72 + ks * 16 + hh * 8);
    const bf16x8 s0 = *(const bf16x8*)(second_rows + l31 * 72 + ks * 16 + hh * 8);
    acc = mfma32(f0, s0, acc);
  }
}
enum { SH_FULL = 0, SH_UP = 1, SH_LO = 2 };
template <int SH> DEV constexpr bool tile_nz(int tx, int ty) { return SH == SH_FULL || (SH == SH_UP ? tx <= ty : tx >= ty); }
struct Acc64 { f32x16 t[2][2]; };
struct Frag64 { bf16x8 f[4][2]; };
template <int SS> DEV bf16x8 pack8(const f32x16& v) {
  return mk8(pk2(v[8 * SS], v[8 * SS + 1]), pk2(v[8 * SS + 2], v[8 * SS + 3]), pk2(v[8 * SS + 4], v[8 * SS + 5]), pk2(v[8 * SS + 6], v[8 * SS + 7]));
}
template <int SH> DEV void to_frag(const Acc64& X, Frag64& F) {
#pragma unroll
  for (int t = 0; t < 2; ++t) {
    if (tile_nz<SH>(0, t)) { F.f[0][t] = pack8<0>(X.t[0][t]); F.f[1][t] = pack8<1>(X.t[0][t]); }
    if (tile_nz<SH>(1, t)) { F.f[2][t] = pack8<0>(X.t[1][t]); F.f[3][t] = pack8<1>(X.t[1][t]); }
  }
}
template <int SH> DEV void zero_acc(Acc64& X) {
#pragma unroll
  for (int a = 0; a < 2; ++a)
#pragma unroll
    for (int b = 0; b < 2; ++b) if (tile_nz<SH>(a, b)) X.t[a][b] = zero16();
}
template <int SHA, int SHB> DEV void prod_ff(const Frag64& A, const Frag64& B, Acc64& D) {
#pragma unroll
  for (int tm = 0; tm < 2; ++tm)
#pragma unroll
    for (int tn = 0; tn < 2; ++tn)
#pragma unroll
      for (int s = 0; s < 4; ++s)
        if (tile_nz<SHA>(s >> 1, tm) && tile_nz<SHB>(s >> 1, tn)) D.t[tm][tn] = mfma32(A.f[s][tm], B.f[s][tn], D.t[tm][tn]);
}
template <int SHA, int SHB, int SHD> DEV void prod_ff_frag(const Frag64& A, const Frag64& B, Frag64& Fo) {
#pragma unroll
  for (int tm = 0; tm < 2; ++tm)
#pragma unroll
    for (int tn = 0; tn < 2; ++tn)
      if (tile_nz<SHD>(tm, tn)) {
        f32x16 acc = zero16();
#pragma unroll
        for (int s = 0; s < 4; ++s)
          if (tile_nz<SHA>(s >> 1, tm) && tile_nz<SHB>(s >> 1, tn)) acc = mfma32(A.f[s][tm], B.f[s][tn], acc);
        Fo.f[2 * tm][tn] = pack8<0>(acc); Fo.f[2 * tm + 1][tn] = pack8<1>(acc);
      }
}
DEV bf16x8 nat_frag(const bf16_t* S, int row, int s, int hh) { return *(const bf16x8*)(S + row * 72 + 16 * s + 8 * hh); }
DEV bf16x8 perm_frag(const bf16_t* S, int row, int s, int hh) {
  const uint2 a = *(const uint2*)(S + row * 72 + 16 * s + 4 * hh), b = *(const uint2*)(S + row * 72 + 16 * s + 8 + 4 * hh);
  return mk8(a.x, a.y, b.x, b.y);
}
template <int SH, int MODE> DEV void gram(const bf16_t* F, const bf16_t* G, int l31, int hh, Acc64& D) {
  zero_acc<SH>(D);
#pragma unroll
  for (int s = 0; s < 4; ++s) {
    bf16x8 ff[2], gg[2];
#pragma unroll
    for (int t = 0; t < 2; ++t) { ff[t] = nat_frag(F, 32 * t + l31, s, hh); gg[t] = nat_frag(G, 32 * t + l31, s, hh); }
#pragma unroll
    for (int tx = 0; tx < 2; ++tx)
#pragma unroll
      for (int ty = 0; ty < 2; ++ty) if (tile_nz<SH>(tx, ty)) D.t[tx][ty] = mfma32(ff[tx], gg[ty], D.t[tx][ty]);
  }
#pragma unroll
  for (int t = 0; t < 2; ++t)
#pragma unroll
    for (int r = 0; r < 16; ++r) {
      const int x = (r & 3) + 8 * (r >> 2) + 4 * hh, y = l31;
      const bool keep = MODE == 0 ? (x < y) : (MODE == 1 ? (y < x) : (x <= y));
      if (!keep) D.t[t][t][r] = 0.f;
    }
}
template <int SHA> DEV void prod_fm_frag(const Frag64& A, const bf16_t* Mem, int l31, int hh, Frag64& Fo) {
#pragma unroll
  for (int tm = 0; tm < 2; ++tm)
#pragma unroll
    for (int tn = 0; tn < 2; ++tn) {
      f32x16 acc = zero16();
#pragma unroll
      for (int s = 0; s < 4; ++s) if (tile_nz<SHA>(s >> 1, tm)) acc = mfma32(A.f[s][tm], perm_frag(Mem, 32 * tn + l31, s, hh), acc);
      Fo.f[2 * tm][tn] = pack8<0>(acc); Fo.f[2 * tm + 1][tn] = pack8<1>(acc);
    }
}
template <int SHA> DEV void prod_fm(const Frag64& A, const bf16_t* Mem, int l31, int hh, Acc64& D) {
#pragma unroll
  for (int s = 0; s < 4; ++s) {
    bf16x8 mm[2];
#pragma unroll
    for (int t = 0; t < 2; ++t) mm[t] = perm_frag(Mem, 32 * t + l31, s, hh);
#pragma unroll
    for (int tm = 0; tm < 2; ++tm)
#pragma unroll
      for (int tn = 0; tn < 2; ++tn) if (tile_nz<SHA>(s >> 1, tm)) D.t[tm][tn] = mfma32(A.f[s][tm], mm[tn], D.t[tm][tn]);
  }
}
DEV void r1_item(const Prm& p, int L, int idx, char* lds) {
  int tid = threadIdx.x; LAUNDER(tid);
  const int w = __builtin_amdgcn_readfirstlane(tid >> 6);
  int lane = tid & 63, l31 = lane & 31, hh = lane >> 5;
  const int cw = w & 1, tw = w >> 1;
  bf16_t* S0 = (bf16_t*)lds;
  bf16_t* S1 = S0 + 4608; bf16_t* S2 = S1 + 4608; bf16_t* S3 = S2 + 4608; bf16_t* S4 = S3 + 4608; bf16_t* S5 = S4 + 4608; bf16_t* S6 = S5 + 4608; bf16_t* S7 = S6 + 4608;
  float* misc = (float*)(S7 + 4608);
  float* Ef = (float*)S4;
  bool prompt; int st, c, hd;
  if (idx < NRW_P) { prompt = true; st = idx / 260; const int rem = idx - st * 260; c = rem >> 2; hd = rem & 3; }
  else { prompt = false; const int j = idx - NRW_P; st = j >> 2; hd = j & 3; c = 0; }
  char* rwp = p.rw + (size_t)idx * RW_BYTES;
  const float* mu = p.shift_mu + L * 896;
  const int i1 = tid >> 2, m0 = (tid & 3) * 16;
  int R1; bool valid1, hasprev1;
  if (prompt) { const int pp = 64 * c - 48 + i1; valid1 = pp >= 0; R1 = st * PT + (valid1 ? pp : 0); hasprev1 = pp >= 1; }
  else { R1 = NPR + 64 * st + i1; valid1 = true; hasprev1 = i1 >= 1; }
  const bf16_t* zr1 = p.zE + (size_t)R1 * ZE + ZE_ZC;
  const int ti0 = 32 * tw + l31;
  int R; bool valid, hasprev;
  if (prompt) { const int pp = 64 * c - 48 + ti0; valid = pp >= 0; R = st * PT + (valid ? pp : 0); hasprev = pp >= 1; }
  else { R = NPR + 64 * st + ti0; valid = true; hasprev = ti0 >= 1; }
  const bf16_t* zr = p.zE + (size_t)R * ZE + ZE_ZC;
  const int chb = 64 * hd + 32 * cw + 4 * hh;
  uint4 la[2][2], lap[2][2]; uint2 lb[3][4], lbp[3][4];
  {
    const bf16_t* sh0 = p.zE + (size_t)(NT + (prompt ? 32 : st)) * ZE + ZE_ZC;
    const bf16_t* zp1 = hasprev1 ? zr1 - ZE : sh0;
    const bf16_t* zp = hasprev ? zr - ZE : sh0;
#pragma unroll
    for (int part = 0; part < 2; ++part)
#pragma unroll
      for (int h8 = 0; h8 < 2; ++h8) { const int col = 768 + 64 * part + m0 + 8 * h8; la[part][h8] = *(const uint4*)(zr1 + col); lap[part][h8] = *(const uint4*)(zp1 + col); }
#pragma unroll
    for (int part = 0; part < 3; ++part)
#pragma unroll
      for (int G = 0; G < 4; ++G) { const int col = 256 * part + chb + 8 * G; lb[part][G] = *(const uint2*)(zr + col); lbp[part][G] = *(const uint2*)(zp + col); }
    const bf16_t* dsrc = p.dw2T + ((size_t)L * 256 + hd * 64 + i1) * 64 + m0;
    const bf16_t* isrc = p.ia2T + ((size_t)L * 256 + hd * 64 + i1) * 64 + m0;
    const uint4 d0 = *(const uint4*)dsrc, d1 = *(const uint4*)(dsrc + 8), e0 = *(const uint4*)isrc, e1 = *(const uint4*)(isrc + 8);
    __builtin_amdgcn_sched_barrier(0);
    *(uint4*)(S2 + i1 * 72 + m0) = d0; *(uint4*)(S2 + i1 * 72 + m0 + 8) = d1;
    *(uint4*)(S3 + i1 * 72 + m0) = e0; *(uint4*)(S3 + i1 * 72 + m0 + 8) = e1;
  }
  {
    float* prm = misc + 384;
#pragma unroll
    for (int q2 = 0; q2 < 2; ++q2) {
      const int ix = tid + 256 * q2, wh = ix >> 6, chp = ix & 63;
      const float* sp = wh == 0 ? p.decay_w0 : wh == 1 ? p.iclr_a0 : wh == 2 ? p.key_kk : wh == 3 ? p.key_ka : wh == 4 ? p.bonus_rk : nullptr;
      prm[ix] = sp ? sp[L * 256 + hd * 64 + chp] : mu[256 * (wh - 5) + 64 * hd + chp];
    }
  }
#pragma unroll
  for (int part = 0; part < 2; ++part) {
#pragma unroll
    for (int h8 = 0; h8 < 2; ++h8) {
      const int col = 768 + 64 * part + m0 + 8 * h8;
      const uint4 u = la[part][h8], v = lap[part][h8];
      const float cur[8] = {bflo(u.x), bfhi(u.x), bflo(u.y), bfhi(u.y), bflo(u.z), bfhi(u.z), bflo(u.w), bfhi(u.w)};
      float prv[8] = {bflo(v.x), bfhi(v.x), bflo(v.y), bfhi(v.y), bflo(v.z), bfhi(v.z), bflo(v.w), bfhi(v.w)};
      float o[8];
#pragma unroll
      for (int e = 0; e < 8; ++e) { float z = cur[e] + (prv[e] - cur[e]) * mu[col + e]; if (!valid1) z = 0.f; o[e] = part == 0 ? (1.f - 2.f / (__expf(2.f * z) + 1.f)) : z; }
      uint4 a; a.x = pk2(o[0], o[1]); a.y = pk2(o[2], o[3]); a.z = pk2(o[4], o[5]); a.w = pk2(o[6], o[7]);
      *(uint4*)((part == 0 ? S0 : S1) + i1 * 72 + m0 + 8 * h8) = a;
    }
  }
  __syncthreads();
  f32x16 accw = zero16(), acca = zero16();
#pragma unroll
  for (int ks = 0; ks < 4; ++ks) {
    const bf16x8 fw = *(const bf16x8*)(S2 + (32 * cw + l31) * 72 + ks * 16 + hh * 8), fa = *(const bf16x8*)(S3 + (32 * cw + l31) * 72 + ks * 16 + hh * 8);
    const bf16x8 sw = *(const bf16x8*)(S0 + (32 * tw + l31) * 72 + ks * 16 + hh * 8), sa = *(const bf16x8*)(S1 + (32 * tw + l31) * 72 + ks * 16 + hh * 8);
    accw = mfma32(fw, sw, accw); acca = mfma32(fa, sa, acca);
  }
  int ti = ti0;
  float e_[16];
  float ssq = 0.f;
#pragma unroll
  for (int G = 0; G < 4; ++G) {
    const int ch = chb + 8 * G, col = 256 + ch;
    const uint2 u = lb[1][G], v = lbp[1][G];
    const float cur[4] = {bflo(u.x), bfhi(u.x), bflo(u.y), bfhi(u.y)};
    float prv[4] = {bflo(v.x), bfhi(v.x), bflo(v.y), bfhi(v.y)};
    const int chq = 32 * cw + 8 * G + 4 * hh;
    const float4 kkw = *(const float4*)(misc + 384 + 128 + chq), w0 = *(const float4*)(misc + 384 + chq), m4 = *(const float4*)(misc + 384 + 384 + chq);
    const float kkv[4] = {kkw.x, kkw.y, kkw.z, kkw.w}, w0v[4] = {w0.x, w0.y, w0.z, w0.w}, muv[4] = {m4.x, m4.y, m4.z, m4.w};
#pragma unroll
    for (int e = 0; e < 4; ++e) {
      float z = cur[e] + (prv[e] - cur[e]) * muv[e];
      if (!valid) z = 0.f;
      const float kkr = z * kkv[e];
      ssq += kkr * kkr;
      e_[4 * G + e] = valid ? 0.6065306597126334f * sigmoid_(w0v[e] + accw[4 * G + e]) : 0.f;
    }
  }
  ssq += __shfl_xor(ssq, 32);
  if (hh == 0) misc[(cw * 64 + ti) * 2] = ssq;
#pragma unroll
  for (int G = 0; G < 4; ++G)
#pragma unroll
    for (int e = 0; e < 4; ++e) Ef[ti * 65 + 32 * cw + 8 * G + 4 * hh + e] = e_[4 * G + e];
  __syncthreads();
  {
    const int ch = tid & 63, seg = tid >> 6;
    float run = 0.f;
#pragma unroll
    for (int t = 0; t < 16; ++t) { run += Ef[(16 * seg + t) * 65 + ch]; Ef[(16 * seg + t) * 65 + ch] = run; }
    __syncthreads();
    float off = 0.f;
    for (int s2 = 0; s2 < seg; ++s2) off += Ef[(16 * s2 + 15) * 65 + ch];
    __syncthreads();
#pragma unroll
    for (int t = 0; t < 16; ++t) Ef[(16 * seg + t) * 65 + ch] += off;
    if (seg == 3) { const float cC = Ef[63 * 65 + ch]; misc[320 + ch] = cC; misc[256 + ch] = __expf(-cC); }
    __syncthreads();
  }
  float cc_[16];
#pragma unroll
  for (int G = 0; G < 4; ++G)
#pragma unroll
    for (int e = 0; e < 4; ++e) cc_[4 * G + e] = Ef[ti * 65 + 32 * cw + 8 * G + 4 * hh + e];
  const float kinv = 1.f / fmaxf(sqrtf(misc[ti * 2] + misc[(64 + ti) * 2]), 1e-12f);
  __syncthreads();
  LAUNDER(ti); LAUNDER(hh);
  uint2 vpk[4];
  float rk = 0.f;
#pragma unroll
  for (int G = 0; G < 4; ++G) {
    const int ch = chb + 8 * G, chl = 32 * cw + 8 * G + 4 * hh;
    float zs[3][4];
#pragma unroll
    for (int part = 0; part < 3; ++part) {
      const int col = 256 * part + ch;
      const uint2 u = lb[part][G], v = lbp[part][G];
      const float cur[4] = {bflo(u.x), bfhi(u.x), bflo(u.y), bfhi(u.y)};
      float prv[4] = {bflo(v.x), bfhi(v.x), bflo(v.y), bfhi(v.y)};
      const float4 m4 = *(const float4*)(misc + 384 + 320 + 64 * part + chl);
      const float muv[4] = {m4.x, m4.y, m4.z, m4.w};
#pragma unroll
      for (int e = 0; e < 4; ++e) { float z = cur[e] + (prv[e] - cur[e]) * muv[e]; zs[part][e] = valid ? z : 0.f; }
    }
    vpk[G] = pk4(zs[2][0], zs[2][1], zs[2][2], zs[2][3]);
    const float4 a04 = *(const float4*)(misc + 384 + 64 + chl), kk4 = *(const float4*)(misc + 384 + 128 + chl), ka4 = *(const float4*)(misc + 384 + 192 + chl), bo4 = *(const float4*)(misc + 384 + 256 + chl);
    const float a0v[4] = {a04.x, a04.y, a04.z, a04.w}, kkv[4] = {kk4.x, kk4.y, kk4.z, kk4.w}, kav[4] = {ka4.x, ka4.y, ka4.z, ka4.w}, bov[4] = {bo4.x, bo4.y, bo4.z, bo4.w};
    float at[4], rt[4], bt[4], kt[4], bh[4], kh[4];
#pragma unroll
    for (int e = 0; e < 4; ++e) {
      const int r = 4 * G + e;
      const float al = sigmoid_(a0v[e] + acca[r]);
      const float kk = zs[1][e] * kkv[e] * kinv;
      const float km = zs[1][e] * (1.f + (al - 1.f) * kav[e]);
      rk += zs[0][e] * km * bov[e];
      const float gC = misc[256 + chl + e];
      const float cprev = cc_[r] - e_[r];
      const float ea = __expf(-cprev), er = __expf(-cc_[r]), ek = __builtin_amdgcn_rcpf(er), eh = ek * gC;
      const float b = kk * al;
      at[e] = -kk * ea; rt[e] = zs[0][e] * er; bt[e] = b * ek; kt[e] = km * ek; bh[e] = b * eh; kh[e] = km * eh;
    }
    *(uint2*)(S0 + ti * 72 + chl) = pk4(at[0], at[1], at[2], at[3]);
    *(uint2*)(S1 + ti * 72 + chl) = pk4(rt[0], rt[1], rt[2], rt[3]);
    *(uint2*)(S2 + ti * 72 + chl) = pk4(bt[0], bt[1], bt[2], bt[3]);
    *(uint2*)(S3 + ti * 72 + chl) = pk4(kt[0], kt[1], kt[2], kt[3]);
#pragma unroll
    for (int e = 0; e < 4; ++e) { S4[(chl + e) * 72 + ti] = f2bf(at[e]); S5[(chl + e) * 72 + ti] = f2bf(bh[e]); S6[(chl + e) * 72 + ti] = f2bf(kh[e]); S7[(chl + e) * 72 + ti] = f2bf(zs[2][e]); }
    *(uint2*)(rwp + 40960 + (ti * 64 + chl) * 2) = vpk[G];
  }
  rk += __shfl_xor(rk, 32);
  if (hh == 0) misc[(cw * 64 + ti) * 2 + 1] = rk;
  __syncthreads();
  if (valid && cw == 0 && hh == 0) p.rkb[(size_t)R * 4 + hd] = misc[ti * 2 + 1] + misc[(64 + ti) * 2 + 1];
  LAUNDER(l31); LAUNDER(hh); LAUNDER(lane);
  {
    Acc64 T;
    {
      Acc64 Mx, MTx;
      gram<SH_UP, 0>(S2, S0, l31, hh, Mx);
      gram<SH_LO, 1>(S0, S2, l31, hh, MTx);
      Frag64 fM, fMT, fT;
      to_frag<SH_UP>(Mx, fM); to_frag<SH_LO>(MTx, fMT);
      __builtin_amdgcn_sched_barrier(0);
      T = Mx;
#pragma unroll
      for (int t = 0; t < 2; ++t)
#pragma unroll
        for (int r = 0; r < 16; ++r) if ((r & 3) + 8 * (r >> 2) + 4 * hh == l31) T.t[t][t][r] += 1.f;
      T.t[1][0] = zero16();
      for (int r = 0; r < 5; ++r) {
        Frag64 fM2, fMT2;
        prod_ff_frag<SH_LO, SH_UP, SH_UP>(fMT, fM, fM2);
        prod_ff_frag<SH_UP, SH_LO, SH_LO>(fM, fMT, fMT2);
#pragma unroll
        for (int s = 0; s < 4; ++s)
#pragma unroll
          for (int t = 0; t < 2; ++t) { if (tile_nz<SH_UP>(s >> 1, t)) fM.f[s][t] = fM2.f[s][t]; if (tile_nz<SH_LO>(s >> 1, t)) fMT.f[s][t] = fMT2.f[s][t]; }
        to_frag<SH_UP>(T, fT);
        prod_ff<SH_LO, SH_UP>(fMT, fT, T);
      }
    }
    Frag64 fT;
    to_frag<SH_UP>(T, fT);
    __builtin_amdgcn_sched_barrier(0);
    if (w < 2) {
      Frag64 fW;
      prod_fm_frag<SH_UP>(fT, S4, l31, hh, fW);
      __builtin_amdgcn_sched_barrier(0);
      Acc64 O; zero_acc<SH_FULL>(O);
      if (w == 0) {
        prod_fm<SH_FULL>(fW, S5, l31, hh, O);
#pragma unroll
        for (int tx = 0; tx < 2; ++tx)
#pragma unroll
          for (int ty = 0; ty < 2; ++ty)
#pragma unroll
            for (int G = 0; G < 4; ++G) {
              const int x0 = 32 * tx + 8 * G + 4 * hh, y = 32 * ty + l31;
              float v[4];
#pragma unroll
              for (int e = 0; e < 4; ++e) { v[e] = O.t[tx][ty][4 * G + e]; if (x0 + e == y) v[e] += misc[256 + y]; }
              *(uint2*)(rwp + 0 + kperm_addr(y, x0) * 2) = pk4(v[0], v[1], v[2], v[3]);
            }
      } else {
        Acc64 Nb; gram<SH_UP, 2>(S2, S1, l31, hh, Nb);
        Frag64 fN; to_frag<SH_UP>(Nb, fN);
        prod_ff<SH_FULL, SH_UP>(fW, fN, O);
#pragma unroll
        for (int tx = 0; tx < 2; ++tx)
#pragma unroll
          for (int ty = 0; ty < 2; ++ty)
#pragma unroll
            for (int G = 0; G < 4; ++G) {
              const int x0 = 32 * tx + 8 * G + 4 * hh, y = 32 * ty + l31;
              const uint2 rr = *(const uint2*)(S1 + y * 72 + x0);
              *(uint2*)(rwp + 8192 + kperm_addr(y, x0) * 2) = pk4(O.t[tx][ty][4 * G] + bflo(rr.x), O.t[tx][ty][4 * G + 1] + bfhi(rr.x), O.t[tx][ty][4 * G + 2] + bflo(rr.y), O.t[tx][ty][4 * G + 3] + bfhi(rr.y));
            }
      }
    } else {
      Frag64 fX;
      {
        Acc64 Nk; gram<SH_LO, 1>(S0, S3, l31, hh, Nk);
        Frag64 fNk; to_frag<SH_LO>(Nk, fNk);
        prod_ff_frag<SH_UP, SH_LO, SH_LO>(fT, fNk, fX);
      }
      __builtin_amdgcn_sched_barrier(0);
      if (w == 2) {
        Acc64 Z; zero_acc<SH_FULL>(Z);
        prod_fm<SH_LO>(fX, S5, l31, hh, Z);
#pragma unroll
        for (int tx = 0; tx < 2; ++tx)
#pragma unroll
          for (int ty = 0; ty < 2; ++ty)
#pragma unroll
            for (int G = 0; G < 4; ++G) {
              const int x0 = 32 * tx + 8 * G + 4 * hh, y = 32 * ty + l31;
              const uint2 kk2 = *(const uint2*)(S6 + y * 72 + x0);
              Z.t[tx][ty][4 * G] += bflo(kk2.x); Z.t[tx][ty][4 * G + 1] += bfhi(kk2.x); Z.t[tx][ty][4 * G + 2] += bflo(kk2.y); Z.t[tx][ty][4 * G + 3] += bfhi(kk2.y);
            }
        Frag64 fZ; to_frag<SH_FULL>(Z, fZ);
        __builtin_amdgcn_sched_barrier(0);
        Acc64 Q; zero_acc<SH_FULL>(Q);
        prod_fm<SH_FULL>(fZ, S7, l31, hh, Q);
#pragma unroll
        for (int tx = 0; tx < 2; ++tx)
#pragma unroll
          for (int ty = 0; ty < 2; ++ty)
#pragma unroll
            for (int G = 0; G < 4; ++G)
              *(uint2*)(rwp + 16384 + clay_addr(32 * tx + 8 * G + 4 * hh, 32 * ty + l31) * 2) = pk4(Q.t[tx][ty][4 * G], Q.t[tx][ty][4 * G + 1], Q.t[tx][ty][4 * G + 2], Q.t[tx][ty][4 * G + 3]);
      } else {
        Acc64 H; gram<SH_UP, 2>(S3, S1, l31, hh, H);
        {
          Acc64 Nb; gram<SH_UP, 2>(S2, S1, l31, hh, Nb);
          Frag64 fN; to_frag<SH_UP>(Nb, fN);
          prod_ff<SH_LO, SH_UP>(fX, fN, H);
        }
        Frag64 fH; to_frag<SH_UP>(H, fH);
        __builtin_amdgcn_sched_barrier(0);
        Acc64 Y; zero_acc<SH_FULL>(Y);
        prod_fm<SH_UP>(fH, S7, l31, hh, Y);
#pragma unroll
        for (int tx = 0; tx < 2; ++tx)
#pragma unroll
          for (int ty = 0; ty < 2; ++ty)
#pragma unroll
            for (int G = 0; G < 4; ++G)
              *(uint2*)(rwp + 24576 + clay_addr(32 * tx + 8 * G + 4 * hh, 32 * ty + l31) * 2) = pk4(Y.t[tx][ty][4 * G], Y.t[tx][ty][4 * G + 1], Y.t[tx][ty][4 * G + 2], Y.t[tx][ty][4 * G + 3]);
      }
    }
  }
  __syncthreads();
}

DEV void r2_wave(const Prm& p, int L, int wi, int lane) {
  bool prompt; int st, hd, vt;
  if (wi < 64) { prompt = true; st = wi >> 4; hd = (wi >> 2) & 3; vt = wi & 3; }
  else { prompt = false; const int j = wi - 64; st = j >> 4; hd = (j >> 2) & 3; vt = j & 3; }
  const int nch = prompt ? 65 : 1;
  const int idx0 = prompt ? st * 260 + hd : NRW_P + st * 4 + hd;
  const int l16 = lane & 15, g = lane >> 4;
  f32x4 acc[4];
  float* outp;
  if (prompt) {
#pragma unroll
    for (int mt = 0; mt < 4; ++mt) acc[mt] = (f32x4){0.f, 0.f, 0.f, 0.f};
    outp = p.wkv_p + ((((size_t)L * 4 + st) * 4 + hd) * 64 + 16 * vt + l16) * 64;
  } else {
    const float* sp = p.state_wkv + ((((size_t)L * 32 + st) * 4 + hd) * 64 + 16 * vt + l16) * 64;
#pragma unroll
    for (int mt = 0; mt < 4; ++mt) acc[mt] = *(const f32x4*)(sp + 16 * mt + 4 * g);
    outp = p.wkv_s + ((((size_t)L * 32 + st) * 4 + hd) * 64 + 16 * vt + l16) * 64;
  }
  const char* rw0 = p.rw + (size_t)idx0 * RW_BYTES;
  uint4 pf[3][8]; uint2 qv[3][4];
#pragma unroll
  for (int k = 0; k < 3; ++k) {
    const int cc = k < nch ? k : nch - 1;
    const char* src = rw0 + (size_t)cc * 4 * RW_BYTES;
#pragma unroll
    for (int i = 0; i < 8; ++i) pf[k][i] = *(const uint4*)(src + (i * 64 + lane) * 16);
#pragma unroll
    for (int mt = 0; mt < 4; ++mt) qv[k][mt] = *(const uint2*)(src + 16384 + ((mt * 4 + vt) * 64 + lane) * 8);
  }
  for (int c0 = 0; c0 < nch; c0 += 3) {
#pragma unroll
    for (int k = 0; k < 3; ++k) {
      const int c = c0 + k;
      if (c < nch) {
        char* cur = (char*)rw0 + (size_t)c * 4 * RW_BYTES;
        uint4 bfr[2];
#pragma unroll
        for (int s = 0; s < 2; ++s) {
          bfr[s].x = pk2(acc[2 * s][0], acc[2 * s][1]); bfr[s].y = pk2(acc[2 * s][2], acc[2 * s][3]);
          bfr[s].z = pk2(acc[2 * s + 1][0], acc[2 * s + 1][1]); bfr[s].w = pk2(acc[2 * s + 1][2], acc[2 * s + 1][3]);
          *(uint4*)(cur + 32768 + ((vt * 2 + s) * 64 + lane) * 16) = bfr[s];
        }
#pragma unroll
        for (int mt = 0; mt < 4; ++mt) {
          f32x4 a = {bflo(qv[k][mt].x), bfhi(qv[k][mt].x), bflo(qv[k][mt].y), bfhi(qv[k][mt].y)};
#pragma unroll
          for (int s = 0; s < 2; ++s) a = mfma16(mk8(pf[k][mt * 2 + s]), mk8(bfr[s]), a);
          acc[mt] = a;
        }
        const int cn = c + 3 < nch ? c + 3 : nch - 1;
        const char* src = rw0 + (size_t)cn * 4 * RW_BYTES;
#pragma unroll
        for (int i = 0; i < 8; ++i) pf[k][i] = *(const uint4*)(src + (i * 64 + lane) * 16);
#pragma unroll
        for (int mt = 0; mt < 4; ++mt) qv[k][mt] = *(const uint2*)(src + 16384 + ((mt * 4 + vt) * 64 + lane) * 8);
      }
    }
  }
#pragma unroll
  for (int mt = 0; mt < 4; ++mt) *(f32x4*)(outp + 16 * mt + 4 * g) = acc[mt];
}

DEV void r3_wave(const Prm& p, int L, int idx, int lane, float* Y  ) {
  LAUNDER(lane);
  bool prompt; int st, c, hd;
  if (idx < NRW_P) { prompt = true; st = idx / 260; const int rem = idx - st * 260; c = rem >> 2; hd = rem & 3; }
  else { prompt = false; const int j = idx - NRW_P; st = j >> 2; hd = j & 3; c = 0; }
  const char* rwp = p.rw + (size_t)idx * RW_BYTES;
  const int l16 = lane & 15, g = lane >> 4;
  bf16_t* mix = p.zE;
  uint4 sf[4][2];
#pragma unroll
  for (int vt = 0; vt < 4; ++vt)
#pragma unroll
    for (int s = 0; s < 2; ++s) sf[vt][s] = *(const uint4*)(rwp + 32768 + ((vt * 2 + s) * 64 + lane) * 16);
  const float lw[4] = {p.lnx_w[L * 256 + hd * 64 + l16], p.lnx_w[L * 256 + hd * 64 + 16 + l16], p.lnx_w[L * 256 + hd * 64 + 32 + l16], p.lnx_w[L * 256 + hd * 64 + 48 + l16]};
  const float lb[4] = {p.lnx_b[L * 256 + hd * 64 + l16], p.lnx_b[L * 256 + hd * 64 + 16 + l16], p.lnx_b[L * 256 + hd * 64 + 32 + l16], p.lnx_b[L * 256 + hd * 64 + 48 + l16]};
#pragma unroll
  for (int it = 0; it < 4; ++it) {
    f32x4 y[4];
    const uint4 gf0 = *(const uint4*)(rwp + 8192 + ((it * 2 + 0) * 64 + lane) * 16), gf1 = *(const uint4*)(rwp + 8192 + ((it * 2 + 1) * 64 + lane) * 16);
#pragma unroll
    for (int vt = 0; vt < 4; ++vt) {
      const uint2 q = *(const uint2*)(rwp + 24576 + ((it * 4 + vt) * 64 + lane) * 8);
      f32x4 a = {bflo(q.x), bfhi(q.x), bflo(q.y), bfhi(q.y)};
      a = mfma16(mk8(gf0), mk8(sf[vt][0]), a);
      a = mfma16(mk8(gf1), mk8(sf[vt][1]), a);
      y[vt] = a;
    }
    __builtin_amdgcn_sched_barrier(0);
#pragma unroll
    for (int rr = 0; rr < 4; ++rr) {
      const int i = 16 * it + 4 * g + rr;
      float s1 = y[0][rr] + y[1][rr] + y[2][rr] + y[3][rr];
      s1 += __shfl_xor(s1, 1); s1 += __shfl_xor(s1, 2); s1 += __shfl_xor(s1, 4); s1 += __shfl_xor(s1, 8);
      const float mean = s1 * (1.f / 64.f);
      const float d0 = y[0][rr] - mean, d1 = y[1][rr] - mean, d2 = y[2][rr] - mean, d3 = y[3][rr] - mean;
      float s2 = d0 * d0 + d1 * d1 + d2 * d2 + d3 * d3;
      s2 += __shfl_xor(s2, 1); s2 += __shfl_xor(s2, 2); s2 += __shfl_xor(s2, 4); s2 += __shfl_xor(s2, 8);
      const float rstd = rsqrtf(s2 * (1.f / 64.f) + GN_EPS);
      Y[i * 68 + l16] = d0 * rstd * lw[0] + lb[0];
      Y[i * 68 + 16 + l16] = d1 * rstd * lw[1] + lb[1];
      Y[i * 68 + 32 + l16] = d2 * rstd * lw[2] + lb[2];
      Y[i * 68 + 48 + l16] = d3 * rstd * lw[3] + lb[3];
    }
  }
  asm volatile("s_waitcnt lgkmcnt(0)" ::: "memory");
  __builtin_amdgcn_wave_barrier();
  const int vc = (lane & 7) * 8;
#pragma unroll
  for (int ps = 0; ps < 8; ++ps) {
    const int i = 8 * ps + (lane >> 3);
    int R; bool valid;
    if (prompt) { const int pp = 64 * c - 48 + i; valid = pp >= 0; R = st * PT + (valid ? pp : 0); }
    else { R = NPR + 64 * st + i; valid = true; }
    if (valid) {
      const float4 y0 = *(const float4*)(Y + i * 68 + vc), y1 = *(const float4*)(Y + i * 68 + vc + 4);
      const float rkbv = p.rkb[(size_t)R * 4 + hd];
      const uint4 vv = *(const uint4*)(rwp + 40960 + (i * 64 + vc) * 2);
      const uint4 gc = *(const uint4*)(p.zL + (size_t)R * ZL + ZL_GC + hd * 64 + vc);
      uint4 o;
      o.x = pk2((y0.x + rkbv * bflo(vv.x)) * silu_(bflo(gc.x)), (y0.y + rkbv * bfhi(vv.x)) * silu_(bfhi(gc.x)));
      o.y = pk2((y0.z + rkbv * bflo(vv.y)) * silu_(bflo(gc.y)), (y0.w + rkbv * bfhi(vv.y)) * silu_(bfhi(gc.y)));
      o.z = pk2((y1.x + rkbv * bflo(vv.z)) * silu_(bflo(gc.z)), (y1.y + rkbv * bfhi(vv.z)) * silu_(bfhi(gc.z)));
      o.w = pk2((y1.z + rkbv * bflo(vv.w)) * silu_(bflo(gc.w)), (y1.w + rkbv * bfhi(vv.w)) * silu_(bfhi(gc.w)));
      *(uint4*)(mix + (size_t)R * D + 768 + hd * 64 + vc) = o;
    }
  }
  asm volatile("s_waitcnt lgkmcnt(0)" ::: "memory");
  __builtin_amdgcn_wave_barrier();
}

DEV void final_norm(const Prm& p) {
  int tid_ = threadIdx.x; LAUNDER(tid_);
  const int lane = tid_ & 63, gw = blockIdx.x * 4 + (tid_ >> 6), NW = gridDim.x * 4;
  for (int R = gw; R < NT; R += NW) {
    if (R < NPR && (R % PT) < 16) continue;
    float* yr = xrow_ptr(p, R);
    const bf16_t* xr = p.xb + (size_t)R * D;
    const float rstd = rsqrtf(p.ssq_x[2 * NTP + R] * (1.f / 1024.f) + RMS_EPS);
#pragma unroll
    for (int j = 0; j < 2; ++j) {
      const uint4 u = ((const uint4*)xr)[lane + 64 * j];
      const float4 g0 = ((const float4*)p.final_g)[2 * (lane + 64 * j)], g1 = ((const float4*)p.final_g)[2 * (lane + 64 * j) + 1];
      float4 o0, o1;
      o0.x = bflo(u.x) * rstd * g0.x; o0.y = bfhi(u.x) * rstd * g0.y; o0.z = bflo(u.y) * rstd * g0.z; o0.w = bfhi(u.y) * rstd * g0.w;
      o1.x = bflo(u.z) * rstd * g1.x; o1.y = bfhi(u.z) * rstd * g1.y; o1.z = bflo(u.w) * rstd * g1.z; o1.w = bfhi(u.w) * rstd * g1.w;
      ((float4*)yr)[2 * (lane + 64 * j)] = o0; ((float4*)yr)[2 * (lane + 64 * j) + 1] = o1;
    }
  }
}

#define XB_TMO      128
#define XB_XCNT(j)  (256  + 64 * (j))
#define XB_XSUB(j)  (1280 + 64 * (j))
#define XB_XGEN(j)  (2304 + 64 * (j))
#define XB_TOP      3328
#define XB_TOPGEN   3392
#define XCD_BAR_WORDS 3456
#define XB_SPIN_CAP (1u << 20)
#define LAS __attribute__((address_space(3)))
DEV unsigned xb_ld(unsigned* p) { return __hip_atomic_load(p, __ATOMIC_RELAXED, __HIP_MEMORY_SCOPE_AGENT); }
DEV unsigned xb_add(unsigned* p, unsigned v) { return __hip_atomic_fetch_add(p, v, __ATOMIC_RELAXED, __HIP_MEMORY_SCOPE_AGENT); }
DEV unsigned xb_xcc_id() { return (unsigned)__builtin_amdgcn_s_getreg((3 << 11) | 20) & 0xFu; }
#define XB_SPIN(cond, bar) do { unsigned _sp = 0; while (cond) { __builtin_amdgcn_s_sleep(1); \
    if ((++_sp & 255u) == 0u) { if (xb_ld(&(bar)[XB_TMO])) break; if (_sp > XB_SPIN_CAP) { atomicAdd(&(bar)[XB_TMO], 1u); break; } } } } while (0)
struct XcdBarrier { unsigned* bar; unsigned x; volatile LAS unsigned* st; };
DEV XcdBarrier xcd_barrier_post(unsigned* bar, volatile LAS unsigned* st) {
  XcdBarrier b; b.bar = bar; b.x = xb_xcc_id(); b.st = st;
  if (threadIdx.x == 0) (void)xb_add(&bar[XB_XCNT(b.x)], 1u);
  return b;
}
DEV void xcd_barrier_complete(unsigned* bar, unsigned x, unsigned& nloc, unsigned& nx) {
  const unsigned G = gridDim.x * gridDim.y * gridDim.z;
  unsigned sum, cnt, mine, sp = 0u;
  for (;;) {
    sum = 0u; cnt = 0u; mine = 0u;
#pragma unroll
    for (unsigned j = 0; j < 16; ++j) { const unsigned c = xb_ld(&bar[XB_XCNT(j)]); sum += c; cnt += (c > 0u) ? 1u : 0u; mine = (j == x) ? c : mine; }
    if (sum == G) break;
    __builtin_amdgcn_s_sleep(1);
    if ((++sp & 255u) == 0u) { if (xb_ld(&bar[XB_TMO])) break; if (sp > XB_SPIN_CAP) { atomicAdd(&bar[XB_TMO], 1u); break; } }
  }
  nloc = mine > 0u ? mine : 1u; nx = cnt > 0u ? cnt : 1u;
}
DEV void xcd_barrier(const XcdBarrier& b) {
  asm volatile("s_waitcnt vmcnt(0)" ::: "memory");
  __syncthreads();
  if (threadIdx.x == 0) {
    unsigned* bar = b.bar;
    __builtin_amdgcn_s_waitcnt(0);
    unsigned nloc = b.st[0], nx = b.st[1];
    if (nloc == 0u) { xcd_barrier_complete(bar, b.x, nloc, nx); b.st[0] = nloc; b.st[1] = nx; }
    const unsigned old = xb_add(&bar[XB_XSUB(b.x)], 1u);
    const unsigned gen = old / nloc;
    if (old + 1u == (gen + 1u) * nloc) {
      __builtin_amdgcn_fence(__ATOMIC_RELEASE, "agent");
      asm volatile("s_waitcnt vmcnt(0)" ::: "memory");
      const unsigned og = xb_add(&bar[XB_TOP], 1u);
      const unsigned tg = og / nx;
      if (og + 1u == (tg + 1u) * nx) xb_add(&bar[XB_TOPGEN], 1u);
      else XB_SPIN(xb_ld(&bar[XB_TOPGEN]) == tg, bar);
      __builtin_amdgcn_fence(__ATOMIC_ACQUIRE, "agent");
      xb_add(&bar[XB_XGEN(b.x)], 1u);
      asm volatile("s_waitcnt vmcnt(0)" ::: "memory");
    } else {
      XB_SPIN(xb_ld(&bar[XB_XGEN(b.x)]) == gen, bar);
      __builtin_amdgcn_fence(__ATOMIC_ACQUIRE, "agent");
      asm volatile("s_waitcnt vmcnt(0)" ::: "memory");
    }
  }
  __syncthreads();
}

#define QCTR(ph, L) (3584 + 64 * (2 * (ph) + (L)))
#define R2DONE(L) (3520 + 16 * (L))
DEV int next_item(unsigned* ctr, char* lds) {
  volatile int* slot = (volatile int*)(lds + LDS_BYTES - 8);
  __syncthreads();
  if (threadIdx.x == 0) *slot = (int)atomicAdd(ctr, 1u);
  __syncthreads();
  return *slot;
}
#define QXC(ph, L, x) (4096 + (((ph) * 2 + (L)) * 8 + (x)) * 16)
DEV int xq_next(unsigned* ctl, int ph, int L, int C, int N, int& k, int home, char* lds) {
  volatile int* slot = (volatile int*)(lds + LDS_BYTES - 8);
  __syncthreads();
  if (threadIdx.x == 0) {
    int res = -1, kk = k;
    while (kk < 8) {
      const int x = (home + kk) & 7, base = x * C;
      int size = N - base; size = size < C ? size : C;
      if (size > 0) { const int idx = (int)atomicAdd(ctl + QXC(ph, L, x), 1u); if (idx < size) { res = base + idx; break; } }
      ++kk;
    }
    slot[0] = res; slot[1] = kk;
  }
  __syncthreads();
  k = slot[1];
  return slot[0];
}
DEV int q_publish(int ticket, char* lds) {
  volatile int* slot = (volatile int*)(lds + LDS_BYTES - 8);
  __syncthreads();
  if (threadIdx.x == 0) *slot = ticket;
  __syncthreads();
  return *slot;
}
DEV int xq_resolve(unsigned* ctl, int ph, int L, int C, int N, int& k, int home, int ticket, char* lds) {
  volatile int* slot = (volatile int*)(lds + LDS_BYTES - 8);
  __syncthreads();
  if (threadIdx.x == 0) {
    int res = -1, kk = k;
    if (kk < 8) {
      const int x = (home + kk) & 7, base = x * C;
      int size = N - base; size = size < C ? size : C;
      if (ticket < size) res = base + ticket;
      else {
        ++kk;
        while (kk < 8) {
          const int x2 = (home + kk) & 7, base2 = x2 * C;
          int size2 = N - base2; size2 = size2 < C ? size2 : C;
          if (size2 > 0) { const int idx = (int)atomicAdd(ctl + QXC(ph, L, x2), 1u); if (idx < size2) { res = base2 + idx; break; } }
          ++kk;
        }
      }
    }
    slot[0] = res; slot[1] = kk;
  }
  __syncthreads();
  k = slot[1];
  return slot[0];
}
DEV unsigned* xq_ctr(unsigned* ctl, int ph, int L, int k, int home) { return k < 8 ? ctl + QXC(ph, L, (home + k) & 7) : nullptr; }
DEV int take_ticket(unsigned* nctr) { int tk = 0x7fffffff; if (nctr && threadIdx.x == 0) tk = (int)atomicAdd(nctr, 1u); return tk; }
DEV void shift_rows_item(const Prm& p, int L, int b) {
  int tid0 = threadIdx.x; LAUNDER(tid0);
  if (tid0 < 224) {
    float4 v = make_float4(0.f, 0.f, 0.f, 0.f);
    if (b < 32) v = *(const float4*)(p.state_shift + ((size_t)L * 32 + b) * 896 + 4 * tid0);
    *(uint2*)(p.zE + (size_t)(NT + b) * ZE + ZE_ZC + 4 * tid0) = pk4(v.x, v.y, v.z, v.w);
  }
}
constexpr int N_ATT = 1312;
DEV void run_p1(const Prm& p, int L, char* lds) {
  const EpiIn epi{p, L};
  const int home = (int)(xb_xcc_id() & 7u);
  int k = 0;
  constexpr int N = 145 * 24, C = (N + 7) / 8;
  int t = take_ticket(xq_ctr(p.ctl, 0, L, k, home));
  for (;;) {
    const int i = xq_resolve(p.ctl, 0, L, C, N, k, home, t, lds);
    if (i < 0) break;
    int mt, nt;
    if (i < 18 * 192) { const int b = i / 192, r = i - b * 192; nt = r >> 3; mt = 8 * b + (r & 7); } else { nt = i - 18 * 192; mt = 144; }
    t = gemm_tile(p.xb, D, p.Wb_in + (size_t)L * INP * 1024, 1024, 1024, mt * 128, nt * 128, lds, epi, xq_ctr(p.ctl, 0, L, k, home));
  }
  unsigned* ctr = p.ctl + QCTR(3, L);
  t = take_ticket(ctr);
  for (;;) {
    const int mt = q_publish(t, lds);
    if (mt >= 145 + 33) break;
    if (mt >= 145) { t = take_ticket(ctr); shift_rows_item(p, L, mt - 145); continue; }
    t = gemm_tile<EpiIn, 2>(p.xb, D, p.Wb_in + (size_t)L * INP * 1024, 1024, 1024, mt * 128, 24 * 128, lds, epi, ctr);
  }
}
DEV void run_p2(const Prm& p, int L, char* lds) {
  const EpiQ epq{p, L};
  constexpr int N1 = NRW, N2 = N1 + 129, N3 = N2 + 145 * 6, N4 = N3 + 16, N5 = N4 + 36;
  const int N6 = L == 0 ? N5 + NWT : N5;
  unsigned* ctr = p.ctl + QCTR(0, L);
  for (;;) {
    const int id = next_item(ctr, lds);
    if (id >= N6) break;
    if (id >= N5) { conv_weights_item(p, 1, id - N5, lds); continue; }
    if (id < N1) r1_item(p, L, id, lds);
    else if (id < N2) kvproj_item(p, L, id - N1, lds);
    else if (id < N3) { const int t = id - N2, mt = t / 6, nt = t - mt * 6; gemm_tile(p.zE + ZE_CQ, ZE, p.Wb_uq + (size_t)L * 768 * 256, 256, 256, mt * 128, nt * 128, lds, epq); }
    else if (id < N4) sample_prep_item(p, L, id - N3);
    else shift_item(p, L, id - N4);
  }
}
DEV void run_p3(const Prm& p, int L, char* lds) {
  int tid_ = threadIdx.x; LAUNDER(tid_);
  const int lane = tid_ & 63, w = __builtin_amdgcn_readfirstlane(tid_ >> 6);
  {
    int ndone = 0;
    for (int wi = blockIdx.x * 4 + w; wi < 576; wi += gridDim.x * 4) { r2_wave(p, L, wi, lane); ++ndone; }
    if (blockIdx.x * 4 < 576) {
      asm volatile("s_waitcnt vmcnt(0)" ::: "memory");
      __syncthreads();
      if (threadIdx.x == 0) {
        int tot = 0;
        for (int wi = blockIdx.x * 4; wi < 576; wi += gridDim.x * 4) tot += (576 - wi) < 4 ? (576 - wi) : 4;
        __builtin_amdgcn_fence(__ATOMIC_RELEASE, "agent");
        asm volatile("s_waitcnt vmcnt(0)" ::: "memory");
        __hip_atomic_fetch_add(p.ctl + R2DONE(L), (unsigned)tot, __ATOMIC_RELAXED, __HIP_MEMORY_SCOPE_AGENT);
      }
    }
    (void)ndone;
  }
  unsigned* ctr = p.ctl + QCTR(1, L);
  for (;;) {
    const int q = next_item(ctr, lds);
    if (q >= 256) break;
    attn_item(p, L, 1024 + q, lds);
  }
  {
    const int home = (int)(xb_xcc_id() & 7u);
    int k = 0;
    int tx = take_ticket(xq_ctr(p.ctl, 2, L, k, home));
    for (;;) {
      const int i = xq_resolve(p.ctl, 2, L, 128, 1024, k, home, tx, lds);
      if (i < 0) break;
      const int x = i >> 7, j = i & 127, qt = 31 - (j >> 2), pair = 4 * x + (j & 3);
      tx = attn_body<false>(p, L, pair >> 3, pair & 7, qt, lds, xq_ctr(p.ctl, 2, L, k, home));
    }
  }
  unsigned* ctr2 = p.ctl + QCTR(2, L);
  constexpr int NC = (NT + 31) / 32, NQ2 = 32 + NC + NRW / 4;
  bool r2_seen = false;
  for (;;) {
    const int q = next_item(ctr2, lds);
    if (q >= NQ2) break;
    if (q < 32) attn_item(p, L, 1280 + q, lds);
    else if (q < 32 + NC) conv_item(p, L, q - 32);
    else {
      if (!r2_seen) {
        if (threadIdx.x == 0) {
          unsigned sp = 0;
          while (__hip_atomic_load(p.ctl + R2DONE(L), __ATOMIC_RELAXED, __HIP_MEMORY_SCOPE_AGENT) < 576u) {
            __builtin_amdgcn_s_sleep(2);
            if (++sp > (1u << 22)) { atomicAdd(&p.ctl[XB_TMO], 1u); break; }
          }
          __builtin_amdgcn_fence(__ATOMIC_ACQUIRE, "agent");
          asm volatile("s_waitcnt vmcnt(0)" ::: "memory");
        }
        __syncthreads();
        r2_seen = true;
      }
      r3_wave(p, L, (q - 32 - NC) * 4 + w, lane, (float*)(lds + w * 17408));
    }
  }
}
DEV void run_p4(const Prm& p, int L, char* lds) {
  const EpiOut epo{p, L};
  const int home = (int)(xb_xcc_id() & 7u);
  int k = 0;
  int t = take_ticket(xq_ctr(p.ctl, 1, L, k, home));
  for (;;) {
    const int i = xq_resolve(p.ctl, 1, L, 128, 1024, k, home, t, lds);
    if (i < 0) break;
    t = gemm_tile(p.zE  , D, p.Wb_out + (size_t)L * 1024 * 1024, 1024, 1024, (i >> 3) * 128, (i & 7) * 128, lds, epo, xq_ctr(p.ctl, 1, L, k, home));
  }
  unsigned* ctr = p.ctl + QCTR(3, L) + 16;
  t = take_ticket(ctr);
  for (;;) {
    const int h = q_publish(t, lds);
    if (h >= 17 * 16) break;
    const int mt = 128 + (h >> 4), r = h & 15;
    t = gemm_tile<EpiOut, 4>(p.zE, D, p.Wb_out + (size_t)L * 1024 * 1024, 1024, 1024, mt * 128, (r >> 1) * 128 + (r & 1) * 64, lds, epo, ctr);
  }
}

__global__ void __launch_bounds__(256, 2) mega(Prm p) {
  extern __shared__ __attribute__((aligned(16))) char lds[];
  volatile LAS unsigned* st = (volatile LAS unsigned*)(lds + LDS_BYTES - 16);
  if (threadIdx.x == 0) { st[0] = 0u; st[1] = 0u; st[2] = 0u; st[3] = 0u; }
  __syncthreads();
  const XcdBarrier xb = xcd_barrier_post(p.ctl, st);
  phase0(p, lds);
  xcd_barrier(xb);
  for (int L = 0; L < 2; ++L) {
    run_p1(p, L, lds); xcd_barrier(xb);
    run_p2(p, L, lds); xcd_barrier(xb);
    run_p3(p, L, lds); xcd_barrier(xb);
    run_p4(p, L, lds); xcd_barrier(xb);
  }
  final_norm(p);
}

static size_t al256(size_t x) { return (x + 255) & ~(size_t)255; }
extern "C" void kernel_launch(void* const* d_in, const int* in_sizes, int n_in, void* d_out, int out_size, void* d_ws, size_t ws_size, hipStream_t stream) {
  Prm p{};
  const float* const* in = (const float* const*)d_in;
  p.x_prompt = in[0]; p.x_sample = in[1]; p.cache_ckv = in[2]; p.cache_krope = in[3]; p.state_conv = in[4]; p.state_shift = in[5]; p.state_wkv = in[6];
  p.meta = in[7]; p.norm_g = in[8]; p.w_in = in[9]; p.conv_w = in[10]; p.q_norm_g = in[11]; p.w_uq = in[12]; p.kv_norm_g = in[13]; p.w_ukv = in[14];
  p.shift_mu = in[15]; p.decay_w0 = in[16]; p.decay_w2 = in[17]; p.iclr_a0 = in[18]; p.iclr_a2 = in[19]; p.key_kk = in[20]; p.key_ka = in[21];
  p.bonus_rk = in[22]; p.lnx_w = in[23]; p.lnx_b = in[24]; p.w_out = in[25]; p.final_g = in[26];
  float* o = (float*)d_out;
  p.y_prompt = o; o += (size_t)4 * 4096 * 1024;
  p.y_sample = o; o += (size_t)32 * 64 * 1024;
  p.ckv_p = o; o += (size_t)2 * 4 * PT * 128;
  p.kr_p = o; o += (size_t)2 * 4 * PT * 32;
  p.conv_p = o; o += 2 * 4 * 2 * 256;
  p.shift_p = o; o += 2 * 4 * 896;
  p.wkv_p = o; o += 2 * 4 * 4 * 64 * 64;
  p.ckv_s = o; o += (size_t)2 * 32 * 64 * 128;
  p.kr_s = o; o += 2 * 32 * 64 * 32;
  p.conv_s = o; o += 2 * 32 * 2 * 256;
  p.shift_s = o; o += 2 * 32 * 896;
  p.wkv_s = o; o += 2 * 32 * 4 * 64 * 64;
  char* w = (char*)d_ws; size_t off = 0;
  auto take = [&](size_t bytes) { char* r = w + off; off = al256(off + bytes); return r; };
  p.ctl = (unsigned*)take(65536);
  p.Wb_in = (bf16_t*)take((size_t)2 * INP * 1024 * 2);
  p.Wb_uq = (bf16_t*)take((size_t)2 * 768 * 256 * 2);
  p.Wb_ukv = (bf16_t*)take((size_t)2 * 1024 * 128 * 2);
  p.Wb_out = (bf16_t*)take((size_t)2 * 1024 * 1024 * 2);
  p.dw2T = (bf16_t*)take((size_t)2 * 256 * 64 * 2);
  p.ia2T = (bf16_t*)take((size_t)2 * 256 * 64 * 2);
  p.ropec = (float*)take((size_t)PT * 16 * 4);
  p.ropes = (float*)take((size_t)PT * 16 * 4);
  p.ssq_x = (float*)take((size_t)7 * NTP * 4);
  p.ssq_q = p.ssq_x + 3 * NTP; p.ssq_kv = p.ssq_x + 5 * NTP;
  p.rkb = (float*)take((size_t)NTP * 4 * 4);
  p.xmeta = (float*)take((size_t)64 * 1024 * 4);
  p.zE = (bf16_t*)take((size_t)NTP * ZE * 2);
  p.zL = (bf16_t*)take((size_t)NTP * ZL * 2);
  p.xb = (bf16_t*)take((size_t)(NTP + 128) * D * 2);
  p.Kn = (bf16_t*)take((size_t)KVR * 512 * 2);
  p.Vt = (bf16_t*)take((size_t)512 * KVR * 2);
  p.Kr = (bf16_t*)take((size_t)KVR * 32 * 2);
  p.rw = take((size_t)NRW * RW_BYTES);
  static int grid = 0;
  if (grid == 0) {
    if (off > ws_size) { fprintf(stderr, "kernel_launch: workspace too small: need %zu have %zu\n", off, ws_size); grid = -1; return; }
    int dev = 0, cus = 0, per_cu = 0;
    (void)hipGetDevice(&dev);
    (void)hipDeviceGetAttribute(&cus, hipDeviceAttributeMultiprocessorCount, dev);
    (void)hipFuncSetAttribute((const void*)mega, hipFuncAttributeMaxDynamicSharedMemorySize, LDS_BYTES);
    (void)hipOccupancyMaxActiveBlocksPerMultiprocessor(&per_cu, (const void*)mega, 256, LDS_BYTES);
    if (per_cu > 2) per_cu = 2;
    if (per_cu < 1) { fprintf(stderr, "kernel_launch: occupancy query returned %d\n", per_cu); per_cu = 1; }
    grid = cus * per_cu;
  }
  if (grid < 0) return;
  (void)hipMemsetAsync(p.ctl, 0, 8192 * 4, stream);
  void* args[] = {&p};
  hipError_t e = hipLaunchCooperativeKernel((const void*)mega, dim3(grid), dim3(256), args, LDS_BYTES, stream);
  if (e != hipSuccess) fprintf(stderr, "cooperative launch failed: %s (grid %d)\n", hipGetErrorString(e), grid);
}
```

```cpp
#include <hip/hip_runtime.h>
#include <cstdio>
#include <cstdint>
#include <type_traits>

typedef unsigned short bf16_t;
typedef short bf16x8 __attribute__((ext_vector_type(8)));
typedef float f32x4 __attribute__((ext_vector_type(4)));
typedef float f32x16 __attribute__((ext_vector_type(16)));
#define DEV __device__ __forceinline__
#define LAUNDER(x) asm volatile("" : "+v"(x))

constexpr int D = 1024;
constexpr int PT = 4112;
constexpr int NPR = 4 * PT;
constexpr int NSM = 32 * 64;
constexpr int NT = NPR + NSM;
constexpr int NTP = 18560;
constexpr int ZL = 1792;
constexpr int ZE = 1312;
constexpr int ZE_CQ = 0, ZE_CKV = 256, ZE_KR = 384, ZE_ZC = 416;
constexpr int ZL_XIN = 0, ZL_BG = 256, ZL_CG = 512, ZL_GA = 768, ZL_GB = 1024, ZL_GC = 1536;
constexpr int INP = 3200;
constexpr int KVR = 16512;
constexpr int NRW_P = 4 * 65 * 4;
constexpr int NRW = NRW_P + 32 * 4;
constexpr int RW_BYTES = 49152;
constexpr float RMS_EPS = 1e-6f;
constexpr float GN_EPS = 64e-5f;
constexpr int LDS_BYTES = 79872;
constexpr int SKEYS = 1088;

struct Prm {
  const float *x_prompt, *x_sample, *cache_ckv, *cache_krope, *state_conv, *state_shift, *state_wkv, *meta, *norm_g, *w_in,
      *conv_w, *q_norm_g, *w_uq, *kv_norm_g, *w_ukv, *shift_mu, *decay_w0, *decay_w2, *iclr_a0, *iclr_a2, *key_kk, *key_ka,
      *bonus_rk, *lnx_w, *lnx_b, *w_out, *final_g;
  float *y_prompt, *y_sample, *ckv_p, *kr_p, *conv_p, *shift_p, *wkv_p, *ckv_s, *kr_s, *conv_s, *shift_s, *wkv_s;
  unsigned* ctl;
  bf16_t *Wb_in, *Wb_uq, *Wb_ukv, *Wb_out, *dw2T, *ia2T;
  float *ropec, *ropes, *ssq_x, *ssq_q, *ssq_kv, *rkb, *xmeta;
  bf16_t *KL, *VLT;
  bf16_t *zE, *zL, *xb, *Kn, *Vt, *Kr;
  char* rw;
};

DEV float bf2f(bf16_t b) { return __uint_as_float((unsigned)b << 16); }
DEV float bflo(unsigned u) { return __uint_as_float(u << 16); }
DEV float bfhi(unsigned u) { return __uint_as_float(u & 0xffff0000u); }
typedef __bf16 hbf16x2_t __attribute__((ext_vector_type(2)));
typedef float hf32x2_t __attribute__((ext_vector_type(2)));
DEV unsigned pk2(float a, float b) { hf32x2_t f = {a, b}; hbf16x2_t r = __builtin_convertvector(f, hbf16x2_t); return __builtin_bit_cast(unsigned, r); }
DEV bf16_t f2bf(float f) { return (bf16_t)(pk2(f, 0.f) & 0xffffu); }
DEV uint2 pk4(float a, float b, float c, float d) { uint2 r; r.x = pk2(a, b); r.y = pk2(c, d); return r; }
DEV float sigmoid_(float x) { return 1.f / (1.f + __expf(-x)); }
DEV float silu_(float x) { return x / (1.f + __expf(-x)); }
DEV float wave_sum(float v) {
#pragma unroll
  for (int o = 1; o < 64; o <<= 1) v += __shfl_xor(v, o);
  return v;
}
DEV f32x16 mfma32(bf16x8 a, bf16x8 b, f32x16 c) { return __builtin_amdgcn_mfma_f32_32x32x16_bf16(a, b, c, 0, 0, 0); }
DEV f32x4 mfma16(bf16x8 a, bf16x8 b, f32x4 c) { return __builtin_amdgcn_mfma_f32_16x16x32_bf16(a, b, c, 0, 0, 0); }
DEV bf16x8 mk8(unsigned a, unsigned b, unsigned c, unsigned d) { uint4 u; u.x = a; u.y = b; u.z = c; u.w = d; return __builtin_bit_cast(bf16x8, u); }
DEV bf16x8 mk8(uint4 u) { return __builtin_bit_cast(bf16x8, u); }
DEV f32x16 zero16() { f32x16 z; for (int i = 0; i < 16; ++i) z[i] = 0.f; return z; }

DEV float* xrow_ptr(const Prm& p, int R) {
  if (R < NPR) { int s = R / PT, q = R - s * PT; return q < 16 ? p.xmeta + (size_t)(s * 16 + q) * D : p.y_prompt + ((size_t)s * 4096 + (q - 16)) * D; }
  return p.y_sample + (size_t)(R - NPR) * D;
}
DEV const float* xin_ptr(const Prm& p, int R) {
  if (R < NPR) { int s = R / PT, q = R - s * PT; return q < 16 ? p.meta + (size_t)q * D : p.x_prompt + ((size_t)s * 4096 + (q - 16)) * D; }
  return p.x_sample + (size_t)(R - NPR) * D;
}
DEV int pos_of(int R) { return R < NPR ? R % PT : 1024 + ((R - NPR) & 63); }

DEV int win_src_col(int n) {
  if (n < 1024) return n;
  if (n < 1536) return 1440 + (n - 1024);
  if (n < 1792) return 2848 + (n - 1536);
  if (n < 2208) return 1024 + (n - 1792);
  if (n < 3104) return 1952 + (n - 2208);
  return -1;
}
DEV int perm32(int rho) { const int n = rho >> 4, i = rho & 15; return 8 * (i >> 2) + 4 * n + (i & 3); }
template <bool PERM, bool P32>
DEV void conv_weight_tile(const float* __restrict__ src, int K, int N, int Npad, bf16_t* __restrict__ dst, const float* __restrict__ sk, float cst, int l, int item, float* T  , int tid) {
  const int ntn = Npad / 64, ntk = K / 64;
  const int r = item, kt = r / ntn, nt = r - kt * ntn;
  const int k0 = kt * 64, n0 = nt * 64;
  {
    const int nslot = n0 + (tid & 15) * 4;
    const int nn = P32 ? (nslot & ~31) + perm32(nslot & 31) : nslot;
    const int sn = PERM ? win_src_col(nn) : (nn < N ? nn : -1);
#pragma unroll
    for (int i = 0; i < 4; ++i) {
      const int k = (tid >> 4) + 16 * i;
      float4 v = make_float4(0.f, 0.f, 0.f, 0.f);
      if (sn >= 0) {
        v = *(const float4*)(src + ((size_t)l * K + k0 + k) * N + sn);
        const float s = (sk ? sk[l * K + k0 + k] : 1.f) * cst;
        v.x *= s; v.y *= s; v.z *= s; v.w *= s;
      }
      float* t = T + k * 65 + (tid & 15) * 4;
      t[0] = v.x; t[1] = v.y; t[2] = v.z; t[3] = v.w;
    }
  }
  __syncthreads();
  {
    const int n = tid >> 2, kc = tid & 3;
    float v[16];
#pragma unroll
    for (int j = 0; j < 16; ++j) v[j] = T[(16 * kc + j) * 65 + n];
    uint4 o0, o1;
    o0.x = pk2(v[0], v[1]); o0.y = pk2(v[2], v[3]); o0.z = pk2(v[4], v[5]); o0.w = pk2(v[6], v[7]);
    o1.x = pk2(v[8], v[9]); o1.y = pk2(v[10], v[11]); o1.z = pk2(v[12], v[13]); o1.w = pk2(v[14], v[15]);
    bf16_t* d = dst + ((size_t)l * Npad + n0 + n) * K + k0 + 16 * kc;
    *(uint4*)d = o0; *(uint4*)(d + 8) = o1;
  }
  __syncthreads();
}
constexpr int WT0 = 16 * 50, WT1 = WT0 + 16 * 16, WT2 = WT1 + 4 * 12, WT3 = WT2 + 2 * 16, WT4 = WT3 + 4, NWT = WT4 + 4;
DEV void conv_weights_item(const Prm& p, int l, int it, char* lds) {
  float* T = (float*)lds;
  int tid = threadIdx.x; LAUNDER(tid);
  if (it < WT0) conv_weight_tile<true, true>(p.w_in, 1024, 3104, INP, p.Wb_in, p.norm_g, 1.f, l, it, T, tid);
  else if (it < WT1) conv_weight_tile<false, true>(p.w_out, 1024, 1024, 1024, p.Wb_out, nullptr, 1.f, l, it - WT0, T, tid);
  else if (it < WT2) conv_weight_tile<false, false>(p.w_uq, 256, 768, 768, p.Wb_uq, p.q_norm_g, 0.10206207261596575f * 1.4426950408889634f, l, it - WT1, T, tid);
  else if (it < WT3) conv_weight_tile<false, false>(p.w_ukv, 128, 1024, 1024, p.Wb_ukv, nullptr, 1.f, l, it - WT2, T, tid);
  else if (it < WT4) conv_weight_tile<false, false>(p.decay_w2, 64, 256, 256, p.dw2T, nullptr, 1.f, l, it - WT3, T, tid);
  else conv_weight_tile<false, false>(p.iclr_a2, 64, 256, 256, p.ia2T, nullptr, 1.f, l, it - WT4, T, tid);
}
DEV void phase0(const Prm& p, char* lds) {
  int tid = threadIdx.x; LAUNDER(tid);
  const int lane = tid & 63, wv = tid >> 6;
  const int gw = blockIdx.x * 4 + wv, NW = gridDim.x * 4;
  const int gt = blockIdx.x * 256 + tid, NTH = gridDim.x * 256;
  for (int R = gw; R < NT; R += NW) {
    const float* src = xin_ptr(p, R);
    float ss = 0.f;
#pragma unroll
    for (int j = 0; j < 4; ++j) {
      const float4 v = ((const float4*)src)[lane + 64 * j];
      ss += v.x * v.x + v.y * v.y + v.z * v.z + v.w * v.w;
      ((uint2*)(p.xb + (size_t)R * D))[lane + 64 * j] = pk4(v.x, v.y, v.z, v.w);
    }
    ss = wave_sum(ss);
    if (lane == 0) p.ssq_x[R] = ss;
  }
  for (int i = gt; i < 6 * NTP; i += NTH) p.ssq_x[NTP + i] = 0.f;
  for (int it = blockIdx.x; it < NWT; it += gridDim.x) conv_weights_item(p, 0, it, lds);
  for (int i = gt; i < PT * 16; i += NTH) {
    const int pos = i >> 4, j = i & 15;
    const float inv = powf(10000.f, -(float)j * 2.0f / 32.f);
    const float ang = (float)pos * inv;
    double a = (double)ang;
    a -= 6.283185307179586476925 * rint(a * 0.15915494309189533577);
    p.ropec[i] = (float)cos(a);
    p.ropes[i] = (float)sin(a);
  }
}

#define LAS3 __attribute__((address_space(3)))
#define RAW_BARRIER() { asm volatile("" ::: "memory"); __builtin_amdgcn_s_barrier(); asm volatile("" ::: "memory"); }
DEV int lds_byte(int r, int c) { const int st = (r >> 4) * 2 + (c >> 5), rr = r & 15, cc = c & 31, ob = rr * 64 + cc * 2; return st * 1024 + (ob ^ (((ob >> 9) & 1) << 5)); }
template <class Epi, int NB = 8>
DEV int gemm_tile(const bf16_t* __restrict__ A, int lda, const bf16_t* __restrict__ Bt, int ldb, int K, int m0, int n0, char* lds, const Epi& epi, unsigned* nctr = nullptr) {
  int tid = threadIdx.x; LAUNDER(tid);
  const int lane = tid & 63, w = __builtin_amdgcn_readfirstlane(tid >> 6), wr = w >> 1, wc = w & 1;
  const int fr = lane & 15, fq = lane >> 4;
  const int sb = lane * 16, swz = sb ^ (((sb >> 9) & 1) << 5), rl = swz >> 6, cl = (swz & 63) >> 1;
  const bf16_t* ga[4]; const bf16_t* gb[4];
#pragma unroll
  for (int i = 0; i < 4; ++i) {
    const int st = 4 * w + i, r = (st >> 1) * 16 + rl, c = (st & 1) * 32 + cl;
    ga[i] = A + (size_t)(m0 + r) * lda + c;
    gb[i] = Bt + (size_t)(n0 + r) * ldb + c;
  }
  const int nk = K / 64;
#define GSTAGE(S, KT) { _Pragma("unroll") for (int i = 0; i < 4; ++i) { \
      __builtin_amdgcn_global_load_lds((const unsigned*)(ga[i] + (KT) * 64), (LAS3 unsigned*)(lds + (S) * 32768 + (4 * w + i) * 1024 + lane * 16), 16, 0, 0); \
      if (2 * w + (i >> 1) < NB) __builtin_amdgcn_global_load_lds((const unsigned*)(gb[i] + (KT) * 64), (LAS3 unsigned*)(lds + (S) * 32768 + 16384 + (4 * w + i) * 1024 + lane * 16), 16, 0, 0); } }
  f32x4 acc[4][4];
#pragma unroll
  for (int i = 0; i < 4; ++i)
#pragma unroll
    for (int j = 0; j < 4; ++j) acc[i][j] = (f32x4){0.f, 0.f, 0.f, 0.f};
  int offA[2], offB[2];
#pragma unroll
  for (int kh = 0; kh < 2; ++kh) { offA[kh] = lds_byte(wr * 64 + fr, kh * 32 + fq * 8); offB[kh] = lds_byte(wc * 64 + fr, kh * 32 + fq * 8); }
  GSTAGE(0, 0)
  if (nk > 1) GSTAGE(1, 1)
  for (int kt = 0; kt < nk; ++kt) {
    const int s = kt & 1;
    if (kt + 1 < nk) { if (2 * w < NB) asm volatile("s_waitcnt vmcnt(8)" ::: "memory"); else asm volatile("s_waitcnt vmcnt(4)" ::: "memory"); }
    else asm volatile("s_waitcnt vmcnt(0)" ::: "memory");
    RAW_BARRIER()
    const char* ia = lds + s * 32768;
    const char* ib = ia + 16384;
    bf16x8 af[2][4], bfv[2][4];
#pragma unroll
    for (int kh = 0; kh < 2; ++kh) {
#pragma unroll
      for (int mi = 0; mi < 4; ++mi) af[kh][mi] = *(const bf16x8*)(ia + offA[kh] + mi * 2048);
#pragma unroll
      for (int ni = 0; ni < (NB < 4 ? NB : 4); ++ni) bfv[kh][ni] = *(const bf16x8*)(ib + offB[kh] + ni * 2048);
    }
    asm volatile("s_waitcnt lgkmcnt(0)" ::: "memory");
    RAW_BARRIER()
    if (kt + 2 < nk) GSTAGE(s, kt + 2)
    __builtin_amdgcn_sched_barrier(0);
    if (NB == 8 || wc == 0) {
#pragma unroll
      for (int kh = 0; kh < 2; ++kh)
#pragma unroll
        for (int mi = 0; mi < 4; ++mi)
#pragma unroll
          for (int ni = 0; ni < (NB < 4 ? NB : 4); ++ni) acc[mi][ni] = mfma16(bfv[kh][ni], af[kh][mi], acc[mi][ni]);
    }
  }
  __syncthreads();
#undef GSTAGE
  int tk = 0x7fffffff; if (nctr && tid == 0) tk = (int)atomicAdd(nctr, 1u);
  if (NB == 8 || wc == 0) epi(acc, m0 + wr * 64, n0 + wc * 64, fr, fq);
  return tk;
}

DEV int lds_byte32(int r, int c) { const int rr = r & 15, ob = rr * 64 + c * 2; return (r >> 4) * 1024 + (ob ^ (((ob >> 9) & 1) << 5)); }
template <class Epi>
DEV void gemm_tile_big(const bf16_t* __restrict__ A, int lda, const bf16_t* __restrict__ Bt, int ldb, int K, int m0, int n0, char* lds, const Epi& epi) {
  int tid = threadIdx.x; LAUNDER(tid);
  const int lane = tid & 63, w = __builtin_amdgcn_readfirstlane(tid >> 6), wr = w >> 1, wc = w & 1;
  const int fr = lane & 15, fq = lane >> 4;
  const int sb = lane * 16, swz = sb ^ (((sb >> 9) & 1) << 5), rl = swz >> 6, cl = (swz & 63) >> 1;
  const bf16_t* ga[4]; const bf16_t* gb[2];
#pragma unroll
  for (int i = 0; i < 4; ++i) ga[i] = A + (size_t)(m0 + (4 * w + i) * 16 + rl) * lda + cl;
#pragma unroll
  for (int i = 0; i < 2; ++i) gb[i] = Bt + (size_t)(n0 + (2 * w + i) * 16 + rl) * ldb + cl;
  const int nk = K / 32;
#define GSTAGE3(S, KT) { _Pragma("unroll") for (int i = 0; i < 4; ++i) \
      __builtin_amdgcn_global_load_lds((const unsigned*)(ga[i] + (KT) * 32), (LAS3 unsigned*)(lds + (S) * 24576 + (4 * w + i) * 1024 + lane * 16), 16, 0, 0); \
    _Pragma("unroll") for (int i = 0; i < 2; ++i) \
      __builtin_amdgcn_global_load_lds((const unsigned*)(gb[i] + (KT) * 32), (LAS3 unsigned*)(lds + (S) * 24576 + 16384 + (2 * w + i) * 1024 + lane * 16), 16, 0, 0); }
  f32x4 acc[8][4];
#pragma unroll
  for (int i = 0; i < 8; ++i)
#pragma unroll
    for (int j = 0; j < 4; ++j) acc[i][j] = (f32x4){0.f, 0.f, 0.f, 0.f};
  const int offA = lds_byte32(wr * 128 + fr, fq * 8), offB = 16384 + lds_byte32(wc * 64 + fr, fq * 8);
  GSTAGE3(0, 0)
  if (nk > 1) GSTAGE3(1, 1)
  int s = 0;
  for (int kt = 0; kt < nk; ++kt) {
    if (kt + 1 < nk) asm volatile("s_waitcnt vmcnt(6)" ::: "memory"); else asm volatile("s_waitcnt vmcnt(0)" ::: "memory");
    RAW_BARRIER()
    if (kt + 2 < nk) { const int s2 = s + 2 >= 3 ? s - 1 : s + 2; GSTAGE3(s2, kt + 2) }
    const char* im = lds + s * 24576;
    bf16x8 af[8], bfv[4];
#pragma unroll
    for (int ni = 0; ni < 4; ++ni) bfv[ni] = *(const bf16x8*)(im + offB + ni * 1024);
#pragma unroll
    for (int mi = 0; mi < 8; ++mi) af[mi] = *(const bf16x8*)(im + offA + mi * 1024);
#pragma unroll
    for (int mi = 0; mi < 8; ++mi)
#pragma unroll
      for (int ni = 0; ni < 4; ++ni) acc[mi][ni] = mfma16(bfv[ni], af[mi], acc[mi][ni]);
    s = s + 1 >= 3 ? 0 : s + 1;
  }
  __syncthreads();
#undef GSTAGE3
  epi(acc, m0 + wr * 128, n0 + wc * 64, fr, fq);
}

struct EpiIn {
  const Prm& p; int L;
  template <int MI>
  DEV void operator()(f32x4 (&acc)[MI][4], int mb, int nb, int fr, int fq) const {
#pragma unroll
    for (int mi = 0; mi < MI; ++mi) {
      const int m = mb + 16 * mi + fr;
      const bool ok = m < NT;
      const float rstd = rsqrtf(p.ssq_x[L * NTP + m] * (1.f / 1024.f) + RMS_EPS);
      float sq = 0.f;
#pragma unroll
      for (int g = 0; g < 2; ++g) {
        const int n0 = nb + 32 * g;
        if (n0 >= 3104) continue;
        bf16_t* dst = n0 < ZL ? p.zL + (size_t)m * ZL + n0 : p.zE + (size_t)m * ZE + (n0 - ZL);
        float v[8];
#pragma unroll
        for (int j = 0; j < 4; ++j) { v[j] = acc[mi][2 * g][j] * rstd; v[4 + j] = acc[mi][2 * g + 1][j] * rstd; }
#pragma unroll
        for (int j = 0; j < 8; ++j) sq += v[j] * v[j];
        if (ok) { uint4 o; o.x = pk2(v[0], v[1]); o.y = pk2(v[2], v[3]); o.z = pk2(v[4], v[5]); o.w = pk2(v[6], v[7]); *(uint4*)(dst + 8 * fq) = o; }
      }
      if (nb >= ZL && nb < ZL + 384) {
        sq += __shfl_xor(sq, 16); sq += __shfl_xor(sq, 32);
        if (fq == 0 && ok) atomicAdd((nb < ZL + 256 ? p.ssq_q : p.ssq_kv) + L * NTP + m, sq);
      }
    }
  }
};
struct EpiQ {
  const Prm& p; int L;
  DEV void operator()(f32x4 (&acc)[4][4], int mb, int nb, int fr, int fq) const {
    bf16_t* Qb = (bf16_t*)p.y_prompt;
#pragma unroll
    for (int mi = 0; mi < 4; ++mi) {
      const int m = mb + 16 * mi + fr;
      const bool ok = m < NT;
      const float rstd = rsqrtf(p.ssq_q[L * NTP + m] * (1.f / 256.f) + RMS_EPS);
      const int pos = pos_of(ok ? m : 0);
#pragma unroll
      for (int np = 0; np < 2; ++np) {
        const int n0 = nb + 32 * np;
        float v[2][4];
#pragma unroll
        for (int h2 = 0; h2 < 2; ++h2)
#pragma unroll
          for (int j = 0; j < 4; ++j) v[h2][j] = acc[mi][2 * np + h2][j] * rstd;
        if (((n0 >> 5) % 3) == 2) {
#pragma unroll
          for (int j = 0; j < 4; ++j) {
            const int c = 4 * fq + j;
            const float cs = p.ropec[pos * 16 + c], sn = p.ropes[pos * 16 + c];
            const float x1 = v[0][j], x2 = v[1][j];
            v[0][j] = x1 * cs - x2 * sn; v[1][j] = x1 * sn + x2 * cs;
          }
        }
        if (ok) {
          *(uint2*)(Qb + (size_t)m * 768 + n0 + 4 * fq) = pk4(v[0][0], v[0][1], v[0][2], v[0][3]);
          *(uint2*)(Qb + (size_t)m * 768 + n0 + 16 + 4 * fq) = pk4(v[1][0], v[1][1], v[1][2], v[1][3]);
        }
      }
    }
  }
};
struct EpiOut {
  const Prm& p; int L;
  DEV void operator()(f32x4 (&acc)[4][4], int mb, int nb, int fr, int fq) const {
#pragma unroll
    for (int mi = 0; mi < 4; ++mi) {
      const int m = mb + 16 * mi + fr;
      const bool ok = m < NT;
      bf16_t* xr = p.xb + (size_t)(ok ? m : 0) * D;
      float ss = 0.f;
#pragma unroll
      for (int g = 0; g < 2; ++g) {
        const int col = nb + 32 * g + 8 * fq;
        const uint4 xi = *(const uint4*)(xr + col);
        float v[8] = {bflo(xi.x), bfhi(xi.x), bflo(xi.y), bfhi(xi.y), bflo(xi.z), bfhi(xi.z), bflo(xi.w), bfhi(xi.w)};
#pragma unroll
        for (int j = 0; j < 4; ++j) { v[j] += acc[mi][2 * g][j]; v[4 + j] += acc[mi][2 * g + 1][j]; }
#pragma unroll
        for (int j = 0; j < 8; ++j) ss += v[j] * v[j];
        if (ok) { uint4 o; o.x = pk2(v[0], v[1]); o.y = pk2(v[2], v[3]); o.z = pk2(v[4], v[5]); o.w = pk2(v[6], v[7]); *(uint4*)(xr + col) = o; }
      }
      ss += __shfl_xor(ss, 16); ss += __shfl_xor(ss, 32);
      if (fq == 0 && ok) atomicAdd(p.ssq_x + (L + 1) * NTP + m, ss);
    }
  }
};

DEV void kv_prep_row(const Prm& p, int L, int R, int half, bool valid, bf16_t* At_row  ) {
  const int Rl = valid ? R : 0;
  const bf16_t* zr = p.zE + (size_t)Rl * ZE;
  const float rstd = rsqrtf(p.ssq_kv[L * NTP + Rl] * (1.f / 128.f) + RMS_EPS);
  float* outc; float* outk;
  if (Rl < NPR) { const int s = Rl / PT, q = Rl - s * PT; outc = p.ckv_p + (((size_t)L * 4 + s) * PT + q) * 128; outk = p.kr_p + (((size_t)L * 4 + s) * PT + q) * 32; }
  else { const int j = Rl - NPR; outc = p.ckv_s + ((size_t)L * NSM + j) * 128; outk = p.kr_s + ((size_t)L * NSM + j) * 32; }
  const float* g = p.kv_norm_g + L * 128 + 64 * half;
#pragma unroll
  for (int c8 = 0; c8 < 8; ++c8) {
    const uint4 u = *(const uint4*)(zr + ZE_CKV + 64 * half + 8 * c8);
    const float4 g0 = *(const float4*)(g + 8 * c8), g1 = *(const float4*)(g + 8 * c8 + 4);
    float4 y0, y1;
    y0.x = bflo(u.x) * rstd * g0.x; y0.y = bfhi(u.x) * rstd * g0.y; y0.z = bflo(u.y) * rstd * g0.z; y0.w = bfhi(u.y) * rstd * g0.w;
    y1.x = bflo(u.z) * rstd * g1.x; y1.y = bfhi(u.z) * rstd * g1.y; y1.z = bflo(u.w) * rstd * g1.z; y1.w = bfhi(u.w) * rstd * g1.w;
    if (valid) { *(float4*)(outc + 64 * half + 8 * c8) = y0; *(float4*)(outc + 64 * half + 8 * c8 + 4) = y1; }
    if (At_row) { uint4 o; o.x = pk2(y0.x, y0.y); o.y = pk2(y0.z, y0.w); o.z = pk2(y1.x, y1.y); o.w = pk2(y1.z, y1.w); *(uint4*)(At_row + 64 * half + 8 * c8) = o; }
    if (valid && Rl >= NPR) {
      const int j = Rl - NPR, b = j >> 6, r = j & 63;
      bf16_t* kl = p.KL + ((size_t)b * SKEYS + 1024 + r) * 160 + 16 * (4 * half + (c8 >> 1)) + 4 * (c8 & 1);
      *(uint2*)kl = pk4(y0.x, y0.y, y0.z, y0.w); *(uint2*)(kl + 8) = pk4(y1.x, y1.y, y1.z, y1.w);
    }
    if (c8 & 1) __builtin_amdgcn_sched_barrier(0);
  }
  if (half == 0) {
    const int pos = pos_of(Rl);
#pragma unroll
    for (int c8 = 0; c8 < 2; ++c8) {
      const uint4 u = *(const uint4*)(zr + ZE_KR + 8 * c8), v = *(const uint4*)(zr + ZE_KR + 16 + 8 * c8);
      const float x1[8] = {bflo(u.x), bfhi(u.x), bflo(u.y), bfhi(u.y), bflo(u.z), bfhi(u.z), bflo(u.w), bfhi(u.w)};
      const float x2[8] = {bflo(v.x), bfhi(v.x), bflo(v.y), bfhi(v.y), bflo(v.z), bfhi(v.z), bflo(v.w), bfhi(v.w)};
      float y1[8], y2[8];
#pragma unroll
      for (int e = 0; e < 8; ++e) {
        const float cs = p.ropec[pos * 16 + 8 * c8 + e], sn = p.ropes[pos * 16 + 8 * c8 + e];
        y1[e] = x1[e] * cs - x2[e] * sn; y2[e] = x1[e] * sn + x2[e] * cs;
      }
      if (valid) {
        float4 o;
        o.x = y1[0]; o.y = y1[1]; o.z = y1[2]; o.w = y1[3]; *(float4*)(outk + 8 * c8) = o;
        o.x = y1[4]; o.y = y1[5]; o.z = y1[6]; o.w = y1[7]; *(float4*)(outk + 8 * c8 + 4) = o;
        o.x = y2[0]; o.y = y2[1]; o.z = y2[2]; o.w = y2[3]; *(float4*)(outk + 16 + 8 * c8) = o;
        o.x = y2[4]; o.y = y2[5]; o.z = y2[6]; o.w = y2[7]; *(float4*)(outk + 16 + 8 * c8 + 4) = o;
        {
          const int j = Rl - NPR;
          bf16_t* krd = Rl < NPR ? p.Kr + (size_t)Rl * 32 : p.KL + ((size_t)(j >> 6) * SKEYS + 1024 + (j & 63)) * 160 + 128;
          uint4 q; q.x = pk2(y1[0], y1[1]); q.y = pk2(y1[2], y1[3]); q.z = pk2(y1[4], y1[5]); q.w = pk2(y1[6], y1[7]); *(uint4*)(krd + 8 * c8) = q;
          q.x = pk2(y2[0], y2[1]); q.y = pk2(y2[2], y2[3]); q.z = pk2(y2[4], y2[5]); q.w = pk2(y2[6], y2[7]); *(uint4*)(krd + 16 + 8 * c8) = q;
        }
      }
    }
  }
}
DEV void kvproj_item(const Prm& p, int L, int mt, char* lds) {
  int tid = threadIdx.x; LAUNDER(tid);
  const int lane = tid & 63, w = __builtin_amdgcn_readfirstlane(tid >> 6), wr = w >> 1, wc = w & 1, l31 = lane & 31, hh = lane >> 5;
  bf16_t* At = (bf16_t*)lds;
  bf16_t* Bs = At + 128 * 136;
  {
    const int r = tid >> 1, half = tid & 1, R = mt * 128 + r;
    kv_prep_row(p, L, R, half, R < NPR, At + r * 136);
  }
  for (int h = 0; h < 8; ++h) {
    __syncthreads();
    {
      const bf16_t* wsrc = p.Wb_ukv + ((size_t)L * 1024 + h * 128) * 128;
#pragma unroll
      for (int i = 0; i < 8; ++i) { const int id = tid + 256 * i, row = id >> 4, cc = id & 15; *(uint4*)(Bs + row * 136 + cc * 8) = *(const uint4*)(wsrc + row * 128 + cc * 8); }
    }
    __syncthreads();
    f32x16 acc[2][2];
#pragma unroll
    for (int i = 0; i < 2; ++i)
#pragma unroll
      for (int j = 0; j < 2; ++j) acc[i][j] = zero16();
    const bf16_t* as = At + (wr * 64 + l31) * 136 + hh * 8;
    const bf16_t* bs = Bs + (wc * 64 + l31) * 136 + hh * 8;
    if (wc == 0) {
#pragma unroll 2
      for (int ks = 0; ks < 8; ++ks) {
        const bf16x8 a0 = *(const bf16x8*)(as + ks * 16), a1 = *(const bf16x8*)(as + 32 * 136 + ks * 16);
        const bf16x8 b0 = *(const bf16x8*)(bs + ks * 16), b1 = *(const bf16x8*)(bs + 32 * 136 + ks * 16);
        acc[0][0] = mfma32(b0, a0, acc[0][0]); acc[0][1] = mfma32(b1, a0, acc[0][1]);
        acc[1][0] = mfma32(b0, a1, acc[1][0]); acc[1][1] = mfma32(b1, a1, acc[1][1]);
      }
#pragma unroll
      for (int i = 0; i < 2; ++i) {
        const int KRr = mt * 128 + wr * 64 + 32 * i + l31;
#pragma unroll
        for (int j = 0; j < 2; ++j)
#pragma unroll
          for (int G = 0; G < 4; ++G)
            *(uint2*)(p.Kn + ((size_t)KRr * 8 + h) * 64 + 32 * j + 8 * G + 4 * hh) = pk4(acc[i][j][4 * G], acc[i][j][4 * G + 1], acc[i][j][4 * G + 2], acc[i][j][4 * G + 3]);
      }
    } else {
#pragma unroll 2
      for (int ks = 0; ks < 8; ++ks) {
        const bf16x8 a0 = *(const bf16x8*)(as + ks * 16), a1 = *(const bf16x8*)(as + 32 * 136 + ks * 16);
        const bf16x8 b0 = *(const bf16x8*)(bs + ks * 16), b1 = *(const bf16x8*)(bs + 32 * 136 + ks * 16);
        acc[0][0] = mfma32(a0, b0, acc[0][0]); acc[0][1] = mfma32(a0, b1, acc[0][1]);
        acc[1][0] = mfma32(a1, b0, acc[1][0]); acc[1][1] = mfma32(a1, b1, acc[1][1]);
      }
#pragma unroll
      for (int j = 0; j < 2; ++j) {
        const int d = 32 * j + l31;
#pragma unroll
        for (int i = 0; i < 2; ++i)
#pragma unroll
          for (int G = 0; G < 4; ++G) {
            const int KRr = mt * 128 + wr * 64 + 32 * i + 16 * (G >> 1) + 8 * hh + 4 * (G & 1);
            *(uint2*)(p.Vt + ((size_t)h * 64 + d) * KVR + KRr) = pk4(acc[i][j][4 * G], acc[i][j][4 * G + 1], acc[i][j][4 * G + 2], acc[i][j][4 * G + 3]);
          }
      }
    }
  }
  __syncthreads();
}
DEV void sample_prep_item(const Prm& p, int L, int it) {
  int tid = threadIdx.x; LAUNDER(tid);
  const int R = NPR + it * 128 + (tid >> 1);
  kv_prep_row(p, L, R, tid & 1, true, nullptr);
}
DEV void shift_item(const Prm& p, int L, int st) {
  int tid0 = threadIdx.x; LAUNDER(tid0);
  if (tid0 < 224) {
    const int R = st < 4 ? st * PT + (PT - 1) : NPR + (st - 4) * 64 + 63;
    const uint2 u = *(const uint2*)(p.zE + (size_t)R * ZE + ZE_ZC + 4 * tid0);
    float4 v; v.x = bflo(u.x); v.y = bfhi(u.x); v.z = bflo(u.y); v.w = bfhi(u.y);
    float* dst = st < 4 ? p.shift_p + ((size_t)L * 4 + st) * 896 : p.shift_s + ((size_t)L * 32 + (st - 4)) * 896;
    *(float4*)(dst + 4 * tid0) = v;
  }
}

DEV void lat_item(const Prm& p, int L, int j) {
  int tid = threadIdx.x; LAUNDER(tid);
  const int b = j >> 4, t = j & 15;
  const float* csrc = p.cache_ckv + (((size_t)L * 32 + b) * 1024 + 64 * t) * 128;
  const float* ksrc = p.cache_krope + (((size_t)L * 32 + b) * 1024 + 64 * t) * 32;
  {
    const int row = tid >> 2, qd = tid & 3;
    const float* s = csrc + row * 128 + 32 * qd;
    bf16_t* d = p.KL + ((size_t)b * SKEYS + 64 * t + row) * 160;
    const float4 v0 = *(const float4*)(s), v1 = *(const float4*)(s + 4), v2 = *(const float4*)(s + 8), v3 = *(const float4*)(s + 12);
    const float4 v4 = *(const float4*)(s + 16), v5 = *(const float4*)(s + 20), v6 = *(const float4*)(s + 24), v7 = *(const float4*)(s + 28);
    const float4 k0 = *(const float4*)(ksrc + row * 32 + 8 * qd), k1 = *(const float4*)(ksrc + row * 32 + 8 * qd + 4);
    uint4 a;
    a.x = pk2(v0.x, v0.y); a.y = pk2(v0.z, v0.w); a.z = pk2(v2.x, v2.y); a.w = pk2(v2.z, v2.w); *(uint4*)(d + 32 * qd) = a;
    a.x = pk2(v1.x, v1.y); a.y = pk2(v1.z, v1.w); a.z = pk2(v3.x, v3.y); a.w = pk2(v3.z, v3.w); *(uint4*)(d + 32 * qd + 8) = a;
    a.x = pk2(v4.x, v4.y); a.y = pk2(v4.z, v4.w); a.z = pk2(v6.x, v6.y); a.w = pk2(v6.z, v6.w); *(uint4*)(d + 32 * qd + 16) = a;
    a.x = pk2(v5.x, v5.y); a.y = pk2(v5.z, v5.w); a.z = pk2(v7.x, v7.y); a.w = pk2(v7.z, v7.w); *(uint4*)(d + 32 * qd + 24) = a;
    a.x = pk2(k0.x, k0.y); a.y = pk2(k0.z, k0.w); a.z = pk2(k1.x, k1.y); a.w = pk2(k1.z, k1.w); *(uint4*)(d + 128 + 8 * qd) = a;
  }
}

template <bool SAMPLE>
DEV int attn_body(const Prm& p, int L, int sb, int head, int qt, char* lds, unsigned* nctr = nullptr) {
  int tid = threadIdx.x; LAUNDER(tid);
  const int lane = tid & 63, w = __builtin_amdgcn_readfirstlane(tid >> 6), l31 = lane & 31, hh = lane >> 5;
  bf16_t* Ks = (bf16_t*)lds;
  bf16_t* Vs = Ks + (SAMPLE ? 1 : 2) * 64 * 104;
  bf16_t* Cs = Vs + (SAMPLE ? 1 : 2) * 64 * 72;
  bf16_t* Wl = Cs + 64 * 136;
  const bf16_t* Qb = (const bf16_t*)p.y_prompt;
  bf16_t* mix = p.zE;
  int Rq0, ntiles, lastvis; bool wact, rowvalid;
  if (SAMPLE) { Rq0 = NPR + 64 * sb; ntiles = 17; lastvis = 16; wact = w < 2; rowvalid = wact; }
  else if (qt >= 0) { Rq0 = sb * PT + 16 + 128 * qt; ntiles = 2 * qt + 3; lastvis = 1 + 2 * qt + (w >> 1); wact = true; rowvalid = true; }
  else { Rq0 = sb * PT; ntiles = 1; lastvis = 0; wact = (w == 0); rowvalid = wact && l31 < 16; }
  const int myrow = Rq0 + 32 * w + l31;
  const int Rld = rowvalid ? myrow : Rq0;
  bf16x8 qf[6];
  {
    const bf16_t* qp = Qb + (size_t)Rld * 768 + head * 96 + hh * 8;
#pragma unroll
    for (int ks = 0; ks < 6; ++ks) qf[ks] = *(const bf16x8*)(qp + 16 * ks);
  }
  float m_run = -1e30f, l_run = 0.f;
  f32x16 o0 = zero16(), o1 = zero16();

  uint4 a_kn0, a_kn1, a_kr, a_vt0, a_vt1;
  a_kn0 = a_kn1 = a_kr = a_vt0 = a_vt1 = make_uint4(0, 0, 0, 0);
#define PLOADX(S, TI) { const int KR0 = sb * PT + ((TI) == 0 ? 0 : 16 + 64 * ((TI) - 1)); \
    S##_kn0 = *(const uint4*)(p.Kn + ((size_t)(KR0 + (tid >> 3)) * 8 + head) * 64 + (tid & 7) * 8); \
    S##_kn1 = *(const uint4*)(p.Kn + ((size_t)(KR0 + 32 + (tid >> 3)) * 8 + head) * 64 + (tid & 7) * 8); \
    S##_kr = *(const uint4*)(p.Kr + (size_t)(KR0 + (tid >> 2)) * 32 + (tid & 3) * 8); \
    S##_vt0 = *(const uint4*)(p.Vt + ((size_t)head * 64 + (tid >> 3)) * KVR + KR0 + (tid & 7) * 8); \
    S##_vt1 = *(const uint4*)(p.Vt + ((size_t)head * 64 + 32 + (tid >> 3)) * KVR + KR0 + (tid & 7) * 8); }
#define PWRITEX(S, BUF) { bf16_t* kb_ = Ks + (BUF) * 64 * 104; bf16_t* vb_ = Vs + (BUF) * 64 * 72; \
    *(uint4*)(kb_ + (tid >> 3) * 104 + (tid & 7) * 8) = S##_kn0; *(uint4*)(kb_ + (32 + (tid >> 3)) * 104 + (tid & 7) * 8) = S##_kn1; \
    *(uint4*)(kb_ + (tid >> 2) * 104 + 64 + (tid & 3) * 8) = S##_kr; \
    *(uint4*)(vb_ + (tid >> 3) * 72 + (tid & 7) * 8) = S##_vt0; *(uint4*)(vb_ + (32 + (tid >> 3)) * 72 + (tid & 7) * 8) = S##_vt1; }
  float4 pc0, pc1, pc2, pc3, pc4, pc5, pc6, pc7, pk0, pk1;
  pc0 = pc1 = pc2 = pc3 = pc4 = pc5 = pc6 = pc7 = pk0 = pk1 = make_float4(0.f, 0.f, 0.f, 0.f);
  if (SAMPLE) {
    const bf16_t* wsrc = p.Wb_ukv + ((size_t)L * 1024 + head * 128) * 128;
#pragma unroll
    for (int i = 0; i < 8; ++i) { const int id = tid + 256 * i, row = id >> 4, cc = id & 15; *(uint4*)(Wl + row * 136 + cc * 8) = *(const uint4*)(wsrc + row * 128 + cc * 8); }
  }
#define SLOAD(TI) { const float* csrc; const float* ksrc; \
    if ((TI) < 16) { csrc = p.cache_ckv + (((size_t)L * 32 + sb) * 1024 + 64 * (TI)) * 128; ksrc = p.cache_krope + (((size_t)L * 32 + sb) * 1024 + 64 * (TI)) * 32; } \
    else { csrc = p.ckv_s + ((size_t)L * NSM + 64 * sb) * 128; ksrc = p.kr_s + ((size_t)L * NSM + 64 * sb) * 32; } \
    const float* cb_ = csrc + (tid >> 5) * 128 + (tid & 31) * 4; \
    pc0 = *(const float4*)(cb_); pc1 = *(const float4*)(cb_ + 8 * 128); pc2 = *(const float4*)(cb_ + 16 * 128); pc3 = *(const float4*)(cb_ + 24 * 128); \
    pc4 = *(const float4*)(cb_ + 32 * 128); pc5 = *(const float4*)(cb_ + 40 * 128); pc6 = *(const float4*)(cb_ + 48 * 128); pc7 = *(const float4*)(cb_ + 56 * 128); \
    const float* kb2_ = ksrc + (tid >> 3) * 32 + (tid & 7) * 4; pk0 = *(const float4*)(kb2_); pk1 = *(const float4*)(kb2_ + 32 * 32); }
#define SWRITE(BUF) { bf16_t* cd_ = Cs + (tid >> 5) * 136 + (tid & 31) * 4; \
    *(uint2*)(cd_) = pk4(pc0.x, pc0.y, pc0.z, pc0.w); *(uint2*)(cd_ + 8 * 136) = pk4(pc1.x, pc1.y, pc1.z, pc1.w); \
    *(uint2*)(cd_ + 16 * 136) = pk4(pc2.x, pc2.y, pc2.z, pc2.w); *(uint2*)(cd_ + 24 * 136) = pk4(pc3.x, pc3.y, pc3.z, pc3.w); \
    *(uint2*)(cd_ + 32 * 136) = pk4(pc4.x, pc4.y, pc4.z, pc4.w); *(uint2*)(cd_ + 40 * 136) = pk4(pc5.x, pc5.y, pc5.z, pc5.w); \
    *(uint2*)(cd_ + 48 * 136) = pk4(pc6.x, pc6.y, pc6.z, pc6.w); *(uint2*)(cd_ + 56 * 136) = pk4(pc7.x, pc7.y, pc7.z, pc7.w); \
    }
#define SWRITEK(BUF) { bf16_t* kd_ = Ks + (BUF) * 64 * 104 + (tid >> 3) * 104 + 64 + (tid & 7) * 4; \
    *(uint2*)(kd_) = pk4(pk0.x, pk0.y, pk0.z, pk0.w); *(uint2*)(kd_ + 32 * 104) = pk4(pk1.x, pk1.y, pk1.z, pk1.w); }
  auto sexpand = [&](int buf) {
    const int a = w & 1, b = w >> 1;
    const bf16_t* cp = Cs + (32 * b + l31) * 136 + hh * 8;
    const bf16_t* wkp = Wl + (32 * a + l31) * 136 + hh * 8;
    const bf16_t* wvp = wkp + 64 * 136;
    f32x16 ka = zero16(), va = zero16();
#pragma unroll
    for (int ks = 0; ks < 8; ++ks) {
      const bf16x8 cf = *(const bf16x8*)(cp + 16 * ks);
      ka = mfma32(*(const bf16x8*)(wkp + 16 * ks), cf, ka);
      va = mfma32(cf, *(const bf16x8*)(wvp + 16 * ks), va);
    }
    bf16_t* kb = Ks + buf * 64 * 104; bf16_t* vb = Vs + buf * 64 * 72;
#pragma unroll
    for (int G = 0; G < 4; ++G) {
      *(uint2*)(kb + (32 * b + l31) * 104 + 32 * a + 8 * G + 4 * hh) = pk4(ka[4 * G], ka[4 * G + 1], ka[4 * G + 2], ka[4 * G + 3]);
      *(uint2*)(vb + (32 * a + l31) * 72 + 32 * b + 8 * G + 4 * hh) = pk4(va[4 * G], va[4 * G + 1], va[4 * G + 2], va[4 * G + 3]);
    }
  };
  const int x7 = (l31 >> 1) & 7, x3 = (l31 >> 2) & 3, xv = (l31 >> 1) & 7;
#define KFRAG(SP, KS, SUB) (SAMPLE ? *(const bf16x8*)((const bf16_t*)(SP) + (l31 + 32 * (SUB)) * 104 + hh * 8 + 16 * (KS)) \
    : ((KS) < 4 ? *(const bf16x8*)((SP) + (l31 + 32 * (SUB)) * 128 + (((2 * (KS) + hh) ^ x7) << 4)) \
                : *(const bf16x8*)((SP) + 8192 + (l31 + 32 * (SUB)) * 64 + (((2 * ((KS) - 4) + hh) ^ x3) << 4))))
#define VHALF(SP, C, SUB) (SAMPLE ? *(const uint2*)((const bf16_t*)(SP) + 64 * 104 + (l31 + 32 * (SUB)) * 72 + 4 * hh + 8 * (C)) \
    : *(const uint2*)((SP) + 12288 + (l31 + 32 * (SUB)) * 128 + 8 * hh + ((((C)) ^ xv) << 4)))
  auto compute_t = [&](auto masked_c, const char* sp) {
    constexpr bool MASKED = decltype(masked_c)::value;
    f32x16 s0 = zero16(), s1 = zero16();
#pragma unroll
    for (int ks = 0; ks < 6; ++ks) {
      const bf16x8 k0 = KFRAG(sp, ks, 0), k1 = KFRAG(sp, ks, 1);
      s0 = mfma32(k0, qf[ks], s0); s1 = mfma32(k1, qf[ks], s1);
    }
    if (!SAMPLE && MASKED) {
#pragma unroll
      for (int r = 8; r < 16; ++r) s0[r] = -1e30f;
#pragma unroll
      for (int r = 0; r < 16; ++r) s1[r] = -1e30f;
    }
    float mx = s0[0];
#pragma unroll
    for (int r = 1; r < 16; ++r) mx = fmaxf(mx, s0[r]);
#pragma unroll
    for (int r = 0; r < 16; ++r) mx = fmaxf(mx, s1[r]);
    mx = fmaxf(mx, __shfl_xor(mx, 32));
    const float mnew = fmaxf(m_run, mx);
    const float alpha = __builtin_amdgcn_exp2f(m_run - mnew);
    m_run = mnew;
    float ps = 0.f;
#pragma unroll
    for (int r = 0; r < 16; ++r) { s0[r] = __builtin_amdgcn_exp2f(s0[r] - mnew); ps += s0[r]; }
#pragma unroll
    for (int r = 0; r < 16; ++r) { s1[r] = __builtin_amdgcn_exp2f(s1[r] - mnew); ps += s1[r]; }
    l_run = l_run * alpha + ps;
#pragma unroll
    for (int r = 0; r < 16; ++r) { o0[r] *= alpha; o1[r] *= alpha; }
    const bf16x8 pf0 = mk8(pk2(s0[0], s0[1]), pk2(s0[2], s0[3]), pk2(s0[4], s0[5]), pk2(s0[6], s0[7]));
    const bf16x8 pf1 = mk8(pk2(s0[8], s0[9]), pk2(s0[10], s0[11]), pk2(s0[12], s0[13]), pk2(s0[14], s0[15]));
    const bf16x8 pf2 = mk8(pk2(s1[0], s1[1]), pk2(s1[2], s1[3]), pk2(s1[4], s1[5]), pk2(s1[6], s1[7]));
    const bf16x8 pf3 = mk8(pk2(s1[8], s1[9]), pk2(s1[10], s1[11]), pk2(s1[12], s1[13]), pk2(s1[14], s1[15]));
#define PV_STEP(S, PF) { bf16x8 v0_, v1_; \
      if (SAMPLE) { const uint2 a0 = VHALF(sp, 2 * S, 0), b0 = VHALF(sp, 2 * S + 1, 0), a1 = VHALF(sp, 2 * S, 1), b1 = VHALF(sp, 2 * S + 1, 1); \
        v0_ = mk8(a0.x, a0.y, b0.x, b0.y); v1_ = mk8(a1.x, a1.y, b1.x, b1.y); } \
      else { v0_ = *(const bf16x8*)(sp + 12288 + l31 * 128 + (((2 * S + hh) ^ xv) << 4)); v1_ = *(const bf16x8*)(sp + 12288 + (l31 + 32) * 128 + (((2 * S + hh) ^ xv) << 4)); } \
      o0 = mfma32(v0_, PF, o0); o1 = mfma32(v1_, PF, o1); }
    PV_STEP(0, pf0) PV_STEP(1, pf1) PV_STEP(2, pf2) PV_STEP(3, pf3)
  };
  bf16x8 qf7 = mk8(0u, 0u, 0u, 0u);
  const bf16x8 kone = mk8(hh == 0 ? 0x3F80u : 0u, 0u, 0u, 0u);
  auto freeze = [&]() {
    const float mf = bflo(pk2(m_run, 0.f));
    const float fac = __builtin_amdgcn_exp2f(m_run - mf);
    l_run *= fac;
#pragma unroll
    for (int r = 0; r < 16; ++r) { o0[r] *= fac; o1[r] *= fac; }
    qf7 = mk8(hh == 0 ? (pk2(-mf, 0.f) & 0xffffu) : 0u, 0u, 0u, 0u);
  };
  auto compute_f = [&](const char* sp) {
    f32x16 s0 = mfma32(kone, qf7, zero16()), s1 = mfma32(kone, qf7, zero16());
#pragma unroll
    for (int ks = 0; ks < 6; ++ks) {
      const bf16x8 k0 = KFRAG(sp, ks, 0), k1 = KFRAG(sp, ks, 1);
      s0 = mfma32(k0, qf[ks], s0); s1 = mfma32(k1, qf[ks], s1);
    }
    float ps = 0.f;
#pragma unroll
    for (int r = 0; r < 16; ++r) { s0[r] = __builtin_amdgcn_exp2f(s0[r]); ps += s0[r]; }
#pragma unroll
    for (int r = 0; r < 16; ++r) { s1[r] = __builtin_amdgcn_exp2f(s1[r]); ps += s1[r]; }
    l_run += ps;
    const bf16x8 pf0 = mk8(pk2(s0[0], s0[1]), pk2(s0[2], s0[3]), pk2(s0[4], s0[5]), pk2(s0[6], s0[7]));
    const bf16x8 pf1 = mk8(pk2(s0[8], s0[9]), pk2(s0[10], s0[11]), pk2(s0[12], s0[13]), pk2(s0[14], s0[15]));
    const bf16x8 pf2 = mk8(pk2(s1[0], s1[1]), pk2(s1[2], s1[3]), pk2(s1[4], s1[5]), pk2(s1[6], s1[7]));
    const bf16x8 pf3 = mk8(pk2(s1[8], s1[9]), pk2(s1[10], s1[11]), pk2(s1[12], s1[13]), pk2(s1[14], s1[15]));
    PV_STEP(0, pf0) PV_STEP(1, pf1) PV_STEP(2, pf2) PV_STEP(3, pf3)
#undef PV_STEP
  };

  if (SAMPLE) {
    SLOAD(0)
    for (int ti = 0; ti < ntiles; ++ti) {
      const int buf = 0;
      SWRITE(buf)
      __syncthreads();
      SWRITEK(buf)
      { const int tn = ti + 1 < ntiles ? ti + 1 : ti; SLOAD(tn) }
      sexpand(buf);
      __syncthreads();
      if (wact) { if (ti == 0) { compute_t(std::false_type{}, (const char*)Ks); freeze(); } else compute_f((const char*)Ks); }
    }
    __syncthreads();
  } else {
    const int l8 = lane >> 3, c8 = lane & 7;
    unsigned kn_o0, kn_o1, kr_o, vt_o0, vt_o1;
    { const int r = 8 * (2 * w) + l8; kn_o0 = (unsigned)((r * 8 + head) * 64 + ((c8 ^ ((r >> 1) & 7)) * 8)); }
    { const int r = 8 * (2 * w + 1) + l8; kn_o1 = (unsigned)((r * 8 + head) * 64 + ((c8 ^ ((r >> 1) & 7)) * 8)); }
    { const int r = 16 * w + (lane >> 2); kr_o = (unsigned)(r * 32 + (((lane & 3) ^ ((r >> 2) & 3)) * 8)); }
    { const int d = 8 * (2 * w) + l8; vt_o0 = (unsigned)((head * 64 + d) * KVR + ((c8 ^ ((d >> 1) & 7)) * 8)); }
    { const int d = 8 * (2 * w + 1) + l8; vt_o1 = (unsigned)((head * 64 + d) * KVR + ((c8 ^ ((d >> 1) & 7)) * 8)); }
#define GLDS16(G, Lp) __builtin_amdgcn_global_load_lds((const unsigned*)(G), (LAS3 unsigned*)(Lp), 16, 0, 0)
#define PDMA(TI, STG) { const int KR0 = sb * PT + ((TI) == 0 ? 0 : 16 + 64 * ((TI) - 1)); char* sb_ = lds + (STG) * 20480 + lane * 16; \
      const bf16_t* kn_ = p.Kn + (size_t)KR0 * 512; const bf16_t* kr_ = p.Kr + (size_t)KR0 * 32; const bf16_t* vt_ = p.Vt + KR0; \
      GLDS16(kn_ + kn_o0, sb_ + (2 * w) * 1024); GLDS16(kn_ + kn_o1, sb_ + (2 * w + 1) * 1024); GLDS16(kr_ + kr_o, sb_ + 8192 + w * 1024); \
      GLDS16(vt_ + vt_o0, sb_ + 12288 + (2 * w) * 1024); GLDS16(vt_ + vt_o1, sb_ + 12288 + (2 * w + 1) * 1024); }
    PDMA(0, 0)
    if (ntiles > 1) PDMA(1, 1)
    int stg = 0, stg2 = 2;
    for (int ti = 0; ti < ntiles; ++ti) {
      if (ti + 1 < ntiles) asm volatile("s_waitcnt vmcnt(5)" ::: "memory"); else asm volatile("s_waitcnt vmcnt(0)" ::: "memory");
      RAW_BARRIER()
      if (ti + 2 < ntiles) PDMA(ti + 2, stg2)
      const char* sp = lds + stg * 20480;
      if (ti == 0) { if (wact) compute_t(std::true_type{}, sp); }
      else if (ti == 1) { compute_t(std::false_type{}, sp); freeze(); }
      else if (ti <= lastvis) compute_f(sp);
      stg = stg == 2 ? 0 : stg + 1; stg2 = stg2 == 2 ? 0 : stg2 + 1;
    }
    __syncthreads();
#undef PDMA
#undef GLDS16
  }
  int tk = 0x7fffffff; if (nctr && tid == 0) tk = (int)atomicAdd(nctr, 1u);
  const float lt = l_run + __shfl_xor(l_run, 32);
  if (rowvalid) {
    const float inv = 1.f / lt;
    const bf16_t* gbp = p.zL + (size_t)myrow * ZL + ZL_GB + 64 * head;
    bf16_t* op = mix + (size_t)myrow * D + 256 + 64 * head;
#pragma unroll
    for (int G = 0; G < 4; ++G) {
      const int d = 8 * G + 4 * hh;
      const uint2 g0 = *(const uint2*)(gbp + d), g1 = *(const uint2*)(gbp + 32 + d);
      *(uint2*)(op + d) = pk4(o0[4 * G] * inv * silu_(bflo(g0.x)), o0[4 * G + 1] * inv * silu_(bfhi(g0.x)), o0[4 * G + 2] * inv * silu_(bflo(g0.y)), o0[4 * G + 3] * inv * silu_(bfhi(g0.y)));
      *(uint2*)(op + 32 + d) = pk4(o1[4 * G] * inv * silu_(bflo(g1.x)), o1[4 * G + 1] * inv * silu_(bfhi(g1.x)), o1[4 * G + 2] * inv * silu_(bflo(g1.y)), o1[4 * G + 3] * inv * silu_(bfhi(g1.y)));
    }
  }
  return tk;
}
DEV void attn_item(const Prm& p, int L, int id, char* lds) {
  if (id < 1024) { const int qt = 31 - (id >> 5), sh = id & 31; attn_body<false>(p, L, sh >> 3, sh & 7, qt, lds); }
  else if (id < 1280) { const int j = id - 1024; attn_body<true>(p, L, j >> 3, j & 7, 0, lds); }
  else { const int j = id - 1280; attn_body<false>(p, L, j >> 3, j & 7, -1, lds); }
}

typedef short v4i16_t __attribute__((ext_vector_type(4)));
DEV uint2 lds_tr16(const char* pl) { const v4i16_t r = __builtin_amdgcn_ds_read_tr16_b64_v4i16((__attribute__((address_space(3))) v4i16_t*)pl); return __builtin_bit_cast(uint2, r); }
DEV void attn_sample(const Prm& p, int L, int b, int hp, char* lds) {
  int tid = threadIdx.x; LAUNDER(tid);
  const int lane = tid & 63, w = __builtin_amdgcn_readfirstlane(tid >> 6), l31 = lane & 31, hh = lane >> 5;
  const int head = 2 * hp + (w >> 1);
  const bf16_t* Qb = (const bf16_t*)p.y_prompt;
  bf16_t* mix = p.zE;
  const int myrow = NPR + 64 * b + 32 * (w & 1) + l31;
  bf16x8 qf[6];
  {
    const bf16_t* qp = Qb + (size_t)myrow * 768 + head * 96 + hh * 8;
#pragma unroll
    for (int ks = 0; ks < 6; ++ks) qf[ks] = *(const bf16x8*)(qp + 16 * ks);
  }
  unsigned kl_o0, kl_o1, kl_o2, kl_o3, kr_o;
  {
    const int l16 = lane >> 4, c16 = lane & 15;
#define KROW(i) (4 * (4 * w + (i)) + l16)
#define KLO(i) ((unsigned)(KROW(i) * 160 + ((c16 ^ (((KROW(i) & 3) << 2) | ((KROW(i) >> 2) & 3))) * 8)))
    kl_o0 = KLO(0); kl_o1 = KLO(1); kl_o2 = KLO(2); kl_o3 = KLO(3);
#undef KLO
#undef KROW
    const int r = 16 * w + (lane >> 2);
    kr_o = (unsigned)(r * 160 + 128 + (((lane & 3) ^ ((r >> 2) & 3)) * 8));
  }
  const bf16_t* klb = p.KL + (size_t)b * SKEYS * 160;
#define GLDS16(G, Lp) __builtin_amdgcn_global_load_lds((const unsigned*)(G), (LAS3 unsigned*)(Lp), 16, 0, 0)
#define SDMA(TI, STG) { char* sb_ = lds + (STG) * 20480 + lane * 16; const bf16_t* kl_ = klb + (size_t)(TI) * 64 * 160; \
    GLDS16(kl_ + kl_o0, sb_ + (4 * w) * 1024); GLDS16(kl_ + kl_o1, sb_ + (4 * w + 1) * 1024); GLDS16(kl_ + kl_o2, sb_ + (4 * w + 2) * 1024); GLDS16(kl_ + kl_o3, sb_ + (4 * w + 3) * 1024); \
    GLDS16(kl_ + kr_o, sb_ + 16384 + w * 1024); }
  SDMA(0, 0)
  SDMA(1, 1)
  bf16x8 qa0, qa1, qa2, qa3, qa4, qa5, qa6, qa7;
  {
    const float* wsrc = p.w_ukv + ((size_t)L * 128 + l31) * 1024 + head * 128 + 8 * hh;
#define QABS(CT, QA, QB) { f32x16 acc = zero16(); \
      _Pragma("unroll") for (int ks = 0; ks < 4; ++ks) { const float* s_ = wsrc + (size_t)(32 * (CT)) * 1024 + 16 * ks; const float4 a_ = *(const float4*)s_, c_ = *(const float4*)(s_ + 4); \
        acc = mfma32(mk8(pk2(a_.x, a_.y), pk2(a_.z, a_.w), pk2(c_.x, c_.y), pk2(c_.z, c_.w)), qf[ks], acc); } \
      QA = mk8(pk2(acc[0], acc[1]), pk2(acc[2], acc[3]), pk2(acc[4], acc[5]), pk2(acc[6], acc[7])); \
      QB = mk8(pk2(acc[8], acc[9]), pk2(acc[10], acc[11]), pk2(acc[12], acc[13]), pk2(acc[14], acc[15])); }
    QABS(0, qa0, qa1) QABS(1, qa2, qa3) QABS(2, qa4, qa5) QABS(3, qa6, qa7)
#undef QABS
  }
  float m_run = -1e30f, l_run = 0.f;
  f32x16 o0 = zero16(), o1 = zero16(), o2 = zero16(), o3 = zero16();
  bf16x8 qf7 = mk8(0u, 0u, 0u, 0u);
  const bf16x8 kone = mk8(hh == 0 ? 0x3F80u : 0u, 0u, 0u, 0u);
  const int xk = ((l31 & 3) << 2) | ((l31 >> 2) & 3), x3 = (l31 >> 2) & 3;
  int va0, va1;
  {
    const int g = l31 >> 4, q = (l31 >> 2) & 3, pp = l31 & 3;
    const int rowb = (4 * hh + q) * 256 + 8 * (pp & 1) + (q << 6);
    va0 = rowb + (((2 * g + (pp >> 1)) ^ hh) << 4);
    va1 = rowb + 2048 + (((2 * g + (pp >> 1)) ^ (hh + 2)) << 4);
  }
  int stg = 0, stg2 = 2;
  for (int ti = 0; ti < 17; ++ti) {
    if (ti + 1 < 17) asm volatile("s_waitcnt vmcnt(5)" ::: "memory"); else asm volatile("s_waitcnt vmcnt(0)" ::: "memory");
    RAW_BARRIER()
    if (ti + 2 < 17) SDMA(ti + 2, stg2)
    const char* sp = lds + stg * 20480;
    f32x16 s0 = mfma32(kone, qf7, zero16()), s1 = s0;
#define QKL(S, QA) { const bf16x8 k0 = *(const bf16x8*)(sp + l31 * 256 + (((2 * (S) + hh) ^ xk) << 4)), k1 = *(const bf16x8*)(sp + (l31 + 32) * 256 + (((2 * (S) + hh) ^ xk) << 4)); \
      s0 = mfma32(k0, QA, s0); s1 = mfma32(k1, QA, s1); }
    QKL(0, qa0) QKL(1, qa1) QKL(2, qa2) QKL(3, qa3) QKL(4, qa4) QKL(5, qa5) QKL(6, qa6) QKL(7, qa7)
#undef QKL
#pragma unroll
    for (int kr = 0; kr < 2; ++kr) {
      const bf16x8 k0 = *(const bf16x8*)(sp + 16384 + l31 * 64 + (((2 * kr + hh) ^ x3) << 4)), k1 = *(const bf16x8*)(sp + 16384 + (l31 + 32) * 64 + (((2 * kr + hh) ^ x3) << 4));
      s0 = mfma32(k0, qf[4 + kr], s0); s1 = mfma32(k1, qf[4 + kr], s1);
    }
    float ps = 0.f;
    if (ti == 0) {
      float mx = s0[0];
#pragma unroll
      for (int r = 1; r < 16; ++r) mx = fmaxf(mx, s0[r]);
#pragma unroll
      for (int r = 0; r < 16; ++r) mx = fmaxf(mx, s1[r]);
      mx = fmaxf(mx, __shfl_xor(mx, 32));
      m_run = bflo(pk2(mx, 0.f));
#pragma unroll
      for (int r = 0; r < 16; ++r) { s0[r] -= m_run; s1[r] -= m_run; }
      qf7 = mk8(hh == 0 ? (pk2(-m_run, 0.f) & 0xffffu) : 0u, 0u, 0u, 0u);
    }
#pragma unroll
    for (int r = 0; r < 16; ++r) { s0[r] = __builtin_amdgcn_exp2f(s0[r]); ps += s0[r]; }
#pragma unroll
    for (int r = 0; r < 16; ++r) { s1[r] = __builtin_amdgcn_exp2f(s1[r]); ps += s1[r]; }
    l_run += ps;
    const bf16x8 pf0 = mk8(pk2(s0[0], s0[1]), pk2(s0[2], s0[3]), pk2(s0[4], s0[5]), pk2(s0[6], s0[7]));
    const bf16x8 pf1 = mk8(pk2(s0[8], s0[9]), pk2(s0[10], s0[11]), pk2(s0[12], s0[13]), pk2(s0[14], s0[15]));
    const bf16x8 pf2 = mk8(pk2(s1[0], s1[1]), pk2(s1[2], s1[3]), pk2(s1[4], s1[5]), pk2(s1[6], s1[7]));
    const bf16x8 pf3 = mk8(pk2(s1[8], s1[9]), pk2(s1[10], s1[11]), pk2(s1[12], s1[13]), pk2(s1[14], s1[15]));
#define PVT(S, CT, PF, OT) { const uint2 a_ = lds_tr16(sp + (va0 ^ ((CT) << 6)) + (S) * 4096), b_ = lds_tr16(sp + (va1 ^ ((CT) << 6)) + (S) * 4096); \
      OT = mfma32(mk8(a_.x, a_.y, b_.x, b_.y), PF, OT); }
#define PVL(S, PF) PVT(S, 0, PF, o0) PVT(S, 1, PF, o1) PVT(S, 2, PF, o2) PVT(S, 3, PF, o3)
    PVL(0, pf0) PVL(1, pf1) PVL(2, pf2) PVL(3, pf3)
#undef PVL
#undef PVT
    stg = stg == 2 ? 0 : stg + 1; stg2 = stg2 == 2 ? 0 : stg2 + 1;
  }
#undef SDMA
#undef GLDS16
  __syncthreads();
  const float lt = l_run + __shfl_xor(l_run, 32);
  const float inv = 1.f / lt;
  f32x16 e0 = zero16(), e1 = zero16();
  const bf16_t* wv = p.Wb_ukv + ((size_t)L * 1024 + head * 128 + 64 + l31) * 128 + 8 * hh;
#define OEXP(S, OT, RB) { const bf16x8 ob = mk8(pk2(OT[RB] * inv, OT[RB + 1] * inv), pk2(OT[RB + 2] * inv, OT[RB + 3] * inv), pk2(OT[RB + 4] * inv, OT[RB + 5] * inv), pk2(OT[RB + 6] * inv, OT[RB + 7] * inv)); \
    e0 = mfma32(*(const bf16x8*)(wv + 16 * (S)), ob, e0); e1 = mfma32(*(const bf16x8*)(wv + 32 * 128 + 16 * (S)), ob, e1); }
  OEXP(0, o0, 0) OEXP(1, o0, 8) OEXP(2, o1, 0) OEXP(3, o1, 8) OEXP(4, o2, 0) OEXP(5, o2, 8) OEXP(6, o3, 0) OEXP(7, o3, 8)
#undef OEXP
  {
    const bf16_t* gbp = p.zL + (size_t)myrow * ZL + ZL_GB + 64 * head;
    bf16_t* op = mix + (size_t)myrow * D + 256 + 64 * head;
#pragma unroll
    for (int G = 0; G < 4; ++G) {
      const int d = 8 * G + 4 * hh;
      const uint2 g0 = *(const uint2*)(gbp + d), g1 = *(const uint2*)(gbp + 32 + d);
      *(uint2*)(op + d) = pk4(e0[4 * G] * silu_(bflo(g0.x)), e0[4 * G + 1] * silu_(bfhi(g0.x)), e0[4 * G + 2] * silu_(bflo(g0.y)), e0[4 * G + 3] * silu_(bfhi(g0.y)));
      *(uint2*)(op + 32 + d) = pk4(e1[4 * G] * silu_(bflo(g1.x)), e1[4 * G + 1] * silu_(bfhi(g1.x)), e1[4 * G + 2] * silu_(bflo(g1.y)), e1[4 * G + 3] * silu_(bfhi(g1.y)));
    }
  }
}

DEV void conv_item(const Prm& p, int L, int item) {
  int tid = threadIdx.x; LAUNDER(tid);
  bf16_t* mix = p.zE;
  const int c0 = (tid & 31) * 8;
  float w0[8], w1[8], w2[8];
#pragma unroll
  for (int e = 0; e < 8; ++e) { w0[e] = p.conv_w[(L * 3 + 0) * 256 + c0 + e]; w1[e] = p.conv_w[(L * 3 + 1) * 256 + c0 + e]; w2[e] = p.conv_w[(L * 3 + 2) * 256 + c0 + e]; }
  for (int it = 0; it < 4; ++it) {
    const int R = item * 32 + it * 8 + (tid >> 5);
    if (R >= NT) continue;
    int q, T; const float* st; float* so;
    if (R < NPR) { const int s = R / PT; q = R - s * PT; T = PT; st = nullptr; so = p.conv_p + ((size_t)L * 4 + s) * 512; }
    else { const int b = (R - NPR) >> 6; q = (R - NPR) & 63; T = 64; st = p.state_conv + ((size_t)L * 32 + b) * 512; so = p.conv_s + ((size_t)L * 32 + b) * 512; }
    float u[3][8];
#pragma unroll
    for (int dlt = 0; dlt < 3; ++dlt) {
      const int t = q - 2 + dlt;
      if (t >= 0) {
        const bf16_t* zr = p.zL + (size_t)(R - 2 + dlt) * ZL;
        const uint4 xi = *(const uint4*)(zr + ZL_XIN + c0), cg = *(const uint4*)(zr + ZL_CG + c0);
        u[dlt][0] = bflo(xi.x) * bflo(cg.x); u[dlt][1] = bfhi(xi.x) * bfhi(cg.x); u[dlt][2] = bflo(xi.y) * bflo(cg.y); u[dlt][3] = bfhi(xi.y) * bfhi(cg.y);
        u[dlt][4] = bflo(xi.z) * bflo(cg.z); u[dlt][5] = bfhi(xi.z) * bfhi(cg.z); u[dlt][6] = bflo(xi.w) * bflo(cg.w); u[dlt][7] = bfhi(xi.w) * bfhi(cg.w);
      } else if (st) {
        const float* sr = st + (t + 2) * 256 + c0;
#pragma unroll
        for (int e = 0; e < 8; ++e) u[dlt][e] = sr[e];
      } else {
#pragma unroll
        for (int e = 0; e < 8; ++e) u[dlt][e] = 0.f;
      }
    }
    const bf16_t* zr = p.zL + (size_t)R * ZL;
    const uint4 bg = *(const uint4*)(zr + ZL_BG + c0), ga = *(const uint4*)(zr + ZL_GA + c0);
    const float bgf[8] = {bflo(bg.x), bfhi(bg.x), bflo(bg.y), bfhi(bg.y), bflo(bg.z), bfhi(bg.z), bflo(bg.w), bfhi(bg.w)};
    const float gaf[8] = {bflo(ga.x), bfhi(ga.x), bflo(ga.y), bfhi(ga.y), bflo(ga.z), bfhi(ga.z), bflo(ga.w), bfhi(ga.w)};
    float y[8];
#pragma unroll
    for (int e = 0; e < 8; ++e) y[e] = bgf[e] * (w0[e] * u[0][e] + w1[e] * u[1][e] + w2[e] * u[2][e]) * silu_(gaf[e]);
    uint4 o; o.x = pk2(y[0], y[1]); o.y = pk2(y[2], y[3]); o.z = pk2(y[4], y[5]); o.w = pk2(y[6], y[7]);
    *(uint4*)(mix + (size_t)R * D + c0) = o;
    if (q >= T - 2) {
      float* d = so + (q - (T - 2)) * 256 + c0;
#pragma unroll
      for (int e = 0; e < 8; ++e) d[e] = u[2][e];
    }
  }
}

DEV int kperm_addr(int m, int kin) {
  const int mt = m >> 4, ml = m & 15, s = kin >> 5, q = (kin >> 4) & 1, g = (kin >> 2) & 3, e = kin & 3;
  return (((mt * 2 + s) * 64 + ml + 16 * g) * 8) + 4 * q + e;
}
DEV int clay_addr(int x, int v) {
  const int xt = x >> 4, g = (x >> 2) & 3, rr = x & 3, vt = v >> 4, l16 = v & 15;
  return ((xt * 4 + vt) * 64 + 16 * g + l16) * 4 + rr;
}
DEV void mm64(const bf16_t* first, const bf16_t* second, int l31, int hh, f32x16 (&acc)[2][2]) {
#pragma unroll
  for (int ks = 0; ks < 4; ++ks) {
    const bf16x8 f0 = *(const bf16x8*)(first + l31 * 72 + ks * 16 + hh * 8), f1 = *(const bf16x8*)(first + (32 + l31) * 72 + ks * 16 + hh * 8);
    const bf16x8 s0 = *(const bf16x8*)(second + l31 * 72 + ks * 16 + hh * 8), s1 = *(const bf16x8*)(second + (32 + l31) * 72 + ks * 16 + hh * 8);
    acc[0][0] = mfma32(f0, s0, acc[0][0]); acc[0][1] = mfma32(f0, s1, acc[0][1]);
    acc[1][0] = mfma32(f1, s0, acc[1][0]); acc[1][1] = mfma32(f1, s1, acc[1][1]);
  }
}
DEV void mm64x32(const bf16_t* first, const bf16_t* second_rows, int l31, int hh, f32x16 (&acc)[2]) {
#pragma unroll
  for (int ks = 0; ks < 4; ++ks) {
    const bf16x8 f0 = *(const bf16x8*)(first + l31 * 72 + ks * 16 + hh * 8), f1 = *(const bf16x8*)(first + (32 + l31) * 72 + ks * 16 + hh * 8);
    const bf16x8 s0 = *(const bf16x8*)(second_rows + l31 * 72 + ks * 16 + hh * 8);
    acc[0] = mfma32(f0, s0, acc[0]); acc[1] = mfma32(f1, s0, acc[1]);
  }
}

DEV void mmq(const bf16_t* first_rows, const bf16_t* second_rows, int l31, int hh, f32x16& acc) {
#pragma unroll
  for (int ks = 0; ks < 4; ++ks) {
    const bf16x8 f0 = *(const bf16x8*)(first_rows + l31 * 72 + ks * 16 + hh * 8);
    const bf16x8 s0 = *(const bf16x8*)(second_rows + l31 * 72 + ks * 16 + hh * 8);
    acc = mfma32(f0, s0, acc);
  }
}
enum { SH_FULL = 0, SH_UP = 1, SH_LO = 2 };
template <int SH> DEV constexpr bool tile_nz(int tx, int ty) { return SH == SH_FULL || (SH == SH_UP ? tx <= ty : tx >= ty); }
struct Acc64 { f32x16 t[2][2]; };
struct Frag64 { bf16x8 f[4][2]; };
template <int SS> DEV bf16x8 pack8(const f32x16& v) {
  return mk8(pk2(v[8 * SS], v[8 * SS + 1]), pk2(v[8 * SS + 2], v[8 * SS + 3]), pk2(v[8 * SS + 4], v[8 * SS + 5]), pk2(v[8 * SS + 6], v[8 * SS + 7]));
}
template <int SH> DEV void to_frag(const Acc64& X, Frag64& F) {
#pragma unroll
  for (int t = 0; t < 2; ++t) {
    if (tile_nz<SH>(0, t)) { F.f[0][t] = pack8<0>(X.t[0][t]); F.f[1][t] = pack8<1>(X.t[0][t]); }
    if (tile_nz<SH>(1, t)) { F.f[2][t] = pack8<0>(X.t[1][t]); F.f[3][t] = pack8<1>(X.t[1][t]); }
  }
}
template <int SH> DEV void zero_acc(Acc64& X) {
#pragma unroll
  for (int a = 0; a < 2; ++a)
#pragma unroll
    for (int b = 0; b < 2; ++b) if (tile_nz<SH>(a, b)) X.t[a][b] = zero16();
}
template <int SHA, int SHB> DEV void prod_ff(const Frag64& A, const Frag64& B, Acc64& D) {
#pragma unroll
  for (int tm = 0; tm < 2; ++tm)
#pragma unroll
    for (int tn = 0; tn < 2; ++tn)
#pragma unroll
      for (int s = 0; s < 4; ++s)
        if (tile_nz<SHA>(s >> 1, tm) && tile_nz<SHB>(s >> 1, tn)) D.t[tm][tn] = mfma32(A.f[s][tm], B.f[s][tn], D.t[tm][tn]);
}
template <int SHA, int SHB, int SHD> DEV void prod_ff_frag(const Frag64& A, const Frag64& B, Frag64& Fo) {
#pragma unroll
  for (int tm = 0; tm < 2; ++tm)
#pragma unroll
    for (int tn = 0; tn < 2; ++tn)
      if (tile_nz<SHD>(tm, tn)) {
        f32x16 acc = zero16();
#pragma unroll
        for (int s = 0; s < 4; ++s)
          if (tile_nz<SHA>(s >> 1, tm) && tile_nz<SHB>(s >> 1, tn)) acc = mfma32(A.f[s][tm], B.f[s][tn], acc);
        Fo.f[2 * tm][tn] = pack8<0>(acc); Fo.f[2 * tm + 1][tn] = pack8<1>(acc);
      }
}
DEV bf16x8 nat_frag(const bf16_t* S, int row, int s, int hh) { return *(const bf16x8*)(S + row * 72 + 16 * s + 8 * hh); }
DEV bf16x8 perm_frag(const bf16_t* S, int row, int s, int hh) {
  const uint2 a = *(const uint2*)(S + row * 72 + 16 * s + 4 * hh), b = *(const uint2*)(S + row * 72 + 16 * s + 8 + 4 * hh);
  return mk8(a.x, a.y, b.x, b.y);
}
template <int SH, int MODE> DEV void gram(const bf16_t* F, const bf16_t* G, int l31, int hh, Acc64& D) {
  zero_acc<SH>(D);
#pragma unroll
  for (int s = 0; s < 4; ++s) {
    bf16x8 ff[2], gg[2];
#pragma unroll
    for (int t = 0; t < 2; ++t) { ff[t] = nat_frag(F, 32 * t + l31, s, hh); gg[t] = nat_frag(G, 32 * t + l31, s, hh); }
#pragma unroll
    for (int tx = 0; tx < 2; ++tx)
#pragma unroll
      for (int ty = 0; ty < 2; ++ty) if (tile_nz<SH>(tx, ty)) D.t[tx][ty] = mfma32(ff[tx], gg[ty], D.t[tx][ty]);
  }
#pragma unroll
  for (int t = 0; t < 2; ++t)
#pragma unroll
    for (int r = 0; r < 16; ++r) {
      const int x = (r & 3) + 8 * (r >> 2) + 4 * hh, y = l31;
      const bool keep = MODE == 0 ? (x < y) : (MODE == 1 ? (y < x) : (x <= y));
      if (!keep) D.t[t][t][r] = 0.f;
    }
}
template <int SHA> DEV void prod_fm_frag(const Frag64& A, const bf16_t* Mem, int l31, int hh, Frag64& Fo) {
#pragma unroll
  for (int tm = 0; tm < 2; ++tm)
#pragma unroll
    for (int tn = 0; tn < 2; ++tn) {
      f32x16 acc = zero16();
#pragma unroll
      for (int s = 0; s < 4; ++s) if (tile_nz<SHA>(s >> 1, tm)) acc = mfma32(A.f[s][tm], perm_frag(Mem, 32 * tn + l31, s, hh), acc);
      Fo.f[2 * tm][tn] = pack8<0>(acc); Fo.f[2 * tm + 1][tn] = pack8<1>(acc);
    }
}
template <int SHA> DEV void prod_fm(const Frag64& A, const bf16_t* Mem, int l31, int hh, Acc64& D) {
#pragma unroll
  for (int s = 0; s < 4; ++s) {
    bf16x8 mm[2];
#pragma unroll
    for (int t = 0; t < 2; ++t) mm[t] = perm_frag(Mem, 32 * t + l31, s, hh);
#pragma unroll
    for (int tm = 0; tm < 2; ++tm)
#pragma unroll
      for (int tn = 0; tn < 2; ++tn) if (tile_nz<SHA>(s >> 1, tm)) D.t[tm][tn] = mfma32(A.f[s][tm], mm[tn], D.t[tm][tn]);
  }
}
DEV void r1_item(const Prm& p, int L, int idx, char* lds) {
  int tid = threadIdx.x; LAUNDER(tid);
  const int w = __builtin_amdgcn_readfirstlane(tid >> 6);
  int lane = tid & 63, l31 = lane & 31, hh = lane >> 5;
  const int cw = w & 1, tw = w >> 1;
  bf16_t* S0 = (bf16_t*)lds;
  bf16_t* S1 = S0 + 4608; bf16_t* S2 = S1 + 4608; bf16_t* S3 = S2 + 4608; bf16_t* S4 = S3 + 4608; bf16_t* S5 = S4 + 4608; bf16_t* S6 = S5 + 4608; bf16_t* S7 = S6 + 4608;
  float* misc = (float*)(S7 + 4608);
  float* Ef = (float*)S4;
  bool prompt; int st, c, hd;
  if (idx < NRW_P) { prompt = true; st = idx / 260; const int rem = idx - st * 260; c = rem >> 2; hd = rem & 3; }
  else { prompt = false; const int j = idx - NRW_P; st = j >> 2; hd = j & 3; c = 0; }
  char* rwp = p.rw + (size_t)idx * RW_BYTES;
  const float* mu = p.shift_mu + L * 896;
  const int i1 = tid >> 2, m0 = (tid & 3) * 16;
  int R1; bool valid1, hasprev1;
  if (prompt) { const int pp = 64 * c - 48 + i1; valid1 = pp >= 0; R1 = st * PT + (valid1 ? pp : 0); hasprev1 = pp >= 1; }
  else { R1 = NPR + 64 * st + i1; valid1 = true; hasprev1 = i1 >= 1; }
  const bf16_t* zr1 = p.zE + (size_t)R1 * ZE + ZE_ZC;
  const int ti0 = 32 * tw + l31;
  int R; bool valid, hasprev;
  if (prompt) { const int pp = 64 * c - 48 + ti0; valid = pp >= 0; R = st * PT + (valid ? pp : 0); hasprev = pp >= 1; }
  else { R = NPR + 64 * st + ti0; valid = true; hasprev = ti0 >= 1; }
  const bf16_t* zr = p.zE + (size_t)R * ZE + ZE_ZC;
  const int chb = 64 * hd + 32 * cw + 4 * hh;
  uint4 la[2][2], lap[2][2]; uint2 lb[3][4], lbp[3][4];
  {
    const bf16_t* sh0 = p.zE + (size_t)(NT + (prompt ? 32 : st)) * ZE + ZE_ZC;
    const bf16_t* zp1 = hasprev1 ? zr1 - ZE : sh0;
    const bf16_t* zp = hasprev ? zr - ZE : sh0;
#pragma unroll
    for (int part = 0; part < 2; ++part)
#pragma unroll
      for (int h8 = 0; h8 < 2; ++h8) { const int col = 768 + 64 * part + m0 + 8 * h8; la[part][h8] = *(const uint4*)(zr1 + col); lap[part][h8] = *(const uint4*)(zp1 + col); }
#pragma unroll
    for (int part = 0; part < 3; ++part)
#pragma unroll
      for (int G = 0; G < 4; ++G) { const int col = 256 * part + chb + 8 * G; lb[part][G] = *(const uint2*)(zr + col); lbp[part][G] = *(const uint2*)(zp + col); }
    const bf16_t* dsrc = p.dw2T + ((size_t)L * 256 + hd * 64 + i1) * 64 + m0;
    const bf16_t* isrc = p.ia2T + ((size_t)L * 256 + hd * 64 + i1) * 64 + m0;
    const uint4 d0 = *(const uint4*)dsrc, d1 = *(const uint4*)(dsrc + 8), e0 = *(const uint4*)isrc, e1 = *(const uint4*)(isrc + 8);
    __builtin_amdgcn_sched_barrier(0);
    *(uint4*)(S2 + i1 * 72 + m0) = d0; *(uint4*)(S2 + i1 * 72 + m0 + 8) = d1;
    *(uint4*)(S3 + i1 * 72 + m0) = e0; *(uint4*)(S3 + i1 * 72 + m0 + 8) = e1;
  }
  {
    float* prm = misc + 384;
#pragma unroll
    for (int q2 = 0; q2 < 2; ++q2) {
      const int ix = tid + 256 * q2, wh = ix >> 6, chp = ix & 63;
      const float* sp = wh == 0 ? p.decay_w0 : wh == 1 ? p.iclr_a0 : wh == 2 ? p.key_kk : wh == 3 ? p.key_ka : wh == 4 ? p.bonus_rk : nullptr;
      prm[ix] = sp ? sp[L * 256 + hd * 64 + chp] : mu[256 * (wh - 5) + 64 * hd + chp];
    }
  }
#pragma unroll
  for (int part = 0; part < 2; ++part) {
#pragma unroll
    for (int h8 = 0; h8 < 2; ++h8) {
      const int col = 768 + 64 * part + m0 + 8 * h8;
      const uint4 u = la[part][h8], v = lap[part][h8];
      const float cur[8] = {bflo(u.x), bfhi(u.x), bflo(u.y), bfhi(u.y), bflo(u.z), bfhi(u.z), bflo(u.w), bfhi(u.w)};
      float prv[8] = {bflo(v.x), bfhi(v.x), bflo(v.y), bfhi(v.y), bflo(v.z), bfhi(v.z), bflo(v.w), bfhi(v.w)};
      float o[8];
#pragma unroll
      for (int e = 0; e < 8; ++e) { float z = cur[e] + (prv[e] - cur[e]) * mu[col + e]; if (!valid1) z = 0.f; o[e] = part == 0 ? (1.f - 2.f / (__expf(2.f * z) + 1.f)) : z; }
      uint4 a; a.x = pk2(o[0], o[1]); a.y = pk2(o[2], o[3]); a.z = pk2(o[4], o[5]); a.w = pk2(o[6], o[7]);
      *(uint4*)((part == 0 ? S0 : S1) + i1 * 72 + m0 + 8 * h8) = a;
    }
  }
  __syncthreads();
  f32x16 accw = zero16(), acca = zero16();
#pragma unroll
  for (int ks = 0; ks < 4; ++ks) {
    const bf16x8 fw = *(const bf16x8*)(S2 + (32 * cw + l31) * 72 + ks * 16 + hh * 8), fa = *(const bf16x8*)(S3 + (32 * cw + l31) * 72 + ks * 16 + hh * 8);
    const bf16x8 sw = *(const bf16x8*)(S0 + (32 * tw + l31) * 72 + ks * 16 + hh * 8), sa = *(const bf16x8*)(S1 + (32 * tw + l31) * 72 + ks * 16 + hh * 8);
    accw = mfma32(fw, sw, accw); acca = mfma32(fa, sa, acca);
  }
  int ti = ti0;
  float e_[16];
  float ssq = 0.f;
#pragma unroll
  for (int G = 0; G < 4; ++G) {
    const int ch = chb + 8 * G, col = 256 + ch;
    const uint2 u = lb[1][G], v = lbp[1][G];
    const float cur[4] = {bflo(u.x), bfhi(u.x), bflo(u.y), bfhi(u.y)};
    float prv[4] = {bflo(v.x), bfhi(v.x), bflo(v.y), bfhi(v.y)};
    const int chq = 32 * cw + 8 * G + 4 * hh;
    const float4 kkw = *(const float4*)(misc + 384 + 128 + chq), w0 = *(const float4*)(misc + 384 + chq), m4 = *(const float4*)(misc + 384 + 384 + chq);
    const float kkv[4] = {kkw.x, kkw.y, kkw.z, kkw.w}, w0v[4] = {w0.x, w0.y, w0.z, w0.w}, muv[4] = {m4.x, m4.y, m4.z, m4.w};
#pragma unroll
    for (int e = 0; e < 4; ++e) {
      float z = cur[e] + (prv[e] - cur[e]) * muv[e];
      if (!valid) z = 0.f;
      const float kkr = z * kkv[e];
      ssq += kkr * kkr;
      e_[4 * G + e] = valid ? 0.6065306597126334f * sigmoid_(w0v[e] + accw[4 * G + e]) : 0.f;
    }
  }
  ssq += __shfl_xor(ssq, 32);
  if (hh == 0) misc[(cw * 64 + ti) * 2] = ssq;
#pragma unroll
  for (int G = 0; G < 4; ++G)
#pragma unroll
    for (int e = 0; e < 4; ++e) Ef[ti * 65 + 32 * cw + 8 * G + 4 * hh + e] = e_[4 * G + e];
  __syncthreads();
  {
    const int ch = tid & 63, seg = tid >> 6;
    float run = 0.f;
#pragma unroll
    for (int t = 0; t < 16; ++t) { run += Ef[(16 * seg + t) * 65 + ch]; Ef[(16 * seg + t) * 65 + ch] = run; }
    __syncthreads();
    float off = 0.f;
    for (int s2 = 0; s2 < seg; ++s2) off += Ef[(16 * s2 + 15) * 65 + ch];
    __syncthreads();
#pragma unroll
    for (int t = 0; t < 16; ++t) Ef[(16 * seg + t) * 65 + ch] += off;
    if (seg == 3) { const float cC = Ef[63 * 65 + ch]; misc[320 + ch] = cC; misc[256 + ch] = __expf(-cC); }
    __syncthreads();
  }
  float cc_[16];
#pragma unroll
  for (int G = 0; G < 4; ++G)
#pragma unroll
    for (int e = 0; e < 4; ++e) cc_[4 * G + e] = Ef[ti * 65 + 32 * cw + 8 * G + 4 * hh + e];
  const float kinv = 1.f / fmaxf(sqrtf(misc[ti * 2] + misc[(64 + ti) * 2]), 1e-12f);
  __syncthreads();
  LAUNDER(ti); LAUNDER(hh);
  uint2 vpk[4];
  float rk = 0.f;
#pragma unroll
  for (int G = 0; G < 4; ++G) {
    const int ch = chb + 8 * G, chl = 32 * cw + 8 * G + 4 * hh;
    float zs[3][4];
#pragma unroll
    for (int part = 0; part < 3; ++part) {
      const int col = 256 * part + ch;
      const uint2 u = lb[part][G], v = lbp[part][G];
      const float cur[4] = {bflo(u.x), bfhi(u.x), bflo(u.y), bfhi(u.y)};
      float prv[4] = {bflo(v.x), bfhi(v.x), bflo(v.y), bfhi(v.y)};
      const float4 m4 = *(const float4*)(misc + 384 + 320 + 64 * part + chl);
      const float muv[4] = {m4.x, m4.y, m4.z, m4.w};
#pragma unroll
      for (int e = 0; e < 4; ++e) { float z = cur[e] + (prv[e] - cur[e]) * muv[e]; zs[part][e] = valid ? z : 0.f; }
    }
    vpk[G] = pk4(zs[2][0], zs[2][1], zs[2][2], zs[2][3]);
    const float4 a04 = *(const float4*)(misc + 384 + 64 + chl), kk4 = *(const float4*)(misc + 384 + 128 + chl), ka4 = *(const float4*)(misc + 384 + 192 + chl), bo4 = *(const float4*)(misc + 384 + 256 + chl);
    const float a0v[4] = {a04.x, a04.y, a04.z, a04.w}, kkv[4] = {kk4.x, kk4.y, kk4.z, kk4.w}, kav[4] = {ka4.x, ka4.y, ka4.z, ka4.w}, bov[4] = {bo4.x, bo4.y, bo4.z, bo4.w};
    float at[4], rt[4], bt[4], kt[4], bh[4], kh[4];
#pragma unroll
    for (int e = 0; e < 4; ++e) {
      const int r = 4 * G + e;
      const float al = sigmoid_(a0v[e] + acca[r]);
      const float kk = zs[1][e] * kkv[e] * kinv;
      const float km = zs[1][e] * (1.f + (al - 1.f) * kav[e]);
      rk += zs[0][e] * km * bov[e];
      const float gC = misc[256 + chl + e];
      const float cprev = cc_[r] - e_[r];
      const float ea = __expf(-cprev), er = __expf(-cc_[r]), ek = __builtin_amdgcn_rcpf(er), eh = ek * gC;
      const float b = kk * al;
      at[e] = -kk * ea; rt[e] = zs[0][e] * er; bt[e] = b * ek; kt[e] = km * ek; bh[e] = b * eh; kh[e] = km * eh;
    }
    *(uint2*)(S0 + ti * 72 + chl) = pk4(at[0], at[1], at[2], at[3]);
    *(uint2*)(S1 + ti * 72 + chl) = pk4(rt[0], rt[1], rt[2], rt[3]);
    *(uint2*)(S2 + ti * 72 + chl) = pk4(bt[0], bt[1], bt[2], bt[3]);
    *(uint2*)(S3 + ti * 72 + chl) = pk4(kt[0], kt[1], kt[2], kt[3]);
#pragma unroll
    for (int e = 0; e < 4; ++e) { S4[(chl + e) * 72 + ti] = f2bf(at[e]); S5[(chl + e) * 72 + ti] = f2bf(bh[e]); S6[(chl + e) * 72 + ti] = f2bf(kh[e]); S7[(chl + e) * 72 + ti] = f2bf(zs[2][e]); }
    *(uint2*)(rwp + 40960 + (ti * 64 + chl) * 2) = vpk[G];
  }
  rk += __shfl_xor(rk, 32);
  if (hh == 0) misc[(cw * 64 + ti) * 2 + 1] = rk;
  __syncthreads();
  if (valid && cw == 0 && hh == 0) p.rkb[(size_t)R * 4 + hd] = misc[ti * 2 + 1] + misc[(64 + ti) * 2 + 1];
  LAUNDER(l31); LAUNDER(hh); LAUNDER(lane);
  {
    Acc64 T;
    {
      Acc64 Mx, MTx;
      gram<SH_UP, 0>(S2, S0, l31, hh, Mx);
      gram<SH_LO, 1>(S0, S2, l31, hh, MTx);
      Frag64 fM, fMT, fT;
      to_frag<SH_UP>(Mx, fM); to_frag<SH_LO>(MTx, fMT);
      __builtin_amdgcn_sched_barrier(0);
      T = Mx;
#pragma unroll
      for (int t = 0; t < 2; ++t)
#pragma unroll
        for (int r = 0; r < 16; ++r) if ((r & 3) + 8 * (r >> 2) + 4 * hh == l31) T.t[t][t][r] += 1.f;
      T.t[1][0] = zero16();
      for (int r = 0; r < 5; ++r) {
        Frag64 fM2, fMT2;
        prod_ff_frag<SH_LO, SH_UP, SH_UP>(fMT, fM, fM2);
        prod_ff_frag<SH_UP, SH_LO, SH_LO>(fM, fMT, fMT2);
#pragma unroll
        for (int s = 0; s < 4; ++s)
#pragma unroll
          for (int t = 0; t < 2; ++t) { if (tile_nz<SH_UP>(s >> 1, t)) fM.f[s][t] = fM2.f[s][t]; if (tile_nz<SH_LO>(s >> 1, t)) fMT.f[s][t] = fMT2.f[s][t]; }
        to_frag<SH_UP>(T, fT);
        prod_ff<SH_LO, SH_UP>(fMT, fT, T);
      }
    }
    Frag64 fT;
    to_frag<SH_UP>(T, fT);
    __builtin_amdgcn_sched_barrier(0);
    if (w < 2) {
      Frag64 fW;
      prod_fm_frag<SH_UP>(fT, S4, l31, hh, fW);
      __builtin_amdgcn_sched_barrier(0);
      Acc64 O; zero_acc<SH_FULL>(O);
      if (w == 0) {
        prod_fm<SH_FULL>(fW, S5, l31, hh, O);
#pragma unroll
        for (int tx = 0; tx < 2; ++tx)
#pragma unroll
          for (int ty = 0; ty < 2; ++ty)
#pragma unroll
            for (int G = 0; G < 4; ++G) {
              const int x0 = 32 * tx + 8 * G + 4 * hh, y = 32 * ty + l31;
              float v[4];
#pragma unroll
              for (int e = 0; e < 4; ++e) { v[e] = O.t[tx][ty][4 * G + e]; if (x0 + e == y) v[e] += misc[256 + y]; }
              *(uint2*)(rwp + 0 + kperm_addr(y, x0) * 2) = pk4(v[0], v[1], v[2], v[3]);
            }
      } else {
        Acc64 Nb; gram<SH_UP, 2>(S2, S1, l31, hh, Nb);
        Frag64 fN; to_frag<SH_UP>(Nb, fN);
        prod_ff<SH_FULL, SH_UP>(fW, fN, O);
#pragma unroll
        for (int tx = 0; tx < 2; ++tx)
#pragma unroll
          for (int ty = 0; ty < 2; ++ty)
#pragma unroll
            for (int G = 0; G < 4; ++G) {
              const int x0 = 32 * tx + 8 * G + 4 * hh, y = 32 * ty + l31;
              const uint2 rr = *(const uint2*)(S1 + y * 72 + x0);
              *(uint2*)(rwp + 8192 + kperm_addr(y, x0) * 2) = pk4(O.t[tx][ty][4 * G] + bflo(rr.x), O.t[tx][ty][4 * G + 1] + bfhi(rr.x), O.t[tx][ty][4 * G + 2] + bflo(rr.y), O.t[tx][ty][4 * G + 3] + bfhi(rr.y));
            }
      }
    } else {
      Frag64 fX;
      {
        Acc64 Nk; gram<SH_LO, 1>(S0, S3, l31, hh, Nk);
        Frag64 fNk; to_frag<SH_LO>(Nk, fNk);
        prod_ff_frag<SH_UP, SH_LO, SH_LO>(fT, fNk, fX);
      }
      __builtin_amdgcn_sched_barrier(0);
      if (w == 2) {
        Acc64 Z; zero_acc<SH_FULL>(Z);
        prod_fm<SH_LO>(fX, S5, l31, hh, Z);
#pragma unroll
        for (int tx = 0; tx < 2; ++tx)
#pragma unroll
          for (int ty = 0; ty < 2; ++ty)
#pragma unroll
            for (int G = 0; G < 4; ++G) {
              const int x0 = 32 * tx + 8 * G + 4 * hh, y = 32 * ty + l31;
              const uint2 kk2 = *(const uint2*)(S6 + y * 72 + x0);
              Z.t[tx][ty][4 * G] += bflo(kk2.x); Z.t[tx][ty][4 * G + 1] += bfhi(kk2.x); Z.t[tx][ty][4 * G + 2] += bflo(kk2.y); Z.t[tx][ty][4 * G + 3] += bfhi(kk2.y);
            }
        Frag64 fZ; to_frag<SH_FULL>(Z, fZ);
        __builtin_amdgcn_sched_barrier(0);
        Acc64 Q; zero_acc<SH_FULL>(Q);
        prod_fm<SH_FULL>(fZ, S7, l31, hh, Q);
#pragma unroll
        for (int tx = 0; tx < 2; ++tx)
#pragma unroll
          for (int ty = 0; ty < 2; ++ty)
#pragma unroll
            for (int G = 0; G < 4; ++G)
              *(uint2*)(rwp + 16384 + clay_addr(32 * tx + 8 * G + 4 * hh, 32 * ty + l31) * 2) = pk4(Q.t[tx][ty][4 * G], Q.t[tx][ty][4 * G + 1], Q.t[tx][ty][4 * G + 2], Q.t[tx][ty][4 * G + 3]);
      } else {
        Acc64 H; gram<SH_UP, 2>(S3, S1, l31, hh, H);
        {
          Acc64 Nb; gram<SH_UP, 2>(S2, S1, l31, hh, Nb);
          Frag64 fN; to_frag<SH_UP>(Nb, fN);
          prod_ff<SH_LO, SH_UP>(fX, fN, H);
        }
        Frag64 fH; to_frag<SH_UP>(H, fH);
        __builtin_amdgcn_sched_barrier(0);
        Acc64 Y; zero_acc<SH_FULL>(Y);
        prod_fm<SH_UP>(fH, S7, l31, hh, Y);
#pragma unroll
        for (int tx = 0; tx < 2; ++tx)
#pragma unroll
          for (int ty = 0; ty < 2; ++ty)
#pragma unroll
            for (int G = 0; G < 4; ++G)
              *(uint2*)(rwp + 24576 + clay_addr(32 * tx + 8 * G + 4 * hh, 32 * ty + l31) * 2) = pk4(Y.t[tx][ty][4 * G], Y.t[tx][ty][4 * G + 1], Y.t[tx][ty][4 * G + 2], Y.t[tx][ty][4 * G + 3]);
      }
    }
  }
  __syncthreads();
}

DEV void r2_wave(const Prm& p, int L, int wi, int lane) {
  bool prompt; int st, hd, vt;
  if (wi < 64) { prompt = true; st = wi >> 4; hd = (wi >> 2) & 3; vt = wi & 3; }
  else { prompt = false; const int j = wi - 64; st = j >> 4; hd = (j >> 2) & 3; vt = j & 3; }
  const int nch = prompt ? 65 : 1;
  const int idx0 = prompt ? st * 260 + hd : NRW_P + st * 4 + hd;
  const int l16 = lane & 15, g = lane >> 4;
  f32x4 acc[4];
  float* outp;
  if (prompt) {
#pragma unroll
    for (int mt = 0; mt < 4; ++mt) acc[mt] = (f32x4){0.f, 0.f, 0.f, 0.f};
    outp = p.wkv_p + ((((size_t)L * 4 + st) * 4 + hd) * 64 + 16 * vt + l16) * 64;
  } else {
    const float* sp = p.state_wkv + ((((size_t)L * 32 + st) * 4 + hd) * 64 + 16 * vt + l16) * 64;
#pragma unroll
    for (int mt = 0; mt < 4; ++mt) acc[mt] = *(const f32x4*)(sp + 16 * mt + 4 * g);
    outp = p.wkv_s + ((((size_t)L * 32 + st) * 4 + hd) * 64 + 16 * vt + l16) * 64;
  }
  const char* rw0 = p.rw + (size_t)idx0 * RW_BYTES;
  uint4 pf[3][8]; uint2 qv[3][4];
#pragma unroll
  for (int k = 0; k < 3; ++k) {
    const int cc = k < nch ? k : nch - 1;
    const char* src = rw0 + (size_t)cc * 4 * RW_BYTES;
#pragma unroll
    for (int i = 0; i < 8; ++i) pf[k][i] = *(const uint4*)(src + (i * 64 + lane) * 16);
#pragma unroll
    for (int mt = 0; mt < 4; ++mt) qv[k][mt] = *(const uint2*)(src + 16384 + ((mt * 4 + vt) * 64 + lane) * 8);
  }
  for (int c0 = 0; c0 < nch; c0 += 3) {
#pragma unroll
    for (int k = 0; k < 3; ++k) {
      const int c = c0 + k;
      if (c < nch) {
        char* cur = (char*)rw0 + (size_t)c * 4 * RW_BYTES;
        uint4 bfr[2];
#pragma unroll
        for (int s = 0; s < 2; ++s) {
          bfr[s].x = pk2(acc[2 * s][0], acc[2 * s][1]); bfr[s].y = pk2(acc[2 * s][2], acc[2 * s][3]);
          bfr[s].z = pk2(acc[2 * s + 1][0], acc[2 * s + 1][1]); bfr[s].w = pk2(acc[2 * s + 1][2], acc[2 * s + 1][3]);
          *(uint4*)(cur + 32768 + ((vt * 2 + s) * 64 + lane) * 16) = bfr[s];
        }
#pragma unroll
        for (int mt = 0; mt < 4; ++mt) {
          f32x4 a = {bflo(qv[k][mt].x), bfhi(qv[k][mt].x), bflo(qv[k][mt].y), bfhi(qv[k][mt].y)};
#pragma unroll
          for (int s = 0; s < 2; ++s) a = mfma16(mk8(pf[k][mt * 2 + s]), mk8(bfr[s]), a);
          acc[mt] = a;
        }
        const int cn = c + 3 < nch ? c + 3 : nch - 1;
        const char* src = rw0 + (size_t)cn * 4 * RW_BYTES;
#pragma unroll
        for (int i = 0; i < 8; ++i) pf[k][i] = *(const uint4*)(src + (i * 64 + lane) * 16);
#pragma unroll
        for (int mt = 0; mt < 4; ++mt) qv[k][mt] = *(const uint2*)(src + 16384 + ((mt * 4 + vt) * 64 + lane) * 8);
      }
    }
  }
#pragma unroll
  for (int mt = 0; mt < 4; ++mt) *(f32x4*)(outp + 16 * mt + 4 * g) = acc[mt];
}

DEV void r3_wave(const Prm& p, int L, int idx, int lane, float* Y  ) {
  LAUNDER(lane);
  bool prompt; int st, c, hd;
  if (idx < NRW_P) { prompt = true; st = idx / 260; const int rem = idx - st * 260; c = rem >> 2; hd = rem & 3; }
  else { prompt = false; const int j = idx - NRW_P; st = j >> 2; hd = j & 3; c = 0; }
  const char* rwp = p.rw + (size_t)idx * RW_BYTES;
  const int l16 = lane & 15, g = lane >> 4;
  bf16_t* mix = p.zE;
  uint4 sf[4][2];
#pragma unroll
  for (int vt = 0; vt < 4; ++vt)
#pragma unroll
    for (int s = 0; s < 2; ++s) sf[vt][s] = *(const uint4*)(rwp + 32768 + ((vt * 2 + s) * 64 + lane) * 16);
  const float lw[4] = {p.lnx_w[L * 256 + hd * 64 + l16], p.lnx_w[L * 256 + hd * 64 + 16 + l16], p.lnx_w[L * 256 + hd * 64 + 32 + l16], p.lnx_w[L * 256 + hd * 64 + 48 + l16]};
  const float lb[4] = {p.lnx_b[L * 256 + hd * 64 + l16], p.lnx_b[L * 256 + hd * 64 + 16 + l16], p.lnx_b[L * 256 + hd * 64 + 32 + l16], p.lnx_b[L * 256 + hd * 64 + 48 + l16]};
#pragma unroll
  for (int it = 0; it < 4; ++it) {
    f32x4 y[4];
    const uint4 gf0 = *(const uint4*)(rwp + 8192 + ((it * 2 + 0) * 64 + lane) * 16), gf1 = *(const uint4*)(rwp + 8192 + ((it * 2 + 1) * 64 + lane) * 16);
#pragma unroll
    for (int vt = 0; vt < 4; ++vt) {
      const uint2 q = *(const uint2*)(rwp + 24576 + ((it * 4 + vt) * 64 + lane) * 8);
      f32x4 a = {bflo(q.x), bfhi(q.x), bflo(q.y), bfhi(q.y)};
      a = mfma16(mk8(gf0), mk8(sf[vt][0]), a);
      a = mfma16(mk8(gf1), mk8(sf[vt][1]), a);
      y[vt] = a;
    }
    __builtin_amdgcn_sched_barrier(0);
#pragma unroll
    for (int rr = 0; rr < 4; ++rr) {
      const int i = 16 * it + 4 * g + rr;
      float s1 = y[0][rr] + y[1][rr] + y[2][rr] + y[3][rr];
      s1 += __shfl_xor(s1, 1); s1 += __shfl_xor(s1, 2); s1 += __shfl_xor(s1, 4); s1 += __shfl_xor(s1, 8);
      const float mean = s1 * (1.f / 64.f);
      const float d0 = y[0][rr] - mean, d1 = y[1][rr] - mean, d2 = y[2][rr] - mean, d3 = y[3][rr] - mean;
      float s2 = d0 * d0 + d1 * d1 + d2 * d2 + d3 * d3;
      s2 += __shfl_xor(s2, 1); s2 += __shfl_xor(s2, 2); s2 += __shfl_xor(s2, 4); s2 += __shfl_xor(s2, 8);
      const float rstd = rsqrtf(s2 * (1.f / 64.f) + GN_EPS);
      Y[i * 68 + l16] = d0 * rstd * lw[0] + lb[0];
      Y[i * 68 + 16 + l16] = d1 * rstd * lw[1] + lb[1];
      Y[i * 68 + 32 + l16] = d2 * rstd * lw[2] + lb[2];
      Y[i * 68 + 48 + l16] = d3 * rstd * lw[3] + lb[3];
    }
  }
  asm volatile("s_waitcnt lgkmcnt(0)" ::: "memory");
  __builtin_amdgcn_wave_barrier();
  const int vc = (lane & 7) * 8;
#pragma unroll
  for (int ps = 0; ps < 8; ++ps) {
    const int i = 8 * ps + (lane >> 3);
    int R; bool valid;
    if (prompt) { const int pp = 64 * c - 48 + i; valid = pp >= 0; R = st * PT + (valid ? pp : 0); }
    else { R = NPR + 64 * st + i; valid = true; }
    if (valid) {
      const float4 y0 = *(const float4*)(Y + i * 68 + vc), y1 = *(const float4*)(Y + i * 68 + vc + 4);
      const float rkbv = p.rkb[(size_t)R * 4 + hd];
      const uint4 vv = *(const uint4*)(rwp + 40960 + (i * 64 + vc) * 2);
      const uint4 gc = *(const uint4*)(p.zL + (size_t)R * ZL + ZL_GC + hd * 64 + vc);
      uint4 o;
      o.x = pk2((y0.x + rkbv * bflo(vv.x)) * silu_(bflo(gc.x)), (y0.y + rkbv * bfhi(vv.x)) * silu_(bfhi(gc.x)));
      o.y = pk2((y0.z + rkbv * bflo(vv.y)) * silu_(bflo(gc.y)), (y0.w + rkbv * bfhi(vv.y)) * silu_(bfhi(gc.y)));
      o.z = pk2((y1.x + rkbv * bflo(vv.z)) * silu_(bflo(gc.z)), (y1.y + rkbv * bfhi(vv.z)) * silu_(bfhi(gc.z)));
      o.w = pk2((y1.z + rkbv * bflo(vv.w)) * silu_(bflo(gc.w)), (y1.w + rkbv * bfhi(vv.w)) * silu_(bfhi(gc.w)));
      *(uint4*)(mix + (size_t)R * D + 768 + hd * 64 + vc) = o;
    }
  }
  asm volatile("s_waitcnt lgkmcnt(0)" ::: "memory");
  __builtin_amdgcn_wave_barrier();
}

DEV void final_norm(const Prm& p) {
  int tid_ = threadIdx.x; LAUNDER(tid_);
  const int lane = tid_ & 63, gw = blockIdx.x * 4 + (tid_ >> 6), NW = gridDim.x * 4;
  for (int R = gw; R < NT; R += NW) {
    if (R < NPR && (R % PT) < 16) continue;
    float* yr = xrow_ptr(p, R);
    const bf16_t* xr = p.xb + (size_t)R * D;
    const float rstd = rsqrtf(p.ssq_x[2 * NTP + R] * (1.f / 1024.f) + RMS_EPS);
#pragma unroll
    for (int j = 0; j < 2; ++j) {
      const uint4 u = ((const uint4*)xr)[lane + 64 * j];
      const float4 g0 = ((const float4*)p.final_g)[2 * (lane + 64 * j)], g1 = ((const float4*)p.final_g)[2 * (lane + 64 * j) + 1];
      float4 o0, o1;
      o0.x = bflo(u.x) * rstd * g0.x; o0.y = bfhi(u.x) * rstd * g0.y; o0.z = bflo(u.y) * rstd * g0.z; o0.w = bfhi(u.y) * rstd * g0.w;
      o1.x = bflo(u.z) * rstd * g1.x; o1.y = bfhi(u.z) * rstd * g1.y; o1.z = bflo(u.w) * rstd * g1.z; o1.w = bfhi(u.w) * rstd * g1.w;
      ((float4*)yr)[2 * (lane + 64 * j)] = o0; ((float4*)yr)[2 * (lane + 64 * j) + 1] = o1;
    }
  }
}

#define XB_TMO      128
#define XB_XCNT(j)  (256  + 64 * (j))
#define XB_XSUB(j)  (1280 + 64 * (j))
#define XB_XGEN(j)  (2304 + 64 * (j))
#define XB_TOP      3328
#define XB_TOPGEN   3392
#define XCD_BAR_WORDS 3456
#define XB_SPIN_CAP (1u << 20)
#define LAS __attribute__((address_space(3)))
DEV unsigned xb_ld(unsigned* p) { return __hip_atomic_load(p, __ATOMIC_RELAXED, __HIP_MEMORY_SCOPE_AGENT); }
DEV unsigned xb_add(unsigned* p, unsigned v) { return __hip_atomic_fetch_add(p, v, __ATOMIC_RELAXED, __HIP_MEMORY_SCOPE_AGENT); }
DEV unsigned xb_xcc_id() { return (unsigned)__builtin_amdgcn_s_getreg((3 << 11) | 20) & 0xFu; }
#define XB_SPIN(cond, bar) do { unsigned _sp = 0; while (cond) { __builtin_amdgcn_s_sleep(1); \
    if ((++_sp & 255u) == 0u) { if (xb_ld(&(bar)[XB_TMO])) break; if (_sp > XB_SPIN_CAP) { atomicAdd(&(bar)[XB_TMO], 1u); break; } } } } while (0)
struct XcdBarrier { unsigned* bar; unsigned x; volatile LAS unsigned* st; };
DEV XcdBarrier xcd_barrier_post(unsigned* bar, volatile LAS unsigned* st) {
  XcdBarrier b; b.bar = bar; b.x = xb_xcc_id(); b.st = st;
  if (threadIdx.x == 0) (void)xb_add(&bar[XB_XCNT(b.x)], 1u);
  return b;
}
DEV void xcd_barrier_complete(unsigned* bar, unsigned x, unsigned& nloc, unsigned& nx) {
  const unsigned G = gridDim.x * gridDim.y * gridDim.z;
  unsigned sum, cnt, mine, sp = 0u;
  for (;;) {
    sum = 0u; cnt = 0u; mine = 0u;
#pragma unroll
    for (unsigned j = 0; j < 16; ++j) { const unsigned c = xb_ld(&bar[XB_XCNT(j)]); sum += c; cnt += (c > 0u) ? 1u : 0u; mine = (j == x) ? c : mine; }
    if (sum == G) break;
    __builtin_amdgcn_s_sleep(1);
    if ((++sp & 255u) == 0u) { if (xb_ld(&bar[XB_TMO])) break; if (sp > XB_SPIN_CAP) { atomicAdd(&bar[XB_TMO], 1u); break; } }
  }
  nloc = mine > 0u ? mine : 1u; nx = cnt > 0u ? cnt : 1u;
}
DEV void xcd_barrier(const XcdBarrier& b) {
  asm volatile("s_waitcnt vmcnt(0)" ::: "memory");
  __syncthreads();
  if (threadIdx.x == 0) {
    unsigned* bar = b.bar;
    __builtin_amdgcn_s_waitcnt(0);
    unsigned nloc = b.st[0], nx = b.st[1];
    if (nloc == 0u) { xcd_barrier_complete(bar, b.x, nloc, nx); b.st[0] = nloc; b.st[1] = nx; }
    const unsigned old = xb_add(&bar[XB_XSUB(b.x)], 1u);
    const unsigned gen = old / nloc;
    if (old + 1u == (gen + 1u) * nloc) {
      __builtin_amdgcn_fence(__ATOMIC_RELEASE, "agent");
      asm volatile("s_waitcnt vmcnt(0)" ::: "memory");
      const unsigned og = xb_add(&bar[XB_TOP], 1u);
      const unsigned tg = og / nx;
      if (og + 1u == (tg + 1u) * nx) xb_add(&bar[XB_TOPGEN], 1u);
      else XB_SPIN(xb_ld(&bar[XB_TOPGEN]) == tg, bar);
      __builtin_amdgcn_fence(__ATOMIC_ACQUIRE, "agent");
      xb_add(&bar[XB_XGEN(b.x)], 1u);
      asm volatile("s_waitcnt vmcnt(0)" ::: "memory");
    } else {
      XB_SPIN(xb_ld(&bar[XB_XGEN(b.x)]) == gen, bar);
      __builtin_amdgcn_fence(__ATOMIC_ACQUIRE, "agent");
      asm volatile("s_waitcnt vmcnt(0)" ::: "memory");
    }
  }
  __syncthreads();
}

#define QCTR(ph, L) (3584 + 64 * (2 * (ph) + (L)))
#define R2DONE(L) (3520 + 16 * (L))
DEV int next_item(unsigned* ctr, char* lds) {
  volatile int* slot = (volatile int*)(lds + LDS_BYTES - 8);
  __syncthreads();
  if (threadIdx.x == 0) *slot = (int)atomicAdd(ctr, 1u);
  __syncthreads();
  return *slot;
}
#define QXC(ph, L, x) (4096 + (((ph) * 2 + (L)) * 8 + (x)) * 16)
DEV int xq_next(unsigned* ctl, int ph, int L, int C, int N, int& k, int home, char* lds) {
  volatile int* slot = (volatile int*)(lds + LDS_BYTES - 8);
  __syncthreads();
  if (threadIdx.x == 0) {
    int res = -1, kk = k;
    while (kk < 8) {
      const int x = (home + kk) & 7, base = x * C;
      int size = N - base; size = size < C ? size : C;
      if (size > 0) { const int idx = (int)atomicAdd(ctl + QXC(ph, L, x), 1u); if (idx < size) { res = base + idx; break; } }
      ++kk;
    }
    slot[0] = res; slot[1] = kk;
  }
  __syncthreads();
  k = slot[1];
  return slot[0];
}
DEV int q_publish(int ticket, char* lds) {
  volatile int* slot = (volatile int*)(lds + LDS_BYTES - 8);
  __syncthreads();
  if (threadIdx.x == 0) *slot = ticket;
  __syncthreads();
  return *slot;
}
DEV int xq_resolve(unsigned* ctl, int ph, int L, int C, int N, int& k, int home, int ticket, char* lds) {
  volatile int* slot = (volatile int*)(lds + LDS_BYTES - 8);
  __syncthreads();
  if (threadIdx.x == 0) {
    int res = -1, kk = k;
    if (kk < 8) {
      const int x = (home + kk) & 7, base = x * C;
      int size = N - base; size = size < C ? size : C;
      if (ticket < size) res = base + ticket;
      else {
        ++kk;
        while (kk < 8) {
          const int x2 = (home + kk) & 7, base2 = x2 * C;
          int size2 = N - base2; size2 = size2 < C ? size2 : C;
          if (size2 > 0) { const int idx = (int)atomicAdd(ctl + QXC(ph, L, x2), 1u); if (idx < size2) { res = base2 + idx; break; } }
          ++kk;
        }
      }
    }
    slot[0] = res; slot[1] = kk;
  }
  __syncthreads();
  k = slot[1];
  return slot[0];
}
DEV unsigned* xq_ctr(unsigned* ctl, int ph, int L, int k, int home) { return k < 8 ? ctl + QXC(ph, L, (home + k) & 7) : nullptr; }
DEV int take_ticket(unsigned* nctr) { int tk = 0x7fffffff; if (nctr && threadIdx.x == 0) tk = (int)atomicAdd(nctr, 1u); return tk; }
DEV void shift_rows_item(const Prm& p, int L, int b) {
  int tid0 = threadIdx.x; LAUNDER(tid0);
  if (tid0 < 224) {
    float4 v = make_float4(0.f, 0.f, 0.f, 0.f);
    if (b < 32) v = *(const float4*)(p.state_shift + ((size_t)L * 32 + b) * 896 + 4 * tid0);
    *(uint2*)(p.zE + (size_t)(NT + b) * ZE + ZE_ZC + 4 * tid0) = pk4(v.x, v.y, v.z, v.w);
  }
}
constexpr int N_ATT = 1312;
DEV void run_p1(const Prm& p, int L, char* lds) {
  const EpiIn epi{p, L};
  const int home = (int)(xb_xcc_id() & 7u);
  int k = 0;
  constexpr int N = 145 * 24, C = (N + 7) / 8;
  int t = take_ticket(xq_ctr(p.ctl, 0, L, k, home));
  for (;;) {
    const int i = xq_resolve(p.ctl, 0, L, C, N, k, home, t, lds);
    if (i < 0) break;
    int mt, nt;
    if (i < 18 * 192) { const int b = i / 192, r = i - b * 192; nt = r >> 3; mt = 8 * b + (r & 7); } else { nt = i - 18 * 192; mt = 144; }
    t = gemm_tile(p.xb, D, p.Wb_in + (size_t)L * INP * 1024, 1024, 1024, mt * 128, nt * 128, lds, epi, xq_ctr(p.ctl, 0, L, k, home));
  }
  unsigned* ctr = p.ctl + QCTR(3, L);
  t = take_ticket(ctr);
  for (;;) {
    const int mt = q_publish(t, lds);
    if (mt >= 145 + 33) break;
    if (mt >= 145) { t = take_ticket(ctr); shift_rows_item(p, L, mt - 145); continue; }
    t = gemm_tile<EpiIn, 2>(p.xb, D, p.Wb_in + (size_t)L * INP * 1024, 1024, 1024, mt * 128, 24 * 128, lds, epi, ctr);
  }
}
DEV void run_p2(const Prm& p, int L, char* lds) {
  const EpiQ epq{p, L};
  constexpr int N1 = NRW, N2 = N1 + 129, N3 = N2 + 145 * 6, N4 = N3 + 16, N4b = N4 + 512, N5 = N4b + 36;
  const int N6 = L == 0 ? N5 + NWT : N5;
  unsigned* ctr = p.ctl + QCTR(0, L);
  for (;;) {
    const int id = next_item(ctr, lds);
    if (id >= N6) break;
    if (id >= N5) { conv_weights_item(p, 1, id - N5, lds); continue; }
    if (id < N1) r1_item(p, L, id, lds);
    else if (id < N2) kvproj_item(p, L, id - N1, lds);
    else if (id < N3) { const int t = id - N2, mt = t / 6, nt = t - mt * 6; gemm_tile(p.zE + ZE_CQ, ZE, p.Wb_uq + (size_t)L * 768 * 256, 256, 256, mt * 128, nt * 128, lds, epq); }
    else if (id < N4) sample_prep_item(p, L, id - N3);
    else if (id < N4b) lat_item(p, L, id - N4);
    else shift_item(p, L, id - N4b);
  }
}
DEV void run_p3(const Prm& p, int L, char* lds) {
  int tid_ = threadIdx.x; LAUNDER(tid_);
  const int lane = tid_ & 63, w = __builtin_amdgcn_readfirstlane(tid_ >> 6);
  {
    int ndone = 0;
    for (int wi = blockIdx.x * 4 + w; wi < 576; wi += gridDim.x * 4) { r2_wave(p, L, wi, lane); ++ndone; }
    if (blockIdx.x * 4 < 576) {
      asm volatile("s_waitcnt vmcnt(0)" ::: "memory");
      __syncthreads();
      if (threadIdx.x == 0) {
        int tot = 0;
        for (int wi = blockIdx.x * 4; wi < 576; wi += gridDim.x * 4) tot += (576 - wi) < 4 ? (576 - wi) : 4;
        __builtin_amdgcn_fence(__ATOMIC_RELEASE, "agent");
        asm volatile("s_waitcnt vmcnt(0)" ::: "memory");
        __hip_atomic_fetch_add(p.ctl + R2DONE(L), (unsigned)tot, __ATOMIC_RELAXED, __HIP_MEMORY_SCOPE_AGENT);
      }
    }
    (void)ndone;
  }
  unsigned* ctr = p.ctl + QCTR(1, L);
  for (;;) {
    const int q = next_item(ctr, lds);
    if (q >= 128) break;
    attn_sample(p, L, q >> 2, q & 3, lds);
  }
  {
    const int home = (int)(xb_xcc_id() & 7u);
    int k = 0;
    int tx = take_ticket(xq_ctr(p.ctl, 2, L, k, home));
    for (;;) {
      const int i = xq_resolve(p.ctl, 2, L, 128, 1024, k, home, tx, lds);
      if (i < 0) break;
      const int x = i >> 7, j = i & 127, qt = 31 - (j >> 2), pair = 4 * x + (j & 3);
      tx = attn_body<false>(p, L, pair >> 3, pair & 7, qt, lds, xq_ctr(p.ctl, 2, L, k, home));
    }
  }
  unsigned* ctr2 = p.ctl + QCTR(2, L);
  constexpr int NC = (NT + 31) / 32, NQ2 = 32 + NC + NRW / 4;
  bool r2_seen = false;
  for (;;) {
    const int q = next_item(ctr2, lds);
    if (q >= NQ2) break;
    if (q < 32) attn_item(p, L, 1280 + q, lds);
    else if (q < 32 + NC) conv_item(p, L, q - 32);
    else {
      if (!r2_seen) {
        if (threadIdx.x == 0) {
          unsigned sp = 0;
          while (__hip_atomic_load(p.ctl + R2DONE(L), __ATOMIC_RELAXED, __HIP_MEMORY_SCOPE_AGENT) < 576u) {
            __builtin_amdgcn_s_sleep(2);
            if (++sp > (1u << 22)) { atomicAdd(&p.ctl[XB_TMO], 1u); break; }
          }
          __builtin_amdgcn_fence(__ATOMIC_ACQUIRE, "agent");
          asm volatile("s_waitcnt vmcnt(0)" ::: "memory");
        }
        __syncthreads();
        r2_seen = true;
      }
      r3_wave(p, L, (q - 32 - NC) * 4 + w, lane, (float*)(lds + w * 17408));
    }
  }
}
DEV void run_p4(const Prm& p, int L, char* lds) {
  const EpiOut epo{p, L};
  const int home = (int)(xb_xcc_id() & 7u);
  int k = 0;
  int t = take_ticket(xq_ctr(p.ctl, 1, L, k, home));
  for (;;) {
    const int i = xq_resolve(p.ctl, 1, L, 128, 1024, k, home, t, lds);
    if (i < 0) break;
    t = gemm_tile(p.zE  , D, p.Wb_out + (size_t)L * 1024 * 1024, 1024, 1024, (i >> 3) * 128, (i & 7) * 128, lds, epo, xq_ctr(p.ctl, 1, L, k, home));
  }
  unsigned* ctr = p.ctl + QCTR(3, L) + 16;
  t = take_ticket(ctr);
  for (;;) {
    const int h = q_publish(t, lds);
    if (h >= 17 * 16) break;
    const int mt = 128 + (h >> 4), r = h & 15;
    t = gemm_tile<EpiOut, 4>(p.zE, D, p.Wb_out + (size_t)L * 1024 * 1024, 1024, 1024, mt * 128, (r >> 1) * 128 + (r & 1) * 64, lds, epo, ctr);
  }
}

__global__ void __launch_bounds__(256, 2) mega(Prm p) {
  extern __shared__ __attribute__((aligned(16))) char lds[];
  volatile LAS unsigned* st = (volatile LAS unsigned*)(lds + LDS_BYTES - 16);
  if (threadIdx.x == 0) { st[0] = 0u; st[1] = 0u; st[2] = 0u; st[3] = 0u; }
  __syncthreads();
  const XcdBarrier xb = xcd_barrier_post(p.ctl, st);
  phase0(p, lds);
  xcd_barrier(xb);
  for (int L = 0; L < 2; ++L) {
    run_p1(p, L, lds); xcd_barrier(xb);
    run_p2(p, L, lds); xcd_barrier(xb);
    run_p3(p, L, lds); xcd_barrier(xb);
    run_p4(p, L, lds); xcd_barrier(xb);
  }
  final_norm(p);
}

static size_t al256(size_t x) { return (x + 255) & ~(size_t)255; }
extern "C" void kernel_launch(void* const* d_in, const int* in_sizes, int n_in, void* d_out, int out_size, void* d_ws, size_t ws_size, hipStream_t stream) {
  Prm p{};
  const float* const* in = (const float* const*)d_in;
  p.x_prompt = in[0]; p.x_sample = in[1]; p.cache_ckv = in[2]; p.cache_krope = in[3]; p.state_conv = in[4]; p.state_shift = in[5]; p.state_wkv = in[6];
  p.meta = in[7]; p.norm_g = in[8]; p.w_in = in[9]; p.conv_w = in[10]; p.q_norm_g = in[11]; p.w_uq = in[12]; p.kv_norm_g = in[13]; p.w_ukv = in[14];
  p.shift_mu = in[15]; p.decay_w0 = in[16]; p.decay_w2 = in[17]; p.iclr_a0 = in[18]; p.iclr_a2 = in[19]; p.key_kk = in[20]; p.key_ka = in[21];
  p.bonus_rk = in[22]; p.lnx_w = in[23]; p.lnx_b = in[24]; p.w_out = in[25]; p.final_g = in[26];
  float* o = (float*)d_out;
  p.y_prompt = o; o += (size_t)4 * 4096 * 1024;
  p.y_sample = o; o += (size_t)32 * 64 * 1024;
  p.ckv_p = o; o += (size_t)2 * 4 * PT * 128;
  p.kr_p = o; o += (size_t)2 * 4 * PT * 32;
  p.conv_p = o; o += 2 * 4 * 2 * 256;
  p.shift_p = o; o += 2 * 4 * 896;
  p.wkv_p = o; o += 2 * 4 * 4 * 64 * 64;
  p.ckv_s = o; o += (size_t)2 * 32 * 64 * 128;
  p.kr_s = o; o += 2 * 32 * 64 * 32;
  p.conv_s = o; o += 2 * 32 * 2 * 256;
  p.shift_s = o; o += 2 * 32 * 896;
  p.wkv_s = o; o += 2 * 32 * 4 * 64 * 64;
  char* w = (char*)d_ws; size_t off = 0;
  auto take = [&](size_t bytes) { char* r = w + off; off = al256(off + bytes); return r; };
  p.ctl = (unsigned*)take(65536);
  p.Wb_in = (bf16_t*)take((size_t)2 * INP * 1024 * 2);
  p.Wb_uq = (bf16_t*)take((size_t)2 * 768 * 256 * 2);
  p.Wb_ukv = (bf16_t*)take((size_t)2 * 1024 * 128 * 2);
  p.Wb_out = (bf16_t*)take((size_t)2 * 1024 * 1024 * 2);
  p.dw2T = (bf16_t*)take((size_t)2 * 256 * 64 * 2);
  p.ia2T = (bf16_t*)take((size_t)2 * 256 * 64 * 2);
  p.ropec = (float*)take((size_t)PT * 16 * 4);
  p.ropes = (float*)take((size_t)PT * 16 * 4);
  p.ssq_x = (float*)take((size_t)7 * NTP * 4);
  p.ssq_q = p.ssq_x + 3 * NTP; p.ssq_kv = p.ssq_x + 5 * NTP;
  p.rkb = (float*)take((size_t)NTP * 4 * 4);
  p.xmeta = (float*)take((size_t)64 * 1024 * 4);
  p.zE = (bf16_t*)take((size_t)NTP * ZE * 2);
  p.zL = (bf16_t*)take((size_t)NTP * ZL * 2);
  p.xb = (bf16_t*)take((size_t)(NTP + 128) * D * 2);
  p.Kn = (bf16_t*)take((size_t)KVR * 512 * 2);
  p.Vt = (bf16_t*)take((size_t)512 * KVR * 2);
  p.Kr = (bf16_t*)take((size_t)KVR * 32 * 2);
  p.rw = take((size_t)NRW * RW_BYTES);
  p.KL = (bf16_t*)((char*)p.y_prompt + ((size_t)32 << 20));
  p.VLT = p.KL + (size_t)32 * SKEYS * 160;
  static int grid = 0;
  if (grid == 0) {
    if (off > ws_size) { fprintf(stderr, "kernel_launch: workspace too small: need %zu have %zu\n", off, ws_size); grid = -1; return; }
    int dev = 0, cus = 0, per_cu = 0;
    (void)hipGetDevice(&dev);
    (void)hipDeviceGetAttribute(&cus, hipDeviceAttributeMultiprocessorCount, dev);
    (void)hipFuncSetAttribute((const void*)mega, hipFuncAttributeMaxDynamicSharedMemorySize, LDS_BYTES);
    (void)hipOccupancyMaxActiveBlocksPerMultiprocessor(&per_cu, (const void*)mega, 256, LDS_BYTES);
    if (per_cu > 2) per_cu = 2;
    if (per_cu < 1) { fprintf(stderr, "kernel_launch: occupancy query returned %d\n", per_cu); per_cu = 1; }
    grid = cus * per_cu;
  }
  if (grid < 0) return;
  (void)hipMemsetAsync(p.ctl, 0, 8192 * 4, stream);
  void* args[] = {&p};
  hipError_t e = hipLaunchCooperativeKernel((const void*)mega, dim3(grid), dim3(256), args, LDS_BYTES, stream);
  if (e != hipSuccess) fprintf(stderr, "cooperative launch failed: %s (grid %d)\n", hipGetErrorString(e), grid);
}
```

```cpp
#include <hip/hip_runtime.h>
#include <cstdio>
#include <cstdint>
#include <type_traits>

typedef unsigned short bf16_t;
typedef short bf16x8 __attribute__((ext_vector_type(8)));
typedef float f32x4 __attribute__((ext_vector_type(4)));
typedef float f32x16 __attribute__((ext_vector_type(16)));
#define DEV __device__ __forceinline__
#define LAUNDER(x) asm volatile("" : "+v"(x))

constexpr int D = 1024;
constexpr int PT = 4112;
constexpr int NPR = 4 * PT;
constexpr int NSM = 32 * 64;
constexpr int NT = NPR + NSM;
constexpr int NTP = 18560;
constexpr int ZL = 1792;
constexpr int ZE = 1312;
constexpr int ZE_CQ = 0, ZE_CKV = 256, ZE_KR = 384, ZE_ZC = 416;
constexpr int ZL_XIN = 0, ZL_BG = 256, ZL_CG = 512, ZL_GA = 768, ZL_GB = 1024, ZL_GC = 1536;
constexpr int INP = 3200;
constexpr int KVR = 16512;
constexpr int NRW_P = 4 * 65 * 4;
constexpr int NRW = NRW_P + 32 * 4;
constexpr int RW_BYTES = 49152;
constexpr float RMS_EPS = 1e-6f;
constexpr float GN_EPS = 64e-5f;
constexpr int LDS_BYTES = 79872;
constexpr int SKEYS = 1088;

struct Prm {
  const float *x_prompt, *x_sample, *cache_ckv, *cache_krope, *state_conv, *state_shift, *state_wkv, *meta, *norm_g, *w_in,
      *conv_w, *q_norm_g, *w_uq, *kv_norm_g, *w_ukv, *shift_mu, *decay_w0, *decay_w2, *iclr_a0, *iclr_a2, *key_kk, *key_ka,
      *bonus_rk, *lnx_w, *lnx_b, *w_out, *final_g;
  float *y_prompt, *y_sample, *ckv_p, *kr_p, *conv_p, *shift_p, *wkv_p, *ckv_s, *kr_s, *conv_s, *shift_s, *wkv_s;
  unsigned* ctl;
  bf16_t *Wb_in, *Wb_uq, *Wb_ukv, *Wb_out, *dw2T, *ia2T;
  float *ropec, *ropes, *ssq_x, *ssq_q, *ssq_kv, *rkb, *xmeta;
  bf16_t *KL, *VLT;
  bf16_t *zE, *zL, *xb, *Kn, *Vt, *Kr;
  char* rw;
};

DEV float bf2f(bf16_t b) { return __uint_as_float((unsigned)b << 16); }
DEV float bflo(unsigned u) { return __uint_as_float(u << 16); }
DEV float bfhi(unsigned u) { return __uint_as_float(u & 0xffff0000u); }
typedef __bf16 hbf16x2_t __attribute__((ext_vector_type(2)));
typedef float hf32x2_t __attribute__((ext_vector_type(2)));
DEV unsigned pk2(float a, float b) { hf32x2_t f = {a, b}; hbf16x2_t r = __builtin_convertvector(f, hbf16x2_t); return __builtin_bit_cast(unsigned, r); }
DEV bf16_t f2bf(float f) { return (bf16_t)(pk2(f, 0.f) & 0xffffu); }
DEV uint2 pk4(float a, float b, float c, float d) { uint2 r; r.x = pk2(a, b); r.y = pk2(c, d); return r; }
DEV float sigmoid_(float x) { return 1.f / (1.f + __expf(-x)); }
DEV float silu_(float x) { return x / (1.f + __expf(-x)); }
DEV float wave_sum(float v) {
#pragma unroll
  for (int o = 1; o < 64; o <<= 1) v += __shfl_xor(v, o);
  return v;
}
DEV f32x16 mfma32(bf16x8 a, bf16x8 b, f32x16 c) { return __builtin_amdgcn_mfma_f32_32x32x16_bf16(a, b, c, 0, 0, 0); }
DEV f32x4 mfma16(bf16x8 a, bf16x8 b, f32x4 c) { return __builtin_amdgcn_mfma_f32_16x16x32_bf16(a, b, c, 0, 0, 0); }
DEV bf16x8 mk8(unsigned a, unsigned b, unsigned c, unsigned d) { uint4 u; u.x = a; u.y = b; u.z = c; u.w = d; return __builtin_bit_cast(bf16x8, u); }
DEV bf16x8 mk8(uint4 u) { return __builtin_bit_cast(bf16x8, u); }
DEV f32x16 zero16() { f32x16 z; for (int i = 0; i < 16; ++i) z[i] = 0.f; return z; }

DEV float* xrow_ptr(const Prm& p, int R) {
  if (R < NPR) { int s = R / PT, q = R - s * PT; return q < 16 ? p.xmeta + (size_t)(s * 16 + q) * D : p.y_prompt + ((size_t)s * 4096 + (q - 16)) * D; }
  return p.y_sample + (size_t)(R - NPR) * D;
}
DEV const float* xin_ptr(const Prm& p, int R) {
  if (R < NPR) { int s = R / PT, q = R - s * PT; return q < 16 ? p.meta + (size_t)q * D : p.x_prompt + ((size_t)s * 4096 + (q - 16)) * D; }
  return p.x_sample + (size_t)(R - NPR) * D;
}
DEV int pos_of(int R) { return R < NPR ? R % PT : 1024 + ((R - NPR) & 63); }

DEV int win_src_col(int n) {
  if (n < 1024) return n;
  if (n < 1536) return 1440 + (n - 1024);
  if (n < 1792) return 2848 + (n - 1536);
  if (n < 2208) return 1024 + (n - 1792);
  if (n < 3104) return 1952 + (n - 2208);
  return -1;
}
DEV int perm32(int rho) { const int n = rho >> 4, i = rho & 15; return 8 * (i >> 2) + 4 * n + (i & 3); }
template <bool PERM, bool P32>
DEV void conv_weight_tile(const float* __restrict__ src, int K, int N, int Npad, bf16_t* __restrict__ dst, const float* __restrict__ sk, float cst, int l, int item, float* T  , int tid) {
  const int ntn = Npad / 64, ntk = K / 64;
  const int r = item, kt = r / ntn, nt = r - kt * ntn;
  const int k0 = kt * 64, n0 = nt * 64;
  {
    const int nslot = n0 + (tid & 15) * 4;
    const int nn = P32 ? (nslot & ~31) + perm32(nslot & 31) : nslot;
    const int sn = PERM ? win_src_col(nn) : (nn < N ? nn : -1);
#pragma unroll
    for (int i = 0; i < 4; ++i) {
      const int k = (tid >> 4) + 16 * i;
      float4 v = make_float4(0.f, 0.f, 0.f, 0.f);
      if (sn >= 0) {
        v = *(const float4*)(src + ((size_t)l * K + k0 + k) * N + sn);
        const float s = (sk ? sk[l * K + k0 + k] : 1.f) * cst;
        v.x *= s; v.y *= s; v.z *= s; v.w *= s;
      }
      float* t = T + k * 65 + (tid & 15) * 4;
      t[0] = v.x; t[1] = v.y; t[2] = v.z; t[3] = v.w;
    }
  }
  __syncthreads();
  {
    const int n = tid >> 2, kc = tid & 3;
    float v[16];
#pragma unroll
    for (int j = 0; j < 16; ++j) v[j] = T[(16 * kc + j) * 65 + n];
    uint4 o0, o1;
    o0.x = pk2(v[0], v[1]); o0.y = pk2(v[2], v[3]); o0.z = pk2(v[4], v[5]); o0.w = pk2(v[6], v[7]);
    o1.x = pk2(v[8], v[9]); o1.y = pk2(v[10], v[11]); o1.z = pk2(v[12], v[13]); o1.w = pk2(v[14], v[15]);
    bf16_t* d = dst + ((size_t)l * Npad + n0 + n) * K + k0 + 16 * kc;
    *(uint4*)d = o0; *(uint4*)(d + 8) = o1;
  }
  __syncthreads();
}
constexpr int WT0 = 16 * 50, WT1 = WT0 + 16 * 16, WT2 = WT1 + 4 * 12, WT3 = WT2 + 2 * 16, WT4 = WT3 + 4, NWT = WT4 + 4;
DEV void conv_weights_item(const Prm& p, int l, int it, char* lds) {
  float* T = (float*)lds;
  int tid = threadIdx.x; LAUNDER(tid);
  if (it < WT0) conv_weight_tile<true, true>(p.w_in, 1024, 3104, INP, p.Wb_in, p.norm_g, 1.f, l, it, T, tid);
  else if (it < WT1) conv_weight_tile<false, true>(p.w_out, 1024, 1024, 1024, p.Wb_out, nullptr, 1.f, l, it - WT0, T, tid);
  else if (it < WT2) conv_weight_tile<false, false>(p.w_uq, 256, 768, 768, p.Wb_uq, p.q_norm_g, 0.10206207261596575f * 1.4426950408889634f, l, it - WT1, T, tid);
  else if (it < WT3) conv_weight_tile<false, false>(p.w_ukv, 128, 1024, 1024, p.Wb_ukv, nullptr, 1.f, l, it - WT2, T, tid);
  else if (it < WT4) conv_weight_tile<false, false>(p.decay_w2, 64, 256, 256, p.dw2T, nullptr, 1.f, l, it - WT3, T, tid);
  else conv_weight_tile<false, false>(p.iclr_a2, 64, 256, 256, p.ia2T, nullptr, 1.f, l, it - WT4, T, tid);
}
DEV void phase0(const Prm& p, char* lds) {
  int tid = threadIdx.x; LAUNDER(tid);
  const int lane = tid & 63, wv = tid >> 6;
  const int gw = blockIdx.x * 4 + wv, NW = gridDim.x * 4;
  const int gt = blockIdx.x * 256 + tid, NTH = gridDim.x * 256;
  for (int R = gw; R < NT; R += NW) {
    const float* src = xin_ptr(p, R);
    float ss = 0.f;
#pragma unroll
    for (int j = 0; j < 4; ++j) {
      const float4 v = ((const float4*)src)[lane + 64 * j];
      ss += v.x * v.x + v.y * v.y + v.z * v.z + v.w * v.w;
      ((uint2*)(p.xb + (size_t)R * D))[lane + 64 * j] = pk4(v.x, v.y, v.z, v.w);
    }
    ss = wave_sum(ss);
    if (lane == 0) p.ssq_x[R] = ss;
  }
  for (int i = gt; i < 6 * NTP; i += NTH) p.ssq_x[NTP + i] = 0.f;
  for (int it = blockIdx.x; it < NWT; it += gridDim.x) conv_weights_item(p, 0, it, lds);
  for (int i = gt; i < PT * 16; i += NTH) {
    const int pos = i >> 4, j = i & 15;
    const float inv = powf(10000.f, -(float)j * 2.0f / 32.f);
    const float ang = (float)pos * inv;
    double a = (double)ang;
    a -= 6.283185307179586476925 * rint(a * 0.15915494309189533577);
    p.ropec[i] = (float)cos(a);
    p.ropes[i] = (float)sin(a);
  }
}

#define LAS3 __attribute__((address_space(3)))
#define RAW_BARRIER() { asm volatile("" ::: "memory"); __builtin_amdgcn_s_barrier(); asm volatile("" ::: "memory"); }
DEV int lds_byte(int r, int c) { const int st = (r >> 4) * 2 + (c >> 5), rr = r & 15, cc = c & 31, ob = rr * 64 + cc * 2; return st * 1024 + (ob ^ (((ob >> 9) & 1) << 5)); }
template <class Epi, int NB = 8>
DEV int gemm_tile(const bf16_t* __restrict__ A, int lda, const bf16_t* __restrict__ Bt, int ldb, int K, int m0, int n0, char* lds, const Epi& epi, unsigned* nctr = nullptr) {
  int tid = threadIdx.x; LAUNDER(tid);
  const int lane = tid & 63, w = __builtin_amdgcn_readfirstlane(tid >> 6), wr = w >> 1, wc = w & 1;
  const int fr = lane & 15, fq = lane >> 4;
  const int sb = lane * 16, swz = sb ^ (((sb >> 9) & 1) << 5), rl = swz >> 6, cl = (swz & 63) >> 1;
  const bf16_t* ga[4]; const bf16_t* gb[4];
#pragma unroll
  for (int i = 0; i < 4; ++i) {
    const int st = 4 * w + i, r = (st >> 1) * 16 + rl, c = (st & 1) * 32 + cl;
    ga[i] = A + (size_t)(m0 + r) * lda + c;
    gb[i] = Bt + (size_t)(n0 + r) * ldb + c;
  }
  const int nk = K / 64;
#define GSTAGE(S, KT) { _Pragma("unroll") for (int i = 0; i < 4; ++i) { \
      __builtin_amdgcn_global_load_lds((const unsigned*)(ga[i] + (KT) * 64), (LAS3 unsigned*)(lds + (S) * 32768 + (4 * w + i) * 1024 + lane * 16), 16, 0, 0); \
      if (2 * w + (i >> 1) < NB) __builtin_amdgcn_global_load_lds((const unsigned*)(gb[i] + (KT) * 64), (LAS3 unsigned*)(lds + (S) * 32768 + 16384 + (4 * w + i) * 1024 + lane * 16), 16, 0, 0); } }
  f32x4 acc[4][4];
#pragma unroll
  for (int i = 0; i < 4; ++i)
#pragma unroll
    for (int j = 0; j < 4; ++j) acc[i][j] = (f32x4){0.f, 0.f, 0.f, 0.f};
  int offA[2], offB[2];
#pragma unroll
  for (int kh = 0; kh < 2; ++kh) { offA[kh] = lds_byte(wr * 64 + fr, kh * 32 + fq * 8); offB[kh] = lds_byte(wc * 64 + fr, kh * 32 + fq * 8); }
  GSTAGE(0, 0)
  if (nk > 1) GSTAGE(1, 1)
  for (int kt = 0; kt < nk; ++kt) {
    const int s = kt & 1;
    if (kt + 1 < nk) { if (2 * w < NB) asm volatile("s_waitcnt vmcnt(8)" ::: "memory"); else asm volatile("s_waitcnt vmcnt(4)" ::: "memory"); }
    else asm volatile("s_waitcnt vmcnt(0)" ::: "memory");
    RAW_BARRIER()
    const char* ia = lds + s * 32768;
    const char* ib = ia + 16384;
    bf16x8 af[2][4], bfv[2][4];
#pragma unroll
    for (int kh = 0; kh < 2; ++kh) {
#pragma unroll
      for (int mi = 0; mi < 4; ++mi) af[kh][mi] = *(const bf16x8*)(ia + offA[kh] + mi * 2048);
#pragma unroll
      for (int ni = 0; ni < (NB < 4 ? NB : 4); ++ni) bfv[kh][ni] = *(const bf16x8*)(ib + offB[kh] + ni * 2048);
    }
    asm volatile("s_waitcnt lgkmcnt(0)" ::: "memory");
    RAW_BARRIER()
    if (kt + 2 < nk) GSTAGE(s, kt + 2)
    __builtin_amdgcn_sched_barrier(0);
    if (NB == 8 || wc == 0) {
#pragma unroll
      for (int kh = 0; kh < 2; ++kh)
#pragma unroll
        for (int mi = 0; mi < 4; ++mi)
#pragma unroll
          for (int ni = 0; ni < (NB < 4 ? NB : 4); ++ni) acc[mi][ni] = mfma16(bfv[kh][ni], af[kh][mi], acc[mi][ni]);
    }
  }
  __syncthreads();
#undef GSTAGE
  int tk = 0x7fffffff; if (nctr && tid == 0) tk = (int)atomicAdd(nctr, 1u);
  if (NB == 8 || wc == 0) epi(acc, m0 + wr * 64, n0 + wc * 64, fr, fq);
  return tk;
}

DEV int lds_byte32(int r, int c) { const int rr = r & 15, ob = rr * 64 + c * 2; return (r >> 4) * 1024 + (ob ^ (((ob >> 9) & 1) << 5)); }
template <class Epi>
DEV void gemm_tile_big(const bf16_t* __restrict__ A, int lda, const bf16_t* __restrict__ Bt, int ldb, int K, int m0, int n0, char* lds, const Epi& epi) {
  int tid = threadIdx.x; LAUNDER(tid);
  const int lane = tid & 63, w = __builtin_amdgcn_readfirstlane(tid >> 6), wr = w >> 1, wc = w & 1;
  const int fr = lane & 15, fq = lane >> 4;
  const int sb = lane * 16, swz = sb ^ (((sb >> 9) & 1) << 5), rl = swz >> 6, cl = (swz & 63) >> 1;
  const bf16_t* ga[4]; const bf16_t* gb[2];
#pragma unroll
  for (int i = 0; i < 4; ++i) ga[i] = A + (size_t)(m0 + (4 * w + i) * 16 + rl) * lda + cl;
#pragma unroll
  for (int i = 0; i < 2; ++i) gb[i] = Bt + (size_t)(n0 + (2 * w + i) * 16 + rl) * ldb + cl;
  const int nk = K / 32;
#define GSTAGE3(S, KT) { _Pragma("unroll") for (int i = 0; i < 4; ++i) \
      __builtin_amdgcn_global_load_lds((const unsigned*)(ga[i] + (KT) * 32), (LAS3 unsigned*)(lds + (S) * 24576 + (4 * w + i) * 1024 + lane * 16), 16, 0, 0); \
    _Pragma("unroll") for (int i = 0; i < 2; ++i) \
      __builtin_amdgcn_global_load_lds((const unsigned*)(gb[i] + (KT) * 32), (LAS3 unsigned*)(lds + (S) * 24576 + 16384 + (2 * w + i) * 1024 + lane * 16), 16, 0, 0); }
  f32x4 acc[8][4];
#pragma unroll
  for (int i = 0; i < 8; ++i)
#pragma unroll
    for (int j = 0; j < 4; ++j) acc[i][j] = (f32x4){0.f, 0.f, 0.f, 0.f};
  const int offA = lds_byte32(wr * 128 + fr, fq * 8), offB = 16384 + lds_byte32(wc * 64 + fr, fq * 8);
  GSTAGE3(0, 0)
  if (nk > 1) GSTAGE3(1, 1)
  int s = 0;
  for (int kt = 0; kt < nk; ++kt) {
    if (kt + 1 < nk) asm volatile("s_waitcnt vmcnt(6)" ::: "memory"); else asm volatile("s_waitcnt vmcnt(0)" ::: "memory");
    RAW_BARRIER()
    if (kt + 2 < nk) { const int s2 = s + 2 >= 3 ? s - 1 : s + 2; GSTAGE3(s2, kt + 2) }
    const char* im = lds + s * 24576;
    bf16x8 af[8], bfv[4];
#pragma unroll
    for (int ni = 0; ni < 4; ++ni) bfv[ni] = *(const bf16x8*)(im + offB + ni * 1024);
#pragma unroll
    for (int mi = 0; mi < 8; ++mi) af[mi] = *(const bf16x8*)(im + offA + mi * 1024);
#pragma unroll
    for (int mi = 0; mi < 8; ++mi)
#pragma unroll
      for (int ni = 0; ni < 4; ++ni) acc[mi][ni] = mfma16(bfv[ni], af[mi], acc[mi][ni]);
    s = s + 1 >= 3 ? 0 : s + 1;
  }
  __syncthreads();
#undef GSTAGE3
  epi(acc, m0 + wr * 128, n0 + wc * 64, fr, fq);
}

struct EpiIn {
  const Prm& p; int L;
  template <int MI>
  DEV void operator()(f32x4 (&acc)[MI][4], int mb, int nb, int fr, int fq) const {
#pragma unroll
    for (int mi = 0; mi < MI; ++mi) {
      const int m = mb + 16 * mi + fr;
      const bool ok = m < NT;
      const float rstd = rsqrtf(p.ssq_x[L * NTP + m] * (1.f / 1024.f) + RMS_EPS);
      float sq = 0.f;
#pragma unroll
      for (int g = 0; g < 2; ++g) {
        const int n0 = nb + 32 * g;
        if (n0 >= 3104) continue;
        bf16_t* dst = n0 < ZL ? p.zL + (size_t)m * ZL + n0 : p.zE + (size_t)m * ZE + (n0 - ZL);
        float v[8];
#pragma unroll
        for (int j = 0; j < 4; ++j) { v[j] = acc[mi][2 * g][j] * rstd; v[4 + j] = acc[mi][2 * g + 1][j] * rstd; }
#pragma unroll
        for (int j = 0; j < 8; ++j) sq += v[j] * v[j];
        if (ok) { uint4 o; o.x = pk2(v[0], v[1]); o.y = pk2(v[2], v[3]); o.z = pk2(v[4], v[5]); o.w = pk2(v[6], v[7]); *(uint4*)(dst + 8 * fq) = o; }
      }
      if (nb >= ZL && nb < ZL + 384) {
        sq += __shfl_xor(sq, 16); sq += __shfl_xor(sq, 32);
        if (fq == 0 && ok) atomicAdd((nb < ZL + 256 ? p.ssq_q : p.ssq_kv) + L * NTP + m, sq);
      }
    }
  }
};
struct EpiQ {
  const Prm& p; int L;
  DEV void operator()(f32x4 (&acc)[4][4], int mb, int nb, int fr, int fq) const {
    bf16_t* Qb = (bf16_t*)p.y_prompt;
#pragma unroll
    for (int mi = 0; mi < 4; ++mi) {
      const int m = mb + 16 * mi + fr;
      const bool ok = m < NT;
      const float rstd = rsqrtf(p.ssq_q[L * NTP + m] * (1.f / 256.f) + RMS_EPS);
      const int pos = pos_of(ok ? m : 0);
#pragma unroll
      for (int np = 0; np < 2; ++np) {
        const int n0 = nb + 32 * np;
        float v[2][4];
#pragma unroll
        for (int h2 = 0; h2 < 2; ++h2)
#pragma unroll
          for (int j = 0; j < 4; ++j) v[h2][j] = acc[mi][2 * np + h2][j] * rstd;
        if (((n0 >> 5) % 3) == 2) {
#pragma unroll
          for (int j = 0; j < 4; ++j) {
            const int c = 4 * fq + j;
            const float cs = p.ropec[pos * 16 + c], sn = p.ropes[pos * 16 + c];
            const float x1 = v[0][j], x2 = v[1][j];
            v[0][j] = x1 * cs - x2 * sn; v[1][j] = x1 * sn + x2 * cs;
          }
        }
        if (ok) {
          *(uint2*)(Qb + (size_t)m * 768 + n0 + 4 * fq) = pk4(v[0][0], v[0][1], v[0][2], v[0][3]);
          *(uint2*)(Qb + (size_t)m * 768 + n0 + 16 + 4 * fq) = pk4(v[1][0], v[1][1], v[1][2], v[1][3]);
        }
      }
    }
  }
};
struct EpiOut {
  const Prm& p; int L;
  DEV void operator()(f32x4 (&acc)[4][4], int mb, int nb, int fr, int fq) const {
#pragma unroll
    for (int mi = 0; mi < 4; ++mi) {
      const int m = mb + 16 * mi + fr;
      const bool ok = m < NT;
      bf16_t* xr = p.xb + (size_t)(ok ? m : 0) * D;
      float ss = 0.f;
#pragma unroll
      for (int g = 0; g < 2; ++g) {
        const int col = nb + 32 * g + 8 * fq;
        const uint4 xi = *(const uint4*)(xr + col);
        float v[8] = {bflo(xi.x), bfhi(xi.x), bflo(xi.y), bfhi(xi.y), bflo(xi.z), bfhi(xi.z), bflo(xi.w), bfhi(xi.w)};
#pragma unroll
        for (int j = 0; j < 4; ++j) { v[j] += acc[mi][2 * g][j]; v[4 + j] += acc[mi][2 * g + 1][j]; }
#pragma unroll
        for (int j = 0; j < 8; ++j) ss += v[j] * v[j];
        if (ok) { uint4 o; o.x = pk2(v[0], v[1]); o.y = pk2(v[2], v[3]); o.z = pk2(v[4], v[5]); o.w = pk2(v[6], v[7]); *(uint4*)(xr + col) = o; }
      }
      ss += __shfl_xor(ss, 16); ss += __shfl_xor(ss, 32);
      if (fq == 0 && ok) atomicAdd(p.ssq_x + (L + 1) * NTP + m, ss);
    }
  }
};

DEV void kv_prep_row(const Prm& p, int L, int R, int half, bool valid, bf16_t* At_row  ) {
  const int Rl = valid ? R : 0;
  const bf16_t* zr = p.zE + (size_t)Rl * ZE;
  const float rstd = rsqrtf(p.ssq_kv[L * NTP + Rl] * (1.f / 128.f) + RMS_EPS);
  float* outc; float* outk;
  if (Rl < NPR) { const int s = Rl / PT, q = Rl - s * PT; outc = p.ckv_p + (((size_t)L * 4 + s) * PT + q) * 128; outk = p.kr_p + (((size_t)L * 4 + s) * PT + q) * 32; }
  else { const int j = Rl - NPR; outc = p.ckv_s + ((size_t)L * NSM + j) * 128; outk = p.kr_s + ((size_t)L * NSM + j) * 32; }
  const float* g = p.kv_norm_g + L * 128 + 64 * half;
#pragma unroll
  for (int c8 = 0; c8 < 8; ++c8) {
    const uint4 u = *(const uint4*)(zr + ZE_CKV + 64 * half + 8 * c8);
    const float4 g0 = *(const float4*)(g + 8 * c8), g1 = *(const float4*)(g + 8 * c8 + 4);
    float4 y0, y1;
    y0.x = bflo(u.x) * rstd * g0.x; y0.y = bfhi(u.x) * rstd * g0.y; y0.z = bflo(u.y) * rstd * g0.z; y0.w = bfhi(u.y) * rstd * g0.w;
    y1.x = bflo(u.z) * rstd * g1.x; y1.y = bfhi(u.z) * rstd * g1.y; y1.z = bflo(u.w) * rstd * g1.z; y1.w = bfhi(u.w) * rstd * g1.w;
    if (valid) { *(float4*)(outc + 64 * half + 8 * c8) = y0; *(float4*)(outc + 64 * half + 8 * c8 + 4) = y1; }
    if (At_row) { uint4 o; o.x = pk2(y0.x, y0.y); o.y = pk2(y0.z, y0.w); o.z = pk2(y1.x, y1.y); o.w = pk2(y1.z, y1.w); *(uint4*)(At_row + 64 * half + 8 * c8) = o; }
    if (valid && Rl >= NPR) {
      const int j = Rl - NPR, b = j >> 6, r = j & 63;
      bf16_t* kl = p.KL + ((size_t)b * SKEYS + 1024 + r) * 160 + 16 * (4 * half + (c8 >> 1)) + 4 * (c8 & 1);
      *(uint2*)kl = pk4(y0.x, y0.y, y0.z, y0.w); *(uint2*)(kl + 8) = pk4(y1.x, y1.y, y1.z, y1.w);
    }
    if (c8 & 1) __builtin_amdgcn_sched_barrier(0);
  }
  if (half == 0) {
    const int pos = pos_of(Rl);
#pragma unroll
    for (int c8 = 0; c8 < 2; ++c8) {
      const uint4 u = *(const uint4*)(zr + ZE_KR + 8 * c8), v = *(const uint4*)(zr + ZE_KR + 16 + 8 * c8);
      const float x1[8] = {bflo(u.x), bfhi(u.x), bflo(u.y), bfhi(u.y), bflo(u.z), bfhi(u.z), bflo(u.w), bfhi(u.w)};
      const float x2[8] = {bflo(v.x), bfhi(v.x), bflo(v.y), bfhi(v.y), bflo(v.z), bfhi(v.z), bflo(v.w), bfhi(v.w)};
      float y1[8], y2[8];
#pragma unroll
      for (int e = 0; e < 8; ++e) {
        const float cs = p.ropec[pos * 16 + 8 * c8 + e], sn = p.ropes[pos * 16 + 8 * c8 + e];
        y1[e] = x1[e] * cs - x2[e] * sn; y2[e] = x1[e] * sn + x2[e] * cs;
      }
      if (valid) {
        float4 o;
        o.x = y1[0]; o.y = y1[1]; o.z = y1[2]; o.w = y1[3]; *(float4*)(outk + 8 * c8) = o;
        o.x = y1[4]; o.y = y1[5]; o.z = y1[6]; o.w = y1[7]; *(float4*)(outk + 8 * c8 + 4) = o;
        o.x = y2[0]; o.y = y2[1]; o.z = y2[2]; o.w = y2[3]; *(float4*)(outk + 16 + 8 * c8) = o;
        o.x = y2[4]; o.y = y2[5]; o.z = y2[6]; o.w = y2[7]; *(float4*)(outk + 16 + 8 * c8 + 4) = o;
        {
          const int j = Rl - NPR;
          bf16_t* krd = Rl < NPR ? p.Kr + (size_t)Rl * 32 : p.KL + ((size_t)(j >> 6) * SKEYS + 1024 + (j & 63)) * 160 + 128;
          uint4 q; q.x = pk2(y1[0], y1[1]); q.y = pk2(y1[2], y1[3]); q.z = pk2(y1[4], y1[5]); q.w = pk2(y1[6], y1[7]); *(uint4*)(krd + 8 * c8) = q;
          q.x = pk2(y2[0], y2[1]); q.y = pk2(y2[2], y2[3]); q.z = pk2(y2[4], y2[5]); q.w = pk2(y2[6], y2[7]); *(uint4*)(krd + 16 + 8 * c8) = q;
        }
      }
    }
  }
}
DEV void kvproj_item(const Prm& p, int L, int mt, char* lds) {
  int tid = threadIdx.x; LAUNDER(tid);
  const int lane = tid & 63, w = __builtin_amdgcn_readfirstlane(tid >> 6), wr = w >> 1, wc = w & 1, l31 = lane & 31, hh = lane >> 5;
  bf16_t* At = (bf16_t*)lds;
  bf16_t* Bs = At + 128 * 136;
  {
    const int r = tid >> 1, half = tid & 1, R = mt * 128 + r;
    kv_prep_row(p, L, R, half, R < NPR, At + r * 136);
  }
  for (int h = 0; h < 8; ++h) {
    __syncthreads();
    {
      const bf16_t* wsrc = p.Wb_ukv + ((size_t)L * 1024 + h * 128) * 128;
#pragma unroll
      for (int i = 0; i < 8; ++i) { const int id = tid + 256 * i, row = id >> 4, cc = id & 15; *(uint4*)(Bs + row * 136 + cc * 8) = *(const uint4*)(wsrc + row * 128 + cc * 8); }
    }
    __syncthreads();
    f32x16 acc[2][2];
#pragma unroll
    for (int i = 0; i < 2; ++i)
#pragma unroll
      for (int j = 0; j < 2; ++j) acc[i][j] = zero16();
    const bf16_t* as = At + (wr * 64 + l31) * 136 + hh * 8;
    const bf16_t* bs = Bs + (wc * 64 + l31) * 136 + hh * 8;
    if (wc == 0) {
#pragma unroll 2
      for (int ks = 0; ks < 8; ++ks) {
        const bf16x8 a0 = *(const bf16x8*)(as + ks * 16), a1 = *(const bf16x8*)(as + 32 * 136 + ks * 16);
        const bf16x8 b0 = *(const bf16x8*)(bs + ks * 16), b1 = *(const bf16x8*)(bs + 32 * 136 + ks * 16);
        acc[0][0] = mfma32(b0, a0, acc[0][0]); acc[0][1] = mfma32(b1, a0, acc[0][1]);
        acc[1][0] = mfma32(b0, a1, acc[1][0]); acc[1][1] = mfma32(b1, a1, acc[1][1]);
      }
#pragma unroll
      for (int i = 0; i < 2; ++i) {
        const int KRr = mt * 128 + wr * 64 + 32 * i + l31;
#pragma unroll
        for (int j = 0; j < 2; ++j)
#pragma unroll
          for (int G = 0; G < 4; ++G)
            *(uint2*)(p.Kn + ((size_t)KRr * 8 + h) * 64 + 32 * j + 8 * G + 4 * hh) = pk4(acc[i][j][4 * G], acc[i][j][4 * G + 1], acc[i][j][4 * G + 2], acc[i][j][4 * G + 3]);
      }
    } else {
#pragma unroll 2
      for (int ks = 0; ks < 8; ++ks) {
        const bf16x8 a0 = *(const bf16x8*)(as + ks * 16), a1 = *(const bf16x8*)(as + 32 * 136 + ks * 16);
        const bf16x8 b0 = *(const bf16x8*)(bs + ks * 16), b1 = *(const bf16x8*)(bs + 32 * 136 + ks * 16);
        acc[0][0] = mfma32(a0, b0, acc[0][0]); acc[0][1] = mfma32(a0, b1, acc[0][1]);
        acc[1][0] = mfma32(a1, b0, acc[1][0]); acc[1][1] = mfma32(a1, b1, acc[1][1]);
      }
#pragma unroll
      for (int j = 0; j < 2; ++j) {
        const int d = 32 * j + l31;
#pragma unroll
        for (int i = 0; i < 2; ++i)
#pragma unroll
          for (int G = 0; G < 4; ++G) {
            const int KRr = mt * 128 + wr * 64 + 32 * i + 16 * (G >> 1) + 8 * hh + 4 * (G & 1);
            *(uint2*)(p.Vt + ((size_t)h * 64 + d) * KVR + KRr) = pk4(acc[i][j][4 * G], acc[i][j][4 * G + 1], acc[i][j][4 * G + 2], acc[i][j][4 * G + 3]);
          }
      }
    }
  }
  __syncthreads();
}
DEV void sample_prep_item(const Prm& p, int L, int it) {
  int tid = threadIdx.x; LAUNDER(tid);
  const int R = NPR + it * 128 + (tid >> 1);
  kv_prep_row(p, L, R, tid & 1, true, nullptr);
}
DEV void shift_item(const Prm& p, int L, int st) {
  int tid0 = threadIdx.x; LAUNDER(tid0);
  if (tid0 < 224) {
    const int R = st < 4 ? st * PT + (PT - 1) : NPR + (st - 4) * 64 + 63;
    const uint2 u = *(const uint2*)(p.zE + (size_t)R * ZE + ZE_ZC + 4 * tid0);
    float4 v; v.x = bflo(u.x); v.y = bfhi(u.x); v.z = bflo(u.y); v.w = bfhi(u.y);
    float* dst = st < 4 ? p.shift_p + ((size_t)L * 4 + st) * 896 : p.shift_s + ((size_t)L * 32 + (st - 4)) * 896;
    *(float4*)(dst + 4 * tid0) = v;
  }
}

DEV void lat_item(const Prm& p, int L, int j) {
  int tid = threadIdx.x; LAUNDER(tid);
  const int b = j >> 4, t = j & 15;
  const float* csrc = p.cache_ckv + (((size_t)L * 32 + b) * 1024 + 64 * t) * 128;
  const float* ksrc = p.cache_krope + (((size_t)L * 32 + b) * 1024 + 64 * t) * 32;
  {
    const int row = tid >> 2, qd = tid & 3;
    const float* s = csrc + row * 128 + 32 * qd;
    bf16_t* d = p.KL + ((size_t)b * SKEYS + 64 * t + row) * 160;
    const float4 v0 = *(const float4*)(s), v1 = *(const float4*)(s + 4), v2 = *(const float4*)(s + 8), v3 = *(const float4*)(s + 12);
    const float4 v4 = *(const float4*)(s + 16), v5 = *(const float4*)(s + 20), v6 = *(const float4*)(s + 24), v7 = *(const float4*)(s + 28);
    const float4 k0 = *(const float4*)(ksrc + row * 32 + 8 * qd), k1 = *(const float4*)(ksrc + row * 32 + 8 * qd + 4);
    uint4 a;
    a.x = pk2(v0.x, v0.y); a.y = pk2(v0.z, v0.w); a.z = pk2(v2.x, v2.y); a.w = pk2(v2.z, v2.w); *(uint4*)(d + 32 * qd) = a;
    a.x = pk2(v1.x, v1.y); a.y = pk2(v1.z, v1.w); a.z = pk2(v3.x, v3.y); a.w = pk2(v3.z, v3.w); *(uint4*)(d + 32 * qd + 8) = a;
    a.x = pk2(v4.x, v4.y); a.y = pk2(v4.z, v4.w); a.z = pk2(v6.x, v6.y); a.w = pk2(v6.z, v6.w); *(uint4*)(d + 32 * qd + 16) = a;
    a.x = pk2(v5.x, v5.y); a.y = pk2(v5.z, v5.w); a.z = pk2(v7.x, v7.y); a.w = pk2(v7.z, v7.w); *(uint4*)(d + 32 * qd + 24) = a;
    a.x = pk2(k0.x, k0.y); a.y = pk2(k0.z, k0.w); a.z = pk2(k1.x, k1.y); a.w = pk2(k1.z, k1.w); *(uint4*)(d + 128 + 8 * qd) = a;
  }
}

template <bool SAMPLE>
DEV int attn_body(const Prm& p, int L, int sb, int head, int qt, char* lds, unsigned* nctr = nullptr) {
  int tid = threadIdx.x; LAUNDER(tid);
  const int lane = tid & 63, w = __builtin_amdgcn_readfirstlane(tid >> 6), l31 = lane & 31, hh = lane >> 5;
  bf16_t* Ks = (bf16_t*)lds;
  bf16_t* Vs = Ks + (SAMPLE ? 1 : 2) * 64 * 104;
  bf16_t* Cs = Vs + (SAMPLE ? 1 : 2) * 64 * 72;
  bf16_t* Wl = Cs + 64 * 136;
  const bf16_t* Qb = (const bf16_t*)p.y_prompt;
  bf16_t* mix = p.zE;
  int Rq0, ntiles, lastvis; bool wact, rowvalid;
  if (SAMPLE) { Rq0 = NPR + 64 * sb; ntiles = 17; lastvis = 16; wact = w < 2; rowvalid = wact; }
  else if (qt >= 0) { Rq0 = sb * PT + 16 + 128 * qt; ntiles = 2 * qt + 3; lastvis = 1 + 2 * qt + (w >> 1); wact = true; rowvalid = true; }
  else { Rq0 = sb * PT; ntiles = 1; lastvis = 0; wact = (w == 0); rowvalid = wact && l31 < 16; }
  const int myrow = Rq0 + 32 * w + l31;
  const int Rld = rowvalid ? myrow : Rq0;
  bf16x8 qf[6];
  {
    const bf16_t* qp = Qb + (size_t)Rld * 768 + head * 96 + hh * 8;
#pragma unroll
    for (int ks = 0; ks < 6; ++ks) qf[ks] = *(const bf16x8*)(qp + 16 * ks);
  }
  float m_run = -1e30f, l_run = 0.f;
  f32x16 o0 = zero16(), o1 = zero16();

  uint4 a_kn0, a_kn1, a_kr, a_vt0, a_vt1;
  a_kn0 = a_kn1 = a_kr = a_vt0 = a_vt1 = make_uint4(0, 0, 0, 0);
#define PLOADX(S, TI) { const int KR0 = sb * PT + ((TI) == 0 ? 0 : 16 + 64 * ((TI) - 1)); \
    S##_kn0 = *(const uint4*)(p.Kn + ((size_t)(KR0 + (tid >> 3)) * 8 + head) * 64 + (tid & 7) * 8); \
    S##_kn1 = *(const uint4*)(p.Kn + ((size_t)(KR0 + 32 + (tid >> 3)) * 8 + head) * 64 + (tid & 7) * 8); \
    S##_kr = *(const uint4*)(p.Kr + (size_t)(KR0 + (tid >> 2)) * 32 + (tid & 3) * 8); \
    S##_vt0 = *(const uint4*)(p.Vt + ((size_t)head * 64 + (tid >> 3)) * KVR + KR0 + (tid & 7) * 8); \
    S##_vt1 = *(const uint4*)(p.Vt + ((size_t)head * 64 + 32 + (tid >> 3)) * KVR + KR0 + (tid & 7) * 8); }
#define PWRITEX(S, BUF) { bf16_t* kb_ = Ks + (BUF) * 64 * 104; bf16_t* vb_ = Vs + (BUF) * 64 * 72; \
    *(uint4*)(kb_ + (tid >> 3) * 104 + (tid & 7) * 8) = S##_kn0; *(uint4*)(kb_ + (32 + (tid >> 3)) * 104 + (tid & 7) * 8) = S##_kn1; \
    *(uint4*)(kb_ + (tid >> 2) * 104 + 64 + (tid & 3) * 8) = S##_kr; \
    *(uint4*)(vb_ + (tid >> 3) * 72 + (tid & 7) * 8) = S##_vt0; *(uint4*)(vb_ + (32 + (tid >> 3)) * 72 + (tid & 7) * 8) = S##_vt1; }
  float4 pc0, pc1, pc2, pc3, pc4, pc5, pc6, pc7, pk0, pk1;
  pc0 = pc1 = pc2 = pc3 = pc4 = pc5 = pc6 = pc7 = pk0 = pk1 = make_float4(0.f, 0.f, 0.f, 0.f);
  if (SAMPLE) {
    const bf16_t* wsrc = p.Wb_ukv + ((size_t)L * 1024 + head * 128) * 128;
#pragma unroll
    for (int i = 0; i < 8; ++i) { const int id = tid + 256 * i, row = id >> 4, cc = id & 15; *(uint4*)(Wl + row * 136 + cc * 8) = *(const uint4*)(wsrc + row * 128 + cc * 8); }
  }
#define SLOAD(TI) { const float* csrc; const float* ksrc; \
    if ((TI) < 16) { csrc = p.cache_ckv + (((size_t)L * 32 + sb) * 1024 + 64 * (TI)) * 128; ksrc = p.cache_krope + (((size_t)L * 32 + sb) * 1024 + 64 * (TI)) * 32; } \
    else { csrc = p.ckv_s + ((size_t)L * NSM + 64 * sb) * 128; ksrc = p.kr_s + ((size_t)L * NSM + 64 * sb) * 32; } \
    const float* cb_ = csrc + (tid >> 5) * 128 + (tid & 31) * 4; \
    pc0 = *(const float4*)(cb_); pc1 = *(const float4*)(cb_ + 8 * 128); pc2 = *(const float4*)(cb_ + 16 * 128); pc3 = *(const float4*)(cb_ + 24 * 128); \
    pc4 = *(const float4*)(cb_ + 32 * 128); pc5 = *(const float4*)(cb_ + 40 * 128); pc6 = *(const float4*)(cb_ + 48 * 128); pc7 = *(const float4*)(cb_ + 56 * 128); \
    const float* kb2_ = ksrc + (tid >> 3) * 32 + (tid & 7) * 4; pk0 = *(const float4*)(kb2_); pk1 = *(const float4*)(kb2_ + 32 * 32); }
#define SWRITE(BUF) { bf16_t* cd_ = Cs + (tid >> 5) * 136 + (tid & 31) * 4; \
    *(uint2*)(cd_) = pk4(pc0.x, pc0.y, pc0.z, pc0.w); *(uint2*)(cd_ + 8 * 136) = pk4(pc1.x, pc1.y, pc1.z, pc1.w); \
    *(uint2*)(cd_ + 16 * 136) = pk4(pc2.x, pc2.y, pc2.z, pc2.w); *(uint2*)(cd_ + 24 * 136) = pk4(pc3.x, pc3.y, pc3.z, pc3.w); \
    *(uint2*)(cd_ + 32 * 136) = pk4(pc4.x, pc4.y, pc4.z, pc4.w); *(uint2*)(cd_ + 40 * 136) = pk4(pc5.x, pc5.y, pc5.z, pc5.w); \
    *(uint2*)(cd_ + 48 * 136) = pk4(pc6.x, pc6.y, pc6.z, pc6.w); *(uint2*)(cd_ + 56 * 136) = pk4(pc7.x, pc7.y, pc7.z, pc7.w); \
    }
#define SWRITEK(BUF) { bf16_t* kd_ = Ks + (BUF) * 64 * 104 + (tid >> 3) * 104 + 64 + (tid & 7) * 4; \
    *(uint2*)(kd_) = pk4(pk0.x, pk0.y, pk0.z, pk0.w); *(uint2*)(kd_ + 32 * 104) = pk4(pk1.x, pk1.y, pk1.z, pk1.w); }
  auto sexpand = [&](int buf) {
    const int a = w & 1, b = w >> 1;
    const bf16_t* cp = Cs + (32 * b + l31) * 136 + hh * 8;
    const bf16_t* wkp = Wl + (32 * a + l31) * 136 + hh * 8;
    const bf16_t* wvp = wkp + 64 * 136;
    f32x16 ka = zero16(), va = zero16();
#pragma unroll
    for (int ks = 0; ks < 8; ++ks) {
      const bf16x8 cf = *(const bf16x8*)(cp + 16 * ks);
      ka = mfma32(*(const bf16x8*)(wkp + 16 * ks), cf, ka);
      va = mfma32(cf, *(const bf16x8*)(wvp + 16 * ks), va);
    }
    bf16_t* kb = Ks + buf * 64 * 104; bf16_t* vb = Vs + buf * 64 * 72;
#pragma unroll
    for (int G = 0; G < 4; ++G) {
      *(uint2*)(kb + (32 * b + l31) * 104 + 32 * a + 8 * G + 4 * hh) = pk4(ka[4 * G], ka[4 * G + 1], ka[4 * G + 2], ka[4 * G + 3]);
      *(uint2*)(vb + (32 * a + l31) * 72 + 32 * b + 8 * G + 4 * hh) = pk4(va[4 * G], va[4 * G + 1], va[4 * G + 2], va[4 * G + 3]);
    }
  };
  const int x7 = (l31 >> 1) & 7, x3 = (l31 >> 2) & 3, xv = (l31 >> 1) & 7;
#define KFRAG(SP, KS, SUB) (SAMPLE ? *(const bf16x8*)((const bf16_t*)(SP) + (l31 + 32 * (SUB)) * 104 + hh * 8 + 16 * (KS)) \
    : ((KS) < 4 ? *(const bf16x8*)((SP) + (l31 + 32 * (SUB)) * 128 + (((2 * (KS) + hh) ^ x7) << 4)) \
                : *(const bf16x8*)((SP) + 8192 + (l31 + 32 * (SUB)) * 64 + (((2 * ((KS) - 4) + hh) ^ x3) << 4))))
#define VHALF(SP, C, SUB) (SAMPLE ? *(const uint2*)((const bf16_t*)(SP) + 64 * 104 + (l31 + 32 * (SUB)) * 72 + 4 * hh + 8 * (C)) \
    : *(const uint2*)((SP) + 12288 + (l31 + 32 * (SUB)) * 128 + 8 * hh + ((((C)) ^ xv) << 4)))
  auto compute_t = [&](auto masked_c, const char* sp) {
    constexpr bool MASKED = decltype(masked_c)::value;
    f32x16 s0 = zero16(), s1 = zero16();
#pragma unroll
    for (int ks = 0; ks < 6; ++ks) {
      const bf16x8 k0 = KFRAG(sp, ks, 0), k1 = KFRAG(sp, ks, 1);
      s0 = mfma32(k0, qf[ks], s0); s1 = mfma32(k1, qf[ks], s1);
    }
    if (!SAMPLE && MASKED) {
#pragma unroll
      for (int r = 8; r < 16; ++r) s0[r] = -1e30f;
#pragma unroll
      for (int r = 0; r < 16; ++r) s1[r] = -1e30f;
    }
    float mx = s0[0];
#pragma unroll
    for (int r = 1; r < 16; ++r) mx = fmaxf(mx, s0[r]);
#pragma unroll
    for (int r = 0; r < 16; ++r) mx = fmaxf(mx, s1[r]);
    mx = fmaxf(mx, __shfl_xor(mx, 32));
    const float mnew = fmaxf(m_run, mx);
    const float alpha = __builtin_amdgcn_exp2f(m_run - mnew);
    m_run = mnew;
    float ps = 0.f;
#pragma unroll
    for (int r = 0; r < 16; ++r) { s0[r] = __builtin_amdgcn_exp2f(s0[r] - mnew); ps += s0[r]; }
#pragma unroll
    for (int r = 0; r < 16; ++r) { s1[r] = __builtin_amdgcn_exp2f(s1[r] - mnew); ps += s1[r]; }
    l_run = l_run * alpha + ps;
#pragma unroll
    for (int r = 0; r < 16; ++r) { o0[r] *= alpha; o1[r] *= alpha; }
    const bf16x8 pf0 = mk8(pk2(s0[0], s0[1]), pk2(s0[2], s0[3]), pk2(s0[4], s0[5]), pk2(s0[6], s0[7]));
    const bf16x8 pf1 = mk8(pk2(s0[8], s0[9]), pk2(s0[10], s0[11]), pk2(s0[12], s0[13]), pk2(s0[14], s0[15]));
    const bf16x8 pf2 = mk8(pk2(s1[0], s1[1]), pk2(s1[2], s1[3]), pk2(s1[4], s1[5]), pk2(s1[6], s1[7]));
    const bf16x8 pf3 = mk8(pk2(s1[8], s1[9]), pk2(s1[10], s1[11]), pk2(s1[12], s1[13]), pk2(s1[14], s1[15]));
#define PV_STEP(S, PF) { bf16x8 v0_, v1_; \
      if (SAMPLE) { const uint2 a0 = VHALF(sp, 2 * S, 0), b0 = VHALF(sp, 2 * S + 1, 0), a1 = VHALF(sp, 2 * S, 1), b1 = VHALF(sp, 2 * S + 1, 1); \
        v0_ = mk8(a0.x, a0.y, b0.x, b0.y); v1_ = mk8(a1.x, a1.y, b1.x, b1.y); } \
      else { v0_ = *(const bf16x8*)(sp + 12288 + l31 * 128 + (((2 * S + hh) ^ xv) << 4)); v1_ = *(const bf16x8*)(sp + 12288 + (l31 + 32) * 128 + (((2 * S + hh) ^ xv) << 4)); } \
      o0 = mfma32(v0_, PF, o0); o1 = mfma32(v1_, PF, o1); }
    PV_STEP(0, pf0) PV_STEP(1, pf1) PV_STEP(2, pf2) PV_STEP(3, pf3)
  };
  bf16x8 qf7 = mk8(0u, 0u, 0u, 0u);
  const bf16x8 kone = mk8(hh == 0 ? 0x3F80u : 0u, 0u, 0u, 0u);
  auto freeze = [&]() {
    const float mf = bflo(pk2(m_run, 0.f));
    const float fac = __builtin_amdgcn_exp2f(m_run - mf);
    l_run *= fac;
#pragma unroll
    for (int r = 0; r < 16; ++r) { o0[r] *= fac; o1[r] *= fac; }
    qf7 = mk8(hh == 0 ? (pk2(-mf, 0.f) & 0xffffu) : 0u, 0u, 0u, 0u);
  };
  auto compute_f = [&](const char* sp) {
    f32x16 s0 = mfma32(kone, qf7, zero16()), s1 = mfma32(kone, qf7, zero16());
#pragma unroll
    for (int ks = 0; ks < 6; ++ks) {
      const bf16x8 k0 = KFRAG(sp, ks, 0), k1 = KFRAG(sp, ks, 1);
      s0 = mfma32(k0, qf[ks], s0); s1 = mfma32(k1, qf[ks], s1);
    }
    float ps = 0.f;
#pragma unroll
    for (int r = 0; r < 16; ++r) { s0[r] = __builtin_amdgcn_exp2f(s0[r]); ps += s0[r]; }
#pragma unroll
    for (int r = 0; r < 16; ++r) { s1[r] = __builtin_amdgcn_exp2f(s1[r]); ps += s1[r]; }
    l_run += ps;
    const bf16x8 pf0 = mk8(pk2(s0[0], s0[1]), pk2(s0[2], s0[3]), pk2(s0[4], s0[5]), pk2(s0[6], s0[7]));
    const bf16x8 pf1 = mk8(pk2(s0[8], s0[9]), pk2(s0[10], s0[11]), pk2(s0[12], s0[13]), pk2(s0[14], s0[15]));
    const bf16x8 pf2 = mk8(pk2(s1[0], s1[1]), pk2(s1[2], s1[3]), pk2(s1[4], s1[5]), pk2(s1[6], s1[7]));
    const bf16x8 pf3 = mk8(pk2(s1[8], s1[9]), pk2(s1[10], s1[11]), pk2(s1[12], s1[13]), pk2(s1[14], s1[15]));
    PV_STEP(0, pf0) PV_STEP(1, pf1) PV_STEP(2, pf2) PV_STEP(3, pf3)
#undef PV_STEP
  };

  if (SAMPLE) {
    SLOAD(0)
    for (int ti = 0; ti < ntiles; ++ti) {
      const int buf = 0;
      SWRITE(buf)
      __syncthreads();
      SWRITEK(buf)
      { const int tn = ti + 1 < ntiles ? ti + 1 : ti; SLOAD(tn) }
      sexpand(buf);
      __syncthreads();
      if (wact) { if (ti == 0) { compute_t(std::false_type{}, (const char*)Ks); freeze(); } else compute_f((const char*)Ks); }
    }
    __syncthreads();
  } else {
    const int l8 = lane >> 3, c8 = lane & 7;
    unsigned kn_o0, kn_o1, kr_o, vt_o0, vt_o1;
    { const int r = 8 * (2 * w) + l8; kn_o0 = (unsigned)((r * 8 + head) * 64 + ((c8 ^ ((r >> 1) & 7)) * 8)); }
    { const int r = 8 * (2 * w + 1) + l8; kn_o1 = (unsigned)((r * 8 + head) * 64 + ((c8 ^ ((r >> 1) & 7)) * 8)); }
    { const int r = 16 * w + (lane >> 2); kr_o = (unsigned)(r * 32 + (((lane & 3) ^ ((r >> 2) & 3)) * 8)); }
    { const int d = 8 * (2 * w) + l8; vt_o0 = (unsigned)((head * 64 + d) * KVR + ((c8 ^ ((d >> 1) & 7)) * 8)); }
    { const int d = 8 * (2 * w + 1) + l8; vt_o1 = (unsigned)((head * 64 + d) * KVR + ((c8 ^ ((d >> 1) & 7)) * 8)); }
#define GLDS16(G, Lp) __builtin_amdgcn_global_load_lds((const unsigned*)(G), (LAS3 unsigned*)(Lp), 16, 0, 0)
#define PDMA(TI, STG) { const int KR0 = sb * PT + ((TI) == 0 ? 0 : 16 + 64 * ((TI) - 1)); char* sb_ = lds + (STG) * 20480 + lane * 16; \
      const bf16_t* kn_ = p.Kn + (size_t)KR0 * 512; const bf16_t* kr_ = p.Kr + (size_t)KR0 * 32; const bf16_t* vt_ = p.Vt + KR0; \
      GLDS16(kn_ + kn_o0, sb_ + (2 * w) * 1024); GLDS16(kn_ + kn_o1, sb_ + (2 * w + 1) * 1024); GLDS16(kr_ + kr_o, sb_ + 8192 + w * 1024); \
      GLDS16(vt_ + vt_o0, sb_ + 12288 + (2 * w) * 1024); GLDS16(vt_ + vt_o1, sb_ + 12288 + (2 * w + 1) * 1024); }
    PDMA(0, 0)
    if (ntiles > 1) PDMA(1, 1)
    int stg = 0, stg2 = 2;
    for (int ti = 0; ti < ntiles; ++ti) {
      if (ti + 1 < ntiles) asm volatile("s_waitcnt vmcnt(5)" ::: "memory"); else asm volatile("s_waitcnt vmcnt(0)" ::: "memory");
      RAW_BARRIER()
      if (ti + 2 < ntiles) PDMA(ti + 2, stg2)
      const char* sp = lds + stg * 20480;
      if (ti == 0) { if (wact) compute_t(std::true_type{}, sp); }
      else if (ti == 1) { compute_t(std::false_type{}, sp); freeze(); }
      else if (ti <= lastvis) compute_f(sp);
      stg = stg == 2 ? 0 : stg + 1; stg2 = stg2 == 2 ? 0 : stg2 + 1;
    }
    __syncthreads();
#undef PDMA
#undef GLDS16
  }
  int tk = 0x7fffffff; if (nctr && tid == 0) tk = (int)atomicAdd(nctr, 1u);
  const float lt = l_run + __shfl_xor(l_run, 32);
  if (rowvalid) {
    const float inv = 1.f / lt;
    const bf16_t* gbp = p.zL + (size_t)myrow * ZL + ZL_GB + 64 * head;
    bf16_t* op = mix + (size_t)myrow * D + 256 + 64 * head;
#pragma unroll
    for (int G = 0; G < 4; ++G) {
      const int d = 8 * G + 4 * hh;
      const uint2 g0 = *(const uint2*)(gbp + d), g1 = *(const uint2*)(gbp + 32 + d);
      *(uint2*)(op + d) = pk4(o0[4 * G] * inv * silu_(bflo(g0.x)), o0[4 * G + 1] * inv * silu_(bfhi(g0.x)), o0[4 * G + 2] * inv * silu_(bflo(g0.y)), o0[4 * G + 3] * inv * silu_(bfhi(g0.y)));
      *(uint2*)(op + 32 + d) = pk4(o1[4 * G] * inv * silu_(bflo(g1.x)), o1[4 * G + 1] * inv * silu_(bfhi(g1.x)), o1[4 * G + 2] * inv * silu_(bflo(g1.y)), o1[4 * G + 3] * inv * silu_(bfhi(g1.y)));
    }
  }
  return tk;
}
DEV void attn_item(const Prm& p, int L, int id, char* lds) {
  if (id < 1024) { const int qt = 31 - (id >> 5), sh = id & 31; attn_body<false>(p, L, sh >> 3, sh & 7, qt, lds); }
  else if (id < 1280) { const int j = id - 1024; attn_body<true>(p, L, j >> 3, j & 7, 0, lds); }
  else { const int j = id - 1280; attn_body<false>(p, L, j >> 3, j & 7, -1, lds); }
}

typedef short v4i16_t __attribute__((ext_vector_type(4)));
DEV uint2 lds_tr16(const char* pl) { const v4i16_t r = __builtin_amdgcn_ds_read_tr16_b64_v4i16((__attribute__((address_space(3))) v4i16_t*)pl); return __builtin_bit_cast(uint2, r); }
DEV void attn_sample(const Prm& p, int L, int b, int hp, char* lds) {
  int tid = threadIdx.x; LAUNDER(tid);
  const int lane = tid & 63, w = __builtin_amdgcn_readfirstlane(tid >> 6), l31 = lane & 31, hh = lane >> 5;
  const int head = 2 * hp + (w >> 1);
  const bf16_t* Qb = (const bf16_t*)p.y_prompt;
  bf16_t* mix = p.zE;
  const int myrow = NPR + 64 * b + 32 * (w & 1) + l31;
  bf16x8 qf[6];
  {
    const bf16_t* qp = Qb + (size_t)myrow * 768 + head * 96 + hh * 8;
#pragma unroll
    for (int ks = 0; ks < 6; ++ks) qf[ks] = *(const bf16x8*)(qp + 16 * ks);
  }
  unsigned kl_o0, kl_o1, kl_o2, kl_o3, kr_o;
  {
    const int l16 = lane >> 4, c16 = lane & 15;
#define KROW(i) (4 * (4 * w + (i)) + l16)
#define KLO(i) ((unsigned)(KROW(i) * 160 + ((c16 ^ (((KROW(i) & 3) << 2) | ((KROW(i) >> 2) & 3))) * 8)))
    kl_o0 = KLO(0); kl_o1 = KLO(1); kl_o2 = KLO(2); kl_o3 = KLO(3);
#undef KLO
#undef KROW
    const int r = 16 * w + (lane >> 2);
    kr_o = (unsigned)(r * 160 + 128 + (((lane & 3) ^ ((r >> 2) & 3)) * 8));
  }
  const bf16_t* klb = p.KL + (size_t)b * SKEYS * 160;
#define GLDS16(G, Lp) __builtin_amdgcn_global_load_lds((const unsigned*)(G), (LAS3 unsigned*)(Lp), 16, 0, 0)
#define SDMA(TI, STG) { char* sb_ = lds + (STG) * 20480 + lane * 16; const bf16_t* kl_ = klb + (size_t)(TI) * 64 * 160; \
    GLDS16(kl_ + kl_o0, sb_ + (4 * w) * 1024); GLDS16(kl_ + kl_o1, sb_ + (4 * w + 1) * 1024); GLDS16(kl_ + kl_o2, sb_ + (4 * w + 2) * 1024); GLDS16(kl_ + kl_o3, sb_ + (4 * w + 3) * 1024); \
    GLDS16(kl_ + kr_o, sb_ + 16384 + w * 1024); }
  SDMA(0, 0)
  SDMA(1, 1)
  bf16x8 qa0, qa1, qa2, qa3, qa4, qa5, qa6, qa7;
  {
    const float* wsrc = p.w_ukv + ((size_t)L * 128 + l31) * 1024 + head * 128 + 8 * hh;
#define QABS(CT, QA, QB) { f32x16 acc = zero16(); \
      _Pragma("unroll") for (int ks = 0; ks < 4; ++ks) { const float* s_ = wsrc + (size_t)(32 * (CT)) * 1024 + 16 * ks; const float4 a_ = *(const float4*)s_, c_ = *(const float4*)(s_ + 4); \
        acc = mfma32(mk8(pk2(a_.x, a_.y), pk2(a_.z, a_.w), pk2(c_.x, c_.y), pk2(c_.z, c_.w)), qf[ks], acc); } \
      QA = mk8(pk2(acc[0], acc[1]), pk2(acc[2], acc[3]), pk2(acc[4], acc[5]), pk2(acc[6], acc[7])); \
      QB = mk8(pk2(acc[8], acc[9]), pk2(acc[10], acc[11]), pk2(acc[12], acc[13]), pk2(acc[14], acc[15])); }
    QABS(0, qa0, qa1) QABS(1, qa2, qa3) QABS(2, qa4, qa5) QABS(3, qa6, qa7)
#undef QABS
  }
  float m_run = -1e30f, l_run = 0.f;
  f32x16 o0 = zero16(), o1 = zero16(), o2 = zero16(), o3 = zero16();
  bf16x8 qf7 = mk8(0u, 0u, 0u, 0u);
  const bf16x8 kone = mk8(hh == 0 ? 0x3F80u : 0u, 0u, 0u, 0u);
  const int xk = ((l31 & 3) << 2) | ((l31 >> 2) & 3), x3 = (l31 >> 2) & 3;
  int va0, va1;
  {
    const int g = l31 >> 4, q = (l31 >> 2) & 3, pp = l31 & 3;
    const int rowb = (4 * hh + q) * 256 + 8 * (pp & 1) + (q << 6);
    va0 = rowb + (((2 * g + (pp >> 1)) ^ hh) << 4);
    va1 = rowb + 2048 + (((2 * g + (pp >> 1)) ^ (hh + 2)) << 4);
  }
  int stg = 0, stg2 = 2;
  for (int ti = 0; ti < 17; ++ti) {
    if (ti + 1 < 17) asm volatile("s_waitcnt vmcnt(5)" ::: "memory"); else asm volatile("s_waitcnt vmcnt(0)" ::: "memory");
    RAW_BARRIER()
    if (ti + 2 < 17) SDMA(ti + 2, stg2)
    const char* sp = lds + stg * 20480;
    f32x16 s0 = mfma32(kone, qf7, zero16()), s1 = s0;
#define QKL(S, QA) { const bf16x8 k0 = *(const bf16x8*)(sp + l31 * 256 + (((2 * (S) + hh) ^ xk) << 4)), k1 = *(const bf16x8*)(sp + (l31 + 32) * 256 + (((2 * (S) + hh) ^ xk) << 4)); \
      s0 = mfma32(k0, QA, s0); s1 = mfma32(k1, QA, s1); }
    QKL(0, qa0) QKL(1, qa1) QKL(2, qa2) QKL(3, qa3) QKL(4, qa4) QKL(5, qa5) QKL(6, qa6) QKL(7, qa7)
#undef QKL
#pragma unroll
    for (int kr = 0; kr < 2; ++kr) {
      const bf16x8 k0 = *(const bf16x8*)(sp + 16384 + l31 * 64 + (((2 * kr + hh) ^ x3) << 4)), k1 = *(const bf16x8*)(sp + 16384 + (l31 + 32) * 64 + (((2 * kr + hh) ^ x3) << 4));
      s0 = mfma32(k0, qf[4 + kr], s0); s1 = mfma32(k1, qf[4 + kr], s1);
    }
    float ps = 0.f;
    if (ti == 0) {
      float mx = s0[0];
#pragma unroll
      for (int r = 1; r < 16; ++r) mx = fmaxf(mx, s0[r]);
#pragma unroll
      for (int r = 0; r < 16; ++r) mx = fmaxf(mx, s1[r]);
      mx = fmaxf(mx, __shfl_xor(mx, 32));
      m_run = bflo(pk2(mx, 0.f));
#pragma unroll
      for (int r = 0; r < 16; ++r) { s0[r] -= m_run; s1[r] -= m_run; }
      qf7 = mk8(hh == 0 ? (pk2(-m_run, 0.f) & 0xffffu) : 0u, 0u, 0u, 0u);
    }
#pragma unroll
    for (int r = 0; r < 16; ++r) { s0[r] = __builtin_amdgcn_exp2f(s0[r]); ps += s0[r]; }
#pragma unroll
    for (int r = 0; r < 16; ++r) { s1[r] = __builtin_amdgcn_exp2f(s1[r]); ps += s1[r]; }
    l_run += ps;
    const bf16x8 pf0 = mk8(pk2(s0[0], s0[1]), pk2(s0[2], s0[3]), pk2(s0[4], s0[5]), pk2(s0[6], s0[7]));
    const bf16x8 pf1 = mk8(pk2(s0[8], s0[9]), pk2(s0[10], s0[11]), pk2(s0[12], s0[13]), pk2(s0[14], s0[15]));
    const bf16x8 pf2 = mk8(pk2(s1[0], s1[1]), pk2(s1[2], s1[3]), pk2(s1[4], s1[5]), pk2(s1[6], s1[7]));
    const bf16x8 pf3 = mk8(pk2(s1[8], s1[9]), pk2(s1[10], s1[11]), pk2(s1[12], s1[13]), pk2(s1[14], s1[15]));
#define PVT(S, CT, PF, OT) { const uint2 a_ = lds_tr16(sp + (va0 ^ ((CT) << 6)) + (S) * 4096), b_ = lds_tr16(sp + (va1 ^ ((CT) << 6)) + (S) * 4096); \
      OT = mfma32(mk8(a_.x, a_.y, b_.x, b_.y), PF, OT); }
#define PVL(S, PF) PVT(S, 0, PF, o0) PVT(S, 1, PF, o1) PVT(S, 2, PF, o2) PVT(S, 3, PF, o3)
    PVL(0, pf0) PVL(1, pf1) PVL(2, pf2) PVL(3, pf3)
#undef PVL
#undef PVT
    stg = stg == 2 ? 0 : stg + 1; stg2 = stg2 == 2 ? 0 : stg2 + 1;
  }
#undef SDMA
#undef GLDS16
  __syncthreads();
  const float lt = l_run + __shfl_xor(l_run, 32);
  const float inv = 1.f / lt;
  f32x16 e0 = zero16(), e1 = zero16();
  const bf16_t* wv = p.Wb_ukv + ((size_t)L * 1024 + head * 128 + 64 + l31) * 128 + 8 * hh;
#define OEXP(S, OT, RB) { const bf16x8 ob = mk8(pk2(OT[RB] * inv, OT[RB + 1] * inv), pk2(OT[RB + 2] * inv, OT[RB + 3] * inv), pk2(OT[RB + 4] * inv, OT[RB + 5] * inv), pk2(OT[RB + 6] * inv, OT[RB + 7] * inv)); \
    e0 = mfma32(*(const bf16x8*)(wv + 16 * (S)), ob, e0); e1 = mfma32(*(const bf16x8*)(wv + 32 * 128 + 16 * (S)), ob, e1); }
  OEXP(0, o0, 0) OEXP(1, o0, 8) OEXP(2, o1, 0) OEXP(3, o1, 8) OEXP(4, o2, 0) OEXP(5, o2, 8) OEXP(6, o3, 0) OEXP(7, o3, 8)
#undef OEXP
  {
    const bf16_t* gbp = p.zL + (size_t)myrow * ZL + ZL_GB + 64 * head;
    bf16_t* op = mix + (size_t)myrow * D + 256 + 64 * head;
#pragma unroll
    for (int G = 0; G < 4; ++G) {
      const int d = 8 * G + 4 * hh;
      const uint2 g0 = *(const uint2*)(gbp + d), g1 = *(const uint2*)(gbp + 32 + d);
      *(uint2*)(op + d) = pk4(e0[4 * G] * silu_(bflo(g0.x)), e0[4 * G + 1] * silu_(bfhi(g0.x)), e0[4 * G + 2] * silu_(bflo(g0.y)), e0[4 * G + 3] * silu_(bfhi(g0.y)));
      *(uint2*)(op + 32 + d) = pk4(e1[4 * G] * silu_(bflo(g1.x)), e1[4 * G + 1] * silu_(bfhi(g1.x)), e1[4 * G + 2] * silu_(bflo(g1.y)), e1[4 * G + 3] * silu_(bfhi(g1.y)));
    }
  }
}

DEV void conv_item(const Prm& p, int L, int item) {
  int tid = threadIdx.x; LAUNDER(tid);
  bf16_t* mix = p.zE;
  const int c0 = (tid & 31) * 8;
  float w0[8], w1[8], w2[8];
#pragma unroll
  for (int e = 0; e < 8; ++e) { w0[e] = p.conv_w[(L * 3 + 0) * 256 + c0 + e]; w1[e] = p.conv_w[(L * 3 + 1) * 256 + c0 + e]; w2[e] = p.conv_w[(L * 3 + 2) * 256 + c0 + e]; }
  for (int it = 0; it < 4; ++it) {
    const int R = item * 32 + it * 8 + (tid >> 5);
    if (R >= NT) continue;
    int q, T; const float* st; float* so;
    if (R < NPR) { const int s = R / PT; q = R - s * PT; T = PT; st = nullptr; so = p.conv_p + ((size_t)L * 4 + s) * 512; }
    else { const int b = (R - NPR) >> 6; q = (R - NPR) & 63; T = 64; st = p.state_conv + ((size_t)L * 32 + b) * 512; so = p.conv_s + ((size_t)L * 32 + b) * 512; }
    float u[3][8];
#pragma unroll
    for (int dlt = 0; dlt < 3; ++dlt) {
      const int t = q - 2 + dlt;
      if (t >= 0) {
        const bf16_t* zr = p.zL + (size_t)(R - 2 + dlt) * ZL;
        const uint4 xi = *(const uint4*)(zr + ZL_XIN + c0), cg = *(const uint4*)(zr + ZL_CG + c0);
        u[dlt][0] = bflo(xi.x) * bflo(cg.x); u[dlt][1] = bfhi(xi.x) * bfhi(cg.x); u[dlt][2] = bflo(xi.y) * bflo(cg.y); u[dlt][3] = bfhi(xi.y) * bfhi(cg.y);
        u[dlt][4] = bflo(xi.z) * bflo(cg.z); u[dlt][5] = bfhi(xi.z) * bfhi(cg.z); u[dlt][6] = bflo(xi.w) * bflo(cg.w); u[dlt][7] = bfhi(xi.w) * bfhi(cg.w);
      } else if (st) {
        const float* sr = st + (t + 2) * 256 + c0;
#pragma unroll
        for (int e = 0; e < 8; ++e) u[dlt][e] = sr[e];
      } else {
#pragma unroll
        for (int e = 0; e < 8; ++e) u[dlt][e] = 0.f;
      }
    }
    const bf16_t* zr = p.zL + (size_t)R * ZL;
    const uint4 bg = *(const uint4*)(zr + ZL_BG + c0), ga = *(const uint4*)(zr + ZL_GA + c0);
    const float bgf[8] = {bflo(bg.x), bfhi(bg.x), bflo(bg.y), bfhi(bg.y), bflo(bg.z), bfhi(bg.z), bflo(bg.w), bfhi(bg.w)};
    const float gaf[8] = {bflo(ga.x), bfhi(ga.x), bflo(ga.y), bfhi(ga.y), bflo(ga.z), bfhi(ga.z), bflo(ga.w), bfhi(ga.w)};
    float y[8];
#pragma unroll
    for (int e = 0; e < 8; ++e) y[e] = bgf[e] * (w0[e] * u[0][e] + w1[e] * u[1][e] + w2[e] * u[2][e]) * silu_(gaf[e]);
    uint4 o; o.x = pk2(y[0], y[1]); o.y = pk2(y[2], y[3]); o.z = pk2(y[4], y[5]); o.w = pk2(y[6], y[7]);
    *(uint4*)(mix + (size_t)R * D + c0) = o;
    if (q >= T - 2) {
      float* d = so + (q - (T - 2)) * 256 + c0;
#pragma unroll
      for (int e = 0; e < 8; ++e) d[e] = u[2][e];
    }
  }
}

DEV int kperm_addr(int m, int kin) {
  const int mt = m >> 4, ml = m & 15, s = kin >> 5, q = (kin >> 4) & 1, g = (kin >> 2) & 3, e = kin & 3;
  return (((mt * 2 + s) * 64 + ml + 16 * g) * 8) + 4 * q + e;
}
DEV int clay_addr(int x, int v) {
  const int xt = x >> 4, g = (x >> 2) & 3, rr = x & 3, vt = v >> 4, l16 = v & 15;
  return ((xt * 4 + vt) * 64 + 16 * g + l16) * 4 + rr;
}
DEV void mm64(const bf16_t* first, const bf16_t* second, int l31, int hh, f32x16 (&acc)[2][2]) {
#pragma unroll
  for (int ks = 0; ks < 4; ++ks) {
    const bf16x8 f0 = *(const bf16x8*)(first + l31 * 72 + ks * 16 + hh * 8), f1 = *(const bf16x8*)(first + (32 + l31) * 72 + ks * 16 + hh * 8);
    const bf16x8 s0 = *(const bf16x8*)(second + l31 * 72 + ks * 16 + hh * 8), s1 = *(const bf16x8*)(second + (32 + l31) * 72 + ks * 16 + hh * 8);
    acc[0][0] = mfma32(f0, s0, acc[0][0]); acc[0][1] = mfma32(f0, s1, acc[0][1]);
    acc[1][0] = mfma32(f1, s0, acc[1][0]); acc[1][1] = mfma32(f1, s1, acc[1][1]);
  }
}
DEV void mm64x32(const bf16_t* first, const bf16_t* second_rows, int l31, int hh, f32x16 (&acc)[2]) {
#pragma unroll
  for (int ks = 0; ks < 4; ++ks) {
    const bf16x8 f0 = *(const bf16x8*)(first + l31 * 72 + ks * 16 + hh * 8), f1 = *(const bf16x8*)(first + (32 + l31) * 72 + ks * 16 + hh * 8);
    const bf16x8 s0 = *(const bf16x8*)(second_rows + l31 * 72 + ks * 16 + hh * 8);
    acc[0] = mfma32(f0, s0, acc[0]); acc[1] = mfma32(f1, s0, acc[1]);
  }
}

DEV void mmq(const bf16_t* first_rows, const bf16_t* second_rows, int l31, int hh, f32x16& acc) {
#pragma unroll
  for (int ks = 0; ks < 4; ++ks) {
    const bf16x8 f0 = *(const bf16x8*)(first_rows + l31 * 72 + ks * 16 + hh * 8);
    const bf16x8 s0 = *(const bf16x8*)(second_rows + l31 * 72 + ks * 16 + hh * 8);
    acc = mfma32(f0, s0, acc);
  }
}
enum { SH_FULL = 0, SH_UP = 1, SH_LO = 2 };
template <int SH> DEV constexpr bool tile_nz(int tx, int ty) { return SH == SH_FULL || (SH == SH_UP ? tx <= ty : tx >= ty); }
struct Acc64 { f32x16 t[2][2]; };
struct Frag64 { bf16x8 f[4][2]; };
template <int SS> DEV bf16x8 pack8(const f32x16& v) {
  return mk8(pk2(v[8 * SS], v[8 * SS + 1]), pk2(v[8 * SS + 2], v[8 * SS + 3]), pk2(v[8 * SS + 4], v[8 * SS + 5]), pk2(v[8 * SS + 6], v[8 * SS + 7]));
}
template <int SH> DEV void to_frag(const Acc64& X, Frag64& F) {
#pragma unroll
  for (int t = 0; t < 2; ++t) {
    if (tile_nz<SH>(0, t)) { F.f[0][t] = pack8<0>(X.t[0][t]); F.f[1][t] = pack8<1>(X.t[0][t]); }
    if (tile_nz<SH>(1, t)) { F.f[2][t] = pack8<0>(X.t[1][t]); F.f[3][t] = pack8<1>(X.t[1][t]); }
  }
}
template <int SH> DEV void zero_acc(Acc64& X) {
#pragma unroll
  for (int a = 0; a < 2; ++a)
#pragma unroll
    for (int b = 0; b < 2; ++b) if (tile_nz<SH>(a, b)) X.t[a][b] = zero16();
}
template <int SHA, int SHB> DEV void prod_ff(const Frag64& A, const Frag64& B, Acc64& D) {
#pragma unroll
  for (int tm = 0; tm < 2; ++tm)
#pragma unroll
    for (int tn = 0; tn < 2; ++tn)
#pragma unroll
      for (int s = 0; s < 4; ++s)
        if (tile_nz<SHA>(s >> 1, tm) && tile_nz<SHB>(s >> 1, tn)) D.t[tm][tn] = mfma32(A.f[s][tm], B.f[s][tn], D.t[tm][tn]);
}
template <int SHA, int SHB, int SHD> DEV void prod_ff_frag(const Frag64& A, const Frag64& B, Frag64& Fo) {
#pragma unroll
  for (int tm = 0; tm < 2; ++tm)
#pragma unroll
    for (int tn = 0; tn < 2; ++tn)
      if (tile_nz<SHD>(tm, tn)) {
        f32x16 acc = zero16();
#pragma unroll
        for (int s = 0; s < 4; ++s)
          if (tile_nz<SHA>(s >> 1, tm) && tile_nz<SHB>(s >> 1, tn)) acc = mfma32(A.f[s][tm], B.f[s][tn], acc);
        Fo.f[2 * tm][tn] = pack8<0>(acc); Fo.f[2 * tm + 1][tn] = pack8<1>(acc);
      }
}
DEV bf16x8 nat_frag(const bf16_t* S, int row, int s, int hh) { return *(const bf16x8*)(S + row * 72 + 16 * s + 8 * hh); }
DEV bf16x8 perm_frag(const bf16_t* S, int row, int s, int hh) {
  const uint2 a = *(const uint2*)(S + row * 72 + 16 * s + 4 * hh), b = *(const uint2*)(S + row * 72 + 16 * s + 8 + 4 * hh);
  return mk8(a.x, a.y, b.x, b.y);
}
template <int SH, int MODE> DEV void gram(const bf16_t* F, const bf16_t* G, int l31, int hh, Acc64& D) {
  zero_acc<SH>(D);
#pragma unroll
  for (int s = 0; s < 4; ++s) {
    bf16x8 ff[2], gg[2];
#pragma unroll
    for (int t = 0; t < 2; ++t) { ff[t] = nat_frag(F, 32 * t + l31, s, hh); gg[t] = nat_frag(G, 32 * t + l31, s, hh); }
#pragma unroll
    for (int tx = 0; tx < 2; ++tx)
#pragma unroll
      for (int ty = 0; ty < 2; ++ty) if (tile_nz<SH>(tx, ty)) D.t[tx][ty] = mfma32(ff[tx], gg[ty], D.t[tx][ty]);
  }
#pragma unroll
  for (int t = 0; t < 2; ++t)
#pragma unroll
    for (int r = 0; r < 16; ++r) {
      const int x = (r & 3) + 8 * (r >> 2) + 4 * hh, y = l31;
      const bool keep = MODE == 0 ? (x < y) : (MODE == 1 ? (y < x) : (x <= y));
      if (!keep) D.t[t][t][r] = 0.f;
    }
}
template <int SHA> DEV void prod_fm_frag(const Frag64& A, const bf16_t* Mem, int l31, int hh, Frag64& Fo) {
#pragma unroll
  for (int tm = 0; tm < 2; ++tm)
#pragma unroll
    for (int tn = 0; tn < 2; ++tn) {
      f32x16 acc = zero16();
#pragma unroll
      for (int s = 0; s < 4; ++s) if (tile_nz<SHA>(s >> 1, tm)) acc = mfma32(A.f[s][tm], perm_frag(Mem, 32 * tn + l31, s, hh), acc);
      Fo.f[2 * tm][tn] = pack8<0>(acc); Fo.f[2 * tm + 1][tn] = pack8<1>(acc);
    }
}
template <int SHA> DEV void prod_fm(const Frag64& A, const bf16_t* Mem, int l31, int hh, Acc64& D) {
#pragma unroll
  for (int s = 0; s < 4; ++s) {
    bf16x8 mm[2];
#pragma unroll
    for (int t = 0; t < 2; ++t) mm[t] = perm_frag(Mem, 32 * t + l31, s, hh);
#pragma unroll
    for (int tm = 0; tm < 2; ++tm)
#pragma unroll
      for (int tn = 0; tn < 2; ++tn) if (tile_nz<SHA>(s >> 1, tm)) D.t[tm][tn] = mfma32(A.f[s][tm], mm[tn], D.t[tm][tn]);
  }
}
DEV void r1_item(const Prm& p, int L, int idx, char* lds) {
  int tid = threadIdx.x; LAUNDER(tid);
  const int w = __builtin_amdgcn_readfirstlane(tid >> 6);
  int lane = tid & 63, l31 = lane & 31, hh = lane >> 5;
  const int cw = w & 1, tw = w >> 1;
  bf16_t* S0 = (bf16_t*)lds;
  bf16_t* S1 = S0 + 4608; bf16_t* S2 = S1 + 4608; bf16_t* S3 = S2 + 4608; bf16_t* S4 = S3 + 4608; bf16_t* S5 = S4 + 4608; bf16_t* S6 = S5 + 4608; bf16_t* S7 = S6 + 4608;
  float* misc = (float*)(S7 + 4608);
  float* Ef = (float*)S4;
  bool prompt; int st, c, hd;
  if (idx < NRW_P) { prompt = true; st = idx / 260; const int rem = idx - st * 260; c = rem >> 2; hd = rem & 3; }
  else { prompt = false; const int j = idx - NRW_P; st = j >> 2; hd = j & 3; c = 0; }
  char* rwp = p.rw + (size_t)idx * RW_BYTES;
  const float* mu = p.shift_mu + L * 896;
  const int i1 = tid >> 2, m0 = (tid & 3) * 16;
  int R1; bool valid1, hasprev1;
  if (prompt) { const int pp = 64 * c - 48 + i1; valid1 = pp >= 0; R1 = st * PT + (valid1 ? pp : 0); hasprev1 = pp >= 1; }
  else { R1 = NPR + 64 * st + i1; valid1 = true; hasprev1 = i1 >= 1; }
  const bf16_t* zr1 = p.zE + (size_t)R1 * ZE + ZE_ZC;
  const int ti0 = 32 * tw + l31;
  int R; bool valid, hasprev;
  if (prompt) { const int pp = 64 * c - 48 + ti0; valid = pp >= 0; R = st * PT + (valid ? pp : 0); hasprev = pp >= 1; }
  else { R = NPR + 64 * st + ti0; valid = true; hasprev = ti0 >= 1; }
  const bf16_t* zr = p.zE + (size_t)R * ZE + ZE_ZC;
  const int chb = 64 * hd + 32 * cw + 4 * hh;
  uint4 la[2][2], lap[2][2]; uint2 lb[3][4], lbp[3][4];
  {
    const bf16_t* sh0 = p.zE + (size_t)(NT + (prompt ? 32 : st)) * ZE + ZE_ZC;
    const bf16_t* zp1 = hasprev1 ? zr1 - ZE : sh0;
    const bf16_t* zp = hasprev ? zr - ZE : sh0;
#pragma unroll
    for (int part = 0; part < 2; ++part)
#pragma unroll
      for (int h8 = 0; h8 < 2; ++h8) { const int col = 768 + 64 * part + m0 + 8 * h8; la[part][h8] = *(const uint4*)(zr1 + col); lap[part][h8] = *(const uint4*)(zp1 + col); }
#pragma unroll
    for (int part = 0; part < 3; ++part)
#pragma unroll
      for (int G = 0; G < 4; ++G) { const int col = 256 * part + chb + 8 * G; lb[part][G] = *(const uint2*)(zr + col); lbp[part][G] = *(const uint2*)(zp + col); }
    const bf16_t* dsrc = p.dw2T + ((size_t)L * 256 + hd * 64 + i1) * 64 + m0;
    const bf16_t* isrc = p.ia2T + ((size_t)L * 256 + hd * 64 + i1) * 64 + m0;
    const uint4 d0 = *(const uint4*)dsrc, d1 = *(const uint4*)(dsrc + 8), e0 = *(const uint4*)isrc, e1 = *(const uint4*)(isrc + 8);
    __builtin_amdgcn_sched_barrier(0);
    *(uint4*)(S2 + i1 * 72 + m0) = d0; *(uint4*)(S2 + i1 * 72 + m0 + 8) = d1;
    *(uint4*)(S3 + i1 * 72 + m0) = e0; *(uint4*)(S3 + i1 * 72 + m0 + 8) = e1;
  }
  {
    float* prm = misc + 384;
#pragma unroll
    for (int q2 = 0; q2 < 2; ++q2) {
      const int ix = tid + 256 * q2, wh = ix >> 6, chp = ix & 63;
      const float* sp = wh == 0 ? p.decay_w0 : wh == 1 ? p.iclr_a0 : wh == 2 ? p.key_kk : wh == 3 ? p.key_ka : wh == 4 ? p.bonus_rk : nullptr;
      prm[ix] = sp ? sp[L * 256 + hd * 64 + chp] : mu[256 * (wh - 5) + 64 * hd + chp];
    }
  }
#pragma unroll
  for (int part = 0; part < 2; ++part) {
#pragma unroll
    for (int h8 = 0; h8 < 2; ++h8) {
      const int col = 768 + 64 * part + m0 + 8 * h8;
      const uint4 u = la[part][h8], v = lap[part][h8];
      const float cur[8] = {bflo(u.x), bfhi(u.x), bflo(u.y), bfhi(u.y), bflo(u.z), bfhi(u.z), bflo(u.w), bfhi(u.w)};
      float prv[8] = {bflo(v.x), bfhi(v.x), bflo(v.y), bfhi(v.y), bflo(v.z), bfhi(v.z), bflo(v.w), bfhi(v.w)};
      float o[8];
#pragma unroll
      for (int e = 0; e < 8; ++e) { float z = cur[e] + (prv[e] - cur[e]) * mu[col + e]; if (!valid1) z = 0.f; o[e] = part == 0 ? (1.f - 2.f / (__expf(2.f * z) + 1.f)) : z; }
      uint4 a; a.x = pk2(o[0], o[1]); a.y = pk2(o[2], o[3]); a.z = pk2(o[4], o[5]); a.w = pk2(o[6], o[7]);
      *(uint4*)((part == 0 ? S0 : S1) + i1 * 72 + m0 + 8 * h8) = a;
    }
  }
  __syncthreads();
  f32x16 accw = zero16(), acca = zero16();
#pragma unroll
  for (int ks = 0; ks < 4; ++ks) {
    const bf16x8 fw = *(const bf16x8*)(S2 + (32 * cw + l31) * 72 + ks * 16 + hh * 8), fa = *(const bf16x8*)(S3 + (32 * cw + l31) * 72 + ks * 16 + hh * 8);
    const bf16x8 sw = *(const bf16x8*)(S0 + (32 * tw + l31) * 72 + ks * 16 + hh * 8), sa = *(const bf16x8*)(S1 + (32 * tw + l31) * 72 + ks * 16 + hh * 8);
    accw = mfma32(fw, sw, accw); acca = mfma32(fa, sa, acca);
  }
  int ti = ti0;
  float e_[16];
  float ssq = 0.f;
#pragma unroll
  for (int G = 0; G < 4; ++G) {
    const int ch = chb + 8 * G, col = 256 + ch;
    const uint2 u = lb[1][G], v = lbp[1][G];
    const float cur[4] = {bflo(u.x), bfhi(u.x), bflo(u.y), bfhi(u.y)};
    float prv[4] = {bflo(v.x), bfhi(v.x), bflo(v.y), bfhi(v.y)};
    const int chq = 32 * cw + 8 * G + 4 * hh;
    const float4 kkw = *(const float4*)(misc + 384 + 128 + chq), w0 = *(const float4*)(misc + 384 + chq), m4 = *(const float4*)(misc + 384 + 384 + chq);
    const float kkv[4] = {kkw.x, kkw.y, kkw.z, kkw.w}, w0v[4] = {w0.x, w0.y, w0.z, w0.w}, muv[4] = {m4.x, m4.y, m4.z, m4.w};
#pragma unroll
    for (int e = 0; e < 4; ++e) {
      float z = cur[e] + (prv[e] - cur[e]) * muv[e];
      if (!valid) z = 0.f;
      const float kkr = z * kkv[e];
      ssq += kkr * kkr;
      e_[4 * G + e] = valid ? 0.6065306597126334f * sigmoid_(w0v[e] + accw[4 * G + e]) : 0.f;
    }
  }
  ssq += __shfl_xor(ssq, 32);
  if (hh == 0) misc[(cw * 64 + ti) * 2] = ssq;
#pragma unroll
  for (int G = 0; G < 4; ++G)
#pragma unroll
    for (int e = 0; e < 4; ++e) Ef[ti * 65 + 32 * cw + 8 * G + 4 * hh + e] = e_[4 * G + e];
  __syncthreads();
  {
    const int ch = tid & 63, seg = tid >> 6;
    float run = 0.f;
#pragma unroll
    for (int t = 0; t < 16; ++t) { run += Ef[(16 * seg + t) * 65 + ch]; Ef[(16 * seg + t) * 65 + ch] = run; }
    __syncthreads();
    float off = 0.f;
    for (int s2 = 0; s2 < seg; ++s2) off += Ef[(16 * s2 + 15) * 65 + ch];
    __syncthreads();
#pragma unroll
    for (int t = 0; t < 16; ++t) Ef[(16 * seg + t) * 65 + ch] += off;
    if (seg == 3) { const float cC = Ef[63 * 65 + ch]; misc[320 + ch] = cC; misc[256 + ch] = __expf(-cC); }
    __syncthreads();
  }
  float cc_[16];
#pragma unroll
  for (int G = 0; G < 4; ++G)
#pragma unroll
    for (int e = 0; e < 4; ++e) cc_[4 * G + e] = Ef[ti * 65 + 32 * cw + 8 * G + 4 * hh + e];
  const float kinv = 1.f / fmaxf(sqrtf(misc[ti * 2] + misc[(64 + ti) * 2]), 1e-12f);
  __syncthreads();
  LAUNDER(ti); LAUNDER(hh);
  uint2 vpk[4];
  float rk = 0.f;
#pragma unroll
  for (int G = 0; G < 4; ++G) {
    const int ch = chb + 8 * G, chl = 32 * cw + 8 * G + 4 * hh;
    float zs[3][4];
#pragma unroll
    for (int part = 0; part < 3; ++part) {
      const int col = 256 * part + ch;
      const uint2 u = lb[part][G], v = lbp[part][G];
      const float cur[4] = {bflo(u.x), bfhi(u.x), bflo(u.y), bfhi(u.y)};
      float prv[4] = {bflo(v.x), bfhi(v.x), bflo(v.y), bfhi(v.y)};
      const float4 m4 = *(const float4*)(misc + 384 + 320 + 64 * part + chl);
      const float muv[4] = {m4.x, m4.y, m4.z, m4.w};
#pragma unroll
      for (int e = 0; e < 4; ++e) { float z = cur[e] + (prv[e] - cur[e]) * muv[e]; zs[part][e] = valid ? z : 0.f; }
    }
    vpk[G] = pk4(zs[2][0], zs[2][1], zs[2][2], zs[2][3]);
    const float4 a04 = *(const float4*)(misc + 384 + 64 + chl), kk4 = *(const float4*)(misc + 384 + 128 + chl), ka4 = *(const float4*)(misc + 384 + 192 + chl), bo4 = *(const float4*)(misc + 384 + 256 + chl);
    const float a0v[4] = {a04.x, a04.y, a04.z, a04.w}, kkv[4] = {kk4.x, kk4.y, kk4.z, kk4.w}, kav[4] = {ka4.x, ka4.y, ka4.z, ka4.w}, bov[4] = {bo4.x, bo4.y, bo4.z, bo4.w};
    float at[4], rt[4], bt[4], kt[4], bh[4], kh[4];
#pragma unroll
    for (int e = 0; e < 4; ++e) {
      const int r = 4 * G + e;
      const float al = sigmoid_(a0v[e] + acca[r]);
      const float kk = zs[1][e] * kkv[e] * kinv;
      const float km = zs[1][e] * (1.f + (al - 1.f) * kav[e]);
      rk += zs[0][e] * km * bov[e];
      const float gC = misc[256 + chl + e];
      const float cprev = cc_[r] - e_[r];
      const float ea = __expf(-cprev), er = __expf(-cc_[r]), ek = __builtin_amdgcn_rcpf(er), eh = ek * gC;
      const float b = kk * al;
      at[e] = -kk * ea; rt[e] = zs[0][e] * er; bt[e] = b * ek; kt[e] = km * ek; bh[e] = b * eh; kh[e] = km * eh;
    }
    *(uint2*)(S0 + ti * 72 + chl) = pk4(at[0], at[1], at[2], at[3]);
    *(uint2*)(S1 + ti * 72 + chl) = pk4(rt[0], rt[1], rt[2], rt[3]);
    *(uint2*)(S2 + ti * 72 + chl) = pk4(bt[0], bt[1], bt[2], bt[3]);
    *(uint2*)(S3 + ti * 72 + chl) = pk4(kt[0], kt[1], kt[2], kt[3]);
#pragma unroll
    for (int e = 0; e < 4; ++e) { S4[(chl + e) * 72 + ti] = f2bf(at[e]); S5[(chl + e) * 72 + ti] = f2bf(bh[e]); S6[(chl + e) * 72 + ti] = f2bf(kh[e]); S7[(chl + e) * 72 + ti] = f2bf(zs[2][e]); }
    *(uint2*)(rwp + 40960 + (ti * 64 + chl) * 2) = vpk[G];
  }
  rk += __shfl_xor(rk, 32);
  if (hh == 0) misc[(cw * 64 + ti) * 2 + 1] = rk;
  __syncthreads();
  if (valid && cw == 0 && hh == 0) p.rkb[(size_t)R * 4 + hd] = misc[ti * 2 + 1] + misc[(64 + ti) * 2 + 1];
  LAUNDER(l31); LAUNDER(hh); LAUNDER(lane);
  {
    Acc64 T;
    {
      Acc64 Mx, MTx;
      gram<SH_UP, 0>(S2, S0, l31, hh, Mx);
      gram<SH_LO, 1>(S0, S2, l31, hh, MTx);
      Frag64 fM, fMT, fT;
      to_frag<SH_UP>(Mx, fM); to_frag<SH_LO>(MTx, fMT);
      __builtin_amdgcn_sched_barrier(0);
      T = Mx;
#pragma unroll
      for (int t = 0; t < 2; ++t)
#pragma unroll
        for (int r = 0; r < 16; ++r) if ((r & 3) + 8 * (r >> 2) + 4 * hh == l31) T.t[t][t][r] += 1.f;
      T.t[1][0] = zero16();
      for (int r = 0; r < 5; ++r) {
        Frag64 fM2, fMT2;
        prod_ff_frag<SH_LO, SH_UP, SH_UP>(fMT, fM, fM2);
        prod_ff_frag<SH_UP, SH_LO, SH_LO>(fM, fMT, fMT2);
#pragma unroll
        for (int s = 0; s < 4; ++s)
#pragma unroll
          for (int t = 0; t < 2; ++t) { if (tile_nz<SH_UP>(s >> 1, t)) fM.f[s][t] = fM2.f[s][t]; if (tile_nz<SH_LO>(s >> 1, t)) fMT.f[s][t] = fMT2.f[s][t]; }
        to_frag<SH_UP>(T, fT);
        prod_ff<SH_LO, SH_UP>(fMT, fT, T);
      }
    }
    Frag64 fT;
    to_frag<SH_UP>(T, fT);
    __builtin_amdgcn_sched_barrier(0);
    if (w < 2) {
      Frag64 fW;
      prod_fm_frag<SH_UP>(fT, S4, l31, hh, fW);
      __builtin_amdgcn_sched_barrier(0);
      Acc64 O; zero_acc<SH_FULL>(O);
      if (w == 0) {
        prod_fm<SH_FULL>(fW, S5, l31, hh, O);
#pragma unroll
        for (int tx = 0; tx < 2; ++tx)
#pragma unroll
          for (int ty = 0; ty < 2; ++ty)
#pragma unroll
            for (int G = 0; G < 4; ++G) {
              const int x0 = 32 * tx + 8 * G + 4 * hh, y = 32 * ty + l31;
              float v[4];
#pragma unroll
              for (int e = 0; e < 4; ++e) { v[e] = O.t[tx][ty][4 * G + e]; if (x0 + e == y) v[e] += misc[256 + y]; }
              *(uint2*)(rwp + 0 + kperm_addr(y, x0) * 2) = pk4(v[0], v[1], v[2], v[3]);
            }
      } else {
        Acc64 Nb; gram<SH_UP, 2>(S2, S1, l31, hh, Nb);
        Frag64 fN; to_frag<SH_UP>(Nb, fN);
        prod_ff<SH_FULL, SH_UP>(fW, fN, O);
#pragma unroll
        for (int tx = 0; tx < 2; ++tx)
#pragma unroll
          for (int ty = 0; ty < 2; ++ty)
#pragma unroll
            for (int G = 0; G < 4; ++G) {
              const int x0 = 32 * tx + 8 * G + 4 * hh, y = 32 * ty + l31;
              const uint2 rr = *(const uint2*)(S1 + y * 72 + x0);
              *(uint2*)(rwp + 8192 + kperm_addr(y, x0) * 2) = pk4(O.t[tx][ty][4 * G] + bflo(rr.x), O.t[tx][ty][4 * G + 1] + bfhi(rr.x), O.t[tx][ty][4 * G + 2] + bflo(rr.y), O.t[tx][ty][4 * G + 3] + bfhi(rr.y));
            }
      }
    } else {
      Frag64 fX;
      {
        Acc64 Nk; gram<SH_LO, 1>(S0, S3, l31, hh, Nk);
        Frag64 fNk; to_frag<SH_LO>(Nk, fNk);
        prod_ff_frag<SH_UP, SH_LO, SH_LO>(fT, fNk, fX);
      }
      __builtin_amdgcn_sched_barrier(0);
      if (w == 2) {
        Acc64 Z; zero_acc<SH_FULL>(Z);
        prod_fm<SH_LO>(fX, S5, l31, hh, Z);
#pragma unroll
        for (int tx = 0; tx < 2; ++tx)
#pragma unroll
          for (int ty = 0; ty < 2; ++ty)
#pragma unroll
            for (int G = 0; G < 4; ++G) {
              const int x0 = 32 * tx + 8 * G + 4 * hh, y = 32 * ty + l31;
              const uint2 kk2 = *(const uint2*)(S6 + y * 72 + x0);
              Z.t[tx][ty][4 * G] += bflo(kk2.x); Z.t[tx][ty][4 * G + 1] += bfhi(kk2.x); Z.t[tx][ty][4 * G + 2] += bflo(kk2.y); Z.t[tx][ty][4 * G + 3] += bfhi(kk2.y);
            }
        Frag64 fZ; to_frag<SH_FULL>(Z, fZ);
        __builtin_amdgcn_sched_barrier(0);
        Acc64 Q; zero_acc<SH_FULL>(Q);
        prod_fm<SH_FULL>(fZ, S7, l31, hh, Q);
#pragma unroll
        for (int tx = 0; tx < 2; ++tx)
#pragma unroll
          for (int ty = 0; ty < 2; ++ty)
#pragma unroll
            for (int G = 0; G < 4; ++G)
              *(uint2*)(rwp + 16384 + clay_addr(32 * tx + 8 * G + 4 * hh, 32 * ty + l31) * 2) = pk4(Q.t[tx][ty][4 * G], Q.t[tx][ty][4 * G + 1], Q.t[tx][ty][4 * G + 2], Q.t[tx][ty][4 * G + 3]);
      } else {
        Acc64 H; gram<SH_UP, 2>(S3, S1, l31, hh, H);
        {
          Acc64 Nb; gram<SH_UP, 2>(S2, S1, l31, hh, Nb);
          Frag64 fN; to_frag<SH_UP>(Nb, fN);
          prod_ff<SH_LO, SH_UP>(fX, fN, H);
        }
        Frag64 fH; to_frag<SH_UP>(H, fH);
        __builtin_amdgcn_sched_barrier(0);
        Acc64 Y; zero_acc<SH_FULL>(Y);
        prod_fm<SH_UP>(fH, S7, l31, hh, Y);
#pragma unroll
        for (int tx = 0; tx < 2; ++tx)
#pragma unroll
          for (int ty = 0; ty < 2; ++ty)
#pragma unroll
            for (int G = 0; G < 4; ++G)
              *(uint2*)(rwp + 24576 + clay_addr(32 * tx + 8 * G + 4 * hh, 32 * ty + l31) * 2) = pk4(Y.t[tx][ty][4 * G], Y.t[tx][ty][4 * G + 1], Y.t[tx][ty][4 * G + 2], Y.t[tx][ty][4 * G + 3]);
      }
    }
  }
  __syncthreads();
}

DEV void r2_wave(const Prm& p, int L, int wi, int lane) {
  bool prompt; int st, hd, vt;
  if (wi < 64) { prompt = true; st = wi >> 4; hd = (wi >> 2) & 3; vt = wi & 3; }
  else { prompt = false; const int j = wi - 64; st = j >> 4; hd = (j >> 2) & 3; vt = j & 3; }
  const int nch = prompt ? 65 : 1;
  const int idx0 = prompt ? st * 260 + hd : NRW_P + st * 4 + hd;
  const int l16 = lane & 15, g = lane >> 4;
  f32x4 acc[4];
  float* outp;
  if (prompt) {
#pragma unroll
    for (int mt = 0; mt < 4; ++mt) acc[mt] = (f32x4){0.f, 0.f, 0.f, 0.f};
    outp = p.wkv_p + ((((size_t)L * 4 + st) * 4 + hd) * 64 + 16 * vt + l16) * 64;
  } else {
    const float* sp = p.state_wkv + ((((size_t)L * 32 + st) * 4 + hd) * 64 + 16 * vt + l16) * 64;
#pragma unroll
    for (int mt = 0; mt < 4; ++mt) acc[mt] = *(const f32x4*)(sp + 16 * mt + 4 * g);
    outp = p.wkv_s + ((((size_t)L * 32 + st) * 4 + hd) * 64 + 16 * vt + l16) * 64;
  }
  const char* rw0 = p.rw + (size_t)idx0 * RW_BYTES;
  uint4 pf[3][8]; uint2 qv[3][4];
#pragma unroll
  for (int k = 0; k < 3; ++k) {
    const int cc = k < nch ? k : nch - 1;
    const char* src = rw0 + (size_t)cc * 4 * RW_BYTES;
#pragma unroll
    for (int i = 0; i < 8; ++i) pf[k][i] = *(const uint4*)(src + (i * 64 + lane) * 16);
#pragma unroll
    for (int mt = 0; mt < 4; ++mt) qv[k][mt] = *(const uint2*)(src + 16384 + ((mt * 4 + vt) * 64 + lane) * 8);
  }
  for (int c0 = 0; c0 < nch; c0 += 3) {
#pragma unroll
    for (int k = 0; k < 3; ++k) {
      const int c = c0 + k;
      if (c < nch) {
        char* cur = (char*)rw0 + (size_t)c * 4 * RW_BYTES;
        uint4 bfr[2];
#pragma unroll
        for (int s = 0; s < 2; ++s) {
          bfr[s].x = pk2(acc[2 * s][0], acc[2 * s][1]); bfr[s].y = pk2(acc[2 * s][2], acc[2 * s][3]);
          bfr[s].z = pk2(acc[2 * s + 1][0], acc[2 * s + 1][1]); bfr[s].w = pk2(acc[2 * s + 1][2], acc[2 * s + 1][3]);
          *(uint4*)(cur + 32768 + ((vt * 2 + s) * 64 + lane) * 16) = bfr[s];
        }
#pragma unroll
        for (int mt = 0; mt < 4; ++mt) {
          f32x4 a = {bflo(qv[k][mt].x), bfhi(qv[k][mt].x), bflo(qv[k][mt].y), bfhi(qv[k][mt].y)};
#pragma unroll
          for (int s = 0; s < 2; ++s) a = mfma16(mk8(pf[k][mt * 2 + s]), mk8(bfr[s]), a);
          acc[mt] = a;
        }
        const int cn = c + 3 < nch ? c + 3 : nch - 1;
        const char* src = rw0 + (size_t)cn * 4 * RW_BYTES;
#pragma unroll
        for (int i = 0; i < 8; ++i) pf[k][i] = *(const uint4*)(src + (i * 64 + lane) * 16);
#pragma unroll
        for (int mt = 0; mt < 4; ++mt) qv[k][mt] = *(const uint2*)(src + 16384 + ((mt * 4 + vt) * 64 + lane) * 8);
      }
    }
  }
#pragma unroll
  for (int mt = 0; mt < 4; ++mt) *(f32x4*)(outp + 16 * mt + 4 * g) = acc[mt];
}

DEV void r3_wave(const Prm& p, int L, int idx, int lane, float* Y  ) {
  LAUNDER(lane);
  bool prompt; int st, c, hd;
  if (idx < NRW_P) { prompt = true; st = idx / 260; const int rem = idx - st * 260; c = rem >> 2; hd = rem & 3; }
  else { prompt = false; const int j = idx - NRW_P; st = j >> 2; hd = j & 3; c = 0; }
  const char* rwp = p.rw + (size_t)idx * RW_BYTES;
  const int l16 = lane & 15, g = lane >> 4;
  bf16_t* mix = p.zE;
  uint4 sf[4][2];
#pragma unroll
  for (int vt = 0; vt < 4; ++vt)
#pragma unroll
    for (int s = 0; s < 2; ++s) sf[vt][s] = *(const uint4*)(rwp + 32768 + ((vt * 2 + s) * 64 + lane) * 16);
  const float lw[4] = {p.lnx_w[L * 256 + hd * 64 + l16], p.lnx_w[L * 256 + hd * 64 + 16 + l16], p.lnx_w[L * 256 + hd * 64 + 32 + l16], p.lnx_w[L * 256 + hd * 64 + 48 + l16]};
  const float lb[4] = {p.lnx_b[L * 256 + hd * 64 + l16], p.lnx_b[L * 256 + hd * 64 + 16 + l16], p.lnx_b[L * 256 + hd * 64 + 32 + l16], p.lnx_b[L * 256 + hd * 64 + 48 + l16]};
#pragma unroll
  for (int it = 0; it < 4; ++it) {
    f32x4 y[4];
    const uint4 gf0 = *(const uint4*)(rwp + 8192 + ((it * 2 + 0) * 64 + lane) * 16), gf1 = *(const uint4*)(rwp + 8192 + ((it * 2 + 1) * 64 + lane) * 16);
#pragma unroll
    for (int vt = 0; vt < 4; ++vt) {
      const uint2 q = *(const uint2*)(rwp + 24576 + ((it * 4 + vt) * 64 + lane) * 8);
      f32x4 a = {bflo(q.x), bfhi(q.x), bflo(q.y), bfhi(q.y)};
      a = mfma16(mk8(gf0), mk8(sf[vt][0]), a);
      a = mfma16(mk8(gf1), mk8(sf[vt][1]), a);
      y[vt] = a;
    }
    __builtin_amdgcn_sched_barrier(0);
#pragma unroll
    for (int rr = 0; rr < 4; ++rr) {
      const int i = 16 * it + 4 * g + rr;
      float s1 = y[0][rr] + y[1][rr] + y[2][rr] + y[3][rr];
      s1 += __shfl_xor(s1, 1); s1 += __shfl_xor(s1, 2); s1 += __shfl_xor(s1, 4); s1 += __shfl_xor(s1, 8);
      const float mean = s1 * (1.f / 64.f);
      const float d0 = y[0][rr] - mean, d1 = y[1][rr] - mean, d2 = y[2][rr] - mean, d3 = y[3][rr] - mean;
      float s2 = d0 * d0 + d1 * d1 + d2 * d2 + d3 * d3;
      s2 += __shfl_xor(s2, 1); s2 += __shfl_xor(s2, 2); s2 += __shfl_xor(s2, 4); s2 += __shfl_xor(s2, 8);
      const float rstd = rsqrtf(s2 * (1.f / 64.f) + GN_EPS);
      Y[i * 68 + l16] = d0 * rstd * lw[0] + lb[0];
      Y[i * 68 + 16 + l16] = d1 * rstd * lw[1] + lb[1];
      Y[i * 68 + 32 + l16] = d2 * rstd * lw[2] + lb[2];
      Y[i * 68 + 48 + l16] = d3 * rstd * lw[3] + lb[3];
    }
  }
  asm volatile("s_waitcnt lgkmcnt(0)" ::: "memory");
  __builtin_amdgcn_wave_barrier();
  const int vc = (lane & 7) * 8;
#pragma unroll
  for (int ps = 0; ps < 8; ++ps) {
    const int i = 8 * ps + (lane >> 3);
    int R; bool valid;
    if (prompt) { const int pp = 64 * c - 48 + i; valid = pp >= 0; R = st * PT + (valid ? pp : 0); }
    else { R = NPR + 64 * st + i; valid = true; }
    if (valid) {
      const float4 y0 = *(const float4*)(Y + i * 68 + vc), y1 = *(const float4*)(Y + i * 68 + vc + 4);
      const float rkbv = p.rkb[(size_t)R * 4 + hd];
      const uint4 vv = *(const uint4*)(rwp + 40960 + (i * 64 + vc) * 2);
      const uint4 gc = *(const uint4*)(p.zL + (size_t)R * ZL + ZL_GC + hd * 64 + vc);
      uint4 o;
      o.x = pk2((y0.x + rkbv * bflo(vv.x)) * silu_(bflo(gc.x)), (y0.y + rkbv * bfhi(vv.x)) * silu_(bfhi(gc.x)));
      o.y = pk2((y0.z + rkbv * bflo(vv.y)) * silu_(bflo(gc.y)), (y0.w + rkbv * bfhi(vv.y)) * silu_(bfhi(gc.y)));
      o.z = pk2((y1.x + rkbv * bflo(vv.z)) * silu_(bflo(gc.z)), (y1.y + rkbv * bfhi(vv.z)) * silu_(bfhi(gc.z)));
      o.w = pk2((y1.z + rkbv * bflo(vv.w)) * silu_(bflo(gc.w)), (y1.w + rkbv * bfhi(vv.w)) * silu_(bfhi(gc.w)));
      *(uint4*)(mix + (size_t)R * D + 768 + hd * 64 + vc) = o;
    }
  }
  asm volatile("s_waitcnt lgkmcnt(0)" ::: "memory");
  __builtin_amdgcn_wave_barrier();
}

DEV void final_norm(const Prm& p) {
  int tid_ = threadIdx.x; LAUNDER(tid_);
  const int lane = tid_ & 63, gw = blockIdx.x * 4 + (tid_ >> 6), NW = gridDim.x * 4;
  for (int R = gw; R < NT; R += NW) {
    if (R < NPR && (R % PT) < 16) continue;
    float* yr = xrow_ptr(p, R);
    const bf16_t* xr = p.xb + (size_t)R * D;
    const float rstd = rsqrtf(p.ssq_x[2 * NTP + R] * (1.f / 1024.f) + RMS_EPS);
#pragma unroll
    for (int j = 0; j < 2; ++j) {
      const uint4 u = ((const uint4*)xr)[lane + 64 * j];
      const float4 g0 = ((const float4*)p.final_g)[2 * (lane + 64 * j)], g1 = ((const float4*)p.final_g)[2 * (lane + 64 * j) + 1];
      float4 o0, o1;
      o0.x = bflo(u.x) * rstd * g0.x; o0.y = bfhi(u.x) * rstd * g0.y; o0.z = bflo(u.y) * rstd * g0.z; o0.w = bfhi(u.y) * rstd * g0.w;
      o1.x = bflo(u.z) * rstd * g1.x; o1.y = bfhi(u.z) * rstd * g1.y; o1.z = bflo(u.w) * rstd * g1.z; o1.w = bfhi(u.w) * rstd * g1.w;
      ((float4*)yr)[2 * (lane + 64 * j)] = o0; ((float4*)yr)[2 * (lane + 64 * j) + 1] = o1;
    }
  }
}

#define XB_TMO      128
#define XB_XCNT(j)  (256  + 64 * (j))
#define XB_XSUB(j)  (1280 + 64 * (j))
#define XB_XGEN(j)  (2304 + 64 * (j))
#define XB_TOP      3328
#define XB_TOPGEN   3392
#define XCD_BAR_WORDS 3456
#define XB_SPIN_CAP (1u << 20)
#define LAS __attribute__((address_space(3)))
DEV unsigned xb_ld(unsigned* p) { return __hip_atomic_load(p, __ATOMIC_RELAXED, __HIP_MEMORY_SCOPE_AGENT); }
DEV unsigned xb_add(unsigned* p, unsigned v) { return __hip_atomic_fetch_add(p, v, __ATOMIC_RELAXED, __HIP_MEMORY_SCOPE_AGENT); }
DEV unsigned xb_xcc_id() { return (unsigned)__builtin_amdgcn_s_getreg((3 << 11) | 20) & 0xFu; }
#define XB_SPIN(cond, bar) do { unsigned _sp = 0; while (cond) { __builtin_amdgcn_s_sleep(1); \
    if ((++_sp & 255u) == 0u) { if (xb_ld(&(bar)[XB_TMO])) break; if (_sp > XB_SPIN_CAP) { atomicAdd(&(bar)[XB_TMO], 1u); break; } } } } while (0)
struct XcdBarrier { unsigned* bar; unsigned x; volatile LAS unsigned* st; };
DEV XcdBarrier xcd_barrier_post(unsigned* bar, volatile LAS unsigned* st) {
  XcdBarrier b; b.bar = bar; b.x = xb_xcc_id(); b.st = st;
  if (threadIdx.x == 0) (void)xb_add(&bar[XB_XCNT(b.x)], 1u);
  return b;
}
DEV void xcd_barrier_complete(unsigned* bar, unsigned x, unsigned& nloc, unsigned& nx) {
  const unsigned G = gridDim.x * gridDim.y * gridDim.z;
  unsigned sum, cnt, mine, sp = 0u;
  for (;;) {
    sum = 0u; cnt = 0u; mine = 0u;
#pragma unroll
    for (unsigned j = 0; j < 16; ++j) { const unsigned c = xb_ld(&bar[XB_XCNT(j)]); sum += c; cnt += (c > 0u) ? 1u : 0u; mine = (j == x) ? c : mine; }
    if (sum == G) break;
    __builtin_amdgcn_s_sleep(1);
    if ((++sp & 255u) == 0u) { if (xb_ld(&bar[XB_TMO])) break; if (sp > XB_SPIN_CAP) { atomicAdd(&bar[XB_TMO], 1u); break; } }
  }
  nloc = mine > 0u ? mine : 1u; nx = cnt > 0u ? cnt : 1u;
}
DEV void xcd_barrier(const XcdBarrier& b) {
  asm volatile("s_waitcnt vmcnt(0)" ::: "memory");
  __syncthreads();
  if (threadIdx.x == 0) {
    unsigned* bar = b.bar;
    __builtin_amdgcn_s_waitcnt(0);
    unsigned nloc = b.st[0], nx = b.st[1];
    if (nloc == 0u) { xcd_barrier_complete(bar, b.x, nloc, nx); b.st[0] = nloc; b.st[1] = nx; }
    const unsigned old = xb_add(&bar[XB_XSUB(b.x)], 1u);
    const unsigned gen = old / nloc;
    if (old + 1u == (gen + 1u) * nloc) {
      __builtin_amdgcn_fence(__ATOMIC_RELEASE, "agent");
      asm volatile("s_waitcnt vmcnt(0)" ::: "memory");
      const unsigned og = xb_add(&bar[XB_TOP], 1u);
      const unsigned tg = og / nx;
      if (og + 1u == (tg + 1u) * nx) xb_add(&bar[XB_TOPGEN], 1u);
      else XB_SPIN(xb_ld(&bar[XB_TOPGEN]) == tg, bar);
      __builtin_amdgcn_fence(__ATOMIC_ACQUIRE, "agent");
      xb_add(&bar[XB_XGEN(b.x)], 1u);
      asm volatile("s_waitcnt vmcnt(0)" ::: "memory");
    } else {
      XB_SPIN(xb_ld(&bar[XB_XGEN(b.x)]) == gen, bar);
      __builtin_amdgcn_fence(__ATOMIC_ACQUIRE, "agent");
      asm volatile("s_waitcnt vmcnt(0)" ::: "memory");
    }
  }
  __syncthreads();
}

#define QCTR(ph, L) (3584 + 64 * (2 * (ph) + (L)))
#define R2DONE(L) (3520 + 16 * (L))
DEV int next_item(unsigned* ctr, char* lds) {
  volatile int* slot = (volatile int*)(lds + LDS_BYTES - 8);
  __syncthreads();
  if (threadIdx.x == 0) *slot = (int)atomicAdd(ctr, 1u);
  __syncthreads();
  return *slot;
}
#define QXC(ph, L, x) (4096 + (((ph) * 2 + (L)) * 8 + (x)) * 16)
DEV int xq_next(unsigned* ctl, int ph, int L, int C, int N, int& k, int home, char* lds) {
  volatile int* slot = (volatile int*)(lds + LDS_BYTES - 8);
  __syncthreads();
  if (threadIdx.x == 0) {
    int res = -1, kk = k;
    while (kk < 8) {
      const int x = (home + kk) & 7, base = x * C;
      int size = N - base; size = size < C ? size : C;
      if (size > 0) { const int idx = (int)atomicAdd(ctl + QXC(ph, L, x), 1u); if (idx < size) { res = base + idx; break; } }
      ++kk;
    }
    slot[0] = res; slot[1] = kk;
  }
  __syncthreads();
  k = slot[1];
  return slot[0];
}
DEV int q_publish(int ticket, char* lds) {
  volatile int* slot = (volatile int*)(lds + LDS_BYTES - 8);
  __syncthreads();
  if (threadIdx.x == 0) *slot = ticket;
  __syncthreads();
  return *slot;
}
DEV int xq_resolve(unsigned* ctl, int ph, int L, int C, int N, int& k, int home, int ticket, char* lds) {
  volatile int* slot = (volatile int*)(lds + LDS_BYTES - 8);
  __syncthreads();
  if (threadIdx.x == 0) {
    int res = -1, kk = k;
    if (kk < 8) {
      const int x = (home + kk) & 7, base = x * C;
      int size = N - base; size = size < C ? size : C;
      if (ticket < size) res = base + ticket;
      else {
        ++kk;
        while (kk < 8) {
          const int x2 = (home + kk) & 7, base2 = x2 * C;
          int size2 = N - base2; size2 = size2 < C ? size2 : C;
          if (size2 > 0) { const int idx = (int)atomicAdd(ctl + QXC(ph, L, x2), 1u); if (idx < size2) { res = base2 + idx; break; } }
          ++kk;
        }
      }
    }
    slot[0] = res; slot[1] = kk;
  }
  __syncthreads();
  k = slot[1];
  return slot[0];
}
DEV unsigned* xq_ctr(unsigned* ctl, int ph, int L, int k, int home) { return k < 8 ? ctl + QXC(ph, L, (home + k) & 7) : nullptr; }
DEV int take_ticket(unsigned* nctr) { int tk = 0x7fffffff; if (nctr && threadIdx.x == 0) tk = (int)atomicAdd(nctr, 1u); return tk; }
DEV void shift_rows_item(const Prm& p, int L, int b) {
  int tid0 = threadIdx.x; LAUNDER(tid0);
  if (tid0 < 224) {
    float4 v = make_float4(0.f, 0.f, 0.f, 0.f);
    if (b < 32) v = *(const float4*)(p.state_shift + ((size_t)L * 32 + b) * 896 + 4 * tid0);
    *(uint2*)(p.zE + (size_t)(NT + b) * ZE + ZE_ZC + 4 * tid0) = pk4(v.x, v.y, v.z, v.w);
  }
}
constexpr int N_ATT = 1312;
DEV void run_p1(const Prm& p, int L, char* lds) {
  const EpiIn epi{p, L};
  const int home = (int)(xb_xcc_id() & 7u);
  int k = 0;
  constexpr int N = 145 * 24, C = (N + 7) / 8;
  int t = take_ticket(xq_ctr(p.ctl, 0, L, k, home));
  for (;;) {
    const int i = xq_resolve(p.ctl, 0, L, C, N, k, home, t, lds);
    if (i < 0) break;
    int mt, nt;
    if (i < 18 * 192) { const int b = i / 192, r = i - b * 192; nt = r >> 3; mt = 8 * b + (r & 7); } else { nt = i - 18 * 192; mt = 144; }
    t = gemm_tile(p.xb, D, p.Wb_in + (size_t)L * INP * 1024, 1024, 1024, mt * 128, nt * 128, lds, epi, xq_ctr(p.ctl, 0, L, k, home));
  }
  unsigned* ctr = p.ctl + QCTR(3, L);
  t = take_ticket(ctr);
  for (;;) {
    const int mt = q_publish(t, lds);
    if (mt >= 145 + 33) break;
    if (mt >= 145) { t = take_ticket(ctr); shift_rows_item(p, L, mt - 145); continue; }
    t = gemm_tile<EpiIn, 2>(p.xb, D, p.Wb_in + (size_t)L * INP * 1024, 1024, 1024, mt * 128, 24 * 128, lds, epi, ctr);
  }
}
DEV void run_p2(const Prm& p, int L, char* lds) {
  const EpiQ epq{p, L};
  constexpr int N1 = NRW, N2 = N1 + 129, N3 = N2 + 145 * 6, N4 = N3 + 16, N4b = N4 + 512, N5 = N4b + 36;
  const int N6 = L == 0 ? N5 + NWT : N5;
  unsigned* ctr = p.ctl + QCTR(0, L);
  for (;;) {
    const int id = next_item(ctr, lds);
    if (id >= N6) break;
    if (id >= N5) { conv_weights_item(p, 1, id - N5, lds); continue; }
    if (id < N1) r1_item(p, L, id, lds);
    else if (id < N2) kvproj_item(p, L, id - N1, lds);
    else if (id < N3) { const int t = id - N2, mt = t / 6, nt = t - mt * 6; gemm_tile(p.zE + ZE_CQ, ZE, p.Wb_uq + (size_t)L * 768 * 256, 256, 256, mt * 128, nt * 128, lds, epq); }
    else if (id < N4) sample_prep_item(p, L, id - N3);
    else if (id < N4b) lat_item(p, L, id - N4);
    else shift_item(p, L, id - N4b);
  }
}
DEV void run_p3(const Prm& p, int L, char* lds) {
  int tid_ = threadIdx.x; LAUNDER(tid_);
  const int lane = tid_ & 63, w = __builtin_amdgcn_readfirstlane(tid_ >> 6);
  {
    int ndone = 0;
    for (int wi = blockIdx.x * 4 + w; wi < 576; wi += gridDim.x * 4) { r2_wave(p, L, wi, lane); ++ndone; }
    if (blockIdx.x * 4 < 576) {
      asm volatile("s_waitcnt vmcnt(0)" ::: "memory");
      __syncthreads();
      if (threadIdx.x == 0) {
        int tot = 0;
        for (int wi = blockIdx.x * 4; wi < 576; wi += gridDim.x * 4) tot += (576 - wi) < 4 ? (576 - wi) : 4;
        __builtin_amdgcn_fence(__ATOMIC_RELEASE, "agent");
        asm volatile("s_waitcnt vmcnt(0)" ::: "memory");
        __hip_atomic_fetch_add(p.ctl + R2DONE(L), (unsigned)tot, __ATOMIC_RELAXED, __HIP_MEMORY_SCOPE_AGENT);
      }
    }
    (void)ndone;
  }
  unsigned* ctr = p.ctl + QCTR(1, L);
  for (;;) {
    const int q = next_item(ctr, lds);
    if (q >= 128) break;
    attn_sample(p, L, q >> 2, q & 3, lds);
  }
  {
    const int home = (int)(xb_xcc_id() & 7u);
    int k = 0;
    int tx = take_ticket(xq_ctr(p.ctl, 2, L, k, home));
    for (;;) {
      const int i = xq_resolve(p.ctl, 2, L, 128, 1024, k, home, tx, lds);
      if (i < 0) break;
      const int x = i >> 7, j = i & 127, qt = 31 - (j >> 2), pair = 4 * x + (j & 3);
      tx = attn_body<false>(p, L, pair >> 3, pair & 7, qt, lds, xq_ctr(p.ctl, 2, L, k, home));
    }
  }
  unsigned* ctr2 = p.ctl + QCTR(2, L);
  constexpr int NC = (NT + 31) / 32, NQ2 = 32 + NC + NRW / 4;
  bool r2_seen = false;
  for (;;) {
    const int q = next_item(ctr2, lds);
    if (q >= NQ2) break;
    constexpr int NR3 = NRW / 4;
    if (q >= NR3 + 32) conv_item(p, L, q - NR3 - 32);
    else if (q >= NR3) attn_item(p, L, 1280 + q - NR3, lds);
    else {
      if (!r2_seen) {
        if (threadIdx.x == 0) {
          unsigned sp = 0;
          while (__hip_atomic_load(p.ctl + R2DONE(L), __ATOMIC_RELAXED, __HIP_MEMORY_SCOPE_AGENT) < 576u) {
            __builtin_amdgcn_s_sleep(2);
            if (++sp > (1u << 22)) { atomicAdd(&p.ctl[XB_TMO], 1u); break; }
          }
          __builtin_amdgcn_fence(__ATOMIC_ACQUIRE, "agent");
          asm volatile("s_waitcnt vmcnt(0)" ::: "memory");
        }
        __syncthreads();
        r2_seen = true;
      }
      r3_wave(p, L, q * 4 + w, lane, (float*)(lds + w * 17408));
    }
  }
}
DEV void run_p4(const Prm& p, int L, char* lds) {
  const EpiOut epo{p, L};
  const int home = (int)(xb_xcc_id() & 7u);
  int k = 0;
  int t = take_ticket(xq_ctr(p.ctl, 1, L, k, home));
  for (;;) {
    const int i = xq_resolve(p.ctl, 1, L, 128, 1024, k, home, t, lds);
    if (i < 0) break;
    t = gemm_tile(p.zE  , D, p.Wb_out + (size_t)L * 1024 * 1024, 1024, 1024, (i >> 3) * 128, (i & 7) * 128, lds, epo, xq_ctr(p.ctl, 1, L, k, home));
  }
  unsigned* ctr = p.ctl + QCTR(3, L) + 16;
  t = take_ticket(ctr);
  for (;;) {
    const int h = q_publish(t, lds);
    if (h >= 17 * 16) break;
    const int mt = 128 + (h >> 4), r = h & 15;
    t = gemm_tile<EpiOut, 4>(p.zE, D, p.Wb_out + (size_t)L * 1024 * 1024, 1024, 1024, mt * 128, (r >> 1) * 128 + (r & 1) * 64, lds, epo, ctr);
  }
}

__global__ void __launch_bounds__(256, 2) mega(Prm p) {
  extern __shared__ __attribute__((aligned(16))) char lds[];
  volatile LAS unsigned* st = (volatile LAS unsigned*)(lds + LDS_BYTES - 16);
  if (threadIdx.x == 0) { st[0] = 0u; st[1] = 0u; st[2] = 0u; st[3] = 0u; }
  __syncthreads();
  const XcdBarrier xb = xcd_barrier_post(p.ctl, st);
  phase0(p, lds);
  xcd_barrier(xb);
  for (int L = 0; L < 2; ++L) {
    run_p1(p, L, lds); xcd_barrier(xb);
    run_p2(p, L, lds); xcd_barrier(xb);
    run_p3(p, L, lds); xcd_barrier(xb);
    run_p4(p, L, lds); xcd_barrier(xb);
  }
  final_norm(p);
}

static size_t al256(size_t x) { return (x + 255) & ~(size_t)255; }
extern "C" void kernel_launch(void* const* d_in, const int* in_sizes, int n_in, void* d_out, int out_size, void* d_ws, size_t ws_size, hipStream_t stream) {
  Prm p{};
  const float* const* in = (const float* const*)d_in;
  p.x_prompt = in[0]; p.x_sample = in[1]; p.cache_ckv = in[2]; p.cache_krope = in[3]; p.state_conv = in[4]; p.state_shift = in[5]; p.state_wkv = in[6];
  p.meta = in[7]; p.norm_g = in[8]; p.w_in = in[9]; p.conv_w = in[10]; p.q_norm_g = in[11]; p.w_uq = in[12]; p.kv_norm_g = in[13]; p.w_ukv = in[14];
  p.shift_mu = in[15]; p.decay_w0 = in[16]; p.decay_w2 = in[17]; p.iclr_a0 = in[18]; p.iclr_a2 = in[19]; p.key_kk = in[20]; p.key_ka = in[21];
  p.bonus_rk = in[22]; p.lnx_w = in[23]; p.lnx_b = in[24]; p.w_out = in[25]; p.final_g = in[26];
  float* o = (float*)d_out;
  p.y_prompt = o; o += (size_t)4 * 4096 * 1024;
  p.y_sample = o; o += (size_t)32 * 64 * 1024;
  p.ckv_p = o; o += (size_t)2 * 4 * PT * 128;
  p.kr_p = o; o += (size_t)2 * 4 * PT * 32;
  p.conv_p = o; o += 2 * 4 * 2 * 256;
  p.shift_p = o; o += 2 * 4 * 896;
  p.wkv_p = o; o += 2 * 4 * 4 * 64 * 64;
  p.ckv_s = o; o += (size_t)2 * 32 * 64 * 128;
  p.kr_s = o; o += 2 * 32 * 64 * 32;
  p.conv_s = o; o += 2 * 32 * 2 * 256;
  p.shift_s = o; o += 2 * 32 * 896;
  p.wkv_s = o; o += 2 * 32 * 4 * 64 * 64;
  char* w = (char*)d_ws; size_t off = 0;
  auto take = [&](size_t bytes) { char* r = w + off; off = al256(off + bytes); return r; };
  p.ctl = (unsigned*)take(65536);
  p.Wb_in = (bf16_t*)take((size_t)2 * INP * 1024 * 2);
  p.Wb_uq = (bf16_t*)take((size_t)2 * 768 * 256 * 2);
  p.Wb_ukv = (bf16_t*)take((size_t)2 * 1024 * 128 * 2);
  p.Wb_out = (bf16_t*)take((size_t)2 * 1024 * 1024 * 2);
  p.dw2T = (bf16_t*)take((size_t)2 * 256 * 64 * 2);
  p.ia2T = (bf16_t*)take((size_t)2 * 256 * 64 * 2);
  p.ropec = (float*)take((size_t)PT * 16 * 4);
  p.ropes = (float*)take((size_t)PT * 16 * 4);
  p.ssq_x = (float*)take((size_t)7 * NTP * 4);
  p.ssq_q = p.ssq_x + 3 * NTP; p.ssq_kv = p.ssq_x + 5 * NTP;
  p.rkb = (float*)take((size_t)NTP * 4 * 4);
  p.xmeta = (float*)take((size_t)64 * 1024 * 4);
  p.zE = (bf16_t*)take((size_t)NTP * ZE * 2);
  p.zL = (bf16_t*)take((size_t)NTP * ZL * 2);
  p.xb = (bf16_t*)take((size_t)(NTP + 128) * D * 2);
  p.Kn = (bf16_t*)take((size_t)KVR * 512 * 2);
  p.Vt = (bf16_t*)take((size_t)512 * KVR * 2);
  p.Kr = (bf16_t*)take((size_t)KVR * 32 * 2);
  p.rw = take((size_t)NRW * RW_BYTES);
  p.KL = (bf16_t*)((char*)p.y_prompt + ((size_t)32 << 20));
  p.VLT = p.KL + (size_t)32 * SKEYS * 160;
  static int grid = 0;
  if (grid == 0) {
    if (off > ws_size) { fprintf(stderr, "kernel_launch: workspace too small: need %zu have %zu\n", off, ws_size); grid = -1; return; }
    int dev = 0, cus = 0, per_cu = 0;
    (void)hipGetDevice(&dev);
    (void)hipDeviceGetAttribute(&cus, hipDeviceAttributeMultiprocessorCount, dev);
    (void)hipFuncSetAttribute((const void*)mega, hipFuncAttributeMaxDynamicSharedMemorySize, LDS_BYTES);
    (void)hipOccupancyMaxActiveBlocksPerMultiprocessor(&per_cu, (const void*)mega, 256, LDS_BYTES);
    if (per_cu > 2) per_cu = 2;
    if (per_cu < 1) { fprintf(stderr, "kernel_launch: occupancy query returned %d\n", per_cu); per_cu = 1; }
    grid = cus * per_cu;
  }
  if (grid < 0) return;
  (void)hipMemsetAsync(p.ctl, 0, 8192 * 4, stream);
  void* args[] = {&p};
  hipError_t e = hipLaunchCooperativeKernel((const void*)mega, dim3(grid), dim3(256), args, LDS_BYTES, stream);
  if (e != hipSuccess) fprintf(stderr, "cooperative launch failed: %s (grid %d)\n", hipGetErrorString(e), grid);
}
```

```cpp
#include <hip/hip_runtime.h>
#include <cstdio>
#include <cstdint>
#include <type_traits>

typedef unsigned short bf16_t;
typedef short bf16x8 __attribute__((ext_vector_type(8)));
typedef float f32x4 __attribute__((ext_vector_type(4)));
typedef float f32x16 __attribute__((ext_vector_type(16)));
#define DEV __device__ __forceinline__
#define LAUNDER(x) asm volatile("" : "+v"(x))

constexpr int D = 1024;
constexpr int PT = 4112;
constexpr int NPR = 4 * PT;
constexpr int NSM = 32 * 64;
constexpr int NT = NPR + NSM;
constexpr int NTP = 18560;
constexpr int ZL = 1792;
constexpr int ZE = 1312;
constexpr int ZE_CQ = 0, ZE_CKV = 256, ZE_KR = 384, ZE_ZC = 416;
constexpr int ZL_XIN = 0, ZL_BG = 256, ZL_CG = 512, ZL_GA = 768, ZL_GB = 1024, ZL_GC = 1536;
constexpr int INP = 3200;
constexpr int KVR = 16512;
constexpr int NRW_P = 4 * 65 * 4;
constexpr int NRW = NRW_P + 32 * 4;
constexpr int RW_BYTES = 49152;
constexpr float RMS_EPS = 1e-6f;
constexpr float GN_EPS = 64e-5f;
constexpr int LDS_BYTES = 79872;
constexpr int SKEYS = 1088;

struct Prm {
  const float *x_prompt, *x_sample, *cache_ckv, *cache_krope, *state_conv, *state_shift, *state_wkv, *meta, *norm_g, *w_in,
      *conv_w, *q_norm_g, *w_uq, *kv_norm_g, *w_ukv, *shift_mu, *decay_w0, *decay_w2, *iclr_a0, *iclr_a2, *key_kk, *key_ka,
      *bonus_rk, *lnx_w, *lnx_b, *w_out, *final_g;
  float *y_prompt, *y_sample, *ckv_p, *kr_p, *conv_p, *shift_p, *wkv_p, *ckv_s, *kr_s, *conv_s, *shift_s, *wkv_s;
  unsigned* ctl;
  bf16_t *Wb_in, *Wb_uq, *Wb_ukv, *Wb_out, *dw2T, *ia2T;
  float *ropec, *ropes, *ssq_x, *ssq_q, *ssq_kv, *rkb, *xmeta;
  bf16_t *KL, *VLT;
  bf16_t *zE, *zL, *xb, *Kn, *Vt, *Kr;
  char* rw;
};

DEV float bf2f(bf16_t b) { return __uint_as_float((unsigned)b << 16); }
DEV float bflo(unsigned u) { return __uint_as_float(u << 16); }
DEV float bfhi(unsigned u) { return __uint_as_float(u & 0xffff0000u); }
typedef __bf16 hbf16x2_t __attribute__((ext_vector_type(2)));
typedef float hf32x2_t __attribute__((ext_vector_type(2)));
DEV unsigned pk2(float a, float b) { hf32x2_t f = {a, b}; hbf16x2_t r = __builtin_convertvector(f, hbf16x2_t); return __builtin_bit_cast(unsigned, r); }
DEV bf16_t f2bf(float f) { return (bf16_t)(pk2(f, 0.f) & 0xffffu); }
DEV uint2 pk4(float a, float b, float c, float d) { uint2 r; r.x = pk2(a, b); r.y = pk2(c, d); return r; }
DEV float sigmoid_(float x) { return 1.f / (1.f + __expf(-x)); }
DEV float silu_(float x) { return x / (1.f + __expf(-x)); }
DEV float wave_sum(float v) {
#pragma unroll
  for (int o = 1; o < 64; o <<= 1) v += __shfl_xor(v, o);
  return v;
}
DEV f32x16 mfma32(bf16x8 a, bf16x8 b, f32x16 c) { return __builtin_amdgcn_mfma_f32_32x32x16_bf16(a, b, c, 0, 0, 0); }
DEV f32x4 mfma16(bf16x8 a, bf16x8 b, f32x4 c) { return __builtin_amdgcn_mfma_f32_16x16x32_bf16(a, b, c, 0, 0, 0); }
DEV bf16x8 mk8(unsigned a, unsigned b, unsigned c, unsigned d) { uint4 u; u.x = a; u.y = b; u.z = c; u.w = d; return __builtin_bit_cast(bf16x8, u); }
DEV bf16x8 mk8(uint4 u) { return __builtin_bit_cast(bf16x8, u); }
DEV f32x16 zero16() { f32x16 z; for (int i = 0; i < 16; ++i) z[i] = 0.f; return z; }

DEV float* xrow_ptr(const Prm& p, int R) {
  if (R < NPR) { int s = R / PT, q = R - s * PT; return q < 16 ? p.xmeta + (size_t)(s * 16 + q) * D : p.y_prompt + ((size_t)s * 4096 + (q - 16)) * D; }
  return p.y_sample + (size_t)(R - NPR) * D;
}
DEV const float* xin_ptr(const Prm& p, int R) {
  if (R < NPR) { int s = R / PT, q = R - s * PT; return q < 16 ? p.meta + (size_t)q * D : p.x_prompt + ((size_t)s * 4096 + (q - 16)) * D; }
  return p.x_sample + (size_t)(R - NPR) * D;
}
DEV int pos_of(int R) { return R < NPR ? R % PT : 1024 + ((R - NPR) & 63); }

DEV int win_src_col(int n) {
  if (n < 1024) return n;
  if (n < 1536) return 1440 + (n - 1024);
  if (n < 1792) return 2848 + (n - 1536);
  if (n < 2208) return 1024 + (n - 1792);
  if (n < 3104) return 1952 + (n - 2208);
  return -1;
}
DEV int perm32(int rho) { const int n = rho >> 4, i = rho & 15; return 8 * (i >> 2) + 4 * n + (i & 3); }
template <bool PERM, bool P32>
DEV void conv_weight_tile(const float* __restrict__ src, int K, int N, int Npad, bf16_t* __restrict__ dst, const float* __restrict__ sk, float cst, int l, int item, float* T  , int tid) {
  const int ntn = Npad / 64, ntk = K / 64;
  const int r = item, kt = r / ntn, nt = r - kt * ntn;
  const int k0 = kt * 64, n0 = nt * 64;
  {
    const int nslot = n0 + (tid & 15) * 4;
    const int nn = P32 ? (nslot & ~31) + perm32(nslot & 31) : nslot;
    const int sn = PERM ? win_src_col(nn) : (nn < N ? nn : -1);
#pragma unroll
    for (int i = 0; i < 4; ++i) {
      const int k = (tid >> 4) + 16 * i;
      float4 v = make_float4(0.f, 0.f, 0.f, 0.f);
      if (sn >= 0) {
        v = *(const float4*)(src + ((size_t)l * K + k0 + k) * N + sn);
        const float s = (sk ? sk[l * K + k0 + k] : 1.f) * cst;
        v.x *= s; v.y *= s; v.z *= s; v.w *= s;
      }
      float* t = T + k * 65 + (tid & 15) * 4;
      t[0] = v.x; t[1] = v.y; t[2] = v.z; t[3] = v.w;
    }
  }
  __syncthreads();
  {
    const int n = tid >> 2, kc = tid & 3;
    float v[16];
#pragma unroll
    for (int j = 0; j < 16; ++j) v[j] = T[(16 * kc + j) * 65 + n];
    uint4 o0, o1;
    o0.x = pk2(v[0], v[1]); o0.y = pk2(v[2], v[3]); o0.z = pk2(v[4], v[5]); o0.w = pk2(v[6], v[7]);
    o1.x = pk2(v[8], v[9]); o1.y = pk2(v[10], v[11]); o1.z = pk2(v[12], v[13]); o1.w = pk2(v[14], v[15]);
    bf16_t* d = dst + ((size_t)l * Npad + n0 + n) * K + k0 + 16 * kc;
    *(uint4*)d = o0; *(uint4*)(d + 8) = o1;
  }
  __syncthreads();
}
constexpr int WT0 = 16 * 50, WT1 = WT0 + 16 * 16, WT2 = WT1 + 4 * 12, WT3 = WT2 + 2 * 16, WT4 = WT3 + 4, NWT = WT4 + 4;
DEV void conv_weights_item(const Prm& p, int l, int it, char* lds) {
  float* T = (float*)lds;
  int tid = threadIdx.x; LAUNDER(tid);
  if (it < WT0) conv_weight_tile<true, true>(p.w_in, 1024, 3104, INP, p.Wb_in, p.norm_g, 1.f, l, it, T, tid);
  else if (it < WT1) conv_weight_tile<false, true>(p.w_out, 1024, 1024, 1024, p.Wb_out, nullptr, 1.f, l, it - WT0, T, tid);
  else if (it < WT2) conv_weight_tile<false, false>(p.w_uq, 256, 768, 768, p.Wb_uq, p.q_norm_g, 0.10206207261596575f * 1.4426950408889634f, l, it - WT1, T, tid);
  else if (it < WT3) conv_weight_tile<false, false>(p.w_ukv, 128, 1024, 1024, p.Wb_ukv, nullptr, 1.f, l, it - WT2, T, tid);
  else if (it < WT4) conv_weight_tile<false, false>(p.decay_w2, 64, 256, 256, p.dw2T, nullptr, 1.f, l, it - WT3, T, tid);
  else conv_weight_tile<false, false>(p.iclr_a2, 64, 256, 256, p.ia2T, nullptr, 1.f, l, it - WT4, T, tid);
}
DEV void phase0(const Prm& p, char* lds) {
  int tid = threadIdx.x; LAUNDER(tid);
  const int lane = tid & 63, wv = tid >> 6;
  const int gw = blockIdx.x * 4 + wv, NW = gridDim.x * 4;
  const int gt = blockIdx.x * 256 + tid, NTH = gridDim.x * 256;
  for (int R = gw; R < NT; R += NW) {
    const float* src = xin_ptr(p, R);
    float ss = 0.f;
#pragma unroll
    for (int j = 0; j < 4; ++j) {
      const float4 v = ((const float4*)src)[lane + 64 * j];
      ss += v.x * v.x + v.y * v.y + v.z * v.z + v.w * v.w;
      ((uint2*)(p.xb + (size_t)R * D))[lane + 64 * j] = pk4(v.x, v.y, v.z, v.w);
    }
    ss = wave_sum(ss);
    if (lane == 0) p.ssq_x[R] = ss;
  }
  for (int i = gt; i < 6 * NTP; i += NTH) p.ssq_x[NTP + i] = 0.f;
  for (int it = blockIdx.x; it < NWT; it += gridDim.x) conv_weights_item(p, 0, it, lds);
  for (int i = gt; i < PT * 16; i += NTH) {
    const int pos = i >> 4, j = i & 15;
    const float inv = powf(10000.f, -(float)j * 2.0f / 32.f);
    const float ang = (float)pos * inv;
    double a = (double)ang;
    a -= 6.283185307179586476925 * rint(a * 0.15915494309189533577);
    p.ropec[i] = (float)cos(a);
    p.ropes[i] = (float)sin(a);
  }
}

#define LAS3 __attribute__((address_space(3)))
#define RAW_BARRIER() { asm volatile("" ::: "memory"); __builtin_amdgcn_s_barrier(); asm volatile("" ::: "memory"); }
DEV int lds_byte(int r, int c) { const int st = (r >> 4) * 2 + (c >> 5), rr = r & 15, cc = c & 31, ob = rr * 64 + cc * 2; return st * 1024 + (ob ^ (((ob >> 9) & 1) << 5)); }
template <class Epi, int NB = 8>
DEV int gemm_tile(const bf16_t* __restrict__ A, int lda, const bf16_t* __restrict__ Bt, int ldb, int K, int m0, int n0, char* lds, const Epi& epi, unsigned* nctr = nullptr) {
  int tid = threadIdx.x; LAUNDER(tid);
  const int lane = tid & 63, w = __builtin_amdgcn_readfirstlane(tid >> 6), wr = w >> 1, wc = w & 1;
  const int fr = lane & 15, fq = lane >> 4;
  const int sb = lane * 16, swz = sb ^ (((sb >> 9) & 1) << 5), rl = swz >> 6, cl = (swz & 63) >> 1;
  const bf16_t* ga[4]; const bf16_t* gb[4];
#pragma unroll
  for (int i = 0; i < 4; ++i) {
    const int st = 4 * w + i, r = (st >> 1) * 16 + rl, c = (st & 1) * 32 + cl;
    ga[i] = A + (size_t)(m0 + r) * lda + c;
    gb[i] = Bt + (size_t)(n0 + r) * ldb + c;
  }
  const int nk = K / 64;
#define GSTAGE(S, KT) { _Pragma("unroll") for (int i = 0; i < 4; ++i) { \
      __builtin_amdgcn_global_load_lds((const unsigned*)(ga[i] + (KT) * 64), (LAS3 unsigned*)(lds + (S) * 32768 + (4 * w + i) * 1024 + lane * 16), 16, 0, 0); \
      if (2 * w + (i >> 1) < NB) __builtin_amdgcn_global_load_lds((const unsigned*)(gb[i] + (KT) * 64), (LAS3 unsigned*)(lds + (S) * 32768 + 16384 + (4 * w + i) * 1024 + lane * 16), 16, 0, 0); } }
  f32x4 acc[4][4];
#pragma unroll
  for (int i = 0; i < 4; ++i)
#pragma unroll
    for (int j = 0; j < 4; ++j) acc[i][j] = (f32x4){0.f, 0.f, 0.f, 0.f};
  int offA[2], offB[2];
#pragma unroll
  for (int kh = 0; kh < 2; ++kh) { offA[kh] = lds_byte(wr * 64 + fr, kh * 32 + fq * 8); offB[kh] = lds_byte(wc * 64 + fr, kh * 32 + fq * 8); }
  GSTAGE(0, 0)
  if (nk > 1) GSTAGE(1, 1)
  for (int kt = 0; kt < nk; ++kt) {
    const int s = kt & 1;
    if (kt + 1 < nk) { if (2 * w < NB) asm volatile("s_waitcnt vmcnt(8)" ::: "memory"); else asm volatile("s_waitcnt vmcnt(4)" ::: "memory"); }
    else asm volatile("s_waitcnt vmcnt(0)" ::: "memory");
    RAW_BARRIER()
    const char* ia = lds + s * 32768;
    const char* ib = ia + 16384;
    bf16x8 af[2][4], bfv[2][4];
#pragma unroll
    for (int kh = 0; kh < 2; ++kh) {
#pragma unroll
      for (int mi = 0; mi < 4; ++mi) af[kh][mi] = *(const bf16x8*)(ia + offA[kh] + mi * 2048);
#pragma unroll
      for (int ni = 0; ni < (NB < 4 ? NB : 4); ++ni) bfv[kh][ni] = *(const bf16x8*)(ib + offB[kh] + ni * 2048);
    }
    asm volatile("s_waitcnt lgkmcnt(0)" ::: "memory");
    RAW_BARRIER()
    if (kt + 2 < nk) GSTAGE(s, kt + 2)
    __builtin_amdgcn_sched_barrier(0);
    if (NB == 8 || wc == 0) {
#pragma unroll
      for (int kh = 0; kh < 2; ++kh)
#pragma unroll
        for (int mi = 0; mi < 4; ++mi)
#pragma unroll
          for (int ni = 0; ni < (NB < 4 ? NB : 4); ++ni) acc[mi][ni] = mfma16(bfv[kh][ni], af[kh][mi], acc[mi][ni]);
    }
  }
  __syncthreads();
#undef GSTAGE
  int tk = 0x7fffffff; if (nctr && tid == 0) tk = (int)atomicAdd(nctr, 1u);
  if (NB == 8 || wc == 0) epi(acc, m0 + wr * 64, n0 + wc * 64, fr, fq);
  return tk;
}

DEV int lds_byte32(int r, int c) { const int rr = r & 15, ob = rr * 64 + c * 2; return (r >> 4) * 1024 + (ob ^ (((ob >> 9) & 1) << 5)); }
template <class Epi>
DEV void gemm_tile_big(const bf16_t* __restrict__ A, int lda, const bf16_t* __restrict__ Bt, int ldb, int K, int m0, int n0, char* lds, const Epi& epi) {
  int tid = threadIdx.x; LAUNDER(tid);
  const int lane = tid & 63, w = __builtin_amdgcn_readfirstlane(tid >> 6), wr = w >> 1, wc = w & 1;
  const int fr = lane & 15, fq = lane >> 4;
  const int sb = lane * 16, swz = sb ^ (((sb >> 9) & 1) << 5), rl = swz >> 6, cl = (swz & 63) >> 1;
  const bf16_t* ga[4]; const bf16_t* gb[2];
#pragma unroll
  for (int i = 0; i < 4; ++i) ga[i] = A + (size_t)(m0 + (4 * w + i) * 16 + rl) * lda + cl;
#pragma unroll
  for (int i = 0; i < 2; ++i) gb[i] = Bt + (size_t)(n0 + (2 * w + i) * 16 + rl) * ldb + cl;
  const int nk = K / 32;
#define GSTAGE3(S, KT) { _Pragma("unroll") for (int i = 0; i < 4; ++i) \
      __builtin_amdgcn_global_load_lds((const unsigned*)(ga[i] + (KT) * 32), (LAS3 unsigned*)(lds + (S) * 24576 + (4 * w + i) * 1024 + lane * 16), 16, 0, 0); \
    _Pragma("unroll") for (int i = 0; i < 2; ++i) \
      __builtin_amdgcn_global_load_lds((const unsigned*)(gb[i] + (KT) * 32), (LAS3 unsigned*)(lds + (S) * 24576 + 16384 + (2 * w + i) * 1024 + lane * 16), 16, 0, 0); }
  f32x4 acc[8][4];
#pragma unroll
  for (int i = 0; i < 8; ++i)
#pragma unroll
    for (int j = 0; j < 4; ++j) acc[i][j] = (f32x4){0.f, 0.f, 0.f, 0.f};
  const int offA = lds_byte32(wr * 128 + fr, fq * 8), offB = 16384 + lds_byte32(wc * 64 + fr, fq * 8);
  GSTAGE3(0, 0)
  if (nk > 1) GSTAGE3(1, 1)
  int s = 0;
  for (int kt = 0; kt < nk; ++kt) {
    if (kt + 1 < nk) asm volatile("s_waitcnt vmcnt(6)" ::: "memory"); else asm volatile("s_waitcnt vmcnt(0)" ::: "memory");
    RAW_BARRIER()
    if (kt + 2 < nk) { const int s2 = s + 2 >= 3 ? s - 1 : s + 2; GSTAGE3(s2, kt + 2) }
    const char* im = lds + s * 24576;
    bf16x8 af[8], bfv[4];
#pragma unroll
    for (int ni = 0; ni < 4; ++ni) bfv[ni] = *(const bf16x8*)(im + offB + ni * 1024);
#pragma unroll
    for (int mi = 0; mi < 8; ++mi) af[mi] = *(const bf16x8*)(im + offA + mi * 1024);
#pragma unroll
    for (int mi = 0; mi < 8; ++mi)
#pragma unroll
      for (int ni = 0; ni < 4; ++ni) acc[mi][ni] = mfma16(bfv[ni], af[mi], acc[mi][ni]);
    s = s + 1 >= 3 ? 0 : s + 1;
  }
  __syncthreads();
#undef GSTAGE3
  epi(acc, m0 + wr * 128, n0 + wc * 64, fr, fq);
}

struct EpiIn {
  const Prm& p; int L;
  struct Pre { float s[4]; };
  DEV Pre preload(int mb, int nb, int fr, int fq) const {
    Pre r;
#pragma unroll
    for (int mi = 0; mi < 4; ++mi) r.s[mi] = p.ssq_x[L * NTP + mb + 16 * mi + fr];
    return r;
  }
  DEV void operator()(f32x4 (&acc)[4][4], int mb, int nb, int fr, int fq) const { finish(acc, preload(mb, nb, fr, fq), mb, nb, fr, fq); }
  DEV void finish(f32x4 (&acc)[4][4], const Pre& pre, int mb, int nb, int fr, int fq) const {
#pragma unroll
    for (int mi = 0; mi < 4; ++mi) {
      const int m = mb + 16 * mi + fr;
      const bool ok = m < NT;
      const float rstd = rsqrtf(pre.s[mi] * (1.f / 1024.f) + RMS_EPS);
      float sq = 0.f;
#pragma unroll
      for (int g = 0; g < 2; ++g) {
        const int n0 = nb + 32 * g;
        if (n0 >= 3104) continue;
        bf16_t* dst = n0 < ZL ? p.zL + (size_t)m * ZL + n0 : p.zE + (size_t)m * ZE + (n0 - ZL);
        float v[8];
#pragma unroll
        for (int j = 0; j < 4; ++j) { v[j] = acc[mi][2 * g][j] * rstd; v[4 + j] = acc[mi][2 * g + 1][j] * rstd; }
#pragma unroll
        for (int j = 0; j < 8; ++j) sq += v[j] * v[j];
        if (ok) { uint4 o; o.x = pk2(v[0], v[1]); o.y = pk2(v[2], v[3]); o.z = pk2(v[4], v[5]); o.w = pk2(v[6], v[7]); *(uint4*)(dst + 8 * fq) = o; }
      }
      if (nb >= ZL && nb < ZL + 384) {
        sq += __shfl_xor(sq, 16); sq += __shfl_xor(sq, 32);
        if (fq == 0 && ok) atomicAdd((nb < ZL + 256 ? p.ssq_q : p.ssq_kv) + L * NTP + m, sq);
      }
    }
  }
};
struct EpiQ {
  const Prm& p; int L;
  DEV void operator()(f32x4 (&acc)[4][4], int mb, int nb, int fr, int fq) const {
    bf16_t* Qb = (bf16_t*)p.y_prompt;
#pragma unroll
    for (int mi = 0; mi < 4; ++mi) {
      const int m = mb + 16 * mi + fr;
      const bool ok = m < NT;
      const float rstd = rsqrtf(p.ssq_q[L * NTP + m] * (1.f / 256.f) + RMS_EPS);
      const int pos = pos_of(ok ? m : 0);
#pragma unroll
      for (int np = 0; np < 2; ++np) {
        const int n0 = nb + 32 * np;
        float v[2][4];
#pragma unroll
        for (int h2 = 0; h2 < 2; ++h2)
#pragma unroll
          for (int j = 0; j < 4; ++j) v[h2][j] = acc[mi][2 * np + h2][j] * rstd;
        if (((n0 >> 5) % 3) == 2) {
#pragma unroll
          for (int j = 0; j < 4; ++j) {
            const int c = 4 * fq + j;
            const float cs = p.ropec[pos * 16 + c], sn = p.ropes[pos * 16 + c];
            const float x1 = v[0][j], x2 = v[1][j];
            v[0][j] = x1 * cs - x2 * sn; v[1][j] = x1 * sn + x2 * cs;
          }
        }
        if (ok) {
          *(uint2*)(Qb + (size_t)m * 768 + n0 + 4 * fq) = pk4(v[0][0], v[0][1], v[0][2], v[0][3]);
          *(uint2*)(Qb + (size_t)m * 768 + n0 + 16 + 4 * fq) = pk4(v[1][0], v[1][1], v[1][2], v[1][3]);
        }
      }
    }
  }
};
struct EpiOut {
  const Prm& p; int L;
  struct Pre { uint4 x[4][2]; };
  DEV Pre preload(int mb, int nb, int fr, int fq) const {
    Pre r;
#pragma unroll
    for (int mi = 0; mi < 4; ++mi) {
      const int m = mb + 16 * mi + fr;
      const bf16_t* xr = p.xb + (size_t)(m < NT ? m : 0) * D;
#pragma unroll
      for (int g = 0; g < 2; ++g) r.x[mi][g] = *(const uint4*)(xr + nb + 32 * g + 8 * fq);
    }
    return r;
  }
  DEV void operator()(f32x4 (&acc)[4][4], int mb, int nb, int fr, int fq) const { finish(acc, preload(mb, nb, fr, fq), mb, nb, fr, fq); }
  DEV void finish(f32x4 (&acc)[4][4], const Pre& pre, int mb, int nb, int fr, int fq) const {
#pragma unroll
    for (int mi = 0; mi < 4; ++mi) {
      const int m = mb + 16 * mi + fr;
      const bool ok = m < NT;
      bf16_t* xr = p.xb + (size_t)(ok ? m : 0) * D;
      float ss = 0.f;
#pragma unroll
      for (int g = 0; g < 2; ++g) {
        const int col = nb + 32 * g + 8 * fq;
        const uint4 xi = pre.x[mi][g];
        float v[8] = {bflo(xi.x), bfhi(xi.x), bflo(xi.y), bfhi(xi.y), bflo(xi.z), bfhi(xi.z), bflo(xi.w), bfhi(xi.w)};
#pragma unroll
        for (int j = 0; j < 4; ++j) { v[j] += acc[mi][2 * g][j]; v[4 + j] += acc[mi][2 * g + 1][j]; }
#pragma unroll
        for (int j = 0; j < 8; ++j) ss += v[j] * v[j];
        if (ok) { uint4 o; o.x = pk2(v[0], v[1]); o.y = pk2(v[2], v[3]); o.z = pk2(v[4], v[5]); o.w = pk2(v[6], v[7]); *(uint4*)(xr + col) = o; }
      }
      ss += __shfl_xor(ss, 16); ss += __shfl_xor(ss, 32);
      if (fq == 0 && ok) atomicAdd(p.ssq_x + (L + 1) * NTP + m, ss);
    }
  }
};

DEV void kv_prep_row(const Prm& p, int L, int R, int half, bool valid, bf16_t* At_row  ) {
  const int Rl = valid ? R : 0;
  const bf16_t* zr = p.zE + (size_t)Rl * ZE;
  const float rstd = rsqrtf(p.ssq_kv[L * NTP + Rl] * (1.f / 128.f) + RMS_EPS);
  float* outc; float* outk;
  if (Rl < NPR) { const int s = Rl / PT, q = Rl - s * PT; outc = p.ckv_p + (((size_t)L * 4 + s) * PT + q) * 128; outk = p.kr_p + (((size_t)L * 4 + s) * PT + q) * 32; }
  else { const int j = Rl - NPR; outc = p.ckv_s + ((size_t)L * NSM + j) * 128; outk = p.kr_s + ((size_t)L * NSM + j) * 32; }
  const float* g = p.kv_norm_g + L * 128 + 64 * half;
#pragma unroll
  for (int c8 = 0; c8 < 8; ++c8) {
    const uint4 u = *(const uint4*)(zr + ZE_CKV + 64 * half + 8 * c8);
    const float4 g0 = *(const float4*)(g + 8 * c8), g1 = *(const float4*)(g + 8 * c8 + 4);
    float4 y0, y1;
    y0.x = bflo(u.x) * rstd * g0.x; y0.y = bfhi(u.x) * rstd * g0.y; y0.z = bflo(u.y) * rstd * g0.z; y0.w = bfhi(u.y) * rstd * g0.w;
    y1.x = bflo(u.z) * rstd * g1.x; y1.y = bfhi(u.z) * rstd * g1.y; y1.z = bflo(u.w) * rstd * g1.z; y1.w = bfhi(u.w) * rstd * g1.w;
    if (valid) { *(float4*)(outc + 64 * half + 8 * c8) = y0; *(float4*)(outc + 64 * half + 8 * c8 + 4) = y1; }
    if (At_row) { uint4 o; o.x = pk2(y0.x, y0.y); o.y = pk2(y0.z, y0.w); o.z = pk2(y1.x, y1.y); o.w = pk2(y1.z, y1.w); *(uint4*)(At_row + 64 * half + 8 * c8) = o; }
    if (valid && Rl >= NPR) {
      const int j = Rl - NPR, b = j >> 6, r = j & 63;
      bf16_t* kl = p.KL + ((size_t)b * SKEYS + 1024 + r) * 160 + 16 * (4 * half + (c8 >> 1)) + 4 * (c8 & 1);
      *(uint2*)kl = pk4(y0.x, y0.y, y0.z, y0.w); *(uint2*)(kl + 8) = pk4(y1.x, y1.y, y1.z, y1.w);
    }
    if (c8 & 1) __builtin_amdgcn_sched_barrier(0);
  }
  if (half == 0) {
    const int pos = pos_of(Rl);
#pragma unroll
    for (int c8 = 0; c8 < 2; ++c8) {
      const uint4 u = *(const uint4*)(zr + ZE_KR + 8 * c8), v = *(const uint4*)(zr + ZE_KR + 16 + 8 * c8);
      const float x1[8] = {bflo(u.x), bfhi(u.x), bflo(u.y), bfhi(u.y), bflo(u.z), bfhi(u.z), bflo(u.w), bfhi(u.w)};
      const float x2[8] = {bflo(v.x), bfhi(v.x), bflo(v.y), bfhi(v.y), bflo(v.z), bfhi(v.z), bflo(v.w), bfhi(v.w)};
      float y1[8], y2[8];
#pragma unroll
      for (int e = 0; e < 8; ++e) {
        const float cs = p.ropec[pos * 16 + 8 * c8 + e], sn = p.ropes[pos * 16 + 8 * c8 + e];
        y1[e] = x1[e] * cs - x2[e] * sn; y2[e] = x1[e] * sn + x2[e] * cs;
      }
      if (valid) {
        float4 o;
        o.x = y1[0]; o.y = y1[1]; o.z = y1[2]; o.w = y1[3]; *(float4*)(outk + 8 * c8) = o;
        o.x = y1[4]; o.y = y1[5]; o.z = y1[6]; o.w = y1[7]; *(float4*)(outk + 8 * c8 + 4) = o;
        o.x = y2[0]; o.y = y2[1]; o.z = y2[2]; o.w = y2[3]; *(float4*)(outk + 16 + 8 * c8) = o;
        o.x = y2[4]; o.y = y2[5]; o.z = y2[6]; o.w = y2[7]; *(float4*)(outk + 16 + 8 * c8 + 4) = o;
        {
          const int j = Rl - NPR;
          bf16_t* krd = Rl < NPR ? p.Kr + (size_t)Rl * 32 : p.KL + ((size_t)(j >> 6) * SKEYS + 1024 + (j & 63)) * 160 + 128;
          uint4 q; q.x = pk2(y1[0], y1[1]); q.y = pk2(y1[2], y1[3]); q.z = pk2(y1[4], y1[5]); q.w = pk2(y1[6], y1[7]); *(uint4*)(krd + 8 * c8) = q;
          q.x = pk2(y2[0], y2[1]); q.y = pk2(y2[2], y2[3]); q.z = pk2(y2[4], y2[5]); q.w = pk2(y2[6], y2[7]); *(uint4*)(krd + 16 + 8 * c8) = q;
        }
      }
    }
  }
}
DEV void kvproj_item(const Prm& p, int L, int mt, char* lds) {
  int tid = threadIdx.x; LAUNDER(tid);
  const int lane = tid & 63, w = __builtin_amdgcn_readfirstlane(tid >> 6), wr = w >> 1, wc = w & 1, l31 = lane & 31, hh = lane >> 5;
  bf16_t* At = (bf16_t*)lds;
  bf16_t* Bs = At + 128 * 136;
  {
    const int r = tid >> 1, half = tid & 1, R = mt * 128 + r;
    kv_prep_row(p, L, R, half, R < NPR, At + r * 136);
  }
  for (int h = 0; h < 8; ++h) {
    __syncthreads();
    {
      const bf16_t* wsrc = p.Wb_ukv + ((size_t)L * 1024 + h * 128) * 128;
#pragma unroll
      for (int i = 0; i < 8; ++i) { const int id = tid + 256 * i, row = id >> 4, cc = id & 15; *(uint4*)(Bs + row * 136 + cc * 8) = *(const uint4*)(wsrc + row * 128 + cc * 8); }
    }
    __syncthreads();
    f32x16 acc[2][2];
#pragma unroll
    for (int i = 0; i < 2; ++i)
#pragma unroll
      for (int j = 0; j < 2; ++j) acc[i][j] = zero16();
    const bf16_t* as = At + (wr * 64 + l31) * 136 + hh * 8;
    const bf16_t* bs = Bs + (wc * 64 + l31) * 136 + hh * 8;
    if (wc == 0) {
#pragma unroll 2
      for (int ks = 0; ks < 8; ++ks) {
        const bf16x8 a0 = *(const bf16x8*)(as + ks * 16), a1 = *(const bf16x8*)(as + 32 * 136 + ks * 16);
        const bf16x8 b0 = *(const bf16x8*)(bs + ks * 16), b1 = *(const bf16x8*)(bs + 32 * 136 + ks * 16);
        acc[0][0] = mfma32(b0, a0, acc[0][0]); acc[0][1] = mfma32(b1, a0, acc[0][1]);
        acc[1][0] = mfma32(b0, a1, acc[1][0]); acc[1][1] = mfma32(b1, a1, acc[1][1]);
      }
#pragma unroll
      for (int i = 0; i < 2; ++i) {
        const int KRr = mt * 128 + wr * 64 + 32 * i + l31;
#pragma unroll
        for (int j = 0; j < 2; ++j)
#pragma unroll
          for (int G = 0; G < 4; ++G)
            *(uint2*)(p.Kn + ((size_t)KRr * 8 + h) * 64 + 32 * j + 8 * G + 4 * hh) = pk4(acc[i][j][4 * G], acc[i][j][4 * G + 1], acc[i][j][4 * G + 2], acc[i][j][4 * G + 3]);
      }
    } else {
#pragma unroll 2
      for (int ks = 0; ks < 8; ++ks) {
        const bf16x8 a0 = *(const bf16x8*)(as + ks * 16), a1 = *(const bf16x8*)(as + 32 * 136 + ks * 16);
        const bf16x8 b0 = *(const bf16x8*)(bs + ks * 16), b1 = *(const bf16x8*)(bs + 32 * 136 + ks * 16);
        acc[0][0] = mfma32(a0, b0, acc[0][0]); acc[0][1] = mfma32(a0, b1, acc[0][1]);
        acc[1][0] = mfma32(a1, b0, acc[1][0]); acc[1][1] = mfma32(a1, b1, acc[1][1]);
      }
#pragma unroll
      for (int j = 0; j < 2; ++j) {
        const int d = 32 * j + l31;
#pragma unroll
        for (int i = 0; i < 2; ++i)
#pragma unroll
          for (int G = 0; G < 4; ++G) {
            const int KRr = mt * 128 + wr * 64 + 32 * i + 16 * (G >> 1) + 8 * hh + 4 * (G & 1);
            *(uint2*)(p.Vt + ((size_t)h * 64 + d) * KVR + KRr) = pk4(acc[i][j][4 * G], acc[i][j][4 * G + 1], acc[i][j][4 * G + 2], acc[i][j][4 * G + 3]);
          }
      }
    }
  }
  __syncthreads();
}
DEV void sample_prep_item(const Prm& p, int L, int it) {
  int tid = threadIdx.x; LAUNDER(tid);
  const int R = NPR + it * 128 + (tid >> 1);
  kv_prep_row(p, L, R, tid & 1, true, nullptr);
}
DEV void shift_item(const Prm& p, int L, int st) {
  int tid0 = threadIdx.x; LAUNDER(tid0);
  if (tid0 < 224) {
    const int R = st < 4 ? st * PT + (PT - 1) : NPR + (st - 4) * 64 + 63;
    const uint2 u = *(const uint2*)(p.zE + (size_t)R * ZE + ZE_ZC + 4 * tid0);
    float4 v; v.x = bflo(u.x); v.y = bfhi(u.x); v.z = bflo(u.y); v.w = bfhi(u.y);
    float* dst = st < 4 ? p.shift_p + ((size_t)L * 4 + st) * 896 : p.shift_s + ((size_t)L * 32 + (st - 4)) * 896;
    *(float4*)(dst + 4 * tid0) = v;
  }
}

DEV void lat_item(const Prm& p, int L, int j) {
  int tid = threadIdx.x; LAUNDER(tid);
  const int b = j >> 4, t = j & 15;
  const float* csrc = p.cache_ckv + (((size_t)L * 32 + b) * 1024 + 64 * t) * 128;
  const float* ksrc = p.cache_krope + (((size_t)L * 32 + b) * 1024 + 64 * t) * 32;
  {
    const int row = tid >> 2, qd = tid & 3;
    const float* s = csrc + row * 128 + 32 * qd;
    bf16_t* d = p.KL + ((size_t)b * SKEYS + 64 * t + row) * 160;
    const float4 v0 = *(const float4*)(s), v1 = *(const float4*)(s + 4), v2 = *(const float4*)(s + 8), v3 = *(const float4*)(s + 12);
    const float4 v4 = *(const float4*)(s + 16), v5 = *(const float4*)(s + 20), v6 = *(const float4*)(s + 24), v7 = *(const float4*)(s + 28);
    const float4 k0 = *(const float4*)(ksrc + row * 32 + 8 * qd), k1 = *(const float4*)(ksrc + row * 32 + 8 * qd + 4);
    uint4 a;
    a.x = pk2(v0.x, v0.y); a.y = pk2(v0.z, v0.w); a.z = pk2(v2.x, v2.y); a.w = pk2(v2.z, v2.w); *(uint4*)(d + 32 * qd) = a;
    a.x = pk2(v1.x, v1.y); a.y = pk2(v1.z, v1.w); a.z = pk2(v3.x, v3.y); a.w = pk2(v3.z, v3.w); *(uint4*)(d + 32 * qd + 8) = a;
    a.x = pk2(v4.x, v4.y); a.y = pk2(v4.z, v4.w); a.z = pk2(v6.x, v6.y); a.w = pk2(v6.z, v6.w); *(uint4*)(d + 32 * qd + 16) = a;
    a.x = pk2(v5.x, v5.y); a.y = pk2(v5.z, v5.w); a.z = pk2(v7.x, v7.y); a.w = pk2(v7.z, v7.w); *(uint4*)(d + 32 * qd + 24) = a;
    a.x = pk2(k0.x, k0.y); a.y = pk2(k0.z, k0.w); a.z = pk2(k1.x, k1.y); a.w = pk2(k1.z, k1.w); *(uint4*)(d + 128 + 8 * qd) = a;
  }
}

template <bool SAMPLE>
DEV int attn_body(const Prm& p, int L, int sb, int head, int qt, char* lds, unsigned* nctr = nullptr) {
  int tid = threadIdx.x; LAUNDER(tid);
  const int lane = tid & 63, w = __builtin_amdgcn_readfirstlane(tid >> 6), l31 = lane & 31, hh = lane >> 5;
  bf16_t* Ks = (bf16_t*)lds;
  bf16_t* Vs = Ks + (SAMPLE ? 1 : 2) * 64 * 104;
  bf16_t* Cs = Vs + (SAMPLE ? 1 : 2) * 64 * 72;
  bf16_t* Wl = Cs + 64 * 136;
  const bf16_t* Qb = (const bf16_t*)p.y_prompt;
  bf16_t* mix = p.zE;
  int Rq0, ntiles, lastvis; bool wact, rowvalid;
  if (SAMPLE) { Rq0 = NPR + 64 * sb; ntiles = 17; lastvis = 16; wact = w < 2; rowvalid = wact; }
  else if (qt >= 0) { Rq0 = sb * PT + 16 + 128 * qt; ntiles = 2 * qt + 3; lastvis = 1 + 2 * qt + (w >> 1); wact = true; rowvalid = true; }
  else { Rq0 = sb * PT; ntiles = 1; lastvis = 0; wact = (w == 0); rowvalid = wact && l31 < 16; }
  const int myrow = Rq0 + 32 * w + l31;
  const int Rld = rowvalid ? myrow : Rq0;
  bf16x8 qf[6];
  {
    const bf16_t* qp = Qb + (size_t)Rld * 768 + head * 96 + hh * 8;
#pragma unroll
    for (int ks = 0; ks < 6; ++ks) qf[ks] = *(const bf16x8*)(qp + 16 * ks);
  }
  float m_run = -1e30f, l_run = 0.f;
  f32x16 o0 = zero16(), o1 = zero16();

  uint4 a_kn0, a_kn1, a_kr, a_vt0, a_vt1;
  a_kn0 = a_kn1 = a_kr = a_vt0 = a_vt1 = make_uint4(0, 0, 0, 0);
#define PLOADX(S, TI) { const int KR0 = sb * PT + ((TI) == 0 ? 0 : 16 + 64 * ((TI) - 1)); \
    S##_kn0 = *(const uint4*)(p.Kn + ((size_t)(KR0 + (tid >> 3)) * 8 + head) * 64 + (tid & 7) * 8); \
    S##_kn1 = *(const uint4*)(p.Kn + ((size_t)(KR0 + 32 + (tid >> 3)) * 8 + head) * 64 + (tid & 7) * 8); \
    S##_kr = *(const uint4*)(p.Kr + (size_t)(KR0 + (tid >> 2)) * 32 + (tid & 3) * 8); \
    S##_vt0 = *(const uint4*)(p.Vt + ((size_t)head * 64 + (tid >> 3)) * KVR + KR0 + (tid & 7) * 8); \
    S##_vt1 = *(const uint4*)(p.Vt + ((size_t)head * 64 + 32 + (tid >> 3)) * KVR + KR0 + (tid & 7) * 8); }
#define PWRITEX(S, BUF) { bf16_t* kb_ = Ks + (BUF) * 64 * 104; bf16_t* vb_ = Vs + (BUF) * 64 * 72; \
    *(uint4*)(kb_ + (tid >> 3) * 104 + (tid & 7) * 8) = S##_kn0; *(uint4*)(kb_ + (32 + (tid >> 3)) * 104 + (tid & 7) * 8) = S##_kn1; \
    *(uint4*)(kb_ + (tid >> 2) * 104 + 64 + (tid & 3) * 8) = S##_kr; \
    *(uint4*)(vb_ + (tid >> 3) * 72 + (tid & 7) * 8) = S##_vt0; *(uint4*)(vb_ + (32 + (tid >> 3)) * 72 + (tid & 7) * 8) = S##_vt1; }
  float4 pc0, pc1, pc2, pc3, pc4, pc5, pc6, pc7, pk0, pk1;
  pc0 = pc1 = pc2 = pc3 = pc4 = pc5 = pc6 = pc7 = pk0 = pk1 = make_float4(0.f, 0.f, 0.f, 0.f);
  if (SAMPLE) {
    const bf16_t* wsrc = p.Wb_ukv + ((size_t)L * 1024 + head * 128) * 128;
#pragma unroll
    for (int i = 0; i < 8; ++i) { const int id = tid + 256 * i, row = id >> 4, cc = id & 15; *(uint4*)(Wl + row * 136 + cc * 8) = *(const uint4*)(wsrc + row * 128 + cc * 8); }
  }
#define SLOAD(TI) { const float* csrc; const float* ksrc; \
    if ((TI) < 16) { csrc = p.cache_ckv + (((size_t)L * 32 + sb) * 1024 + 64 * (TI)) * 128; ksrc = p.cache_krope + (((size_t)L * 32 + sb) * 1024 + 64 * (TI)) * 32; } \
    else { csrc = p.ckv_s + ((size_t)L * NSM + 64 * sb) * 128; ksrc = p.kr_s + ((size_t)L * NSM + 64 * sb) * 32; } \
    const float* cb_ = csrc + (tid >> 5) * 128 + (tid & 31) * 4; \
    pc0 = *(const float4*)(cb_); pc1 = *(const float4*)(cb_ + 8 * 128); pc2 = *(const float4*)(cb_ + 16 * 128); pc3 = *(const float4*)(cb_ + 24 * 128); \
    pc4 = *(const float4*)(cb_ + 32 * 128); pc5 = *(const float4*)(cb_ + 40 * 128); pc6 = *(const float4*)(cb_ + 48 * 128); pc7 = *(const float4*)(cb_ + 56 * 128); \
    const float* kb2_ = ksrc + (tid >> 3) * 32 + (tid & 7) * 4; pk0 = *(const float4*)(kb2_); pk1 = *(const float4*)(kb2_ + 32 * 32); }
#define SWRITE(BUF) { bf16_t* cd_ = Cs + (tid >> 5) * 136 + (tid & 31) * 4; \
    *(uint2*)(cd_) = pk4(pc0.x, pc0.y, pc0.z, pc0.w); *(uint2*)(cd_ + 8 * 136) = pk4(pc1.x, pc1.y, pc1.z, pc1.w); \
    *(uint2*)(cd_ + 16 * 136) = pk4(pc2.x, pc2.y, pc2.z, pc2.w); *(uint2*)(cd_ + 24 * 136) = pk4(pc3.x, pc3.y, pc3.z, pc3.w); \
    *(uint2*)(cd_ + 32 * 136) = pk4(pc4.x, pc4.y, pc4.z, pc4.w); *(uint2*)(cd_ + 40 * 136) = pk4(pc5.x, pc5.y, pc5.z, pc5.w); \
    *(uint2*)(cd_ + 48 * 136) = pk4(pc6.x, pc6.y, pc6.z, pc6.w); *(uint2*)(cd_ + 56 * 136) = pk4(pc7.x, pc7.y, pc7.z, pc7.w); \
    }
#define SWRITEK(BUF) { bf16_t* kd_ = Ks + (BUF) * 64 * 104 + (tid >> 3) * 104 + 64 + (tid & 7) * 4; \
    *(uint2*)(kd_) = pk4(pk0.x, pk0.y, pk0.z, pk0.w); *(uint2*)(kd_ + 32 * 104) = pk4(pk1.x, pk1.y, pk1.z, pk1.w); }
  auto sexpand = [&](int buf) {
    const int a = w & 1, b = w >> 1;
    const bf16_t* cp = Cs + (32 * b + l31) * 136 + hh * 8;
    const bf16_t* wkp = Wl + (32 * a + l31) * 136 + hh * 8;
    const bf16_t* wvp = wkp + 64 * 136;
    f32x16 ka = zero16(), va = zero16();
#pragma unroll
    for (int ks = 0; ks < 8; ++ks) {
      const bf16x8 cf = *(const bf16x8*)(cp + 16 * ks);
      ka = mfma32(*(const bf16x8*)(wkp + 16 * ks), cf, ka);
      va = mfma32(cf, *(const bf16x8*)(wvp + 16 * ks), va);
    }
    bf16_t* kb = Ks + buf * 64 * 104; bf16_t* vb = Vs + buf * 64 * 72;
#pragma unroll
    for (int G = 0; G < 4; ++G) {
      *(uint2*)(kb + (32 * b + l31) * 104 + 32 * a + 8 * G + 4 * hh) = pk4(ka[4 * G], ka[4 * G + 1], ka[4 * G + 2], ka[4 * G + 3]);
      *(uint2*)(vb + (32 * a + l31) * 72 + 32 * b + 8 * G + 4 * hh) = pk4(va[4 * G], va[4 * G + 1], va[4 * G + 2], va[4 * G + 3]);
    }
  };
  const int x7 = (l31 >> 1) & 7, x3 = (l31 >> 2) & 3, xv = (l31 >> 1) & 7;
#define KFRAG(SP, KS, SUB) (SAMPLE ? *(const bf16x8*)((const bf16_t*)(SP) + (l31 + 32 * (SUB)) * 104 + hh * 8 + 16 * (KS)) \
    : ((KS) < 4 ? *(const bf16x8*)((SP) + (l31 + 32 * (SUB)) * 128 + (((2 * (KS) + hh) ^ x7) << 4)) \
                : *(const bf16x8*)((SP) + 8192 + (l31 + 32 * (SUB)) * 64 + (((2 * ((KS) - 4) + hh) ^ x3) << 4))))
#define VHALF(SP, C, SUB) (SAMPLE ? *(const uint2*)((const bf16_t*)(SP) + 64 * 104 + (l31 + 32 * (SUB)) * 72 + 4 * hh + 8 * (C)) \
    : *(const uint2*)((SP) + 12288 + (l31 + 32 * (SUB)) * 128 + 8 * hh + ((((C)) ^ xv) << 4)))
  auto compute_t = [&](auto masked_c, const char* sp) {
    constexpr bool MASKED = decltype(masked_c)::value;
    f32x16 s0 = zero16(), s1 = zero16();
#pragma unroll
    for (int ks = 0; ks < 6; ++ks) {
      const bf16x8 k0 = KFRAG(sp, ks, 0), k1 = KFRAG(sp, ks, 1);
      s0 = mfma32(k0, qf[ks], s0); s1 = mfma32(k1, qf[ks], s1);
    }
    if (!SAMPLE && MASKED) {
#pragma unroll
      for (int r = 8; r < 16; ++r) s0[r] = -1e30f;
#pragma unroll
      for (int r = 0; r < 16; ++r) s1[r] = -1e30f;
    }
    float mx = s0[0];
#pragma unroll
    for (int r = 1; r < 16; ++r) mx = fmaxf(mx, s0[r]);
#pragma unroll
    for (int r = 0; r < 16; ++r) mx = fmaxf(mx, s1[r]);
    mx = fmaxf(mx, __shfl_xor(mx, 32));
    const float mnew = fmaxf(m_run, mx);
    const float alpha = __builtin_amdgcn_exp2f(m_run - mnew);
    m_run = mnew;
    float ps = 0.f;
#pragma unroll
    for (int r = 0; r < 16; ++r) { s0[r] = __builtin_amdgcn_exp2f(s0[r] - mnew); ps += s0[r]; }
#pragma unroll
    for (int r = 0; r < 16; ++r) { s1[r] = __builtin_amdgcn_exp2f(s1[r] - mnew); ps += s1[r]; }
    l_run = l_run * alpha + ps;
#pragma unroll
    for (int r = 0; r < 16; ++r) { o0[r] *= alpha; o1[r] *= alpha; }
    const bf16x8 pf0 = mk8(pk2(s0[0], s0[1]), pk2(s0[2], s0[3]), pk2(s0[4], s0[5]), pk2(s0[6], s0[7]));
    const bf16x8 pf1 = mk8(pk2(s0[8], s0[9]), pk2(s0[10], s0[11]), pk2(s0[12], s0[13]), pk2(s0[14], s0[15]));
    const bf16x8 pf2 = mk8(pk2(s1[0], s1[1]), pk2(s1[2], s1[3]), pk2(s1[4], s1[5]), pk2(s1[6], s1[7]));
    const bf16x8 pf3 = mk8(pk2(s1[8], s1[9]), pk2(s1[10], s1[11]), pk2(s1[12], s1[13]), pk2(s1[14], s1[15]));
#define PV_STEP(S, PF) { bf16x8 v0_, v1_; \
      if (SAMPLE) { const uint2 a0 = VHALF(sp, 2 * S, 0), b0 = VHALF(sp, 2 * S + 1, 0), a1 = VHALF(sp, 2 * S, 1), b1 = VHALF(sp, 2 * S + 1, 1); \
        v0_ = mk8(a0.x, a0.y, b0.x, b0.y); v1_ = mk8(a1.x, a1.y, b1.x, b1.y); } \
      else { v0_ = *(const bf16x8*)(sp + 12288 + l31 * 128 + (((2 * S + hh) ^ xv) << 4)); v1_ = *(const bf16x8*)(sp + 12288 + (l31 + 32) * 128 + (((2 * S + hh) ^ xv) << 4)); } \
      o0 = mfma32(v0_, PF, o0); o1 = mfma32(v1_, PF, o1); }
    PV_STEP(0, pf0) PV_STEP(1, pf1) PV_STEP(2, pf2) PV_STEP(3, pf3)
  };
  bf16x8 qf7 = mk8(0u, 0u, 0u, 0u);
  const bf16x8 kone = mk8(hh == 0 ? 0x3F80u : 0u, 0u, 0u, 0u);
  auto freeze = [&]() {
    const float mf = bflo(pk2(m_run, 0.f));
    const float fac = __builtin_amdgcn_exp2f(m_run - mf);
    l_run *= fac;
#pragma unroll
    for (int r = 0; r < 16; ++r) { o0[r] *= fac; o1[r] *= fac; }
    qf7 = mk8(hh == 0 ? (pk2(-mf, 0.f) & 0xffffu) : 0u, 0u, 0u, 0u);
  };
  auto compute_f = [&](const char* sp) {
    f32x16 s0 = mfma32(kone, qf7, zero16()), s1 = mfma32(kone, qf7, zero16());
#pragma unroll
    for (int ks = 0; ks < 6; ++ks) {
      const bf16x8 k0 = KFRAG(sp, ks, 0), k1 = KFRAG(sp, ks, 1);
      s0 = mfma32(k0, qf[ks], s0); s1 = mfma32(k1, qf[ks], s1);
    }
    float ps = 0.f;
#pragma unroll
    for (int r = 0; r < 16; ++r) { s0[r] = __builtin_amdgcn_exp2f(s0[r]); ps += s0[r]; }
#pragma unroll
    for (int r = 0; r < 16; ++r) { s1[r] = __builtin_amdgcn_exp2f(s1[r]); ps += s1[r]; }
    l_run += ps;
    const bf16x8 pf0 = mk8(pk2(s0[0], s0[1]), pk2(s0[2], s0[3]), pk2(s0[4], s0[5]), pk2(s0[6], s0[7]));
    const bf16x8 pf1 = mk8(pk2(s0[8], s0[9]), pk2(s0[10], s0[11]), pk2(s0[12], s0[13]), pk2(s0[14], s0[15]));
    const bf16x8 pf2 = mk8(pk2(s1[0], s1[1]), pk2(s1[2], s1[3]), pk2(s1[4], s1[5]), pk2(s1[6], s1[7]));
    const bf16x8 pf3 = mk8(pk2(s1[8], s1[9]), pk2(s1[10], s1[11]), pk2(s1[12], s1[13]), pk2(s1[14], s1[15]));
    PV_STEP(0, pf0) PV_STEP(1, pf1) PV_STEP(2, pf2) PV_STEP(3, pf3)
#undef PV_STEP
  };

  if (SAMPLE) {
    SLOAD(0)
    for (int ti = 0; ti < ntiles; ++ti) {
      const int buf = 0;
      SWRITE(buf)
      __syncthreads();
      SWRITEK(buf)
      { const int tn = ti + 1 < ntiles ? ti + 1 : ti; SLOAD(tn) }
      sexpand(buf);
      __syncthreads();
      if (wact) { if (ti == 0) { compute_t(std::false_type{}, (const char*)Ks); freeze(); } else compute_f((const char*)Ks); }
    }
    __syncthreads();
  } else {
    const int l8 = lane >> 3, c8 = lane & 7;
    unsigned kn_o0, kn_o1, kr_o, vt_o0, vt_o1;
    { const int r = 8 * (2 * w) + l8; kn_o0 = (unsigned)((r * 8 + head) * 64 + ((c8 ^ ((r >> 1) & 7)) * 8)); }
    { const int r = 8 * (2 * w + 1) + l8; kn_o1 = (unsigned)((r * 8 + head) * 64 + ((c8 ^ ((r >> 1) & 7)) * 8)); }
    { const int r = 16 * w + (lane >> 2); kr_o = (unsigned)(r * 32 + (((lane & 3) ^ ((r >> 2) & 3)) * 8)); }
    { const int d = 8 * (2 * w) + l8; vt_o0 = (unsigned)((head * 64 + d) * KVR + ((c8 ^ ((d >> 1) & 7)) * 8)); }
    { const int d = 8 * (2 * w + 1) + l8; vt_o1 = (unsigned)((head * 64 + d) * KVR + ((c8 ^ ((d >> 1) & 7)) * 8)); }
#define GLDS16(G, Lp) __builtin_amdgcn_global_load_lds((const unsigned*)(G), (LAS3 unsigned*)(Lp), 16, 0, 0)
#define PDMA(TI, STG) { const int KR0 = sb * PT + ((TI) == 0 ? 0 : 16 + 64 * ((TI) - 1)); char* sb_ = lds + (STG) * 20480 + lane * 16; \
      const bf16_t* kn_ = p.Kn + (size_t)KR0 * 512; const bf16_t* kr_ = p.Kr + (size_t)KR0 * 32; const bf16_t* vt_ = p.Vt + KR0; \
      GLDS16(kn_ + kn_o0, sb_ + (2 * w) * 1024); GLDS16(kn_ + kn_o1, sb_ + (2 * w + 1) * 1024); GLDS16(kr_ + kr_o, sb_ + 8192 + w * 1024); \
      GLDS16(vt_ + vt_o0, sb_ + 12288 + (2 * w) * 1024); GLDS16(vt_ + vt_o1, sb_ + 12288 + (2 * w + 1) * 1024); }
    PDMA(0, 0)
    if (ntiles > 1) PDMA(1, 1)
    int stg = 0, stg2 = 2;
    for (int ti = 0; ti < ntiles; ++ti) {
      if (ti + 1 < ntiles) asm volatile("s_waitcnt vmcnt(5)" ::: "memory"); else asm volatile("s_waitcnt vmcnt(0)" ::: "memory");
      RAW_BARRIER()
      if (ti + 2 < ntiles) PDMA(ti + 2, stg2)
      const char* sp = lds + stg * 20480;
      if (ti == 0) { if (wact) compute_t(std::true_type{}, sp); }
      else if (ti == 1) { compute_t(std::false_type{}, sp); freeze(); }
      else if (ti <= lastvis) compute_f(sp);
      stg = stg == 2 ? 0 : stg + 1; stg2 = stg2 == 2 ? 0 : stg2 + 1;
    }
    __syncthreads();
#undef PDMA
#undef GLDS16
  }
  int tk = 0x7fffffff; if (nctr && tid == 0) tk = (int)atomicAdd(nctr, 1u);
  const float lt = l_run + __shfl_xor(l_run, 32);
  if (rowvalid) {
    const float inv = 1.f / lt;
    const bf16_t* gbp = p.zL + (size_t)myrow * ZL + ZL_GB + 64 * head;
    bf16_t* op = mix + (size_t)myrow * D + 256 + 64 * head;
#pragma unroll
    for (int G = 0; G < 4; ++G) {
      const int d = 8 * G + 4 * hh;
      const uint2 g0 = *(const uint2*)(gbp + d), g1 = *(const uint2*)(gbp + 32 + d);
      *(uint2*)(op + d) = pk4(o0[4 * G] * inv * silu_(bflo(g0.x)), o0[4 * G + 1] * inv * silu_(bfhi(g0.x)), o0[4 * G + 2] * inv * silu_(bflo(g0.y)), o0[4 * G + 3] * inv * silu_(bfhi(g0.y)));
      *(uint2*)(op + 32 + d) = pk4(o1[4 * G] * inv * silu_(bflo(g1.x)), o1[4 * G + 1] * inv * silu_(bfhi(g1.x)), o1[4 * G + 2] * inv * silu_(bflo(g1.y)), o1[4 * G + 3] * inv * silu_(bfhi(g1.y)));
    }
  }
  return tk;
}
DEV void attn_item(const Prm& p, int L, int id, char* lds) {
  if (id < 1024) { const int qt = 31 - (id >> 5), sh = id & 31; attn_body<false>(p, L, sh >> 3, sh & 7, qt, lds); }
  else if (id < 1280) { const int j = id - 1024; attn_body<true>(p, L, j >> 3, j & 7, 0, lds); }
  else { const int j = id - 1280; attn_body<false>(p, L, j >> 3, j & 7, -1, lds); }
}

typedef short v4i16_t __attribute__((ext_vector_type(4)));
DEV uint2 lds_tr16(const char* pl) { const v4i16_t r = __builtin_amdgcn_ds_read_tr16_b64_v4i16((__attribute__((address_space(3))) v4i16_t*)pl); return __builtin_bit_cast(uint2, r); }
DEV void attn_sample(const Prm& p, int L, int b, int hp, char* lds) {
  int tid = threadIdx.x; LAUNDER(tid);
  const int lane = tid & 63, w = __builtin_amdgcn_readfirstlane(tid >> 6), l31 = lane & 31, hh = lane >> 5;
  const int head = 2 * hp + (w >> 1);
  const bf16_t* Qb = (const bf16_t*)p.y_prompt;
  bf16_t* mix = p.zE;
  const int myrow = NPR + 64 * b + 32 * (w & 1) + l31;
  bf16x8 qf[6];
  {
    const bf16_t* qp = Qb + (size_t)myrow * 768 + head * 96 + hh * 8;
#pragma unroll
    for (int ks = 0; ks < 6; ++ks) qf[ks] = *(const bf16x8*)(qp + 16 * ks);
  }
  unsigned kl_o0, kl_o1, kl_o2, kl_o3, kr_o;
  {
    const int l16 = lane >> 4, c16 = lane & 15;
#define KROW(i) (4 * (4 * w + (i)) + l16)
#define KLO(i) ((unsigned)(KROW(i) * 160 + ((c16 ^ (((KROW(i) & 3) << 2) | ((KROW(i) >> 2) & 3))) * 8)))
    kl_o0 = KLO(0); kl_o1 = KLO(1); kl_o2 = KLO(2); kl_o3 = KLO(3);
#undef KLO
#undef KROW
    const int r = 16 * w + (lane >> 2);
    kr_o = (unsigned)(r * 160 + 128 + (((lane & 3) ^ ((r >> 2) & 3)) * 8));
  }
  const bf16_t* klb = p.KL + (size_t)b * SKEYS * 160;
#define GLDS16(G, Lp) __builtin_amdgcn_global_load_lds((const unsigned*)(G), (LAS3 unsigned*)(Lp), 16, 0, 0)
#define SDMA(TI, STG) { char* sb_ = lds + (STG) * 20480 + lane * 16; const bf16_t* kl_ = klb + (size_t)(TI) * 64 * 160; \
    GLDS16(kl_ + kl_o0, sb_ + (4 * w) * 1024); GLDS16(kl_ + kl_o1, sb_ + (4 * w + 1) * 1024); GLDS16(kl_ + kl_o2, sb_ + (4 * w + 2) * 1024); GLDS16(kl_ + kl_o3, sb_ + (4 * w + 3) * 1024); \
    GLDS16(kl_ + kr_o, sb_ + 16384 + w * 1024); }
  SDMA(0, 0)
  SDMA(1, 1)
  bf16x8 qa0, qa1, qa2, qa3, qa4, qa5, qa6, qa7;
  {
    const float* wsrc = p.w_ukv + ((size_t)L * 128 + l31) * 1024 + head * 128 + 8 * hh;
#define QABS(CT, QA, QB) { f32x16 acc = zero16(); \
      _Pragma("unroll") for (int ks = 0; ks < 4; ++ks) { const float* s_ = wsrc + (size_t)(32 * (CT)) * 1024 + 16 * ks; const float4 a_ = *(const float4*)s_, c_ = *(const float4*)(s_ + 4); \
        acc = mfma32(mk8(pk2(a_.x, a_.y), pk2(a_.z, a_.w), pk2(c_.x, c_.y), pk2(c_.z, c_.w)), qf[ks], acc); } \
      QA = mk8(pk2(acc[0], acc[1]), pk2(acc[2], acc[3]), pk2(acc[4], acc[5]), pk2(acc[6], acc[7])); \
      QB = mk8(pk2(acc[8], acc[9]), pk2(acc[10], acc[11]), pk2(acc[12], acc[13]), pk2(acc[14], acc[15])); }
    QABS(0, qa0, qa1) QABS(1, qa2, qa3) QABS(2, qa4, qa5) QABS(3, qa6, qa7)
#undef QABS
  }
  float m_run = -1e30f, l_run = 0.f;
  f32x16 o0 = zero16(), o1 = zero16(), o2 = zero16(), o3 = zero16();
  bf16x8 qf7 = mk8(0u, 0u, 0u, 0u);
  const bf16x8 kone = mk8(hh == 0 ? 0x3F80u : 0u, 0u, 0u, 0u);
  const int xk = ((l31 & 3) << 2) | ((l31 >> 2) & 3), x3 = (l31 >> 2) & 3;
  int va0, va1;
  {
    const int g = l31 >> 4, q = (l31 >> 2) & 3, pp = l31 & 3;
    const int rowb = (4 * hh + q) * 256 + 8 * (pp & 1) + (q << 6);
    va0 = rowb + (((2 * g + (pp >> 1)) ^ hh) << 4);
    va1 = rowb + 2048 + (((2 * g + (pp >> 1)) ^ (hh + 2)) << 4);
  }
  int stg = 0, stg2 = 2;
  for (int ti = 0; ti < 17; ++ti) {
    if (ti + 1 < 17) asm volatile("s_waitcnt vmcnt(5)" ::: "memory"); else asm volatile("s_waitcnt vmcnt(0)" ::: "memory");
    RAW_BARRIER()
    if (ti + 2 < 17) SDMA(ti + 2, stg2)
    const char* sp = lds + stg * 20480;
    f32x16 s0 = mfma32(kone, qf7, zero16()), s1 = s0;
#define QKL(S, QA) { const bf16x8 k0 = *(const bf16x8*)(sp + l31 * 256 + (((2 * (S) + hh) ^ xk) << 4)), k1 = *(const bf16x8*)(sp + (l31 + 32) * 256 + (((2 * (S) + hh) ^ xk) << 4)); \
      s0 = mfma32(k0, QA, s0); s1 = mfma32(k1, QA, s1); }
    QKL(0, qa0) QKL(1, qa1) QKL(2, qa2) QKL(3, qa3) QKL(4, qa4) QKL(5, qa5) QKL(6, qa6) QKL(7, qa7)
#undef QKL
#pragma unroll
    for (int kr = 0; kr < 2; ++kr) {
      const bf16x8 k0 = *(const bf16x8*)(sp + 16384 + l31 * 64 + (((2 * kr + hh) ^ x3) << 4)), k1 = *(const bf16x8*)(sp + 16384 + (l31 + 32) * 64 + (((2 * kr + hh) ^ x3) << 4));
      s0 = mfma32(k0, qf[4 + kr], s0); s1 = mfma32(k1, qf[4 + kr], s1);
    }
    float ps = 0.f;
    if (ti == 0) {
      float mx = s0[0];
#pragma unroll
      for (int r = 1; r < 16; ++r) mx = fmaxf(mx, s0[r]);
#pragma unroll
      for (int r = 0; r < 16; ++r) mx = fmaxf(mx, s1[r]);
      mx = fmaxf(mx, __shfl_xor(mx, 32));
      m_run = bflo(pk2(mx, 0.f));
#pragma unroll
      for (int r = 0; r < 16; ++r) { s0[r] -= m_run; s1[r] -= m_run; }
      qf7 = mk8(hh == 0 ? (pk2(-m_run, 0.f) & 0xffffu) : 0u, 0u, 0u, 0u);
    }
#pragma unroll
    for (int r = 0; r < 16; ++r) { s0[r] = __builtin_amdgcn_exp2f(s0[r]); ps += s0[r]; }
#pragma unroll
    for (int r = 0; r < 16; ++r) { s1[r] = __builtin_amdgcn_exp2f(s1[r]); ps += s1[r]; }
    l_run += ps;
    const bf16x8 pf0 = mk8(pk2(s0[0], s0[1]), pk2(s0[2], s0[3]), pk2(s0[4], s0[5]), pk2(s0[6], s0[7]));
    const bf16x8 pf1 = mk8(pk2(s0[8], s0[9]), pk2(s0[10], s0[11]), pk2(s0[12], s0[13]), pk2(s0[14], s0[15]));
    const bf16x8 pf2 = mk8(pk2(s1[0], s1[1]), pk2(s1[2], s1[3]), pk2(s1[4], s1[5]), pk2(s1[6], s1[7]));
    const bf16x8 pf3 = mk8(pk2(s1[8], s1[9]), pk2(s1[10], s1[11]), pk2(s1[12], s1[13]), pk2(s1[14], s1[15]));
#define PVT(S, CT, PF, OT) { const uint2 a_ = lds_tr16(sp + (va0 ^ ((CT) << 6)) + (S) * 4096), b_ = lds_tr16(sp + (va1 ^ ((CT) << 6)) + (S) * 4096); \
      OT = mfma32(mk8(a_.x, a_.y, b_.x, b_.y), PF, OT); }
#define PVL(S, PF) PVT(S, 0, PF, o0) PVT(S, 1, PF, o1) PVT(S, 2, PF, o2) PVT(S, 3, PF, o3)
    PVL(0, pf0) PVL(1, pf1) PVL(2, pf2) PVL(3, pf3)
#undef PVL
#undef PVT
    stg = stg == 2 ? 0 : stg + 1; stg2 = stg2 == 2 ? 0 : stg2 + 1;
  }
#undef SDMA
#undef GLDS16
  __syncthreads();
  const float lt = l_run + __shfl_xor(l_run, 32);
  const float inv = 1.f / lt;
  f32x16 e0 = zero16(), e1 = zero16();
  const bf16_t* wv = p.Wb_ukv + ((size_t)L * 1024 + head * 128 + 64 + l31) * 128 + 8 * hh;
#define OEXP(S, OT, RB) { const bf16x8 ob = mk8(pk2(OT[RB] * inv, OT[RB + 1] * inv), pk2(OT[RB + 2] * inv, OT[RB + 3] * inv), pk2(OT[RB + 4] * inv, OT[RB + 5] * inv), pk2(OT[RB + 6] * inv, OT[RB + 7] * inv)); \
    e0 = mfma32(*(const bf16x8*)(wv + 16 * (S)), ob, e0); e1 = mfma32(*(const bf16x8*)(wv + 32 * 128 + 16 * (S)), ob, e1); }
  OEXP(0, o0, 0) OEXP(1, o0, 8) OEXP(2, o1, 0) OEXP(3, o1, 8) OEXP(4, o2, 0) OEXP(5, o2, 8) OEXP(6, o3, 0) OEXP(7, o3, 8)
#undef OEXP
  {
    const bf16_t* gbp = p.zL + (size_t)myrow * ZL + ZL_GB + 64 * head;
    bf16_t* op = mix + (size_t)myrow * D + 256 + 64 * head;
#pragma unroll
    for (int G = 0; G < 4; ++G) {
      const int d = 8 * G + 4 * hh;
      const uint2 g0 = *(const uint2*)(gbp + d), g1 = *(const uint2*)(gbp + 32 + d);
      *(uint2*)(op + d) = pk4(e0[4 * G] * silu_(bflo(g0.x)), e0[4 * G + 1] * silu_(bfhi(g0.x)), e0[4 * G + 2] * silu_(bflo(g0.y)), e0[4 * G + 3] * silu_(bfhi(g0.y)));
      *(uint2*)(op + 32 + d) = pk4(e1[4 * G] * silu_(bflo(g1.x)), e1[4 * G + 1] * silu_(bfhi(g1.x)), e1[4 * G + 2] * silu_(bflo(g1.y)), e1[4 * G + 3] * silu_(bfhi(g1.y)));
    }
  }
}

DEV void conv_item(const Prm& p, int L, int item) {
  int tid = threadIdx.x; LAUNDER(tid);
  bf16_t* mix = p.zE;
  const int c0 = (tid & 31) * 8;
  float w0[8], w1[8], w2[8];
#pragma unroll
  for (int e = 0; e < 8; ++e) { w0[e] = p.conv_w[(L * 3 + 0) * 256 + c0 + e]; w1[e] = p.conv_w[(L * 3 + 1) * 256 + c0 + e]; w2[e] = p.conv_w[(L * 3 + 2) * 256 + c0 + e]; }
  for (int it = 0; it < 4; ++it) {
    const int R = item * 32 + it * 8 + (tid >> 5);
    if (R >= NT) continue;
    int q, T; const float* st; float* so;
    if (R < NPR) { const int s = R / PT; q = R - s * PT; T = PT; st = nullptr; so = p.conv_p + ((size_t)L * 4 + s) * 512; }
    else { const int b = (R - NPR) >> 6; q = (R - NPR) & 63; T = 64; st = p.state_conv + ((size_t)L * 32 + b) * 512; so = p.conv_s + ((size_t)L * 32 + b) * 512; }
    float u[3][8];
#pragma unroll
    for (int dlt = 0; dlt < 3; ++dlt) {
      const int t = q - 2 + dlt;
      if (t >= 0) {
        const bf16_t* zr = p.zL + (size_t)(R - 2 + dlt) * ZL;
        const uint4 xi = *(const uint4*)(zr + ZL_XIN + c0), cg = *(const uint4*)(zr + ZL_CG + c0);
        u[dlt][0] = bflo(xi.x) * bflo(cg.x); u[dlt][1] = bfhi(xi.x) * bfhi(cg.x); u[dlt][2] = bflo(xi.y) * bflo(cg.y); u[dlt][3] = bfhi(xi.y) * bfhi(cg.y);
        u[dlt][4] = bflo(xi.z) * bflo(cg.z); u[dlt][5] = bfhi(xi.z) * bfhi(cg.z); u[dlt][6] = bflo(xi.w) * bflo(cg.w); u[dlt][7] = bfhi(xi.w) * bfhi(cg.w);
      } else if (st) {
        const float* sr = st + (t + 2) * 256 + c0;
#pragma unroll
        for (int e = 0; e < 8; ++e) u[dlt][e] = sr[e];
      } else {
#pragma unroll
        for (int e = 0; e < 8; ++e) u[dlt][e] = 0.f;
      }
    }
    const bf16_t* zr = p.zL + (size_t)R * ZL;
    const uint4 bg = *(const uint4*)(zr + ZL_BG + c0), ga = *(const uint4*)(zr + ZL_GA + c0);
    const float bgf[8] = {bflo(bg.x), bfhi(bg.x), bflo(bg.y), bfhi(bg.y), bflo(bg.z), bfhi(bg.z), bflo(bg.w), bfhi(bg.w)};
    const float gaf[8] = {bflo(ga.x), bfhi(ga.x), bflo(ga.y), bfhi(ga.y), bflo(ga.z), bfhi(ga.z), bflo(ga.w), bfhi(ga.w)};
    float y[8];
#pragma unroll
    for (int e = 0; e < 8; ++e) y[e] = bgf[e] * (w0[e] * u[0][e] + w1[e] * u[1][e] + w2[e] * u[2][e]) * silu_(gaf[e]);
    uint4 o; o.x = pk2(y[0], y[1]); o.y = pk2(y[2], y[3]); o.z = pk2(y[4], y[5]); o.w = pk2(y[6], y[7]);
    *(uint4*)(mix + (size_t)R * D + c0) = o;
    if (q >= T - 2) {
      float* d = so + (q - (T - 2)) * 256 + c0;
#pragma unroll
      for (int e = 0; e < 8; ++e) d[e] = u[2][e];
    }
  }
}

DEV int kperm_addr(int m, int kin) {
  const int mt = m >> 4, ml = m & 15, s = kin >> 5, q = (kin >> 4) & 1, g = (kin >> 2) & 3, e = kin & 3;
  return (((mt * 2 + s) * 64 + ml + 16 * g) * 8) + 4 * q + e;
}
DEV int clay_addr(int x, int v) {
  const int xt = x >> 4, g = (x >> 2) & 3, rr = x & 3, vt = v >> 4, l16 = v & 15;
  return ((xt * 4 + vt) * 64 + 16 * g + l16) * 4 + rr;
}
DEV void mm64(const bf16_t* first, const bf16_t* second, int l31, int hh, f32x16 (&acc)[2][2]) {
#pragma unroll
  for (int ks = 0; ks < 4; ++ks) {
    const bf16x8 f0 = *(const bf16x8*)(first + l31 * 72 + ks * 16 + hh * 8), f1 = *(const bf16x8*)(first + (32 + l31) * 72 + ks * 16 + hh * 8);
    const bf16x8 s0 = *(const bf16x8*)(second + l31 * 72 + ks * 16 + hh * 8), s1 = *(const bf16x8*)(second + (32 + l31) * 72 + ks * 16 + hh * 8);
    acc[0][0] = mfma32(f0, s0, acc[0][0]); acc[0][1] = mfma32(f0, s1, acc[0][1]);
    acc[1][0] = mfma32(f1, s0, acc[1][0]); acc[1][1] = mfma32(f1, s1, acc[1][1]);
  }
}
DEV void mm64x32(const bf16_t* first, const bf16_t* second_rows, int l31, int hh, f32x16 (&acc)[2]) {
#pragma unroll
  for (int ks = 0; ks < 4; ++ks) {
    const bf16x8 f0 = *(const bf16x8*)(first + l31 * 72 + ks * 16 + hh * 8), f1 = *(const bf16x8*)(first + (32 + l31) * 72 + ks * 16 + hh * 8);
    const bf16x8 s0 = *(const bf16x8*)(second_rows + l31 * 72 + ks * 16 + hh * 8);
    acc[0] = mfma32(f0, s0, acc[0]); acc[1] = mfma32(f1, s0, acc[1]);
  }
}

DEV void mmq(const bf16_t* first_rows, const bf16_t* second_rows, int l31, int hh, f32x16& acc) {
#pragma unroll
  for (int ks = 0; ks < 4; ++ks) {
    const bf16x8 f0 = *(const bf16x8*)(first_rows + l31 * 72 + ks * 16 + hh * 8);
    const bf16x8 s0 = *(const bf16x8*)(second_rows + l31 * 72 + ks * 16 + hh * 8);
    acc = mfma32(f0, s0, acc);
  }
}
enum { SH_FULL = 0, SH_UP = 1, SH_LO = 2 };
template <int SH> DEV constexpr bool tile_nz(int tx, int ty) { return SH == SH_FULL || (SH == SH_UP ? tx <= ty : tx >= ty); }
struct Acc64 { f32x16 t[2][2]; };
struct Frag64 { bf16x8 f[4][2]; };
template <int SS> DEV bf16x8 pack8(const f32x16& v) {
  return mk8(pk2(v[8 * SS], v[8 * SS + 1]), pk2(v[8 * SS + 2], v[8 * SS + 3]), pk2(v[8 * SS + 4], v[8 * SS + 5]), pk2(v[8 * SS + 6], v[8 * SS + 7]));
}
template <int SH> DEV void to_frag(const Acc64& X, Frag64& F) {
#pragma unroll
  for (int t = 0; t < 2; ++t) {
    if (tile_nz<SH>(0, t)) { F.f[0][t] = pack8<0>(X.t[0][t]); F.f[1][t] = pack8<1>(X.t[0][t]); }
    if (tile_nz<SH>(1, t)) { F.f[2][t] = pack8<0>(X.t[1][t]); F.f[3][t] = pack8<1>(X.t[1][t]); }
  }
}
template <int SH> DEV void zero_acc(Acc64& X) {
#pragma unroll
  for (int a = 0; a < 2; ++a)
#pragma unroll
    for (int b = 0; b < 2; ++b) if (tile_nz<SH>(a, b)) X.t[a][b] = zero16();
}
template <int SHA, int SHB> DEV void prod_ff(const Frag64& A, const Frag64& B, Acc64& D) {
#pragma unroll
  for (int tm = 0; tm < 2; ++tm)
#pragma unroll
    for (int tn = 0; tn < 2; ++tn)
#pragma unroll
      for (int s = 0; s < 4; ++s)
        if (tile_nz<SHA>(s >> 1, tm) && tile_nz<SHB>(s >> 1, tn)) D.t[tm][tn] = mfma32(A.f[s][tm], B.f[s][tn], D.t[tm][tn]);
}
template <int SHA, int SHB, int SHD> DEV void prod_ff_frag(const Frag64& A, const Frag64& B, Frag64& Fo) {
#pragma unroll
  for (int tm = 0; tm < 2; ++tm)
#pragma unroll
    for (int tn = 0; tn < 2; ++tn)
      if (tile_nz<SHD>(tm, tn)) {
        f32x16 acc = zero16();
#pragma unroll
        for (int s = 0; s < 4; ++s)
          if (tile_nz<SHA>(s >> 1, tm) && tile_nz<SHB>(s >> 1, tn)) acc = mfma32(A.f[s][tm], B.f[s][tn], acc);
        Fo.f[2 * tm][tn] = pack8<0>(acc); Fo.f[2 * tm + 1][tn] = pack8<1>(acc);
      }
}
DEV bf16x8 nat_frag(const bf16_t* S, int row, int s, int hh) { return *(const bf16x8*)(S + row * 72 + 16 * s + 8 * hh); }
DEV bf16x8 perm_frag(const bf16_t* S, int row, int s, int hh) {
  const uint2 a = *(const uint2*)(S + row * 72 + 16 * s + 4 * hh), b = *(const uint2*)(S + row * 72 + 16 * s + 8 + 4 * hh);
  return mk8(a.x, a.y, b.x, b.y);
}
template <int SH, int MODE> DEV void gram(const bf16_t* F, const bf16_t* G, int l31, int hh, Acc64& D) {
  zero_acc<SH>(D);
#pragma unroll
  for (int s = 0; s < 4; ++s) {
    bf16x8 ff[2], gg[2];
#pragma unroll
    for (int t = 0; t < 2; ++t) { ff[t] = nat_frag(F, 32 * t + l31, s, hh); gg[t] = nat_frag(G, 32 * t + l31, s, hh); }
#pragma unroll
    for (int tx = 0; tx < 2; ++tx)
#pragma unroll
      for (int ty = 0; ty < 2; ++ty) if (tile_nz<SH>(tx, ty)) D.t[tx][ty] = mfma32(ff[tx], gg[ty], D.t[tx][ty]);
  }
#pragma unroll
  for (int t = 0; t < 2; ++t)
#pragma unroll
    for (int r = 0; r < 16; ++r) {
      const int x = (r & 3) + 8 * (r >> 2) + 4 * hh, y = l31;
      const bool keep = MODE == 0 ? (x < y) : (MODE == 1 ? (y < x) : (x <= y));
      if (!keep) D.t[t][t][r] = 0.f;
    }
}
template <int SHA> DEV void prod_fm_frag(const Frag64& A, const bf16_t* Mem, int l31, int hh, Frag64& Fo) {
#pragma unroll
  for (int tm = 0; tm < 2; ++tm)
#pragma unroll
    for (int tn = 0; tn < 2; ++tn) {
      f32x16 acc = zero16();
#pragma unroll
      for (int s = 0; s < 4; ++s) if (tile_nz<SHA>(s >> 1, tm)) acc = mfma32(A.f[s][tm], perm_frag(Mem, 32 * tn + l31, s, hh), acc);
      Fo.f[2 * tm][tn] = pack8<0>(acc); Fo.f[2 * tm + 1][tn] = pack8<1>(acc);
    }
}
template <int SHA> DEV void prod_fm(const Frag64& A, const bf16_t* Mem, int l31, int hh, Acc64& D) {
#pragma unroll
  for (int s = 0; s < 4; ++s) {
    bf16x8 mm[2];
#pragma unroll
    for (int t = 0; t < 2; ++t) mm[t] = perm_frag(Mem, 32 * t + l31, s, hh);
#pragma unroll
    for (int tm = 0; tm < 2; ++tm)
#pragma unroll
      for (int tn = 0; tn < 2; ++tn) if (tile_nz<SHA>(s >> 1, tm)) D.t[tm][tn] = mfma32(A.f[s][tm], mm[tn], D.t[tm][tn]);
  }
}
DEV void r1_item(const Prm& p, int L, int idx, char* lds) {
  int tid = threadIdx.x; LAUNDER(tid);
  const int w = __builtin_amdgcn_readfirstlane(tid >> 6);
  int lane = tid & 63, l31 = lane & 31, hh = lane >> 5;
  const int cw = w & 1, tw = w >> 1;
  bf16_t* S0 = (bf16_t*)lds;
  bf16_t* S1 = S0 + 4608; bf16_t* S2 = S1 + 4608; bf16_t* S3 = S2 + 4608; bf16_t* S4 = S3 + 4608; bf16_t* S5 = S4 + 4608; bf16_t* S6 = S5 + 4608; bf16_t* S7 = S6 + 4608;
  float* misc = (float*)(S7 + 4608);
  float* Ef = (float*)S4;
  bool prompt; int st, c, hd;
  if (idx < NRW_P) { prompt = true; st = idx / 260; const int rem = idx - st * 260; c = rem >> 2; hd = rem & 3; }
  else { prompt = false; const int j = idx - NRW_P; st = j >> 2; hd = j & 3; c = 0; }
  char* rwp = p.rw + (size_t)idx * RW_BYTES;
  const float* mu = p.shift_mu + L * 896;
  const int i1 = tid >> 2, m0 = (tid & 3) * 16;
  int R1; bool valid1, hasprev1;
  if (prompt) { const int pp = 64 * c - 48 + i1; valid1 = pp >= 0; R1 = st * PT + (valid1 ? pp : 0); hasprev1 = pp >= 1; }
  else { R1 = NPR + 64 * st + i1; valid1 = true; hasprev1 = i1 >= 1; }
  const bf16_t* zr1 = p.zE + (size_t)R1 * ZE + ZE_ZC;
  const int ti0 = 32 * tw + l31;
  int R; bool valid, hasprev;
  if (prompt) { const int pp = 64 * c - 48 + ti0; valid = pp >= 0; R = st * PT + (valid ? pp : 0); hasprev = pp >= 1; }
  else { R = NPR + 64 * st + ti0; valid = true; hasprev = ti0 >= 1; }
  const bf16_t* zr = p.zE + (size_t)R * ZE + ZE_ZC;
  const int chb = 64 * hd + 32 * cw + 4 * hh;
  uint4 la[2][2], lap[2][2]; uint2 lb[3][4], lbp[3][4];
  {
    const bf16_t* sh0 = p.zE + (size_t)(NT + (prompt ? 32 : st)) * ZE + ZE_ZC;
    const bf16_t* zp1 = hasprev1 ? zr1 - ZE : sh0;
    const bf16_t* zp = hasprev ? zr - ZE : sh0;
#pragma unroll
    for (int part = 0; part < 2; ++part)
#pragma unroll
      for (int h8 = 0; h8 < 2; ++h8) { const int col = 768 + 64 * part + m0 + 8 * h8; la[part][h8] = *(const uint4*)(zr1 + col); lap[part][h8] = *(const uint4*)(zp1 + col); }
#pragma unroll
    for (int part = 0; part < 3; ++part)
#pragma unroll
      for (int G = 0; G < 4; ++G) { const int col = 256 * part + chb + 8 * G; lb[part][G] = *(const uint2*)(zr + col); lbp[part][G] = *(const uint2*)(zp + col); }
    const bf16_t* dsrc = p.dw2T + ((size_t)L * 256 + hd * 64 + i1) * 64 + m0;
    const bf16_t* isrc = p.ia2T + ((size_t)L * 256 + hd * 64 + i1) * 64 + m0;
    const uint4 d0 = *(const uint4*)dsrc, d1 = *(const uint4*)(dsrc + 8), e0 = *(const uint4*)isrc, e1 = *(const uint4*)(isrc + 8);
    __builtin_amdgcn_sched_barrier(0);
    *(uint4*)(S2 + i1 * 72 + m0) = d0; *(uint4*)(S2 + i1 * 72 + m0 + 8) = d1;
    *(uint4*)(S3 + i1 * 72 + m0) = e0; *(uint4*)(S3 + i1 * 72 + m0 + 8) = e1;
  }
  {
    float* prm = misc + 384;
#pragma unroll
    for (int q2 = 0; q2 < 2; ++q2) {
      const int ix = tid + 256 * q2, wh = ix >> 6, chp = ix & 63;
      const float* sp = wh == 0 ? p.decay_w0 : wh == 1 ? p.iclr_a0 : wh == 2 ? p.key_kk : wh == 3 ? p.key_ka : wh == 4 ? p.bonus_rk : nullptr;
      prm[ix] = sp ? sp[L * 256 + hd * 64 + chp] : mu[256 * (wh - 5) + 64 * hd + chp];
    }
  }
#pragma unroll
  for (int part = 0; part < 2; ++part) {
#pragma unroll
    for (int h8 = 0; h8 < 2; ++h8) {
      const int col = 768 + 64 * part + m0 + 8 * h8;
      const uint4 u = la[part][h8], v = lap[part][h8];
      const float cur[8] = {bflo(u.x), bfhi(u.x), bflo(u.y), bfhi(u.y), bflo(u.z), bfhi(u.z), bflo(u.w), bfhi(u.w)};
      float prv[8] = {bflo(v.x), bfhi(v.x), bflo(v.y), bfhi(v.y), bflo(v.z), bfhi(v.z), bflo(v.w), bfhi(v.w)};
      float o[8];
#pragma unroll
      for (int e = 0; e < 8; ++e) { float z = cur[e] + (prv[e] - cur[e]) * mu[col + e]; if (!valid1) z = 0.f; o[e] = part == 0 ? (1.f - 2.f / (__expf(2.f * z) + 1.f)) : z; }
      uint4 a; a.x = pk2(o[0], o[1]); a.y = pk2(o[2], o[3]); a.z = pk2(o[4], o[5]); a.w = pk2(o[6], o[7]);
      *(uint4*)((part == 0 ? S0 : S1) + i1 * 72 + m0 + 8 * h8) = a;
    }
  }
  __syncthreads();
  f32x16 accw = zero16(), acca = zero16();
#pragma unroll
  for (int ks = 0; ks < 4; ++ks) {
    const bf16x8 fw = *(const bf16x8*)(S2 + (32 * cw + l31) * 72 + ks * 16 + hh * 8), fa = *(const bf16x8*)(S3 + (32 * cw + l31) * 72 + ks * 16 + hh * 8);
    const bf16x8 sw = *(const bf16x8*)(S0 + (32 * tw + l31) * 72 + ks * 16 + hh * 8), sa = *(const bf16x8*)(S1 + (32 * tw + l31) * 72 + ks * 16 + hh * 8);
    accw = mfma32(fw, sw, accw); acca = mfma32(fa, sa, acca);
  }
  int ti = ti0;
  float e_[16];
  float ssq = 0.f;
#pragma unroll
  for (int G = 0; G < 4; ++G) {
    const int ch = chb + 8 * G, col = 256 + ch;
    const uint2 u = lb[1][G], v = lbp[1][G];
    const float cur[4] = {bflo(u.x), bfhi(u.x), bflo(u.y), bfhi(u.y)};
    float prv[4] = {bflo(v.x), bfhi(v.x), bflo(v.y), bfhi(v.y)};
    const int chq = 32 * cw + 8 * G + 4 * hh;
    const float4 kkw = *(const float4*)(misc + 384 + 128 + chq), w0 = *(const float4*)(misc + 384 + chq), m4 = *(const float4*)(misc + 384 + 384 + chq);
    const float kkv[4] = {kkw.x, kkw.y, kkw.z, kkw.w}, w0v[4] = {w0.x, w0.y, w0.z, w0.w}, muv[4] = {m4.x, m4.y, m4.z, m4.w};
#pragma unroll
    for (int e = 0; e < 4; ++e) {
      float z = cur[e] + (prv[e] - cur[e]) * muv[e];
      if (!valid) z = 0.f;
      const float kkr = z * kkv[e];
      ssq += kkr * kkr;
      e_[4 * G + e] = valid ? 0.6065306597126334f * sigmoid_(w0v[e] + accw[4 * G + e]) : 0.f;
    }
  }
  ssq += __shfl_xor(ssq, 32);
  if (hh == 0) misc[(cw * 64 + ti) * 2] = ssq;
#pragma unroll
  for (int G = 0; G < 4; ++G)
#pragma unroll
    for (int e = 0; e < 4; ++e) Ef[ti * 65 + 32 * cw + 8 * G + 4 * hh + e] = e_[4 * G + e];
  __syncthreads();
  {
    const int ch = tid & 63, seg = tid >> 6;
    float run = 0.f;
#pragma unroll
    for (int t = 0; t < 16; ++t) { run += Ef[(16 * seg + t) * 65 + ch]; Ef[(16 * seg + t) * 65 + ch] = run; }
    __syncthreads();
    float off = 0.f;
    for (int s2 = 0; s2 < seg; ++s2) off += Ef[(16 * s2 + 15) * 65 + ch];
    __syncthreads();
#pragma unroll
    for (int t = 0; t < 16; ++t) Ef[(16 * seg + t) * 65 + ch] += off;
    if (seg == 3) { const float cC = Ef[63 * 65 + ch]; misc[320 + ch] = cC; misc[256 + ch] = __expf(-cC); }
    __syncthreads();
  }
  float cc_[16];
#pragma unroll
  for (int G = 0; G < 4; ++G)
#pragma unroll
    for (int e = 0; e < 4; ++e) cc_[4 * G + e] = Ef[ti * 65 + 32 * cw + 8 * G + 4 * hh + e];
  const float kinv = 1.f / fmaxf(sqrtf(misc[ti * 2] + misc[(64 + ti) * 2]), 1e-12f);
  __syncthreads();
  LAUNDER(ti); LAUNDER(hh);
  uint2 vpk[4];
  float rk = 0.f;
#pragma unroll
  for (int G = 0; G < 4; ++G) {
    const int ch = chb + 8 * G, chl = 32 * cw + 8 * G + 4 * hh;
    float zs[3][4];
#pragma unroll
    for (int part = 0; part < 3; ++part) {
      const int col = 256 * part + ch;
      const uint2 u = lb[part][G], v = lbp[part][G];
      const float cur[4] = {bflo(u.x), bfhi(u.x), bflo(u.y), bfhi(u.y)};
      float prv[4] = {bflo(v.x), bfhi(v.x), bflo(v.y), bfhi(v.y)};
      const float4 m4 = *(const float4*)(misc + 384 + 320 + 64 * part + chl);
      const float muv[4] = {m4.x, m4.y, m4.z, m4.w};
#pragma unroll
      for (int e = 0; e < 4; ++e) { float z = cur[e] + (prv[e] - cur[e]) * muv[e]; zs[part][e] = valid ? z : 0.f; }
    }
    vpk[G] = pk4(zs[2][0], zs[2][1], zs[2][2], zs[2][3]);
    const float4 a04 = *(const float4*)(misc + 384 + 64 + chl), kk4 = *(const float4*)(misc + 384 + 128 + chl), ka4 = *(const float4*)(misc + 384 + 192 + chl), bo4 = *(const float4*)(misc + 384 + 256 + chl);
    const float a0v[4] = {a04.x, a04.y, a04.z, a04.w}, kkv[4] = {kk4.x, kk4.y, kk4.z, kk4.w}, kav[4] = {ka4.x, ka4.y, ka4.z, ka4.w}, bov[4] = {bo4.x, bo4.y, bo4.z, bo4.w};
    float at[4], rt[4], bt[4], kt[4], bh[4], kh[4];
#pragma unroll
    for (int e = 0; e < 4; ++e) {
      const int r = 4 * G + e;
      const float al = sigmoid_(a0v[e] + acca[r]);
      const float kk = zs[1][e] * kkv[e] * kinv;
      const float km = zs[1][e] * (1.f + (al - 1.f) * kav[e]);
      rk += zs[0][e] * km * bov[e];
      const float gC = misc[256 + chl + e];
      const float cprev = cc_[r] - e_[r];
      const float ea = __expf(-cprev), er = __expf(-cc_[r]), ek = __builtin_amdgcn_rcpf(er), eh = ek * gC;
      const float b = kk * al;
      at[e] = -kk * ea; rt[e] = zs[0][e] * er; bt[e] = b * ek; kt[e] = km * ek; bh[e] = b * eh; kh[e] = km * eh;
    }
    *(uint2*)(S0 + ti * 72 + chl) = pk4(at[0], at[1], at[2], at[3]);
    *(uint2*)(S1 + ti * 72 + chl) = pk4(rt[0], rt[1], rt[2], rt[3]);
    *(uint2*)(S2 + ti * 72 + chl) = pk4(bt[0], bt[1], bt[2], bt[3]);
    *(uint2*)(S3 + ti * 72 + chl) = pk4(kt[0], kt[1], kt[2], kt[3]);
#pragma unroll
    for (int e = 0; e < 4; ++e) { S4[(chl + e) * 72 + ti] = f2bf(at[e]); S5[(chl + e) * 72 + ti] = f2bf(bh[e]); S6[(chl + e) * 72 + ti] = f2bf(kh[e]); S7[(chl + e) * 72 + ti] = f2bf(zs[2][e]); }
    *(uint2*)(rwp + 40960 + (ti * 64 + chl) * 2) = vpk[G];
  }
  rk += __shfl_xor(rk, 32);
  if (hh == 0) misc[(cw * 64 + ti) * 2 + 1] = rk;
  __syncthreads();
  if (valid && cw == 0 && hh == 0) p.rkb[(size_t)R * 4 + hd] = misc[ti * 2 + 1] + misc[(64 + ti) * 2 + 1];
  LAUNDER(l31); LAUNDER(hh); LAUNDER(lane);
  {
    Acc64 T;
    {
      Acc64 Mx, MTx;
      gram<SH_UP, 0>(S2, S0, l31, hh, Mx);
      gram<SH_LO, 1>(S0, S2, l31, hh, MTx);
      Frag64 fM, fMT, fT;
      to_frag<SH_UP>(Mx, fM); to_frag<SH_LO>(MTx, fMT);
      __builtin_amdgcn_sched_barrier(0);
      T = Mx;
#pragma unroll
      for (int t = 0; t < 2; ++t)
#pragma unroll
        for (int r = 0; r < 16; ++r) if ((r & 3) + 8 * (r >> 2) + 4 * hh == l31) T.t[t][t][r] += 1.f;
      T.t[1][0] = zero16();
      for (int r = 0; r < 5; ++r) {
        Frag64 fM2, fMT2;
        prod_ff_frag<SH_LO, SH_UP, SH_UP>(fMT, fM, fM2);
        prod_ff_frag<SH_UP, SH_LO, SH_LO>(fM, fMT, fMT2);
#pragma unroll
        for (int s = 0; s < 4; ++s)
#pragma unroll
          for (int t = 0; t < 2; ++t) { if (tile_nz<SH_UP>(s >> 1, t)) fM.f[s][t] = fM2.f[s][t]; if (tile_nz<SH_LO>(s >> 1, t)) fMT.f[s][t] = fMT2.f[s][t]; }
        to_frag<SH_UP>(T, fT);
        prod_ff<SH_LO, SH_UP>(fMT, fT, T);
      }
    }
    Frag64 fT;
    to_frag<SH_UP>(T, fT);
    __builtin_amdgcn_sched_barrier(0);
    if (w < 2) {
      Frag64 fW;
      prod_fm_frag<SH_UP>(fT, S4, l31, hh, fW);
      __builtin_amdgcn_sched_barrier(0);
      Acc64 O; zero_acc<SH_FULL>(O);
      if (w == 0) {
        prod_fm<SH_FULL>(fW, S5, l31, hh, O);
#pragma unroll
        for (int tx = 0; tx < 2; ++tx)
#pragma unroll
          for (int ty = 0; ty < 2; ++ty)
#pragma unroll
            for (int G = 0; G < 4; ++G) {
              const int x0 = 32 * tx + 8 * G + 4 * hh, y = 32 * ty + l31;
              float v[4];
#pragma unroll
              for (int e = 0; e < 4; ++e) { v[e] = O.t[tx][ty][4 * G + e]; if (x0 + e == y) v[e] += misc[256 + y]; }
              *(uint2*)(rwp + 0 + kperm_addr(y, x0) * 2) = pk4(v[0], v[1], v[2], v[3]);
            }
      } else {
        Acc64 Nb; gram<SH_UP, 2>(S2, S1, l31, hh, Nb);
        Frag64 fN; to_frag<SH_UP>(Nb, fN);
        prod_ff<SH_FULL, SH_UP>(fW, fN, O);
#pragma unroll
        for (int tx = 0; tx < 2; ++tx)
#pragma unroll
          for (int ty = 0; ty < 2; ++ty)
#pragma unroll
            for (int G = 0; G < 4; ++G) {
              const int x0 = 32 * tx + 8 * G + 4 * hh, y = 32 * ty + l31;
              const uint2 rr = *(const uint2*)(S1 + y * 72 + x0);
              *(uint2*)(rwp + 8192 + kperm_addr(y, x0) * 2) = pk4(O.t[tx][ty][4 * G] + bflo(rr.x), O.t[tx][ty][4 * G + 1] + bfhi(rr.x), O.t[tx][ty][4 * G + 2] + bflo(rr.y), O.t[tx][ty][4 * G + 3] + bfhi(rr.y));
            }
      }
    } else {
      Frag64 fX;
      {
        Acc64 Nk; gram<SH_LO, 1>(S0, S3, l31, hh, Nk);
        Frag64 fNk; to_frag<SH_LO>(Nk, fNk);
        prod_ff_frag<SH_UP, SH_LO, SH_LO>(fT, fNk, fX);
      }
      __builtin_amdgcn_sched_barrier(0);
      if (w == 2) {
        Acc64 Z; zero_acc<SH_FULL>(Z);
        prod_fm<SH_LO>(fX, S5, l31, hh, Z);
#pragma unroll
        for (int tx = 0; tx < 2; ++tx)
#pragma unroll
          for (int ty = 0; ty < 2; ++ty)
#pragma unroll
            for (int G = 0; G < 4; ++G) {
              const int x0 = 32 * tx + 8 * G + 4 * hh, y = 32 * ty + l31;
              const uint2 kk2 = *(const uint2*)(S6 + y * 72 + x0);
              Z.t[tx][ty][4 * G] += bflo(kk2.x); Z.t[tx][ty][4 * G + 1] += bfhi(kk2.x); Z.t[tx][ty][4 * G + 2] += bflo(kk2.y); Z.t[tx][ty][4 * G + 3] += bfhi(kk2.y);
            }
        Frag64 fZ; to_frag<SH_FULL>(Z, fZ);
        __builtin_amdgcn_sched_barrier(0);
        Acc64 Q; zero_acc<SH_FULL>(Q);
        prod_fm<SH_FULL>(fZ, S7, l31, hh, Q);
#pragma unroll
        for (int tx = 0; tx < 2; ++tx)
#pragma unroll
          for (int ty = 0; ty < 2; ++ty)
#pragma unroll
            for (int G = 0; G < 4; ++G)
              *(uint2*)(rwp + 16384 + clay_addr(32 * tx + 8 * G + 4 * hh, 32 * ty + l31) * 2) = pk4(Q.t[tx][ty][4 * G], Q.t[tx][ty][4 * G + 1], Q.t[tx][ty][4 * G + 2], Q.t[tx][ty][4 * G + 3]);
      } else {
        Acc64 H; gram<SH_UP, 2>(S3, S1, l31, hh, H);
        {
          Acc64 Nb; gram<SH_UP, 2>(S2, S1, l31, hh, Nb);
          Frag64 fN; to_frag<SH_UP>(Nb, fN);
          prod_ff<SH_LO, SH_UP>(fX, fN, H);
        }
        Frag64 fH; to_frag<SH_UP>(H, fH);
        __builtin_amdgcn_sched_barrier(0);
        Acc64 Y; zero_acc<SH_FULL>(Y);
        prod_fm<SH_UP>(fH, S7, l31, hh, Y);
#pragma unroll
        for (int tx = 0; tx < 2; ++tx)
#pragma unroll
          for (int ty = 0; ty < 2; ++ty)
#pragma unroll
            for (int G = 0; G < 4; ++G)
              *(uint2*)(rwp + 24576 + clay_addr(32 * tx + 8 * G + 4 * hh, 32 * ty + l31) * 2) = pk4(Y.t[tx][ty][4 * G], Y.t[tx][ty][4 * G + 1], Y.t[tx][ty][4 * G + 2], Y.t[tx][ty][4 * G + 3]);
      }
    }
  }
  __syncthreads();
}

DEV void r2_wave(const Prm& p, int L, int wi, int lane) {
  bool prompt; int st, hd, vt;
  if (wi < 64) { prompt = true; st = wi >> 4; hd = (wi >> 2) & 3; vt = wi & 3; }
  else { prompt = false; const int j = wi - 64; st = j >> 4; hd = (j >> 2) & 3; vt = j & 3; }
  const int nch = prompt ? 65 : 1;
  const int idx0 = prompt ? st * 260 + hd : NRW_P + st * 4 + hd;
  const int l16 = lane & 15, g = lane >> 4;
  f32x4 acc[4];
  float* outp;
  if (prompt) {
#pragma unroll
    for (int mt = 0; mt < 4; ++mt) acc[mt] = (f32x4){0.f, 0.f, 0.f, 0.f};
    outp = p.wkv_p + ((((size_t)L * 4 + st) * 4 + hd) * 64 + 16 * vt + l16) * 64;
  } else {
    const float* sp = p.state_wkv + ((((size_t)L * 32 + st) * 4 + hd) * 64 + 16 * vt + l16) * 64;
#pragma unroll
    for (int mt = 0; mt < 4; ++mt) acc[mt] = *(const f32x4*)(sp + 16 * mt + 4 * g);
    outp = p.wkv_s + ((((size_t)L * 32 + st) * 4 + hd) * 64 + 16 * vt + l16) * 64;
  }
  const char* rw0 = p.rw + (size_t)idx0 * RW_BYTES;
  uint4 pf[3][8]; uint2 qv[3][4];
#pragma unroll
  for (int k = 0; k < 3; ++k) {
    const int cc = k < nch ? k : nch - 1;
    const char* src = rw0 + (size_t)cc * 4 * RW_BYTES;
#pragma unroll
    for (int i = 0; i < 8; ++i) pf[k][i] = *(const uint4*)(src + (i * 64 + lane) * 16);
#pragma unroll
    for (int mt = 0; mt < 4; ++mt) qv[k][mt] = *(const uint2*)(src + 16384 + ((mt * 4 + vt) * 64 + lane) * 8);
  }
  for (int c0 = 0; c0 < nch; c0 += 3) {
#pragma unroll
    for (int k = 0; k < 3; ++k) {
      const int c = c0 + k;
      if (c < nch) {
        char* cur = (char*)rw0 + (size_t)c * 4 * RW_BYTES;
        uint4 bfr[2];
#pragma unroll
        for (int s = 0; s < 2; ++s) {
          bfr[s].x = pk2(acc[2 * s][0], acc[2 * s][1]); bfr[s].y = pk2(acc[2 * s][2], acc[2 * s][3]);
          bfr[s].z = pk2(acc[2 * s + 1][0], acc[2 * s + 1][1]); bfr[s].w = pk2(acc[2 * s + 1][2], acc[2 * s + 1][3]);
          *(uint4*)(cur + 32768 + ((vt * 2 + s) * 64 + lane) * 16) = bfr[s];
        }
#pragma unroll
        for (int mt = 0; mt < 4; ++mt) {
          f32x4 a = {bflo(qv[k][mt].x), bfhi(qv[k][mt].x), bflo(qv[k][mt].y), bfhi(qv[k][mt].y)};
#pragma unroll
          for (int s = 0; s < 2; ++s) a = mfma16(mk8(pf[k][mt * 2 + s]), mk8(bfr[s]), a);
          acc[mt] = a;
        }
        const int cn = c + 3 < nch ? c + 3 : nch - 1;
        const char* src = rw0 + (size_t)cn * 4 * RW_BYTES;
#pragma unroll
        for (int i = 0; i < 8; ++i) pf[k][i] = *(const uint4*)(src + (i * 64 + lane) * 16);
#pragma unroll
        for (int mt = 0; mt < 4; ++mt) qv[k][mt] = *(const uint2*)(src + 16384 + ((mt * 4 + vt) * 64 + lane) * 8);
      }
    }
  }
#pragma unroll
  for (int mt = 0; mt < 4; ++mt) *(f32x4*)(outp + 16 * mt + 4 * g) = acc[mt];
}

DEV void r3_wave(const Prm& p, int L, int idx, int lane, float* Y  ) {
  LAUNDER(lane);
  bool prompt; int st, c, hd;
  if (idx < NRW_P) { prompt = true; st = idx / 260; const int rem = idx - st * 260; c = rem >> 2; hd = rem & 3; }
  else { prompt = false; const int j = idx - NRW_P; st = j >> 2; hd = j & 3; c = 0; }
  const char* rwp = p.rw + (size_t)idx * RW_BYTES;
  const int l16 = lane & 15, g = lane >> 4;
  bf16_t* mix = p.zE;
  uint4 sf[4][2];
#pragma unroll
  for (int vt = 0; vt < 4; ++vt)
#pragma unroll
    for (int s = 0; s < 2; ++s) sf[vt][s] = *(const uint4*)(rwp + 32768 + ((vt * 2 + s) * 64 + lane) * 16);
  const float lw[4] = {p.lnx_w[L * 256 + hd * 64 + l16], p.lnx_w[L * 256 + hd * 64 + 16 + l16], p.lnx_w[L * 256 + hd * 64 + 32 + l16], p.lnx_w[L * 256 + hd * 64 + 48 + l16]};
  const float lb[4] = {p.lnx_b[L * 256 + hd * 64 + l16], p.lnx_b[L * 256 + hd * 64 + 16 + l16], p.lnx_b[L * 256 + hd * 64 + 32 + l16], p.lnx_b[L * 256 + hd * 64 + 48 + l16]};
#pragma unroll
  for (int it = 0; it < 4; ++it) {
    f32x4 y[4];
    const uint4 gf0 = *(const uint4*)(rwp + 8192 + ((it * 2 + 0) * 64 + lane) * 16), gf1 = *(const uint4*)(rwp + 8192 + ((it * 2 + 1) * 64 + lane) * 16);
#pragma unroll
    for (int vt = 0; vt < 4; ++vt) {
      const uint2 q = *(const uint2*)(rwp + 24576 + ((it * 4 + vt) * 64 + lane) * 8);
      f32x4 a = {bflo(q.x), bfhi(q.x), bflo(q.y), bfhi(q.y)};
      a = mfma16(mk8(gf0), mk8(sf[vt][0]), a);
      a = mfma16(mk8(gf1), mk8(sf[vt][1]), a);
      y[vt] = a;
    }
    __builtin_amdgcn_sched_barrier(0);
#pragma unroll
    for (int rr = 0; rr < 4; ++rr) {
      const int i = 16 * it + 4 * g + rr;
      float s1 = y[0][rr] + y[1][rr] + y[2][rr] + y[3][rr];
      s1 += __shfl_xor(s1, 1); s1 += __shfl_xor(s1, 2); s1 += __shfl_xor(s1, 4); s1 += __shfl_xor(s1, 8);
      const float mean = s1 * (1.f / 64.f);
      const float d0 = y[0][rr] - mean, d1 = y[1][rr] - mean, d2 = y[2][rr] - mean, d3 = y[3][rr] - mean;
      float s2 = d0 * d0 + d1 * d1 + d2 * d2 + d3 * d3;
      s2 += __shfl_xor(s2, 1); s2 += __shfl_xor(s2, 2); s2 += __shfl_xor(s2, 4); s2 += __shfl_xor(s2, 8);
      const float rstd = rsqrtf(s2 * (1.f / 64.f) + GN_EPS);
      Y[i * 68 + l16] = d0 * rstd * lw[0] + lb[0];
      Y[i * 68 + 16 + l16] = d1 * rstd * lw[1] + lb[1];
      Y[i * 68 + 32 + l16] = d2 * rstd * lw[2] + lb[2];
      Y[i * 68 + 48 + l16] = d3 * rstd * lw[3] + lb[3];
    }
  }
  asm volatile("s_waitcnt lgkmcnt(0)" ::: "memory");
  __builtin_amdgcn_wave_barrier();
  const int vc = (lane & 7) * 8;
#pragma unroll
  for (int ps = 0; ps < 8; ++ps) {
    const int i = 8 * ps + (lane >> 3);
    int R; bool valid;
    if (prompt) { const int pp = 64 * c - 48 + i; valid = pp >= 0; R = st * PT + (valid ? pp : 0); }
    else { R = NPR + 64 * st + i; valid = true; }
    if (valid) {
      const float4 y0 = *(const float4*)(Y + i * 68 + vc), y1 = *(const float4*)(Y + i * 68 + vc + 4);
      const float rkbv = p.rkb[(size_t)R * 4 + hd];
      const uint4 vv = *(const uint4*)(rwp + 40960 + (i * 64 + vc) * 2);
      const uint4 gc = *(const uint4*)(p.zL + (size_t)R * ZL + ZL_GC + hd * 64 + vc);
      uint4 o;
      o.x = pk2((y0.x + rkbv * bflo(vv.x)) * silu_(bflo(gc.x)), (y0.y + rkbv * bfhi(vv.x)) * silu_(bfhi(gc.x)));
      o.y = pk2((y0.z + rkbv * bflo(vv.y)) * silu_(bflo(gc.y)), (y0.w + rkbv * bfhi(vv.y)) * silu_(bfhi(gc.y)));
      o.z = pk2((y1.x + rkbv * bflo(vv.z)) * silu_(bflo(gc.z)), (y1.y + rkbv * bfhi(vv.z)) * silu_(bfhi(gc.z)));
      o.w = pk2((y1.z + rkbv * bflo(vv.w)) * silu_(bflo(gc.w)), (y1.w + rkbv * bfhi(vv.w)) * silu_(bfhi(gc.w)));
      *(uint4*)(mix + (size_t)R * D + 768 + hd * 64 + vc) = o;
    }
  }
  asm volatile("s_waitcnt lgkmcnt(0)" ::: "memory");
  __builtin_amdgcn_wave_barrier();
}

DEV void final_norm(const Prm& p) {
  int tid_ = threadIdx.x; LAUNDER(tid_);
  const int lane = tid_ & 63, gw = blockIdx.x * 4 + (tid_ >> 6), NW = gridDim.x * 4;
  for (int R = gw; R < NT; R += NW) {
    if (R < NPR && (R % PT) < 16) continue;
    float* yr = xrow_ptr(p, R);
    const bf16_t* xr = p.xb + (size_t)R * D;
    const float rstd = rsqrtf(p.ssq_x[2 * NTP + R] * (1.f / 1024.f) + RMS_EPS);
#pragma unroll
    for (int j = 0; j < 2; ++j) {
      const uint4 u = ((const uint4*)xr)[lane + 64 * j];
      const float4 g0 = ((const float4*)p.final_g)[2 * (lane + 64 * j)], g1 = ((const float4*)p.final_g)[2 * (lane + 64 * j) + 1];
      float4 o0, o1;
      o0.x = bflo(u.x) * rstd * g0.x; o0.y = bfhi(u.x) * rstd * g0.y; o0.z = bflo(u.y) * rstd * g0.z; o0.w = bfhi(u.y) * rstd * g0.w;
      o1.x = bflo(u.z) * rstd * g1.x; o1.y = bfhi(u.z) * rstd * g1.y; o1.z = bflo(u.w) * rstd * g1.z; o1.w = bfhi(u.w) * rstd * g1.w;
      ((float4*)yr)[2 * (lane + 64 * j)] = o0; ((float4*)yr)[2 * (lane + 64 * j) + 1] = o1;
    }
  }
}

#define XB_TMO      128
#define XB_XCNT(j)  (256  + 64 * (j))
#define XB_XSUB(j)  (1280 + 64 * (j))
#define XB_XGEN(j)  (2304 + 64 * (j))
#define XB_TOP      3328
#define XB_TOPGEN   3392
#define XCD_BAR_WORDS 3456
#define XB_SPIN_CAP (1u << 20)
#define LAS __attribute__((address_space(3)))
DEV unsigned xb_ld(unsigned* p) { return __hip_atomic_load(p, __ATOMIC_RELAXED, __HIP_MEMORY_SCOPE_AGENT); }
DEV unsigned xb_add(unsigned* p, unsigned v) { return __hip_atomic_fetch_add(p, v, __ATOMIC_RELAXED, __HIP_MEMORY_SCOPE_AGENT); }
DEV unsigned xb_xcc_id() { return (unsigned)__builtin_amdgcn_s_getreg((3 << 11) | 20) & 0xFu; }
#define XB_SPIN(cond, bar) do { unsigned _sp = 0; while (cond) { __builtin_amdgcn_s_sleep(1); \
    if ((++_sp & 255u) == 0u) { if (xb_ld(&(bar)[XB_TMO])) break; if (_sp > XB_SPIN_CAP) { atomicAdd(&(bar)[XB_TMO], 1u); break; } } } } while (0)
struct XcdBarrier { unsigned* bar; unsigned x; volatile LAS unsigned* st; };
DEV XcdBarrier xcd_barrier_post(unsigned* bar, volatile LAS unsigned* st) {
  XcdBarrier b; b.bar = bar; b.x = xb_xcc_id(); b.st = st;
  if (threadIdx.x == 0) (void)xb_add(&bar[XB_XCNT(b.x)], 1u);
  return b;
}
DEV void xcd_barrier_complete(unsigned* bar, unsigned x, unsigned& nloc, unsigned& nx) {
  const unsigned G = gridDim.x * gridDim.y * gridDim.z;
  unsigned sum, cnt, mine, sp = 0u;
  for (;;) {
    sum = 0u; cnt = 0u; mine = 0u;
#pragma unroll
    for (unsigned j = 0; j < 16; ++j) { const unsigned c = xb_ld(&bar[XB_XCNT(j)]); sum += c; cnt += (c > 0u) ? 1u : 0u; mine = (j == x) ? c : mine; }
    if (sum == G) break;
    __builtin_amdgcn_s_sleep(1);
    if ((++sp & 255u) == 0u) { if (xb_ld(&bar[XB_TMO])) break; if (sp > XB_SPIN_CAP) { atomicAdd(&bar[XB_TMO], 1u); break; } }
  }
  nloc = mine > 0u ? mine : 1u; nx = cnt > 0u ? cnt : 1u;
}
DEV void xcd_barrier(const XcdBarrier& b) {
  asm volatile("s_waitcnt vmcnt(0)" ::: "memory");
  __syncthreads();
  if (threadIdx.x == 0) {
    unsigned* bar = b.bar;
    __builtin_amdgcn_s_waitcnt(0);
    unsigned nloc = b.st[0], nx = b.st[1];
    if (nloc == 0u) { xcd_barrier_complete(bar, b.x, nloc, nx); b.st[0] = nloc; b.st[1] = nx; }
    const unsigned old = xb_add(&bar[XB_XSUB(b.x)], 1u);
    const unsigned gen = old / nloc;
    if (old + 1u == (gen + 1u) * nloc) {
      __builtin_amdgcn_fence(__ATOMIC_RELEASE, "agent");
      asm volatile("s_waitcnt vmcnt(0)" ::: "memory");
      const unsigned og = xb_add(&bar[XB_TOP], 1u);
      const unsigned tg = og / nx;
      if (og + 1u == (tg + 1u) * nx) xb_add(&bar[XB_TOPGEN], 1u);
      else XB_SPIN(xb_ld(&bar[XB_TOPGEN]) == tg, bar);
      __builtin_amdgcn_fence(__ATOMIC_ACQUIRE, "agent");
      xb_add(&bar[XB_XGEN(b.x)], 1u);
      asm volatile("s_waitcnt vmcnt(0)" ::: "memory");
    } else {
      XB_SPIN(xb_ld(&bar[XB_XGEN(b.x)]) == gen, bar);
      __builtin_amdgcn_fence(__ATOMIC_ACQUIRE, "agent");
      asm volatile("s_waitcnt vmcnt(0)" ::: "memory");
    }
  }
  __syncthreads();
}

#define QCTR(ph, L) (3584 + 64 * (2 * (ph) + (L)))
#define R2DONE(L) (3520 + 16 * (L))
DEV int next_item(unsigned* ctr, char* lds) {
  volatile int* slot = (volatile int*)(lds + LDS_BYTES - 8);
  __syncthreads();
  if (threadIdx.x == 0) *slot = (int)atomicAdd(ctr, 1u);
  __syncthreads();
  return *slot;
}
#define QXC(ph, L, x) (4096 + (((ph) * 2 + (L)) * 8 + (x)) * 16)
DEV int xq_next(unsigned* ctl, int ph, int L, int C, int N, int& k, int home, char* lds) {
  volatile int* slot = (volatile int*)(lds + LDS_BYTES - 8);
  __syncthreads();
  if (threadIdx.x == 0) {
    int res = -1, kk = k;
    while (kk < 8) {
      const int x = (home + kk) & 7, base = x * C;
      int size = N - base; size = size < C ? size : C;
      if (size > 0) { const int idx = (int)atomicAdd(ctl + QXC(ph, L, x), 1u); if (idx < size) { res = base + idx; break; } }
      ++kk;
    }
    slot[0] = res; slot[1] = kk;
  }
  __syncthreads();
  k = slot[1];
  return slot[0];
}
DEV int q_publish(int ticket, char* lds) {
  volatile int* slot = (volatile int*)(lds + LDS_BYTES - 8);
  __syncthreads();
  if (threadIdx.x == 0) *slot = ticket;
  __syncthreads();
  return *slot;
}
DEV int xq_resolve(unsigned* ctl, int ph, int L, int C, int N, int& k, int home, int ticket, char* lds) {
  volatile int* slot = (volatile int*)(lds + LDS_BYTES - 8);
  __syncthreads();
  if (threadIdx.x == 0) {
    int res = -1, kk = k;
    if (kk < 8) {
      const int x = (home + kk) & 7, base = x * C;
      int size = N - base; size = size < C ? size : C;
      if (ticket < size) res = base + ticket;
      else {
        ++kk;
        while (kk < 8) {
          const int x2 = (home + kk) & 7, base2 = x2 * C;
          int size2 = N - base2; size2 = size2 < C ? size2 : C;
          if (size2 > 0) { const int idx = (int)atomicAdd(ctl + QXC(ph, L, x2), 1u); if (idx < size2) { res = base2 + idx; break; } }
          ++kk;
        }
      }
    }
    slot[0] = res; slot[1] = kk;
  }
  __syncthreads();
  k = slot[1];
  return slot[0];
}
DEV unsigned* xq_ctr(unsigned* ctl, int ph, int L, int k, int home) { return k < 8 ? ctl + QXC(ph, L, (home + k) & 7) : nullptr; }
DEV int take_ticket(unsigned* nctr) { int tk = 0x7fffffff; if (nctr && threadIdx.x == 0) tk = (int)atomicAdd(nctr, 1u); return tk; }
struct XQueue {
  unsigned* ctl; int ph, L, C, N, k, home, t;
  DEV void prefetch() { t = take_ticket(xq_ctr(ctl, ph, L, k, home)); }
  DEV int resolve(char* lds) { return xq_resolve(ctl, ph, L, C, N, k, home, t, lds); }
};
template <class Epi, class Map>
DEV void gemm_stream(const bf16_t* __restrict__ A, int lda, const bf16_t* __restrict__ Bt, int ldb, int K, char* lds, const Epi& epi, XQueue& q) {
  int tid = threadIdx.x; LAUNDER(tid);
  const int lane = tid & 63, w = __builtin_amdgcn_readfirstlane(tid >> 6), wr = w >> 1, wc = w & 1;
  const int fr = lane & 15, fq = lane >> 4;
  const int sb = lane * 16, swz = sb ^ (((sb >> 9) & 1) << 5), rl = swz >> 6, cl = (swz & 63) >> 1;
  const int nk = K / 64;
  int offA[2], offB[2];
#pragma unroll
  for (int kh = 0; kh < 2; ++kh) { offA[kh] = lds_byte(wr * 64 + fr, kh * 32 + fq * 8); offB[kh] = lds_byte(wc * 64 + fr, kh * 32 + fq * 8); }
  q.prefetch();
  int item = q.resolve(lds);
  if (item < 0) return;
  int m0, n0; Map::map(item, m0, n0);
  const bf16_t* ga[4]; const bf16_t* gb[4];
#define SETPTR(M0, N0) { _Pragma("unroll") for (int i = 0; i < 4; ++i) { const int st = 4 * w + i, r = (st >> 1) * 16 + rl, c = (st & 1) * 32 + cl; \
      ga[i] = A + (size_t)((M0) + r) * lda + c; gb[i] = Bt + (size_t)((N0) + r) * ldb + c; } }
#define GSTAGE(S, KT) { _Pragma("unroll") for (int i = 0; i < 4; ++i) { \
      __builtin_amdgcn_global_load_lds((const unsigned*)(ga[i] + (KT) * 64), (LAS3 unsigned*)(lds + (S) * 32768 + (4 * w + i) * 1024 + lane * 16), 16, 0, 0); \
      __builtin_amdgcn_global_load_lds((const unsigned*)(gb[i] + (KT) * 64), (LAS3 unsigned*)(lds + (S) * 32768 + 16384 + (4 * w + i) * 1024 + lane * 16), 16, 0, 0); } }
  SETPTR(m0, n0)
  GSTAGE(0, 0)
  GSTAGE(1, 1)
  for (;;) {
    f32x4 acc[4][4];
#pragma unroll
    for (int i = 0; i < 4; ++i)
#pragma unroll
      for (int j = 0; j < 4; ++j) acc[i][j] = (f32x4){0.f, 0.f, 0.f, 0.f};
    for (int kt = 0; kt < nk; ++kt) {
      const int s = kt & 1;
      if (kt + 1 < nk) asm volatile("s_waitcnt vmcnt(8)" ::: "memory"); else asm volatile("s_waitcnt vmcnt(0)" ::: "memory");
      RAW_BARRIER()
      const char* ia = lds + s * 32768;
      const char* ib = ia + 16384;
      bf16x8 af[2][4], bfv[2][4];
#pragma unroll
      for (int kh = 0; kh < 2; ++kh) {
#pragma unroll
        for (int mi = 0; mi < 4; ++mi) af[kh][mi] = *(const bf16x8*)(ia + offA[kh] + mi * 2048);
#pragma unroll
        for (int ni = 0; ni < 4; ++ni) bfv[kh][ni] = *(const bf16x8*)(ib + offB[kh] + ni * 2048);
      }
      asm volatile("s_waitcnt lgkmcnt(0)" ::: "memory");
      RAW_BARRIER()
      if (kt + 2 < nk) GSTAGE(s, kt + 2)
      if (kt == nk - 3) q.prefetch();
      __builtin_amdgcn_sched_barrier(0);
#pragma unroll
      for (int kh = 0; kh < 2; ++kh)
#pragma unroll
        for (int mi = 0; mi < 4; ++mi)
#pragma unroll
          for (int ni = 0; ni < 4; ++ni) acc[mi][ni] = mfma16(bfv[kh][ni], af[kh][mi], acc[mi][ni]);
    }
    const int nxt = q.resolve(lds);
    const typename Epi::Pre pre = epi.preload(m0 + wr * 64, n0 + wc * 64, fr, fq);
    __builtin_amdgcn_sched_barrier(0);
    int m1 = 0, n1 = 0;
    if (nxt >= 0) { Map::map(nxt, m1, n1); SETPTR(m1, n1) GSTAGE(0, 0) GSTAGE(1, 1) }
    __builtin_amdgcn_sched_barrier(0);
    epi.finish(acc, pre, m0 + wr * 64, n0 + wc * 64, fr, fq);
    if (nxt < 0) break;
    m0 = m1; n0 = n1;
  }
#undef GSTAGE
#undef SETPTR
}
struct MapP1 { static DEV void map(int i, int& m0, int& n0) { int mt, nt; if (i < 18 * 192) { const int b = i / 192, r = i - b * 192; nt = r >> 3; mt = 8 * b + (r & 7); } else { nt = i - 18 * 192; mt = 144; } m0 = mt * 128; n0 = nt * 128; } };
struct MapP4 { static DEV void map(int i, int& m0, int& n0) { m0 = (i >> 3) * 128; n0 = (i & 7) * 128; } };
DEV void shift_rows_item(const Prm& p, int L, int b) {
  int tid0 = threadIdx.x; LAUNDER(tid0);
  if (tid0 < 224) {
    float4 v = make_float4(0.f, 0.f, 0.f, 0.f);
    if (b < 32) v = *(const float4*)(p.state_shift + ((size_t)L * 32 + b) * 896 + 4 * tid0);
    *(uint2*)(p.zE + (size_t)(NT + b) * ZE + ZE_ZC + 4 * tid0) = pk4(v.x, v.y, v.z, v.w);
  }
}
constexpr int N_ATT = 1312;
DEV void run_p1(const Prm& p, int L, char* lds) {
  const EpiIn epi{p, L};
  const int home = (int)(xb_xcc_id() & 7u);
  constexpr int N = 145 * 24, C = (N + 7) / 8;
  {
    XQueue q{p.ctl, 0, L, C, N, 0, home, 0};
    gemm_stream<EpiIn, MapP1>(p.xb, D, p.Wb_in + (size_t)L * INP * 1024, 1024, 1024, lds, epi, q);
  }
  unsigned* ctr = p.ctl + QCTR(3, L);
  int t = take_ticket(ctr);
  for (;;) {
    const int mt = q_publish(t, lds);
    if (mt >= 145 + 33) break;
    if (mt >= 145) { t = take_ticket(ctr); shift_rows_item(p, L, mt - 145); continue; }
    t = gemm_tile<EpiIn, 2>(p.xb, D, p.Wb_in + (size_t)L * INP * 1024, 1024, 1024, mt * 128, 24 * 128, lds, epi, ctr);
  }
}
DEV void run_p2(const Prm& p, int L, char* lds) {
  const EpiQ epq{p, L};
  constexpr int N1 = NRW, N2 = N1 + 129, N3 = N2 + 145 * 6, N4 = N3 + 16, N4b = N4 + 512, N5 = N4b + 36;
  const int N6 = L == 0 ? N5 + NWT : N5;
  unsigned* ctr = p.ctl + QCTR(0, L);
  for (;;) {
    const int id = next_item(ctr, lds);
    if (id >= N6) break;
    if (id >= N5) { conv_weights_item(p, 1, id - N5, lds); continue; }
    if (id < N1) r1_item(p, L, id, lds);
    else if (id < N2) kvproj_item(p, L, id - N1, lds);
    else if (id < N3) { const int t = id - N2, mt = t / 6, nt = t - mt * 6; gemm_tile(p.zE + ZE_CQ, ZE, p.Wb_uq + (size_t)L * 768 * 256, 256, 256, mt * 128, nt * 128, lds, epq); }
    else if (id < N4) sample_prep_item(p, L, id - N3);
    else if (id < N4b) lat_item(p, L, id - N4);
    else shift_item(p, L, id - N4b);
  }
}
DEV void run_p3(const Prm& p, int L, char* lds) {
  int tid_ = threadIdx.x; LAUNDER(tid_);
  const int lane = tid_ & 63, w = __builtin_amdgcn_readfirstlane(tid_ >> 6);
  {
    int ndone = 0;
    for (int wi = blockIdx.x * 4 + w; wi < 576; wi += gridDim.x * 4) { r2_wave(p, L, wi, lane); ++ndone; }
    if (blockIdx.x * 4 < 576) {
      asm volatile("s_waitcnt vmcnt(0)" ::: "memory");
      __syncthreads();
      if (threadIdx.x == 0) {
        int tot = 0;
        for (int wi = blockIdx.x * 4; wi < 576; wi += gridDim.x * 4) tot += (576 - wi) < 4 ? (576 - wi) : 4;
        __builtin_amdgcn_fence(__ATOMIC_RELEASE, "agent");
        asm volatile("s_waitcnt vmcnt(0)" ::: "memory");
        __hip_atomic_fetch_add(p.ctl + R2DONE(L), (unsigned)tot, __ATOMIC_RELAXED, __HIP_MEMORY_SCOPE_AGENT);
      }
    }
    (void)ndone;
  }
  unsigned* ctr = p.ctl + QCTR(1, L);
  for (;;) {
    const int q = next_item(ctr, lds);
    if (q >= 128) break;
    attn_sample(p, L, q >> 2, q & 3, lds);
  }
  {
    const int home = (int)(xb_xcc_id() & 7u);
    int k = 0;
    int tx = take_ticket(xq_ctr(p.ctl, 2, L, k, home));
    for (;;) {
      const int i = xq_resolve(p.ctl, 2, L, 128, 1024, k, home, tx, lds);
      if (i < 0) break;
      const int x = i >> 7, j = i & 127, qt = 31 - (j >> 2), pair = 4 * x + (j & 3);
      tx = attn_body<false>(p, L, pair >> 3, pair & 7, qt, lds, xq_ctr(p.ctl, 2, L, k, home));
    }
  }
  unsigned* ctr2 = p.ctl + QCTR(2, L);
  constexpr int NC = (NT + 31) / 32, NQ2 = 32 + NC + NRW / 4;
  bool r2_seen = false;
  for (;;) {
    const int q = next_item(ctr2, lds);
    if (q >= NQ2) break;
    constexpr int NR3 = NRW / 4;
    if (q >= NR3 + 32) conv_item(p, L, q - NR3 - 32);
    else if (q >= NR3) attn_item(p, L, 1280 + q - NR3, lds);
    else {
      if (!r2_seen) {
        if (threadIdx.x == 0) {
          unsigned sp = 0;
          while (__hip_atomic_load(p.ctl + R2DONE(L), __ATOMIC_RELAXED, __HIP_MEMORY_SCOPE_AGENT) < 576u) {
            __builtin_amdgcn_s_sleep(2);
            if (++sp > (1u << 22)) { atomicAdd(&p.ctl[XB_TMO], 1u); break; }
          }
          __builtin_amdgcn_fence(__ATOMIC_ACQUIRE, "agent");
          asm volatile("s_waitcnt vmcnt(0)" ::: "memory");
        }
        __syncthreads();
        r2_seen = true;
      }
      r3_wave(p, L, q * 4 + w, lane, (float*)(lds + w * 17408));
    }
  }
}
DEV void run_p4(const Prm& p, int L, char* lds) {
  const EpiOut epo{p, L};
  const int home = (int)(xb_xcc_id() & 7u);
  {
    XQueue q{p.ctl, 1, L, 128, 1024, 0, home, 0};
    gemm_stream<EpiOut, MapP4>(p.zE  , D, p.Wb_out + (size_t)L * 1024 * 1024, 1024, 1024, lds, epo, q);
  }
  unsigned* ctr = p.ctl + QCTR(3, L) + 16;
  int t = take_ticket(ctr);
  for (;;) {
    const int h = q_publish(t, lds);
    if (h >= 17 * 16) break;
    const int mt = 128 + (h >> 4), r = h & 15;
    t = gemm_tile<EpiOut, 4>(p.zE, D, p.Wb_out + (size_t)L * 1024 * 1024, 1024, 1024, mt * 128, (r >> 1) * 128 + (r & 1) * 64, lds, epo, ctr);
  }
}

__global__ void __launch_bounds__(256, 2) mega(Prm p) {
  extern __shared__ __attribute__((aligned(16))) char lds[];
  volatile LAS unsigned* st = (volatile LAS unsigned*)(lds + LDS_BYTES - 16);
  if (threadIdx.x == 0) { st[0] = 0u; st[1] = 0u; st[2] = 0u; st[3] = 0u; }
  __syncthreads();
  const XcdBarrier xb = xcd_barrier_post(p.ctl, st);
  phase0(p, lds);
  xcd_barrier(xb);
  for (int L = 0; L < 2; ++L) {
    run_p1(p, L, lds); xcd_barrier(xb);
    run_p2(p, L, lds); xcd_barrier(xb);
    run_p3(p, L, lds); xcd_barrier(xb);
    run_p4(p, L, lds); xcd_barrier(xb);
  }
  final_norm(p);
}

static size_t al256(size_t x) { return (x + 255) & ~(size_t)255; }
extern "C" void kernel_launch(void* const* d_in, const int* in_sizes, int n_in, void* d_out, int out_size, void* d_ws, size_t ws_size, hipStream_t stream) {
  Prm p{};
  const float* const* in = (const float* const*)d_in;
  p.x_prompt = in[0]; p.x_sample = in[1]; p.cache_ckv = in[2]; p.cache_krope = in[3]; p.state_conv = in[4]; p.state_shift = in[5]; p.state_wkv = in[6];
  p.meta = in[7]; p.norm_g = in[8]; p.w_in = in[9]; p.conv_w = in[10]; p.q_norm_g = in[11]; p.w_uq = in[12]; p.kv_norm_g = in[13]; p.w_ukv = in[14];
  p.shift_mu = in[15]; p.decay_w0 = in[16]; p.decay_w2 = in[17]; p.iclr_a0 = in[18]; p.iclr_a2 = in[19]; p.key_kk = in[20]; p.key_ka = in[21];
  p.bonus_rk = in[22]; p.lnx_w = in[23]; p.lnx_b = in[24]; p.w_out = in[25]; p.final_g = in[26];
  float* o = (float*)d_out;
  p.y_prompt = o; o += (size_t)4 * 4096 * 1024;
  p.y_sample = o; o += (size_t)32 * 64 * 1024;
  p.ckv_p = o; o += (size_t)2 * 4 * PT * 128;
  p.kr_p = o; o += (size_t)2 * 4 * PT * 32;
  p.conv_p = o; o += 2 * 4 * 2 * 256;
  p.shift_p = o; o += 2 * 4 * 896;
  p.wkv_p = o; o += 2 * 4 * 4 * 64 * 64;
  p.ckv_s = o; o += (size_t)2 * 32 * 64 * 128;
  p.kr_s = o; o += 2 * 32 * 64 * 32;
  p.conv_s = o; o += 2 * 32 * 2 * 256;
  p.shift_s = o; o += 2 * 32 * 896;
  p.wkv_s = o; o += 2 * 32 * 4 * 64 * 64;
  char* w = (char*)d_ws; size_t off = 0;
  auto take = [&](size_t bytes) { char* r = w + off; off = al256(off + bytes); return r; };
  p.ctl = (unsigned*)take(65536);
  p.Wb_in = (bf16_t*)take((size_t)2 * INP * 1024 * 2);
  p.Wb_uq = (bf16_t*)take((size_t)2 * 768 * 256 * 2);
  p.Wb_ukv = (bf16_t*)take((size_t)2 * 1024 * 128 * 2);
  p.Wb_out = (bf16_t*)take((size_t)2 * 1024 * 1024 * 2);
  p.dw2T = (bf16_t*)take((size_t)2 * 256 * 64 * 2);
  p.ia2T = (bf16_t*)take((size_t)2 * 256 * 64 * 2);
  p.ropec = (float*)take((size_t)PT * 16 * 4);
  p.ropes = (float*)take((size_t)PT * 16 * 4);
  p.ssq_x = (float*)take((size_t)7 * NTP * 4);
  p.ssq_q = p.ssq_x + 3 * NTP; p.ssq_kv = p.ssq_x + 5 * NTP;
  p.rkb = (float*)take((size_t)NTP * 4 * 4);
  p.xmeta = (float*)take((size_t)64 * 1024 * 4);
  p.zE = (bf16_t*)take((size_t)NTP * ZE * 2);
  p.zL = (bf16_t*)take((size_t)NTP * ZL * 2);
  p.xb = (bf16_t*)take((size_t)(NTP + 128) * D * 2);
  p.Kn = (bf16_t*)take((size_t)KVR * 512 * 2);
  p.Vt = (bf16_t*)take((size_t)512 * KVR * 2);
  p.Kr = (bf16_t*)take((size_t)KVR * 32 * 2);
  p.rw = take((size_t)NRW * RW_BYTES);
  p.KL = (bf16_t*)((char*)p.y_prompt + ((size_t)32 << 20));
  p.VLT = p.KL + (size_t)32 * SKEYS * 160;
  static int grid = 0;
  if (grid == 0) {
    if (off > ws_size) { fprintf(stderr, "kernel_launch: workspace too small: need %zu have %zu\n", off, ws_size); grid = -1; return; }
    int dev = 0, cus = 0, per_cu = 0;
    (void)hipGetDevice(&dev);
    (void)hipDeviceGetAttribute(&cus, hipDeviceAttributeMultiprocessorCount, dev);
    (void)hipFuncSetAttribute((const void*)mega, hipFuncAttributeMaxDynamicSharedMemorySize, LDS_BYTES);
    (void)hipOccupancyMaxActiveBlocksPerMultiprocessor(&per_cu, (const void*)mega, 256, LDS_BYTES);
    if (per_cu > 2) per_cu = 2;
    if (per_cu < 1) { fprintf(stderr, "kernel_launch: occupancy query returned %d\n", per_cu); per_cu = 1; }
    grid = cus * per_cu;
  }
  if (grid < 0) return;
  (void)hipMemsetAsync(p.ctl, 0, 8192 * 4, stream);
  void* args[] = {&p};
  hipError_t e = hipLaunchCooperativeKernel((const void*)mega, dim3(grid), dim3(256), args, LDS_BYTES, stream);
  if (e != hipSuccess) fprintf(stderr, "cooperative launch failed: %s (grid %d)\n", hipGetErrorString(e), grid);
}
```

```cpp
#include <hip/hip_runtime.h>
#include <cstdio>
#include <cstdint>
#include <type_traits>

typedef unsigned short bf16_t;
typedef short bf16x8 __attribute__((ext_vector_type(8)));
typedef float f32x4 __attribute__((ext_vector_type(4)));
typedef float f32x16 __attribute__((ext_vector_type(16)));
#define DEV __device__ __forceinline__
#define LAUNDER(x) asm volatile("" : "+v"(x))

constexpr int D = 1024;
constexpr int PT = 4112;
constexpr int NPR = 4 * PT;
constexpr int NSM = 32 * 64;
constexpr int NT = NPR + NSM;
constexpr int NTP = 18560;
constexpr int ZL = 1792;
constexpr int ZE = 1312;
constexpr int ZE_CQ = 0, ZE_CKV = 256, ZE_KR = 384, ZE_ZC = 416;
constexpr int ZL_XIN = 0, ZL_BG = 256, ZL_CG = 512, ZL_GA = 768, ZL_GB = 1024, ZL_GC = 1536;
constexpr int INP = 3200;
constexpr int KVR = 16512;
constexpr int NRW_P = 4 * 65 * 4;
constexpr int NRW = NRW_P + 32 * 4;
constexpr int RW_BYTES = 49152;
constexpr float RMS_EPS = 1e-6f;
constexpr float GN_EPS = 64e-5f;
constexpr int LDS_BYTES = 79872;
constexpr int SKEYS = 1088;

struct Prm {
  const float *x_prompt, *x_sample, *cache_ckv, *cache_krope, *state_conv, *state_shift, *state_wkv, *meta, *norm_g, *w_in,
      *conv_w, *q_norm_g, *w_uq, *kv_norm_g, *w_ukv, *shift_mu, *decay_w0, *decay_w2, *iclr_a0, *iclr_a2, *key_kk, *key_ka,
      *bonus_rk, *lnx_w, *lnx_b, *w_out, *final_g;
  float *y_prompt, *y_sample, *ckv_p, *kr_p, *conv_p, *shift_p, *wkv_p, *ckv_s, *kr_s, *conv_s, *shift_s, *wkv_s;
  unsigned* ctl;
  bf16_t *Wb_in, *Wb_uq, *Wb_ukv, *Wb_out, *dw2T, *ia2T;
  float *ropec, *ropes, *ssq_x, *ssq_q, *ssq_kv, *rkb, *xmeta;
  bf16_t *KL, *VLT;
  bf16_t *zE, *zL, *xb, *Kn, *Vt, *Kr;
  char* rw;
};

DEV float bf2f(bf16_t b) { return __uint_as_float((unsigned)b << 16); }
DEV float bflo(unsigned u) { return __uint_as_float(u << 16); }
DEV float bfhi(unsigned u) { return __uint_as_float(u & 0xffff0000u); }
typedef __bf16 hbf16x2_t __attribute__((ext_vector_type(2)));
typedef float hf32x2_t __attribute__((ext_vector_type(2)));
DEV unsigned pk2(float a, float b) { hf32x2_t f = {a, b}; hbf16x2_t r = __builtin_convertvector(f, hbf16x2_t); return __builtin_bit_cast(unsigned, r); }
DEV bf16_t f2bf(float f) { return (bf16_t)(pk2(f, 0.f) & 0xffffu); }
DEV uint2 pk4(float a, float b, float c, float d) { uint2 r; r.x = pk2(a, b); r.y = pk2(c, d); return r; }
DEV float sigmoid_(float x) { return 1.f / (1.f + __expf(-x)); }
DEV float silu_(float x) { return x / (1.f + __expf(-x)); }
DEV float wave_sum(float v) {
#pragma unroll
  for (int o = 1; o < 64; o <<= 1) v += __shfl_xor(v, o);
  return v;
}
DEV f32x16 mfma32(bf16x8 a, bf16x8 b, f32x16 c) { return __builtin_amdgcn_mfma_f32_32x32x16_bf16(a, b, c, 0, 0, 0); }
DEV f32x4 mfma16(bf16x8 a, bf16x8 b, f32x4 c) { return __builtin_amdgcn_mfma_f32_16x16x32_bf16(a, b, c, 0, 0, 0); }
DEV bf16x8 mk8(unsigned a, unsigned b, unsigned c, unsigned d) { uint4 u; u.x = a; u.y = b; u.z = c; u.w = d; return __builtin_bit_cast(bf16x8, u); }
DEV bf16x8 mk8(uint4 u) { return __builtin_bit_cast(bf16x8, u); }
DEV f32x16 zero16() { f32x16 z; for (int i = 0; i < 16; ++i) z[i] = 0.f; return z; }

DEV float* xrow_ptr(const Prm& p, int R) {
  if (R < NPR) { int s = R / PT, q = R - s * PT; return q < 16 ? p.xmeta + (size_t)(s * 16 + q) * D : p.y_prompt + ((size_t)s * 4096 + (q - 16)) * D; }
  return p.y_sample + (size_t)(R - NPR) * D;
}
DEV const float* xin_ptr(const Prm& p, int R) {
  if (R < NPR) { int s = R / PT, q = R - s * PT; return q < 16 ? p.meta + (size_t)q * D : p.x_prompt + ((size_t)s * 4096 + (q - 16)) * D; }
  return p.x_sample + (size_t)(R - NPR) * D;
}
DEV int pos_of(int R) { return R < NPR ? R % PT : 1024 + ((R - NPR) & 63); }

DEV int win_src_col(int n) {
  if (n < 1024) return n;
  if (n < 1536) return 1440 + (n - 1024);
  if (n < 1792) return 2848 + (n - 1536);
  if (n < 2208) return 1024 + (n - 1792);
  if (n < 3104) return 1952 + (n - 2208);
  return -1;
}
DEV int perm32(int rho) { const int n = rho >> 4, i = rho & 15; return 8 * (i >> 2) + 4 * n + (i & 3); }
template <bool PERM, bool P32>
DEV void conv_weight_tile(const float* __restrict__ src, int K, int N, int Npad, bf16_t* __restrict__ dst, const float* __restrict__ sk, float cst, int l, int item, float* T  , int tid) {
  const int ntn = Npad / 64, ntk = K / 64;
  const int r = item, kt = r / ntn, nt = r - kt * ntn;
  const int k0 = kt * 64, n0 = nt * 64;
  {
    const int nslot = n0 + (tid & 15) * 4;
    const int nn = P32 ? (nslot & ~31) + perm32(nslot & 31) : nslot;
    const int sn = PERM ? win_src_col(nn) : (nn < N ? nn : -1);
#pragma unroll
    for (int i = 0; i < 4; ++i) {
      const int k = (tid >> 4) + 16 * i;
      float4 v = make_float4(0.f, 0.f, 0.f, 0.f);
      if (sn >= 0) {
        v = *(const float4*)(src + ((size_t)l * K + k0 + k) * N + sn);
        const float s = (sk ? sk[l * K + k0 + k] : 1.f) * cst;
        v.x *= s; v.y *= s; v.z *= s; v.w *= s;
      }
      float* t = T + k * 65 + (tid & 15) * 4;
      t[0] = v.x; t[1] = v.y; t[2] = v.z; t[3] = v.w;
    }
  }
  __syncthreads();
  {
    const int n = tid >> 2, kc = tid & 3;
    float v[16];
#pragma unroll
    for (int j = 0; j < 16; ++j) v[j] = T[(16 * kc + j) * 65 + n];
    uint4 o0, o1;
    o0.x = pk2(v[0], v[1]); o0.y = pk2(v[2], v[3]); o0.z = pk2(v[4], v[5]); o0.w = pk2(v[6], v[7]);
    o1.x = pk2(v[8], v[9]); o1.y = pk2(v[10], v[11]); o1.z = pk2(v[12], v[13]); o1.w = pk2(v[14], v[15]);
    bf16_t* d = dst + ((size_t)l * Npad + n0 + n) * K + k0 + 16 * kc;
    *(uint4*)d = o0; *(uint4*)(d + 8) = o1;
  }
  __syncthreads();
}
constexpr int WT0 = 16 * 50, WT1 = WT0 + 16 * 16, WT2 = WT1 + 4 * 12, WT3 = WT2 + 2 * 16, WT4 = WT3 + 4, NWT = WT4 + 4;
DEV void conv_weights_item(const Prm& p, int l, int it, char* lds) {
  float* T = (float*)lds;
  int tid = threadIdx.x; LAUNDER(tid);
  if (it < WT0) conv_weight_tile<true, true>(p.w_in, 1024, 3104, INP, p.Wb_in, p.norm_g, 1.f, l, it, T, tid);
  else if (it < WT1) conv_weight_tile<false, true>(p.w_out, 1024, 1024, 1024, p.Wb_out, nullptr, 1.f, l, it - WT0, T, tid);
  else if (it < WT2) conv_weight_tile<false, false>(p.w_uq, 256, 768, 768, p.Wb_uq, p.q_norm_g, 0.10206207261596575f * 1.4426950408889634f, l, it - WT1, T, tid);
  else if (it < WT3) conv_weight_tile<false, false>(p.w_ukv, 128, 1024, 1024, p.Wb_ukv, nullptr, 1.f, l, it - WT2, T, tid);
  else if (it < WT4) conv_weight_tile<false, false>(p.decay_w2, 64, 256, 256, p.dw2T, nullptr, 1.f, l, it - WT3, T, tid);
  else conv_weight_tile<false, false>(p.iclr_a2, 64, 256, 256, p.ia2T, nullptr, 1.f, l, it - WT4, T, tid);
}
DEV void phase0(const Prm& p, char* lds) {
  int tid = threadIdx.x; LAUNDER(tid);
  const int lane = tid & 63, wv = tid >> 6;
  const int gw = blockIdx.x * 4 + wv, NW = gridDim.x * 4;
  const int gt = blockIdx.x * 256 + tid, NTH = gridDim.x * 256;
  for (int R = gw; R < NT; R += NW) {
    const float* src = xin_ptr(p, R);
    float ss = 0.f;
#pragma unroll
    for (int j = 0; j < 4; ++j) {
      const float4 v = ((const float4*)src)[lane + 64 * j];
      ss += v.x * v.x + v.y * v.y + v.z * v.z + v.w * v.w;
      ((uint2*)(p.xb + (size_t)R * D))[lane + 64 * j] = pk4(v.x, v.y, v.z, v.w);
    }
    ss = wave_sum(ss);
    if (lane == 0) p.ssq_x[R] = ss;
  }
  for (int i = gt; i < 6 * NTP; i += NTH) p.ssq_x[NTP + i] = 0.f;
  for (int it = blockIdx.x; it < NWT; it += gridDim.x) conv_weights_item(p, 0, it, lds);
  for (int i = gt; i < PT * 16; i += NTH) {
    const int pos = i >> 4, j = i & 15;
    const float inv = powf(10000.f, -(float)j * 2.0f / 32.f);
    const float ang = (float)pos * inv;
    double a = (double)ang;
    a -= 6.283185307179586476925 * rint(a * 0.15915494309189533577);
    p.ropec[i] = (float)cos(a);
    p.ropes[i] = (float)sin(a);
  }
}

#define LAS3 __attribute__((address_space(3)))
#define RAW_BARRIER() { asm volatile("" ::: "memory"); __builtin_amdgcn_s_barrier(); asm volatile("" ::: "memory"); }
DEV int lds_byte(int r, int c) { const int st = (r >> 4) * 2 + (c >> 5), rr = r & 15, cc = c & 31, ob = rr * 64 + cc * 2; return st * 1024 + (ob ^ (((ob >> 9) & 1) << 5)); }
template <class Epi, int NB = 8>
DEV int gemm_tile(const bf16_t* __restrict__ A, int lda, const bf16_t* __restrict__ Bt, int ldb, int K, int m0, int n0, char* lds, const Epi& epi, unsigned* nctr = nullptr) {
  int tid = threadIdx.x; LAUNDER(tid);
  const int lane = tid & 63, w = __builtin_amdgcn_readfirstlane(tid >> 6), wr = w >> 1, wc = w & 1;
  const int fr = lane & 15, fq = lane >> 4;
  const int sb = lane * 16, swz = sb ^ (((sb >> 9) & 1) << 5), rl = swz >> 6, cl = (swz & 63) >> 1;
  const bf16_t* ga[4]; const bf16_t* gb[4];
#pragma unroll
  for (int i = 0; i < 4; ++i) {
    const int st = 4 * w + i, r = (st >> 1) * 16 + rl, c = (st & 1) * 32 + cl;
    ga[i] = A + (size_t)(m0 + r) * lda + c;
    gb[i] = Bt + (size_t)(n0 + r) * ldb + c;
  }
  const int nk = K / 64;
#define GSTAGE(S, KT) { _Pragma("unroll") for (int i = 0; i < 4; ++i) { \
      __builtin_amdgcn_global_load_lds((const unsigned*)(ga[i] + (KT) * 64), (LAS3 unsigned*)(lds + (S) * 32768 + (4 * w + i) * 1024 + lane * 16), 16, 0, 0); \
      if (2 * w + (i >> 1) < NB) __builtin_amdgcn_global_load_lds((const unsigned*)(gb[i] + (KT) * 64), (LAS3 unsigned*)(lds + (S) * 32768 + 16384 + (4 * w + i) * 1024 + lane * 16), 16, 0, 0); } }
  f32x4 acc[4][4];
#pragma unroll
  for (int i = 0; i < 4; ++i)
#pragma unroll
    for (int j = 0; j < 4; ++j) acc[i][j] = (f32x4){0.f, 0.f, 0.f, 0.f};
  int offA[2], offB[2];
#pragma unroll
  for (int kh = 0; kh < 2; ++kh) { offA[kh] = lds_byte(wr * 64 + fr, kh * 32 + fq * 8); offB[kh] = lds_byte(wc * 64 + fr, kh * 32 + fq * 8); }
  GSTAGE(0, 0)
  if (nk > 1) GSTAGE(1, 1)
  for (int kt = 0; kt < nk; ++kt) {
    const int s = kt & 1;
    if (kt + 1 < nk) { if (2 * w < NB) asm volatile("s_waitcnt vmcnt(8)" ::: "memory"); else asm volatile("s_waitcnt vmcnt(4)" ::: "memory"); }
    else asm volatile("s_waitcnt vmcnt(0)" ::: "memory");
    RAW_BARRIER()
    const char* ia = lds + s * 32768;
    const char* ib = ia + 16384;
    bf16x8 af[2][4], bfv[2][4];
#pragma unroll
    for (int kh = 0; kh < 2; ++kh) {
#pragma unroll
      for (int mi = 0; mi < 4; ++mi) af[kh][mi] = *(const bf16x8*)(ia + offA[kh] + mi * 2048);
#pragma unroll
      for (int ni = 0; ni < (NB < 4 ? NB : 4); ++ni) bfv[kh][ni] = *(const bf16x8*)(ib + offB[kh] + ni * 2048);
    }
    asm volatile("s_waitcnt lgkmcnt(0)" ::: "memory");
    RAW_BARRIER()
    if (kt + 2 < nk) GSTAGE(s, kt + 2)
    __builtin_amdgcn_sched_barrier(0);
    if (NB == 8 || wc == 0) {
#pragma unroll
      for (int kh = 0; kh < 2; ++kh)
#pragma unroll
        for (int mi = 0; mi < 4; ++mi)
#pragma unroll
          for (int ni = 0; ni < (NB < 4 ? NB : 4); ++ni) acc[mi][ni] = mfma16(bfv[kh][ni], af[kh][mi], acc[mi][ni]);
    }
  }
  __syncthreads();
#undef GSTAGE
  int tk = 0x7fffffff; if (nctr && tid == 0) tk = (int)atomicAdd(nctr, 1u);
  if (NB == 8 || wc == 0) epi(acc, m0 + wr * 64, n0 + wc * 64, fr, fq);
  return tk;
}

DEV int lds_byte32(int r, int c) { const int rr = r & 15, ob = rr * 64 + c * 2; return (r >> 4) * 1024 + (ob ^ (((ob >> 9) & 1) << 5)); }
template <class Epi>
DEV void gemm_tile_big(const bf16_t* __restrict__ A, int lda, const bf16_t* __restrict__ Bt, int ldb, int K, int m0, int n0, char* lds, const Epi& epi) {
  int tid = threadIdx.x; LAUNDER(tid);
  const int lane = tid & 63, w = __builtin_amdgcn_readfirstlane(tid >> 6), wr = w >> 1, wc = w & 1;
  const int fr = lane & 15, fq = lane >> 4;
  const int sb = lane * 16, swz = sb ^ (((sb >> 9) & 1) << 5), rl = swz >> 6, cl = (swz & 63) >> 1;
  const bf16_t* ga[4]; const bf16_t* gb[2];
#pragma unroll
  for (int i = 0; i < 4; ++i) ga[i] = A + (size_t)(m0 + (4 * w + i) * 16 + rl) * lda + cl;
#pragma unroll
  for (int i = 0; i < 2; ++i) gb[i] = Bt + (size_t)(n0 + (2 * w + i) * 16 + rl) * ldb + cl;
  const int nk = K / 32;
#define GSTAGE3(S, KT) { _Pragma("unroll") for (int i = 0; i < 4; ++i) \
      __builtin_amdgcn_global_load_lds((const unsigned*)(ga[i] + (KT) * 32), (LAS3 unsigned*)(lds + (S) * 24576 + (4 * w + i) * 1024 + lane * 16), 16, 0, 0); \
    _Pragma("unroll") for (int i = 0; i < 2; ++i) \
      __builtin_amdgcn_global_load_lds((const unsigned*)(gb[i] + (KT) * 32), (LAS3 unsigned*)(lds + (S) * 24576 + 16384 + (2 * w + i) * 1024 + lane * 16), 16, 0, 0); }
  f32x4 acc[8][4];
#pragma unroll
  for (int i = 0; i < 8; ++i)
#pragma unroll
    for (int j = 0; j < 4; ++j) acc[i][j] = (f32x4){0.f, 0.f, 0.f, 0.f};
  const int offA = lds_byte32(wr * 128 + fr, fq * 8), offB = 16384 + lds_byte32(wc * 64 + fr, fq * 8);
  GSTAGE3(0, 0)
  if (nk > 1) GSTAGE3(1, 1)
  int s = 0;
  for (int kt = 0; kt < nk; ++kt) {
    if (kt + 1 < nk) asm volatile("s_waitcnt vmcnt(6)" ::: "memory"); else asm volatile("s_waitcnt vmcnt(0)" ::: "memory");
    RAW_BARRIER()
    if (kt + 2 < nk) { const int s2 = s + 2 >= 3 ? s - 1 : s + 2; GSTAGE3(s2, kt + 2) }
    const char* im = lds + s * 24576;
    bf16x8 af[8], bfv[4];
#pragma unroll
    for (int ni = 0; ni < 4; ++ni) bfv[ni] = *(const bf16x8*)(im + offB + ni * 1024);
#pragma unroll
    for (int mi = 0; mi < 8; ++mi) af[mi] = *(const bf16x8*)(im + offA + mi * 1024);
#pragma unroll
    for (int mi = 0; mi < 8; ++mi)
#pragma unroll
      for (int ni = 0; ni < 4; ++ni) acc[mi][ni] = mfma16(bfv[ni], af[mi], acc[mi][ni]);
    s = s + 1 >= 3 ? 0 : s + 1;
  }
  __syncthreads();
#undef GSTAGE3
  epi(acc, m0 + wr * 128, n0 + wc * 64, fr, fq);
}

struct EpiIn {
  const Prm& p; int L;
  struct Pre { float s[4]; };
  DEV Pre preload(int mb, int nb, int fr, int fq) const {
    Pre r;
#pragma unroll
    for (int mi = 0; mi < 4; ++mi) r.s[mi] = p.ssq_x[L * NTP + mb + 16 * mi + fr];
    return r;
  }
  DEV void operator()(f32x4 (&acc)[4][4], int mb, int nb, int fr, int fq) const { finish(acc, preload(mb, nb, fr, fq), mb, nb, fr, fq); }
  DEV void finish(f32x4 (&acc)[4][4], const Pre& pre, int mb, int nb, int fr, int fq) const {
#pragma unroll
    for (int mi = 0; mi < 4; ++mi) {
      const int m = mb + 16 * mi + fr;
      const bool ok = m < NT;
      const float rstd = rsqrtf(pre.s[mi] * (1.f / 1024.f) + RMS_EPS);
      float sq = 0.f;
#pragma unroll
      for (int g = 0; g < 2; ++g) {
        const int n0 = nb + 32 * g;
        if (n0 >= 3104) continue;
        bf16_t* dst = n0 < ZL ? p.zL + (size_t)m * ZL + n0 : p.zE + (size_t)m * ZE + (n0 - ZL);
        float v[8];
#pragma unroll
        for (int j = 0; j < 4; ++j) { v[j] = acc[mi][2 * g][j] * rstd; v[4 + j] = acc[mi][2 * g + 1][j] * rstd; }
#pragma unroll
        for (int j = 0; j < 8; ++j) sq += v[j] * v[j];
        if (ok) { uint4 o; o.x = pk2(v[0], v[1]); o.y = pk2(v[2], v[3]); o.z = pk2(v[4], v[5]); o.w = pk2(v[6], v[7]); *(uint4*)(dst + 8 * fq) = o; }
      }
      if (nb >= ZL && nb < ZL + 384) {
        sq += __shfl_xor(sq, 16); sq += __shfl_xor(sq, 32);
        if (fq == 0 && ok) atomicAdd((nb < ZL + 256 ? p.ssq_q : p.ssq_kv) + L * NTP + m, sq);
      }
    }
  }
};
struct EpiQ {
  const Prm& p; int L;
  DEV void operator()(f32x4 (&acc)[4][4], int mb, int nb, int fr, int fq) const {
    bf16_t* Qb = (bf16_t*)p.y_prompt;
#pragma unroll
    for (int mi = 0; mi < 4; ++mi) {
      const int m = mb + 16 * mi + fr;
      const bool ok = m < NT;
      const float rstd = rsqrtf(p.ssq_q[L * NTP + m] * (1.f / 256.f) + RMS_EPS);
      const int pos = pos_of(ok ? m : 0);
#pragma unroll
      for (int np = 0; np < 2; ++np) {
        const int n0 = nb + 32 * np;
        float v[2][4];
#pragma unroll
        for (int h2 = 0; h2 < 2; ++h2)
#pragma unroll
          for (int j = 0; j < 4; ++j) v[h2][j] = acc[mi][2 * np + h2][j] * rstd;
        if (((n0 >> 5) % 3) == 2) {
#pragma unroll
          for (int j = 0; j < 4; ++j) {
            const int c = 4 * fq + j;
            const float cs = p.ropec[pos * 16 + c], sn = p.ropes[pos * 16 + c];
            const float x1 = v[0][j], x2 = v[1][j];
            v[0][j] = x1 * cs - x2 * sn; v[1][j] = x1 * sn + x2 * cs;
          }
        }
        if (ok) {
          *(uint2*)(Qb + (size_t)m * 768 + n0 + 4 * fq) = pk4(v[0][0], v[0][1], v[0][2], v[0][3]);
          *(uint2*)(Qb + (size_t)m * 768 + n0 + 16 + 4 * fq) = pk4(v[1][0], v[1][1], v[1][2], v[1][3]);
        }
      }
    }
  }
};
struct EpiOut {
  const Prm& p; int L;
  struct Pre { uint4 x[4][2]; };
  DEV Pre preload(int mb, int nb, int fr, int fq) const {
    Pre r;
#pragma unroll
    for (int mi = 0; mi < 4; ++mi) {
      const int m = mb + 16 * mi + fr;
      const bf16_t* xr = p.xb + (size_t)(m < NT ? m : 0) * D;
#pragma unroll
      for (int g = 0; g < 2; ++g) r.x[mi][g] = *(const uint4*)(xr + nb + 32 * g + 8 * fq);
    }
    return r;
  }
  DEV void operator()(f32x4 (&acc)[4][4], int mb, int nb, int fr, int fq) const { finish(acc, preload(mb, nb, fr, fq), mb, nb, fr, fq); }
  DEV void finish(f32x4 (&acc)[4][4], const Pre& pre, int mb, int nb, int fr, int fq) const {
#pragma unroll
    for (int mi = 0; mi < 4; ++mi) {
      const int m = mb + 16 * mi + fr;
      const bool ok = m < NT;
      bf16_t* xr = p.xb + (size_t)(ok ? m : 0) * D;
      float ss = 0.f;
#pragma unroll
      for (int g = 0; g < 2; ++g) {
        const int col = nb + 32 * g + 8 * fq;
        const uint4 xi = pre.x[mi][g];
        float v[8] = {bflo(xi.x), bfhi(xi.x), bflo(xi.y), bfhi(xi.y), bflo(xi.z), bfhi(xi.z), bflo(xi.w), bfhi(xi.w)};
#pragma unroll
        for (int j = 0; j < 4; ++j) { v[j] += acc[mi][2 * g][j]; v[4 + j] += acc[mi][2 * g + 1][j]; }
#pragma unroll
        for (int j = 0; j < 8; ++j) ss += v[j] * v[j];
        if (ok) { uint4 o; o.x = pk2(v[0], v[1]); o.y = pk2(v[2], v[3]); o.z = pk2(v[4], v[5]); o.w = pk2(v[6], v[7]); *(uint4*)(xr + col) = o; }
      }
      ss += __shfl_xor(ss, 16); ss += __shfl_xor(ss, 32);
      if (fq == 0 && ok) atomicAdd(p.ssq_x + (L + 1) * NTP + m, ss);
    }
  }
};

DEV void kv_prep_row(const Prm& p, int L, int R, int half, bool valid, bf16_t* At_row  ) {
  const int Rl = valid ? R : 0;
  const bf16_t* zr = p.zE + (size_t)Rl * ZE;
  const float rstd = rsqrtf(p.ssq_kv[L * NTP + Rl] * (1.f / 128.f) + RMS_EPS);
  float* outc; float* outk;
  if (Rl < NPR) { const int s = Rl / PT, q = Rl - s * PT; outc = p.ckv_p + (((size_t)L * 4 + s) * PT + q) * 128; outk = p.kr_p + (((size_t)L * 4 + s) * PT + q) * 32; }
  else { const int j = Rl - NPR; outc = p.ckv_s + ((size_t)L * NSM + j) * 128; outk = p.kr_s + ((size_t)L * NSM + j) * 32; }
  const float* g = p.kv_norm_g + L * 128 + 64 * half;
#pragma unroll
  for (int c8 = 0; c8 < 8; ++c8) {
    const uint4 u = *(const uint4*)(zr + ZE_CKV + 64 * half + 8 * c8);
    const float4 g0 = *(const float4*)(g + 8 * c8), g1 = *(const float4*)(g + 8 * c8 + 4);
    float4 y0, y1;
    y0.x = bflo(u.x) * rstd * g0.x; y0.y = bfhi(u.x) * rstd * g0.y; y0.z = bflo(u.y) * rstd * g0.z; y0.w = bfhi(u.y) * rstd * g0.w;
    y1.x = bflo(u.z) * rstd * g1.x; y1.y = bfhi(u.z) * rstd * g1.y; y1.z = bflo(u.w) * rstd * g1.z; y1.w = bfhi(u.w) * rstd * g1.w;
    if (valid) { *(float4*)(outc + 64 * half + 8 * c8) = y0; *(float4*)(outc + 64 * half + 8 * c8 + 4) = y1; }
    if (At_row) { uint4 o; o.x = pk2(y0.x, y0.y); o.y = pk2(y0.z, y0.w); o.z = pk2(y1.x, y1.y); o.w = pk2(y1.z, y1.w); *(uint4*)(At_row + 64 * half + 8 * c8) = o; }
    if (valid && Rl >= NPR) {
      const int j = Rl - NPR, b = j >> 6, r = j & 63;
      bf16_t* kl = p.KL + ((size_t)b * SKEYS + 1024 + r) * 160 + 16 * (4 * half + (c8 >> 1)) + 4 * (c8 & 1);
      *(uint2*)kl = pk4(y0.x, y0.y, y0.z, y0.w); *(uint2*)(kl + 8) = pk4(y1.x, y1.y, y1.z, y1.w);
    }
    if (c8 & 1) __builtin_amdgcn_sched_barrier(0);
  }
  if (half == 0) {
    const int pos = pos_of(Rl);
#pragma unroll
    for (int c8 = 0; c8 < 2; ++c8) {
      const uint4 u = *(const uint4*)(zr + ZE_KR + 8 * c8), v = *(const uint4*)(zr + ZE_KR + 16 + 8 * c8);
      const float x1[8] = {bflo(u.x), bfhi(u.x), bflo(u.y), bfhi(u.y), bflo(u.z), bfhi(u.z), bflo(u.w), bfhi(u.w)};
      const float x2[8] = {bflo(v.x), bfhi(v.x), bflo(v.y), bfhi(v.y), bflo(v.z), bfhi(v.z), bflo(v.w), bfhi(v.w)};
      float y1[8], y2[8];
#pragma unroll
      for (int e = 0; e < 8; ++e) {
        const float cs = p.ropec[pos * 16 + 8 * c8 + e], sn = p.ropes[pos * 16 + 8 * c8 + e];
        y1[e] = x1[e] * cs - x2[e] * sn; y2[e] = x1[e] * sn + x2[e] * cs;
      }
      if (valid) {
        float4 o;
        o.x = y1[0]; o.y = y1[1]; o.z = y1[2]; o.w = y1[3]; *(float4*)(outk + 8 * c8) = o;
        o.x = y1[4]; o.y = y1[5]; o.z = y1[6]; o.w = y1[7]; *(float4*)(outk + 8 * c8 + 4) = o;
        o.x = y2[0]; o.y = y2[1]; o.z = y2[2]; o.w = y2[3]; *(float4*)(outk + 16 + 8 * c8) = o;
        o.x = y2[4]; o.y = y2[5]; o.z = y2[6]; o.w = y2[7]; *(float4*)(outk + 16 + 8 * c8 + 4) = o;
        {
          const int j = Rl - NPR;
          bf16_t* krd = Rl < NPR ? p.Kr + (size_t)Rl * 32 : p.KL + ((size_t)(j >> 6) * SKEYS + 1024 + (j & 63)) * 160 + 128;
          uint4 q; q.x = pk2(y1[0], y1[1]); q.y = pk2(y1[2], y1[3]); q.z = pk2(y1[4], y1[5]); q.w = pk2(y1[6], y1[7]); *(uint4*)(krd + 8 * c8) = q;
          q.x = pk2(y2[0], y2[1]); q.y = pk2(y2[2], y2[3]); q.z = pk2(y2[4], y2[5]); q.w = pk2(y2[6], y2[7]); *(uint4*)(krd + 16 + 8 * c8) = q;
        }
      }
    }
  }
}
DEV void kvproj_item(const Prm& p, int L, int mt, char* lds) {
  int tid = threadIdx.x; LAUNDER(tid);
  const int lane = tid & 63, w = __builtin_amdgcn_readfirstlane(tid >> 6), wr = w >> 1, wc = w & 1, l31 = lane & 31, hh = lane >> 5;
  bf16_t* At = (bf16_t*)lds;
  bf16_t* Bs = At + 128 * 136;
  {
    const int r = tid >> 1, half = tid & 1, R = mt * 128 + r;
    kv_prep_row(p, L, R, half, R < NPR, At + r * 136);
  }
  for (int h = 0; h < 8; ++h) {
    __syncthreads();
    {
      const bf16_t* wsrc = p.Wb_ukv + ((size_t)L * 1024 + h * 128) * 128;
#pragma unroll
      for (int i = 0; i < 8; ++i) { const int id = tid + 256 * i, row = id >> 4, cc = id & 15; *(uint4*)(Bs + row * 136 + cc * 8) = *(const uint4*)(wsrc + row * 128 + cc * 8); }
    }
    __syncthreads();
    f32x16 acc[2][2];
#pragma unroll
    for (int i = 0; i < 2; ++i)
#pragma unroll
      for (int j = 0; j < 2; ++j) acc[i][j] = zero16();
    const bf16_t* as = At + (wr * 64 + l31) * 136 + hh * 8;
    const bf16_t* bs = Bs + (wc * 64 + l31) * 136 + hh * 8;
    if (wc == 0) {
#pragma unroll 2
      for (int ks = 0; ks < 8; ++ks) {
        const bf16x8 a0 = *(const bf16x8*)(as + ks * 16), a1 = *(const bf16x8*)(as + 32 * 136 + ks * 16);
        const bf16x8 b0 = *(const bf16x8*)(bs + ks * 16), b1 = *(const bf16x8*)(bs + 32 * 136 + ks * 16);
        acc[0][0] = mfma32(b0, a0, acc[0][0]); acc[0][1] = mfma32(b1, a0, acc[0][1]);
        acc[1][0] = mfma32(b0, a1, acc[1][0]); acc[1][1] = mfma32(b1, a1, acc[1][1]);
      }
#pragma unroll
      for (int i = 0; i < 2; ++i) {
        const int KRr = mt * 128 + wr * 64 + 32 * i + l31;
#pragma unroll
        for (int j = 0; j < 2; ++j)
#pragma unroll
          for (int G = 0; G < 4; ++G)
            *(uint2*)(p.Kn + ((size_t)KRr * 8 + h) * 64 + 32 * j + 8 * G + 4 * hh) = pk4(acc[i][j][4 * G], acc[i][j][4 * G + 1], acc[i][j][4 * G + 2], acc[i][j][4 * G + 3]);
      }
    } else {
#pragma unroll 2
      for (int ks = 0; ks < 8; ++ks) {
        const bf16x8 a0 = *(const bf16x8*)(as + ks * 16), a1 = *(const bf16x8*)(as + 32 * 136 + ks * 16);
        const bf16x8 b0 = *(const bf16x8*)(bs + ks * 16), b1 = *(const bf16x8*)(bs + 32 * 136 + ks * 16);
        acc[0][0] = mfma32(a0, b0, acc[0][0]); acc[0][1] = mfma32(a0, b1, acc[0][1]);
        acc[1][0] = mfma32(a1, b0, acc[1][0]); acc[1][1] = mfma32(a1, b1, acc[1][1]);
      }
#pragma unroll
      for (int j = 0; j < 2; ++j) {
        const int d = 32 * j + l31;
#pragma unroll
        for (int i = 0; i < 2; ++i)
#pragma unroll
          for (int G = 0; G < 4; ++G) {
            const int KRr = mt * 128 + wr * 64 + 32 * i + 16 * (G >> 1) + 8 * hh + 4 * (G & 1);
            *(uint2*)(p.Vt + ((size_t)h * 64 + d) * KVR + KRr) = pk4(acc[i][j][4 * G], acc[i][j][4 * G + 1], acc[i][j][4 * G + 2], acc[i][j][4 * G + 3]);
          }
      }
    }
  }
  __syncthreads();
}
DEV void sample_prep_item(const Prm& p, int L, int it) {
  int tid = threadIdx.x; LAUNDER(tid);
  const int R = NPR + it * 128 + (tid >> 1);
  kv_prep_row(p, L, R, tid & 1, true, nullptr);
}
DEV void shift_item(const Prm& p, int L, int st) {
  int tid0 = threadIdx.x; LAUNDER(tid0);
  if (tid0 < 224) {
    const int R = st < 4 ? st * PT + (PT - 1) : NPR + (st - 4) * 64 + 63;
    const uint2 u = *(const uint2*)(p.zE + (size_t)R * ZE + ZE_ZC + 4 * tid0);
    float4 v; v.x = bflo(u.x); v.y = bfhi(u.x); v.z = bflo(u.y); v.w = bfhi(u.y);
    float* dst = st < 4 ? p.shift_p + ((size_t)L * 4 + st) * 896 : p.shift_s + ((size_t)L * 32 + (st - 4)) * 896;
    *(float4*)(dst + 4 * tid0) = v;
  }
}

DEV void lat_item(const Prm& p, int L, int j) {
  int tid = threadIdx.x; LAUNDER(tid);
  const int b = j >> 4, t = j & 15;
  const float* csrc = p.cache_ckv + (((size_t)L * 32 + b) * 1024 + 64 * t) * 128;
  const float* ksrc = p.cache_krope + (((size_t)L * 32 + b) * 1024 + 64 * t) * 32;
  {
    const int row = tid >> 2, qd = tid & 3;
    const float* s = csrc + row * 128 + 32 * qd;
    bf16_t* d = p.KL + ((size_t)b * SKEYS + 64 * t + row) * 160;
    const float4 v0 = *(const float4*)(s), v1 = *(const float4*)(s + 4), v2 = *(const float4*)(s + 8), v3 = *(const float4*)(s + 12);
    const float4 v4 = *(const float4*)(s + 16), v5 = *(const float4*)(s + 20), v6 = *(const float4*)(s + 24), v7 = *(const float4*)(s + 28);
    const float4 k0 = *(const float4*)(ksrc + row * 32 + 8 * qd), k1 = *(const float4*)(ksrc + row * 32 + 8 * qd + 4);
    uint4 a;
    a.x = pk2(v0.x, v0.y); a.y = pk2(v0.z, v0.w); a.z = pk2(v2.x, v2.y); a.w = pk2(v2.z, v2.w); *(uint4*)(d + 32 * qd) = a;
    a.x = pk2(v1.x, v1.y); a.y = pk2(v1.z, v1.w); a.z = pk2(v3.x, v3.y); a.w = pk2(v3.z, v3.w); *(uint4*)(d + 32 * qd + 8) = a;
    a.x = pk2(v4.x, v4.y); a.y = pk2(v4.z, v4.w); a.z = pk2(v6.x, v6.y); a.w = pk2(v6.z, v6.w); *(uint4*)(d + 32 * qd + 16) = a;
    a.x = pk2(v5.x, v5.y); a.y = pk2(v5.z, v5.w); a.z = pk2(v7.x, v7.y); a.w = pk2(v7.z, v7.w); *(uint4*)(d + 32 * qd + 24) = a;
    a.x = pk2(k0.x, k0.y); a.y = pk2(k0.z, k0.w); a.z = pk2(k1.x, k1.y); a.w = pk2(k1.z, k1.w); *(uint4*)(d + 128 + 8 * qd) = a;
  }
}

template <bool SAMPLE>
DEV int attn_body(const Prm& p, int L, int sb, int head, int qt, char* lds, unsigned* nctr = nullptr) {
  int tid = threadIdx.x; LAUNDER(tid);
  const int lane = tid & 63, w = __builtin_amdgcn_readfirstlane(tid >> 6), l31 = lane & 31, hh = lane >> 5;
  bf16_t* Ks = (bf16_t*)lds;
  bf16_t* Vs = Ks + (SAMPLE ? 1 : 2) * 64 * 104;
  bf16_t* Cs = Vs + (SAMPLE ? 1 : 2) * 64 * 72;
  bf16_t* Wl = Cs + 64 * 136;
  const bf16_t* Qb = (const bf16_t*)p.y_prompt;
  bf16_t* mix = p.zE;
  int Rq0, ntiles, lastvis; bool wact, rowvalid;
  if (SAMPLE) { Rq0 = NPR + 64 * sb; ntiles = 17; lastvis = 16; wact = w < 2; rowvalid = wact; }
  else if (qt >= 0) { Rq0 = sb * PT + 16 + 128 * qt; ntiles = 2 * qt + 3; lastvis = 1 + 2 * qt + (w >> 1); wact = true; rowvalid = true; }
  else { Rq0 = sb * PT; ntiles = 1; lastvis = 0; wact = (w == 0); rowvalid = wact && l31 < 16; }
  const int myrow = Rq0 + 32 * w + l31;
  const int Rld = rowvalid ? myrow : Rq0;
  bf16x8 qf[6];
  {
    const bf16_t* qp = Qb + (size_t)Rld * 768 + head * 96 + hh * 8;
#pragma unroll
    for (int ks = 0; ks < 6; ++ks) qf[ks] = *(const bf16x8*)(qp + 16 * ks);
  }
  float m_run = -1e30f, l_run = 0.f;
  f32x16 o0 = zero16(), o1 = zero16();

  uint4 a_kn0, a_kn1, a_kr, a_vt0, a_vt1;
  a_kn0 = a_kn1 = a_kr = a_vt0 = a_vt1 = make_uint4(0, 0, 0, 0);
#define PLOADX(S, TI) { const int KR0 = sb * PT + ((TI) == 0 ? 0 : 16 + 64 * ((TI) - 1)); \
    S##_kn0 = *(const uint4*)(p.Kn + ((size_t)(KR0 + (tid >> 3)) * 8 + head) * 64 + (tid & 7) * 8); \
    S##_kn1 = *(const uint4*)(p.Kn + ((size_t)(KR0 + 32 + (tid >> 3)) * 8 + head) * 64 + (tid & 7) * 8); \
    S##_kr = *(const uint4*)(p.Kr + (size_t)(KR0 + (tid >> 2)) * 32 + (tid & 3) * 8); \
    S##_vt0 = *(const uint4*)(p.Vt + ((size_t)head * 64 + (tid >> 3)) * KVR + KR0 + (tid & 7) * 8); \
    S##_vt1 = *(const uint4*)(p.Vt + ((size_t)head * 64 + 32 + (tid >> 3)) * KVR + KR0 + (tid & 7) * 8); }
#define PWRITEX(S, BUF) { bf16_t* kb_ = Ks + (BUF) * 64 * 104; bf16_t* vb_ = Vs + (BUF) * 64 * 72; \
    *(uint4*)(kb_ + (tid >> 3) * 104 + (tid & 7) * 8) = S##_kn0; *(uint4*)(kb_ + (32 + (tid >> 3)) * 104 + (tid & 7) * 8) = S##_kn1; \
    *(uint4*)(kb_ + (tid >> 2) * 104 + 64 + (tid & 3) * 8) = S##_kr; \
    *(uint4*)(vb_ + (tid >> 3) * 72 + (tid & 7) * 8) = S##_vt0; *(uint4*)(vb_ + (32 + (tid >> 3)) * 72 + (tid & 7) * 8) = S##_vt1; }
  float4 pc0, pc1, pc2, pc3, pc4, pc5, pc6, pc7, pk0, pk1;
  pc0 = pc1 = pc2 = pc3 = pc4 = pc5 = pc6 = pc7 = pk0 = pk1 = make_float4(0.f, 0.f, 0.f, 0.f);
  if (SAMPLE) {
    const bf16_t* wsrc = p.Wb_ukv + ((size_t)L * 1024 + head * 128) * 128;
#pragma unroll
    for (int i = 0; i < 8; ++i) { const int id = tid + 256 * i, row = id >> 4, cc = id & 15; *(uint4*)(Wl + row * 136 + cc * 8) = *(const uint4*)(wsrc + row * 128 + cc * 8); }
  }
#define SLOAD(TI) { const float* csrc; const float* ksrc; \
    if ((TI) < 16) { csrc = p.cache_ckv + (((size_t)L * 32 + sb) * 1024 + 64 * (TI)) * 128; ksrc = p.cache_krope + (((size_t)L * 32 + sb) * 1024 + 64 * (TI)) * 32; } \
    else { csrc = p.ckv_s + ((size_t)L * NSM + 64 * sb) * 128; ksrc = p.kr_s + ((size_t)L * NSM + 64 * sb) * 32; } \
    const float* cb_ = csrc + (tid >> 5) * 128 + (tid & 31) * 4; \
    pc0 = *(const float4*)(cb_); pc1 = *(const float4*)(cb_ + 8 * 128); pc2 = *(const float4*)(cb_ + 16 * 128); pc3 = *(const float4*)(cb_ + 24 * 128); \
    pc4 = *(const float4*)(cb_ + 32 * 128); pc5 = *(const float4*)(cb_ + 40 * 128); pc6 = *(const float4*)(cb_ + 48 * 128); pc7 = *(const float4*)(cb_ + 56 * 128); \
    const float* kb2_ = ksrc + (tid >> 3) * 32 + (tid & 7) * 4; pk0 = *(const float4*)(kb2_); pk1 = *(const float4*)(kb2_ + 32 * 32); }
#define SWRITE(BUF) { bf16_t* cd_ = Cs + (tid >> 5) * 136 + (tid & 31) * 4; \
    *(uint2*)(cd_) = pk4(pc0.x, pc0.y, pc0.z, pc0.w); *(uint2*)(cd_ + 8 * 136) = pk4(pc1.x, pc1.y, pc1.z, pc1.w); \
    *(uint2*)(cd_ + 16 * 136) = pk4(pc2.x, pc2.y, pc2.z, pc2.w); *(uint2*)(cd_ + 24 * 136) = pk4(pc3.x, pc3.y, pc3.z, pc3.w); \
    *(uint2*)(cd_ + 32 * 136) = pk4(pc4.x, pc4.y, pc4.z, pc4.w); *(uint2*)(cd_ + 40 * 136) = pk4(pc5.x, pc5.y, pc5.z, pc5.w); \
    *(uint2*)(cd_ + 48 * 136) = pk4(pc6.x, pc6.y, pc6.z, pc6.w); *(uint2*)(cd_ + 56 * 136) = pk4(pc7.x, pc7.y, pc7.z, pc7.w); \
    }
#define SWRITEK(BUF) { bf16_t* kd_ = Ks + (BUF) * 64 * 104 + (tid >> 3) * 104 + 64 + (tid & 7) * 4; \
    *(uint2*)(kd_) = pk4(pk0.x, pk0.y, pk0.z, pk0.w); *(uint2*)(kd_ + 32 * 104) = pk4(pk1.x, pk1.y, pk1.z, pk1.w); }
  auto sexpand = [&](int buf) {
    const int a = w & 1, b = w >> 1;
    const bf16_t* cp = Cs + (32 * b + l31) * 136 + hh * 8;
    const bf16_t* wkp = Wl + (32 * a + l31) * 136 + hh * 8;
    const bf16_t* wvp = wkp + 64 * 136;
    f32x16 ka = zero16(), va = zero16();
#pragma unroll
    for (int ks = 0; ks < 8; ++ks) {
      const bf16x8 cf = *(const bf16x8*)(cp + 16 * ks);
      ka = mfma32(*(const bf16x8*)(wkp + 16 * ks), cf, ka);
      va = mfma32(cf, *(const bf16x8*)(wvp + 16 * ks), va);
    }
    bf16_t* kb = Ks + buf * 64 * 104; bf16_t* vb = Vs + buf * 64 * 72;
#pragma unroll
    for (int G = 0; G < 4; ++G) {
      *(uint2*)(kb + (32 * b + l31) * 104 + 32 * a + 8 * G + 4 * hh) = pk4(ka[4 * G], ka[4 * G + 1], ka[4 * G + 2], ka[4 * G + 3]);
      *(uint2*)(vb + (32 * a + l31) * 72 + 32 * b + 8 * G + 4 * hh) = pk4(va[4 * G], va[4 * G + 1], va[4 * G + 2], va[4 * G + 3]);
    }
  };
  const int x7 = (l31 >> 1) & 7, x3 = (l31 >> 2) & 3, xv = (l31 >> 1) & 7;
#define KFRAG(SP, KS, SUB) (SAMPLE ? *(const bf16x8*)((const bf16_t*)(SP) + (l31 + 32 * (SUB)) * 104 + hh * 8 + 16 * (KS)) \
    : ((KS) < 4 ? *(const bf16x8*)((SP) + (l31 + 32 * (SUB)) * 128 + (((2 * (KS) + hh) ^ x7) << 4)) \
                : *(const bf16x8*)((SP) + 8192 + (l31 + 32 * (SUB)) * 64 + (((2 * ((KS) - 4) + hh) ^ x3) << 4))))
#define VHALF(SP, C, SUB) (SAMPLE ? *(const uint2*)((const bf16_t*)(SP) + 64 * 104 + (l31 + 32 * (SUB)) * 72 + 4 * hh + 8 * (C)) \
    : *(const uint2*)((SP) + 12288 + (l31 + 32 * (SUB)) * 128 + 8 * hh + ((((C)) ^ xv) << 4)))
  auto compute_t = [&](auto masked_c, const char* sp) {
    constexpr bool MASKED = decltype(masked_c)::value;
    f32x16 s0 = zero16(), s1 = zero16();
#pragma unroll
    for (int ks = 0; ks < 6; ++ks) {
      const bf16x8 k0 = KFRAG(sp, ks, 0), k1 = KFRAG(sp, ks, 1);
      s0 = mfma32(k0, qf[ks], s0); s1 = mfma32(k1, qf[ks], s1);
    }
    if (!SAMPLE && MASKED) {
#pragma unroll
      for (int r = 8; r < 16; ++r) s0[r] = -1e30f;
#pragma unroll
      for (int r = 0; r < 16; ++r) s1[r] = -1e30f;
    }
    float mx = s0[0];
#pragma unroll
    for (int r = 1; r < 16; ++r) mx = fmaxf(mx, s0[r]);
#pragma unroll
    for (int r = 0; r < 16; ++r) mx = fmaxf(mx, s1[r]);
    mx = fmaxf(mx, __shfl_xor(mx, 32));
    const float mnew = fmaxf(m_run, mx);
    const float alpha = __builtin_amdgcn_exp2f(m_run - mnew);
    m_run = mnew;
    float ps = 0.f;
#pragma unroll
    for (int r = 0; r < 16; ++r) { s0[r] = __builtin_amdgcn_exp2f(s0[r] - mnew); ps += s0[r]; }
#pragma unroll
    for (int r = 0; r < 16; ++r) { s1[r] = __builtin_amdgcn_exp2f(s1[r] - mnew); ps += s1[r]; }
    l_run = l_run * alpha + ps;
#pragma unroll
    for (int r = 0; r < 16; ++r) { o0[r] *= alpha; o1[r] *= alpha; }
    const bf16x8 pf0 = mk8(pk2(s0[0], s0[1]), pk2(s0[2], s0[3]), pk2(s0[4], s0[5]), pk2(s0[6], s0[7]));
    const bf16x8 pf1 = mk8(pk2(s0[8], s0[9]), pk2(s0[10], s0[11]), pk2(s0[12], s0[13]), pk2(s0[14], s0[15]));
    const bf16x8 pf2 = mk8(pk2(s1[0], s1[1]), pk2(s1[2], s1[3]), pk2(s1[4], s1[5]), pk2(s1[6], s1[7]));
    const bf16x8 pf3 = mk8(pk2(s1[8], s1[9]), pk2(s1[10], s1[11]), pk2(s1[12], s1[13]), pk2(s1[14], s1[15]));
#define PV_STEP(S, PF) { bf16x8 v0_, v1_; \
      if (SAMPLE) { const uint2 a0 = VHALF(sp, 2 * S, 0), b0 = VHALF(sp, 2 * S + 1, 0), a1 = VHALF(sp, 2 * S, 1), b1 = VHALF(sp, 2 * S + 1, 1); \
        v0_ = mk8(a0.x, a0.y, b0.x, b0.y); v1_ = mk8(a1.x, a1.y, b1.x, b1.y); } \
      else { v0_ = *(const bf16x8*)(sp + 12288 + l31 * 128 + (((2 * S + hh) ^ xv) << 4)); v1_ = *(const bf16x8*)(sp + 12288 + (l31 + 32) * 128 + (((2 * S + hh) ^ xv) << 4)); } \
      o0 = mfma32(v0_, PF, o0); o1 = mfma32(v1_, PF, o1); }
    PV_STEP(0, pf0) PV_STEP(1, pf1) PV_STEP(2, pf2) PV_STEP(3, pf3)
  };
  bf16x8 qf7 = mk8(0u, 0u, 0u, 0u);
  const bf16x8 kone = mk8(hh == 0 ? 0x3F80u : 0u, 0u, 0u, 0u);
  auto freeze = [&]() {
    const float mf = bflo(pk2(m_run, 0.f));
    const float fac = __builtin_amdgcn_exp2f(m_run - mf);
    l_run *= fac;
#pragma unroll
    for (int r = 0; r < 16; ++r) { o0[r] *= fac; o1[r] *= fac; }
    qf7 = mk8(hh == 0 ? (pk2(-mf, 0.f) & 0xffffu) : 0u, 0u, 0u, 0u);
  };
  auto compute_f = [&](const char* sp) {
    f32x16 s0 = mfma32(kone, qf7, zero16()), s1 = mfma32(kone, qf7, zero16());
#pragma unroll
    for (int ks = 0; ks < 6; ++ks) {
      const bf16x8 k0 = KFRAG(sp, ks, 0), k1 = KFRAG(sp, ks, 1);
      s0 = mfma32(k0, qf[ks], s0); s1 = mfma32(k1, qf[ks], s1);
    }
    float ps = 0.f;
#pragma unroll
    for (int r = 0; r < 16; ++r) { s0[r] = __builtin_amdgcn_exp2f(s0[r]); ps += s0[r]; }
#pragma unroll
    for (int r = 0; r < 16; ++r) { s1[r] = __builtin_amdgcn_exp2f(s1[r]); ps += s1[r]; }
    l_run += ps;
    const bf16x8 pf0 = mk8(pk2(s0[0], s0[1]), pk2(s0[2], s0[3]), pk2(s0[4], s0[5]), pk2(s0[6], s0[7]));
    const bf16x8 pf1 = mk8(pk2(s0[8], s0[9]), pk2(s0[10], s0[11]), pk2(s0[12], s0[13]), pk2(s0[14], s0[15]));
    const bf16x8 pf2 = mk8(pk2(s1[0], s1[1]), pk2(s1[2], s1[3]), pk2(s1[4], s1[5]), pk2(s1[6], s1[7]));
    const bf16x8 pf3 = mk8(pk2(s1[8], s1[9]), pk2(s1[10], s1[11]), pk2(s1[12], s1[13]), pk2(s1[14], s1[15]));
    PV_STEP(0, pf0) PV_STEP(1, pf1) PV_STEP(2, pf2) PV_STEP(3, pf3)
#undef PV_STEP
  };

  if (SAMPLE) {
    SLOAD(0)
    for (int ti = 0; ti < ntiles; ++ti) {
      const int buf = 0;
      SWRITE(buf)
      __syncthreads();
      SWRITEK(buf)
      { const int tn = ti + 1 < ntiles ? ti + 1 : ti; SLOAD(tn) }
      sexpand(buf);
      __syncthreads();
      if (wact) { if (ti == 0) { compute_t(std::false_type{}, (const char*)Ks); freeze(); } else compute_f((const char*)Ks); }
    }
    __syncthreads();
  } else {
    const int l8 = lane >> 3, c8 = lane & 7;
    unsigned kn_o0, kn_o1, kr_o, vt_o0, vt_o1;
    { const int r = 8 * (2 * w) + l8; kn_o0 = (unsigned)((r * 8 + head) * 64 + ((c8 ^ ((r >> 1) & 7)) * 8)); }
    { const int r = 8 * (2 * w + 1) + l8; kn_o1 = (unsigned)((r * 8 + head) * 64 + ((c8 ^ ((r >> 1) & 7)) * 8)); }
    { const int r = 16 * w + (lane >> 2); kr_o = (unsigned)(r * 32 + (((lane & 3) ^ ((r >> 2) & 3)) * 8)); }
    { const int d = 8 * (2 * w) + l8; vt_o0 = (unsigned)((head * 64 + d) * KVR + ((c8 ^ ((d >> 1) & 7)) * 8)); }
    { const int d = 8 * (2 * w + 1) + l8; vt_o1 = (unsigned)((head * 64 + d) * KVR + ((c8 ^ ((d >> 1) & 7)) * 8)); }
#define GLDS16(G, Lp) __builtin_amdgcn_global_load_lds((const unsigned*)(G), (LAS3 unsigned*)(Lp), 16, 0, 0)
#define PDMA(TI, STG) { const int KR0 = sb * PT + ((TI) == 0 ? 0 : 16 + 64 * ((TI) - 1)); char* sb_ = lds + (STG) * 20480 + lane * 16; \
      const bf16_t* kn_ = p.Kn + (size_t)KR0 * 512; const bf16_t* kr_ = p.Kr + (size_t)KR0 * 32; const bf16_t* vt_ = p.Vt + KR0; \
      GLDS16(kn_ + kn_o0, sb_ + (2 * w) * 1024); GLDS16(kn_ + kn_o1, sb_ + (2 * w + 1) * 1024); GLDS16(kr_ + kr_o, sb_ + 8192 + w * 1024); \
      GLDS16(vt_ + vt_o0, sb_ + 12288 + (2 * w) * 1024); GLDS16(vt_ + vt_o1, sb_ + 12288 + (2 * w + 1) * 1024); }
    PDMA(0, 0)
    if (ntiles > 1) PDMA(1, 1)
    int stg = 0, stg2 = 2;
    for (int ti = 0; ti < ntiles; ++ti) {
      if (ti + 1 < ntiles) asm volatile("s_waitcnt vmcnt(5)" ::: "memory"); else asm volatile("s_waitcnt vmcnt(0)" ::: "memory");
      RAW_BARRIER()
      if (ti + 2 < ntiles) PDMA(ti + 2, stg2)
      const char* sp = lds + stg * 20480;
      if (ti == 0) { if (wact) compute_t(std::true_type{}, sp); }
      else if (ti == 1) { compute_t(std::false_type{}, sp); freeze(); }
      else if (ti <= lastvis) compute_f(sp);
      stg = stg == 2 ? 0 : stg + 1; stg2 = stg2 == 2 ? 0 : stg2 + 1;
    }
    __syncthreads();
#undef PDMA
#undef GLDS16
  }
  int tk = 0x7fffffff; if (nctr && tid == 0) tk = (int)atomicAdd(nctr, 1u);
  const float lt = l_run + __shfl_xor(l_run, 32);
  if (rowvalid) {
    const float inv = 1.f / lt;
    const bf16_t* gbp = p.zL + (size_t)myrow * ZL + ZL_GB + 64 * head;
    bf16_t* op = mix + (size_t)myrow * D + 256 + 64 * head;
#pragma unroll
    for (int G = 0; G < 4; ++G) {
      const int d = 8 * G + 4 * hh;
      const uint2 g0 = *(const uint2*)(gbp + d), g1 = *(const uint2*)(gbp + 32 + d);
      *(uint2*)(op + d) = pk4(o0[4 * G] * inv * silu_(bflo(g0.x)), o0[4 * G + 1] * inv * silu_(bfhi(g0.x)), o0[4 * G + 2] * inv * silu_(bflo(g0.y)), o0[4 * G + 3] * inv * silu_(bfhi(g0.y)));
      *(uint2*)(op + 32 + d) = pk4(o1[4 * G] * inv * silu_(bflo(g1.x)), o1[4 * G + 1] * inv * silu_(bfhi(g1.x)), o1[4 * G + 2] * inv * silu_(bflo(g1.y)), o1[4 * G + 3] * inv * silu_(bfhi(g1.y)));
    }
  }
  return tk;
}
DEV void attn_item(const Prm& p, int L, int id, char* lds) {
  if (id < 1024) { const int qt = 31 - (id >> 5), sh = id & 31; attn_body<false>(p, L, sh >> 3, sh & 7, qt, lds); }
  else if (id < 1280) { const int j = id - 1024; attn_body<true>(p, L, j >> 3, j & 7, 0, lds); }
  else { const int j = id - 1280; attn_body<false>(p, L, j >> 3, j & 7, -1, lds); }
}

typedef short v4i16_t __attribute__((ext_vector_type(4)));
DEV uint2 lds_tr16(const char* pl) { const v4i16_t r = __builtin_amdgcn_ds_read_tr16_b64_v4i16((__attribute__((address_space(3))) v4i16_t*)pl); return __builtin_bit_cast(uint2, r); }
DEV void attn_sample(const Prm& p, int L, int b, int hp, char* lds) {
  int tid = threadIdx.x; LAUNDER(tid);
  const int lane = tid & 63, w = __builtin_amdgcn_readfirstlane(tid >> 6), l31 = lane & 31, hh = lane >> 5;
  const int head = 2 * hp + (w >> 1);
  const bf16_t* Qb = (const bf16_t*)p.y_prompt;
  bf16_t* mix = p.zE;
  const int myrow = NPR + 64 * b + 32 * (w & 1) + l31;
  bf16x8 qf[6];
  {
    const bf16_t* qp = Qb + (size_t)myrow * 768 + head * 96 + hh * 8;
#pragma unroll
    for (int ks = 0; ks < 6; ++ks) qf[ks] = *(const bf16x8*)(qp + 16 * ks);
  }
  unsigned kl_o0, kl_o1, kl_o2, kl_o3, kr_o;
  {
    const int l16 = lane >> 4, c16 = lane & 15;
#define KROW(i) (4 * (4 * w + (i)) + l16)
#define KLO(i) ((unsigned)(KROW(i) * 160 + ((c16 ^ (((KROW(i) & 3) << 2) | ((KROW(i) >> 2) & 3))) * 8)))
    kl_o0 = KLO(0); kl_o1 = KLO(1); kl_o2 = KLO(2); kl_o3 = KLO(3);
#undef KLO
#undef KROW
    const int r = 16 * w + (lane >> 2);
    kr_o = (unsigned)(r * 160 + 128 + (((lane & 3) ^ ((r >> 2) & 3)) * 8));
  }
  const bf16_t* klb = p.KL + (size_t)b * SKEYS * 160;
#define GLDS16(G, Lp) __builtin_amdgcn_global_load_lds((const unsigned*)(G), (LAS3 unsigned*)(Lp), 16, 0, 0)
#define SDMA(TI, STG) { char* sb_ = lds + (STG) * 20480 + lane * 16; const bf16_t* kl_ = klb + (size_t)(TI) * 64 * 160; \
    GLDS16(kl_ + kl_o0, sb_ + (4 * w) * 1024); GLDS16(kl_ + kl_o1, sb_ + (4 * w + 1) * 1024); GLDS16(kl_ + kl_o2, sb_ + (4 * w + 2) * 1024); GLDS16(kl_ + kl_o3, sb_ + (4 * w + 3) * 1024); \
    GLDS16(kl_ + kr_o, sb_ + 16384 + w * 1024); }
  SDMA(0, 0)
  SDMA(1, 1)
  bf16x8 qa0, qa1, qa2, qa3, qa4, qa5, qa6, qa7;
  {
    const float* wsrc = p.w_ukv + ((size_t)L * 128 + l31) * 1024 + head * 128 + 8 * hh;
#define QABS(CT, QA, QB) { f32x16 acc = zero16(); \
      _Pragma("unroll") for (int ks = 0; ks < 4; ++ks) { const float* s_ = wsrc + (size_t)(32 * (CT)) * 1024 + 16 * ks; const float4 a_ = *(const float4*)s_, c_ = *(const float4*)(s_ + 4); \
        acc = mfma32(mk8(pk2(a_.x, a_.y), pk2(a_.z, a_.w), pk2(c_.x, c_.y), pk2(c_.z, c_.w)), qf[ks], acc); } \
      QA = mk8(pk2(acc[0], acc[1]), pk2(acc[2], acc[3]), pk2(acc[4], acc[5]), pk2(acc[6], acc[7])); \
      QB = mk8(pk2(acc[8], acc[9]), pk2(acc[10], acc[11]), pk2(acc[12], acc[13]), pk2(acc[14], acc[15])); }
    QABS(0, qa0, qa1) QABS(1, qa2, qa3) QABS(2, qa4, qa5) QABS(3, qa6, qa7)
#undef QABS
  }
  float m_run = -1e30f, l_run = 0.f;
  f32x16 o0 = zero16(), o1 = zero16(), o2 = zero16(), o3 = zero16();
  bf16x8 qf7 = mk8(0u, 0u, 0u, 0u);
  const bf16x8 kone = mk8(hh == 0 ? 0x3F80u : 0u, 0u, 0u, 0u);
  const int xk = ((l31 & 3) << 2) | ((l31 >> 2) & 3), x3 = (l31 >> 2) & 3;
  int va0, va1;
  {
    const int g = l31 >> 4, q = (l31 >> 2) & 3, pp = l31 & 3;
    const int rowb = (4 * hh + q) * 256 + 8 * (pp & 1) + (q << 6);
    va0 = rowb + (((2 * g + (pp >> 1)) ^ hh) << 4);
    va1 = rowb + 2048 + (((2 * g + (pp >> 1)) ^ (hh + 2)) << 4);
  }
  int stg = 0, stg2 = 2;
  for (int ti = 0; ti < 17; ++ti) {
    if (ti + 1 < 17) asm volatile("s_waitcnt vmcnt(5)" ::: "memory"); else asm volatile("s_waitcnt vmcnt(0)" ::: "memory");
    RAW_BARRIER()
    if (ti + 2 < 17) SDMA(ti + 2, stg2)
    const char* sp = lds + stg * 20480;
    f32x16 s0 = mfma32(kone, qf7, zero16()), s1 = s0;
#define QKL(S, QA) { const bf16x8 k0 = *(const bf16x8*)(sp + l31 * 256 + (((2 * (S) + hh) ^ xk) << 4)), k1 = *(const bf16x8*)(sp + (l31 + 32) * 256 + (((2 * (S) + hh) ^ xk) << 4)); \
      s0 = mfma32(k0, QA, s0); s1 = mfma32(k1, QA, s1); }
    QKL(0, qa0) QKL(1, qa1) QKL(2, qa2) QKL(3, qa3) QKL(4, qa4) QKL(5, qa5) QKL(6, qa6) QKL(7, qa7)
#undef QKL
#pragma unroll
    for (int kr = 0; kr < 2; ++kr) {
      const bf16x8 k0 = *(const bf16x8*)(sp + 16384 + l31 * 64 + (((2 * kr + hh) ^ x3) << 4)), k1 = *(const bf16x8*)(sp + 16384 + (l31 + 32) * 64 + (((2 * kr + hh) ^ x3) << 4));
      s0 = mfma32(k0, qf[4 + kr], s0); s1 = mfma32(k1, qf[4 + kr], s1);
    }
    float ps = 0.f;
    if (ti == 0) {
      float mx = s0[0];
#pragma unroll
      for (int r = 1; r < 16; ++r) mx = fmaxf(mx, s0[r]);
#pragma unroll
      for (int r = 0; r < 16; ++r) mx = fmaxf(mx, s1[r]);
      mx = fmaxf(mx, __shfl_xor(mx, 32));
      m_run = bflo(pk2(mx, 0.f));
#pragma unroll
      for (int r = 0; r < 16; ++r) { s0[r] -= m_run; s1[r] -= m_run; }
      qf7 = mk8(hh == 0 ? (pk2(-m_run, 0.f) & 0xffffu) : 0u, 0u, 0u, 0u);
    }
#pragma unroll
    for (int r = 0; r < 16; ++r) { s0[r] = __builtin_amdgcn_exp2f(s0[r]); ps += s0[r]; }
#pragma unroll
    for (int r = 0; r < 16; ++r) { s1[r] = __builtin_amdgcn_exp2f(s1[r]); ps += s1[r]; }
    l_run += ps;
    const bf16x8 pf0 = mk8(pk2(s0[0], s0[1]), pk2(s0[2], s0[3]), pk2(s0[4], s0[5]), pk2(s0[6], s0[7]));
    const bf16x8 pf1 = mk8(pk2(s0[8], s0[9]), pk2(s0[10], s0[11]), pk2(s0[12], s0[13]), pk2(s0[14], s0[15]));
    const bf16x8 pf2 = mk8(pk2(s1[0], s1[1]), pk2(s1[2], s1[3]), pk2(s1[4], s1[5]), pk2(s1[6], s1[7]));
    const bf16x8 pf3 = mk8(pk2(s1[8], s1[9]), pk2(s1[10], s1[11]), pk2(s1[12], s1[13]), pk2(s1[14], s1[15]));
#define PVT(S, CT, PF, OT) { const uint2 a_ = lds_tr16(sp + (va0 ^ ((CT) << 6)) + (S) * 4096), b_ = lds_tr16(sp + (va1 ^ ((CT) << 6)) + (S) * 4096); \
      OT = mfma32(mk8(a_.x, a_.y, b_.x, b_.y), PF, OT); }
#define PVL(S, PF) PVT(S, 0, PF, o0) PVT(S, 1, PF, o1) PVT(S, 2, PF, o2) PVT(S, 3, PF, o3)
    PVL(0, pf0) PVL(1, pf1) PVL(2, pf2) PVL(3, pf3)
#undef PVL
#undef PVT
    stg = stg == 2 ? 0 : stg + 1; stg2 = stg2 == 2 ? 0 : stg2 + 1;
  }
#undef SDMA
#undef GLDS16
  __syncthreads();
  const float lt = l_run + __shfl_xor(l_run, 32);
  const float inv = 1.f / lt;
  f32x16 e0 = zero16(), e1 = zero16();
  const bf16_t* wv = p.Wb_ukv + ((size_t)L * 1024 + head * 128 + 64 + l31) * 128 + 8 * hh;
#define OEXP(S, OT, RB) { const bf16x8 ob = mk8(pk2(OT[RB] * inv, OT[RB + 1] * inv), pk2(OT[RB + 2] * inv, OT[RB + 3] * inv), pk2(OT[RB + 4] * inv, OT[RB + 5] * inv), pk2(OT[RB + 6] * inv, OT[RB + 7] * inv)); \
    e0 = mfma32(*(const bf16x8*)(wv + 16 * (S)), ob, e0); e1 = mfma32(*(const bf16x8*)(wv + 32 * 128 + 16 * (S)), ob, e1); }
  OEXP(0, o0, 0) OEXP(1, o0, 8) OEXP(2, o1, 0) OEXP(3, o1, 8) OEXP(4, o2, 0) OEXP(5, o2, 8) OEXP(6, o3, 0) OEXP(7, o3, 8)
#undef OEXP
  {
    const bf16_t* gbp = p.zL + (size_t)myrow * ZL + ZL_GB + 64 * head;
    bf16_t* op = mix + (size_t)myrow * D + 256 + 64 * head;
#pragma unroll
    for (int G = 0; G < 4; ++G) {
      const int d = 8 * G + 4 * hh;
      const uint2 g0 = *(const uint2*)(gbp + d), g1 = *(const uint2*)(gbp + 32 + d);
      *(uint2*)(op + d) = pk4(e0[4 * G] * silu_(bflo(g0.x)), e0[4 * G + 1] * silu_(bfhi(g0.x)), e0[4 * G + 2] * silu_(bflo(g0.y)), e0[4 * G + 3] * silu_(bfhi(g0.y)));
      *(uint2*)(op + 32 + d) = pk4(e1[4 * G] * silu_(bflo(g1.x)), e1[4 * G + 1] * silu_(bfhi(g1.x)), e1[4 * G + 2] * silu_(bflo(g1.y)), e1[4 * G + 3] * silu_(bfhi(g1.y)));
    }
  }
}

DEV void conv_item(const Prm& p, int L, int item) {
  int tid = threadIdx.x; LAUNDER(tid);
  bf16_t* mix = p.zE;
  const int c0 = (tid & 31) * 8;
  float w0[8], w1[8], w2[8];
#pragma unroll
  for (int e = 0; e < 8; ++e) { w0[e] = p.conv_w[(L * 3 + 0) * 256 + c0 + e]; w1[e] = p.conv_w[(L * 3 + 1) * 256 + c0 + e]; w2[e] = p.conv_w[(L * 3 + 2) * 256 + c0 + e]; }
  for (int it = 0; it < 4; ++it) {
    const int R = item * 32 + it * 8 + (tid >> 5);
    if (R >= NT) continue;
    int q, T; const float* st; float* so;
    if (R < NPR) { const int s = R / PT; q = R - s * PT; T = PT; st = nullptr; so = p.conv_p + ((size_t)L * 4 + s) * 512; }
    else { const int b = (R - NPR) >> 6; q = (R - NPR) & 63; T = 64; st = p.state_conv + ((size_t)L * 32 + b) * 512; so = p.conv_s + ((size_t)L * 32 + b) * 512; }
    float u[3][8];
#pragma unroll
    for (int dlt = 0; dlt < 3; ++dlt) {
      const int t = q - 2 + dlt;
      if (t >= 0) {
        const bf16_t* zr = p.zL + (size_t)(R - 2 + dlt) * ZL;
        const uint4 xi = *(const uint4*)(zr + ZL_XIN + c0), cg = *(const uint4*)(zr + ZL_CG + c0);
        u[dlt][0] = bflo(xi.x) * bflo(cg.x); u[dlt][1] = bfhi(xi.x) * bfhi(cg.x); u[dlt][2] = bflo(xi.y) * bflo(cg.y); u[dlt][3] = bfhi(xi.y) * bfhi(cg.y);
        u[dlt][4] = bflo(xi.z) * bflo(cg.z); u[dlt][5] = bfhi(xi.z) * bfhi(cg.z); u[dlt][6] = bflo(xi.w) * bflo(cg.w); u[dlt][7] = bfhi(xi.w) * bfhi(cg.w);
      } else if (st) {
        const float* sr = st + (t + 2) * 256 + c0;
#pragma unroll
        for (int e = 0; e < 8; ++e) u[dlt][e] = sr[e];
      } else {
#pragma unroll
        for (int e = 0; e < 8; ++e) u[dlt][e] = 0.f;
      }
    }
    const bf16_t* zr = p.zL + (size_t)R * ZL;
    const uint4 bg = *(const uint4*)(zr + ZL_BG + c0), ga = *(const uint4*)(zr + ZL_GA + c0);
    const float bgf[8] = {bflo(bg.x), bfhi(bg.x), bflo(bg.y), bfhi(bg.y), bflo(bg.z), bfhi(bg.z), bflo(bg.w), bfhi(bg.w)};
    const float gaf[8] = {bflo(ga.x), bfhi(ga.x), bflo(ga.y), bfhi(ga.y), bflo(ga.z), bfhi(ga.z), bflo(ga.w), bfhi(ga.w)};
    float y[8];
#pragma unroll
    for (int e = 0; e < 8; ++e) y[e] = bgf[e] * (w0[e] * u[0][e] + w1[e] * u[1][e] + w2[e] * u[2][e]) * silu_(gaf[e]);
    uint4 o; o.x = pk2(y[0], y[1]); o.y = pk2(y[2], y[3]); o.z = pk2(y[4], y[5]); o.w = pk2(y[6], y[7]);
    *(uint4*)(mix + (size_t)R * D + c0) = o;
    if (q >= T - 2) {
      float* d = so + (q - (T - 2)) * 256 + c0;
#pragma unroll
      for (int e = 0; e < 8; ++e) d[e] = u[2][e];
    }
  }
}

DEV int kperm_addr(int m, int kin) {
  const int mt = m >> 4, ml = m & 15, s = kin >> 5, q = (kin >> 4) & 1, g = (kin >> 2) & 3, e = kin & 3;
  return (((mt * 2 + s) * 64 + ml + 16 * g) * 8) + 4 * q + e;
}
DEV int clay_addr(int x, int v) {
  const int xt = x >> 4, g = (x >> 2) & 3, rr = x & 3, vt = v >> 4, l16 = v & 15;
  return ((xt * 4 + vt) * 64 + 16 * g + l16) * 4 + rr;
}
DEV void mm64(const bf16_t* first, const bf16_t* second, int l31, int hh, f32x16 (&acc)[2][2]) {
#pragma unroll
  for (int ks = 0; ks < 4; ++ks) {
    const bf16x8 f0 = *(const bf16x8*)(first + l31 * 72 + ks * 16 + hh * 8), f1 = *(const bf16x8*)(first + (32 + l31) * 72 + ks * 16 + hh * 8);
    const bf16x8 s0 = *(const bf16x8*)(second + l31 * 72 + ks * 16 + hh * 8), s1 = *(const bf16x8*)(second + (32 + l31) * 72 + ks * 16 + hh * 8);
    acc[0][0] = mfma32(f0, s0, acc[0][0]); acc[0][1] = mfma32(f0, s1, acc[0][1]);
    acc[1][0] = mfma32(f1, s0, acc[1][0]); acc[1][1] = mfma32(f1, s1, acc[1][1]);
  }
}
DEV void mm64x32(const bf16_t* first, const bf16_t* second_rows, int l31, int hh, f32x16 (&acc)[2]) {
#pragma unroll
  for (int ks = 0; ks < 4; ++ks) {
    const bf16x8 f0 = *(const bf16x8*)(first + l31 * 72 + ks * 16 + hh * 8), f1 = *(const bf16x8*)(first + (32 + l31) * 72 + ks * 16 + hh * 8);
    const bf16x8 s0 = *(const bf16x8*)(second_rows + l31 * 72 + ks * 16 + hh * 8);
    acc[0] = mfma32(f0, s0, acc[0]); acc[1] = mfma32(f1, s0, acc[1]);
  }
}

DEV void mmq(const bf16_t* first_rows, const bf16_t* second_rows, int l31, int hh, f32x16& acc) {
#pragma unroll
  for (int ks = 0; ks < 4; ++ks) {
    const bf16x8 f0 = *(const bf16x8*)(first_rows + l31 * 72 + ks * 16 + hh * 8);
    const bf16x8 s0 = *(const bf16x8*)(second_rows + l31 * 72 + ks * 16 + hh * 8);
    acc = mfma32(f0, s0, acc);
  }
}
enum { SH_FULL = 0, SH_UP = 1, SH_LO = 2 };
template <int SH> DEV constexpr bool tile_nz(int tx, int ty) { return SH == SH_FULL || (SH == SH_UP ? tx <= ty : tx >= ty); }
struct Acc64 { f32x16 t[2][2]; };
struct Frag64 { bf16x8 f[4][2]; };
template <int SS> DEV bf16x8 pack8(const f32x16& v) {
  return mk8(pk2(v[8 * SS], v[8 * SS + 1]), pk2(v[8 * SS + 2], v[8 * SS + 3]), pk2(v[8 * SS + 4], v[8 * SS + 5]), pk2(v[8 * SS + 6], v[8 * SS + 7]));
}
template <int SH> DEV void to_frag(const Acc64& X, Frag64& F) {
#pragma unroll
  for (int t = 0; t < 2; ++t) {
    if (tile_nz<SH>(0, t)) { F.f[0][t] = pack8<0>(X.t[0][t]); F.f[1][t] = pack8<1>(X.t[0][t]); }
    if (tile_nz<SH>(1, t)) { F.f[2][t] = pack8<0>(X.t[1][t]); F.f[3][t] = pack8<1>(X.t[1][t]); }
  }
}
template <int SH> DEV void zero_acc(Acc64& X) {
#pragma unroll
  for (int a = 0; a < 2; ++a)
#pragma unroll
    for (int b = 0; b < 2; ++b) if (tile_nz<SH>(a, b)) X.t[a][b] = zero16();
}
template <int SHA, int SHB> DEV void prod_ff(const Frag64& A, const Frag64& B, Acc64& D) {
#pragma unroll
  for (int tm = 0; tm < 2; ++tm)
#pragma unroll
    for (int tn = 0; tn < 2; ++tn)
#pragma unroll
      for (int s = 0; s < 4; ++s)
        if (tile_nz<SHA>(s >> 1, tm) && tile_nz<SHB>(s >> 1, tn)) D.t[tm][tn] = mfma32(A.f[s][tm], B.f[s][tn], D.t[tm][tn]);
}
template <int SHA, int SHB, int SHD> DEV void prod_ff_frag(const Frag64& A, const Frag64& B, Frag64& Fo) {
#pragma unroll
  for (int tm = 0; tm < 2; ++tm)
#pragma unroll
    for (int tn = 0; tn < 2; ++tn)
      if (tile_nz<SHD>(tm, tn)) {
        f32x16 acc = zero16();
#pragma unroll
        for (int s = 0; s < 4; ++s)
          if (tile_nz<SHA>(s >> 1, tm) && tile_nz<SHB>(s >> 1, tn)) acc = mfma32(A.f[s][tm], B.f[s][tn], acc);
        Fo.f[2 * tm][tn] = pack8<0>(acc); Fo.f[2 * tm + 1][tn] = pack8<1>(acc);
      }
}
DEV bf16x8 nat_frag(const bf16_t* S, int row, int s, int hh) { return *(const bf16x8*)(S + row * 72 + 16 * s + 8 * hh); }
DEV bf16x8 perm_frag(const bf16_t* S, int row, int s, int hh) {
  const uint2 a = *(const uint2*)(S + row * 72 + 16 * s + 4 * hh), b = *(const uint2*)(S + row * 72 + 16 * s + 8 + 4 * hh);
  return mk8(a.x, a.y, b.x, b.y);
}
template <int SH, int MODE> DEV void gram(const bf16_t* F, const bf16_t* G, int l31, int hh, Acc64& D) {
  zero_acc<SH>(D);
#pragma unroll
  for (int s = 0; s < 4; ++s) {
    bf16x8 ff[2], gg[2];
#pragma unroll
    for (int t = 0; t < 2; ++t) { ff[t] = nat_frag(F, 32 * t + l31, s, hh); gg[t] = nat_frag(G, 32 * t + l31, s, hh); }
#pragma unroll
    for (int tx = 0; tx < 2; ++tx)
#pragma unroll
      for (int ty = 0; ty < 2; ++ty) if (tile_nz<SH>(tx, ty)) D.t[tx][ty] = mfma32(ff[tx], gg[ty], D.t[tx][ty]);
  }
#pragma unroll
  for (int t = 0; t < 2; ++t)
#pragma unroll
    for (int r = 0; r < 16; ++r) {
      const int x = (r & 3) + 8 * (r >> 2) + 4 * hh, y = l31;
      const bool keep = MODE == 0 ? (x < y) : (MODE == 1 ? (y < x) : (x <= y));
      if (!keep) D.t[t][t][r] = 0.f;
    }
}
template <int SHA> DEV void prod_fm_frag(const Frag64& A, const bf16_t* Mem, int l31, int hh, Frag64& Fo) {
#pragma unroll
  for (int tm = 0; tm < 2; ++tm)
#pragma unroll
    for (int tn = 0; tn < 2; ++tn) {
      f32x16 acc = zero16();
#pragma unroll
      for (int s = 0; s < 4; ++s) if (tile_nz<SHA>(s >> 1, tm)) acc = mfma32(A.f[s][tm], perm_frag(Mem, 32 * tn + l31, s, hh), acc);
      Fo.f[2 * tm][tn] = pack8<0>(acc); Fo.f[2 * tm + 1][tn] = pack8<1>(acc);
    }
}
template <int SHA> DEV void prod_fm(const Frag64& A, const bf16_t* Mem, int l31, int hh, Acc64& D) {
#pragma unroll
  for (int s = 0; s < 4; ++s) {
    bf16x8 mm[2];
#pragma unroll
    for (int t = 0; t < 2; ++t) mm[t] = perm_frag(Mem, 32 * t + l31, s, hh);
#pragma unroll
    for (int tm = 0; tm < 2; ++tm)
#pragma unroll
      for (int tn = 0; tn < 2; ++tn) if (tile_nz<SHA>(s >> 1, tm)) D.t[tm][tn] = mfma32(A.f[s][tm], mm[tn], D.t[tm][tn]);
  }
}
DEV void r1_item(const Prm& p, int L, int idx, char* lds) {
  int tid = threadIdx.x; LAUNDER(tid);
  const int w = __builtin_amdgcn_readfirstlane(tid >> 6);
  int lane = tid & 63, l31 = lane & 31, hh = lane >> 5;
  const int cw = w & 1, tw = w >> 1;
  bf16_t* S0 = (bf16_t*)lds;
  bf16_t* S1 = S0 + 4608; bf16_t* S2 = S1 + 4608; bf16_t* S3 = S2 + 4608; bf16_t* S4 = S3 + 4608; bf16_t* S5 = S4 + 4608; bf16_t* S6 = S5 + 4608; bf16_t* S7 = S6 + 4608;
  float* misc = (float*)(S7 + 4608);
  float* Ef = (float*)S4;
  bool prompt; int st, c, hd;
  if (idx < NRW_P) { prompt = true; st = idx / 260; const int rem = idx - st * 260; c = rem >> 2; hd = rem & 3; }
  else { prompt = false; const int j = idx - NRW_P; st = j >> 2; hd = j & 3; c = 0; }
  char* rwp = p.rw + (size_t)idx * RW_BYTES;
  const float* mu = p.shift_mu + L * 896;
  const int i1 = tid >> 2, m0 = (tid & 3) * 16;
  int R1; bool valid1, hasprev1;
  if (prompt) { const int pp = 64 * c - 48 + i1; valid1 = pp >= 0; R1 = st * PT + (valid1 ? pp : 0); hasprev1 = pp >= 1; }
  else { R1 = NPR + 64 * st + i1; valid1 = true; hasprev1 = i1 >= 1; }
  const bf16_t* zr1 = p.zE + (size_t)R1 * ZE + ZE_ZC;
  const int ti0 = 32 * tw + l31;
  int R; bool valid, hasprev;
  if (prompt) { const int pp = 64 * c - 48 + ti0; valid = pp >= 0; R = st * PT + (valid ? pp : 0); hasprev = pp >= 1; }
  else { R = NPR + 64 * st + ti0; valid = true; hasprev = ti0 >= 1; }
  const bf16_t* zr = p.zE + (size_t)R * ZE + ZE_ZC;
  const int chb = 64 * hd + 32 * cw + 4 * hh;
  uint4 la[2][2], lap[2][2]; uint2 lb[3][4], lbp[3][4];
  {
    const bf16_t* sh0 = p.zE + (size_t)(NT + (prompt ? 32 : st)) * ZE + ZE_ZC;
    const bf16_t* zp1 = hasprev1 ? zr1 - ZE : sh0;
    const bf16_t* zp = hasprev ? zr - ZE : sh0;
#pragma unroll
    for (int part = 0; part < 2; ++part)
#pragma unroll
      for (int h8 = 0; h8 < 2; ++h8) { const int col = 768 + 64 * part + m0 + 8 * h8; la[part][h8] = *(const uint4*)(zr1 + col); lap[part][h8] = *(const uint4*)(zp1 + col); }
#pragma unroll
    for (int part = 0; part < 3; ++part)
#pragma unroll
      for (int G = 0; G < 4; ++G) { const int col = 256 * part + chb + 8 * G; lb[part][G] = *(const uint2*)(zr + col); lbp[part][G] = *(const uint2*)(zp + col); }
    const bf16_t* dsrc = p.dw2T + ((size_t)L * 256 + hd * 64 + i1) * 64 + m0;
    const bf16_t* isrc = p.ia2T + ((size_t)L * 256 + hd * 64 + i1) * 64 + m0;
    const uint4 d0 = *(const uint4*)dsrc, d1 = *(const uint4*)(dsrc + 8), e0 = *(const uint4*)isrc, e1 = *(const uint4*)(isrc + 8);
    __builtin_amdgcn_sched_barrier(0);
    *(uint4*)(S2 + i1 * 72 + m0) = d0; *(uint4*)(S2 + i1 * 72 + m0 + 8) = d1;
    *(uint4*)(S3 + i1 * 72 + m0) = e0; *(uint4*)(S3 + i1 * 72 + m0 + 8) = e1;
  }
  {
    float* prm = misc + 384;
#pragma unroll
    for (int q2 = 0; q2 < 2; ++q2) {
      const int ix = tid + 256 * q2, wh = ix >> 6, chp = ix & 63;
      const float* sp = wh == 0 ? p.decay_w0 : wh == 1 ? p.iclr_a0 : wh == 2 ? p.key_kk : wh == 3 ? p.key_ka : wh == 4 ? p.bonus_rk : nullptr;
      prm[ix] = sp ? sp[L * 256 + hd * 64 + chp] : mu[256 * (wh - 5) + 64 * hd + chp];
    }
  }
#pragma unroll
  for (int part = 0; part < 2; ++part) {
#pragma unroll
    for (int h8 = 0; h8 < 2; ++h8) {
      const int col = 768 + 64 * part + m0 + 8 * h8;
      const uint4 u = la[part][h8], v = lap[part][h8];
      const float cur[8] = {bflo(u.x), bfhi(u.x), bflo(u.y), bfhi(u.y), bflo(u.z), bfhi(u.z), bflo(u.w), bfhi(u.w)};
      float prv[8] = {bflo(v.x), bfhi(v.x), bflo(v.y), bfhi(v.y), bflo(v.z), bfhi(v.z), bflo(v.w), bfhi(v.w)};
      float o[8];
#pragma unroll
      for (int e = 0; e < 8; ++e) { float z = cur[e] + (prv[e] - cur[e]) * mu[col + e]; if (!valid1) z = 0.f; o[e] = part == 0 ? (1.f - 2.f / (__expf(2.f * z) + 1.f)) : z; }
      uint4 a; a.x = pk2(o[0], o[1]); a.y = pk2(o[2], o[3]); a.z = pk2(o[4], o[5]); a.w = pk2(o[6], o[7]);
      *(uint4*)((part == 0 ? S0 : S1) + i1 * 72 + m0 + 8 * h8) = a;
    }
  }
  __syncthreads();
  f32x16 accw = zero16(), acca = zero16();
#pragma unroll
  for (int ks = 0; ks < 4; ++ks) {
    const bf16x8 fw = *(const bf16x8*)(S2 + (32 * cw + l31) * 72 + ks * 16 + hh * 8), fa = *(const bf16x8*)(S3 + (32 * cw + l31) * 72 + ks * 16 + hh * 8);
    const bf16x8 sw = *(const bf16x8*)(S0 + (32 * tw + l31) * 72 + ks * 16 + hh * 8), sa = *(const bf16x8*)(S1 + (32 * tw + l31) * 72 + ks * 16 + hh * 8);
    accw = mfma32(fw, sw, accw); acca = mfma32(fa, sa, acca);
  }
  int ti = ti0;
  float e_[16];
  float ssq = 0.f;
#pragma unroll
  for (int G = 0; G < 4; ++G) {
    const int ch = chb + 8 * G, col = 256 + ch;
    const uint2 u = lb[1][G], v = lbp[1][G];
    const float cur[4] = {bflo(u.x), bfhi(u.x), bflo(u.y), bfhi(u.y)};
    float prv[4] = {bflo(v.x), bfhi(v.x), bflo(v.y), bfhi(v.y)};
    const int chq = 32 * cw + 8 * G + 4 * hh;
    const float4 kkw = *(const float4*)(misc + 384 + 128 + chq), w0 = *(const float4*)(misc + 384 + chq), m4 = *(const float4*)(misc + 384 + 384 + chq);
    const float kkv[4] = {kkw.x, kkw.y, kkw.z, kkw.w}, w0v[4] = {w0.x, w0.y, w0.z, w0.w}, muv[4] = {m4.x, m4.y, m4.z, m4.w};
#pragma unroll
    for (int e = 0; e < 4; ++e) {
      float z = cur[e] + (prv[e] - cur[e]) * muv[e];
      if (!valid) z = 0.f;
      const float kkr = z * kkv[e];
      ssq += kkr * kkr;
      e_[4 * G + e] = valid ? 0.6065306597126334f * sigmoid_(w0v[e] + accw[4 * G + e]) : 0.f;
    }
  }
  ssq += __shfl_xor(ssq, 32);
  if (hh == 0) misc[(cw * 64 + ti) * 2] = ssq;
#pragma unroll
  for (int G = 0; G < 4; ++G)
#pragma unroll
    for (int e = 0; e < 4; ++e) Ef[ti * 65 + 32 * cw + 8 * G + 4 * hh + e] = e_[4 * G + e];
  __syncthreads();
  {
    const int ch = tid & 63, seg = tid >> 6;
    float run = 0.f;
#pragma unroll
    for (int t = 0; t < 16; ++t) { run += Ef[(16 * seg + t) * 65 + ch]; Ef[(16 * seg + t) * 65 + ch] = run; }
    __syncthreads();
    float off = 0.f;
    for (int s2 = 0; s2 < seg; ++s2) off += Ef[(16 * s2 + 15) * 65 + ch];
    __syncthreads();
#pragma unroll
    for (int t = 0; t < 16; ++t) Ef[(16 * seg + t) * 65 + ch] += off;
    if (seg == 3) { const float cC = Ef[63 * 65 + ch]; misc[320 + ch] = cC; misc[256 + ch] = __expf(-cC); }
    __syncthreads();
  }
  float cc_[16];
#pragma unroll
  for (int G = 0; G < 4; ++G)
#pragma unroll
    for (int e = 0; e < 4; ++e) cc_[4 * G + e] = Ef[ti * 65 + 32 * cw + 8 * G + 4 * hh + e];
  const float kinv = 1.f / fmaxf(sqrtf(misc[ti * 2] + misc[(64 + ti) * 2]), 1e-12f);
  __syncthreads();
  LAUNDER(ti); LAUNDER(hh);
  uint2 vpk[4];
  float rk = 0.f;
#pragma unroll
  for (int G = 0; G < 4; ++G) {
    const int ch = chb + 8 * G, chl = 32 * cw + 8 * G + 4 * hh;
    float zs[3][4];
#pragma unroll
    for (int part = 0; part < 3; ++part) {
      const int col = 256 * part + ch;
      const uint2 u = lb[part][G], v = lbp[part][G];
      const float cur[4] = {bflo(u.x), bfhi(u.x), bflo(u.y), bfhi(u.y)};
      float prv[4] = {bflo(v.x), bfhi(v.x), bflo(v.y), bfhi(v.y)};
      const float4 m4 = *(const float4*)(misc + 384 + 320 + 64 * part + chl);
      const float muv[4] = {m4.x, m4.y, m4.z, m4.w};
#pragma unroll
      for (int e = 0; e < 4; ++e) { float z = cur[e] + (prv[e] - cur[e]) * muv[e]; zs[part][e] = valid ? z : 0.f; }
    }
    vpk[G] = pk4(zs[2][0], zs[2][1], zs[2][2], zs[2][3]);
    const float4 a04 = *(const float4*)(misc + 384 + 64 + chl), kk4 = *(const float4*)(misc + 384 + 128 + chl), ka4 = *(const float4*)(misc + 384 + 192 + chl), bo4 = *(const float4*)(misc + 384 + 256 + chl);
    const float a0v[4] = {a04.x, a04.y, a04.z, a04.w}, kkv[4] = {kk4.x, kk4.y, kk4.z, kk4.w}, kav[4] = {ka4.x, ka4.y, ka4.z, ka4.w}, bov[4] = {bo4.x, bo4.y, bo4.z, bo4.w};
    float at[4], rt[4], bt[4], kt[4], bh[4], kh[4];
#pragma unroll
    for (int e = 0; e < 4; ++e) {
      const int r = 4 * G + e;
      const float al = sigmoid_(a0v[e] + acca[r]);
      const float kk = zs[1][e] * kkv[e] * kinv;
      const float km = zs[1][e] * (1.f + (al - 1.f) * kav[e]);
      rk += zs[0][e] * km * bov[e];
      const float gC = misc[256 + chl + e];
      const float cprev = cc_[r] - e_[r];
      const float ea = __expf(-cprev), er = __expf(-cc_[r]), ek = __builtin_amdgcn_rcpf(er), eh = ek * gC;
      const float b = kk * al;
      at[e] = -kk * ea; rt[e] = zs[0][e] * er; bt[e] = b * ek; kt[e] = km * ek; bh[e] = b * eh; kh[e] = km * eh;
    }
    *(uint2*)(S0 + ti * 72 + chl) = pk4(at[0], at[1], at[2], at[3]);
    *(uint2*)(S1 + ti * 72 + chl) = pk4(rt[0], rt[1], rt[2], rt[3]);
    *(uint2*)(S2 + ti * 72 + chl) = pk4(bt[0], bt[1], bt[2], bt[3]);
    *(uint2*)(S3 + ti * 72 + chl) = pk4(kt[0], kt[1], kt[2], kt[3]);
#pragma unroll
    for (int e = 0; e < 4; ++e) { S4[(chl + e) * 72 + ti] = f2bf(at[e]); S5[(chl + e) * 72 + ti] = f2bf(bh[e]); S6[(chl + e) * 72 + ti] = f2bf(kh[e]); S7[(chl + e) * 72 + ti] = f2bf(zs[2][e]); }
    *(uint2*)(rwp + 40960 + (ti * 64 + chl) * 2) = vpk[G];
  }
  rk += __shfl_xor(rk, 32);
  if (hh == 0) misc[(cw * 64 + ti) * 2 + 1] = rk;
  __syncthreads();
  if (valid && cw == 0 && hh == 0) p.rkb[(size_t)R * 4 + hd] = misc[ti * 2 + 1] + misc[(64 + ti) * 2 + 1];
  LAUNDER(l31); LAUNDER(hh); LAUNDER(lane);
  {
    Acc64 T;
    {
      Acc64 Mx, MTx;
      gram<SH_UP, 0>(S2, S0, l31, hh, Mx);
      gram<SH_LO, 1>(S0, S2, l31, hh, MTx);
      Frag64 fM, fMT, fT;
      to_frag<SH_UP>(Mx, fM); to_frag<SH_LO>(MTx, fMT);
      __builtin_amdgcn_sched_barrier(0);
      T = Mx;
#pragma unroll
      for (int t = 0; t < 2; ++t)
#pragma unroll
        for (int r = 0; r < 16; ++r) if ((r & 3) + 8 * (r >> 2) + 4 * hh == l31) T.t[t][t][r] += 1.f;
      T.t[1][0] = zero16();
      for (int r = 0; r < 5; ++r) {
        Frag64 fM2, fMT2;
        prod_ff_frag<SH_LO, SH_UP, SH_UP>(fMT, fM, fM2);
        prod_ff_frag<SH_UP, SH_LO, SH_LO>(fM, fMT, fMT2);
#pragma unroll
        for (int s = 0; s < 4; ++s)
#pragma unroll
          for (int t = 0; t < 2; ++t) { if (tile_nz<SH_UP>(s >> 1, t)) fM.f[s][t] = fM2.f[s][t]; if (tile_nz<SH_LO>(s >> 1, t)) fMT.f[s][t] = fMT2.f[s][t]; }
        to_frag<SH_UP>(T, fT);
        prod_ff<SH_LO, SH_UP>(fMT, fT, T);
      }
    }
    Frag64 fT;
    to_frag<SH_UP>(T, fT);
    __builtin_amdgcn_sched_barrier(0);
    if (w < 2) {
      Frag64 fW;
      prod_fm_frag<SH_UP>(fT, S4, l31, hh, fW);
      __builtin_amdgcn_sched_barrier(0);
      Acc64 O; zero_acc<SH_FULL>(O);
      if (w == 0) {
        prod_fm<SH_FULL>(fW, S5, l31, hh, O);
#pragma unroll
        for (int tx = 0; tx < 2; ++tx)
#pragma unroll
          for (int ty = 0; ty < 2; ++ty)
#pragma unroll
            for (int G = 0; G < 4; ++G) {
              const int x0 = 32 * tx + 8 * G + 4 * hh, y = 32 * ty + l31;
              float v[4];
#pragma unroll
              for (int e = 0; e < 4; ++e) { v[e] = O.t[tx][ty][4 * G + e]; if (x0 + e == y) v[e] += misc[256 + y]; }
              *(uint2*)(rwp + 0 + kperm_addr(y, x0) * 2) = pk4(v[0], v[1], v[2], v[3]);
            }
      } else {
        Acc64 Nb; gram<SH_UP, 2>(S2, S1, l31, hh, Nb);
        Frag64 fN; to_frag<SH_UP>(Nb, fN);
        prod_ff<SH_FULL, SH_UP>(fW, fN, O);
#pragma unroll
        for (int tx = 0; tx < 2; ++tx)
#pragma unroll
          for (int ty = 0; ty < 2; ++ty)
#pragma unroll
            for (int G = 0; G < 4; ++G) {
              const int x0 = 32 * tx + 8 * G + 4 * hh, y = 32 * ty + l31;
              const uint2 rr = *(const uint2*)(S1 + y * 72 + x0);
              *(uint2*)(rwp + 8192 + kperm_addr(y, x0) * 2) = pk4(O.t[tx][ty][4 * G] + bflo(rr.x), O.t[tx][ty][4 * G + 1] + bfhi(rr.x), O.t[tx][ty][4 * G + 2] + bflo(rr.y), O.t[tx][ty][4 * G + 3] + bfhi(rr.y));
            }
      }
    } else {
      Frag64 fX;
      {
        Acc64 Nk; gram<SH_LO, 1>(S0, S3, l31, hh, Nk);
        Frag64 fNk; to_frag<SH_LO>(Nk, fNk);
        prod_ff_frag<SH_UP, SH_LO, SH_LO>(fT, fNk, fX);
      }
      __builtin_amdgcn_sched_barrier(0);
      if (w == 2) {
        Acc64 Z; zero_acc<SH_FULL>(Z);
        prod_fm<SH_LO>(fX, S5, l31, hh, Z);
#pragma unroll
        for (int tx = 0; tx < 2; ++tx)
#pragma unroll
          for (int ty = 0; ty < 2; ++ty)
#pragma unroll
            for (int G = 0; G < 4; ++G) {
              const int x0 = 32 * tx + 8 * G + 4 * hh, y = 32 * ty + l31;
              const uint2 kk2 = *(const uint2*)(S6 + y * 72 + x0);
              Z.t[tx][ty][4 * G] += bflo(kk2.x); Z.t[tx][ty][4 * G + 1] += bfhi(kk2.x); Z.t[tx][ty][4 * G + 2] += bflo(kk2.y); Z.t[tx][ty][4 * G + 3] += bfhi(kk2.y);
            }
        Frag64 fZ; to_frag<SH_FULL>(Z, fZ);
        __builtin_amdgcn_sched_barrier(0);
        Acc64 Q; zero_acc<SH_FULL>(Q);
        prod_fm<SH_FULL>(fZ, S7, l31, hh, Q);
#pragma unroll
        for (int tx = 0; tx < 2; ++tx)
#pragma unroll
          for (int ty = 0; ty < 2; ++ty)
#pragma unroll
            for (int G = 0; G < 4; ++G)
              *(uint2*)(rwp + 16384 + clay_addr(32 * tx + 8 * G + 4 * hh, 32 * ty + l31) * 2) = pk4(Q.t[tx][ty][4 * G], Q.t[tx][ty][4 * G + 1], Q.t[tx][ty][4 * G + 2], Q.t[tx][ty][4 * G + 3]);
      } else {
        Acc64 H; gram<SH_UP, 2>(S3, S1, l31, hh, H);
        {
          Acc64 Nb; gram<SH_UP, 2>(S2, S1, l31, hh, Nb);
          Frag64 fN; to_frag<SH_UP>(Nb, fN);
          prod_ff<SH_LO, SH_UP>(fX, fN, H);
        }
        Frag64 fH; to_frag<SH_UP>(H, fH);
        __builtin_amdgcn_sched_barrier(0);
        Acc64 Y; zero_acc<SH_FULL>(Y);
        prod_fm<SH_UP>(fH, S7, l31, hh, Y);
#pragma unroll
        for (int tx = 0; tx < 2; ++tx)
#pragma unroll
          for (int ty = 0; ty < 2; ++ty)
#pragma unroll
            for (int G = 0; G < 4; ++G)
              *(uint2*)(rwp + 24576 + clay_addr(32 * tx + 8 * G + 4 * hh, 32 * ty + l31) * 2) = pk4(Y.t[tx][ty][4 * G], Y.t[tx][ty][4 * G + 1], Y.t[tx][ty][4 * G + 2], Y.t[tx][ty][4 * G + 3]);
      }
    }
  }
  __syncthreads();
}

DEV void r2_wave(const Prm& p, int L, int wi, int lane) {
  bool prompt; int st, hd, vt;
  if (wi < 64) { prompt = true; st = wi >> 4; hd = (wi >> 2) & 3; vt = wi & 3; }
  else { prompt = false; const int j = wi - 64; st = j >> 4; hd = (j >> 2) & 3; vt = j & 3; }
  const int nch = prompt ? 65 : 1;
  const int idx0 = prompt ? st * 260 + hd : NRW_P + st * 4 + hd;
  const int l16 = lane & 15, g = lane >> 4;
  f32x4 acc[4];
  float* outp;
  if (prompt) {
#pragma unroll
    for (int mt = 0; mt < 4; ++mt) acc[mt] = (f32x4){0.f, 0.f, 0.f, 0.f};
    outp = p.wkv_p + ((((size_t)L * 4 + st) * 4 + hd) * 64 + 16 * vt + l16) * 64;
  } else {
    const float* sp = p.state_wkv + ((((size_t)L * 32 + st) * 4 + hd) * 64 + 16 * vt + l16) * 64;
#pragma unroll
    for (int mt = 0; mt < 4; ++mt) acc[mt] = *(const f32x4*)(sp + 16 * mt + 4 * g);
    outp = p.wkv_s + ((((size_t)L * 32 + st) * 4 + hd) * 64 + 16 * vt + l16) * 64;
  }
  const char* rw0 = p.rw + (size_t)idx0 * RW_BYTES;
  uint4 pf[3][8]; uint2 qv[3][4];
#pragma unroll
  for (int k = 0; k < 3; ++k) {
    const int cc = k < nch ? k : nch - 1;
    const char* src = rw0 + (size_t)cc * 4 * RW_BYTES;
#pragma unroll
    for (int i = 0; i < 8; ++i) pf[k][i] = *(const uint4*)(src + (i * 64 + lane) * 16);
#pragma unroll
    for (int mt = 0; mt < 4; ++mt) qv[k][mt] = *(const uint2*)(src + 16384 + ((mt * 4 + vt) * 64 + lane) * 8);
  }
  for (int c0 = 0; c0 < nch; c0 += 3) {
#pragma unroll
    for (int k = 0; k < 3; ++k) {
      const int c = c0 + k;
      if (c < nch) {
        char* cur = (char*)rw0 + (size_t)c * 4 * RW_BYTES;
        uint4 bfr[2];
#pragma unroll
        for (int s = 0; s < 2; ++s) {
          bfr[s].x = pk2(acc[2 * s][0], acc[2 * s][1]); bfr[s].y = pk2(acc[2 * s][2], acc[2 * s][3]);
          bfr[s].z = pk2(acc[2 * s + 1][0], acc[2 * s + 1][1]); bfr[s].w = pk2(acc[2 * s + 1][2], acc[2 * s + 1][3]);
          *(uint4*)(cur + 32768 + ((vt * 2 + s) * 64 + lane) * 16) = bfr[s];
        }
#pragma unroll
        for (int mt = 0; mt < 4; ++mt) {
          f32x4 a = {bflo(qv[k][mt].x), bfhi(qv[k][mt].x), bflo(qv[k][mt].y), bfhi(qv[k][mt].y)};
#pragma unroll
          for (int s = 0; s < 2; ++s) a = mfma16(mk8(pf[k][mt * 2 + s]), mk8(bfr[s]), a);
          acc[mt] = a;
        }
        const int cn = c + 3 < nch ? c + 3 : nch - 1;
        const char* src = rw0 + (size_t)cn * 4 * RW_BYTES;
#pragma unroll
        for (int i = 0; i < 8; ++i) pf[k][i] = *(const uint4*)(src + (i * 64 + lane) * 16);
#pragma unroll
        for (int mt = 0; mt < 4; ++mt) qv[k][mt] = *(const uint2*)(src + 16384 + ((mt * 4 + vt) * 64 + lane) * 8);
      }
    }
  }
#pragma unroll
  for (int mt = 0; mt < 4; ++mt) *(f32x4*)(outp + 16 * mt + 4 * g) = acc[mt];
}

DEV void r3_wave(const Prm& p, int L, int idx, int lane, float* Y  ) {
  LAUNDER(lane);
  bool prompt; int st, c, hd;
  if (idx < NRW_P) { prompt = true; st = idx / 260; const int rem = idx - st * 260; c = rem >> 2; hd = rem & 3; }
  else { prompt = false; const int j = idx - NRW_P; st = j >> 2; hd = j & 3; c = 0; }
  const char* rwp = p.rw + (size_t)idx * RW_BYTES;
  const int l16 = lane & 15, g = lane >> 4;
  bf16_t* mix = p.zE;
  uint4 sf[4][2];
#pragma unroll
  for (int vt = 0; vt < 4; ++vt)
#pragma unroll
    for (int s = 0; s < 2; ++s) sf[vt][s] = *(const uint4*)(rwp + 32768 + ((vt * 2 + s) * 64 + lane) * 16);
  const float lw[4] = {p.lnx_w[L * 256 + hd * 64 + l16], p.lnx_w[L * 256 + hd * 64 + 16 + l16], p.lnx_w[L * 256 + hd * 64 + 32 + l16], p.lnx_w[L * 256 + hd * 64 + 48 + l16]};
  const float lb[4] = {p.lnx_b[L * 256 + hd * 64 + l16], p.lnx_b[L * 256 + hd * 64 + 16 + l16], p.lnx_b[L * 256 + hd * 64 + 32 + l16], p.lnx_b[L * 256 + hd * 64 + 48 + l16]};
#pragma unroll
  for (int it = 0; it < 4; ++it) {
    f32x4 y[4];
    const uint4 gf0 = *(const uint4*)(rwp + 8192 + ((it * 2 + 0) * 64 + lane) * 16), gf1 = *(const uint4*)(rwp + 8192 + ((it * 2 + 1) * 64 + lane) * 16);
#pragma unroll
    for (int vt = 0; vt < 4; ++vt) {
      const uint2 q = *(const uint2*)(rwp + 24576 + ((it * 4 + vt) * 64 + lane) * 8);
      f32x4 a = {bflo(q.x), bfhi(q.x), bflo(q.y), bfhi(q.y)};
      a = mfma16(mk8(gf0), mk8(sf[vt][0]), a);
      a = mfma16(mk8(gf1), mk8(sf[vt][1]), a);
      y[vt] = a;
    }
    __builtin_amdgcn_sched_barrier(0);
#pragma unroll
    for (int rr = 0; rr < 4; ++rr) {
      const int i = 16 * it + 4 * g + rr;
      float s1 = y[0][rr] + y[1][rr] + y[2][rr] + y[3][rr];
      s1 += __shfl_xor(s1, 1); s1 += __shfl_xor(s1, 2); s1 += __shfl_xor(s1, 4); s1 += __shfl_xor(s1, 8);
      const float mean = s1 * (1.f / 64.f);
      const float d0 = y[0][rr] - mean, d1 = y[1][rr] - mean, d2 = y[2][rr] - mean, d3 = y[3][rr] - mean;
      float s2 = d0 * d0 + d1 * d1 + d2 * d2 + d3 * d3;
      s2 += __shfl_xor(s2, 1); s2 += __shfl_xor(s2, 2); s2 += __shfl_xor(s2, 4); s2 += __shfl_xor(s2, 8);
      const float rstd = rsqrtf(s2 * (1.f / 64.f) + GN_EPS);
      Y[i * 68 + l16] = d0 * rstd * lw[0] + lb[0];
      Y[i * 68 + 16 + l16] = d1 * rstd * lw[1] + lb[1];
      Y[i * 68 + 32 + l16] = d2 * rstd * lw[2] + lb[2];
      Y[i * 68 + 48 + l16] = d3 * rstd * lw[3] + lb[3];
    }
  }
  asm volatile("s_waitcnt lgkmcnt(0)" ::: "memory");
  __builtin_amdgcn_wave_barrier();
  const int vc = (lane & 7) * 8;
#pragma unroll
  for (int ps = 0; ps < 8; ++ps) {
    const int i = 8 * ps + (lane >> 3);
    int R; bool valid;
    if (prompt) { const int pp = 64 * c - 48 + i; valid = pp >= 0; R = st * PT + (valid ? pp : 0); }
    else { R = NPR + 64 * st + i; valid = true; }
    if (valid) {
      const float4 y0 = *(const float4*)(Y + i * 68 + vc), y1 = *(const float4*)(Y + i * 68 + vc + 4);
      const float rkbv = p.rkb[(size_t)R * 4 + hd];
      const uint4 vv = *(const uint4*)(rwp + 40960 + (i * 64 + vc) * 2);
      const uint4 gc = *(const uint4*)(p.zL + (size_t)R * ZL + ZL_GC + hd * 64 + vc);
      uint4 o;
      o.x = pk2((y0.x + rkbv * bflo(vv.x)) * silu_(bflo(gc.x)), (y0.y + rkbv * bfhi(vv.x)) * silu_(bfhi(gc.x)));
      o.y = pk2((y0.z + rkbv * bflo(vv.y)) * silu_(bflo(gc.y)), (y0.w + rkbv * bfhi(vv.y)) * silu_(bfhi(gc.y)));
      o.z = pk2((y1.x + rkbv * bflo(vv.z)) * silu_(bflo(gc.z)), (y1.y + rkbv * bfhi(vv.z)) * silu_(bfhi(gc.z)));
      o.w = pk2((y1.z + rkbv * bflo(vv.w)) * silu_(bflo(gc.w)), (y1.w + rkbv * bfhi(vv.w)) * silu_(bfhi(gc.w)));
      *(uint4*)(mix + (size_t)R * D + 768 + hd * 64 + vc) = o;
    }
  }
  asm volatile("s_waitcnt lgkmcnt(0)" ::: "memory");
  __builtin_amdgcn_wave_barrier();
}

DEV void final_norm(const Prm& p) {
  int tid_ = threadIdx.x; LAUNDER(tid_);
  const int lane = tid_ & 63, gw = blockIdx.x * 4 + (tid_ >> 6), NW = gridDim.x * 4;
  for (int R = gw; R < NT; R += NW) {
    if (R < NPR && (R % PT) < 16) continue;
    float* yr = xrow_ptr(p, R);
    const bf16_t* xr = p.xb + (size_t)R * D;
    const float rstd = rsqrtf(p.ssq_x[2 * NTP + R] * (1.f / 1024.f) + RMS_EPS);
#pragma unroll
    for (int j = 0; j < 2; ++j) {
      const uint4 u = ((const uint4*)xr)[lane + 64 * j];
      const float4 g0 = ((const float4*)p.final_g)[2 * (lane + 64 * j)], g1 = ((const float4*)p.final_g)[2 * (lane + 64 * j) + 1];
      float4 o0, o1;
      o0.x = bflo(u.x) * rstd * g0.x; o0.y = bfhi(u.x) * rstd * g0.y; o0.z = bflo(u.y) * rstd * g0.z; o0.w = bfhi(u.y) * rstd * g0.w;
      o1.x = bflo(u.z) * rstd * g1.x; o1.y = bfhi(u.z) * rstd * g1.y; o1.z = bflo(u.w) * rstd * g1.z; o1.w = bfhi(u.w) * rstd * g1.w;
      ((float4*)yr)[2 * (lane + 64 * j)] = o0; ((float4*)yr)[2 * (lane + 64 * j) + 1] = o1;
    }
  }
}

#define XB_TMO      128
#define XB_XCNT(j)  (256  + 64 * (j))
#define XB_XSUB(j)  (1280 + 64 * (j))
#define XB_XGEN(j)  (2304 + 64 * (j))
#define XB_TOP      3328
#define XB_TOPGEN   3392
#define XCD_BAR_WORDS 3456
#define XB_SPIN_CAP (1u << 20)
#define LAS __attribute__((address_space(3)))
DEV unsigned xb_ld(unsigned* p) { return __hip_atomic_load(p, __ATOMIC_RELAXED, __HIP_MEMORY_SCOPE_AGENT); }
DEV unsigned xb_add(unsigned* p, unsigned v) { return __hip_atomic_fetch_add(p, v, __ATOMIC_RELAXED, __HIP_MEMORY_SCOPE_AGENT); }
DEV unsigned xb_xcc_id() { return (unsigned)__builtin_amdgcn_s_getreg((3 << 11) | 20) & 0xFu; }
#define XB_SPIN(cond, bar) do { unsigned _sp = 0; while (cond) { __builtin_amdgcn_s_sleep(1); \
    if ((++_sp & 255u) == 0u) { if (xb_ld(&(bar)[XB_TMO])) break; if (_sp > XB_SPIN_CAP) { atomicAdd(&(bar)[XB_TMO], 1u); break; } } } } while (0)
struct XcdBarrier { unsigned* bar; unsigned x; volatile LAS unsigned* st; };
DEV XcdBarrier xcd_barrier_post(unsigned* bar, volatile LAS unsigned* st) {
  XcdBarrier b; b.bar = bar; b.x = xb_xcc_id(); b.st = st;
  if (threadIdx.x == 0) (void)xb_add(&bar[XB_XCNT(b.x)], 1u);
  return b;
}
DEV void xcd_barrier_complete(unsigned* bar, unsigned x, unsigned& nloc, unsigned& nx) {
  const unsigned G = gridDim.x * gridDim.y * gridDim.z;
  unsigned sum, cnt, mine, sp = 0u;
  for (;;) {
    sum = 0u; cnt = 0u; mine = 0u;
#pragma unroll
    for (unsigned j = 0; j < 16; ++j) { const unsigned c = xb_ld(&bar[XB_XCNT(j)]); sum += c; cnt += (c > 0u) ? 1u : 0u; mine = (j == x) ? c : mine; }
    if (sum == G) break;
    __builtin_amdgcn_s_sleep(1);
    if ((++sp & 255u) == 0u) { if (xb_ld(&bar[XB_TMO])) break; if (sp > XB_SPIN_CAP) { atomicAdd(&bar[XB_TMO], 1u); break; } }
  }
  nloc = mine > 0u ? mine : 1u; nx = cnt > 0u ? cnt : 1u;
}
DEV void xcd_barrier(const XcdBarrier& b) {
  asm volatile("s_waitcnt vmcnt(0)" ::: "memory");
  __syncthreads();
  if (threadIdx.x == 0) {
    unsigned* bar = b.bar;
    __builtin_amdgcn_s_waitcnt(0);
    unsigned nloc = b.st[0], nx = b.st[1];
    if (nloc == 0u) { xcd_barrier_complete(bar, b.x, nloc, nx); b.st[0] = nloc; b.st[1] = nx; }
    const unsigned old = xb_add(&bar[XB_XSUB(b.x)], 1u);
    const unsigned gen = old / nloc;
    if (old + 1u == (gen + 1u) * nloc) {
      __builtin_amdgcn_fence(__ATOMIC_RELEASE, "agent");
      asm volatile("s_waitcnt vmcnt(0)" ::: "memory");
      const unsigned og = xb_add(&bar[XB_TOP], 1u);
      const unsigned tg = og / nx;
      if (og + 1u == (tg + 1u) * nx) xb_add(&bar[XB_TOPGEN], 1u);
      else XB_SPIN(xb_ld(&bar[XB_TOPGEN]) == tg, bar);
      __builtin_amdgcn_fence(__ATOMIC_ACQUIRE, "agent");
      xb_add(&bar[XB_XGEN(b.x)], 1u);
      asm volatile("s_waitcnt vmcnt(0)" ::: "memory");
    } else {
      XB_SPIN(xb_ld(&bar[XB_XGEN(b.x)]) == gen, bar);
      __builtin_amdgcn_fence(__ATOMIC_ACQUIRE, "agent");
      asm volatile("s_waitcnt vmcnt(0)" ::: "memory");
    }
  }
  __syncthreads();
}

#define QCTR(ph, L) (3584 + 64 * (2 * (ph) + (L)))
#define R2DONE(L) (3520 + 16 * (L))
DEV int next_item(unsigned* ctr, char* lds) {
  volatile int* slot = (volatile int*)(lds + LDS_BYTES - 8);
  __syncthreads();
  if (threadIdx.x == 0) *slot = (int)atomicAdd(ctr, 1u);
  __syncthreads();
  return *slot;
}
#define QXC(ph, L, x) (4096 + (((ph) * 2 + (L)) * 8 + (x)) * 16)
DEV int xq_next(unsigned* ctl, int ph, int L, int C, int N, int& k, int home, char* lds) {
  volatile int* slot = (volatile int*)(lds + LDS_BYTES - 8);
  __syncthreads();
  if (threadIdx.x == 0) {
    int res = -1, kk = k;
    while (kk < 8) {
      const int x = (home + kk) & 7, base = x * C;
      int size = N - base; size = size < C ? size : C;
      if (size > 0) { const int idx = (int)atomicAdd(ctl + QXC(ph, L, x), 1u); if (idx < size) { res = base + idx; break; } }
      ++kk;
    }
    slot[0] = res; slot[1] = kk;
  }
  __syncthreads();
  k = slot[1];
  return slot[0];
}
DEV int q_publish(int ticket, char* lds) {
  volatile int* slot = (volatile int*)(lds + LDS_BYTES - 8);
  __syncthreads();
  if (threadIdx.x == 0) *slot = ticket;
  __syncthreads();
  return *slot;
}
DEV int xq_resolve(unsigned* ctl, int ph, int L, int C, int N, int& k, int home, int ticket, char* lds) {
  volatile int* slot = (volatile int*)(lds + LDS_BYTES - 8);
  __syncthreads();
  if (threadIdx.x == 0) {
    int res = -1, kk = k;
    if (kk < 8) {
      const int x = (home + kk) & 7, base = x * C;
      int size = N - base; size = size < C ? size : C;
      if (ticket < size) res = base + ticket;
      else {
        ++kk;
        while (kk < 8) {
          const int x2 = (home + kk) & 7, base2 = x2 * C;
          int size2 = N - base2; size2 = size2 < C ? size2 : C;
          if (size2 > 0) { const int idx = (int)atomicAdd(ctl + QXC(ph, L, x2), 1u); if (idx < size2) { res = base2 + idx; break; } }
          ++kk;
        }
      }
    }
    slot[0] = res; slot[1] = kk;
  }
  __syncthreads();
  k = slot[1];
  return slot[0];
}
DEV unsigned* xq_ctr(unsigned* ctl, int ph, int L, int k, int home) { return k < 8 ? ctl + QXC(ph, L, (home + k) & 7) : nullptr; }
DEV int take_ticket(unsigned* nctr) { int tk = 0x7fffffff; if (nctr && threadIdx.x == 0) tk = (int)atomicAdd(nctr, 1u); return tk; }
struct XQueue {
  unsigned* ctl; int ph, L, C, N, k, home, t;
  DEV void prefetch() { t = take_ticket(xq_ctr(ctl, ph, L, k, home)); }
  DEV int resolve(char* lds) { return xq_resolve(ctl, ph, L, C, N, k, home, t, lds); }
};
template <class Epi, class Map>
DEV void gemm_stream(const bf16_t* __restrict__ A, int lda, const bf16_t* __restrict__ Bt, int ldb, int K, char* lds, const Epi& epi, XQueue& q) {
  int tid = threadIdx.x; LAUNDER(tid);
  const int lane = tid & 63, w = __builtin_amdgcn_readfirstlane(tid >> 6), wr = w >> 1, wc = w & 1;
  const int fr = lane & 15, fq = lane >> 4;
  const int sb = lane * 16, swz = sb ^ (((sb >> 9) & 1) << 5), rl = swz >> 6, cl = (swz & 63) >> 1;
  const int nk = K / 64;
  int offA[2], offB[2];
#pragma unroll
  for (int kh = 0; kh < 2; ++kh) { offA[kh] = lds_byte(wr * 64 + fr, kh * 32 + fq * 8); offB[kh] = lds_byte(wc * 64 + fr, kh * 32 + fq * 8); }
  q.prefetch();
  int item = q.resolve(lds);
  if (item < 0) return;
  int m0, n0; Map::map(item, m0, n0);
  const bf16_t* ga[4]; const bf16_t* gb[4];
#define SETPTR(M0, N0) { _Pragma("unroll") for (int i = 0; i < 4; ++i) { const int st = 4 * w + i, r = (st >> 1) * 16 + rl, c = (st & 1) * 32 + cl; \
      ga[i] = A + (size_t)((M0) + r) * lda + c; gb[i] = Bt + (size_t)((N0) + r) * ldb + c; } }
#define GSTAGE(S, KT) { _Pragma("unroll") for (int i = 0; i < 4; ++i) { \
      __builtin_amdgcn_global_load_lds((const unsigned*)(ga[i] + (KT) * 64), (LAS3 unsigned*)(lds + (S) * 32768 + (4 * w + i) * 1024 + lane * 16), 16, 0, 0); \
      __builtin_amdgcn_global_load_lds((const unsigned*)(gb[i] + (KT) * 64), (LAS3 unsigned*)(lds + (S) * 32768 + 16384 + (4 * w + i) * 1024 + lane * 16), 16, 0, 0); } }
  SETPTR(m0, n0)
  GSTAGE(0, 0)
  GSTAGE(1, 1)
  for (;;) {
    f32x4 acc[4][4];
#pragma unroll
    for (int i = 0; i < 4; ++i)
#pragma unroll
      for (int j = 0; j < 4; ++j) acc[i][j] = (f32x4){0.f, 0.f, 0.f, 0.f};
    for (int kt = 0; kt < nk; ++kt) {
      const int s = kt & 1;
      if (kt + 1 < nk) asm volatile("s_waitcnt vmcnt(8)" ::: "memory"); else asm volatile("s_waitcnt vmcnt(0)" ::: "memory");
      RAW_BARRIER()
      const char* ia = lds + s * 32768;
      const char* ib = ia + 16384;
      bf16x8 af[2][4], bfv[2][4];
#pragma unroll
      for (int kh = 0; kh < 2; ++kh) {
#pragma unroll
        for (int mi = 0; mi < 4; ++mi) af[kh][mi] = *(const bf16x8*)(ia + offA[kh] + mi * 2048);
#pragma unroll
        for (int ni = 0; ni < 4; ++ni) bfv[kh][ni] = *(const bf16x8*)(ib + offB[kh] + ni * 2048);
      }
      asm volatile("s_waitcnt lgkmcnt(8)" ::: "memory");
      __builtin_amdgcn_sched_barrier(0);
#pragma unroll
      for (int mi = 0; mi < 4; ++mi)
#pragma unroll
        for (int ni = 0; ni < 4; ++ni) acc[mi][ni] = mfma16(bfv[0][ni], af[0][mi], acc[mi][ni]);
      __builtin_amdgcn_sched_barrier(0);
      asm volatile("s_waitcnt lgkmcnt(0)" ::: "memory");
      RAW_BARRIER()
      if (kt + 2 < nk) GSTAGE(s, kt + 2)
      if (kt == nk - 3) q.prefetch();
      __builtin_amdgcn_sched_barrier(0);
#pragma unroll
      for (int mi = 0; mi < 4; ++mi)
#pragma unroll
        for (int ni = 0; ni < 4; ++ni) acc[mi][ni] = mfma16(bfv[1][ni], af[1][mi], acc[mi][ni]);
    }
    const int nxt = q.resolve(lds);
    const typename Epi::Pre pre = epi.preload(m0 + wr * 64, n0 + wc * 64, fr, fq);
    __builtin_amdgcn_sched_barrier(0);
    int m1 = 0, n1 = 0;
    if (nxt >= 0) { Map::map(nxt, m1, n1); SETPTR(m1, n1) GSTAGE(0, 0) GSTAGE(1, 1) }
    __builtin_amdgcn_sched_barrier(0);
    epi.finish(acc, pre, m0 + wr * 64, n0 + wc * 64, fr, fq);
    if (nxt < 0) break;
    m0 = m1; n0 = n1;
  }
#undef GSTAGE
#undef SETPTR
}
struct MapP1 { static DEV void map(int i, int& m0, int& n0) { int mt, nt; if (i < 18 * 192) { const int b = i / 192, r = i - b * 192; nt = r >> 3; mt = 8 * b + (r & 7); } else { nt = i - 18 * 192; mt = 144; } m0 = mt * 128; n0 = nt * 128; } };
struct MapP4 { static DEV void map(int i, int& m0, int& n0) { m0 = (i >> 3) * 128; n0 = (i & 7) * 128; } };
DEV void shift_rows_item(const Prm& p, int L, int b) {
  int tid0 = threadIdx.x; LAUNDER(tid0);
  if (tid0 < 224) {
    float4 v = make_float4(0.f, 0.f, 0.f, 0.f);
    if (b < 32) v = *(const float4*)(p.state_shift + ((size_t)L * 32 + b) * 896 + 4 * tid0);
    *(uint2*)(p.zE + (size_t)(NT + b) * ZE + ZE_ZC + 4 * tid0) = pk4(v.x, v.y, v.z, v.w);
  }
}
constexpr int N_ATT = 1312;
DEV void run_p1(const Prm& p, int L, char* lds) {
  const EpiIn epi{p, L};
  const int home = (int)(xb_xcc_id() & 7u);
  constexpr int N = 145 * 24, C = (N + 7) / 8;
  {
    XQueue q{p.ctl, 0, L, C, N, 0, home, 0};
    gemm_stream<EpiIn, MapP1>(p.xb, D, p.Wb_in + (size_t)L * INP * 1024, 1024, 1024, lds, epi, q);
  }
  unsigned* ctr = p.ctl + QCTR(3, L);
  int t = take_ticket(ctr);
  for (;;) {
    const int mt = q_publish(t, lds);
    if (mt >= 145 + 33) break;
    if (mt >= 145) { t = take_ticket(ctr); shift_rows_item(p, L, mt - 145); continue; }
    t = gemm_tile<EpiIn, 2>(p.xb, D, p.Wb_in + (size_t)L * INP * 1024, 1024, 1024, mt * 128, 24 * 128, lds, epi, ctr);
  }
}
DEV void run_p2(const Prm& p, int L, char* lds) {
  const EpiQ epq{p, L};
  constexpr int N1 = NRW, N2 = N1 + 129, N3 = N2 + 145 * 6, N4 = N3 + 16, N4b = N4 + 512, N5 = N4b + 36;
  const int N6 = L == 0 ? N5 + NWT : N5;
  unsigned* ctr = p.ctl + QCTR(0, L);
  for (;;) {
    const int id = next_item(ctr, lds);
    if (id >= N6) break;
    if (id >= N5) { conv_weights_item(p, 1, id - N5, lds); continue; }
    if (id < N1) r1_item(p, L, id, lds);
    else if (id < N2) kvproj_item(p, L, id - N1, lds);
    else if (id < N3) { const int t = id - N2, mt = t / 6, nt = t - mt * 6; gemm_tile(p.zE + ZE_CQ, ZE, p.Wb_uq + (size_t)L * 768 * 256, 256, 256, mt * 128, nt * 128, lds, epq); }
    else if (id < N4) sample_prep_item(p, L, id - N3);
    else if (id < N4b) lat_item(p, L, id - N4);
    else shift_item(p, L, id - N4b);
  }
}
DEV void run_p3(const Prm& p, int L, char* lds) {
  int tid_ = threadIdx.x; LAUNDER(tid_);
  const int lane = tid_ & 63, w = __builtin_amdgcn_readfirstlane(tid_ >> 6);
  {
    int ndone = 0;
    for (int wi = blockIdx.x * 4 + w; wi < 576; wi += gridDim.x * 4) { r2_wave(p, L, wi, lane); ++ndone; }
    if (blockIdx.x * 4 < 576) {
      asm volatile("s_waitcnt vmcnt(0)" ::: "memory");
      __syncthreads();
      if (threadIdx.x == 0) {
        int tot = 0;
        for (int wi = blockIdx.x * 4; wi < 576; wi += gridDim.x * 4) tot += (576 - wi) < 4 ? (576 - wi) : 4;
        __builtin_amdgcn_fence(__ATOMIC_RELEASE, "agent");
        asm volatile("s_waitcnt vmcnt(0)" ::: "memory");
        __hip_atomic_fetch_add(p.ctl + R2DONE(L), (unsigned)tot, __ATOMIC_RELAXED, __HIP_MEMORY_SCOPE_AGENT);
      }
    }
    (void)ndone;
  }
  unsigned* ctr = p.ctl + QCTR(1, L);
  for (;;) {
    const int q = next_item(ctr, lds);
    if (q >= 128) break;
    attn_sample(p, L, q >> 2, q & 3, lds);
  }
  {
    const int home = (int)(xb_xcc_id() & 7u);
    int k = 0;
    int tx = take_ticket(xq_ctr(p.ctl, 2, L, k, home));
    for (;;) {
      const int i = xq_resolve(p.ctl, 2, L, 128, 1024, k, home, tx, lds);
      if (i < 0) break;
      const int x = i >> 7, j = i & 127, qt = 31 - (j >> 2), pair = 4 * x + (j & 3);
      tx = attn_body<false>(p, L, pair >> 3, pair & 7, qt, lds, xq_ctr(p.ctl, 2, L, k, home));
    }
  }
  unsigned* ctr2 = p.ctl + QCTR(2, L);
  constexpr int NC = (NT + 31) / 32, NQ2 = 32 + NC + NRW / 4;
  bool r2_seen = false;
  for (;;) {
    const int q = next_item(ctr2, lds);
    if (q >= NQ2) break;
    constexpr int NR3 = NRW / 4;
    if (q >= NR3 + 32) conv_item(p, L, q - NR3 - 32);
    else if (q >= NR3) attn_item(p, L, 1280 + q - NR3, lds);
    else {
      if (!r2_seen) {
        if (threadIdx.x == 0) {
          unsigned sp = 0;
          while (__hip_atomic_load(p.ctl + R2DONE(L), __ATOMIC_RELAXED, __HIP_MEMORY_SCOPE_AGENT) < 576u) {
            __builtin_amdgcn_s_sleep(2);
            if (++sp > (1u << 22)) { atomicAdd(&p.ctl[XB_TMO], 1u); break; }
          }
          __builtin_amdgcn_fence(__ATOMIC_ACQUIRE, "agent");
          asm volatile("s_waitcnt vmcnt(0)" ::: "memory");
        }
        __syncthreads();
        r2_seen = true;
      }
      r3_wave(p, L, q * 4 + w, lane, (float*)(lds + w * 17408));
    }
  }
}
DEV void run_p4(const Prm& p, int L, char* lds) {
  const EpiOut epo{p, L};
  const int home = (int)(xb_xcc_id() & 7u);
  {
    XQueue q{p.ctl, 1, L, 128, 1024, 0, home, 0};
    gemm_stream<EpiOut, MapP4>(p.zE  , D, p.Wb_out + (size_t)L * 1024 * 1024, 1024, 1024, lds, epo, q);
  }
  unsigned* ctr = p.ctl + QCTR(3, L) + 16;
  int t = take_ticket(ctr);
  for (;;) {
    const int h = q_publish(t, lds);
    if (h >= 17 * 16) break;
    const int mt = 128 + (h >> 4), r = h & 15;
    t = gemm_tile<EpiOut, 4>(p.zE, D, p.Wb_out + (size_t)L * 1024 * 1024, 1024, 1024, mt * 128, (r >> 1) * 128 + (r & 1) * 64, lds, epo, ctr);
  }
}

__global__ void __launch_bounds__(256, 2) mega(Prm p) {
  extern __shared__ __attribute__((aligned(16))) char lds[];
  volatile LAS unsigned* st = (volatile LAS unsigned*)(lds + LDS_BYTES - 16);
  if (threadIdx.x == 0) { st[0] = 0u; st[1] = 0u; st[2] = 0u; st[3] = 0u; }
  __syncthreads();
  const XcdBarrier xb = xcd_barrier_post(p.ctl, st);
  phase0(p, lds);
  xcd_barrier(xb);
  for (int L = 0; L < 2; ++L) {
    run_p1(p, L, lds); xcd_barrier(xb);
    run_p2(p, L, lds); xcd_barrier(xb);
    run_p3(p, L, lds); xcd_barrier(xb);
    run_p4(p, L, lds); xcd_barrier(xb);
  }
  final_norm(p);
}

static size_t al256(size_t x) { return (x + 255) & ~(size_t)255; }
extern "C" void kernel_launch(void* const* d_in, const int* in_sizes, int n_in, void* d_out, int out_size, void* d_ws, size_t ws_size, hipStream_t stream) {
  Prm p{};
  const float* const* in = (const float* const*)d_in;
  p.x_prompt = in[0]; p.x_sample = in[1]; p.cache_ckv = in[2]; p.cache_krope = in[3]; p.state_conv = in[4]; p.state_shift = in[5]; p.state_wkv = in[6];
  p.meta = in[7]; p.norm_g = in[8]; p.w_in = in[9]; p.conv_w = in[10]; p.q_norm_g = in[11]; p.w_uq = in[12]; p.kv_norm_g = in[13]; p.w_ukv = in[14];
  p.shift_mu = in[15]; p.decay_w0 = in[16]; p.decay_w2 = in[17]; p.iclr_a0 = in[18]; p.iclr_a2 = in[19]; p.key_kk = in[20]; p.key_ka = in[21];
  p.bonus_rk = in[22]; p.lnx_w = in[23]; p.lnx_b = in[24]; p.w_out = in[25]; p.final_g = in[26];
  float* o = (float*)d_out;
  p.y_prompt = o; o += (size_t)4 * 4096 * 1024;
  p.y_sample = o; o += (size_t)32 * 64 * 1024;
  p.ckv_p = o; o += (size_t)2 * 4 * PT * 128;
  p.kr_p = o; o += (size_t)2 * 4 * PT * 32;
  p.conv_p = o; o += 2 * 4 * 2 * 256;
  p.shift_p = o; o += 2 * 4 * 896;
  p.wkv_p = o; o += 2 * 4 * 4 * 64 * 64;
  p.ckv_s = o; o += (size_t)2 * 32 * 64 * 128;
  p.kr_s = o; o += 2 * 32 * 64 * 32;
  p.conv_s = o; o += 2 * 32 * 2 * 256;
  p.shift_s = o; o += 2 * 32 * 896;
  p.wkv_s = o; o += 2 * 32 * 4 * 64 * 64;
  char* w = (char*)d_ws; size_t off = 0;
  auto take = [&](size_t bytes) { char* r = w + off; off = al256(off + bytes); return r; };
  p.ctl = (unsigned*)take(65536);
  p.Wb_in = (bf16_t*)take((size_t)2 * INP * 1024 * 2);
  p.Wb_uq = (bf16_t*)take((size_t)2 * 768 * 256 * 2);
  p.Wb_ukv = (bf16_t*)take((size_t)2 * 1024 * 128 * 2);
  p.Wb_out = (bf16_t*)take((size_t)2 * 1024 * 1024 * 2);
  p.dw2T = (bf16_t*)take((size_t)2 * 256 * 64 * 2);
  p.ia2T = (bf16_t*)take((size_t)2 * 256 * 64 * 2);
  p.ropec = (float*)take((size_t)PT * 16 * 4);
  p.ropes = (float*)take((size_t)PT * 16 * 4);
  p.ssq_x = (float*)take((size_t)7 * NTP * 4);
  p.ssq_q = p.ssq_x + 3 * NTP; p.ssq_kv = p.ssq_x + 5 * NTP;
  p.rkb = (float*)take((size_t)NTP * 4 * 4);
  p.xmeta = (float*)take((size_t)64 * 1024 * 4);
  p.zE = (bf16_t*)take((size_t)NTP * ZE * 2);
  p.zL = (bf16_t*)take((size_t)NTP * ZL * 2);
  p.xb = (bf16_t*)take((size_t)(NTP + 128) * D * 2);
  p.Kn = (bf16_t*)take((size_t)KVR * 512 * 2);
  p.Vt = (bf16_t*)take((size_t)512 * KVR * 2);
  p.Kr = (bf16_t*)take((size_t)KVR * 32 * 2);
  p.rw = take((size_t)NRW * RW_BYTES);
  p.KL = (bf16_t*)((char*)p.y_prompt + ((size_t)32 << 20));
  p.VLT = p.KL + (size_t)32 * SKEYS * 160;
  static int grid = 0;
  if (grid == 0) {
    if (off > ws_size) { fprintf(stderr, "kernel_launch: workspace too small: need %zu have %zu\n", off, ws_size); grid = -1; return; }
    int dev = 0, cus = 0, per_cu = 0;
    (void)hipGetDevice(&dev);
    (void)hipDeviceGetAttribute(&cus, hipDeviceAttributeMultiprocessorCount, dev);
    (void)hipFuncSetAttribute((const void*)mega, hipFuncAttributeMaxDynamicSharedMemorySize, LDS_BYTES);
    (void)hipOccupancyMaxActiveBlocksPerMultiprocessor(&per_cu, (const void*)mega, 256, LDS_BYTES);
    if (per_cu > 2) per_cu = 2;
    if (per_cu < 1) { fprintf(stderr, "kernel_launch: occupancy query returned %d\n", per_cu); per_cu = 1; }
    grid = cus * per_cu;
  }
  if (grid < 0) return;
  (void)hipMemsetAsync(p.ctl, 0, 8192 * 4, stream);
  void* args[] = {&p};
  hipError_t e = hipLaunchCooperativeKernel((const void*)mega, dim3(grid), dim3(256), args, LDS_BYTES, stream);
  if (e != hipSuccess) fprintf(stderr, "cooperative launch failed: %s (grid %d)\n", hipGetErrorString(e), grid);
}
```

```cpp
#include <hip/hip_runtime.h>
#include <cstdio>
#include <cstdint>
#include <type_traits>

typedef unsigned short bf16_t;
typedef short bf16x8 __attribute__((ext_vector_type(8)));
typedef float f32x4 __attribute__((ext_vector_type(4)));
typedef float f32x16 __attribute__((ext_vector_type(16)));
#define DEV __device__ __forceinline__
#define LAUNDER(x) asm volatile("" : "+v"(x))

constexpr int D = 1024;
constexpr int PT = 4112;
constexpr int NPR = 4 * PT;
constexpr int NSM = 32 * 64;
constexpr int NT = NPR + NSM;
constexpr int NTP = 18560;
constexpr int ZL = 1792;
constexpr int ZE = 1312;
constexpr int ZE_CQ = 0, ZE_CKV = 256, ZE_KR = 384, ZE_ZC = 416;
constexpr int ZL_XIN = 0, ZL_BG = 256, ZL_CG = 512, ZL_GA = 768, ZL_GB = 1024, ZL_GC = 1536;
constexpr int INP = 3200;
constexpr int KVR = 16512;
constexpr int NRW_P = 4 * 65 * 4;
constexpr int NRW = NRW_P + 32 * 4;
constexpr int RW_BYTES = 49152;
constexpr float RMS_EPS = 1e-6f;
constexpr float GN_EPS = 64e-5f;
constexpr int LDS_BYTES = 79872;
constexpr int SKEYS = 1088;

struct Prm {
  const float *x_prompt, *x_sample, *cache_ckv, *cache_krope, *state_conv, *state_shift, *state_wkv, *meta, *norm_g, *w_in,
      *conv_w, *q_norm_g, *w_uq, *kv_norm_g, *w_ukv, *shift_mu, *decay_w0, *decay_w2, *iclr_a0, *iclr_a2, *key_kk, *key_ka,
      *bonus_rk, *lnx_w, *lnx_b, *w_out, *final_g;
  float *y_prompt, *y_sample, *ckv_p, *kr_p, *conv_p, *shift_p, *wkv_p, *ckv_s, *kr_s, *conv_s, *shift_s, *wkv_s;
  unsigned* ctl;
  bf16_t *Wb_in, *Wb_uq, *Wb_ukv, *Wb_out, *dw2T, *ia2T;
  float *ropec, *ropes, *ssq_x, *ssq_q, *ssq_kv, *rkb, *xmeta;
  bf16_t *KL, *VLT;
  bf16_t *zE, *zL, *xb, *Kn, *Vt, *Kr;
  char* rw;
};

DEV float bf2f(bf16_t b) { return __uint_as_float((unsigned)b << 16); }
DEV float bflo(unsigned u) { return __uint_as_float(u << 16); }
DEV float bfhi(unsigned u) { return __uint_as_float(u & 0xffff0000u); }
typedef __bf16 hbf16x2_t __attribute__((ext_vector_type(2)));
typedef float hf32x2_t __attribute__((ext_vector_type(2)));
DEV unsigned pk2(float a, float b) { hf32x2_t f = {a, b}; hbf16x2_t r = __builtin_convertvector(f, hbf16x2_t); return __builtin_bit_cast(unsigned, r); }
DEV bf16_t f2bf(float f) { return (bf16_t)(pk2(f, 0.f) & 0xffffu); }
DEV uint2 pk4(float a, float b, float c, float d) { uint2 r; r.x = pk2(a, b); r.y = pk2(c, d); return r; }
DEV float sigmoid_(float x) { return 1.f / (1.f + __expf(-x)); }
DEV float silu_(float x) { return x / (1.f + __expf(-x)); }
DEV float wave_sum(float v) {
#pragma unroll
  for (int o = 1; o < 64; o <<= 1) v += __shfl_xor(v, o);
  return v;
}
DEV f32x16 mfma32(bf16x8 a, bf16x8 b, f32x16 c) { return __builtin_amdgcn_mfma_f32_32x32x16_bf16(a, b, c, 0, 0, 0); }
DEV f32x4 mfma16(bf16x8 a, bf16x8 b, f32x4 c) { return __builtin_amdgcn_mfma_f32_16x16x32_bf16(a, b, c, 0, 0, 0); }
DEV bf16x8 mk8(unsigned a, unsigned b, unsigned c, unsigned d) { uint4 u; u.x = a; u.y = b; u.z = c; u.w = d; return __builtin_bit_cast(bf16x8, u); }
DEV bf16x8 mk8(uint4 u) { return __builtin_bit_cast(bf16x8, u); }
DEV f32x16 zero16() { f32x16 z; for (int i = 0; i < 16; ++i) z[i] = 0.f; return z; }

DEV float* xrow_ptr(const Prm& p, int R) {
  if (R < NPR) { int s = R / PT, q = R - s * PT; return q < 16 ? p.xmeta + (size_t)(s * 16 + q) * D : p.y_prompt + ((size_t)s * 4096 + (q - 16)) * D; }
  return p.y_sample + (size_t)(R - NPR) * D;
}
DEV const float* xin_ptr(const Prm& p, int R) {
  if (R < NPR) { int s = R / PT, q = R - s * PT; return q < 16 ? p.meta + (size_t)q * D : p.x_prompt + ((size_t)s * 4096 + (q - 16)) * D; }
  return p.x_sample + (size_t)(R - NPR) * D;
}
DEV int pos_of(int R) { return R < NPR ? R % PT : 1024 + ((R - NPR) & 63); }

DEV int win_src_col(int n) {
  if (n < 1024) return n;
  if (n < 1536) return 1440 + (n - 1024);
  if (n < 1792) return 2848 + (n - 1536);
  if (n < 2208) return 1024 + (n - 1792);
  if (n < 3104) return 1952 + (n - 2208);
  return -1;
}
DEV int perm32(int rho) { const int n = rho >> 4, i = rho & 15; return 8 * (i >> 2) + 4 * n + (i & 3); }
template <bool PERM, bool P32>
DEV void conv_weight_tile(const float* __restrict__ src, int K, int N, int Npad, bf16_t* __restrict__ dst, const float* __restrict__ sk, float cst, int l, int item, float* T  , int tid) {
  const int ntn = Npad / 64, ntk = K / 64;
  const int r = item, kt = r / ntn, nt = r - kt * ntn;
  const int k0 = kt * 64, n0 = nt * 64;
  {
    const int nslot = n0 + (tid & 15) * 4;
    const int nn = P32 ? (nslot & ~31) + perm32(nslot & 31) : nslot;
    const int sn = PERM ? win_src_col(nn) : (nn < N ? nn : -1);
#pragma unroll
    for (int i = 0; i < 4; ++i) {
      const int k = (tid >> 4) + 16 * i;
      float4 v = make_float4(0.f, 0.f, 0.f, 0.f);
      if (sn >= 0) {
        v = *(const float4*)(src + ((size_t)l * K + k0 + k) * N + sn);
        const float s = (sk ? sk[l * K + k0 + k] : 1.f) * cst;
        v.x *= s; v.y *= s; v.z *= s; v.w *= s;
      }
      float* t = T + k * 65 + (tid & 15) * 4;
      t[0] = v.x; t[1] = v.y; t[2] = v.z; t[3] = v.w;
    }
  }
  __syncthreads();
  {
    const int n = tid >> 2, kc = tid & 3;
    float v[16];
#pragma unroll
    for (int j = 0; j < 16; ++j) v[j] = T[(16 * kc + j) * 65 + n];
    uint4 o0, o1;
    o0.x = pk2(v[0], v[1]); o0.y = pk2(v[2], v[3]); o0.z = pk2(v[4], v[5]); o0.w = pk2(v[6], v[7]);
    o1.x = pk2(v[8], v[9]); o1.y = pk2(v[10], v[11]); o1.z = pk2(v[12], v[13]); o1.w = pk2(v[14], v[15]);
    bf16_t* d = dst + ((size_t)l * Npad + n0 + n) * K + k0 + 16 * kc;
    *(uint4*)d = o0; *(uint4*)(d + 8) = o1;
  }
  __syncthreads();
}
constexpr int WT0 = 16 * 50, WT1 = WT0 + 16 * 16, WT2 = WT1 + 4 * 12, WT3 = WT2 + 2 * 16, WT4 = WT3 + 4, NWT = WT4 + 4;
DEV void conv_weights_item(const Prm& p, int l, int it, char* lds) {
  float* T = (float*)lds;
  int tid = threadIdx.x; LAUNDER(tid);
  if (it < WT0) conv_weight_tile<true, true>(p.w_in, 1024, 3104, INP, p.Wb_in, p.norm_g, 1.f, l, it, T, tid);
  else if (it < WT1) conv_weight_tile<false, true>(p.w_out, 1024, 1024, 1024, p.Wb_out, nullptr, 1.f, l, it - WT0, T, tid);
  else if (it < WT2) conv_weight_tile<false, false>(p.w_uq, 256, 768, 768, p.Wb_uq, p.q_norm_g, 0.10206207261596575f * 1.4426950408889634f, l, it - WT1, T, tid);
  else if (it < WT3) conv_weight_tile<false, false>(p.w_ukv, 128, 1024, 1024, p.Wb_ukv, nullptr, 1.f, l, it - WT2, T, tid);
  else if (it < WT4) conv_weight_tile<false, false>(p.decay_w2, 64, 256, 256, p.dw2T, nullptr, 1.f, l, it - WT3, T, tid);
  else conv_weight_tile<false, false>(p.iclr_a2, 64, 256, 256, p.ia2T, nullptr, 1.f, l, it - WT4, T, tid);
}
DEV void phase0(const Prm& p, char* lds) {
  int tid = threadIdx.x; LAUNDER(tid);
  const int lane = tid & 63, wv = tid >> 6;
  const int gw = blockIdx.x * 4 + wv, NW = gridDim.x * 4;
  const int gt = blockIdx.x * 256 + tid, NTH = gridDim.x * 256;
  for (int R = gw; R < NT; R += NW) {
    const float* src = xin_ptr(p, R);
    float ss = 0.f;
#pragma unroll
    for (int j = 0; j < 4; ++j) {
      const float4 v = ((const float4*)src)[lane + 64 * j];
      ss += v.x * v.x + v.y * v.y + v.z * v.z + v.w * v.w;
      ((uint2*)(p.xb + (size_t)R * D))[lane + 64 * j] = pk4(v.x, v.y, v.z, v.w);
    }
    ss = wave_sum(ss);
    if (lane == 0) p.ssq_x[R] = ss;
  }
  for (int i = gt; i < 6 * NTP; i += NTH) p.ssq_x[NTP + i] = 0.f;
  for (int it = blockIdx.x; it < NWT; it += gridDim.x) conv_weights_item(p, 0, it, lds);
  for (int i = gt; i < PT * 16; i += NTH) {
    const int pos = i >> 4, j = i & 15;
    const float inv = powf(10000.f, -(float)j * 2.0f / 32.f);
    const float ang = (float)pos * inv;
    double a = (double)ang;
    a -= 6.283185307179586476925 * rint(a * 0.15915494309189533577);
    p.ropec[i] = (float)cos(a);
    p.ropes[i] = (float)sin(a);
  }
}

#define LAS3 __attribute__((address_space(3)))
#define RAW_BARRIER() { asm volatile("" ::: "memory"); __builtin_amdgcn_s_barrier(); asm volatile("" ::: "memory"); }
DEV int lds_byte(int r, int c) { const int st = (r >> 4) * 2 + (c >> 5), rr = r & 15, cc = c & 31, ob = rr * 64 + cc * 2; return st * 1024 + (ob ^ (((ob >> 9) & 1) << 5)); }
template <class Epi, int NB = 8>
DEV int gemm_tile(const bf16_t* __restrict__ A, int lda, const bf16_t* __restrict__ Bt, int ldb, int K, int m0, int n0, char* lds, const Epi& epi, unsigned* nctr = nullptr) {
  int tid = threadIdx.x; LAUNDER(tid);
  const int lane = tid & 63, w = __builtin_amdgcn_readfirstlane(tid >> 6), wr = w >> 1, wc = w & 1;
  const int fr = lane & 15, fq = lane >> 4;
  const int sb = lane * 16, swz = sb ^ (((sb >> 9) & 1) << 5), rl = swz >> 6, cl = (swz & 63) >> 1;
  const bf16_t* ga[4]; const bf16_t* gb[4];
#pragma unroll
  for (int i = 0; i < 4; ++i) {
    const int st = 4 * w + i, r = (st >> 1) * 16 + rl, c = (st & 1) * 32 + cl;
    ga[i] = A + (size_t)(m0 + r) * lda + c;
    gb[i] = Bt + (size_t)(n0 + r) * ldb + c;
  }
  const int nk = K / 64;
#define GSTAGE(S, KT) { _Pragma("unroll") for (int i = 0; i < 4; ++i) { \
      __builtin_amdgcn_global_load_lds((const unsigned*)(ga[i] + (KT) * 64), (LAS3 unsigned*)(lds + (S) * 32768 + (4 * w + i) * 1024 + lane * 16), 16, 0, 0); \
      if (2 * w + (i >> 1) < NB) __builtin_amdgcn_global_load_lds((const unsigned*)(gb[i] + (KT) * 64), (LAS3 unsigned*)(lds + (S) * 32768 + 16384 + (4 * w + i) * 1024 + lane * 16), 16, 0, 0); } }
  f32x4 acc[4][4];
#pragma unroll
  for (int i = 0; i < 4; ++i)
#pragma unroll
    for (int j = 0; j < 4; ++j) acc[i][j] = (f32x4){0.f, 0.f, 0.f, 0.f};
  int offA[2], offB[2];
#pragma unroll
  for (int kh = 0; kh < 2; ++kh) { offA[kh] = lds_byte(wr * 64 + fr, kh * 32 + fq * 8); offB[kh] = lds_byte(wc * 64 + fr, kh * 32 + fq * 8); }
  GSTAGE(0, 0)
  if (nk > 1) GSTAGE(1, 1)
  for (int kt = 0; kt < nk; ++kt) {
    const int s = kt & 1;
    if (kt + 1 < nk) { if (2 * w < NB) asm volatile("s_waitcnt vmcnt(8)" ::: "memory"); else asm volatile("s_waitcnt vmcnt(4)" ::: "memory"); }
    else asm volatile("s_waitcnt vmcnt(0)" ::: "memory");
    RAW_BARRIER()
    const char* ia = lds + s * 32768;
    const char* ib = ia + 16384;
    bf16x8 af[2][4], bfv[2][4];
#pragma unroll
    for (int kh = 0; kh < 2; ++kh) {
#pragma unroll
      for (int mi = 0; mi < 4; ++mi) af[kh][mi] = *(const bf16x8*)(ia + offA[kh] + mi * 2048);
#pragma unroll
      for (int ni = 0; ni < (NB < 4 ? NB : 4); ++ni) bfv[kh][ni] = *(const bf16x8*)(ib + offB[kh] + ni * 2048);
    }
    asm volatile("s_waitcnt lgkmcnt(%0)" :: "n"(4 + (NB < 4 ? NB : 4)) : "memory");
    __builtin_amdgcn_sched_barrier(0);
    if (NB == 8 || wc == 0) {
#pragma unroll
      for (int mi = 0; mi < 4; ++mi)
#pragma unroll
        for (int ni = 0; ni < (NB < 4 ? NB : 4); ++ni) acc[mi][ni] = mfma16(bfv[0][ni], af[0][mi], acc[mi][ni]);
    }
    __builtin_amdgcn_sched_barrier(0);
    asm volatile("s_waitcnt lgkmcnt(0)" ::: "memory");
    RAW_BARRIER()
    if (kt + 2 < nk) GSTAGE(s, kt + 2)
    __builtin_amdgcn_sched_barrier(0);
    if (NB == 8 || wc == 0) {
#pragma unroll
      for (int mi = 0; mi < 4; ++mi)
#pragma unroll
        for (int ni = 0; ni < (NB < 4 ? NB : 4); ++ni) acc[mi][ni] = mfma16(bfv[1][ni], af[1][mi], acc[mi][ni]);
    }
  }
  __syncthreads();
#undef GSTAGE
  int tk = 0x7fffffff; if (nctr && tid == 0) tk = (int)atomicAdd(nctr, 1u);
  if (NB == 8 || wc == 0) epi(acc, m0 + wr * 64, n0 + wc * 64, fr, fq);
  return tk;
}

DEV int lds_byte32(int r, int c) { const int rr = r & 15, ob = rr * 64 + c * 2; return (r >> 4) * 1024 + (ob ^ (((ob >> 9) & 1) << 5)); }
template <class Epi>
DEV void gemm_tile_big(const bf16_t* __restrict__ A, int lda, const bf16_t* __restrict__ Bt, int ldb, int K, int m0, int n0, char* lds, const Epi& epi) {
  int tid = threadIdx.x; LAUNDER(tid);
  const int lane = tid & 63, w = __builtin_amdgcn_readfirstlane(tid >> 6), wr = w >> 1, wc = w & 1;
  const int fr = lane & 15, fq = lane >> 4;
  const int sb = lane * 16, swz = sb ^ (((sb >> 9) & 1) << 5), rl = swz >> 6, cl = (swz & 63) >> 1;
  const bf16_t* ga[4]; const bf16_t* gb[2];
#pragma unroll
  for (int i = 0; i < 4; ++i) ga[i] = A + (size_t)(m0 + (4 * w + i) * 16 + rl) * lda + cl;
#pragma unroll
  for (int i = 0; i < 2; ++i) gb[i] = Bt + (size_t)(n0 + (2 * w + i) * 16 + rl) * ldb + cl;
  const int nk = K / 32;
#define GSTAGE3(S, KT) { _Pragma("unroll") for (int i = 0; i < 4; ++i) \
      __builtin_amdgcn_global_load_lds((const unsigned*)(ga[i] + (KT) * 32), (LAS3 unsigned*)(lds + (S) * 24576 + (4 * w + i) * 1024 + lane * 16), 16, 0, 0); \
    _Pragma("unroll") for (int i = 0; i < 2; ++i) \
      __builtin_amdgcn_global_load_lds((const unsigned*)(gb[i] + (KT) * 32), (LAS3 unsigned*)(lds + (S) * 24576 + 16384 + (2 * w + i) * 1024 + lane * 16), 16, 0, 0); }
  f32x4 acc[8][4];
#pragma unroll
  for (int i = 0; i < 8; ++i)
#pragma unroll
    for (int j = 0; j < 4; ++j) acc[i][j] = (f32x4){0.f, 0.f, 0.f, 0.f};
  const int offA = lds_byte32(wr * 128 + fr, fq * 8), offB = 16384 + lds_byte32(wc * 64 + fr, fq * 8);
  GSTAGE3(0, 0)
  if (nk > 1) GSTAGE3(1, 1)
  int s = 0;
  for (int kt = 0; kt < nk; ++kt) {
    if (kt + 1 < nk) asm volatile("s_waitcnt vmcnt(6)" ::: "memory"); else asm volatile("s_waitcnt vmcnt(0)" ::: "memory");
    RAW_BARRIER()
    if (kt + 2 < nk) { const int s2 = s + 2 >= 3 ? s - 1 : s + 2; GSTAGE3(s2, kt + 2) }
    const char* im = lds + s * 24576;
    bf16x8 af[8], bfv[4];
#pragma unroll
    for (int ni = 0; ni < 4; ++ni) bfv[ni] = *(const bf16x8*)(im + offB + ni * 1024);
#pragma unroll
    for (int mi = 0; mi < 8; ++mi) af[mi] = *(const bf16x8*)(im + offA + mi * 1024);
#pragma unroll
    for (int mi = 0; mi < 8; ++mi)
#pragma unroll
      for (int ni = 0; ni < 4; ++ni) acc[mi][ni] = mfma16(bfv[ni], af[mi], acc[mi][ni]);
    s = s + 1 >= 3 ? 0 : s + 1;
  }
  __syncthreads();
#undef GSTAGE3
  epi(acc, m0 + wr * 128, n0 + wc * 64, fr, fq);
}

struct EpiIn {
  const Prm& p; int L;
  struct Pre { float s[4]; };
  DEV Pre preload(int mb, int nb, int fr, int fq) const {
    Pre r;
#pragma unroll
    for (int mi = 0; mi < 4; ++mi) r.s[mi] = p.ssq_x[L * NTP + mb + 16 * mi + fr];
    return r;
  }
  DEV void operator()(f32x4 (&acc)[4][4], int mb, int nb, int fr, int fq) const { finish(acc, preload(mb, nb, fr, fq), mb, nb, fr, fq); }
  DEV void finish(f32x4 (&acc)[4][4], const Pre& pre, int mb, int nb, int fr, int fq) const {
#pragma unroll
    for (int mi = 0; mi < 4; ++mi) {
      const int m = mb + 16 * mi + fr;
      const bool ok = m < NT;
      const float rstd = rsqrtf(pre.s[mi] * (1.f / 1024.f) + RMS_EPS);
      float sq = 0.f;
#pragma unroll
      for (int g = 0; g < 2; ++g) {
        const int n0 = nb + 32 * g;
        if (n0 >= 3104) continue;
        bf16_t* dst = n0 < ZL ? p.zL + (size_t)m * ZL + n0 : p.zE + (size_t)m * ZE + (n0 - ZL);
        float v[8];
#pragma unroll
        for (int j = 0; j < 4; ++j) { v[j] = acc[mi][2 * g][j] * rstd; v[4 + j] = acc[mi][2 * g + 1][j] * rstd; }
#pragma unroll
        for (int j = 0; j < 8; ++j) sq += v[j] * v[j];
        if (ok) { uint4 o; o.x = pk2(v[0], v[1]); o.y = pk2(v[2], v[3]); o.z = pk2(v[4], v[5]); o.w = pk2(v[6], v[7]); *(uint4*)(dst + 8 * fq) = o; }
      }
      if (nb >= ZL && nb < ZL + 384) {
        sq += __shfl_xor(sq, 16); sq += __shfl_xor(sq, 32);
        if (fq == 0 && ok) atomicAdd((nb < ZL + 256 ? p.ssq_q : p.ssq_kv) + L * NTP + m, sq);
      }
    }
  }
};
struct EpiQ {
  const Prm& p; int L;
  DEV void operator()(f32x4 (&acc)[4][4], int mb, int nb, int fr, int fq) const {
    bf16_t* Qb = (bf16_t*)p.y_prompt;
#pragma unroll
    for (int mi = 0; mi < 4; ++mi) {
      const int m = mb + 16 * mi + fr;
      const bool ok = m < NT;
      const float rstd = rsqrtf(p.ssq_q[L * NTP + m] * (1.f / 256.f) + RMS_EPS);
      const int pos = pos_of(ok ? m : 0);
#pragma unroll
      for (int np = 0; np < 2; ++np) {
        const int n0 = nb + 32 * np;
        float v[2][4];
#pragma unroll
        for (int h2 = 0; h2 < 2; ++h2)
#pragma unroll
          for (int j = 0; j < 4; ++j) v[h2][j] = acc[mi][2 * np + h2][j] * rstd;
        if (((n0 >> 5) % 3) == 2) {
#pragma unroll
          for (int j = 0; j < 4; ++j) {
            const int c = 4 * fq + j;
            const float cs = p.ropec[pos * 16 + c], sn = p.ropes[pos * 16 + c];
            const float x1 = v[0][j], x2 = v[1][j];
            v[0][j] = x1 * cs - x2 * sn; v[1][j] = x1 * sn + x2 * cs;
          }
        }
        if (ok) {
          *(uint2*)(Qb + (size_t)m * 768 + n0 + 4 * fq) = pk4(v[0][0], v[0][1], v[0][2], v[0][3]);
          *(uint2*)(Qb + (size_t)m * 768 + n0 + 16 + 4 * fq) = pk4(v[1][0], v[1][1], v[1][2], v[1][3]);
        }
      }
    }
  }
};
struct EpiOut {
  const Prm& p; int L;
  struct Pre { uint4 x[4][2]; };
  DEV Pre preload(int mb, int nb, int fr, int fq) const {
    Pre r;
#pragma unroll
    for (int mi = 0; mi < 4; ++mi) {
      const int m = mb + 16 * mi + fr;
      const bf16_t* xr = p.xb + (size_t)(m < NT ? m : 0) * D;
#pragma unroll
      for (int g = 0; g < 2; ++g) r.x[mi][g] = *(const uint4*)(xr + nb + 32 * g + 8 * fq);
    }
    return r;
  }
  DEV void operator()(f32x4 (&acc)[4][4], int mb, int nb, int fr, int fq) const { finish(acc, preload(mb, nb, fr, fq), mb, nb, fr, fq); }
  DEV void finish(f32x4 (&acc)[4][4], const Pre& pre, int mb, int nb, int fr, int fq) const {
#pragma unroll
    for (int mi = 0; mi < 4; ++mi) {
      const int m = mb + 16 * mi + fr;
      const bool ok = m < NT;
      bf16_t* xr = p.xb + (size_t)(ok ? m : 0) * D;
      float ss = 0.f;
#pragma unroll
      for (int g = 0; g < 2; ++g) {
        const int col = nb + 32 * g + 8 * fq;
        const uint4 xi = pre.x[mi][g];
        float v[8] = {bflo(xi.x), bfhi(xi.x), bflo(xi.y), bfhi(xi.y), bflo(xi.z), bfhi(xi.z), bflo(xi.w), bfhi(xi.w)};
#pragma unroll
        for (int j = 0; j < 4; ++j) { v[j] += acc[mi][2 * g][j]; v[4 + j] += acc[mi][2 * g + 1][j]; }
#pragma unroll
        for (int j = 0; j < 8; ++j) ss += v[j] * v[j];
        if (ok) { uint4 o; o.x = pk2(v[0], v[1]); o.y = pk2(v[2], v[3]); o.z = pk2(v[4], v[5]); o.w = pk2(v[6], v[7]); *(uint4*)(xr + col) = o; }
      }
      ss += __shfl_xor(ss, 16); ss += __shfl_xor(ss, 32);
      if (fq == 0 && ok) atomicAdd(p.ssq_x + (L + 1) * NTP + m, ss);
    }
  }
};

DEV void kv_prep_row(const Prm& p, int L, int R, int half, bool valid, bf16_t* At_row  ) {
  const int Rl = valid ? R : 0;
  const bf16_t* zr = p.zE + (size_t)Rl * ZE;
  const float rstd = rsqrtf(p.ssq_kv[L * NTP + Rl] * (1.f / 128.f) + RMS_EPS);
  float* outc; float* outk;
  if (Rl < NPR) { const int s = Rl / PT, q = Rl - s * PT; outc = p.ckv_p + (((size_t)L * 4 + s) * PT + q) * 128; outk = p.kr_p + (((size_t)L * 4 + s) * PT + q) * 32; }
  else { const int j = Rl - NPR; outc = p.ckv_s + ((size_t)L * NSM + j) * 128; outk = p.kr_s + ((size_t)L * NSM + j) * 32; }
  const float* g = p.kv_norm_g + L * 128 + 64 * half;
#pragma unroll
  for (int c8 = 0; c8 < 8; ++c8) {
    const uint4 u = *(const uint4*)(zr + ZE_CKV + 64 * half + 8 * c8);
    const float4 g0 = *(const float4*)(g + 8 * c8), g1 = *(const float4*)(g + 8 * c8 + 4);
    float4 y0, y1;
    y0.x = bflo(u.x) * rstd * g0.x; y0.y = bfhi(u.x) * rstd * g0.y; y0.z = bflo(u.y) * rstd * g0.z; y0.w = bfhi(u.y) * rstd * g0.w;
    y1.x = bflo(u.z) * rstd * g1.x; y1.y = bfhi(u.z) * rstd * g1.y; y1.z = bflo(u.w) * rstd * g1.z; y1.w = bfhi(u.w) * rstd * g1.w;
    if (valid) { *(float4*)(outc + 64 * half + 8 * c8) = y0; *(float4*)(outc + 64 * half + 8 * c8 + 4) = y1; }
    if (At_row) { uint4 o; o.x = pk2(y0.x, y0.y); o.y = pk2(y0.z, y0.w); o.z = pk2(y1.x, y1.y); o.w = pk2(y1.z, y1.w); *(uint4*)(At_row + 64 * half + 8 * c8) = o; }
    if (valid && Rl >= NPR) {
      const int j = Rl - NPR, b = j >> 6, r = j & 63;
      bf16_t* kl = p.KL + ((size_t)b * SKEYS + 1024 + r) * 160 + 16 * (4 * half + (c8 >> 1)) + 4 * (c8 & 1);
      *(uint2*)kl = pk4(y0.x, y0.y, y0.z, y0.w); *(uint2*)(kl + 8) = pk4(y1.x, y1.y, y1.z, y1.w);
    }
    if (c8 & 1) __builtin_amdgcn_sched_barrier(0);
  }
  if (half == 0) {
    const int pos = pos_of(Rl);
#pragma unroll
    for (int c8 = 0; c8 < 2; ++c8) {
      const uint4 u = *(const uint4*)(zr + ZE_KR + 8 * c8), v = *(const uint4*)(zr + ZE_KR + 16 + 8 * c8);
      const float x1[8] = {bflo(u.x), bfhi(u.x), bflo(u.y), bfhi(u.y), bflo(u.z), bfhi(u.z), bflo(u.w), bfhi(u.w)};
      const float x2[8] = {bflo(v.x), bfhi(v.x), bflo(v.y), bfhi(v.y), bflo(v.z), bfhi(v.z), bflo(v.w), bfhi(v.w)};
      float y1[8], y2[8];
#pragma unroll
      for (int e = 0; e < 8; ++e) {
        const float cs = p.ropec[pos * 16 + 8 * c8 + e], sn = p.ropes[pos * 16 + 8 * c8 + e];
        y1[e] = x1[e] * cs - x2[e] * sn; y2[e] = x1[e] * sn + x2[e] * cs;
      }
      if (valid) {
        float4 o;
        o.x = y1[0]; o.y = y1[1]; o.z = y1[2]; o.w = y1[3]; *(float4*)(outk + 8 * c8) = o;
        o.x = y1[4]; o.y = y1[5]; o.z = y1[6]; o.w = y1[7]; *(float4*)(outk + 8 * c8 + 4) = o;
        o.x = y2[0]; o.y = y2[1]; o.z = y2[2]; o.w = y2[3]; *(float4*)(outk + 16 + 8 * c8) = o;
        o.x = y2[4]; o.y = y2[5]; o.z = y2[6]; o.w = y2[7]; *(float4*)(outk + 16 + 8 * c8 + 4) = o;
        {
          const int j = Rl - NPR;
          bf16_t* krd = Rl < NPR ? p.Kr + (size_t)Rl * 32 : p.KL + ((size_t)(j >> 6) * SKEYS + 1024 + (j & 63)) * 160 + 128;
          uint4 q; q.x = pk2(y1[0], y1[1]); q.y = pk2(y1[2], y1[3]); q.z = pk2(y1[4], y1[5]); q.w = pk2(y1[6], y1[7]); *(uint4*)(krd + 8 * c8) = q;
          q.x = pk2(y2[0], y2[1]); q.y = pk2(y2[2], y2[3]); q.z = pk2(y2[4], y2[5]); q.w = pk2(y2[6], y2[7]); *(uint4*)(krd + 16 + 8 * c8) = q;
        }
      }
    }
  }
}
DEV void kvproj_item(const Prm& p, int L, int mt, char* lds) {
  int tid = threadIdx.x; LAUNDER(tid);
  const int lane = tid & 63, w = __builtin_amdgcn_readfirstlane(tid >> 6), wr = w >> 1, wc = w & 1, l31 = lane & 31, hh = lane >> 5;
  bf16_t* At = (bf16_t*)lds;
  bf16_t* Bs = At + 128 * 136;
  {
    const int r = tid >> 1, half = tid & 1, R = mt * 128 + r;
    kv_prep_row(p, L, R, half, R < NPR, At + r * 136);
  }
  for (int h = 0; h < 8; ++h) {
    __syncthreads();
    {
      const bf16_t* wsrc = p.Wb_ukv + ((size_t)L * 1024 + h * 128) * 128;
#pragma unroll
      for (int i = 0; i < 8; ++i) { const int id = tid + 256 * i, row = id >> 4, cc = id & 15; *(uint4*)(Bs + row * 136 + cc * 8) = *(const uint4*)(wsrc + row * 128 + cc * 8); }
    }
    __syncthreads();
    f32x16 acc[2][2];
#pragma unroll
    for (int i = 0; i < 2; ++i)
#pragma unroll
      for (int j = 0; j < 2; ++j) acc[i][j] = zero16();
    const bf16_t* as = At + (wr * 64 + l31) * 136 + hh * 8;
    const bf16_t* bs = Bs + (wc * 64 + l31) * 136 + hh * 8;
    if (wc == 0) {
#pragma unroll 2
      for (int ks = 0; ks < 8; ++ks) {
        const bf16x8 a0 = *(const bf16x8*)(as + ks * 16), a1 = *(const bf16x8*)(as + 32 * 136 + ks * 16);
        const bf16x8 b0 = *(const bf16x8*)(bs + ks * 16), b1 = *(const bf16x8*)(bs + 32 * 136 + ks * 16);
        acc[0][0] = mfma32(b0, a0, acc[0][0]); acc[0][1] = mfma32(b1, a0, acc[0][1]);
        acc[1][0] = mfma32(b0, a1, acc[1][0]); acc[1][1] = mfma32(b1, a1, acc[1][1]);
      }
#pragma unroll
      for (int i = 0; i < 2; ++i) {
        const int KRr = mt * 128 + wr * 64 + 32 * i + l31;
#pragma unroll
        for (int j = 0; j < 2; ++j)
#pragma unroll
          for (int G = 0; G < 4; ++G)
            *(uint2*)(p.Kn + ((size_t)KRr * 8 + h) * 64 + 32 * j + 8 * G + 4 * hh) = pk4(acc[i][j][4 * G], acc[i][j][4 * G + 1], acc[i][j][4 * G + 2], acc[i][j][4 * G + 3]);
      }
    } else {
#pragma unroll 2
      for (int ks = 0; ks < 8; ++ks) {
        const bf16x8 a0 = *(const bf16x8*)(as + ks * 16), a1 = *(const bf16x8*)(as + 32 * 136 + ks * 16);
        const bf16x8 b0 = *(const bf16x8*)(bs + ks * 16), b1 = *(const bf16x8*)(bs + 32 * 136 + ks * 16);
        acc[0][0] = mfma32(a0, b0, acc[0][0]); acc[0][1] = mfma32(a0, b1, acc[0][1]);
        acc[1][0] = mfma32(a1, b0, acc[1][0]); acc[1][1] = mfma32(a1, b1, acc[1][1]);
      }
#pragma unroll
      for (int j = 0; j < 2; ++j) {
        const int d = 32 * j + l31;
#pragma unroll
        for (int i = 0; i < 2; ++i)
#pragma unroll
          for (int G = 0; G < 4; ++G) {
            const int KRr = mt * 128 + wr * 64 + 32 * i + 16 * (G >> 1) + 8 * hh + 4 * (G & 1);
            *(uint2*)(p.Vt + ((size_t)h * 64 + d) * KVR + KRr) = pk4(acc[i][j][4 * G], acc[i][j][4 * G + 1], acc[i][j][4 * G + 2], acc[i][j][4 * G + 3]);
          }
      }
    }
  }
  __syncthreads();
}
DEV void sample_prep_item(const Prm& p, int L, int it) {
  int tid = threadIdx.x; LAUNDER(tid);
  const int R = NPR + it * 128 + (tid >> 1);
  kv_prep_row(p, L, R, tid & 1, true, nullptr);
}
DEV void shift_item(const Prm& p, int L, int st) {
  int tid0 = threadIdx.x; LAUNDER(tid0);
  if (tid0 < 224) {
    const int R = st < 4 ? st * PT + (PT - 1) : NPR + (st - 4) * 64 + 63;
    const uint2 u = *(const uint2*)(p.zE + (size_t)R * ZE + ZE_ZC + 4 * tid0);
    float4 v; v.x = bflo(u.x); v.y = bfhi(u.x); v.z = bflo(u.y); v.w = bfhi(u.y);
    float* dst = st < 4 ? p.shift_p + ((size_t)L * 4 + st) * 896 : p.shift_s + ((size_t)L * 32 + (st - 4)) * 896;
    *(float4*)(dst + 4 * tid0) = v;
  }
}

DEV void lat_item(const Prm& p, int L, int j) {
  int tid = threadIdx.x; LAUNDER(tid);
  const int b = j >> 4, t = j & 15;
  const float* csrc = p.cache_ckv + (((size_t)L * 32 + b) * 1024 + 64 * t) * 128;
  const float* ksrc = p.cache_krope + (((size_t)L * 32 + b) * 1024 + 64 * t) * 32;
  {
    const int row = tid >> 2, qd = tid & 3;
    const float* s = csrc + row * 128 + 32 * qd;
    bf16_t* d = p.KL + ((size_t)b * SKEYS + 64 * t + row) * 160;
    const float4 v0 = *(const float4*)(s), v1 = *(const float4*)(s + 4), v2 = *(const float4*)(s + 8), v3 = *(const float4*)(s + 12);
    const float4 v4 = *(const float4*)(s + 16), v5 = *(const float4*)(s + 20), v6 = *(const float4*)(s + 24), v7 = *(const float4*)(s + 28);
    const float4 k0 = *(const float4*)(ksrc + row * 32 + 8 * qd), k1 = *(const float4*)(ksrc + row * 32 + 8 * qd + 4);
    uint4 a;
    a.x = pk2(v0.x, v0.y); a.y = pk2(v0.z, v0.w); a.z = pk2(v2.x, v2.y); a.w = pk2(v2.z, v2.w); *(uint4*)(d + 32 * qd) = a;
    a.x = pk2(v1.x, v1.y); a.y = pk2(v1.z, v1.w); a.z = pk2(v3.x, v3.y); a.w = pk2(v3.z, v3.w); *(uint4*)(d + 32 * qd + 8) = a;
    a.x = pk2(v4.x, v4.y); a.y = pk2(v4.z, v4.w); a.z = pk2(v6.x, v6.y); a.w = pk2(v6.z, v6.w); *(uint4*)(d + 32 * qd + 16) = a;
    a.x = pk2(v5.x, v5.y); a.y = pk2(v5.z, v5.w); a.z = pk2(v7.x, v7.y); a.w = pk2(v7.z, v7.w); *(uint4*)(d + 32 * qd + 24) = a;
    a.x = pk2(k0.x, k0.y); a.y = pk2(k0.z, k0.w); a.z = pk2(k1.x, k1.y); a.w = pk2(k1.z, k1.w); *(uint4*)(d + 128 + 8 * qd) = a;
  }
}

template <bool SAMPLE>
DEV int attn_body(const Prm& p, int L, int sb, int head, int qt, char* lds, unsigned* nctr = nullptr) {
  int tid = threadIdx.x; LAUNDER(tid);
  const int lane = tid & 63, w = __builtin_amdgcn_readfirstlane(tid >> 6), l31 = lane & 31, hh = lane >> 5;
  bf16_t* Ks = (bf16_t*)lds;
  bf16_t* Vs = Ks + (SAMPLE ? 1 : 2) * 64 * 104;
  bf16_t* Cs = Vs + (SAMPLE ? 1 : 2) * 64 * 72;
  bf16_t* Wl = Cs + 64 * 136;
  const bf16_t* Qb = (const bf16_t*)p.y_prompt;
  bf16_t* mix = p.zE;
  int Rq0, ntiles, lastvis; bool wact, rowvalid;
  if (SAMPLE) { Rq0 = NPR + 64 * sb; ntiles = 17; lastvis = 16; wact = w < 2; rowvalid = wact; }
  else if (qt >= 0) { Rq0 = sb * PT + 16 + 128 * qt; ntiles = 2 * qt + 3; lastvis = 1 + 2 * qt + (w >> 1); wact = true; rowvalid = true; }
  else { Rq0 = sb * PT; ntiles = 1; lastvis = 0; wact = (w == 0); rowvalid = wact && l31 < 16; }
  const int myrow = Rq0 + 32 * w + l31;
  const int Rld = rowvalid ? myrow : Rq0;
  bf16x8 qf[6];
  {
    const bf16_t* qp = Qb + (size_t)Rld * 768 + head * 96 + hh * 8;
#pragma unroll
    for (int ks = 0; ks < 6; ++ks) qf[ks] = *(const bf16x8*)(qp + 16 * ks);
  }
  float m_run = -1e30f, l_run = 0.f;
  f32x16 o0 = zero16(), o1 = zero16();

  uint4 a_kn0, a_kn1, a_kr, a_vt0, a_vt1;
  a_kn0 = a_kn1 = a_kr = a_vt0 = a_vt1 = make_uint4(0, 0, 0, 0);
#define PLOADX(S, TI) { const int KR0 = sb * PT + ((TI) == 0 ? 0 : 16 + 64 * ((TI) - 1)); \
    S##_kn0 = *(const uint4*)(p.Kn + ((size_t)(KR0 + (tid >> 3)) * 8 + head) * 64 + (tid & 7) * 8); \
    S##_kn1 = *(const uint4*)(p.Kn + ((size_t)(KR0 + 32 + (tid >> 3)) * 8 + head) * 64 + (tid & 7) * 8); \
    S##_kr = *(const uint4*)(p.Kr + (size_t)(KR0 + (tid >> 2)) * 32 + (tid & 3) * 8); \
    S##_vt0 = *(const uint4*)(p.Vt + ((size_t)head * 64 + (tid >> 3)) * KVR + KR0 + (tid & 7) * 8); \
    S##_vt1 = *(const uint4*)(p.Vt + ((size_t)head * 64 + 32 + (tid >> 3)) * KVR + KR0 + (tid & 7) * 8); }
#define PWRITEX(S, BUF) { bf16_t* kb_ = Ks + (BUF) * 64 * 104; bf16_t* vb_ = Vs + (BUF) * 64 * 72; \
    *(uint4*)(kb_ + (tid >> 3) * 104 + (tid & 7) * 8) = S##_kn0; *(uint4*)(kb_ + (32 + (tid >> 3)) * 104 + (tid & 7) * 8) = S##_kn1; \
    *(uint4*)(kb_ + (tid >> 2) * 104 + 64 + (tid & 3) * 8) = S##_kr; \
    *(uint4*)(vb_ + (tid >> 3) * 72 + (tid & 7) * 8) = S##_vt0; *(uint4*)(vb_ + (32 + (tid >> 3)) * 72 + (tid & 7) * 8) = S##_vt1; }
  float4 pc0, pc1, pc2, pc3, pc4, pc5, pc6, pc7, pk0, pk1;
  pc0 = pc1 = pc2 = pc3 = pc4 = pc5 = pc6 = pc7 = pk0 = pk1 = make_float4(0.f, 0.f, 0.f, 0.f);
  if (SAMPLE) {
    const bf16_t* wsrc = p.Wb_ukv + ((size_t)L * 1024 + head * 128) * 128;
#pragma unroll
    for (int i = 0; i < 8; ++i) { const int id = tid + 256 * i, row = id >> 4, cc = id & 15; *(uint4*)(Wl + row * 136 + cc * 8) = *(const uint4*)(wsrc + row * 128 + cc * 8); }
  }
#define SLOAD(TI) { const float* csrc; const float* ksrc; \
    if ((TI) < 16) { csrc = p.cache_ckv + (((size_t)L * 32 + sb) * 1024 + 64 * (TI)) * 128; ksrc = p.cache_krope + (((size_t)L * 32 + sb) * 1024 + 64 * (TI)) * 32; } \
    else { csrc = p.ckv_s + ((size_t)L * NSM + 64 * sb) * 128; ksrc = p.kr_s + ((size_t)L * NSM + 64 * sb) * 32; } \
    const float* cb_ = csrc + (tid >> 5) * 128 + (tid & 31) * 4; \
    pc0 = *(const float4*)(cb_); pc1 = *(const float4*)(cb_ + 8 * 128); pc2 = *(const float4*)(cb_ + 16 * 128); pc3 = *(const float4*)(cb_ + 24 * 128); \
    pc4 = *(const float4*)(cb_ + 32 * 128); pc5 = *(const float4*)(cb_ + 40 * 128); pc6 = *(const float4*)(cb_ + 48 * 128); pc7 = *(const float4*)(cb_ + 56 * 128); \
    const float* kb2_ = ksrc + (tid >> 3) * 32 + (tid & 7) * 4; pk0 = *(const float4*)(kb2_); pk1 = *(const float4*)(kb2_ + 32 * 32); }
#define SWRITE(BUF) { bf16_t* cd_ = Cs + (tid >> 5) * 136 + (tid & 31) * 4; \
    *(uint2*)(cd_) = pk4(pc0.x, pc0.y, pc0.z, pc0.w); *(uint2*)(cd_ + 8 * 136) = pk4(pc1.x, pc1.y, pc1.z, pc1.w); \
    *(uint2*)(cd_ + 16 * 136) = pk4(pc2.x, pc2.y, pc2.z, pc2.w); *(uint2*)(cd_ + 24 * 136) = pk4(pc3.x, pc3.y, pc3.z, pc3.w); \
    *(uint2*)(cd_ + 32 * 136) = pk4(pc4.x, pc4.y, pc4.z, pc4.w); *(uint2*)(cd_ + 40 * 136) = pk4(pc5.x, pc5.y, pc5.z, pc5.w); \
    *(uint2*)(cd_ + 48 * 136) = pk4(pc6.x, pc6.y, pc6.z, pc6.w); *(uint2*)(cd_ + 56 * 136) = pk4(pc7.x, pc7.y, pc7.z, pc7.w); \
    }
#define SWRITEK(BUF) { bf16_t* kd_ = Ks + (BUF) * 64 * 104 + (tid >> 3) * 104 + 64 + (tid & 7) * 4; \
    *(uint2*)(kd_) = pk4(pk0.x, pk0.y, pk0.z, pk0.w); *(uint2*)(kd_ + 32 * 104) = pk4(pk1.x, pk1.y, pk1.z, pk1.w); }
  auto sexpand = [&](int buf) {
    const int a = w & 1, b = w >> 1;
    const bf16_t* cp = Cs + (32 * b + l31) * 136 + hh * 8;
    const bf16_t* wkp = Wl + (32 * a + l31) * 136 + hh * 8;
    const bf16_t* wvp = wkp + 64 * 136;
    f32x16 ka = zero16(), va = zero16();
#pragma unroll
    for (int ks = 0; ks < 8; ++ks) {
      const bf16x8 cf = *(const bf16x8*)(cp + 16 * ks);
      ka = mfma32(*(const bf16x8*)(wkp + 16 * ks), cf, ka);
      va = mfma32(cf, *(const bf16x8*)(wvp + 16 * ks), va);
    }
    bf16_t* kb = Ks + buf * 64 * 104; bf16_t* vb = Vs + buf * 64 * 72;
#pragma unroll
    for (int G = 0; G < 4; ++G) {
      *(uint2*)(kb + (32 * b + l31) * 104 + 32 * a + 8 * G + 4 * hh) = pk4(ka[4 * G], ka[4 * G + 1], ka[4 * G + 2], ka[4 * G + 3]);
      *(uint2*)(vb + (32 * a + l31) * 72 + 32 * b + 8 * G + 4 * hh) = pk4(va[4 * G], va[4 * G + 1], va[4 * G + 2], va[4 * G + 3]);
    }
  };
  const int x7 = (l31 >> 1) & 7, x3 = (l31 >> 2) & 3, xv = (l31 >> 1) & 7;
#define KFRAG(SP, KS, SUB) (SAMPLE ? *(const bf16x8*)((const bf16_t*)(SP) + (l31 + 32 * (SUB)) * 104 + hh * 8 + 16 * (KS)) \
    : ((KS) < 4 ? *(const bf16x8*)((SP) + (l31 + 32 * (SUB)) * 128 + (((2 * (KS) + hh) ^ x7) << 4)) \
                : *(const bf16x8*)((SP) + 8192 + (l31 + 32 * (SUB)) * 64 + (((2 * ((KS) - 4) + hh) ^ x3) << 4))))
#define VHALF(SP, C, SUB) (SAMPLE ? *(const uint2*)((const bf16_t*)(SP) + 64 * 104 + (l31 + 32 * (SUB)) * 72 + 4 * hh + 8 * (C)) \
    : *(const uint2*)((SP) + 12288 + (l31 + 32 * (SUB)) * 128 + 8 * hh + ((((C)) ^ xv) << 4)))
  auto compute_t = [&](auto masked_c, const char* sp) {
    constexpr bool MASKED = decltype(masked_c)::value;
    f32x16 s0 = zero16(), s1 = zero16();
#pragma unroll
    for (int ks = 0; ks < 6; ++ks) {
      const bf16x8 k0 = KFRAG(sp, ks, 0), k1 = KFRAG(sp, ks, 1);
      s0 = mfma32(k0, qf[ks], s0); s1 = mfma32(k1, qf[ks], s1);
    }
    if (!SAMPLE && MASKED) {
#pragma unroll
      for (int r = 8; r < 16; ++r) s0[r] = -1e30f;
#pragma unroll
      for (int r = 0; r < 16; ++r) s1[r] = -1e30f;
    }
    float mx = s0[0];
#pragma unroll
    for (int r = 1; r < 16; ++r) mx = fmaxf(mx, s0[r]);
#pragma unroll
    for (int r = 0; r < 16; ++r) mx = fmaxf(mx, s1[r]);
    mx = fmaxf(mx, __shfl_xor(mx, 32));
    const float mnew = fmaxf(m_run, mx);
    const float alpha = __builtin_amdgcn_exp2f(m_run - mnew);
    m_run = mnew;
    float ps = 0.f;
#pragma unroll
    for (int r = 0; r < 16; ++r) { s0[r] = __builtin_amdgcn_exp2f(s0[r] - mnew); ps += s0[r]; }
#pragma unroll
    for (int r = 0; r < 16; ++r) { s1[r] = __builtin_amdgcn_exp2f(s1[r] - mnew); ps += s1[r]; }
    l_run = l_run * alpha + ps;
#pragma unroll
    for (int r = 0; r < 16; ++r) { o0[r] *= alpha; o1[r] *= alpha; }
    const bf16x8 pf0 = mk8(pk2(s0[0], s0[1]), pk2(s0[2], s0[3]), pk2(s0[4], s0[5]), pk2(s0[6], s0[7]));
    const bf16x8 pf1 = mk8(pk2(s0[8], s0[9]), pk2(s0[10], s0[11]), pk2(s0[12], s0[13]), pk2(s0[14], s0[15]));
    const bf16x8 pf2 = mk8(pk2(s1[0], s1[1]), pk2(s1[2], s1[3]), pk2(s1[4], s1[5]), pk2(s1[6], s1[7]));
    const bf16x8 pf3 = mk8(pk2(s1[8], s1[9]), pk2(s1[10], s1[11]), pk2(s1[12], s1[13]), pk2(s1[14], s1[15]));
#define PV_STEP(S, PF) { bf16x8 v0_, v1_; \
      if (SAMPLE) { const uint2 a0 = VHALF(sp, 2 * S, 0), b0 = VHALF(sp, 2 * S + 1, 0), a1 = VHALF(sp, 2 * S, 1), b1 = VHALF(sp, 2 * S + 1, 1); \
        v0_ = mk8(a0.x, a0.y, b0.x, b0.y); v1_ = mk8(a1.x, a1.y, b1.x, b1.y); } \
      else { v0_ = *(const bf16x8*)(sp + 12288 + l31 * 128 + (((2 * S + hh) ^ xv) << 4)); v1_ = *(const bf16x8*)(sp + 12288 + (l31 + 32) * 128 + (((2 * S + hh) ^ xv) << 4)); } \
      o0 = mfma32(v0_, PF, o0); o1 = mfma32(v1_, PF, o1); }
    PV_STEP(0, pf0) PV_STEP(1, pf1) PV_STEP(2, pf2) PV_STEP(3, pf3)
  };
  bf16x8 qf7 = mk8(0u, 0u, 0u, 0u);
  const bf16x8 kone = mk8(hh == 0 ? 0x3F80u : 0u, 0u, 0u, 0u);
  auto freeze = [&]() {
    const float mf = bflo(pk2(m_run, 0.f));
    const float fac = __builtin_amdgcn_exp2f(m_run - mf);
    l_run *= fac;
#pragma unroll
    for (int r = 0; r < 16; ++r) { o0[r] *= fac; o1[r] *= fac; }
    qf7 = mk8(hh == 0 ? (pk2(-mf, 0.f) & 0xffffu) : 0u, 0u, 0u, 0u);
  };
  auto compute_f = [&](const char* sp) {
    f32x16 s0 = mfma32(kone, qf7, zero16()), s1 = mfma32(kone, qf7, zero16());
#pragma unroll
    for (int ks = 0; ks < 6; ++ks) {
      const bf16x8 k0 = KFRAG(sp, ks, 0), k1 = KFRAG(sp, ks, 1);
      s0 = mfma32(k0, qf[ks], s0); s1 = mfma32(k1, qf[ks], s1);
    }
    float ps = 0.f;
#pragma unroll
    for (int r = 0; r < 16; ++r) { s0[r] = __builtin_amdgcn_exp2f(s0[r]); ps += s0[r]; }
#pragma unroll
    for (int r = 0; r < 16; ++r) { s1[r] = __builtin_amdgcn_exp2f(s1[r]); ps += s1[r]; }
    l_run += ps;
    const bf16x8 pf0 = mk8(pk2(s0[0], s0[1]), pk2(s0[2], s0[3]), pk2(s0[4], s0[5]), pk2(s0[6], s0[7]));
    const bf16x8 pf1 = mk8(pk2(s0[8], s0[9]), pk2(s0[10], s0[11]), pk2(s0[12], s0[13]), pk2(s0[14], s0[15]));
    const bf16x8 pf2 = mk8(pk2(s1[0], s1[1]), pk2(s1[2], s1[3]), pk2(s1[4], s1[5]), pk2(s1[6], s1[7]));
    const bf16x8 pf3 = mk8(pk2(s1[8], s1[9]), pk2(s1[10], s1[11]), pk2(s1[12], s1[13]), pk2(s1[14], s1[15]));
    PV_STEP(0, pf0) PV_STEP(1, pf1) PV_STEP(2, pf2) PV_STEP(3, pf3)
#undef PV_STEP
  };

  if (SAMPLE) {
    SLOAD(0)
    for (int ti = 0; ti < ntiles; ++ti) {
      const int buf = 0;
      SWRITE(buf)
      __syncthreads();
      SWRITEK(buf)
      { const int tn = ti + 1 < ntiles ? ti + 1 : ti; SLOAD(tn) }
      sexpand(buf);
      __syncthreads();
      if (wact) { if (ti == 0) { compute_t(std::false_type{}, (const char*)Ks); freeze(); } else compute_f((const char*)Ks); }
    }
    __syncthreads();
  } else {
    const int l8 = lane >> 3, c8 = lane & 7;
    unsigned kn_o0, kn_o1, kr_o, vt_o0, vt_o1;
    { const int r = 8 * (2 * w) + l8; kn_o0 = (unsigned)((r * 8 + head) * 64 + ((c8 ^ ((r >> 1) & 7)) * 8)); }
    { const int r = 8 * (2 * w + 1) + l8; kn_o1 = (unsigned)((r * 8 + head) * 64 + ((c8 ^ ((r >> 1) & 7)) * 8)); }
    { const int r = 16 * w + (lane >> 2); kr_o = (unsigned)(r * 32 + (((lane & 3) ^ ((r >> 2) & 3)) * 8)); }
    { const int d = 8 * (2 * w) + l8; vt_o0 = (unsigned)((head * 64 + d) * KVR + ((c8 ^ ((d >> 1) & 7)) * 8)); }
    { const int d = 8 * (2 * w + 1) + l8; vt_o1 = (unsigned)((head * 64 + d) * KVR + ((c8 ^ ((d >> 1) & 7)) * 8)); }
#define GLDS16(G, Lp) __builtin_amdgcn_global_load_lds((const unsigned*)(G), (LAS3 unsigned*)(Lp), 16, 0, 0)
#define PDMA(TI, STG) { const int KR0 = sb * PT + ((TI) == 0 ? 0 : 16 + 64 * ((TI) - 1)); char* sb_ = lds + (STG) * 20480 + lane * 16; \
      const bf16_t* kn_ = p.Kn + (size_t)KR0 * 512; const bf16_t* kr_ = p.Kr + (size_t)KR0 * 32; const bf16_t* vt_ = p.Vt + KR0; \
      GLDS16(kn_ + kn_o0, sb_ + (2 * w) * 1024); GLDS16(kn_ + kn_o1, sb_ + (2 * w + 1) * 1024); GLDS16(kr_ + kr_o, sb_ + 8192 + w * 1024); \
      GLDS16(vt_ + vt_o0, sb_ + 12288 + (2 * w) * 1024); GLDS16(vt_ + vt_o1, sb_ + 12288 + (2 * w + 1) * 1024); }
    PDMA(0, 0)
    if (ntiles > 1) PDMA(1, 1)
    int stg = 0, stg2 = 2;
    for (int ti = 0; ti < ntiles; ++ti) {
      if (ti + 1 < ntiles) asm volatile("s_waitcnt vmcnt(5)" ::: "memory"); else asm volatile("s_waitcnt vmcnt(0)" ::: "memory");
      RAW_BARRIER()
      if (ti + 2 < ntiles) PDMA(ti + 2, stg2)
      const char* sp = lds + stg * 20480;
      if (ti == 0) { if (wact) compute_t(std::true_type{}, sp); }
      else if (ti == 1) { compute_t(std::false_type{}, sp); freeze(); }
      else if (ti <= lastvis) compute_f(sp);
      stg = stg == 2 ? 0 : stg + 1; stg2 = stg2 == 2 ? 0 : stg2 + 1;
    }
    __syncthreads();
#undef PDMA
#undef GLDS16
  }
  int tk = 0x7fffffff; if (nctr && tid == 0) tk = (int)atomicAdd(nctr, 1u);
  const float lt = l_run + __shfl_xor(l_run, 32);
  if (rowvalid) {
    const float inv = 1.f / lt;
    const bf16_t* gbp = p.zL + (size_t)myrow * ZL + ZL_GB + 64 * head;
    bf16_t* op = mix + (size_t)myrow * D + 256 + 64 * head;
#pragma unroll
    for (int G = 0; G < 4; ++G) {
      const int d = 8 * G + 4 * hh;
      const uint2 g0 = *(const uint2*)(gbp + d), g1 = *(const uint2*)(gbp + 32 + d);
      *(uint2*)(op + d) = pk4(o0[4 * G] * inv * silu_(bflo(g0.x)), o0[4 * G + 1] * inv * silu_(bfhi(g0.x)), o0[4 * G + 2] * inv * silu_(bflo(g0.y)), o0[4 * G + 3] * inv * silu_(bfhi(g0.y)));
      *(uint2*)(op + 32 + d) = pk4(o1[4 * G] * inv * silu_(bflo(g1.x)), o1[4 * G + 1] * inv * silu_(bfhi(g1.x)), o1[4 * G + 2] * inv * silu_(bflo(g1.y)), o1[4 * G + 3] * inv * silu_(bfhi(g1.y)));
    }
  }
  return tk;
}
DEV void attn_item(const Prm& p, int L, int id, char* lds) {
  if (id < 1024) { const int qt = 31 - (id >> 5), sh = id & 31; attn_body<false>(p, L, sh >> 3, sh & 7, qt, lds); }
  else if (id < 1280) { const int j = id - 1024; attn_body<true>(p, L, j >> 3, j & 7, 0, lds); }
  else { const int j = id - 1280; attn_body<false>(p, L, j >> 3, j & 7, -1, lds); }
}

typedef short v4i16_t __attribute__((ext_vector_type(4)));
DEV uint2 lds_tr16(const char* pl) { const v4i16_t r = __builtin_amdgcn_ds_read_tr16_b64_v4i16((__attribute__((address_space(3))) v4i16_t*)pl); return __builtin_bit_cast(uint2, r); }
DEV void attn_sample(const Prm& p, int L, int b, int hp, char* lds) {
  int tid = threadIdx.x; LAUNDER(tid);
  const int lane = tid & 63, w = __builtin_amdgcn_readfirstlane(tid >> 6), l31 = lane & 31, hh = lane >> 5;
  const int head = 2 * hp + (w >> 1);
  const bf16_t* Qb = (const bf16_t*)p.y_prompt;
  bf16_t* mix = p.zE;
  const int myrow = NPR + 64 * b + 32 * (w & 1) + l31;
  bf16x8 qf[6];
  {
    const bf16_t* qp = Qb + (size_t)myrow * 768 + head * 96 + hh * 8;
#pragma unroll
    for (int ks = 0; ks < 6; ++ks) qf[ks] = *(const bf16x8*)(qp + 16 * ks);
  }
  unsigned kl_o0, kl_o1, kl_o2, kl_o3, kr_o;
  {
    const int l16 = lane >> 4, c16 = lane & 15;
#define KROW(i) (4 * (4 * w + (i)) + l16)
#define KLO(i) ((unsigned)(KROW(i) * 160 + ((c16 ^ (((KROW(i) & 3) << 2) | ((KROW(i) >> 2) & 3))) * 8)))
    kl_o0 = KLO(0); kl_o1 = KLO(1); kl_o2 = KLO(2); kl_o3 = KLO(3);
#undef KLO
#undef KROW
    const int r = 16 * w + (lane >> 2);
    kr_o = (unsigned)(r * 160 + 128 + (((lane & 3) ^ ((r >> 2) & 3)) * 8));
  }
  const bf16_t* klb = p.KL + (size_t)b * SKEYS * 160;
#define GLDS16(G, Lp) __builtin_amdgcn_global_load_lds((const unsigned*)(G), (LAS3 unsigned*)(Lp), 16, 0, 0)
#define SDMA(TI, STG) { char* sb_ = lds + (STG) * 20480 + lane * 16; const bf16_t* kl_ = klb + (size_t)(TI) * 64 * 160; \
    GLDS16(kl_ + kl_o0, sb_ + (4 * w) * 1024); GLDS16(kl_ + kl_o1, sb_ + (4 * w + 1) * 1024); GLDS16(kl_ + kl_o2, sb_ + (4 * w + 2) * 1024); GLDS16(kl_ + kl_o3, sb_ + (4 * w + 3) * 1024); \
    GLDS16(kl_ + kr_o, sb_ + 16384 + w * 1024); }
  SDMA(0, 0)
  SDMA(1, 1)
  bf16x8 qa0, qa1, qa2, qa3, qa4, qa5, qa6, qa7;
  {
    const float* wsrc = p.w_ukv + ((size_t)L * 128 + l31) * 1024 + head * 128 + 8 * hh;
#define QABS(CT, QA, QB) { f32x16 acc = zero16(); \
      _Pragma("unroll") for (int ks = 0; ks < 4; ++ks) { const float* s_ = wsrc + (size_t)(32 * (CT)) * 1024 + 16 * ks; const float4 a_ = *(const float4*)s_, c_ = *(const float4*)(s_ + 4); \
        acc = mfma32(mk8(pk2(a_.x, a_.y), pk2(a_.z, a_.w), pk2(c_.x, c_.y), pk2(c_.z, c_.w)), qf[ks], acc); } \
      QA = mk8(pk2(acc[0], acc[1]), pk2(acc[2], acc[3]), pk2(acc[4], acc[5]), pk2(acc[6], acc[7])); \
      QB = mk8(pk2(acc[8], acc[9]), pk2(acc[10], acc[11]), pk2(acc[12], acc[13]), pk2(acc[14], acc[15])); }
    QABS(0, qa0, qa1) QABS(1, qa2, qa3) QABS(2, qa4, qa5) QABS(3, qa6, qa7)
#undef QABS
  }
  float m_run = -1e30f, l_run = 0.f;
  f32x16 o0 = zero16(), o1 = zero16(), o2 = zero16(), o3 = zero16();
  bf16x8 qf7 = mk8(0u, 0u, 0u, 0u);
  const bf16x8 kone = mk8(hh == 0 ? 0x3F80u : 0u, 0u, 0u, 0u);
  const int xk = ((l31 & 3) << 2) | ((l31 >> 2) & 3), x3 = (l31 >> 2) & 3;
  int va0, va1;
  {
    const int g = l31 >> 4, q = (l31 >> 2) & 3, pp = l31 & 3;
    const int rowb = (4 * hh + q) * 256 + 8 * (pp & 1) + (q << 6);
    va0 = rowb + (((2 * g + (pp >> 1)) ^ hh) << 4);
    va1 = rowb + 2048 + (((2 * g + (pp >> 1)) ^ (hh + 2)) << 4);
  }
  int stg = 0, stg2 = 2;
  for (int ti = 0; ti < 17; ++ti) {
    if (ti + 1 < 17) asm volatile("s_waitcnt vmcnt(5)" ::: "memory"); else asm volatile("s_waitcnt vmcnt(0)" ::: "memory");
    RAW_BARRIER()
    if (ti + 2 < 17) SDMA(ti + 2, stg2)
    const char* sp = lds + stg * 20480;
    f32x16 s0 = mfma32(kone, qf7, zero16()), s1 = s0;
#define QKL(S, QA) { const bf16x8 k0 = *(const bf16x8*)(sp + l31 * 256 + (((2 * (S) + hh) ^ xk) << 4)), k1 = *(const bf16x8*)(sp + (l31 + 32) * 256 + (((2 * (S) + hh) ^ xk) << 4)); \
      s0 = mfma32(k0, QA, s0); s1 = mfma32(k1, QA, s1); }
    QKL(0, qa0) QKL(1, qa1) QKL(2, qa2) QKL(3, qa3) QKL(4, qa4) QKL(5, qa5) QKL(6, qa6) QKL(7, qa7)
#undef QKL
#pragma unroll
    for (int kr = 0; kr < 2; ++kr) {
      const bf16x8 k0 = *(const bf16x8*)(sp + 16384 + l31 * 64 + (((2 * kr + hh) ^ x3) << 4)), k1 = *(const bf16x8*)(sp + 16384 + (l31 + 32) * 64 + (((2 * kr + hh) ^ x3) << 4));
      s0 = mfma32(k0, qf[4 + kr], s0); s1 = mfma32(k1, qf[4 + kr], s1);
    }
    float ps = 0.f;
    if (ti == 0) {
      float mx = s0[0];
#pragma unroll
      for (int r = 1; r < 16; ++r) mx = fmaxf(mx, s0[r]);
#pragma unroll
      for (int r = 0; r < 16; ++r) mx = fmaxf(mx, s1[r]);
      mx = fmaxf(mx, __shfl_xor(mx, 32));
      m_run = bflo(pk2(mx, 0.f));
#pragma unroll
      for (int r = 0; r < 16; ++r) { s0[r] -= m_run; s1[r] -= m_run; }
      qf7 = mk8(hh == 0 ? (pk2(-m_run, 0.f) & 0xffffu) : 0u, 0u, 0u, 0u);
    }
#pragma unroll
    for (int r = 0; r < 16; ++r) { s0[r] = __builtin_amdgcn_exp2f(s0[r]); ps += s0[r]; }
#pragma unroll
    for (int r = 0; r < 16; ++r) { s1[r] = __builtin_amdgcn_exp2f(s1[r]); ps += s1[r]; }
    l_run += ps;
    const bf16x8 pf0 = mk8(pk2(s0[0], s0[1]), pk2(s0[2], s0[3]), pk2(s0[4], s0[5]), pk2(s0[6], s0[7]));
    const bf16x8 pf1 = mk8(pk2(s0[8], s0[9]), pk2(s0[10], s0[11]), pk2(s0[12], s0[13]), pk2(s0[14], s0[15]));
    const bf16x8 pf2 = mk8(pk2(s1[0], s1[1]), pk2(s1[2], s1[3]), pk2(s1[4], s1[5]), pk2(s1[6], s1[7]));
    const bf16x8 pf3 = mk8(pk2(s1[8], s1[9]), pk2(s1[10], s1[11]), pk2(s1[12], s1[13]), pk2(s1[14], s1[15]));
#define PVT(S, CT, PF, OT) { const uint2 a_ = lds_tr16(sp + (va0 ^ ((CT) << 6)) + (S) * 4096), b_ = lds_tr16(sp + (va1 ^ ((CT) << 6)) + (S) * 4096); \
      OT = mfma32(mk8(a_.x, a_.y, b_.x, b_.y), PF, OT); }
#define PVL(S, PF) PVT(S, 0, PF, o0) PVT(S, 1, PF, o1) PVT(S, 2, PF, o2) PVT(S, 3, PF, o3)
    PVL(0, pf0) PVL(1, pf1) PVL(2, pf2) PVL(3, pf3)
#undef PVL
#undef PVT
    stg = stg == 2 ? 0 : stg + 1; stg2 = stg2 == 2 ? 0 : stg2 + 1;
  }
#undef SDMA
#undef GLDS16
  __syncthreads();
  const float lt = l_run + __shfl_xor(l_run, 32);
  const float inv = 1.f / lt;
  f32x16 e0 = zero16(), e1 = zero16();
  const bf16_t* wv = p.Wb_ukv + ((size_t)L * 1024 + head * 128 + 64 + l31) * 128 + 8 * hh;
#define OEXP(S, OT, RB) { const bf16x8 ob = mk8(pk2(OT[RB] * inv, OT[RB + 1] * inv), pk2(OT[RB + 2] * inv, OT[RB + 3] * inv), pk2(OT[RB + 4] * inv, OT[RB + 5] * inv), pk2(OT[RB + 6] * inv, OT[RB + 7] * inv)); \
    e0 = mfma32(*(const bf16x8*)(wv + 16 * (S)), ob, e0); e1 = mfma32(*(const bf16x8*)(wv + 32 * 128 + 16 * (S)), ob, e1); }
  OEXP(0, o0, 0) OEXP(1, o0, 8) OEXP(2, o1, 0) OEXP(3, o1, 8) OEXP(4, o2, 0) OEXP(5, o2, 8) OEXP(6, o3, 0) OEXP(7, o3, 8)
#undef OEXP
  {
    const bf16_t* gbp = p.zL + (size_t)myrow * ZL + ZL_GB + 64 * head;
    bf16_t* op = mix + (size_t)myrow * D + 256 + 64 * head;
#pragma unroll
    for (int G = 0; G < 4; ++G) {
      const int d = 8 * G + 4 * hh;
      const uint2 g0 = *(const uint2*)(gbp + d), g1 = *(const uint2*)(gbp + 32 + d);
      *(uint2*)(op + d) = pk4(e0[4 * G] * silu_(bflo(g0.x)), e0[4 * G + 1] * silu_(bfhi(g0.x)), e0[4 * G + 2] * silu_(bflo(g0.y)), e0[4 * G + 3] * silu_(bfhi(g0.y)));
      *(uint2*)(op + 32 + d) = pk4(e1[4 * G] * silu_(bflo(g1.x)), e1[4 * G + 1] * silu_(bfhi(g1.x)), e1[4 * G + 2] * silu_(bflo(g1.y)), e1[4 * G + 3] * silu_(bfhi(g1.y)));
    }
  }
}

DEV void conv_item(const Prm& p, int L, int item) {
  int tid = threadIdx.x; LAUNDER(tid);
  bf16_t* mix = p.zE;
  const int c0 = (tid & 31) * 8;
  float w0[8], w1[8], w2[8];
#pragma unroll
  for (int e = 0; e < 8; ++e) { w0[e] = p.conv_w[(L * 3 + 0) * 256 + c0 + e]; w1[e] = p.conv_w[(L * 3 + 1) * 256 + c0 + e]; w2[e] = p.conv_w[(L * 3 + 2) * 256 + c0 + e]; }
  for (int it = 0; it < 4; ++it) {
    const int R = item * 32 + it * 8 + (tid >> 5);
    if (R >= NT) continue;
    int q, T; const float* st; float* so;
    if (R < NPR) { const int s = R / PT; q = R - s * PT; T = PT; st = nullptr; so = p.conv_p + ((size_t)L * 4 + s) * 512; }
    else { const int b = (R - NPR) >> 6; q = (R - NPR) & 63; T = 64; st = p.state_conv + ((size_t)L * 32 + b) * 512; so = p.conv_s + ((size_t)L * 32 + b) * 512; }
    float u[3][8];
#pragma unroll
    for (int dlt = 0; dlt < 3; ++dlt) {
      const int t = q - 2 + dlt;
      if (t >= 0) {
        const bf16_t* zr = p.zL + (size_t)(R - 2 + dlt) * ZL;
        const uint4 xi = *(const uint4*)(zr + ZL_XIN + c0), cg = *(const uint4*)(zr + ZL_CG + c0);
        u[dlt][0] = bflo(xi.x) * bflo(cg.x); u[dlt][1] = bfhi(xi.x) * bfhi(cg.x); u[dlt][2] = bflo(xi.y) * bflo(cg.y); u[dlt][3] = bfhi(xi.y) * bfhi(cg.y);
        u[dlt][4] = bflo(xi.z) * bflo(cg.z); u[dlt][5] = bfhi(xi.z) * bfhi(cg.z); u[dlt][6] = bflo(xi.w) * bflo(cg.w); u[dlt][7] = bfhi(xi.w) * bfhi(cg.w);
      } else if (st) {
        const float* sr = st + (t + 2) * 256 + c0;
#pragma unroll
        for (int e = 0; e < 8; ++e) u[dlt][e] = sr[e];
      } else {
#pragma unroll
        for (int e = 0; e < 8; ++e) u[dlt][e] = 0.f;
      }
    }
    const bf16_t* zr = p.zL + (size_t)R * ZL;
    const uint4 bg = *(const uint4*)(zr + ZL_BG + c0), ga = *(const uint4*)(zr + ZL_GA + c0);
    const float bgf[8] = {bflo(bg.x), bfhi(bg.x), bflo(bg.y), bfhi(bg.y), bflo(bg.z), bfhi(bg.z), bflo(bg.w), bfhi(bg.w)};
    const float gaf[8] = {bflo(ga.x), bfhi(ga.x), bflo(ga.y), bfhi(ga.y), bflo(ga.z), bfhi(ga.z), bflo(ga.w), bfhi(ga.w)};
    float y[8];
#pragma unroll
    for (int e = 0; e < 8; ++e) y[e] = bgf[e] * (w0[e] * u[0][e] + w1[e] * u[1][e] + w2[e] * u[2][e]) * silu_(gaf[e]);
    uint4 o; o.x = pk2(y[0], y[1]); o.y = pk2(y[2], y[3]); o.z = pk2(y[4], y[5]); o.w = pk2(y[6], y[7]);
    *(uint4*)(mix + (size_t)R * D + c0) = o;
    if (q >= T - 2) {
      float* d = so + (q - (T - 2)) * 256 + c0;
#pragma unroll
      for (int e = 0; e < 8; ++e) d[e] = u[2][e];
    }
  }
}

DEV int kperm_addr(int m, int kin) {
  const int mt = m >> 4, ml = m & 15, s = kin >> 5, q = (kin >> 4) & 1, g = (kin >> 2) & 3, e = kin & 3;
  return (((mt * 2 + s) * 64 + ml + 16 * g) * 8) + 4 * q + e;
}
DEV int clay_addr(int x, int v) {
  const int xt = x >> 4, g = (x >> 2) & 3, rr = x & 3, vt = v >> 4, l16 = v & 15;
  return ((xt * 4 + vt) * 64 + 16 * g + l16) * 4 + rr;
}
DEV void mm64(const bf16_t* first, const bf16_t* second, int l31, int hh, f32x16 (&acc)[2][2]) {
#pragma unroll
  for (int ks = 0; ks < 4; ++ks) {
    const bf16x8 f0 = *(const bf16x8*)(first + l31 * 72 + ks * 16 + hh * 8), f1 = *(const bf16x8*)(first + (32 + l31) * 72 + ks * 16 + hh * 8);
    const bf16x8 s0 = *(const bf16x8*)(second + l31 * 72 + ks * 16 + hh * 8), s1 = *(const bf16x8*)(second + (32 + l31) * 72 + ks * 16 + hh * 8);
    acc[0][0] = mfma32(f0, s0, acc[0][0]); acc[0][1] = mfma32(f0, s1, acc[0][1]);
    acc[1][0] = mfma32(f1, s0, acc[1][0]); acc[1][1] = mfma32(f1, s1, acc[1][1]);
  }
}
DEV void mm64x32(const bf16_t* first, const bf16_t* second_rows, int l31, int hh, f32x16 (&acc)[2]) {
#pragma unroll
  for (int ks = 0; ks < 4; ++ks) {
    const bf16x8 f0 = *(const bf16x8*)(first + l31 * 72 + ks * 16 + hh * 8), f1 = *(const bf16x8*)(first + (32 + l31) * 72 + ks * 16 + hh * 8);
    const bf16x8 s0 = *(const bf16x8*)(second_rows + l31 * 72 + ks * 16 + hh * 8);
    acc[0] = mfma32(f0, s0, acc[0]); acc[1] = mfma32(f1, s0, acc[1]);
  }
}

DEV void mmq(const bf16_t* first_rows, const bf16_t* second_rows, int l31, int hh, f32x16& acc) {
#pragma unroll
  for (int ks = 0; ks < 4; ++ks) {
    const bf16x8 f0 = *(const bf16x8*)(first_rows + l31 * 72 + ks * 16 + hh * 8);
    const bf16x8 s0 = *(const bf16x8*)(second_rows + l31 * 72 + ks * 16 + hh * 8);
    acc = mfma32(f0, s0, acc);
  }
}
enum { SH_FULL = 0, SH_UP = 1, SH_LO = 2 };
template <int SH> DEV constexpr bool tile_nz(int tx, int ty) { return SH == SH_FULL || (SH == SH_UP ? tx <= ty : tx >= ty); }
struct Acc64 { f32x16 t[2][2]; };
struct Frag64 { bf16x8 f[4][2]; };
template <int SS> DEV bf16x8 pack8(const f32x16& v) {
  return mk8(pk2(v[8 * SS], v[8 * SS + 1]), pk2(v[8 * SS + 2], v[8 * SS + 3]), pk2(v[8 * SS + 4], v[8 * SS + 5]), pk2(v[8 * SS + 6], v[8 * SS + 7]));
}
template <int SH> DEV void to_frag(const Acc64& X, Frag64& F) {
#pragma unroll
  for (int t = 0; t < 2; ++t) {
    if (tile_nz<SH>(0, t)) { F.f[0][t] = pack8<0>(X.t[0][t]); F.f[1][t] = pack8<1>(X.t[0][t]); }
    if (tile_nz<SH>(1, t)) { F.f[2][t] = pack8<0>(X.t[1][t]); F.f[3][t] = pack8<1>(X.t[1][t]); }
  }
}
template <int SH> DEV void zero_acc(Acc64& X) {
#pragma unroll
  for (int a = 0; a < 2; ++a)
#pragma unroll
    for (int b = 0; b < 2; ++b) if (tile_nz<SH>(a, b)) X.t[a][b] = zero16();
}
template <int SHA, int SHB> DEV void prod_ff(const Frag64& A, const Frag64& B, Acc64& D) {
#pragma unroll
  for (int tm = 0; tm < 2; ++tm)
#pragma unroll
    for (int tn = 0; tn < 2; ++tn)
#pragma unroll
      for (int s = 0; s < 4; ++s)
        if (tile_nz<SHA>(s >> 1, tm) && tile_nz<SHB>(s >> 1, tn)) D.t[tm][tn] = mfma32(A.f[s][tm], B.f[s][tn], D.t[tm][tn]);
}
template <int SHA, int SHB, int SHD> DEV void prod_ff_frag(const Frag64& A, const Frag64& B, Frag64& Fo) {
#pragma unroll
  for (int tm = 0; tm < 2; ++tm)
#pragma unroll
    for (int tn = 0; tn < 2; ++tn)
      if (tile_nz<SHD>(tm, tn)) {
        f32x16 acc = zero16();
#pragma unroll
        for (int s = 0; s < 4; ++s)
          if (tile_nz<SHA>(s >> 1, tm) && tile_nz<SHB>(s >> 1, tn)) acc = mfma32(A.f[s][tm], B.f[s][tn], acc);
        Fo.f[2 * tm][tn] = pack8<0>(acc); Fo.f[2 * tm + 1][tn] = pack8<1>(acc);
      }
}
DEV bf16x8 nat_frag(const bf16_t* S, int row, int s, int hh) { return *(const bf16x8*)(S + row * 72 + 16 * s + 8 * hh); }
DEV bf16x8 perm_frag(const bf16_t* S, int row, int s, int hh) {
  const uint2 a = *(const uint2*)(S + row * 72 + 16 * s + 4 * hh), b = *(const uint2*)(S + row * 72 + 16 * s + 8 + 4 * hh);
  return mk8(a.x, a.y, b.x, b.y);
}
template <int SH, int MODE> DEV void gram(const bf16_t* F, const bf16_t* G, int l31, int hh, Acc64& D) {
  zero_acc<SH>(D);
#pragma unroll
  for (int s = 0; s < 4; ++s) {
    bf16x8 ff[2], gg[2];
#pragma unroll
    for (int t = 0; t < 2; ++t) { ff[t] = nat_frag(F, 32 * t + l31, s, hh); gg[t] = nat_frag(G, 32 * t + l31, s, hh); }
#pragma unroll
    for (int tx = 0; tx < 2; ++tx)
#pragma unroll
      for (int ty = 0; ty < 2; ++ty) if (tile_nz<SH>(tx, ty)) D.t[tx][ty] = mfma32(ff[tx], gg[ty], D.t[tx][ty]);
  }
#pragma unroll
  for (int t = 0; t < 2; ++t)
#pragma unroll
    for (int r = 0; r < 16; ++r) {
      const int x = (r & 3) + 8 * (r >> 2) + 4 * hh, y = l31;
      const bool keep = MODE == 0 ? (x < y) : (MODE == 1 ? (y < x) : (x <= y));
      if (!keep) D.t[t][t][r] = 0.f;
    }
}
template <int SHA> DEV void prod_fm_frag(const Frag64& A, const bf16_t* Mem, int l31, int hh, Frag64& Fo) {
#pragma unroll
  for (int tm = 0; tm < 2; ++tm)
#pragma unroll
    for (int tn = 0; tn < 2; ++tn) {
      f32x16 acc = zero16();
#pragma unroll
      for (int s = 0; s < 4; ++s) if (tile_nz<SHA>(s >> 1, tm)) acc = mfma32(A.f[s][tm], perm_frag(Mem, 32 * tn + l31, s, hh), acc);
      Fo.f[2 * tm][tn] = pack8<0>(acc); Fo.f[2 * tm + 1][tn] = pack8<1>(acc);
    }
}
template <int SHA> DEV void prod_fm(const Frag64& A, const bf16_t* Mem, int l31, int hh, Acc64& D) {
#pragma unroll
  for (int s = 0; s < 4; ++s) {
    bf16x8 mm[2];
#pragma unroll
    for (int t = 0; t < 2; ++t) mm[t] = perm_frag(Mem, 32 * t + l31, s, hh);
#pragma unroll
    for (int tm = 0; tm < 2; ++tm)
#pragma unroll
      for (int tn = 0; tn < 2; ++tn) if (tile_nz<SHA>(s >> 1, tm)) D.t[tm][tn] = mfma32(A.f[s][tm], mm[tn], D.t[tm][tn]);
  }
}
DEV void r1_item(const Prm& p, int L, int idx, char* lds) {
  int tid = threadIdx.x; LAUNDER(tid);
  const int w = __builtin_amdgcn_readfirstlane(tid >> 6);
  int lane = tid & 63, l31 = lane & 31, hh = lane >> 5;
  const int cw = w & 1, tw = w >> 1;
  bf16_t* S0 = (bf16_t*)lds;
  bf16_t* S1 = S0 + 4608; bf16_t* S2 = S1 + 4608; bf16_t* S3 = S2 + 4608; bf16_t* S4 = S3 + 4608; bf16_t* S5 = S4 + 4608; bf16_t* S6 = S5 + 4608; bf16_t* S7 = S6 + 4608;
  float* misc = (float*)(S7 + 4608);
  float* Ef = (float*)S4;
  bool prompt; int st, c, hd;
  if (idx < NRW_P) { prompt = true; st = idx / 260; const int rem = idx - st * 260; c = rem >> 2; hd = rem & 3; }
  else { prompt = false; const int j = idx - NRW_P; st = j >> 2; hd = j & 3; c = 0; }
  char* rwp = p.rw + (size_t)idx * RW_BYTES;
  const float* mu = p.shift_mu + L * 896;
  const int i1 = tid >> 2, m0 = (tid & 3) * 16;
  int R1; bool valid1, hasprev1;
  if (prompt) { const int pp = 64 * c - 48 + i1; valid1 = pp >= 0; R1 = st * PT + (valid1 ? pp : 0); hasprev1 = pp >= 1; }
  else { R1 = NPR + 64 * st + i1; valid1 = true; hasprev1 = i1 >= 1; }
  const bf16_t* zr1 = p.zE + (size_t)R1 * ZE + ZE_ZC;
  const int ti0 = 32 * tw + l31;
  int R; bool valid, hasprev;
  if (prompt) { const int pp = 64 * c - 48 + ti0; valid = pp >= 0; R = st * PT + (valid ? pp : 0); hasprev = pp >= 1; }
  else { R = NPR + 64 * st + ti0; valid = true; hasprev = ti0 >= 1; }
  const bf16_t* zr = p.zE + (size_t)R * ZE + ZE_ZC;
  const int chb = 64 * hd + 32 * cw + 4 * hh;
  uint4 la[2][2], lap[2][2]; uint2 lb[3][4], lbp[3][4];
  {
    const bf16_t* sh0 = p.zE + (size_t)(NT + (prompt ? 32 : st)) * ZE + ZE_ZC;
    const bf16_t* zp1 = hasprev1 ? zr1 - ZE : sh0;
    const bf16_t* zp = hasprev ? zr - ZE : sh0;
#pragma unroll
    for (int part = 0; part < 2; ++part)
#pragma unroll
      for (int h8 = 0; h8 < 2; ++h8) { const int col = 768 + 64 * part + m0 + 8 * h8; la[part][h8] = *(const uint4*)(zr1 + col); lap[part][h8] = *(const uint4*)(zp1 + col); }
#pragma unroll
    for (int part = 0; part < 3; ++part)
#pragma unroll
      for (int G = 0; G < 4; ++G) { const int col = 256 * part + chb + 8 * G; lb[part][G] = *(const uint2*)(zr + col); lbp[part][G] = *(const uint2*)(zp + col); }
    const bf16_t* dsrc = p.dw2T + ((size_t)L * 256 + hd * 64 + i1) * 64 + m0;
    const bf16_t* isrc = p.ia2T + ((size_t)L * 256 + hd * 64 + i1) * 64 + m0;
    const uint4 d0 = *(const uint4*)dsrc, d1 = *(const uint4*)(dsrc + 8), e0 = *(const uint4*)isrc, e1 = *(const uint4*)(isrc + 8);
    __builtin_amdgcn_sched_barrier(0);
    *(uint4*)(S2 + i1 * 72 + m0) = d0; *(uint4*)(S2 + i1 * 72 + m0 + 8) = d1;
    *(uint4*)(S3 + i1 * 72 + m0) = e0; *(uint4*)(S3 + i1 * 72 + m0 + 8) = e1;
  }
  {
    float* prm = misc + 384;
#pragma unroll
    for (int q2 = 0; q2 < 2; ++q2) {
      const int ix = tid + 256 * q2, wh = ix >> 6, chp = ix & 63;
      const float* sp = wh == 0 ? p.decay_w0 : wh == 1 ? p.iclr_a0 : wh == 2 ? p.key_kk : wh == 3 ? p.key_ka : wh == 4 ? p.bonus_rk : nullptr;
      prm[ix] = sp ? sp[L * 256 + hd * 64 + chp] : mu[256 * (wh - 5) + 64 * hd + chp];
    }
  }
#pragma unroll
  for (int part = 0; part < 2; ++part) {
#pragma unroll
    for (int h8 = 0; h8 < 2; ++h8) {
      const int col = 768 + 64 * part + m0 + 8 * h8;
      const uint4 u = la[part][h8], v = lap[part][h8];
      const float cur[8] = {bflo(u.x), bfhi(u.x), bflo(u.y), bfhi(u.y), bflo(u.z), bfhi(u.z), bflo(u.w), bfhi(u.w)};
      float prv[8] = {bflo(v.x), bfhi(v.x), bflo(v.y), bfhi(v.y), bflo(v.z), bfhi(v.z), bflo(v.w), bfhi(v.w)};
      float o[8];
#pragma unroll
      for (int e = 0; e < 8; ++e) { float z = cur[e] + (prv[e] - cur[e]) * mu[col + e]; if (!valid1) z = 0.f; o[e] = part == 0 ? (1.f - 2.f / (__expf(2.f * z) + 1.f)) : z; }
      uint4 a; a.x = pk2(o[0], o[1]); a.y = pk2(o[2], o[3]); a.z = pk2(o[4], o[5]); a.w = pk2(o[6], o[7]);
      *(uint4*)((part == 0 ? S0 : S1) + i1 * 72 + m0 + 8 * h8) = a;
    }
  }
  __syncthreads();
  f32x16 accw = zero16(), acca = zero16();
#pragma unroll
  for (int ks = 0; ks < 4; ++ks) {
    const bf16x8 fw = *(const bf16x8*)(S2 + (32 * cw + l31) * 72 + ks * 16 + hh * 8), fa = *(const bf16x8*)(S3 + (32 * cw + l31) * 72 + ks * 16 + hh * 8);
    const bf16x8 sw = *(const bf16x8*)(S0 + (32 * tw + l31) * 72 + ks * 16 + hh * 8), sa = *(const bf16x8*)(S1 + (32 * tw + l31) * 72 + ks * 16 + hh * 8);
    accw = mfma32(fw, sw, accw); acca = mfma32(fa, sa, acca);
  }
  int ti = ti0;
  float e_[16];
  float ssq = 0.f;
#pragma unroll
  for (int G = 0; G < 4; ++G) {
    const int ch = chb + 8 * G, col = 256 + ch;
    const uint2 u = lb[1][G], v = lbp[1][G];
    const float cur[4] = {bflo(u.x), bfhi(u.x), bflo(u.y), bfhi(u.y)};
    float prv[4] = {bflo(v.x), bfhi(v.x), bflo(v.y), bfhi(v.y)};
    const int chq = 32 * cw + 8 * G + 4 * hh;
    const float4 kkw = *(const float4*)(misc + 384 + 128 + chq), w0 = *(const float4*)(misc + 384 + chq), m4 = *(const float4*)(misc + 384 + 384 + chq);
    const float kkv[4] = {kkw.x, kkw.y, kkw.z, kkw.w}, w0v[4] = {w0.x, w0.y, w0.z, w0.w}, muv[4] = {m4.x, m4.y, m4.z, m4.w};
#pragma unroll
    for (int e = 0; e < 4; ++e) {
      float z = cur[e] + (prv[e] - cur[e]) * muv[e];
      if (!valid) z = 0.f;
      const float kkr = z * kkv[e];
      ssq += kkr * kkr;
      e_[4 * G + e] = valid ? 0.6065306597126334f * sigmoid_(w0v[e] + accw[4 * G + e]) : 0.f;
    }
  }
  ssq += __shfl_xor(ssq, 32);
  if (hh == 0) misc[(cw * 64 + ti) * 2] = ssq;
#pragma unroll
  for (int G = 0; G < 4; ++G)
#pragma unroll
    for (int e = 0; e < 4; ++e) Ef[ti * 65 + 32 * cw + 8 * G + 4 * hh + e] = e_[4 * G + e];
  __syncthreads();
  {
    const int ch = tid & 63, seg = tid >> 6;
    float run = 0.f;
#pragma unroll
    for (int t = 0; t < 16; ++t) { run += Ef[(16 * seg + t) * 65 + ch]; Ef[(16 * seg + t) * 65 + ch] = run; }
    __syncthreads();
    float off = 0.f;
    for (int s2 = 0; s2 < seg; ++s2) off += Ef[(16 * s2 + 15) * 65 + ch];
    __syncthreads();
#pragma unroll
    for (int t = 0; t < 16; ++t) Ef[(16 * seg + t) * 65 + ch] += off;
    if (seg == 3) { const float cC = Ef[63 * 65 + ch]; misc[320 + ch] = cC; misc[256 + ch] = __expf(-cC); }
    __syncthreads();
  }
  float cc_[16];
#pragma unroll
  for (int G = 0; G < 4; ++G)
#pragma unroll
    for (int e = 0; e < 4; ++e) cc_[4 * G + e] = Ef[ti * 65 + 32 * cw + 8 * G + 4 * hh + e];
  const float kinv = 1.f / fmaxf(sqrtf(misc[ti * 2] + misc[(64 + ti) * 2]), 1e-12f);
  __syncthreads();
  LAUNDER(ti); LAUNDER(hh);
  uint2 vpk[4];
  float rk = 0.f;
#pragma unroll
  for (int G = 0; G < 4; ++G) {
    const int ch = chb + 8 * G, chl = 32 * cw + 8 * G + 4 * hh;
    float zs[3][4];
#pragma unroll
    for (int part = 0; part < 3; ++part) {
      const int col = 256 * part + ch;
      const uint2 u = lb[part][G], v = lbp[part][G];
      const float cur[4] = {bflo(u.x), bfhi(u.x), bflo(u.y), bfhi(u.y)};
      float prv[4] = {bflo(v.x), bfhi(v.x), bflo(v.y), bfhi(v.y)};
      const float4 m4 = *(const float4*)(misc + 384 + 320 + 64 * part + chl);
      const float muv[4] = {m4.x, m4.y, m4.z, m4.w};
#pragma unroll
      for (int e = 0; e < 4; ++e) { float z = cur[e] + (prv[e] - cur[e]) * muv[e]; zs[part][e] = valid ? z : 0.f; }
    }
    vpk[G] = pk4(zs[2][0], zs[2][1], zs[2][2], zs[2][3]);
    const float4 a04 = *(const float4*)(misc + 384 + 64 + chl), kk4 = *(const float4*)(misc + 384 + 128 + chl), ka4 = *(const float4*)(misc + 384 + 192 + chl), bo4 = *(const float4*)(misc + 384 + 256 + chl);
    const float a0v[4] = {a04.x, a04.y, a04.z, a04.w}, kkv[4] = {kk4.x, kk4.y, kk4.z, kk4.w}, kav[4] = {ka4.x, ka4.y, ka4.z, ka4.w}, bov[4] = {bo4.x, bo4.y, bo4.z, bo4.w};
    float at[4], rt[4], bt[4], kt[4], bh[4], kh[4];
#pragma unroll
    for (int e = 0; e < 4; ++e) {
      const int r = 4 * G + e;
      const float al = sigmoid_(a0v[e] + acca[r]);
      const float kk = zs[1][e] * kkv[e] * kinv;
      const float km = zs[1][e] * (1.f + (al - 1.f) * kav[e]);
      rk += zs[0][e] * km * bov[e];
      const float gC = misc[256 + chl + e];
      const float cprev = cc_[r] - e_[r];
      const float ea = __expf(-cprev), er = __expf(-cc_[r]), ek = __builtin_amdgcn_rcpf(er), eh = ek * gC;
      const float b = kk * al;
      at[e] = -kk * ea; rt[e] = zs[0][e] * er; bt[e] = b * ek; kt[e] = km * ek; bh[e] = b * eh; kh[e] = km * eh;
    }
    *(uint2*)(S0 + ti * 72 + chl) = pk4(at[0], at[1], at[2], at[3]);
    *(uint2*)(S1 + ti * 72 + chl) = pk4(rt[0], rt[1], rt[2], rt[3]);
    *(uint2*)(S2 + ti * 72 + chl) = pk4(bt[0], bt[1], bt[2], bt[3]);
    *(uint2*)(S3 + ti * 72 + chl) = pk4(kt[0], kt[1], kt[2], kt[3]);
#pragma unroll
    for (int e = 0; e < 4; ++e) { S4[(chl + e) * 72 + ti] = f2bf(at[e]); S5[(chl + e) * 72 + ti] = f2bf(bh[e]); S6[(chl + e) * 72 + ti] = f2bf(kh[e]); S7[(chl + e) * 72 + ti] = f2bf(zs[2][e]); }
    *(uint2*)(rwp + 40960 + (ti * 64 + chl) * 2) = vpk[G];
  }
  rk += __shfl_xor(rk, 32);
  if (hh == 0) misc[(cw * 64 + ti) * 2 + 1] = rk;
  __syncthreads();
  if (valid && cw == 0 && hh == 0) p.rkb[(size_t)R * 4 + hd] = misc[ti * 2 + 1] + misc[(64 + ti) * 2 + 1];
  LAUNDER(l31); LAUNDER(hh); LAUNDER(lane);
  {
    Acc64 T;
    {
      Acc64 Mx, MTx;
      gram<SH_UP, 0>(S2, S0, l31, hh, Mx);
      gram<SH_LO, 1>(S0, S2, l31, hh, MTx);
      Frag64 fM, fMT, fT;
      to_frag<SH_UP>(Mx, fM); to_frag<SH_LO>(MTx, fMT);
      __builtin_amdgcn_sched_barrier(0);
      T = Mx;
#pragma unroll
      for (int t = 0; t < 2; ++t)
#pragma unroll
        for (int r = 0; r < 16; ++r) if ((r & 3) + 8 * (r >> 2) + 4 * hh == l31) T.t[t][t][r] += 1.f;
      T.t[1][0] = zero16();
      for (int r = 0; r < 5; ++r) {
        Frag64 fM2, fMT2;
        prod_ff_frag<SH_LO, SH_UP, SH_UP>(fMT, fM, fM2);
        prod_ff_frag<SH_UP, SH_LO, SH_LO>(fM, fMT, fMT2);
#pragma unroll
        for (int s = 0; s < 4; ++s)
#pragma unroll
          for (int t = 0; t < 2; ++t) { if (tile_nz<SH_UP>(s >> 1, t)) fM.f[s][t] = fM2.f[s][t]; if (tile_nz<SH_LO>(s >> 1, t)) fMT.f[s][t] = fMT2.f[s][t]; }
        to_frag<SH_UP>(T, fT);
        prod_ff<SH_LO, SH_UP>(fMT, fT, T);
      }
    }
    Frag64 fT;
    to_frag<SH_UP>(T, fT);
    __builtin_amdgcn_sched_barrier(0);
    if (w < 2) {
      Frag64 fW;
      prod_fm_frag<SH_UP>(fT, S4, l31, hh, fW);
      __builtin_amdgcn_sched_barrier(0);
      Acc64 O; zero_acc<SH_FULL>(O);
      if (w == 0) {
        prod_fm<SH_FULL>(fW, S5, l31, hh, O);
#pragma unroll
        for (int tx = 0; tx < 2; ++tx)
#pragma unroll
          for (int ty = 0; ty < 2; ++ty)
#pragma unroll
            for (int G = 0; G < 4; ++G) {
              const int x0 = 32 * tx + 8 * G + 4 * hh, y = 32 * ty + l31;
              float v[4];
#pragma unroll
              for (int e = 0; e < 4; ++e) { v[e] = O.t[tx][ty][4 * G + e]; if (x0 + e == y) v[e] += misc[256 + y]; }
              *(uint2*)(rwp + 0 + kperm_addr(y, x0) * 2) = pk4(v[0], v[1], v[2], v[3]);
            }
      } else {
        Acc64 Nb; gram<SH_UP, 2>(S2, S1, l31, hh, Nb);
        Frag64 fN; to_frag<SH_UP>(Nb, fN);
        prod_ff<SH_FULL, SH_UP>(fW, fN, O);
#pragma unroll
        for (int tx = 0; tx < 2; ++tx)
#pragma unroll
          for (int ty = 0; ty < 2; ++ty)
#pragma unroll
            for (int G = 0; G < 4; ++G) {
              const int x0 = 32 * tx + 8 * G + 4 * hh, y = 32 * ty + l31;
              const uint2 rr = *(const uint2*)(S1 + y * 72 + x0);
              *(uint2*)(rwp + 8192 + kperm_addr(y, x0) * 2) = pk4(O.t[tx][ty][4 * G] + bflo(rr.x), O.t[tx][ty][4 * G + 1] + bfhi(rr.x), O.t[tx][ty][4 * G + 2] + bflo(rr.y), O.t[tx][ty][4 * G + 3] + bfhi(rr.y));
            }
      }
    } else {
      Frag64 fX;
      {
        Acc64 Nk; gram<SH_LO, 1>(S0, S3, l31, hh, Nk);
        Frag64 fNk; to_frag<SH_LO>(Nk, fNk);
        prod_ff_frag<SH_UP, SH_LO, SH_LO>(fT, fNk, fX);
      }
      __builtin_amdgcn_sched_barrier(0);
      if (w == 2) {
        Acc64 Z; zero_acc<SH_FULL>(Z);
        prod_fm<SH_LO>(fX, S5, l31, hh, Z);
#pragma unroll
        for (int tx = 0; tx < 2; ++tx)
#pragma unroll
          for (int ty = 0; ty < 2; ++ty)
#pragma unroll
            for (int G = 0; G < 4; ++G) {
              const int x0 = 32 * tx + 8 * G + 4 * hh, y = 32 * ty + l31;
              const uint2 kk2 = *(const uint2*)(S6 + y * 72 + x0);
              Z.t[tx][ty][4 * G] += bflo(kk2.x); Z.t[tx][ty][4 * G + 1] += bfhi(kk2.x); Z.t[tx][ty][4 * G + 2] += bflo(kk2.y); Z.t[tx][ty][4 * G + 3] += bfhi(kk2.y);
            }
        Frag64 fZ; to_frag<SH_FULL>(Z, fZ);
        __builtin_amdgcn_sched_barrier(0);
        Acc64 Q; zero_acc<SH_FULL>(Q);
        prod_fm<SH_FULL>(fZ, S7, l31, hh, Q);
#pragma unroll
        for (int tx = 0; tx < 2; ++tx)
#pragma unroll
          for (int ty = 0; ty < 2; ++ty)
#pragma unroll
            for (int G = 0; G < 4; ++G)
              *(uint2*)(rwp + 16384 + clay_addr(32 * tx + 8 * G + 4 * hh, 32 * ty + l31) * 2) = pk4(Q.t[tx][ty][4 * G], Q.t[tx][ty][4 * G + 1], Q.t[tx][ty][4 * G + 2], Q.t[tx][ty][4 * G + 3]);
      } else {
        Acc64 H; gram<SH_UP, 2>(S3, S1, l31, hh, H);
        {
          Acc64 Nb; gram<SH_UP, 2>(S2, S1, l31, hh, Nb);
          Frag64 fN; to_frag<SH_UP>(Nb, fN);
          prod_ff<SH_LO, SH_UP>(fX, fN, H);
        }
        Frag64 fH; to_frag<SH_UP>(H, fH);
        __builtin_amdgcn_sched_barrier(0);
        Acc64 Y; zero_acc<SH_FULL>(Y);
        prod_fm<SH_UP>(fH, S7, l31, hh, Y);
#pragma unroll
        for (int tx = 0; tx < 2; ++tx)
#pragma unroll
          for (int ty = 0; ty < 2; ++ty)
#pragma unroll
            for (int G = 0; G < 4; ++G)
              *(uint2*)(rwp + 24576 + clay_addr(32 * tx + 8 * G + 4 * hh, 32 * ty + l31) * 2) = pk4(Y.t[tx][ty][4 * G], Y.t[tx][ty][4 * G + 1], Y.t[tx][ty][4 * G + 2], Y.t[tx][ty][4 * G + 3]);
      }
    }
  }
  __syncthreads();
}

DEV void r2_wave(const Prm& p, int L, int wi, int lane) {
  bool prompt; int st, hd, vt;
  if (wi < 64) { prompt = true; st = wi >> 4; hd = (wi >> 2) & 3; vt = wi & 3; }
  else { prompt = false; const int j = wi - 64; st = j >> 4; hd = (j >> 2) & 3; vt = j & 3; }
  const int nch = prompt ? 65 : 1;
  const int idx0 = prompt ? st * 260 + hd : NRW_P + st * 4 + hd;
  const int l16 = lane & 15, g = lane >> 4;
  f32x4 acc[4];
  float* outp;
  if (prompt) {
#pragma unroll
    for (int mt = 0; mt < 4; ++mt) acc[mt] = (f32x4){0.f, 0.f, 0.f, 0.f};
    outp = p.wkv_p + ((((size_t)L * 4 + st) * 4 + hd) * 64 + 16 * vt + l16) * 64;
  } else {
    const float* sp = p.state_wkv + ((((size_t)L * 32 + st) * 4 + hd) * 64 + 16 * vt + l16) * 64;
#pragma unroll
    for (int mt = 0; mt < 4; ++mt) acc[mt] = *(const f32x4*)(sp + 16 * mt + 4 * g);
    outp = p.wkv_s + ((((size_t)L * 32 + st) * 4 + hd) * 64 + 16 * vt + l16) * 64;
  }
  const char* rw0 = p.rw + (size_t)idx0 * RW_BYTES;
  uint4 pf[3][8]; uint2 qv[3][4];
#pragma unroll
  for (int k = 0; k < 3; ++k) {
    const int cc = k < nch ? k : nch - 1;
    const char* src = rw0 + (size_t)cc * 4 * RW_BYTES;
#pragma unroll
    for (int i = 0; i < 8; ++i) pf[k][i] = *(const uint4*)(src + (i * 64 + lane) * 16);
#pragma unroll
    for (int mt = 0; mt < 4; ++mt) qv[k][mt] = *(const uint2*)(src + 16384 + ((mt * 4 + vt) * 64 + lane) * 8);
  }
  for (int c0 = 0; c0 < nch; c0 += 3) {
#pragma unroll
    for (int k = 0; k < 3; ++k) {
      const int c = c0 + k;
      if (c < nch) {
        char* cur = (char*)rw0 + (size_t)c * 4 * RW_BYTES;
        uint4 bfr[2];
#pragma unroll
        for (int s = 0; s < 2; ++s) {
          bfr[s].x = pk2(acc[2 * s][0], acc[2 * s][1]); bfr[s].y = pk2(acc[2 * s][2], acc[2 * s][3]);
          bfr[s].z = pk2(acc[2 * s + 1][0], acc[2 * s + 1][1]); bfr[s].w = pk2(acc[2 * s + 1][2], acc[2 * s + 1][3]);
          *(uint4*)(cur + 32768 + ((vt * 2 + s) * 64 + lane) * 16) = bfr[s];
        }
#pragma unroll
        for (int mt = 0; mt < 4; ++mt) {
          f32x4 a = {bflo(qv[k][mt].x), bfhi(qv[k][mt].x), bflo(qv[k][mt].y), bfhi(qv[k][mt].y)};
#pragma unroll
          for (int s = 0; s < 2; ++s) a = mfma16(mk8(pf[k][mt * 2 + s]), mk8(bfr[s]), a);
          acc[mt] = a;
        }
        const int cn = c + 3 < nch ? c + 3 : nch - 1;
        const char* src = rw0 + (size_t)cn * 4 * RW_BYTES;
#pragma unroll
        for (int i = 0; i < 8; ++i) pf[k][i] = *(const uint4*)(src + (i * 64 + lane) * 16);
#pragma unroll
        for (int mt = 0; mt < 4; ++mt) qv[k][mt] = *(const uint2*)(src + 16384 + ((mt * 4 + vt) * 64 + lane) * 8);
      }
    }
  }
#pragma unroll
  for (int mt = 0; mt < 4; ++mt) *(f32x4*)(outp + 16 * mt + 4 * g) = acc[mt];
}

DEV void r3_wave(const Prm& p, int L, int idx, int lane, float* Y  ) {
  LAUNDER(lane);
  bool prompt; int st, c, hd;
  if (idx < NRW_P) { prompt = true; st = idx / 260; const int rem = idx - st * 260; c = rem >> 2; hd = rem & 3; }
  else { prompt = false; const int j = idx - NRW_P; st = j >> 2; hd = j & 3; c = 0; }
  const char* rwp = p.rw + (size_t)idx * RW_BYTES;
  const int l16 = lane & 15, g = lane >> 4;
  bf16_t* mix = p.zE;
  uint4 sf[4][2];
#pragma unroll
  for (int vt = 0; vt < 4; ++vt)
#pragma unroll
    for (int s = 0; s < 2; ++s) sf[vt][s] = *(const uint4*)(rwp + 32768 + ((vt * 2 + s) * 64 + lane) * 16);
  const float lw[4] = {p.lnx_w[L * 256 + hd * 64 + l16], p.lnx_w[L * 256 + hd * 64 + 16 + l16], p.lnx_w[L * 256 + hd * 64 + 32 + l16], p.lnx_w[L * 256 + hd * 64 + 48 + l16]};
  const float lb[4] = {p.lnx_b[L * 256 + hd * 64 + l16], p.lnx_b[L * 256 + hd * 64 + 16 + l16], p.lnx_b[L * 256 + hd * 64 + 32 + l16], p.lnx_b[L * 256 + hd * 64 + 48 + l16]};
#pragma unroll
  for (int it = 0; it < 4; ++it) {
    f32x4 y[4];
    const uint4 gf0 = *(const uint4*)(rwp + 8192 + ((it * 2 + 0) * 64 + lane) * 16), gf1 = *(const uint4*)(rwp + 8192 + ((it * 2 + 1) * 64 + lane) * 16);
#pragma unroll
    for (int vt = 0; vt < 4; ++vt) {
      const uint2 q = *(const uint2*)(rwp + 24576 + ((it * 4 + vt) * 64 + lane) * 8);
      f32x4 a = {bflo(q.x), bfhi(q.x), bflo(q.y), bfhi(q.y)};
      a = mfma16(mk8(gf0), mk8(sf[vt][0]), a);
      a = mfma16(mk8(gf1), mk8(sf[vt][1]), a);
      y[vt] = a;
    }
    __builtin_amdgcn_sched_barrier(0);
#pragma unroll
    for (int rr = 0; rr < 4; ++rr) {
      const int i = 16 * it + 4 * g + rr;
      float s1 = y[0][rr] + y[1][rr] + y[2][rr] + y[3][rr];
      s1 += __shfl_xor(s1, 1); s1 += __shfl_xor(s1, 2); s1 += __shfl_xor(s1, 4); s1 += __shfl_xor(s1, 8);
      const float mean = s1 * (1.f / 64.f);
      const float d0 = y[0][rr] - mean, d1 = y[1][rr] - mean, d2 = y[2][rr] - mean, d3 = y[3][rr] - mean;
      float s2 = d0 * d0 + d1 * d1 + d2 * d2 + d3 * d3;
      s2 += __shfl_xor(s2, 1); s2 += __shfl_xor(s2, 2); s2 += __shfl_xor(s2, 4); s2 += __shfl_xor(s2, 8);
      const float rstd = rsqrtf(s2 * (1.f / 64.f) + GN_EPS);
      Y[i * 68 + l16] = d0 * rstd * lw[0] + lb[0];
      Y[i * 68 + 16 + l16] = d1 * rstd * lw[1] + lb[1];
      Y[i * 68 + 32 + l16] = d2 * rstd * lw[2] + lb[2];
      Y[i * 68 + 48 + l16] = d3 * rstd * lw[3] + lb[3];
    }
  }
  asm volatile("s_waitcnt lgkmcnt(0)" ::: "memory");
  __builtin_amdgcn_wave_barrier();
  const int vc = (lane & 7) * 8;
#pragma unroll
  for (int ps = 0; ps < 8; ++ps) {
    const int i = 8 * ps + (lane >> 3);
    int R; bool valid;
    if (prompt) { const int pp = 64 * c - 48 + i; valid = pp >= 0; R = st * PT + (valid ? pp : 0); }
    else { R = NPR + 64 * st + i; valid = true; }
    if (valid) {
      const float4 y0 = *(const float4*)(Y + i * 68 + vc), y1 = *(const float4*)(Y + i * 68 + vc + 4);
      const float rkbv = p.rkb[(size_t)R * 4 + hd];
      const uint4 vv = *(const uint4*)(rwp + 40960 + (i * 64 + vc) * 2);
      const uint4 gc = *(const uint4*)(p.zL + (size_t)R * ZL + ZL_GC + hd * 64 + vc);
      uint4 o;
      o.x = pk2((y0.x + rkbv * bflo(vv.x)) * silu_(bflo(gc.x)), (y0.y + rkbv * bfhi(vv.x)) * silu_(bfhi(gc.x)));
      o.y = pk2((y0.z + rkbv * bflo(vv.y)) * silu_(bflo(gc.y)), (y0.w + rkbv * bfhi(vv.y)) * silu_(bfhi(gc.y)));
      o.z = pk2((y1.x + rkbv * bflo(vv.z)) * silu_(bflo(gc.z)), (y1.y + rkbv * bfhi(vv.z)) * silu_(bfhi(gc.z)));
      o.w = pk2((y1.z + rkbv * bflo(vv.w)) * silu_(bflo(gc.w)), (y1.w + rkbv * bfhi(vv.w)) * silu_(bfhi(gc.w)));
      *(uint4*)(mix + (size_t)R * D + 768 + hd * 64 + vc) = o;
    }
  }
  asm volatile("s_waitcnt lgkmcnt(0)" ::: "memory");
  __builtin_amdgcn_wave_barrier();
}

DEV void final_norm(const Prm& p) {
  int tid_ = threadIdx.x; LAUNDER(tid_);
  const int lane = tid_ & 63, gw = blockIdx.x * 4 + (tid_ >> 6), NW = gridDim.x * 4;
  for (int R = gw; R < NT; R += NW) {
    if (R < NPR && (R % PT) < 16) continue;
    float* yr = xrow_ptr(p, R);
    const bf16_t* xr = p.xb + (size_t)R * D;
    const float rstd = rsqrtf(p.ssq_x[2 * NTP + R] * (1.f / 1024.f) + RMS_EPS);
#pragma unroll
    for (int j = 0; j < 2; ++j) {
      const uint4 u = ((const uint4*)xr)[lane + 64 * j];
      const float4 g0 = ((const float4*)p.final_g)[2 * (lane + 64 * j)], g1 = ((const float4*)p.final_g)[2 * (lane + 64 * j) + 1];
      float4 o0, o1;
      o0.x = bflo(u.x) * rstd * g0.x; o0.y = bfhi(u.x) * rstd * g0.y; o0.z = bflo(u.y) * rstd * g0.z; o0.w = bfhi(u.y) * rstd * g0.w;
      o1.x = bflo(u.z) * rstd * g1.x; o1.y = bfhi(u.z) * rstd * g1.y; o1.z = bflo(u.w) * rstd * g1.z; o1.w = bfhi(u.w) * rstd * g1.w;
      ((float4*)yr)[2 * (lane + 64 * j)] = o0; ((float4*)yr)[2 * (lane + 64 * j) + 1] = o1;
    }
  }
}

#define XB_TMO      128
#define XB_XCNT(j)  (256  + 64 * (j))
#define XB_XSUB(j)  (1280 + 64 * (j))
#define XB_XGEN(j)  (2304 + 64 * (j))
#define XB_TOP      3328
#define XB_TOPGEN   3392
#define XCD_BAR_WORDS 3456
#define XB_SPIN_CAP (1u << 20)
#define LAS __attribute__((address_space(3)))
DEV unsigned xb_ld(unsigned* p) { return __hip_atomic_load(p, __ATOMIC_RELAXED, __HIP_MEMORY_SCOPE_AGENT); }
DEV unsigned xb_add(unsigned* p, unsigned v) { return __hip_atomic_fetch_add(p, v, __ATOMIC_RELAXED, __HIP_MEMORY_SCOPE_AGENT); }
DEV unsigned xb_xcc_id() { return (unsigned)__builtin_amdgcn_s_getreg((3 << 11) | 20) & 0xFu; }
#define XB_SPIN(cond, bar) do { unsigned _sp = 0; while (cond) { __builtin_amdgcn_s_sleep(1); \
    if ((++_sp & 255u) == 0u) { if (xb_ld(&(bar)[XB_TMO])) break; if (_sp > XB_SPIN_CAP) { atomicAdd(&(bar)[XB_TMO], 1u); break; } } } } while (0)
struct XcdBarrier { unsigned* bar; unsigned x; volatile LAS unsigned* st; };
DEV XcdBarrier xcd_barrier_post(unsigned* bar, volatile LAS unsigned* st) {
  XcdBarrier b; b.bar = bar; b.x = xb_xcc_id(); b.st = st;
  if (threadIdx.x == 0) (void)xb_add(&bar[XB_XCNT(b.x)], 1u);
  return b;
}
DEV void xcd_barrier_complete(unsigned* bar, unsigned x, unsigned& nloc, unsigned& nx) {
  const unsigned G = gridDim.x * gridDim.y * gridDim.z;
  unsigned sum, cnt, mine, sp = 0u;
  for (;;) {
    sum = 0u; cnt = 0u; mine = 0u;
#pragma unroll
    for (unsigned j = 0; j < 16; ++j) { const unsigned c = xb_ld(&bar[XB_XCNT(j)]); sum += c; cnt += (c > 0u) ? 1u : 0u; mine = (j == x) ? c : mine; }
    if (sum == G) break;
    __builtin_amdgcn_s_sleep(1);
    if ((++sp & 255u) == 0u) { if (xb_ld(&bar[XB_TMO])) break; if (sp > XB_SPIN_CAP) { atomicAdd(&bar[XB_TMO], 1u); break; } }
  }
  nloc = mine > 0u ? mine : 1u; nx = cnt > 0u ? cnt : 1u;
}
DEV void xcd_barrier(const XcdBarrier& b) {
  asm volatile("s_waitcnt vmcnt(0)" ::: "memory");
  __syncthreads();
  if (threadIdx.x == 0) {
    unsigned* bar = b.bar;
    __builtin_amdgcn_s_waitcnt(0);
    unsigned nloc = b.st[0], nx = b.st[1];
    if (nloc == 0u) { xcd_barrier_complete(bar, b.x, nloc, nx); b.st[0] = nloc; b.st[1] = nx; }
    const unsigned old = xb_add(&bar[XB_XSUB(b.x)], 1u);
    const unsigned gen = old / nloc;
    if (old + 1u == (gen + 1u) * nloc) {
      __builtin_amdgcn_fence(__ATOMIC_RELEASE, "agent");
      asm volatile("s_waitcnt vmcnt(0)" ::: "memory");
      const unsigned og = xb_add(&bar[XB_TOP], 1u);
      const unsigned tg = og / nx;
      if (og + 1u == (tg + 1u) * nx) xb_add(&bar[XB_TOPGEN], 1u);
      else XB_SPIN(xb_ld(&bar[XB_TOPGEN]) == tg, bar);
      __builtin_amdgcn_fence(__ATOMIC_ACQUIRE, "agent");
      xb_add(&bar[XB_XGEN(b.x)], 1u);
      asm volatile("s_waitcnt vmcnt(0)" ::: "memory");
    } else {
      XB_SPIN(xb_ld(&bar[XB_XGEN(b.x)]) == gen, bar);
      __builtin_amdgcn_fence(__ATOMIC_ACQUIRE, "agent");
      asm volatile("s_waitcnt vmcnt(0)" ::: "memory");
    }
  }
  __syncthreads();
}

#define QCTR(ph, L) (3584 + 64 * (2 * (ph) + (L)))
#define R2DONE(L) (3520 + 16 * (L))
DEV int next_item(unsigned* ctr, char* lds) {
  volatile int* slot = (volatile int*)(lds + LDS_BYTES - 8);
  __syncthreads();
  if (threadIdx.x == 0) *slot = (int)atomicAdd(ctr, 1u);
  __syncthreads();
  return *slot;
}
#define QXC(ph, L, x) (4096 + (((ph) * 2 + (L)) * 8 + (x)) * 16)
DEV int xq_next(unsigned* ctl, int ph, int L, int C, int N, int& k, int home, char* lds) {
  volatile int* slot = (volatile int*)(lds + LDS_BYTES - 8);
  __syncthreads();
  if (threadIdx.x == 0) {
    int res = -1, kk = k;
    while (kk < 8) {
      const int x = (home + kk) & 7, base = x * C;
      int size = N - base; size = size < C ? size : C;
      if (size > 0) { const int idx = (int)atomicAdd(ctl + QXC(ph, L, x), 1u); if (idx < size) { res = base + idx; break; } }
      ++kk;
    }
    slot[0] = res; slot[1] = kk;
  }
  __syncthreads();
  k = slot[1];
  return slot[0];
}
DEV int q_publish(int ticket, char* lds) {
  volatile int* slot = (volatile int*)(lds + LDS_BYTES - 8);
  __syncthreads();
  if (threadIdx.x == 0) *slot = ticket;
  __syncthreads();
  return *slot;
}
DEV int xq_resolve(unsigned* ctl, int ph, int L, int C, int N, int& k, int home, int ticket, char* lds) {
  volatile int* slot = (volatile int*)(lds + LDS_BYTES - 8);
  __syncthreads();
  if (threadIdx.x == 0) {
    int res = -1, kk = k;
    if (kk < 8) {
      const int x = (home + kk) & 7, base = x * C;
      int size = N - base; size = size < C ? size : C;
      if (ticket < size) res = base + ticket;
      else {
        ++kk;
        while (kk < 8) {
          const int x2 = (home + kk) & 7, base2 = x2 * C;
          int size2 = N - base2; size2 = size2 < C ? size2 : C;
          if (size2 > 0) { const int idx = (int)atomicAdd(ctl + QXC(ph, L, x2), 1u); if (idx < size2) { res = base2 + idx; break; } }
          ++kk;
        }
      }
    }
    slot[0] = res; slot[1] = kk;
  }
  __syncthreads();
  k = slot[1];
  return slot[0];
}
DEV unsigned* xq_ctr(unsigned* ctl, int ph, int L, int k, int home) { return k < 8 ? ctl + QXC(ph, L, (home + k) & 7) : nullptr; }
DEV int take_ticket(unsigned* nctr) { int tk = 0x7fffffff; if (nctr && threadIdx.x == 0) tk = (int)atomicAdd(nctr, 1u); return tk; }
struct XQueue {
  unsigned* ctl; int ph, L, C, N, k, home, t;
  DEV void prefetch() { t = take_ticket(xq_ctr(ctl, ph, L, k, home)); }
  DEV int resolve(char* lds) { return xq_resolve(ctl, ph, L, C, N, k, home, t, lds); }
};
template <class Epi, class Map>
DEV void gemm_stream(const bf16_t* __restrict__ A, int lda, const bf16_t* __restrict__ Bt, int ldb, int K, char* lds, const Epi& epi, XQueue& q) {
  int tid = threadIdx.x; LAUNDER(tid);
  const int lane = tid & 63, w = __builtin_amdgcn_readfirstlane(tid >> 6), wr = w >> 1, wc = w & 1;
  const int fr = lane & 15, fq = lane >> 4;
  const int sb = lane * 16, swz = sb ^ (((sb >> 9) & 1) << 5), rl = swz >> 6, cl = (swz & 63) >> 1;
  const int nk = K / 64;
  int offA[2], offB[2];
#pragma unroll
  for (int kh = 0; kh < 2; ++kh) { offA[kh] = lds_byte(wr * 64 + fr, kh * 32 + fq * 8); offB[kh] = lds_byte(wc * 64 + fr, kh * 32 + fq * 8); }
  q.prefetch();
  int item = q.resolve(lds);
  if (item < 0) return;
  int m0, n0; Map::map(item, m0, n0);
  const bf16_t* ga[4]; const bf16_t* gb[4];
#define SETPTR(M0, N0) { _Pragma("unroll") for (int i = 0; i < 4; ++i) { const int st = 4 * w + i, r = (st >> 1) * 16 + rl, c = (st & 1) * 32 + cl; \
      ga[i] = A + (size_t)((M0) + r) * lda + c; gb[i] = Bt + (size_t)((N0) + r) * ldb + c; } }
#define GSTAGE(S, KT) { _Pragma("unroll") for (int i = 0; i < 4; ++i) { \
      __builtin_amdgcn_global_load_lds((const unsigned*)(ga[i] + (KT) * 64), (LAS3 unsigned*)(lds + (S) * 32768 + (4 * w + i) * 1024 + lane * 16), 16, 0, 0); \
      __builtin_amdgcn_global_load_lds((const unsigned*)(gb[i] + (KT) * 64), (LAS3 unsigned*)(lds + (S) * 32768 + 16384 + (4 * w + i) * 1024 + lane * 16), 16, 0, 0); } }
  SETPTR(m0, n0)
  GSTAGE(0, 0)
  GSTAGE(1, 1)
  for (;;) {
    f32x4 acc[4][4];
#pragma unroll
    for (int i = 0; i < 4; ++i)
#pragma unroll
      for (int j = 0; j < 4; ++j) acc[i][j] = (f32x4){0.f, 0.f, 0.f, 0.f};
    for (int kt = 0; kt < nk; ++kt) {
      const int s = kt & 1;
      if (kt + 1 < nk) asm volatile("s_waitcnt vmcnt(8)" ::: "memory"); else asm volatile("s_waitcnt vmcnt(0)" ::: "memory");
      RAW_BARRIER()
      const char* ia = lds + s * 32768;
      const char* ib = ia + 16384;
      bf16x8 af[2][4], bfv[2][4];
#pragma unroll
      for (int kh = 0; kh < 2; ++kh) {
#pragma unroll
        for (int mi = 0; mi < 4; ++mi) af[kh][mi] = *(const bf16x8*)(ia + offA[kh] + mi * 2048);
#pragma unroll
        for (int ni = 0; ni < 4; ++ni) bfv[kh][ni] = *(const bf16x8*)(ib + offB[kh] + ni * 2048);
      }
      asm volatile("s_waitcnt lgkmcnt(8)" ::: "memory");
      __builtin_amdgcn_sched_barrier(0);
#pragma unroll
      for (int mi = 0; mi < 4; ++mi)
#pragma unroll
        for (int ni = 0; ni < 4; ++ni) acc[mi][ni] = mfma16(bfv[0][ni], af[0][mi], acc[mi][ni]);
      __builtin_amdgcn_sched_barrier(0);
      asm volatile("s_waitcnt lgkmcnt(0)" ::: "memory");
      RAW_BARRIER()
      if (kt + 2 < nk) GSTAGE(s, kt + 2)
      if (kt == nk - 3) q.prefetch();
      __builtin_amdgcn_sched_barrier(0);
#pragma unroll
      for (int mi = 0; mi < 4; ++mi)
#pragma unroll
        for (int ni = 0; ni < 4; ++ni) acc[mi][ni] = mfma16(bfv[1][ni], af[1][mi], acc[mi][ni]);
    }
    const int nxt = q.resolve(lds);
    const typename Epi::Pre pre = epi.preload(m0 + wr * 64, n0 + wc * 64, fr, fq);
    __builtin_amdgcn_sched_barrier(0);
    int m1 = 0, n1 = 0;
    if (nxt >= 0) { Map::map(nxt, m1, n1); SETPTR(m1, n1) GSTAGE(0, 0) GSTAGE(1, 1) }
    __builtin_amdgcn_sched_barrier(0);
    epi.finish(acc, pre, m0 + wr * 64, n0 + wc * 64, fr, fq);
    if (nxt < 0) break;
    m0 = m1; n0 = n1;
  }
#undef GSTAGE
#undef SETPTR
}
struct MapP1 { static DEV void map(int i, int& m0, int& n0) { int mt, nt; if (i < 18 * 192) { const int b = i / 192, r = i - b * 192; nt = r >> 3; mt = 8 * b + (r & 7); } else { nt = i - 18 * 192; mt = 144; } m0 = mt * 128; n0 = nt * 128; } };
struct MapP4 { static DEV void map(int i, int& m0, int& n0) { m0 = (i >> 3) * 128; n0 = (i & 7) * 128; } };
DEV void shift_rows_item(const Prm& p, int L, int b) {
  int tid0 = threadIdx.x; LAUNDER(tid0);
  if (tid0 < 224) {
    float4 v = make_float4(0.f, 0.f, 0.f, 0.f);
    if (b < 32) v = *(const float4*)(p.state_shift + ((size_t)L * 32 + b) * 896 + 4 * tid0);
    *(uint2*)(p.zE + (size_t)(NT + b) * ZE + ZE_ZC + 4 * tid0) = pk4(v.x, v.y, v.z, v.w);
  }
}
constexpr int N_ATT = 1312;
DEV void run_p1(const Prm& p, int L, char* lds) {
  const EpiIn epi{p, L};
  const int home = (int)(xb_xcc_id() & 7u);
  constexpr int N = 145 * 24, C = (N + 7) / 8;
  {
    XQueue q{p.ctl, 0, L, C, N, 0, home, 0};
    gemm_stream<EpiIn, MapP1>(p.xb, D, p.Wb_in + (size_t)L * INP * 1024, 1024, 1024, lds, epi, q);
  }
  unsigned* ctr = p.ctl + QCTR(3, L);
  int t = take_ticket(ctr);
  for (;;) {
    const int mt = q_publish(t, lds);
    if (mt >= 145 + 33) break;
    if (mt >= 145) { t = take_ticket(ctr); shift_rows_item(p, L, mt - 145); continue; }
    t = gemm_tile<EpiIn, 2>(p.xb, D, p.Wb_in + (size_t)L * INP * 1024, 1024, 1024, mt * 128, 24 * 128, lds, epi, ctr);
  }
}
DEV void run_p2(const Prm& p, int L, char* lds) {
  const EpiQ epq{p, L};
  constexpr int N1 = NRW, N2 = N1 + 129, N3 = N2 + 145 * 6, N4 = N3 + 16, N4b = N4 + 512, N5 = N4b + 36;
  const int N6 = L == 0 ? N5 + NWT : N5;
  unsigned* ctr = p.ctl + QCTR(0, L);
  for (;;) {
    const int id = next_item(ctr, lds);
    if (id >= N6) break;
    if (id >= N5) { conv_weights_item(p, 1, id - N5, lds); continue; }
    if (id < N1) r1_item(p, L, id, lds);
    else if (id < N2) kvproj_item(p, L, id - N1, lds);
    else if (id < N3) { const int t = id - N2, mt = t / 6, nt = t - mt * 6; gemm_tile(p.zE + ZE_CQ, ZE, p.Wb_uq + (size_t)L * 768 * 256, 256, 256, mt * 128, nt * 128, lds, epq); }
    else if (id < N4) sample_prep_item(p, L, id - N3);
    else if (id < N4b) lat_item(p, L, id - N4);
    else shift_item(p, L, id - N4b);
  }
}
DEV void run_p3(const Prm& p, int L, char* lds) {
  int tid_ = threadIdx.x; LAUNDER(tid_);
  const int lane = tid_ & 63, w = __builtin_amdgcn_readfirstlane(tid_ >> 6);
  {
    int ndone = 0;
    for (int wi = blockIdx.x * 4 + w; wi < 576; wi += gridDim.x * 4) { r2_wave(p, L, wi, lane); ++ndone; }
    if (blockIdx.x * 4 < 576) {
      asm volatile("s_waitcnt vmcnt(0)" ::: "memory");
      __syncthreads();
      if (threadIdx.x == 0) {
        int tot = 0;
        for (int wi = blockIdx.x * 4; wi < 576; wi += gridDim.x * 4) tot += (576 - wi) < 4 ? (576 - wi) : 4;
        __builtin_amdgcn_fence(__ATOMIC_RELEASE, "agent");
        asm volatile("s_waitcnt vmcnt(0)" ::: "memory");
        __hip_atomic_fetch_add(p.ctl + R2DONE(L), (unsigned)tot, __ATOMIC_RELAXED, __HIP_MEMORY_SCOPE_AGENT);
      }
    }
    (void)ndone;
  }
  unsigned* ctr = p.ctl + QCTR(1, L);
  for (;;) {
    const int q = next_item(ctr, lds);
    if (q >= 128) break;
    attn_sample(p, L, q >> 2, q & 3, lds);
  }
  {
    const int home = (int)(xb_xcc_id() & 7u);
    int k = 0;
    int tx = take_ticket(xq_ctr(p.ctl, 2, L, k, home));
    for (;;) {
      const int i = xq_resolve(p.ctl, 2, L, 128, 1024, k, home, tx, lds);
      if (i < 0) break;
      const int x = i >> 7, j = i & 127, qt = 31 - (j >> 2), pair = 4 * x + (j & 3);
      tx = attn_body<false>(p, L, pair >> 3, pair & 7, qt, lds, xq_ctr(p.ctl, 2, L, k, home));
    }
  }
  unsigned* ctr2 = p.ctl + QCTR(2, L);
  constexpr int NC = (NT + 31) / 32, NQ2 = 32 + NC + NRW / 4;
  bool r2_seen = false;
  for (;;) {
    const int q = next_item(ctr2, lds);
    if (q >= NQ2) break;
    constexpr int NR3 = NRW / 4;
    if (q >= NR3 + 32) conv_item(p, L, q - NR3 - 32);
    else if (q >= NR3) attn_item(p, L, 1280 + q - NR3, lds);
    else {
      if (!r2_seen) {
        if (threadIdx.x == 0) {
          unsigned sp = 0;
          while (__hip_atomic_load(p.ctl + R2DONE(L), __ATOMIC_RELAXED, __HIP_MEMORY_SCOPE_AGENT) < 576u) {
            __builtin_amdgcn_s_sleep(2);
            if (++sp > (1u << 22)) { atomicAdd(&p.ctl[XB_TMO], 1u); break; }
          }
          __builtin_amdgcn_fence(__ATOMIC_ACQUIRE, "agent");
          asm volatile("s_waitcnt vmcnt(0)" ::: "memory");
        }
        __syncthreads();
        r2_seen = true;
      }
      r3_wave(p, L, q * 4 + w, lane, (float*)(lds + w * 17408));
    }
  }
}
DEV void run_p4(const Prm& p, int L, char* lds) {
  const EpiOut epo{p, L};
  const int home = (int)(xb_xcc_id() & 7u);
  {
    XQueue q{p.ctl, 1, L, 128, 1024, 0, home, 0};
    gemm_stream<EpiOut, MapP4>(p.zE  , D, p.Wb_out + (size_t)L * 1024 * 1024, 1024, 1024, lds, epo, q);
  }
  unsigned* ctr = p.ctl + QCTR(3, L) + 16;
  int t = take_ticket(ctr);
  for (;;) {
    const int h = q_publish(t, lds);
    if (h >= 17 * 16) break;
    const int mt = 128 + (h >> 4), r = h & 15;
    t = gemm_tile<EpiOut, 4>(p.zE, D, p.Wb_out + (size_t)L * 1024 * 1024, 1024, 1024, mt * 128, (r >> 1) * 128 + (r & 1) * 64, lds, epo, ctr);
  }
}

__global__ void __launch_bounds__(256, 2) mega(Prm p) {
  extern __shared__ __attribute__((aligned(16))) char lds[];
  volatile LAS unsigned* st = (volatile LAS unsigned*)(lds + LDS_BYTES - 16);
  if (threadIdx.x == 0) { st[0] = 0u; st[1] = 0u; st[2] = 0u; st[3] = 0u; }
  __syncthreads();
  const XcdBarrier xb = xcd_barrier_post(p.ctl, st);
  phase0(p, lds);
  xcd_barrier(xb);
  for (int L = 0; L < 2; ++L) {
    run_p1(p, L, lds); xcd_barrier(xb);
    run_p2(p, L, lds); xcd_barrier(xb);
    run_p3(p, L, lds); xcd_barrier(xb);
    run_p4(p, L, lds); xcd_barrier(xb);
  }
  final_norm(p);
}

static size_t al256(size_t x) { return (x + 255) & ~(size_t)255; }
extern "C" void kernel_launch(void* const* d_in, const int* in_sizes, int n_in, void* d_out, int out_size, void* d_ws, size_t ws_size, hipStream_t stream) {
  Prm p{};
  const float* const* in = (const float* const*)d_in;
  p.x_prompt = in[0]; p.x_sample = in[1]; p.cache_ckv = in[2]; p.cache_krope = in[3]; p.state_conv = in[4]; p.state_shift = in[5]; p.state_wkv = in[6];
  p.meta = in[7]; p.norm_g = in[8]; p.w_in = in[9]; p.conv_w = in[10]; p.q_norm_g = in[11]; p.w_uq = in[12]; p.kv_norm_g = in[13]; p.w_ukv = in[14];
  p.shift_mu = in[15]; p.decay_w0 = in[16]; p.decay_w2 = in[17]; p.iclr_a0 = in[18]; p.iclr_a2 = in[19]; p.key_kk = in[20]; p.key_ka = in[21];
  p.bonus_rk = in[22]; p.lnx_w = in[23]; p.lnx_b = in[24]; p.w_out = in[25]; p.final_g = in[26];
  float* o = (float*)d_out;
  p.y_prompt = o; o += (size_t)4 * 4096 * 1024;
  p.y_sample = o; o += (size_t)32 * 64 * 1024;
  p.ckv_p = o; o += (size_t)2 * 4 * PT * 128;
  p.kr_p = o; o += (size_t)2 * 4 * PT * 32;
  p.conv_p = o; o += 2 * 4 * 2 * 256;
  p.shift_p = o; o += 2 * 4 * 896;
  p.wkv_p = o; o += 2 * 4 * 4 * 64 * 64;
  p.ckv_s = o; o += (size_t)2 * 32 * 64 * 128;
  p.kr_s = o; o += 2 * 32 * 64 * 32;
  p.conv_s = o; o += 2 * 32 * 2 * 256;
  p.shift_s = o; o += 2 * 32 * 896;
  p.wkv_s = o; o += 2 * 32 * 4 * 64 * 64;
  char* w = (char*)d_ws; size_t off = 0;
  auto take = [&](size_t bytes) { char* r = w + off; off = al256(off + bytes); return r; };
  p.ctl = (unsigned*)take(65536);
  p.Wb_in = (bf16_t*)take((size_t)2 * INP * 1024 * 2);
  p.Wb_uq = (bf16_t*)take((size_t)2 * 768 * 256 * 2);
  p.Wb_ukv = (bf16_t*)take((size_t)2 * 1024 * 128 * 2);
  p.Wb_out = (bf16_t*)take((size_t)2 * 1024 * 1024 * 2);
  p.dw2T = (bf16_t*)take((size_t)2 * 256 * 64 * 2);
  p.ia2T = (bf16_t*)take((size_t)2 * 256 * 64 * 2);
  p.ropec = (float*)take((size_t)PT * 16 * 4);
  p.ropes = (float*)take((size_t)PT * 16 * 4);
  p.ssq_x = (float*)take((size_t)7 * NTP * 4);
  p.ssq_q = p.ssq_x + 3 * NTP; p.ssq_kv = p.ssq_x + 5 * NTP;
  p.rkb = (float*)take((size_t)NTP * 4 * 4);
  p.xmeta = (float*)take((size_t)64 * 1024 * 4);
  p.zE = (bf16_t*)take((size_t)NTP * ZE * 2);
  p.zL = (bf16_t*)take((size_t)NTP * ZL * 2);
  p.xb = (bf16_t*)take((size_t)(NTP + 128) * D * 2);
  p.Kn = (bf16_t*)take((size_t)KVR * 512 * 2);
  p.Vt = (bf16_t*)take((size_t)512 * KVR * 2);
  p.Kr = (bf16_t*)take((size_t)KVR * 32 * 2);
  p.rw = take((size_t)NRW * RW_BYTES);
  p.KL = (bf16_t*)((char*)p.y_prompt + ((size_t)32 << 20));
  p.VLT = p.KL + (size_t)32 * SKEYS * 160;
  static int grid = 0;
  if (grid == 0) {
    if (off > ws_size) { fprintf(stderr, "kernel_launch: workspace too small: need %zu have %zu\n", off, ws_size); grid = -1; return; }
    int dev = 0, cus = 0, per_cu = 0;
    (void)hipGetDevice(&dev);
    (void)hipDeviceGetAttribute(&cus, hipDeviceAttributeMultiprocessorCount, dev);
    (void)hipFuncSetAttribute((const void*)mega, hipFuncAttributeMaxDynamicSharedMemorySize, LDS_BYTES);
    (void)hipOccupancyMaxActiveBlocksPerMultiprocessor(&per_cu, (const void*)mega, 256, LDS_BYTES);
    if (per_cu > 2) per_cu = 2;
    if (per_cu < 1) { fprintf(stderr, "kernel_launch: occupancy query returned %d\n", per_cu); per_cu = 1; }
    grid = cus * per_cu;
  }
  if (grid < 0) return;
  (void)hipMemsetAsync(p.ctl, 0, 8192 * 4, stream);
  void* args[] = {&p};
  hipError_t e = hipLaunchCooperativeKernel((const void*)mega, dim3(grid), dim3(256), args, LDS_BYTES, stream);
  if (e != hipSuccess) fprintf(stderr, "cooperative launch failed: %s (grid %d)\n", hipGetErrorString(e), grid);
}
```

```cpp
#include <hip/hip_runtime.h>
#include <cstdio>
#include <cstdint>
#include <type_traits>

typedef unsigned short bf16_t;
typedef short bf16x8 __attribute__((ext_vector_type(8)));
typedef float f32x4 __attribute__((ext_vector_type(4)));
typedef float f32x16 __attribute__((ext_vector_type(16)));
#define DEV __device__ __forceinline__
#define LAUNDER(x) asm volatile("" : "+v"(x))

constexpr int D = 1024;
constexpr int PT = 4112;
constexpr int NPR = 4 * PT;
constexpr int NSM = 32 * 64;
constexpr int NT = NPR + NSM;
constexpr int NTP = 18560;
constexpr int ZL = 1792;
constexpr int ZE = 1312;
constexpr int ZE_CQ = 0, ZE_CKV = 256, ZE_KR = 384, ZE_ZC = 416;
constexpr int ZL_XIN = 0, ZL_BG = 256, ZL_CG = 512, ZL_GA = 768, ZL_GB = 1024, ZL_GC = 1536;
constexpr int INP = 3200;
constexpr int KVR = 16512;
constexpr int NRW_P = 4 * 65 * 4;
constexpr int NRW = NRW_P + 32 * 4;
constexpr int RW_BYTES = 49152;
constexpr float RMS_EPS = 1e-6f;
constexpr float GN_EPS = 64e-5f;
constexpr int LDS_BYTES = 79872;
constexpr int SKEYS = 1088;

struct Prm {
  const float *x_prompt, *x_sample, *cache_ckv, *cache_krope, *state_conv, *state_shift, *state_wkv, *meta, *norm_g, *w_in,
      *conv_w, *q_norm_g, *w_uq, *kv_norm_g, *w_ukv, *shift_mu, *decay_w0, *decay_w2, *iclr_a0, *iclr_a2, *key_kk, *key_ka,
      *bonus_rk, *lnx_w, *lnx_b, *w_out, *final_g;
  float *y_prompt, *y_sample, *ckv_p, *kr_p, *conv_p, *shift_p, *wkv_p, *ckv_s, *kr_s, *conv_s, *shift_s, *wkv_s;
  unsigned* ctl;
  bf16_t *Wb_in, *Wb_uq, *Wb_ukv, *Wb_out, *dw2T, *ia2T;
  float *ropec, *ropes, *ssq_x, *ssq_q, *ssq_kv, *rkb, *xmeta;
  bf16_t *KL, *VLT;
  bf16_t *zE, *zL, *xb, *Kn, *Vt, *Kr;
  char* rw;
};

DEV float bf2f(bf16_t b) { return __uint_as_float((unsigned)b << 16); }
DEV float bflo(unsigned u) { return __uint_as_float(u << 16); }
DEV float bfhi(unsigned u) { return __uint_as_float(u & 0xffff0000u); }
typedef __bf16 hbf16x2_t __attribute__((ext_vector_type(2)));
typedef float hf32x2_t __attribute__((ext_vector_type(2)));
DEV unsigned pk2(float a, float b) { hf32x2_t f = {a, b}; hbf16x2_t r = __builtin_convertvector(f, hbf16x2_t); return __builtin_bit_cast(unsigned, r); }
DEV bf16_t f2bf(float f) { return (bf16_t)(pk2(f, 0.f) & 0xffffu); }
DEV uint2 pk4(float a, float b, float c, float d) { uint2 r; r.x = pk2(a, b); r.y = pk2(c, d); return r; }
DEV float sigmoid_(float x) { return 1.f / (1.f + __expf(-x)); }
DEV float silu_(float x) { return x / (1.f + __expf(-x)); }
DEV float wave_sum(float v) {
#pragma unroll
  for (int o = 1; o < 64; o <<= 1) v += __shfl_xor(v, o);
  return v;
}
DEV f32x16 mfma32(bf16x8 a, bf16x8 b, f32x16 c) { return __builtin_amdgcn_mfma_f32_32x32x16_bf16(a, b, c, 0, 0, 0); }
DEV f32x4 mfma16(bf16x8 a, bf16x8 b, f32x4 c) { return __builtin_amdgcn_mfma_f32_16x16x32_bf16(a, b, c, 0, 0, 0); }
DEV bf16x8 mk8(unsigned a, unsigned b, unsigned c, unsigned d) { uint4 u; u.x = a; u.y = b; u.z = c; u.w = d; return __builtin_bit_cast(bf16x8, u); }
DEV bf16x8 mk8(uint4 u) { return __builtin_bit_cast(bf16x8, u); }
DEV f32x16 zero16() { f32x16 z; for (int i = 0; i < 16; ++i) z[i] = 0.f; return z; }

DEV float* xrow_ptr(const Prm& p, int R) {
  if (R < NPR) { int s = R / PT, q = R - s * PT; return q < 16 ? p.xmeta + (size_t)(s * 16 + q) * D : p.y_prompt + ((size_t)s * 4096 + (q - 16)) * D; }
  return p.y_sample + (size_t)(R - NPR) * D;
}
DEV const float* xin_ptr(const Prm& p, int R) {
  if (R < NPR) { int s = R / PT, q = R - s * PT; return q < 16 ? p.meta + (size_t)q * D : p.x_prompt + ((size_t)s * 4096 + (q - 16)) * D; }
  return p.x_sample + (size_t)(R - NPR) * D;
}
DEV int pos_of(int R) { return R < NPR ? R % PT : 1024 + ((R - NPR) & 63); }

DEV int win_src_col(int n) {
  if (n < 1024) return n;
  if (n < 1536) return 1440 + (n - 1024);
  if (n < 1792) return 2848 + (n - 1536);
  if (n < 2208) return 1024 + (n - 1792);
  if (n < 3104) return 1952 + (n - 2208);
  return -1;
}
DEV int perm32(int rho) { const int n = rho >> 4, i = rho & 15; return 8 * (i >> 2) + 4 * n + (i & 3); }
template <bool PERM, bool P32>
DEV void conv_weight_tile(const float* __restrict__ src, int K, int N, int Npad, bf16_t* __restrict__ dst, const float* __restrict__ sk, float cst, int l, int item, float* T  , int tid) {
  const int ntn = Npad / 64, ntk = K / 64;
  const int r = item, kt = r / ntn, nt = r - kt * ntn;
  const int k0 = kt * 64, n0 = nt * 64;
  {
    const int nslot = n0 + (tid & 15) * 4;
    const int nn = P32 ? (nslot & ~31) + perm32(nslot & 31) : nslot;
    const int sn = PERM ? win_src_col(nn) : (nn < N ? nn : -1);
#pragma unroll
    for (int i = 0; i < 4; ++i) {
      const int k = (tid >> 4) + 16 * i;
      float4 v = make_float4(0.f, 0.f, 0.f, 0.f);
      if (sn >= 0) {
        v = *(const float4*)(src + ((size_t)l * K + k0 + k) * N + sn);
        const float s = (sk ? sk[l * K + k0 + k] : 1.f) * cst;
        v.x *= s; v.y *= s; v.z *= s; v.w *= s;
      }
      float* t = T + k * 65 + (tid & 15) * 4;
      t[0] = v.x; t[1] = v.y; t[2] = v.z; t[3] = v.w;
    }
  }
  __syncthreads();
  {
    const int n = tid >> 2, kc = tid & 3;
    float v[16];
#pragma unroll
    for (int j = 0; j < 16; ++j) v[j] = T[(16 * kc + j) * 65 + n];
    uint4 o0, o1;
    o0.x = pk2(v[0], v[1]); o0.y = pk2(v[2], v[3]); o0.z = pk2(v[4], v[5]); o0.w = pk2(v[6], v[7]);
    o1.x = pk2(v[8], v[9]); o1.y = pk2(v[10], v[11]); o1.z = pk2(v[12], v[13]); o1.w = pk2(v[14], v[15]);
    bf16_t* d = dst + ((size_t)l * Npad + n0 + n) * K + k0 + 16 * kc;
    *(uint4*)d = o0; *(uint4*)(d + 8) = o1;
  }
  __syncthreads();
}
constexpr int WT0 = 16 * 50, WT1 = WT0 + 16 * 16, WT2 = WT1 + 4 * 12, WT3 = WT2 + 2 * 16, WT4 = WT3 + 4, NWT = WT4 + 4;
DEV void conv_weights_item(const Prm& p, int l, int it, char* lds) {
  float* T = (float*)lds;
  int tid = threadIdx.x; LAUNDER(tid);
  if (it < WT0) conv_weight_tile<true, true>(p.w_in, 1024, 3104, INP, p.Wb_in, p.norm_g, 1.f, l, it, T, tid);
  else if (it < WT1) conv_weight_tile<false, true>(p.w_out, 1024, 1024, 1024, p.Wb_out, nullptr, 1.f, l, it - WT0, T, tid);
  else if (it < WT2) conv_weight_tile<false, false>(p.w_uq, 256, 768, 768, p.Wb_uq, p.q_norm_g, 0.10206207261596575f * 1.4426950408889634f, l, it - WT1, T, tid);
  else if (it < WT3) conv_weight_tile<false, false>(p.w_ukv, 128, 1024, 1024, p.Wb_ukv, nullptr, 1.f, l, it - WT2, T, tid);
  else if (it < WT4) conv_weight_tile<false, false>(p.decay_w2, 64, 256, 256, p.dw2T, nullptr, 1.f, l, it - WT3, T, tid);
  else conv_weight_tile<false, false>(p.iclr_a2, 64, 256, 256, p.ia2T, nullptr, 1.f, l, it - WT4, T, tid);
}
DEV void phase0(const Prm& p, char* lds) {
  int tid = threadIdx.x; LAUNDER(tid);
  const int lane = tid & 63, wv = tid >> 6;
  const int gw = blockIdx.x * 4 + wv, NW = gridDim.x * 4;
  const int gt = blockIdx.x * 256 + tid, NTH = gridDim.x * 256;
  for (int R = gw; R < NT; R += NW) {
    const float* src = xin_ptr(p, R);
    float ss = 0.f;
#pragma unroll
    for (int j = 0; j < 4; ++j) {
      const float4 v = ((const float4*)src)[lane + 64 * j];
      ss += v.x * v.x + v.y * v.y + v.z * v.z + v.w * v.w;
      ((uint2*)(p.xb + (size_t)R * D))[lane + 64 * j] = pk4(v.x, v.y, v.z, v.w);
    }
    ss = wave_sum(ss);
    if (lane == 0) p.ssq_x[R] = ss;
  }
  for (int i = gt; i < 6 * NTP; i += NTH) p.ssq_x[NTP + i] = 0.f;
  for (int it = blockIdx.x; it < NWT; it += gridDim.x) conv_weights_item(p, 0, it, lds);
  for (int i = gt; i < PT * 16; i += NTH) {
    const int pos = i >> 4, j = i & 15;
    const float inv = powf(10000.f, -(float)j * 2.0f / 32.f);
    const float ang = (float)pos * inv;
    double a = (double)ang;
    a -= 6.283185307179586476925 * rint(a * 0.15915494309189533577);
    p.ropec[i] = (float)cos(a);
    p.ropes[i] = (float)sin(a);
  }
}

#define LAS3 __attribute__((address_space(3)))
#define RAW_BARRIER() { asm volatile("" ::: "memory"); __builtin_amdgcn_s_barrier(); asm volatile("" ::: "memory"); }
DEV int lds_byte(int r, int c) { const int st = (r >> 4) * 2 + (c >> 5), rr = r & 15, cc = c & 31, ob = rr * 64 + cc * 2; return st * 1024 + (ob ^ (((ob >> 9) & 1) << 5)); }
template <class Epi, int NB = 8>
DEV int gemm_tile(const bf16_t* __restrict__ A, int lda, const bf16_t* __restrict__ Bt, int ldb, int K, int m0, int n0, char* lds, const Epi& epi, unsigned* nctr = nullptr) {
  int tid = threadIdx.x; LAUNDER(tid);
  const int lane = tid & 63, w = __builtin_amdgcn_readfirstlane(tid >> 6), wr = w >> 1, wc = w & 1;
  const int fr = lane & 15, fq = lane >> 4;
  const int sb = lane * 16, swz = sb ^ (((sb >> 9) & 1) << 5), rl = swz >> 6, cl = (swz & 63) >> 1;
  const bf16_t* ga[4]; const bf16_t* gb[4];
#pragma unroll
  for (int i = 0; i < 4; ++i) {
    const int st = 4 * w + i, r = (st >> 1) * 16 + rl, c = (st & 1) * 32 + cl;
    ga[i] = A + (size_t)(m0 + r) * lda + c;
    gb[i] = Bt + (size_t)(n0 + r) * ldb + c;
  }
  const int nk = K / 64;
#define GSTAGE(S, KT) { _Pragma("unroll") for (int i = 0; i < 4; ++i) { \
      __builtin_amdgcn_global_load_lds((const unsigned*)(ga[i] + (KT) * 64), (LAS3 unsigned*)(lds + (S) * 32768 + (4 * w + i) * 1024 + lane * 16), 16, 0, 0); \
      if (2 * w + (i >> 1) < NB) __builtin_amdgcn_global_load_lds((const unsigned*)(gb[i] + (KT) * 64), (LAS3 unsigned*)(lds + (S) * 32768 + 16384 + (4 * w + i) * 1024 + lane * 16), 16, 0, 0); } }
  f32x4 acc[4][4];
#pragma unroll
  for (int i = 0; i < 4; ++i)
#pragma unroll
    for (int j = 0; j < 4; ++j) acc[i][j] = (f32x4){0.f, 0.f, 0.f, 0.f};
  int offA[2], offB[2];
#pragma unroll
  for (int kh = 0; kh < 2; ++kh) { offA[kh] = lds_byte(wr * 64 + fr, kh * 32 + fq * 8); offB[kh] = lds_byte(wc * 64 + fr, kh * 32 + fq * 8); }
  GSTAGE(0, 0)
  if (nk > 1) GSTAGE(1, 1)
  for (int kt = 0; kt < nk; ++kt) {
    const int s = kt & 1;
    if (kt + 1 < nk) { if (2 * w < NB) asm volatile("s_waitcnt vmcnt(8)" ::: "memory"); else asm volatile("s_waitcnt vmcnt(4)" ::: "memory"); }
    else asm volatile("s_waitcnt vmcnt(0)" ::: "memory");
    RAW_BARRIER()
    const char* ia = lds + s * 32768;
    const char* ib = ia + 16384;
    bf16x8 af[2][4], bfv[2][4];
#pragma unroll
    for (int kh = 0; kh < 2; ++kh) {
#pragma unroll
      for (int mi = 0; mi < 4; ++mi) af[kh][mi] = *(const bf16x8*)(ia + offA[kh] + mi * 2048);
#pragma unroll
      for (int ni = 0; ni < (NB < 4 ? NB : 4); ++ni) bfv[kh][ni] = *(const bf16x8*)(ib + offB[kh] + ni * 2048);
    }
    asm volatile("s_waitcnt lgkmcnt(%0)" :: "n"(4 + (NB < 4 ? NB : 4)) : "memory");
    __builtin_amdgcn_sched_barrier(0);
    if (NB == 8 || wc == 0) {
#pragma unroll
      for (int mi = 0; mi < 4; ++mi)
#pragma unroll
        for (int ni = 0; ni < (NB < 4 ? NB : 4); ++ni) acc[mi][ni] = mfma16(bfv[0][ni], af[0][mi], acc[mi][ni]);
    }
    __builtin_amdgcn_sched_barrier(0);
    asm volatile("s_waitcnt lgkmcnt(0)" ::: "memory");
    RAW_BARRIER()
    if (kt + 2 < nk) GSTAGE(s, kt + 2)
    __builtin_amdgcn_sched_barrier(0);
    if (NB == 8 || wc == 0) {
#pragma unroll
      for (int mi = 0; mi < 4; ++mi)
#pragma unroll
        for (int ni = 0; ni < (NB < 4 ? NB : 4); ++ni) acc[mi][ni] = mfma16(bfv[1][ni], af[1][mi], acc[mi][ni]);
    }
  }
  __syncthreads();
#undef GSTAGE
  int tk = 0x7fffffff; if (nctr && tid == 0) tk = (int)atomicAdd(nctr, 1u);
  if (NB == 8 || wc == 0) epi(acc, m0 + wr * 64, n0 + wc * 64, fr, fq);
  return tk;
}

DEV int lds_byte32(int r, int c) { const int rr = r & 15, ob = rr * 64 + c * 2; return (r >> 4) * 1024 + (ob ^ (((ob >> 9) & 1) << 5)); }
template <class Epi>
DEV void gemm_tile_big(const bf16_t* __restrict__ A, int lda, const bf16_t* __restrict__ Bt, int ldb, int K, int m0, int n0, char* lds, const Epi& epi) {
  int tid = threadIdx.x; LAUNDER(tid);
  const int lane = tid & 63, w = __builtin_amdgcn_readfirstlane(tid >> 6), wr = w >> 1, wc = w & 1;
  const int fr = lane & 15, fq = lane >> 4;
  const int sb = lane * 16, swz = sb ^ (((sb >> 9) & 1) << 5), rl = swz >> 6, cl = (swz & 63) >> 1;
  const bf16_t* ga[4]; const bf16_t* gb[2];
#pragma unroll
  for (int i = 0; i < 4; ++i) ga[i] = A + (size_t)(m0 + (4 * w + i) * 16 + rl) * lda + cl;
#pragma unroll
  for (int i = 0; i < 2; ++i) gb[i] = Bt + (size_t)(n0 + (2 * w + i) * 16 + rl) * ldb + cl;
  const int nk = K / 32;
#define GSTAGE3(S, KT) { _Pragma("unroll") for (int i = 0; i < 4; ++i) \
      __builtin_amdgcn_global_load_lds((const unsigned*)(ga[i] + (KT) * 32), (LAS3 unsigned*)(lds + (S) * 24576 + (4 * w + i) * 1024 + lane * 16), 16, 0, 0); \
    _Pragma("unroll") for (int i = 0; i < 2; ++i) \
      __builtin_amdgcn_global_load_lds((const unsigned*)(gb[i] + (KT) * 32), (LAS3 unsigned*)(lds + (S) * 24576 + 16384 + (2 * w + i) * 1024 + lane * 16), 16, 0, 0); }
  f32x4 acc[8][4];
#pragma unroll
  for (int i = 0; i < 8; ++i)
#pragma unroll
    for (int j = 0; j < 4; ++j) acc[i][j] = (f32x4){0.f, 0.f, 0.f, 0.f};
  const int offA = lds_byte32(wr * 128 + fr, fq * 8), offB = 16384 + lds_byte32(wc * 64 + fr, fq * 8);
  GSTAGE3(0, 0)
  if (nk > 1) GSTAGE3(1, 1)
  int s = 0;
  for (int kt = 0; kt < nk; ++kt) {
    if (kt + 1 < nk) asm volatile("s_waitcnt vmcnt(6)" ::: "memory"); else asm volatile("s_waitcnt vmcnt(0)" ::: "memory");
    RAW_BARRIER()
    if (kt + 2 < nk) { const int s2 = s + 2 >= 3 ? s - 1 : s + 2; GSTAGE3(s2, kt + 2) }
    const char* im = lds + s * 24576;
    bf16x8 af[8], bfv[4];
#pragma unroll
    for (int ni = 0; ni < 4; ++ni) bfv[ni] = *(const bf16x8*)(im + offB + ni * 1024);
#pragma unroll
    for (int mi = 0; mi < 8; ++mi) af[mi] = *(const bf16x8*)(im + offA + mi * 1024);
#pragma unroll
    for (int mi = 0; mi < 8; ++mi)
#pragma unroll
      for (int ni = 0; ni < 4; ++ni) acc[mi][ni] = mfma16(bfv[ni], af[mi], acc[mi][ni]);
    s = s + 1 >= 3 ? 0 : s + 1;
  }
  __syncthreads();
#undef GSTAGE3
  epi(acc, m0 + wr * 128, n0 + wc * 64, fr, fq);
}

struct EpiIn {
  const Prm& p; int L;
  struct Pre { float s[4]; };
  DEV Pre preload(int mb, int nb, int fr, int fq) const {
    Pre r;
#pragma unroll
    for (int mi = 0; mi < 4; ++mi) r.s[mi] = p.ssq_x[L * NTP + mb + 16 * mi + fr];
    return r;
  }
  DEV void operator()(f32x4 (&acc)[4][4], int mb, int nb, int fr, int fq) const { finish(acc, preload(mb, nb, fr, fq), mb, nb, fr, fq); }
  DEV void finish(f32x4 (&acc)[4][4], const Pre& pre, int mb, int nb, int fr, int fq) const {
#pragma unroll
    for (int mi = 0; mi < 4; ++mi) {
      const int m = mb + 16 * mi + fr;
      const bool ok = m < NT;
      const float rstd = rsqrtf(pre.s[mi] * (1.f / 1024.f) + RMS_EPS);
      float sq = 0.f;
#pragma unroll
      for (int g = 0; g < 2; ++g) {
        const int n0 = nb + 32 * g;
        if (n0 >= 3104) continue;
        bf16_t* dst = n0 < ZL ? p.zL + (size_t)m * ZL + n0 : p.zE + (size_t)m * ZE + (n0 - ZL);
        float v[8];
#pragma unroll
        for (int j = 0; j < 4; ++j) { v[j] = acc[mi][2 * g][j] * rstd; v[4 + j] = acc[mi][2 * g + 1][j] * rstd; }
#pragma unroll
        for (int j = 0; j < 8; ++j) sq += v[j] * v[j];
        if (ok) { uint4 o; o.x = pk2(v[0], v[1]); o.y = pk2(v[2], v[3]); o.z = pk2(v[4], v[5]); o.w = pk2(v[6], v[7]); *(uint4*)(dst + 8 * fq) = o; }
      }
      if (nb >= ZL && nb < ZL + 384) {
        sq += __shfl_xor(sq, 16); sq += __shfl_xor(sq, 32);
        if (fq == 0 && ok) atomicAdd((nb < ZL + 256 ? p.ssq_q : p.ssq_kv) + L * NTP + m, sq);
      }
    }
  }
};
struct EpiQ {
  const Prm& p; int L;
  DEV void operator()(f32x4 (&acc)[4][4], int mb, int nb, int fr, int fq) const {
    bf16_t* Qb = (bf16_t*)p.y_prompt;
#pragma unroll
    for (int mi = 0; mi < 4; ++mi) {
      const int m = mb + 16 * mi + fr;
      const bool ok = m < NT;
      const float rstd = rsqrtf(p.ssq_q[L * NTP + m] * (1.f / 256.f) + RMS_EPS);
      const int pos = pos_of(ok ? m : 0);
#pragma unroll
      for (int np = 0; np < 2; ++np) {
        const int n0 = nb + 32 * np;
        float v[2][4];
#pragma unroll
        for (int h2 = 0; h2 < 2; ++h2)
#pragma unroll
          for (int j = 0; j < 4; ++j) v[h2][j] = acc[mi][2 * np + h2][j] * rstd;
        if (((n0 >> 5) % 3) == 2) {
#pragma unroll
          for (int j = 0; j < 4; ++j) {
            const int c = 4 * fq + j;
            const float cs = p.ropec[pos * 16 + c], sn = p.ropes[pos * 16 + c];
            const float x1 = v[0][j], x2 = v[1][j];
            v[0][j] = x1 * cs - x2 * sn; v[1][j] = x1 * sn + x2 * cs;
          }
        }
        if (ok) {
          *(uint2*)(Qb + (size_t)m * 768 + n0 + 4 * fq) = pk4(v[0][0], v[0][1], v[0][2], v[0][3]);
          *(uint2*)(Qb + (size_t)m * 768 + n0 + 16 + 4 * fq) = pk4(v[1][0], v[1][1], v[1][2], v[1][3]);
        }
      }
    }
  }
};
struct EpiOut {
  const Prm& p; int L;
  struct Pre { uint4 x[4][2]; };
  DEV Pre preload(int mb, int nb, int fr, int fq) const {
    Pre r;
#pragma unroll
    for (int mi = 0; mi < 4; ++mi) {
      const int m = mb + 16 * mi + fr;
      const bf16_t* xr = p.xb + (size_t)(m < NT ? m : 0) * D;
#pragma unroll
      for (int g = 0; g < 2; ++g) r.x[mi][g] = *(const uint4*)(xr + nb + 32 * g + 8 * fq);
    }
    return r;
  }
  DEV void operator()(f32x4 (&acc)[4][4], int mb, int nb, int fr, int fq) const { finish(acc, preload(mb, nb, fr, fq), mb, nb, fr, fq); }
  DEV void finish(f32x4 (&acc)[4][4], const Pre& pre, int mb, int nb, int fr, int fq) const {
#pragma unroll
    for (int mi = 0; mi < 4; ++mi) {
      const int m = mb + 16 * mi + fr;
      const bool ok = m < NT;
      bf16_t* xr = p.xb + (size_t)(ok ? m : 0) * D;
      float ss = 0.f;
#pragma unroll
      for (int g = 0; g < 2; ++g) {
        const int col = nb + 32 * g + 8 * fq;
        const uint4 xi = pre.x[mi][g];
        float v[8] = {bflo(xi.x), bfhi(xi.x), bflo(xi.y), bfhi(xi.y), bflo(xi.z), bfhi(xi.z), bflo(xi.w), bfhi(xi.w)};
#pragma unroll
        for (int j = 0; j < 4; ++j) { v[j] += acc[mi][2 * g][j]; v[4 + j] += acc[mi][2 * g + 1][j]; }
#pragma unroll
        for (int j = 0; j < 8; ++j) ss += v[j] * v[j];
        if (ok) { uint4 o; o.x = pk2(v[0], v[1]); o.y = pk2(v[2], v[3]); o.z = pk2(v[4], v[5]); o.w = pk2(v[6], v[7]); *(uint4*)(xr + col) = o; }
      }
      ss += __shfl_xor(ss, 16); ss += __shfl_xor(ss, 32);
      if (fq == 0 && ok) atomicAdd(p.ssq_x + (L + 1) * NTP + m, ss);
    }
  }
};

DEV void kv_prep_row(const Prm& p, int L, int R, int half, bool valid, bf16_t* At_row  ) {
  const int Rl = valid ? R : 0;
  const bf16_t* zr = p.zE + (size_t)Rl * ZE;
  const float rstd = rsqrtf(p.ssq_kv[L * NTP + Rl] * (1.f / 128.f) + RMS_EPS);
  float* outc; float* outk;
  if (Rl < NPR) { const int s = Rl / PT, q = Rl - s * PT; outc = p.ckv_p + (((size_t)L * 4 + s) * PT + q) * 128; outk = p.kr_p + (((size_t)L * 4 + s) * PT + q) * 32; }
  else { const int j = Rl - NPR; outc = p.ckv_s + ((size_t)L * NSM + j) * 128; outk = p.kr_s + ((size_t)L * NSM + j) * 32; }
  const float* g = p.kv_norm_g + L * 128 + 64 * half;
#pragma unroll
  for (int c8 = 0; c8 < 8; ++c8) {
    const uint4 u = *(const uint4*)(zr + ZE_CKV + 64 * half + 8 * c8);
    const float4 g0 = *(const float4*)(g + 8 * c8), g1 = *(const float4*)(g + 8 * c8 + 4);
    float4 y0, y1;
    y0.x = bflo(u.x) * rstd * g0.x; y0.y = bfhi(u.x) * rstd * g0.y; y0.z = bflo(u.y) * rstd * g0.z; y0.w = bfhi(u.y) * rstd * g0.w;
    y1.x = bflo(u.z) * rstd * g1.x; y1.y = bfhi(u.z) * rstd * g1.y; y1.z = bflo(u.w) * rstd * g1.z; y1.w = bfhi(u.w) * rstd * g1.w;
    if (valid) { *(float4*)(outc + 64 * half + 8 * c8) = y0; *(float4*)(outc + 64 * half + 8 * c8 + 4) = y1; }
    if (At_row) { uint4 o; o.x = pk2(y0.x, y0.y); o.y = pk2(y0.z, y0.w); o.z = pk2(y1.x, y1.y); o.w = pk2(y1.z, y1.w); *(uint4*)(At_row + 64 * half + 8 * c8) = o; }
    if (valid && Rl >= NPR) {
      const int j = Rl - NPR, b = j >> 6, r = j & 63;
      bf16_t* kl = p.KL + ((size_t)b * SKEYS + 1024 + r) * 160 + 16 * (4 * half + (c8 >> 1)) + 4 * (c8 & 1);
      *(uint2*)kl = pk4(y0.x, y0.y, y0.z, y0.w); *(uint2*)(kl + 8) = pk4(y1.x, y1.y, y1.z, y1.w);
    }
    if (c8 & 1) __builtin_amdgcn_sched_barrier(0);
  }
  if (half == 0) {
    const int pos = pos_of(Rl);
#pragma unroll
    for (int c8 = 0; c8 < 2; ++c8) {
      const uint4 u = *(const uint4*)(zr + ZE_KR + 8 * c8), v = *(const uint4*)(zr + ZE_KR + 16 + 8 * c8);
      const float x1[8] = {bflo(u.x), bfhi(u.x), bflo(u.y), bfhi(u.y), bflo(u.z), bfhi(u.z), bflo(u.w), bfhi(u.w)};
      const float x2[8] = {bflo(v.x), bfhi(v.x), bflo(v.y), bfhi(v.y), bflo(v.z), bfhi(v.z), bflo(v.w), bfhi(v.w)};
      float y1[8], y2[8];
#pragma unroll
      for (int e = 0; e < 8; ++e) {
        const float cs = p.ropec[pos * 16 + 8 * c8 + e], sn = p.ropes[pos * 16 + 8 * c8 + e];
        y1[e] = x1[e] * cs - x2[e] * sn; y2[e] = x1[e] * sn + x2[e] * cs;
      }
      if (valid) {
        float4 o;
        o.x = y1[0]; o.y = y1[1]; o.z = y1[2]; o.w = y1[3]; *(float4*)(outk + 8 * c8) = o;
        o.x = y1[4]; o.y = y1[5]; o.z = y1[6]; o.w = y1[7]; *(float4*)(outk + 8 * c8 + 4) = o;
        o.x = y2[0]; o.y = y2[1]; o.z = y2[2]; o.w = y2[3]; *(float4*)(outk + 16 + 8 * c8) = o;
        o.x = y2[4]; o.y = y2[5]; o.z = y2[6]; o.w = y2[7]; *(float4*)(outk + 16 + 8 * c8 + 4) = o;
        {
          const int j = Rl - NPR;
          bf16_t* krd = Rl < NPR ? p.Kr + (size_t)Rl * 32 : p.KL + ((size_t)(j >> 6) * SKEYS + 1024 + (j & 63)) * 160 + 128;
          uint4 q; q.x = pk2(y1[0], y1[1]); q.y = pk2(y1[2], y1[3]); q.z = pk2(y1[4], y1[5]); q.w = pk2(y1[6], y1[7]); *(uint4*)(krd + 8 * c8) = q;
          q.x = pk2(y2[0], y2[1]); q.y = pk2(y2[2], y2[3]); q.z = pk2(y2[4], y2[5]); q.w = pk2(y2[6], y2[7]); *(uint4*)(krd + 16 + 8 * c8) = q;
        }
      }
    }
  }
}
DEV void kvproj_item(const Prm& p, int L, int mt, char* lds) {
  int tid = threadIdx.x; LAUNDER(tid);
  const int lane = tid & 63, w = __builtin_amdgcn_readfirstlane(tid >> 6), wr = w >> 1, wc = w & 1, l31 = lane & 31, hh = lane >> 5;
  bf16_t* At = (bf16_t*)lds;
  bf16_t* Bs = At + 128 * 136;
  {
    const int r = tid >> 1, half = tid & 1, R = mt * 128 + r;
    kv_prep_row(p, L, R, half, R < NPR, At + r * 136);
  }
  for (int h = 0; h < 8; ++h) {
    __syncthreads();
    {
      const bf16_t* wsrc = p.Wb_ukv + ((size_t)L * 1024 + h * 128) * 128;
#pragma unroll
      for (int i = 0; i < 8; ++i) { const int id = tid + 256 * i, row = id >> 4, cc = id & 15; *(uint4*)(Bs + row * 136 + cc * 8) = *(const uint4*)(wsrc + row * 128 + cc * 8); }
    }
    __syncthreads();
    f32x16 acc[2][2];
#pragma unroll
    for (int i = 0; i < 2; ++i)
#pragma unroll
      for (int j = 0; j < 2; ++j) acc[i][j] = zero16();
    const bf16_t* as = At + (wr * 64 + l31) * 136 + hh * 8;
    const bf16_t* bs = Bs + (wc * 64 + l31) * 136 + hh * 8;
    if (wc == 0) {
#pragma unroll 2
      for (int ks = 0; ks < 8; ++ks) {
        const bf16x8 a0 = *(const bf16x8*)(as + ks * 16), a1 = *(const bf16x8*)(as + 32 * 136 + ks * 16);
        const bf16x8 b0 = *(const bf16x8*)(bs + ks * 16), b1 = *(const bf16x8*)(bs + 32 * 136 + ks * 16);
        acc[0][0] = mfma32(b0, a0, acc[0][0]); acc[0][1] = mfma32(b1, a0, acc[0][1]);
        acc[1][0] = mfma32(b0, a1, acc[1][0]); acc[1][1] = mfma32(b1, a1, acc[1][1]);
      }
#pragma unroll
      for (int i = 0; i < 2; ++i) {
        const int KRr = mt * 128 + wr * 64 + 32 * i + l31;
#pragma unroll
        for (int j = 0; j < 2; ++j)
#pragma unroll
          for (int G = 0; G < 4; ++G)
            *(uint2*)(p.Kn + ((size_t)KRr * 8 + h) * 64 + 32 * j + 8 * G + 4 * hh) = pk4(acc[i][j][4 * G], acc[i][j][4 * G + 1], acc[i][j][4 * G + 2], acc[i][j][4 * G + 3]);
      }
    } else {
#pragma unroll 2
      for (int ks = 0; ks < 8; ++ks) {
        const bf16x8 a0 = *(const bf16x8*)(as + ks * 16), a1 = *(const bf16x8*)(as + 32 * 136 + ks * 16);
        const bf16x8 b0 = *(const bf16x8*)(bs + ks * 16), b1 = *(const bf16x8*)(bs + 32 * 136 + ks * 16);
        acc[0][0] = mfma32(a0, b0, acc[0][0]); acc[0][1] = mfma32(a0, b1, acc[0][1]);
        acc[1][0] = mfma32(a1, b0, acc[1][0]); acc[1][1] = mfma32(a1, b1, acc[1][1]);
      }
#pragma unroll
      for (int j = 0; j < 2; ++j) {
        const int d = 32 * j + l31;
#pragma unroll
        for (int i = 0; i < 2; ++i)
#pragma unroll
          for (int G = 0; G < 4; ++G) {
            const int KRr = mt * 128 + wr * 64 + 32 * i + 16 * (G >> 1) + 8 * hh + 4 * (G & 1);
            *(uint2*)(p.Vt + ((size_t)h * 64 + d) * KVR + KRr) = pk4(acc[i][j][4 * G], acc[i][j][4 * G + 1], acc[i][j][4 * G + 2], acc[i][j][4 * G + 3]);
          }
      }
    }
  }
  __syncthreads();
}
DEV void sample_prep_item(const Prm& p, int L, int it) {
  int tid = threadIdx.x; LAUNDER(tid);
  const int R = NPR + it * 128 + (tid >> 1);
  kv_prep_row(p, L, R, tid & 1, true, nullptr);
}
DEV void shift_item(const Prm& p, int L, int st) {
  int tid0 = threadIdx.x; LAUNDER(tid0);
  if (tid0 < 224) {
    const int R = st < 4 ? st * PT + (PT - 1) : NPR + (st - 4) * 64 + 63;
    const uint2 u = *(const uint2*)(p.zE + (size_t)R * ZE + ZE_ZC + 4 * tid0);
    float4 v; v.x = bflo(u.x); v.y = bfhi(u.x); v.z = bflo(u.y); v.w = bfhi(u.y);
    float* dst = st < 4 ? p.shift_p + ((size_t)L * 4 + st) * 896 : p.shift_s + ((size_t)L * 32 + (st - 4)) * 896;
    *(float4*)(dst + 4 * tid0) = v;
  }
}

DEV void lat_item(const Prm& p, int L, int j) {
  int tid = threadIdx.x; LAUNDER(tid);
  const int b = j >> 4, t = j & 15;
  const float* csrc = p.cache_ckv + (((size_t)L * 32 + b) * 1024 + 64 * t) * 128;
  const float* ksrc = p.cache_krope + (((size_t)L * 32 + b) * 1024 + 64 * t) * 32;
  {
    const int row = tid >> 2, qd = tid & 3;
    const float* s = csrc + row * 128 + 32 * qd;
    bf16_t* d = p.KL + ((size_t)b * SKEYS + 64 * t + row) * 160;
    const float4 v0 = *(const float4*)(s), v1 = *(const float4*)(s + 4), v2 = *(const float4*)(s + 8), v3 = *(const float4*)(s + 12);
    const float4 v4 = *(const float4*)(s + 16), v5 = *(const float4*)(s + 20), v6 = *(const float4*)(s + 24), v7 = *(const float4*)(s + 28);
    const float4 k0 = *(const float4*)(ksrc + row * 32 + 8 * qd), k1 = *(const float4*)(ksrc + row * 32 + 8 * qd + 4);
    uint4 a;
    a.x = pk2(v0.x, v0.y); a.y = pk2(v0.z, v0.w); a.z = pk2(v2.x, v2.y); a.w = pk2(v2.z, v2.w); *(uint4*)(d + 32 * qd) = a;
    a.x = pk2(v1.x, v1.y); a.y = pk2(v1.z, v1.w); a.z = pk2(v3.x, v3.y); a.w = pk2(v3.z, v3.w); *(uint4*)(d + 32 * qd + 8) = a;
    a.x = pk2(v4.x, v4.y); a.y = pk2(v4.z, v4.w); a.z = pk2(v6.x, v6.y); a.w = pk2(v6.z, v6.w); *(uint4*)(d + 32 * qd + 16) = a;
    a.x = pk2(v5.x, v5.y); a.y = pk2(v5.z, v5.w); a.z = pk2(v7.x, v7.y); a.w = pk2(v7.z, v7.w); *(uint4*)(d + 32 * qd + 24) = a;
    a.x = pk2(k0.x, k0.y); a.y = pk2(k0.z, k0.w); a.z = pk2(k1.x, k1.y); a.w = pk2(k1.z, k1.w); *(uint4*)(d + 128 + 8 * qd) = a;
  }
}

template <bool SAMPLE>
DEV int attn_body(const Prm& p, int L, int sb, int head, int qt, char* lds, unsigned* nctr = nullptr) {
  int tid = threadIdx.x; LAUNDER(tid);
  const int lane = tid & 63, w = __builtin_amdgcn_readfirstlane(tid >> 6), l31 = lane & 31, hh = lane >> 5;
  bf16_t* Ks = (bf16_t*)lds;
  bf16_t* Vs = Ks + (SAMPLE ? 1 : 2) * 64 * 104;
  bf16_t* Cs = Vs + (SAMPLE ? 1 : 2) * 64 * 72;
  bf16_t* Wl = Cs + 64 * 136;
  const bf16_t* Qb = (const bf16_t*)p.y_prompt;
  bf16_t* mix = p.zE;
  int Rq0, ntiles, lastvis; bool wact, rowvalid;
  if (SAMPLE) { Rq0 = NPR + 64 * sb; ntiles = 17; lastvis = 16; wact = w < 2; rowvalid = wact; }
  else if (qt >= 0) { Rq0 = sb * PT + 16 + 128 * qt; ntiles = 2 * qt + 3; lastvis = 1 + 2 * qt + (w >> 1); wact = true; rowvalid = true; }
  else { Rq0 = sb * PT; ntiles = 1; lastvis = 0; wact = (w == 0); rowvalid = wact && l31 < 16; }
  const int myrow = Rq0 + 32 * w + l31;
  const int Rld = rowvalid ? myrow : Rq0;
  bf16x8 qf[6];
  {
    const bf16_t* qp = Qb + (size_t)Rld * 768 + head * 96 + hh * 8;
#pragma unroll
    for (int ks = 0; ks < 6; ++ks) qf[ks] = *(const bf16x8*)(qp + 16 * ks);
  }
  float m_run = -1e30f, l_run = 0.f;
  f32x16 o0 = zero16(), o1 = zero16();

  uint4 a_kn0, a_kn1, a_kr, a_vt0, a_vt1;
  a_kn0 = a_kn1 = a_kr = a_vt0 = a_vt1 = make_uint4(0, 0, 0, 0);
#define PLOADX(S, TI) { const int KR0 = sb * PT + ((TI) == 0 ? 0 : 16 + 64 * ((TI) - 1)); \
    S##_kn0 = *(const uint4*)(p.Kn + ((size_t)(KR0 + (tid >> 3)) * 8 + head) * 64 + (tid & 7) * 8); \
    S##_kn1 = *(const uint4*)(p.Kn + ((size_t)(KR0 + 32 + (tid >> 3)) * 8 + head) * 64 + (tid & 7) * 8); \
    S##_kr = *(const uint4*)(p.Kr + (size_t)(KR0 + (tid >> 2)) * 32 + (tid & 3) * 8); \
    S##_vt0 = *(const uint4*)(p.Vt + ((size_t)head * 64 + (tid >> 3)) * KVR + KR0 + (tid & 7) * 8); \
    S##_vt1 = *(const uint4*)(p.Vt + ((size_t)head * 64 + 32 + (tid >> 3)) * KVR + KR0 + (tid & 7) * 8); }
#define PWRITEX(S, BUF) { bf16_t* kb_ = Ks + (BUF) * 64 * 104; bf16_t* vb_ = Vs + (BUF) * 64 * 72; \
    *(uint4*)(kb_ + (tid >> 3) * 104 + (tid & 7) * 8) = S##_kn0; *(uint4*)(kb_ + (32 + (tid >> 3)) * 104 + (tid & 7) * 8) = S##_kn1; \
    *(uint4*)(kb_ + (tid >> 2) * 104 + 64 + (tid & 3) * 8) = S##_kr; \
    *(uint4*)(vb_ + (tid >> 3) * 72 + (tid & 7) * 8) = S##_vt0; *(uint4*)(vb_ + (32 + (tid >> 3)) * 72 + (tid & 7) * 8) = S##_vt1; }
  float4 pc0, pc1, pc2, pc3, pc4, pc5, pc6, pc7, pk0, pk1;
  pc0 = pc1 = pc2 = pc3 = pc4 = pc5 = pc6 = pc7 = pk0 = pk1 = make_float4(0.f, 0.f, 0.f, 0.f);
  if (SAMPLE) {
    const bf16_t* wsrc = p.Wb_ukv + ((size_t)L * 1024 + head * 128) * 128;
#pragma unroll
    for (int i = 0; i < 8; ++i) { const int id = tid + 256 * i, row = id >> 4, cc = id & 15; *(uint4*)(Wl + row * 136 + cc * 8) = *(const uint4*)(wsrc + row * 128 + cc * 8); }
  }
#define SLOAD(TI) { const float* csrc; const float* ksrc; \
    if ((TI) < 16) { csrc = p.cache_ckv + (((size_t)L * 32 + sb) * 1024 + 64 * (TI)) * 128; ksrc = p.cache_krope + (((size_t)L * 32 + sb) * 1024 + 64 * (TI)) * 32; } \
    else { csrc = p.ckv_s + ((size_t)L * NSM + 64 * sb) * 128; ksrc = p.kr_s + ((size_t)L * NSM + 64 * sb) * 32; } \
    const float* cb_ = csrc + (tid >> 5) * 128 + (tid & 31) * 4; \
    pc0 = *(const float4*)(cb_); pc1 = *(const float4*)(cb_ + 8 * 128); pc2 = *(const float4*)(cb_ + 16 * 128); pc3 = *(const float4*)(cb_ + 24 * 128); \
    pc4 = *(const float4*)(cb_ + 32 * 128); pc5 = *(const float4*)(cb_ + 40 * 128); pc6 = *(const float4*)(cb_ + 48 * 128); pc7 = *(const float4*)(cb_ + 56 * 128); \
    const float* kb2_ = ksrc + (tid >> 3) * 32 + (tid & 7) * 4; pk0 = *(const float4*)(kb2_); pk1 = *(const float4*)(kb2_ + 32 * 32); }
#define SWRITE(BUF) { bf16_t* cd_ = Cs + (tid >> 5) * 136 + (tid & 31) * 4; \
    *(uint2*)(cd_) = pk4(pc0.x, pc0.y, pc0.z, pc0.w); *(uint2*)(cd_ + 8 * 136) = pk4(pc1.x, pc1.y, pc1.z, pc1.w); \
    *(uint2*)(cd_ + 16 * 136) = pk4(pc2.x, pc2.y, pc2.z, pc2.w); *(uint2*)(cd_ + 24 * 136) = pk4(pc3.x, pc3.y, pc3.z, pc3.w); \
    *(uint2*)(cd_ + 32 * 136) = pk4(pc4.x, pc4.y, pc4.z, pc4.w); *(uint2*)(cd_ + 40 * 136) = pk4(pc5.x, pc5.y, pc5.z, pc5.w); \
    *(uint2*)(cd_ + 48 * 136) = pk4(pc6.x, pc6.y, pc6.z, pc6.w); *(uint2*)(cd_ + 56 * 136) = pk4(pc7.x, pc7.y, pc7.z, pc7.w); \
    }
#define SWRITEK(BUF) { bf16_t* kd_ = Ks + (BUF) * 64 * 104 + (tid >> 3) * 104 + 64 + (tid & 7) * 4; \
    *(uint2*)(kd_) = pk4(pk0.x, pk0.y, pk0.z, pk0.w); *(uint2*)(kd_ + 32 * 104) = pk4(pk1.x, pk1.y, pk1.z, pk1.w); }
  auto sexpand = [&](int buf) {
    const int a = w & 1, b = w >> 1;
    const bf16_t* cp = Cs + (32 * b + l31) * 136 + hh * 8;
    const bf16_t* wkp = Wl + (32 * a + l31) * 136 + hh * 8;
    const bf16_t* wvp = wkp + 64 * 136;
    f32x16 ka = zero16(), va = zero16();
#pragma unroll
    for (int ks = 0; ks < 8; ++ks) {
      const bf16x8 cf = *(const bf16x8*)(cp + 16 * ks);
      ka = mfma32(*(const bf16x8*)(wkp + 16 * ks), cf, ka);
      va = mfma32(cf, *(const bf16x8*)(wvp + 16 * ks), va);
    }
    bf16_t* kb = Ks + buf * 64 * 104; bf16_t* vb = Vs + buf * 64 * 72;
#pragma unroll
    for (int G = 0; G < 4; ++G) {
      *(uint2*)(kb + (32 * b + l31) * 104 + 32 * a + 8 * G + 4 * hh) = pk4(ka[4 * G], ka[4 * G + 1], ka[4 * G + 2], ka[4 * G + 3]);
      *(uint2*)(vb + (32 * a + l31) * 72 + 32 * b + 8 * G + 4 * hh) = pk4(va[4 * G], va[4 * G + 1], va[4 * G + 2], va[4 * G + 3]);
    }
  };
  const int x7 = (l31 >> 1) & 7, x3 = (l31 >> 2) & 3, xv = (l31 >> 1) & 7;
#define KFRAG(SP, KS, SUB) (SAMPLE ? *(const bf16x8*)((const bf16_t*)(SP) + (l31 + 32 * (SUB)) * 104 + hh * 8 + 16 * (KS)) \
    : ((KS) < 4 ? *(const bf16x8*)((SP) + (l31 + 32 * (SUB)) * 128 + (((2 * (KS) + hh) ^ x7) << 4)) \
                : *(const bf16x8*)((SP) + 8192 + (l31 + 32 * (SUB)) * 64 + (((2 * ((KS) - 4) + hh) ^ x3) << 4))))
#define VFR(S, SUB) (*(const bf16x8*)(sp + 12288 + (l31 + 32 * (SUB)) * 128 + (((2 * (S) + hh) ^ xv) << 4)))
#define VHALF(SP, C, SUB) (SAMPLE ? *(const uint2*)((const bf16_t*)(SP) + 64 * 104 + (l31 + 32 * (SUB)) * 72 + 4 * hh + 8 * (C)) \
    : *(const uint2*)((SP) + 12288 + (l31 + 32 * (SUB)) * 128 + 8 * hh + ((((C)) ^ xv) << 4)))
  auto compute_t = [&](auto masked_c, const char* sp) {
    constexpr bool MASKED = decltype(masked_c)::value;
    f32x16 s0 = zero16(), s1 = zero16();
    {
      bf16x8 kf[12];
#pragma unroll
      for (int ks = 0; ks < 6; ++ks) { kf[2 * ks] = KFRAG(sp, ks, 0); kf[2 * ks + 1] = KFRAG(sp, ks, 1); }
      __builtin_amdgcn_sched_barrier(0);
#pragma unroll
      for (int ks = 0; ks < 6; ++ks) { s0 = mfma32(kf[2 * ks], qf[ks], s0); s1 = mfma32(kf[2 * ks + 1], qf[ks], s1); }
    }
    bf16x8 vf[8];
    if (!SAMPLE) {
#pragma unroll
      for (int S = 0; S < 4; ++S) { vf[2 * S] = VFR(S, 0); vf[2 * S + 1] = VFR(S, 1); }
      __builtin_amdgcn_sched_barrier(0);
    }
    if (!SAMPLE && MASKED) {
#pragma unroll
      for (int r = 8; r < 16; ++r) s0[r] = -1e30f;
#pragma unroll
      for (int r = 0; r < 16; ++r) s1[r] = -1e30f;
    }
    float mx = s0[0];
#pragma unroll
    for (int r = 1; r < 16; ++r) mx = fmaxf(mx, s0[r]);
#pragma unroll
    for (int r = 0; r < 16; ++r) mx = fmaxf(mx, s1[r]);
    mx = fmaxf(mx, __shfl_xor(mx, 32));
    const float mnew = fmaxf(m_run, mx);
    const float alpha = __builtin_amdgcn_exp2f(m_run - mnew);
    m_run = mnew;
    float ps = 0.f;
#pragma unroll
    for (int r = 0; r < 16; ++r) { s0[r] = __builtin_amdgcn_exp2f(s0[r] - mnew); ps += s0[r]; }
#pragma unroll
    for (int r = 0; r < 16; ++r) { s1[r] = __builtin_amdgcn_exp2f(s1[r] - mnew); ps += s1[r]; }
    l_run = l_run * alpha + ps;
#pragma unroll
    for (int r = 0; r < 16; ++r) { o0[r] *= alpha; o1[r] *= alpha; }
    const bf16x8 pf0 = mk8(pk2(s0[0], s0[1]), pk2(s0[2], s0[3]), pk2(s0[4], s0[5]), pk2(s0[6], s0[7]));
    const bf16x8 pf1 = mk8(pk2(s0[8], s0[9]), pk2(s0[10], s0[11]), pk2(s0[12], s0[13]), pk2(s0[14], s0[15]));
    const bf16x8 pf2 = mk8(pk2(s1[0], s1[1]), pk2(s1[2], s1[3]), pk2(s1[4], s1[5]), pk2(s1[6], s1[7]));
    const bf16x8 pf3 = mk8(pk2(s1[8], s1[9]), pk2(s1[10], s1[11]), pk2(s1[12], s1[13]), pk2(s1[14], s1[15]));
#define PV_STEP(S, PF) { bf16x8 v0_, v1_; \
      if (SAMPLE) { const uint2 a0 = VHALF(sp, 2 * S, 0), b0 = VHALF(sp, 2 * S + 1, 0), a1 = VHALF(sp, 2 * S, 1), b1 = VHALF(sp, 2 * S + 1, 1); \
        v0_ = mk8(a0.x, a0.y, b0.x, b0.y); v1_ = mk8(a1.x, a1.y, b1.x, b1.y); } \
      else { v0_ = *(const bf16x8*)(sp + 12288 + l31 * 128 + (((2 * S + hh) ^ xv) << 4)); v1_ = *(const bf16x8*)(sp + 12288 + (l31 + 32) * 128 + (((2 * S + hh) ^ xv) << 4)); } \
      o0 = mfma32(v0_, PF, o0); o1 = mfma32(v1_, PF, o1); }
    if (SAMPLE) { PV_STEP(0, pf0) PV_STEP(1, pf1) PV_STEP(2, pf2) PV_STEP(3, pf3) }
    else {
      o0 = mfma32(vf[0], pf0, o0); o1 = mfma32(vf[1], pf0, o1); o0 = mfma32(vf[2], pf1, o0); o1 = mfma32(vf[3], pf1, o1);
      o0 = mfma32(vf[4], pf2, o0); o1 = mfma32(vf[5], pf2, o1); o0 = mfma32(vf[6], pf3, o0); o1 = mfma32(vf[7], pf3, o1);
    }
  };
  bf16x8 qf7 = mk8(0u, 0u, 0u, 0u);
  const bf16x8 kone = mk8(hh == 0 ? 0x3F80u : 0u, 0u, 0u, 0u);
  auto freeze = [&]() {
    const float mf = bflo(pk2(m_run, 0.f));
    const float fac = __builtin_amdgcn_exp2f(m_run - mf);
    l_run *= fac;
#pragma unroll
    for (int r = 0; r < 16; ++r) { o0[r] *= fac; o1[r] *= fac; }
    qf7 = mk8(hh == 0 ? (pk2(-mf, 0.f) & 0xffffu) : 0u, 0u, 0u, 0u);
  };
  auto compute_f = [&](const char* sp) {
    f32x16 s0, s1;
    {
      bf16x8 kf[12];
#pragma unroll
      for (int ks = 0; ks < 6; ++ks) { kf[2 * ks] = KFRAG(sp, ks, 0); kf[2 * ks + 1] = KFRAG(sp, ks, 1); }
      __builtin_amdgcn_sched_barrier(0);
      s0 = mfma32(kone, qf7, zero16()); s1 = mfma32(kone, qf7, zero16());
#pragma unroll
      for (int ks = 0; ks < 6; ++ks) { s0 = mfma32(kf[2 * ks], qf[ks], s0); s1 = mfma32(kf[2 * ks + 1], qf[ks], s1); }
    }
    bf16x8 vf[8];
    if (!SAMPLE) {
#pragma unroll
      for (int S = 0; S < 4; ++S) { vf[2 * S] = VFR(S, 0); vf[2 * S + 1] = VFR(S, 1); }
      __builtin_amdgcn_sched_barrier(0);
    }
    float ps = 0.f;
#pragma unroll
    for (int r = 0; r < 16; ++r) { s0[r] = __builtin_amdgcn_exp2f(s0[r]); ps += s0[r]; }
#pragma unroll
    for (int r = 0; r < 16; ++r) { s1[r] = __builtin_amdgcn_exp2f(s1[r]); ps += s1[r]; }
    l_run += ps;
    const bf16x8 pf0 = mk8(pk2(s0[0], s0[1]), pk2(s0[2], s0[3]), pk2(s0[4], s0[5]), pk2(s0[6], s0[7]));
    const bf16x8 pf1 = mk8(pk2(s0[8], s0[9]), pk2(s0[10], s0[11]), pk2(s0[12], s0[13]), pk2(s0[14], s0[15]));
    const bf16x8 pf2 = mk8(pk2(s1[0], s1[1]), pk2(s1[2], s1[3]), pk2(s1[4], s1[5]), pk2(s1[6], s1[7]));
    const bf16x8 pf3 = mk8(pk2(s1[8], s1[9]), pk2(s1[10], s1[11]), pk2(s1[12], s1[13]), pk2(s1[14], s1[15]));
    if (SAMPLE) { PV_STEP(0, pf0) PV_STEP(1, pf1) PV_STEP(2, pf2) PV_STEP(3, pf3) }
    else {
      o0 = mfma32(vf[0], pf0, o0); o1 = mfma32(vf[1], pf0, o1); o0 = mfma32(vf[2], pf1, o0); o1 = mfma32(vf[3], pf1, o1);
      o0 = mfma32(vf[4], pf2, o0); o1 = mfma32(vf[5], pf2, o1); o0 = mfma32(vf[6], pf3, o0); o1 = mfma32(vf[7], pf3, o1);
    }
#undef PV_STEP
  };

  if (SAMPLE) {
    SLOAD(0)
    for (int ti = 0; ti < ntiles; ++ti) {
      const int buf = 0;
      SWRITE(buf)
      __syncthreads();
      SWRITEK(buf)
      { const int tn = ti + 1 < ntiles ? ti + 1 : ti; SLOAD(tn) }
      sexpand(buf);
      __syncthreads();
      if (wact) { if (ti == 0) { compute_t(std::false_type{}, (const char*)Ks); freeze(); } else compute_f((const char*)Ks); }
    }
    __syncthreads();
  } else {
    const int l8 = lane >> 3, c8 = lane & 7;
    unsigned kn_o0, kn_o1, kr_o, vt_o0, vt_o1;
    { const int r = 8 * (2 * w) + l8; kn_o0 = (unsigned)((r * 8 + head) * 64 + ((c8 ^ ((r >> 1) & 7)) * 8)); }
    { const int r = 8 * (2 * w + 1) + l8; kn_o1 = (unsigned)((r * 8 + head) * 64 + ((c8 ^ ((r >> 1) & 7)) * 8)); }
    { const int r = 16 * w + (lane >> 2); kr_o = (unsigned)(r * 32 + (((lane & 3) ^ ((r >> 2) & 3)) * 8)); }
    { const int d = 8 * (2 * w) + l8; vt_o0 = (unsigned)((head * 64 + d) * KVR + ((c8 ^ ((d >> 1) & 7)) * 8)); }
    { const int d = 8 * (2 * w + 1) + l8; vt_o1 = (unsigned)((head * 64 + d) * KVR + ((c8 ^ ((d >> 1) & 7)) * 8)); }
#define GLDS16(G, Lp) __builtin_amdgcn_global_load_lds((const unsigned*)(G), (LAS3 unsigned*)(Lp), 16, 0, 0)
#define PDMA(TI, STG) { const int KR0 = sb * PT + ((TI) == 0 ? 0 : 16 + 64 * ((TI) - 1)); char* sb_ = lds + (STG) * 20480 + lane * 16; \
      const bf16_t* kn_ = p.Kn + (size_t)KR0 * 512; const bf16_t* kr_ = p.Kr + (size_t)KR0 * 32; const bf16_t* vt_ = p.Vt + KR0; \
      GLDS16(kn_ + kn_o0, sb_ + (2 * w) * 1024); GLDS16(kn_ + kn_o1, sb_ + (2 * w + 1) * 1024); GLDS16(kr_ + kr_o, sb_ + 8192 + w * 1024); \
      GLDS16(vt_ + vt_o0, sb_ + 12288 + (2 * w) * 1024); GLDS16(vt_ + vt_o1, sb_ + 12288 + (2 * w + 1) * 1024); }
    PDMA(0, 0)
    if (ntiles > 1) PDMA(1, 1)
    int stg = 0, stg2 = 2;
    for (int ti = 0; ti < ntiles; ++ti) {
      if (ti + 1 < ntiles) asm volatile("s_waitcnt vmcnt(5)" ::: "memory"); else asm volatile("s_waitcnt vmcnt(0)" ::: "memory");
      RAW_BARRIER()
      if (ti + 2 < ntiles) PDMA(ti + 2, stg2)
      const char* sp = lds + stg * 20480;
      if (ti == 0) { if (wact) compute_t(std::true_type{}, sp); }
      else if (ti == 1) { compute_t(std::false_type{}, sp); freeze(); }
      else if (ti <= lastvis) compute_f(sp);
      stg = stg == 2 ? 0 : stg + 1; stg2 = stg2 == 2 ? 0 : stg2 + 1;
    }
    __syncthreads();
#undef PDMA
#undef GLDS16
  }
  int tk = 0x7fffffff; if (nctr && tid == 0) tk = (int)atomicAdd(nctr, 1u);
  const float lt = l_run + __shfl_xor(l_run, 32);
  if (rowvalid) {
    const float inv = 1.f / lt;
    const bf16_t* gbp = p.zL + (size_t)myrow * ZL + ZL_GB + 64 * head;
    bf16_t* op = mix + (size_t)myrow * D + 256 + 64 * head;
#pragma unroll
    for (int G = 0; G < 4; ++G) {
      const int d = 8 * G + 4 * hh;
      const uint2 g0 = *(const uint2*)(gbp + d), g1 = *(const uint2*)(gbp + 32 + d);
      *(uint2*)(op + d) = pk4(o0[4 * G] * inv * silu_(bflo(g0.x)), o0[4 * G + 1] * inv * silu_(bfhi(g0.x)), o0[4 * G + 2] * inv * silu_(bflo(g0.y)), o0[4 * G + 3] * inv * silu_(bfhi(g0.y)));
      *(uint2*)(op + 32 + d) = pk4(o1[4 * G] * inv * silu_(bflo(g1.x)), o1[4 * G + 1] * inv * silu_(bfhi(g1.x)), o1[4 * G + 2] * inv * silu_(bflo(g1.y)), o1[4 * G + 3] * inv * silu_(bfhi(g1.y)));
    }
  }
  return tk;
}
DEV void attn_item(const Prm& p, int L, int id, char* lds) {
  if (id < 1024) { const int qt = 31 - (id >> 5), sh = id & 31; attn_body<false>(p, L, sh >> 3, sh & 7, qt, lds); }
  else if (id < 1280) { const int j = id - 1024; attn_body<true>(p, L, j >> 3, j & 7, 0, lds); }
  else { const int j = id - 1280; attn_body<false>(p, L, j >> 3, j & 7, -1, lds); }
}

typedef short v4i16_t __attribute__((ext_vector_type(4)));
DEV uint2 lds_tr16(const char* pl) { const v4i16_t r = __builtin_amdgcn_ds_read_tr16_b64_v4i16((__attribute__((address_space(3))) v4i16_t*)pl); return __builtin_bit_cast(uint2, r); }
DEV void attn_sample(const Prm& p, int L, int b, int hp, char* lds) {
  int tid = threadIdx.x; LAUNDER(tid);
  const int lane = tid & 63, w = __builtin_amdgcn_readfirstlane(tid >> 6), l31 = lane & 31, hh = lane >> 5;
  const int head = 2 * hp + (w >> 1);
  const bf16_t* Qb = (const bf16_t*)p.y_prompt;
  bf16_t* mix = p.zE;
  const int myrow = NPR + 64 * b + 32 * (w & 1) + l31;
  bf16x8 qf[6];
  {
    const bf16_t* qp = Qb + (size_t)myrow * 768 + head * 96 + hh * 8;
#pragma unroll
    for (int ks = 0; ks < 6; ++ks) qf[ks] = *(const bf16x8*)(qp + 16 * ks);
  }
  unsigned kl_o0, kl_o1, kl_o2, kl_o3, kr_o;
  {
    const int l16 = lane >> 4, c16 = lane & 15;
#define KROW(i) (4 * (4 * w + (i)) + l16)
#define KLO(i) ((unsigned)(KROW(i) * 160 + ((c16 ^ (((KROW(i) & 3) << 2) | ((KROW(i) >> 2) & 3))) * 8)))
    kl_o0 = KLO(0); kl_o1 = KLO(1); kl_o2 = KLO(2); kl_o3 = KLO(3);
#undef KLO
#undef KROW
    const int r = 16 * w + (lane >> 2);
    kr_o = (unsigned)(r * 160 + 128 + (((lane & 3) ^ ((r >> 2) & 3)) * 8));
  }
  const bf16_t* klb = p.KL + (size_t)b * SKEYS * 160;
#define GLDS16(G, Lp) __builtin_amdgcn_global_load_lds((const unsigned*)(G), (LAS3 unsigned*)(Lp), 16, 0, 0)
#define SDMA(TI, STG) { char* sb_ = lds + (STG) * 20480 + lane * 16; const bf16_t* kl_ = klb + (size_t)(TI) * 64 * 160; \
    GLDS16(kl_ + kl_o0, sb_ + (4 * w) * 1024); GLDS16(kl_ + kl_o1, sb_ + (4 * w + 1) * 1024); GLDS16(kl_ + kl_o2, sb_ + (4 * w + 2) * 1024); GLDS16(kl_ + kl_o3, sb_ + (4 * w + 3) * 1024); \
    GLDS16(kl_ + kr_o, sb_ + 16384 + w * 1024); }
  SDMA(0, 0)
  SDMA(1, 1)
  bf16x8 qa0, qa1, qa2, qa3, qa4, qa5, qa6, qa7;
  {
    const float* wsrc = p.w_ukv + ((size_t)L * 128 + l31) * 1024 + head * 128 + 8 * hh;
#define QABS(CT, QA, QB) { f32x16 acc = zero16(); \
      _Pragma("unroll") for (int ks = 0; ks < 4; ++ks) { const float* s_ = wsrc + (size_t)(32 * (CT)) * 1024 + 16 * ks; const float4 a_ = *(const float4*)s_, c_ = *(const float4*)(s_ + 4); \
        acc = mfma32(mk8(pk2(a_.x, a_.y), pk2(a_.z, a_.w), pk2(c_.x, c_.y), pk2(c_.z, c_.w)), qf[ks], acc); } \
      QA = mk8(pk2(acc[0], acc[1]), pk2(acc[2], acc[3]), pk2(acc[4], acc[5]), pk2(acc[6], acc[7])); \
      QB = mk8(pk2(acc[8], acc[9]), pk2(acc[10], acc[11]), pk2(acc[12], acc[13]), pk2(acc[14], acc[15])); }
    QABS(0, qa0, qa1) QABS(1, qa2, qa3) QABS(2, qa4, qa5) QABS(3, qa6, qa7)
#undef QABS
  }
  float m_run = -1e30f, l_run = 0.f;
  f32x16 o0 = zero16(), o1 = zero16(), o2 = zero16(), o3 = zero16();
  bf16x8 qf7 = mk8(0u, 0u, 0u, 0u);
  const bf16x8 kone = mk8(hh == 0 ? 0x3F80u : 0u, 0u, 0u, 0u);
  const int xk = ((l31 & 3) << 2) | ((l31 >> 2) & 3), x3 = (l31 >> 2) & 3;
  int va0, va1;
  {
    const int g = l31 >> 4, q = (l31 >> 2) & 3, pp = l31 & 3;
    const int rowb = (4 * hh + q) * 256 + 8 * (pp & 1) + (q << 6);
    va0 = rowb + (((2 * g + (pp >> 1)) ^ hh) << 4);
    va1 = rowb + 2048 + (((2 * g + (pp >> 1)) ^ (hh + 2)) << 4);
  }
  int stg = 0, stg2 = 2;
  for (int ti = 0; ti < 17; ++ti) {
    if (ti + 1 < 17) asm volatile("s_waitcnt vmcnt(5)" ::: "memory"); else asm volatile("s_waitcnt vmcnt(0)" ::: "memory");
    RAW_BARRIER()
    if (ti + 2 < 17) SDMA(ti + 2, stg2)
    const char* sp = lds + stg * 20480;
    f32x16 s0 = mfma32(kone, qf7, zero16()), s1 = s0;
#define QKL(S, QA) { const bf16x8 k0 = *(const bf16x8*)(sp + l31 * 256 + (((2 * (S) + hh) ^ xk) << 4)), k1 = *(const bf16x8*)(sp + (l31 + 32) * 256 + (((2 * (S) + hh) ^ xk) << 4)); \
      s0 = mfma32(k0, QA, s0); s1 = mfma32(k1, QA, s1); }
    QKL(0, qa0) QKL(1, qa1) QKL(2, qa2) QKL(3, qa3) QKL(4, qa4) QKL(5, qa5) QKL(6, qa6) QKL(7, qa7)
#undef QKL
#pragma unroll
    for (int kr = 0; kr < 2; ++kr) {
      const bf16x8 k0 = *(const bf16x8*)(sp + 16384 + l31 * 64 + (((2 * kr + hh) ^ x3) << 4)), k1 = *(const bf16x8*)(sp + 16384 + (l31 + 32) * 64 + (((2 * kr + hh) ^ x3) << 4));
      s0 = mfma32(k0, qf[4 + kr], s0); s1 = mfma32(k1, qf[4 + kr], s1);
    }
    float ps = 0.f;
    if (ti == 0) {
      float mx = s0[0];
#pragma unroll
      for (int r = 1; r < 16; ++r) mx = fmaxf(mx, s0[r]);
#pragma unroll
      for (int r = 0; r < 16; ++r) mx = fmaxf(mx, s1[r]);
      mx = fmaxf(mx, __shfl_xor(mx, 32));
      m_run = bflo(pk2(mx, 0.f));
#pragma unroll
      for (int r = 0; r < 16; ++r) { s0[r] -= m_run; s1[r] -= m_run; }
      qf7 = mk8(hh == 0 ? (pk2(-m_run, 0.f) & 0xffffu) : 0u, 0u, 0u, 0u);
    }
#pragma unroll
    for (int r = 0; r < 16; ++r) { s0[r] = __builtin_amdgcn_exp2f(s0[r]); ps += s0[r]; }
#pragma unroll
    for (int r = 0; r < 16; ++r) { s1[r] = __builtin_amdgcn_exp2f(s1[r]); ps += s1[r]; }
    l_run += ps;
    const bf16x8 pf0 = mk8(pk2(s0[0], s0[1]), pk2(s0[2], s0[3]), pk2(s0[4], s0[5]), pk2(s0[6], s0[7]));
    const bf16x8 pf1 = mk8(pk2(s0[8], s0[9]), pk2(s0[10], s0[11]), pk2(s0[12], s0[13]), pk2(s0[14], s0[15]));
    const bf16x8 pf2 = mk8(pk2(s1[0], s1[1]), pk2(s1[2], s1[3]), pk2(s1[4], s1[5]), pk2(s1[6], s1[7]));
    const bf16x8 pf3 = mk8(pk2(s1[8], s1[9]), pk2(s1[10], s1[11]), pk2(s1[12], s1[13]), pk2(s1[14], s1[15]));
#define PVT(S, CT, PF, OT) { const uint2 a_ = lds_tr16(sp + (va0 ^ ((CT) << 6)) + (S) * 4096), b_ = lds_tr16(sp + (va1 ^ ((CT) << 6)) + (S) * 4096); \
      OT = mfma32(mk8(a_.x, a_.y, b_.x, b_.y), PF, OT); }
#define PVL(S, PF) PVT(S, 0, PF, o0) PVT(S, 1, PF, o1) PVT(S, 2, PF, o2) PVT(S, 3, PF, o3)
    PVL(0, pf0) PVL(1, pf1) PVL(2, pf2) PVL(3, pf3)
#undef PVL
#undef PVT
    stg = stg == 2 ? 0 : stg + 1; stg2 = stg2 == 2 ? 0 : stg2 + 1;
  }
#undef SDMA
#undef GLDS16
  __syncthreads();
  const float lt = l_run + __shfl_xor(l_run, 32);
  const float inv = 1.f / lt;
  f32x16 e0 = zero16(), e1 = zero16();
  const bf16_t* wv = p.Wb_ukv + ((size_t)L * 1024 + head * 128 + 64 + l31) * 128 + 8 * hh;
#define OEXP(S, OT, RB) { const bf16x8 ob = mk8(pk2(OT[RB] * inv, OT[RB + 1] * inv), pk2(OT[RB + 2] * inv, OT[RB + 3] * inv), pk2(OT[RB + 4] * inv, OT[RB + 5] * inv), pk2(OT[RB + 6] * inv, OT[RB + 7] * inv)); \
    e0 = mfma32(*(const bf16x8*)(wv + 16 * (S)), ob, e0); e1 = mfma32(*(const bf16x8*)(wv + 32 * 128 + 16 * (S)), ob, e1); }
  OEXP(0, o0, 0) OEXP(1, o0, 8) OEXP(2, o1, 0) OEXP(3, o1, 8) OEXP(4, o2, 0) OEXP(5, o2, 8) OEXP(6, o3, 0) OEXP(7, o3, 8)
#undef OEXP
  {
    const bf16_t* gbp = p.zL + (size_t)myrow * ZL + ZL_GB + 64 * head;
    bf16_t* op = mix + (size_t)myrow * D + 256 + 64 * head;
#pragma unroll
    for (int G = 0; G < 4; ++G) {
      const int d = 8 * G + 4 * hh;
      const uint2 g0 = *(const uint2*)(gbp + d), g1 = *(const uint2*)(gbp + 32 + d);
      *(uint2*)(op + d) = pk4(e0[4 * G] * silu_(bflo(g0.x)), e0[4 * G + 1] * silu_(bfhi(g0.x)), e0[4 * G + 2] * silu_(bflo(g0.y)), e0[4 * G + 3] * silu_(bfhi(g0.y)));
      *(uint2*)(op + 32 + d) = pk4(e1[4 * G] * silu_(bflo(g1.x)), e1[4 * G + 1] * silu_(bfhi(g1.x)), e1[4 * G + 2] * silu_(bflo(g1.y)), e1[4 * G + 3] * silu_(bfhi(g1.y)));
    }
  }
}

DEV void conv_item(const Prm& p, int L, int item) {
  int tid = threadIdx.x; LAUNDER(tid);
  bf16_t* mix = p.zE;
  const int c0 = (tid & 31) * 8;
  float w0[8], w1[8], w2[8];
#pragma unroll
  for (int e = 0; e < 8; ++e) { w0[e] = p.conv_w[(L * 3 + 0) * 256 + c0 + e]; w1[e] = p.conv_w[(L * 3 + 1) * 256 + c0 + e]; w2[e] = p.conv_w[(L * 3 + 2) * 256 + c0 + e]; }
  for (int it = 0; it < 4; ++it) {
    const int R = item * 32 + it * 8 + (tid >> 5);
    if (R >= NT) continue;
    int q, T; const float* st; float* so;
    if (R < NPR) { const int s = R / PT; q = R - s * PT; T = PT; st = nullptr; so = p.conv_p + ((size_t)L * 4 + s) * 512; }
    else { const int b = (R - NPR) >> 6; q = (R - NPR) & 63; T = 64; st = p.state_conv + ((size_t)L * 32 + b) * 512; so = p.conv_s + ((size_t)L * 32 + b) * 512; }
    float u[3][8];
#pragma unroll
    for (int dlt = 0; dlt < 3; ++dlt) {
      const int t = q - 2 + dlt;
      if (t >= 0) {
        const bf16_t* zr = p.zL + (size_t)(R - 2 + dlt) * ZL;
        const uint4 xi = *(const uint4*)(zr + ZL_XIN + c0), cg = *(const uint4*)(zr + ZL_CG + c0);
        u[dlt][0] = bflo(xi.x) * bflo(cg.x); u[dlt][1] = bfhi(xi.x) * bfhi(cg.x); u[dlt][2] = bflo(xi.y) * bflo(cg.y); u[dlt][3] = bfhi(xi.y) * bfhi(cg.y);
        u[dlt][4] = bflo(xi.z) * bflo(cg.z); u[dlt][5] = bfhi(xi.z) * bfhi(cg.z); u[dlt][6] = bflo(xi.w) * bflo(cg.w); u[dlt][7] = bfhi(xi.w) * bfhi(cg.w);
      } else if (st) {
        const float* sr = st + (t + 2) * 256 + c0;
#pragma unroll
        for (int e = 0; e < 8; ++e) u[dlt][e] = sr[e];
      } else {
#pragma unroll
        for (int e = 0; e < 8; ++e) u[dlt][e] = 0.f;
      }
    }
    const bf16_t* zr = p.zL + (size_t)R * ZL;
    const uint4 bg = *(const uint4*)(zr + ZL_BG + c0), ga = *(const uint4*)(zr + ZL_GA + c0);
    const float bgf[8] = {bflo(bg.x), bfhi(bg.x), bflo(bg.y), bfhi(bg.y), bflo(bg.z), bfhi(bg.z), bflo(bg.w), bfhi(bg.w)};
    const float gaf[8] = {bflo(ga.x), bfhi(ga.x), bflo(ga.y), bfhi(ga.y), bflo(ga.z), bfhi(ga.z), bflo(ga.w), bfhi(ga.w)};
    float y[8];
#pragma unroll
    for (int e = 0; e < 8; ++e) y[e] = bgf[e] * (w0[e] * u[0][e] + w1[e] * u[1][e] + w2[e] * u[2][e]) * silu_(gaf[e]);
    uint4 o; o.x = pk2(y[0], y[1]); o.y = pk2(y[2], y[3]); o.z = pk2(y[4], y[5]); o.w = pk2(y[6], y[7]);
    *(uint4*)(mix + (size_t)R * D + c0) = o;
    if (q >= T - 2) {
      float* d = so + (q - (T - 2)) * 256 + c0;
#pragma unroll
      for (int e = 0; e < 8; ++e) d[e] = u[2][e];
    }
  }
}

DEV int kperm_addr(int m, int kin) {
  const int mt = m >> 4, ml = m & 15, s = kin >> 5, q = (kin >> 4) & 1, g = (kin >> 2) & 3, e = kin & 3;
  return (((mt * 2 + s) * 64 + ml + 16 * g) * 8) + 4 * q + e;
}
DEV int clay_addr(int x, int v) {
  const int xt = x >> 4, g = (x >> 2) & 3, rr = x & 3, vt = v >> 4, l16 = v & 15;
  return ((xt * 4 + vt) * 64 + 16 * g + l16) * 4 + rr;
}
DEV void mm64(const bf16_t* first, const bf16_t* second, int l31, int hh, f32x16 (&acc)[2][2]) {
#pragma unroll
  for (int ks = 0; ks < 4; ++ks) {
    const bf16x8 f0 = *(const bf16x8*)(first + l31 * 72 + ks * 16 + hh * 8), f1 = *(const bf16x8*)(first + (32 + l31) * 72 + ks * 16 + hh * 8);
    const bf16x8 s0 = *(const bf16x8*)(second + l31 * 72 + ks * 16 + hh * 8), s1 = *(const bf16x8*)(second + (32 + l31) * 72 + ks * 16 + hh * 8);
    acc[0][0] = mfma32(f0, s0, acc[0][0]); acc[0][1] = mfma32(f0, s1, acc[0][1]);
    acc[1][0] = mfma32(f1, s0, acc[1][0]); acc[1][1] = mfma32(f1, s1, acc[1][1]);
  }
}
DEV void mm64x32(const bf16_t* first, const bf16_t* second_rows, int l31, int hh, f32x16 (&acc)[2]) {
#pragma unroll
  for (int ks = 0; ks < 4; ++ks) {
    const bf16x8 f0 = *(const bf16x8*)(first + l31 * 72 + ks * 16 + hh * 8), f1 = *(const bf16x8*)(first + (32 + l31) * 72 + ks * 16 + hh * 8);
    const bf16x8 s0 = *(const bf16x8*)(second_rows + l31 * 72 + ks * 16 + hh * 8);
    acc[0] = mfma32(f0, s0, acc[0]); acc[1] = mfma32(f1, s0, acc[1]);
  }
}

DEV void mmq(const bf16_t* first_rows, const bf16_t* second_rows, int l31, int hh, f32x16& acc) {
#pragma unroll
  for (int ks = 0; ks < 4; ++ks) {
    const bf16x8 f0 = *(const bf16x8*)(first_rows + l31 * 72 + ks * 16 + hh * 8);
    const bf16x8 s0 = *(const bf16x8*)(second_rows + l31 * 72 + ks * 16 + hh * 8);
    acc = mfma32(f0, s0, acc);
  }
}
enum { SH_FULL = 0, SH_UP = 1, SH_LO = 2 };
template <int SH> DEV constexpr bool tile_nz(int tx, int ty) { return SH == SH_FULL || (SH == SH_UP ? tx <= ty : tx >= ty); }
struct Acc64 { f32x16 t[2][2]; };
struct Frag64 { bf16x8 f[4][2]; };
template <int SS> DEV bf16x8 pack8(const f32x16& v) {
  return mk8(pk2(v[8 * SS], v[8 * SS + 1]), pk2(v[8 * SS + 2], v[8 * SS + 3]), pk2(v[8 * SS + 4], v[8 * SS + 5]), pk2(v[8 * SS + 6], v[8 * SS + 7]));
}
template <int SH> DEV void to_frag(const Acc64& X, Frag64& F) {
#pragma unroll
  for (int t = 0; t < 2; ++t) {
    if (tile_nz<SH>(0, t)) { F.f[0][t] = pack8<0>(X.t[0][t]); F.f[1][t] = pack8<1>(X.t[0][t]); }
    if (tile_nz<SH>(1, t)) { F.f[2][t] = pack8<0>(X.t[1][t]); F.f[3][t] = pack8<1>(X.t[1][t]); }
  }
}
template <int SH> DEV void zero_acc(Acc64& X) {
#pragma unroll
  for (int a = 0; a < 2; ++a)
#pragma unroll
    for (int b = 0; b < 2; ++b) if (tile_nz<SH>(a, b)) X.t[a][b] = zero16();
}
template <int SHA, int SHB> DEV void prod_ff(const Frag64& A, const Frag64& B, Acc64& D) {
#pragma unroll
  for (int tm = 0; tm < 2; ++tm)
#pragma unroll
    for (int tn = 0; tn < 2; ++tn)
#pragma unroll
      for (int s = 0; s < 4; ++s)
        if (tile_nz<SHA>(s >> 1, tm) && tile_nz<SHB>(s >> 1, tn)) D.t[tm][tn] = mfma32(A.f[s][tm], B.f[s][tn], D.t[tm][tn]);
}
template <int SHA, int SHB, int SHD> DEV void prod_ff_frag(const Frag64& A, const Frag64& B, Frag64& Fo) {
#pragma unroll
  for (int tm = 0; tm < 2; ++tm)
#pragma unroll
    for (int tn = 0; tn < 2; ++tn)
      if (tile_nz<SHD>(tm, tn)) {
        f32x16 acc = zero16();
#pragma unroll
        for (int s = 0; s < 4; ++s)
          if (tile_nz<SHA>(s >> 1, tm) && tile_nz<SHB>(s >> 1, tn)) acc = mfma32(A.f[s][tm], B.f[s][tn], acc);
        Fo.f[2 * tm][tn] = pack8<0>(acc); Fo.f[2 * tm + 1][tn] = pack8<1>(acc);
      }
}
DEV bf16x8 nat_frag(const bf16_t* S, int row, int s, int hh) { return *(const bf16x8*)(S + row * 72 + 16 * s + 8 * hh); }
DEV bf16x8 perm_frag(const bf16_t* S, int row, int s, int hh) {
  const uint2 a = *(const uint2*)(S + row * 72 + 16 * s + 4 * hh), b = *(const uint2*)(S + row * 72 + 16 * s + 8 + 4 * hh);
  return mk8(a.x, a.y, b.x, b.y);
}
template <int SH, int MODE> DEV void gram(const bf16_t* F, const bf16_t* G, int l31, int hh, Acc64& D) {
  zero_acc<SH>(D);
#pragma unroll
  for (int s = 0; s < 4; ++s) {
    bf16x8 ff[2], gg[2];
#pragma unroll
    for (int t = 0; t < 2; ++t) { ff[t] = nat_frag(F, 32 * t + l31, s, hh); gg[t] = nat_frag(G, 32 * t + l31, s, hh); }
#pragma unroll
    for (int tx = 0; tx < 2; ++tx)
#pragma unroll
      for (int ty = 0; ty < 2; ++ty) if (tile_nz<SH>(tx, ty)) D.t[tx][ty] = mfma32(ff[tx], gg[ty], D.t[tx][ty]);
  }
#pragma unroll
  for (int t = 0; t < 2; ++t)
#pragma unroll
    for (int r = 0; r < 16; ++r) {
      const int x = (r & 3) + 8 * (r >> 2) + 4 * hh, y = l31;
      const bool keep = MODE == 0 ? (x < y) : (MODE == 1 ? (y < x) : (x <= y));
      if (!keep) D.t[t][t][r] = 0.f;
    }
}
template <int SHA> DEV void prod_fm_frag(const Frag64& A, const bf16_t* Mem, int l31, int hh, Frag64& Fo) {
#pragma unroll
  for (int tm = 0; tm < 2; ++tm)
#pragma unroll
    for (int tn = 0; tn < 2; ++tn) {
      f32x16 acc = zero16();
#pragma unroll
      for (int s = 0; s < 4; ++s) if (tile_nz<SHA>(s >> 1, tm)) acc = mfma32(A.f[s][tm], perm_frag(Mem, 32 * tn + l31, s, hh), acc);
      Fo.f[2 * tm][tn] = pack8<0>(acc); Fo.f[2 * tm + 1][tn] = pack8<1>(acc);
    }
}
template <int SHA> DEV void prod_fm(const Frag64& A, const bf16_t* Mem, int l31, int hh, Acc64& D) {
#pragma unroll
  for (int s = 0; s < 4; ++s) {
    bf16x8 mm[2];
#pragma unroll
    for (int t = 0; t < 2; ++t) mm[t] = perm_frag(Mem, 32 * t + l31, s, hh);
#pragma unroll
    for (int tm = 0; tm < 2; ++tm)
#pragma unroll
      for (int tn = 0; tn < 2; ++tn) if (tile_nz<SHA>(s >> 1, tm)) D.t[tm][tn] = mfma32(A.f[s][tm], mm[tn], D.t[tm][tn]);
  }
}
DEV void r1_item(const Prm& p, int L, int idx, char* lds) {
  int tid = threadIdx.x; LAUNDER(tid);
  const int w = __builtin_amdgcn_readfirstlane(tid >> 6);
  int lane = tid & 63, l31 = lane & 31, hh = lane >> 5;
  const int cw = w & 1, tw = w >> 1;
  bf16_t* S0 = (bf16_t*)lds;
  bf16_t* S1 = S0 + 4608; bf16_t* S2 = S1 + 4608; bf16_t* S3 = S2 + 4608; bf16_t* S4 = S3 + 4608; bf16_t* S5 = S4 + 4608; bf16_t* S6 = S5 + 4608; bf16_t* S7 = S6 + 4608;
  float* misc = (float*)(S7 + 4608);
  float* Ef = (float*)S4;
  bool prompt; int st, c, hd;
  if (idx < NRW_P) { prompt = true; st = idx / 260; const int rem = idx - st * 260; c = rem >> 2; hd = rem & 3; }
  else { prompt = false; const int j = idx - NRW_P; st = j >> 2; hd = j & 3; c = 0; }
  char* rwp = p.rw + (size_t)idx * RW_BYTES;
  const float* mu = p.shift_mu + L * 896;
  const int i1 = tid >> 2, m0 = (tid & 3) * 16;
  int R1; bool valid1, hasprev1;
  if (prompt) { const int pp = 64 * c - 48 + i1; valid1 = pp >= 0; R1 = st * PT + (valid1 ? pp : 0); hasprev1 = pp >= 1; }
  else { R1 = NPR + 64 * st + i1; valid1 = true; hasprev1 = i1 >= 1; }
  const bf16_t* zr1 = p.zE + (size_t)R1 * ZE + ZE_ZC;
  const int ti0 = 32 * tw + l31;
  int R; bool valid, hasprev;
  if (prompt) { const int pp = 64 * c - 48 + ti0; valid = pp >= 0; R = st * PT + (valid ? pp : 0); hasprev = pp >= 1; }
  else { R = NPR + 64 * st + ti0; valid = true; hasprev = ti0 >= 1; }
  const bf16_t* zr = p.zE + (size_t)R * ZE + ZE_ZC;
  const int chb = 64 * hd + 32 * cw + 4 * hh;
  uint4 la[2][2], lap[2][2]; uint2 lb[3][4], lbp[3][4];
  {
    const bf16_t* sh0 = p.zE + (size_t)(NT + (prompt ? 32 : st)) * ZE + ZE_ZC;
    const bf16_t* zp1 = hasprev1 ? zr1 - ZE : sh0;
    const bf16_t* zp = hasprev ? zr - ZE : sh0;
#pragma unroll
    for (int part = 0; part < 2; ++part)
#pragma unroll
      for (int h8 = 0; h8 < 2; ++h8) { const int col = 768 + 64 * part + m0 + 8 * h8; la[part][h8] = *(const uint4*)(zr1 + col); lap[part][h8] = *(const uint4*)(zp1 + col); }
#pragma unroll
    for (int part = 0; part < 3; ++part)
#pragma unroll
      for (int G = 0; G < 4; ++G) { const int col = 256 * part + chb + 8 * G; lb[part][G] = *(const uint2*)(zr + col); lbp[part][G] = *(const uint2*)(zp + col); }
    const bf16_t* dsrc = p.dw2T + ((size_t)L * 256 + hd * 64 + i1) * 64 + m0;
    const bf16_t* isrc = p.ia2T + ((size_t)L * 256 + hd * 64 + i1) * 64 + m0;
    const uint4 d0 = *(const uint4*)dsrc, d1 = *(const uint4*)(dsrc + 8), e0 = *(const uint4*)isrc, e1 = *(const uint4*)(isrc + 8);
    __builtin_amdgcn_sched_barrier(0);
    *(uint4*)(S2 + i1 * 72 + m0) = d0; *(uint4*)(S2 + i1 * 72 + m0 + 8) = d1;
    *(uint4*)(S3 + i1 * 72 + m0) = e0; *(uint4*)(S3 + i1 * 72 + m0 + 8) = e1;
  }
  {
    float* prm = misc + 384;
#pragma unroll
    for (int q2 = 0; q2 < 2; ++q2) {
      const int ix = tid + 256 * q2, wh = ix >> 6, chp = ix & 63;
      const float* sp = wh == 0 ? p.decay_w0 : wh == 1 ? p.iclr_a0 : wh == 2 ? p.key_kk : wh == 3 ? p.key_ka : wh == 4 ? p.bonus_rk : nullptr;
      prm[ix] = sp ? sp[L * 256 + hd * 64 + chp] : mu[256 * (wh - 5) + 64 * hd + chp];
    }
  }
#pragma unroll
  for (int part = 0; part < 2; ++part) {
#pragma unroll
    for (int h8 = 0; h8 < 2; ++h8) {
      const int col = 768 + 64 * part + m0 + 8 * h8;
      const uint4 u = la[part][h8], v = lap[part][h8];
      const float cur[8] = {bflo(u.x), bfhi(u.x), bflo(u.y), bfhi(u.y), bflo(u.z), bfhi(u.z), bflo(u.w), bfhi(u.w)};
      float prv[8] = {bflo(v.x), bfhi(v.x), bflo(v.y), bfhi(v.y), bflo(v.z), bfhi(v.z), bflo(v.w), bfhi(v.w)};
      float o[8];
#pragma unroll
      for (int e = 0; e < 8; ++e) { float z = cur[e] + (prv[e] - cur[e]) * mu[col + e]; if (!valid1) z = 0.f; o[e] = part == 0 ? (1.f - 2.f / (__expf(2.f * z) + 1.f)) : z; }
      uint4 a; a.x = pk2(o[0], o[1]); a.y = pk2(o[2], o[3]); a.z = pk2(o[4], o[5]); a.w = pk2(o[6], o[7]);
      *(uint4*)((part == 0 ? S0 : S1) + i1 * 72 + m0 + 8 * h8) = a;
    }
  }
  __syncthreads();
  f32x16 accw = zero16(), acca = zero16();
#pragma unroll
  for (int ks = 0; ks < 4; ++ks) {
    const bf16x8 fw = *(const bf16x8*)(S2 + (32 * cw + l31) * 72 + ks * 16 + hh * 8), fa = *(const bf16x8*)(S3 + (32 * cw + l31) * 72 + ks * 16 + hh * 8);
    const bf16x8 sw = *(const bf16x8*)(S0 + (32 * tw + l31) * 72 + ks * 16 + hh * 8), sa = *(const bf16x8*)(S1 + (32 * tw + l31) * 72 + ks * 16 + hh * 8);
    accw = mfma32(fw, sw, accw); acca = mfma32(fa, sa, acca);
  }
  int ti = ti0;
  float e_[16];
  float ssq = 0.f;
#pragma unroll
  for (int G = 0; G < 4; ++G) {
    const int ch = chb + 8 * G, col = 256 + ch;
    const uint2 u = lb[1][G], v = lbp[1][G];
    const float cur[4] = {bflo(u.x), bfhi(u.x), bflo(u.y), bfhi(u.y)};
    float prv[4] = {bflo(v.x), bfhi(v.x), bflo(v.y), bfhi(v.y)};
    const int chq = 32 * cw + 8 * G + 4 * hh;
    const float4 kkw = *(const float4*)(misc + 384 + 128 + chq), w0 = *(const float4*)(misc + 384 + chq), m4 = *(const float4*)(misc + 384 + 384 + chq);
    const float kkv[4] = {kkw.x, kkw.y, kkw.z, kkw.w}, w0v[4] = {w0.x, w0.y, w0.z, w0.w}, muv[4] = {m4.x, m4.y, m4.z, m4.w};
#pragma unroll
    for (int e = 0; e < 4; ++e) {
      float z = cur[e] + (prv[e] - cur[e]) * muv[e];
      if (!valid) z = 0.f;
      const float kkr = z * kkv[e];
      ssq += kkr * kkr;
      e_[4 * G + e] = valid ? 0.6065306597126334f * sigmoid_(w0v[e] + accw[4 * G + e]) : 0.f;
    }
  }
  ssq += __shfl_xor(ssq, 32);
  if (hh == 0) misc[(cw * 64 + ti) * 2] = ssq;
#pragma unroll
  for (int G = 0; G < 4; ++G)
#pragma unroll
    for (int e = 0; e < 4; ++e) Ef[ti * 65 + 32 * cw + 8 * G + 4 * hh + e] = e_[4 * G + e];
  __syncthreads();
  {
    const int ch = tid & 63, seg = tid >> 6;
    float run = 0.f;
#pragma unroll
    for (int t = 0; t < 16; ++t) { run += Ef[(16 * seg + t) * 65 + ch]; Ef[(16 * seg + t) * 65 + ch] = run; }
    __syncthreads();
    float off = 0.f;
    for (int s2 = 0; s2 < seg; ++s2) off += Ef[(16 * s2 + 15) * 65 + ch];
    __syncthreads();
#pragma unroll
    for (int t = 0; t < 16; ++t) Ef[(16 * seg + t) * 65 + ch] += off;
    if (seg == 3) { const float cC = Ef[63 * 65 + ch]; misc[320 + ch] = cC; misc[256 + ch] = __expf(-cC); }
    __syncthreads();
  }
  float cc_[16];
#pragma unroll
  for (int G = 0; G < 4; ++G)
#pragma unroll
    for (int e = 0; e < 4; ++e) cc_[4 * G + e] = Ef[ti * 65 + 32 * cw + 8 * G + 4 * hh + e];
  const float kinv = 1.f / fmaxf(sqrtf(misc[ti * 2] + misc[(64 + ti) * 2]), 1e-12f);
  __syncthreads();
  LAUNDER(ti); LAUNDER(hh);
  uint2 vpk[4];
  float rk = 0.f;
#pragma unroll
  for (int G = 0; G < 4; ++G) {
    const int ch = chb + 8 * G, chl = 32 * cw + 8 * G + 4 * hh;
    float zs[3][4];
#pragma unroll
    for (int part = 0; part < 3; ++part) {
      const int col = 256 * part + ch;
      const uint2 u = lb[part][G], v = lbp[part][G];
      const float cur[4] = {bflo(u.x), bfhi(u.x), bflo(u.y), bfhi(u.y)};
      float prv[4] = {bflo(v.x), bfhi(v.x), bflo(v.y), bfhi(v.y)};
      const float4 m4 = *(const float4*)(misc + 384 + 320 + 64 * part + chl);
      const float muv[4] = {m4.x, m4.y, m4.z, m4.w};
#pragma unroll
      for (int e = 0; e < 4; ++e) { float z = cur[e] + (prv[e] - cur[e]) * muv[e]; zs[part][e] = valid ? z : 0.f; }
    }
    vpk[G] = pk4(zs[2][0], zs[2][1], zs[2][2], zs[2][3]);
    const float4 a04 = *(const float4*)(misc + 384 + 64 + chl), kk4 = *(const float4*)(misc + 384 + 128 + chl), ka4 = *(const float4*)(misc + 384 + 192 + chl), bo4 = *(const float4*)(misc + 384 + 256 + chl);
    const float a0v[4] = {a04.x, a04.y, a04.z, a04.w}, kkv[4] = {kk4.x, kk4.y, kk4.z, kk4.w}, kav[4] = {ka4.x, ka4.y, ka4.z, ka4.w}, bov[4] = {bo4.x, bo4.y, bo4.z, bo4.w};
    float at[4], rt[4], bt[4], kt[4], bh[4], kh[4];
#pragma unroll
    for (int e = 0; e < 4; ++e) {
      const int r = 4 * G + e;
      const float al = sigmoid_(a0v[e] + acca[r]);
      const float kk = zs[1][e] * kkv[e] * kinv;
      const float km = zs[1][e] * (1.f + (al - 1.f) * kav[e]);
      rk += zs[0][e] * km * bov[e];
      const float gC = misc[256 + chl + e];
      const float cprev = cc_[r] - e_[r];
      const float ea = __expf(-cprev), er = __expf(-cc_[r]), ek = __builtin_amdgcn_rcpf(er), eh = ek * gC;
      const float b = kk * al;
      at[e] = -kk * ea; rt[e] = zs[0][e] * er; bt[e] = b * ek; kt[e] = km * ek; bh[e] = b * eh; kh[e] = km * eh;
    }
    *(uint2*)(S0 + ti * 72 + chl) = pk4(at[0], at[1], at[2], at[3]);
    *(uint2*)(S1 + ti * 72 + chl) = pk4(rt[0], rt[1], rt[2], rt[3]);
    *(uint2*)(S2 + ti * 72 + chl) = pk4(bt[0], bt[1], bt[2], bt[3]);
    *(uint2*)(S3 + ti * 72 + chl) = pk4(kt[0], kt[1], kt[2], kt[3]);
#pragma unroll
    for (int e = 0; e < 4; ++e) { S4[(chl + e) * 72 + ti] = f2bf(at[e]); S5[(chl + e) * 72 + ti] = f2bf(bh[e]); S6[(chl + e) * 72 + ti] = f2bf(kh[e]); S7[(chl + e) * 72 + ti] = f2bf(zs[2][e]); }
    *(uint2*)(rwp + 40960 + (ti * 64 + chl) * 2) = vpk[G];
  }
  rk += __shfl_xor(rk, 32);
  if (hh == 0) misc[(cw * 64 + ti) * 2 + 1] = rk;
  __syncthreads();
  if (valid && cw == 0 && hh == 0) p.rkb[(size_t)R * 4 + hd] = misc[ti * 2 + 1] + misc[(64 + ti) * 2 + 1];
  LAUNDER(l31); LAUNDER(hh); LAUNDER(lane);
  {
    Acc64 T;
    {
      Acc64 Mx, MTx;
      gram<SH_UP, 0>(S2, S0, l31, hh, Mx);
      gram<SH_LO, 1>(S0, S2, l31, hh, MTx);
      Frag64 fM, fMT, fT;
      to_frag<SH_UP>(Mx, fM); to_frag<SH_LO>(MTx, fMT);
      __builtin_amdgcn_sched_barrier(0);
      T = Mx;
#pragma unroll
      for (int t = 0; t < 2; ++t)
#pragma unroll
        for (int r = 0; r < 16; ++r) if ((r & 3) + 8 * (r >> 2) + 4 * hh == l31) T.t[t][t][r] += 1.f;
      T.t[1][0] = zero16();
      for (int r = 0; r < 5; ++r) {
        Frag64 fM2, fMT2;
        prod_ff_frag<SH_LO, SH_UP, SH_UP>(fMT, fM, fM2);
        prod_ff_frag<SH_UP, SH_LO, SH_LO>(fM, fMT, fMT2);
#pragma unroll
        for (int s = 0; s < 4; ++s)
#pragma unroll
          for (int t = 0; t < 2; ++t) { if (tile_nz<SH_UP>(s >> 1, t)) fM.f[s][t] = fM2.f[s][t]; if (tile_nz<SH_LO>(s >> 1, t)) fMT.f[s][t] = fMT2.f[s][t]; }
        to_frag<SH_UP>(T, fT);
        prod_ff<SH_LO, SH_UP>(fMT, fT, T);
      }
    }
    Frag64 fT;
    to_frag<SH_UP>(T, fT);
    __builtin_amdgcn_sched_barrier(0);
    if (w < 2) {
      Frag64 fW;
      prod_fm_frag<SH_UP>(fT, S4, l31, hh, fW);
      __builtin_amdgcn_sched_barrier(0);
      Acc64 O; zero_acc<SH_FULL>(O);
      if (w == 0) {
        prod_fm<SH_FULL>(fW, S5, l31, hh, O);
#pragma unroll
        for (int tx = 0; tx < 2; ++tx)
#pragma unroll
          for (int ty = 0; ty < 2; ++ty)
#pragma unroll
            for (int G = 0; G < 4; ++G) {
              const int x0 = 32 * tx + 8 * G + 4 * hh, y = 32 * ty + l31;
              float v[4];
#pragma unroll
              for (int e = 0; e < 4; ++e) { v[e] = O.t[tx][ty][4 * G + e]; if (x0 + e == y) v[e] += misc[256 + y]; }
              *(uint2*)(rwp + 0 + kperm_addr(y, x0) * 2) = pk4(v[0], v[1], v[2], v[3]);
            }
      } else {
        Acc64 Nb; gram<SH_UP, 2>(S2, S1, l31, hh, Nb);
        Frag64 fN; to_frag<SH_UP>(Nb, fN);
        prod_ff<SH_FULL, SH_UP>(fW, fN, O);
#pragma unroll
        for (int tx = 0; tx < 2; ++tx)
#pragma unroll
          for (int ty = 0; ty < 2; ++ty)
#pragma unroll
            for (int G = 0; G < 4; ++G) {
              const int x0 = 32 * tx + 8 * G + 4 * hh, y = 32 * ty + l31;
              const uint2 rr = *(const uint2*)(S1 + y * 72 + x0);
              *(uint2*)(rwp + 8192 + kperm_addr(y, x0) * 2) = pk4(O.t[tx][ty][4 * G] + bflo(rr.x), O.t[tx][ty][4 * G + 1] + bfhi(rr.x), O.t[tx][ty][4 * G + 2] + bflo(rr.y), O.t[tx][ty][4 * G + 3] + bfhi(rr.y));
            }
      }
    } else {
      Frag64 fX;
      {
        Acc64 Nk; gram<SH_LO, 1>(S0, S3, l31, hh, Nk);
        Frag64 fNk; to_frag<SH_LO>(Nk, fNk);
        prod_ff_frag<SH_UP, SH_LO, SH_LO>(fT, fNk, fX);
      }
      __builtin_amdgcn_sched_barrier(0);
      if (w == 2) {
        Acc64 Z; zero_acc<SH_FULL>(Z);
        prod_fm<SH_LO>(fX, S5, l31, hh, Z);
#pragma unroll
        for (int tx = 0; tx < 2; ++tx)
#pragma unroll
          for (int ty = 0; ty < 2; ++ty)
#pragma unroll
            for (int G = 0; G < 4; ++G) {
              const int x0 = 32 * tx + 8 * G + 4 * hh, y = 32 * ty + l31;
              const uint2 kk2 = *(const uint2*)(S6 + y * 72 + x0);
              Z.t[tx][ty][4 * G] += bflo(kk2.x); Z.t[tx][ty][4 * G + 1] += bfhi(kk2.x); Z.t[tx][ty][4 * G + 2] += bflo(kk2.y); Z.t[tx][ty][4 * G + 3] += bfhi(kk2.y);
            }
        Frag64 fZ; to_frag<SH_FULL>(Z, fZ);
        __builtin_amdgcn_sched_barrier(0);
        Acc64 Q; zero_acc<SH_FULL>(Q);
        prod_fm<SH_FULL>(fZ, S7, l31, hh, Q);
#pragma unroll
        for (int tx = 0; tx < 2; ++tx)
#pragma unroll
          for (int ty = 0; ty < 2; ++ty)
#pragma unroll
            for (int G = 0; G < 4; ++G)
              *(uint2*)(rwp + 16384 + clay_addr(32 * tx + 8 * G + 4 * hh, 32 * ty + l31) * 2) = pk4(Q.t[tx][ty][4 * G], Q.t[tx][ty][4 * G + 1], Q.t[tx][ty][4 * G + 2], Q.t[tx][ty][4 * G + 3]);
      } else {
        Acc64 H; gram<SH_UP, 2>(S3, S1, l31, hh, H);
        {
          Acc64 Nb; gram<SH_UP, 2>(S2, S1, l31, hh, Nb);
          Frag64 fN; to_frag<SH_UP>(Nb, fN);
          prod_ff<SH_LO, SH_UP>(fX, fN, H);
        }
        Frag64 fH; to_frag<SH_UP>(H, fH);
        __builtin_amdgcn_sched_barrier(0);
        Acc64 Y; zero_acc<SH_FULL>(Y);
        prod_fm<SH_UP>(fH, S7, l31, hh, Y);
#pragma unroll
        for (int tx = 0; tx < 2; ++tx)
#pragma unroll
          for (int ty = 0; ty < 2; ++ty)
#pragma unroll
            for (int G = 0; G < 4; ++G)
              *(uint2*)(rwp + 24576 + clay_addr(32 * tx + 8 * G + 4 * hh, 32 * ty + l31) * 2) = pk4(Y.t[tx][ty][4 * G], Y.t[tx][ty][4 * G + 1], Y.t[tx][ty][4 * G + 2], Y.t[tx][ty][4 * G + 3]);
      }
    }
  }
  __syncthreads();
}

DEV void r2_wave(const Prm& p, int L, int wi, int lane) {
  bool prompt; int st, hd, vt;
  if (wi < 64) { prompt = true; st = wi >> 4; hd = (wi >> 2) & 3; vt = wi & 3; }
  else { prompt = false; const int j = wi - 64; st = j >> 4; hd = (j >> 2) & 3; vt = j & 3; }
  const int nch = prompt ? 65 : 1;
  const int idx0 = prompt ? st * 260 + hd : NRW_P + st * 4 + hd;
  const int l16 = lane & 15, g = lane >> 4;
  f32x4 acc[4];
  float* outp;
  if (prompt) {
#pragma unroll
    for (int mt = 0; mt < 4; ++mt) acc[mt] = (f32x4){0.f, 0.f, 0.f, 0.f};
    outp = p.wkv_p + ((((size_t)L * 4 + st) * 4 + hd) * 64 + 16 * vt + l16) * 64;
  } else {
    const float* sp = p.state_wkv + ((((size_t)L * 32 + st) * 4 + hd) * 64 + 16 * vt + l16) * 64;
#pragma unroll
    for (int mt = 0; mt < 4; ++mt) acc[mt] = *(const f32x4*)(sp + 16 * mt + 4 * g);
    outp = p.wkv_s + ((((size_t)L * 32 + st) * 4 + hd) * 64 + 16 * vt + l16) * 64;
  }
  const char* rw0 = p.rw + (size_t)idx0 * RW_BYTES;
  uint4 pf[3][8]; uint2 qv[3][4];
#pragma unroll
  for (int k = 0; k < 3; ++k) {
    const int cc = k < nch ? k : nch - 1;
    const char* src = rw0 + (size_t)cc * 4 * RW_BYTES;
#pragma unroll
    for (int i = 0; i < 8; ++i) pf[k][i] = *(const uint4*)(src + (i * 64 + lane) * 16);
#pragma unroll
    for (int mt = 0; mt < 4; ++mt) qv[k][mt] = *(const uint2*)(src + 16384 + ((mt * 4 + vt) * 64 + lane) * 8);
  }
  for (int c0 = 0; c0 < nch; c0 += 3) {
#pragma unroll
    for (int k = 0; k < 3; ++k) {
      const int c = c0 + k;
      if (c < nch) {
        char* cur = (char*)rw0 + (size_t)c * 4 * RW_BYTES;
        uint4 bfr[2];
#pragma unroll
        for (int s = 0; s < 2; ++s) {
          bfr[s].x = pk2(acc[2 * s][0], acc[2 * s][1]); bfr[s].y = pk2(acc[2 * s][2], acc[2 * s][3]);
          bfr[s].z = pk2(acc[2 * s + 1][0], acc[2 * s + 1][1]); bfr[s].w = pk2(acc[2 * s + 1][2], acc[2 * s + 1][3]);
          *(uint4*)(cur + 32768 + ((vt * 2 + s) * 64 + lane) * 16) = bfr[s];
        }
#pragma unroll
        for (int mt = 0; mt < 4; ++mt) {
          f32x4 a = {bflo(qv[k][mt].x), bfhi(qv[k][mt].x), bflo(qv[k][mt].y), bfhi(qv[k][mt].y)};
#pragma unroll
          for (int s = 0; s < 2; ++s) a = mfma16(mk8(pf[k][mt * 2 + s]), mk8(bfr[s]), a);
          acc[mt] = a;
        }
        const int cn = c + 3 < nch ? c + 3 : nch - 1;
        const char* src = rw0 + (size_t)cn * 4 * RW_BYTES;
#pragma unroll
        for (int i = 0; i < 8; ++i) pf[k][i] = *(const uint4*)(src + (i * 64 + lane) * 16);
#pragma unroll
        for (int mt = 0; mt < 4; ++mt) qv[k][mt] = *(const uint2*)(src + 16384 + ((mt * 4 + vt) * 64 + lane) * 8);
      }
    }
  }
#pragma unroll
  for (int mt = 0; mt < 4; ++mt) *(f32x4*)(outp + 16 * mt + 4 * g) = acc[mt];
}

DEV void r3_wave(const Prm& p, int L, int idx, int lane, float* Y  ) {
  LAUNDER(lane);
  bool prompt; int st, c, hd;
  if (idx < NRW_P) { prompt = true; st = idx / 260; const int rem = idx - st * 260; c = rem >> 2; hd = rem & 3; }
  else { prompt = false; const int j = idx - NRW_P; st = j >> 2; hd = j & 3; c = 0; }
  const char* rwp = p.rw + (size_t)idx * RW_BYTES;
  const int l16 = lane & 15, g = lane >> 4;
  bf16_t* mix = p.zE;
  uint4 sf[4][2];
#pragma unroll
  for (int vt = 0; vt < 4; ++vt)
#pragma unroll
    for (int s = 0; s < 2; ++s) sf[vt][s] = *(const uint4*)(rwp + 32768 + ((vt * 2 + s) * 64 + lane) * 16);
  const float lw[4] = {p.lnx_w[L * 256 + hd * 64 + l16], p.lnx_w[L * 256 + hd * 64 + 16 + l16], p.lnx_w[L * 256 + hd * 64 + 32 + l16], p.lnx_w[L * 256 + hd * 64 + 48 + l16]};
  const float lb[4] = {p.lnx_b[L * 256 + hd * 64 + l16], p.lnx_b[L * 256 + hd * 64 + 16 + l16], p.lnx_b[L * 256 + hd * 64 + 32 + l16], p.lnx_b[L * 256 + hd * 64 + 48 + l16]};
#pragma unroll
  for (int it = 0; it < 4; ++it) {
    f32x4 y[4];
    const uint4 gf0 = *(const uint4*)(rwp + 8192 + ((it * 2 + 0) * 64 + lane) * 16), gf1 = *(const uint4*)(rwp + 8192 + ((it * 2 + 1) * 64 + lane) * 16);
#pragma unroll
    for (int vt = 0; vt < 4; ++vt) {
      const uint2 q = *(const uint2*)(rwp + 24576 + ((it * 4 + vt) * 64 + lane) * 8);
      f32x4 a = {bflo(q.x), bfhi(q.x), bflo(q.y), bfhi(q.y)};
      a = mfma16(mk8(gf0), mk8(sf[vt][0]), a);
      a = mfma16(mk8(gf1), mk8(sf[vt][1]), a);
      y[vt] = a;
    }
    __builtin_amdgcn_sched_barrier(0);
#pragma unroll
    for (int rr = 0; rr < 4; ++rr) {
      const int i = 16 * it + 4 * g + rr;
      float s1 = y[0][rr] + y[1][rr] + y[2][rr] + y[3][rr];
      s1 += __shfl_xor(s1, 1); s1 += __shfl_xor(s1, 2); s1 += __shfl_xor(s1, 4); s1 += __shfl_xor(s1, 8);
      const float mean = s1 * (1.f / 64.f);
      const float d0 = y[0][rr] - mean, d1 = y[1][rr] - mean, d2 = y[2][rr] - mean, d3 = y[3][rr] - mean;
      float s2 = d0 * d0 + d1 * d1 + d2 * d2 + d3 * d3;
      s2 += __shfl_xor(s2, 1); s2 += __shfl_xor(s2, 2); s2 += __shfl_xor(s2, 4); s2 += __shfl_xor(s2, 8);
      const float rstd = rsqrtf(s2 * (1.f / 64.f) + GN_EPS);
      Y[i * 68 + l16] = d0 * rstd * lw[0] + lb[0];
      Y[i * 68 + 16 + l16] = d1 * rstd * lw[1] + lb[1];
      Y[i * 68 + 32 + l16] = d2 * rstd * lw[2] + lb[2];
      Y[i * 68 + 48 + l16] = d3 * rstd * lw[3] + lb[3];
    }
  }
  asm volatile("s_waitcnt lgkmcnt(0)" ::: "memory");
  __builtin_amdgcn_wave_barrier();
  const int vc = (lane & 7) * 8;
#pragma unroll
  for (int ps = 0; ps < 8; ++ps) {
    const int i = 8 * ps + (lane >> 3);
    int R; bool valid;
    if (prompt) { const int pp = 64 * c - 48 + i; valid = pp >= 0; R = st * PT + (valid ? pp : 0); }
    else { R = NPR + 64 * st + i; valid = true; }
    if (valid) {
      const float4 y0 = *(const float4*)(Y + i * 68 + vc), y1 = *(const float4*)(Y + i * 68 + vc + 4);
      const float rkbv = p.rkb[(size_t)R * 4 + hd];
      const uint4 vv = *(const uint4*)(rwp + 40960 + (i * 64 + vc) * 2);
      const uint4 gc = *(const uint4*)(p.zL + (size_t)R * ZL + ZL_GC + hd * 64 + vc);
      uint4 o;
      o.x = pk2((y0.x + rkbv * bflo(vv.x)) * silu_(bflo(gc.x)), (y0.y + rkbv * bfhi(vv.x)) * silu_(bfhi(gc.x)));
      o.y = pk2((y0.z + rkbv * bflo(vv.y)) * silu_(bflo(gc.y)), (y0.w + rkbv * bfhi(vv.y)) * silu_(bfhi(gc.y)));
      o.z = pk2((y1.x + rkbv * bflo(vv.z)) * silu_(bflo(gc.z)), (y1.y + rkbv * bfhi(vv.z)) * silu_(bfhi(gc.z)));
      o.w = pk2((y1.z + rkbv * bflo(vv.w)) * silu_(bflo(gc.w)), (y1.w + rkbv * bfhi(vv.w)) * silu_(bfhi(gc.w)));
      *(uint4*)(mix + (size_t)R * D + 768 + hd * 64 + vc) = o;
    }
  }
  asm volatile("s_waitcnt lgkmcnt(0)" ::: "memory");
  __builtin_amdgcn_wave_barrier();
}

DEV void final_norm(const Prm& p) {
  int tid_ = threadIdx.x; LAUNDER(tid_);
  const int lane = tid_ & 63, gw = blockIdx.x * 4 + (tid_ >> 6), NW = gridDim.x * 4;
  for (int R = gw; R < NT; R += NW) {
    if (R < NPR && (R % PT) < 16) continue;
    float* yr = xrow_ptr(p, R);
    const bf16_t* xr = p.xb + (size_t)R * D;
    const float rstd = rsqrtf(p.ssq_x[2 * NTP + R] * (1.f / 1024.f) + RMS_EPS);
#pragma unroll
    for (int j = 0; j < 2; ++j) {
      const uint4 u = ((const uint4*)xr)[lane + 64 * j];
      const float4 g0 = ((const float4*)p.final_g)[2 * (lane + 64 * j)], g1 = ((const float4*)p.final_g)[2 * (lane + 64 * j) + 1];
      float4 o0, o1;
      o0.x = bflo(u.x) * rstd * g0.x; o0.y = bfhi(u.x) * rstd * g0.y; o0.z = bflo(u.y) * rstd * g0.z; o0.w = bfhi(u.y) * rstd * g0.w;
      o1.x = bflo(u.z) * rstd * g1.x; o1.y = bfhi(u.z) * rstd * g1.y; o1.z = bflo(u.w) * rstd * g1.z; o1.w = bfhi(u.w) * rstd * g1.w;
      ((float4*)yr)[2 * (lane + 64 * j)] = o0; ((float4*)yr)[2 * (lane + 64 * j) + 1] = o1;
    }
  }
}

#define XB_TMO      128
#define XB_XCNT(j)  (256  + 64 * (j))
#define XB_XSUB(j)  (1280 + 64 * (j))
#define XB_XGEN(j)  (2304 + 64 * (j))
#define XB_TOP      3328
#define XB_TOPGEN   3392
#define XCD_BAR_WORDS 3456
#define XB_SPIN_CAP (1u << 20)
#define LAS __attribute__((address_space(3)))
DEV unsigned xb_ld(unsigned* p) { return __hip_atomic_load(p, __ATOMIC_RELAXED, __HIP_MEMORY_SCOPE_AGENT); }
DEV unsigned xb_add(unsigned* p, unsigned v) { return __hip_atomic_fetch_add(p, v, __ATOMIC_RELAXED, __HIP_MEMORY_SCOPE_AGENT); }
DEV unsigned xb_xcc_id() { return (unsigned)__builtin_amdgcn_s_getreg((3 << 11) | 20) & 0xFu; }
#define XB_SPIN(cond, bar) do { unsigned _sp = 0; while (cond) { __builtin_amdgcn_s_sleep(1); \
    if ((++_sp & 255u) == 0u) { if (xb_ld(&(bar)[XB_TMO])) break; if (_sp > XB_SPIN_CAP) { atomicAdd(&(bar)[XB_TMO], 1u); break; } } } } while (0)
struct XcdBarrier { unsigned* bar; unsigned x; volatile LAS unsigned* st; };
DEV XcdBarrier xcd_barrier_post(unsigned* bar, volatile LAS unsigned* st) {
  XcdBarrier b; b.bar = bar; b.x = xb_xcc_id(); b.st = st;
  if (threadIdx.x == 0) (void)xb_add(&bar[XB_XCNT(b.x)], 1u);
  return b;
}
DEV void xcd_barrier_complete(unsigned* bar, unsigned x, unsigned& nloc, unsigned& nx) {
  const unsigned G = gridDim.x * gridDim.y * gridDim.z;
  unsigned sum, cnt, mine, sp = 0u;
  for (;;) {
    sum = 0u; cnt = 0u; mine = 0u;
#pragma unroll
    for (unsigned j = 0; j < 16; ++j) { const unsigned c = xb_ld(&bar[XB_XCNT(j)]); sum += c; cnt += (c > 0u) ? 1u : 0u; mine = (j == x) ? c : mine; }
    if (sum == G) break;
    __builtin_amdgcn_s_sleep(1);
    if ((++sp & 255u) == 0u) { if (xb_ld(&bar[XB_TMO])) break; if (sp > XB_SPIN_CAP) { atomicAdd(&bar[XB_TMO], 1u); break; } }
  }
  nloc = mine > 0u ? mine : 1u; nx = cnt > 0u ? cnt : 1u;
}
DEV void xcd_barrier(const XcdBarrier& b) {
  asm volatile("s_waitcnt vmcnt(0)" ::: "memory");
  __syncthreads();
  if (threadIdx.x == 0) {
    unsigned* bar = b.bar;
    __builtin_amdgcn_s_waitcnt(0);
    unsigned nloc = b.st[0], nx = b.st[1];
    if (nloc == 0u) { xcd_barrier_complete(bar, b.x, nloc, nx); b.st[0] = nloc; b.st[1] = nx; }
    const unsigned old = xb_add(&bar[XB_XSUB(b.x)], 1u);
    const unsigned gen = old / nloc;
    if (old + 1u == (gen + 1u) * nloc) {
      __builtin_amdgcn_fence(__ATOMIC_RELEASE, "agent");
      asm volatile("s_waitcnt vmcnt(0)" ::: "memory");
      const unsigned og = xb_add(&bar[XB_TOP], 1u);
      const unsigned tg = og / nx;
      if (og + 1u == (tg + 1u) * nx) xb_add(&bar[XB_TOPGEN], 1u);
      else XB_SPIN(xb_ld(&bar[XB_TOPGEN]) == tg, bar);
      __builtin_amdgcn_fence(__ATOMIC_ACQUIRE, "agent");
      xb_add(&bar[XB_XGEN(b.x)], 1u);
      asm volatile("s_waitcnt vmcnt(0)" ::: "memory");
    } else {
      XB_SPIN(xb_ld(&bar[XB_XGEN(b.x)]) == gen, bar);
      __builtin_amdgcn_fence(__ATOMIC_ACQUIRE, "agent");
      asm volatile("s_waitcnt vmcnt(0)" ::: "memory");
    }
  }
  __syncthreads();
}

#define QCTR(ph, L) (3584 + 64 * (2 * (ph) + (L)))
#define R2DONE(L) (3520 + 16 * (L))
DEV int next_item(unsigned* ctr, char* lds) {
  volatile int* slot = (volatile int*)(lds + LDS_BYTES - 8);
  __syncthreads();
  if (threadIdx.x == 0) *slot = (int)atomicAdd(ctr, 1u);
  __syncthreads();
  return *slot;
}
#define QXC(ph, L, x) (4096 + (((ph) * 2 + (L)) * 8 + (x)) * 16)
DEV int xq_next(unsigned* ctl, int ph, int L, int C, int N, int& k, int home, char* lds) {
  volatile int* slot = (volatile int*)(lds + LDS_BYTES - 8);
  __syncthreads();
  if (threadIdx.x == 0) {
    int res = -1, kk = k;
    while (kk < 8) {
      const int x = (home + kk) & 7, base = x * C;
      int size = N - base; size = size < C ? size : C;
      if (size > 0) { const int idx = (int)atomicAdd(ctl + QXC(ph, L, x), 1u); if (idx < size) { res = base + idx; break; } }
      ++kk;
    }
    slot[0] = res; slot[1] = kk;
  }
  __syncthreads();
  k = slot[1];
  return slot[0];
}
DEV int q_publish(int ticket, char* lds) {
  volatile int* slot = (volatile int*)(lds + LDS_BYTES - 8);
  __syncthreads();
  if (threadIdx.x == 0) *slot = ticket;
  __syncthreads();
  return *slot;
}
DEV int xq_resolve(unsigned* ctl, int ph, int L, int C, int N, int& k, int home, int ticket, char* lds) {
  volatile int* slot = (volatile int*)(lds + LDS_BYTES - 8);
  __syncthreads();
  if (threadIdx.x == 0) {
    int res = -1, kk = k;
    if (kk < 8) {
      const int x = (home + kk) & 7, base = x * C;
      int size = N - base; size = size < C ? size : C;
      if (ticket < size) res = base + ticket;
      else {
        ++kk;
        while (kk < 8) {
          const int x2 = (home + kk) & 7, base2 = x2 * C;
          int size2 = N - base2; size2 = size2 < C ? size2 : C;
          if (size2 > 0) { const int idx = (int)atomicAdd(ctl + QXC(ph, L, x2), 1u); if (idx < size2) { res = base2 + idx; break; } }
          ++kk;
        }
      }
    }
    slot[0] = res; slot[1] = kk;
  }
  __syncthreads();
  k = slot[1];
  return slot[0];
}
DEV unsigned* xq_ctr(unsigned* ctl, int ph, int L, int k, int home) { return k < 8 ? ctl + QXC(ph, L, (home + k) & 7) : nullptr; }
DEV int take_ticket(unsigned* nctr) { int tk = 0x7fffffff; if (nctr && threadIdx.x == 0) tk = (int)atomicAdd(nctr, 1u); return tk; }
struct XQueue {
  unsigned* ctl; int ph, L, C, N, k, home, t;
  DEV void prefetch() { t = take_ticket(xq_ctr(ctl, ph, L, k, home)); }
  DEV int resolve(char* lds) { return xq_resolve(ctl, ph, L, C, N, k, home, t, lds); }
};
template <class Epi, class Map>
DEV void gemm_stream(const bf16_t* __restrict__ A, int lda, const bf16_t* __restrict__ Bt, int ldb, int K, char* lds, const Epi& epi, XQueue& q) {
  int tid = threadIdx.x; LAUNDER(tid);
  const int lane = tid & 63, w = __builtin_amdgcn_readfirstlane(tid >> 6), wr = w >> 1, wc = w & 1;
  const int fr = lane & 15, fq = lane >> 4;
  const int sb = lane * 16, swz = sb ^ (((sb >> 9) & 1) << 5), rl = swz >> 6, cl = (swz & 63) >> 1;
  const int nk = K / 64;
  int offA[2], offB[2];
#pragma unroll
  for (int kh = 0; kh < 2; ++kh) { offA[kh] = lds_byte(wr * 64 + fr, kh * 32 + fq * 8); offB[kh] = lds_byte(wc * 64 + fr, kh * 32 + fq * 8); }
  q.prefetch();
  int item = q.resolve(lds);
  if (item < 0) return;
  int m0, n0; Map::map(item, m0, n0);
  const bf16_t* ga[4]; const bf16_t* gb[4];
#define SETPTR(M0, N0) { _Pragma("unroll") for (int i = 0; i < 4; ++i) { const int st = 4 * w + i, r = (st >> 1) * 16 + rl, c = (st & 1) * 32 + cl; \
      ga[i] = A + (size_t)((M0) + r) * lda + c; gb[i] = Bt + (size_t)((N0) + r) * ldb + c; } }
#define GSTAGE(S, KT) { _Pragma("unroll") for (int i = 0; i < 4; ++i) { \
      __builtin_amdgcn_global_load_lds((const unsigned*)(ga[i] + (KT) * 64), (LAS3 unsigned*)(lds + (S) * 32768 + (4 * w + i) * 1024 + lane * 16), 16, 0, 0); \
      __builtin_amdgcn_global_load_lds((const unsigned*)(gb[i] + (KT) * 64), (LAS3 unsigned*)(lds + (S) * 32768 + 16384 + (4 * w + i) * 1024 + lane * 16), 16, 0, 0); } }
  SETPTR(m0, n0)
  GSTAGE(0, 0)
  GSTAGE(1, 1)
  for (;;) {
    f32x4 acc[4][4];
#pragma unroll
    for (int i = 0; i < 4; ++i)
#pragma unroll
      for (int j = 0; j < 4; ++j) acc[i][j] = (f32x4){0.f, 0.f, 0.f, 0.f};
    for (int kt = 0; kt < nk; ++kt) {
      const int s = kt & 1;
      if (kt + 1 < nk) asm volatile("s_waitcnt vmcnt(8)" ::: "memory"); else asm volatile("s_waitcnt vmcnt(0)" ::: "memory");
      RAW_BARRIER()
      const char* ia = lds + s * 32768;
      const char* ib = ia + 16384;
      bf16x8 af[2][4], bfv[2][4];
#pragma unroll
      for (int kh = 0; kh < 2; ++kh) {
#pragma unroll
        for (int mi = 0; mi < 4; ++mi) af[kh][mi] = *(const bf16x8*)(ia + offA[kh] + mi * 2048);
#pragma unroll
        for (int ni = 0; ni < 4; ++ni) bfv[kh][ni] = *(const bf16x8*)(ib + offB[kh] + ni * 2048);
      }
      asm volatile("s_waitcnt lgkmcnt(8)" ::: "memory");
      __builtin_amdgcn_sched_barrier(0);
#pragma unroll
      for (int mi = 0; mi < 4; ++mi)
#pragma unroll
        for (int ni = 0; ni < 4; ++ni) acc[mi][ni] = mfma16(bfv[0][ni], af[0][mi], acc[mi][ni]);
      __builtin_amdgcn_sched_barrier(0);
      asm volatile("s_waitcnt lgkmcnt(0)" ::: "memory");
      RAW_BARRIER()
      if (kt + 2 < nk) GSTAGE(s, kt + 2)
      if (kt == nk - 3) q.prefetch();
      __builtin_amdgcn_sched_barrier(0);
#pragma unroll
      for (int mi = 0; mi < 4; ++mi)
#pragma unroll
        for (int ni = 0; ni < 4; ++ni) acc[mi][ni] = mfma16(bfv[1][ni], af[1][mi], acc[mi][ni]);
    }
    const int nxt = q.resolve(lds);
    const typename Epi::Pre pre = epi.preload(m0 + wr * 64, n0 + wc * 64, fr, fq);
    __builtin_amdgcn_sched_barrier(0);
    int m1 = 0, n1 = 0;
    if (nxt >= 0) { Map::map(nxt, m1, n1); SETPTR(m1, n1) GSTAGE(0, 0) GSTAGE(1, 1) }
    __builtin_amdgcn_sched_barrier(0);
    epi.finish(acc, pre, m0 + wr * 64, n0 + wc * 64, fr, fq);
    if (nxt < 0) break;
    m0 = m1; n0 = n1;
  }
#undef GSTAGE
#undef SETPTR
}
struct MapP1 { static DEV void map(int i, int& m0, int& n0) { int mt, nt; if (i < 18 * 192) { const int b = i / 192, r = i - b * 192; nt = r >> 3; mt = 8 * b + (r & 7); } else { nt = i - 18 * 192; mt = 144; } m0 = mt * 128; n0 = nt * 128; } };
struct MapP4 { static DEV void map(int i, int& m0, int& n0) { m0 = (i >> 3) * 128; n0 = (i & 7) * 128; } };
DEV void shift_rows_item(const Prm& p, int L, int b) {
  int tid0 = threadIdx.x; LAUNDER(tid0);
  if (tid0 < 224) {
    float4 v = make_float4(0.f, 0.f, 0.f, 0.f);
    if (b < 32) v = *(const float4*)(p.state_shift + ((size_t)L * 32 + b) * 896 + 4 * tid0);
    *(uint2*)(p.zE + (size_t)(NT + b) * ZE + ZE_ZC + 4 * tid0) = pk4(v.x, v.y, v.z, v.w);
  }
}
constexpr int N_ATT = 1312;
DEV void run_p1(const Prm& p, int L, char* lds) {
  const EpiIn epi{p, L};
  const int home = (int)(xb_xcc_id() & 7u);
  constexpr int N = 145 * 24, C = (N + 7) / 8;
  {
    XQueue q{p.ctl, 0, L, C, N, 0, home, 0};
    gemm_stream<EpiIn, MapP1>(p.xb, D, p.Wb_in + (size_t)L * INP * 1024, 1024, 1024, lds, epi, q);
  }
  unsigned* ctr = p.ctl + QCTR(3, L);
  int t = take_ticket(ctr);
  for (;;) {
    const int mt = q_publish(t, lds);
    if (mt >= 145 + 33) break;
    if (mt >= 145) { t = take_ticket(ctr); shift_rows_item(p, L, mt - 145); continue; }
    t = gemm_tile<EpiIn, 2>(p.xb, D, p.Wb_in + (size_t)L * INP * 1024, 1024, 1024, mt * 128, 24 * 128, lds, epi, ctr);
  }
}
DEV void run_p2(const Prm& p, int L, char* lds) {
  const EpiQ epq{p, L};
  constexpr int N1 = NRW, N2 = N1 + 129, N3 = N2 + 145 * 6, N4 = N3 + 16, N4b = N4 + 512, N5 = N4b + 36;
  const int N6 = L == 0 ? N5 + NWT : N5;
  unsigned* ctr = p.ctl + QCTR(0, L);
  for (;;) {
    const int id = next_item(ctr, lds);
    if (id >= N6) break;
    if (id >= N5) { conv_weights_item(p, 1, id - N5, lds); continue; }
    if (id < N1) r1_item(p, L, id, lds);
    else if (id < N2) kvproj_item(p, L, id - N1, lds);
    else if (id < N3) { const int t = id - N2, mt = t / 6, nt = t - mt * 6; gemm_tile(p.zE + ZE_CQ, ZE, p.Wb_uq + (size_t)L * 768 * 256, 256, 256, mt * 128, nt * 128, lds, epq); }
    else if (id < N4) sample_prep_item(p, L, id - N3);
    else if (id < N4b) lat_item(p, L, id - N4);
    else shift_item(p, L, id - N4b);
  }
}
DEV void run_p3(const Prm& p, int L, char* lds) {
  int tid_ = threadIdx.x; LAUNDER(tid_);
  const int lane = tid_ & 63, w = __builtin_amdgcn_readfirstlane(tid_ >> 6);
  {
    int ndone = 0;
    for (int wi = blockIdx.x * 4 + w; wi < 576; wi += gridDim.x * 4) { r2_wave(p, L, wi, lane); ++ndone; }
    if (blockIdx.x * 4 < 576) {
      asm volatile("s_waitcnt vmcnt(0)" ::: "memory");
      __syncthreads();
      if (threadIdx.x == 0) {
        int tot = 0;
        for (int wi = blockIdx.x * 4; wi < 576; wi += gridDim.x * 4) tot += (576 - wi) < 4 ? (576 - wi) : 4;
        __builtin_amdgcn_fence(__ATOMIC_RELEASE, "agent");
        asm volatile("s_waitcnt vmcnt(0)" ::: "memory");
        __hip_atomic_fetch_add(p.ctl + R2DONE(L), (unsigned)tot, __ATOMIC_RELAXED, __HIP_MEMORY_SCOPE_AGENT);
      }
    }
    (void)ndone;
  }
  unsigned* ctr = p.ctl + QCTR(1, L);
  for (;;) {
    const int q = next_item(ctr, lds);
    if (q >= 128) break;
    attn_sample(p, L, q >> 2, q & 3, lds);
  }
  {
    const int home = (int)(xb_xcc_id() & 7u);
    int k = 0;
    int tx = take_ticket(xq_ctr(p.ctl, 2, L, k, home));
    for (;;) {
      const int i = xq_resolve(p.ctl, 2, L, 128, 1024, k, home, tx, lds);
      if (i < 0) break;
      const int x = i >> 7, j = i & 127, qt = 31 - (j >> 2), pair = 4 * x + (j & 3);
      tx = attn_body<false>(p, L, pair >> 3, pair & 7, qt, lds, xq_ctr(p.ctl, 2, L, k, home));
    }
  }
  unsigned* ctr2 = p.ctl + QCTR(2, L);
  constexpr int NC = (NT + 31) / 32, NQ2 = 32 + NC + NRW / 4;
  bool r2_seen = false;
  for (;;) {
    const int q = next_item(ctr2, lds);
    if (q >= NQ2) break;
    constexpr int NR3 = NRW / 4;
    if (q >= NR3 + 32) conv_item(p, L, q - NR3 - 32);
    else if (q >= NR3) attn_item(p, L, 1280 + q - NR3, lds);
    else {
      if (!r2_seen) {
        if (threadIdx.x == 0) {
          unsigned sp = 0;
          while (__hip_atomic_load(p.ctl + R2DONE(L), __ATOMIC_RELAXED, __HIP_MEMORY_SCOPE_AGENT) < 576u) {
            __builtin_amdgcn_s_sleep(2);
            if (++sp > (1u << 22)) { atomicAdd(&p.ctl[XB_TMO], 1u); break; }
          }
          __builtin_amdgcn_fence(__ATOMIC_ACQUIRE, "agent");
          asm volatile("s_waitcnt vmcnt(0)" ::: "memory");
        }
        __syncthreads();
        r2_seen = true;
      }
      r3_wave(p, L, q * 4 + w, lane, (float*)(lds + w * 17408));
    }
  }
}
DEV void run_p4(const Prm& p, int L, char* lds) {
  const EpiOut epo{p, L};
  const int home = (int)(xb_xcc_id() & 7u);
  {
    XQueue q{p.ctl, 1, L, 128, 1024, 0, home, 0};
    gemm_stream<EpiOut, MapP4>(p.zE  , D, p.Wb_out + (size_t)L * 1024 * 1024, 1024, 1024, lds, epo, q);
  }
  unsigned* ctr = p.ctl + QCTR(3, L) + 16;
  int t = take_ticket(ctr);
  for (;;) {
    const int h = q_publish(t, lds);
    if (h >= 17 * 16) break;
    const int mt = 128 + (h >> 4), r = h & 15;
    t = gemm_tile<EpiOut, 4>(p.zE, D, p.Wb_out + (size_t)L * 1024 * 1024, 1024, 1024, mt * 128, (r >> 1) * 128 + (r & 1) * 64, lds, epo, ctr);
  }
}

__global__ void __launch_bounds__(256, 2) mega(Prm p) {
  extern __shared__ __attribute__((aligned(16))) char lds[];
  volatile LAS unsigned* st = (volatile LAS unsigned*)(lds + LDS_BYTES - 16);
  if (threadIdx.x == 0) { st[0] = 0u; st[1] = 0u; st[2] = 0u; st[3] = 0u; }
  __syncthreads();
  const XcdBarrier xb = xcd_barrier_post(p.ctl, st);
  phase0(p, lds);
  xcd_barrier(xb);
  for (int L = 0; L < 2; ++L) {
    run_p1(p, L, lds); xcd_barrier(xb);
    run_p2(p, L, lds); xcd_barrier(xb);
    run_p3(p, L, lds); xcd_barrier(xb);
    run_p4(p, L, lds); xcd_barrier(xb);
  }
  final_norm(p);
}

static size_t al256(size_t x) { return (x + 255) & ~(size_t)255; }
extern "C" void kernel_launch(void* const* d_in, const int* in_sizes, int n_in, void* d_out, int out_size, void* d_ws, size_t ws_size, hipStream_t stream) {
  Prm p{};
  const float* const* in = (const float* const*)d_in;
  p.x_prompt = in[0]; p.x_sample = in[1]; p.cache_ckv = in[2]; p.cache_krope = in[3]; p.state_conv = in[4]; p.state_shift = in[5]; p.state_wkv = in[6];
  p.meta = in[7]; p.norm_g = in[8]; p.w_in = in[9]; p.conv_w = in[10]; p.q_norm_g = in[11]; p.w_uq = in[12]; p.kv_norm_g = in[13]; p.w_ukv = in[14];
  p.shift_mu = in[15]; p.decay_w0 = in[16]; p.decay_w2 = in[17]; p.iclr_a0 = in[18]; p.iclr_a2 = in[19]; p.key_kk = in[20]; p.key_ka = in[21];
  p.bonus_rk = in[22]; p.lnx_w = in[23]; p.lnx_b = in[24]; p.w_out = in[25]; p.final_g = in[26];
  float* o = (float*)d_out;
  p.y_prompt = o; o += (size_t)4 * 4096 * 1024;
  p.y_sample = o; o += (size_t)32 * 64 * 1024;
  p.ckv_p = o; o += (size_t)2 * 4 * PT * 128;
  p.kr_p = o; o += (size_t)2 * 4 * PT * 32;
  p.conv_p = o; o += 2 * 4 * 2 * 256;
  p.shift_p = o; o += 2 * 4 * 896;
  p.wkv_p = o; o += 2 * 4 * 4 * 64 * 64;
  p.ckv_s = o; o += (size_t)2 * 32 * 64 * 128;
  p.kr_s = o; o += 2 * 32 * 64 * 32;
  p.conv_s = o; o += 2 * 32 * 2 * 256;
  p.shift_s = o; o += 2 * 32 * 896;
  p.wkv_s = o; o += 2 * 32 * 4 * 64 * 64;
  char* w = (char*)d_ws; size_t off = 0;
  auto take = [&](size_t bytes) { char* r = w + off; off = al256(off + bytes); return r; };
  p.ctl = (unsigned*)take(65536);
  p.Wb_in = (bf16_t*)take((size_t)2 * INP * 1024 * 2);
  p.Wb_uq = (bf16_t*)take((size_t)2 * 768 * 256 * 2);
  p.Wb_ukv = (bf16_t*)take((size_t)2 * 1024 * 128 * 2);
  p.Wb_out = (bf16_t*)take((size_t)2 * 1024 * 1024 * 2);
  p.dw2T = (bf16_t*)take((size_t)2 * 256 * 64 * 2);
  p.ia2T = (bf16_t*)take((size_t)2 * 256 * 64 * 2);
  p.ropec = (float*)take((size_t)PT * 16 * 4);
  p.ropes = (float*)take((size_t)PT * 16 * 4);
  p.ssq_x = (float*)take((size_t)7 * NTP * 4);
  p.ssq_q = p.ssq_x + 3 * NTP; p.ssq_kv = p.ssq_x + 5 * NTP;
  p.rkb = (float*)take((size_t)NTP * 4 * 4);
  p.xmeta = (float*)take((size_t)64 * 1024 * 4);
  p.zE = (bf16_t*)take((size_t)NTP * ZE * 2);
  p.zL = (bf16_t*)take((size_t)NTP * ZL * 2);
  p.xb = (bf16_t*)take((size_t)(NTP + 128) * D * 2);
  p.Kn = (bf16_t*)take((size_t)KVR * 512 * 2);
  p.Vt = (bf16_t*)take((size_t)512 * KVR * 2);
  p.Kr = (bf16_t*)take((size_t)KVR * 32 * 2);
  p.rw = take((size_t)NRW * RW_BYTES);
  p.KL = (bf16_t*)((char*)p.y_prompt + ((size_t)32 << 20));
  p.VLT = p.KL + (size_t)32 * SKEYS * 160;
  static int grid = 0;
  if (grid == 0) {
    if (off > ws_size) { fprintf(stderr, "kernel_launch: workspace too small: need %zu have %zu\n", off, ws_size); grid = -1; return; }
    int dev = 0, cus = 0, per_cu = 0;
    (void)hipGetDevice(&dev);
    (void)hipDeviceGetAttribute(&cus, hipDeviceAttributeMultiprocessorCount, dev);
    (void)hipFuncSetAttribute((const void*)mega, hipFuncAttributeMaxDynamicSharedMemorySize, LDS_BYTES);
    (void)hipOccupancyMaxActiveBlocksPerMultiprocessor(&per_cu, (const void*)mega, 256, LDS_BYTES);
    if (per_cu > 2) per_cu = 2;
    if (per_cu < 1) { fprintf(stderr, "kernel_launch: occupancy query returned %d\n", per_cu); per_cu = 1; }
    grid = cus * per_cu;
  }
  if (grid < 0) return;
  (void)hipMemsetAsync(p.ctl, 0, 8192 * 4, stream);
  void* args[] = {&p};
  hipError_t e = hipLaunchCooperativeKernel((const void*)mega, dim3(grid), dim3(256), args, LDS_BYTES, stream);
  if (e != hipSuccess) fprintf(stderr, "cooperative launch failed: %s (grid %d)\n", hipGetErrorString(e), grid);
}
```

```cpp
#include <hip/hip_runtime.h>
#include <cstdio>
#include <cstdint>
#include <type_traits>

typedef unsigned short bf16_t;
typedef short bf16x8 __attribute__((ext_vector_type(8)));
typedef float f32x4 __attribute__((ext_vector_type(4)));
typedef float f32x16 __attribute__((ext_vector_type(16)));
#define DEV __device__ __forceinline__
#define LAUNDER(x) asm volatile("" : "+v"(x))

constexpr int D = 1024;
constexpr int PT = 4112;
constexpr int NPR = 4 * PT;
constexpr int NSM = 32 * 64;
constexpr int NT = NPR + NSM;
constexpr int NTP = 18560;
constexpr int ZL = 1792;
constexpr int ZE = 1312;
constexpr int ZE_CQ = 0, ZE_CKV = 256, ZE_KR = 384, ZE_ZC = 416;
constexpr int ZL_XIN = 0, ZL_BG = 256, ZL_CG = 512, ZL_GA = 768, ZL_GB = 1024, ZL_GC = 1536;
constexpr int INP = 3200;
constexpr int KVR = 16512;
constexpr int NRW_P = 4 * 65 * 4;
constexpr int NRW = NRW_P + 32 * 4;
constexpr int RW_BYTES = 49152;
constexpr float RMS_EPS = 1e-6f;
constexpr float GN_EPS = 64e-5f;
constexpr int LDS_BYTES = 79872;
constexpr int SKEYS = 1088;

struct Prm {
  const float *x_prompt, *x_sample, *cache_ckv, *cache_krope, *state_conv, *state_shift, *state_wkv, *meta, *norm_g, *w_in,
      *conv_w, *q_norm_g, *w_uq, *kv_norm_g, *w_ukv, *shift_mu, *decay_w0, *decay_w2, *iclr_a0, *iclr_a2, *key_kk, *key_ka,
      *bonus_rk, *lnx_w, *lnx_b, *w_out, *final_g;
  float *y_prompt, *y_sample, *ckv_p, *kr_p, *conv_p, *shift_p, *wkv_p, *ckv_s, *kr_s, *conv_s, *shift_s, *wkv_s;
  unsigned* ctl;
  bf16_t *Wb_in, *Wb_uq, *Wb_ukv, *Wb_out, *dw2T, *ia2T;
  float *ropec, *ropes, *ssq_x, *ssq_q, *ssq_kv, *rkb, *xmeta;
  bf16_t *KL, *VLT;
  bf16_t *zE, *zL, *xb, *Kn, *Vt, *Kr;
  char* rw;
};

DEV float bf2f(bf16_t b) { return __uint_as_float((unsigned)b << 16); }
DEV float bflo(unsigned u) { return __uint_as_float(u << 16); }
DEV float bfhi(unsigned u) { return __uint_as_float(u & 0xffff0000u); }
typedef __bf16 hbf16x2_t __attribute__((ext_vector_type(2)));
typedef float hf32x2_t __attribute__((ext_vector_type(2)));
DEV unsigned pk2(float a, float b) { hf32x2_t f = {a, b}; hbf16x2_t r = __builtin_convertvector(f, hbf16x2_t); return __builtin_bit_cast(unsigned, r); }
DEV bf16_t f2bf(float f) { return (bf16_t)(pk2(f, 0.f) & 0xffffu); }
DEV uint2 pk4(float a, float b, float c, float d) { uint2 r; r.x = pk2(a, b); r.y = pk2(c, d); return r; }
DEV float sigmoid_(float x) { return 1.f / (1.f + __expf(-x)); }
DEV float silu_(float x) { return x / (1.f + __expf(-x)); }
DEV float wave_sum(float v) {
#pragma unroll
  for (int o = 1; o < 64; o <<= 1) v += __shfl_xor(v, o);
  return v;
}
DEV f32x16 mfma32(bf16x8 a, bf16x8 b, f32x16 c) { return __builtin_amdgcn_mfma_f32_32x32x16_bf16(a, b, c, 0, 0, 0); }
DEV f32x4 mfma16(bf16x8 a, bf16x8 b, f32x4 c) { return __builtin_amdgcn_mfma_f32_16x16x32_bf16(a, b, c, 0, 0, 0); }
DEV bf16x8 mk8(unsigned a, unsigned b, unsigned c, unsigned d) { uint4 u; u.x = a; u.y = b; u.z = c; u.w = d; return __builtin_bit_cast(bf16x8, u); }
DEV bf16x8 mk8(uint4 u) { return __builtin_bit_cast(bf16x8, u); }
DEV f32x16 zero16() { f32x16 z; for (int i = 0; i < 16; ++i) z[i] = 0.f; return z; }

DEV float* xrow_ptr(const Prm& p, int R) {
  if (R < NPR) { int s = R / PT, q = R - s * PT; return q < 16 ? p.xmeta + (size_t)(s * 16 + q) * D : p.y_prompt + ((size_t)s * 4096 + (q - 16)) * D; }
  return p.y_sample + (size_t)(R - NPR) * D;
}
DEV const float* xin_ptr(const Prm& p, int R) {
  if (R < NPR) { int s = R / PT, q = R - s * PT; return q < 16 ? p.meta + (size_t)q * D : p.x_prompt + ((size_t)s * 4096 + (q - 16)) * D; }
  return p.x_sample + (size_t)(R - NPR) * D;
}
DEV int pos_of(int R) { return R < NPR ? R % PT : 1024 + ((R - NPR) & 63); }

DEV int win_src_col(int n) {
  if (n < 1024) return n;
  if (n < 1536) return 1440 + (n - 1024);
  if (n < 1792) return 2848 + (n - 1536);
  if (n < 2208) return 1024 + (n - 1792);
  if (n < 3104) return 1952 + (n - 2208);
  return -1;
}
DEV int perm32(int rho) { const int n = rho >> 4, i = rho & 15; return 8 * (i >> 2) + 4 * n + (i & 3); }
template <bool PERM, bool P32>
DEV void conv_weight_tile(const float* __restrict__ src, int K, int N, int Npad, bf16_t* __restrict__ dst, const float* __restrict__ sk, float cst, int l, int item, float* T  , int tid) {
  const int ntn = Npad / 64, ntk = K / 64;
  const int r = item, kt = r / ntn, nt = r - kt * ntn;
  const int k0 = kt * 64, n0 = nt * 64;
  {
    const int nslot = n0 + (tid & 15) * 4;
    const int nn = P32 ? (nslot & ~31) + perm32(nslot & 31) : nslot;
    const int sn = PERM ? win_src_col(nn) : (nn < N ? nn : -1);
#pragma unroll
    for (int i = 0; i < 4; ++i) {
      const int k = (tid >> 4) + 16 * i;
      float4 v = make_float4(0.f, 0.f, 0.f, 0.f);
      if (sn >= 0) {
        v = *(const float4*)(src + ((size_t)l * K + k0 + k) * N + sn);
        const float s = (sk ? sk[l * K + k0 + k] : 1.f) * cst;
        v.x *= s; v.y *= s; v.z *= s; v.w *= s;
      }
      float* t = T + k * 65 + (tid & 15) * 4;
      t[0] = v.x; t[1] = v.y; t[2] = v.z; t[3] = v.w;
    }
  }
  __syncthreads();
  {
    const int n = tid >> 2, kc = tid & 3;
    float v[16];
#pragma unroll
    for (int j = 0; j < 16; ++j) v[j] = T[(16 * kc + j) * 65 + n];
    uint4 o0, o1;
    o0.x = pk2(v[0], v[1]); o0.y = pk2(v[2], v[3]); o0.z = pk2(v[4], v[5]); o0.w = pk2(v[6], v[7]);
    o1.x = pk2(v[8], v[9]); o1.y = pk2(v[10], v[11]); o1.z = pk2(v[12], v[13]); o1.w = pk2(v[14], v[15]);
    bf16_t* d = dst + ((size_t)l * Npad + n0 + n) * K + k0 + 16 * kc;
    *(uint4*)d = o0; *(uint4*)(d + 8) = o1;
  }
  __syncthreads();
}
constexpr int WT0 = 16 * 50, WT1 = WT0 + 16 * 16, WT2 = WT1 + 4 * 12, WT3 = WT2 + 2 * 16, WT4 = WT3 + 4, NWT = WT4 + 4;
DEV void conv_weights_item(const Prm& p, int l, int it, char* lds) {
  float* T = (float*)lds;
  int tid = threadIdx.x; LAUNDER(tid);
  if (it < WT0) conv_weight_tile<true, true>(p.w_in, 1024, 3104, INP, p.Wb_in, p.norm_g, 1.f, l, it, T, tid);
  else if (it < WT1) conv_weight_tile<false, true>(p.w_out, 1024, 1024, 1024, p.Wb_out, nullptr, 1.f, l, it - WT0, T, tid);
  else if (it < WT2) conv_weight_tile<false, false>(p.w_uq, 256, 768, 768, p.Wb_uq, p.q_norm_g, 0.10206207261596575f * 1.4426950408889634f, l, it - WT1, T, tid);
  else if (it < WT3) conv_weight_tile<false, false>(p.w_ukv, 128, 1024, 1024, p.Wb_ukv, nullptr, 1.f, l, it - WT2, T, tid);
  else if (it < WT4) conv_weight_tile<false, false>(p.decay_w2, 64, 256, 256, p.dw2T, nullptr, 1.f, l, it - WT3, T, tid);
  else conv_weight_tile<false, false>(p.iclr_a2, 64, 256, 256, p.ia2T, nullptr, 1.f, l, it - WT4, T, tid);
}
DEV void phase0(const Prm& p, char* lds) {
  int tid = threadIdx.x; LAUNDER(tid);
  const int lane = tid & 63, wv = tid >> 6;
  const int gw = blockIdx.x * 4 + wv, NW = gridDim.x * 4;
  const int gt = blockIdx.x * 256 + tid, NTH = gridDim.x * 256;
  for (int R = gw; R < NT; R += NW) {
    const float* src = xin_ptr(p, R);
    float ss = 0.f;
#pragma unroll
    for (int j = 0; j < 4; ++j) {
      const float4 v = ((const float4*)src)[lane + 64 * j];
      ss += v.x * v.x + v.y * v.y + v.z * v.z + v.w * v.w;
      ((uint2*)(p.xb + (size_t)R * D))[lane + 64 * j] = pk4(v.x, v.y, v.z, v.w);
    }
    ss = wave_sum(ss);
    if (lane == 0) p.ssq_x[R] = ss;
  }
  for (int i = gt; i < 6 * NTP; i += NTH) p.ssq_x[NTP + i] = 0.f;
  for (int it = blockIdx.x; it < NWT; it += gridDim.x) conv_weights_item(p, 0, it, lds);
  for (int i = gt; i < PT * 16; i += NTH) {
    const int pos = i >> 4, j = i & 15;
    const float inv = powf(10000.f, -(float)j * 2.0f / 32.f);
    const float ang = (float)pos * inv;
    double a = (double)ang;
    a -= 6.283185307179586476925 * rint(a * 0.15915494309189533577);
    p.ropec[i] = (float)cos(a);
    p.ropes[i] = (float)sin(a);
  }
}

#define LAS3 __attribute__((address_space(3)))
#define RAW_BARRIER() { asm volatile("" ::: "memory"); __builtin_amdgcn_s_barrier(); asm volatile("" ::: "memory"); }
DEV int lds_byte(int r, int c) { const int st = (r >> 4) * 2 + (c >> 5), rr = r & 15, cc = c & 31, ob = rr * 64 + cc * 2; return st * 1024 + (ob ^ (((ob >> 9) & 1) << 5)); }
template <class Epi, int NB = 8>
DEV int gemm_tile(const bf16_t* __restrict__ A, int lda, const bf16_t* __restrict__ Bt, int ldb, int K, int m0, int n0, char* lds, const Epi& epi, unsigned* nctr = nullptr) {
  int tid = threadIdx.x; LAUNDER(tid);
  const int lane = tid & 63, w = __builtin_amdgcn_readfirstlane(tid >> 6), wr = w >> 1, wc = w & 1;
  const int fr = lane & 15, fq = lane >> 4;
  const int sb = lane * 16, swz = sb ^ (((sb >> 9) & 1) << 5), rl = swz >> 6, cl = (swz & 63) >> 1;
  const bf16_t* ga[4]; const bf16_t* gb[4];
#pragma unroll
  for (int i = 0; i < 4; ++i) {
    const int st = 4 * w + i, r = (st >> 1) * 16 + rl, c = (st & 1) * 32 + cl;
    ga[i] = A + (size_t)(m0 + r) * lda + c;
    gb[i] = Bt + (size_t)(n0 + r) * ldb + c;
  }
  const int nk = K / 64;
#define GSTAGE(S, KT) { _Pragma("unroll") for (int i = 0; i < 4; ++i) { \
      __builtin_amdgcn_global_load_lds((const unsigned*)(ga[i] + (KT) * 64), (LAS3 unsigned*)(lds + (S) * 32768 + (4 * w + i) * 1024 + lane * 16), 16, 0, 0); \
      if (2 * w + (i >> 1) < NB) __builtin_amdgcn_global_load_lds((const unsigned*)(gb[i] + (KT) * 64), (LAS3 unsigned*)(lds + (S) * 32768 + 16384 + (4 * w + i) * 1024 + lane * 16), 16, 0, 0); } }
  f32x4 acc[4][4];
#pragma unroll
  for (int i = 0; i < 4; ++i)
#pragma unroll
    for (int j = 0; j < 4; ++j) acc[i][j] = (f32x4){0.f, 0.f, 0.f, 0.f};
  int offA[2], offB[2];
#pragma unroll
  for (int kh = 0; kh < 2; ++kh) { offA[kh] = lds_byte(wr * 64 + fr, kh * 32 + fq * 8); offB[kh] = lds_byte(wc * 64 + fr, kh * 32 + fq * 8); }
  GSTAGE(0, 0)
  if (nk > 1) GSTAGE(1, 1)
  for (int kt = 0; kt < nk; ++kt) {
    const int s = kt & 1;
    if (kt + 1 < nk) { if (2 * w < NB) asm volatile("s_waitcnt vmcnt(8)" ::: "memory"); else asm volatile("s_waitcnt vmcnt(4)" ::: "memory"); }
    else asm volatile("s_waitcnt vmcnt(0)" ::: "memory");
    RAW_BARRIER()
    const char* ia = lds + s * 32768;
    const char* ib = ia + 16384;
    bf16x8 af[2][4], bfv[2][4];
#pragma unroll
    for (int kh = 0; kh < 2; ++kh) {
#pragma unroll
      for (int mi = 0; mi < 4; ++mi) af[kh][mi] = *(const bf16x8*)(ia + offA[kh] + mi * 2048);
#pragma unroll
      for (int ni = 0; ni < (NB < 4 ? NB : 4); ++ni) bfv[kh][ni] = *(const bf16x8*)(ib + offB[kh] + ni * 2048);
    }
    asm volatile("s_waitcnt lgkmcnt(%0)" :: "n"(4 + (NB < 4 ? NB : 4)) : "memory");
    __builtin_amdgcn_sched_barrier(0);
    if (NB == 8 || wc == 0) {
#pragma unroll
      for (int mi = 0; mi < 4; ++mi)
#pragma unroll
        for (int ni = 0; ni < (NB < 4 ? NB : 4); ++ni) acc[mi][ni] = mfma16(bfv[0][ni], af[0][mi], acc[mi][ni]);
    }
    __builtin_amdgcn_sched_barrier(0);
    asm volatile("s_waitcnt lgkmcnt(0)" ::: "memory");
    RAW_BARRIER()
    if (kt + 2 < nk) GSTAGE(s, kt + 2)
    __builtin_amdgcn_sched_barrier(0);
    if (NB == 8 || wc == 0) {
#pragma unroll
      for (int mi = 0; mi < 4; ++mi)
#pragma unroll
        for (int ni = 0; ni < (NB < 4 ? NB : 4); ++ni) acc[mi][ni] = mfma16(bfv[1][ni], af[1][mi], acc[mi][ni]);
    }
  }
  __syncthreads();
#undef GSTAGE
  int tk = 0x7fffffff; if (nctr && tid == 0) tk = (int)atomicAdd(nctr, 1u);
  if (NB == 8 || wc == 0) epi(acc, m0 + wr * 64, n0 + wc * 64, fr, fq);
  return tk;
}

DEV int lds_byte32(int r, int c) { const int rr = r & 15, ob = rr * 64 + c * 2; return (r >> 4) * 1024 + (ob ^ (((ob >> 9) & 1) << 5)); }
template <class Epi>
DEV void gemm_tile_big(const bf16_t* __restrict__ A, int lda, const bf16_t* __restrict__ Bt, int ldb, int K, int m0, int n0, char* lds, const Epi& epi) {
  int tid = threadIdx.x; LAUNDER(tid);
  const int lane = tid & 63, w = __builtin_amdgcn_readfirstlane(tid >> 6), wr = w >> 1, wc = w & 1;
  const int fr = lane & 15, fq = lane >> 4;
  const int sb = lane * 16, swz = sb ^ (((sb >> 9) & 1) << 5), rl = swz >> 6, cl = (swz & 63) >> 1;
  const bf16_t* ga[4]; const bf16_t* gb[2];
#pragma unroll
  for (int i = 0; i < 4; ++i) ga[i] = A + (size_t)(m0 + (4 * w + i) * 16 + rl) * lda + cl;
#pragma unroll
  for (int i = 0; i < 2; ++i) gb[i] = Bt + (size_t)(n0 + (2 * w + i) * 16 + rl) * ldb + cl;
  const int nk = K / 32;
#define GSTAGE3(S, KT) { _Pragma("unroll") for (int i = 0; i < 4; ++i) \
      __builtin_amdgcn_global_load_lds((const unsigned*)(ga[i] + (KT) * 32), (LAS3 unsigned*)(lds + (S) * 24576 + (4 * w + i) * 1024 + lane * 16), 16, 0, 0); \
    _Pragma("unroll") for (int i = 0; i < 2; ++i) \
      __builtin_amdgcn_global_load_lds((const unsigned*)(gb[i] + (KT) * 32), (LAS3 unsigned*)(lds + (S) * 24576 + 16384 + (2 * w + i) * 1024 + lane * 16), 16, 0, 0); }
  f32x4 acc[8][4];
#pragma unroll
  for (int i = 0; i < 8; ++i)
#pragma unroll
    for (int j = 0; j < 4; ++j) acc[i][j] = (f32x4){0.f, 0.f, 0.f, 0.f};
  const int offA = lds_byte32(wr * 128 + fr, fq * 8), offB = 16384 + lds_byte32(wc * 64 + fr, fq * 8);
  GSTAGE3(0, 0)
  if (nk > 1) GSTAGE3(1, 1)
  int s = 0;
  for (int kt = 0; kt < nk; ++kt) {
    if (kt + 1 < nk) asm volatile("s_waitcnt vmcnt(6)" ::: "memory"); else asm volatile("s_waitcnt vmcnt(0)" ::: "memory");
    RAW_BARRIER()
    if (kt + 2 < nk) { const int s2 = s + 2 >= 3 ? s - 1 : s + 2; GSTAGE3(s2, kt + 2) }
    const char* im = lds + s * 24576;
    bf16x8 af[8], bfv[4];
#pragma unroll
    for (int ni = 0; ni < 4; ++ni) bfv[ni] = *(const bf16x8*)(im + offB + ni * 1024);
#pragma unroll
    for (int mi = 0; mi < 8; ++mi) af[mi] = *(const bf16x8*)(im + offA + mi * 1024);
#pragma unroll
    for (int mi = 0; mi < 8; ++mi)
#pragma unroll
      for (int ni = 0; ni < 4; ++ni) acc[mi][ni] = mfma16(bfv[ni], af[mi], acc[mi][ni]);
    s = s + 1 >= 3 ? 0 : s + 1;
  }
  __syncthreads();
#undef GSTAGE3
  epi(acc, m0 + wr * 128, n0 + wc * 64, fr, fq);
}

struct EpiIn {
  const Prm& p; int L;
  struct Pre { float s[4]; };
  DEV Pre preload(int mb, int nb, int fr, int fq) const {
    Pre r;
#pragma unroll
    for (int mi = 0; mi < 4; ++mi) r.s[mi] = p.ssq_x[L * NTP + mb + 16 * mi + fr];
    return r;
  }
  DEV void operator()(f32x4 (&acc)[4][4], int mb, int nb, int fr, int fq) const { finish(acc, preload(mb, nb, fr, fq), mb, nb, fr, fq); }
  DEV void finish(f32x4 (&acc)[4][4], const Pre& pre, int mb, int nb, int fr, int fq) const {
#pragma unroll
    for (int mi = 0; mi < 4; ++mi) {
      const int m = mb + 16 * mi + fr;
      const bool ok = m < NT;
      const float rstd = rsqrtf(pre.s[mi] * (1.f / 1024.f) + RMS_EPS);
      float sq = 0.f;
#pragma unroll
      for (int g = 0; g < 2; ++g) {
        const int n0 = nb + 32 * g;
        if (n0 >= 3104) continue;
        bf16_t* dst = n0 < ZL ? p.zL + (size_t)m * ZL + n0 : p.zE + (size_t)m * ZE + (n0 - ZL);
        float v[8];
#pragma unroll
        for (int j = 0; j < 4; ++j) { v[j] = acc[mi][2 * g][j] * rstd; v[4 + j] = acc[mi][2 * g + 1][j] * rstd; }
#pragma unroll
        for (int j = 0; j < 8; ++j) sq += v[j] * v[j];
        if (ok) { uint4 o; o.x = pk2(v[0], v[1]); o.y = pk2(v[2], v[3]); o.z = pk2(v[4], v[5]); o.w = pk2(v[6], v[7]); *(uint4*)(dst + 8 * fq) = o; }
      }
      if (nb >= ZL && nb < ZL + 384) {
        sq += __shfl_xor(sq, 16); sq += __shfl_xor(sq, 32);
        if (fq == 0 && ok) atomicAdd((nb < ZL + 256 ? p.ssq_q : p.ssq_kv) + L * NTP + m, sq);
      }
    }
  }
};
struct EpiQ {
  const Prm& p; int L;
  DEV void operator()(f32x4 (&acc)[4][4], int mb, int nb, int fr, int fq) const {
    bf16_t* Qb = (bf16_t*)p.y_prompt;
#pragma unroll
    for (int mi = 0; mi < 4; ++mi) {
      const int m = mb + 16 * mi + fr;
      const bool ok = m < NT;
      const float rstd = rsqrtf(p.ssq_q[L * NTP + m] * (1.f / 256.f) + RMS_EPS);
      const int pos = pos_of(ok ? m : 0);
#pragma unroll
      for (int np = 0; np < 2; ++np) {
        const int n0 = nb + 32 * np;
        float v[2][4];
#pragma unroll
        for (int h2 = 0; h2 < 2; ++h2)
#pragma unroll
          for (int j = 0; j < 4; ++j) v[h2][j] = acc[mi][2 * np + h2][j] * rstd;
        if (((n0 >> 5) % 3) == 2) {
#pragma unroll
          for (int j = 0; j < 4; ++j) {
            const int c = 4 * fq + j;
            const float cs = p.ropec[pos * 16 + c], sn = p.ropes[pos * 16 + c];
            const float x1 = v[0][j], x2 = v[1][j];
            v[0][j] = x1 * cs - x2 * sn; v[1][j] = x1 * sn + x2 * cs;
          }
        }
        if (ok) {
          *(uint2*)(Qb + (size_t)m * 768 + n0 + 4 * fq) = pk4(v[0][0], v[0][1], v[0][2], v[0][3]);
          *(uint2*)(Qb + (size_t)m * 768 + n0 + 16 + 4 * fq) = pk4(v[1][0], v[1][1], v[1][2], v[1][3]);
        }
      }
    }
  }
};
struct EpiOut {
  const Prm& p; int L;
  struct Pre { uint4 x[4][2]; };
  DEV Pre preload(int mb, int nb, int fr, int fq) const {
    Pre r;
#pragma unroll
    for (int mi = 0; mi < 4; ++mi) {
      const int m = mb + 16 * mi + fr;
      const bf16_t* xr = p.xb + (size_t)(m < NT ? m : 0) * D;
#pragma unroll
      for (int g = 0; g < 2; ++g) r.x[mi][g] = *(const uint4*)(xr + nb + 32 * g + 8 * fq);
    }
    return r;
  }
  DEV void operator()(f32x4 (&acc)[4][4], int mb, int nb, int fr, int fq) const { finish(acc, preload(mb, nb, fr, fq), mb, nb, fr, fq); }
  DEV void finish(f32x4 (&acc)[4][4], const Pre& pre, int mb, int nb, int fr, int fq) const {
#pragma unroll
    for (int mi = 0; mi < 4; ++mi) {
      const int m = mb + 16 * mi + fr;
      const bool ok = m < NT;
      bf16_t* xr = p.xb + (size_t)(ok ? m : 0) * D;
      float ss = 0.f;
#pragma unroll
      for (int g = 0; g < 2; ++g) {
        const int col = nb + 32 * g + 8 * fq;
        const uint4 xi = pre.x[mi][g];
        float v[8] = {bflo(xi.x), bfhi(xi.x), bflo(xi.y), bfhi(xi.y), bflo(xi.z), bfhi(xi.z), bflo(xi.w), bfhi(xi.w)};
#pragma unroll
        for (int j = 0; j < 4; ++j) { v[j] += acc[mi][2 * g][j]; v[4 + j] += acc[mi][2 * g + 1][j]; }
#pragma unroll
        for (int j = 0; j < 8; ++j) ss += v[j] * v[j];
        if (ok) { uint4 o; o.x = pk2(v[0], v[1]); o.y = pk2(v[2], v[3]); o.z = pk2(v[4], v[5]); o.w = pk2(v[6], v[7]); *(uint4*)(xr + col) = o; }
      }
      ss += __shfl_xor(ss, 16); ss += __shfl_xor(ss, 32);
      if (fq == 0 && ok) atomicAdd(p.ssq_x + (L + 1) * NTP + m, ss);
    }
  }
};

DEV void kv_prep_row(const Prm& p, int L, int R, int half, bool valid, bf16_t* At_row  ) {
  const int Rl = valid ? R : 0;
  const bf16_t* zr = p.zE + (size_t)Rl * ZE;
  const float rstd = rsqrtf(p.ssq_kv[L * NTP + Rl] * (1.f / 128.f) + RMS_EPS);
  float* outc; float* outk;
  if (Rl < NPR) { const int s = Rl / PT, q = Rl - s * PT; outc = p.ckv_p + (((size_t)L * 4 + s) * PT + q) * 128; outk = p.kr_p + (((size_t)L * 4 + s) * PT + q) * 32; }
  else { const int j = Rl - NPR; outc = p.ckv_s + ((size_t)L * NSM + j) * 128; outk = p.kr_s + ((size_t)L * NSM + j) * 32; }
  const float* g = p.kv_norm_g + L * 128 + 64 * half;
#pragma unroll
  for (int c8 = 0; c8 < 8; ++c8) {
    const uint4 u = *(const uint4*)(zr + ZE_CKV + 64 * half + 8 * c8);
    const float4 g0 = *(const float4*)(g + 8 * c8), g1 = *(const float4*)(g + 8 * c8 + 4);
    float4 y0, y1;
    y0.x = bflo(u.x) * rstd * g0.x; y0.y = bfhi(u.x) * rstd * g0.y; y0.z = bflo(u.y) * rstd * g0.z; y0.w = bfhi(u.y) * rstd * g0.w;
    y1.x = bflo(u.z) * rstd * g1.x; y1.y = bfhi(u.z) * rstd * g1.y; y1.z = bflo(u.w) * rstd * g1.z; y1.w = bfhi(u.w) * rstd * g1.w;
    if (valid) { *(float4*)(outc + 64 * half + 8 * c8) = y0; *(float4*)(outc + 64 * half + 8 * c8 + 4) = y1; }
    if (At_row) { uint4 o; o.x = pk2(y0.x, y0.y); o.y = pk2(y0.z, y0.w); o.z = pk2(y1.x, y1.y); o.w = pk2(y1.z, y1.w); *(uint4*)(At_row + 64 * half + 8 * c8) = o; }
    if (valid && Rl >= NPR) {
      const int j = Rl - NPR, b = j >> 6, r = j & 63;
      bf16_t* kl = p.KL + ((size_t)b * SKEYS + 1024 + r) * 160 + 16 * (4 * half + (c8 >> 1)) + 4 * (c8 & 1);
      *(uint2*)kl = pk4(y0.x, y0.y, y0.z, y0.w); *(uint2*)(kl + 8) = pk4(y1.x, y1.y, y1.z, y1.w);
    }
    if (c8 & 1) __builtin_amdgcn_sched_barrier(0);
  }
  if (half == 0) {
    const int pos = pos_of(Rl);
#pragma unroll
    for (int c8 = 0; c8 < 2; ++c8) {
      const uint4 u = *(const uint4*)(zr + ZE_KR + 8 * c8), v = *(const uint4*)(zr + ZE_KR + 16 + 8 * c8);
      const float x1[8] = {bflo(u.x), bfhi(u.x), bflo(u.y), bfhi(u.y), bflo(u.z), bfhi(u.z), bflo(u.w), bfhi(u.w)};
      const float x2[8] = {bflo(v.x), bfhi(v.x), bflo(v.y), bfhi(v.y), bflo(v.z), bfhi(v.z), bflo(v.w), bfhi(v.w)};
      float y1[8], y2[8];
#pragma unroll
      for (int e = 0; e < 8; ++e) {
        const float cs = p.ropec[pos * 16 + 8 * c8 + e], sn = p.ropes[pos * 16 + 8 * c8 + e];
        y1[e] = x1[e] * cs - x2[e] * sn; y2[e] = x1[e] * sn + x2[e] * cs;
      }
      if (valid) {
        float4 o;
        o.x = y1[0]; o.y = y1[1]; o.z = y1[2]; o.w = y1[3]; *(float4*)(outk + 8 * c8) = o;
        o.x = y1[4]; o.y = y1[5]; o.z = y1[6]; o.w = y1[7]; *(float4*)(outk + 8 * c8 + 4) = o;
        o.x = y2[0]; o.y = y2[1]; o.z = y2[2]; o.w = y2[3]; *(float4*)(outk + 16 + 8 * c8) = o;
        o.x = y2[4]; o.y = y2[5]; o.z = y2[6]; o.w = y2[7]; *(float4*)(outk + 16 + 8 * c8 + 4) = o;
        {
          const int j = Rl - NPR;
          bf16_t* krd = Rl < NPR ? p.Kr + (size_t)Rl * 32 : p.KL + ((size_t)(j >> 6) * SKEYS + 1024 + (j & 63)) * 160 + 128;
          uint4 q; q.x = pk2(y1[0], y1[1]); q.y = pk2(y1[2], y1[3]); q.z = pk2(y1[4], y1[5]); q.w = pk2(y1[6], y1[7]); *(uint4*)(krd + 8 * c8) = q;
          q.x = pk2(y2[0], y2[1]); q.y = pk2(y2[2], y2[3]); q.z = pk2(y2[4], y2[5]); q.w = pk2(y2[6], y2[7]); *(uint4*)(krd + 16 + 8 * c8) = q;
        }
      }
    }
  }
}
DEV void kvproj_item(const Prm& p, int L, int mt, char* lds) {
  int tid = threadIdx.x; LAUNDER(tid);
  const int lane = tid & 63, w = __builtin_amdgcn_readfirstlane(tid >> 6), wr = w >> 1, wc = w & 1, l31 = lane & 31, hh = lane >> 5;
  bf16_t* At = (bf16_t*)lds;
  bf16_t* Bs = At + 128 * 136;
  {
    const int r = tid >> 1, half = tid & 1, R = mt * 128 + r;
    kv_prep_row(p, L, R, half, R < NPR, At + r * 136);
  }
  for (int h = 0; h < 8; ++h) {
    __syncthreads();
    {
      const bf16_t* wsrc = p.Wb_ukv + ((size_t)L * 1024 + h * 128) * 128;
#pragma unroll
      for (int i = 0; i < 8; ++i) { const int id = tid + 256 * i, row = id >> 4, cc = id & 15; *(uint4*)(Bs + row * 136 + cc * 8) = *(const uint4*)(wsrc + row * 128 + cc * 8); }
    }
    __syncthreads();
    f32x16 acc[2][2];
#pragma unroll
    for (int i = 0; i < 2; ++i)
#pragma unroll
      for (int j = 0; j < 2; ++j) acc[i][j] = zero16();
    const bf16_t* as = At + (wr * 64 + l31) * 136 + hh * 8;
    const bf16_t* bs = Bs + (wc * 64 + l31) * 136 + hh * 8;
    if (wc == 0) {
#pragma unroll 2
      for (int ks = 0; ks < 8; ++ks) {
        const bf16x8 a0 = *(const bf16x8*)(as + ks * 16), a1 = *(const bf16x8*)(as + 32 * 136 + ks * 16);
        const bf16x8 b0 = *(const bf16x8*)(bs + ks * 16), b1 = *(const bf16x8*)(bs + 32 * 136 + ks * 16);
        acc[0][0] = mfma32(b0, a0, acc[0][0]); acc[0][1] = mfma32(b1, a0, acc[0][1]);
        acc[1][0] = mfma32(b0, a1, acc[1][0]); acc[1][1] = mfma32(b1, a1, acc[1][1]);
      }
#pragma unroll
      for (int i = 0; i < 2; ++i) {
        const int KRr = mt * 128 + wr * 64 + 32 * i + l31;
#pragma unroll
        for (int j = 0; j < 2; ++j)
#pragma unroll
          for (int G = 0; G < 4; ++G)
            *(uint2*)(p.Kn + ((size_t)KRr * 8 + h) * 64 + 32 * j + 8 * G + 4 * hh) = pk4(acc[i][j][4 * G], acc[i][j][4 * G + 1], acc[i][j][4 * G + 2], acc[i][j][4 * G + 3]);
      }
    } else {
#pragma unroll 2
      for (int ks = 0; ks < 8; ++ks) {
        const bf16x8 a0 = *(const bf16x8*)(as + ks * 16), a1 = *(const bf16x8*)(as + 32 * 136 + ks * 16);
        const bf16x8 b0 = *(const bf16x8*)(bs + ks * 16), b1 = *(const bf16x8*)(bs + 32 * 136 + ks * 16);
        acc[0][0] = mfma32(a0, b0, acc[0][0]); acc[0][1] = mfma32(a0, b1, acc[0][1]);
        acc[1][0] = mfma32(a1, b0, acc[1][0]); acc[1][1] = mfma32(a1, b1, acc[1][1]);
      }
#pragma unroll
      for (int j = 0; j < 2; ++j) {
        const int d = 32 * j + l31;
#pragma unroll
        for (int i = 0; i < 2; ++i)
#pragma unroll
          for (int G = 0; G < 4; ++G) {
            const int KRr = mt * 128 + wr * 64 + 32 * i + 16 * (G >> 1) + 8 * hh + 4 * (G & 1);
            *(uint2*)(p.Vt + ((size_t)h * 64 + d) * KVR + KRr) = pk4(acc[i][j][4 * G], acc[i][j][4 * G + 1], acc[i][j][4 * G + 2], acc[i][j][4 * G + 3]);
          }
      }
    }
  }
  __syncthreads();
}
DEV void sample_prep_item(const Prm& p, int L, int it) {
  int tid = threadIdx.x; LAUNDER(tid);
  const int R = NPR + it * 128 + (tid >> 1);
  kv_prep_row(p, L, R, tid & 1, true, nullptr);
}
DEV void shift_item(const Prm& p, int L, int st) {
  int tid0 = threadIdx.x; LAUNDER(tid0);
  if (tid0 < 224) {
    const int R = st < 4 ? st * PT + (PT - 1) : NPR + (st - 4) * 64 + 63;
    const uint2 u = *(const uint2*)(p.zE + (size_t)R * ZE + ZE_ZC + 4 * tid0);
    float4 v; v.x = bflo(u.x); v.y = bfhi(u.x); v.z = bflo(u.y); v.w = bfhi(u.y);
    float* dst = st < 4 ? p.shift_p + ((size_t)L * 4 + st) * 896 : p.shift_s + ((size_t)L * 32 + (st - 4)) * 896;
    *(float4*)(dst + 4 * tid0) = v;
  }
}

DEV void lat_item(const Prm& p, int L, int j) {
  int tid = threadIdx.x; LAUNDER(tid);
  const int b = j >> 4, t = j & 15;
  const float* csrc = p.cache_ckv + (((size_t)L * 32 + b) * 1024 + 64 * t) * 128;
  const float* ksrc = p.cache_krope + (((size_t)L * 32 + b) * 1024 + 64 * t) * 32;
  {
    const int row = tid >> 2, qd = tid & 3;
    const float* s = csrc + row * 128 + 32 * qd;
    bf16_t* d = p.KL + ((size_t)b * SKEYS + 64 * t + row) * 160;
    const float4 v0 = *(const float4*)(s), v1 = *(const float4*)(s + 4), v2 = *(const float4*)(s + 8), v3 = *(const float4*)(s + 12);
    const float4 v4 = *(const float4*)(s + 16), v5 = *(const float4*)(s + 20), v6 = *(const float4*)(s + 24), v7 = *(const float4*)(s + 28);
    const float4 k0 = *(const float4*)(ksrc + row * 32 + 8 * qd), k1 = *(const float4*)(ksrc + row * 32 + 8 * qd + 4);
    uint4 a;
    a.x = pk2(v0.x, v0.y); a.y = pk2(v0.z, v0.w); a.z = pk2(v2.x, v2.y); a.w = pk2(v2.z, v2.w); *(uint4*)(d + 32 * qd) = a;
    a.x = pk2(v1.x, v1.y); a.y = pk2(v1.z, v1.w); a.z = pk2(v3.x, v3.y); a.w = pk2(v3.z, v3.w); *(uint4*)(d + 32 * qd + 8) = a;
    a.x = pk2(v4.x, v4.y); a.y = pk2(v4.z, v4.w); a.z = pk2(v6.x, v6.y); a.w = pk2(v6.z, v6.w); *(uint4*)(d + 32 * qd + 16) = a;
    a.x = pk2(v5.x, v5.y); a.y = pk2(v5.z, v5.w); a.z = pk2(v7.x, v7.y); a.w = pk2(v7.z, v7.w); *(uint4*)(d + 32 * qd + 24) = a;
    a.x = pk2(k0.x, k0.y); a.y = pk2(k0.z, k0.w); a.z = pk2(k1.x, k1.y); a.w = pk2(k1.z, k1.w); *(uint4*)(d + 128 + 8 * qd) = a;
  }
}

template <bool SAMPLE>
DEV int attn_body(const Prm& p, int L, int sb, int head, int qt, char* lds, unsigned* nctr = nullptr) {
  int tid = threadIdx.x; LAUNDER(tid);
  const int lane = tid & 63, w = __builtin_amdgcn_readfirstlane(tid >> 6), l31 = lane & 31, hh = lane >> 5;
  bf16_t* Ks = (bf16_t*)lds;
  bf16_t* Vs = Ks + (SAMPLE ? 1 : 2) * 64 * 104;
  bf16_t* Cs = Vs + (SAMPLE ? 1 : 2) * 64 * 72;
  bf16_t* Wl = Cs + 64 * 136;
  const bf16_t* Qb = (const bf16_t*)p.y_prompt;
  bf16_t* mix = p.zE;
  int Rq0, ntiles, lastvis; bool wact, rowvalid;
  if (SAMPLE) { Rq0 = NPR + 64 * sb; ntiles = 17; lastvis = 16; wact = w < 2; rowvalid = wact; }
  else if (qt >= 0) { Rq0 = sb * PT + 16 + 128 * qt; ntiles = 2 * qt + 3; lastvis = 1 + 2 * qt + (w >> 1); wact = true; rowvalid = true; }
  else { Rq0 = sb * PT; ntiles = 1; lastvis = 0; wact = (w == 0); rowvalid = wact && l31 < 16; }
  const int myrow = Rq0 + 32 * w + l31;
  const int Rld = rowvalid ? myrow : Rq0;
  bf16x8 qf[6];
  {
    const bf16_t* qp = Qb + (size_t)Rld * 768 + head * 96 + hh * 8;
#pragma unroll
    for (int ks = 0; ks < 6; ++ks) qf[ks] = *(const bf16x8*)(qp + 16 * ks);
  }
  float m_run = -1e30f, l_run = 0.f;
  f32x16 o0 = zero16(), o1 = zero16();

  uint4 a_kn0, a_kn1, a_kr, a_vt0, a_vt1;
  a_kn0 = a_kn1 = a_kr = a_vt0 = a_vt1 = make_uint4(0, 0, 0, 0);
#define PLOADX(S, TI) { const int KR0 = sb * PT + ((TI) == 0 ? 0 : 16 + 64 * ((TI) - 1)); \
    S##_kn0 = *(const uint4*)(p.Kn + ((size_t)(KR0 + (tid >> 3)) * 8 + head) * 64 + (tid & 7) * 8); \
    S##_kn1 = *(const uint4*)(p.Kn + ((size_t)(KR0 + 32 + (tid >> 3)) * 8 + head) * 64 + (tid & 7) * 8); \
    S##_kr = *(const uint4*)(p.Kr + (size_t)(KR0 + (tid >> 2)) * 32 + (tid & 3) * 8); \
    S##_vt0 = *(const uint4*)(p.Vt + ((size_t)head * 64 + (tid >> 3)) * KVR + KR0 + (tid & 7) * 8); \
    S##_vt1 = *(const uint4*)(p.Vt + ((size_t)head * 64 + 32 + (tid >> 3)) * KVR + KR0 + (tid & 7) * 8); }
#define PWRITEX(S, BUF) { bf16_t* kb_ = Ks + (BUF) * 64 * 104; bf16_t* vb_ = Vs + (BUF) * 64 * 72; \
    *(uint4*)(kb_ + (tid >> 3) * 104 + (tid & 7) * 8) = S##_kn0; *(uint4*)(kb_ + (32 + (tid >> 3)) * 104 + (tid & 7) * 8) = S##_kn1; \
    *(uint4*)(kb_ + (tid >> 2) * 104 + 64 + (tid & 3) * 8) = S##_kr; \
    *(uint4*)(vb_ + (tid >> 3) * 72 + (tid & 7) * 8) = S##_vt0; *(uint4*)(vb_ + (32 + (tid >> 3)) * 72 + (tid & 7) * 8) = S##_vt1; }
  float4 pc0, pc1, pc2, pc3, pc4, pc5, pc6, pc7, pk0, pk1;
  pc0 = pc1 = pc2 = pc3 = pc4 = pc5 = pc6 = pc7 = pk0 = pk1 = make_float4(0.f, 0.f, 0.f, 0.f);
  if (SAMPLE) {
    const bf16_t* wsrc = p.Wb_ukv + ((size_t)L * 1024 + head * 128) * 128;
#pragma unroll
    for (int i = 0; i < 8; ++i) { const int id = tid + 256 * i, row = id >> 4, cc = id & 15; *(uint4*)(Wl + row * 136 + cc * 8) = *(const uint4*)(wsrc + row * 128 + cc * 8); }
  }
#define SLOAD(TI) { const float* csrc; const float* ksrc; \
    if ((TI) < 16) { csrc = p.cache_ckv + (((size_t)L * 32 + sb) * 1024 + 64 * (TI)) * 128; ksrc = p.cache_krope + (((size_t)L * 32 + sb) * 1024 + 64 * (TI)) * 32; } \
    else { csrc = p.ckv_s + ((size_t)L * NSM + 64 * sb) * 128; ksrc = p.kr_s + ((size_t)L * NSM + 64 * sb) * 32; } \
    const float* cb_ = csrc + (tid >> 5) * 128 + (tid & 31) * 4; \
    pc0 = *(const float4*)(cb_); pc1 = *(const float4*)(cb_ + 8 * 128); pc2 = *(const float4*)(cb_ + 16 * 128); pc3 = *(const float4*)(cb_ + 24 * 128); \
    pc4 = *(const float4*)(cb_ + 32 * 128); pc5 = *(const float4*)(cb_ + 40 * 128); pc6 = *(const float4*)(cb_ + 48 * 128); pc7 = *(const float4*)(cb_ + 56 * 128); \
    const float* kb2_ = ksrc + (tid >> 3) * 32 + (tid & 7) * 4; pk0 = *(const float4*)(kb2_); pk1 = *(const float4*)(kb2_ + 32 * 32); }
#define SWRITE(BUF) { bf16_t* cd_ = Cs + (tid >> 5) * 136 + (tid & 31) * 4; \
    *(uint2*)(cd_) = pk4(pc0.x, pc0.y, pc0.z, pc0.w); *(uint2*)(cd_ + 8 * 136) = pk4(pc1.x, pc1.y, pc1.z, pc1.w); \
    *(uint2*)(cd_ + 16 * 136) = pk4(pc2.x, pc2.y, pc2.z, pc2.w); *(uint2*)(cd_ + 24 * 136) = pk4(pc3.x, pc3.y, pc3.z, pc3.w); \
    *(uint2*)(cd_ + 32 * 136) = pk4(pc4.x, pc4.y, pc4.z, pc4.w); *(uint2*)(cd_ + 40 * 136) = pk4(pc5.x, pc5.y, pc5.z, pc5.w); \
    *(uint2*)(cd_ + 48 * 136) = pk4(pc6.x, pc6.y, pc6.z, pc6.w); *(uint2*)(cd_ + 56 * 136) = pk4(pc7.x, pc7.y, pc7.z, pc7.w); \
    }
#define SWRITEK(BUF) { bf16_t* kd_ = Ks + (BUF) * 64 * 104 + (tid >> 3) * 104 + 64 + (tid & 7) * 4; \
    *(uint2*)(kd_) = pk4(pk0.x, pk0.y, pk0.z, pk0.w); *(uint2*)(kd_ + 32 * 104) = pk4(pk1.x, pk1.y, pk1.z, pk1.w); }
  auto sexpand = [&](int buf) {
    const int a = w & 1, b = w >> 1;
    const bf16_t* cp = Cs + (32 * b + l31) * 136 + hh * 8;
    const bf16_t* wkp = Wl + (32 * a + l31) * 136 + hh * 8;
    const bf16_t* wvp = wkp + 64 * 136;
    f32x16 ka = zero16(), va = zero16();
#pragma unroll
    for (int ks = 0; ks < 8; ++ks) {
      const bf16x8 cf = *(const bf16x8*)(cp + 16 * ks);
      ka = mfma32(*(const bf16x8*)(wkp + 16 * ks), cf, ka);
      va = mfma32(cf, *(const bf16x8*)(wvp + 16 * ks), va);
    }
    bf16_t* kb = Ks + buf * 64 * 104; bf16_t* vb = Vs + buf * 64 * 72;
#pragma unroll
    for (int G = 0; G < 4; ++G) {
      *(uint2*)(kb + (32 * b + l31) * 104 + 32 * a + 8 * G + 4 * hh) = pk4(ka[4 * G], ka[4 * G + 1], ka[4 * G + 2], ka[4 * G + 3]);
      *(uint2*)(vb + (32 * a + l31) * 72 + 32 * b + 8 * G + 4 * hh) = pk4(va[4 * G], va[4 * G + 1], va[4 * G + 2], va[4 * G + 3]);
    }
  };
  const int x7 = (l31 >> 1) & 7, x3 = (l31 >> 2) & 3, xv = (l31 >> 1) & 7;
#define KFRAG(SP, KS, SUB) (SAMPLE ? *(const bf16x8*)((const bf16_t*)(SP) + (l31 + 32 * (SUB)) * 104 + hh * 8 + 16 * (KS)) \
    : ((KS) < 4 ? *(const bf16x8*)((SP) + (l31 + 32 * (SUB)) * 128 + (((2 * (KS) + hh) ^ x7) << 4)) \
                : *(const bf16x8*)((SP) + 8192 + (l31 + 32 * (SUB)) * 64 + (((2 * ((KS) - 4) + hh) ^ x3) << 4))))
#define VFR(S, SUB) (*(const bf16x8*)(sp + 12288 + (l31 + 32 * (SUB)) * 128 + (((2 * (S) + hh) ^ xv) << 4)))
#define VHALF(SP, C, SUB) (SAMPLE ? *(const uint2*)((const bf16_t*)(SP) + 64 * 104 + (l31 + 32 * (SUB)) * 72 + 4 * hh + 8 * (C)) \
    : *(const uint2*)((SP) + 12288 + (l31 + 32 * (SUB)) * 128 + 8 * hh + ((((C)) ^ xv) << 4)))
  auto compute_t = [&](auto masked_c, const char* sp) {
    constexpr bool MASKED = decltype(masked_c)::value;
    f32x16 s0 = zero16(), s1 = zero16();
    {
      bf16x8 kf[12];
#pragma unroll
      for (int ks = 0; ks < 6; ++ks) { kf[2 * ks] = KFRAG(sp, ks, 0); kf[2 * ks + 1] = KFRAG(sp, ks, 1); }
      __builtin_amdgcn_sched_barrier(0);
#pragma unroll
      for (int ks = 0; ks < 6; ++ks) { s0 = mfma32(kf[2 * ks], qf[ks], s0); s1 = mfma32(kf[2 * ks + 1], qf[ks], s1); }
    }
    bf16x8 vf[8];
    if (!SAMPLE) {
#pragma unroll
      for (int S = 0; S < 4; ++S) { vf[2 * S] = VFR(S, 0); vf[2 * S + 1] = VFR(S, 1); }
      __builtin_amdgcn_sched_barrier(0);
    }
    if (!SAMPLE && MASKED) {
#pragma unroll
      for (int r = 8; r < 16; ++r) s0[r] = -1e30f;
#pragma unroll
      for (int r = 0; r < 16; ++r) s1[r] = -1e30f;
    }
    float mx = s0[0];
#pragma unroll
    for (int r = 1; r < 16; ++r) mx = fmaxf(mx, s0[r]);
#pragma unroll
    for (int r = 0; r < 16; ++r) mx = fmaxf(mx, s1[r]);
    mx = fmaxf(mx, __shfl_xor(mx, 32));
    const float mnew = fmaxf(m_run, mx);
    const float alpha = __builtin_amdgcn_exp2f(m_run - mnew);
    m_run = mnew;
    float ps = 0.f;
#pragma unroll
    for (int r = 0; r < 16; ++r) { s0[r] = __builtin_amdgcn_exp2f(s0[r] - mnew); ps += s0[r]; }
#pragma unroll
    for (int r = 0; r < 16; ++r) { s1[r] = __builtin_amdgcn_exp2f(s1[r] - mnew); ps += s1[r]; }
    l_run = l_run * alpha + ps;
#pragma unroll
    for (int r = 0; r < 16; ++r) { o0[r] *= alpha; o1[r] *= alpha; }
    const bf16x8 pf0 = mk8(pk2(s0[0], s0[1]), pk2(s0[2], s0[3]), pk2(s0[4], s0[5]), pk2(s0[6], s0[7]));
    const bf16x8 pf1 = mk8(pk2(s0[8], s0[9]), pk2(s0[10], s0[11]), pk2(s0[12], s0[13]), pk2(s0[14], s0[15]));
    const bf16x8 pf2 = mk8(pk2(s1[0], s1[1]), pk2(s1[2], s1[3]), pk2(s1[4], s1[5]), pk2(s1[6], s1[7]));
    const bf16x8 pf3 = mk8(pk2(s1[8], s1[9]), pk2(s1[10], s1[11]), pk2(s1[12], s1[13]), pk2(s1[14], s1[15]));
#define PV_STEP(S, PF) { bf16x8 v0_, v1_; \
      if (SAMPLE) { const uint2 a0 = VHALF(sp, 2 * S, 0), b0 = VHALF(sp, 2 * S + 1, 0), a1 = VHALF(sp, 2 * S, 1), b1 = VHALF(sp, 2 * S + 1, 1); \
        v0_ = mk8(a0.x, a0.y, b0.x, b0.y); v1_ = mk8(a1.x, a1.y, b1.x, b1.y); } \
      else { v0_ = *(const bf16x8*)(sp + 12288 + l31 * 128 + (((2 * S + hh) ^ xv) << 4)); v1_ = *(const bf16x8*)(sp + 12288 + (l31 + 32) * 128 + (((2 * S + hh) ^ xv) << 4)); } \
      o0 = mfma32(v0_, PF, o0); o1 = mfma32(v1_, PF, o1); }
    if (SAMPLE) { PV_STEP(0, pf0) PV_STEP(1, pf1) PV_STEP(2, pf2) PV_STEP(3, pf3) }
    else {
      o0 = mfma32(vf[0], pf0, o0); o1 = mfma32(vf[1], pf0, o1); o0 = mfma32(vf[2], pf1, o0); o1 = mfma32(vf[3], pf1, o1);
      o0 = mfma32(vf[4], pf2, o0); o1 = mfma32(vf[5], pf2, o1); o0 = mfma32(vf[6], pf3, o0); o1 = mfma32(vf[7], pf3, o1);
    }
  };
  auto compute_meta = [&](const char* sp) {
    f32x16 s0 = zero16();
    {
      bf16x8 kf[6];
#pragma unroll
      for (int ks = 0; ks < 6; ++ks) kf[ks] = KFRAG(sp, ks, 0);
      __builtin_amdgcn_sched_barrier(0);
#pragma unroll
      for (int ks = 0; ks < 6; ++ks) s0 = mfma32(kf[ks], qf[ks], s0);
    }
    const bf16x8 v0 = VFR(0, 0), v1 = VFR(0, 1);
    float mx = s0[0];
#pragma unroll
    for (int r = 1; r < 8; ++r) mx = fmaxf(mx, s0[r]);
    mx = fmaxf(mx, __shfl_xor(mx, 32));
    m_run = mx;
    float ps = 0.f;
#pragma unroll
    for (int r = 0; r < 8; ++r) { s0[r] = __builtin_amdgcn_exp2f(s0[r] - mx); ps += s0[r]; }
    l_run = ps;
    const bf16x8 pf0 = mk8(pk2(s0[0], s0[1]), pk2(s0[2], s0[3]), pk2(s0[4], s0[5]), pk2(s0[6], s0[7]));
    o0 = mfma32(v0, pf0, zero16()); o1 = mfma32(v1, pf0, zero16());
  };
  bf16x8 qf7 = mk8(0u, 0u, 0u, 0u);
  const bf16x8 kone = mk8(hh == 0 ? 0x3F80u : 0u, 0u, 0u, 0u);
  auto freeze = [&]() {
    const float mf = bflo(pk2(m_run, 0.f));
    const float fac = __builtin_amdgcn_exp2f(m_run - mf);
    l_run *= fac;
#pragma unroll
    for (int r = 0; r < 16; ++r) { o0[r] *= fac; o1[r] *= fac; }
    qf7 = mk8(hh == 0 ? (pk2(-mf, 0.f) & 0xffffu) : 0u, 0u, 0u, 0u);
  };
  auto compute_f = [&](const char* sp) {
    f32x16 s0, s1;
    {
      bf16x8 kf[12];
#pragma unroll
      for (int ks = 0; ks < 6; ++ks) { kf[2 * ks] = KFRAG(sp, ks, 0); kf[2 * ks + 1] = KFRAG(sp, ks, 1); }
      __builtin_amdgcn_sched_barrier(0);
      s0 = mfma32(kone, qf7, zero16()); s1 = mfma32(kone, qf7, zero16());
#pragma unroll
      for (int ks = 0; ks < 6; ++ks) { s0 = mfma32(kf[2 * ks], qf[ks], s0); s1 = mfma32(kf[2 * ks + 1], qf[ks], s1); }
    }
    bf16x8 vf[8];
    if (!SAMPLE) {
#pragma unroll
      for (int S = 0; S < 4; ++S) { vf[2 * S] = VFR(S, 0); vf[2 * S + 1] = VFR(S, 1); }
      __builtin_amdgcn_sched_barrier(0);
    }
    float ps = 0.f;
#pragma unroll
    for (int r = 0; r < 16; ++r) { s0[r] = __builtin_amdgcn_exp2f(s0[r]); ps += s0[r]; }
#pragma unroll
    for (int r = 0; r < 16; ++r) { s1[r] = __builtin_amdgcn_exp2f(s1[r]); ps += s1[r]; }
    l_run += ps;
    const bf16x8 pf0 = mk8(pk2(s0[0], s0[1]), pk2(s0[2], s0[3]), pk2(s0[4], s0[5]), pk2(s0[6], s0[7]));
    const bf16x8 pf1 = mk8(pk2(s0[8], s0[9]), pk2(s0[10], s0[11]), pk2(s0[12], s0[13]), pk2(s0[14], s0[15]));
    const bf16x8 pf2 = mk8(pk2(s1[0], s1[1]), pk2(s1[2], s1[3]), pk2(s1[4], s1[5]), pk2(s1[6], s1[7]));
    const bf16x8 pf3 = mk8(pk2(s1[8], s1[9]), pk2(s1[10], s1[11]), pk2(s1[12], s1[13]), pk2(s1[14], s1[15]));
    if (SAMPLE) { PV_STEP(0, pf0) PV_STEP(1, pf1) PV_STEP(2, pf2) PV_STEP(3, pf3) }
    else {
      o0 = mfma32(vf[0], pf0, o0); o1 = mfma32(vf[1], pf0, o1); o0 = mfma32(vf[2], pf1, o0); o1 = mfma32(vf[3], pf1, o1);
      o0 = mfma32(vf[4], pf2, o0); o1 = mfma32(vf[5], pf2, o1); o0 = mfma32(vf[6], pf3, o0); o1 = mfma32(vf[7], pf3, o1);
    }
#undef PV_STEP
  };

  if (SAMPLE) {
    SLOAD(0)
    for (int ti = 0; ti < ntiles; ++ti) {
      const int buf = 0;
      SWRITE(buf)
      __syncthreads();
      SWRITEK(buf)
      { const int tn = ti + 1 < ntiles ? ti + 1 : ti; SLOAD(tn) }
      sexpand(buf);
      __syncthreads();
      if (wact) { if (ti == 0) { compute_t(std::false_type{}, (const char*)Ks); freeze(); } else compute_f((const char*)Ks); }
    }
    __syncthreads();
  } else {
    const int l8 = lane >> 3, c8 = lane & 7;
    unsigned kn_o0, kn_o1, kr_o, vt_o0, vt_o1;
    { const int r = 8 * (2 * w) + l8; kn_o0 = (unsigned)((r * 8 + head) * 64 + ((c8 ^ ((r >> 1) & 7)) * 8)); }
    { const int r = 8 * (2 * w + 1) + l8; kn_o1 = (unsigned)((r * 8 + head) * 64 + ((c8 ^ ((r >> 1) & 7)) * 8)); }
    { const int r = 16 * w + (lane >> 2); kr_o = (unsigned)(r * 32 + (((lane & 3) ^ ((r >> 2) & 3)) * 8)); }
    { const int d = 8 * (2 * w) + l8; vt_o0 = (unsigned)((head * 64 + d) * KVR + ((c8 ^ ((d >> 1) & 7)) * 8)); }
    { const int d = 8 * (2 * w + 1) + l8; vt_o1 = (unsigned)((head * 64 + d) * KVR + ((c8 ^ ((d >> 1) & 7)) * 8)); }
#define GLDS16(G, Lp) __builtin_amdgcn_global_load_lds((const unsigned*)(G), (LAS3 unsigned*)(Lp), 16, 0, 0)
#define PDMA(TI, STG) { const int KR0 = sb * PT + ((TI) == 0 ? 0 : 16 + 64 * ((TI) - 1)); char* sb_ = lds + (STG) * 20480 + lane * 16; \
      const bf16_t* kn_ = p.Kn + (size_t)KR0 * 512; const bf16_t* kr_ = p.Kr + (size_t)KR0 * 32; const bf16_t* vt_ = p.Vt + KR0; \
      GLDS16(kn_ + kn_o0, sb_ + (2 * w) * 1024); GLDS16(kn_ + kn_o1, sb_ + (2 * w + 1) * 1024); GLDS16(kr_ + kr_o, sb_ + 8192 + w * 1024); \
      GLDS16(vt_ + vt_o0, sb_ + 12288 + (2 * w) * 1024); GLDS16(vt_ + vt_o1, sb_ + 12288 + (2 * w + 1) * 1024); }
    PDMA(0, 0)
    if (ntiles > 1) PDMA(1, 1)
    int stg = 0, stg2 = 2;
    for (int ti = 0; ti < ntiles; ++ti) {
      if (ti + 1 < ntiles) asm volatile("s_waitcnt vmcnt(5)" ::: "memory"); else asm volatile("s_waitcnt vmcnt(0)" ::: "memory");
      RAW_BARRIER()
      if (ti + 2 < ntiles) PDMA(ti + 2, stg2)
      const char* sp = lds + stg * 20480;
      if (ti == 0) { if (wact) compute_meta(sp); }
      else if (ti == 1) { compute_t(std::false_type{}, sp); freeze(); }
      else if (ti <= lastvis) compute_f(sp);
      stg = stg == 2 ? 0 : stg + 1; stg2 = stg2 == 2 ? 0 : stg2 + 1;
    }
    __syncthreads();
#undef PDMA
#undef GLDS16
  }
  int tk = 0x7fffffff; if (nctr && tid == 0) tk = (int)atomicAdd(nctr, 1u);
  const float lt = l_run + __shfl_xor(l_run, 32);
  if (rowvalid) {
    const float inv = 1.f / lt;
    const bf16_t* gbp = p.zL + (size_t)myrow * ZL + ZL_GB + 64 * head;
    bf16_t* op = mix + (size_t)myrow * D + 256 + 64 * head;
#pragma unroll
    for (int G = 0; G < 4; ++G) {
      const int d = 8 * G + 4 * hh;
      const uint2 g0 = *(const uint2*)(gbp + d), g1 = *(const uint2*)(gbp + 32 + d);
      *(uint2*)(op + d) = pk4(o0[4 * G] * inv * silu_(bflo(g0.x)), o0[4 * G + 1] * inv * silu_(bfhi(g0.x)), o0[4 * G + 2] * inv * silu_(bflo(g0.y)), o0[4 * G + 3] * inv * silu_(bfhi(g0.y)));
      *(uint2*)(op + 32 + d) = pk4(o1[4 * G] * inv * silu_(bflo(g1.x)), o1[4 * G + 1] * inv * silu_(bfhi(g1.x)), o1[4 * G + 2] * inv * silu_(bflo(g1.y)), o1[4 * G + 3] * inv * silu_(bfhi(g1.y)));
    }
  }
  return tk;
}
DEV void attn_item(const Prm& p, int L, int id, char* lds) {
  if (id < 1024) { const int qt = 31 - (id >> 5), sh = id & 31; attn_body<false>(p, L, sh >> 3, sh & 7, qt, lds); }
  else if (id < 1280) { const int j = id - 1024; attn_body<true>(p, L, j >> 3, j & 7, 0, lds); }
  else { const int j = id - 1280; attn_body<false>(p, L, j >> 3, j & 7, -1, lds); }
}

typedef short v4i16_t __attribute__((ext_vector_type(4)));
DEV uint2 lds_tr16(const char* pl) { const v4i16_t r = __builtin_amdgcn_ds_read_tr16_b64_v4i16((__attribute__((address_space(3))) v4i16_t*)pl); return __builtin_bit_cast(uint2, r); }
DEV void attn_sample(const Prm& p, int L, int b, int hp, char* lds) {
  int tid = threadIdx.x; LAUNDER(tid);
  const int lane = tid & 63, w = __builtin_amdgcn_readfirstlane(tid >> 6), l31 = lane & 31, hh = lane >> 5;
  const int head = 2 * hp + (w >> 1);
  const bf16_t* Qb = (const bf16_t*)p.y_prompt;
  bf16_t* mix = p.zE;
  const int myrow = NPR + 64 * b + 32 * (w & 1) + l31;
  bf16x8 qf[6];
  {
    const bf16_t* qp = Qb + (size_t)myrow * 768 + head * 96 + hh * 8;
#pragma unroll
    for (int ks = 0; ks < 6; ++ks) qf[ks] = *(const bf16x8*)(qp + 16 * ks);
  }
  unsigned kl_o0, kl_o1, kl_o2, kl_o3, kr_o;
  {
    const int l16 = lane >> 4, c16 = lane & 15;
#define KROW(i) (4 * (4 * w + (i)) + l16)
#define KLO(i) ((unsigned)(KROW(i) * 160 + ((c16 ^ (((KROW(i) & 3) << 2) | ((KROW(i) >> 2) & 3))) * 8)))
    kl_o0 = KLO(0); kl_o1 = KLO(1); kl_o2 = KLO(2); kl_o3 = KLO(3);
#undef KLO
#undef KROW
    const int r = 16 * w + (lane >> 2);
    kr_o = (unsigned)(r * 160 + 128 + (((lane & 3) ^ ((r >> 2) & 3)) * 8));
  }
  const bf16_t* klb = p.KL + (size_t)b * SKEYS * 160;
#define GLDS16(G, Lp) __builtin_amdgcn_global_load_lds((const unsigned*)(G), (LAS3 unsigned*)(Lp), 16, 0, 0)
#define SDMA(TI, STG) { char* sb_ = lds + (STG) * 20480 + lane * 16; const bf16_t* kl_ = klb + (size_t)(TI) * 64 * 160; \
    GLDS16(kl_ + kl_o0, sb_ + (4 * w) * 1024); GLDS16(kl_ + kl_o1, sb_ + (4 * w + 1) * 1024); GLDS16(kl_ + kl_o2, sb_ + (4 * w + 2) * 1024); GLDS16(kl_ + kl_o3, sb_ + (4 * w + 3) * 1024); \
    GLDS16(kl_ + kr_o, sb_ + 16384 + w * 1024); }
  SDMA(0, 0)
  SDMA(1, 1)
  bf16x8 qa0, qa1, qa2, qa3, qa4, qa5, qa6, qa7;
  {
    const float* wsrc = p.w_ukv + ((size_t)L * 128 + l31) * 1024 + head * 128 + 8 * hh;
#define QABS(CT, QA, QB) { f32x16 acc = zero16(); \
      _Pragma("unroll") for (int ks = 0; ks < 4; ++ks) { const float* s_ = wsrc + (size_t)(32 * (CT)) * 1024 + 16 * ks; const float4 a_ = *(const float4*)s_, c_ = *(const float4*)(s_ + 4); \
        acc = mfma32(mk8(pk2(a_.x, a_.y), pk2(a_.z, a_.w), pk2(c_.x, c_.y), pk2(c_.z, c_.w)), qf[ks], acc); } \
      QA = mk8(pk2(acc[0], acc[1]), pk2(acc[2], acc[3]), pk2(acc[4], acc[5]), pk2(acc[6], acc[7])); \
      QB = mk8(pk2(acc[8], acc[9]), pk2(acc[10], acc[11]), pk2(acc[12], acc[13]), pk2(acc[14], acc[15])); }
    QABS(0, qa0, qa1) QABS(1, qa2, qa3) QABS(2, qa4, qa5) QABS(3, qa6, qa7)
#undef QABS
  }
  float m_run = -1e30f, l_run = 0.f;
  f32x16 o0 = zero16(), o1 = zero16(), o2 = zero16(), o3 = zero16();
  bf16x8 qf7 = mk8(0u, 0u, 0u, 0u);
  const bf16x8 kone = mk8(hh == 0 ? 0x3F80u : 0u, 0u, 0u, 0u);
  const int xk = ((l31 & 3) << 2) | ((l31 >> 2) & 3), x3 = (l31 >> 2) & 3;
  int va0, va1;
  {
    const int g = l31 >> 4, q = (l31 >> 2) & 3, pp = l31 & 3;
    const int rowb = (4 * hh + q) * 256 + 8 * (pp & 1) + (q << 6);
    va0 = rowb + (((2 * g + (pp >> 1)) ^ hh) << 4);
    va1 = rowb + 2048 + (((2 * g + (pp >> 1)) ^ (hh + 2)) << 4);
  }
  int stg = 0, stg2 = 2;
  for (int ti = 0; ti < 17; ++ti) {
    if (ti + 1 < 17) asm volatile("s_waitcnt vmcnt(5)" ::: "memory"); else asm volatile("s_waitcnt vmcnt(0)" ::: "memory");
    RAW_BARRIER()
    if (ti + 2 < 17) SDMA(ti + 2, stg2)
    const char* sp = lds + stg * 20480;
    f32x16 s0 = mfma32(kone, qf7, zero16()), s1 = s0;
#define QKL(S, QA) { const bf16x8 k0 = *(const bf16x8*)(sp + l31 * 256 + (((2 * (S) + hh) ^ xk) << 4)), k1 = *(const bf16x8*)(sp + (l31 + 32) * 256 + (((2 * (S) + hh) ^ xk) << 4)); \
      s0 = mfma32(k0, QA, s0); s1 = mfma32(k1, QA, s1); }
    QKL(0, qa0) QKL(1, qa1) QKL(2, qa2) QKL(3, qa3) QKL(4, qa4) QKL(5, qa5) QKL(6, qa6) QKL(7, qa7)
#undef QKL
#pragma unroll
    for (int kr = 0; kr < 2; ++kr) {
      const bf16x8 k0 = *(const bf16x8*)(sp + 16384 + l31 * 64 + (((2 * kr + hh) ^ x3) << 4)), k1 = *(const bf16x8*)(sp + 16384 + (l31 + 32) * 64 + (((2 * kr + hh) ^ x3) << 4));
      s0 = mfma32(k0, qf[4 + kr], s0); s1 = mfma32(k1, qf[4 + kr], s1);
    }
    float ps = 0.f;
    if (ti == 0) {
      float mx = s0[0];
#pragma unroll
      for (int r = 1; r < 16; ++r) mx = fmaxf(mx, s0[r]);
#pragma unroll
      for (int r = 0; r < 16; ++r) mx = fmaxf(mx, s1[r]);
      mx = fmaxf(mx, __shfl_xor(mx, 32));
      m_run = bflo(pk2(mx, 0.f));
#pragma unroll
      for (int r = 0; r < 16; ++r) { s0[r] -= m_run; s1[r] -= m_run; }
      qf7 = mk8(hh == 0 ? (pk2(-m_run, 0.f) & 0xffffu) : 0u, 0u, 0u, 0u);
    }
#pragma unroll
    for (int r = 0; r < 16; ++r) { s0[r] = __builtin_amdgcn_exp2f(s0[r]); ps += s0[r]; }
#pragma unroll
    for (int r = 0; r < 16; ++r) { s1[r] = __builtin_amdgcn_exp2f(s1[r]); ps += s1[r]; }
    l_run += ps;
    const bf16x8 pf0 = mk8(pk2(s0[0], s0[1]), pk2(s0[2], s0[3]), pk2(s0[4], s0[5]), pk2(s0[6], s0[7]));
    const bf16x8 pf1 = mk8(pk2(s0[8], s0[9]), pk2(s0[10], s0[11]), pk2(s0[12], s0[13]), pk2(s0[14], s0[15]));
    const bf16x8 pf2 = mk8(pk2(s1[0], s1[1]), pk2(s1[2], s1[3]), pk2(s1[4], s1[5]), pk2(s1[6], s1[7]));
    const bf16x8 pf3 = mk8(pk2(s1[8], s1[9]), pk2(s1[10], s1[11]), pk2(s1[12], s1[13]), pk2(s1[14], s1[15]));
#define PVT(S, CT, PF, OT) { const uint2 a_ = lds_tr16(sp + (va0 ^ ((CT) << 6)) + (S) * 4096), b_ = lds_tr16(sp + (va1 ^ ((CT) << 6)) + (S) * 4096); \
      OT = mfma32(mk8(a_.x, a_.y, b_.x, b_.y), PF, OT); }
#define PVL(S, PF) PVT(S, 0, PF, o0) PVT(S, 1, PF, o1) PVT(S, 2, PF, o2) PVT(S, 3, PF, o3)
    PVL(0, pf0) PVL(1, pf1) PVL(2, pf2) PVL(3, pf3)
#undef PVL
#undef PVT
    stg = stg == 2 ? 0 : stg + 1; stg2 = stg2 == 2 ? 0 : stg2 + 1;
  }
#undef SDMA
#undef GLDS16
  __syncthreads();
  const float lt = l_run + __shfl_xor(l_run, 32);
  const float inv = 1.f / lt;
  f32x16 e0 = zero16(), e1 = zero16();
  const bf16_t* wv = p.Wb_ukv + ((size_t)L * 1024 + head * 128 + 64 + l31) * 128 + 8 * hh;
#define OEXP(S, OT, RB) { const bf16x8 ob = mk8(pk2(OT[RB] * inv, OT[RB + 1] * inv), pk2(OT[RB + 2] * inv, OT[RB + 3] * inv), pk2(OT[RB + 4] * inv, OT[RB + 5] * inv), pk2(OT[RB + 6] * inv, OT[RB + 7] * inv)); \
    e0 = mfma32(*(const bf16x8*)(wv + 16 * (S)), ob, e0); e1 = mfma32(*(const bf16x8*)(wv + 32 * 128 + 16 * (S)), ob, e1); }
  OEXP(0, o0, 0) OEXP(1, o0, 8) OEXP(2, o1, 0) OEXP(3, o1, 8) OEXP(4, o2, 0) OEXP(5, o2, 8) OEXP(6, o3, 0) OEXP(7, o3, 8)
#undef OEXP
  {
    const bf16_t* gbp = p.zL + (size_t)myrow * ZL + ZL_GB + 64 * head;
    bf16_t* op = mix + (size_t)myrow * D + 256 + 64 * head;
#pragma unroll
    for (int G = 0; G < 4; ++G) {
      const int d = 8 * G + 4 * hh;
      const uint2 g0 = *(const uint2*)(gbp + d), g1 = *(const uint2*)(gbp + 32 + d);
      *(uint2*)(op + d) = pk4(e0[4 * G] * silu_(bflo(g0.x)), e0[4 * G + 1] * silu_(bfhi(g0.x)), e0[4 * G + 2] * silu_(bflo(g0.y)), e0[4 * G + 3] * silu_(bfhi(g0.y)));
      *(uint2*)(op + 32 + d) = pk4(e1[4 * G] * silu_(bflo(g1.x)), e1[4 * G + 1] * silu_(bfhi(g1.x)), e1[4 * G + 2] * silu_(bflo(g1.y)), e1[4 * G + 3] * silu_(bfhi(g1.y)));
    }
  }
}

DEV void conv_item(const Prm& p, int L, int item) {
  int tid = threadIdx.x; LAUNDER(tid);
  bf16_t* mix = p.zE;
  const int c0 = (tid & 31) * 8;
  float w0[8], w1[8], w2[8];
#pragma unroll
  for (int e = 0; e < 8; ++e) { w0[e] = p.conv_w[(L * 3 + 0) * 256 + c0 + e]; w1[e] = p.conv_w[(L * 3 + 1) * 256 + c0 + e]; w2[e] = p.conv_w[(L * 3 + 2) * 256 + c0 + e]; }
  for (int it = 0; it < 4; ++it) {
    const int R = item * 32 + it * 8 + (tid >> 5);
    if (R >= NT) continue;
    int q, T; const float* st; float* so;
    if (R < NPR) { const int s = R / PT; q = R - s * PT; T = PT; st = nullptr; so = p.conv_p + ((size_t)L * 4 + s) * 512; }
    else { const int b = (R - NPR) >> 6; q = (R - NPR) & 63; T = 64; st = p.state_conv + ((size_t)L * 32 + b) * 512; so = p.conv_s + ((size_t)L * 32 + b) * 512; }
    float u[3][8];
#pragma unroll
    for (int dlt = 0; dlt < 3; ++dlt) {
      const int t = q - 2 + dlt;
      if (t >= 0) {
        const bf16_t* zr = p.zL + (size_t)(R - 2 + dlt) * ZL;
        const uint4 xi = *(const uint4*)(zr + ZL_XIN + c0), cg = *(const uint4*)(zr + ZL_CG + c0);
        u[dlt][0] = bflo(xi.x) * bflo(cg.x); u[dlt][1] = bfhi(xi.x) * bfhi(cg.x); u[dlt][2] = bflo(xi.y) * bflo(cg.y); u[dlt][3] = bfhi(xi.y) * bfhi(cg.y);
        u[dlt][4] = bflo(xi.z) * bflo(cg.z); u[dlt][5] = bfhi(xi.z) * bfhi(cg.z); u[dlt][6] = bflo(xi.w) * bflo(cg.w); u[dlt][7] = bfhi(xi.w) * bfhi(cg.w);
      } else if (st) {
        const float* sr = st + (t + 2) * 256 + c0;
#pragma unroll
        for (int e = 0; e < 8; ++e) u[dlt][e] = sr[e];
      } else {
#pragma unroll
        for (int e = 0; e < 8; ++e) u[dlt][e] = 0.f;
      }
    }
    const bf16_t* zr = p.zL + (size_t)R * ZL;
    const uint4 bg = *(const uint4*)(zr + ZL_BG + c0), ga = *(const uint4*)(zr + ZL_GA + c0);
    const float bgf[8] = {bflo(bg.x), bfhi(bg.x), bflo(bg.y), bfhi(bg.y), bflo(bg.z), bfhi(bg.z), bflo(bg.w), bfhi(bg.w)};
    const float gaf[8] = {bflo(ga.x), bfhi(ga.x), bflo(ga.y), bfhi(ga.y), bflo(ga.z), bfhi(ga.z), bflo(ga.w), bfhi(ga.w)};
    float y[8];
#pragma unroll
    for (int e = 0; e < 8; ++e) y[e] = bgf[e] * (w0[e] * u[0][e] + w1[e] * u[1][e] + w2[e] * u[2][e]) * silu_(gaf[e]);
    uint4 o; o.x = pk2(y[0], y[1]); o.y = pk2(y[2], y[3]); o.z = pk2(y[4], y[5]); o.w = pk2(y[6], y[7]);
    *(uint4*)(mix + (size_t)R * D + c0) = o;
    if (q >= T - 2) {
      float* d = so + (q - (T - 2)) * 256 + c0;
#pragma unroll
      for (int e = 0; e < 8; ++e) d[e] = u[2][e];
    }
  }
}

DEV int kperm_addr(int m, int kin) {
  const int mt = m >> 4, ml = m & 15, s = kin >> 5, q = (kin >> 4) & 1, g = (kin >> 2) & 3, e = kin & 3;
  return (((mt * 2 + s) * 64 + ml + 16 * g) * 8) + 4 * q + e;
}
DEV int clay_addr(int x, int v) {
  const int xt = x >> 4, g = (x >> 2) & 3, rr = x & 3, vt = v >> 4, l16 = v & 15;
  return ((xt * 4 + vt) * 64 + 16 * g + l16) * 4 + rr;
}
DEV void mm64(const bf16_t* first, const bf16_t* second, int l31, int hh, f32x16 (&acc)[2][2]) {
#pragma unroll
  for (int ks = 0; ks < 4; ++ks) {
    const bf16x8 f0 = *(const bf16x8*)(first + l31 * 72 + ks * 16 + hh * 8), f1 = *(const bf16x8*)(first + (32 + l31) * 72 + ks * 16 + hh * 8);
    const bf16x8 s0 = *(const bf16x8*)(second + l31 * 72 + ks * 16 + hh * 8), s1 = *(const bf16x8*)(second + (32 + l31) * 72 + ks * 16 + hh * 8);
    acc[0][0] = mfma32(f0, s0, acc[0][0]); acc[0][1] = mfma32(f0, s1, acc[0][1]);
    acc[1][0] = mfma32(f1, s0, acc[1][0]); acc[1][1] = mfma32(f1, s1, acc[1][1]);
  }
}
DEV void mm64x32(const bf16_t* first, const bf16_t* second_rows, int l31, int hh, f32x16 (&acc)[2]) {
#pragma unroll
  for (int ks = 0; ks < 4; ++ks) {
    const bf16x8 f0 = *(const bf16x8*)(first + l31 * 72 + ks * 16 + hh * 8), f1 = *(const bf16x8*)(first + (32 + l31) * 72 + ks * 16 + hh * 8);
    const bf16x8 s0 = *(const bf16x8*)(second_rows + l31 * 72 + ks * 16 + hh * 8);
    acc[0] = mfma32(f0, s0, acc[0]); acc[1] = mfma32(f1, s0, acc[1]);
  }
}

DEV void mmq(const bf16_t* first_rows, const bf16_t* second_rows, int l31, int hh, f32x16& acc) {
#pragma unroll
  for (int ks = 0; ks < 4; ++ks) {
    const bf16x8 f0 = *(const bf16x8*)(first_rows + l31 * 72 + ks * 16 + hh * 8);
    const bf16x8 s0 = *(const bf16x8*)(second_rows + l31 * 72 + ks * 16 + hh * 8);
    acc = mfma32(f0, s0, acc);
  }
}
enum { SH_FULL = 0, SH_UP = 1, SH_LO = 2 };
template <int SH> DEV constexpr bool tile_nz(int tx, int ty) { return SH == SH_FULL || (SH == SH_UP ? tx <= ty : tx >= ty); }
struct Acc64 { f32x16 t[2][2]; };
struct Frag64 { bf16x8 f[4][2]; };
template <int SS> DEV bf16x8 pack8(const f32x16& v) {
  return mk8(pk2(v[8 * SS], v[8 * SS + 1]), pk2(v[8 * SS + 2], v[8 * SS + 3]), pk2(v[8 * SS + 4], v[8 * SS + 5]), pk2(v[8 * SS + 6], v[8 * SS + 7]));
}
template <int SH> DEV void to_frag(const Acc64& X, Frag64& F) {
#pragma unroll
  for (int t = 0; t < 2; ++t) {
    if (tile_nz<SH>(0, t)) { F.f[0][t] = pack8<0>(X.t[0][t]); F.f[1][t] = pack8<1>(X.t[0][t]); }
    if (tile_nz<SH>(1, t)) { F.f[2][t] = pack8<0>(X.t[1][t]); F.f[3][t] = pack8<1>(X.t[1][t]); }
  }
}
template <int SH> DEV void zero_acc(Acc64& X) {
#pragma unroll
  for (int a = 0; a < 2; ++a)
#pragma unroll
    for (int b = 0; b < 2; ++b) if (tile_nz<SH>(a, b)) X.t[a][b] = zero16();
}
template <int SHA, int SHB> DEV void prod_ff(const Frag64& A, const Frag64& B, Acc64& D) {
#pragma unroll
  for (int tm = 0; tm < 2; ++tm)
#pragma unroll
    for (int tn = 0; tn < 2; ++tn)
#pragma unroll
      for (int s = 0; s < 4; ++s)
        if (tile_nz<SHA>(s >> 1, tm) && tile_nz<SHB>(s >> 1, tn)) D.t[tm][tn] = mfma32(A.f[s][tm], B.f[s][tn], D.t[tm][tn]);
}
template <int SHA, int SHB, int SHD> DEV void prod_ff_frag(const Frag64& A, const Frag64& B, Frag64& Fo) {
#pragma unroll
  for (int tm = 0; tm < 2; ++tm)
#pragma unroll
    for (int tn = 0; tn < 2; ++tn)
      if (tile_nz<SHD>(tm, tn)) {
        f32x16 acc = zero16();
#pragma unroll
        for (int s = 0; s < 4; ++s)
          if (tile_nz<SHA>(s >> 1, tm) && tile_nz<SHB>(s >> 1, tn)) acc = mfma32(A.f[s][tm], B.f[s][tn], acc);
        Fo.f[2 * tm][tn] = pack8<0>(acc); Fo.f[2 * tm + 1][tn] = pack8<1>(acc);
      }
}
DEV bf16x8 nat_frag(const bf16_t* S, int row, int s, int hh) { return *(const bf16x8*)(S + row * 72 + 16 * s + 8 * hh); }
DEV bf16x8 perm_frag(const bf16_t* S, int row, int s, int hh) {
  const uint2 a = *(const uint2*)(S + row * 72 + 16 * s + 4 * hh), b = *(const uint2*)(S + row * 72 + 16 * s + 8 + 4 * hh);
  return mk8(a.x, a.y, b.x, b.y);
}
template <int SH, int MODE> DEV void gram(const bf16_t* F, const bf16_t* G, int l31, int hh, Acc64& D) {
  zero_acc<SH>(D);
#pragma unroll
  for (int s = 0; s < 4; ++s) {
    bf16x8 ff[2], gg[2];
#pragma unroll
    for (int t = 0; t < 2; ++t) { ff[t] = nat_frag(F, 32 * t + l31, s, hh); gg[t] = nat_frag(G, 32 * t + l31, s, hh); }
#pragma unroll
    for (int tx = 0; tx < 2; ++tx)
#pragma unroll
      for (int ty = 0; ty < 2; ++ty) if (tile_nz<SH>(tx, ty)) D.t[tx][ty] = mfma32(ff[tx], gg[ty], D.t[tx][ty]);
  }
#pragma unroll
  for (int t = 0; t < 2; ++t)
#pragma unroll
    for (int r = 0; r < 16; ++r) {
      const int x = (r & 3) + 8 * (r >> 2) + 4 * hh, y = l31;
      const bool keep = MODE == 0 ? (x < y) : (MODE == 1 ? (y < x) : (x <= y));
      if (!keep) D.t[t][t][r] = 0.f;
    }
}
template <int SHA> DEV void prod_fm_frag(const Frag64& A, const bf16_t* Mem, int l31, int hh, Frag64& Fo) {
#pragma unroll
  for (int tm = 0; tm < 2; ++tm)
#pragma unroll
    for (int tn = 0; tn < 2; ++tn) {
      f32x16 acc = zero16();
#pragma unroll
      for (int s = 0; s < 4; ++s) if (tile_nz<SHA>(s >> 1, tm)) acc = mfma32(A.f[s][tm], perm_frag(Mem, 32 * tn + l31, s, hh), acc);
      Fo.f[2 * tm][tn] = pack8<0>(acc); Fo.f[2 * tm + 1][tn] = pack8<1>(acc);
    }
}
template <int SHA> DEV void prod_fm(const Frag64& A, const bf16_t* Mem, int l31, int hh, Acc64& D) {
#pragma unroll
  for (int s = 0; s < 4; ++s) {
    bf16x8 mm[2];
#pragma unroll
    for (int t = 0; t < 2; ++t) mm[t] = perm_frag(Mem, 32 * t + l31, s, hh);
#pragma unroll
    for (int tm = 0; tm < 2; ++tm)
#pragma unroll
      for (int tn = 0; tn < 2; ++tn) if (tile_nz<SHA>(s >> 1, tm)) D.t[tm][tn] = mfma32(A.f[s][tm], mm[tn], D.t[tm][tn]);
  }
}
DEV void r1_item(const Prm& p, int L, int idx, char* lds) {
  int tid = threadIdx.x; LAUNDER(tid);
  const int w = __builtin_amdgcn_readfirstlane(tid >> 6);
  int lane = tid & 63, l31 = lane & 31, hh = lane >> 5;
  const int cw = w & 1, tw = w >> 1;
  bf16_t* S0 = (bf16_t*)lds;
  bf16_t* S1 = S0 + 4608; bf16_t* S2 = S1 + 4608; bf16_t* S3 = S2 + 4608; bf16_t* S4 = S3 + 4608; bf16_t* S5 = S4 + 4608; bf16_t* S6 = S5 + 4608; bf16_t* S7 = S6 + 4608;
  float* misc = (float*)(S7 + 4608);
  float* Ef = (float*)S4;
  bool prompt; int st, c, hd;
  if (idx < NRW_P) { prompt = true; st = idx / 260; const int rem = idx - st * 260; c = rem >> 2; hd = rem & 3; }
  else { prompt = false; const int j = idx - NRW_P; st = j >> 2; hd = j & 3; c = 0; }
  char* rwp = p.rw + (size_t)idx * RW_BYTES;
  const float* mu = p.shift_mu + L * 896;
  const int i1 = tid >> 2, m0 = (tid & 3) * 16;
  int R1; bool valid1, hasprev1;
  if (prompt) { const int pp = 64 * c - 48 + i1; valid1 = pp >= 0; R1 = st * PT + (valid1 ? pp : 0); hasprev1 = pp >= 1; }
  else { R1 = NPR + 64 * st + i1; valid1 = true; hasprev1 = i1 >= 1; }
  const bf16_t* zr1 = p.zE + (size_t)R1 * ZE + ZE_ZC;
  const int ti0 = 32 * tw + l31;
  int R; bool valid, hasprev;
  if (prompt) { const int pp = 64 * c - 48 + ti0; valid = pp >= 0; R = st * PT + (valid ? pp : 0); hasprev = pp >= 1; }
  else { R = NPR + 64 * st + ti0; valid = true; hasprev = ti0 >= 1; }
  const bf16_t* zr = p.zE + (size_t)R * ZE + ZE_ZC;
  const int chb = 64 * hd + 32 * cw + 4 * hh;
  uint4 la[2][2], lap[2][2]; uint2 lb[3][4], lbp[3][4];
  {
    const bf16_t* sh0 = p.zE + (size_t)(NT + (prompt ? 32 : st)) * ZE + ZE_ZC;
    const bf16_t* zp1 = hasprev1 ? zr1 - ZE : sh0;
    const bf16_t* zp = hasprev ? zr - ZE : sh0;
#pragma unroll
    for (int part = 0; part < 2; ++part)
#pragma unroll
      for (int h8 = 0; h8 < 2; ++h8) { const int col = 768 + 64 * part + m0 + 8 * h8; la[part][h8] = *(const uint4*)(zr1 + col); lap[part][h8] = *(const uint4*)(zp1 + col); }
#pragma unroll
    for (int part = 0; part < 3; ++part)
#pragma unroll
      for (int G = 0; G < 4; ++G) { const int col = 256 * part + chb + 8 * G; lb[part][G] = *(const uint2*)(zr + col); lbp[part][G] = *(const uint2*)(zp + col); }
    const bf16_t* dsrc = p.dw2T + ((size_t)L * 256 + hd * 64 + i1) * 64 + m0;
    const bf16_t* isrc = p.ia2T + ((size_t)L * 256 + hd * 64 + i1) * 64 + m0;
    const uint4 d0 = *(const uint4*)dsrc, d1 = *(const uint4*)(dsrc + 8), e0 = *(const uint4*)isrc, e1 = *(const uint4*)(isrc + 8);
    __builtin_amdgcn_sched_barrier(0);
    *(uint4*)(S2 + i1 * 72 + m0) = d0; *(uint4*)(S2 + i1 * 72 + m0 + 8) = d1;
    *(uint4*)(S3 + i1 * 72 + m0) = e0; *(uint4*)(S3 + i1 * 72 + m0 + 8) = e1;
  }
  {
    float* prm = misc + 384;
#pragma unroll
    for (int q2 = 0; q2 < 2; ++q2) {
      const int ix = tid + 256 * q2, wh = ix >> 6, chp = ix & 63;
      const float* sp = wh == 0 ? p.decay_w0 : wh == 1 ? p.iclr_a0 : wh == 2 ? p.key_kk : wh == 3 ? p.key_ka : wh == 4 ? p.bonus_rk : nullptr;
      prm[ix] = sp ? sp[L * 256 + hd * 64 + chp] : mu[256 * (wh - 5) + 64 * hd + chp];
    }
  }
#pragma unroll
  for (int part = 0; part < 2; ++part) {
#pragma unroll
    for (int h8 = 0; h8 < 2; ++h8) {
      const int col = 768 + 64 * part + m0 + 8 * h8;
      const uint4 u = la[part][h8], v = lap[part][h8];
      const float cur[8] = {bflo(u.x), bfhi(u.x), bflo(u.y), bfhi(u.y), bflo(u.z), bfhi(u.z), bflo(u.w), bfhi(u.w)};
      float prv[8] = {bflo(v.x), bfhi(v.x), bflo(v.y), bfhi(v.y), bflo(v.z), bfhi(v.z), bflo(v.w), bfhi(v.w)};
      float o[8];
#pragma unroll
      for (int e = 0; e < 8; ++e) { float z = cur[e] + (prv[e] - cur[e]) * mu[col + e]; if (!valid1) z = 0.f; o[e] = part == 0 ? (1.f - 2.f / (__expf(2.f * z) + 1.f)) : z; }
      uint4 a; a.x = pk2(o[0], o[1]); a.y = pk2(o[2], o[3]); a.z = pk2(o[4], o[5]); a.w = pk2(o[6], o[7]);
      *(uint4*)((part == 0 ? S0 : S1) + i1 * 72 + m0 + 8 * h8) = a;
    }
  }
  __syncthreads();
  f32x16 accw = zero16(), acca = zero16();
#pragma unroll
  for (int ks = 0; ks < 4; ++ks) {
    const bf16x8 fw = *(const bf16x8*)(S2 + (32 * cw + l31) * 72 + ks * 16 + hh * 8), fa = *(const bf16x8*)(S3 + (32 * cw + l31) * 72 + ks * 16 + hh * 8);
    const bf16x8 sw = *(const bf16x8*)(S0 + (32 * tw + l31) * 72 + ks * 16 + hh * 8), sa = *(const bf16x8*)(S1 + (32 * tw + l31) * 72 + ks * 16 + hh * 8);
    accw = mfma32(fw, sw, accw); acca = mfma32(fa, sa, acca);
  }
  int ti = ti0;
  float e_[16];
  float ssq = 0.f;
#pragma unroll
  for (int G = 0; G < 4; ++G) {
    const int ch = chb + 8 * G, col = 256 + ch;
    const uint2 u = lb[1][G], v = lbp[1][G];
    const float cur[4] = {bflo(u.x), bfhi(u.x), bflo(u.y), bfhi(u.y)};
    float prv[4] = {bflo(v.x), bfhi(v.x), bflo(v.y), bfhi(v.y)};
    const int chq = 32 * cw + 8 * G + 4 * hh;
    const float4 kkw = *(const float4*)(misc + 384 + 128 + chq), w0 = *(const float4*)(misc + 384 + chq), m4 = *(const float4*)(misc + 384 + 384 + chq);
    const float kkv[4] = {kkw.x, kkw.y, kkw.z, kkw.w}, w0v[4] = {w0.x, w0.y, w0.z, w0.w}, muv[4] = {m4.x, m4.y, m4.z, m4.w};
#pragma unroll
    for (int e = 0; e < 4; ++e) {
      float z = cur[e] + (prv[e] - cur[e]) * muv[e];
      if (!valid) z = 0.f;
      const float kkr = z * kkv[e];
      ssq += kkr * kkr;
      e_[4 * G + e] = valid ? 0.6065306597126334f * sigmoid_(w0v[e] + accw[4 * G + e]) : 0.f;
    }
  }
  ssq += __shfl_xor(ssq, 32);
  if (hh == 0) misc[(cw * 64 + ti) * 2] = ssq;
#pragma unroll
  for (int G = 0; G < 4; ++G)
#pragma unroll
    for (int e = 0; e < 4; ++e) Ef[ti * 65 + 32 * cw + 8 * G + 4 * hh + e] = e_[4 * G + e];
  __syncthreads();
  {
    const int ch = tid & 63, seg = tid >> 6;
    float run = 0.f;
#pragma unroll
    for (int t = 0; t < 16; ++t) { run += Ef[(16 * seg + t) * 65 + ch]; Ef[(16 * seg + t) * 65 + ch] = run; }
    __syncthreads();
    float off = 0.f;
    for (int s2 = 0; s2 < seg; ++s2) off += Ef[(16 * s2 + 15) * 65 + ch];
    __syncthreads();
#pragma unroll
    for (int t = 0; t < 16; ++t) Ef[(16 * seg + t) * 65 + ch] += off;
    if (seg == 3) { const float cC = Ef[63 * 65 + ch]; misc[320 + ch] = cC; misc[256 + ch] = __expf(-cC); }
    __syncthreads();
  }
  float cc_[16];
#pragma unroll
  for (int G = 0; G < 4; ++G)
#pragma unroll
    for (int e = 0; e < 4; ++e) cc_[4 * G + e] = Ef[ti * 65 + 32 * cw + 8 * G + 4 * hh + e];
  const float kinv = 1.f / fmaxf(sqrtf(misc[ti * 2] + misc[(64 + ti) * 2]), 1e-12f);
  __syncthreads();
  LAUNDER(ti); LAUNDER(hh);
  uint2 vpk[4];
  float rk = 0.f;
#pragma unroll
  for (int G = 0; G < 4; ++G) {
    const int ch = chb + 8 * G, chl = 32 * cw + 8 * G + 4 * hh;
    float zs[3][4];
#pragma unroll
    for (int part = 0; part < 3; ++part) {
      const int col = 256 * part + ch;
      const uint2 u = lb[part][G], v = lbp[part][G];
      const float cur[4] = {bflo(u.x), bfhi(u.x), bflo(u.y), bfhi(u.y)};
      float prv[4] = {bflo(v.x), bfhi(v.x), bflo(v.y), bfhi(v.y)};
      const float4 m4 = *(const float4*)(misc + 384 + 320 + 64 * part + chl);
      const float muv[4] = {m4.x, m4.y, m4.z, m4.w};
#pragma unroll
      for (int e = 0; e < 4; ++e) { float z = cur[e] + (prv[e] - cur[e]) * muv[e]; zs[part][e] = valid ? z : 0.f; }
    }
    vpk[G] = pk4(zs[2][0], zs[2][1], zs[2][2], zs[2][3]);
    const float4 a04 = *(const float4*)(misc + 384 + 64 + chl), kk4 = *(const float4*)(misc + 384 + 128 + chl), ka4 = *(const float4*)(misc + 384 + 192 + chl), bo4 = *(const float4*)(misc + 384 + 256 + chl);
    const float a0v[4] = {a04.x, a04.y, a04.z, a04.w}, kkv[4] = {kk4.x, kk4.y, kk4.z, kk4.w}, kav[4] = {ka4.x, ka4.y, ka4.z, ka4.w}, bov[4] = {bo4.x, bo4.y, bo4.z, bo4.w};
    float at[4], rt[4], bt[4], kt[4], bh[4], kh[4];
#pragma unroll
    for (int e = 0; e < 4; ++e) {
      const int r = 4 * G + e;
      const float al = sigmoid_(a0v[e] + acca[r]);
      const float kk = zs[1][e] * kkv[e] * kinv;
      const float km = zs[1][e] * (1.f + (al - 1.f) * kav[e]);
      rk += zs[0][e] * km * bov[e];
      const float gC = misc[256 + chl + e];
      const float cprev = cc_[r] - e_[r];
      const float ea = __expf(-cprev), er = __expf(-cc_[r]), ek = __builtin_amdgcn_rcpf(er), eh = ek * gC;
      const float b = kk * al;
      at[e] = -kk * ea; rt[e] = zs[0][e] * er; bt[e] = b * ek; kt[e] = km * ek; bh[e] = b * eh; kh[e] = km * eh;
    }
    *(uint2*)(S0 + ti * 72 + chl) = pk4(at[0], at[1], at[2], at[3]);
    *(uint2*)(S1 + ti * 72 + chl) = pk4(rt[0], rt[1], rt[2], rt[3]);
    *(uint2*)(S2 + ti * 72 + chl) = pk4(bt[0], bt[1], bt[2], bt[3]);
    *(uint2*)(S3 + ti * 72 + chl) = pk4(kt[0], kt[1], kt[2], kt[3]);
#pragma unroll
    for (int e = 0; e < 4; ++e) { S4[(chl + e) * 72 + ti] = f2bf(at[e]); S5[(chl + e) * 72 + ti] = f2bf(bh[e]); S6[(chl + e) * 72 + ti] = f2bf(kh[e]); S7[(chl + e) * 72 + ti] = f2bf(zs[2][e]); }
    *(uint2*)(rwp + 40960 + (ti * 64 + chl) * 2) = vpk[G];
  }
  rk += __shfl_xor(rk, 32);
  if (hh == 0) misc[(cw * 64 + ti) * 2 + 1] = rk;
  __syncthreads();
  if (valid && cw == 0 && hh == 0) p.rkb[(size_t)R * 4 + hd] = misc[ti * 2 + 1] + misc[(64 + ti) * 2 + 1];
  LAUNDER(l31); LAUNDER(hh); LAUNDER(lane);
  {
    Acc64 T;
    {
      Acc64 Mx, MTx;
      gram<SH_UP, 0>(S2, S0, l31, hh, Mx);
      gram<SH_LO, 1>(S0, S2, l31, hh, MTx);
      Frag64 fM, fMT, fT;
      to_frag<SH_UP>(Mx, fM); to_frag<SH_LO>(MTx, fMT);
      __builtin_amdgcn_sched_barrier(0);
      T = Mx;
#pragma unroll
      for (int t = 0; t < 2; ++t)
#pragma unroll
        for (int r = 0; r < 16; ++r) if ((r & 3) + 8 * (r >> 2) + 4 * hh == l31) T.t[t][t][r] += 1.f;
      T.t[1][0] = zero16();
      for (int r = 0; r < 5; ++r) {
        Frag64 fM2, fMT2;
        prod_ff_frag<SH_LO, SH_UP, SH_UP>(fMT, fM, fM2);
        prod_ff_frag<SH_UP, SH_LO, SH_LO>(fM, fMT, fMT2);
#pragma unroll
        for (int s = 0; s < 4; ++s)
#pragma unroll
          for (int t = 0; t < 2; ++t) { if (tile_nz<SH_UP>(s >> 1, t)) fM.f[s][t] = fM2.f[s][t]; if (tile_nz<SH_LO>(s >> 1, t)) fMT.f[s][t] = fMT2.f[s][t]; }
        to_frag<SH_UP>(T, fT);
        prod_ff<SH_LO, SH_UP>(fMT, fT, T);
      }
    }
    Frag64 fT;
    to_frag<SH_UP>(T, fT);
    __builtin_amdgcn_sched_barrier(0);
    if (w < 2) {
      Frag64 fW;
      prod_fm_frag<SH_UP>(fT, S4, l31, hh, fW);
      __builtin_amdgcn_sched_barrier(0);
      Acc64 O; zero_acc<SH_FULL>(O);
      if (w == 0) {
        prod_fm<SH_FULL>(fW, S5, l31, hh, O);
#pragma unroll
        for (int tx = 0; tx < 2; ++tx)
#pragma unroll
          for (int ty = 0; ty < 2; ++ty)
#pragma unroll
            for (int G = 0; G < 4; ++G) {
              const int x0 = 32 * tx + 8 * G + 4 * hh, y = 32 * ty + l31;
              float v[4];
#pragma unroll
              for (int e = 0; e < 4; ++e) { v[e] = O.t[tx][ty][4 * G + e]; if (x0 + e == y) v[e] += misc[256 + y]; }
              *(uint2*)(rwp + 0 + kperm_addr(y, x0) * 2) = pk4(v[0], v[1], v[2], v[3]);
            }
      } else {
        Acc64 Nb; gram<SH_UP, 2>(S2, S1, l31, hh, Nb);
        Frag64 fN; to_frag<SH_UP>(Nb, fN);
        prod_ff<SH_FULL, SH_UP>(fW, fN, O);
#pragma unroll
        for (int tx = 0; tx < 2; ++tx)
#pragma unroll
          for (int ty = 0; ty < 2; ++ty)
#pragma unroll
            for (int G = 0; G < 4; ++G) {
              const int x0 = 32 * tx + 8 * G + 4 * hh, y = 32 * ty + l31;
              const uint2 rr = *(const uint2*)(S1 + y * 72 + x0);
              *(uint2*)(rwp + 8192 + kperm_addr(y, x0) * 2) = pk4(O.t[tx][ty][4 * G] + bflo(rr.x), O.t[tx][ty][4 * G + 1] + bfhi(rr.x), O.t[tx][ty][4 * G + 2] + bflo(rr.y), O.t[tx][ty][4 * G + 3] + bfhi(rr.y));
            }
      }
    } else {
      Frag64 fX;
      {
        Acc64 Nk; gram<SH_LO, 1>(S0, S3, l31, hh, Nk);
        Frag64 fNk; to_frag<SH_LO>(Nk, fNk);
        prod_ff_frag<SH_UP, SH_LO, SH_LO>(fT, fNk, fX);
      }
      __builtin_amdgcn_sched_barrier(0);
      if (w == 2) {
        Acc64 Z; zero_acc<SH_FULL>(Z);
        prod_fm<SH_LO>(fX, S5, l31, hh, Z);
#pragma unroll
        for (int tx = 0; tx < 2; ++tx)
#pragma unroll
          for (int ty = 0; ty < 2; ++ty)
#pragma unroll
            for (int G = 0; G < 4; ++G) {
              const int x0 = 32 * tx + 8 * G + 4 * hh, y = 32 * ty + l31;
              const uint2 kk2 = *(const uint2*)(S6 + y * 72 + x0);
              Z.t[tx][ty][4 * G] += bflo(kk2.x); Z.t[tx][ty][4 * G + 1] += bfhi(kk2.x); Z.t[tx][ty][4 * G + 2] += bflo(kk2.y); Z.t[tx][ty][4 * G + 3] += bfhi(kk2.y);
            }
        Frag64 fZ; to_frag<SH_FULL>(Z, fZ);
        __builtin_amdgcn_sched_barrier(0);
        Acc64 Q; zero_acc<SH_FULL>(Q);
        prod_fm<SH_FULL>(fZ, S7, l31, hh, Q);
#pragma unroll
        for (int tx = 0; tx < 2; ++tx)
#pragma unroll
          for (int ty = 0; ty < 2; ++ty)
#pragma unroll
            for (int G = 0; G < 4; ++G)
              *(uint2*)(rwp + 16384 + clay_addr(32 * tx + 8 * G + 4 * hh, 32 * ty + l31) * 2) = pk4(Q.t[tx][ty][4 * G], Q.t[tx][ty][4 * G + 1], Q.t[tx][ty][4 * G + 2], Q.t[tx][ty][4 * G + 3]);
      } else {
        Acc64 H; gram<SH_UP, 2>(S3, S1, l31, hh, H);
        {
          Acc64 Nb; gram<SH_UP, 2>(S2, S1, l31, hh, Nb);
          Frag64 fN; to_frag<SH_UP>(Nb, fN);
          prod_ff<SH_LO, SH_UP>(fX, fN, H);
        }
        Frag64 fH; to_frag<SH_UP>(H, fH);
        __builtin_amdgcn_sched_barrier(0);
        Acc64 Y; zero_acc<SH_FULL>(Y);
        prod_fm<SH_UP>(fH, S7, l31, hh, Y);
#pragma unroll
        for (int tx = 0; tx < 2; ++tx)
#pragma unroll
          for (int ty = 0; ty < 2; ++ty)
#pragma unroll
            for (int G = 0; G < 4; ++G)
              *(uint2*)(rwp + 24576 + clay_addr(32 * tx + 8 * G + 4 * hh, 32 * ty + l31) * 2) = pk4(Y.t[tx][ty][4 * G], Y.t[tx][ty][4 * G + 1], Y.t[tx][ty][4 * G + 2], Y.t[tx][ty][4 * G + 3]);
      }
    }
  }
  __syncthreads();
}

DEV void r2_wave(const Prm& p, int L, int wi, int lane) {
  bool prompt; int st, hd, vt;
  if (wi < 64) { prompt = true; st = wi >> 4; hd = (wi >> 2) & 3; vt = wi & 3; }
  else { prompt = false; const int j = wi - 64; st = j >> 4; hd = (j >> 2) & 3; vt = j & 3; }
  const int nch = prompt ? 65 : 1;
  const int idx0 = prompt ? st * 260 + hd : NRW_P + st * 4 + hd;
  const int l16 = lane & 15, g = lane >> 4;
  f32x4 acc[4];
  float* outp;
  if (prompt) {
#pragma unroll
    for (int mt = 0; mt < 4; ++mt) acc[mt] = (f32x4){0.f, 0.f, 0.f, 0.f};
    outp = p.wkv_p + ((((size_t)L * 4 + st) * 4 + hd) * 64 + 16 * vt + l16) * 64;
  } else {
    const float* sp = p.state_wkv + ((((size_t)L * 32 + st) * 4 + hd) * 64 + 16 * vt + l16) * 64;
#pragma unroll
    for (int mt = 0; mt < 4; ++mt) acc[mt] = *(const f32x4*)(sp + 16 * mt + 4 * g);
    outp = p.wkv_s + ((((size_t)L * 32 + st) * 4 + hd) * 64 + 16 * vt + l16) * 64;
  }
  const char* rw0 = p.rw + (size_t)idx0 * RW_BYTES;
  uint4 pf[3][8]; uint2 qv[3][4];
#pragma unroll
  for (int k = 0; k < 3; ++k) {
    const int cc = k < nch ? k : nch - 1;
    const char* src = rw0 + (size_t)cc * 4 * RW_BYTES;
#pragma unroll
    for (int i = 0; i < 8; ++i) pf[k][i] = *(const uint4*)(src + (i * 64 + lane) * 16);
#pragma unroll
    for (int mt = 0; mt < 4; ++mt) qv[k][mt] = *(const uint2*)(src + 16384 + ((mt * 4 + vt) * 64 + lane) * 8);
  }
  for (int c0 = 0; c0 < nch; c0 += 3) {
#pragma unroll
    for (int k = 0; k < 3; ++k) {
      const int c = c0 + k;
      if (c < nch) {
        char* cur = (char*)rw0 + (size_t)c * 4 * RW_BYTES;
        uint4 bfr[2];
#pragma unroll
        for (int s = 0; s < 2; ++s) {
          bfr[s].x = pk2(acc[2 * s][0], acc[2 * s][1]); bfr[s].y = pk2(acc[2 * s][2], acc[2 * s][3]);
          bfr[s].z = pk2(acc[2 * s + 1][0], acc[2 * s + 1][1]); bfr[s].w = pk2(acc[2 * s + 1][2], acc[2 * s + 1][3]);
          *(uint4*)(cur + 32768 + ((vt * 2 + s) * 64 + lane) * 16) = bfr[s];
        }
#pragma unroll
        for (int mt = 0; mt < 4; ++mt) {
          f32x4 a = {bflo(qv[k][mt].x), bfhi(qv[k][mt].x), bflo(qv[k][mt].y), bfhi(qv[k][mt].y)};
#pragma unroll
          for (int s = 0; s < 2; ++s) a = mfma16(mk8(pf[k][mt * 2 + s]), mk8(bfr[s]), a);
          acc[mt] = a;
        }
        const int cn = c + 3 < nch ? c + 3 : nch - 1;
        const char* src = rw0 + (size_t)cn * 4 * RW_BYTES;
#pragma unroll
        for (int i = 0; i < 8; ++i) pf[k][i] = *(const uint4*)(src + (i * 64 + lane) * 16);
#pragma unroll
        for (int mt = 0; mt < 4; ++mt) qv[k][mt] = *(const uint2*)(src + 16384 + ((mt * 4 + vt) * 64 + lane) * 8);
      }
    }
  }
#pragma unroll
  for (int mt = 0; mt < 4; ++mt) *(f32x4*)(outp + 16 * mt + 4 * g) = acc[mt];
}

DEV void r3_wave(const Prm& p, int L, int idx, int lane, float* Y  ) {
  LAUNDER(lane);
  bool prompt; int st, c, hd;
  if (idx < NRW_P) { prompt = true; st = idx / 260; const int rem = idx - st * 260; c = rem >> 2; hd = rem & 3; }
  else { prompt = false; const int j = idx - NRW_P; st = j >> 2; hd = j & 3; c = 0; }
  const char* rwp = p.rw + (size_t)idx * RW_BYTES;
  const int l16 = lane & 15, g = lane >> 4;
  bf16_t* mix = p.zE;
  uint4 sf[4][2];
#pragma unroll
  for (int vt = 0; vt < 4; ++vt)
#pragma unroll
    for (int s = 0; s < 2; ++s) sf[vt][s] = *(const uint4*)(rwp + 32768 + ((vt * 2 + s) * 64 + lane) * 16);
  const float lw[4] = {p.lnx_w[L * 256 + hd * 64 + l16], p.lnx_w[L * 256 + hd * 64 + 16 + l16], p.lnx_w[L * 256 + hd * 64 + 32 + l16], p.lnx_w[L * 256 + hd * 64 + 48 + l16]};
  const float lb[4] = {p.lnx_b[L * 256 + hd * 64 + l16], p.lnx_b[L * 256 + hd * 64 + 16 + l16], p.lnx_b[L * 256 + hd * 64 + 32 + l16], p.lnx_b[L * 256 + hd * 64 + 48 + l16]};
#pragma unroll
  for (int it = 0; it < 4; ++it) {
    f32x4 y[4];
    const uint4 gf0 = *(const uint4*)(rwp + 8192 + ((it * 2 + 0) * 64 + lane) * 16), gf1 = *(const uint4*)(rwp + 8192 + ((it * 2 + 1) * 64 + lane) * 16);
#pragma unroll
    for (int vt = 0; vt < 4; ++vt) {
      const uint2 q = *(const uint2*)(rwp + 24576 + ((it * 4 + vt) * 64 + lane) * 8);
      f32x4 a = {bflo(q.x), bfhi(q.x), bflo(q.y), bfhi(q.y)};
      a = mfma16(mk8(gf0), mk8(sf[vt][0]), a);
      a = mfma16(mk8(gf1), mk8(sf[vt][1]), a);
      y[vt] = a;
    }
    __builtin_amdgcn_sched_barrier(0);
#pragma unroll
    for (int rr = 0; rr < 4; ++rr) {
      const int i = 16 * it + 4 * g + rr;
      float s1 = y[0][rr] + y[1][rr] + y[2][rr] + y[3][rr];
      s1 += __shfl_xor(s1, 1); s1 += __shfl_xor(s1, 2); s1 += __shfl_xor(s1, 4); s1 += __shfl_xor(s1, 8);
      const float mean = s1 * (1.f / 64.f);
      const float d0 = y[0][rr] - mean, d1 = y[1][rr] - mean, d2 = y[2][rr] - mean, d3 = y[3][rr] - mean;
      float s2 = d0 * d0 + d1 * d1 + d2 * d2 + d3 * d3;
      s2 += __shfl_xor(s2, 1); s2 += __shfl_xor(s2, 2); s2 += __shfl_xor(s2, 4); s2 += __shfl_xor(s2, 8);
      const float rstd = rsqrtf(s2 * (1.f / 64.f) + GN_EPS);
      Y[i * 68 + l16] = d0 * rstd * lw[0] + lb[0];
      Y[i * 68 + 16 + l16] = d1 * rstd * lw[1] + lb[1];
      Y[i * 68 + 32 + l16] = d2 * rstd * lw[2] + lb[2];
      Y[i * 68 + 48 + l16] = d3 * rstd * lw[3] + lb[3];
    }
  }
  asm volatile("s_waitcnt lgkmcnt(0)" ::: "memory");
  __builtin_amdgcn_wave_barrier();
  const int vc = (lane & 7) * 8;
#pragma unroll
  for (int ps = 0; ps < 8; ++ps) {
    const int i = 8 * ps + (lane >> 3);
    int R; bool valid;
    if (prompt) { const int pp = 64 * c - 48 + i; valid = pp >= 0; R = st * PT + (valid ? pp : 0); }
    else { R = NPR + 64 * st + i; valid = true; }
    if (valid) {
      const float4 y0 = *(const float4*)(Y + i * 68 + vc), y1 = *(const float4*)(Y + i * 68 + vc + 4);
      const float rkbv = p.rkb[(size_t)R * 4 + hd];
      const uint4 vv = *(const uint4*)(rwp + 40960 + (i * 64 + vc) * 2);
      const uint4 gc = *(const uint4*)(p.zL + (size_t)R * ZL + ZL_GC + hd * 64 + vc);
      uint4 o;
      o.x = pk2((y0.x + rkbv * bflo(vv.x)) * silu_(bflo(gc.x)), (y0.y + rkbv * bfhi(vv.x)) * silu_(bfhi(gc.x)));
      o.y = pk2((y0.z + rkbv * bflo(vv.y)) * silu_(bflo(gc.y)), (y0.w + rkbv * bfhi(vv.y)) * silu_(bfhi(gc.y)));
      o.z = pk2((y1.x + rkbv * bflo(vv.z)) * silu_(bflo(gc.z)), (y1.y + rkbv * bfhi(vv.z)) * silu_(bfhi(gc.z)));
      o.w = pk2((y1.z + rkbv * bflo(vv.w)) * silu_(bflo(gc.w)), (y1.w + rkbv * bfhi(vv.w)) * silu_(bfhi(gc.w)));
      *(uint4*)(mix + (size_t)R * D + 768 + hd * 64 + vc) = o;
    }
  }
  asm volatile("s_waitcnt lgkmcnt(0)" ::: "memory");
  __builtin_amdgcn_wave_barrier();
}

DEV void final_norm(const Prm& p) {
  int tid_ = threadIdx.x; LAUNDER(tid_);
  const int lane = tid_ & 63, gw = blockIdx.x * 4 + (tid_ >> 6), NW = gridDim.x * 4;
  for (int R = gw; R < NT; R += NW) {
    if (R < NPR && (R % PT) < 16) continue;
    float* yr = xrow_ptr(p, R);
    const bf16_t* xr = p.xb + (size_t)R * D;
    const float rstd = rsqrtf(p.ssq_x[2 * NTP + R] * (1.f / 1024.f) + RMS_EPS);
#pragma unroll
    for (int j = 0; j < 2; ++j) {
      const uint4 u = ((const uint4*)xr)[lane + 64 * j];
      const float4 g0 = ((const float4*)p.final_g)[2 * (lane + 64 * j)], g1 = ((const float4*)p.final_g)[2 * (lane + 64 * j) + 1];
      float4 o0, o1;
      o0.x = bflo(u.x) * rstd * g0.x; o0.y = bfhi(u.x) * rstd * g0.y; o0.z = bflo(u.y) * rstd * g0.z; o0.w = bfhi(u.y) * rstd * g0.w;
      o1.x = bflo(u.z) * rstd * g1.x; o1.y = bfhi(u.z) * rstd * g1.y; o1.z = bflo(u.w) * rstd * g1.z; o1.w = bfhi(u.w) * rstd * g1.w;
      ((float4*)yr)[2 * (lane + 64 * j)] = o0; ((float4*)yr)[2 * (lane + 64 * j) + 1] = o1;
    }
  }
}

#define XB_TMO      128
#define XB_XCNT(j)  (256  + 64 * (j))
#define XB_XSUB(j)  (1280 + 64 * (j))
#define XB_XGEN(j)  (2304 + 64 * (j))
#define XB_TOP      3328
#define XB_TOPGEN   3392
#define XCD_BAR_WORDS 3456
#define XB_SPIN_CAP (1u << 20)
#define LAS __attribute__((address_space(3)))
DEV unsigned xb_ld(unsigned* p) { return __hip_atomic_load(p, __ATOMIC_RELAXED, __HIP_MEMORY_SCOPE_AGENT); }
DEV unsigned xb_add(unsigned* p, unsigned v) { return __hip_atomic_fetch_add(p, v, __ATOMIC_RELAXED, __HIP_MEMORY_SCOPE_AGENT); }
DEV unsigned xb_xcc_id() { return (unsigned)__builtin_amdgcn_s_getreg((3 << 11) | 20) & 0xFu; }
#define XB_SPIN(cond, bar) do { unsigned _sp = 0; while (cond) { __builtin_amdgcn_s_sleep(1); \
    if ((++_sp & 255u) == 0u) { if (xb_ld(&(bar)[XB_TMO])) break; if (_sp > XB_SPIN_CAP) { atomicAdd(&(bar)[XB_TMO], 1u); break; } } } } while (0)
struct XcdBarrier { unsigned* bar; unsigned x; volatile LAS unsigned* st; };
DEV XcdBarrier xcd_barrier_post(unsigned* bar, volatile LAS unsigned* st) {
  XcdBarrier b; b.bar = bar; b.x = xb_xcc_id(); b.st = st;
  if (threadIdx.x == 0) (void)xb_add(&bar[XB_XCNT(b.x)], 1u);
  return b;
}
DEV void xcd_barrier_complete(unsigned* bar, unsigned x, unsigned& nloc, unsigned& nx) {
  const unsigned G = gridDim.x * gridDim.y * gridDim.z;
  unsigned sum, cnt, mine, sp = 0u;
  for (;;) {
    sum = 0u; cnt = 0u; mine = 0u;
#pragma unroll
    for (unsigned j = 0; j < 16; ++j) { const unsigned c = xb_ld(&bar[XB_XCNT(j)]); sum += c; cnt += (c > 0u) ? 1u : 0u; mine = (j == x) ? c : mine; }
    if (sum == G) break;
    __builtin_amdgcn_s_sleep(1);
    if ((++sp & 255u) == 0u) { if (xb_ld(&bar[XB_TMO])) break; if (sp > XB_SPIN_CAP) { atomicAdd(&bar[XB_TMO], 1u); break; } }
  }
  nloc = mine > 0u ? mine : 1u; nx = cnt > 0u ? cnt : 1u;
}
DEV void xcd_barrier(const XcdBarrier& b) {
  asm volatile("s_waitcnt vmcnt(0)" ::: "memory");
  __syncthreads();
  if (threadIdx.x == 0) {
    unsigned* bar = b.bar;
    __builtin_amdgcn_s_waitcnt(0);
    unsigned nloc = b.st[0], nx = b.st[1];
    if (nloc == 0u) { xcd_barrier_complete(bar, b.x, nloc, nx); b.st[0] = nloc; b.st[1] = nx; }
    const unsigned old = xb_add(&bar[XB_XSUB(b.x)], 1u);
    const unsigned gen = old / nloc;
    if (old + 1u == (gen + 1u) * nloc) {
      __builtin_amdgcn_fence(__ATOMIC_RELEASE, "agent");
      asm volatile("s_waitcnt vmcnt(0)" ::: "memory");
      const unsigned og = xb_add(&bar[XB_TOP], 1u);
      const unsigned tg = og / nx;
      if (og + 1u == (tg + 1u) * nx) xb_add(&bar[XB_TOPGEN], 1u);
      else XB_SPIN(xb_ld(&bar[XB_TOPGEN]) == tg, bar);
      __builtin_amdgcn_fence(__ATOMIC_ACQUIRE, "agent");
      xb_add(&bar[XB_XGEN(b.x)], 1u);
      asm volatile("s_waitcnt vmcnt(0)" ::: "memory");
    } else {
      XB_SPIN(xb_ld(&bar[XB_XGEN(b.x)]) == gen, bar);
      __builtin_amdgcn_fence(__ATOMIC_ACQUIRE, "agent");
      asm volatile("s_waitcnt vmcnt(0)" ::: "memory");
    }
  }
  __syncthreads();
}

#define QCTR(ph, L) (3584 + 64 * (2 * (ph) + (L)))
#define R2DONE(L) (3520 + 16 * (L))
DEV int next_item(unsigned* ctr, char* lds) {
  volatile int* slot = (volatile int*)(lds + LDS_BYTES - 8);
  __syncthreads();
  if (threadIdx.x == 0) *slot = (int)atomicAdd(ctr, 1u);
  __syncthreads();
  return *slot;
}
#define QXC(ph, L, x) (4096 + (((ph) * 2 + (L)) * 8 + (x)) * 16)
DEV int xq_next(unsigned* ctl, int ph, int L, int C, int N, int& k, int home, char* lds) {
  volatile int* slot = (volatile int*)(lds + LDS_BYTES - 8);
  __syncthreads();
  if (threadIdx.x == 0) {
    int res = -1, kk = k;
    while (kk < 8) {
      const int x = (home + kk) & 7, base = x * C;
      int size = N - base; size = size < C ? size : C;
      if (size > 0) { const int idx = (int)atomicAdd(ctl + QXC(ph, L, x), 1u); if (idx < size) { res = base + idx; break; } }
      ++kk;
    }
    slot[0] = res; slot[1] = kk;
  }
  __syncthreads();
  k = slot[1];
  return slot[0];
}
DEV int q_publish(int ticket, char* lds) {
  volatile int* slot = (volatile int*)(lds + LDS_BYTES - 8);
  __syncthreads();
  if (threadIdx.x == 0) *slot = ticket;
  __syncthreads();
  return *slot;
}
DEV int xq_resolve(unsigned* ctl, int ph, int L, int C, int N, int& k, int home, int ticket, char* lds) {
  volatile int* slot = (volatile int*)(lds + LDS_BYTES - 8);
  __syncthreads();
  if (threadIdx.x == 0) {
    int res = -1, kk = k;
    if (kk < 8) {
      const int x = (home + kk) & 7, base = x * C;
      int size = N - base; size = size < C ? size : C;
      if (ticket < size) res = base + ticket;
      else {
        ++kk;
        while (kk < 8) {
          const int x2 = (home + kk) & 7, base2 = x2 * C;
          int size2 = N - base2; size2 = size2 < C ? size2 : C;
          if (size2 > 0) { const int idx = (int)atomicAdd(ctl + QXC(ph, L, x2), 1u); if (idx < size2) { res = base2 + idx; break; } }
          ++kk;
        }
      }
    }
    slot[0] = res; slot[1] = kk;
  }
  __syncthreads();
  k = slot[1];
  return slot[0];
}
DEV unsigned* xq_ctr(unsigned* ctl, int ph, int L, int k, int home) { return k < 8 ? ctl + QXC(ph, L, (home + k) & 7) : nullptr; }
DEV int take_ticket(unsigned* nctr) { int tk = 0x7fffffff; if (nctr && threadIdx.x == 0) tk = (int)atomicAdd(nctr, 1u); return tk; }
struct XQueue {
  unsigned* ctl; int ph, L, C, N, k, home, t;
  DEV void prefetch() { t = take_ticket(xq_ctr(ctl, ph, L, k, home)); }
  DEV int resolve(char* lds) { return xq_resolve(ctl, ph, L, C, N, k, home, t, lds); }
};
template <class Epi, class Map>
DEV void gemm_stream(const bf16_t* __restrict__ A, int lda, const bf16_t* __restrict__ Bt, int ldb, int K, char* lds, const Epi& epi, XQueue& q) {
  int tid = threadIdx.x; LAUNDER(tid);
  const int lane = tid & 63, w = __builtin_amdgcn_readfirstlane(tid >> 6), wr = w >> 1, wc = w & 1;
  const int fr = lane & 15, fq = lane >> 4;
  const int sb = lane * 16, swz = sb ^ (((sb >> 9) & 1) << 5), rl = swz >> 6, cl = (swz & 63) >> 1;
  const int nk = K / 64;
  int offA[2], offB[2];
#pragma unroll
  for (int kh = 0; kh < 2; ++kh) { offA[kh] = lds_byte(wr * 64 + fr, kh * 32 + fq * 8); offB[kh] = lds_byte(wc * 64 + fr, kh * 32 + fq * 8); }
  q.prefetch();
  int item = q.resolve(lds);
  if (item < 0) return;
  int m0, n0; Map::map(item, m0, n0);
  const bf16_t* ga[4]; const bf16_t* gb[4];
#define SETPTR(M0, N0) { _Pragma("unroll") for (int i = 0; i < 4; ++i) { const int st = 4 * w + i, r = (st >> 1) * 16 + rl, c = (st & 1) * 32 + cl; \
      ga[i] = A + (size_t)((M0) + r) * lda + c; gb[i] = Bt + (size_t)((N0) + r) * ldb + c; } }
#define GSTAGE(S, KT) { _Pragma("unroll") for (int i = 0; i < 4; ++i) { \
      __builtin_amdgcn_global_load_lds((const unsigned*)(ga[i] + (KT) * 64), (LAS3 unsigned*)(lds + (S) * 32768 + (4 * w + i) * 1024 + lane * 16), 16, 0, 0); \
      __builtin_amdgcn_global_load_lds((const unsigned*)(gb[i] + (KT) * 64), (LAS3 unsigned*)(lds + (S) * 32768 + 16384 + (4 * w + i) * 1024 + lane * 16), 16, 0, 0); } }
  SETPTR(m0, n0)
  GSTAGE(0, 0)
  GSTAGE(1, 1)
  for (;;) {
    f32x4 acc[4][4];
#pragma unroll
    for (int i = 0; i < 4; ++i)
#pragma unroll
      for (int j = 0; j < 4; ++j) acc[i][j] = (f32x4){0.f, 0.f, 0.f, 0.f};
    for (int kt = 0; kt < nk; ++kt) {
      const int s = kt & 1;
      if (kt + 1 < nk) asm volatile("s_waitcnt vmcnt(8)" ::: "memory"); else asm volatile("s_waitcnt vmcnt(0)" ::: "memory");
      RAW_BARRIER()
      const char* ia = lds + s * 32768;
      const char* ib = ia + 16384;
      bf16x8 af[2][4], bfv[2][4];
#pragma unroll
      for (int kh = 0; kh < 2; ++kh) {
#pragma unroll
        for (int mi = 0; mi < 4; ++mi) af[kh][mi] = *(const bf16x8*)(ia + offA[kh] + mi * 2048);
#pragma unroll
        for (int ni = 0; ni < 4; ++ni) bfv[kh][ni] = *(const bf16x8*)(ib + offB[kh] + ni * 2048);
      }
      asm volatile("s_waitcnt lgkmcnt(8)" ::: "memory");
      __builtin_amdgcn_sched_barrier(0);
#pragma unroll
      for (int mi = 0; mi < 4; ++mi)
#pragma unroll
        for (int ni = 0; ni < 4; ++ni) acc[mi][ni] = mfma16(bfv[0][ni], af[0][mi], acc[mi][ni]);
      __builtin_amdgcn_sched_barrier(0);
      asm volatile("s_waitcnt lgkmcnt(0)" ::: "memory");
      RAW_BARRIER()
      if (kt + 2 < nk) GSTAGE(s, kt + 2)
      if (kt == nk - 3) q.prefetch();
      __builtin_amdgcn_sched_barrier(0);
#pragma unroll
      for (int mi = 0; mi < 4; ++mi)
#pragma unroll
        for (int ni = 0; ni < 4; ++ni) acc[mi][ni] = mfma16(bfv[1][ni], af[1][mi], acc[mi][ni]);
    }
    const int nxt = q.resolve(lds);
    const typename Epi::Pre pre = epi.preload(m0 + wr * 64, n0 + wc * 64, fr, fq);
    __builtin_amdgcn_sched_barrier(0);
    int m1 = 0, n1 = 0;
    if (nxt >= 0) { Map::map(nxt, m1, n1); SETPTR(m1, n1) GSTAGE(0, 0) GSTAGE(1, 1) }
    __builtin_amdgcn_sched_barrier(0);
    epi.finish(acc, pre, m0 + wr * 64, n0 + wc * 64, fr, fq);
    if (nxt < 0) break;
    m0 = m1; n0 = n1;
  }
#undef GSTAGE
#undef SETPTR
}
struct MapP1 { static DEV void map(int i, int& m0, int& n0) { int mt, nt; if (i < 18 * 192) { const int b = i / 192, r = i - b * 192; nt = r >> 3; mt = 8 * b + (r & 7); } else { nt = i - 18 * 192; mt = 144; } m0 = mt * 128; n0 = nt * 128; } };
struct MapP4 { static DEV void map(int i, int& m0, int& n0) { m0 = (i >> 3) * 128; n0 = (i & 7) * 128; } };
DEV void shift_rows_item(const Prm& p, int L, int b) {
  int tid0 = threadIdx.x; LAUNDER(tid0);
  if (tid0 < 224) {
    float4 v = make_float4(0.f, 0.f, 0.f, 0.f);
    if (b < 32) v = *(const float4*)(p.state_shift + ((size_t)L * 32 + b) * 896 + 4 * tid0);
    *(uint2*)(p.zE + (size_t)(NT + b) * ZE + ZE_ZC + 4 * tid0) = pk4(v.x, v.y, v.z, v.w);
  }
}
constexpr int N_ATT = 1312;
DEV void run_p1(const Prm& p, int L, char* lds) {
  const EpiIn epi{p, L};
  const int home = (int)(xb_xcc_id() & 7u);
  constexpr int N = 145 * 24, C = (N + 7) / 8;
  {
    XQueue q{p.ctl, 0, L, C, N, 0, home, 0};
    gemm_stream<EpiIn, MapP1>(p.xb, D, p.Wb_in + (size_t)L * INP * 1024, 1024, 1024, lds, epi, q);
  }
  unsigned* ctr = p.ctl + QCTR(3, L);
  int t = take_ticket(ctr);
  for (;;) {
    const int mt = q_publish(t, lds);
    if (mt >= 145 + 33) break;
    if (mt >= 145) { t = take_ticket(ctr); shift_rows_item(p, L, mt - 145); continue; }
    t = gemm_tile<EpiIn, 2>(p.xb, D, p.Wb_in + (size_t)L * INP * 1024, 1024, 1024, mt * 128, 24 * 128, lds, epi, ctr);
  }
}
DEV void run_p2(const Prm& p, int L, char* lds) {
  const EpiQ epq{p, L};
  constexpr int N1 = NRW, N2 = N1 + 129, N3 = N2 + 145 * 6, N4 = N3 + 16, N4b = N4 + 512, N5 = N4b + 36;
  const int N6 = L == 0 ? N5 + NWT : N5;
  unsigned* ctr = p.ctl + QCTR(0, L);
  for (;;) {
    const int id = next_item(ctr, lds);
    if (id >= N6) break;
    if (id >= N5) { conv_weights_item(p, 1, id - N5, lds); continue; }
    if (id < N1) r1_item(p, L, id, lds);
    else if (id < N2) kvproj_item(p, L, id - N1, lds);
    else if (id < N3) { const int t = id - N2, mt = t / 6, nt = t - mt * 6; gemm_tile(p.zE + ZE_CQ, ZE, p.Wb_uq + (size_t)L * 768 * 256, 256, 256, mt * 128, nt * 128, lds, epq); }
    else if (id < N4) sample_prep_item(p, L, id - N3);
    else if (id < N4b) lat_item(p, L, id - N4);
    else shift_item(p, L, id - N4b);
  }
}
DEV void run_p3(const Prm& p, int L, char* lds) {
  int tid_ = threadIdx.x; LAUNDER(tid_);
  const int lane = tid_ & 63, w = __builtin_amdgcn_readfirstlane(tid_ >> 6);
  {
    int ndone = 0;
    for (int wi = blockIdx.x * 4 + w; wi < 576; wi += gridDim.x * 4) { r2_wave(p, L, wi, lane); ++ndone; }
    if (blockIdx.x * 4 < 576) {
      asm volatile("s_waitcnt vmcnt(0)" ::: "memory");
      __syncthreads();
      if (threadIdx.x == 0) {
        int tot = 0;
        for (int wi = blockIdx.x * 4; wi < 576; wi += gridDim.x * 4) tot += (576 - wi) < 4 ? (576 - wi) : 4;
        __builtin_amdgcn_fence(__ATOMIC_RELEASE, "agent");
        asm volatile("s_waitcnt vmcnt(0)" ::: "memory");
        __hip_atomic_fetch_add(p.ctl + R2DONE(L), (unsigned)tot, __ATOMIC_RELAXED, __HIP_MEMORY_SCOPE_AGENT);
      }
    }
    (void)ndone;
  }
  unsigned* ctr = p.ctl + QCTR(1, L);
  for (;;) {
    const int q = next_item(ctr, lds);
    if (q >= 128) break;
    attn_sample(p, L, q >> 2, q & 3, lds);
  }
  {
    const int home = (int)(xb_xcc_id() & 7u);
    int k = 0;
    int tx = take_ticket(xq_ctr(p.ctl, 2, L, k, home));
    for (;;) {
      const int i = xq_resolve(p.ctl, 2, L, 128, 1024, k, home, tx, lds);
      if (i < 0) break;
      const int x = i >> 7, j = i & 127, qt = 31 - (j >> 2), pair = 4 * x + (j & 3);
      tx = attn_body<false>(p, L, pair >> 3, pair & 7, qt, lds, xq_ctr(p.ctl, 2, L, k, home));
    }
  }
  unsigned* ctr2 = p.ctl + QCTR(2, L);
  constexpr int NC = (NT + 31) / 32, NQ2 = 32 + NC + NRW / 4;
  bool r2_seen = false;
  for (;;) {
    const int q = next_item(ctr2, lds);
    if (q >= NQ2) break;
    constexpr int NR3 = NRW / 4;
    if (q >= NR3 + 32) conv_item(p, L, q - NR3 - 32);
    else if (q >= NR3) attn_item(p, L, 1280 + q - NR3, lds);
    else {
      if (!r2_seen) {
        if (threadIdx.x == 0) {
          unsigned sp = 0;
          while (__hip_atomic_load(p.ctl + R2DONE(L), __ATOMIC_RELAXED, __HIP_MEMORY_SCOPE_AGENT) < 576u) {
            __builtin_amdgcn_s_sleep(2);
            if (++sp > (1u << 22)) { atomicAdd(&p.ctl[XB_TMO], 1u); break; }
          }
          __builtin_amdgcn_fence(__ATOMIC_ACQUIRE, "agent");
          asm volatile("s_waitcnt vmcnt(0)" ::: "memory");
        }
        __syncthreads();
        r2_seen = true;
      }
      r3_wave(p, L, q * 4 + w, lane, (float*)(lds + w * 17408));
    }
  }
}
DEV void run_p4(const Prm& p, int L, char* lds) {
  const EpiOut epo{p, L};
  const int home = (int)(xb_xcc_id() & 7u);
  {
    XQueue q{p.ctl, 1, L, 128, 1024, 0, home, 0};
    gemm_stream<EpiOut, MapP4>(p.zE  , D, p.Wb_out + (size_t)L * 1024 * 1024, 1024, 1024, lds, epo, q);
  }
  unsigned* ctr = p.ctl + QCTR(3, L) + 16;
  int t = take_ticket(ctr);
  for (;;) {
    const int h = q_publish(t, lds);
    if (h >= 17 * 16) break;
    const int mt = 128 + (h >> 4), r = h & 15;
    t = gemm_tile<EpiOut, 4>(p.zE, D, p.Wb_out + (size_t)L * 1024 * 1024, 1024, 1024, mt * 128, (r >> 1) * 128 + (r & 1) * 64, lds, epo, ctr);
  }
}

__global__ void __launch_bounds__(256, 2) mega(Prm p) {
  extern __shared__ __attribute__((aligned(16))) char lds[];
  volatile LAS unsigned* st = (volatile LAS unsigned*)(lds + LDS_BYTES - 16);
  if (threadIdx.x == 0) { st[0] = 0u; st[1] = 0u; st[2] = 0u; st[3] = 0u; }
  __syncthreads();
  const XcdBarrier xb = xcd_barrier_post(p.ctl, st);
  phase0(p, lds);
  xcd_barrier(xb);
  for (int L = 0; L < 2; ++L) {
    run_p1(p, L, lds); xcd_barrier(xb);
    run_p2(p, L, lds); xcd_barrier(xb);
    run_p3(p, L, lds); xcd_barrier(xb);
    run_p4(p, L, lds); xcd_barrier(xb);
  }
  final_norm(p);
}

static size_t al256(size_t x) { return (x + 255) & ~(size_t)255; }
extern "C" void kernel_launch(void* const* d_in, const int* in_sizes, int n_in, void* d_out, int out_size, void* d_ws, size_t ws_size, hipStream_t stream) {
  Prm p{};
  const float* const* in = (const float* const*)d_in;
  p.x_prompt = in[0]; p.x_sample = in[1]; p.cache_ckv = in[2]; p.cache_krope = in[3]; p.state_conv = in[4]; p.state_shift = in[5]; p.state_wkv = in[6];
  p.meta = in[7]; p.norm_g = in[8]; p.w_in = in[9]; p.conv_w = in[10]; p.q_norm_g = in[11]; p.w_uq = in[12]; p.kv_norm_g = in[13]; p.w_ukv = in[14];
  p.shift_mu = in[15]; p.decay_w0 = in[16]; p.decay_w2 = in[17]; p.iclr_a0 = in[18]; p.iclr_a2 = in[19]; p.key_kk = in[20]; p.key_ka = in[21];
  p.bonus_rk = in[22]; p.lnx_w = in[23]; p.lnx_b = in[24]; p.w_out = in[25]; p.final_g = in[26];
  float* o = (float*)d_out;
  p.y_prompt = o; o += (size_t)4 * 4096 * 1024;
  p.y_sample = o; o += (size_t)32 * 64 * 1024;
  p.ckv_p = o; o += (size_t)2 * 4 * PT * 128;
  p.kr_p = o; o += (size_t)2 * 4 * PT * 32;
  p.conv_p = o; o += 2 * 4 * 2 * 256;
  p.shift_p = o; o += 2 * 4 * 896;
  p.wkv_p = o; o += 2 * 4 * 4 * 64 * 64;
  p.ckv_s = o; o += (size_t)2 * 32 * 64 * 128;
  p.kr_s = o; o += 2 * 32 * 64 * 32;
  p.conv_s = o; o += 2 * 32 * 2 * 256;
  p.shift_s = o; o += 2 * 32 * 896;
  p.wkv_s = o; o += 2 * 32 * 4 * 64 * 64;
  char* w = (char*)d_ws; size_t off = 0;
  auto take = [&](size_t bytes) { char* r = w + off; off = al256(off + bytes); return r; };
  p.ctl = (unsigned*)take(65536);
  p.Wb_in = (bf16_t*)take((size_t)2 * INP * 1024 * 2);
  p.Wb_uq = (bf16_t*)take((size_t)2 * 768 * 256 * 2);
  p.Wb_ukv = (bf16_t*)take((size_t)2 * 1024 * 128 * 2);
  p.Wb_out = (bf16_t*)take((size_t)2 * 1024 * 1024 * 2);
  p.dw2T = (bf16_t*)take((size_t)2 * 256 * 64 * 2);
  p.ia2T = (bf16_t*)take((size_t)2 * 256 * 64 * 2);
  p.ropec = (float*)take((size_t)PT * 16 * 4);
  p.ropes = (float*)take((size_t)PT * 16 * 4);
  p.ssq_x = (float*)take((size_t)7 * NTP * 4);
  p.ssq_q = p.ssq_x + 3 * NTP; p.ssq_kv = p.ssq_x + 5 * NTP;
  p.rkb = (float*)take((size_t)NTP * 4 * 4);
  p.xmeta = (float*)take((size_t)64 * 1024 * 4);
  p.zE = (bf16_t*)take((size_t)NTP * ZE * 2);
  p.zL = (bf16_t*)take((size_t)NTP * ZL * 2);
  p.xb = (bf16_t*)take((size_t)(NTP + 128) * D * 2);
  p.Kn = (bf16_t*)take((size_t)KVR * 512 * 2);
  p.Vt = (bf16_t*)take((size_t)512 * KVR * 2);
  p.Kr = (bf16_t*)take((size_t)KVR * 32 * 2);
  p.rw = take((size_t)NRW * RW_BYTES);
  p.KL = (bf16_t*)((char*)p.y_prompt + ((size_t)32 << 20));
  p.VLT = p.KL + (size_t)32 * SKEYS * 160;
  static int grid = 0;
  if (grid == 0) {
    if (off > ws_size) { fprintf(stderr, "kernel_launch: workspace too small: need %zu have %zu\n", off, ws_size); grid = -1; return; }
    int dev = 0, cus = 0, per_cu = 0;
    (void)hipGetDevice(&dev);
    (void)hipDeviceGetAttribute(&cus, hipDeviceAttributeMultiprocessorCount, dev);
    (void)hipFuncSetAttribute((const void*)mega, hipFuncAttributeMaxDynamicSharedMemorySize, LDS_BYTES);
    (void)hipOccupancyMaxActiveBlocksPerMultiprocessor(&per_cu, (const void*)mega, 256, LDS_BYTES);
    if (per_cu > 2) per_cu = 2;
    if (per_cu < 1) { fprintf(stderr, "kernel_launch: occupancy query returned %d\n", per_cu); per_cu = 1; }
    grid = cus * per_cu;
  }
  if (grid < 0) return;
  (void)hipMemsetAsync(p.ctl, 0, 8192 * 4, stream);
  void* args[] = {&p};
  hipError_t e = hipLaunchCooperativeKernel((const void*)mega, dim3(grid), dim3(256), args, LDS_BYTES, stream);
  if (e != hipSuccess) fprintf(stderr, "cooperative launch failed: %s (grid %d)\n", hipGetErrorString(e), grid);
}
```

```cpp
#include <hip/hip_runtime.h>
#include <cstdio>
#include <cstdint>
#include <type_traits>

typedef unsigned short bf16_t;
typedef short bf16x8 __attribute__((ext_vector_type(8)));
typedef float f32x4 __attribute__((ext_vector_type(4)));
typedef float f32x16 __attribute__((ext_vector_type(16)));
#define DEV __device__ __forceinline__
#define LAUNDER(x) asm volatile("" : "+v"(x))

constexpr int D = 1024;
constexpr int PT = 4112;
constexpr int NPR = 4 * PT;
constexpr int NSM = 32 * 64;
constexpr int NT = NPR + NSM;
constexpr int NTP = 18560;
constexpr int ZL = 1792;
constexpr int ZE = 1312;
constexpr int ZE_CQ = 0, ZE_CKV = 256, ZE_KR = 384, ZE_ZC = 416;
constexpr int ZL_XIN = 0, ZL_BG = 256, ZL_CG = 512, ZL_GA = 768, ZL_GB = 1024, ZL_GC = 1536;
constexpr int INP = 3200;
constexpr int KVR = 16512;
constexpr int NRW_P = 4 * 65 * 4;
constexpr int NRW = NRW_P + 32 * 4;
constexpr int RW_BYTES = 49152;
constexpr float RMS_EPS = 1e-6f;
constexpr float GN_EPS = 64e-5f;
constexpr int LDS_BYTES = 79872;
constexpr int SKEYS = 1088;

struct Prm {
  const float *x_prompt, *x_sample, *cache_ckv, *cache_krope, *state_conv, *state_shift, *state_wkv, *meta, *norm_g, *w_in,
      *conv_w, *q_norm_g, *w_uq, *kv_norm_g, *w_ukv, *shift_mu, *decay_w0, *decay_w2, *iclr_a0, *iclr_a2, *key_kk, *key_ka,
      *bonus_rk, *lnx_w, *lnx_b, *w_out, *final_g;
  float *y_prompt, *y_sample, *ckv_p, *kr_p, *conv_p, *shift_p, *wkv_p, *ckv_s, *kr_s, *conv_s, *shift_s, *wkv_s;
  unsigned* ctl;
  bf16_t *Wb_in, *Wb_uq, *Wb_ukv, *Wb_out, *dw2T, *ia2T;
  float *ropec, *ropes, *ssq_x, *ssq_q, *ssq_kv, *rkb, *xmeta;
  bf16_t *KL, *VLT;
  bf16_t *zE, *zL, *xb, *Kn, *Vt, *Kr;
  char* rw;
};

DEV float bf2f(bf16_t b) { return __uint_as_float((unsigned)b << 16); }
DEV float bflo(unsigned u) { return __uint_as_float(u << 16); }
DEV float bfhi(unsigned u) { return __uint_as_float(u & 0xffff0000u); }
typedef __bf16 hbf16x2_t __attribute__((ext_vector_type(2)));
typedef float hf32x2_t __attribute__((ext_vector_type(2)));
DEV unsigned pk2(float a, float b) { hf32x2_t f = {a, b}; hbf16x2_t r = __builtin_convertvector(f, hbf16x2_t); return __builtin_bit_cast(unsigned, r); }
DEV bf16_t f2bf(float f) { return (bf16_t)(pk2(f, 0.f) & 0xffffu); }
DEV uint2 pk4(float a, float b, float c, float d) { uint2 r; r.x = pk2(a, b); r.y = pk2(c, d); return r; }
DEV float sigmoid_(float x) { return 1.f / (1.f + __expf(-x)); }
DEV float silu_(float x) { return x / (1.f + __expf(-x)); }
DEV float wave_sum(float v) {
#pragma unroll
  for (int o = 1; o < 64; o <<= 1) v += __shfl_xor(v, o);
  return v;
}
DEV f32x16 mfma32(bf16x8 a, bf16x8 b, f32x16 c) { return __builtin_amdgcn_mfma_f32_32x32x16_bf16(a, b, c, 0, 0, 0); }
DEV f32x4 mfma16(bf16x8 a, bf16x8 b, f32x4 c) { return __builtin_amdgcn_mfma_f32_16x16x32_bf16(a, b, c, 0, 0, 0); }
DEV bf16x8 mk8(unsigned a, unsigned b, unsigned c, unsigned d) { uint4 u; u.x = a; u.y = b; u.z = c; u.w = d; return __builtin_bit_cast(bf16x8, u); }
DEV bf16x8 mk8(uint4 u) { return __builtin_bit_cast(bf16x8, u); }
DEV f32x16 zero16() { f32x16 z; for (int i = 0; i < 16; ++i) z[i] = 0.f; return z; }

DEV float* xrow_ptr(const Prm& p, int R) {
  if (R < NPR) { int s = R / PT, q = R - s * PT; return q < 16 ? p.xmeta + (size_t)(s * 16 + q) * D : p.y_prompt + ((size_t)s * 4096 + (q - 16)) * D; }
  return p.y_sample + (size_t)(R - NPR) * D;
}
DEV const float* xin_ptr(const Prm& p, int R) {
  if (R < NPR) { int s = R / PT, q = R - s * PT; return q < 16 ? p.meta + (size_t)q * D : p.x_prompt + ((size_t)s * 4096 + (q - 16)) * D; }
  return p.x_sample + (size_t)(R - NPR) * D;
}
DEV int pos_of(int R) { return R < NPR ? R % PT : 1024 + ((R - NPR) & 63); }

DEV int win_src_col(int n) {
  if (n < 1024) return n;
  if (n < 1536) return 1440 + (n - 1024);
  if (n < 1792) return 2848 + (n - 1536);
  if (n < 2208) return 1024 + (n - 1792);
  if (n < 3104) return 1952 + (n - 2208);
  return -1;
}
DEV int perm32(int rho) { const int n = rho >> 4, i = rho & 15; return 8 * (i >> 2) + 4 * n + (i & 3); }
template <bool PERM, bool P32>
DEV void conv_weight_tile(const float* __restrict__ src, int K, int N, int Npad, bf16_t* __restrict__ dst, const float* __restrict__ sk, float cst, int l, int item, float* T  , int tid) {
  const int ntn = Npad / 64, ntk = K / 64;
  const int r = item, kt = r / ntn, nt = r - kt * ntn;
  const int k0 = kt * 64, n0 = nt * 64;
  {
    const int nslot = n0 + (tid & 15) * 4;
    const int nn = P32 ? (nslot & ~31) + perm32(nslot & 31) : nslot;
    const int sn = PERM ? win_src_col(nn) : (nn < N ? nn : -1);
#pragma unroll
    for (int i = 0; i < 4; ++i) {
      const int k = (tid >> 4) + 16 * i;
      float4 v = make_float4(0.f, 0.f, 0.f, 0.f);
      if (sn >= 0) {
        v = *(const float4*)(src + ((size_t)l * K + k0 + k) * N + sn);
        const float s = (sk ? sk[l * K + k0 + k] : 1.f) * cst;
        v.x *= s; v.y *= s; v.z *= s; v.w *= s;
      }
      float* t = T + k * 65 + (tid & 15) * 4;
      t[0] = v.x; t[1] = v.y; t[2] = v.z; t[3] = v.w;
    }
  }
  __syncthreads();
  {
    const int n = tid >> 2, kc = tid & 3;
    float v[16];
#pragma unroll
    for (int j = 0; j < 16; ++j) v[j] = T[(16 * kc + j) * 65 + n];
    uint4 o0, o1;
    o0.x = pk2(v[0], v[1]); o0.y = pk2(v[2], v[3]); o0.z = pk2(v[4], v[5]); o0.w = pk2(v[6], v[7]);
    o1.x = pk2(v[8], v[9]); o1.y = pk2(v[10], v[11]); o1.z = pk2(v[12], v[13]); o1.w = pk2(v[14], v[15]);
    bf16_t* d = dst + ((size_t)l * Npad + n0 + n) * K + k0 + 16 * kc;
    *(uint4*)d = o0; *(uint4*)(d + 8) = o1;
  }
  __syncthreads();
}
constexpr int WT0 = 16 * 50, WT1 = WT0 + 16 * 16, WT2 = WT1 + 4 * 12, WT3 = WT2 + 2 * 16, WT4 = WT3 + 4, NWT = WT4 + 4;
DEV void conv_weights_item(const Prm& p, int l, int it, char* lds) {
  float* T = (float*)lds;
  int tid = threadIdx.x; LAUNDER(tid);
  if (it < WT0) conv_weight_tile<true, true>(p.w_in, 1024, 3104, INP, p.Wb_in, p.norm_g, 1.f, l, it, T, tid);
  else if (it < WT1) conv_weight_tile<false, true>(p.w_out, 1024, 1024, 1024, p.Wb_out, nullptr, 1.f, l, it - WT0, T, tid);
  else if (it < WT2) conv_weight_tile<false, false>(p.w_uq, 256, 768, 768, p.Wb_uq, p.q_norm_g, 0.10206207261596575f * 1.4426950408889634f, l, it - WT1, T, tid);
  else if (it < WT3) conv_weight_tile<false, false>(p.w_ukv, 128, 1024, 1024, p.Wb_ukv, nullptr, 1.f, l, it - WT2, T, tid);
  else if (it < WT4) conv_weight_tile<false, false>(p.decay_w2, 64, 256, 256, p.dw2T, nullptr, 1.f, l, it - WT3, T, tid);
  else conv_weight_tile<false, false>(p.iclr_a2, 64, 256, 256, p.ia2T, nullptr, 1.f, l, it - WT4, T, tid);
}
DEV void phase0(const Prm& p, char* lds) {
  int tid = threadIdx.x; LAUNDER(tid);
  const int lane = tid & 63, wv = tid >> 6;
  const int gw = blockIdx.x * 4 + wv, NW = gridDim.x * 4;
  const int gt = blockIdx.x * 256 + tid, NTH = gridDim.x * 256;
  for (int R = gw; R < NT; R += NW) {
    const float* src = xin_ptr(p, R);
    float ss = 0.f;
#pragma unroll
    for (int j = 0; j < 4; ++j) {
      const float4 v = ((const float4*)src)[lane + 64 * j];
      ss += v.x * v.x + v.y * v.y + v.z * v.z + v.w * v.w;
      ((uint2*)(p.xb + (size_t)R * D))[lane + 64 * j] = pk4(v.x, v.y, v.z, v.w);
    }
    ss = wave_sum(ss);
    if (lane == 0) p.ssq_x[R] = ss;
  }
  for (int i = gt; i < 6 * NTP; i += NTH) p.ssq_x[NTP + i] = 0.f;
  for (int it = blockIdx.x; it < NWT; it += gridDim.x) conv_weights_item(p, 0, it, lds);
  for (int i = gt; i < PT * 16; i += NTH) {
    const int pos = i >> 4, j = i & 15;
    const float inv = powf(10000.f, -(float)j * 2.0f / 32.f);
    const float ang = (float)pos * inv;
    double a = (double)ang;
    a -= 6.283185307179586476925 * rint(a * 0.15915494309189533577);
    p.ropec[i] = (float)cos(a);
    p.ropes[i] = (float)sin(a);
  }
}

#define LAS3 __attribute__((address_space(3)))
#define RAW_BARRIER() { asm volatile("" ::: "memory"); __builtin_amdgcn_s_barrier(); asm volatile("" ::: "memory"); }
DEV int lds_byte(int r, int c) { const int st = (r >> 4) * 2 + (c >> 5), rr = r & 15, cc = c & 31, ob = rr * 64 + cc * 2; return st * 1024 + (ob ^ (((ob >> 9) & 1) << 5)); }
template <class Epi, int NB = 8>
DEV int gemm_tile(const bf16_t* __restrict__ A, int lda, const bf16_t* __restrict__ Bt, int ldb, int K, int m0, int n0, char* lds, const Epi& epi, unsigned* nctr = nullptr) {
  int tid = threadIdx.x; LAUNDER(tid);
  const int lane = tid & 63, w = __builtin_amdgcn_readfirstlane(tid >> 6), wr = w >> 1, wc = w & 1;
  const int fr = lane & 15, fq = lane >> 4;
  const int sb = lane * 16, swz = sb ^ (((sb >> 9) & 1) << 5), rl = swz >> 6, cl = (swz & 63) >> 1;
  const bf16_t* ga[4]; const bf16_t* gb[4];
#pragma unroll
  for (int i = 0; i < 4; ++i) {
    const int st = 4 * w + i, r = (st >> 1) * 16 + rl, c = (st & 1) * 32 + cl;
    ga[i] = A + (size_t)(m0 + r) * lda + c;
    gb[i] = Bt + (size_t)(n0 + r) * ldb + c;
  }
  const int nk = K / 64;
#define GSTAGE(S, KT) { _Pragma("unroll") for (int i = 0; i < 4; ++i) { \
      __builtin_amdgcn_global_load_lds((const unsigned*)(ga[i] + (KT) * 64), (LAS3 unsigned*)(lds + (S) * 32768 + (4 * w + i) * 1024 + lane * 16), 16, 0, 0); \
      if (2 * w + (i >> 1) < NB) __builtin_amdgcn_global_load_lds((const unsigned*)(gb[i] + (KT) * 64), (LAS3 unsigned*)(lds + (S) * 32768 + 16384 + (4 * w + i) * 1024 + lane * 16), 16, 0, 0); } }
  f32x4 acc[4][4];
#pragma unroll
  for (int i = 0; i < 4; ++i)
#pragma unroll
    for (int j = 0; j < 4; ++j) acc[i][j] = (f32x4){0.f, 0.f, 0.f, 0.f};
  int offA[2], offB[2];
#pragma unroll
  for (int kh = 0; kh < 2; ++kh) { offA[kh] = lds_byte(wr * 64 + fr, kh * 32 + fq * 8); offB[kh] = lds_byte(wc * 64 + fr, kh * 32 + fq * 8); }
  GSTAGE(0, 0)
  if (nk > 1) GSTAGE(1, 1)
  for (int kt = 0; kt < nk; ++kt) {
    const int s = kt & 1;
    if (kt + 1 < nk) { if (2 * w < NB) asm volatile("s_waitcnt vmcnt(8)" ::: "memory"); else asm volatile("s_waitcnt vmcnt(4)" ::: "memory"); }
    else asm volatile("s_waitcnt vmcnt(0)" ::: "memory");
    RAW_BARRIER()
    const char* ia = lds + s * 32768;
    const char* ib = ia + 16384;
    bf16x8 af[2][4], bfv[2][4];
#pragma unroll
    for (int kh = 0; kh < 2; ++kh) {
#pragma unroll
      for (int mi = 0; mi < 4; ++mi) af[kh][mi] = *(const bf16x8*)(ia + offA[kh] + mi * 2048);
#pragma unroll
      for (int ni = 0; ni < (NB < 4 ? NB : 4); ++ni) bfv[kh][ni] = *(const bf16x8*)(ib + offB[kh] + ni * 2048);
    }
    asm volatile("s_waitcnt lgkmcnt(%0)" :: "n"(4 + (NB < 4 ? NB : 4)) : "memory");
    __builtin_amdgcn_sched_barrier(0);
    if (NB == 8 || wc == 0) {
#pragma unroll
      for (int mi = 0; mi < 4; ++mi)
#pragma unroll
        for (int ni = 0; ni < (NB < 4 ? NB : 4); ++ni) acc[mi][ni] = mfma16(bfv[0][ni], af[0][mi], acc[mi][ni]);
    }
    __builtin_amdgcn_sched_barrier(0);
    asm volatile("s_waitcnt lgkmcnt(0)" ::: "memory");
    RAW_BARRIER()
    if (kt + 2 < nk) GSTAGE(s, kt + 2)
    __builtin_amdgcn_sched_barrier(0);
    if (NB == 8 || wc == 0) {
#pragma unroll
      for (int mi = 0; mi < 4; ++mi)
#pragma unroll
        for (int ni = 0; ni < (NB < 4 ? NB : 4); ++ni) acc[mi][ni] = mfma16(bfv[1][ni], af[1][mi], acc[mi][ni]);
    }
  }
  __syncthreads();
#undef GSTAGE
  int tk = 0x7fffffff; if (nctr && tid == 0) tk = (int)atomicAdd(nctr, 1u);
  if (NB == 8 || wc == 0) epi(acc, m0 + wr * 64, n0 + wc * 64, fr, fq);
  return tk;
}

struct EpiIn {
  const Prm& p; int L;
  struct Pre { float s[4]; };
  DEV Pre preload(int mb, int nb, int fr, int fq) const {
    Pre r;
#pragma unroll
    for (int mi = 0; mi < 4; ++mi) r.s[mi] = p.ssq_x[L * NTP + mb + 16 * mi + fr];
    return r;
  }
  DEV void operator()(f32x4 (&acc)[4][4], int mb, int nb, int fr, int fq) const { finish(acc, preload(mb, nb, fr, fq), mb, nb, fr, fq); }
  DEV void finish(f32x4 (&acc)[4][4], const Pre& pre, int mb, int nb, int fr, int fq) const {
#pragma unroll
    for (int mi = 0; mi < 4; ++mi) {
      const int m = mb + 16 * mi + fr;
      const bool ok = m < NT;
      const float rstd = rsqrtf(pre.s[mi] * (1.f / 1024.f) + RMS_EPS);
      float sq = 0.f;
#pragma unroll
      for (int g = 0; g < 2; ++g) {
        const int n0 = nb + 32 * g;
        if (n0 >= 3104) continue;
        bf16_t* dst = n0 < ZL ? p.zL + (size_t)m * ZL + n0 : p.zE + (size_t)m * ZE + (n0 - ZL);
        float v[8];
#pragma unroll
        for (int j = 0; j < 4; ++j) { v[j] = acc[mi][2 * g][j] * rstd; v[4 + j] = acc[mi][2 * g + 1][j] * rstd; }
#pragma unroll
        for (int j = 0; j < 8; ++j) sq += v[j] * v[j];
        if (ok) { uint4 o; o.x = pk2(v[0], v[1]); o.y = pk2(v[2], v[3]); o.z = pk2(v[4], v[5]); o.w = pk2(v[6], v[7]); *(uint4*)(dst + 8 * fq) = o; }
      }
      if (nb >= ZL && nb < ZL + 384) {
        sq += __shfl_xor(sq, 16); sq += __shfl_xor(sq, 32);
        if (fq == 0 && ok) atomicAdd((nb < ZL + 256 ? p.ssq_q : p.ssq_kv) + L * NTP + m, sq);
      }
    }
  }
};
struct EpiQ {
  const Prm& p; int L;
  DEV void operator()(f32x4 (&acc)[4][4], int mb, int nb, int fr, int fq) const {
    bf16_t* Qb = (bf16_t*)p.y_prompt;
#pragma unroll
    for (int mi = 0; mi < 4; ++mi) {
      const int m = mb + 16 * mi + fr;
      const bool ok = m < NT;
      const float rstd = rsqrtf(p.ssq_q[L * NTP + m] * (1.f / 256.f) + RMS_EPS);
      const int pos = pos_of(ok ? m : 0);
#pragma unroll
      for (int np = 0; np < 2; ++np) {
        const int n0 = nb + 32 * np;
        float v[2][4];
#pragma unroll
        for (int h2 = 0; h2 < 2; ++h2)
#pragma unroll
          for (int j = 0; j < 4; ++j) v[h2][j] = acc[mi][2 * np + h2][j] * rstd;
        if (((n0 >> 5) % 3) == 2) {
#pragma unroll
          for (int j = 0; j < 4; ++j) {
            const int c = 4 * fq + j;
            const float cs = p.ropec[pos * 16 + c], sn = p.ropes[pos * 16 + c];
            const float x1 = v[0][j], x2 = v[1][j];
            v[0][j] = x1 * cs - x2 * sn; v[1][j] = x1 * sn + x2 * cs;
          }
        }
        if (ok) {
          *(uint2*)(Qb + (size_t)m * 768 + n0 + 4 * fq) = pk4(v[0][0], v[0][1], v[0][2], v[0][3]);
          *(uint2*)(Qb + (size_t)m * 768 + n0 + 16 + 4 * fq) = pk4(v[1][0], v[1][1], v[1][2], v[1][3]);
        }
      }
    }
  }
};
struct EpiOut {
  const Prm& p; int L;
  struct Pre { uint4 x[4][2]; };
  DEV Pre preload(int mb, int nb, int fr, int fq) const {
    Pre r;
#pragma unroll
    for (int mi = 0; mi < 4; ++mi) {
      const int m = mb + 16 * mi + fr;
      const bf16_t* xr = p.xb + (size_t)(m < NT ? m : 0) * D;
#pragma unroll
      for (int g = 0; g < 2; ++g) r.x[mi][g] = *(const uint4*)(xr + nb + 32 * g + 8 * fq);
    }
    return r;
  }
  DEV void operator()(f32x4 (&acc)[4][4], int mb, int nb, int fr, int fq) const { finish(acc, preload(mb, nb, fr, fq), mb, nb, fr, fq); }
  DEV void finish(f32x4 (&acc)[4][4], const Pre& pre, int mb, int nb, int fr, int fq) const {
#pragma unroll
    for (int mi = 0; mi < 4; ++mi) {
      const int m = mb + 16 * mi + fr;
      const bool ok = m < NT;
      bf16_t* xr = p.xb + (size_t)(ok ? m : 0) * D;
      float ss = 0.f;
#pragma unroll
      for (int g = 0; g < 2; ++g) {
        const int col = nb + 32 * g + 8 * fq;
        const uint4 xi = pre.x[mi][g];
        float v[8] = {bflo(xi.x), bfhi(xi.x), bflo(xi.y), bfhi(xi.y), bflo(xi.z), bfhi(xi.z), bflo(xi.w), bfhi(xi.w)};
#pragma unroll
        for (int j = 0; j < 4; ++j) { v[j] += acc[mi][2 * g][j]; v[4 + j] += acc[mi][2 * g + 1][j]; }
#pragma unroll
        for (int j = 0; j < 8; ++j) ss += v[j] * v[j];
        if (ok) { uint4 o; o.x = pk2(v[0], v[1]); o.y = pk2(v[2], v[3]); o.z = pk2(v[4], v[5]); o.w = pk2(v[6], v[7]); *(uint4*)(xr + col) = o; }
      }
      ss += __shfl_xor(ss, 16); ss += __shfl_xor(ss, 32);
      if (fq == 0 && ok) atomicAdd(p.ssq_x + (L + 1) * NTP + m, ss);
    }
  }
};

DEV void kv_prep_row(const Prm& p, int L, int R, int half, bool valid, bf16_t* At_row  ) {
  const int Rl = valid ? R : 0;
  const bf16_t* zr = p.zE + (size_t)Rl * ZE;
  const float rstd = rsqrtf(p.ssq_kv[L * NTP + Rl] * (1.f / 128.f) + RMS_EPS);
  float* outc; float* outk;
  if (Rl < NPR) { const int s = Rl / PT, q = Rl - s * PT; outc = p.ckv_p + (((size_t)L * 4 + s) * PT + q) * 128; outk = p.kr_p + (((size_t)L * 4 + s) * PT + q) * 32; }
  else { const int j = Rl - NPR; outc = p.ckv_s + ((size_t)L * NSM + j) * 128; outk = p.kr_s + ((size_t)L * NSM + j) * 32; }
  const float* g = p.kv_norm_g + L * 128 + 64 * half;
#pragma unroll
  for (int c8 = 0; c8 < 8; ++c8) {
    const uint4 u = *(const uint4*)(zr + ZE_CKV + 64 * half + 8 * c8);
    const float4 g0 = *(const float4*)(g + 8 * c8), g1 = *(const float4*)(g + 8 * c8 + 4);
    float4 y0, y1;
    y0.x = bflo(u.x) * rstd * g0.x; y0.y = bfhi(u.x) * rstd * g0.y; y0.z = bflo(u.y) * rstd * g0.z; y0.w = bfhi(u.y) * rstd * g0.w;
    y1.x = bflo(u.z) * rstd * g1.x; y1.y = bfhi(u.z) * rstd * g1.y; y1.z = bflo(u.w) * rstd * g1.z; y1.w = bfhi(u.w) * rstd * g1.w;
    if (valid) { *(float4*)(outc + 64 * half + 8 * c8) = y0; *(float4*)(outc + 64 * half + 8 * c8 + 4) = y1; }
    if (At_row) { uint4 o; o.x = pk2(y0.x, y0.y); o.y = pk2(y0.z, y0.w); o.z = pk2(y1.x, y1.y); o.w = pk2(y1.z, y1.w); *(uint4*)(At_row + 64 * half + 8 * c8) = o; }
    if (valid && Rl >= NPR) {
      const int j = Rl - NPR, b = j >> 6, r = j & 63;
      bf16_t* kl = p.KL + ((size_t)b * SKEYS + 1024 + r) * 160 + 16 * (4 * half + (c8 >> 1)) + 4 * (c8 & 1);
      *(uint2*)kl = pk4(y0.x, y0.y, y0.z, y0.w); *(uint2*)(kl + 8) = pk4(y1.x, y1.y, y1.z, y1.w);
    }
    if (c8 & 1) __builtin_amdgcn_sched_barrier(0);
  }
  if (half == 0) {
    const int pos = pos_of(Rl);
#pragma unroll
    for (int c8 = 0; c8 < 2; ++c8) {
      const uint4 u = *(const uint4*)(zr + ZE_KR + 8 * c8), v = *(const uint4*)(zr + ZE_KR + 16 + 8 * c8);
      const float x1[8] = {bflo(u.x), bfhi(u.x), bflo(u.y), bfhi(u.y), bflo(u.z), bfhi(u.z), bflo(u.w), bfhi(u.w)};
      const float x2[8] = {bflo(v.x), bfhi(v.x), bflo(v.y), bfhi(v.y), bflo(v.z), bfhi(v.z), bflo(v.w), bfhi(v.w)};
      float y1[8], y2[8];
#pragma unroll
      for (int e = 0; e < 8; ++e) {
        const float cs = p.ropec[pos * 16 + 8 * c8 + e], sn = p.ropes[pos * 16 + 8 * c8 + e];
        y1[e] = x1[e] * cs - x2[e] * sn; y2[e] = x1[e] * sn + x2[e] * cs;
      }
      if (valid) {
        float4 o;
        o.x = y1[0]; o.y = y1[1]; o.z = y1[2]; o.w = y1[3]; *(float4*)(outk + 8 * c8) = o;
        o.x = y1[4]; o.y = y1[5]; o.z = y1[6]; o.w = y1[7]; *(float4*)(outk + 8 * c8 + 4) = o;
        o.x = y2[0]; o.y = y2[1]; o.z = y2[2]; o.w = y2[3]; *(float4*)(outk + 16 + 8 * c8) = o;
        o.x = y2[4]; o.y = y2[5]; o.z = y2[6]; o.w = y2[7]; *(float4*)(outk + 16 + 8 * c8 + 4) = o;
        {
          const int j = Rl - NPR;
          bf16_t* krd = Rl < NPR ? p.Kr + (size_t)Rl * 32 : p.KL + ((size_t)(j >> 6) * SKEYS + 1024 + (j & 63)) * 160 + 128;
          uint4 q; q.x = pk2(y1[0], y1[1]); q.y = pk2(y1[2], y1[3]); q.z = pk2(y1[4], y1[5]); q.w = pk2(y1[6], y1[7]); *(uint4*)(krd + 8 * c8) = q;
          q.x = pk2(y2[0], y2[1]); q.y = pk2(y2[2], y2[3]); q.z = pk2(y2[4], y2[5]); q.w = pk2(y2[6], y2[7]); *(uint4*)(krd + 16 + 8 * c8) = q;
        }
      }
    }
  }
}
DEV void kvproj_item(const Prm& p, int L, int mt, char* lds) {
  int tid = threadIdx.x; LAUNDER(tid);
  const int lane = tid & 63, w = __builtin_amdgcn_readfirstlane(tid >> 6), wr = w >> 1, wc = w & 1, l31 = lane & 31, hh = lane >> 5;
  bf16_t* At = (bf16_t*)lds;
  bf16_t* Bs = At + 128 * 136;
  {
    const int r = tid >> 1, half = tid & 1, R = mt * 128 + r;
    kv_prep_row(p, L, R, half, R < NPR, At + r * 136);
  }
  for (int h = 0; h < 8; ++h) {
    __syncthreads();
    {
      const bf16_t* wsrc = p.Wb_ukv + ((size_t)L * 1024 + h * 128) * 128;
#pragma unroll
      for (int i = 0; i < 8; ++i) { const int id = tid + 256 * i, row = id >> 4, cc = id & 15; *(uint4*)(Bs + row * 136 + cc * 8) = *(const uint4*)(wsrc + row * 128 + cc * 8); }
    }
    __syncthreads();
    f32x16 acc[2][2];
#pragma unroll
    for (int i = 0; i < 2; ++i)
#pragma unroll
      for (int j = 0; j < 2; ++j) acc[i][j] = zero16();
    const bf16_t* as = At + (wr * 64 + l31) * 136 + hh * 8;
    const bf16_t* bs = Bs + (wc * 64 + l31) * 136 + hh * 8;
    if (wc == 0) {
#pragma unroll 2
      for (int ks = 0; ks < 8; ++ks) {
        const bf16x8 a0 = *(const bf16x8*)(as + ks * 16), a1 = *(const bf16x8*)(as + 32 * 136 + ks * 16);
        const bf16x8 b0 = *(const bf16x8*)(bs + ks * 16), b1 = *(const bf16x8*)(bs + 32 * 136 + ks * 16);
        acc[0][0] = mfma32(b0, a0, acc[0][0]); acc[0][1] = mfma32(b1, a0, acc[0][1]);
        acc[1][0] = mfma32(b0, a1, acc[1][0]); acc[1][1] = mfma32(b1, a1, acc[1][1]);
      }
#pragma unroll
      for (int i = 0; i < 2; ++i) {
        const int KRr = mt * 128 + wr * 64 + 32 * i + l31;
#pragma unroll
        for (int j = 0; j < 2; ++j)
#pragma unroll
          for (int G = 0; G < 4; ++G)
            *(uint2*)(p.Kn + ((size_t)KRr * 8 + h) * 64 + 32 * j + 8 * G + 4 * hh) = pk4(acc[i][j][4 * G], acc[i][j][4 * G + 1], acc[i][j][4 * G + 2], acc[i][j][4 * G + 3]);
      }
    } else {
#pragma unroll 2
      for (int ks = 0; ks < 8; ++ks) {
        const bf16x8 a0 = *(const bf16x8*)(as + ks * 16), a1 = *(const bf16x8*)(as + 32 * 136 + ks * 16);
        const bf16x8 b0 = *(const bf16x8*)(bs + ks * 16), b1 = *(const bf16x8*)(bs + 32 * 136 + ks * 16);
        acc[0][0] = mfma32(a0, b0, acc[0][0]); acc[0][1] = mfma32(a0, b1, acc[0][1]);
        acc[1][0] = mfma32(a1, b0, acc[1][0]); acc[1][1] = mfma32(a1, b1, acc[1][1]);
      }
#pragma unroll
      for (int j = 0; j < 2; ++j) {
        const int d = 32 * j + l31;
#pragma unroll
        for (int i = 0; i < 2; ++i)
#pragma unroll
          for (int G = 0; G < 4; ++G) {
            const int KRr = mt * 128 + wr * 64 + 32 * i + 16 * (G >> 1) + 8 * hh + 4 * (G & 1);
            *(uint2*)(p.Vt + ((size_t)h * 64 + d) * KVR + KRr) = pk4(acc[i][j][4 * G], acc[i][j][4 * G + 1], acc[i][j][4 * G + 2], acc[i][j][4 * G + 3]);
          }
      }
    }
  }
  __syncthreads();
}
DEV void sample_prep_item(const Prm& p, int L, int it) {
  int tid = threadIdx.x; LAUNDER(tid);
  const int R = NPR + it * 128 + (tid >> 1);
  kv_prep_row(p, L, R, tid & 1, true, nullptr);
}
DEV void shift_item(const Prm& p, int L, int st) {
  int tid0 = threadIdx.x; LAUNDER(tid0);
  if (tid0 < 224) {
    const int R = st < 4 ? st * PT + (PT - 1) : NPR + (st - 4) * 64 + 63;
    const uint2 u = *(const uint2*)(p.zE + (size_t)R * ZE + ZE_ZC + 4 * tid0);
    float4 v; v.x = bflo(u.x); v.y = bfhi(u.x); v.z = bflo(u.y); v.w = bfhi(u.y);
    float* dst = st < 4 ? p.shift_p + ((size_t)L * 4 + st) * 896 : p.shift_s + ((size_t)L * 32 + (st - 4)) * 896;
    *(float4*)(dst + 4 * tid0) = v;
  }
}

DEV void lat_item(const Prm& p, int L, int j) {
  int tid = threadIdx.x; LAUNDER(tid);
  const int b = j >> 4, t = j & 15;
  const float* csrc = p.cache_ckv + (((size_t)L * 32 + b) * 1024 + 64 * t) * 128;
  const float* ksrc = p.cache_krope + (((size_t)L * 32 + b) * 1024 + 64 * t) * 32;
  {
    const int row = tid >> 2, qd = tid & 3;
    const float* s = csrc + row * 128 + 32 * qd;
    bf16_t* d = p.KL + ((size_t)b * SKEYS + 64 * t + row) * 160;
    const float4 v0 = *(const float4*)(s), v1 = *(const float4*)(s + 4), v2 = *(const float4*)(s + 8), v3 = *(const float4*)(s + 12);
    const float4 v4 = *(const float4*)(s + 16), v5 = *(const float4*)(s + 20), v6 = *(const float4*)(s + 24), v7 = *(const float4*)(s + 28);
    const float4 k0 = *(const float4*)(ksrc + row * 32 + 8 * qd), k1 = *(const float4*)(ksrc + row * 32 + 8 * qd + 4);
    uint4 a;
    a.x = pk2(v0.x, v0.y); a.y = pk2(v0.z, v0.w); a.z = pk2(v2.x, v2.y); a.w = pk2(v2.z, v2.w); *(uint4*)(d + 32 * qd) = a;
    a.x = pk2(v1.x, v1.y); a.y = pk2(v1.z, v1.w); a.z = pk2(v3.x, v3.y); a.w = pk2(v3.z, v3.w); *(uint4*)(d + 32 * qd + 8) = a;
    a.x = pk2(v4.x, v4.y); a.y = pk2(v4.z, v4.w); a.z = pk2(v6.x, v6.y); a.w = pk2(v6.z, v6.w); *(uint4*)(d + 32 * qd + 16) = a;
    a.x = pk2(v5.x, v5.y); a.y = pk2(v5.z, v5.w); a.z = pk2(v7.x, v7.y); a.w = pk2(v7.z, v7.w); *(uint4*)(d + 32 * qd + 24) = a;
    a.x = pk2(k0.x, k0.y); a.y = pk2(k0.z, k0.w); a.z = pk2(k1.x, k1.y); a.w = pk2(k1.z, k1.w); *(uint4*)(d + 128 + 8 * qd) = a;
  }
}

template <bool SAMPLE>
DEV int attn_body(const Prm& p, int L, int sb, int head, int qt, char* lds, unsigned* nctr = nullptr) {
  int tid = threadIdx.x; LAUNDER(tid);
  const int lane = tid & 63, w = __builtin_amdgcn_readfirstlane(tid >> 6), l31 = lane & 31, hh = lane >> 5;
  bf16_t* Ks = (bf16_t*)lds;
  bf16_t* Vs = Ks + (SAMPLE ? 1 : 2) * 64 * 104;
  bf16_t* Cs = Vs + (SAMPLE ? 1 : 2) * 64 * 72;
  bf16_t* Wl = Cs + 64 * 136;
  const bf16_t* Qb = (const bf16_t*)p.y_prompt;
  bf16_t* mix = p.zE;
  int Rq0, ntiles, lastvis; bool wact, rowvalid;
  if (SAMPLE) { Rq0 = NPR + 64 * sb; ntiles = 17; lastvis = 16; wact = w < 2; rowvalid = wact; }
  else if (qt >= 0) { Rq0 = sb * PT + 16 + 128 * qt; ntiles = 2 * qt + 3; lastvis = 1 + 2 * qt + (w >> 1); wact = true; rowvalid = true; }
  else { Rq0 = sb * PT; ntiles = 1; lastvis = 0; wact = (w == 0); rowvalid = wact && l31 < 16; }
  const int myrow = Rq0 + 32 * w + l31;
  const int Rld = rowvalid ? myrow : Rq0;
  bf16x8 qf[6];
  {
    const bf16_t* qp = Qb + (size_t)Rld * 768 + head * 96 + hh * 8;
#pragma unroll
    for (int ks = 0; ks < 6; ++ks) qf[ks] = *(const bf16x8*)(qp + 16 * ks);
  }
  float m_run = -1e30f, l_run = 0.f;
  f32x16 o0 = zero16(), o1 = zero16();

  uint4 a_kn0, a_kn1, a_kr, a_vt0, a_vt1;
  a_kn0 = a_kn1 = a_kr = a_vt0 = a_vt1 = make_uint4(0, 0, 0, 0);
#define PLOADX(S, TI) { const int KR0 = sb * PT + ((TI) == 0 ? 0 : 16 + 64 * ((TI) - 1)); \
    S##_kn0 = *(const uint4*)(p.Kn + ((size_t)(KR0 + (tid >> 3)) * 8 + head) * 64 + (tid & 7) * 8); \
    S##_kn1 = *(const uint4*)(p.Kn + ((size_t)(KR0 + 32 + (tid >> 3)) * 8 + head) * 64 + (tid & 7) * 8); \
    S##_kr = *(const uint4*)(p.Kr + (size_t)(KR0 + (tid >> 2)) * 32 + (tid & 3) * 8); \
    S##_vt0 = *(const uint4*)(p.Vt + ((size_t)head * 64 + (tid >> 3)) * KVR + KR0 + (tid & 7) * 8); \
    S##_vt1 = *(const uint4*)(p.Vt + ((size_t)head * 64 + 32 + (tid >> 3)) * KVR + KR0 + (tid & 7) * 8); }
#define PWRITEX(S, BUF) { bf16_t* kb_ = Ks + (BUF) * 64 * 104; bf16_t* vb_ = Vs + (BUF) * 64 * 72; \
    *(uint4*)(kb_ + (tid >> 3) * 104 + (tid & 7) * 8) = S##_kn0; *(uint4*)(kb_ + (32 + (tid >> 3)) * 104 + (tid & 7) * 8) = S##_kn1; \
    *(uint4*)(kb_ + (tid >> 2) * 104 + 64 + (tid & 3) * 8) = S##_kr; \
    *(uint4*)(vb_ + (tid >> 3) * 72 + (tid & 7) * 8) = S##_vt0; *(uint4*)(vb_ + (32 + (tid >> 3)) * 72 + (tid & 7) * 8) = S##_vt1; }
  float4 pc0, pc1, pc2, pc3, pc4, pc5, pc6, pc7, pk0, pk1;
  pc0 = pc1 = pc2 = pc3 = pc4 = pc5 = pc6 = pc7 = pk0 = pk1 = make_float4(0.f, 0.f, 0.f, 0.f);
  if (SAMPLE) {
    const bf16_t* wsrc = p.Wb_ukv + ((size_t)L * 1024 + head * 128) * 128;
#pragma unroll
    for (int i = 0; i < 8; ++i) { const int id = tid + 256 * i, row = id >> 4, cc = id & 15; *(uint4*)(Wl + row * 136 + cc * 8) = *(const uint4*)(wsrc + row * 128 + cc * 8); }
  }
#define SLOAD(TI) { const float* csrc; const float* ksrc; \
    if ((TI) < 16) { csrc = p.cache_ckv + (((size_t)L * 32 + sb) * 1024 + 64 * (TI)) * 128; ksrc = p.cache_krope + (((size_t)L * 32 + sb) * 1024 + 64 * (TI)) * 32; } \
    else { csrc = p.ckv_s + ((size_t)L * NSM + 64 * sb) * 128; ksrc = p.kr_s + ((size_t)L * NSM + 64 * sb) * 32; } \
    const float* cb_ = csrc + (tid >> 5) * 128 + (tid & 31) * 4; \
    pc0 = *(const float4*)(cb_); pc1 = *(const float4*)(cb_ + 8 * 128); pc2 = *(const float4*)(cb_ + 16 * 128); pc3 = *(const float4*)(cb_ + 24 * 128); \
    pc4 = *(const float4*)(cb_ + 32 * 128); pc5 = *(const float4*)(cb_ + 40 * 128); pc6 = *(const float4*)(cb_ + 48 * 128); pc7 = *(const float4*)(cb_ + 56 * 128); \
    const float* kb2_ = ksrc + (tid >> 3) * 32 + (tid & 7) * 4; pk0 = *(const float4*)(kb2_); pk1 = *(const float4*)(kb2_ + 32 * 32); }
#define SWRITE(BUF) { bf16_t* cd_ = Cs + (tid >> 5) * 136 + (tid & 31) * 4; \
    *(uint2*)(cd_) = pk4(pc0.x, pc0.y, pc0.z, pc0.w); *(uint2*)(cd_ + 8 * 136) = pk4(pc1.x, pc1.y, pc1.z, pc1.w); \
    *(uint2*)(cd_ + 16 * 136) = pk4(pc2.x, pc2.y, pc2.z, pc2.w); *(uint2*)(cd_ + 24 * 136) = pk4(pc3.x, pc3.y, pc3.z, pc3.w); \
    *(uint2*)(cd_ + 32 * 136) = pk4(pc4.x, pc4.y, pc4.z, pc4.w); *(uint2*)(cd_ + 40 * 136) = pk4(pc5.x, pc5.y, pc5.z, pc5.w); \
    *(uint2*)(cd_ + 48 * 136) = pk4(pc6.x, pc6.y, pc6.z, pc6.w); *(uint2*)(cd_ + 56 * 136) = pk4(pc7.x, pc7.y, pc7.z, pc7.w); \
    }
#define SWRITEK(BUF) { bf16_t* kd_ = Ks + (BUF) * 64 * 104 + (tid >> 3) * 104 + 64 + (tid & 7) * 4; \
    *(uint2*)(kd_) = pk4(pk0.x, pk0.y, pk0.z, pk0.w); *(uint2*)(kd_ + 32 * 104) = pk4(pk1.x, pk1.y, pk1.z, pk1.w); }
  auto sexpand = [&](int buf) {
    const int a = w & 1, b = w >> 1;
    const bf16_t* cp = Cs + (32 * b + l31) * 136 + hh * 8;
    const bf16_t* wkp = Wl + (32 * a + l31) * 136 + hh * 8;
    const bf16_t* wvp = wkp + 64 * 136;
    f32x16 ka = zero16(), va = zero16();
#pragma unroll
    for (int ks = 0; ks < 8; ++ks) {
      const bf16x8 cf = *(const bf16x8*)(cp + 16 * ks);
      ka = mfma32(*(const bf16x8*)(wkp + 16 * ks), cf, ka);
      va = mfma32(cf, *(const bf16x8*)(wvp + 16 * ks), va);
    }
    bf16_t* kb = Ks + buf * 64 * 104; bf16_t* vb = Vs + buf * 64 * 72;
#pragma unroll
    for (int G = 0; G < 4; ++G) {
      *(uint2*)(kb + (32 * b + l31) * 104 + 32 * a + 8 * G + 4 * hh) = pk4(ka[4 * G], ka[4 * G + 1], ka[4 * G + 2], ka[4 * G + 3]);
      *(uint2*)(vb + (32 * a + l31) * 72 + 32 * b + 8 * G + 4 * hh) = pk4(va[4 * G], va[4 * G + 1], va[4 * G + 2], va[4 * G + 3]);
    }
  };
  const int x7 = (l31 >> 1) & 7, x3 = (l31 >> 2) & 3, xv = (l31 >> 1) & 7;
#define KFRAG(SP, KS, SUB) (SAMPLE ? *(const bf16x8*)((const bf16_t*)(SP) + (l31 + 32 * (SUB)) * 104 + hh * 8 + 16 * (KS)) \
    : ((KS) < 4 ? *(const bf16x8*)((SP) + (l31 + 32 * (SUB)) * 128 + (((2 * (KS) + hh) ^ x7) << 4)) \
                : *(const bf16x8*)((SP) + 8192 + (l31 + 32 * (SUB)) * 64 + (((2 * ((KS) - 4) + hh) ^ x3) << 4))))
#define VFR(S, SUB) (*(const bf16x8*)(sp + 12288 + (l31 + 32 * (SUB)) * 128 + (((2 * (S) + hh) ^ xv) << 4)))
#define VHALF(SP, C, SUB) (SAMPLE ? *(const uint2*)((const bf16_t*)(SP) + 64 * 104 + (l31 + 32 * (SUB)) * 72 + 4 * hh + 8 * (C)) \
    : *(const uint2*)((SP) + 12288 + (l31 + 32 * (SUB)) * 128 + 8 * hh + ((((C)) ^ xv) << 4)))
  auto compute_t = [&](auto masked_c, const char* sp) {
    constexpr bool MASKED = decltype(masked_c)::value;
    f32x16 s0 = zero16(), s1 = zero16();
    {
      bf16x8 kf[12];
#pragma unroll
      for (int ks = 0; ks < 6; ++ks) { kf[2 * ks] = KFRAG(sp, ks, 0); kf[2 * ks + 1] = KFRAG(sp, ks, 1); }
      __builtin_amdgcn_sched_barrier(0);
#pragma unroll
      for (int ks = 0; ks < 6; ++ks) { s0 = mfma32(kf[2 * ks], qf[ks], s0); s1 = mfma32(kf[2 * ks + 1], qf[ks], s1); }
    }
    bf16x8 vf[8];
    if (!SAMPLE) {
#pragma unroll
      for (int S = 0; S < 4; ++S) { vf[2 * S] = VFR(S, 0); vf[2 * S + 1] = VFR(S, 1); }
      __builtin_amdgcn_sched_barrier(0);
    }
    if (!SAMPLE && MASKED) {
#pragma unroll
      for (int r = 8; r < 16; ++r) s0[r] = -1e30f;
#pragma unroll
      for (int r = 0; r < 16; ++r) s1[r] = -1e30f;
    }
    float mx = s0[0];
#pragma unroll
    for (int r = 1; r < 16; ++r) mx = fmaxf(mx, s0[r]);
#pragma unroll
    for (int r = 0; r < 16; ++r) mx = fmaxf(mx, s1[r]);
    mx = fmaxf(mx, __shfl_xor(mx, 32));
    const float mnew = fmaxf(m_run, mx);
    const float alpha = __builtin_amdgcn_exp2f(m_run - mnew);
    m_run = mnew;
    float ps = 0.f;
#pragma unroll
    for (int r = 0; r < 16; ++r) { s0[r] = __builtin_amdgcn_exp2f(s0[r] - mnew); ps += s0[r]; }
#pragma unroll
    for (int r = 0; r < 16; ++r) { s1[r] = __builtin_amdgcn_exp2f(s1[r] - mnew); ps += s1[r]; }
    l_run = l_run * alpha + ps;
#pragma unroll
    for (int r = 0; r < 16; ++r) { o0[r] *= alpha; o1[r] *= alpha; }
    const bf16x8 pf0 = mk8(pk2(s0[0], s0[1]), pk2(s0[2], s0[3]), pk2(s0[4], s0[5]), pk2(s0[6], s0[7]));
    const bf16x8 pf1 = mk8(pk2(s0[8], s0[9]), pk2(s0[10], s0[11]), pk2(s0[12], s0[13]), pk2(s0[14], s0[15]));
    const bf16x8 pf2 = mk8(pk2(s1[0], s1[1]), pk2(s1[2], s1[3]), pk2(s1[4], s1[5]), pk2(s1[6], s1[7]));
    const bf16x8 pf3 = mk8(pk2(s1[8], s1[9]), pk2(s1[10], s1[11]), pk2(s1[12], s1[13]), pk2(s1[14], s1[15]));
#define PV_STEP(S, PF) { bf16x8 v0_, v1_; \
      if (SAMPLE) { const uint2 a0 = VHALF(sp, 2 * S, 0), b0 = VHALF(sp, 2 * S + 1, 0), a1 = VHALF(sp, 2 * S, 1), b1 = VHALF(sp, 2 * S + 1, 1); \
        v0_ = mk8(a0.x, a0.y, b0.x, b0.y); v1_ = mk8(a1.x, a1.y, b1.x, b1.y); } \
      else { v0_ = *(const bf16x8*)(sp + 12288 + l31 * 128 + (((2 * S + hh) ^ xv) << 4)); v1_ = *(const bf16x8*)(sp + 12288 + (l31 + 32) * 128 + (((2 * S + hh) ^ xv) << 4)); } \
      o0 = mfma32(v0_, PF, o0); o1 = mfma32(v1_, PF, o1); }
    if (SAMPLE) { PV_STEP(0, pf0) PV_STEP(1, pf1) PV_STEP(2, pf2) PV_STEP(3, pf3) }
    else {
      o0 = mfma32(vf[0], pf0, o0); o1 = mfma32(vf[1], pf0, o1); o0 = mfma32(vf[2], pf1, o0); o1 = mfma32(vf[3], pf1, o1);
      o0 = mfma32(vf[4], pf2, o0); o1 = mfma32(vf[5], pf2, o1); o0 = mfma32(vf[6], pf3, o0); o1 = mfma32(vf[7], pf3, o1);
    }
  };
  auto compute_meta = [&](const char* sp) {
    f32x16 s0 = zero16();
    {
      bf16x8 kf[6];
#pragma unroll
      for (int ks = 0; ks < 6; ++ks) kf[ks] = KFRAG(sp, ks, 0);
      __builtin_amdgcn_sched_barrier(0);
#pragma unroll
      for (int ks = 0; ks < 6; ++ks) s0 = mfma32(kf[ks], qf[ks], s0);
    }
    const bf16x8 v0 = VFR(0, 0), v1 = VFR(0, 1);
    float mx = s0[0];
#pragma unroll
    for (int r = 1; r < 8; ++r) mx = fmaxf(mx, s0[r]);
    mx = fmaxf(mx, __shfl_xor(mx, 32));
    m_run = mx;
    float ps = 0.f;
#pragma unroll
    for (int r = 0; r < 8; ++r) { s0[r] = __builtin_amdgcn_exp2f(s0[r] - mx); ps += s0[r]; }
    l_run = ps;
    const bf16x8 pf0 = mk8(pk2(s0[0], s0[1]), pk2(s0[2], s0[3]), pk2(s0[4], s0[5]), pk2(s0[6], s0[7]));
    o0 = mfma32(v0, pf0, zero16()); o1 = mfma32(v1, pf0, zero16());
  };
  bf16x8 qf7 = mk8(0u, 0u, 0u, 0u);
  const bf16x8 kone = mk8(hh == 0 ? 0x3F80u : 0u, 0u, 0u, 0u);
  auto freeze = [&]() {
    const float mf = bflo(pk2(m_run, 0.f));
    const float fac = __builtin_amdgcn_exp2f(m_run - mf);
    l_run *= fac;
#pragma unroll
    for (int r = 0; r < 16; ++r) { o0[r] *= fac; o1[r] *= fac; }
    qf7 = mk8(hh == 0 ? (pk2(-mf, 0.f) & 0xffffu) : 0u, 0u, 0u, 0u);
  };
  auto compute_f = [&](const char* sp) {
    f32x16 s0, s1;
    {
      bf16x8 kf[12];
#pragma unroll
      for (int ks = 0; ks < 6; ++ks) { kf[2 * ks] = KFRAG(sp, ks, 0); kf[2 * ks + 1] = KFRAG(sp, ks, 1); }
      __builtin_amdgcn_sched_barrier(0);
      s0 = mfma32(kone, qf7, zero16()); s1 = mfma32(kone, qf7, zero16());
#pragma unroll
      for (int ks = 0; ks < 6; ++ks) { s0 = mfma32(kf[2 * ks], qf[ks], s0); s1 = mfma32(kf[2 * ks + 1], qf[ks], s1); }
    }
    bf16x8 vf[8];
    if (!SAMPLE) {
#pragma unroll
      for (int S = 0; S < 4; ++S) { vf[2 * S] = VFR(S, 0); vf[2 * S + 1] = VFR(S, 1); }
      __builtin_amdgcn_sched_barrier(0);
    }
    float ps = 0.f;
#pragma unroll
    for (int r = 0; r < 16; ++r) { s0[r] = __builtin_amdgcn_exp2f(s0[r]); ps += s0[r]; }
#pragma unroll
    for (int r = 0; r < 16; ++r) { s1[r] = __builtin_amdgcn_exp2f(s1[r]); ps += s1[r]; }
    l_run += ps;
    const bf16x8 pf0 = mk8(pk2(s0[0], s0[1]), pk2(s0[2], s0[3]), pk2(s0[4], s0[5]), pk2(s0[6], s0[7]));
    const bf16x8 pf1 = mk8(pk2(s0[8], s0[9]), pk2(s0[10], s0[11]), pk2(s0[12], s0[13]), pk2(s0[14], s0[15]));
    const bf16x8 pf2 = mk8(pk2(s1[0], s1[1]), pk2(s1[2], s1[3]), pk2(s1[4], s1[5]), pk2(s1[6], s1[7]));
    const bf16x8 pf3 = mk8(pk2(s1[8], s1[9]), pk2(s1[10], s1[11]), pk2(s1[12], s1[13]), pk2(s1[14], s1[15]));
    if (SAMPLE) { PV_STEP(0, pf0) PV_STEP(1, pf1) PV_STEP(2, pf2) PV_STEP(3, pf3) }
    else {
      o0 = mfma32(vf[0], pf0, o0); o1 = mfma32(vf[1], pf0, o1); o0 = mfma32(vf[2], pf1, o0); o1 = mfma32(vf[3], pf1, o1);
      o0 = mfma32(vf[4], pf2, o0); o1 = mfma32(vf[5], pf2, o1); o0 = mfma32(vf[6], pf3, o0); o1 = mfma32(vf[7], pf3, o1);
    }
#undef PV_STEP
  };

  if (SAMPLE) {
    SLOAD(0)
    for (int ti = 0; ti < ntiles; ++ti) {
      const int buf = 0;
      SWRITE(buf)
      __syncthreads();
      SWRITEK(buf)
      { const int tn = ti + 1 < ntiles ? ti + 1 : ti; SLOAD(tn) }
      sexpand(buf);
      __syncthreads();
      if (wact) { if (ti == 0) { compute_t(std::false_type{}, (const char*)Ks); freeze(); } else compute_f((const char*)Ks); }
    }
    __syncthreads();
  } else {
    const int l8 = lane >> 3, c8 = lane & 7;
    unsigned kn_o0, kn_o1, kr_o, vt_o0, vt_o1;
    { const int r = 8 * (2 * w) + l8; kn_o0 = (unsigned)((r * 8 + head) * 64 + ((c8 ^ ((r >> 1) & 7)) * 8)); }
    { const int r = 8 * (2 * w + 1) + l8; kn_o1 = (unsigned)((r * 8 + head) * 64 + ((c8 ^ ((r >> 1) & 7)) * 8)); }
    { const int r = 16 * w + (lane >> 2); kr_o = (unsigned)(r * 32 + (((lane & 3) ^ ((r >> 2) & 3)) * 8)); }
    { const int d = 8 * (2 * w) + l8; vt_o0 = (unsigned)((head * 64 + d) * KVR + ((c8 ^ ((d >> 1) & 7)) * 8)); }
    { const int d = 8 * (2 * w + 1) + l8; vt_o1 = (unsigned)((head * 64 + d) * KVR + ((c8 ^ ((d >> 1) & 7)) * 8)); }
#define GLDS16(G, Lp) __builtin_amdgcn_global_load_lds((const unsigned*)(G), (LAS3 unsigned*)(Lp), 16, 0, 0)
#define PDMA(TI, STG) { const int KR0 = sb * PT + ((TI) == 0 ? 0 : 16 + 64 * ((TI) - 1)); char* sb_ = lds + (STG) * 20480 + lane * 16; \
      const bf16_t* kn_ = p.Kn + (size_t)KR0 * 512; const bf16_t* kr_ = p.Kr + (size_t)KR0 * 32; const bf16_t* vt_ = p.Vt + KR0; \
      GLDS16(kn_ + kn_o0, sb_ + (2 * w) * 1024); GLDS16(kn_ + kn_o1, sb_ + (2 * w + 1) * 1024); GLDS16(kr_ + kr_o, sb_ + 8192 + w * 1024); \
      GLDS16(vt_ + vt_o0, sb_ + 12288 + (2 * w) * 1024); GLDS16(vt_ + vt_o1, sb_ + 12288 + (2 * w + 1) * 1024); }
    PDMA(0, 0)
    if (ntiles > 1) PDMA(1, 1)
    int stg = 0, stg2 = 2;
    for (int ti = 0; ti < ntiles; ++ti) {
      if (ti + 1 < ntiles) asm volatile("s_waitcnt vmcnt(5)" ::: "memory"); else asm volatile("s_waitcnt vmcnt(0)" ::: "memory");
      RAW_BARRIER()
      if (ti + 2 < ntiles) PDMA(ti + 2, stg2)
      const char* sp = lds + stg * 20480;
      if (ti == 0) { if (wact) compute_meta(sp); }
      else if (ti == 1) { compute_t(std::false_type{}, sp); freeze(); }
      else if (ti <= lastvis) compute_f(sp);
      stg = stg == 2 ? 0 : stg + 1; stg2 = stg2 == 2 ? 0 : stg2 + 1;
    }
    __syncthreads();
#undef PDMA
#undef GLDS16
  }
  int tk = 0x7fffffff; if (nctr && tid == 0) tk = (int)atomicAdd(nctr, 1u);
  const float lt = l_run + __shfl_xor(l_run, 32);
  if (rowvalid) {
    const float inv = 1.f / lt;
    const bf16_t* gbp = p.zL + (size_t)myrow * ZL + ZL_GB + 64 * head;
    bf16_t* op = mix + (size_t)myrow * D + 256 + 64 * head;
#pragma unroll
    for (int G = 0; G < 4; ++G) {
      const int d = 8 * G + 4 * hh;
      const uint2 g0 = *(const uint2*)(gbp + d), g1 = *(const uint2*)(gbp + 32 + d);
      *(uint2*)(op + d) = pk4(o0[4 * G] * inv * silu_(bflo(g0.x)), o0[4 * G + 1] * inv * silu_(bfhi(g0.x)), o0[4 * G + 2] * inv * silu_(bflo(g0.y)), o0[4 * G + 3] * inv * silu_(bfhi(g0.y)));
      *(uint2*)(op + 32 + d) = pk4(o1[4 * G] * inv * silu_(bflo(g1.x)), o1[4 * G + 1] * inv * silu_(bfhi(g1.x)), o1[4 * G + 2] * inv * silu_(bflo(g1.y)), o1[4 * G + 3] * inv * silu_(bfhi(g1.y)));
    }
  }
  return tk;
}
DEV void attn_item(const Prm& p, int L, int id, char* lds) {
  if (id < 1024) { const int qt = 31 - (id >> 5), sh = id & 31; attn_body<false>(p, L, sh >> 3, sh & 7, qt, lds); }
  else { const int j = id - 1280; attn_body<false>(p, L, j >> 3, j & 7, -1, lds); }
}

typedef short v4i16_t __attribute__((ext_vector_type(4)));
DEV uint2 lds_tr16(const char* pl) { const v4i16_t r = __builtin_amdgcn_ds_read_tr16_b64_v4i16((__attribute__((address_space(3))) v4i16_t*)pl); return __builtin_bit_cast(uint2, r); }
DEV void attn_sample(const Prm& p, int L, int b, int hp, char* lds) {
  int tid = threadIdx.x; LAUNDER(tid);
  const int lane = tid & 63, w = __builtin_amdgcn_readfirstlane(tid >> 6), l31 = lane & 31, hh = lane >> 5;
  const int head = 2 * hp + (w >> 1);
  const bf16_t* Qb = (const bf16_t*)p.y_prompt;
  bf16_t* mix = p.zE;
  const int myrow = NPR + 64 * b + 32 * (w & 1) + l31;
  bf16x8 qf[6];
  {
    const bf16_t* qp = Qb + (size_t)myrow * 768 + head * 96 + hh * 8;
#pragma unroll
    for (int ks = 0; ks < 6; ++ks) qf[ks] = *(const bf16x8*)(qp + 16 * ks);
  }
  unsigned kl_o0, kl_o1, kl_o2, kl_o3, kr_o;
  {
    const int l16 = lane >> 4, c16 = lane & 15;
#define KROW(i) (4 * (4 * w + (i)) + l16)
#define KLO(i) ((unsigned)(KROW(i) * 160 + ((c16 ^ (((KROW(i) & 3) << 2) | ((KROW(i) >> 2) & 3))) * 8)))
    kl_o0 = KLO(0); kl_o1 = KLO(1); kl_o2 = KLO(2); kl_o3 = KLO(3);
#undef KLO
#undef KROW
    const int r = 16 * w + (lane >> 2);
    kr_o = (unsigned)(r * 160 + 128 + (((lane & 3) ^ ((r >> 2) & 3)) * 8));
  }
  const bf16_t* klb = p.KL + (size_t)b * SKEYS * 160;
#define GLDS16(G, Lp) __builtin_amdgcn_global_load_lds((const unsigned*)(G), (LAS3 unsigned*)(Lp), 16, 0, 0)
#define SDMA(TI, STG) { char* sb_ = lds + (STG) * 20480 + lane * 16; const bf16_t* kl_ = klb + (size_t)(TI) * 64 * 160; \
    GLDS16(kl_ + kl_o0, sb_ + (4 * w) * 1024); GLDS16(kl_ + kl_o1, sb_ + (4 * w + 1) * 1024); GLDS16(kl_ + kl_o2, sb_ + (4 * w + 2) * 1024); GLDS16(kl_ + kl_o3, sb_ + (4 * w + 3) * 1024); \
    GLDS16(kl_ + kr_o, sb_ + 16384 + w * 1024); }
  SDMA(0, 0)
  SDMA(1, 1)
  bf16x8 qa0, qa1, qa2, qa3, qa4, qa5, qa6, qa7;
  {
    const float* wsrc = p.w_ukv + ((size_t)L * 128 + l31) * 1024 + head * 128 + 8 * hh;
#define QABS(CT, QA, QB) { f32x16 acc = zero16(); \
      _Pragma("unroll") for (int ks = 0; ks < 4; ++ks) { const float* s_ = wsrc + (size_t)(32 * (CT)) * 1024 + 16 * ks; const float4 a_ = *(const float4*)s_, c_ = *(const float4*)(s_ + 4); \
        acc = mfma32(mk8(pk2(a_.x, a_.y), pk2(a_.z, a_.w), pk2(c_.x, c_.y), pk2(c_.z, c_.w)), qf[ks], acc); } \
      QA = mk8(pk2(acc[0], acc[1]), pk2(acc[2], acc[3]), pk2(acc[4], acc[5]), pk2(acc[6], acc[7])); \
      QB = mk8(pk2(acc[8], acc[9]), pk2(acc[10], acc[11]), pk2(acc[12], acc[13]), pk2(acc[14], acc[15])); }
    QABS(0, qa0, qa1) QABS(1, qa2, qa3) QABS(2, qa4, qa5) QABS(3, qa6, qa7)
#undef QABS
  }
  float m_run = -1e30f, l_run = 0.f;
  f32x16 o0 = zero16(), o1 = zero16(), o2 = zero16(), o3 = zero16();
  bf16x8 qf7 = mk8(0u, 0u, 0u, 0u);
  const bf16x8 kone = mk8(hh == 0 ? 0x3F80u : 0u, 0u, 0u, 0u);
  const int xk = ((l31 & 3) << 2) | ((l31 >> 2) & 3), x3 = (l31 >> 2) & 3;
  int va0, va1;
  {
    const int g = l31 >> 4, q = (l31 >> 2) & 3, pp = l31 & 3;
    const int rowb = (4 * hh + q) * 256 + 8 * (pp & 1) + (q << 6);
    va0 = rowb + (((2 * g + (pp >> 1)) ^ hh) << 4);
    va1 = rowb + 2048 + (((2 * g + (pp >> 1)) ^ (hh + 2)) << 4);
  }
  int stg = 0, stg2 = 2;
  for (int ti = 0; ti < 17; ++ti) {
    if (ti + 1 < 17) asm volatile("s_waitcnt vmcnt(5)" ::: "memory"); else asm volatile("s_waitcnt vmcnt(0)" ::: "memory");
    RAW_BARRIER()
    if (ti + 2 < 17) SDMA(ti + 2, stg2)
    const char* sp = lds + stg * 20480;
    f32x16 s0 = mfma32(kone, qf7, zero16()), s1 = s0;
#define QKL(S, QA) { const bf16x8 k0 = *(const bf16x8*)(sp + l31 * 256 + (((2 * (S) + hh) ^ xk) << 4)), k1 = *(const bf16x8*)(sp + (l31 + 32) * 256 + (((2 * (S) + hh) ^ xk) << 4)); \
      s0 = mfma32(k0, QA, s0); s1 = mfma32(k1, QA, s1); }
    QKL(0, qa0) QKL(1, qa1) QKL(2, qa2) QKL(3, qa3) QKL(4, qa4) QKL(5, qa5) QKL(6, qa6) QKL(7, qa7)
#undef QKL
#pragma unroll
    for (int kr = 0; kr < 2; ++kr) {
      const bf16x8 k0 = *(const bf16x8*)(sp + 16384 + l31 * 64 + (((2 * kr + hh) ^ x3) << 4)), k1 = *(const bf16x8*)(sp + 16384 + (l31 + 32) * 64 + (((2 * kr + hh) ^ x3) << 4));
      s0 = mfma32(k0, qf[4 + kr], s0); s1 = mfma32(k1, qf[4 + kr], s1);
    }
    float ps = 0.f;
    if (ti == 0) {
      float mx = s0[0];
#pragma unroll
      for (int r = 1; r < 16; ++r) mx = fmaxf(mx, s0[r]);
#pragma unroll
      for (int r = 0; r < 16; ++r) mx = fmaxf(mx, s1[r]);
      mx = fmaxf(mx, __shfl_xor(mx, 32));
      m_run = bflo(pk2(mx, 0.f));
#pragma unroll
      for (int r = 0; r < 16; ++r) { s0[r] -= m_run; s1[r] -= m_run; }
      qf7 = mk8(hh == 0 ? (pk2(-m_run, 0.f) & 0xffffu) : 0u, 0u, 0u, 0u);
    }
#pragma unroll
    for (int r = 0; r < 16; ++r) { s0[r] = __builtin_amdgcn_exp2f(s0[r]); ps += s0[r]; }
#pragma unroll
    for (int r = 0; r < 16; ++r) { s1[r] = __builtin_amdgcn_exp2f(s1[r]); ps += s1[r]; }
    l_run += ps;
    const bf16x8 pf0 = mk8(pk2(s0[0], s0[1]), pk2(s0[2], s0[3]), pk2(s0[4], s0[5]), pk2(s0[6], s0[7]));
    const bf16x8 pf1 = mk8(pk2(s0[8], s0[9]), pk2(s0[10], s0[11]), pk2(s0[12], s0[13]), pk2(s0[14], s0[15]));
    const bf16x8 pf2 = mk8(pk2(s1[0], s1[1]), pk2(s1[2], s1[3]), pk2(s1[4], s1[5]), pk2(s1[6], s1[7]));
    const bf16x8 pf3 = mk8(pk2(s1[8], s1[9]), pk2(s1[10], s1[11]), pk2(s1[12], s1[13]), pk2(s1[14], s1[15]));
#define PVT(S, CT, PF, OT) { const uint2 a_ = lds_tr16(sp + (va0 ^ ((CT) << 6)) + (S) * 4096), b_ = lds_tr16(sp + (va1 ^ ((CT) << 6)) + (S) * 4096); \
      OT = mfma32(mk8(a_.x, a_.y, b_.x, b_.y), PF, OT); }
#define PVL(S, PF) PVT(S, 0, PF, o0) PVT(S, 1, PF, o1) PVT(S, 2, PF, o2) PVT(S, 3, PF, o3)
    PVL(0, pf0) PVL(1, pf1) PVL(2, pf2) PVL(3, pf3)
#undef PVL
#undef PVT
    stg = stg == 2 ? 0 : stg + 1; stg2 = stg2 == 2 ? 0 : stg2 + 1;
  }
#undef SDMA
#undef GLDS16
  __syncthreads();
  const float lt = l_run + __shfl_xor(l_run, 32);
  const float inv = 1.f / lt;
  f32x16 e0 = zero16(), e1 = zero16();
  const bf16_t* wv = p.Wb_ukv + ((size_t)L * 1024 + head * 128 + 64 + l31) * 128 + 8 * hh;
#define OEXP(S, OT, RB) { const bf16x8 ob = mk8(pk2(OT[RB] * inv, OT[RB + 1] * inv), pk2(OT[RB + 2] * inv, OT[RB + 3] * inv), pk2(OT[RB + 4] * inv, OT[RB + 5] * inv), pk2(OT[RB + 6] * inv, OT[RB + 7] * inv)); \
    e0 = mfma32(*(const bf16x8*)(wv + 16 * (S)), ob, e0); e1 = mfma32(*(const bf16x8*)(wv + 32 * 128 + 16 * (S)), ob, e1); }
  OEXP(0, o0, 0) OEXP(1, o0, 8) OEXP(2, o1, 0) OEXP(3, o1, 8) OEXP(4, o2, 0) OEXP(5, o2, 8) OEXP(6, o3, 0) OEXP(7, o3, 8)
#undef OEXP
  {
    const bf16_t* gbp = p.zL + (size_t)myrow * ZL + ZL_GB + 64 * head;
    bf16_t* op = mix + (size_t)myrow * D + 256 + 64 * head;
#pragma unroll
    for (int G = 0; G < 4; ++G) {
      const int d = 8 * G + 4 * hh;
      const uint2 g0 = *(const uint2*)(gbp + d), g1 = *(const uint2*)(gbp + 32 + d);
      *(uint2*)(op + d) = pk4(e0[4 * G] * silu_(bflo(g0.x)), e0[4 * G + 1] * silu_(bfhi(g0.x)), e0[4 * G + 2] * silu_(bflo(g0.y)), e0[4 * G + 3] * silu_(bfhi(g0.y)));
      *(uint2*)(op + 32 + d) = pk4(e1[4 * G] * silu_(bflo(g1.x)), e1[4 * G + 1] * silu_(bfhi(g1.x)), e1[4 * G + 2] * silu_(bflo(g1.y)), e1[4 * G + 3] * silu_(bfhi(g1.y)));
    }
  }
}

DEV void conv_item(const Prm& p, int L, int item) {
  int tid = threadIdx.x; LAUNDER(tid);
  bf16_t* mix = p.zE;
  const int c0 = (tid & 31) * 8;
  float w0[8], w1[8], w2[8];
#pragma unroll
  for (int e = 0; e < 8; ++e) { w0[e] = p.conv_w[(L * 3 + 0) * 256 + c0 + e]; w1[e] = p.conv_w[(L * 3 + 1) * 256 + c0 + e]; w2[e] = p.conv_w[(L * 3 + 2) * 256 + c0 + e]; }
  for (int it = 0; it < 4; ++it) {
    const int R = item * 32 + it * 8 + (tid >> 5);
    if (R >= NT) continue;
    int q, T; const float* st; float* so;
    if (R < NPR) { const int s = R / PT; q = R - s * PT; T = PT; st = nullptr; so = p.conv_p + ((size_t)L * 4 + s) * 512; }
    else { const int b = (R - NPR) >> 6; q = (R - NPR) & 63; T = 64; st = p.state_conv + ((size_t)L * 32 + b) * 512; so = p.conv_s + ((size_t)L * 32 + b) * 512; }
    float u[3][8];
#pragma unroll
    for (int dlt = 0; dlt < 3; ++dlt) {
      const int t = q - 2 + dlt;
      if (t >= 0) {
        const bf16_t* zr = p.zL + (size_t)(R - 2 + dlt) * ZL;
        const uint4 xi = *(const uint4*)(zr + ZL_XIN + c0), cg = *(const uint4*)(zr + ZL_CG + c0);
        u[dlt][0] = bflo(xi.x) * bflo(cg.x); u[dlt][1] = bfhi(xi.x) * bfhi(cg.x); u[dlt][2] = bflo(xi.y) * bflo(cg.y); u[dlt][3] = bfhi(xi.y) * bfhi(cg.y);
        u[dlt][4] = bflo(xi.z) * bflo(cg.z); u[dlt][5] = bfhi(xi.z) * bfhi(cg.z); u[dlt][6] = bflo(xi.w) * bflo(cg.w); u[dlt][7] = bfhi(xi.w) * bfhi(cg.w);
      } else if (st) {
        const float* sr = st + (t + 2) * 256 + c0;
#pragma unroll
        for (int e = 0; e < 8; ++e) u[dlt][e] = sr[e];
      } else {
#pragma unroll
        for (int e = 0; e < 8; ++e) u[dlt][e] = 0.f;
      }
    }
    const bf16_t* zr = p.zL + (size_t)R * ZL;
    const uint4 bg = *(const uint4*)(zr + ZL_BG + c0), ga = *(const uint4*)(zr + ZL_GA + c0);
    const float bgf[8] = {bflo(bg.x), bfhi(bg.x), bflo(bg.y), bfhi(bg.y), bflo(bg.z), bfhi(bg.z), bflo(bg.w), bfhi(bg.w)};
    const float gaf[8] = {bflo(ga.x), bfhi(ga.x), bflo(ga.y), bfhi(ga.y), bflo(ga.z), bfhi(ga.z), bflo(ga.w), bfhi(ga.w)};
    float y[8];
#pragma unroll
    for (int e = 0; e < 8; ++e) y[e] = bgf[e] * (w0[e] * u[0][e] + w1[e] * u[1][e] + w2[e] * u[2][e]) * silu_(gaf[e]);
    uint4 o; o.x = pk2(y[0], y[1]); o.y = pk2(y[2], y[3]); o.z = pk2(y[4], y[5]); o.w = pk2(y[6], y[7]);
    *(uint4*)(mix + (size_t)R * D + c0) = o;
    if (q >= T - 2) {
      float* d = so + (q - (T - 2)) * 256 + c0;
#pragma unroll
      for (int e = 0; e < 8; ++e) d[e] = u[2][e];
    }
  }
}

DEV int kperm_addr(int m, int kin) {
  const int mt = m >> 4, ml = m & 15, s = kin >> 5, q = (kin >> 4) & 1, g = (kin >> 2) & 3, e = kin & 3;
  return (((mt * 2 + s) * 64 + ml + 16 * g) * 8) + 4 * q + e;
}
DEV int clay_addr(int x, int v) {
  const int xt = x >> 4, g = (x >> 2) & 3, rr = x & 3, vt = v >> 4, l16 = v & 15;
  return ((xt * 4 + vt) * 64 + 16 * g + l16) * 4 + rr;
}
DEV void mm64(const bf16_t* first, const bf16_t* second, int l31, int hh, f32x16 (&acc)[2][2]) {
#pragma unroll
  for (int ks = 0; ks < 4; ++ks) {
    const bf16x8 f0 = *(const bf16x8*)(first + l31 * 72 + ks * 16 + hh * 8), f1 = *(const bf16x8*)(first + (32 + l31) * 72 + ks * 16 + hh * 8);
    const bf16x8 s0 = *(const bf16x8*)(second + l31 * 72 + ks * 16 + hh * 8), s1 = *(const bf16x8*)(second + (32 + l31) * 72 + ks * 16 + hh * 8);
    acc[0][0] = mfma32(f0, s0, acc[0][0]); acc[0][1] = mfma32(f0, s1, acc[0][1]);
    acc[1][0] = mfma32(f1, s0, acc[1][0]); acc[1][1] = mfma32(f1, s1, acc[1][1]);
  }
}
DEV void mm64x32(const bf16_t* first, const bf16_t* second_rows, int l31, int hh, f32x16 (&acc)[2]) {
#pragma unroll
  for (int ks = 0; ks < 4; ++ks) {
    const bf16x8 f0 = *(const bf16x8*)(first + l31 * 72 + ks * 16 + hh * 8), f1 = *(const bf16x8*)(first + (32 + l31) * 72 + ks * 16 + hh * 8);
    const bf16x8 s0 = *(const bf16x8*)(second_rows + l31 * 72 + ks * 16 + hh * 8);
    acc[0] = mfma32(f0, s0, acc[0]); acc[1] = mfma32(f1, s0, acc[1]);
  }
}

DEV void mmq(const bf16_t* first_rows, const bf16_t* second_rows, int l31, int hh, f32x16& acc) {
#pragma unroll
  for (int ks = 0; ks < 4; ++ks) {
    const bf16x8 f0 = *(const bf16x8*)(first_rows + l31 * 72 + ks * 16 + hh * 8);
    const bf16x8 s0 = *(const bf16x8*)(second_rows + l31 * 72 + ks * 16 + hh * 8);
    acc = mfma32(f0, s0, acc);
  }
}
enum { SH_FULL = 0, SH_UP = 1, SH_LO = 2 };
template <int SH> DEV constexpr bool tile_nz(int tx, int ty) { return SH == SH_FULL || (SH == SH_UP ? tx <= ty : tx >= ty); }
struct Acc64 { f32x16 t[2][2]; };
struct Frag64 { bf16x8 f[4][2]; };
template <int SS> DEV bf16x8 pack8(const f32x16& v) {
  return mk8(pk2(v[8 * SS], v[8 * SS + 1]), pk2(v[8 * SS + 2], v[8 * SS + 3]), pk2(v[8 * SS + 4], v[8 * SS + 5]), pk2(v[8 * SS + 6], v[8 * SS + 7]));
}
template <int SH> DEV void to_frag(const Acc64& X, Frag64& F) {
#pragma unroll
  for (int t = 0; t < 2; ++t) {
    if (tile_nz<SH>(0, t)) { F.f[0][t] = pack8<0>(X.t[0][t]); F.f[1][t] = pack8<1>(X.t[0][t]); }
    if (tile_nz<SH>(1, t)) { F.f[2][t] = pack8<0>(X.t[1][t]); F.f[3][t] = pack8<1>(X.t[1][t]); }
  }
}
template <int SH> DEV void zero_acc(Acc64& X) {
#pragma unroll
  for (int a = 0; a < 2; ++a)
#pragma unroll
    for (int b = 0; b < 2; ++b) if (tile_nz<SH>(a, b)) X.t[a][b] = zero16();
}
template <int SHA, int SHB> DEV void prod_ff(const Frag64& A, const Frag64& B, Acc64& D) {
#pragma unroll
  for (int tm = 0; tm < 2; ++tm)
#pragma unroll
    for (int tn = 0; tn < 2; ++tn)
#pragma unroll
      for (int s = 0; s < 4; ++s)
        if (tile_nz<SHA>(s >> 1, tm) && tile_nz<SHB>(s >> 1, tn)) D.t[tm][tn] = mfma32(A.f[s][tm], B.f[s][tn], D.t[tm][tn]);
}
template <int SHA, int SHB, int SHD> DEV void prod_ff_frag(const Frag64& A, const Frag64& B, Frag64& Fo) {
#pragma unroll
  for (int tm = 0; tm < 2; ++tm)
#pragma unroll
    for (int tn = 0; tn < 2; ++tn)
      if (tile_nz<SHD>(tm, tn)) {
        f32x16 acc = zero16();
#pragma unroll
        for (int s = 0; s < 4; ++s)
          if (tile_nz<SHA>(s >> 1, tm) && tile_nz<SHB>(s >> 1, tn)) acc = mfma32(A.f[s][tm], B.f[s][tn], acc);
        Fo.f[2 * tm][tn] = pack8<0>(acc); Fo.f[2 * tm + 1][tn] = pack8<1>(acc);
      }
}
DEV bf16x8 nat_frag(const bf16_t* S, int row, int s, int hh) { return *(const bf16x8*)(S + row * 72 + 16 * s + 8 * hh); }
DEV bf16x8 perm_frag(const bf16_t* S, int row, int s, int hh) {
  const uint2 a = *(const uint2*)(S + row * 72 + 16 * s + 4 * hh), b = *(const uint2*)(S + row * 72 + 16 * s + 8 + 4 * hh);
  return mk8(a.x, a.y, b.x, b.y);
}
template <int SH, int MODE> DEV void gram(const bf16_t* F, const bf16_t* G, int l31, int hh, Acc64& D) {
  zero_acc<SH>(D);
#pragma unroll
  for (int s = 0; s < 4; ++s) {
    bf16x8 ff[2], gg[2];
#pragma unroll
    for (int t = 0; t < 2; ++t) { ff[t] = nat_frag(F, 32 * t + l31, s, hh); gg[t] = nat_frag(G, 32 * t + l31, s, hh); }
#pragma unroll
    for (int tx = 0; tx < 2; ++tx)
#pragma unroll
      for (int ty = 0; ty < 2; ++ty) if (tile_nz<SH>(tx, ty)) D.t[tx][ty] = mfma32(ff[tx], gg[ty], D.t[tx][ty]);
  }
#pragma unroll
  for (int t = 0; t < 2; ++t)
#pragma unroll
    for (int r = 0; r < 16; ++r) {
      const int x = (r & 3) + 8 * (r >> 2) + 4 * hh, y = l31;
      const bool keep = MODE == 0 ? (x < y) : (MODE == 1 ? (y < x) : (x <= y));
      if (!keep) D.t[t][t][r] = 0.f;
    }
}
template <int SHA> DEV void prod_fm_frag(const Frag64& A, const bf16_t* Mem, int l31, int hh, Frag64& Fo) {
#pragma unroll
  for (int tm = 0; tm < 2; ++tm)
#pragma unroll
    for (int tn = 0; tn < 2; ++tn) {
      f32x16 acc = zero16();
#pragma unroll
      for (int s = 0; s < 4; ++s) if (tile_nz<SHA>(s >> 1, tm)) acc = mfma32(A.f[s][tm], perm_frag(Mem, 32 * tn + l31, s, hh), acc);
      Fo.f[2 * tm][tn] = pack8<0>(acc); Fo.f[2 * tm + 1][tn] = pack8<1>(acc);
    }
}
template <int SHA> DEV void prod_fm(const Frag64& A, const bf16_t* Mem, int l31, int hh, Acc64& D) {
#pragma unroll
  for (int s = 0; s < 4; ++s) {
    bf16x8 mm[2];
#pragma unroll
    for (int t = 0; t < 2; ++t) mm[t] = perm_frag(Mem, 32 * t + l31, s, hh);
#pragma unroll
    for (int tm = 0; tm < 2; ++tm)
#pragma unroll
      for (int tn = 0; tn < 2; ++tn) if (tile_nz<SHA>(s >> 1, tm)) D.t[tm][tn] = mfma32(A.f[s][tm], mm[tn], D.t[tm][tn]);
  }
}
DEV void r1_item(const Prm& p, int L, int idx, char* lds) {
  int tid = threadIdx.x; LAUNDER(tid);
  const int w = __builtin_amdgcn_readfirstlane(tid >> 6);
  int lane = tid & 63, l31 = lane & 31, hh = lane >> 5;
  const int cw = w & 1, tw = w >> 1;
  bf16_t* S0 = (bf16_t*)lds;
  bf16_t* S1 = S0 + 4608; bf16_t* S2 = S1 + 4608; bf16_t* S3 = S2 + 4608; bf16_t* S4 = S3 + 4608; bf16_t* S5 = S4 + 4608; bf16_t* S6 = S5 + 4608; bf16_t* S7 = S6 + 4608;
  float* misc = (float*)(S7 + 4608);
  float* Ef = (float*)S4;
  bool prompt; int st, c, hd;
  if (idx < NRW_P) { prompt = true; st = idx / 260; const int rem = idx - st * 260; c = rem >> 2; hd = rem & 3; }
  else { prompt = false; const int j = idx - NRW_P; st = j >> 2; hd = j & 3; c = 0; }
  char* rwp = p.rw + (size_t)idx * RW_BYTES;
  const float* mu = p.shift_mu + L * 896;
  const int i1 = tid >> 2, m0 = (tid & 3) * 16;
  int R1; bool valid1, hasprev1;
  if (prompt) { const int pp = 64 * c - 48 + i1; valid1 = pp >= 0; R1 = st * PT + (valid1 ? pp : 0); hasprev1 = pp >= 1; }
  else { R1 = NPR + 64 * st + i1; valid1 = true; hasprev1 = i1 >= 1; }
  const bf16_t* zr1 = p.zE + (size_t)R1 * ZE + ZE_ZC;
  const int ti0 = 32 * tw + l31;
  int R; bool valid, hasprev;
  if (prompt) { const int pp = 64 * c - 48 + ti0; valid = pp >= 0; R = st * PT + (valid ? pp : 0); hasprev = pp >= 1; }
  else { R = NPR + 64 * st + ti0; valid = true; hasprev = ti0 >= 1; }
  const bf16_t* zr = p.zE + (size_t)R * ZE + ZE_ZC;
  const int chb = 64 * hd + 32 * cw + 4 * hh;
  uint4 la[2][2], lap[2][2]; uint2 lb[3][4], lbp[3][4];
  {
    const bf16_t* sh0 = p.zE + (size_t)(NT + (prompt ? 32 : st)) * ZE + ZE_ZC;
    const bf16_t* zp1 = hasprev1 ? zr1 - ZE : sh0;
    const bf16_t* zp = hasprev ? zr - ZE : sh0;
#pragma unroll
    for (int part = 0; part < 2; ++part)
#pragma unroll
      for (int h8 = 0; h8 < 2; ++h8) { const int col = 768 + 64 * part + m0 + 8 * h8; la[part][h8] = *(const uint4*)(zr1 + col); lap[part][h8] = *(const uint4*)(zp1 + col); }
#pragma unroll
    for (int part = 0; part < 3; ++part)
#pragma unroll
      for (int G = 0; G < 4; ++G) { const int col = 256 * part + chb + 8 * G; lb[part][G] = *(const uint2*)(zr + col); lbp[part][G] = *(const uint2*)(zp + col); }
    const bf16_t* dsrc = p.dw2T + ((size_t)L * 256 + hd * 64 + i1) * 64 + m0;
    const bf16_t* isrc = p.ia2T + ((size_t)L * 256 + hd * 64 + i1) * 64 + m0;
    const uint4 d0 = *(const uint4*)dsrc, d1 = *(const uint4*)(dsrc + 8), e0 = *(const uint4*)isrc, e1 = *(const uint4*)(isrc + 8);
    __builtin_amdgcn_sched_barrier(0);
    *(uint4*)(S2 + i1 * 72 + m0) = d0; *(uint4*)(S2 + i1 * 72 + m0 + 8) = d1;
    *(uint4*)(S3 + i1 * 72 + m0) = e0; *(uint4*)(S3 + i1 * 72 + m0 + 8) = e1;
  }
  {
    float* prm = misc + 384;
#pragma unroll
    for (int q2 = 0; q2 < 2; ++q2) {
      const int ix = tid + 256 * q2, wh = ix >> 6, chp = ix & 63;
      const float* sp = wh == 0 ? p.decay_w0 : wh == 1 ? p.iclr_a0 : wh == 2 ? p.key_kk : wh == 3 ? p.key_ka : wh == 4 ? p.bonus_rk : nullptr;
      prm[ix] = sp ? sp[L * 256 + hd * 64 + chp] : mu[256 * (wh - 5) + 64 * hd + chp];
    }
  }
#pragma unroll
  for (int part = 0; part < 2; ++part) {
#pragma unroll
    for (int h8 = 0; h8 < 2; ++h8) {
      const int col = 768 + 64 * part + m0 + 8 * h8;
      const uint4 u = la[part][h8], v = lap[part][h8];
      const float cur[8] = {bflo(u.x), bfhi(u.x), bflo(u.y), bfhi(u.y), bflo(u.z), bfhi(u.z), bflo(u.w), bfhi(u.w)};
      float prv[8] = {bflo(v.x), bfhi(v.x), bflo(v.y), bfhi(v.y), bflo(v.z), bfhi(v.z), bflo(v.w), bfhi(v.w)};
      float o[8];
#pragma unroll
      for (int e = 0; e < 8; ++e) { float z = cur[e] + (prv[e] - cur[e]) * mu[col + e]; if (!valid1) z = 0.f; o[e] = part == 0 ? (1.f - 2.f / (__expf(2.f * z) + 1.f)) : z; }
      uint4 a; a.x = pk2(o[0], o[1]); a.y = pk2(o[2], o[3]); a.z = pk2(o[4], o[5]); a.w = pk2(o[6], o[7]);
      *(uint4*)((part == 0 ? S0 : S1) + i1 * 72 + m0 + 8 * h8) = a;
    }
  }
  __syncthreads();
  f32x16 accw = zero16(), acca = zero16();
#pragma unroll
  for (int ks = 0; ks < 4; ++ks) {
    const bf16x8 fw = *(const bf16x8*)(S2 + (32 * cw + l31) * 72 + ks * 16 + hh * 8), fa = *(const bf16x8*)(S3 + (32 * cw + l31) * 72 + ks * 16 + hh * 8);
    const bf16x8 sw = *(const bf16x8*)(S0 + (32 * tw + l31) * 72 + ks * 16 + hh * 8), sa = *(const bf16x8*)(S1 + (32 * tw + l31) * 72 + ks * 16 + hh * 8);
    accw = mfma32(fw, sw, accw); acca = mfma32(fa, sa, acca);
  }
  int ti = ti0;
  float e_[16];
  float ssq = 0.f;
#pragma unroll
  for (int G = 0; G < 4; ++G) {
    const int ch = chb + 8 * G, col = 256 + ch;
    const uint2 u = lb[1][G], v = lbp[1][G];
    const float cur[4] = {bflo(u.x), bfhi(u.x), bflo(u.y), bfhi(u.y)};
    float prv[4] = {bflo(v.x), bfhi(v.x), bflo(v.y), bfhi(v.y)};
    const int chq = 32 * cw + 8 * G + 4 * hh;
    const float4 kkw = *(const float4*)(misc + 384 + 128 + chq), w0 = *(const float4*)(misc + 384 + chq), m4 = *(const float4*)(misc + 384 + 384 + chq);
    const float kkv[4] = {kkw.x, kkw.y, kkw.z, kkw.w}, w0v[4] = {w0.x, w0.y, w0.z, w0.w}, muv[4] = {m4.x, m4.y, m4.z, m4.w};
#pragma unroll
    for (int e = 0; e < 4; ++e) {
      float z = cur[e] + (prv[e] - cur[e]) * muv[e];
      if (!valid) z = 0.f;
      const float kkr = z * kkv[e];
      ssq += kkr * kkr;
      e_[4 * G + e] = valid ? 0.6065306597126334f * sigmoid_(w0v[e] + accw[4 * G + e]) : 0.f;
    }
  }
  ssq += __shfl_xor(ssq, 32);
  if (hh == 0) misc[(cw * 64 + ti) * 2] = ssq;
#pragma unroll
  for (int G = 0; G < 4; ++G)
#pragma unroll
    for (int e = 0; e < 4; ++e) Ef[ti * 65 + 32 * cw + 8 * G + 4 * hh + e] = e_[4 * G + e];
  __syncthreads();
  {
    const int ch = tid & 63, seg = tid >> 6;
    float run = 0.f;
#pragma unroll
    for (int t = 0; t < 16; ++t) { run += Ef[(16 * seg + t) * 65 + ch]; Ef[(16 * seg + t) * 65 + ch] = run; }
    __syncthreads();
    float off = 0.f;
    for (int s2 = 0; s2 < seg; ++s2) off += Ef[(16 * s2 + 15) * 65 + ch];
    __syncthreads();
#pragma unroll
    for (int t = 0; t < 16; ++t) Ef[(16 * seg + t) * 65 + ch] += off;
    if (seg == 3) { const float cC = Ef[63 * 65 + ch]; misc[320 + ch] = cC; misc[256 + ch] = __expf(-cC); }
    __syncthreads();
  }
  float cc_[16];
#pragma unroll
  for (int G = 0; G < 4; ++G)
#pragma unroll
    for (int e = 0; e < 4; ++e) cc_[4 * G + e] = Ef[ti * 65 + 32 * cw + 8 * G + 4 * hh + e];
  const float kinv = 1.f / fmaxf(sqrtf(misc[ti * 2] + misc[(64 + ti) * 2]), 1e-12f);
  __syncthreads();
  LAUNDER(ti); LAUNDER(hh);
  uint2 vpk[4];
  float rk = 0.f;
#pragma unroll
  for (int G = 0; G < 4; ++G) {
    const int ch = chb + 8 * G, chl = 32 * cw + 8 * G + 4 * hh;
    float zs[3][4];
#pragma unroll
    for (int part = 0; part < 3; ++part) {
      const int col = 256 * part + ch;
      const uint2 u = lb[part][G], v = lbp[part][G];
      const float cur[4] = {bflo(u.x), bfhi(u.x), bflo(u.y), bfhi(u.y)};
      float prv[4] = {bflo(v.x), bfhi(v.x), bflo(v.y), bfhi(v.y)};
      const float4 m4 = *(const float4*)(misc + 384 + 320 + 64 * part + chl);
      const float muv[4] = {m4.x, m4.y, m4.z, m4.w};
#pragma unroll
      for (int e = 0; e < 4; ++e) { float z = cur[e] + (prv[e] - cur[e]) * muv[e]; zs[part][e] = valid ? z : 0.f; }
    }
    vpk[G] = pk4(zs[2][0], zs[2][1], zs[2][2], zs[2][3]);
    const float4 a04 = *(const float4*)(misc + 384 + 64 + chl), kk4 = *(const float4*)(misc + 384 + 128 + chl), ka4 = *(const float4*)(misc + 384 + 192 + chl), bo4 = *(const float4*)(misc + 384 + 256 + chl);
    const float a0v[4] = {a04.x, a04.y, a04.z, a04.w}, kkv[4] = {kk4.x, kk4.y, kk4.z, kk4.w}, kav[4] = {ka4.x, ka4.y, ka4.z, ka4.w}, bov[4] = {bo4.x, bo4.y, bo4.z, bo4.w};
    float at[4], rt[4], bt[4], kt[4], bh[4], kh[4];
#pragma unroll
    for (int e = 0; e < 4; ++e) {
      const int r = 4 * G + e;
      const float al = sigmoid_(a0v[e] + acca[r]);
      const float kk = zs[1][e] * kkv[e] * kinv;
      const float km = zs[1][e] * (1.f + (al - 1.f) * kav[e]);
      rk += zs[0][e] * km * bov[e];
      const float gC = misc[256 + chl + e];
      const float cprev = cc_[r] - e_[r];
      const float ea = __expf(-cprev), er = __expf(-cc_[r]), ek = __builtin_amdgcn_rcpf(er), eh = ek * gC;
      const float b = kk * al;
      at[e] = -kk * ea; rt[e] = zs[0][e] * er; bt[e] = b * ek; kt[e] = km * ek; bh[e] = b * eh; kh[e] = km * eh;
    }
    *(uint2*)(S0 + ti * 72 + chl) = pk4(at[0], at[1], at[2], at[3]);
    *(uint2*)(S1 + ti * 72 + chl) = pk4(rt[0], rt[1], rt[2], rt[3]);
    *(uint2*)(S2 + ti * 72 + chl) = pk4(bt[0], bt[1], bt[2], bt[3]);
    *(uint2*)(S3 + ti * 72 + chl) = pk4(kt[0], kt[1], kt[2], kt[3]);
#pragma unroll
    for (int e = 0; e < 4; ++e) { S4[(chl + e) * 72 + ti] = f2bf(at[e]); S5[(chl + e) * 72 + ti] = f2bf(bh[e]); S6[(chl + e) * 72 + ti] = f2bf(kh[e]); S7[(chl + e) * 72 + ti] = f2bf(zs[2][e]); }
    *(uint2*)(rwp + 40960 + (ti * 64 + chl) * 2) = vpk[G];
  }
  rk += __shfl_xor(rk, 32);
  if (hh == 0) misc[(cw * 64 + ti) * 2 + 1] = rk;
  __syncthreads();
  if (valid && cw == 0 && hh == 0) p.rkb[(size_t)R * 4 + hd] = misc[ti * 2 + 1] + misc[(64 + ti) * 2 + 1];
  LAUNDER(l31); LAUNDER(hh); LAUNDER(lane);
  {
    Acc64 T;
    {
      Acc64 Mx, MTx;
      gram<SH_UP, 0>(S2, S0, l31, hh, Mx);
      gram<SH_LO, 1>(S0, S2, l31, hh, MTx);
      Frag64 fM, fMT, fT;
      to_frag<SH_UP>(Mx, fM); to_frag<SH_LO>(MTx, fMT);
      __builtin_amdgcn_sched_barrier(0);
      T = Mx;
#pragma unroll
      for (int t = 0; t < 2; ++t)
#pragma unroll
        for (int r = 0; r < 16; ++r) if ((r & 3) + 8 * (r >> 2) + 4 * hh == l31) T.t[t][t][r] += 1.f;
      T.t[1][0] = zero16();
      for (int r = 0; r < 5; ++r) {
        Frag64 fM2, fMT2;
        prod_ff_frag<SH_LO, SH_UP, SH_UP>(fMT, fM, fM2);
        prod_ff_frag<SH_UP, SH_LO, SH_LO>(fM, fMT, fMT2);
#pragma unroll
        for (int s = 0; s < 4; ++s)
#pragma unroll
          for (int t = 0; t < 2; ++t) { if (tile_nz<SH_UP>(s >> 1, t)) fM.f[s][t] = fM2.f[s][t]; if (tile_nz<SH_LO>(s >> 1, t)) fMT.f[s][t] = fMT2.f[s][t]; }
        to_frag<SH_UP>(T, fT);
        prod_ff<SH_LO, SH_UP>(fMT, fT, T);
      }
    }
    Frag64 fT;
    to_frag<SH_UP>(T, fT);
    __builtin_amdgcn_sched_barrier(0);
    if (w < 2) {
      Frag64 fW;
      prod_fm_frag<SH_UP>(fT, S4, l31, hh, fW);
      __builtin_amdgcn_sched_barrier(0);
      Acc64 O; zero_acc<SH_FULL>(O);
      if (w == 0) {
        prod_fm<SH_FULL>(fW, S5, l31, hh, O);
#pragma unroll
        for (int tx = 0; tx < 2; ++tx)
#pragma unroll
          for (int ty = 0; ty < 2; ++ty)
#pragma unroll
            for (int G = 0; G < 4; ++G) {
              const int x0 = 32 * tx + 8 * G + 4 * hh, y = 32 * ty + l31;
              float v[4];
#pragma unroll
              for (int e = 0; e < 4; ++e) { v[e] = O.t[tx][ty][4 * G + e]; if (x0 + e == y) v[e] += misc[256 + y]; }
              *(uint2*)(rwp + 0 + kperm_addr(y, x0) * 2) = pk4(v[0], v[1], v[2], v[3]);
            }
      } else {
        Acc64 Nb; gram<SH_UP, 2>(S2, S1, l31, hh, Nb);
        Frag64 fN; to_frag<SH_UP>(Nb, fN);
        prod_ff<SH_FULL, SH_UP>(fW, fN, O);
#pragma unroll
        for (int tx = 0; tx < 2; ++tx)
#pragma unroll
          for (int ty = 0; ty < 2; ++ty)
#pragma unroll
            for (int G = 0; G < 4; ++G) {
              const int x0 = 32 * tx + 8 * G + 4 * hh, y = 32 * ty + l31;
              const uint2 rr = *(const uint2*)(S1 + y * 72 + x0);
              *(uint2*)(rwp + 8192 + kperm_addr(y, x0) * 2) = pk4(O.t[tx][ty][4 * G] + bflo(rr.x), O.t[tx][ty][4 * G + 1] + bfhi(rr.x), O.t[tx][ty][4 * G + 2] + bflo(rr.y), O.t[tx][ty][4 * G + 3] + bfhi(rr.y));
            }
      }
    } else {
      Frag64 fX;
      {
        Acc64 Nk; gram<SH_LO, 1>(S0, S3, l31, hh, Nk);
        Frag64 fNk; to_frag<SH_LO>(Nk, fNk);
        prod_ff_frag<SH_UP, SH_LO, SH_LO>(fT, fNk, fX);
      }
      __builtin_amdgcn_sched_barrier(0);
      if (w == 2) {
        Acc64 Z; zero_acc<SH_FULL>(Z);
        prod_fm<SH_LO>(fX, S5, l31, hh, Z);
#pragma unroll
        for (int tx = 0; tx < 2; ++tx)
#pragma unroll
          for (int ty = 0; ty < 2; ++ty)
#pragma unroll
            for (int G = 0; G < 4; ++G) {
              const int x0 = 32 * tx + 8 * G + 4 * hh, y = 32 * ty + l31;
              const uint2 kk2 = *(const uint2*)(S6 + y * 72 + x0);
              Z.t[tx][ty][4 * G] += bflo(kk2.x); Z.t[tx][ty][4 * G + 1] += bfhi(kk2.x); Z.t[tx][ty][4 * G + 2] += bflo(kk2.y); Z.t[tx][ty][4 * G + 3] += bfhi(kk2.y);
            }
        Frag64 fZ; to_frag<SH_FULL>(Z, fZ);
        __builtin_amdgcn_sched_barrier(0);
        Acc64 Q; zero_acc<SH_FULL>(Q);
        prod_fm<SH_FULL>(fZ, S7, l31, hh, Q);
#pragma unroll
        for (int tx = 0; tx < 2; ++tx)
#pragma unroll
          for (int ty = 0; ty < 2; ++ty)
#pragma unroll
            for (int G = 0; G < 4; ++G)
              *(uint2*)(rwp + 16384 + clay_addr(32 * tx + 8 * G + 4 * hh, 32 * ty + l31) * 2) = pk4(Q.t[tx][ty][4 * G], Q.t[tx][ty][4 * G + 1], Q.t[tx][ty][4 * G + 2], Q.t[tx][ty][4 * G + 3]);
      } else {
        Acc64 H; gram<SH_UP, 2>(S3, S1, l31, hh, H);
        {
          Acc64 Nb; gram<SH_UP, 2>(S2, S1, l31, hh, Nb);
          Frag64 fN; to_frag<SH_UP>(Nb, fN);
          prod_ff<SH_LO, SH_UP>(fX, fN, H);
        }
        Frag64 fH; to_frag<SH_UP>(H, fH);
        __builtin_amdgcn_sched_barrier(0);
        Acc64 Y; zero_acc<SH_FULL>(Y);
        prod_fm<SH_UP>(fH, S7, l31, hh, Y);
#pragma unroll
        for (int tx = 0; tx < 2; ++tx)
#pragma unroll
          for (int ty = 0; ty < 2; ++ty)
#pragma unroll
            for (int G = 0; G < 4; ++G)
              *(uint2*)(rwp + 24576 + clay_addr(32 * tx + 8 * G + 4 * hh, 32 * ty + l31) * 2) = pk4(Y.t[tx][ty][4 * G], Y.t[tx][ty][4 * G + 1], Y.t[tx][ty][4 * G + 2], Y.t[tx][ty][4 * G + 3]);
      }
    }
  }
  __syncthreads();
}

DEV void r2_wave(const Prm& p, int L, int wi, int lane) {
  bool prompt; int st, hd, vt;
  if (wi < 64) { prompt = true; st = wi >> 4; hd = (wi >> 2) & 3; vt = wi & 3; }
  else { prompt = false; const int j = wi - 64; st = j >> 4; hd = (j >> 2) & 3; vt = j & 3; }
  const int nch = prompt ? 65 : 1;
  const int idx0 = prompt ? st * 260 + hd : NRW_P + st * 4 + hd;
  const int l16 = lane & 15, g = lane >> 4;
  f32x4 acc[4];
  float* outp;
  if (prompt) {
#pragma unroll
    for (int mt = 0; mt < 4; ++mt) acc[mt] = (f32x4){0.f, 0.f, 0.f, 0.f};
    outp = p.wkv_p + ((((size_t)L * 4 + st) * 4 + hd) * 64 + 16 * vt + l16) * 64;
  } else {
    const float* sp = p.state_wkv + ((((size_t)L * 32 + st) * 4 + hd) * 64 + 16 * vt + l16) * 64;
#pragma unroll
    for (int mt = 0; mt < 4; ++mt) acc[mt] = *(const f32x4*)(sp + 16 * mt + 4 * g);
    outp = p.wkv_s + ((((size_t)L * 32 + st) * 4 + hd) * 64 + 16 * vt + l16) * 64;
  }
  const char* rw0 = p.rw + (size_t)idx0 * RW_BYTES;
  uint4 pf[3][8]; uint2 qv[3][4];
#pragma unroll
  for (int k = 0; k < 3; ++k) {
    const int cc = k < nch ? k : nch - 1;
    const char* src = rw0 + (size_t)cc * 4 * RW_BYTES;
#pragma unroll
    for (int i = 0; i < 8; ++i) pf[k][i] = *(const uint4*)(src + (i * 64 + lane) * 16);
#pragma unroll
    for (int mt = 0; mt < 4; ++mt) qv[k][mt] = *(const uint2*)(src + 16384 + ((mt * 4 + vt) * 64 + lane) * 8);
  }
  for (int c0 = 0; c0 < nch; c0 += 3) {
#pragma unroll
    for (int k = 0; k < 3; ++k) {
      const int c = c0 + k;
      if (c < nch) {
        char* cur = (char*)rw0 + (size_t)c * 4 * RW_BYTES;
        uint4 bfr[2];
#pragma unroll
        for (int s = 0; s < 2; ++s) {
          bfr[s].x = pk2(acc[2 * s][0], acc[2 * s][1]); bfr[s].y = pk2(acc[2 * s][2], acc[2 * s][3]);
          bfr[s].z = pk2(acc[2 * s + 1][0], acc[2 * s + 1][1]); bfr[s].w = pk2(acc[2 * s + 1][2], acc[2 * s + 1][3]);
          *(uint4*)(cur + 32768 + ((vt * 2 + s) * 64 + lane) * 16) = bfr[s];
        }
#pragma unroll
        for (int mt = 0; mt < 4; ++mt) {
          f32x4 a = {bflo(qv[k][mt].x), bfhi(qv[k][mt].x), bflo(qv[k][mt].y), bfhi(qv[k][mt].y)};
#pragma unroll
          for (int s = 0; s < 2; ++s) a = mfma16(mk8(pf[k][mt * 2 + s]), mk8(bfr[s]), a);
          acc[mt] = a;
        }
        const int cn = c + 3 < nch ? c + 3 : nch - 1;
        const char* src = rw0 + (size_t)cn * 4 * RW_BYTES;
#pragma unroll
        for (int i = 0; i < 8; ++i) pf[k][i] = *(const uint4*)(src + (i * 64 + lane) * 16);
#pragma unroll
        for (int mt = 0; mt < 4; ++mt) qv[k][mt] = *(const uint2*)(src + 16384 + ((mt * 4 + vt) * 64 + lane) * 8);
      }
    }
  }
#pragma unroll
  for (int mt = 0; mt < 4; ++mt) *(f32x4*)(outp + 16 * mt + 4 * g) = acc[mt];
}

DEV void r3_wave(const Prm& p, int L, int idx, int lane, float* Y  ) {
  LAUNDER(lane);
  bool prompt; int st, c, hd;
  if (idx < NRW_P) { prompt = true; st = idx / 260; const int rem = idx - st * 260; c = rem >> 2; hd = rem & 3; }
  else { prompt = false; const int j = idx - NRW_P; st = j >> 2; hd = j & 3; c = 0; }
  const char* rwp = p.rw + (size_t)idx * RW_BYTES;
  const int l16 = lane & 15, g = lane >> 4;
  bf16_t* mix = p.zE;
  uint4 sf[4][2];
#pragma unroll
  for (int vt = 0; vt < 4; ++vt)
#pragma unroll
    for (int s = 0; s < 2; ++s) sf[vt][s] = *(const uint4*)(rwp + 32768 + ((vt * 2 + s) * 64 + lane) * 16);
  const float lw[4] = {p.lnx_w[L * 256 + hd * 64 + l16], p.lnx_w[L * 256 + hd * 64 + 16 + l16], p.lnx_w[L * 256 + hd * 64 + 32 + l16], p.lnx_w[L * 256 + hd * 64 + 48 + l16]};
  const float lb[4] = {p.lnx_b[L * 256 + hd * 64 + l16], p.lnx_b[L * 256 + hd * 64 + 16 + l16], p.lnx_b[L * 256 + hd * 64 + 32 + l16], p.lnx_b[L * 256 + hd * 64 + 48 + l16]};
#pragma unroll
  for (int it = 0; it < 4; ++it) {
    f32x4 y[4];
    const uint4 gf0 = *(const uint4*)(rwp + 8192 + ((it * 2 + 0) * 64 + lane) * 16), gf1 = *(const uint4*)(rwp + 8192 + ((it * 2 + 1) * 64 + lane) * 16);
#pragma unroll
    for (int vt = 0; vt < 4; ++vt) {
      const uint2 q = *(const uint2*)(rwp + 24576 + ((it * 4 + vt) * 64 + lane) * 8);
      f32x4 a = {bflo(q.x), bfhi(q.x), bflo(q.y), bfhi(q.y)};
      a = mfma16(mk8(gf0), mk8(sf[vt][0]), a);
      a = mfma16(mk8(gf1), mk8(sf[vt][1]), a);
      y[vt] = a;
    }
    __builtin_amdgcn_sched_barrier(0);
#pragma unroll
    for (int rr = 0; rr < 4; ++rr) {
      const int i = 16 * it + 4 * g + rr;
      float s1 = y[0][rr] + y[1][rr] + y[2][rr] + y[3][rr];
      s1 += __shfl_xor(s1, 1); s1 += __shfl_xor(s1, 2); s1 += __shfl_xor(s1, 4); s1 += __shfl_xor(s1, 8);
      const float mean = s1 * (1.f / 64.f);
      const float d0 = y[0][rr] - mean, d1 = y[1][rr] - mean, d2 = y[2][rr] - mean, d3 = y[3][rr] - mean;
      float s2 = d0 * d0 + d1 * d1 + d2 * d2 + d3 * d3;
      s2 += __shfl_xor(s2, 1); s2 += __shfl_xor(s2, 2); s2 += __shfl_xor(s2, 4); s2 += __shfl_xor(s2, 8);
      const float rstd = rsqrtf(s2 * (1.f / 64.f) + GN_EPS);
      Y[i * 68 + l16] = d0 * rstd * lw[0] + lb[0];
      Y[i * 68 + 16 + l16] = d1 * rstd * lw[1] + lb[1];
      Y[i * 68 + 32 + l16] = d2 * rstd * lw[2] + lb[2];
      Y[i * 68 + 48 + l16] = d3 * rstd * lw[3] + lb[3];
    }
  }
  asm volatile("s_waitcnt lgkmcnt(0)" ::: "memory");
  __builtin_amdgcn_wave_barrier();
  const int vc = (lane & 7) * 8;
#pragma unroll
  for (int ps = 0; ps < 8; ++ps) {
    const int i = 8 * ps + (lane >> 3);
    int R; bool valid;
    if (prompt) { const int pp = 64 * c - 48 + i; valid = pp >= 0; R = st * PT + (valid ? pp : 0); }
    else { R = NPR + 64 * st + i; valid = true; }
    if (valid) {
      const float4 y0 = *(const float4*)(Y + i * 68 + vc), y1 = *(const float4*)(Y + i * 68 + vc + 4);
      const float rkbv = p.rkb[(size_t)R * 4 + hd];
      const uint4 vv = *(const uint4*)(rwp + 40960 + (i * 64 + vc) * 2);
      const uint4 gc = *(const uint4*)(p.zL + (size_t)R * ZL + ZL_GC + hd * 64 + vc);
      uint4 o;
      o.x = pk2((y0.x + rkbv * bflo(vv.x)) * silu_(bflo(gc.x)), (y0.y + rkbv * bfhi(vv.x)) * silu_(bfhi(gc.x)));
      o.y = pk2((y0.z + rkbv * bflo(vv.y)) * silu_(bflo(gc.y)), (y0.w + rkbv * bfhi(vv.y)) * silu_(bfhi(gc.y)));
      o.z = pk2((y1.x + rkbv * bflo(vv.z)) * silu_(bflo(gc.z)), (y1.y + rkbv * bfhi(vv.z)) * silu_(bfhi(gc.z)));
      o.w = pk2((y1.z + rkbv * bflo(vv.w)) * silu_(bflo(gc.w)), (y1.w + rkbv * bfhi(vv.w)) * silu_(bfhi(gc.w)));
      *(uint4*)(mix + (size_t)R * D + 768 + hd * 64 + vc) = o;
    }
  }
  asm volatile("s_waitcnt lgkmcnt(0)" ::: "memory");
  __builtin_amdgcn_wave_barrier();
}

DEV void final_norm(const Prm& p) {
  int tid_ = threadIdx.x; LAUNDER(tid_);
  const int lane = tid_ & 63, gw = blockIdx.x * 4 + (tid_ >> 6), NW = gridDim.x * 4;
  for (int R = gw; R < NT; R += NW) {
    if (R < NPR && (R % PT) < 16) continue;
    float* yr = xrow_ptr(p, R);
    const bf16_t* xr = p.xb + (size_t)R * D;
    const float rstd = rsqrtf(p.ssq_x[2 * NTP + R] * (1.f / 1024.f) + RMS_EPS);
#pragma unroll
    for (int j = 0; j < 2; ++j) {
      const uint4 u = ((const uint4*)xr)[lane + 64 * j];
      const float4 g0 = ((const float4*)p.final_g)[2 * (lane + 64 * j)], g1 = ((const float4*)p.final_g)[2 * (lane + 64 * j) + 1];
      float4 o0, o1;
      o0.x = bflo(u.x) * rstd * g0.x; o0.y = bfhi(u.x) * rstd * g0.y; o0.z = bflo(u.y) * rstd * g0.z; o0.w = bfhi(u.y) * rstd * g0.w;
      o1.x = bflo(u.z) * rstd * g1.x; o1.y = bfhi(u.z) * rstd * g1.y; o1.z = bflo(u.w) * rstd * g1.z; o1.w = bfhi(u.w) * rstd * g1.w;
      ((float4*)yr)[2 * (lane + 64 * j)] = o0; ((float4*)yr)[2 * (lane + 64 * j) + 1] = o1;
    }
  }
}

#define XB_TMO      128
#define XB_XCNT(j)  (256  + 64 * (j))
#define XB_XSUB(j)  (1280 + 64 * (j))
#define XB_XGEN(j)  (2304 + 64 * (j))
#define XB_TOP      3328
#define XB_TOPGEN   3392
#define XCD_BAR_WORDS 3456
#define XB_SPIN_CAP (1u << 20)
#define LAS __attribute__((address_space(3)))
DEV unsigned xb_ld(unsigned* p) { return __hip_atomic_load(p, __ATOMIC_RELAXED, __HIP_MEMORY_SCOPE_AGENT); }
DEV unsigned xb_add(unsigned* p, unsigned v) { return __hip_atomic_fetch_add(p, v, __ATOMIC_RELAXED, __HIP_MEMORY_SCOPE_AGENT); }
DEV unsigned xb_xcc_id() { return (unsigned)__builtin_amdgcn_s_getreg((3 << 11) | 20) & 0xFu; }
#define XB_SPIN(cond, bar) do { unsigned _sp = 0; while (cond) { __builtin_amdgcn_s_sleep(1); \
    if ((++_sp & 255u) == 0u) { if (xb_ld(&(bar)[XB_TMO])) break; if (_sp > XB_SPIN_CAP) { atomicAdd(&(bar)[XB_TMO], 1u); break; } } } } while (0)
struct XcdBarrier { unsigned* bar; unsigned x; volatile LAS unsigned* st; };
DEV XcdBarrier xcd_barrier_post(unsigned* bar, volatile LAS unsigned* st) {
  XcdBarrier b; b.bar = bar; b.x = xb_xcc_id(); b.st = st;
  if (threadIdx.x == 0) (void)xb_add(&bar[XB_XCNT(b.x)], 1u);
  return b;
}
DEV void xcd_barrier_complete(unsigned* bar, unsigned x, unsigned& nloc, unsigned& nx) {
  const unsigned G = gridDim.x * gridDim.y * gridDim.z;
  unsigned sum, cnt, mine, sp = 0u;
  for (;;) {
    sum = 0u; cnt = 0u; mine = 0u;
#pragma unroll
    for (unsigned j = 0; j < 16; ++j) { const unsigned c = xb_ld(&bar[XB_XCNT(j)]); sum += c; cnt += (c > 0u) ? 1u : 0u; mine = (j == x) ? c : mine; }
    if (sum == G) break;
    __builtin_amdgcn_s_sleep(1);
    if ((++sp & 255u) == 0u) { if (xb_ld(&bar[XB_TMO])) break; if (sp > XB_SPIN_CAP) { atomicAdd(&bar[XB_TMO], 1u); break; } }
  }
  nloc = mine > 0u ? mine : 1u; nx = cnt > 0u ? cnt : 1u;
}
DEV void xcd_barrier(const XcdBarrier& b) {
  asm volatile("s_waitcnt vmcnt(0)" ::: "memory");
  __syncthreads();
  if (threadIdx.x == 0) {
    unsigned* bar = b.bar;
    __builtin_amdgcn_s_waitcnt(0);
    unsigned nloc = b.st[0], nx = b.st[1];
    if (nloc == 0u) { xcd_barrier_complete(bar, b.x, nloc, nx); b.st[0] = nloc; b.st[1] = nx; }
    const unsigned old = xb_add(&bar[XB_XSUB(b.x)], 1u);
    const unsigned gen = old / nloc;
    if (old + 1u == (gen + 1u) * nloc) {
      __builtin_amdgcn_fence(__ATOMIC_RELEASE, "agent");
      asm volatile("s_waitcnt vmcnt(0)" ::: "memory");
      const unsigned og = xb_add(&bar[XB_TOP], 1u);
      const unsigned tg = og / nx;
      if (og + 1u == (tg + 1u) * nx) xb_add(&bar[XB_TOPGEN], 1u);
      else XB_SPIN(xb_ld(&bar[XB_TOPGEN]) == tg, bar);
      __builtin_amdgcn_fence(__ATOMIC_ACQUIRE, "agent");
      xb_add(&bar[XB_XGEN(b.x)], 1u);
      asm volatile("s_waitcnt vmcnt(0)" ::: "memory");
    } else {
      XB_SPIN(xb_ld(&bar[XB_XGEN(b.x)]) == gen, bar);
      __builtin_amdgcn_fence(__ATOMIC_ACQUIRE, "agent");
      asm volatile("s_waitcnt vmcnt(0)" ::: "memory");
    }
  }
  __syncthreads();
}

#define QCTR(ph, L) (3584 + 64 * (2 * (ph) + (L)))
#define R2DONE(L) (3520 + 16 * (L))
DEV int next_item(unsigned* ctr, char* lds) {
  volatile int* slot = (volatile int*)(lds + LDS_BYTES - 8);
  __syncthreads();
  if (threadIdx.x == 0) *slot = (int)atomicAdd(ctr, 1u);
  __syncthreads();
  return *slot;
}
#define QXC(ph, L, x) (4096 + (((ph) * 2 + (L)) * 8 + (x)) * 16)
DEV int xq_next(unsigned* ctl, int ph, int L, int C, int N, int& k, int home, char* lds) {
  volatile int* slot = (volatile int*)(lds + LDS_BYTES - 8);
  __syncthreads();
  if (threadIdx.x == 0) {
    int res = -1, kk = k;
    while (kk < 8) {
      const int x = (home + kk) & 7, base = x * C;
      int size = N - base; size = size < C ? size : C;
      if (size > 0) { const int idx = (int)atomicAdd(ctl + QXC(ph, L, x), 1u); if (idx < size) { res = base + idx; break; } }
      ++kk;
    }
    slot[0] = res; slot[1] = kk;
  }
  __syncthreads();
  k = slot[1];
  return slot[0];
}
DEV int q_publish(int ticket, char* lds) {
  volatile int* slot = (volatile int*)(lds + LDS_BYTES - 8);
  __syncthreads();
  if (threadIdx.x == 0) *slot = ticket;
  __syncthreads();
  return *slot;
}
DEV int xq_resolve(unsigned* ctl, int ph, int L, int C, int N, int& k, int home, int ticket, char* lds) {
  volatile int* slot = (volatile int*)(lds + LDS_BYTES - 8);
  __syncthreads();
  if (threadIdx.x == 0) {
    int res = -1, kk = k;
    if (kk < 8) {
      const int x = (home + kk) & 7, base = x * C;
      int size = N - base; size = size < C ? size : C;
      if (ticket < size) res = base + ticket;
      else {
        ++kk;
        while (kk < 8) {
          const int x2 = (home + kk) & 7, base2 = x2 * C;
          int size2 = N - base2; size2 = size2 < C ? size2 : C;
          if (size2 > 0) { const int idx = (int)atomicAdd(ctl + QXC(ph, L, x2), 1u); if (idx < size2) { res = base2 + idx; break; } }
          ++kk;
        }
      }
    }
    slot[0] = res; slot[1] = kk;
  }
  __syncthreads();
  k = slot[1];
  return slot[0];
}
DEV unsigned* xq_ctr(unsigned* ctl, int ph, int L, int k, int home) { return k < 8 ? ctl + QXC(ph, L, (home + k) & 7) : nullptr; }
DEV int take_ticket(unsigned* nctr) { int tk = 0x7fffffff; if (nctr && threadIdx.x == 0) tk = (int)atomicAdd(nctr, 1u); return tk; }
struct XQueue {
  unsigned* ctl; int ph, L, C, N, k, home, t;
  DEV void prefetch() { t = take_ticket(xq_ctr(ctl, ph, L, k, home)); }
  DEV int resolve(char* lds) { return xq_resolve(ctl, ph, L, C, N, k, home, t, lds); }
};
template <class Epi, class Map>
DEV void gemm_stream(const bf16_t* __restrict__ A, int lda, const bf16_t* __restrict__ Bt, int ldb, int K, char* lds, const Epi& epi, XQueue& q) {
  int tid = threadIdx.x; LAUNDER(tid);
  const int lane = tid & 63, w = __builtin_amdgcn_readfirstlane(tid >> 6), wr = w >> 1, wc = w & 1;
  const int fr = lane & 15, fq = lane >> 4;
  const int sb = lane * 16, swz = sb ^ (((sb >> 9) & 1) << 5), rl = swz >> 6, cl = (swz & 63) >> 1;
  const int nk = K / 64;
  int offA[2], offB[2];
#pragma unroll
  for (int kh = 0; kh < 2; ++kh) { offA[kh] = lds_byte(wr * 64 + fr, kh * 32 + fq * 8); offB[kh] = lds_byte(wc * 64 + fr, kh * 32 + fq * 8); }
  q.prefetch();
  int item = q.resolve(lds);
  if (item < 0) return;
  int m0, n0; Map::map(item, m0, n0);
  const bf16_t* ga[4]; const bf16_t* gb[4];
#define SETPTR(M0, N0) { _Pragma("unroll") for (int i = 0; i < 4; ++i) { const int st = 4 * w + i, r = (st >> 1) * 16 + rl, c = (st & 1) * 32 + cl; \
      ga[i] = A + (size_t)((M0) + r) * lda + c; gb[i] = Bt + (size_t)((N0) + r) * ldb + c; } }
#define GSTAGE(S, KT) { _Pragma("unroll") for (int i = 0; i < 4; ++i) { \
      __builtin_amdgcn_global_load_lds((const unsigned*)(ga[i] + (KT) * 64), (LAS3 unsigned*)(lds + (S) * 32768 + (4 * w + i) * 1024 + lane * 16), 16, 0, 0); \
      __builtin_amdgcn_global_load_lds((const unsigned*)(gb[i] + (KT) * 64), (LAS3 unsigned*)(lds + (S) * 32768 + 16384 + (4 * w + i) * 1024 + lane * 16), 16, 0, 0); } }
  SETPTR(m0, n0)
  GSTAGE(0, 0)
  GSTAGE(1, 1)
  for (;;) {
    f32x4 acc[4][4];
#pragma unroll
    for (int i = 0; i < 4; ++i)
#pragma unroll
      for (int j = 0; j < 4; ++j) acc[i][j] = (f32x4){0.f, 0.f, 0.f, 0.f};
    for (int kt = 0; kt < nk; ++kt) {
      const int s = kt & 1;
      if (kt + 1 < nk) asm volatile("s_waitcnt vmcnt(8)" ::: "memory"); else asm volatile("s_waitcnt vmcnt(0)" ::: "memory");
      RAW_BARRIER()
      const char* ia = lds + s * 32768;
      const char* ib = ia + 16384;
      bf16x8 af[2][4], bfv[2][4];
#pragma unroll
      for (int kh = 0; kh < 2; ++kh) {
#pragma unroll
        for (int mi = 0; mi < 4; ++mi) af[kh][mi] = *(const bf16x8*)(ia + offA[kh] + mi * 2048);
#pragma unroll
        for (int ni = 0; ni < 4; ++ni) bfv[kh][ni] = *(const bf16x8*)(ib + offB[kh] + ni * 2048);
      }
      asm volatile("s_waitcnt lgkmcnt(8)" ::: "memory");
      __builtin_amdgcn_sched_barrier(0);
#pragma unroll
      for (int mi = 0; mi < 4; ++mi)
#pragma unroll
        for (int ni = 0; ni < 4; ++ni) acc[mi][ni] = mfma16(bfv[0][ni], af[0][mi], acc[mi][ni]);
      __builtin_amdgcn_sched_barrier(0);
      asm volatile("s_waitcnt lgkmcnt(0)" ::: "memory");
      RAW_BARRIER()
      if (kt + 2 < nk) GSTAGE(s, kt + 2)
      if (kt == nk - 3) q.prefetch();
      __builtin_amdgcn_sched_barrier(0);
#pragma unroll
      for (int mi = 0; mi < 4; ++mi)
#pragma unroll
        for (int ni = 0; ni < 4; ++ni) acc[mi][ni] = mfma16(bfv[1][ni], af[1][mi], acc[mi][ni]);
    }
    const int nxt = q.resolve(lds);
    const typename Epi::Pre pre = epi.preload(m0 + wr * 64, n0 + wc * 64, fr, fq);
    __builtin_amdgcn_sched_barrier(0);
    int m1 = 0, n1 = 0;
    if (nxt >= 0) { Map::map(nxt, m1, n1); SETPTR(m1, n1) GSTAGE(0, 0) GSTAGE(1, 1) }
    __builtin_amdgcn_sched_barrier(0);
    epi.finish(acc, pre, m0 + wr * 64, n0 + wc * 64, fr, fq);
    if (nxt < 0) break;
    m0 = m1; n0 = n1;
  }
#undef GSTAGE
#undef SETPTR
}
struct MapP1 { static DEV void map(int i, int& m0, int& n0) { int mt, nt; if (i < 18 * 192) { const int b = i / 192, r = i - b * 192; nt = r >> 3; mt = 8 * b + (r & 7); } else { nt = i - 18 * 192; mt = 144; } m0 = mt * 128; n0 = nt * 128; } };
struct MapP4 { static DEV void map(int i, int& m0, int& n0) { m0 = (i >> 3) * 128; n0 = (i & 7) * 128; } };
DEV void shift_rows_item(const Prm& p, int L, int b) {
  int tid0 = threadIdx.x; LAUNDER(tid0);
  if (tid0 < 224) {
    float4 v = make_float4(0.f, 0.f, 0.f, 0.f);
    if (b < 32) v = *(const float4*)(p.state_shift + ((size_t)L * 32 + b) * 896 + 4 * tid0);
    *(uint2*)(p.zE + (size_t)(NT + b) * ZE + ZE_ZC + 4 * tid0) = pk4(v.x, v.y, v.z, v.w);
  }
}
constexpr int N_ATT = 1312;
DEV void run_p1(const Prm& p, int L, char* lds) {
  const EpiIn epi{p, L};
  const int home = (int)(xb_xcc_id() & 7u);
  constexpr int N = 145 * 24, C = (N + 7) / 8;
  {
    XQueue q{p.ctl, 0, L, C, N, 0, home, 0};
    gemm_stream<EpiIn, MapP1>(p.xb, D, p.Wb_in + (size_t)L * INP * 1024, 1024, 1024, lds, epi, q);
  }
  unsigned* ctr = p.ctl + QCTR(3, L);
  int t = take_ticket(ctr);
  for (;;) {
    const int mt = q_publish(t, lds);
    if (mt >= 145 + 33) break;
    if (mt >= 145) { t = take_ticket(ctr); shift_rows_item(p, L, mt - 145); continue; }
    t = gemm_tile<EpiIn, 2>(p.xb, D, p.Wb_in + (size_t)L * INP * 1024, 1024, 1024, mt * 128, 24 * 128, lds, epi, ctr);
  }
}
DEV void run_p2(const Prm& p, int L, char* lds) {
  const EpiQ epq{p, L};
  constexpr int N1 = NRW, N2 = N1 + 129, N3 = N2 + 145 * 6, N4 = N3 + 16, N4b = N4 + 512, N5 = N4b + 36;
  const int N6 = L == 0 ? N5 + NWT : N5;
  unsigned* ctr = p.ctl + QCTR(0, L);
  for (;;) {
    const int id = next_item(ctr, lds);
    if (id >= N6) break;
    if (id >= N5) { conv_weights_item(p, 1, id - N5, lds); continue; }
    if (id < N1) r1_item(p, L, id, lds);
    else if (id < N2) kvproj_item(p, L, id - N1, lds);
    else if (id < N3) { const int t = id - N2, mt = t / 6, nt = t - mt * 6; gemm_tile(p.zE + ZE_CQ, ZE, p.Wb_uq + (size_t)L * 768 * 256, 256, 256, mt * 128, nt * 128, lds, epq); }
    else if (id < N4) sample_prep_item(p, L, id - N3);
    else if (id < N4b) lat_item(p, L, id - N4);
    else shift_item(p, L, id - N4b);
  }
}
DEV void run_p3(const Prm& p, int L, char* lds) {
  int tid_ = threadIdx.x; LAUNDER(tid_);
  const int lane = tid_ & 63, w = __builtin_amdgcn_readfirstlane(tid_ >> 6);
  {
    int ndone = 0;
    for (int wi = blockIdx.x * 4 + w; wi < 576; wi += gridDim.x * 4) { r2_wave(p, L, wi, lane); ++ndone; }
    if (blockIdx.x * 4 < 576) {
      asm volatile("s_waitcnt vmcnt(0)" ::: "memory");
      __syncthreads();
      if (threadIdx.x == 0) {
        int tot = 0;
        for (int wi = blockIdx.x * 4; wi < 576; wi += gridDim.x * 4) tot += (576 - wi) < 4 ? (576 - wi) : 4;
        __builtin_amdgcn_fence(__ATOMIC_RELEASE, "agent");
        asm volatile("s_waitcnt vmcnt(0)" ::: "memory");
        __hip_atomic_fetch_add(p.ctl + R2DONE(L), (unsigned)tot, __ATOMIC_RELAXED, __HIP_MEMORY_SCOPE_AGENT);
      }
    }
    (void)ndone;
  }
  unsigned* ctr = p.ctl + QCTR(1, L);
  for (;;) {
    const int q = next_item(ctr, lds);
    if (q >= 128) break;
    attn_sample(p, L, q >> 2, q & 3, lds);
  }
  {
    const int home = (int)(xb_xcc_id() & 7u);
    int k = 0;
    int tx = take_ticket(xq_ctr(p.ctl, 2, L, k, home));
    for (;;) {
      const int i = xq_resolve(p.ctl, 2, L, 128, 1024, k, home, tx, lds);
      if (i < 0) break;
      const int x = i >> 7, j = i & 127, qt = 31 - (j >> 2), pair = 4 * x + (j & 3);
      tx = attn_body<false>(p, L, pair >> 3, pair & 7, qt, lds, xq_ctr(p.ctl, 2, L, k, home));
    }
  }
  unsigned* ctr2 = p.ctl + QCTR(2, L);
  constexpr int NC = (NT + 31) / 32, NQ2 = 32 + NC + NRW / 4;
  bool r2_seen = false;
  for (;;) {
    const int q = next_item(ctr2, lds);
    if (q >= NQ2) break;
    constexpr int NR3 = NRW / 4;
    if (q >= NR3 + 32) conv_item(p, L, q - NR3 - 32);
    else if (q >= NR3) attn_item(p, L, 1280 + q - NR3, lds);
    else {
      if (!r2_seen) {
        if (threadIdx.x == 0) {
          unsigned sp = 0;
          while (__hip_atomic_load(p.ctl + R2DONE(L), __ATOMIC_RELAXED, __HIP_MEMORY_SCOPE_AGENT) < 576u) {
            __builtin_amdgcn_s_sleep(2);
            if (++sp > (1u << 22)) { atomicAdd(&p.ctl[XB_TMO], 1u); break; }
          }
          __builtin_amdgcn_fence(__ATOMIC_ACQUIRE, "agent");
          asm volatile("s_waitcnt vmcnt(0)" ::: "memory");
        }
        __syncthreads();
        r2_seen = true;
      }
      r3_wave(p, L, q * 4 + w, lane, (float*)(lds + w * 17408));
    }
  }
}
DEV void run_p4(const Prm& p, int L, char* lds) {
  const EpiOut epo{p, L};
  const int home = (int)(xb_xcc_id() & 7u);
  {
    XQueue q{p.ctl, 1, L, 128, 1024, 0, home, 0};
    gemm_stream<EpiOut, MapP4>(p.zE  , D, p.Wb_out + (size_t)L * 1024 * 1024, 1024, 1024, lds, epo, q);
  }
  unsigned* ctr = p.ctl + QCTR(3, L) + 16;
  int t = take_ticket(ctr);
  for (;;) {
    const int h = q_publish(t, lds);
    if (h >= 17 * 16) break;
    const int mt = 128 + (h >> 4), r = h & 15;
    t = gemm_tile<EpiOut, 4>(p.zE, D, p.Wb_out + (size_t)L * 1024 * 1024, 1024, 1024, mt * 128, (r >> 1) * 128 + (r & 1) * 64, lds, epo, ctr);
  }
}

__global__ void __launch_bounds__(256, 2) mega(Prm p) {
  extern __shared__ __attribute__((aligned(16))) char lds[];
  volatile LAS unsigned* st = (volatile LAS unsigned*)(lds + LDS_BYTES - 16);
  if (threadIdx.x == 0) { st[0] = 0u; st[1] = 0u; st[2] = 0u; st[3] = 0u; }
  __syncthreads();
  const XcdBarrier xb = xcd_barrier_post(p.ctl, st);
  phase0(p, lds);
  xcd_barrier(xb);
  for (int L = 0; L < 2; ++L) {
    run_p1(p, L, lds); xcd_barrier(xb);
    run_p2(p, L, lds); xcd_barrier(xb);
    run_p3(p, L, lds); xcd_barrier(xb);
    run_p4(p, L, lds); xcd_barrier(xb);
  }
  final_norm(p);
}

static size_t al256(size_t x) { return (x + 255) & ~(size_t)255; }
extern "C" void kernel_launch(void* const* d_in, const int* in_sizes, int n_in, void* d_out, int out_size, void* d_ws, size_t ws_size, hipStream_t stream) {
  Prm p{};
  const float* const* in = (const float* const*)d_in;
  p.x_prompt = in[0]; p.x_sample = in[1]; p.cache_ckv = in[2]; p.cache_krope = in[3]; p.state_conv = in[4]; p.state_shift = in[5]; p.state_wkv = in[6];
  p.meta = in[7]; p.norm_g = in[8]; p.w_in = in[9]; p.conv_w = in[10]; p.q_norm_g = in[11]; p.w_uq = in[12]; p.kv_norm_g = in[13]; p.w_ukv = in[14];
  p.shift_mu = in[15]; p.decay_w0 = in[16]; p.decay_w2 = in[17]; p.iclr_a0 = in[18]; p.iclr_a2 = in[19]; p.key_kk = in[20]; p.key_ka = in[21];
  p.bonus_rk = in[22]; p.lnx_w = in[23]; p.lnx_b = in[24]; p.w_out = in[25]; p.final_g = in[26];
  float* o = (float*)d_out;
  p.y_prompt = o; o += (size_t)4 * 4096 * 1024;
  p.y_sample = o; o += (size_t)32 * 64 * 1024;
  p.ckv_p = o; o += (size_t)2 * 4 * PT * 128;
  p.kr_p = o; o += (size_t)2 * 4 * PT * 32;
  p.conv_p = o; o += 2 * 4 * 2 * 256;
  p.shift_p = o; o += 2 * 4 * 896;
  p.wkv_p = o; o += 2 * 4 * 4 * 64 * 64;
  p.ckv_s = o; o += (size_t)2 * 32 * 64 * 128;
  p.kr_s = o; o += 2 * 32 * 64 * 32;
  p.conv_s = o; o += 2 * 32 * 2 * 256;
  p.shift_s = o; o += 2 * 32 * 896;
  p.wkv_s = o; o += 2 * 32 * 4 * 64 * 64;
  char* w = (char*)d_ws; size_t off = 0;
  auto take = [&](size_t bytes) { char* r = w + off; off = al256(off + bytes); return r; };
  p.ctl = (unsigned*)take(65536);
  p.Wb_in = (bf16_t*)take((size_t)2 * INP * 1024 * 2);
  p.Wb_uq = (bf16_t*)take((size_t)2 * 768 * 256 * 2);
  p.Wb_ukv = (bf16_t*)take((size_t)2 * 1024 * 128 * 2);
  p.Wb_out = (bf16_t*)take((size_t)2 * 1024 * 1024 * 2);
  p.dw2T = (bf16_t*)take((size_t)2 * 256 * 64 * 2);
  p.ia2T = (bf16_t*)take((size_t)2 * 256 * 64 * 2);
  p.ropec = (float*)take((size_t)PT * 16 * 4);
  p.ropes = (float*)take((size_t)PT * 16 * 4);
  p.ssq_x = (float*)take((size_t)7 * NTP * 4);
  p.ssq_q = p.ssq_x + 3 * NTP; p.ssq_kv = p.ssq_x + 5 * NTP;
  p.rkb = (float*)take((size_t)NTP * 4 * 4);
  p.xmeta = (float*)take((size_t)64 * 1024 * 4);
  p.zE = (bf16_t*)take((size_t)NTP * ZE * 2);
  p.zL = (bf16_t*)take((size_t)NTP * ZL * 2);
  p.xb = (bf16_t*)take((size_t)(NTP + 128) * D * 2);
  p.Kn = (bf16_t*)take((size_t)KVR * 512 * 2);
  p.Vt = (bf16_t*)take((size_t)512 * KVR * 2);
  p.Kr = (bf16_t*)take((size_t)KVR * 32 * 2);
  p.rw = take((size_t)NRW * RW_BYTES);
  p.KL = (bf16_t*)((char*)p.y_prompt + ((size_t)32 << 20));
  p.VLT = p.KL + (size_t)32 * SKEYS * 160;
  static int grid = 0;
  if (grid == 0) {
    if (off > ws_size) { fprintf(stderr, "kernel_launch: workspace too small: need %zu have %zu\n", off, ws_size); grid = -1; return; }
    int dev = 0, cus = 0, per_cu = 0;
    (void)hipGetDevice(&dev);
    (void)hipDeviceGetAttribute(&cus, hipDeviceAttributeMultiprocessorCount, dev);
    (void)hipFuncSetAttribute((const void*)mega, hipFuncAttributeMaxDynamicSharedMemorySize, LDS_BYTES);
    (void)hipOccupancyMaxActiveBlocksPerMultiprocessor(&per_cu, (const void*)mega, 256, LDS_BYTES);
    if (per_cu > 2) per_cu = 2;
    if (per_cu < 1) { fprintf(stderr, "kernel_launch: occupancy query returned %d\n", per_cu); per_cu = 1; }
    grid = cus * per_cu;
  }
  if (grid < 0) return;
  (void)hipMemsetAsync(p.ctl, 0, 8192 * 4, stream);
  void* args[] = {&p};
  hipError_t e = hipLaunchCooperativeKernel((const void*)mega, dim3(grid), dim3(256), args, LDS_BYTES, stream);
  if (e != hipSuccess) fprintf(stderr, "cooperative launch failed: %s (grid %d)\n", hipGetErrorString(e), grid);
}
```

```cpp
#include <hip/hip_runtime.h>
#include <cstdio>
#include <cstdint>
#include <type_traits>

typedef unsigned short bf16_t;
typedef short bf16x8 __attribute__((ext_vector_type(8)));
typedef float f32x4 __attribute__((ext_vector_type(4)));
typedef float f32x16 __attribute__((ext_vector_type(16)));
#define DEV __device__ __forceinline__
#define LAUNDER(x) asm volatile("" : "+v"(x))

constexpr int D = 1024;
constexpr int PT = 4112;
constexpr int NPR = 4 * PT;
constexpr int NSM = 32 * 64;
constexpr int NT = NPR + NSM;
constexpr int NTP = 18560;
constexpr int ZL = 1792;
constexpr int ZE = 1312;
constexpr int ZE_CQ = 0, ZE_CKV = 256, ZE_KR = 384, ZE_ZC = 416;
constexpr int ZL_XIN = 0, ZL_BG = 256, ZL_CG = 512, ZL_GA = 768, ZL_GB = 1024, ZL_GC = 1536;
constexpr int INP = 3200;
constexpr int KVR = 16512;
constexpr int NRW_P = 4 * 65 * 4;
constexpr int NRW = NRW_P + 32 * 4;
constexpr int RW_BYTES = 49152;
constexpr float RMS_EPS = 1e-6f;
constexpr float GN_EPS = 64e-5f;
constexpr int LDS_BYTES = 79872;
constexpr int SKEYS = 1088;

struct Prm {
  const float *x_prompt, *x_sample, *cache_ckv, *cache_krope, *state_conv, *state_shift, *state_wkv, *meta, *norm_g, *w_in,
      *conv_w, *q_norm_g, *w_uq, *kv_norm_g, *w_ukv, *shift_mu, *decay_w0, *decay_w2, *iclr_a0, *iclr_a2, *key_kk, *key_ka,
      *bonus_rk, *lnx_w, *lnx_b, *w_out, *final_g;
  float *y_prompt, *y_sample, *ckv_p, *kr_p, *conv_p, *shift_p, *wkv_p, *ckv_s, *kr_s, *conv_s, *shift_s, *wkv_s;
  unsigned* ctl;
  bf16_t *Wb_in, *Wb_uq, *Wb_ukv, *Wb_out, *dw2T, *ia2T;
  float *ropec, *ropes, *ssq_x, *ssq_q, *ssq_kv, *rkb, *xmeta;
  bf16_t *KL, *VLT;
  bf16_t *zE, *zL, *xb, *Kn, *Vt, *Kr;
  char* rw;
};

DEV float bf2f(bf16_t b) { return __uint_as_float((unsigned)b << 16); }
DEV float bflo(unsigned u) { return __uint_as_float(u << 16); }
DEV float bfhi(unsigned u) { return __uint_as_float(u & 0xffff0000u); }
typedef __bf16 hbf16x2_t __attribute__((ext_vector_type(2)));
typedef float hf32x2_t __attribute__((ext_vector_type(2)));
DEV unsigned pk2(float a, float b) { hf32x2_t f = {a, b}; hbf16x2_t r = __builtin_convertvector(f, hbf16x2_t); return __builtin_bit_cast(unsigned, r); }
DEV bf16_t f2bf(float f) { return (bf16_t)(pk2(f, 0.f) & 0xffffu); }
DEV uint2 pk4(float a, float b, float c, float d) { uint2 r; r.x = pk2(a, b); r.y = pk2(c, d); return r; }
DEV float sigmoid_(float x) { return 1.f / (1.f + __expf(-x)); }
DEV float silu_(float x) { return x / (1.f + __expf(-x)); }
DEV float wave_sum(float v) {
#pragma unroll
  for (int o = 1; o < 64; o <<= 1) v += __shfl_xor(v, o);
  return v;
}
DEV f32x16 mfma32(bf16x8 a, bf16x8 b, f32x16 c) { return __builtin_amdgcn_mfma_f32_32x32x16_bf16(a, b, c, 0, 0, 0); }
DEV f32x4 mfma16(bf16x8 a, bf16x8 b, f32x4 c) { return __builtin_amdgcn_mfma_f32_16x16x32_bf16(a, b, c, 0, 0, 0); }
DEV bf16x8 mk8(unsigned a, unsigned b, unsigned c, unsigned d) { uint4 u; u.x = a; u.y = b; u.z = c; u.w = d; return __builtin_bit_cast(bf16x8, u); }
DEV bf16x8 mk8(uint4 u) { return __builtin_bit_cast(bf16x8, u); }
DEV f32x16 zero16() { f32x16 z; for (int i = 0; i < 16; ++i) z[i] = 0.f; return z; }

DEV float* xrow_ptr(const Prm& p, int R) {
  if (R < NPR) { int s = R / PT, q = R - s * PT; return q < 16 ? p.xmeta + (size_t)(s * 16 + q) * D : p.y_prompt + ((size_t)s * 4096 + (q - 16)) * D; }
  return p.y_sample + (size_t)(R - NPR) * D;
}
DEV const float* xin_ptr(const Prm& p, int R) {
  if (R < NPR) { int s = R / PT, q = R - s * PT; return q < 16 ? p.meta + (size_t)q * D : p.x_prompt + ((size_t)s * 4096 + (q - 16)) * D; }
  return p.x_sample + (size_t)(R - NPR) * D;
}
DEV int pos_of(int R) { return R < NPR ? R % PT : 1024 + ((R - NPR) & 63); }

DEV int win_src_col(int n) {
  if (n < 1024) return n;
  if (n < 1536) return 1440 + (n - 1024);
  if (n < 1792) return 2848 + (n - 1536);
  if (n < 2208) return 1024 + (n - 1792);
  if (n < 3104) return 1952 + (n - 2208);
  return -1;
}
DEV int perm32(int rho) { const int n = rho >> 4, i = rho & 15; return 8 * (i >> 2) + 4 * n + (i & 3); }
template <bool PERM, bool P32>
DEV void conv_weight_tile(const float* __restrict__ src, int K, int N, int Npad, bf16_t* __restrict__ dst, const float* __restrict__ sk, float cst, int l, int item, float* T  , int tid) {
  const int ntn = Npad / 64, ntk = K / 64;
  const int r = item, kt = r / ntn, nt = r - kt * ntn;
  const int k0 = kt * 64, n0 = nt * 64;
  {
    const int nslot = n0 + (tid & 15) * 4;
    const int nn = P32 ? (nslot & ~31) + perm32(nslot & 31) : nslot;
    const int sn = PERM ? win_src_col(nn) : (nn < N ? nn : -1);
#pragma unroll
    for (int i = 0; i < 4; ++i) {
      const int k = (tid >> 4) + 16 * i;
      float4 v = make_float4(0.f, 0.f, 0.f, 0.f);
      if (sn >= 0) {
        v = *(const float4*)(src + ((size_t)l * K + k0 + k) * N + sn);
        const float s = (sk ? sk[l * K + k0 + k] : 1.f) * cst;
        v.x *= s; v.y *= s; v.z *= s; v.w *= s;
      }
      float* t = T + k * 65 + (tid & 15) * 4;
      t[0] = v.x; t[1] = v.y; t[2] = v.z; t[3] = v.w;
    }
  }
  __syncthreads();
  {
    const int n = tid >> 2, kc = tid & 3;
    float v[16];
#pragma unroll
    for (int j = 0; j < 16; ++j) v[j] = T[(16 * kc + j) * 65 + n];
    uint4 o0, o1;
    o0.x = pk2(v[0], v[1]); o0.y = pk2(v[2], v[3]); o0.z = pk2(v[4], v[5]); o0.w = pk2(v[6], v[7]);
    o1.x = pk2(v[8], v[9]); o1.y = pk2(v[10], v[11]); o1.z = pk2(v[12], v[13]); o1.w = pk2(v[14], v[15]);
    bf16_t* d = dst + ((size_t)l * Npad + n0 + n) * K + k0 + 16 * kc;
    *(uint4*)d = o0; *(uint4*)(d + 8) = o1;
  }
  __syncthreads();
}
constexpr int WT0 = 16 * 50, WT1 = WT0 + 16 * 16, WT2 = WT1 + 4 * 12, WT3 = WT2 + 2 * 16, WT4 = WT3 + 4, NWT = WT4 + 4;
DEV void conv_weights_item(const Prm& p, int l, int it, char* lds) {
  float* T = (float*)lds;
  int tid = threadIdx.x; LAUNDER(tid);
  if (it < WT0) conv_weight_tile<true, true>(p.w_in, 1024, 3104, INP, p.Wb_in, p.norm_g, 1.f, l, it, T, tid);
  else if (it < WT1) conv_weight_tile<false, true>(p.w_out, 1024, 1024, 1024, p.Wb_out, nullptr, 1.f, l, it - WT0, T, tid);
  else if (it < WT2) conv_weight_tile<false, false>(p.w_uq, 256, 768, 768, p.Wb_uq, p.q_norm_g, 0.10206207261596575f * 1.4426950408889634f, l, it - WT1, T, tid);
  else if (it < WT3) conv_weight_tile<false, false>(p.w_ukv, 128, 1024, 1024, p.Wb_ukv, nullptr, 1.f, l, it - WT2, T, tid);
  else if (it < WT4) conv_weight_tile<false, false>(p.decay_w2, 64, 256, 256, p.dw2T, nullptr, 1.f, l, it - WT3, T, tid);
  else conv_weight_tile<false, false>(p.iclr_a2, 64, 256, 256, p.ia2T, nullptr, 1.f, l, it - WT4, T, tid);
}
DEV void phase0(const Prm& p, char* lds) {
  int tid = threadIdx.x; LAUNDER(tid);
  const int lane = tid & 63, wv = tid >> 6;
  const int gw = blockIdx.x * 4 + wv, NW = gridDim.x * 4;
  const int gt = blockIdx.x * 256 + tid, NTH = gridDim.x * 256;
  for (int R = gw; R < NT; R += NW) {
    const float* src = xin_ptr(p, R);
    float ss = 0.f;
#pragma unroll
    for (int j = 0; j < 4; ++j) {
      const float4 v = ((const float4*)src)[lane + 64 * j];
      ss += v.x * v.x + v.y * v.y + v.z * v.z + v.w * v.w;
      ((uint2*)(p.xb + (size_t)R * D))[lane + 64 * j] = pk4(v.x, v.y, v.z, v.w);
    }
    ss = wave_sum(ss);
    if (lane == 0) p.ssq_x[R] = ss;
  }
  for (int i = gt; i < 6 * NTP; i += NTH) p.ssq_x[NTP + i] = 0.f;
  for (int it = blockIdx.x; it < NWT; it += gridDim.x) conv_weights_item(p, 0, it, lds);
  for (int i = gt; i < PT * 16; i += NTH) {
    const int pos = i >> 4, j = i & 15;
    const float inv = powf(10000.f, -(float)j * 2.0f / 32.f);
    const float ang = (float)pos * inv;
    double a = (double)ang;
    a -= 6.283185307179586476925 * rint(a * 0.15915494309189533577);
    p.ropec[i] = (float)cos(a);
    p.ropes[i] = (float)sin(a);
  }
}

#define LAS3 __attribute__((address_space(3)))
#define RAW_BARRIER() { asm volatile("" ::: "memory"); __builtin_amdgcn_s_barrier(); asm volatile("" ::: "memory"); }
DEV int lds_byte(int r, int c) { const int st = (r >> 4) * 2 + (c >> 5), rr = r & 15, cc = c & 31, ob = rr * 64 + cc * 2; return st * 1024 + (ob ^ (((ob >> 9) & 1) << 5)); }
template <class Epi, int NB = 8>
DEV int gemm_tile(const bf16_t* __restrict__ A, int lda, const bf16_t* __restrict__ Bt, int ldb, int K, int m0, int n0, char* lds, const Epi& epi, unsigned* nctr = nullptr) {
  int tid = threadIdx.x; LAUNDER(tid);
  const int lane = tid & 63, w = __builtin_amdgcn_readfirstlane(tid >> 6), wr = w >> 1, wc = w & 1;
  const int fr = lane & 15, fq = lane >> 4;
  const int sb = lane * 16, swz = sb ^ (((sb >> 9) & 1) << 5), rl = swz >> 6, cl = (swz & 63) >> 1;
  const bf16_t* ga[4]; const bf16_t* gb[4];
#pragma unroll
  for (int i = 0; i < 4; ++i) {
    const int st = 4 * w + i, r = (st >> 1) * 16 + rl, c = (st & 1) * 32 + cl;
    ga[i] = A + (size_t)(m0 + r) * lda + c;
    gb[i] = Bt + (size_t)(n0 + r) * ldb + c;
  }
  const int nk = K / 64;
#define GSTAGE(S, KT) { _Pragma("unroll") for (int i = 0; i < 4; ++i) { \
      __builtin_amdgcn_global_load_lds((const unsigned*)(ga[i] + (KT) * 64), (LAS3 unsigned*)(lds + (S) * 32768 + (4 * w + i) * 1024 + lane * 16), 16, 0, 0); \
      if (2 * w + (i >> 1) < NB) __builtin_amdgcn_global_load_lds((const unsigned*)(gb[i] + (KT) * 64), (LAS3 unsigned*)(lds + (S) * 32768 + 16384 + (4 * w + i) * 1024 + lane * 16), 16, 0, 0); } }
  f32x4 acc[4][4];
#pragma unroll
  for (int i = 0; i < 4; ++i)
#pragma unroll
    for (int j = 0; j < 4; ++j) acc[i][j] = (f32x4){0.f, 0.f, 0.f, 0.f};
  int offA[2], offB[2];
#pragma unroll
  for (int kh = 0; kh < 2; ++kh) { offA[kh] = lds_byte(wr * 64 + fr, kh * 32 + fq * 8); offB[kh] = lds_byte(wc * 64 + fr, kh * 32 + fq * 8); }
  GSTAGE(0, 0)
  if (nk > 1) GSTAGE(1, 1)
  for (int kt = 0; kt < nk; ++kt) {
    const int s = kt & 1;
    if (kt + 1 < nk) { if (2 * w < NB) asm volatile("s_waitcnt vmcnt(8)" ::: "memory"); else asm volatile("s_waitcnt vmcnt(4)" ::: "memory"); }
    else asm volatile("s_waitcnt vmcnt(0)" ::: "memory");
    RAW_BARRIER()
    const char* ia = lds + s * 32768;
    const char* ib = ia + 16384;
    bf16x8 af[2][4], bfv[2][4];
#pragma unroll
    for (int kh = 0; kh < 2; ++kh) {
#pragma unroll
      for (int mi = 0; mi < 4; ++mi) af[kh][mi] = *(const bf16x8*)(ia + offA[kh] + mi * 2048);
#pragma unroll
      for (int ni = 0; ni < (NB < 4 ? NB : 4); ++ni) bfv[kh][ni] = *(const bf16x8*)(ib + offB[kh] + ni * 2048);
    }
    asm volatile("s_waitcnt lgkmcnt(%0)" :: "n"(4 + (NB < 4 ? NB : 4)) : "memory");
    __builtin_amdgcn_sched_barrier(0);
    if (NB == 8 || wc == 0) {
#pragma unroll
      for (int mi = 0; mi < 4; ++mi)
#pragma unroll
        for (int ni = 0; ni < (NB < 4 ? NB : 4); ++ni) acc[mi][ni] = mfma16(bfv[0][ni], af[0][mi], acc[mi][ni]);
    }
    __builtin_amdgcn_sched_barrier(0);
    asm volatile("s_waitcnt lgkmcnt(0)" ::: "memory");
    RAW_BARRIER()
    if (kt + 2 < nk) GSTAGE(s, kt + 2)
    __builtin_amdgcn_sched_barrier(0);
    if (NB == 8 || wc == 0) {
#pragma unroll
      for (int mi = 0; mi < 4; ++mi)
#pragma unroll
        for (int ni = 0; ni < (NB < 4 ? NB : 4); ++ni) acc[mi][ni] = mfma16(bfv[1][ni], af[1][mi], acc[mi][ni]);
    }
  }
  __syncthreads();
#undef GSTAGE
  int tk = 0x7fffffff; if (nctr && tid == 0) tk = (int)atomicAdd(nctr, 1u);
  if (NB == 8 || wc == 0) epi(acc, m0 + wr * 64, n0 + wc * 64, fr, fq);
  return tk;
}

struct EpiIn {
  const Prm& p; int L;
  struct Pre { float s[4]; };
  DEV Pre preload(int mb, int nb, int fr, int fq) const {
    Pre r;
#pragma unroll
    for (int mi = 0; mi < 4; ++mi) r.s[mi] = p.ssq_x[L * NTP + mb + 16 * mi + fr];
    return r;
  }
  DEV void operator()(f32x4 (&acc)[4][4], int mb, int nb, int fr, int fq) const { finish(acc, preload(mb, nb, fr, fq), mb, nb, fr, fq); }
  DEV void finish(f32x4 (&acc)[4][4], const Pre& pre, int mb, int nb, int fr, int fq) const {
#pragma unroll
    for (int mi = 0; mi < 4; ++mi) {
      const int m = mb + 16 * mi + fr;
      const bool ok = m < NT;
      const float rstd = rsqrtf(pre.s[mi] * (1.f / 1024.f) + RMS_EPS);
      float sq = 0.f;
#pragma unroll
      for (int g = 0; g < 2; ++g) {
        const int n0 = nb + 32 * g;
        if (n0 >= 3104) continue;
        bf16_t* dst = n0 < ZL ? p.zL + (size_t)m * ZL + n0 : p.zE + (size_t)m * ZE + (n0 - ZL);
        float v[8];
#pragma unroll
        for (int j = 0; j < 4; ++j) { v[j] = acc[mi][2 * g][j] * rstd; v[4 + j] = acc[mi][2 * g + 1][j] * rstd; }
#pragma unroll
        for (int j = 0; j < 8; ++j) sq += v[j] * v[j];
        if (ok) { uint4 o; o.x = pk2(v[0], v[1]); o.y = pk2(v[2], v[3]); o.z = pk2(v[4], v[5]); o.w = pk2(v[6], v[7]); *(uint4*)(dst + 8 * fq) = o; }
      }
      if (nb >= ZL && nb < ZL + 384) {
        sq += __shfl_xor(sq, 16); sq += __shfl_xor(sq, 32);
        if (fq == 0 && ok) atomicAdd((nb < ZL + 256 ? p.ssq_q : p.ssq_kv) + L * NTP + m, sq);
      }
    }
  }
};
struct EpiQ {
  const Prm& p; int L;
  DEV void operator()(f32x4 (&acc)[4][4], int mb, int nb, int fr, int fq) const {
    bf16_t* Qb = (bf16_t*)p.y_prompt;
#pragma unroll
    for (int mi = 0; mi < 4; ++mi) {
      const int m = mb + 16 * mi + fr;
      const bool ok = m < NT;
      const float rstd = rsqrtf(p.ssq_q[L * NTP + m] * (1.f / 256.f) + RMS_EPS);
      const int pos = pos_of(ok ? m : 0);
#pragma unroll
      for (int np = 0; np < 2; ++np) {
        const int n0 = nb + 32 * np;
        float v[2][4];
#pragma unroll
        for (int h2 = 0; h2 < 2; ++h2)
#pragma unroll
          for (int j = 0; j < 4; ++j) v[h2][j] = acc[mi][2 * np + h2][j] * rstd;
        if (((n0 >> 5) % 3) == 2) {
#pragma unroll
          for (int j = 0; j < 4; ++j) {
            const int c = 4 * fq + j;
            const float cs = p.ropec[pos * 16 + c], sn = p.ropes[pos * 16 + c];
            const float x1 = v[0][j], x2 = v[1][j];
            v[0][j] = x1 * cs - x2 * sn; v[1][j] = x1 * sn + x2 * cs;
          }
        }
        if (ok) {
          *(uint2*)(Qb + (size_t)m * 768 + n0 + 4 * fq) = pk4(v[0][0], v[0][1], v[0][2], v[0][3]);
          *(uint2*)(Qb + (size_t)m * 768 + n0 + 16 + 4 * fq) = pk4(v[1][0], v[1][1], v[1][2], v[1][3]);
        }
      }
    }
  }
};
struct EpiOut {
  const Prm& p; int L;
  struct Pre { uint4 x[4][2]; };
  DEV Pre preload(int mb, int nb, int fr, int fq) const {
    Pre r;
#pragma unroll
    for (int mi = 0; mi < 4; ++mi) {
      const int m = mb + 16 * mi + fr;
      const bf16_t* xr = p.xb + (size_t)(m < NT ? m : 0) * D;
#pragma unroll
      for (int g = 0; g < 2; ++g) r.x[mi][g] = *(const uint4*)(xr + nb + 32 * g + 8 * fq);
    }
    return r;
  }
  DEV void operator()(f32x4 (&acc)[4][4], int mb, int nb, int fr, int fq) const { finish(acc, preload(mb, nb, fr, fq), mb, nb, fr, fq); }
  DEV void finish(f32x4 (&acc)[4][4], const Pre& pre, int mb, int nb, int fr, int fq) const {
#pragma unroll
    for (int mi = 0; mi < 4; ++mi) {
      const int m = mb + 16 * mi + fr;
      const bool ok = m < NT;
      bf16_t* xr = p.xb + (size_t)(ok ? m : 0) * D;
      float ss = 0.f;
#pragma unroll
      for (int g = 0; g < 2; ++g) {
        const int col = nb + 32 * g + 8 * fq;
        const uint4 xi = pre.x[mi][g];
        float v[8] = {bflo(xi.x), bfhi(xi.x), bflo(xi.y), bfhi(xi.y), bflo(xi.z), bfhi(xi.z), bflo(xi.w), bfhi(xi.w)};
#pragma unroll
        for (int j = 0; j < 4; ++j) { v[j] += acc[mi][2 * g][j]; v[4 + j] += acc[mi][2 * g + 1][j]; }
#pragma unroll
        for (int j = 0; j < 8; ++j) ss += v[j] * v[j];
        if (ok) { uint4 o; o.x = pk2(v[0], v[1]); o.y = pk2(v[2], v[3]); o.z = pk2(v[4], v[5]); o.w = pk2(v[6], v[7]); *(uint4*)(xr + col) = o; }
      }
      ss += __shfl_xor(ss, 16); ss += __shfl_xor(ss, 32);
      if (fq == 0 && ok) atomicAdd(p.ssq_x + (L + 1) * NTP + m, ss);
    }
  }
};

DEV void kv_prep_row(const Prm& p, int L, int R, int half, bool valid, bf16_t* At_row  ) {
  const int Rl = valid ? R : 0;
  const bf16_t* zr = p.zE + (size_t)Rl * ZE;
  const float rstd = rsqrtf(p.ssq_kv[L * NTP + Rl] * (1.f / 128.f) + RMS_EPS);
  float* outc; float* outk;
  if (Rl < NPR) { const int s = Rl / PT, q = Rl - s * PT; outc = p.ckv_p + (((size_t)L * 4 + s) * PT + q) * 128; outk = p.kr_p + (((size_t)L * 4 + s) * PT + q) * 32; }
  else { const int j = Rl - NPR; outc = p.ckv_s + ((size_t)L * NSM + j) * 128; outk = p.kr_s + ((size_t)L * NSM + j) * 32; }
  const float* g = p.kv_norm_g + L * 128 + 64 * half;
#pragma unroll
  for (int c8 = 0; c8 < 8; ++c8) {
    const uint4 u = *(const uint4*)(zr + ZE_CKV + 64 * half + 8 * c8);
    const float4 g0 = *(const float4*)(g + 8 * c8), g1 = *(const float4*)(g + 8 * c8 + 4);
    float4 y0, y1;
    y0.x = bflo(u.x) * rstd * g0.x; y0.y = bfhi(u.x) * rstd * g0.y; y0.z = bflo(u.y) * rstd * g0.z; y0.w = bfhi(u.y) * rstd * g0.w;
    y1.x = bflo(u.z) * rstd * g1.x; y1.y = bfhi(u.z) * rstd * g1.y; y1.z = bflo(u.w) * rstd * g1.z; y1.w = bfhi(u.w) * rstd * g1.w;
    if (valid) { *(float4*)(outc + 64 * half + 8 * c8) = y0; *(float4*)(outc + 64 * half + 8 * c8 + 4) = y1; }
    if (At_row) { uint4 o; o.x = pk2(y0.x, y0.y); o.y = pk2(y0.z, y0.w); o.z = pk2(y1.x, y1.y); o.w = pk2(y1.z, y1.w); *(uint4*)(At_row + 64 * half + 8 * c8) = o; }
    if (valid && Rl >= NPR) {
      const int j = Rl - NPR, b = j >> 6, r = j & 63;
      bf16_t* kl = p.KL + ((size_t)b * SKEYS + 1024 + r) * 160 + 16 * (4 * half + (c8 >> 1)) + 4 * (c8 & 1);
      *(uint2*)kl = pk4(y0.x, y0.y, y0.z, y0.w); *(uint2*)(kl + 8) = pk4(y1.x, y1.y, y1.z, y1.w);
    }
    if (c8 & 1) __builtin_amdgcn_sched_barrier(0);
  }
  if (half == 0) {
    const int pos = pos_of(Rl);
#pragma unroll
    for (int c8 = 0; c8 < 2; ++c8) {
      const uint4 u = *(const uint4*)(zr + ZE_KR + 8 * c8), v = *(const uint4*)(zr + ZE_KR + 16 + 8 * c8);
      const float x1[8] = {bflo(u.x), bfhi(u.x), bflo(u.y), bfhi(u.y), bflo(u.z), bfhi(u.z), bflo(u.w), bfhi(u.w)};
      const float x2[8] = {bflo(v.x), bfhi(v.x), bflo(v.y), bfhi(v.y), bflo(v.z), bfhi(v.z), bflo(v.w), bfhi(v.w)};
      float y1[8], y2[8];
#pragma unroll
      for (int e = 0; e < 8; ++e) {
        const float cs = p.ropec[pos * 16 + 8 * c8 + e], sn = p.ropes[pos * 16 + 8 * c8 + e];
        y1[e] = x1[e] * cs - x2[e] * sn; y2[e] = x1[e] * sn + x2[e] * cs;
      }
      if (valid) {
        float4 o;
        o.x = y1[0]; o.y = y1[1]; o.z = y1[2]; o.w = y1[3]; *(float4*)(outk + 8 * c8) = o;
        o.x = y1[4]; o.y = y1[5]; o.z = y1[6]; o.w = y1[7]; *(float4*)(outk + 8 * c8 + 4) = o;
        o.x = y2[0]; o.y = y2[1]; o.z = y2[2]; o.w = y2[3]; *(float4*)(outk + 16 + 8 * c8) = o;
        o.x = y2[4]; o.y = y2[5]; o.z = y2[6]; o.w = y2[7]; *(float4*)(outk + 16 + 8 * c8 + 4) = o;
        {
          const int j = Rl - NPR;
          bf16_t* krd = Rl < NPR ? p.Kr + (size_t)Rl * 32 : p.KL + ((size_t)(j >> 6) * SKEYS + 1024 + (j & 63)) * 160 + 128;
          uint4 q; q.x = pk2(y1[0], y1[1]); q.y = pk2(y1[2], y1[3]); q.z = pk2(y1[4], y1[5]); q.w = pk2(y1[6], y1[7]); *(uint4*)(krd + 8 * c8) = q;
          q.x = pk2(y2[0], y2[1]); q.y = pk2(y2[2], y2[3]); q.z = pk2(y2[4], y2[5]); q.w = pk2(y2[6], y2[7]); *(uint4*)(krd + 16 + 8 * c8) = q;
        }
      }
    }
  }
}
DEV void kvproj_item(const Prm& p, int L, int mt, char* lds) {
  int tid = threadIdx.x; LAUNDER(tid);
  const int lane = tid & 63, w = __builtin_amdgcn_readfirstlane(tid >> 6), wr = w >> 1, wc = w & 1, l31 = lane & 31, hh = lane >> 5;
  bf16_t* At = (bf16_t*)lds;
  bf16_t* Bs = At + 128 * 136;
  {
    const int r = tid >> 1, half = tid & 1, R = mt * 128 + r;
    kv_prep_row(p, L, R, half, R < NPR, At + r * 136);
  }
  for (int h = 0; h < 8; ++h) {
    __syncthreads();
    {
      const bf16_t* wsrc = p.Wb_ukv + ((size_t)L * 1024 + h * 128) * 128;
#pragma unroll
      for (int i = 0; i < 8; ++i) { const int id = tid + 256 * i, row = id >> 4, cc = id & 15; *(uint4*)(Bs + row * 136 + cc * 8) = *(const uint4*)(wsrc + row * 128 + cc * 8); }
    }
    __syncthreads();
    f32x16 acc[2][2];
#pragma unroll
    for (int i = 0; i < 2; ++i)
#pragma unroll
      for (int j = 0; j < 2; ++j) acc[i][j] = zero16();
    const bf16_t* as = At + (wr * 64 + l31) * 136 + hh * 8;
    const bf16_t* bs = Bs + (wc * 64 + l31) * 136 + hh * 8;
    if (wc == 0) {
#pragma unroll 2
      for (int ks = 0; ks < 8; ++ks) {
        const bf16x8 a0 = *(const bf16x8*)(as + ks * 16), a1 = *(const bf16x8*)(as + 32 * 136 + ks * 16);
        const bf16x8 b0 = *(const bf16x8*)(bs + ks * 16), b1 = *(const bf16x8*)(bs + 32 * 136 + ks * 16);
        acc[0][0] = mfma32(b0, a0, acc[0][0]); acc[0][1] = mfma32(b1, a0, acc[0][1]);
        acc[1][0] = mfma32(b0, a1, acc[1][0]); acc[1][1] = mfma32(b1, a1, acc[1][1]);
      }
#pragma unroll
      for (int i = 0; i < 2; ++i) {
        const int KRr = mt * 128 + wr * 64 + 32 * i + l31;
#pragma unroll
        for (int j = 0; j < 2; ++j)
#pragma unroll
          for (int G = 0; G < 4; ++G)
            *(uint2*)(p.Kn + ((size_t)KRr * 8 + h) * 64 + 32 * j + 8 * G + 4 * hh) = pk4(acc[i][j][4 * G], acc[i][j][4 * G + 1], acc[i][j][4 * G + 2], acc[i][j][4 * G + 3]);
      }
    } else {
#pragma unroll 2
      for (int ks = 0; ks < 8; ++ks) {
        const bf16x8 a0 = *(const bf16x8*)(as + ks * 16), a1 = *(const bf16x8*)(as + 32 * 136 + ks * 16);
        const bf16x8 b0 = *(const bf16x8*)(bs + ks * 16), b1 = *(const bf16x8*)(bs + 32 * 136 + ks * 16);
        acc[0][0] = mfma32(a0, b0, acc[0][0]); acc[0][1] = mfma32(a0, b1, acc[0][1]);
        acc[1][0] = mfma32(a1, b0, acc[1][0]); acc[1][1] = mfma32(a1, b1, acc[1][1]);
      }
#pragma unroll
      for (int j = 0; j < 2; ++j) {
        const int d = 32 * j + l31;
#pragma unroll
        for (int i = 0; i < 2; ++i)
#pragma unroll
          for (int G = 0; G < 4; ++G) {
            const int KRr = mt * 128 + wr * 64 + 32 * i + 16 * (G >> 1) + 8 * hh + 4 * (G & 1);
            *(uint2*)(p.Vt + ((size_t)h * 64 + d) * KVR + KRr) = pk4(acc[i][j][4 * G], acc[i][j][4 * G + 1], acc[i][j][4 * G + 2], acc[i][j][4 * G + 3]);
          }
      }
    }
  }
  __syncthreads();
}
DEV void sample_prep_item(const Prm& p, int L, int it) {
  int tid = threadIdx.x; LAUNDER(tid);
  const int R = NPR + it * 128 + (tid >> 1);
  kv_prep_row(p, L, R, tid & 1, true, nullptr);
}
DEV void shift_item(const Prm& p, int L, int st) {
  int tid0 = threadIdx.x; LAUNDER(tid0);
  if (tid0 < 224) {
    const int R = st < 4 ? st * PT + (PT - 1) : NPR + (st - 4) * 64 + 63;
    const uint2 u = *(const uint2*)(p.zE + (size_t)R * ZE + ZE_ZC + 4 * tid0);
    float4 v; v.x = bflo(u.x); v.y = bfhi(u.x); v.z = bflo(u.y); v.w = bfhi(u.y);
    float* dst = st < 4 ? p.shift_p + ((size_t)L * 4 + st) * 896 : p.shift_s + ((size_t)L * 32 + (st - 4)) * 896;
    *(float4*)(dst + 4 * tid0) = v;
  }
}

DEV void lat_item(const Prm& p, int L, int j) {
  int tid = threadIdx.x; LAUNDER(tid);
  const int b = j >> 4, t = j & 15;
  const float* csrc = p.cache_ckv + (((size_t)L * 32 + b) * 1024 + 64 * t) * 128;
  const float* ksrc = p.cache_krope + (((size_t)L * 32 + b) * 1024 + 64 * t) * 32;
  {
    const int row = tid >> 2, qd = tid & 3;
    const float* s = csrc + row * 128 + 32 * qd;
    bf16_t* d = p.KL + ((size_t)b * SKEYS + 64 * t + row) * 160;
    const float4 v0 = *(const float4*)(s), v1 = *(const float4*)(s + 4), v2 = *(const float4*)(s + 8), v3 = *(const float4*)(s + 12);
    const float4 v4 = *(const float4*)(s + 16), v5 = *(const float4*)(s + 20), v6 = *(const float4*)(s + 24), v7 = *(const float4*)(s + 28);
    const float4 k0 = *(const float4*)(ksrc + row * 32 + 8 * qd), k1 = *(const float4*)(ksrc + row * 32 + 8 * qd + 4);
    uint4 a;
    a.x = pk2(v0.x, v0.y); a.y = pk2(v0.z, v0.w); a.z = pk2(v2.x, v2.y); a.w = pk2(v2.z, v2.w); *(uint4*)(d + 32 * qd) = a;
    a.x = pk2(v1.x, v1.y); a.y = pk2(v1.z, v1.w); a.z = pk2(v3.x, v3.y); a.w = pk2(v3.z, v3.w); *(uint4*)(d + 32 * qd + 8) = a;
    a.x = pk2(v4.x, v4.y); a.y = pk2(v4.z, v4.w); a.z = pk2(v6.x, v6.y); a.w = pk2(v6.z, v6.w); *(uint4*)(d + 32 * qd + 16) = a;
    a.x = pk2(v5.x, v5.y); a.y = pk2(v5.z, v5.w); a.z = pk2(v7.x, v7.y); a.w = pk2(v7.z, v7.w); *(uint4*)(d + 32 * qd + 24) = a;
    a.x = pk2(k0.x, k0.y); a.y = pk2(k0.z, k0.w); a.z = pk2(k1.x, k1.y); a.w = pk2(k1.z, k1.w); *(uint4*)(d + 128 + 8 * qd) = a;
  }
}

template <bool SAMPLE>
DEV int attn_body(const Prm& p, int L, int sb, int head, int qt, char* lds, unsigned* nctr = nullptr) {
  int tid = threadIdx.x; LAUNDER(tid);
  const int lane = tid & 63, w = __builtin_amdgcn_readfirstlane(tid >> 6), l31 = lane & 31, hh = lane >> 5;
  bf16_t* Ks = (bf16_t*)lds;
  bf16_t* Vs = Ks + (SAMPLE ? 1 : 2) * 64 * 104;
  bf16_t* Cs = Vs + (SAMPLE ? 1 : 2) * 64 * 72;
  bf16_t* Wl = Cs + 64 * 136;
  const bf16_t* Qb = (const bf16_t*)p.y_prompt;
  bf16_t* mix = p.zE;
  int Rq0, ntiles, lastvis; bool wact, rowvalid;
  if (SAMPLE) { Rq0 = NPR + 64 * sb; ntiles = 17; lastvis = 16; wact = w < 2; rowvalid = wact; }
  else if (qt >= 0) { Rq0 = sb * PT + 16 + 128 * qt; ntiles = 2 * qt + 3; lastvis = 1 + 2 * qt + (w >> 1); wact = true; rowvalid = true; }
  else { Rq0 = sb * PT; ntiles = 1; lastvis = 0; wact = (w == 0); rowvalid = wact && l31 < 16; }
  const int myrow = Rq0 + 32 * w + l31;
  const int Rld = rowvalid ? myrow : Rq0;
  bf16x8 qf[6];
  {
    const bf16_t* qp = Qb + (size_t)Rld * 768 + head * 96 + hh * 8;
#pragma unroll
    for (int ks = 0; ks < 6; ++ks) qf[ks] = *(const bf16x8*)(qp + 16 * ks);
  }
  float m_run = -1e30f, l_run = 0.f;
  f32x16 o0 = zero16(), o1 = zero16();

  uint4 a_kn0, a_kn1, a_kr, a_vt0, a_vt1;
  a_kn0 = a_kn1 = a_kr = a_vt0 = a_vt1 = make_uint4(0, 0, 0, 0);
#define PLOADX(S, TI) { const int KR0 = sb * PT + ((TI) == 0 ? 0 : 16 + 64 * ((TI) - 1)); \
    S##_kn0 = *(const uint4*)(p.Kn + ((size_t)(KR0 + (tid >> 3)) * 8 + head) * 64 + (tid & 7) * 8); \
    S##_kn1 = *(const uint4*)(p.Kn + ((size_t)(KR0 + 32 + (tid >> 3)) * 8 + head) * 64 + (tid & 7) * 8); \
    S##_kr = *(const uint4*)(p.Kr + (size_t)(KR0 + (tid >> 2)) * 32 + (tid & 3) * 8); \
    S##_vt0 = *(const uint4*)(p.Vt + ((size_t)head * 64 + (tid >> 3)) * KVR + KR0 + (tid & 7) * 8); \
    S##_vt1 = *(const uint4*)(p.Vt + ((size_t)head * 64 + 32 + (tid >> 3)) * KVR + KR0 + (tid & 7) * 8); }
#define PWRITEX(S, BUF) { bf16_t* kb_ = Ks + (BUF) * 64 * 104; bf16_t* vb_ = Vs + (BUF) * 64 * 72; \
    *(uint4*)(kb_ + (tid >> 3) * 104 + (tid & 7) * 8) = S##_kn0; *(uint4*)(kb_ + (32 + (tid >> 3)) * 104 + (tid & 7) * 8) = S##_kn1; \
    *(uint4*)(kb_ + (tid >> 2) * 104 + 64 + (tid & 3) * 8) = S##_kr; \
    *(uint4*)(vb_ + (tid >> 3) * 72 + (tid & 7) * 8) = S##_vt0; *(uint4*)(vb_ + (32 + (tid >> 3)) * 72 + (tid & 7) * 8) = S##_vt1; }
  float4 pc0, pc1, pc2, pc3, pc4, pc5, pc6, pc7, pk0, pk1;
  pc0 = pc1 = pc2 = pc3 = pc4 = pc5 = pc6 = pc7 = pk0 = pk1 = make_float4(0.f, 0.f, 0.f, 0.f);
  if (SAMPLE) {
    const bf16_t* wsrc = p.Wb_ukv + ((size_t)L * 1024 + head * 128) * 128;
#pragma unroll
    for (int i = 0; i < 8; ++i) { const int id = tid + 256 * i, row = id >> 4, cc = id & 15; *(uint4*)(Wl + row * 136 + cc * 8) = *(const uint4*)(wsrc + row * 128 + cc * 8); }
  }
#define SLOAD(TI) { const float* csrc; const float* ksrc; \
    if ((TI) < 16) { csrc = p.cache_ckv + (((size_t)L * 32 + sb) * 1024 + 64 * (TI)) * 128; ksrc = p.cache_krope + (((size_t)L * 32 + sb) * 1024 + 64 * (TI)) * 32; } \
    else { csrc = p.ckv_s + ((size_t)L * NSM + 64 * sb) * 128; ksrc = p.kr_s + ((size_t)L * NSM + 64 * sb) * 32; } \
    const float* cb_ = csrc + (tid >> 5) * 128 + (tid & 31) * 4; \
    pc0 = *(const float4*)(cb_); pc1 = *(const float4*)(cb_ + 8 * 128); pc2 = *(const float4*)(cb_ + 16 * 128); pc3 = *(const float4*)(cb_ + 24 * 128); \
    pc4 = *(const float4*)(cb_ + 32 * 128); pc5 = *(const float4*)(cb_ + 40 * 128); pc6 = *(const float4*)(cb_ + 48 * 128); pc7 = *(const float4*)(cb_ + 56 * 128); \
    const float* kb2_ = ksrc + (tid >> 3) * 32 + (tid & 7) * 4; pk0 = *(const float4*)(kb2_); pk1 = *(const float4*)(kb2_ + 32 * 32); }
#define SWRITE(BUF) { bf16_t* cd_ = Cs + (tid >> 5) * 136 + (tid & 31) * 4; \
    *(uint2*)(cd_) = pk4(pc0.x, pc0.y, pc0.z, pc0.w); *(uint2*)(cd_ + 8 * 136) = pk4(pc1.x, pc1.y, pc1.z, pc1.w); \
    *(uint2*)(cd_ + 16 * 136) = pk4(pc2.x, pc2.y, pc2.z, pc2.w); *(uint2*)(cd_ + 24 * 136) = pk4(pc3.x, pc3.y, pc3.z, pc3.w); \
    *(uint2*)(cd_ + 32 * 136) = pk4(pc4.x, pc4.y, pc4.z, pc4.w); *(uint2*)(cd_ + 40 * 136) = pk4(pc5.x, pc5.y, pc5.z, pc5.w); \
    *(uint2*)(cd_ + 48 * 136) = pk4(pc6.x, pc6.y, pc6.z, pc6.w); *(uint2*)(cd_ + 56 * 136) = pk4(pc7.x, pc7.y, pc7.z, pc7.w); \
    }
#define SWRITEK(BUF) { bf16_t* kd_ = Ks + (BUF) * 64 * 104 + (tid >> 3) * 104 + 64 + (tid & 7) * 4; \
    *(uint2*)(kd_) = pk4(pk0.x, pk0.y, pk0.z, pk0.w); *(uint2*)(kd_ + 32 * 104) = pk4(pk1.x, pk1.y, pk1.z, pk1.w); }
  auto sexpand = [&](int buf) {
    const int a = w & 1, b = w >> 1;
    const bf16_t* cp = Cs + (32 * b + l31) * 136 + hh * 8;
    const bf16_t* wkp = Wl + (32 * a + l31) * 136 + hh * 8;
    const bf16_t* wvp = wkp + 64 * 136;
    f32x16 ka = zero16(), va = zero16();
#pragma unroll
    for (int ks = 0; ks < 8; ++ks) {
      const bf16x8 cf = *(const bf16x8*)(cp + 16 * ks);
      ka = mfma32(*(const bf16x8*)(wkp + 16 * ks), cf, ka);
      va = mfma32(cf, *(const bf16x8*)(wvp + 16 * ks), va);
    }
    bf16_t* kb = Ks + buf * 64 * 104; bf16_t* vb = Vs + buf * 64 * 72;
#pragma unroll
    for (int G = 0; G < 4; ++G) {
      *(uint2*)(kb + (32 * b + l31) * 104 + 32 * a + 8 * G + 4 * hh) = pk4(ka[4 * G], ka[4 * G + 1], ka[4 * G + 2], ka[4 * G + 3]);
      *(uint2*)(vb + (32 * a + l31) * 72 + 32 * b + 8 * G + 4 * hh) = pk4(va[4 * G], va[4 * G + 1], va[4 * G + 2], va[4 * G + 3]);
    }
  };
  const int x7 = (l31 >> 1) & 7, x3 = (l31 >> 2) & 3, xv = (l31 >> 1) & 7;
#define KFRAG(SP, KS, SUB) (SAMPLE ? *(const bf16x8*)((const bf16_t*)(SP) + (l31 + 32 * (SUB)) * 104 + hh * 8 + 16 * (KS)) \
    : ((KS) < 4 ? *(const bf16x8*)((SP) + (l31 + 32 * (SUB)) * 128 + (((2 * (KS) + hh) ^ x7) << 4)) \
                : *(const bf16x8*)((SP) + 8192 + (l31 + 32 * (SUB)) * 64 + (((2 * ((KS) - 4) + hh) ^ x3) << 4))))
#define VFR(S, SUB) (*(const bf16x8*)(sp + 12288 + (l31 + 32 * (SUB)) * 128 + (((2 * (S) + hh) ^ xv) << 4)))
#define VHALF(SP, C, SUB) (SAMPLE ? *(const uint2*)((const bf16_t*)(SP) + 64 * 104 + (l31 + 32 * (SUB)) * 72 + 4 * hh + 8 * (C)) \
    : *(const uint2*)((SP) + 12288 + (l31 + 32 * (SUB)) * 128 + 8 * hh + ((((C)) ^ xv) << 4)))
  auto compute_t = [&](auto masked_c, const char* sp) {
    constexpr bool MASKED = decltype(masked_c)::value;
    f32x16 s0 = zero16(), s1 = zero16();
    {
      bf16x8 kf[12];
#pragma unroll
      for (int ks = 0; ks < 6; ++ks) { kf[2 * ks] = KFRAG(sp, ks, 0); kf[2 * ks + 1] = KFRAG(sp, ks, 1); }
      __builtin_amdgcn_sched_barrier(0);
#pragma unroll
      for (int ks = 0; ks < 6; ++ks) { s0 = mfma32(kf[2 * ks], qf[ks], s0); s1 = mfma32(kf[2 * ks + 1], qf[ks], s1); }
    }
    bf16x8 vf[8];
    if (!SAMPLE) {
#pragma unroll
      for (int S = 0; S < 4; ++S) { vf[2 * S] = VFR(S, 0); vf[2 * S + 1] = VFR(S, 1); }
      __builtin_amdgcn_sched_barrier(0);
    }
    if (!SAMPLE && MASKED) {
#pragma unroll
      for (int r = 8; r < 16; ++r) s0[r] = -1e30f;
#pragma unroll
      for (int r = 0; r < 16; ++r) s1[r] = -1e30f;
    }
    float mx = s0[0];
#pragma unroll
    for (int r = 1; r < 16; ++r) mx = fmaxf(mx, s0[r]);
#pragma unroll
    for (int r = 0; r < 16; ++r) mx = fmaxf(mx, s1[r]);
    mx = fmaxf(mx, __shfl_xor(mx, 32));
    const float mnew = fmaxf(m_run, mx);
    const float alpha = __builtin_amdgcn_exp2f(m_run - mnew);
    m_run = mnew;
    float ps = 0.f;
#pragma unroll
    for (int r = 0; r < 16; ++r) { s0[r] = __builtin_amdgcn_exp2f(s0[r] - mnew); ps += s0[r]; }
#pragma unroll
    for (int r = 0; r < 16; ++r) { s1[r] = __builtin_amdgcn_exp2f(s1[r] - mnew); ps += s1[r]; }
    l_run = l_run * alpha + ps;
#pragma unroll
    for (int r = 0; r < 16; ++r) { o0[r] *= alpha; o1[r] *= alpha; }
    const bf16x8 pf0 = mk8(pk2(s0[0], s0[1]), pk2(s0[2], s0[3]), pk2(s0[4], s0[5]), pk2(s0[6], s0[7]));
    const bf16x8 pf1 = mk8(pk2(s0[8], s0[9]), pk2(s0[10], s0[11]), pk2(s0[12], s0[13]), pk2(s0[14], s0[15]));
    const bf16x8 pf2 = mk8(pk2(s1[0], s1[1]), pk2(s1[2], s1[3]), pk2(s1[4], s1[5]), pk2(s1[6], s1[7]));
    const bf16x8 pf3 = mk8(pk2(s1[8], s1[9]), pk2(s1[10], s1[11]), pk2(s1[12], s1[13]), pk2(s1[14], s1[15]));
#define PV_STEP(S, PF) { bf16x8 v0_, v1_; \
      if (SAMPLE) { const uint2 a0 = VHALF(sp, 2 * S, 0), b0 = VHALF(sp, 2 * S + 1, 0), a1 = VHALF(sp, 2 * S, 1), b1 = VHALF(sp, 2 * S + 1, 1); \
        v0_ = mk8(a0.x, a0.y, b0.x, b0.y); v1_ = mk8(a1.x, a1.y, b1.x, b1.y); } \
      else { v0_ = *(const bf16x8*)(sp + 12288 + l31 * 128 + (((2 * S + hh) ^ xv) << 4)); v1_ = *(const bf16x8*)(sp + 12288 + (l31 + 32) * 128 + (((2 * S + hh) ^ xv) << 4)); } \
      o0 = mfma32(v0_, PF, o0); o1 = mfma32(v1_, PF, o1); }
    if (SAMPLE) { PV_STEP(0, pf0) PV_STEP(1, pf1) PV_STEP(2, pf2) PV_STEP(3, pf3) }
    else {
      o0 = mfma32(vf[0], pf0, o0); o1 = mfma32(vf[1], pf0, o1); o0 = mfma32(vf[2], pf1, o0); o1 = mfma32(vf[3], pf1, o1);
      o0 = mfma32(vf[4], pf2, o0); o1 = mfma32(vf[5], pf2, o1); o0 = mfma32(vf[6], pf3, o0); o1 = mfma32(vf[7], pf3, o1);
    }
  };
  auto compute_meta = [&](const char* sp) {
    f32x16 s0 = zero16();
    {
      bf16x8 kf[6];
#pragma unroll
      for (int ks = 0; ks < 6; ++ks) kf[ks] = KFRAG(sp, ks, 0);
      __builtin_amdgcn_sched_barrier(0);
#pragma unroll
      for (int ks = 0; ks < 6; ++ks) s0 = mfma32(kf[ks], qf[ks], s0);
    }
    const bf16x8 v0 = VFR(0, 0), v1 = VFR(0, 1);
    float mx = s0[0];
#pragma unroll
    for (int r = 1; r < 8; ++r) mx = fmaxf(mx, s0[r]);
    mx = fmaxf(mx, __shfl_xor(mx, 32));
    m_run = mx;
    float ps = 0.f;
#pragma unroll
    for (int r = 0; r < 8; ++r) { s0[r] = __builtin_amdgcn_exp2f(s0[r] - mx); ps += s0[r]; }
    l_run = ps;
    const bf16x8 pf0 = mk8(pk2(s0[0], s0[1]), pk2(s0[2], s0[3]), pk2(s0[4], s0[5]), pk2(s0[6], s0[7]));
    o0 = mfma32(v0, pf0, zero16()); o1 = mfma32(v1, pf0, zero16());
  };
  bf16x8 qf7 = mk8(0u, 0u, 0u, 0u);
  const bf16x8 kone = mk8(hh == 0 ? 0x3F80u : 0u, 0u, 0u, 0u);
  auto freeze = [&]() {
    const float mf = bflo(pk2(m_run, 0.f));
    const float fac = __builtin_amdgcn_exp2f(m_run - mf);
    l_run *= fac;
#pragma unroll
    for (int r = 0; r < 16; ++r) { o0[r] *= fac; o1[r] *= fac; }
    qf7 = mk8(hh == 0 ? (pk2(-mf, 0.f) & 0xffffu) : 0u, 0u, 0u, 0u);
  };
  auto compute_f = [&](const char* sp) {
    f32x16 s0, s1;
    {
      bf16x8 kf[12];
#pragma unroll
      for (int ks = 0; ks < 6; ++ks) { kf[2 * ks] = KFRAG(sp, ks, 0); kf[2 * ks + 1] = KFRAG(sp, ks, 1); }
      __builtin_amdgcn_sched_barrier(0);
      s0 = mfma32(kone, qf7, zero16()); s1 = mfma32(kone, qf7, zero16());
#pragma unroll
      for (int ks = 0; ks < 6; ++ks) { s0 = mfma32(kf[2 * ks], qf[ks], s0); s1 = mfma32(kf[2 * ks + 1], qf[ks], s1); }
    }
    bf16x8 vf[8];
    if (!SAMPLE) {
#pragma unroll
      for (int S = 0; S < 4; ++S) { vf[2 * S] = VFR(S, 0); vf[2 * S + 1] = VFR(S, 1); }
      __builtin_amdgcn_sched_barrier(0);
    }
    float ps = 0.f;
#pragma unroll
    for (int r = 0; r < 16; ++r) { s0[r] = __builtin_amdgcn_exp2f(s0[r]); ps += s0[r]; }
#pragma unroll
    for (int r = 0; r < 16; ++r) { s1[r] = __builtin_amdgcn_exp2f(s1[r]); ps += s1[r]; }
    l_run += ps;
    const bf16x8 pf0 = mk8(pk2(s0[0], s0[1]), pk2(s0[2], s0[3]), pk2(s0[4], s0[5]), pk2(s0[6], s0[7]));
    const bf16x8 pf1 = mk8(pk2(s0[8], s0[9]), pk2(s0[10], s0[11]), pk2(s0[12], s0[13]), pk2(s0[14], s0[15]));
    const bf16x8 pf2 = mk8(pk2(s1[0], s1[1]), pk2(s1[2], s1[3]), pk2(s1[4], s1[5]), pk2(s1[6], s1[7]));
    const bf16x8 pf3 = mk8(pk2(s1[8], s1[9]), pk2(s1[10], s1[11]), pk2(s1[12], s1[13]), pk2(s1[14], s1[15]));
    if (SAMPLE) { PV_STEP(0, pf0) PV_STEP(1, pf1) PV_STEP(2, pf2) PV_STEP(3, pf3) }
    else {
      o0 = mfma32(vf[0], pf0, o0); o1 = mfma32(vf[1], pf0, o1); o0 = mfma32(vf[2], pf1, o0); o1 = mfma32(vf[3], pf1, o1);
      o0 = mfma32(vf[4], pf2, o0); o1 = mfma32(vf[5], pf2, o1); o0 = mfma32(vf[6], pf3, o0); o1 = mfma32(vf[7], pf3, o1);
    }
#undef PV_STEP
  };

  if (SAMPLE) {
    SLOAD(0)
    for (int ti = 0; ti < ntiles; ++ti) {
      const int buf = 0;
      SWRITE(buf)
      __syncthreads();
      SWRITEK(buf)
      { const int tn = ti + 1 < ntiles ? ti + 1 : ti; SLOAD(tn) }
      sexpand(buf);
      __syncthreads();
      if (wact) { if (ti == 0) { compute_t(std::false_type{}, (const char*)Ks); freeze(); } else compute_f((const char*)Ks); }
    }
    __syncthreads();
  } else {
    const int l8 = lane >> 3, c8 = lane & 7;
    unsigned kn_o0, kn_o1, kr_o, vt_o0, vt_o1;
    { const int r = 8 * (2 * w) + l8; kn_o0 = (unsigned)((r * 8 + head) * 64 + ((c8 ^ ((r >> 1) & 7)) * 8)); }
    { const int r = 8 * (2 * w + 1) + l8; kn_o1 = (unsigned)((r * 8 + head) * 64 + ((c8 ^ ((r >> 1) & 7)) * 8)); }
    { const int r = 16 * w + (lane >> 2); kr_o = (unsigned)(r * 32 + (((lane & 3) ^ ((r >> 2) & 3)) * 8)); }
    { const int d = 8 * (2 * w) + l8; vt_o0 = (unsigned)((head * 64 + d) * KVR + ((c8 ^ ((d >> 1) & 7)) * 8)); }
    { const int d = 8 * (2 * w + 1) + l8; vt_o1 = (unsigned)((head * 64 + d) * KVR + ((c8 ^ ((d >> 1) & 7)) * 8)); }
#define GLDS16(G, Lp) __builtin_amdgcn_global_load_lds((const unsigned*)(G), (LAS3 unsigned*)(Lp), 16, 0, 0)
#define PDMA(TI, STG) { const int KR0 = sb * PT + ((TI) == 0 ? 0 : 16 + 64 * ((TI) - 1)); char* sb_ = lds + (STG) * 20480 + lane * 16; \
      const bf16_t* kn_ = p.Kn + (size_t)KR0 * 512; const bf16_t* kr_ = p.Kr + (size_t)KR0 * 32; const bf16_t* vt_ = p.Vt + KR0; \
      GLDS16(kn_ + kn_o0, sb_ + (2 * w) * 1024); GLDS16(kn_ + kn_o1, sb_ + (2 * w + 1) * 1024); GLDS16(kr_ + kr_o, sb_ + 8192 + w * 1024); \
      GLDS16(vt_ + vt_o0, sb_ + 12288 + (2 * w) * 1024); GLDS16(vt_ + vt_o1, sb_ + 12288 + (2 * w + 1) * 1024); }
    PDMA(0, 0)
    if (ntiles > 1) PDMA(1, 1)
    int stg = 0, stg2 = 2;
    for (int ti = 0; ti < ntiles; ++ti) {
      if (ti + 1 < ntiles) asm volatile("s_waitcnt vmcnt(5)" ::: "memory"); else asm volatile("s_waitcnt vmcnt(0)" ::: "memory");
      RAW_BARRIER()
      if (ti + 2 < ntiles) PDMA(ti + 2, stg2)
      const char* sp = lds + stg * 20480;
      if (ti == 0) { if (wact) compute_meta(sp); }
      else if (ti == 1) { compute_t(std::false_type{}, sp); freeze(); }
      else if (ti <= lastvis) compute_f(sp);
      stg = stg == 2 ? 0 : stg + 1; stg2 = stg2 == 2 ? 0 : stg2 + 1;
    }
    __syncthreads();
#undef PDMA
#undef GLDS16
  }
  int tk = 0x7fffffff; if (nctr && tid == 0) tk = (int)atomicAdd(nctr, 1u);
  const float lt = l_run + __shfl_xor(l_run, 32);
  if (rowvalid) {
    const float inv = 1.f / lt;
    const bf16_t* gbp = p.zL + (size_t)myrow * ZL + ZL_GB + 64 * head;
    bf16_t* op = mix + (size_t)myrow * D + 256 + 64 * head;
#pragma unroll
    for (int G = 0; G < 4; ++G) {
      const int d = 8 * G + 4 * hh;
      const uint2 g0 = *(const uint2*)(gbp + d), g1 = *(const uint2*)(gbp + 32 + d);
      *(uint2*)(op + d) = pk4(o0[4 * G] * inv * silu_(bflo(g0.x)), o0[4 * G + 1] * inv * silu_(bfhi(g0.x)), o0[4 * G + 2] * inv * silu_(bflo(g0.y)), o0[4 * G + 3] * inv * silu_(bfhi(g0.y)));
      *(uint2*)(op + 32 + d) = pk4(o1[4 * G] * inv * silu_(bflo(g1.x)), o1[4 * G + 1] * inv * silu_(bfhi(g1.x)), o1[4 * G + 2] * inv * silu_(bflo(g1.y)), o1[4 * G + 3] * inv * silu_(bfhi(g1.y)));
    }
  }
  return tk;
}
DEV void attn_item(const Prm& p, int L, int id, char* lds) {
  if (id < 1024) { const int qt = 31 - (id >> 5), sh = id & 31; attn_body<false>(p, L, sh >> 3, sh & 7, qt, lds); }
  else { const int j = id - 1280; attn_body<false>(p, L, j >> 3, j & 7, -1, lds); }
}

typedef short v4i16_t __attribute__((ext_vector_type(4)));
DEV uint2 lds_tr16(const char* pl) { const v4i16_t r = __builtin_amdgcn_ds_read_tr16_b64_v4i16((__attribute__((address_space(3))) v4i16_t*)pl); return __builtin_bit_cast(uint2, r); }
DEV void attn_sample(const Prm& p, int L, int b, int hp, char* lds) {
  int tid = threadIdx.x; LAUNDER(tid);
  const int lane = tid & 63, w = __builtin_amdgcn_readfirstlane(tid >> 6), l31 = lane & 31, hh = lane >> 5;
  const int head = 2 * hp + (w >> 1);
  const bf16_t* Qb = (const bf16_t*)p.y_prompt;
  bf16_t* mix = p.zE;
  const int myrow = NPR + 64 * b + 32 * (w & 1) + l31;
  bf16x8 qf[6];
  {
    const bf16_t* qp = Qb + (size_t)myrow * 768 + head * 96 + hh * 8;
#pragma unroll
    for (int ks = 0; ks < 6; ++ks) qf[ks] = *(const bf16x8*)(qp + 16 * ks);
  }
  unsigned kl_o0, kl_o1, kl_o2, kl_o3, kr_o;
  {
    const int l16 = lane >> 4, c16 = lane & 15;
#define KROW(i) (4 * (4 * w + (i)) + l16)
#define KLO(i) ((unsigned)(KROW(i) * 160 + ((c16 ^ (((KROW(i) & 3) << 2) | ((KROW(i) >> 2) & 3))) * 8)))
    kl_o0 = KLO(0); kl_o1 = KLO(1); kl_o2 = KLO(2); kl_o3 = KLO(3);
#undef KLO
#undef KROW
    const int r = 16 * w + (lane >> 2);
    kr_o = (unsigned)(r * 160 + 128 + (((lane & 3) ^ ((r >> 2) & 3)) * 8));
  }
  const bf16_t* klb = p.KL + (size_t)b * SKEYS * 160;
#define GLDS16(G, Lp) __builtin_amdgcn_global_load_lds((const unsigned*)(G), (LAS3 unsigned*)(Lp), 16, 0, 0)
#define SDMA(TI, STG) { char* sb_ = lds + (STG) * 20480 + lane * 16; const bf16_t* kl_ = klb + (size_t)(TI) * 64 * 160; \
    GLDS16(kl_ + kl_o0, sb_ + (4 * w) * 1024); GLDS16(kl_ + kl_o1, sb_ + (4 * w + 1) * 1024); GLDS16(kl_ + kl_o2, sb_ + (4 * w + 2) * 1024); GLDS16(kl_ + kl_o3, sb_ + (4 * w + 3) * 1024); \
    GLDS16(kl_ + kr_o, sb_ + 16384 + w * 1024); }
  SDMA(0, 0)
  SDMA(1, 1)
  bf16x8 qa0, qa1, qa2, qa3, qa4, qa5, qa6, qa7;
  {
    const float* wsrc = p.w_ukv + ((size_t)L * 128 + l31) * 1024 + head * 128 + 8 * hh;
#define QABS(CT, QA, QB) { f32x16 acc = zero16(); \
      _Pragma("unroll") for (int ks = 0; ks < 4; ++ks) { const float* s_ = wsrc + (size_t)(32 * (CT)) * 1024 + 16 * ks; const float4 a_ = *(const float4*)s_, c_ = *(const float4*)(s_ + 4); \
        acc = mfma32(mk8(pk2(a_.x, a_.y), pk2(a_.z, a_.w), pk2(c_.x, c_.y), pk2(c_.z, c_.w)), qf[ks], acc); } \
      QA = mk8(pk2(acc[0], acc[1]), pk2(acc[2], acc[3]), pk2(acc[4], acc[5]), pk2(acc[6], acc[7])); \
      QB = mk8(pk2(acc[8], acc[9]), pk2(acc[10], acc[11]), pk2(acc[12], acc[13]), pk2(acc[14], acc[15])); }
    QABS(0, qa0, qa1) QABS(1, qa2, qa3) QABS(2, qa4, qa5) QABS(3, qa6, qa7)
#undef QABS
  }
  float m_run = -1e30f, l_run = 0.f;
  f32x16 o0 = zero16(), o1 = zero16(), o2 = zero16(), o3 = zero16();
  bf16x8 qf7 = mk8(0u, 0u, 0u, 0u);
  const bf16x8 kone = mk8(hh == 0 ? 0x3F80u : 0u, 0u, 0u, 0u);
  const int xk = ((l31 & 3) << 2) | ((l31 >> 2) & 3), x3 = (l31 >> 2) & 3;
  int va0, va1;
  {
    const int g = l31 >> 4, q = (l31 >> 2) & 3, pp = l31 & 3;
    const int rowb = (4 * hh + q) * 256 + 8 * (pp & 1) + (q << 6);
    va0 = rowb + (((2 * g + (pp >> 1)) ^ hh) << 4);
    va1 = rowb + 2048 + (((2 * g + (pp >> 1)) ^ (hh + 2)) << 4);
  }
  int stg = 0, stg2 = 2;
  for (int ti = 0; ti < 17; ++ti) {
    if (ti + 1 < 17) asm volatile("s_waitcnt vmcnt(5)" ::: "memory"); else asm volatile("s_waitcnt vmcnt(0)" ::: "memory");
    RAW_BARRIER()
    if (ti + 2 < 17) SDMA(ti + 2, stg2)
    const char* sp = lds + stg * 20480;
    f32x16 s0 = mfma32(kone, qf7, zero16()), s1 = s0;
#define QKL(S, QA) { const bf16x8 k0 = *(const bf16x8*)(sp + l31 * 256 + (((2 * (S) + hh) ^ xk) << 4)), k1 = *(const bf16x8*)(sp + (l31 + 32) * 256 + (((2 * (S) + hh) ^ xk) << 4)); \
      s0 = mfma32(k0, QA, s0); s1 = mfma32(k1, QA, s1); }
    QKL(0, qa0) QKL(1, qa1) QKL(2, qa2) QKL(3, qa3) QKL(4, qa4) QKL(5, qa5) QKL(6, qa6) QKL(7, qa7)
#undef QKL
#pragma unroll
    for (int kr = 0; kr < 2; ++kr) {
      const bf16x8 k0 = *(const bf16x8*)(sp + 16384 + l31 * 64 + (((2 * kr + hh) ^ x3) << 4)), k1 = *(const bf16x8*)(sp + 16384 + (l31 + 32) * 64 + (((2 * kr + hh) ^ x3) << 4));
      s0 = mfma32(k0, qf[4 + kr], s0); s1 = mfma32(k1, qf[4 + kr], s1);
    }
    float ps = 0.f;
    if (ti == 0) {
      float mx = s0[0];
#pragma unroll
      for (int r = 1; r < 16; ++r) mx = fmaxf(mx, s0[r]);
#pragma unroll
      for (int r = 0; r < 16; ++r) mx = fmaxf(mx, s1[r]);
      mx = fmaxf(mx, __shfl_xor(mx, 32));
      m_run = bflo(pk2(mx, 0.f));
#pragma unroll
      for (int r = 0; r < 16; ++r) { s0[r] -= m_run; s1[r] -= m_run; }
      qf7 = mk8(hh == 0 ? (pk2(-m_run, 0.f) & 0xffffu) : 0u, 0u, 0u, 0u);
    }
#pragma unroll
    for (int r = 0; r < 16; ++r) { s0[r] = __builtin_amdgcn_exp2f(s0[r]); ps += s0[r]; }
#pragma unroll
    for (int r = 0; r < 16; ++r) { s1[r] = __builtin_amdgcn_exp2f(s1[r]); ps += s1[r]; }
    l_run += ps;
    const bf16x8 pf0 = mk8(pk2(s0[0], s0[1]), pk2(s0[2], s0[3]), pk2(s0[4], s0[5]), pk2(s0[6], s0[7]));
    const bf16x8 pf1 = mk8(pk2(s0[8], s0[9]), pk2(s0[10], s0[11]), pk2(s0[12], s0[13]), pk2(s0[14], s0[15]));
    const bf16x8 pf2 = mk8(pk2(s1[0], s1[1]), pk2(s1[2], s1[3]), pk2(s1[4], s1[5]), pk2(s1[6], s1[7]));
    const bf16x8 pf3 = mk8(pk2(s1[8], s1[9]), pk2(s1[10], s1[11]), pk2(s1[12], s1[13]), pk2(s1[14], s1[15]));
#define PVT(S, CT, PF, OT) { const uint2 a_ = lds_tr16(sp + (va0 ^ ((CT) << 6)) + (S) * 4096), b_ = lds_tr16(sp + (va1 ^ ((CT) << 6)) + (S) * 4096); \
      OT = mfma32(mk8(a_.x, a_.y, b_.x, b_.y), PF, OT); }
#define PVL(S, PF) PVT(S, 0, PF, o0) PVT(S, 1, PF, o1) PVT(S, 2, PF, o2) PVT(S, 3, PF, o3)
    PVL(0, pf0) PVL(1, pf1) PVL(2, pf2) PVL(3, pf3)
#undef PVL
#undef PVT
    stg = stg == 2 ? 0 : stg + 1; stg2 = stg2 == 2 ? 0 : stg2 + 1;
  }
#undef SDMA
#undef GLDS16
  __syncthreads();
  const float lt = l_run + __shfl_xor(l_run, 32);
  const float inv = 1.f / lt;
  f32x16 e0 = zero16(), e1 = zero16();
  const bf16_t* wv = p.Wb_ukv + ((size_t)L * 1024 + head * 128 + 64 + l31) * 128 + 8 * hh;
#define OEXP(S, OT, RB) { const bf16x8 ob = mk8(pk2(OT[RB] * inv, OT[RB + 1] * inv), pk2(OT[RB + 2] * inv, OT[RB + 3] * inv), pk2(OT[RB + 4] * inv, OT[RB + 5] * inv), pk2(OT[RB + 6] * inv, OT[RB + 7] * inv)); \
    e0 = mfma32(*(const bf16x8*)(wv + 16 * (S)), ob, e0); e1 = mfma32(*(const bf16x8*)(wv + 32 * 128 + 16 * (S)), ob, e1); }
  OEXP(0, o0, 0) OEXP(1, o0, 8) OEXP(2, o1, 0) OEXP(3, o1, 8) OEXP(4, o2, 0) OEXP(5, o2, 8) OEXP(6, o3, 0) OEXP(7, o3, 8)
#undef OEXP
  {
    const bf16_t* gbp = p.zL + (size_t)myrow * ZL + ZL_GB + 64 * head;
    bf16_t* op = mix + (size_t)myrow * D + 256 + 64 * head;
#pragma unroll
    for (int G = 0; G < 4; ++G) {
      const int d = 8 * G + 4 * hh;
      const uint2 g0 = *(const uint2*)(gbp + d), g1 = *(const uint2*)(gbp + 32 + d);
      *(uint2*)(op + d) = pk4(e0[4 * G] * silu_(bflo(g0.x)), e0[4 * G + 1] * silu_(bfhi(g0.x)), e0[4 * G + 2] * silu_(bflo(g0.y)), e0[4 * G + 3] * silu_(bfhi(g0.y)));
      *(uint2*)(op + 32 + d) = pk4(e1[4 * G] * silu_(bflo(g1.x)), e1[4 * G + 1] * silu_(bfhi(g1.x)), e1[4 * G + 2] * silu_(bflo(g1.y)), e1[4 * G + 3] * silu_(bfhi(g1.y)));
    }
  }
}

DEV void conv_item(const Prm& p, int L, int item) {
  int tid = threadIdx.x; LAUNDER(tid);
  bf16_t* mix = p.zE;
  const int c0 = (tid & 31) * 8;
  float w0[8], w1[8], w2[8];
#pragma unroll
  for (int e = 0; e < 8; ++e) { w0[e] = p.conv_w[(L * 3 + 0) * 256 + c0 + e]; w1[e] = p.conv_w[(L * 3 + 1) * 256 + c0 + e]; w2[e] = p.conv_w[(L * 3 + 2) * 256 + c0 + e]; }
  for (int it = 0; it < 4; ++it) {
    const int R = item * 32 + it * 8 + (tid >> 5);
    if (R >= NT) continue;
    int q, T; const float* st; float* so;
    if (R < NPR) { const int s = R / PT; q = R - s * PT; T = PT; st = nullptr; so = p.conv_p + ((size_t)L * 4 + s) * 512; }
    else { const int b = (R - NPR) >> 6; q = (R - NPR) & 63; T = 64; st = p.state_conv + ((size_t)L * 32 + b) * 512; so = p.conv_s + ((size_t)L * 32 + b) * 512; }
    float u[3][8];
#pragma unroll
    for (int dlt = 0; dlt < 3; ++dlt) {
      const int t = q - 2 + dlt;
      if (t >= 0) {
        const bf16_t* zr = p.zL + (size_t)(R - 2 + dlt) * ZL;
        const uint4 xi = *(const uint4*)(zr + ZL_XIN + c0), cg = *(const uint4*)(zr + ZL_CG + c0);
        u[dlt][0] = bflo(xi.x) * bflo(cg.x); u[dlt][1] = bfhi(xi.x) * bfhi(cg.x); u[dlt][2] = bflo(xi.y) * bflo(cg.y); u[dlt][3] = bfhi(xi.y) * bfhi(cg.y);
        u[dlt][4] = bflo(xi.z) * bflo(cg.z); u[dlt][5] = bfhi(xi.z) * bfhi(cg.z); u[dlt][6] = bflo(xi.w) * bflo(cg.w); u[dlt][7] = bfhi(xi.w) * bfhi(cg.w);
      } else if (st) {
        const float* sr = st + (t + 2) * 256 + c0;
#pragma unroll
        for (int e = 0; e < 8; ++e) u[dlt][e] = sr[e];
      } else {
#pragma unroll
        for (int e = 0; e < 8; ++e) u[dlt][e] = 0.f;
      }
    }
    const bf16_t* zr = p.zL + (size_t)R * ZL;
    const uint4 bg = *(const uint4*)(zr + ZL_BG + c0), ga = *(const uint4*)(zr + ZL_GA + c0);
    const float bgf[8] = {bflo(bg.x), bfhi(bg.x), bflo(bg.y), bfhi(bg.y), bflo(bg.z), bfhi(bg.z), bflo(bg.w), bfhi(bg.w)};
    const float gaf[8] = {bflo(ga.x), bfhi(ga.x), bflo(ga.y), bfhi(ga.y), bflo(ga.z), bfhi(ga.z), bflo(ga.w), bfhi(ga.w)};
    float y[8];
#pragma unroll
    for (int e = 0; e < 8; ++e) y[e] = bgf[e] * (w0[e] * u[0][e] + w1[e] * u[1][e] + w2[e] * u[2][e]) * silu_(gaf[e]);
    uint4 o; o.x = pk2(y[0], y[1]); o.y = pk2(y[2], y[3]); o.z = pk2(y[4], y[5]); o.w = pk2(y[6], y[7]);
    *(uint4*)(mix + (size_t)R * D + c0) = o;
    if (q >= T - 2) {
      float* d = so + (q - (T - 2)) * 256 + c0;
#pragma unroll
      for (int e = 0; e < 8; ++e) d[e] = u[2][e];
    }
  }
}

DEV int kperm_addr(int m, int kin) {
  const int mt = m >> 4, ml = m & 15, s = kin >> 5, q = (kin >> 4) & 1, g = (kin >> 2) & 3, e = kin & 3;
  return (((mt * 2 + s) * 64 + ml + 16 * g) * 8) + 4 * q + e;
}
DEV int clay_addr(int x, int v) {
  const int xt = x >> 4, g = (x >> 2) & 3, rr = x & 3, vt = v >> 4, l16 = v & 15;
  return ((xt * 4 + vt) * 64 + 16 * g + l16) * 4 + rr;
}
DEV void mm64(const bf16_t* first, const bf16_t* second, int l31, int hh, f32x16 (&acc)[2][2]) {
#pragma unroll
  for (int ks = 0; ks < 4; ++ks) {
    const bf16x8 f0 = *(const bf16x8*)(first + l31 * 72 + ks * 16 + hh * 8), f1 = *(const bf16x8*)(first + (32 + l31) * 72 + ks * 16 + hh * 8);
    const bf16x8 s0 = *(const bf16x8*)(second + l31 * 72 + ks * 16 + hh * 8), s1 = *(const bf16x8*)(second + (32 + l31) * 72 + ks * 16 + hh * 8);
    acc[0][0] = mfma32(f0, s0, acc[0][0]); acc[0][1] = mfma32(f0, s1, acc[0][1]);
    acc[1][0] = mfma32(f1, s0, acc[1][0]); acc[1][1] = mfma32(f1, s1, acc[1][1]);
  }
}
DEV void mm64x32(const bf16_t* first, const bf16_t* second_rows, int l31, int hh, f32x16 (&acc)[2]) {
#pragma unroll
  for (int ks = 0; ks < 4; ++ks) {
    const bf16x8 f0 = *(const bf16x8*)(first + l31 * 72 + ks * 16 + hh * 8), f1 = *(const bf16x8*)(first + (32 + l31) * 72 + ks * 16 + hh * 8);
    const bf16x8 s0 = *(const bf16x8*)(second_rows + l31 * 72 + ks * 16 + hh * 8);
    acc[0] = mfma32(f0, s0, acc[0]); acc[1] = mfma32(f1, s0, acc[1]);
  }
}

DEV void mmq(const bf16_t* first_rows, const bf16_t* second_rows, int l31, int hh, f32x16& acc) {
#pragma unroll
  for (int ks = 0; ks < 4; ++ks) {
    const bf16x8 f0 = *(const bf16x8*)(first_rows + l31 * 72 + ks * 16 + hh * 8);
    const bf16x8 s0 = *(const bf16x8*)(second_rows + l31 * 72 + ks * 16 + hh * 8);
    acc = mfma32(f0, s0, acc);
  }
}
enum { SH_FULL = 0, SH_UP = 1, SH_LO = 2 };
template <int SH> DEV constexpr bool tile_nz(int tx, int ty) { return SH == SH_FULL || (SH == SH_UP ? tx <= ty : tx >= ty); }
struct Acc64 { f32x16 t[2][2]; };
struct Frag64 { bf16x8 f[4][2]; };
template <int SS> DEV bf16x8 pack8(const f32x16& v) {
  return mk8(pk2(v[8 * SS], v[8 * SS + 1]), pk2(v[8 * SS + 2], v[8 * SS + 3]), pk2(v[8 * SS + 4], v[8 * SS + 5]), pk2(v[8 * SS + 6], v[8 * SS + 7]));
}
template <int SH> DEV void to_frag(const Acc64& X, Frag64& F) {
#pragma unroll
  for (int t = 0; t < 2; ++t) {
    if (tile_nz<SH>(0, t)) { F.f[0][t] = pack8<0>(X.t[0][t]); F.f[1][t] = pack8<1>(X.t[0][t]); }
    if (tile_nz<SH>(1, t)) { F.f[2][t] = pack8<0>(X.t[1][t]); F.f[3][t] = pack8<1>(X.t[1][t]); }
  }
}
template <int SH> DEV void zero_acc(Acc64& X) {
#pragma unroll
  for (int a = 0; a < 2; ++a)
#pragma unroll
    for (int b = 0; b < 2; ++b) if (tile_nz<SH>(a, b)) X.t[a][b] = zero16();
}
template <int SHA, int SHB> DEV void prod_ff(const Frag64& A, const Frag64& B, Acc64& D) {
#pragma unroll
  for (int tm = 0; tm < 2; ++tm)
#pragma unroll
    for (int tn = 0; tn < 2; ++tn)
#pragma unroll
      for (int s = 0; s < 4; ++s)
        if (tile_nz<SHA>(s >> 1, tm) && tile_nz<SHB>(s >> 1, tn)) D.t[tm][tn] = mfma32(A.f[s][tm], B.f[s][tn], D.t[tm][tn]);
}
template <int SHA, int SHB, int SHD> DEV void prod_ff_frag(const Frag64& A, const Frag64& B, Frag64& Fo) {
#pragma unroll
  for (int tm = 0; tm < 2; ++tm)
#pragma unroll
    for (int tn = 0; tn < 2; ++tn)
      if (tile_nz<SHD>(tm, tn)) {
        f32x16 acc = zero16();
#pragma unroll
        for (int s = 0; s < 4; ++s)
          if (tile_nz<SHA>(s >> 1, tm) && tile_nz<SHB>(s >> 1, tn)) acc = mfma32(A.f[s][tm], B.f[s][tn], acc);
        Fo.f[2 * tm][tn] = pack8<0>(acc); Fo.f[2 * tm + 1][tn] = pack8<1>(acc);
      }
}
DEV bf16x8 nat_frag(const bf16_t* S, int row, int s, int hh) { return *(const bf16x8*)(S + row * 72 + 16 * s + 8 * hh); }
DEV bf16x8 perm_frag(const bf16_t* S, int row, int s, int hh) {
  const uint2 a = *(const uint2*)(S + row * 72 + 16 * s + 4 * hh), b = *(const uint2*)(S + row * 72 + 16 * s + 8 + 4 * hh);
  return mk8(a.x, a.y, b.x, b.y);
}
template <int SH, int MODE> DEV void gram(const bf16_t* F, const bf16_t* G, int l31, int hh, Acc64& D) {
  zero_acc<SH>(D);
#pragma unroll
  for (int s = 0; s < 4; ++s) {
    bf16x8 ff[2], gg[2];
#pragma unroll
    for (int t = 0; t < 2; ++t) { ff[t] = nat_frag(F, 32 * t + l31, s, hh); gg[t] = nat_frag(G, 32 * t + l31, s, hh); }
#pragma unroll
    for (int tx = 0; tx < 2; ++tx)
#pragma unroll
      for (int ty = 0; ty < 2; ++ty) if (tile_nz<SH>(tx, ty)) D.t[tx][ty] = mfma32(ff[tx], gg[ty], D.t[tx][ty]);
  }
#pragma unroll
  for (int t = 0; t < 2; ++t)
#pragma unroll
    for (int r = 0; r < 16; ++r) {
      const int x = (r & 3) + 8 * (r >> 2) + 4 * hh, y = l31;
      const bool keep = MODE == 0 ? (x < y) : (MODE == 1 ? (y < x) : (x <= y));
      if (!keep) D.t[t][t][r] = 0.f;
    }
}
template <int SHA> DEV void prod_fm_frag(const Frag64& A, const bf16_t* Mem, int l31, int hh, Frag64& Fo) {
#pragma unroll
  for (int tm = 0; tm < 2; ++tm)
#pragma unroll
    for (int tn = 0; tn < 2; ++tn) {
      f32x16 acc = zero16();
#pragma unroll
      for (int s = 0; s < 4; ++s) if (tile_nz<SHA>(s >> 1, tm)) acc = mfma32(A.f[s][tm], perm_frag(Mem, 32 * tn + l31, s, hh), acc);
      Fo.f[2 * tm][tn] = pack8<0>(acc); Fo.f[2 * tm + 1][tn] = pack8<1>(acc);
    }
}
template <int SHA> DEV void prod_fm(const Frag64& A, const bf16_t* Mem, int l31, int hh, Acc64& D) {
#pragma unroll
  for (int s = 0; s < 4; ++s) {
    bf16x8 mm[2];
#pragma unroll
    for (int t = 0; t < 2; ++t) mm[t] = perm_frag(Mem, 32 * t + l31, s, hh);
#pragma unroll
    for (int tm = 0; tm < 2; ++tm)
#pragma unroll
      for (int tn = 0; tn < 2; ++tn) if (tile_nz<SHA>(s >> 1, tm)) D.t[tm][tn] = mfma32(A.f[s][tm], mm[tn], D.t[tm][tn]);
  }
}
DEV void r1_item(const Prm& p, int L, int idx, char* lds) {
  int tid = threadIdx.x; LAUNDER(tid);
  const int w = __builtin_amdgcn_readfirstlane(tid >> 6);
  int lane = tid & 63, l31 = lane & 31, hh = lane >> 5;
  const int cw = w & 1, tw = w >> 1;
  bf16_t* S0 = (bf16_t*)lds;
  bf16_t* S1 = S0 + 4608; bf16_t* S2 = S1 + 4608; bf16_t* S3 = S2 + 4608; bf16_t* S4 = S3 + 4608; bf16_t* S5 = S4 + 4608; bf16_t* S6 = S5 + 4608; bf16_t* S7 = S6 + 4608;
  float* misc = (float*)(S7 + 4608);
  float* Ef = (float*)S4;
  bool prompt; int st, c, hd;
  if (idx < NRW_P) { prompt = true; st = idx / 260; const int rem = idx - st * 260; c = rem >> 2; hd = rem & 3; }
  else { prompt = false; const int j = idx - NRW_P; st = j >> 2; hd = j & 3; c = 0; }
  char* rwp = p.rw + (size_t)idx * RW_BYTES;
  const float* mu = p.shift_mu + L * 896;
  const int i1 = tid >> 2, m0 = (tid & 3) * 16;
  int R1; bool valid1, hasprev1;
  if (prompt) { const int pp = 64 * c - 48 + i1; valid1 = pp >= 0; R1 = st * PT + (valid1 ? pp : 0); hasprev1 = pp >= 1; }
  else { R1 = NPR + 64 * st + i1; valid1 = true; hasprev1 = i1 >= 1; }
  const bf16_t* zr1 = p.zE + (size_t)R1 * ZE + ZE_ZC;
  const int ti0 = 32 * tw + l31;
  int R; bool valid, hasprev;
  if (prompt) { const int pp = 64 * c - 48 + ti0; valid = pp >= 0; R = st * PT + (valid ? pp : 0); hasprev = pp >= 1; }
  else { R = NPR + 64 * st + ti0; valid = true; hasprev = ti0 >= 1; }
  const bf16_t* zr = p.zE + (size_t)R * ZE + ZE_ZC;
  const int chb = 64 * hd + 32 * cw + 4 * hh;
  uint4 la[2][2], lap[2][2]; uint2 lb[3][4], lbp[3][4];
  {
    const bf16_t* sh0 = p.zE + (size_t)(NT + (prompt ? 32 : st)) * ZE + ZE_ZC;
    const bf16_t* zp1 = hasprev1 ? zr1 - ZE : sh0;
    const bf16_t* zp = hasprev ? zr - ZE : sh0;
#pragma unroll
    for (int part = 0; part < 2; ++part)
#pragma unroll
      for (int h8 = 0; h8 < 2; ++h8) { const int col = 768 + 64 * part + m0 + 8 * h8; la[part][h8] = *(const uint4*)(zr1 + col); lap[part][h8] = *(const uint4*)(zp1 + col); }
#pragma unroll
    for (int part = 0; part < 3; ++part)
#pragma unroll
      for (int G = 0; G < 4; ++G) { const int col = 256 * part + chb + 8 * G; lb[part][G] = *(const uint2*)(zr + col); lbp[part][G] = *(const uint2*)(zp + col); }
    const bf16_t* dsrc = p.dw2T + ((size_t)L * 256 + hd * 64 + i1) * 64 + m0;
    const bf16_t* isrc = p.ia2T + ((size_t)L * 256 + hd * 64 + i1) * 64 + m0;
    const uint4 d0 = *(const uint4*)dsrc, d1 = *(const uint4*)(dsrc + 8), e0 = *(const uint4*)isrc, e1 = *(const uint4*)(isrc + 8);
    __builtin_amdgcn_sched_barrier(0);
    *(uint4*)(S2 + i1 * 72 + m0) = d0; *(uint4*)(S2 + i1 * 72 + m0 + 8) = d1;
    *(uint4*)(S3 + i1 * 72 + m0) = e0; *(uint4*)(S3 + i1 * 72 + m0 + 8) = e1;
  }
  {
    float* prm = misc + 384;
#pragma unroll
    for (int q2 = 0; q2 < 2; ++q2) {
      const int ix = tid + 256 * q2, wh = ix >> 6, chp = ix & 63;
      const float* sp = wh == 0 ? p.decay_w0 : wh == 1 ? p.iclr_a0 : wh == 2 ? p.key_kk : wh == 3 ? p.key_ka : wh == 4 ? p.bonus_rk : nullptr;
      prm[ix] = sp ? sp[L * 256 + hd * 64 + chp] : mu[256 * (wh - 5) + 64 * hd + chp];
    }
  }
#pragma unroll
  for (int part = 0; part < 2; ++part) {
#pragma unroll
    for (int h8 = 0; h8 < 2; ++h8) {
      const int col = 768 + 64 * part + m0 + 8 * h8;
      const uint4 u = la[part][h8], v = lap[part][h8];
      const float cur[8] = {bflo(u.x), bfhi(u.x), bflo(u.y), bfhi(u.y), bflo(u.z), bfhi(u.z), bflo(u.w), bfhi(u.w)};
      float prv[8] = {bflo(v.x), bfhi(v.x), bflo(v.y), bfhi(v.y), bflo(v.z), bfhi(v.z), bflo(v.w), bfhi(v.w)};
      float o[8];
#pragma unroll
      for (int e = 0; e < 8; ++e) { float z = cur[e] + (prv[e] - cur[e]) * mu[col + e]; if (!valid1) z = 0.f; o[e] = part == 0 ? (1.f - 2.f / (__expf(2.f * z) + 1.f)) : z; }
      uint4 a; a.x = pk2(o[0], o[1]); a.y = pk2(o[2], o[3]); a.z = pk2(o[4], o[5]); a.w = pk2(o[6], o[7]);
      *(uint4*)((part == 0 ? S0 : S1) + i1 * 72 + m0 + 8 * h8) = a;
    }
  }
  __syncthreads();
  f32x16 accw = zero16(), acca = zero16();
#pragma unroll
  for (int ks = 0; ks < 4; ++ks) {
    const bf16x8 fw = *(const bf16x8*)(S2 + (32 * cw + l31) * 72 + ks * 16 + hh * 8), fa = *(const bf16x8*)(S3 + (32 * cw + l31) * 72 + ks * 16 + hh * 8);
    const bf16x8 sw = *(const bf16x8*)(S0 + (32 * tw + l31) * 72 + ks * 16 + hh * 8), sa = *(const bf16x8*)(S1 + (32 * tw + l31) * 72 + ks * 16 + hh * 8);
    accw = mfma32(fw, sw, accw); acca = mfma32(fa, sa, acca);
  }
  int ti = ti0;
  float e_[16];
  float ssq = 0.f;
#pragma unroll
  for (int G = 0; G < 4; ++G) {
    const int ch = chb + 8 * G, col = 256 + ch;
    const uint2 u = lb[1][G], v = lbp[1][G];
    const float cur[4] = {bflo(u.x), bfhi(u.x), bflo(u.y), bfhi(u.y)};
    float prv[4] = {bflo(v.x), bfhi(v.x), bflo(v.y), bfhi(v.y)};
    const int chq = 32 * cw + 8 * G + 4 * hh;
    const float4 kkw = *(const float4*)(misc + 384 + 128 + chq), w0 = *(const float4*)(misc + 384 + chq), m4 = *(const float4*)(misc + 384 + 384 + chq);
    const float kkv[4] = {kkw.x, kkw.y, kkw.z, kkw.w}, w0v[4] = {w0.x, w0.y, w0.z, w0.w}, muv[4] = {m4.x, m4.y, m4.z, m4.w};
#pragma unroll
    for (int e = 0; e < 4; ++e) {
      float z = cur[e] + (prv[e] - cur[e]) * muv[e];
      if (!valid) z = 0.f;
      const float kkr = z * kkv[e];
      ssq += kkr * kkr;
      e_[4 * G + e] = valid ? 0.6065306597126334f * sigmoid_(w0v[e] + accw[4 * G + e]) : 0.f;
    }
  }
  ssq += __shfl_xor(ssq, 32);
  if (hh == 0) misc[(cw * 64 + ti) * 2] = ssq;
#pragma unroll
  for (int G = 0; G < 4; ++G)
#pragma unroll
    for (int e = 0; e < 4; ++e) Ef[ti * 65 + 32 * cw + 8 * G + 4 * hh + e] = e_[4 * G + e];
  __syncthreads();
  {
    const int ch = tid & 63, seg = tid >> 6;
    float run = 0.f;
#pragma unroll
    for (int t = 0; t < 16; ++t) { run += Ef[(16 * seg + t) * 65 + ch]; Ef[(16 * seg + t) * 65 + ch] = run; }
    __syncthreads();
    float off = 0.f;
    for (int s2 = 0; s2 < seg; ++s2) off += Ef[(16 * s2 + 15) * 65 + ch];
    __syncthreads();
#pragma unroll
    for (int t = 0; t < 16; ++t) Ef[(16 * seg + t) * 65 + ch] += off;
    if (seg == 3) { const float cC = Ef[63 * 65 + ch]; misc[320 + ch] = cC; misc[256 + ch] = __expf(-cC); }
    __syncthreads();
  }
  float cc_[16];
#pragma unroll
  for (int G = 0; G < 4; ++G)
#pragma unroll
    for (int e = 0; e < 4; ++e) cc_[4 * G + e] = Ef[ti * 65 + 32 * cw + 8 * G + 4 * hh + e];
  const float kinv = 1.f / fmaxf(sqrtf(misc[ti * 2] + misc[(64 + ti) * 2]), 1e-12f);
  __syncthreads();
  LAUNDER(ti); LAUNDER(hh);
  uint2 vpk[4];
  float rk = 0.f;
#pragma unroll
  for (int G = 0; G < 4; ++G) {
    const int ch = chb + 8 * G, chl = 32 * cw + 8 * G + 4 * hh;
    float zs[3][4];
#pragma unroll
    for (int part = 0; part < 3; ++part) {
      const int col = 256 * part + ch;
      const uint2 u = lb[part][G], v = lbp[part][G];
      const float cur[4] = {bflo(u.x), bfhi(u.x), bflo(u.y), bfhi(u.y)};
      float prv[4] = {bflo(v.x), bfhi(v.x), bflo(v.y), bfhi(v.y)};
      const float4 m4 = *(const float4*)(misc + 384 + 320 + 64 * part + chl);
      const float muv[4] = {m4.x, m4.y, m4.z, m4.w};
#pragma unroll
      for (int e = 0; e < 4; ++e) { float z = cur[e] + (prv[e] - cur[e]) * muv[e]; zs[part][e] = valid ? z : 0.f; }
    }
    vpk[G] = pk4(zs[2][0], zs[2][1], zs[2][2], zs[2][3]);
    const float4 a04 = *(const float4*)(misc + 384 + 64 + chl), kk4 = *(const float4*)(misc + 384 + 128 + chl), ka4 = *(const float4*)(misc + 384 + 192 + chl), bo4 = *(const float4*)(misc + 384 + 256 + chl);
    const float a0v[4] = {a04.x, a04.y, a04.z, a04.w}, kkv[4] = {kk4.x, kk4.y, kk4.z, kk4.w}, kav[4] = {ka4.x, ka4.y, ka4.z, ka4.w}, bov[4] = {bo4.x, bo4.y, bo4.z, bo4.w};
    float at[4], rt[4], bt[4], kt[4], bh[4], kh[4];
#pragma unroll
    for (int e = 0; e < 4; ++e) {
      const int r = 4 * G + e;
      const float al = sigmoid_(a0v[e] + acca[r]);
      const float kk = zs[1][e] * kkv[e] * kinv;
      const float km = zs[1][e] * (1.f + (al - 1.f) * kav[e]);
      rk += zs[0][e] * km * bov[e];
      const float gC = misc[256 + chl + e];
      const float cprev = cc_[r] - e_[r];
      const float ea = __expf(-cprev), er = __expf(-cc_[r]), ek = __builtin_amdgcn_rcpf(er), eh = ek * gC;
      const float b = kk * al;
      at[e] = -kk * ea; rt[e] = zs[0][e] * er; bt[e] = b * ek; kt[e] = km * ek; bh[e] = b * eh; kh[e] = km * eh;
    }
    *(uint2*)(S0 + ti * 72 + chl) = pk4(at[0], at[1], at[2], at[3]);
    *(uint2*)(S1 + ti * 72 + chl) = pk4(rt[0], rt[1], rt[2], rt[3]);
    *(uint2*)(S2 + ti * 72 + chl) = pk4(bt[0], bt[1], bt[2], bt[3]);
    *(uint2*)(S3 + ti * 72 + chl) = pk4(kt[0], kt[1], kt[2], kt[3]);
#pragma unroll
    for (int e = 0; e < 4; ++e) { S4[(chl + e) * 72 + ti] = f2bf(at[e]); S5[(chl + e) * 72 + ti] = f2bf(bh[e]); S6[(chl + e) * 72 + ti] = f2bf(kh[e]); S7[(chl + e) * 72 + ti] = f2bf(zs[2][e]); }
    *(uint2*)(rwp + 40960 + (ti * 64 + chl) * 2) = vpk[G];
  }
  rk += __shfl_xor(rk, 32);
  if (hh == 0) misc[(cw * 64 + ti) * 2 + 1] = rk;
  __syncthreads();
  if (valid && cw == 0 && hh == 0) p.rkb[(size_t)R * 4 + hd] = misc[ti * 2 + 1] + misc[(64 + ti) * 2 + 1];
  LAUNDER(l31); LAUNDER(hh); LAUNDER(lane);
  {
    Acc64 T;
    {
      Acc64 Mx, MTx;
      gram<SH_UP, 0>(S2, S0, l31, hh, Mx);
      gram<SH_LO, 1>(S0, S2, l31, hh, MTx);
      Frag64 fM, fMT, fT;
      to_frag<SH_UP>(Mx, fM); to_frag<SH_LO>(MTx, fMT);
      __builtin_amdgcn_sched_barrier(0);
      T = Mx;
#pragma unroll
      for (int t = 0; t < 2; ++t)
#pragma unroll
        for (int r = 0; r < 16; ++r) if ((r & 3) + 8 * (r >> 2) + 4 * hh == l31) T.t[t][t][r] += 1.f;
      T.t[1][0] = zero16();
      for (int r = 0; r < 5; ++r) {
        Frag64 fM2, fMT2;
        prod_ff_frag<SH_LO, SH_UP, SH_UP>(fMT, fM, fM2);
        prod_ff_frag<SH_UP, SH_LO, SH_LO>(fM, fMT, fMT2);
#pragma unroll
        for (int s = 0; s < 4; ++s)
#pragma unroll
          for (int t = 0; t < 2; ++t) { if (tile_nz<SH_UP>(s >> 1, t)) fM.f[s][t] = fM2.f[s][t]; if (tile_nz<SH_LO>(s >> 1, t)) fMT.f[s][t] = fMT2.f[s][t]; }
        to_frag<SH_UP>(T, fT);
        prod_ff<SH_LO, SH_UP>(fMT, fT, T);
      }
    }
    Frag64 fT;
    to_frag<SH_UP>(T, fT);
    __builtin_amdgcn_sched_barrier(0);
    if (w < 2) {
      Frag64 fW;
      prod_fm_frag<SH_UP>(fT, S4, l31, hh, fW);
      __builtin_amdgcn_sched_barrier(0);
      Acc64 O; zero_acc<SH_FULL>(O);
      if (w == 0) {
        prod_fm<SH_FULL>(fW, S5, l31, hh, O);
#pragma unroll
        for (int tx = 0; tx < 2; ++tx)
#pragma unroll
          for (int ty = 0; ty < 2; ++ty)
#pragma unroll
            for (int G = 0; G < 4; ++G) {
              const int x0 = 32 * tx + 8 * G + 4 * hh, y = 32 * ty + l31;
              float v[4];
#pragma unroll
              for (int e = 0; e < 4; ++e) { v[e] = O.t[tx][ty][4 * G + e]; if (x0 + e == y) v[e] += misc[256 + y]; }
              *(uint2*)(rwp + 0 + kperm_addr(y, x0) * 2) = pk4(v[0], v[1], v[2], v[3]);
            }
      } else {
        Acc64 Nb; gram<SH_UP, 2>(S2, S1, l31, hh, Nb);
        Frag64 fN; to_frag<SH_UP>(Nb, fN);
        prod_ff<SH_FULL, SH_UP>(fW, fN, O);
#pragma unroll
        for (int tx = 0; tx < 2; ++tx)
#pragma unroll
          for (int ty = 0; ty < 2; ++ty)
#pragma unroll
            for (int G = 0; G < 4; ++G) {
              const int x0 = 32 * tx + 8 * G + 4 * hh, y = 32 * ty + l31;
              const uint2 rr = *(const uint2*)(S1 + y * 72 + x0);
              *(uint2*)(rwp + 8192 + kperm_addr(y, x0) * 2) = pk4(O.t[tx][ty][4 * G] + bflo(rr.x), O.t[tx][ty][4 * G + 1] + bfhi(rr.x), O.t[tx][ty][4 * G + 2] + bflo(rr.y), O.t[tx][ty][4 * G + 3] + bfhi(rr.y));
            }
      }
    } else {
      Frag64 fX;
      {
        Acc64 Nk; gram<SH_LO, 1>(S0, S3, l31, hh, Nk);
        Frag64 fNk; to_frag<SH_LO>(Nk, fNk);
        prod_ff_frag<SH_UP, SH_LO, SH_LO>(fT, fNk, fX);
      }
      __builtin_amdgcn_sched_barrier(0);
      if (w == 2) {
        Acc64 Z; zero_acc<SH_FULL>(Z);
        prod_fm<SH_LO>(fX, S5, l31, hh, Z);
#pragma unroll
        for (int tx = 0; tx < 2; ++tx)
#pragma unroll
          for (int ty = 0; ty < 2; ++ty)
#pragma unroll
            for (int G = 0; G < 4; ++G) {
              const int x0 = 32 * tx + 8 * G + 4 * hh, y = 32 * ty + l31;
              const uint2 kk2 = *(const uint2*)(S6 + y * 72 + x0);
              Z.t[tx][ty][4 * G] += bflo(kk2.x); Z.t[tx][ty][4 * G + 1] += bfhi(kk2.x); Z.t[tx][ty][4 * G + 2] += bflo(kk2.y); Z.t[tx][ty][4 * G + 3] += bfhi(kk2.y);
            }
        Frag64 fZ; to_frag<SH_FULL>(Z, fZ);
        __builtin_amdgcn_sched_barrier(0);
        Acc64 Q; zero_acc<SH_FULL>(Q);
        prod_fm<SH_FULL>(fZ, S7, l31, hh, Q);
#pragma unroll
        for (int tx = 0; tx < 2; ++tx)
#pragma unroll
          for (int ty = 0; ty < 2; ++ty)
#pragma unroll
            for (int G = 0; G < 4; ++G)
              *(uint2*)(rwp + 16384 + clay_addr(32 * tx + 8 * G + 4 * hh, 32 * ty + l31) * 2) = pk4(Q.t[tx][ty][4 * G], Q.t[tx][ty][4 * G + 1], Q.t[tx][ty][4 * G + 2], Q.t[tx][ty][4 * G + 3]);
      } else {
        Acc64 H; gram<SH_UP, 2>(S3, S1, l31, hh, H);
        {
          Acc64 Nb; gram<SH_UP, 2>(S2, S1, l31, hh, Nb);
          Frag64 fN; to_frag<SH_UP>(Nb, fN);
          prod_ff<SH_LO, SH_UP>(fX, fN, H);
        }
        Frag64 fH; to_frag<SH_UP>(H, fH);
        __builtin_amdgcn_sched_barrier(0);
        Acc64 Y; zero_acc<SH_FULL>(Y);
        prod_fm<SH_UP>(fH, S7, l31, hh, Y);
#pragma unroll
        for (int tx = 0; tx < 2; ++tx)
#pragma unroll
          for (int ty = 0; ty < 2; ++ty)
#pragma unroll
            for (int G = 0; G < 4; ++G)
              *(uint2*)(rwp + 24576 + clay_addr(32 * tx + 8 * G + 4 * hh, 32 * ty + l31) * 2) = pk4(Y.t[tx][ty][4 * G], Y.t[tx][ty][4 * G + 1], Y.t[tx][ty][4 * G + 2], Y.t[tx][ty][4 * G + 3]);
      }
    }
  }
  __syncthreads();
}

DEV void r2_wave(const Prm& p, int L, int wi, int lane) {
  bool prompt; int st, hd, vt;
  if (wi < 64) { prompt = true; st = wi >> 4; hd = (wi >> 2) & 3; vt = wi & 3; }
  else { prompt = false; const int j = wi - 64; st = j >> 4; hd = (j >> 2) & 3; vt = j & 3; }
  const int nch = prompt ? 65 : 1;
  const int idx0 = prompt ? st * 260 + hd : NRW_P + st * 4 + hd;
  const int l16 = lane & 15, g = lane >> 4;
  f32x4 acc[4];
  float* outp;
  if (prompt) {
#pragma unroll
    for (int mt = 0; mt < 4; ++mt) acc[mt] = (f32x4){0.f, 0.f, 0.f, 0.f};
    outp = p.wkv_p + ((((size_t)L * 4 + st) * 4 + hd) * 64 + 16 * vt + l16) * 64;
  } else {
    const float* sp = p.state_wkv + ((((size_t)L * 32 + st) * 4 + hd) * 64 + 16 * vt + l16) * 64;
#pragma unroll
    for (int mt = 0; mt < 4; ++mt) acc[mt] = *(const f32x4*)(sp + 16 * mt + 4 * g);
    outp = p.wkv_s + ((((size_t)L * 32 + st) * 4 + hd) * 64 + 16 * vt + l16) * 64;
  }
  const char* rw0 = p.rw + (size_t)idx0 * RW_BYTES;
  uint4 pf[3][8]; uint2 qv[3][4];
#pragma unroll
  for (int k = 0; k < 3; ++k) {
    const int cc = k < nch ? k : nch - 1;
    const char* src = rw0 + (size_t)cc * 4 * RW_BYTES;
#pragma unroll
    for (int i = 0; i < 8; ++i) pf[k][i] = *(const uint4*)(src + (i * 64 + lane) * 16);
#pragma unroll
    for (int mt = 0; mt < 4; ++mt) qv[k][mt] = *(const uint2*)(src + 16384 + ((mt * 4 + vt) * 64 + lane) * 8);
  }
  for (int c0 = 0; c0 < nch; c0 += 3) {
#pragma unroll
    for (int k = 0; k < 3; ++k) {
      const int c = c0 + k;
      if (c < nch) {
        char* cur = (char*)rw0 + (size_t)c * 4 * RW_BYTES;
        uint4 bfr[2];
#pragma unroll
        for (int s = 0; s < 2; ++s) {
          bfr[s].x = pk2(acc[2 * s][0], acc[2 * s][1]); bfr[s].y = pk2(acc[2 * s][2], acc[2 * s][3]);
          bfr[s].z = pk2(acc[2 * s + 1][0], acc[2 * s + 1][1]); bfr[s].w = pk2(acc[2 * s + 1][2], acc[2 * s + 1][3]);
          *(uint4*)(cur + 32768 + ((vt * 2 + s) * 64 + lane) * 16) = bfr[s];
        }
#pragma unroll
        for (int mt = 0; mt < 4; ++mt) {
          f32x4 a = {bflo(qv[k][mt].x), bfhi(qv[k][mt].x), bflo(qv[k][mt].y), bfhi(qv[k][mt].y)};
#pragma unroll
          for (int s = 0; s < 2; ++s) a = mfma16(mk8(pf[k][mt * 2 + s]), mk8(bfr[s]), a);
          acc[mt] = a;
        }
        const int cn = c + 3 < nch ? c + 3 : nch - 1;
        const char* src = rw0 + (size_t)cn * 4 * RW_BYTES;
#pragma unroll
        for (int i = 0; i < 8; ++i) pf[k][i] = *(const uint4*)(src + (i * 64 + lane) * 16);
#pragma unroll
        for (int mt = 0; mt < 4; ++mt) qv[k][mt] = *(const uint2*)(src + 16384 + ((mt * 4 + vt) * 64 + lane) * 8);
      }
    }
  }
#pragma unroll
  for (int mt = 0; mt < 4; ++mt) *(f32x4*)(outp + 16 * mt + 4 * g) = acc[mt];
}

DEV void r3_wave(const Prm& p, int L, int idx, int lane, float* Y  ) {
  LAUNDER(lane);
  bool prompt; int st, c, hd;
  if (idx < NRW_P) { prompt = true; st = idx / 260; const int rem = idx - st * 260; c = rem >> 2; hd = rem & 3; }
  else { prompt = false; const int j = idx - NRW_P; st = j >> 2; hd = j & 3; c = 0; }
  const char* rwp = p.rw + (size_t)idx * RW_BYTES;
  const int l16 = lane & 15, g = lane >> 4;
  bf16_t* mix = p.zE;
  uint4 sf[4][2], gf[4][2]; uint2 qv[4][4];
#pragma unroll
  for (int vt = 0; vt < 4; ++vt)
#pragma unroll
    for (int s = 0; s < 2; ++s) sf[vt][s] = *(const uint4*)(rwp + 32768 + ((vt * 2 + s) * 64 + lane) * 16);
#pragma unroll
  for (int it = 0; it < 4; ++it) {
    gf[it][0] = *(const uint4*)(rwp + 8192 + ((it * 2 + 0) * 64 + lane) * 16); gf[it][1] = *(const uint4*)(rwp + 8192 + ((it * 2 + 1) * 64 + lane) * 16);
#pragma unroll
    for (int vt = 0; vt < 4; ++vt) qv[it][vt] = *(const uint2*)(rwp + 24576 + ((it * 4 + vt) * 64 + lane) * 8);
  }
  const float lw[4] = {p.lnx_w[L * 256 + hd * 64 + l16], p.lnx_w[L * 256 + hd * 64 + 16 + l16], p.lnx_w[L * 256 + hd * 64 + 32 + l16], p.lnx_w[L * 256 + hd * 64 + 48 + l16]};
  const float lb[4] = {p.lnx_b[L * 256 + hd * 64 + l16], p.lnx_b[L * 256 + hd * 64 + 16 + l16], p.lnx_b[L * 256 + hd * 64 + 32 + l16], p.lnx_b[L * 256 + hd * 64 + 48 + l16]};
  const int vc = (lane & 7) * 8;
  float rkv[8]; uint4 vvv[8], gcv[8];
#pragma unroll
  for (int ps = 0; ps < 8; ++ps) {
    const int i = 8 * ps + (lane >> 3);
    int R;
    if (prompt) { const int pp = 64 * c - 48 + i; R = st * PT + (pp >= 0 ? pp : 0); }
    else R = NPR + 64 * st + i;
    rkv[ps] = p.rkb[(size_t)R * 4 + hd];
    vvv[ps] = *(const uint4*)(rwp + 40960 + (i * 64 + vc) * 2);
    gcv[ps] = *(const uint4*)(p.zL + (size_t)R * ZL + ZL_GC + hd * 64 + vc);
  }
  __builtin_amdgcn_sched_barrier(0);
#pragma unroll
  for (int it = 0; it < 4; ++it) {
    f32x4 y[4];
#pragma unroll
    for (int vt = 0; vt < 4; ++vt) {
      const uint2 q = qv[it][vt];
      f32x4 a = {bflo(q.x), bfhi(q.x), bflo(q.y), bfhi(q.y)};
      a = mfma16(mk8(gf[it][0]), mk8(sf[vt][0]), a);
      a = mfma16(mk8(gf[it][1]), mk8(sf[vt][1]), a);
      y[vt] = a;
    }
#pragma unroll
    for (int rr = 0; rr < 4; ++rr) {
      const int i = 16 * it + 4 * g + rr;
      float s1 = y[0][rr] + y[1][rr] + y[2][rr] + y[3][rr];
      s1 += __shfl_xor(s1, 1); s1 += __shfl_xor(s1, 2); s1 += __shfl_xor(s1, 4); s1 += __shfl_xor(s1, 8);
      const float mean = s1 * (1.f / 64.f);
      const float d0 = y[0][rr] - mean, d1 = y[1][rr] - mean, d2 = y[2][rr] - mean, d3 = y[3][rr] - mean;
      float s2 = d0 * d0 + d1 * d1 + d2 * d2 + d3 * d3;
      s2 += __shfl_xor(s2, 1); s2 += __shfl_xor(s2, 2); s2 += __shfl_xor(s2, 4); s2 += __shfl_xor(s2, 8);
      const float rstd = rsqrtf(s2 * (1.f / 64.f) + GN_EPS);
      Y[i * 68 + l16] = d0 * rstd * lw[0] + lb[0];
      Y[i * 68 + 16 + l16] = d1 * rstd * lw[1] + lb[1];
      Y[i * 68 + 32 + l16] = d2 * rstd * lw[2] + lb[2];
      Y[i * 68 + 48 + l16] = d3 * rstd * lw[3] + lb[3];
    }
  }
  asm volatile("s_waitcnt lgkmcnt(0)" ::: "memory");
  __builtin_amdgcn_wave_barrier();
#pragma unroll
  for (int ps = 0; ps < 8; ++ps) {
    const int i = 8 * ps + (lane >> 3);
    int R; bool valid;
    if (prompt) { const int pp = 64 * c - 48 + i; valid = pp >= 0; R = st * PT + (valid ? pp : 0); }
    else { R = NPR + 64 * st + i; valid = true; }
    if (valid) {
      const float4 y0 = *(const float4*)(Y + i * 68 + vc), y1 = *(const float4*)(Y + i * 68 + vc + 4);
      const float rkbv = rkv[ps];
      const uint4 vv = vvv[ps];
      const uint4 gc = gcv[ps];
      uint4 o;
      o.x = pk2((y0.x + rkbv * bflo(vv.x)) * silu_(bflo(gc.x)), (y0.y + rkbv * bfhi(vv.x)) * silu_(bfhi(gc.x)));
      o.y = pk2((y0.z + rkbv * bflo(vv.y)) * silu_(bflo(gc.y)), (y0.w + rkbv * bfhi(vv.y)) * silu_(bfhi(gc.y)));
      o.z = pk2((y1.x + rkbv * bflo(vv.z)) * silu_(bflo(gc.z)), (y1.y + rkbv * bfhi(vv.z)) * silu_(bfhi(gc.z)));
      o.w = pk2((y1.z + rkbv * bflo(vv.w)) * silu_(bflo(gc.w)), (y1.w + rkbv * bfhi(vv.w)) * silu_(bfhi(gc.w)));
      *(uint4*)(mix + (size_t)R * D + 768 + hd * 64 + vc) = o;
    }
  }
  asm volatile("s_waitcnt lgkmcnt(0)" ::: "memory");
  __builtin_amdgcn_wave_barrier();
}

DEV void final_norm(const Prm& p) {
  int tid_ = threadIdx.x; LAUNDER(tid_);
  const int lane = tid_ & 63, gw = blockIdx.x * 4 + (tid_ >> 6), NW = gridDim.x * 4;
  for (int R = gw; R < NT; R += NW) {
    if (R < NPR && (R % PT) < 16) continue;
    float* yr = xrow_ptr(p, R);
    const bf16_t* xr = p.xb + (size_t)R * D;
    const float rstd = rsqrtf(p.ssq_x[2 * NTP + R] * (1.f / 1024.f) + RMS_EPS);
#pragma unroll
    for (int j = 0; j < 2; ++j) {
      const uint4 u = ((const uint4*)xr)[lane + 64 * j];
      const float4 g0 = ((const float4*)p.final_g)[2 * (lane + 64 * j)], g1 = ((const float4*)p.final_g)[2 * (lane + 64 * j) + 1];
      float4 o0, o1;
      o0.x = bflo(u.x) * rstd * g0.x; o0.y = bfhi(u.x) * rstd * g0.y; o0.z = bflo(u.y) * rstd * g0.z; o0.w = bfhi(u.y) * rstd * g0.w;
      o1.x = bflo(u.z) * rstd * g1.x; o1.y = bfhi(u.z) * rstd * g1.y; o1.z = bflo(u.w) * rstd * g1.z; o1.w = bfhi(u.w) * rstd * g1.w;
      ((float4*)yr)[2 * (lane + 64 * j)] = o0; ((float4*)yr)[2 * (lane + 64 * j) + 1] = o1;
    }
  }
}

#define XB_TMO      128
#define XB_XCNT(j)  (256  + 64 * (j))
#define XB_XSUB(j)  (1280 + 64 * (j))
#define XB_XGEN(j)  (2304 + 64 * (j))
#define XB_TOP      3328
#define XB_TOPGEN   3392
#define XCD_BAR_WORDS 3456
#define XB_SPIN_CAP (1u << 20)
#define LAS __attribute__((address_space(3)))
DEV unsigned xb_ld(unsigned* p) { return __hip_atomic_load(p, __ATOMIC_RELAXED, __HIP_MEMORY_SCOPE_AGENT); }
DEV unsigned xb_add(unsigned* p, unsigned v) { return __hip_atomic_fetch_add(p, v, __ATOMIC_RELAXED, __HIP_MEMORY_SCOPE_AGENT); }
DEV unsigned xb_xcc_id() { return (unsigned)__builtin_amdgcn_s_getreg((3 << 11) | 20) & 0xFu; }
#define XB_SPIN(cond, bar) do { unsigned _sp = 0; while (cond) { __builtin_amdgcn_s_sleep(1); \
    if ((++_sp & 255u) == 0u) { if (xb_ld(&(bar)[XB_TMO])) break; if (_sp > XB_SPIN_CAP) { atomicAdd(&(bar)[XB_TMO], 1u); break; } } } } while (0)
struct XcdBarrier { unsigned* bar; unsigned x; volatile LAS unsigned* st; };
DEV XcdBarrier xcd_barrier_post(unsigned* bar, volatile LAS unsigned* st) {
  XcdBarrier b; b.bar = bar; b.x = xb_xcc_id(); b.st = st;
  if (threadIdx.x == 0) (void)xb_add(&bar[XB_XCNT(b.x)], 1u);
  return b;
}
DEV void xcd_barrier_complete(unsigned* bar, unsigned x, unsigned& nloc, unsigned& nx) {
  const unsigned G = gridDim.x * gridDim.y * gridDim.z;
  unsigned sum, cnt, mine, sp = 0u;
  for (;;) {
    sum = 0u; cnt = 0u; mine = 0u;
#pragma unroll
    for (unsigned j = 0; j < 16; ++j) { const unsigned c = xb_ld(&bar[XB_XCNT(j)]); sum += c; cnt += (c > 0u) ? 1u : 0u; mine = (j == x) ? c : mine; }
    if (sum == G) break;
    __builtin_amdgcn_s_sleep(1);
    if ((++sp & 255u) == 0u) { if (xb_ld(&bar[XB_TMO])) break; if (sp > XB_SPIN_CAP) { atomicAdd(&bar[XB_TMO], 1u); break; } }
  }
  nloc = mine > 0u ? mine : 1u; nx = cnt > 0u ? cnt : 1u;
}
DEV void xcd_barrier(const XcdBarrier& b) {
  asm volatile("s_waitcnt vmcnt(0)" ::: "memory");
  __syncthreads();
  if (threadIdx.x == 0) {
    unsigned* bar = b.bar;
    __builtin_amdgcn_s_waitcnt(0);
    unsigned nloc = b.st[0], nx = b.st[1];
    if (nloc == 0u) { xcd_barrier_complete(bar, b.x, nloc, nx); b.st[0] = nloc; b.st[1] = nx; }
    const unsigned old = xb_add(&bar[XB_XSUB(b.x)], 1u);
    const unsigned gen = old / nloc;
    if (old + 1u == (gen + 1u) * nloc) {
      __builtin_amdgcn_fence(__ATOMIC_RELEASE, "agent");
      asm volatile("s_waitcnt vmcnt(0)" ::: "memory");
      const unsigned og = xb_add(&bar[XB_TOP], 1u);
      const unsigned tg = og / nx;
      if (og + 1u == (tg + 1u) * nx) xb_add(&bar[XB_TOPGEN], 1u);
      else XB_SPIN(xb_ld(&bar[XB_TOPGEN]) == tg, bar);
      __builtin_amdgcn_fence(__ATOMIC_ACQUIRE, "agent");
      xb_add(&bar[XB_XGEN(b.x)], 1u);
      asm volatile("s_waitcnt vmcnt(0)" ::: "memory");
    } else {
      XB_SPIN(xb_ld(&bar[XB_XGEN(b.x)]) == gen, bar);
      __builtin_amdgcn_fence(__ATOMIC_ACQUIRE, "agent");
      asm volatile("s_waitcnt vmcnt(0)" ::: "memory");
    }
  }
  __syncthreads();
}

#define QCTR(ph, L) (3584 + 64 * (2 * (ph) + (L)))
#define R2DONE(L) (3520 + 16 * (L))
DEV int next_item(unsigned* ctr, char* lds) {
  volatile int* slot = (volatile int*)(lds + LDS_BYTES - 8);
  __syncthreads();
  if (threadIdx.x == 0) *slot = (int)atomicAdd(ctr, 1u);
  __syncthreads();
  return *slot;
}
#define QXC(ph, L, x) (4096 + (((ph) * 2 + (L)) * 8 + (x)) * 16)
DEV int xq_next(unsigned* ctl, int ph, int L, int C, int N, int& k, int home, char* lds) {
  volatile int* slot = (volatile int*)(lds + LDS_BYTES - 8);
  __syncthreads();
  if (threadIdx.x == 0) {
    int res = -1, kk = k;
    while (kk < 8) {
      const int x = (home + kk) & 7, base = x * C;
      int size = N - base; size = size < C ? size : C;
      if (size > 0) { const int idx = (int)atomicAdd(ctl + QXC(ph, L, x), 1u); if (idx < size) { res = base + idx; break; } }
      ++kk;
    }
    slot[0] = res; slot[1] = kk;
  }
  __syncthreads();
  k = slot[1];
  return slot[0];
}
DEV int q_publish(int ticket, char* lds) {
  volatile int* slot = (volatile int*)(lds + LDS_BYTES - 8);
  __syncthreads();
  if (threadIdx.x == 0) *slot = ticket;
  __syncthreads();
  return *slot;
}
DEV int xq_resolve(unsigned* ctl, int ph, int L, int C, int N, int& k, int home, int ticket, char* lds) {
  volatile int* slot = (volatile int*)(lds + LDS_BYTES - 8);
  __syncthreads();
  if (threadIdx.x == 0) {
    int res = -1, kk = k;
    if (kk < 8) {
      const int x = (home + kk) & 7, base = x * C;
      int size = N - base; size = size < C ? size : C;
      if (ticket < size) res = base + ticket;
      else {
        ++kk;
        while (kk < 8) {
          const int x2 = (home + kk) & 7, base2 = x2 * C;
          int size2 = N - base2; size2 = size2 < C ? size2 : C;
          if (size2 > 0) { const int idx = (int)atomicAdd(ctl + QXC(ph, L, x2), 1u); if (idx < size2) { res = base2 + idx; break; } }
          ++kk;
        }
      }
    }
    slot[0] = res; slot[1] = kk;
  }
  __syncthreads();
  k = slot[1];
  return slot[0];
}
DEV unsigned* xq_ctr(unsigned* ctl, int ph, int L, int k, int home) { return k < 8 ? ctl + QXC(ph, L, (home + k) & 7) : nullptr; }
DEV int take_ticket(unsigned* nctr) { int tk = 0x7fffffff; if (nctr && threadIdx.x == 0) tk = (int)atomicAdd(nctr, 1u); return tk; }
struct XQueue {
  unsigned* ctl; int ph, L, C, N, k, home, t;
  DEV void prefetch() { t = take_ticket(xq_ctr(ctl, ph, L, k, home)); }
  DEV int resolve(char* lds) { return xq_resolve(ctl, ph, L, C, N, k, home, t, lds); }
};
template <class Epi, class Map>
DEV void gemm_stream(const bf16_t* __restrict__ A, int lda, const bf16_t* __restrict__ Bt, int ldb, int K, char* lds, const Epi& epi, XQueue& q) {
  int tid = threadIdx.x; LAUNDER(tid);
  const int lane = tid & 63, w = __builtin_amdgcn_readfirstlane(tid >> 6), wr = w >> 1, wc = w & 1;
  const int fr = lane & 15, fq = lane >> 4;
  const int sb = lane * 16, swz = sb ^ (((sb >> 9) & 1) << 5), rl = swz >> 6, cl = (swz & 63) >> 1;
  const int nk = K / 64;
  int offA[2], offB[2];
#pragma unroll
  for (int kh = 0; kh < 2; ++kh) { offA[kh] = lds_byte(wr * 64 + fr, kh * 32 + fq * 8); offB[kh] = lds_byte(wc * 64 + fr, kh * 32 + fq * 8); }
  q.prefetch();
  int item = q.resolve(lds);
  if (item < 0) return;
  int m0, n0; Map::map(item, m0, n0);
  const bf16_t* ga[4]; const bf16_t* gb[4];
#define SETPTR(M0, N0) { _Pragma("unroll") for (int i = 0; i < 4; ++i) { const int st = 4 * w + i, r = (st >> 1) * 16 + rl, c = (st & 1) * 32 + cl; \
      ga[i] = A + (size_t)((M0) + r) * lda + c; gb[i] = Bt + (size_t)((N0) + r) * ldb + c; } }
#define GSTAGE(S, KT) { _Pragma("unroll") for (int i = 0; i < 4; ++i) { \
      __builtin_amdgcn_global_load_lds((const unsigned*)(ga[i] + (KT) * 64), (LAS3 unsigned*)(lds + (S) * 32768 + (4 * w + i) * 1024 + lane * 16), 16, 0, 0); \
      __builtin_amdgcn_global_load_lds((const unsigned*)(gb[i] + (KT) * 64), (LAS3 unsigned*)(lds + (S) * 32768 + 16384 + (4 * w + i) * 1024 + lane * 16), 16, 0, 0); } }
  SETPTR(m0, n0)
  GSTAGE(0, 0)
  GSTAGE(1, 1)
  for (;;) {
    f32x4 acc[4][4];
#pragma unroll
    for (int i = 0; i < 4; ++i)
#pragma unroll
      for (int j = 0; j < 4; ++j) acc[i][j] = (f32x4){0.f, 0.f, 0.f, 0.f};
    for (int kt = 0; kt < nk; ++kt) {
      const int s = kt & 1;
      if (kt + 1 < nk) asm volatile("s_waitcnt vmcnt(8)" ::: "memory"); else asm volatile("s_waitcnt vmcnt(0)" ::: "memory");
      RAW_BARRIER()
      const char* ia = lds + s * 32768;
      const char* ib = ia + 16384;
      bf16x8 af[2][4], bfv[2][4];
#pragma unroll
      for (int kh = 0; kh < 2; ++kh) {
#pragma unroll
        for (int mi = 0; mi < 4; ++mi) af[kh][mi] = *(const bf16x8*)(ia + offA[kh] + mi * 2048);
#pragma unroll
        for (int ni = 0; ni < 4; ++ni) bfv[kh][ni] = *(const bf16x8*)(ib + offB[kh] + ni * 2048);
      }
      asm volatile("s_waitcnt lgkmcnt(8)" ::: "memory");
      __builtin_amdgcn_sched_barrier(0);
#pragma unroll
      for (int mi = 0; mi < 4; ++mi)
#pragma unroll
        for (int ni = 0; ni < 4; ++ni) acc[mi][ni] = mfma16(bfv[0][ni], af[0][mi], acc[mi][ni]);
      __builtin_amdgcn_sched_barrier(0);
      asm volatile("s_waitcnt lgkmcnt(0)" ::: "memory");
      RAW_BARRIER()
      if (kt + 2 < nk) GSTAGE(s, kt + 2)
      if (kt == nk - 3) q.prefetch();
      __builtin_amdgcn_sched_barrier(0);
#pragma unroll
      for (int mi = 0; mi < 4; ++mi)
#pragma unroll
        for (int ni = 0; ni < 4; ++ni) acc[mi][ni] = mfma16(bfv[1][ni], af[1][mi], acc[mi][ni]);
    }
    const int nxt = q.resolve(lds);
    const typename Epi::Pre pre = epi.preload(m0 + wr * 64, n0 + wc * 64, fr, fq);
    __builtin_amdgcn_sched_barrier(0);
    int m1 = 0, n1 = 0;
    if (nxt >= 0) { Map::map(nxt, m1, n1); SETPTR(m1, n1) GSTAGE(0, 0) GSTAGE(1, 1) }
    __builtin_amdgcn_sched_barrier(0);
    epi.finish(acc, pre, m0 + wr * 64, n0 + wc * 64, fr, fq);
    if (nxt < 0) break;
    m0 = m1; n0 = n1;
  }
#undef GSTAGE
#undef SETPTR
}
struct MapP1 { static DEV void map(int i, int& m0, int& n0) { int mt, nt; if (i < 18 * 192) { const int b = i / 192, r = i - b * 192; nt = r >> 3; mt = 8 * b + (r & 7); } else { nt = i - 18 * 192; mt = 144; } m0 = mt * 128; n0 = nt * 128; } };
struct MapP4 { static DEV void map(int i, int& m0, int& n0) { m0 = (i >> 3) * 128; n0 = (i & 7) * 128; } };
DEV void shift_rows_item(const Prm& p, int L, int b) {
  int tid0 = threadIdx.x; LAUNDER(tid0);
  if (tid0 < 224) {
    float4 v = make_float4(0.f, 0.f, 0.f, 0.f);
    if (b < 32) v = *(const float4*)(p.state_shift + ((size_t)L * 32 + b) * 896 + 4 * tid0);
    *(uint2*)(p.zE + (size_t)(NT + b) * ZE + ZE_ZC + 4 * tid0) = pk4(v.x, v.y, v.z, v.w);
  }
}
constexpr int N_ATT = 1312;
DEV void run_p1(const Prm& p, int L, char* lds) {
  const EpiIn epi{p, L};
  const int home = (int)(xb_xcc_id() & 7u);
  constexpr int N = 145 * 24, C = (N + 7) / 8;
  {
    XQueue q{p.ctl, 0, L, C, N, 0, home, 0};
    gemm_stream<EpiIn, MapP1>(p.xb, D, p.Wb_in + (size_t)L * INP * 1024, 1024, 1024, lds, epi, q);
  }
  unsigned* ctr = p.ctl + QCTR(3, L);
  int t = take_ticket(ctr);
  for (;;) {
    const int mt = q_publish(t, lds);
    if (mt >= 145 + 33) break;
    if (mt >= 145) { t = take_ticket(ctr); shift_rows_item(p, L, mt - 145); continue; }
    t = gemm_tile<EpiIn, 2>(p.xb, D, p.Wb_in + (size_t)L * INP * 1024, 1024, 1024, mt * 128, 24 * 128, lds, epi, ctr);
  }
}
DEV void run_p2(const Prm& p, int L, char* lds) {
  const EpiQ epq{p, L};
  constexpr int N1 = NRW, N2 = N1 + 129, N3 = N2 + 145 * 6, N4 = N3 + 16, N4b = N4 + 512, N5 = N4b + 36;
  const int N6 = L == 0 ? N5 + NWT : N5;
  unsigned* ctr = p.ctl + QCTR(0, L);
  for (;;) {
    const int id = next_item(ctr, lds);
    if (id >= N6) break;
    if (id >= N5) { conv_weights_item(p, 1, id - N5, lds); continue; }
    if (id < N1) r1_item(p, L, id, lds);
    else if (id < N2) kvproj_item(p, L, id - N1, lds);
    else if (id < N3) { const int t = id - N2, mt = t / 6, nt = t - mt * 6; gemm_tile(p.zE + ZE_CQ, ZE, p.Wb_uq + (size_t)L * 768 * 256, 256, 256, mt * 128, nt * 128, lds, epq); }
    else if (id < N4) sample_prep_item(p, L, id - N3);
    else if (id < N4b) lat_item(p, L, id - N4);
    else shift_item(p, L, id - N4b);
  }
}
DEV void run_p3(const Prm& p, int L, char* lds) {
  int tid_ = threadIdx.x; LAUNDER(tid_);
  const int lane = tid_ & 63, w = __builtin_amdgcn_readfirstlane(tid_ >> 6);
  {
    int ndone = 0;
    for (int wi = blockIdx.x * 4 + w; wi < 576; wi += gridDim.x * 4) { r2_wave(p, L, wi, lane); ++ndone; }
    if (blockIdx.x * 4 < 576) {
      asm volatile("s_waitcnt vmcnt(0)" ::: "memory");
      __syncthreads();
      if (threadIdx.x == 0) {
        int tot = 0;
        for (int wi = blockIdx.x * 4; wi < 576; wi += gridDim.x * 4) tot += (576 - wi) < 4 ? (576 - wi) : 4;
        __builtin_amdgcn_fence(__ATOMIC_RELEASE, "agent");
        asm volatile("s_waitcnt vmcnt(0)" ::: "memory");
        __hip_atomic_fetch_add(p.ctl + R2DONE(L), (unsigned)tot, __ATOMIC_RELAXED, __HIP_MEMORY_SCOPE_AGENT);
      }
    }
    (void)ndone;
  }
  unsigned* ctr = p.ctl + QCTR(1, L);
  for (;;) {
    const int q = next_item(ctr, lds);
    if (q >= 128) break;
    attn_sample(p, L, q >> 2, q & 3, lds);
  }
  {
    const int home = (int)(xb_xcc_id() & 7u);
    int k = 0;
    int tx = take_ticket(xq_ctr(p.ctl, 2, L, k, home));
    for (;;) {
      const int i = xq_resolve(p.ctl, 2, L, 128, 1024, k, home, tx, lds);
      if (i < 0) break;
      const int x = i >> 7, j = i & 127, qt = 31 - (j >> 2), pair = 4 * x + (j & 3);
      tx = attn_body<false>(p, L, pair >> 3, pair & 7, qt, lds, xq_ctr(p.ctl, 2, L, k, home));
    }
  }
  unsigned* ctr2 = p.ctl + QCTR(2, L);
  constexpr int NC = (NT + 31) / 32, NQ2 = 32 + NC + NRW / 4;
  bool r2_seen = false;
  for (;;) {
    const int q = next_item(ctr2, lds);
    if (q >= NQ2) break;
    constexpr int NR3 = NRW / 4;
    if (q >= NR3 + 32) conv_item(p, L, q - NR3 - 32);
    else if (q >= NR3) attn_item(p, L, 1280 + q - NR3, lds);
    else {
      if (!r2_seen) {
        if (threadIdx.x == 0) {
          unsigned sp = 0;
          while (__hip_atomic_load(p.ctl + R2DONE(L), __ATOMIC_RELAXED, __HIP_MEMORY_SCOPE_AGENT) < 576u) {
            __builtin_amdgcn_s_sleep(2);
            if (++sp > (1u << 22)) { atomicAdd(&p.ctl[XB_TMO], 1u); break; }
          }
          __builtin_amdgcn_fence(__ATOMIC_ACQUIRE, "agent");
          asm volatile("s_waitcnt vmcnt(0)" ::: "memory");
        }
        __syncthreads();
        r2_seen = true;
      }
      r3_wave(p, L, q * 4 + w, lane, (float*)(lds + w * 17408));
    }
  }
}
DEV void run_p4(const Prm& p, int L, char* lds) {
  const EpiOut epo{p, L};
  const int home = (int)(xb_xcc_id() & 7u);
  {
    XQueue q{p.ctl, 1, L, 128, 1024, 0, home, 0};
    gemm_stream<EpiOut, MapP4>(p.zE  , D, p.Wb_out + (size_t)L * 1024 * 1024, 1024, 1024, lds, epo, q);
  }
  unsigned* ctr = p.ctl + QCTR(3, L) + 16;
  int t = take_ticket(ctr);
  for (;;) {
    const int h = q_publish(t, lds);
    if (h >= 17 * 16) break;
    const int mt = 128 + (h >> 4), r = h & 15;
    t = gemm_tile<EpiOut, 4>(p.zE, D, p.Wb_out + (size_t)L * 1024 * 1024, 1024, 1024, mt * 128, (r >> 1) * 128 + (r & 1) * 64, lds, epo, ctr);
  }
}

__global__ void __launch_bounds__(256, 2) mega(Prm p) {
  extern __shared__ __attribute__((aligned(16))) char lds[];
  volatile LAS unsigned* st = (volatile LAS unsigned*)(lds + LDS_BYTES - 16);
  if (threadIdx.x == 0) { st[0] = 0u; st[1] = 0u; st[2] = 0u; st[3] = 0u; }
  __syncthreads();
  const XcdBarrier xb = xcd_barrier_post(p.ctl, st);
  phase0(p, lds);
  xcd_barrier(xb);
  for (int L = 0; L < 2; ++L) {
    run_p1(p, L, lds); xcd_barrier(xb);
    run_p2(p, L, lds); xcd_barrier(xb);
    run_p3(p, L, lds); xcd_barrier(xb);
    run_p4(p, L, lds); xcd_barrier(xb);
  }
  final_norm(p);
}

static size_t al256(size_t x) { return (x + 255) & ~(size_t)255; }
extern "C" void kernel_launch(void* const* d_in, const int* in_sizes, int n_in, void* d_out, int out_size, void* d_ws, size_t ws_size, hipStream_t stream) {
  Prm p{};
  const float* const* in = (const float* const*)d_in;
  p.x_prompt = in[0]; p.x_sample = in[1]; p.cache_ckv = in[2]; p.cache_krope = in[3]; p.state_conv = in[4]; p.state_shift = in[5]; p.state_wkv = in[6];
  p.meta = in[7]; p.norm_g = in[8]; p.w_in = in[9]; p.conv_w = in[10]; p.q_norm_g = in[11]; p.w_uq = in[12]; p.kv_norm_g = in[13]; p.w_ukv = in[14];
  p.shift_mu = in[15]; p.decay_w0 = in[16]; p.decay_w2 = in[17]; p.iclr_a0 = in[18]; p.iclr_a2 = in[19]; p.key_kk = in[20]; p.key_ka = in[21];
  p.bonus_rk = in[22]; p.lnx_w = in[23]; p.lnx_b = in[24]; p.w_out = in[25]; p.final_g = in[26];
  float* o = (float*)d_out;
  p.y_prompt = o; o += (size_t)4 * 4096 * 1024;
  p.y_sample = o; o += (size_t)32 * 64 * 1024;
  p.ckv_p = o; o += (size_t)2 * 4 * PT * 128;
  p.kr_p = o; o += (size_t)2 * 4 * PT * 32;
  p.conv_p = o; o += 2 * 4 * 2 * 256;
  p.shift_p = o; o += 2 * 4 * 896;
  p.wkv_p = o; o += 2 * 4 * 4 * 64 * 64;
  p.ckv_s = o; o += (size_t)2 * 32 * 64 * 128;
  p.kr_s = o; o += 2 * 32 * 64 * 32;
  p.conv_s = o; o += 2 * 32 * 2 * 256;
  p.shift_s = o; o += 2 * 32 * 896;
  p.wkv_s = o; o += 2 * 32 * 4 * 64 * 64;
  char* w = (char*)d_ws; size_t off = 0;
  auto take = [&](size_t bytes) { char* r = w + off; off = al256(off + bytes); return r; };
  p.ctl = (unsigned*)take(65536);
  p.Wb_in = (bf16_t*)take((size_t)2 * INP * 1024 * 2);
  p.Wb_uq = (bf16_t*)take((size_t)2 * 768 * 256 * 2);
  p.Wb_ukv = (bf16_t*)take((size_t)2 * 1024 * 128 * 2);
  p.Wb_out = (bf16_t*)take((size_t)2 * 1024 * 1024 * 2);
  p.dw2T = (bf16_t*)take((size_t)2 * 256 * 64 * 2);
  p.ia2T = (bf16_t*)take((size_t)2 * 256 * 64 * 2);
  p.ropec = (float*)take((size_t)PT * 16 * 4);
  p.ropes = (float*)take((size_t)PT * 16 * 4);
  p.ssq_x = (float*)take((size_t)7 * NTP * 4);
  p.ssq_q = p.ssq_x + 3 * NTP; p.ssq_kv = p.ssq_x + 5 * NTP;
  p.rkb = (float*)take((size_t)NTP * 4 * 4);
  p.xmeta = (float*)take((size_t)64 * 1024 * 4);
  p.zE = (bf16_t*)take((size_t)NTP * ZE * 2);
  p.zL = (bf16_t*)take((size_t)NTP * ZL * 2);
  p.xb = (bf16_t*)take((size_t)(NTP + 128) * D * 2);
  p.Kn = (bf16_t*)take((size_t)KVR * 512 * 2);
  p.Vt = (bf16_t*)take((size_t)512 * KVR * 2);
  p.Kr = (bf16_t*)take((size_t)KVR * 32 * 2);
  p.rw = take((size_t)NRW * RW_BYTES);
  p.KL = (bf16_t*)((char*)p.y_prompt + ((size_t)32 << 20));
  p.VLT = p.KL + (size_t)32 * SKEYS * 160;
  static int grid = 0;
  if (grid == 0) {
    if (off > ws_size) { fprintf(stderr, "kernel_launch: workspace too small: need %zu have %zu\n", off, ws_size); grid = -1; return; }
    int dev = 0, cus = 0, per_cu = 0;
    (void)hipGetDevice(&dev);
    (void)hipDeviceGetAttribute(&cus, hipDeviceAttributeMultiprocessorCount, dev);
    (void)hipFuncSetAttribute((const void*)mega, hipFuncAttributeMaxDynamicSharedMemorySize, LDS_BYTES);
    (void)hipOccupancyMaxActiveBlocksPerMultiprocessor(&per_cu, (const void*)mega, 256, LDS_BYTES);
    if (per_cu > 2) per_cu = 2;
    if (per_cu < 1) { fprintf(stderr, "kernel_launch: occupancy query returned %d\n", per_cu); per_cu = 1; }
    grid = cus * per_cu;
  }
  if (grid < 0) return;
  (void)hipMemsetAsync(p.ctl, 0, 8192 * 4, stream);
  void* args[] = {&p};
  hipError_t e = hipLaunchCooperativeKernel((const void*)mega, dim3(grid), dim3(256), args, LDS_BYTES, stream);
  if (e != hipSuccess) fprintf(stderr, "cooperative launch failed: %s (grid %d)\n", hipGetErrorString(e), grid);
}
```

```cpp
#include <hip/hip_runtime.h>
#include <cstdio>
#include <cstdint>
#include <type_traits>

typedef unsigned short bf16_t;
typedef short bf16x8 __attribute__((ext_vector_type(8)));
typedef float f32x4 __attribute__((ext_vector_type(4)));
typedef float f32x16 __attribute__((ext_vector_type(16)));
#define DEV __device__ __forceinline__
#define LAUNDER(x) asm volatile("" : "+v"(x))

constexpr int D = 1024;
constexpr int PT = 4112;
constexpr int NPR = 4 * PT;
constexpr int NSM = 32 * 64;
constexpr int NT = NPR + NSM;
constexpr int NTP = 18560;
constexpr int ZL = 1792;
constexpr int ZE = 1312;
constexpr int ZE_CQ = 0, ZE_CKV = 256, ZE_KR = 384, ZE_ZC = 416;
constexpr int ZL_XIN = 0, ZL_BG = 256, ZL_CG = 512, ZL_GA = 768, ZL_GB = 1024, ZL_GC = 1536;
constexpr int INP = 3200;
constexpr int KVR = 16512;
constexpr int NRW_P = 4 * 65 * 4;
constexpr int NRW = NRW_P + 32 * 4;
constexpr int RW_BYTES = 49152;
constexpr float RMS_EPS = 1e-6f;
constexpr float GN_EPS = 64e-5f;
constexpr int LDS_BYTES = 79872;
constexpr int SKEYS = 1088;

struct Prm {
  const float *x_prompt, *x_sample, *cache_ckv, *cache_krope, *state_conv, *state_shift, *state_wkv, *meta, *norm_g, *w_in,
      *conv_w, *q_norm_g, *w_uq, *kv_norm_g, *w_ukv, *shift_mu, *decay_w0, *decay_w2, *iclr_a0, *iclr_a2, *key_kk, *key_ka,
      *bonus_rk, *lnx_w, *lnx_b, *w_out, *final_g;
  float *y_prompt, *y_sample, *ckv_p, *kr_p, *conv_p, *shift_p, *wkv_p, *ckv_s, *kr_s, *conv_s, *shift_s, *wkv_s;
  unsigned* ctl;
  bf16_t *Wb_in, *Wb_uq, *Wb_ukv, *Wb_out, *dw2T, *ia2T;
  float *ropec, *ropes, *ssq_x, *ssq_q, *ssq_kv, *rkb, *xmeta;
  bf16_t *KL, *VLT;
  bf16_t *zE, *zL, *xb, *Kn, *Vt, *Kr;
  char* rw;
};

DEV float bf2f(bf16_t b) { return __uint_as_float((unsigned)b << 16); }
DEV float bflo(unsigned u) { return __uint_as_float(u << 16); }
DEV float bfhi(unsigned u) { return __uint_as_float(u & 0xffff0000u); }
typedef __bf16 hbf16x2_t __attribute__((ext_vector_type(2)));
typedef float hf32x2_t __attribute__((ext_vector_type(2)));
DEV unsigned pk2(float a, float b) { hf32x2_t f = {a, b}; hbf16x2_t r = __builtin_convertvector(f, hbf16x2_t); return __builtin_bit_cast(unsigned, r); }
DEV bf16_t f2bf(float f) { return (bf16_t)(pk2(f, 0.f) & 0xffffu); }
DEV uint2 pk4(float a, float b, float c, float d) { uint2 r; r.x = pk2(a, b); r.y = pk2(c, d); return r; }
DEV float sigmoid_(float x) { return 1.f / (1.f + __expf(-x)); }
DEV float silu_(float x) { return x / (1.f + __expf(-x)); }
DEV float wave_sum(float v) {
#pragma unroll
  for (int o = 1; o < 64; o <<= 1) v += __shfl_xor(v, o);
  return v;
}
DEV f32x16 mfma32(bf16x8 a, bf16x8 b, f32x16 c) { return __builtin_amdgcn_mfma_f32_32x32x16_bf16(a, b, c, 0, 0, 0); }
DEV f32x4 mfma16(bf16x8 a, bf16x8 b, f32x4 c) { return __builtin_amdgcn_mfma_f32_16x16x32_bf16(a, b, c, 0, 0, 0); }
DEV bf16x8 mk8(unsigned a, unsigned b, unsigned c, unsigned d) { uint4 u; u.x = a; u.y = b; u.z = c; u.w = d; return __builtin_bit_cast(bf16x8, u); }
DEV bf16x8 mk8(uint4 u) { return __builtin_bit_cast(bf16x8, u); }
DEV f32x16 zero16() { f32x16 z; for (int i = 0; i < 16; ++i) z[i] = 0.f; return z; }

DEV float* xrow_ptr(const Prm& p, int R) {
  if (R < NPR) { int s = R / PT, q = R - s * PT; return q < 16 ? p.xmeta + (size_t)(s * 16 + q) * D : p.y_prompt + ((size_t)s * 4096 + (q - 16)) * D; }
  return p.y_sample + (size_t)(R - NPR) * D;
}
DEV const float* xin_ptr(const Prm& p, int R) {
  if (R < NPR) { int s = R / PT, q = R - s * PT; return q < 16 ? p.meta + (size_t)q * D : p.x_prompt + ((size_t)s * 4096 + (q - 16)) * D; }
  return p.x_sample + (size_t)(R - NPR) * D;
}
DEV int pos_of(int R) { return R < NPR ? R % PT : 1024 + ((R - NPR) & 63); }

DEV int win_src_col(int n) {
  if (n < 1024) return n;
  if (n < 1536) return 1440 + (n - 1024);
  if (n < 1792) return 2848 + (n - 1536);
  if (n < 2208) return 1024 + (n - 1792);
  if (n < 3104) return 1952 + (n - 2208);
  return -1;
}
DEV int perm32(int rho) { const int n = rho >> 4, i = rho & 15; return 8 * (i >> 2) + 4 * n + (i & 3); }
template <bool PERM, bool P32>
DEV void conv_weight_tile(const float* __restrict__ src, int K, int N, int Npad, bf16_t* __restrict__ dst, const float* __restrict__ sk, float cst, int l, int item, float* T  , int tid) {
  const int ntn = Npad / 64, ntk = K / 64;
  const int r = item, kt = r / ntn, nt = r - kt * ntn;
  const int k0 = kt * 64, n0 = nt * 64;
  {
    const int nslot = n0 + (tid & 15) * 4;
    const int nn = P32 ? (nslot & ~31) + perm32(nslot & 31) : nslot;
    const int sn = PERM ? win_src_col(nn) : (nn < N ? nn : -1);
#pragma unroll
    for (int i = 0; i < 4; ++i) {
      const int k = (tid >> 4) + 16 * i;
      float4 v = make_float4(0.f, 0.f, 0.f, 0.f);
      if (sn >= 0) {
        v = *(const float4*)(src + ((size_t)l * K + k0 + k) * N + sn);
        const float s = (sk ? sk[l * K + k0 + k] : 1.f) * cst;
        v.x *= s; v.y *= s; v.z *= s; v.w *= s;
      }
      float* t = T + k * 65 + (tid & 15) * 4;
      t[0] = v.x; t[1] = v.y; t[2] = v.z; t[3] = v.w;
    }
  }
  __syncthreads();
  {
    const int n = tid >> 2, kc = tid & 3;
    float v[16];
#pragma unroll
    for (int j = 0; j < 16; ++j) v[j] = T[(16 * kc + j) * 65 + n];
    uint4 o0, o1;
    o0.x = pk2(v[0], v[1]); o0.y = pk2(v[2], v[3]); o0.z = pk2(v[4], v[5]); o0.w = pk2(v[6], v[7]);
    o1.x = pk2(v[8], v[9]); o1.y = pk2(v[10], v[11]); o1.z = pk2(v[12], v[13]); o1.w = pk2(v[14], v[15]);
    bf16_t* d = dst + ((size_t)l * Npad + n0 + n) * K + k0 + 16 * kc;
    *(uint4*)d = o0; *(uint4*)(d + 8) = o1;
  }
  __syncthreads();
}
constexpr int WT0 = 16 * 50, WT1 = WT0 + 16 * 16, WT2 = WT1 + 4 * 12, WT3 = WT2 + 2 * 16, WT4 = WT3 + 4, NWT = WT4 + 4;
DEV void conv_weights_item(const Prm& p, int l, int it, char* lds) {
  float* T = (float*)lds;
  int tid = threadIdx.x; LAUNDER(tid);
  if (it < WT0) conv_weight_tile<true, true>(p.w_in, 1024, 3104, INP, p.Wb_in, p.norm_g, 1.f, l, it, T, tid);
  else if (it < WT1) conv_weight_tile<false, true>(p.w_out, 1024, 1024, 1024, p.Wb_out, nullptr, 1.f, l, it - WT0, T, tid);
  else if (it < WT2) conv_weight_tile<false, false>(p.w_uq, 256, 768, 768, p.Wb_uq, p.q_norm_g, 0.10206207261596575f * 1.4426950408889634f, l, it - WT1, T, tid);
  else if (it < WT3) conv_weight_tile<false, false>(p.w_ukv, 128, 1024, 1024, p.Wb_ukv, nullptr, 1.f, l, it - WT2, T, tid);
  else if (it < WT4) conv_weight_tile<false, false>(p.decay_w2, 64, 256, 256, p.dw2T, nullptr, 1.f, l, it - WT3, T, tid);
  else conv_weight_tile<false, false>(p.iclr_a2, 64, 256, 256, p.ia2T, nullptr, 1.f, l, it - WT4, T, tid);
}
DEV void phase0(const Prm& p, char* lds) {
  int tid = threadIdx.x; LAUNDER(tid);
  const int lane = tid & 63, wv = tid >> 6;
  const int gw = blockIdx.x * 4 + wv, NW = gridDim.x * 4;
  const int gt = blockIdx.x * 256 + tid, NTH = gridDim.x * 256;
  for (int R = gw; R < NT; R += NW) {
    const float* src = xin_ptr(p, R);
    float ss = 0.f;
#pragma unroll
    for (int j = 0; j < 4; ++j) {
      const float4 v = ((const float4*)src)[lane + 64 * j];
      ss += v.x * v.x + v.y * v.y + v.z * v.z + v.w * v.w;
      ((uint2*)(p.xb + (size_t)R * D))[lane + 64 * j] = pk4(v.x, v.y, v.z, v.w);
    }
    ss = wave_sum(ss);
    if (lane == 0) p.ssq_x[R] = ss;
  }
  for (int i = gt; i < 6 * NTP; i += NTH) p.ssq_x[NTP + i] = 0.f;
  for (int it = blockIdx.x; it < NWT; it += gridDim.x) conv_weights_item(p, 0, it, lds);
  for (int i = gt; i < PT * 16; i += NTH) {
    const int pos = i >> 4, j = i & 15;
    const float inv = powf(10000.f, -(float)j * 2.0f / 32.f);
    const float ang = (float)pos * inv;
    double a = (double)ang;
    a -= 6.283185307179586476925 * rint(a * 0.15915494309189533577);
    p.ropec[i] = (float)cos(a);
    p.ropes[i] = (float)sin(a);
  }
}

#define LAS3 __attribute__((address_space(3)))
#define RAW_BARRIER() { asm volatile("" ::: "memory"); __builtin_amdgcn_s_barrier(); asm volatile("" ::: "memory"); }
DEV int lds_byte(int r, int c) { const int st = (r >> 4) * 2 + (c >> 5), rr = r & 15, cc = c & 31, ob = rr * 64 + cc * 2; return st * 1024 + (ob ^ (((ob >> 9) & 1) << 5)); }
template <class Epi, int NB = 8>
DEV int gemm_tile(const bf16_t* __restrict__ A, int lda, const bf16_t* __restrict__ Bt, int ldb, int K, int m0, int n0, char* lds, const Epi& epi, unsigned* nctr = nullptr) {
  int tid = threadIdx.x; LAUNDER(tid);
  const int lane = tid & 63, w = __builtin_amdgcn_readfirstlane(tid >> 6), wr = w >> 1, wc = w & 1;
  const int fr = lane & 15, fq = lane >> 4;
  const int sb = lane * 16, swz = sb ^ (((sb >> 9) & 1) << 5), rl = swz >> 6, cl = (swz & 63) >> 1;
  const bf16_t* ga[4]; const bf16_t* gb[4];
#pragma unroll
  for (int i = 0; i < 4; ++i) {
    const int st = 4 * w + i, r = (st >> 1) * 16 + rl, c = (st & 1) * 32 + cl;
    ga[i] = A + (size_t)(m0 + r) * lda + c;
    gb[i] = Bt + (size_t)(n0 + r) * ldb + c;
  }
  const int nk = K / 64;
#define GSTAGE(S, KT) { _Pragma("unroll") for (int i = 0; i < 4; ++i) { \
      __builtin_amdgcn_global_load_lds((const unsigned*)(ga[i] + (KT) * 64), (LAS3 unsigned*)(lds + (S) * 32768 + (4 * w + i) * 1024 + lane * 16), 16, 0, 0); \
      if (2 * w + (i >> 1) < NB) __builtin_amdgcn_global_load_lds((const unsigned*)(gb[i] + (KT) * 64), (LAS3 unsigned*)(lds + (S) * 32768 + 16384 + (4 * w + i) * 1024 + lane * 16), 16, 0, 0); } }
  f32x4 acc[4][4];
#pragma unroll
  for (int i = 0; i < 4; ++i)
#pragma unroll
    for (int j = 0; j < 4; ++j) acc[i][j] = (f32x4){0.f, 0.f, 0.f, 0.f};
  int offA[2], offB[2];
#pragma unroll
  for (int kh = 0; kh < 2; ++kh) { offA[kh] = lds_byte(wr * 64 + fr, kh * 32 + fq * 8); offB[kh] = lds_byte(wc * 64 + fr, kh * 32 + fq * 8); }
  GSTAGE(0, 0)
  if (nk > 1) GSTAGE(1, 1)
  for (int kt = 0; kt < nk; ++kt) {
    const int s = kt & 1;
    if (kt + 1 < nk) { if (2 * w < NB) asm volatile("s_waitcnt vmcnt(8)" ::: "memory"); else asm volatile("s_waitcnt vmcnt(4)" ::: "memory"); }
    else asm volatile("s_waitcnt vmcnt(0)" ::: "memory");
    RAW_BARRIER()
    const char* ia = lds + s * 32768;
    const char* ib = ia + 16384;
    bf16x8 af[2][4], bfv[2][4];
#pragma unroll
    for (int kh = 0; kh < 2; ++kh) {
#pragma unroll
      for (int mi = 0; mi < 4; ++mi) af[kh][mi] = *(const bf16x8*)(ia + offA[kh] + mi * 2048);
#pragma unroll
      for (int ni = 0; ni < (NB < 4 ? NB : 4); ++ni) bfv[kh][ni] = *(const bf16x8*)(ib + offB[kh] + ni * 2048);
    }
    asm volatile("s_waitcnt lgkmcnt(%0)" :: "n"(4 + (NB < 4 ? NB : 4)) : "memory");
    __builtin_amdgcn_sched_barrier(0);
    if (NB == 8 || wc == 0) {
#pragma unroll
      for (int mi = 0; mi < 4; ++mi)
#pragma unroll
        for (int ni = 0; ni < (NB < 4 ? NB : 4); ++ni) acc[mi][ni] = mfma16(bfv[0][ni], af[0][mi], acc[mi][ni]);
    }
    __builtin_amdgcn_sched_barrier(0);
    asm volatile("s_waitcnt lgkmcnt(0)" ::: "memory");
    RAW_BARRIER()
    if (kt + 2 < nk) GSTAGE(s, kt + 2)
    __builtin_amdgcn_sched_barrier(0);
    if (NB == 8 || wc == 0) {
#pragma unroll
      for (int mi = 0; mi < 4; ++mi)
#pragma unroll
        for (int ni = 0; ni < (NB < 4 ? NB : 4); ++ni) acc[mi][ni] = mfma16(bfv[1][ni], af[1][mi], acc[mi][ni]);
    }
  }
  __syncthreads();
#undef GSTAGE
  int tk = 0x7fffffff; if (nctr && tid == 0) tk = (int)atomicAdd(nctr, 1u);
  if (NB == 8 || wc == 0) epi(acc, m0 + wr * 64, n0 + wc * 64, fr, fq);
  return tk;
}

struct EpiIn {
  const Prm& p; int L;
  struct Pre { float s[4]; };
  DEV Pre preload(int mb, int nb, int fr, int fq) const {
    Pre r;
#pragma unroll
    for (int mi = 0; mi < 4; ++mi) r.s[mi] = p.ssq_x[L * NTP + mb + 16 * mi + fr];
    return r;
  }
  DEV void operator()(f32x4 (&acc)[4][4], int mb, int nb, int fr, int fq) const { finish(acc, preload(mb, nb, fr, fq), mb, nb, fr, fq); }
  DEV void finish(f32x4 (&acc)[4][4], const Pre& pre, int mb, int nb, int fr, int fq) const {
#pragma unroll
    for (int mi = 0; mi < 4; ++mi) {
      const int m = mb + 16 * mi + fr;
      const bool ok = m < NT;
      const float rstd = rsqrtf(pre.s[mi] * (1.f / 1024.f) + RMS_EPS);
      float sq = 0.f;
#pragma unroll
      for (int g = 0; g < 2; ++g) {
        const int n0 = nb + 32 * g;
        if (n0 >= 3104) continue;
        bf16_t* dst = n0 < ZL ? p.zL + (size_t)m * ZL + n0 : p.zE + (size_t)m * ZE + (n0 - ZL);
        float v[8];
#pragma unroll
        for (int j = 0; j < 4; ++j) { v[j] = acc[mi][2 * g][j] * rstd; v[4 + j] = acc[mi][2 * g + 1][j] * rstd; }
#pragma unroll
        for (int j = 0; j < 8; ++j) sq += v[j] * v[j];
        if (ok) { uint4 o; o.x = pk2(v[0], v[1]); o.y = pk2(v[2], v[3]); o.z = pk2(v[4], v[5]); o.w = pk2(v[6], v[7]); *(uint4*)(dst + 8 * fq) = o; }
      }
      if (nb >= ZL && nb < ZL + 384) {
        sq += __shfl_xor(sq, 16); sq += __shfl_xor(sq, 32);
        if (fq == 0 && ok) atomicAdd((nb < ZL + 256 ? p.ssq_q : p.ssq_kv) + L * NTP + m, sq);
      }
    }
  }
};
struct EpiQ {
  const Prm& p; int L;
  DEV void operator()(f32x4 (&acc)[4][4], int mb, int nb, int fr, int fq) const {
    bf16_t* Qb = (bf16_t*)p.y_prompt;
#pragma unroll
    for (int mi = 0; mi < 4; ++mi) {
      const int m = mb + 16 * mi + fr;
      const bool ok = m < NT;
      const float rstd = rsqrtf(p.ssq_q[L * NTP + m] * (1.f / 256.f) + RMS_EPS);
      const int pos = pos_of(ok ? m : 0);
#pragma unroll
      for (int np = 0; np < 2; ++np) {
        const int n0 = nb + 32 * np;
        float v[2][4];
#pragma unroll
        for (int h2 = 0; h2 < 2; ++h2)
#pragma unroll
          for (int j = 0; j < 4; ++j) v[h2][j] = acc[mi][2 * np + h2][j] * rstd;
        if (((n0 >> 5) % 3) == 2) {
#pragma unroll
          for (int j = 0; j < 4; ++j) {
            const int c = 4 * fq + j;
            const float cs = p.ropec[pos * 16 + c], sn = p.ropes[pos * 16 + c];
            const float x1 = v[0][j], x2 = v[1][j];
            v[0][j] = x1 * cs - x2 * sn; v[1][j] = x1 * sn + x2 * cs;
          }
        }
        if (ok) {
          *(uint2*)(Qb + (size_t)m * 768 + n0 + 4 * fq) = pk4(v[0][0], v[0][1], v[0][2], v[0][3]);
          *(uint2*)(Qb + (size_t)m * 768 + n0 + 16 + 4 * fq) = pk4(v[1][0], v[1][1], v[1][2], v[1][3]);
        }
      }
    }
  }
};
struct EpiOut {
  const Prm& p; int L;
  struct Pre { uint4 x[4][2]; };
  DEV Pre preload(int mb, int nb, int fr, int fq) const {
    Pre r;
#pragma unroll
    for (int mi = 0; mi < 4; ++mi) {
      const int m = mb + 16 * mi + fr;
      const bf16_t* xr = p.xb + (size_t)(m < NT ? m : 0) * D;
#pragma unroll
      for (int g = 0; g < 2; ++g) r.x[mi][g] = *(const uint4*)(xr + nb + 32 * g + 8 * fq);
    }
    return r;
  }
  DEV void operator()(f32x4 (&acc)[4][4], int mb, int nb, int fr, int fq) const { finish(acc, preload(mb, nb, fr, fq), mb, nb, fr, fq); }
  DEV void finish(f32x4 (&acc)[4][4], const Pre& pre, int mb, int nb, int fr, int fq) const {
#pragma unroll
    for (int mi = 0; mi < 4; ++mi) {
      const int m = mb + 16 * mi + fr;
      const bool ok = m < NT;
      bf16_t* xr = p.xb + (size_t)(ok ? m : 0) * D;
      float ss = 0.f;
#pragma unroll
      for (int g = 0; g < 2; ++g) {
        const int col = nb + 32 * g + 8 * fq;
        const uint4 xi = pre.x[mi][g];
        float v[8] = {bflo(xi.x), bfhi(xi.x), bflo(xi.y), bfhi(xi.y), bflo(xi.z), bfhi(xi.z), bflo(xi.w), bfhi(xi.w)};
#pragma unroll
        for (int j = 0; j < 4; ++j) { v[j] += acc[mi][2 * g][j]; v[4 + j] += acc[mi][2 * g + 1][j]; }
#pragma unroll
        for (int j = 0; j < 8; ++j) ss += v[j] * v[j];
        if (ok) { uint4 o; o.x = pk2(v[0], v[1]); o.y = pk2(v[2], v[3]); o.z = pk2(v[4], v[5]); o.w = pk2(v[6], v[7]); *(uint4*)(xr + col) = o; }
      }
      ss += __shfl_xor(ss, 16); ss += __shfl_xor(ss, 32);
      if (fq == 0 && ok) atomicAdd(p.ssq_x + (L + 1) * NTP + m, ss);
    }
  }
};

DEV void kv_prep_row(const Prm& p, int L, int R, int half, bool valid, bf16_t* At_row  ) {
  const int Rl = valid ? R : 0;
  const bf16_t* zr = p.zE + (size_t)Rl * ZE;
  const float rstd = rsqrtf(p.ssq_kv[L * NTP + Rl] * (1.f / 128.f) + RMS_EPS);
  float* outc; float* outk;
  if (Rl < NPR) { const int s = Rl / PT, q = Rl - s * PT; outc = p.ckv_p + (((size_t)L * 4 + s) * PT + q) * 128; outk = p.kr_p + (((size_t)L * 4 + s) * PT + q) * 32; }
  else { const int j = Rl - NPR; outc = p.ckv_s + ((size_t)L * NSM + j) * 128; outk = p.kr_s + ((size_t)L * NSM + j) * 32; }
  const float* g = p.kv_norm_g + L * 128 + 64 * half;
#pragma unroll
  for (int c8 = 0; c8 < 8; ++c8) {
    const uint4 u = *(const uint4*)(zr + ZE_CKV + 64 * half + 8 * c8);
    const float4 g0 = *(const float4*)(g + 8 * c8), g1 = *(const float4*)(g + 8 * c8 + 4);
    float4 y0, y1;
    y0.x = bflo(u.x) * rstd * g0.x; y0.y = bfhi(u.x) * rstd * g0.y; y0.z = bflo(u.y) * rstd * g0.z; y0.w = bfhi(u.y) * rstd * g0.w;
    y1.x = bflo(u.z) * rstd * g1.x; y1.y = bfhi(u.z) * rstd * g1.y; y1.z = bflo(u.w) * rstd * g1.z; y1.w = bfhi(u.w) * rstd * g1.w;
    if (valid) { *(float4*)(outc + 64 * half + 8 * c8) = y0; *(float4*)(outc + 64 * half + 8 * c8 + 4) = y1; }
    if (At_row) { uint4 o; o.x = pk2(y0.x, y0.y); o.y = pk2(y0.z, y0.w); o.z = pk2(y1.x, y1.y); o.w = pk2(y1.z, y1.w); *(uint4*)(At_row + 64 * half + 8 * c8) = o; }
    if (valid && Rl >= NPR) {
      const int j = Rl - NPR, b = j >> 6, r = j & 63;
      bf16_t* kl = p.KL + ((size_t)b * SKEYS + 1024 + r) * 160 + 16 * (4 * half + (c8 >> 1)) + 4 * (c8 & 1);
      *(uint2*)kl = pk4(y0.x, y0.y, y0.z, y0.w); *(uint2*)(kl + 8) = pk4(y1.x, y1.y, y1.z, y1.w);
    }
    if (c8 & 1) __builtin_amdgcn_sched_barrier(0);
  }
  if (half == 0) {
    const int pos = pos_of(Rl);
#pragma unroll
    for (int c8 = 0; c8 < 2; ++c8) {
      const uint4 u = *(const uint4*)(zr + ZE_KR + 8 * c8), v = *(const uint4*)(zr + ZE_KR + 16 + 8 * c8);
      const float x1[8] = {bflo(u.x), bfhi(u.x), bflo(u.y), bfhi(u.y), bflo(u.z), bfhi(u.z), bflo(u.w), bfhi(u.w)};
      const float x2[8] = {bflo(v.x), bfhi(v.x), bflo(v.y), bfhi(v.y), bflo(v.z), bfhi(v.z), bflo(v.w), bfhi(v.w)};
      float y1[8], y2[8];
#pragma unroll
      for (int e = 0; e < 8; ++e) {
        const float cs = p.ropec[pos * 16 + 8 * c8 + e], sn = p.ropes[pos * 16 + 8 * c8 + e];
        y1[e] = x1[e] * cs - x2[e] * sn; y2[e] = x1[e] * sn + x2[e] * cs;
      }
      if (valid) {
        float4 o;
        o.x = y1[0]; o.y = y1[1]; o.z = y1[2]; o.w = y1[3]; *(float4*)(outk + 8 * c8) = o;
        o.x = y1[4]; o.y = y1[5]; o.z = y1[6]; o.w = y1[7]; *(float4*)(outk + 8 * c8 + 4) = o;
        o.x = y2[0]; o.y = y2[1]; o.z = y2[2]; o.w = y2[3]; *(float4*)(outk + 16 + 8 * c8) = o;
        o.x = y2[4]; o.y = y2[5]; o.z = y2[6]; o.w = y2[7]; *(float4*)(outk + 16 + 8 * c8 + 4) = o;
        {
          const int j = Rl - NPR;
          bf16_t* krd = Rl < NPR ? p.Kr + (size_t)Rl * 32 : p.KL + ((size_t)(j >> 6) * SKEYS + 1024 + (j & 63)) * 160 + 128;
          uint4 q; q.x = pk2(y1[0], y1[1]); q.y = pk2(y1[2], y1[3]); q.z = pk2(y1[4], y1[5]); q.w = pk2(y1[6], y1[7]); *(uint4*)(krd + 8 * c8) = q;
          q.x = pk2(y2[0], y2[1]); q.y = pk2(y2[2], y2[3]); q.z = pk2(y2[4], y2[5]); q.w = pk2(y2[6], y2[7]); *(uint4*)(krd + 16 + 8 * c8) = q;
        }
      }
    }
  }
}
DEV void kvproj_item(const Prm& p, int L, int mt, char* lds) {
  int tid = threadIdx.x; LAUNDER(tid);
  const int lane = tid & 63, w = __builtin_amdgcn_readfirstlane(tid >> 6), wr = w >> 1, wc = w & 1, l31 = lane & 31, hh = lane >> 5;
  bf16_t* At = (bf16_t*)lds;
  bf16_t* Bs = At + 128 * 136;
  {
    const int r = tid >> 1, half = tid & 1, R = mt * 128 + r;
    kv_prep_row(p, L, R, half, R < NPR, At + r * 136);
  }
  for (int h = 0; h < 8; ++h) {
    __syncthreads();
    {
      const bf16_t* wsrc = p.Wb_ukv + ((size_t)L * 1024 + h * 128) * 128;
#pragma unroll
      for (int i = 0; i < 8; ++i) { const int id = tid + 256 * i, row = id >> 4, cc = id & 15; *(uint4*)(Bs + row * 136 + cc * 8) = *(const uint4*)(wsrc + row * 128 + cc * 8); }
    }
    __syncthreads();
    f32x16 acc[2][2];
#pragma unroll
    for (int i = 0; i < 2; ++i)
#pragma unroll
      for (int j = 0; j < 2; ++j) acc[i][j] = zero16();
    const bf16_t* as = At + (wr * 64 + l31) * 136 + hh * 8;
    const bf16_t* bs = Bs + (wc * 64 + l31) * 136 + hh * 8;
    if (wc == 0) {
#pragma unroll 2
      for (int ks = 0; ks < 8; ++ks) {
        const bf16x8 a0 = *(const bf16x8*)(as + ks * 16), a1 = *(const bf16x8*)(as + 32 * 136 + ks * 16);
        const bf16x8 b0 = *(const bf16x8*)(bs + ks * 16), b1 = *(const bf16x8*)(bs + 32 * 136 + ks * 16);
        acc[0][0] = mfma32(b0, a0, acc[0][0]); acc[0][1] = mfma32(b1, a0, acc[0][1]);
        acc[1][0] = mfma32(b0, a1, acc[1][0]); acc[1][1] = mfma32(b1, a1, acc[1][1]);
      }
#pragma unroll
      for (int i = 0; i < 2; ++i) {
        const int KRr = mt * 128 + wr * 64 + 32 * i + l31;
#pragma unroll
        for (int j = 0; j < 2; ++j)
#pragma unroll
          for (int G = 0; G < 4; ++G)
            *(uint2*)(p.Kn + ((size_t)KRr * 8 + h) * 64 + 32 * j + 8 * G + 4 * hh) = pk4(acc[i][j][4 * G], acc[i][j][4 * G + 1], acc[i][j][4 * G + 2], acc[i][j][4 * G + 3]);
      }
    } else {
#pragma unroll 2
      for (int ks = 0; ks < 8; ++ks) {
        const bf16x8 a0 = *(const bf16x8*)(as + ks * 16), a1 = *(const bf16x8*)(as + 32 * 136 + ks * 16);
        const bf16x8 b0 = *(const bf16x8*)(bs + ks * 16), b1 = *(const bf16x8*)(bs + 32 * 136 + ks * 16);
        acc[0][0] = mfma32(a0, b0, acc[0][0]); acc[0][1] = mfma32(a0, b1, acc[0][1]);
        acc[1][0] = mfma32(a1, b0, acc[1][0]); acc[1][1] = mfma32(a1, b1, acc[1][1]);
      }
#pragma unroll
      for (int j = 0; j < 2; ++j) {
        const int d = 32 * j + l31;
#pragma unroll
        for (int i = 0; i < 2; ++i)
#pragma unroll
          for (int G = 0; G < 4; ++G) {
            const int KRr = mt * 128 + wr * 64 + 32 * i + 16 * (G >> 1) + 8 * hh + 4 * (G & 1);
            *(uint2*)(p.Vt + ((size_t)h * 64 + d) * KVR + KRr) = pk4(acc[i][j][4 * G], acc[i][j][4 * G + 1], acc[i][j][4 * G + 2], acc[i][j][4 * G + 3]);
          }
      }
    }
  }
  __syncthreads();
}
DEV void sample_prep_item(const Prm& p, int L, int it) {
  int tid = threadIdx.x; LAUNDER(tid);
  const int R = NPR + it * 128 + (tid >> 1);
  kv_prep_row(p, L, R, tid & 1, true, nullptr);
}
DEV void shift_item(const Prm& p, int L, int st) {
  int tid0 = threadIdx.x; LAUNDER(tid0);
  if (tid0 < 224) {
    const int R = st < 4 ? st * PT + (PT - 1) : NPR + (st - 4) * 64 + 63;
    const uint2 u = *(const uint2*)(p.zE + (size_t)R * ZE + ZE_ZC + 4 * tid0);
    float4 v; v.x = bflo(u.x); v.y = bfhi(u.x); v.z = bflo(u.y); v.w = bfhi(u.y);
    float* dst = st < 4 ? p.shift_p + ((size_t)L * 4 + st) * 896 : p.shift_s + ((size_t)L * 32 + (st - 4)) * 896;
    *(float4*)(dst + 4 * tid0) = v;
  }
}

DEV void lat_item(const Prm& p, int L, int j) {
  int tid = threadIdx.x; LAUNDER(tid);
  const int b = j >> 4, t = j & 15;
  const float* csrc = p.cache_ckv + (((size_t)L * 32 + b) * 1024 + 64 * t) * 128;
  const float* ksrc = p.cache_krope + (((size_t)L * 32 + b) * 1024 + 64 * t) * 32;
  {
    const int row = tid >> 2, qd = tid & 3;
    const float* s = csrc + row * 128 + 32 * qd;
    bf16_t* d = p.KL + ((size_t)b * SKEYS + 64 * t + row) * 160;
    const float4 v0 = *(const float4*)(s), v1 = *(const float4*)(s + 4), v2 = *(const float4*)(s + 8), v3 = *(const float4*)(s + 12);
    const float4 v4 = *(const float4*)(s + 16), v5 = *(const float4*)(s + 20), v6 = *(const float4*)(s + 24), v7 = *(const float4*)(s + 28);
    const float4 k0 = *(const float4*)(ksrc + row * 32 + 8 * qd), k1 = *(const float4*)(ksrc + row * 32 + 8 * qd + 4);
    uint4 a;
    a.x = pk2(v0.x, v0.y); a.y = pk2(v0.z, v0.w); a.z = pk2(v2.x, v2.y); a.w = pk2(v2.z, v2.w); *(uint4*)(d + 32 * qd) = a;
    a.x = pk2(v1.x, v1.y); a.y = pk2(v1.z, v1.w); a.z = pk2(v3.x, v3.y); a.w = pk2(v3.z, v3.w); *(uint4*)(d + 32 * qd + 8) = a;
    a.x = pk2(v4.x, v4.y); a.y = pk2(v4.z, v4.w); a.z = pk2(v6.x, v6.y); a.w = pk2(v6.z, v6.w); *(uint4*)(d + 32 * qd + 16) = a;
    a.x = pk2(v5.x, v5.y); a.y = pk2(v5.z, v5.w); a.z = pk2(v7.x, v7.y); a.w = pk2(v7.z, v7.w); *(uint4*)(d + 32 * qd + 24) = a;
    a.x = pk2(k0.x, k0.y); a.y = pk2(k0.z, k0.w); a.z = pk2(k1.x, k1.y); a.w = pk2(k1.z, k1.w); *(uint4*)(d + 128 + 8 * qd) = a;
  }
}

template <bool SAMPLE>
DEV int attn_body(const Prm& p, int L, int sb, int head, int qt, char* lds, unsigned* nctr = nullptr) {
  int tid = threadIdx.x; LAUNDER(tid);
  const int lane = tid & 63, w = __builtin_amdgcn_readfirstlane(tid >> 6), l31 = lane & 31, hh = lane >> 5;
  bf16_t* Ks = (bf16_t*)lds;
  bf16_t* Vs = Ks + (SAMPLE ? 1 : 2) * 64 * 104;
  bf16_t* Cs = Vs + (SAMPLE ? 1 : 2) * 64 * 72;
  bf16_t* Wl = Cs + 64 * 136;
  const bf16_t* Qb = (const bf16_t*)p.y_prompt;
  bf16_t* mix = p.zE;
  int Rq0, ntiles, lastvis; bool wact, rowvalid;
  if (SAMPLE) { Rq0 = NPR + 64 * sb; ntiles = 17; lastvis = 16; wact = w < 2; rowvalid = wact; }
  else if (qt >= 0) { Rq0 = sb * PT + 16 + 128 * qt; ntiles = 2 * qt + 3; lastvis = 1 + 2 * qt + (w >> 1); wact = true; rowvalid = true; }
  else { Rq0 = sb * PT; ntiles = 1; lastvis = 0; wact = (w == 0); rowvalid = wact && l31 < 16; }
  const int myrow = Rq0 + 32 * w + l31;
  const int Rld = rowvalid ? myrow : Rq0;
  bf16x8 qf[6];
  {
    const bf16_t* qp = Qb + (size_t)Rld * 768 + head * 96 + hh * 8;
#pragma unroll
    for (int ks = 0; ks < 6; ++ks) qf[ks] = *(const bf16x8*)(qp + 16 * ks);
  }
  float m_run = -1e30f, l_run = 0.f;
  f32x16 o0 = zero16(), o1 = zero16();

  uint4 a_kn0, a_kn1, a_kr, a_vt0, a_vt1;
  a_kn0 = a_kn1 = a_kr = a_vt0 = a_vt1 = make_uint4(0, 0, 0, 0);
#define PLOADX(S, TI) { const int KR0 = sb * PT + ((TI) == 0 ? 0 : 16 + 64 * ((TI) - 1)); \
    S##_kn0 = *(const uint4*)(p.Kn + ((size_t)(KR0 + (tid >> 3)) * 8 + head) * 64 + (tid & 7) * 8); \
    S##_kn1 = *(const uint4*)(p.Kn + ((size_t)(KR0 + 32 + (tid >> 3)) * 8 + head) * 64 + (tid & 7) * 8); \
    S##_kr = *(const uint4*)(p.Kr + (size_t)(KR0 + (tid >> 2)) * 32 + (tid & 3) * 8); \
    S##_vt0 = *(const uint4*)(p.Vt + ((size_t)head * 64 + (tid >> 3)) * KVR + KR0 + (tid & 7) * 8); \
    S##_vt1 = *(const uint4*)(p.Vt + ((size_t)head * 64 + 32 + (tid >> 3)) * KVR + KR0 + (tid & 7) * 8); }
#define PWRITEX(S, BUF) { bf16_t* kb_ = Ks + (BUF) * 64 * 104; bf16_t* vb_ = Vs + (BUF) * 64 * 72; \
    *(uint4*)(kb_ + (tid >> 3) * 104 + (tid & 7) * 8) = S##_kn0; *(uint4*)(kb_ + (32 + (tid >> 3)) * 104 + (tid & 7) * 8) = S##_kn1; \
    *(uint4*)(kb_ + (tid >> 2) * 104 + 64 + (tid & 3) * 8) = S##_kr; \
    *(uint4*)(vb_ + (tid >> 3) * 72 + (tid & 7) * 8) = S##_vt0; *(uint4*)(vb_ + (32 + (tid >> 3)) * 72 + (tid & 7) * 8) = S##_vt1; }
  float4 pc0, pc1, pc2, pc3, pc4, pc5, pc6, pc7, pk0, pk1;
  pc0 = pc1 = pc2 = pc3 = pc4 = pc5 = pc6 = pc7 = pk0 = pk1 = make_float4(0.f, 0.f, 0.f, 0.f);
  if (SAMPLE) {
    const bf16_t* wsrc = p.Wb_ukv + ((size_t)L * 1024 + head * 128) * 128;
#pragma unroll
    for (int i = 0; i < 8; ++i) { const int id = tid + 256 * i, row = id >> 4, cc = id & 15; *(uint4*)(Wl + row * 136 + cc * 8) = *(const uint4*)(wsrc + row * 128 + cc * 8); }
  }
#define SLOAD(TI) { const float* csrc; const float* ksrc; \
    if ((TI) < 16) { csrc = p.cache_ckv + (((size_t)L * 32 + sb) * 1024 + 64 * (TI)) * 128; ksrc = p.cache_krope + (((size_t)L * 32 + sb) * 1024 + 64 * (TI)) * 32; } \
    else { csrc = p.ckv_s + ((size_t)L * NSM + 64 * sb) * 128; ksrc = p.kr_s + ((size_t)L * NSM + 64 * sb) * 32; } \
    const float* cb_ = csrc + (tid >> 5) * 128 + (tid & 31) * 4; \
    pc0 = *(const float4*)(cb_); pc1 = *(const float4*)(cb_ + 8 * 128); pc2 = *(const float4*)(cb_ + 16 * 128); pc3 = *(const float4*)(cb_ + 24 * 128); \
    pc4 = *(const float4*)(cb_ + 32 * 128); pc5 = *(const float4*)(cb_ + 40 * 128); pc6 = *(const float4*)(cb_ + 48 * 128); pc7 = *(const float4*)(cb_ + 56 * 128); \
    const float* kb2_ = ksrc + (tid >> 3) * 32 + (tid & 7) * 4; pk0 = *(const float4*)(kb2_); pk1 = *(const float4*)(kb2_ + 32 * 32); }
#define SWRITE(BUF) { bf16_t* cd_ = Cs + (tid >> 5) * 136 + (tid & 31) * 4; \
    *(uint2*)(cd_) = pk4(pc0.x, pc0.y, pc0.z, pc0.w); *(uint2*)(cd_ + 8 * 136) = pk4(pc1.x, pc1.y, pc1.z, pc1.w); \
    *(uint2*)(cd_ + 16 * 136) = pk4(pc2.x, pc2.y, pc2.z, pc2.w); *(uint2*)(cd_ + 24 * 136) = pk4(pc3.x, pc3.y, pc3.z, pc3.w); \
    *(uint2*)(cd_ + 32 * 136) = pk4(pc4.x, pc4.y, pc4.z, pc4.w); *(uint2*)(cd_ + 40 * 136) = pk4(pc5.x, pc5.y, pc5.z, pc5.w); \
    *(uint2*)(cd_ + 48 * 136) = pk4(pc6.x, pc6.y, pc6.z, pc6.w); *(uint2*)(cd_ + 56 * 136) = pk4(pc7.x, pc7.y, pc7.z, pc7.w); \
    }
#define SWRITEK(BUF) { bf16_t* kd_ = Ks + (BUF) * 64 * 104 + (tid >> 3) * 104 + 64 + (tid & 7) * 4; \
    *(uint2*)(kd_) = pk4(pk0.x, pk0.y, pk0.z, pk0.w); *(uint2*)(kd_ + 32 * 104) = pk4(pk1.x, pk1.y, pk1.z, pk1.w); }
  auto sexpand = [&](int buf) {
    const int a = w & 1, b = w >> 1;
    const bf16_t* cp = Cs + (32 * b + l31) * 136 + hh * 8;
    const bf16_t* wkp = Wl + (32 * a + l31) * 136 + hh * 8;
    const bf16_t* wvp = wkp + 64 * 136;
    f32x16 ka = zero16(), va = zero16();
#pragma unroll
    for (int ks = 0; ks < 8; ++ks) {
      const bf16x8 cf = *(const bf16x8*)(cp + 16 * ks);
      ka = mfma32(*(const bf16x8*)(wkp + 16 * ks), cf, ka);
      va = mfma32(cf, *(const bf16x8*)(wvp + 16 * ks), va);
    }
    bf16_t* kb = Ks + buf * 64 * 104; bf16_t* vb = Vs + buf * 64 * 72;
#pragma unroll
    for (int G = 0; G < 4; ++G) {
      *(uint2*)(kb + (32 * b + l31) * 104 + 32 * a + 8 * G + 4 * hh) = pk4(ka[4 * G], ka[4 * G + 1], ka[4 * G + 2], ka[4 * G + 3]);
      *(uint2*)(vb + (32 * a + l31) * 72 + 32 * b + 8 * G + 4 * hh) = pk4(va[4 * G], va[4 * G + 1], va[4 * G + 2], va[4 * G + 3]);
    }
  };
  const int x7 = (l31 >> 1) & 7, x3 = (l31 >> 2) & 3, xv = (l31 >> 1) & 7;
#define KFRAG(SP, KS, SUB) (SAMPLE ? *(const bf16x8*)((const bf16_t*)(SP) + (l31 + 32 * (SUB)) * 104 + hh * 8 + 16 * (KS)) \
    : ((KS) < 4 ? *(const bf16x8*)((SP) + (l31 + 32 * (SUB)) * 128 + (((2 * (KS) + hh) ^ x7) << 4)) \
                : *(const bf16x8*)((SP) + 8192 + (l31 + 32 * (SUB)) * 64 + (((2 * ((KS) - 4) + hh) ^ x3) << 4))))
#define VFR(S, SUB) (*(const bf16x8*)(sp + 12288 + (l31 + 32 * (SUB)) * 128 + (((2 * (S) + hh) ^ xv) << 4)))
#define VHALF(SP, C, SUB) (SAMPLE ? *(const uint2*)((const bf16_t*)(SP) + 64 * 104 + (l31 + 32 * (SUB)) * 72 + 4 * hh + 8 * (C)) \
    : *(const uint2*)((SP) + 12288 + (l31 + 32 * (SUB)) * 128 + 8 * hh + ((((C)) ^ xv) << 4)))
  auto compute_t = [&](auto masked_c, const char* sp) {
    constexpr bool MASKED = decltype(masked_c)::value;
    f32x16 s0 = zero16(), s1 = zero16();
    {
      bf16x8 kf[12];
#pragma unroll
      for (int ks = 0; ks < 6; ++ks) { kf[2 * ks] = KFRAG(sp, ks, 0); kf[2 * ks + 1] = KFRAG(sp, ks, 1); }
      __builtin_amdgcn_sched_barrier(0);
#pragma unroll
      for (int ks = 0; ks < 6; ++ks) { s0 = mfma32(kf[2 * ks], qf[ks], s0); s1 = mfma32(kf[2 * ks + 1], qf[ks], s1); }
    }
    bf16x8 vf[8];
    if (!SAMPLE) {
#pragma unroll
      for (int S = 0; S < 4; ++S) { vf[2 * S] = VFR(S, 0); vf[2 * S + 1] = VFR(S, 1); }
      __builtin_amdgcn_sched_barrier(0);
    }
    if (!SAMPLE && MASKED) {
#pragma unroll
      for (int r = 8; r < 16; ++r) s0[r] = -1e30f;
#pragma unroll
      for (int r = 0; r < 16; ++r) s1[r] = -1e30f;
    }
    float mx = s0[0];
#pragma unroll
    for (int r = 1; r < 16; ++r) mx = fmaxf(mx, s0[r]);
#pragma unroll
    for (int r = 0; r < 16; ++r) mx = fmaxf(mx, s1[r]);
    mx = fmaxf(mx, __shfl_xor(mx, 32));
    const float mnew = fmaxf(m_run, mx);
    const float alpha = __builtin_amdgcn_exp2f(m_run - mnew);
    m_run = mnew;
    float ps = 0.f;
#pragma unroll
    for (int r = 0; r < 16; ++r) { s0[r] = __builtin_amdgcn_exp2f(s0[r] - mnew); ps += s0[r]; }
#pragma unroll
    for (int r = 0; r < 16; ++r) { s1[r] = __builtin_amdgcn_exp2f(s1[r] - mnew); ps += s1[r]; }
    l_run = l_run * alpha + ps;
#pragma unroll
    for (int r = 0; r < 16; ++r) { o0[r] *= alpha; o1[r] *= alpha; }
    const bf16x8 pf0 = mk8(pk2(s0[0], s0[1]), pk2(s0[2], s0[3]), pk2(s0[4], s0[5]), pk2(s0[6], s0[7]));
    const bf16x8 pf1 = mk8(pk2(s0[8], s0[9]), pk2(s0[10], s0[11]), pk2(s0[12], s0[13]), pk2(s0[14], s0[15]));
    const bf16x8 pf2 = mk8(pk2(s1[0], s1[1]), pk2(s1[2], s1[3]), pk2(s1[4], s1[5]), pk2(s1[6], s1[7]));
    const bf16x8 pf3 = mk8(pk2(s1[8], s1[9]), pk2(s1[10], s1[11]), pk2(s1[12], s1[13]), pk2(s1[14], s1[15]));
#define PV_STEP(S, PF) { bf16x8 v0_, v1_; \
      if (SAMPLE) { const uint2 a0 = VHALF(sp, 2 * S, 0), b0 = VHALF(sp, 2 * S + 1, 0), a1 = VHALF(sp, 2 * S, 1), b1 = VHALF(sp, 2 * S + 1, 1); \
        v0_ = mk8(a0.x, a0.y, b0.x, b0.y); v1_ = mk8(a1.x, a1.y, b1.x, b1.y); } \
      else { v0_ = *(const bf16x8*)(sp + 12288 + l31 * 128 + (((2 * S + hh) ^ xv) << 4)); v1_ = *(const bf16x8*)(sp + 12288 + (l31 + 32) * 128 + (((2 * S + hh) ^ xv) << 4)); } \
      o0 = mfma32(v0_, PF, o0); o1 = mfma32(v1_, PF, o1); }
    if (SAMPLE) { PV_STEP(0, pf0) PV_STEP(1, pf1) PV_STEP(2, pf2) PV_STEP(3, pf3) }
    else {
      o0 = mfma32(vf[0], pf0, o0); o1 = mfma32(vf[1], pf0, o1); o0 = mfma32(vf[2], pf1, o0); o1 = mfma32(vf[3], pf1, o1);
      o0 = mfma32(vf[4], pf2, o0); o1 = mfma32(vf[5], pf2, o1); o0 = mfma32(vf[6], pf3, o0); o1 = mfma32(vf[7], pf3, o1);
    }
  };
  auto compute_meta = [&](const char* sp) {
    f32x16 s0 = zero16();
    {
      bf16x8 kf[6];
#pragma unroll
      for (int ks = 0; ks < 6; ++ks) kf[ks] = KFRAG(sp, ks, 0);
      __builtin_amdgcn_sched_barrier(0);
#pragma unroll
      for (int ks = 0; ks < 6; ++ks) s0 = mfma32(kf[ks], qf[ks], s0);
    }
    const bf16x8 v0 = VFR(0, 0), v1 = VFR(0, 1);
    float mx = s0[0];
#pragma unroll
    for (int r = 1; r < 8; ++r) mx = fmaxf(mx, s0[r]);
    mx = fmaxf(mx, __shfl_xor(mx, 32));
    m_run = mx;
    float ps = 0.f;
#pragma unroll
    for (int r = 0; r < 8; ++r) { s0[r] = __builtin_amdgcn_exp2f(s0[r] - mx); ps += s0[r]; }
    l_run = ps;
    const bf16x8 pf0 = mk8(pk2(s0[0], s0[1]), pk2(s0[2], s0[3]), pk2(s0[4], s0[5]), pk2(s0[6], s0[7]));
    o0 = mfma32(v0, pf0, zero16()); o1 = mfma32(v1, pf0, zero16());
  };
  bf16x8 qf7 = mk8(0u, 0u, 0u, 0u);
  const bf16x8 kone = mk8(hh == 0 ? 0x3F80u : 0u, 0u, 0u, 0u);
  auto freeze = [&]() {
    const float mf = bflo(pk2(m_run, 0.f));
    const float fac = __builtin_amdgcn_exp2f(m_run - mf);
    l_run *= fac;
#pragma unroll
    for (int r = 0; r < 16; ++r) { o0[r] *= fac; o1[r] *= fac; }
    qf7 = mk8(hh == 0 ? (pk2(-mf, 0.f) & 0xffffu) : 0u, 0u, 0u, 0u);
  };
  auto compute_f = [&](const char* sp) {
    f32x16 s0, s1;
    {
      bf16x8 kf[12];
#pragma unroll
      for (int ks = 0; ks < 6; ++ks) { kf[2 * ks] = KFRAG(sp, ks, 0); kf[2 * ks + 1] = KFRAG(sp, ks, 1); }
      __builtin_amdgcn_sched_barrier(0);
      s0 = mfma32(kone, qf7, zero16()); s1 = mfma32(kone, qf7, zero16());
#pragma unroll
      for (int ks = 0; ks < 6; ++ks) { s0 = mfma32(kf[2 * ks], qf[ks], s0); s1 = mfma32(kf[2 * ks + 1], qf[ks], s1); }
    }
    bf16x8 vf[8];
    if (!SAMPLE) {
#pragma unroll
      for (int S = 0; S < 4; ++S) { vf[2 * S] = VFR(S, 0); vf[2 * S + 1] = VFR(S, 1); }
      __builtin_amdgcn_sched_barrier(0);
    }
    float ps = 0.f;
#pragma unroll
    for (int r = 0; r < 16; ++r) { s0[r] = __builtin_amdgcn_exp2f(s0[r]); ps += s0[r]; }
#pragma unroll
    for (int r = 0; r < 16; ++r) { s1[r] = __builtin_amdgcn_exp2f(s1[r]); ps += s1[r]; }
    l_run += ps;
    const bf16x8 pf0 = mk8(pk2(s0[0], s0[1]), pk2(s0[2], s0[3]), pk2(s0[4], s0[5]), pk2(s0[6], s0[7]));
    const bf16x8 pf1 = mk8(pk2(s0[8], s0[9]), pk2(s0[10], s0[11]), pk2(s0[12], s0[13]), pk2(s0[14], s0[15]));
    const bf16x8 pf2 = mk8(pk2(s1[0], s1[1]), pk2(s1[2], s1[3]), pk2(s1[4], s1[5]), pk2(s1[6], s1[7]));
    const bf16x8 pf3 = mk8(pk2(s1[8], s1[9]), pk2(s1[10], s1[11]), pk2(s1[12], s1[13]), pk2(s1[14], s1[15]));
    if (SAMPLE) { PV_STEP(0, pf0) PV_STEP(1, pf1) PV_STEP(2, pf2) PV_STEP(3, pf3) }
    else {
      o0 = mfma32(vf[0], pf0, o0); o1 = mfma32(vf[1], pf0, o1); o0 = mfma32(vf[2], pf1, o0); o1 = mfma32(vf[3], pf1, o1);
      o0 = mfma32(vf[4], pf2, o0); o1 = mfma32(vf[5], pf2, o1); o0 = mfma32(vf[6], pf3, o0); o1 = mfma32(vf[7], pf3, o1);
    }
#undef PV_STEP
  };

  if (SAMPLE) {
    SLOAD(0)
    for (int ti = 0; ti < ntiles; ++ti) {
      const int buf = 0;
      SWRITE(buf)
      __syncthreads();
      SWRITEK(buf)
      { const int tn = ti + 1 < ntiles ? ti + 1 : ti; SLOAD(tn) }
      sexpand(buf);
      __syncthreads();
      if (wact) { if (ti == 0) { compute_t(std::false_type{}, (const char*)Ks); freeze(); } else compute_f((const char*)Ks); }
    }
    __syncthreads();
  } else {
    const int l8 = lane >> 3, c8 = lane & 7;
    unsigned kn_o0, kn_o1, kr_o, vt_o0, vt_o1;
    { const int r = 8 * (2 * w) + l8; kn_o0 = (unsigned)((r * 8 + head) * 64 + ((c8 ^ ((r >> 1) & 7)) * 8)); }
    { const int r = 8 * (2 * w + 1) + l8; kn_o1 = (unsigned)((r * 8 + head) * 64 + ((c8 ^ ((r >> 1) & 7)) * 8)); }
    { const int r = 16 * w + (lane >> 2); kr_o = (unsigned)(r * 32 + (((lane & 3) ^ ((r >> 2) & 3)) * 8)); }
    { const int d = 8 * (2 * w) + l8; vt_o0 = (unsigned)((head * 64 + d) * KVR + ((c8 ^ ((d >> 1) & 7)) * 8)); }
    { const int d = 8 * (2 * w + 1) + l8; vt_o1 = (unsigned)((head * 64 + d) * KVR + ((c8 ^ ((d >> 1) & 7)) * 8)); }
#define GLDS16(G, Lp) __builtin_amdgcn_global_load_lds((const unsigned*)(G), (LAS3 unsigned*)(Lp), 16, 0, 0)
#define PDMA(TI, STG) { const int KR0 = sb * PT + ((TI) == 0 ? 0 : 16 + 64 * ((TI) - 1)); char* sb_ = lds + (STG) * 20480 + lane * 16; \
      const bf16_t* kn_ = p.Kn + (size_t)KR0 * 512; const bf16_t* kr_ = p.Kr + (size_t)KR0 * 32; const bf16_t* vt_ = p.Vt + KR0; \
      GLDS16(kn_ + kn_o0, sb_ + (2 * w) * 1024); GLDS16(kn_ + kn_o1, sb_ + (2 * w + 1) * 1024); GLDS16(kr_ + kr_o, sb_ + 8192 + w * 1024); \
      GLDS16(vt_ + vt_o0, sb_ + 12288 + (2 * w) * 1024); GLDS16(vt_ + vt_o1, sb_ + 12288 + (2 * w + 1) * 1024); }
    PDMA(0, 0)
    if (ntiles > 1) PDMA(1, 1)
    int stg = 0, stg2 = 2;
    for (int ti = 0; ti < ntiles; ++ti) {
      if (ti + 1 < ntiles) asm volatile("s_waitcnt vmcnt(5)" ::: "memory"); else asm volatile("s_waitcnt vmcnt(0)" ::: "memory");
      RAW_BARRIER()
      if (ti + 2 < ntiles) PDMA(ti + 2, stg2)
      const char* sp = lds + stg * 20480;
      if (ti == 0) { if (wact) compute_meta(sp); }
      else if (ti == 1) { compute_t(std::false_type{}, sp); freeze(); }
      else if (ti <= lastvis) compute_f(sp);
      stg = stg == 2 ? 0 : stg + 1; stg2 = stg2 == 2 ? 0 : stg2 + 1;
    }
    __syncthreads();
#undef PDMA
#undef GLDS16
  }
  int tk = 0x7fffffff; if (nctr && tid == 0) tk = (int)atomicAdd(nctr, 1u);
  const float lt = l_run + __shfl_xor(l_run, 32);
  if (rowvalid) {
    const float inv = 1.f / lt;
    const bf16_t* gbp = p.zL + (size_t)myrow * ZL + ZL_GB + 64 * head;
    bf16_t* op = mix + (size_t)myrow * D + 256 + 64 * head;
#pragma unroll
    for (int G = 0; G < 4; ++G) {
      const int d = 8 * G + 4 * hh;
      const uint2 g0 = *(const uint2*)(gbp + d), g1 = *(const uint2*)(gbp + 32 + d);
      *(uint2*)(op + d) = pk4(o0[4 * G] * inv * silu_(bflo(g0.x)), o0[4 * G + 1] * inv * silu_(bfhi(g0.x)), o0[4 * G + 2] * inv * silu_(bflo(g0.y)), o0[4 * G + 3] * inv * silu_(bfhi(g0.y)));
      *(uint2*)(op + 32 + d) = pk4(o1[4 * G] * inv * silu_(bflo(g1.x)), o1[4 * G + 1] * inv * silu_(bfhi(g1.x)), o1[4 * G + 2] * inv * silu_(bflo(g1.y)), o1[4 * G + 3] * inv * silu_(bfhi(g1.y)));
    }
  }
  return tk;
}
DEV void attn_item(const Prm& p, int L, int id, char* lds) {
  if (id < 1024) { const int qt = 31 - (id >> 5), sh = id & 31; attn_body<false>(p, L, sh >> 3, sh & 7, qt, lds); }
  else { const int j = id - 1280; attn_body<false>(p, L, j >> 3, j & 7, -1, lds); }
}

typedef short v4i16_t __attribute__((ext_vector_type(4)));
DEV uint2 lds_tr16(const char* pl) { const v4i16_t r = __builtin_amdgcn_ds_read_tr16_b64_v4i16((__attribute__((address_space(3))) v4i16_t*)pl); return __builtin_bit_cast(uint2, r); }
DEV void attn_sample(const Prm& p, int L, int b, int hp, char* lds) {
  int tid = threadIdx.x; LAUNDER(tid);
  const int lane = tid & 63, w = __builtin_amdgcn_readfirstlane(tid >> 6), l31 = lane & 31, hh = lane >> 5;
  const int head = 2 * hp + (w >> 1);
  const bf16_t* Qb = (const bf16_t*)p.y_prompt;
  bf16_t* mix = p.zE;
  const int myrow = NPR + 64 * b + 32 * (w & 1) + l31;
  bf16x8 qf[6];
  {
    const bf16_t* qp = Qb + (size_t)myrow * 768 + head * 96 + hh * 8;
#pragma unroll
    for (int ks = 0; ks < 6; ++ks) qf[ks] = *(const bf16x8*)(qp + 16 * ks);
  }
  unsigned kl_o0, kl_o1, kl_o2, kl_o3, kr_o;
  {
    const int l16 = lane >> 4, c16 = lane & 15;
#define KROW(i) (4 * (4 * w + (i)) + l16)
#define KLO(i) ((unsigned)(KROW(i) * 160 + ((c16 ^ (((KROW(i) & 3) << 2) | ((KROW(i) >> 2) & 3))) * 8)))
    kl_o0 = KLO(0); kl_o1 = KLO(1); kl_o2 = KLO(2); kl_o3 = KLO(3);
#undef KLO
#undef KROW
    const int r = 16 * w + (lane >> 2);
    kr_o = (unsigned)(r * 160 + 128 + (((lane & 3) ^ ((r >> 2) & 3)) * 8));
  }
  const bf16_t* klb = p.KL + (size_t)b * SKEYS * 160;
#define GLDS16(G, Lp) __builtin_amdgcn_global_load_lds((const unsigned*)(G), (LAS3 unsigned*)(Lp), 16, 0, 0)
#define SDMA(TI, STG) { char* sb_ = lds + (STG) * 20480 + lane * 16; const bf16_t* kl_ = klb + (size_t)(TI) * 64 * 160; \
    GLDS16(kl_ + kl_o0, sb_ + (4 * w) * 1024); GLDS16(kl_ + kl_o1, sb_ + (4 * w + 1) * 1024); GLDS16(kl_ + kl_o2, sb_ + (4 * w + 2) * 1024); GLDS16(kl_ + kl_o3, sb_ + (4 * w + 3) * 1024); \
    GLDS16(kl_ + kr_o, sb_ + 16384 + w * 1024); }
  SDMA(0, 0)
  SDMA(1, 1)
  bf16x8 qa0, qa1, qa2, qa3, qa4, qa5, qa6, qa7;
  {
    const float* wsrc = p.w_ukv + ((size_t)L * 128 + l31) * 1024 + head * 128 + 8 * hh;
#define QABS(CT, QA, QB) { f32x16 acc = zero16(); \
      _Pragma("unroll") for (int ks = 0; ks < 4; ++ks) { const float* s_ = wsrc + (size_t)(32 * (CT)) * 1024 + 16 * ks; const float4 a_ = *(const float4*)s_, c_ = *(const float4*)(s_ + 4); \
        acc = mfma32(mk8(pk2(a_.x, a_.y), pk2(a_.z, a_.w), pk2(c_.x, c_.y), pk2(c_.z, c_.w)), qf[ks], acc); } \
      QA = mk8(pk2(acc[0], acc[1]), pk2(acc[2], acc[3]), pk2(acc[4], acc[5]), pk2(acc[6], acc[7])); \
      QB = mk8(pk2(acc[8], acc[9]), pk2(acc[10], acc[11]), pk2(acc[12], acc[13]), pk2(acc[14], acc[15])); }
    QABS(0, qa0, qa1) QABS(1, qa2, qa3) QABS(2, qa4, qa5) QABS(3, qa6, qa7)
#undef QABS
  }
  float m_run = -1e30f, l_run = 0.f;
  f32x16 o0 = zero16(), o1 = zero16(), o2 = zero16(), o3 = zero16();
  bf16x8 qf7 = mk8(0u, 0u, 0u, 0u);
  const bf16x8 kone = mk8(hh == 0 ? 0x3F80u : 0u, 0u, 0u, 0u);
  const int xk = ((l31 & 3) << 2) | ((l31 >> 2) & 3), x3 = (l31 >> 2) & 3;
  int va0, va1;
  {
    const int g = l31 >> 4, q = (l31 >> 2) & 3, pp = l31 & 3;
    const int rowb = (4 * hh + q) * 256 + 8 * (pp & 1) + (q << 6);
    va0 = rowb + (((2 * g + (pp >> 1)) ^ hh) << 4);
    va1 = rowb + 2048 + (((2 * g + (pp >> 1)) ^ (hh + 2)) << 4);
  }
  int stg = 0, stg2 = 2;
  for (int ti = 0; ti < 17; ++ti) {
    if (ti + 1 < 17) asm volatile("s_waitcnt vmcnt(5)" ::: "memory"); else asm volatile("s_waitcnt vmcnt(0)" ::: "memory");
    RAW_BARRIER()
    if (ti + 2 < 17) SDMA(ti + 2, stg2)
    const char* sp = lds + stg * 20480;
    f32x16 s0 = mfma32(kone, qf7, zero16()), s1 = s0;
#define QKL(S, QA) { const bf16x8 k0 = *(const bf16x8*)(sp + l31 * 256 + (((2 * (S) + hh) ^ xk) << 4)), k1 = *(const bf16x8*)(sp + (l31 + 32) * 256 + (((2 * (S) + hh) ^ xk) << 4)); \
      s0 = mfma32(k0, QA, s0); s1 = mfma32(k1, QA, s1); }
    QKL(0, qa0) QKL(1, qa1) QKL(2, qa2) QKL(3, qa3) QKL(4, qa4) QKL(5, qa5) QKL(6, qa6) QKL(7, qa7)
#undef QKL
#pragma unroll
    for (int kr = 0; kr < 2; ++kr) {
      const bf16x8 k0 = *(const bf16x8*)(sp + 16384 + l31 * 64 + (((2 * kr + hh) ^ x3) << 4)), k1 = *(const bf16x8*)(sp + 16384 + (l31 + 32) * 64 + (((2 * kr + hh) ^ x3) << 4));
      s0 = mfma32(k0, qf[4 + kr], s0); s1 = mfma32(k1, qf[4 + kr], s1);
    }
    float ps = 0.f;
    if (ti == 0) {
      float mx = s0[0];
#pragma unroll
      for (int r = 1; r < 16; ++r) mx = fmaxf(mx, s0[r]);
#pragma unroll
      for (int r = 0; r < 16; ++r) mx = fmaxf(mx, s1[r]);
      mx = fmaxf(mx, __shfl_xor(mx, 32));
      m_run = bflo(pk2(mx, 0.f));
#pragma unroll
      for (int r = 0; r < 16; ++r) { s0[r] -= m_run; s1[r] -= m_run; }
      qf7 = mk8(hh == 0 ? (pk2(-m_run, 0.f) & 0xffffu) : 0u, 0u, 0u, 0u);
    }
#pragma unroll
    for (int r = 0; r < 16; ++r) { s0[r] = __builtin_amdgcn_exp2f(s0[r]); ps += s0[r]; }
#pragma unroll
    for (int r = 0; r < 16; ++r) { s1[r] = __builtin_amdgcn_exp2f(s1[r]); ps += s1[r]; }
    l_run += ps;
    const bf16x8 pf0 = mk8(pk2(s0[0], s0[1]), pk2(s0[2], s0[3]), pk2(s0[4], s0[5]), pk2(s0[6], s0[7]));
    const bf16x8 pf1 = mk8(pk2(s0[8], s0[9]), pk2(s0[10], s0[11]), pk2(s0[12], s0[13]), pk2(s0[14], s0[15]));
    const bf16x8 pf2 = mk8(pk2(s1[0], s1[1]), pk2(s1[2], s1[3]), pk2(s1[4], s1[5]), pk2(s1[6], s1[7]));
    const bf16x8 pf3 = mk8(pk2(s1[8], s1[9]), pk2(s1[10], s1[11]), pk2(s1[12], s1[13]), pk2(s1[14], s1[15]));
#define PVT(S, CT, PF, OT) { const uint2 a_ = lds_tr16(sp + (va0 ^ ((CT) << 6)) + (S) * 4096), b_ = lds_tr16(sp + (va1 ^ ((CT) << 6)) + (S) * 4096); \
      OT = mfma32(mk8(a_.x, a_.y, b_.x, b_.y), PF, OT); }
#define PVL(S, PF) PVT(S, 0, PF, o0) PVT(S, 1, PF, o1) PVT(S, 2, PF, o2) PVT(S, 3, PF, o3)
    PVL(0, pf0) PVL(1, pf1) PVL(2, pf2) PVL(3, pf3)
#undef PVL
#undef PVT
    stg = stg == 2 ? 0 : stg + 1; stg2 = stg2 == 2 ? 0 : stg2 + 1;
  }
#undef SDMA
#undef GLDS16
  __syncthreads();
  const float lt = l_run + __shfl_xor(l_run, 32);
  const float inv = 1.f / lt;
  f32x16 e0 = zero16(), e1 = zero16();
  const bf16_t* wv = p.Wb_ukv + ((size_t)L * 1024 + head * 128 + 64 + l31) * 128 + 8 * hh;
#define OEXP(S, OT, RB) { const bf16x8 ob = mk8(pk2(OT[RB] * inv, OT[RB + 1] * inv), pk2(OT[RB + 2] * inv, OT[RB + 3] * inv), pk2(OT[RB + 4] * inv, OT[RB + 5] * inv), pk2(OT[RB + 6] * inv, OT[RB + 7] * inv)); \
    e0 = mfma32(*(const bf16x8*)(wv + 16 * (S)), ob, e0); e1 = mfma32(*(const bf16x8*)(wv + 32 * 128 + 16 * (S)), ob, e1); }
  OEXP(0, o0, 0) OEXP(1, o0, 8) OEXP(2, o1, 0) OEXP(3, o1, 8) OEXP(4, o2, 0) OEXP(5, o2, 8) OEXP(6, o3, 0) OEXP(7, o3, 8)
#undef OEXP
  {
    const bf16_t* gbp = p.zL + (size_t)myrow * ZL + ZL_GB + 64 * head;
    bf16_t* op = mix + (size_t)myrow * D + 256 + 64 * head;
#pragma unroll
    for (int G = 0; G < 4; ++G) {
      const int d = 8 * G + 4 * hh;
      const uint2 g0 = *(const uint2*)(gbp + d), g1 = *(const uint2*)(gbp + 32 + d);
      *(uint2*)(op + d) = pk4(e0[4 * G] * silu_(bflo(g0.x)), e0[4 * G + 1] * silu_(bfhi(g0.x)), e0[4 * G + 2] * silu_(bflo(g0.y)), e0[4 * G + 3] * silu_(bfhi(g0.y)));
      *(uint2*)(op + 32 + d) = pk4(e1[4 * G] * silu_(bflo(g1.x)), e1[4 * G + 1] * silu_(bfhi(g1.x)), e1[4 * G + 2] * silu_(bflo(g1.y)), e1[4 * G + 3] * silu_(bfhi(g1.y)));
    }
  }
}

DEV void conv_item(const Prm& p, int L, int item) {
  int tid = threadIdx.x; LAUNDER(tid);
  bf16_t* mix = p.zE;
  const int c0 = (tid & 31) * 8;
  float w0[8], w1[8], w2[8];
#pragma unroll
  for (int e = 0; e < 8; ++e) { w0[e] = p.conv_w[(L * 3 + 0) * 256 + c0 + e]; w1[e] = p.conv_w[(L * 3 + 1) * 256 + c0 + e]; w2[e] = p.conv_w[(L * 3 + 2) * 256 + c0 + e]; }
  uint4 xiv[4][3], cgv[4][3], bgv[4], gav[4];
#pragma unroll
  for (int it = 0; it < 4; ++it) {
    const int R = item * 32 + it * 8 + (tid >> 5), Rc = R < NT ? R : NT - 1;
#pragma unroll
    for (int dlt = 0; dlt < 3; ++dlt) {
      const int rr = Rc - 2 + dlt;
      const bf16_t* zr = p.zL + (size_t)(rr > 0 ? rr : 0) * ZL;
      xiv[it][dlt] = *(const uint4*)(zr + ZL_XIN + c0); cgv[it][dlt] = *(const uint4*)(zr + ZL_CG + c0);
    }
    const bf16_t* zr = p.zL + (size_t)Rc * ZL;
    bgv[it] = *(const uint4*)(zr + ZL_BG + c0); gav[it] = *(const uint4*)(zr + ZL_GA + c0);
  }
  __builtin_amdgcn_sched_barrier(0);
#pragma unroll
  for (int it = 0; it < 4; ++it) {
    const int R = item * 32 + it * 8 + (tid >> 5);
    if (R >= NT) continue;
    int q, T; const float* st; float* so;
    if (R < NPR) { const int s = R / PT; q = R - s * PT; T = PT; st = nullptr; so = p.conv_p + ((size_t)L * 4 + s) * 512; }
    else { const int b = (R - NPR) >> 6; q = (R - NPR) & 63; T = 64; st = p.state_conv + ((size_t)L * 32 + b) * 512; so = p.conv_s + ((size_t)L * 32 + b) * 512; }
    float u[3][8];
#pragma unroll
    for (int dlt = 0; dlt < 3; ++dlt) {
      const int t = q - 2 + dlt;
      if (t >= 0) {
        const uint4 xi = xiv[it][dlt], cg = cgv[it][dlt];
        u[dlt][0] = bflo(xi.x) * bflo(cg.x); u[dlt][1] = bfhi(xi.x) * bfhi(cg.x); u[dlt][2] = bflo(xi.y) * bflo(cg.y); u[dlt][3] = bfhi(xi.y) * bfhi(cg.y);
        u[dlt][4] = bflo(xi.z) * bflo(cg.z); u[dlt][5] = bfhi(xi.z) * bfhi(cg.z); u[dlt][6] = bflo(xi.w) * bflo(cg.w); u[dlt][7] = bfhi(xi.w) * bfhi(cg.w);
      } else if (st) {
        const float* sr = st + (t + 2) * 256 + c0;
#pragma unroll
        for (int e = 0; e < 8; ++e) u[dlt][e] = sr[e];
      } else {
#pragma unroll
        for (int e = 0; e < 8; ++e) u[dlt][e] = 0.f;
      }
    }
    const uint4 bg = bgv[it], ga = gav[it];
    const float bgf[8] = {bflo(bg.x), bfhi(bg.x), bflo(bg.y), bfhi(bg.y), bflo(bg.z), bfhi(bg.z), bflo(bg.w), bfhi(bg.w)};
    const float gaf[8] = {bflo(ga.x), bfhi(ga.x), bflo(ga.y), bfhi(ga.y), bflo(ga.z), bfhi(ga.z), bflo(ga.w), bfhi(ga.w)};
    float y[8];
#pragma unroll
    for (int e = 0; e < 8; ++e) y[e] = bgf[e] * (w0[e] * u[0][e] + w1[e] * u[1][e] + w2[e] * u[2][e]) * silu_(gaf[e]);
    uint4 o; o.x = pk2(y[0], y[1]); o.y = pk2(y[2], y[3]); o.z = pk2(y[4], y[5]); o.w = pk2(y[6], y[7]);
    *(uint4*)(mix + (size_t)R * D + c0) = o;
    if (q >= T - 2) {
      float* d = so + (q - (T - 2)) * 256 + c0;
#pragma unroll
      for (int e = 0; e < 8; ++e) d[e] = u[2][e];
    }
  }
}

DEV int kperm_addr(int m, int kin) {
  const int mt = m >> 4, ml = m & 15, s = kin >> 5, q = (kin >> 4) & 1, g = (kin >> 2) & 3, e = kin & 3;
  return (((mt * 2 + s) * 64 + ml + 16 * g) * 8) + 4 * q + e;
}
DEV int clay_addr(int x, int v) {
  const int xt = x >> 4, g = (x >> 2) & 3, rr = x & 3, vt = v >> 4, l16 = v & 15;
  return ((xt * 4 + vt) * 64 + 16 * g + l16) * 4 + rr;
}
DEV void mm64(const bf16_t* first, const bf16_t* second, int l31, int hh, f32x16 (&acc)[2][2]) {
#pragma unroll
  for (int ks = 0; ks < 4; ++ks) {
    const bf16x8 f0 = *(const bf16x8*)(first + l31 * 72 + ks * 16 + hh * 8), f1 = *(const bf16x8*)(first + (32 + l31) * 72 + ks * 16 + hh * 8);
    const bf16x8 s0 = *(const bf16x8*)(second + l31 * 72 + ks * 16 + hh * 8), s1 = *(const bf16x8*)(second + (32 + l31) * 72 + ks * 16 + hh * 8);
    acc[0][0] = mfma32(f0, s0, acc[0][0]); acc[0][1] = mfma32(f0, s1, acc[0][1]);
    acc[1][0] = mfma32(f1, s0, acc[1][0]); acc[1][1] = mfma32(f1, s1, acc[1][1]);
  }
}
DEV void mm64x32(const bf16_t* first, const bf16_t* second_rows, int l31, int hh, f32x16 (&acc)[2]) {
#pragma unroll
  for (int ks = 0; ks < 4; ++ks) {
    const bf16x8 f0 = *(const bf16x8*)(first + l31 * 72 + ks * 16 + hh * 8), f1 = *(const bf16x8*)(first + (32 + l31) * 72 + ks * 16 + hh * 8);
    const bf16x8 s0 = *(const bf16x8*)(second_rows + l31 * 72 + ks * 16 + hh * 8);
    acc[0] = mfma32(f0, s0, acc[0]); acc[1] = mfma32(f1, s0, acc[1]);
  }
}

DEV void mmq(const bf16_t* first_rows, const bf16_t* second_rows, int l31, int hh, f32x16& acc) {
#pragma unroll
  for (int ks = 0; ks < 4; ++ks) {
    const bf16x8 f0 = *(const bf16x8*)(first_rows + l31 * 72 + ks * 16 + hh * 8);
    const bf16x8 s0 = *(const bf16x8*)(second_rows + l31 * 72 + ks * 16 + hh * 8);
    acc = mfma32(f0, s0, acc);
  }
}
enum { SH_FULL = 0, SH_UP = 1, SH_LO = 2 };
template <int SH> DEV constexpr bool tile_nz(int tx, int ty) { return SH == SH_FULL || (SH == SH_UP ? tx <= ty : tx >= ty); }
struct Acc64 { f32x16 t[2][2]; };
struct Frag64 { bf16x8 f[4][2]; };
template <int SS> DEV bf16x8 pack8(const f32x16& v) {
  return mk8(pk2(v[8 * SS], v[8 * SS + 1]), pk2(v[8 * SS + 2], v[8 * SS + 3]), pk2(v[8 * SS + 4], v[8 * SS + 5]), pk2(v[8 * SS + 6], v[8 * SS + 7]));
}
template <int SH> DEV void to_frag(const Acc64& X, Frag64& F) {
#pragma unroll
  for (int t = 0; t < 2; ++t) {
    if (tile_nz<SH>(0, t)) { F.f[0][t] = pack8<0>(X.t[0][t]); F.f[1][t] = pack8<1>(X.t[0][t]); }
    if (tile_nz<SH>(1, t)) { F.f[2][t] = pack8<0>(X.t[1][t]); F.f[3][t] = pack8<1>(X.t[1][t]); }
  }
}
template <int SH> DEV void zero_acc(Acc64& X) {
#pragma unroll
  for (int a = 0; a < 2; ++a)
#pragma unroll
    for (int b = 0; b < 2; ++b) if (tile_nz<SH>(a, b)) X.t[a][b] = zero16();
}
template <int SHA, int SHB> DEV void prod_ff(const Frag64& A, const Frag64& B, Acc64& D) {
#pragma unroll
  for (int tm = 0; tm < 2; ++tm)
#pragma unroll
    for (int tn = 0; tn < 2; ++tn)
#pragma unroll
      for (int s = 0; s < 4; ++s)
        if (tile_nz<SHA>(s >> 1, tm) && tile_nz<SHB>(s >> 1, tn)) D.t[tm][tn] = mfma32(A.f[s][tm], B.f[s][tn], D.t[tm][tn]);
}
template <int SHA, int SHB, int SHD> DEV void prod_ff_frag(const Frag64& A, const Frag64& B, Frag64& Fo) {
#pragma unroll
  for (int tm = 0; tm < 2; ++tm)
#pragma unroll
    for (int tn = 0; tn < 2; ++tn)
      if (tile_nz<SHD>(tm, tn)) {
        f32x16 acc = zero16();
#pragma unroll
        for (int s = 0; s < 4; ++s)
          if (tile_nz<SHA>(s >> 1, tm) && tile_nz<SHB>(s >> 1, tn)) acc = mfma32(A.f[s][tm], B.f[s][tn], acc);
        Fo.f[2 * tm][tn] = pack8<0>(acc); Fo.f[2 * tm + 1][tn] = pack8<1>(acc);
      }
}
DEV bf16x8 nat_frag(const bf16_t* S, int row, int s, int hh) { return *(const bf16x8*)(S + row * 72 + 16 * s + 8 * hh); }
DEV bf16x8 perm_frag(const bf16_t* S, int row, int s, int hh) {
  const uint2 a = *(const uint2*)(S + row * 72 + 16 * s + 4 * hh), b = *(const uint2*)(S + row * 72 + 16 * s + 8 + 4 * hh);
  return mk8(a.x, a.y, b.x, b.y);
}
template <int SH, int MODE> DEV void gram(const bf16_t* F, const bf16_t* G, int l31, int hh, Acc64& D) {
  zero_acc<SH>(D);
#pragma unroll
  for (int s = 0; s < 4; ++s) {
    bf16x8 ff[2], gg[2];
#pragma unroll
    for (int t = 0; t < 2; ++t) { ff[t] = nat_frag(F, 32 * t + l31, s, hh); gg[t] = nat_frag(G, 32 * t + l31, s, hh); }
#pragma unroll
    for (int tx = 0; tx < 2; ++tx)
#pragma unroll
      for (int ty = 0; ty < 2; ++ty) if (tile_nz<SH>(tx, ty)) D.t[tx][ty] = mfma32(ff[tx], gg[ty], D.t[tx][ty]);
  }
#pragma unroll
  for (int t = 0; t < 2; ++t)
#pragma unroll
    for (int r = 0; r < 16; ++r) {
      const int x = (r & 3) + 8 * (r >> 2) + 4 * hh, y = l31;
      const bool keep = MODE == 0 ? (x < y) : (MODE == 1 ? (y < x) : (x <= y));
      if (!keep) D.t[t][t][r] = 0.f;
    }
}
template <int SHA> DEV void prod_fm_frag(const Frag64& A, const bf16_t* Mem, int l31, int hh, Frag64& Fo) {
#pragma unroll
  for (int tm = 0; tm < 2; ++tm)
#pragma unroll
    for (int tn = 0; tn < 2; ++tn) {
      f32x16 acc = zero16();
#pragma unroll
      for (int s = 0; s < 4; ++s) if (tile_nz<SHA>(s >> 1, tm)) acc = mfma32(A.f[s][tm], perm_frag(Mem, 32 * tn + l31, s, hh), acc);
      Fo.f[2 * tm][tn] = pack8<0>(acc); Fo.f[2 * tm + 1][tn] = pack8<1>(acc);
    }
}
template <int SHA> DEV void prod_fm(const Frag64& A, const bf16_t* Mem, int l31, int hh, Acc64& D) {
#pragma unroll
  for (int s = 0; s < 4; ++s) {
    bf16x8 mm[2];
#pragma unroll
    for (int t = 0; t < 2; ++t) mm[t] = perm_frag(Mem, 32 * t + l31, s, hh);
#pragma unroll
    for (int tm = 0; tm < 2; ++tm)
#pragma unroll
      for (int tn = 0; tn < 2; ++tn) if (tile_nz<SHA>(s >> 1, tm)) D.t[tm][tn] = mfma32(A.f[s][tm], mm[tn], D.t[tm][tn]);
  }
}
DEV void r1_item(const Prm& p, int L, int idx, char* lds) {
  int tid = threadIdx.x; LAUNDER(tid);
  const int w = __builtin_amdgcn_readfirstlane(tid >> 6);
  int lane = tid & 63, l31 = lane & 31, hh = lane >> 5;
  const int cw = w & 1, tw = w >> 1;
  bf16_t* S0 = (bf16_t*)lds;
  bf16_t* S1 = S0 + 4608; bf16_t* S2 = S1 + 4608; bf16_t* S3 = S2 + 4608; bf16_t* S4 = S3 + 4608; bf16_t* S5 = S4 + 4608; bf16_t* S6 = S5 + 4608; bf16_t* S7 = S6 + 4608;
  float* misc = (float*)(S7 + 4608);
  float* Ef = (float*)S4;
  bool prompt; int st, c, hd;
  if (idx < NRW_P) { prompt = true; st = idx / 260; const int rem = idx - st * 260; c = rem >> 2; hd = rem & 3; }
  else { prompt = false; const int j = idx - NRW_P; st = j >> 2; hd = j & 3; c = 0; }
  char* rwp = p.rw + (size_t)idx * RW_BYTES;
  const float* mu = p.shift_mu + L * 896;
  const int i1 = tid >> 2, m0 = (tid & 3) * 16;
  int R1; bool valid1, hasprev1;
  if (prompt) { const int pp = 64 * c - 48 + i1; valid1 = pp >= 0; R1 = st * PT + (valid1 ? pp : 0); hasprev1 = pp >= 1; }
  else { R1 = NPR + 64 * st + i1; valid1 = true; hasprev1 = i1 >= 1; }
  const bf16_t* zr1 = p.zE + (size_t)R1 * ZE + ZE_ZC;
  const int ti0 = 32 * tw + l31;
  int R; bool valid, hasprev;
  if (prompt) { const int pp = 64 * c - 48 + ti0; valid = pp >= 0; R = st * PT + (valid ? pp : 0); hasprev = pp >= 1; }
  else { R = NPR + 64 * st + ti0; valid = true; hasprev = ti0 >= 1; }
  const bf16_t* zr = p.zE + (size_t)R * ZE + ZE_ZC;
  const int chb = 64 * hd + 32 * cw + 4 * hh;
  uint4 la[2][2], lap[2][2]; uint2 lb[3][4], lbp[3][4];
  {
    const bf16_t* sh0 = p.zE + (size_t)(NT + (prompt ? 32 : st)) * ZE + ZE_ZC;
    const bf16_t* zp1 = hasprev1 ? zr1 - ZE : sh0;
    const bf16_t* zp = hasprev ? zr - ZE : sh0;
#pragma unroll
    for (int part = 0; part < 2; ++part)
#pragma unroll
      for (int h8 = 0; h8 < 2; ++h8) { const int col = 768 + 64 * part + m0 + 8 * h8; la[part][h8] = *(const uint4*)(zr1 + col); lap[part][h8] = *(const uint4*)(zp1 + col); }
#pragma unroll
    for (int part = 0; part < 3; ++part)
#pragma unroll
      for (int G = 0; G < 4; ++G) { const int col = 256 * part + chb + 8 * G; lb[part][G] = *(const uint2*)(zr + col); lbp[part][G] = *(const uint2*)(zp + col); }
    const bf16_t* dsrc = p.dw2T + ((size_t)L * 256 + hd * 64 + i1) * 64 + m0;
    const bf16_t* isrc = p.ia2T + ((size_t)L * 256 + hd * 64 + i1) * 64 + m0;
    const uint4 d0 = *(const uint4*)dsrc, d1 = *(const uint4*)(dsrc + 8), e0 = *(const uint4*)isrc, e1 = *(const uint4*)(isrc + 8);
    __builtin_amdgcn_sched_barrier(0);
    *(uint4*)(S2 + i1 * 72 + m0) = d0; *(uint4*)(S2 + i1 * 72 + m0 + 8) = d1;
    *(uint4*)(S3 + i1 * 72 + m0) = e0; *(uint4*)(S3 + i1 * 72 + m0 + 8) = e1;
  }
  {
    float* prm = misc + 384;
#pragma unroll
    for (int q2 = 0; q2 < 2; ++q2) {
      const int ix = tid + 256 * q2, wh = ix >> 6, chp = ix & 63;
      const float* sp = wh == 0 ? p.decay_w0 : wh == 1 ? p.iclr_a0 : wh == 2 ? p.key_kk : wh == 3 ? p.key_ka : wh == 4 ? p.bonus_rk : nullptr;
      prm[ix] = sp ? sp[L * 256 + hd * 64 + chp] : mu[256 * (wh - 5) + 64 * hd + chp];
    }
  }
#pragma unroll
  for (int part = 0; part < 2; ++part) {
#pragma unroll
    for (int h8 = 0; h8 < 2; ++h8) {
      const int col = 768 + 64 * part + m0 + 8 * h8;
      const uint4 u = la[part][h8], v = lap[part][h8];
      const float cur[8] = {bflo(u.x), bfhi(u.x), bflo(u.y), bfhi(u.y), bflo(u.z), bfhi(u.z), bflo(u.w), bfhi(u.w)};
      float prv[8] = {bflo(v.x), bfhi(v.x), bflo(v.y), bfhi(v.y), bflo(v.z), bfhi(v.z), bflo(v.w), bfhi(v.w)};
      float o[8];
#pragma unroll
      for (int e = 0; e < 8; ++e) { float z = cur[e] + (prv[e] - cur[e]) * mu[col + e]; if (!valid1) z = 0.f; o[e] = part == 0 ? (1.f - 2.f / (__expf(2.f * z) + 1.f)) : z; }
      uint4 a; a.x = pk2(o[0], o[1]); a.y = pk2(o[2], o[3]); a.z = pk2(o[4], o[5]); a.w = pk2(o[6], o[7]);
      *(uint4*)((part == 0 ? S0 : S1) + i1 * 72 + m0 + 8 * h8) = a;
    }
  }
  __syncthreads();
  f32x16 accw = zero16(), acca = zero16();
#pragma unroll
  for (int ks = 0; ks < 4; ++ks) {
    const bf16x8 fw = *(const bf16x8*)(S2 + (32 * cw + l31) * 72 + ks * 16 + hh * 8), fa = *(const bf16x8*)(S3 + (32 * cw + l31) * 72 + ks * 16 + hh * 8);
    const bf16x8 sw = *(const bf16x8*)(S0 + (32 * tw + l31) * 72 + ks * 16 + hh * 8), sa = *(const bf16x8*)(S1 + (32 * tw + l31) * 72 + ks * 16 + hh * 8);
    accw = mfma32(fw, sw, accw); acca = mfma32(fa, sa, acca);
  }
  int ti = ti0;
  float e_[16];
  float ssq = 0.f;
#pragma unroll
  for (int G = 0; G < 4; ++G) {
    const int ch = chb + 8 * G, col = 256 + ch;
    const uint2 u = lb[1][G], v = lbp[1][G];
    const float cur[4] = {bflo(u.x), bfhi(u.x), bflo(u.y), bfhi(u.y)};
    float prv[4] = {bflo(v.x), bfhi(v.x), bflo(v.y), bfhi(v.y)};
    const int chq = 32 * cw + 8 * G + 4 * hh;
    const float4 kkw = *(const float4*)(misc + 384 + 128 + chq), w0 = *(const float4*)(misc + 384 + chq), m4 = *(const float4*)(misc + 384 + 384 + chq);
    const float kkv[4] = {kkw.x, kkw.y, kkw.z, kkw.w}, w0v[4] = {w0.x, w0.y, w0.z, w0.w}, muv[4] = {m4.x, m4.y, m4.z, m4.w};
#pragma unroll
    for (int e = 0; e < 4; ++e) {
      float z = cur[e] + (prv[e] - cur[e]) * muv[e];
      if (!valid) z = 0.f;
      const float kkr = z * kkv[e];
      ssq += kkr * kkr;
      e_[4 * G + e] = valid ? 0.6065306597126334f * sigmoid_(w0v[e] + accw[4 * G + e]) : 0.f;
    }
  }
  ssq += __shfl_xor(ssq, 32);
  if (hh == 0) misc[(cw * 64 + ti) * 2] = ssq;
#pragma unroll
  for (int G = 0; G < 4; ++G)
#pragma unroll
    for (int e = 0; e < 4; ++e) Ef[ti * 65 + 32 * cw + 8 * G + 4 * hh + e] = e_[4 * G + e];
  __syncthreads();
  {
    const int ch = tid & 63, seg = tid >> 6;
    float run = 0.f;
#pragma unroll
    for (int t = 0; t < 16; ++t) { run += Ef[(16 * seg + t) * 65 + ch]; Ef[(16 * seg + t) * 65 + ch] = run; }
    __syncthreads();
    float off = 0.f;
    for (int s2 = 0; s2 < seg; ++s2) off += Ef[(16 * s2 + 15) * 65 + ch];
    __syncthreads();
#pragma unroll
    for (int t = 0; t < 16; ++t) Ef[(16 * seg + t) * 65 + ch] += off;
    if (seg == 3) { const float cC = Ef[63 * 65 + ch]; misc[320 + ch] = cC; misc[256 + ch] = __expf(-cC); }
    __syncthreads();
  }
  float cc_[16];
#pragma unroll
  for (int G = 0; G < 4; ++G)
#pragma unroll
    for (int e = 0; e < 4; ++e) cc_[4 * G + e] = Ef[ti * 65 + 32 * cw + 8 * G + 4 * hh + e];
  const float kinv = 1.f / fmaxf(sqrtf(misc[ti * 2] + misc[(64 + ti) * 2]), 1e-12f);
  __syncthreads();
  LAUNDER(ti); LAUNDER(hh);
  uint2 vpk[4];
  float rk = 0.f;
#pragma unroll
  for (int G = 0; G < 4; ++G) {
    const int ch = chb + 8 * G, chl = 32 * cw + 8 * G + 4 * hh;
    float zs[3][4];
#pragma unroll
    for (int part = 0; part < 3; ++part) {
      const int col = 256 * part + ch;
      const uint2 u = lb[part][G], v = lbp[part][G];
      const float cur[4] = {bflo(u.x), bfhi(u.x), bflo(u.y), bfhi(u.y)};
      float prv[4] = {bflo(v.x), bfhi(v.x), bflo(v.y), bfhi(v.y)};
      const float4 m4 = *(const float4*)(misc + 384 + 320 + 64 * part + chl);
      const float muv[4] = {m4.x, m4.y, m4.z, m4.w};
#pragma unroll
      for (int e = 0; e < 4; ++e) { float z = cur[e] + (prv[e] - cur[e]) * muv[e]; zs[part][e] = valid ? z : 0.f; }
    }
    vpk[G] = pk4(zs[2][0], zs[2][1], zs[2][2], zs[2][3]);
    const float4 a04 = *(const float4*)(misc + 384 + 64 + chl), kk4 = *(const float4*)(misc + 384 + 128 + chl), ka4 = *(const float4*)(misc + 384 + 192 + chl), bo4 = *(const float4*)(misc + 384 + 256 + chl);
    const float a0v[4] = {a04.x, a04.y, a04.z, a04.w}, kkv[4] = {kk4.x, kk4.y, kk4.z, kk4.w}, kav[4] = {ka4.x, ka4.y, ka4.z, ka4.w}, bov[4] = {bo4.x, bo4.y, bo4.z, bo4.w};
    float at[4], rt[4], bt[4], kt[4], bh[4], kh[4];
#pragma unroll
    for (int e = 0; e < 4; ++e) {
      const int r = 4 * G + e;
      const float al = sigmoid_(a0v[e] + acca[r]);
      const float kk = zs[1][e] * kkv[e] * kinv;
      const float km = zs[1][e] * (1.f + (al - 1.f) * kav[e]);
      rk += zs[0][e] * km * bov[e];
      const float gC = misc[256 + chl + e];
      const float cprev = cc_[r] - e_[r];
      const float ea = __expf(-cprev), er = __expf(-cc_[r]), ek = __builtin_amdgcn_rcpf(er), eh = ek * gC;
      const float b = kk * al;
      at[e] = -kk * ea; rt[e] = zs[0][e] * er; bt[e] = b * ek; kt[e] = km * ek; bh[e] = b * eh; kh[e] = km * eh;
    }
    *(uint2*)(S0 + ti * 72 + chl) = pk4(at[0], at[1], at[2], at[3]);
    *(uint2*)(S1 + ti * 72 + chl) = pk4(rt[0], rt[1], rt[2], rt[3]);
    *(uint2*)(S2 + ti * 72 + chl) = pk4(bt[0], bt[1], bt[2], bt[3]);
    *(uint2*)(S3 + ti * 72 + chl) = pk4(kt[0], kt[1], kt[2], kt[3]);
#pragma unroll
    for (int e = 0; e < 4; ++e) { S4[(chl + e) * 72 + ti] = f2bf(at[e]); S5[(chl + e) * 72 + ti] = f2bf(bh[e]); S6[(chl + e) * 72 + ti] = f2bf(kh[e]); S7[(chl + e) * 72 + ti] = f2bf(zs[2][e]); }
    *(uint2*)(rwp + 40960 + (ti * 64 + chl) * 2) = vpk[G];
  }
  rk += __shfl_xor(rk, 32);
  if (hh == 0) misc[(cw * 64 + ti) * 2 + 1] = rk;
  __syncthreads();
  if (valid && cw == 0 && hh == 0) p.rkb[(size_t)R * 4 + hd] = misc[ti * 2 + 1] + misc[(64 + ti) * 2 + 1];
  LAUNDER(l31); LAUNDER(hh); LAUNDER(lane);
  {
    Acc64 T;
    {
      Acc64 Mx, MTx;
      gram<SH_UP, 0>(S2, S0, l31, hh, Mx);
      gram<SH_LO, 1>(S0, S2, l31, hh, MTx);
      Frag64 fM, fMT, fT;
      to_frag<SH_UP>(Mx, fM); to_frag<SH_LO>(MTx, fMT);
      __builtin_amdgcn_sched_barrier(0);
      T = Mx;
#pragma unroll
      for (int t = 0; t < 2; ++t)
#pragma unroll
        for (int r = 0; r < 16; ++r) if ((r & 3) + 8 * (r >> 2) + 4 * hh == l31) T.t[t][t][r] += 1.f;
      T.t[1][0] = zero16();
      for (int r = 0; r < 5; ++r) {
        Frag64 fM2, fMT2;
        prod_ff_frag<SH_LO, SH_UP, SH_UP>(fMT, fM, fM2);
        prod_ff_frag<SH_UP, SH_LO, SH_LO>(fM, fMT, fMT2);
#pragma unroll
        for (int s = 0; s < 4; ++s)
#pragma unroll
          for (int t = 0; t < 2; ++t) { if (tile_nz<SH_UP>(s >> 1, t)) fM.f[s][t] = fM2.f[s][t]; if (tile_nz<SH_LO>(s >> 1, t)) fMT.f[s][t] = fMT2.f[s][t]; }
        to_frag<SH_UP>(T, fT);
        prod_ff<SH_LO, SH_UP>(fMT, fT, T);
      }
    }
    Frag64 fT;
    to_frag<SH_UP>(T, fT);
    __builtin_amdgcn_sched_barrier(0);
    if (w < 2) {
      Frag64 fW;
      prod_fm_frag<SH_UP>(fT, S4, l31, hh, fW);
      __builtin_amdgcn_sched_barrier(0);
      Acc64 O; zero_acc<SH_FULL>(O);
      if (w == 0) {
        prod_fm<SH_FULL>(fW, S5, l31, hh, O);
#pragma unroll
        for (int tx = 0; tx < 2; ++tx)
#pragma unroll
          for (int ty = 0; ty < 2; ++ty)
#pragma unroll
            for (int G = 0; G < 4; ++G) {
              const int x0 = 32 * tx + 8 * G + 4 * hh, y = 32 * ty + l31;
              float v[4];
#pragma unroll
              for (int e = 0; e < 4; ++e) { v[e] = O.t[tx][ty][4 * G + e]; if (x0 + e == y) v[e] += misc[256 + y]; }
              *(uint2*)(rwp + 0 + kperm_addr(y, x0) * 2) = pk4(v[0], v[1], v[2], v[3]);
            }
      } else {
        Acc64 Nb; gram<SH_UP, 2>(S2, S1, l31, hh, Nb);
        Frag64 fN; to_frag<SH_UP>(Nb, fN);
        prod_ff<SH_FULL, SH_UP>(fW, fN, O);
#pragma unroll
        for (int tx = 0; tx < 2; ++tx)
#pragma unroll
          for (int ty = 0; ty < 2; ++ty)
#pragma unroll
            for (int G = 0; G < 4; ++G) {
              const int x0 = 32 * tx + 8 * G + 4 * hh, y = 32 * ty + l31;
              const uint2 rr = *(const uint2*)(S1 + y * 72 + x0);
              *(uint2*)(rwp + 8192 + kperm_addr(y, x0) * 2) = pk4(O.t[tx][ty][4 * G] + bflo(rr.x), O.t[tx][ty][4 * G + 1] + bfhi(rr.x), O.t[tx][ty][4 * G + 2] + bflo(rr.y), O.t[tx][ty][4 * G + 3] + bfhi(rr.y));
            }
      }
    } else {
      Frag64 fX;
      {
        Acc64 Nk; gram<SH_LO, 1>(S0, S3, l31, hh, Nk);
        Frag64 fNk; to_frag<SH_LO>(Nk, fNk);
        prod_ff_frag<SH_UP, SH_LO, SH_LO>(fT, fNk, fX);
      }
      __builtin_amdgcn_sched_barrier(0);
      if (w == 2) {
        Acc64 Z; zero_acc<SH_FULL>(Z);
        prod_fm<SH_LO>(fX, S5, l31, hh, Z);
#pragma unroll
        for (int tx = 0; tx < 2; ++tx)
#pragma unroll
          for (int ty = 0; ty < 2; ++ty)
#pragma unroll
            for (int G = 0; G < 4; ++G) {
              const int x0 = 32 * tx + 8 * G + 4 * hh, y = 32 * ty + l31;
              const uint2 kk2 = *(const uint2*)(S6 + y * 72 + x0);
              Z.t[tx][ty][4 * G] += bflo(kk2.x); Z.t[tx][ty][4 * G + 1] += bfhi(kk2.x); Z.t[tx][ty][4 * G + 2] += bflo(kk2.y); Z.t[tx][ty][4 * G + 3] += bfhi(kk2.y);
            }
        Frag64 fZ; to_frag<SH_FULL>(Z, fZ);
        __builtin_amdgcn_sched_barrier(0);
        Acc64 Q; zero_acc<SH_FULL>(Q);
        prod_fm<SH_FULL>(fZ, S7, l31, hh, Q);
#pragma unroll
        for (int tx = 0; tx < 2; ++tx)
#pragma unroll
          for (int ty = 0; ty < 2; ++ty)
#pragma unroll
            for (int G = 0; G < 4; ++G)
              *(uint2*)(rwp + 16384 + clay_addr(32 * tx + 8 * G + 4 * hh, 32 * ty + l31) * 2) = pk4(Q.t[tx][ty][4 * G], Q.t[tx][ty][4 * G + 1], Q.t[tx][ty][4 * G + 2], Q.t[tx][ty][4 * G + 3]);
      } else {
        Acc64 H; gram<SH_UP, 2>(S3, S1, l31, hh, H);
        {
          Acc64 Nb; gram<SH_UP, 2>(S2, S1, l31, hh, Nb);
          Frag64 fN; to_frag<SH_UP>(Nb, fN);
          prod_ff<SH_LO, SH_UP>(fX, fN, H);
        }
        Frag64 fH; to_frag<SH_UP>(H, fH);
        __builtin_amdgcn_sched_barrier(0);
        Acc64 Y; zero_acc<SH_FULL>(Y);
        prod_fm<SH_UP>(fH, S7, l31, hh, Y);
#pragma unroll
        for (int tx = 0; tx < 2; ++tx)
#pragma unroll
          for (int ty = 0; ty < 2; ++ty)
#pragma unroll
            for (int G = 0; G < 4; ++G)
              *(uint2*)(rwp + 24576 + clay_addr(32 * tx + 8 * G + 4 * hh, 32 * ty + l31) * 2) = pk4(Y.t[tx][ty][4 * G], Y.t[tx][ty][4 * G + 1], Y.t[tx][ty][4 * G + 2], Y.t[tx][ty][4 * G + 3]);
      }
    }
  }
  __syncthreads();
}

DEV void r2_wave(const Prm& p, int L, int wi, int lane) {
  bool prompt; int st, hd, vt;
  if (wi < 64) { prompt = true; st = wi >> 4; hd = (wi >> 2) & 3; vt = wi & 3; }
  else { prompt = false; const int j = wi - 64; st = j >> 4; hd = (j >> 2) & 3; vt = j & 3; }
  const int nch = prompt ? 65 : 1;
  const int idx0 = prompt ? st * 260 + hd : NRW_P + st * 4 + hd;
  const int l16 = lane & 15, g = lane >> 4;
  f32x4 acc[4];
  float* outp;
  if (prompt) {
#pragma unroll
    for (int mt = 0; mt < 4; ++mt) acc[mt] = (f32x4){0.f, 0.f, 0.f, 0.f};
    outp = p.wkv_p + ((((size_t)L * 4 + st) * 4 + hd) * 64 + 16 * vt + l16) * 64;
  } else {
    const float* sp = p.state_wkv + ((((size_t)L * 32 + st) * 4 + hd) * 64 + 16 * vt + l16) * 64;
#pragma unroll
    for (int mt = 0; mt < 4; ++mt) acc[mt] = *(const f32x4*)(sp + 16 * mt + 4 * g);
    outp = p.wkv_s + ((((size_t)L * 32 + st) * 4 + hd) * 64 + 16 * vt + l16) * 64;
  }
  const char* rw0 = p.rw + (size_t)idx0 * RW_BYTES;
  uint4 pf[3][8]; uint2 qv[3][4];
#pragma unroll
  for (int k = 0; k < 3; ++k) {
    const int cc = k < nch ? k : nch - 1;
    const char* src = rw0 + (size_t)cc * 4 * RW_BYTES;
#pragma unroll
    for (int i = 0; i < 8; ++i) pf[k][i] = *(const uint4*)(src + (i * 64 + lane) * 16);
#pragma unroll
    for (int mt = 0; mt < 4; ++mt) qv[k][mt] = *(const uint2*)(src + 16384 + ((mt * 4 + vt) * 64 + lane) * 8);
  }
  for (int c0 = 0; c0 < nch; c0 += 3) {
#pragma unroll
    for (int k = 0; k < 3; ++k) {
      const int c = c0 + k;
      if (c < nch) {
        char* cur = (char*)rw0 + (size_t)c * 4 * RW_BYTES;
        uint4 bfr[2];
#pragma unroll
        for (int s = 0; s < 2; ++s) {
          bfr[s].x = pk2(acc[2 * s][0], acc[2 * s][1]); bfr[s].y = pk2(acc[2 * s][2], acc[2 * s][3]);
          bfr[s].z = pk2(acc[2 * s + 1][0], acc[2 * s + 1][1]); bfr[s].w = pk2(acc[2 * s + 1][2], acc[2 * s + 1][3]);
          *(uint4*)(cur + 32768 + ((vt * 2 + s) * 64 + lane) * 16) = bfr[s];
        }
#pragma unroll
        for (int mt = 0; mt < 4; ++mt) {
          f32x4 a = {bflo(qv[k][mt].x), bfhi(qv[k][mt].x), bflo(qv[k][mt].y), bfhi(qv[k][mt].y)};
#pragma unroll
          for (int s = 0; s < 2; ++s) a = mfma16(mk8(pf[k][mt * 2 + s]), mk8(bfr[s]), a);
          acc[mt] = a;
        }
        const int cn = c + 3 < nch ? c + 3 : nch - 1;
        const char* src = rw0 + (size_t)cn * 4 * RW_BYTES;
#pragma unroll
        for (int i = 0; i < 8; ++i) pf[k][i] = *(const uint4*)(src + (i * 64 + lane) * 16);
#pragma unroll
        for (int mt = 0; mt < 4; ++mt) qv[k][mt] = *(const uint2*)(src + 16384 + ((mt * 4 + vt) * 64 + lane) * 8);
      }
    }
  }
#pragma unroll
  for (int mt = 0; mt < 4; ++mt) *(f32x4*)(outp + 16 * mt + 4 * g) = acc[mt];
}

DEV void r3_wave(const Prm& p, int L, int idx, int lane, float* Y  ) {
  LAUNDER(lane);
  bool prompt; int st, c, hd;
  if (idx < NRW_P) { prompt = true; st = idx / 260; const int rem = idx - st * 260; c = rem >> 2; hd = rem & 3; }
  else { prompt = false; const int j = idx - NRW_P; st = j >> 2; hd = j & 3; c = 0; }
  const char* rwp = p.rw + (size_t)idx * RW_BYTES;
  const int l16 = lane & 15, g = lane >> 4;
  bf16_t* mix = p.zE;
  uint4 sf[4][2], gf[4][2]; uint2 qv[4][4];
#pragma unroll
  for (int vt = 0; vt < 4; ++vt)
#pragma unroll
    for (int s = 0; s < 2; ++s) sf[vt][s] = *(const uint4*)(rwp + 32768 + ((vt * 2 + s) * 64 + lane) * 16);
#pragma unroll
  for (int it = 0; it < 4; ++it) {
    gf[it][0] = *(const uint4*)(rwp + 8192 + ((it * 2 + 0) * 64 + lane) * 16); gf[it][1] = *(const uint4*)(rwp + 8192 + ((it * 2 + 1) * 64 + lane) * 16);
#pragma unroll
    for (int vt = 0; vt < 4; ++vt) qv[it][vt] = *(const uint2*)(rwp + 24576 + ((it * 4 + vt) * 64 + lane) * 8);
  }
  const float lw[4] = {p.lnx_w[L * 256 + hd * 64 + l16], p.lnx_w[L * 256 + hd * 64 + 16 + l16], p.lnx_w[L * 256 + hd * 64 + 32 + l16], p.lnx_w[L * 256 + hd * 64 + 48 + l16]};
  const float lb[4] = {p.lnx_b[L * 256 + hd * 64 + l16], p.lnx_b[L * 256 + hd * 64 + 16 + l16], p.lnx_b[L * 256 + hd * 64 + 32 + l16], p.lnx_b[L * 256 + hd * 64 + 48 + l16]};
  const int vc = (lane & 7) * 8;
  float rkv[8]; uint4 vvv[8], gcv[8];
#pragma unroll
  for (int ps = 0; ps < 8; ++ps) {
    const int i = 8 * ps + (lane >> 3);
    int R;
    if (prompt) { const int pp = 64 * c - 48 + i; R = st * PT + (pp >= 0 ? pp : 0); }
    else R = NPR + 64 * st + i;
    rkv[ps] = p.rkb[(size_t)R * 4 + hd];
    vvv[ps] = *(const uint4*)(rwp + 40960 + (i * 64 + vc) * 2);
    gcv[ps] = *(const uint4*)(p.zL + (size_t)R * ZL + ZL_GC + hd * 64 + vc);
  }
  __builtin_amdgcn_sched_barrier(0);
#pragma unroll
  for (int it = 0; it < 4; ++it) {
    f32x4 y[4];
#pragma unroll
    for (int vt = 0; vt < 4; ++vt) {
      const uint2 q = qv[it][vt];
      f32x4 a = {bflo(q.x), bfhi(q.x), bflo(q.y), bfhi(q.y)};
      a = mfma16(mk8(gf[it][0]), mk8(sf[vt][0]), a);
      a = mfma16(mk8(gf[it][1]), mk8(sf[vt][1]), a);
      y[vt] = a;
    }
#pragma unroll
    for (int rr = 0; rr < 4; ++rr) {
      const int i = 16 * it + 4 * g + rr;
      float s1 = y[0][rr] + y[1][rr] + y[2][rr] + y[3][rr];
      s1 += __shfl_xor(s1, 1); s1 += __shfl_xor(s1, 2); s1 += __shfl_xor(s1, 4); s1 += __shfl_xor(s1, 8);
      const float mean = s1 * (1.f / 64.f);
      const float d0 = y[0][rr] - mean, d1 = y[1][rr] - mean, d2 = y[2][rr] - mean, d3 = y[3][rr] - mean;
      float s2 = d0 * d0 + d1 * d1 + d2 * d2 + d3 * d3;
      s2 += __shfl_xor(s2, 1); s2 += __shfl_xor(s2, 2); s2 += __shfl_xor(s2, 4); s2 += __shfl_xor(s2, 8);
      const float rstd = rsqrtf(s2 * (1.f / 64.f) + GN_EPS);
      Y[i * 68 + l16] = d0 * rstd * lw[0] + lb[0];
      Y[i * 68 + 16 + l16] = d1 * rstd * lw[1] + lb[1];
      Y[i * 68 + 32 + l16] = d2 * rstd * lw[2] + lb[2];
      Y[i * 68 + 48 + l16] = d3 * rstd * lw[3] + lb[3];
    }
  }
  asm volatile("s_waitcnt lgkmcnt(0)" ::: "memory");
  __builtin_amdgcn_wave_barrier();
#pragma unroll
  for (int ps = 0; ps < 8; ++ps) {
    const int i = 8 * ps + (lane >> 3);
    int R; bool valid;
    if (prompt) { const int pp = 64 * c - 48 + i; valid = pp >= 0; R = st * PT + (valid ? pp : 0); }
    else { R = NPR + 64 * st + i; valid = true; }
    if (valid) {
      const float4 y0 = *(const float4*)(Y + i * 68 + vc), y1 = *(const float4*)(Y + i * 68 + vc + 4);
      const float rkbv = rkv[ps];
      const uint4 vv = vvv[ps];
      const uint4 gc = gcv[ps];
      uint4 o;
      o.x = pk2((y0.x + rkbv * bflo(vv.x)) * silu_(bflo(gc.x)), (y0.y + rkbv * bfhi(vv.x)) * silu_(bfhi(gc.x)));
      o.y = pk2((y0.z + rkbv * bflo(vv.y)) * silu_(bflo(gc.y)), (y0.w + rkbv * bfhi(vv.y)) * silu_(bfhi(gc.y)));
      o.z = pk2((y1.x + rkbv * bflo(vv.z)) * silu_(bflo(gc.z)), (y1.y + rkbv * bfhi(vv.z)) * silu_(bfhi(gc.z)));
      o.w = pk2((y1.z + rkbv * bflo(vv.w)) * silu_(bflo(gc.w)), (y1.w + rkbv * bfhi(vv.w)) * silu_(bfhi(gc.w)));
      *(uint4*)(mix + (size_t)R * D + 768 + hd * 64 + vc) = o;
    }
  }
  asm volatile("s_waitcnt lgkmcnt(0)" ::: "memory");
  __builtin_amdgcn_wave_barrier();
}

DEV void final_norm(const Prm& p) {
  int tid_ = threadIdx.x; LAUNDER(tid_);
  const int lane = tid_ & 63, gw = blockIdx.x * 4 + (tid_ >> 6), NW = gridDim.x * 4;
  for (int R = gw; R < NT; R += NW) {
    if (R < NPR && (R % PT) < 16) continue;
    float* yr = xrow_ptr(p, R);
    const bf16_t* xr = p.xb + (size_t)R * D;
    const float rstd = rsqrtf(p.ssq_x[2 * NTP + R] * (1.f / 1024.f) + RMS_EPS);
#pragma unroll
    for (int j = 0; j < 2; ++j) {
      const uint4 u = ((const uint4*)xr)[lane + 64 * j];
      const float4 g0 = ((const float4*)p.final_g)[2 * (lane + 64 * j)], g1 = ((const float4*)p.final_g)[2 * (lane + 64 * j) + 1];
      float4 o0, o1;
      o0.x = bflo(u.x) * rstd * g0.x; o0.y = bfhi(u.x) * rstd * g0.y; o0.z = bflo(u.y) * rstd * g0.z; o0.w = bfhi(u.y) * rstd * g0.w;
      o1.x = bflo(u.z) * rstd * g1.x; o1.y = bfhi(u.z) * rstd * g1.y; o1.z = bflo(u.w) * rstd * g1.z; o1.w = bfhi(u.w) * rstd * g1.w;
      ((float4*)yr)[2 * (lane + 64 * j)] = o0; ((float4*)yr)[2 * (lane + 64 * j) + 1] = o1;
    }
  }
}

#define XB_TMO      128
#define XB_XCNT(j)  (256  + 64 * (j))
#define XB_XSUB(j)  (1280 + 64 * (j))
#define XB_XGEN(j)  (2304 + 64 * (j))
#define XB_TOP      3328
#define XB_TOPGEN   3392
#define XCD_BAR_WORDS 3456
#define XB_SPIN_CAP (1u << 20)
#define LAS __attribute__((address_space(3)))
DEV unsigned xb_ld(unsigned* p) { return __hip_atomic_load(p, __ATOMIC_RELAXED, __HIP_MEMORY_SCOPE_AGENT); }
DEV unsigned xb_add(unsigned* p, unsigned v) { return __hip_atomic_fetch_add(p, v, __ATOMIC_RELAXED, __HIP_MEMORY_SCOPE_AGENT); }
DEV unsigned xb_xcc_id() { return (unsigned)__builtin_amdgcn_s_getreg((3 << 11) | 20) & 0xFu; }
#define XB_SPIN(cond, bar) do { unsigned _sp = 0; while (cond) { __builtin_amdgcn_s_sleep(1); \
    if ((++_sp & 255u) == 0u) { if (xb_ld(&(bar)[XB_TMO])) break; if (_sp > XB_SPIN_CAP) { atomicAdd(&(bar)[XB_TMO], 1u); break; } } } } while (0)
struct XcdBarrier { unsigned* bar; unsigned x; volatile LAS unsigned* st; };
DEV XcdBarrier xcd_barrier_post(unsigned* bar, volatile LAS unsigned* st) {
  XcdBarrier b; b.bar = bar; b.x = xb_xcc_id(); b.st = st;
  if (threadIdx.x == 0) (void)xb_add(&bar[XB_XCNT(b.x)], 1u);
  return b;
}
DEV void xcd_barrier_complete(unsigned* bar, unsigned x, unsigned& nloc, unsigned& nx) {
  const unsigned G = gridDim.x * gridDim.y * gridDim.z;
  unsigned sum, cnt, mine, sp = 0u;
  for (;;) {
    sum = 0u; cnt = 0u; mine = 0u;
#pragma unroll
    for (unsigned j = 0; j < 16; ++j) { const unsigned c = xb_ld(&bar[XB_XCNT(j)]); sum += c; cnt += (c > 0u) ? 1u : 0u; mine = (j == x) ? c : mine; }
    if (sum == G) break;
    __builtin_amdgcn_s_sleep(1);
    if ((++sp & 255u) == 0u) { if (xb_ld(&bar[XB_TMO])) break; if (sp > XB_SPIN_CAP) { atomicAdd(&bar[XB_TMO], 1u); break; } }
  }
  nloc = mine > 0u ? mine : 1u; nx = cnt > 0u ? cnt : 1u;
}
DEV void xcd_barrier(const XcdBarrier& b) {
  asm volatile("s_waitcnt vmcnt(0)" ::: "memory");
  __syncthreads();
  if (threadIdx.x == 0) {
    unsigned* bar = b.bar;
    __builtin_amdgcn_s_waitcnt(0);
    unsigned nloc = b.st[0], nx = b.st[1];
    if (nloc == 0u) { xcd_barrier_complete(bar, b.x, nloc, nx); b.st[0] = nloc; b.st[1] = nx; }
    const unsigned old = xb_add(&bar[XB_XSUB(b.x)], 1u);
    const unsigned gen = old / nloc;
    if (old + 1u == (gen + 1u) * nloc) {
      __builtin_amdgcn_fence(__ATOMIC_RELEASE, "agent");
      asm volatile("s_waitcnt vmcnt(0)" ::: "memory");
      const unsigned og = xb_add(&bar[XB_TOP], 1u);
      const unsigned tg = og / nx;
      if (og + 1u == (tg + 1u) * nx) xb_add(&bar[XB_TOPGEN], 1u);
      else XB_SPIN(xb_ld(&bar[XB_TOPGEN]) == tg, bar);
      __builtin_amdgcn_fence(__ATOMIC_ACQUIRE, "agent");
      xb_add(&bar[XB_XGEN(b.x)], 1u);
      asm volatile("s_waitcnt vmcnt(0)" ::: "memory");
    } else {
      XB_SPIN(xb_ld(&bar[XB_XGEN(b.x)]) == gen, bar);
      __builtin_amdgcn_fence(__ATOMIC_ACQUIRE, "agent");
      asm volatile("s_waitcnt vmcnt(0)" ::: "memory");
    }
  }
  __syncthreads();
}

#define QCTR(ph, L) (3584 + 64 * (2 * (ph) + (L)))
#define R2DONE(L) (3520 + 16 * (L))
DEV int next_item(unsigned* ctr, char* lds) {
  volatile int* slot = (volatile int*)(lds + LDS_BYTES - 8);
  __syncthreads();
  if (threadIdx.x == 0) *slot = (int)atomicAdd(ctr, 1u);
  __syncthreads();
  return *slot;
}
#define QXC(ph, L, x) (4096 + (((ph) * 2 + (L)) * 8 + (x)) * 16)
DEV int xq_next(unsigned* ctl, int ph, int L, int C, int N, int& k, int home, char* lds) {
  volatile int* slot = (volatile int*)(lds + LDS_BYTES - 8);
  __syncthreads();
  if (threadIdx.x == 0) {
    int res = -1, kk = k;
    while (kk < 8) {
      const int x = (home + kk) & 7, base = x * C;
      int size = N - base; size = size < C ? size : C;
      if (size > 0) { const int idx = (int)atomicAdd(ctl + QXC(ph, L, x), 1u); if (idx < size) { res = base + idx; break; } }
      ++kk;
    }
    slot[0] = res; slot[1] = kk;
  }
  __syncthreads();
  k = slot[1];
  return slot[0];
}
DEV int q_publish(int ticket, char* lds) {
  volatile int* slot = (volatile int*)(lds + LDS_BYTES - 8);
  __syncthreads();
  if (threadIdx.x == 0) *slot = ticket;
  __syncthreads();
  return *slot;
}
DEV int xq_resolve(unsigned* ctl, int ph, int L, int C, int N, int& k, int home, int ticket, char* lds) {
  volatile int* slot = (volatile int*)(lds + LDS_BYTES - 8);
  __syncthreads();
  if (threadIdx.x == 0) {
    int res = -1, kk = k;
    if (kk < 8) {
      const int x = (home + kk) & 7, base = x * C;
      int size = N - base; size = size < C ? size : C;
      if (ticket < size) res = base + ticket;
      else {
        ++kk;
        while (kk < 8) {
          const int x2 = (home + kk) & 7, base2 = x2 * C;
          int size2 = N - base2; size2 = size2 < C ? size2 : C;
          if (size2 > 0) { const int idx = (int)atomicAdd(ctl + QXC(ph, L, x2), 1u); if (idx < size2) { res = base2 + idx; break; } }
          ++kk;
        }
      }
    }
    slot[0] = res; slot[1] = kk;
  }
  __syncthreads();
  k = slot[1];
  return slot[0];
}
DEV unsigned* xq_ctr(unsigned* ctl, int ph, int L, int k, int home) { return k < 8 ? ctl + QXC(ph, L, (home + k) & 7) : nullptr; }
DEV int take_ticket(unsigned* nctr) { int tk = 0x7fffffff; if (nctr && threadIdx.x == 0) tk = (int)atomicAdd(nctr, 1u); return tk; }
struct XQueue {
  unsigned* ctl; int ph, L, C, N, k, home, t;
  DEV void prefetch() { t = take_ticket(xq_ctr(ctl, ph, L, k, home)); }
  DEV int resolve(char* lds) { return xq_resolve(ctl, ph, L, C, N, k, home, t, lds); }
};
template <class Epi, class Map>
DEV void gemm_stream(const bf16_t* __restrict__ A, int lda, const bf16_t* __restrict__ Bt, int ldb, int K, char* lds, const Epi& epi, XQueue& q) {
  int tid = threadIdx.x; LAUNDER(tid);
  const int lane = tid & 63, w = __builtin_amdgcn_readfirstlane(tid >> 6), wr = w >> 1, wc = w & 1;
  const int fr = lane & 15, fq = lane >> 4;
  const int sb = lane * 16, swz = sb ^ (((sb >> 9) & 1) << 5), rl = swz >> 6, cl = (swz & 63) >> 1;
  const int nk = K / 64;
  int offA[2], offB[2];
#pragma unroll
  for (int kh = 0; kh < 2; ++kh) { offA[kh] = lds_byte(wr * 64 + fr, kh * 32 + fq * 8); offB[kh] = lds_byte(wc * 64 + fr, kh * 32 + fq * 8); }
  q.prefetch();
  int item = q.resolve(lds);
  if (item < 0) return;
  int m0, n0; Map::map(item, m0, n0);
  const bf16_t* ga[4]; const bf16_t* gb[4];
#define SETPTR(M0, N0) { _Pragma("unroll") for (int i = 0; i < 4; ++i) { const int st = 4 * w + i, r = (st >> 1) * 16 + rl, c = (st & 1) * 32 + cl; \
      ga[i] = A + (size_t)((M0) + r) * lda + c; gb[i] = Bt + (size_t)((N0) + r) * ldb + c; } }
#define GSTAGE(S, KT) { _Pragma("unroll") for (int i = 0; i < 4; ++i) { \
      __builtin_amdgcn_global_load_lds((const unsigned*)(ga[i] + (KT) * 64), (LAS3 unsigned*)(lds + (S) * 32768 + (4 * w + i) * 1024 + lane * 16), 16, 0, 0); \
      __builtin_amdgcn_global_load_lds((const unsigned*)(gb[i] + (KT) * 64), (LAS3 unsigned*)(lds + (S) * 32768 + 16384 + (4 * w + i) * 1024 + lane * 16), 16, 0, 0); } }
  SETPTR(m0, n0)
  GSTAGE(0, 0)
  GSTAGE(1, 1)
  for (;;) {
    f32x4 acc[4][4];
#pragma unroll
    for (int i = 0; i < 4; ++i)
#pragma unroll
      for (int j = 0; j < 4; ++j) acc[i][j] = (f32x4){0.f, 0.f, 0.f, 0.f};
    for (int kt = 0; kt < nk; ++kt) {
      const int s = kt & 1;
      if (kt + 1 < nk) asm volatile("s_waitcnt vmcnt(8)" ::: "memory"); else asm volatile("s_waitcnt vmcnt(0)" ::: "memory");
      RAW_BARRIER()
      const char* ia = lds + s * 32768;
      const char* ib = ia + 16384;
      bf16x8 af[2][4], bfv[2][4];
#pragma unroll
      for (int kh = 0; kh < 2; ++kh) {
#pragma unroll
        for (int mi = 0; mi < 4; ++mi) af[kh][mi] = *(const bf16x8*)(ia + offA[kh] + mi * 2048);
#pragma unroll
        for (int ni = 0; ni < 4; ++ni) bfv[kh][ni] = *(const bf16x8*)(ib + offB[kh] + ni * 2048);
      }
      asm volatile("s_waitcnt lgkmcnt(8)" ::: "memory");
      __builtin_amdgcn_sched_barrier(0);
#pragma unroll
      for (int mi = 0; mi < 4; ++mi)
#pragma unroll
        for (int ni = 0; ni < 4; ++ni) acc[mi][ni] = mfma16(bfv[0][ni], af[0][mi], acc[mi][ni]);
      __builtin_amdgcn_sched_barrier(0);
      asm volatile("s_waitcnt lgkmcnt(0)" ::: "memory");
      RAW_BARRIER()
      if (kt + 2 < nk) GSTAGE(s, kt + 2)
      if (kt == nk - 3) q.prefetch();
      __builtin_amdgcn_sched_barrier(0);
#pragma unroll
      for (int mi = 0; mi < 4; ++mi)
#pragma unroll
        for (int ni = 0; ni < 4; ++ni) acc[mi][ni] = mfma16(bfv[1][ni], af[1][mi], acc[mi][ni]);
    }
    const int nxt = q.resolve(lds);
    const typename Epi::Pre pre = epi.preload(m0 + wr * 64, n0 + wc * 64, fr, fq);
    __builtin_amdgcn_sched_barrier(0);
    int m1 = 0, n1 = 0;
    if (nxt >= 0) { Map::map(nxt, m1, n1); SETPTR(m1, n1) GSTAGE(0, 0) GSTAGE(1, 1) }
    __builtin_amdgcn_sched_barrier(0);
    epi.finish(acc, pre, m0 + wr * 64, n0 + wc * 64, fr, fq);
    if (nxt < 0) break;
    m0 = m1; n0 = n1;
  }
#undef GSTAGE
#undef SETPTR
}
struct MapP1 { static DEV void map(int i, int& m0, int& n0) { int mt, nt; if (i < 18 * 192) { const int b = i / 192, r = i - b * 192; nt = r >> 3; mt = 8 * b + (r & 7); } else { nt = i - 18 * 192; mt = 144; } m0 = mt * 128; n0 = nt * 128; } };
struct MapP4 { static DEV void map(int i, int& m0, int& n0) { m0 = (i >> 3) * 128; n0 = (i & 7) * 128; } };
DEV void shift_rows_item(const Prm& p, int L, int b) {
  int tid0 = threadIdx.x; LAUNDER(tid0);
  if (tid0 < 224) {
    float4 v = make_float4(0.f, 0.f, 0.f, 0.f);
    if (b < 32) v = *(const float4*)(p.state_shift + ((size_t)L * 32 + b) * 896 + 4 * tid0);
    *(uint2*)(p.zE + (size_t)(NT + b) * ZE + ZE_ZC + 4 * tid0) = pk4(v.x, v.y, v.z, v.w);
  }
}
constexpr int N_ATT = 1312;
DEV void run_p1(const Prm& p, int L, char* lds) {
  const EpiIn epi{p, L};
  const int home = (int)(xb_xcc_id() & 7u);
  constexpr int N = 145 * 24, C = (N + 7) / 8;
  {
    XQueue q{p.ctl, 0, L, C, N, 0, home, 0};
    gemm_stream<EpiIn, MapP1>(p.xb, D, p.Wb_in + (size_t)L * INP * 1024, 1024, 1024, lds, epi, q);
  }
  unsigned* ctr = p.ctl + QCTR(3, L);
  int t = take_ticket(ctr);
  for (;;) {
    const int mt = q_publish(t, lds);
    if (mt >= 145 + 33) break;
    if (mt >= 145) { t = take_ticket(ctr); shift_rows_item(p, L, mt - 145); continue; }
    t = gemm_tile<EpiIn, 2>(p.xb, D, p.Wb_in + (size_t)L * INP * 1024, 1024, 1024, mt * 128, 24 * 128, lds, epi, ctr);
  }
}
DEV void run_p2(const Prm& p, int L, char* lds) {
  const EpiQ epq{p, L};
  constexpr int N1 = NRW, N2 = N1 + 129, N3 = N2 + 145 * 6, N4 = N3 + 16, N4b = N4 + 512, N5 = N4b + 36;
  const int N6 = L == 0 ? N5 + NWT : N5;
  unsigned* ctr = p.ctl + QCTR(0, L);
  for (;;) {
    const int id = next_item(ctr, lds);
    if (id >= N6) break;
    if (id >= N5) { conv_weights_item(p, 1, id - N5, lds); continue; }
    if (id < N1) r1_item(p, L, id, lds);
    else if (id < N2) kvproj_item(p, L, id - N1, lds);
    else if (id < N3) { const int t = id - N2, mt = t / 6, nt = t - mt * 6; gemm_tile(p.zE + ZE_CQ, ZE, p.Wb_uq + (size_t)L * 768 * 256, 256, 256, mt * 128, nt * 128, lds, epq); }
    else if (id < N4) sample_prep_item(p, L, id - N3);
    else if (id < N4b) lat_item(p, L, id - N4);
    else shift_item(p, L, id - N4b);
  }
}
DEV void run_p3(const Prm& p, int L, char* lds) {
  int tid_ = threadIdx.x; LAUNDER(tid_);
  const int lane = tid_ & 63, w = __builtin_amdgcn_readfirstlane(tid_ >> 6);
  {
    int ndone = 0;
    for (int wi = blockIdx.x * 4 + w; wi < 576; wi += gridDim.x * 4) { r2_wave(p, L, wi, lane); ++ndone; }
    if (blockIdx.x * 4 < 576) {
      asm volatile("s_waitcnt vmcnt(0)" ::: "memory");
      __syncthreads();
      if (threadIdx.x == 0) {
        int tot = 0;
        for (int wi = blockIdx.x * 4; wi < 576; wi += gridDim.x * 4) tot += (576 - wi) < 4 ? (576 - wi) : 4;
        __builtin_amdgcn_fence(__ATOMIC_RELEASE, "agent");
        asm volatile("s_waitcnt vmcnt(0)" ::: "memory");
        __hip_atomic_fetch_add(p.ctl + R2DONE(L), (unsigned)tot, __ATOMIC_RELAXED, __HIP_MEMORY_SCOPE_AGENT);
      }
    }
    (void)ndone;
  }
  unsigned* ctr = p.ctl + QCTR(1, L);
  for (;;) {
    const int q = next_item(ctr, lds);
    if (q >= 128) break;
    attn_sample(p, L, q >> 2, q & 3, lds);
  }
  {
    const int home = (int)(xb_xcc_id() & 7u);
    int k = 0;
    int tx = take_ticket(xq_ctr(p.ctl, 2, L, k, home));
    for (;;) {
      const int i = xq_resolve(p.ctl, 2, L, 128, 1024, k, home, tx, lds);
      if (i < 0) break;
      const int x = i >> 7, j = i & 127, qt = 31 - (j >> 2), pair = 4 * x + (j & 3);
      tx = attn_body<false>(p, L, pair >> 3, pair & 7, qt, lds, xq_ctr(p.ctl, 2, L, k, home));
    }
  }
  unsigned* ctr2 = p.ctl + QCTR(2, L);
  constexpr int NC = (NT + 31) / 32, NQ2 = 32 + NC + NRW / 4;
  bool r2_seen = false;
  for (;;) {
    const int q = next_item(ctr2, lds);
    if (q >= NQ2) break;
    constexpr int NR3 = NRW / 4;
    if (q >= NR3 + 32) conv_item(p, L, q - NR3 - 32);
    else if (q >= NR3) attn_item(p, L, 1280 + q - NR3, lds);
    else {
      if (!r2_seen) {
        if (threadIdx.x == 0) {
          unsigned sp = 0;
          while (__hip_atomic_load(p.ctl + R2DONE(L), __ATOMIC_RELAXED, __HIP_MEMORY_SCOPE_AGENT) < 576u) {
            __builtin_amdgcn_s_sleep(2);
            if (++sp > (1u << 22)) { atomicAdd(&p.ctl[XB_TMO], 1u); break; }
          }
          __builtin_amdgcn_fence(__ATOMIC_ACQUIRE, "agent");
          asm volatile("s_waitcnt vmcnt(0)" ::: "memory");
        }
        __syncthreads();
        r2_seen = true;
      }
      r3_wave(p, L, q * 4 + w, lane, (float*)(lds + w * 17408));
    }
  }
}
DEV void run_p4(const Prm& p, int L, char* lds) {
  const EpiOut epo{p, L};
  const int home = (int)(xb_xcc_id() & 7u);
  {
    XQueue q{p.ctl, 1, L, 128, 1024, 0, home, 0};
    gemm_stream<EpiOut, MapP4>(p.zE  , D, p.Wb_out + (size_t)L * 1024 * 1024, 1024, 1024, lds, epo, q);
  }
  unsigned* ctr = p.ctl + QCTR(3, L) + 16;
  int t = take_ticket(ctr);
  for (;;) {
    const int h = q_publish(t, lds);
    if (h >= 17 * 16) break;
    const int mt = 128 + (h >> 4), r = h & 15;
    t = gemm_tile<EpiOut, 4>(p.zE, D, p.Wb_out + (size_t)L * 1024 * 1024, 1024, 1024, mt * 128, (r >> 1) * 128 + (r & 1) * 64, lds, epo, ctr);
  }
}

__global__ void __launch_bounds__(256, 2) mega(Prm p) {
  extern __shared__ __attribute__((aligned(16))) char lds[];
  volatile LAS unsigned* st = (volatile LAS unsigned*)(lds + LDS_BYTES - 16);
  if (threadIdx.x == 0) { st[0] = 0u; st[1] = 0u; st[2] = 0u; st[3] = 0u; }
  __syncthreads();
  const XcdBarrier xb = xcd_barrier_post(p.ctl, st);
  phase0(p, lds);
  xcd_barrier(xb);
  for (int L = 0; L < 2; ++L) {
    run_p1(p, L, lds); xcd_barrier(xb);
    run_p2(p, L, lds); xcd_barrier(xb);
    run_p3(p, L, lds); xcd_barrier(xb);
    run_p4(p, L, lds); xcd_barrier(xb);
  }
  final_norm(p);
}

static size_t al256(size_t x) { return (x + 255) & ~(size_t)255; }
extern "C" void kernel_launch(void* const* d_in, const int* in_sizes, int n_in, void* d_out, int out_size, void* d_ws, size_t ws_size, hipStream_t stream) {
  Prm p{};
  const float* const* in = (const float* const*)d_in;
  p.x_prompt = in[0]; p.x_sample = in[1]; p.cache_ckv = in[2]; p.cache_krope = in[3]; p.state_conv = in[4]; p.state_shift = in[5]; p.state_wkv = in[6];
  p.meta = in[7]; p.norm_g = in[8]; p.w_in = in[9]; p.conv_w = in[10]; p.q_norm_g = in[11]; p.w_uq = in[12]; p.kv_norm_g = in[13]; p.w_ukv = in[14];
  p.shift_mu = in[15]; p.decay_w0 = in[16]; p.decay_w2 = in[17]; p.iclr_a0 = in[18]; p.iclr_a2 = in[19]; p.key_kk = in[20]; p.key_ka = in[21];
  p.bonus_rk = in[22]; p.lnx_w = in[23]; p.lnx_b = in[24]; p.w_out = in[25]; p.final_g = in[26];
  float* o = (float*)d_out;
  p.y_prompt = o; o += (size_t)4 * 4096 * 1024;
  p.y_sample = o; o += (size_t)32 * 64 * 1024;
  p.ckv_p = o; o += (size_t)2 * 4 * PT * 128;
  p.kr_p = o; o += (size_t)2 * 4 * PT * 32;
  p.conv_p = o; o += 2 * 4 * 2 * 256;
  p.shift_p = o; o += 2 * 4 * 896;
  p.wkv_p = o; o += 2 * 4 * 4 * 64 * 64;
  p.ckv_s = o; o += (size_t)2 * 32 * 64 * 128;
  p.kr_s = o; o += 2 * 32 * 64 * 32;
  p.conv_s = o; o += 2 * 32 * 2 * 256;
  p.shift_s = o; o += 2 * 32 * 896;
  p.wkv_s = o; o += 2 * 32 * 4 * 64 * 64;
  char* w = (char*)d_ws; size_t off = 0;
  auto take = [&](size_t bytes) { char* r = w + off; off = al256(off + bytes); return r; };
  p.ctl = (unsigned*)take(65536);
  p.Wb_in = (bf16_t*)take((size_t)2 * INP * 1024 * 2);
  p.Wb_uq = (bf16_t*)take((size_t)2 * 768 * 256 * 2);
  p.Wb_ukv = (bf16_t*)take((size_t)2 * 1024 * 128 * 2);
  p.Wb_out = (bf16_t*)take((size_t)2 * 1024 * 1024 * 2);
  p.dw2T = (bf16_t*)take((size_t)2 * 256 * 64 * 2);
  p.ia2T = (bf16_t*)take((size_t)2 * 256 * 64 * 2);
  p.ropec = (float*)take((size_t)PT * 16 * 4);
  p.ropes = (float*)take((size_t)PT * 16 * 4);
  p.ssq_x = (float*)take((size_t)7 * NTP * 4);
  p.ssq_q = p.ssq_x + 3 * NTP; p.ssq_kv = p.ssq_x + 5 * NTP;
  p.rkb = (float*)take((size_t)NTP * 4 * 4);
  p.xmeta = (float*)take((size_t)64 * 1024 * 4);
  p.zE = (bf16_t*)take((size_t)NTP * ZE * 2);
  p.zL = (bf16_t*)take((size_t)NTP * ZL * 2);
  p.xb = (bf16_t*)take((size_t)(NTP + 128) * D * 2);
  p.Kn = (bf16_t*)take((size_t)KVR * 512 * 2);
  p.Vt = (bf16_t*)take((size_t)512 * KVR * 2);
  p.Kr = (bf16_t*)take((size_t)KVR * 32 * 2);
  p.rw = take((size_t)NRW * RW_BYTES);
  p.KL = (bf16_t*)((char*)p.y_prompt + ((size_t)32 << 20));
  p.VLT = p.KL + (size_t)32 * SKEYS * 160;
  static int grid = 0;
  if (grid == 0) {
    if (off > ws_size) { fprintf(stderr, "kernel_launch: workspace too small: need %zu have %zu\n", off, ws_size); grid = -1; return; }
    int dev = 0, cus = 0, per_cu = 0;
    (void)hipGetDevice(&dev);
    (void)hipDeviceGetAttribute(&cus, hipDeviceAttributeMultiprocessorCount, dev);
    (void)hipFuncSetAttribute((const void*)mega, hipFuncAttributeMaxDynamicSharedMemorySize, LDS_BYTES);
    (void)hipOccupancyMaxActiveBlocksPerMultiprocessor(&per_cu, (const void*)mega, 256, LDS_BYTES);
    if (per_cu > 2) per_cu = 2;
    if (per_cu < 1) { fprintf(stderr, "kernel_launch: occupancy query returned %d\n", per_cu); per_cu = 1; }
    grid = cus * per_cu;
  }
  if (grid < 0) return;
  (void)hipMemsetAsync(p.ctl, 0, 8192 * 4, stream);
  void* args[] = {&p};
  hipError_t e = hipLaunchCooperativeKernel((const void*)mega, dim3(grid), dim3(256), args, LDS_BYTES, stream);
  if (e != hipSuccess) fprintf(stderr, "cooperative launch failed: %s (grid %d)\n", hipGetErrorString(e), grid);
}
```

```cpp
#include <hip/hip_runtime.h>
#include <cstdio>
#include <cstdint>
#include <type_traits>

typedef unsigned short bf16_t;
typedef short bf16x8 __attribute__((ext_vector_type(8)));
typedef float f32x4 __attribute__((ext_vector_type(4)));
typedef float f32x16 __attribute__((ext_vector_type(16)));
#define DEV __device__ __forceinline__
#define LAUNDER(x) asm volatile("" : "+v"(x))

constexpr int D = 1024;
constexpr int PT = 4112;
constexpr int NPR = 4 * PT;
constexpr int NSM = 32 * 64;
constexpr int NT = NPR + NSM;
constexpr int NTP = 18560;
constexpr int ZL = 1792;
constexpr int ZE = 1312;
constexpr int ZE_CQ = 0, ZE_CKV = 256, ZE_KR = 384, ZE_ZC = 416;
constexpr int ZL_XIN = 0, ZL_BG = 256, ZL_CG = 512, ZL_GA = 768, ZL_GB = 1024, ZL_GC = 1536;
constexpr int INP = 3200;
constexpr int KVR = 16512;
constexpr int NRW_P = 4 * 65 * 4;
constexpr int NRW = NRW_P + 32 * 4;
constexpr int RW_BYTES = 49152;
constexpr float RMS_EPS = 1e-6f;
constexpr float GN_EPS = 64e-5f;
constexpr int LDS_BYTES = 79872;
constexpr int SKEYS = 1088;

struct Prm {
  const float *x_prompt, *x_sample, *cache_ckv, *cache_krope, *state_conv, *state_shift, *state_wkv, *meta, *norm_g, *w_in,
      *conv_w, *q_norm_g, *w_uq, *kv_norm_g, *w_ukv, *shift_mu, *decay_w0, *decay_w2, *iclr_a0, *iclr_a2, *key_kk, *key_ka,
      *bonus_rk, *lnx_w, *lnx_b, *w_out, *final_g;
  float *y_prompt, *y_sample, *ckv_p, *kr_p, *conv_p, *shift_p, *wkv_p, *ckv_s, *kr_s, *conv_s, *shift_s, *wkv_s;
  unsigned* ctl;
  bf16_t *Wb_in, *Wb_uq, *Wb_ukv, *Wb_out, *dw2T, *ia2T;
  float *ropec, *ropes, *ssq_x, *ssq_q, *ssq_kv, *rkb, *xmeta;
  bf16_t *KL, *VLT;
  bf16_t *zE, *zL, *xb, *Kn, *Vt, *Kr;
  char* rw;
};

DEV float bf2f(bf16_t b) { return __uint_as_float((unsigned)b << 16); }
DEV float bflo(unsigned u) { return __uint_as_float(u << 16); }
DEV float bfhi(unsigned u) { return __uint_as_float(u & 0xffff0000u); }
typedef __bf16 hbf16x2_t __attribute__((ext_vector_type(2)));
typedef float hf32x2_t __attribute__((ext_vector_type(2)));
DEV unsigned pk2(float a, float b) { hf32x2_t f = {a, b}; hbf16x2_t r = __builtin_convertvector(f, hbf16x2_t); return __builtin_bit_cast(unsigned, r); }
DEV bf16_t f2bf(float f) { return (bf16_t)(pk2(f, 0.f) & 0xffffu); }
DEV uint2 pk4(float a, float b, float c, float d) { uint2 r; r.x = pk2(a, b); r.y = pk2(c, d); return r; }
DEV float sigmoid_(float x) { return 1.f / (1.f + __expf(-x)); }
DEV float silu_(float x) { return x / (1.f + __expf(-x)); }
DEV float wave_sum(float v) {
#pragma unroll
  for (int o = 1; o < 64; o <<= 1) v += __shfl_xor(v, o);
  return v;
}
DEV f32x16 mfma32(bf16x8 a, bf16x8 b, f32x16 c) { return __builtin_amdgcn_mfma_f32_32x32x16_bf16(a, b, c, 0, 0, 0); }
DEV f32x4 mfma16(bf16x8 a, bf16x8 b, f32x4 c) { return __builtin_amdgcn_mfma_f32_16x16x32_bf16(a, b, c, 0, 0, 0); }
DEV bf16x8 mk8(unsigned a, unsigned b, unsigned c, unsigned d) { uint4 u; u.x = a; u.y = b; u.z = c; u.w = d; return __builtin_bit_cast(bf16x8, u); }
DEV bf16x8 mk8(uint4 u) { return __builtin_bit_cast(bf16x8, u); }
DEV f32x16 zero16() { f32x16 z; for (int i = 0; i < 16; ++i) z[i] = 0.f; return z; }

DEV float* xrow_ptr(const Prm& p, int R) {
  if (R < NPR) { int s = R / PT, q = R - s * PT; return q < 16 ? p.xmeta + (size_t)(s * 16 + q) * D : p.y_prompt + ((size_t)s * 4096 + (q - 16)) * D; }
  return p.y_sample + (size_t)(R - NPR) * D;
}
DEV const float* xin_ptr(const Prm& p, int R) {
  if (R < NPR) { int s = R / PT, q = R - s * PT; return q < 16 ? p.meta + (size_t)q * D : p.x_prompt + ((size_t)s * 4096 + (q - 16)) * D; }
  return p.x_sample + (size_t)(R - NPR) * D;
}
DEV int pos_of(int R) { return R < NPR ? R % PT : 1024 + ((R - NPR) & 63); }

DEV int win_src_col(int n) {
  if (n < 1024) return n;
  if (n < 1536) return 1440 + (n - 1024);
  if (n < 1792) return 2848 + (n - 1536);
  if (n < 2208) return 1024 + (n - 1792);
  if (n < 3104) return 1952 + (n - 2208);
  return -1;
}
DEV int perm32(int rho) { const int n = rho >> 4, i = rho & 15; return 8 * (i >> 2) + 4 * n + (i & 3); }
template <bool PERM, bool P32>
DEV void conv_weight_tile(const float* __restrict__ src, int K, int N, int Npad, bf16_t* __restrict__ dst, const float* __restrict__ sk, float cst, int l, int item, float* T  , int tid) {
  const int ntn = Npad / 64, ntk = K / 64;
  const int r = item, kt = r / ntn, nt = r - kt * ntn;
  const int k0 = kt * 64, n0 = nt * 64;
  {
    const int nslot = n0 + (tid & 15) * 4;
    const int nn = P32 ? (nslot & ~31) + perm32(nslot & 31) : nslot;
    const int sn = PERM ? win_src_col(nn) : (nn < N ? nn : -1);
#pragma unroll
    for (int i = 0; i < 4; ++i) {
      const int k = (tid >> 4) + 16 * i;
      float4 v = make_float4(0.f, 0.f, 0.f, 0.f);
      if (sn >= 0) {
        v = *(const float4*)(src + ((size_t)l * K + k0 + k) * N + sn);
        const float s = (sk ? sk[l * K + k0 + k] : 1.f) * cst;
        v.x *= s; v.y *= s; v.z *= s; v.w *= s;
      }
      float* t = T + k * 65 + (tid & 15) * 4;
      t[0] = v.x; t[1] = v.y; t[2] = v.z; t[3] = v.w;
    }
  }
  __syncthreads();
  {
    const int n = tid >> 2, kc = tid & 3;
    float v[16];
#pragma unroll
    for (int j = 0; j < 16; ++j) v[j] = T[(16 * kc + j) * 65 + n];
    uint4 o0, o1;
    o0.x = pk2(v[0], v[1]); o0.y = pk2(v[2], v[3]); o0.z = pk2(v[4], v[5]); o0.w = pk2(v[6], v[7]);
    o1.x = pk2(v[8], v[9]); o1.y = pk2(v[10], v[11]); o1.z = pk2(v[12], v[13]); o1.w = pk2(v[14], v[15]);
    bf16_t* d = dst + ((size_t)l * Npad + n0 + n) * K + k0 + 16 * kc;
    *(uint4*)d = o0; *(uint4*)(d + 8) = o1;
  }
  __syncthreads();
}
constexpr int WT0 = 16 * 50, WT1 = WT0 + 16 * 16, WT2 = WT1 + 4 * 12, WT3 = WT2 + 2 * 16, WT4 = WT3 + 4, NWT = WT4 + 4;
DEV void conv_weights_item(const Prm& p, int l, int it, char* lds) {
  float* T = (float*)lds;
  int tid = threadIdx.x; LAUNDER(tid);
  if (it < WT0) conv_weight_tile<true, true>(p.w_in, 1024, 3104, INP, p.Wb_in, p.norm_g, 1.f, l, it, T, tid);
  else if (it < WT1) conv_weight_tile<false, true>(p.w_out, 1024, 1024, 1024, p.Wb_out, nullptr, 1.f, l, it - WT0, T, tid);
  else if (it < WT2) conv_weight_tile<false, false>(p.w_uq, 256, 768, 768, p.Wb_uq, p.q_norm_g, 0.10206207261596575f * 1.4426950408889634f, l, it - WT1, T, tid);
  else if (it < WT3) conv_weight_tile<false, false>(p.w_ukv, 128, 1024, 1024, p.Wb_ukv, nullptr, 1.f, l, it - WT2, T, tid);
  else if (it < WT4) conv_weight_tile<false, false>(p.decay_w2, 64, 256, 256, p.dw2T, nullptr, 1.f, l, it - WT3, T, tid);
  else conv_weight_tile<false, false>(p.iclr_a2, 64, 256, 256, p.ia2T, nullptr, 1.f, l, it - WT4, T, tid);
}
DEV void phase0(const Prm& p, char* lds) {
  int tid = threadIdx.x; LAUNDER(tid);
  const int lane = tid & 63, wv = tid >> 6;
  const int gw = blockIdx.x * 4 + wv, NW = gridDim.x * 4;
  const int gt = blockIdx.x * 256 + tid, NTH = gridDim.x * 256;
  for (int R = gw; R < NT; R += NW) {
    const float* src = xin_ptr(p, R);
    float ss = 0.f;
#pragma unroll
    for (int j = 0; j < 4; ++j) {
      const float4 v = ((const float4*)src)[lane + 64 * j];
      ss += v.x * v.x + v.y * v.y + v.z * v.z + v.w * v.w;
      ((uint2*)(p.xb + (size_t)R * D))[lane + 64 * j] = pk4(v.x, v.y, v.z, v.w);
    }
    ss = wave_sum(ss);
    if (lane == 0) p.ssq_x[R] = ss;
  }
  for (int i = gt; i < 6 * NTP; i += NTH) p.ssq_x[NTP + i] = 0.f;
  for (int it = blockIdx.x; it < NWT; it += gridDim.x) conv_weights_item(p, 0, it, lds);
  for (int i = gt; i < PT * 16; i += NTH) {
    const int pos = i >> 4, j = i & 15;
    const float inv = powf(10000.f, -(float)j * 2.0f / 32.f);
    const float ang = (float)pos * inv;
    double a = (double)ang;
    a -= 6.283185307179586476925 * rint(a * 0.15915494309189533577);
    p.ropec[i] = (float)cos(a);
    p.ropes[i] = (float)sin(a);
  }
}

#define LAS3 __attribute__((address_space(3)))
#define RAW_BARRIER() { asm volatile("" ::: "memory"); __builtin_amdgcn_s_barrier(); asm volatile("" ::: "memory"); }
DEV int lds_byte(int r, int c) { const int st = (r >> 4) * 2 + (c >> 5), rr = r & 15, cc = c & 31, ob = rr * 64 + cc * 2; return st * 1024 + (ob ^ (((ob >> 9) & 1) << 5)); }
template <class Epi, int NB = 8>
DEV int gemm_tile(const bf16_t* __restrict__ A, int lda, const bf16_t* __restrict__ Bt, int ldb, int K, int m0, int n0, char* lds, const Epi& epi, unsigned* nctr = nullptr) {
  int tid = threadIdx.x; LAUNDER(tid);
  const int lane = tid & 63, w = __builtin_amdgcn_readfirstlane(tid >> 6), wr = w >> 1, wc = w & 1;
  const int fr = lane & 15, fq = lane >> 4;
  const int sb = lane * 16, swz = sb ^ (((sb >> 9) & 1) << 5), rl = swz >> 6, cl = (swz & 63) >> 1;
  const bf16_t* ga[4]; const bf16_t* gb[4];
#pragma unroll
  for (int i = 0; i < 4; ++i) {
    const int st = 4 * w + i, r = (st >> 1) * 16 + rl, c = (st & 1) * 32 + cl;
    ga[i] = A + (size_t)(m0 + r) * lda + c;
    gb[i] = Bt + (size_t)(n0 + r) * ldb + c;
  }
  const int nk = K / 64;
#define GSTAGE(S, KT) { _Pragma("unroll") for (int i = 0; i < 4; ++i) { \
      __builtin_amdgcn_global_load_lds((const unsigned*)(ga[i] + (KT) * 64), (LAS3 unsigned*)(lds + (S) * 32768 + (4 * w + i) * 1024 + lane * 16), 16, 0, 0); \
      if (2 * w + (i >> 1) < NB) __builtin_amdgcn_global_load_lds((const unsigned*)(gb[i] + (KT) * 64), (LAS3 unsigned*)(lds + (S) * 32768 + 16384 + (4 * w + i) * 1024 + lane * 16), 16, 0, 0); } }
  f32x4 acc[4][4];
#pragma unroll
  for (int i = 0; i < 4; ++i)
#pragma unroll
    for (int j = 0; j < 4; ++j) acc[i][j] = (f32x4){0.f, 0.f, 0.f, 0.f};
  int offA[2], offB[2];
#pragma unroll
  for (int kh = 0; kh < 2; ++kh) { offA[kh] = lds_byte(wr * 64 + fr, kh * 32 + fq * 8); offB[kh] = lds_byte(wc * 64 + fr, kh * 32 + fq * 8); }
  GSTAGE(0, 0)
  if (nk > 1) GSTAGE(1, 1)
  for (int kt = 0; kt < nk; ++kt) {
    const int s = kt & 1;
    if (kt + 1 < nk) { if (2 * w < NB) asm volatile("s_waitcnt vmcnt(8)" ::: "memory"); else asm volatile("s_waitcnt vmcnt(4)" ::: "memory"); }
    else asm volatile("s_waitcnt vmcnt(0)" ::: "memory");
    RAW_BARRIER()
    const char* ia = lds + s * 32768;
    const char* ib = ia + 16384;
    bf16x8 af[2][4], bfv[2][4];
#pragma unroll
    for (int kh = 0; kh < 2; ++kh) {
#pragma unroll
      for (int mi = 0; mi < 4; ++mi) af[kh][mi] = *(const bf16x8*)(ia + offA[kh] + mi * 2048);
#pragma unroll
      for (int ni = 0; ni < (NB < 4 ? NB : 4); ++ni) bfv[kh][ni] = *(const bf16x8*)(ib + offB[kh] + ni * 2048);
    }
    asm volatile("s_waitcnt lgkmcnt(%0)" :: "n"(4 + (NB < 4 ? NB : 4)) : "memory");
    __builtin_amdgcn_sched_barrier(0);
    if (NB == 8 || wc == 0) {
#pragma unroll
      for (int mi = 0; mi < 4; ++mi)
#pragma unroll
        for (int ni = 0; ni < (NB < 4 ? NB : 4); ++ni) acc[mi][ni] = mfma16(bfv[0][ni], af[0][mi], acc[mi][ni]);
    }
    __builtin_amdgcn_sched_barrier(0);
    asm volatile("s_waitcnt lgkmcnt(0)" ::: "memory");
    RAW_BARRIER()
    if (kt + 2 < nk) GSTAGE(s, kt + 2)
    __builtin_amdgcn_sched_barrier(0);
    if (NB == 8 || wc == 0) {
#pragma unroll
      for (int mi = 0; mi < 4; ++mi)
#pragma unroll
        for (int ni = 0; ni < (NB < 4 ? NB : 4); ++ni) acc[mi][ni] = mfma16(bfv[1][ni], af[1][mi], acc[mi][ni]);
    }
  }
  __syncthreads();
#undef GSTAGE
  int tk = 0x7fffffff; if (nctr && tid == 0) tk = (int)atomicAdd(nctr, 1u);
  if (NB == 8 || wc == 0) epi(acc, m0 + wr * 64, n0 + wc * 64, fr, fq);
  return tk;
}

struct EpiIn {
  const Prm& p; int L;
  struct Pre { float s[4]; };
  DEV Pre preload(int mb, int nb, int fr, int fq) const {
    Pre r;
#pragma unroll
    for (int mi = 0; mi < 4; ++mi) r.s[mi] = p.ssq_x[L * NTP + mb + 16 * mi + fr];
    return r;
  }
  DEV void operator()(f32x4 (&acc)[4][4], int mb, int nb, int fr, int fq) const { finish(acc, preload(mb, nb, fr, fq), mb, nb, fr, fq); }
  DEV void finish(f32x4 (&acc)[4][4], const Pre& pre, int mb, int nb, int fr, int fq) const {
#pragma unroll
    for (int mi = 0; mi < 4; ++mi) {
      const int m = mb + 16 * mi + fr;
      const bool ok = m < NT;
      const float rstd = rsqrtf(pre.s[mi] * (1.f / 1024.f) + RMS_EPS);
      float sq = 0.f;
#pragma unroll
      for (int g = 0; g < 2; ++g) {
        const int n0 = nb + 32 * g;
        if (n0 >= 3104) continue;
        bf16_t* dst = n0 < ZL ? p.zL + (size_t)m * ZL + n0 : p.zE + (size_t)m * ZE + (n0 - ZL);
        float v[8];
#pragma unroll
        for (int j = 0; j < 4; ++j) { v[j] = acc[mi][2 * g][j] * rstd; v[4 + j] = acc[mi][2 * g + 1][j] * rstd; }
#pragma unroll
        for (int j = 0; j < 8; ++j) sq += v[j] * v[j];
        if (ok) { uint4 o; o.x = pk2(v[0], v[1]); o.y = pk2(v[2], v[3]); o.z = pk2(v[4], v[5]); o.w = pk2(v[6], v[7]); *(uint4*)(dst + 8 * fq) = o; }
      }
      if (nb >= ZL && nb < ZL + 384) {
        sq += __shfl_xor(sq, 16); sq += __shfl_xor(sq, 32);
        if (fq == 0 && ok) atomicAdd((nb < ZL + 256 ? p.ssq_q : p.ssq_kv) + L * NTP + m, sq);
      }
    }
  }
};
struct EpiQ {
  const Prm& p; int L;
  DEV void operator()(f32x4 (&acc)[4][4], int mb, int nb, int fr, int fq) const {
    bf16_t* Qb = (bf16_t*)p.y_prompt;
#pragma unroll
    for (int mi = 0; mi < 4; ++mi) {
      const int m = mb + 16 * mi + fr;
      const bool ok = m < NT;
      const float rstd = rsqrtf(p.ssq_q[L * NTP + m] * (1.f / 256.f) + RMS_EPS);
      const int pos = pos_of(ok ? m : 0);
#pragma unroll
      for (int np = 0; np < 2; ++np) {
        const int n0 = nb + 32 * np;
        float v[2][4];
#pragma unroll
        for (int h2 = 0; h2 < 2; ++h2)
#pragma unroll
          for (int j = 0; j < 4; ++j) v[h2][j] = acc[mi][2 * np + h2][j] * rstd;
        if (((n0 >> 5) % 3) == 2) {
#pragma unroll
          for (int j = 0; j < 4; ++j) {
            const int c = 4 * fq + j;
            const float cs = p.ropec[pos * 16 + c], sn = p.ropes[pos * 16 + c];
            const float x1 = v[0][j], x2 = v[1][j];
            v[0][j] = x1 * cs - x2 * sn; v[1][j] = x1 * sn + x2 * cs;
          }
        }
        if (ok) {
          *(uint2*)(Qb + (size_t)m * 768 + n0 + 4 * fq) = pk4(v[0][0], v[0][1], v[0][2], v[0][3]);
          *(uint2*)(Qb + (size_t)m * 768 + n0 + 16 + 4 * fq) = pk4(v[1][0], v[1][1], v[1][2], v[1][3]);
        }
      }
    }
  }
};
struct EpiOut {
  const Prm& p; int L;
  struct Pre { uint4 x[4][2]; };
  DEV Pre preload(int mb, int nb, int fr, int fq) const {
    Pre r;
#pragma unroll
    for (int mi = 0; mi < 4; ++mi) {
      const int m = mb + 16 * mi + fr;
      const bf16_t* xr = p.xb + (size_t)(m < NT ? m : 0) * D;
#pragma unroll
      for (int g = 0; g < 2; ++g) r.x[mi][g] = *(const uint4*)(xr + nb + 32 * g + 8 * fq);
    }
    return r;
  }
  DEV void operator()(f32x4 (&acc)[4][4], int mb, int nb, int fr, int fq) const { finish(acc, preload(mb, nb, fr, fq), mb, nb, fr, fq); }
  DEV void finish(f32x4 (&acc)[4][4], const Pre& pre, int mb, int nb, int fr, int fq) const {
#pragma unroll
    for (int mi = 0; mi < 4; ++mi) {
      const int m = mb + 16 * mi + fr;
      const bool ok = m < NT;
      bf16_t* xr = p.xb + (size_t)(ok ? m : 0) * D;
      float ss = 0.f;
#pragma unroll
      for (int g = 0; g < 2; ++g) {
        const int col = nb + 32 * g + 8 * fq;
        const uint4 xi = pre.x[mi][g];
        float v[8] = {bflo(xi.x), bfhi(xi.x), bflo(xi.y), bfhi(xi.y), bflo(xi.z), bfhi(xi.z), bflo(xi.w), bfhi(xi.w)};
#pragma unroll
        for (int j = 0; j < 4; ++j) { v[j] += acc[mi][2 * g][j]; v[4 + j] += acc[mi][2 * g + 1][j]; }
#pragma unroll
        for (int j = 0; j < 8; ++j) ss += v[j] * v[j];
        if (ok) { uint4 o; o.x = pk2(v[0], v[1]); o.y = pk2(v[2], v[3]); o.z = pk2(v[4], v[5]); o.w = pk2(v[6], v[7]); *(uint4*)(xr + col) = o; }
      }
      ss += __shfl_xor(ss, 16); ss += __shfl_xor(ss, 32);
      if (fq == 0 && ok) atomicAdd(p.ssq_x + (L + 1) * NTP + m, ss);
    }
  }
};

DEV void kv_prep_row(const Prm& p, int L, int R, int half, bool valid, bf16_t* At_row  ) {
  const int Rl = valid ? R : 0;
  const bf16_t* zr = p.zE + (size_t)Rl * ZE;
  const float rstd = rsqrtf(p.ssq_kv[L * NTP + Rl] * (1.f / 128.f) + RMS_EPS);
  float* outc; float* outk;
  if (Rl < NPR) { const int s = Rl / PT, q = Rl - s * PT; outc = p.ckv_p + (((size_t)L * 4 + s) * PT + q) * 128; outk = p.kr_p + (((size_t)L * 4 + s) * PT + q) * 32; }
  else { const int j = Rl - NPR; outc = p.ckv_s + ((size_t)L * NSM + j) * 128; outk = p.kr_s + ((size_t)L * NSM + j) * 32; }
  const float* g = p.kv_norm_g + L * 128 + 64 * half;
  uint4 uu[8], kru[2], krv[2];
#pragma unroll
  for (int c8 = 0; c8 < 8; ++c8) uu[c8] = *(const uint4*)(zr + ZE_CKV + 64 * half + 8 * c8);
#pragma unroll
  for (int c8 = 0; c8 < 2; ++c8) { kru[c8] = *(const uint4*)(zr + ZE_KR + 8 * c8); krv[c8] = *(const uint4*)(zr + ZE_KR + 16 + 8 * c8); }
  __builtin_amdgcn_sched_barrier(0);
#pragma unroll
  for (int c8 = 0; c8 < 8; ++c8) {
    const uint4 u = uu[c8];
    const float4 g0 = *(const float4*)(g + 8 * c8), g1 = *(const float4*)(g + 8 * c8 + 4);
    float4 y0, y1;
    y0.x = bflo(u.x) * rstd * g0.x; y0.y = bfhi(u.x) * rstd * g0.y; y0.z = bflo(u.y) * rstd * g0.z; y0.w = bfhi(u.y) * rstd * g0.w;
    y1.x = bflo(u.z) * rstd * g1.x; y1.y = bfhi(u.z) * rstd * g1.y; y1.z = bflo(u.w) * rstd * g1.z; y1.w = bfhi(u.w) * rstd * g1.w;
    if (valid) { *(float4*)(outc + 64 * half + 8 * c8) = y0; *(float4*)(outc + 64 * half + 8 * c8 + 4) = y1; }
    if (At_row) { uint4 o; o.x = pk2(y0.x, y0.y); o.y = pk2(y0.z, y0.w); o.z = pk2(y1.x, y1.y); o.w = pk2(y1.z, y1.w); *(uint4*)(At_row + 64 * half + 8 * c8) = o; }
    if (valid && Rl >= NPR) {
      const int j = Rl - NPR, b = j >> 6, r = j & 63;
      bf16_t* kl = p.KL + ((size_t)b * SKEYS + 1024 + r) * 160 + 16 * (4 * half + (c8 >> 1)) + 4 * (c8 & 1);
      *(uint2*)kl = pk4(y0.x, y0.y, y0.z, y0.w); *(uint2*)(kl + 8) = pk4(y1.x, y1.y, y1.z, y1.w);
    }
    if (c8 & 1) __builtin_amdgcn_sched_barrier(0);
  }
  if (half == 0) {
    const int pos = pos_of(Rl);
#pragma unroll
    for (int c8 = 0; c8 < 2; ++c8) {
      const uint4 u = kru[c8], v = krv[c8];
      const float x1[8] = {bflo(u.x), bfhi(u.x), bflo(u.y), bfhi(u.y), bflo(u.z), bfhi(u.z), bflo(u.w), bfhi(u.w)};
      const float x2[8] = {bflo(v.x), bfhi(v.x), bflo(v.y), bfhi(v.y), bflo(v.z), bfhi(v.z), bflo(v.w), bfhi(v.w)};
      float y1[8], y2[8];
#pragma unroll
      for (int e = 0; e < 8; ++e) {
        const float cs = p.ropec[pos * 16 + 8 * c8 + e], sn = p.ropes[pos * 16 + 8 * c8 + e];
        y1[e] = x1[e] * cs - x2[e] * sn; y2[e] = x1[e] * sn + x2[e] * cs;
      }
      if (valid) {
        float4 o;
        o.x = y1[0]; o.y = y1[1]; o.z = y1[2]; o.w = y1[3]; *(float4*)(outk + 8 * c8) = o;
        o.x = y1[4]; o.y = y1[5]; o.z = y1[6]; o.w = y1[7]; *(float4*)(outk + 8 * c8 + 4) = o;
        o.x = y2[0]; o.y = y2[1]; o.z = y2[2]; o.w = y2[3]; *(float4*)(outk + 16 + 8 * c8) = o;
        o.x = y2[4]; o.y = y2[5]; o.z = y2[6]; o.w = y2[7]; *(float4*)(outk + 16 + 8 * c8 + 4) = o;
        {
          const int j = Rl - NPR;
          bf16_t* krd = Rl < NPR ? p.Kr + (size_t)Rl * 32 : p.KL + ((size_t)(j >> 6) * SKEYS + 1024 + (j & 63)) * 160 + 128;
          uint4 q; q.x = pk2(y1[0], y1[1]); q.y = pk2(y1[2], y1[3]); q.z = pk2(y1[4], y1[5]); q.w = pk2(y1[6], y1[7]); *(uint4*)(krd + 8 * c8) = q;
          q.x = pk2(y2[0], y2[1]); q.y = pk2(y2[2], y2[3]); q.z = pk2(y2[4], y2[5]); q.w = pk2(y2[6], y2[7]); *(uint4*)(krd + 16 + 8 * c8) = q;
        }
      }
    }
  }
}
DEV void kvproj_item(const Prm& p, int L, int mt, char* lds) {
  int tid = threadIdx.x; LAUNDER(tid);
  const int lane = tid & 63, w = __builtin_amdgcn_readfirstlane(tid >> 6), wr = w >> 1, wc = w & 1, l31 = lane & 31, hh = lane >> 5;
  bf16_t* At = (bf16_t*)lds;
  bf16_t* Bs = At + 128 * 136;
  {
    const int r = tid >> 1, half = tid & 1, R = mt * 128 + r;
    kv_prep_row(p, L, R, half, R < NPR, At + r * 136);
  }
  uint4 bp0, bp1, bp2, bp3, bp4, bp5, bp6, bp7;
  const int brow = tid >> 4, bcc = (tid & 15) * 8;
#define BLOAD(H) { const bf16_t* ws_ = p.Wb_ukv + ((size_t)L * 1024 + (H) * 128 + brow) * 128 + bcc; \
    bp0 = *(const uint4*)(ws_); bp1 = *(const uint4*)(ws_ + 16 * 128); bp2 = *(const uint4*)(ws_ + 32 * 128); bp3 = *(const uint4*)(ws_ + 48 * 128); \
    bp4 = *(const uint4*)(ws_ + 64 * 128); bp5 = *(const uint4*)(ws_ + 80 * 128); bp6 = *(const uint4*)(ws_ + 96 * 128); bp7 = *(const uint4*)(ws_ + 112 * 128); }
  BLOAD(0)
  for (int h = 0; h < 8; ++h) {
    __syncthreads();
    {
      bf16_t* bd_ = Bs + brow * 136 + bcc;
      *(uint4*)(bd_) = bp0; *(uint4*)(bd_ + 16 * 136) = bp1; *(uint4*)(bd_ + 32 * 136) = bp2; *(uint4*)(bd_ + 48 * 136) = bp3;
      *(uint4*)(bd_ + 64 * 136) = bp4; *(uint4*)(bd_ + 80 * 136) = bp5; *(uint4*)(bd_ + 96 * 136) = bp6; *(uint4*)(bd_ + 112 * 136) = bp7;
    }
    __syncthreads();
    BLOAD(h < 7 ? h + 1 : 7)
    __builtin_amdgcn_sched_barrier(0);
    f32x16 acc[2][2];
#pragma unroll
    for (int i = 0; i < 2; ++i)
#pragma unroll
      for (int j = 0; j < 2; ++j) acc[i][j] = zero16();
    const bf16_t* as = At + (wr * 64 + l31) * 136 + hh * 8;
    const bf16_t* bs = Bs + (wc * 64 + l31) * 136 + hh * 8;
    if (wc == 0) {
#pragma unroll 2
      for (int ks = 0; ks < 8; ++ks) {
        const bf16x8 a0 = *(const bf16x8*)(as + ks * 16), a1 = *(const bf16x8*)(as + 32 * 136 + ks * 16);
        const bf16x8 b0 = *(const bf16x8*)(bs + ks * 16), b1 = *(const bf16x8*)(bs + 32 * 136 + ks * 16);
        acc[0][0] = mfma32(b0, a0, acc[0][0]); acc[0][1] = mfma32(b1, a0, acc[0][1]);
        acc[1][0] = mfma32(b0, a1, acc[1][0]); acc[1][1] = mfma32(b1, a1, acc[1][1]);
      }
#pragma unroll
      for (int i = 0; i < 2; ++i) {
        const int KRr = mt * 128 + wr * 64 + 32 * i + l31;
#pragma unroll
        for (int j = 0; j < 2; ++j)
#pragma unroll
          for (int G = 0; G < 4; ++G)
            *(uint2*)(p.Kn + ((size_t)KRr * 8 + h) * 64 + 32 * j + 8 * G + 4 * hh) = pk4(acc[i][j][4 * G], acc[i][j][4 * G + 1], acc[i][j][4 * G + 2], acc[i][j][4 * G + 3]);
      }
    } else {
#pragma unroll 2
      for (int ks = 0; ks < 8; ++ks) {
        const bf16x8 a0 = *(const bf16x8*)(as + ks * 16), a1 = *(const bf16x8*)(as + 32 * 136 + ks * 16);
        const bf16x8 b0 = *(const bf16x8*)(bs + ks * 16), b1 = *(const bf16x8*)(bs + 32 * 136 + ks * 16);
        acc[0][0] = mfma32(a0, b0, acc[0][0]); acc[0][1] = mfma32(a0, b1, acc[0][1]);
        acc[1][0] = mfma32(a1, b0, acc[1][0]); acc[1][1] = mfma32(a1, b1, acc[1][1]);
      }
#pragma unroll
      for (int j = 0; j < 2; ++j) {
        const int d = 32 * j + l31;
#pragma unroll
        for (int i = 0; i < 2; ++i)
#pragma unroll
          for (int G = 0; G < 4; ++G) {
            const int KRr = mt * 128 + wr * 64 + 32 * i + 16 * (G >> 1) + 8 * hh + 4 * (G & 1);
            *(uint2*)(p.Vt + ((size_t)h * 64 + d) * KVR + KRr) = pk4(acc[i][j][4 * G], acc[i][j][4 * G + 1], acc[i][j][4 * G + 2], acc[i][j][4 * G + 3]);
          }
      }
    }
  }
  __syncthreads();
#undef BLOAD
}
DEV void sample_prep_item(const Prm& p, int L, int it) {
  int tid = threadIdx.x; LAUNDER(tid);
  const int R = NPR + it * 128 + (tid >> 1);
  kv_prep_row(p, L, R, tid & 1, true, nullptr);
}
DEV void shift_item(const Prm& p, int L, int st) {
  int tid0 = threadIdx.x; LAUNDER(tid0);
  if (tid0 < 224) {
    const int R = st < 4 ? st * PT + (PT - 1) : NPR + (st - 4) * 64 + 63;
    const uint2 u = *(const uint2*)(p.zE + (size_t)R * ZE + ZE_ZC + 4 * tid0);
    float4 v; v.x = bflo(u.x); v.y = bfhi(u.x); v.z = bflo(u.y); v.w = bfhi(u.y);
    float* dst = st < 4 ? p.shift_p + ((size_t)L * 4 + st) * 896 : p.shift_s + ((size_t)L * 32 + (st - 4)) * 896;
    *(float4*)(dst + 4 * tid0) = v;
  }
}

DEV void lat_item(const Prm& p, int L, int j) {
  int tid = threadIdx.x; LAUNDER(tid);
  const int b = j >> 4, t = j & 15;
  const float* csrc = p.cache_ckv + (((size_t)L * 32 + b) * 1024 + 64 * t) * 128;
  const float* ksrc = p.cache_krope + (((size_t)L * 32 + b) * 1024 + 64 * t) * 32;
  {
    const int row = tid >> 2, qd = tid & 3;
    const float* s = csrc + row * 128 + 32 * qd;
    bf16_t* d = p.KL + ((size_t)b * SKEYS + 64 * t + row) * 160;
    const float4 v0 = *(const float4*)(s), v1 = *(const float4*)(s + 4), v2 = *(const float4*)(s + 8), v3 = *(const float4*)(s + 12);
    const float4 v4 = *(const float4*)(s + 16), v5 = *(const float4*)(s + 20), v6 = *(const float4*)(s + 24), v7 = *(const float4*)(s + 28);
    const float4 k0 = *(const float4*)(ksrc + row * 32 + 8 * qd), k1 = *(const float4*)(ksrc + row * 32 + 8 * qd + 4);
    uint4 a;
    a.x = pk2(v0.x, v0.y); a.y = pk2(v0.z, v0.w); a.z = pk2(v2.x, v2.y); a.w = pk2(v2.z, v2.w); *(uint4*)(d + 32 * qd) = a;
    a.x = pk2(v1.x, v1.y); a.y = pk2(v1.z, v1.w); a.z = pk2(v3.x, v3.y); a.w = pk2(v3.z, v3.w); *(uint4*)(d + 32 * qd + 8) = a;
    a.x = pk2(v4.x, v4.y); a.y = pk2(v4.z, v4.w); a.z = pk2(v6.x, v6.y); a.w = pk2(v6.z, v6.w); *(uint4*)(d + 32 * qd + 16) = a;
    a.x = pk2(v5.x, v5.y); a.y = pk2(v5.z, v5.w); a.z = pk2(v7.x, v7.y); a.w = pk2(v7.z, v7.w); *(uint4*)(d + 32 * qd + 24) = a;
    a.x = pk2(k0.x, k0.y); a.y = pk2(k0.z, k0.w); a.z = pk2(k1.x, k1.y); a.w = pk2(k1.z, k1.w); *(uint4*)(d + 128 + 8 * qd) = a;
  }
}

template <bool SAMPLE>
DEV int attn_body(const Prm& p, int L, int sb, int head, int qt, char* lds, unsigned* nctr = nullptr) {
  int tid = threadIdx.x; LAUNDER(tid);
  const int lane = tid & 63, w = __builtin_amdgcn_readfirstlane(tid >> 6), l31 = lane & 31, hh = lane >> 5;
  bf16_t* Ks = (bf16_t*)lds;
  bf16_t* Vs = Ks + (SAMPLE ? 1 : 2) * 64 * 104;
  bf16_t* Cs = Vs + (SAMPLE ? 1 : 2) * 64 * 72;
  bf16_t* Wl = Cs + 64 * 136;
  const bf16_t* Qb = (const bf16_t*)p.y_prompt;
  bf16_t* mix = p.zE;
  int Rq0, ntiles, lastvis; bool wact, rowvalid;
  if (SAMPLE) { Rq0 = NPR + 64 * sb; ntiles = 17; lastvis = 16; wact = w < 2; rowvalid = wact; }
  else if (qt >= 0) { Rq0 = sb * PT + 16 + 128 * qt; ntiles = 2 * qt + 3; lastvis = 1 + 2 * qt + (w >> 1); wact = true; rowvalid = true; }
  else { Rq0 = sb * PT; ntiles = 1; lastvis = 0; wact = (w == 0); rowvalid = wact && l31 < 16; }
  const int myrow = Rq0 + 32 * w + l31;
  const int Rld = rowvalid ? myrow : Rq0;
  bf16x8 qf[6];
  {
    const bf16_t* qp = Qb + (size_t)Rld * 768 + head * 96 + hh * 8;
#pragma unroll
    for (int ks = 0; ks < 6; ++ks) qf[ks] = *(const bf16x8*)(qp + 16 * ks);
  }
  float m_run = -1e30f, l_run = 0.f;
  f32x16 o0 = zero16(), o1 = zero16();

  uint4 a_kn0, a_kn1, a_kr, a_vt0, a_vt1;
  a_kn0 = a_kn1 = a_kr = a_vt0 = a_vt1 = make_uint4(0, 0, 0, 0);
#define PLOADX(S, TI) { const int KR0 = sb * PT + ((TI) == 0 ? 0 : 16 + 64 * ((TI) - 1)); \
    S##_kn0 = *(const uint4*)(p.Kn + ((size_t)(KR0 + (tid >> 3)) * 8 + head) * 64 + (tid & 7) * 8); \
    S##_kn1 = *(const uint4*)(p.Kn + ((size_t)(KR0 + 32 + (tid >> 3)) * 8 + head) * 64 + (tid & 7) * 8); \
    S##_kr = *(const uint4*)(p.Kr + (size_t)(KR0 + (tid >> 2)) * 32 + (tid & 3) * 8); \
    S##_vt0 = *(const uint4*)(p.Vt + ((size_t)head * 64 + (tid >> 3)) * KVR + KR0 + (tid & 7) * 8); \
    S##_vt1 = *(const uint4*)(p.Vt + ((size_t)head * 64 + 32 + (tid >> 3)) * KVR + KR0 + (tid & 7) * 8); }
#define PWRITEX(S, BUF) { bf16_t* kb_ = Ks + (BUF) * 64 * 104; bf16_t* vb_ = Vs + (BUF) * 64 * 72; \
    *(uint4*)(kb_ + (tid >> 3) * 104 + (tid & 7) * 8) = S##_kn0; *(uint4*)(kb_ + (32 + (tid >> 3)) * 104 + (tid & 7) * 8) = S##_kn1; \
    *(uint4*)(kb_ + (tid >> 2) * 104 + 64 + (tid & 3) * 8) = S##_kr; \
    *(uint4*)(vb_ + (tid >> 3) * 72 + (tid & 7) * 8) = S##_vt0; *(uint4*)(vb_ + (32 + (tid >> 3)) * 72 + (tid & 7) * 8) = S##_vt1; }
  float4 pc0, pc1, pc2, pc3, pc4, pc5, pc6, pc7, pk0, pk1;
  pc0 = pc1 = pc2 = pc3 = pc4 = pc5 = pc6 = pc7 = pk0 = pk1 = make_float4(0.f, 0.f, 0.f, 0.f);
  if (SAMPLE) {
    const bf16_t* wsrc = p.Wb_ukv + ((size_t)L * 1024 + head * 128) * 128;
#pragma unroll
    for (int i = 0; i < 8; ++i) { const int id = tid + 256 * i, row = id >> 4, cc = id & 15; *(uint4*)(Wl + row * 136 + cc * 8) = *(const uint4*)(wsrc + row * 128 + cc * 8); }
  }
#define SLOAD(TI) { const float* csrc; const float* ksrc; \
    if ((TI) < 16) { csrc = p.cache_ckv + (((size_t)L * 32 + sb) * 1024 + 64 * (TI)) * 128; ksrc = p.cache_krope + (((size_t)L * 32 + sb) * 1024 + 64 * (TI)) * 32; } \
    else { csrc = p.ckv_s + ((size_t)L * NSM + 64 * sb) * 128; ksrc = p.kr_s + ((size_t)L * NSM + 64 * sb) * 32; } \
    const float* cb_ = csrc + (tid >> 5) * 128 + (tid & 31) * 4; \
    pc0 = *(const float4*)(cb_); pc1 = *(const float4*)(cb_ + 8 * 128); pc2 = *(const float4*)(cb_ + 16 * 128); pc3 = *(const float4*)(cb_ + 24 * 128); \
    pc4 = *(const float4*)(cb_ + 32 * 128); pc5 = *(const float4*)(cb_ + 40 * 128); pc6 = *(const float4*)(cb_ + 48 * 128); pc7 = *(const float4*)(cb_ + 56 * 128); \
    const float* kb2_ = ksrc + (tid >> 3) * 32 + (tid & 7) * 4; pk0 = *(const float4*)(kb2_); pk1 = *(const float4*)(kb2_ + 32 * 32); }
#define SWRITE(BUF) { bf16_t* cd_ = Cs + (tid >> 5) * 136 + (tid & 31) * 4; \
    *(uint2*)(cd_) = pk4(pc0.x, pc0.y, pc0.z, pc0.w); *(uint2*)(cd_ + 8 * 136) = pk4(pc1.x, pc1.y, pc1.z, pc1.w); \
    *(uint2*)(cd_ + 16 * 136) = pk4(pc2.x, pc2.y, pc2.z, pc2.w); *(uint2*)(cd_ + 24 * 136) = pk4(pc3.x, pc3.y, pc3.z, pc3.w); \
    *(uint2*)(cd_ + 32 * 136) = pk4(pc4.x, pc4.y, pc4.z, pc4.w); *(uint2*)(cd_ + 40 * 136) = pk4(pc5.x, pc5.y, pc5.z, pc5.w); \
    *(uint2*)(cd_ + 48 * 136) = pk4(pc6.x, pc6.y, pc6.z, pc6.w); *(uint2*)(cd_ + 56 * 136) = pk4(pc7.x, pc7.y, pc7.z, pc7.w); \
    }
#define SWRITEK(BUF) { bf16_t* kd_ = Ks + (BUF) * 64 * 104 + (tid >> 3) * 104 + 64 + (tid & 7) * 4; \
    *(uint2*)(kd_) = pk4(pk0.x, pk0.y, pk0.z, pk0.w); *(uint2*)(kd_ + 32 * 104) = pk4(pk1.x, pk1.y, pk1.z, pk1.w); }
  auto sexpand = [&](int buf) {
    const int a = w & 1, b = w >> 1;
    const bf16_t* cp = Cs + (32 * b + l31) * 136 + hh * 8;
    const bf16_t* wkp = Wl + (32 * a + l31) * 136 + hh * 8;
    const bf16_t* wvp = wkp + 64 * 136;
    f32x16 ka = zero16(), va = zero16();
#pragma unroll
    for (int ks = 0; ks < 8; ++ks) {
      const bf16x8 cf = *(const bf16x8*)(cp + 16 * ks);
      ka = mfma32(*(const bf16x8*)(wkp + 16 * ks), cf, ka);
      va = mfma32(cf, *(const bf16x8*)(wvp + 16 * ks), va);
    }
    bf16_t* kb = Ks + buf * 64 * 104; bf16_t* vb = Vs + buf * 64 * 72;
#pragma unroll
    for (int G = 0; G < 4; ++G) {
      *(uint2*)(kb + (32 * b + l31) * 104 + 32 * a + 8 * G + 4 * hh) = pk4(ka[4 * G], ka[4 * G + 1], ka[4 * G + 2], ka[4 * G + 3]);
      *(uint2*)(vb + (32 * a + l31) * 72 + 32 * b + 8 * G + 4 * hh) = pk4(va[4 * G], va[4 * G + 1], va[4 * G + 2], va[4 * G + 3]);
    }
  };
  const int x7 = (l31 >> 1) & 7, x3 = (l31 >> 2) & 3, xv = (l31 >> 1) & 7;
#define KFRAG(SP, KS, SUB) (SAMPLE ? *(const bf16x8*)((const bf16_t*)(SP) + (l31 + 32 * (SUB)) * 104 + hh * 8 + 16 * (KS)) \
    : ((KS) < 4 ? *(const bf16x8*)((SP) + (l31 + 32 * (SUB)) * 128 + (((2 * (KS) + hh) ^ x7) << 4)) \
                : *(const bf16x8*)((SP) + 8192 + (l31 + 32 * (SUB)) * 64 + (((2 * ((KS) - 4) + hh) ^ x3) << 4))))
#define VFR(S, SUB) (*(const bf16x8*)(sp + 12288 + (l31 + 32 * (SUB)) * 128 + (((2 * (S) + hh) ^ xv) << 4)))
#define VHALF(SP, C, SUB) (SAMPLE ? *(const uint2*)((const bf16_t*)(SP) + 64 * 104 + (l31 + 32 * (SUB)) * 72 + 4 * hh + 8 * (C)) \
    : *(const uint2*)((SP) + 12288 + (l31 + 32 * (SUB)) * 128 + 8 * hh + ((((C)) ^ xv) << 4)))
  auto compute_t = [&](auto masked_c, const char* sp) {
    constexpr bool MASKED = decltype(masked_c)::value;
    f32x16 s0 = zero16(), s1 = zero16();
    {
      bf16x8 kf[12];
#pragma unroll
      for (int ks = 0; ks < 6; ++ks) { kf[2 * ks] = KFRAG(sp, ks, 0); kf[2 * ks + 1] = KFRAG(sp, ks, 1); }
      __builtin_amdgcn_sched_barrier(0);
#pragma unroll
      for (int ks = 0; ks < 6; ++ks) { s0 = mfma32(kf[2 * ks], qf[ks], s0); s1 = mfma32(kf[2 * ks + 1], qf[ks], s1); }
    }
    bf16x8 vf[8];
    if (!SAMPLE) {
#pragma unroll
      for (int S = 0; S < 4; ++S) { vf[2 * S] = VFR(S, 0); vf[2 * S + 1] = VFR(S, 1); }
      __builtin_amdgcn_sched_barrier(0);
    }
    if (!SAMPLE && MASKED) {
#pragma unroll
      for (int r = 8; r < 16; ++r) s0[r] = -1e30f;
#pragma unroll
      for (int r = 0; r < 16; ++r) s1[r] = -1e30f;
    }
    float mx = s0[0];
#pragma unroll
    for (int r = 1; r < 16; ++r) mx = fmaxf(mx, s0[r]);
#pragma unroll
    for (int r = 0; r < 16; ++r) mx = fmaxf(mx, s1[r]);
    mx = fmaxf(mx, __shfl_xor(mx, 32));
    const float mnew = fmaxf(m_run, mx);
    const float alpha = __builtin_amdgcn_exp2f(m_run - mnew);
    m_run = mnew;
    float ps = 0.f;
#pragma unroll
    for (int r = 0; r < 16; ++r) { s0[r] = __builtin_amdgcn_exp2f(s0[r] - mnew); ps += s0[r]; }
#pragma unroll
    for (int r = 0; r < 16; ++r) { s1[r] = __builtin_amdgcn_exp2f(s1[r] - mnew); ps += s1[r]; }
    l_run = l_run * alpha + ps;
#pragma unroll
    for (int r = 0; r < 16; ++r) { o0[r] *= alpha; o1[r] *= alpha; }
    const bf16x8 pf0 = mk8(pk2(s0[0], s0[1]), pk2(s0[2], s0[3]), pk2(s0[4], s0[5]), pk2(s0[6], s0[7]));
    const bf16x8 pf1 = mk8(pk2(s0[8], s0[9]), pk2(s0[10], s0[11]), pk2(s0[12], s0[13]), pk2(s0[14], s0[15]));
    const bf16x8 pf2 = mk8(pk2(s1[0], s1[1]), pk2(s1[2], s1[3]), pk2(s1[4], s1[5]), pk2(s1[6], s1[7]));
    const bf16x8 pf3 = mk8(pk2(s1[8], s1[9]), pk2(s1[10], s1[11]), pk2(s1[12], s1[13]), pk2(s1[14], s1[15]));
#define PV_STEP(S, PF) { bf16x8 v0_, v1_; \
      if (SAMPLE) { const uint2 a0 = VHALF(sp, 2 * S, 0), b0 = VHALF(sp, 2 * S + 1, 0), a1 = VHALF(sp, 2 * S, 1), b1 = VHALF(sp, 2 * S + 1, 1); \
        v0_ = mk8(a0.x, a0.y, b0.x, b0.y); v1_ = mk8(a1.x, a1.y, b1.x, b1.y); } \
      else { v0_ = *(const bf16x8*)(sp + 12288 + l31 * 128 + (((2 * S + hh) ^ xv) << 4)); v1_ = *(const bf16x8*)(sp + 12288 + (l31 + 32) * 128 + (((2 * S + hh) ^ xv) << 4)); } \
      o0 = mfma32(v0_, PF, o0); o1 = mfma32(v1_, PF, o1); }
    if (SAMPLE) { PV_STEP(0, pf0) PV_STEP(1, pf1) PV_STEP(2, pf2) PV_STEP(3, pf3) }
    else {
      o0 = mfma32(vf[0], pf0, o0); o1 = mfma32(vf[1], pf0, o1); o0 = mfma32(vf[2], pf1, o0); o1 = mfma32(vf[3], pf1, o1);
      o0 = mfma32(vf[4], pf2, o0); o1 = mfma32(vf[5], pf2, o1); o0 = mfma32(vf[6], pf3, o0); o1 = mfma32(vf[7], pf3, o1);
    }
  };
  auto compute_meta = [&](const char* sp) {
    f32x16 s0 = zero16();
    {
      bf16x8 kf[6];
#pragma unroll
      for (int ks = 0; ks < 6; ++ks) kf[ks] = KFRAG(sp, ks, 0);
      __builtin_amdgcn_sched_barrier(0);
#pragma unroll
      for (int ks = 0; ks < 6; ++ks) s0 = mfma32(kf[ks], qf[ks], s0);
    }
    const bf16x8 v0 = VFR(0, 0), v1 = VFR(0, 1);
    float mx = s0[0];
#pragma unroll
    for (int r = 1; r < 8; ++r) mx = fmaxf(mx, s0[r]);
    mx = fmaxf(mx, __shfl_xor(mx, 32));
    m_run = mx;
    float ps = 0.f;
#pragma unroll
    for (int r = 0; r < 8; ++r) { s0[r] = __builtin_amdgcn_exp2f(s0[r] - mx); ps += s0[r]; }
    l_run = ps;
    const bf16x8 pf0 = mk8(pk2(s0[0], s0[1]), pk2(s0[2], s0[3]), pk2(s0[4], s0[5]), pk2(s0[6], s0[7]));
    o0 = mfma32(v0, pf0, zero16()); o1 = mfma32(v1, pf0, zero16());
  };
  bf16x8 qf7 = mk8(0u, 0u, 0u, 0u);
  const bf16x8 kone = mk8(hh == 0 ? 0x3F80u : 0u, 0u, 0u, 0u);
  auto freeze = [&]() {
    const float mf = bflo(pk2(m_run, 0.f));
    const float fac = __builtin_amdgcn_exp2f(m_run - mf);
    l_run *= fac;
#pragma unroll
    for (int r = 0; r < 16; ++r) { o0[r] *= fac; o1[r] *= fac; }
    qf7 = mk8(hh == 0 ? (pk2(-mf, 0.f) & 0xffffu) : 0u, 0u, 0u, 0u);
  };
  auto compute_f = [&](const char* sp) {
    f32x16 s0, s1;
    {
      bf16x8 kf[12];
#pragma unroll
      for (int ks = 0; ks < 6; ++ks) { kf[2 * ks] = KFRAG(sp, ks, 0); kf[2 * ks + 1] = KFRAG(sp, ks, 1); }
      __builtin_amdgcn_sched_barrier(0);
      s0 = mfma32(kone, qf7, zero16()); s1 = mfma32(kone, qf7, zero16());
#pragma unroll
      for (int ks = 0; ks < 6; ++ks) { s0 = mfma32(kf[2 * ks], qf[ks], s0); s1 = mfma32(kf[2 * ks + 1], qf[ks], s1); }
    }
    bf16x8 vf[8];
    if (!SAMPLE) {
#pragma unroll
      for (int S = 0; S < 4; ++S) { vf[2 * S] = VFR(S, 0); vf[2 * S + 1] = VFR(S, 1); }
      __builtin_amdgcn_sched_barrier(0);
    }
    float ps = 0.f;
#pragma unroll
    for (int r = 0; r < 16; ++r) { s0[r] = __builtin_amdgcn_exp2f(s0[r]); ps += s0[r]; }
#pragma unroll
    for (int r = 0; r < 16; ++r) { s1[r] = __builtin_amdgcn_exp2f(s1[r]); ps += s1[r]; }
    l_run += ps;
    const bf16x8 pf0 = mk8(pk2(s0[0], s0[1]), pk2(s0[2], s0[3]), pk2(s0[4], s0[5]), pk2(s0[6], s0[7]));
    const bf16x8 pf1 = mk8(pk2(s0[8], s0[9]), pk2(s0[10], s0[11]), pk2(s0[12], s0[13]), pk2(s0[14], s0[15]));
    const bf16x8 pf2 = mk8(pk2(s1[0], s1[1]), pk2(s1[2], s1[3]), pk2(s1[4], s1[5]), pk2(s1[6], s1[7]));
    const bf16x8 pf3 = mk8(pk2(s1[8], s1[9]), pk2(s1[10], s1[11]), pk2(s1[12], s1[13]), pk2(s1[14], s1[15]));
    if (SAMPLE) { PV_STEP(0, pf0) PV_STEP(1, pf1) PV_STEP(2, pf2) PV_STEP(3, pf3) }
    else {
      o0 = mfma32(vf[0], pf0, o0); o1 = mfma32(vf[1], pf0, o1); o0 = mfma32(vf[2], pf1, o0); o1 = mfma32(vf[3], pf1, o1);
      o0 = mfma32(vf[4], pf2, o0); o1 = mfma32(vf[5], pf2, o1); o0 = mfma32(vf[6], pf3, o0); o1 = mfma32(vf[7], pf3, o1);
    }
#undef PV_STEP
  };

  if (SAMPLE) {
    SLOAD(0)
    for (int ti = 0; ti < ntiles; ++ti) {
      const int buf = 0;
      SWRITE(buf)
      __syncthreads();
      SWRITEK(buf)
      { const int tn = ti + 1 < ntiles ? ti + 1 : ti; SLOAD(tn) }
      sexpand(buf);
      __syncthreads();
      if (wact) { if (ti == 0) { compute_t(std::false_type{}, (const char*)Ks); freeze(); } else compute_f((const char*)Ks); }
    }
    __syncthreads();
  } else {
    const int l8 = lane >> 3, c8 = lane & 7;
    unsigned kn_o0, kn_o1, kr_o, vt_o0, vt_o1;
    { const int r = 8 * (2 * w) + l8; kn_o0 = (unsigned)((r * 8 + head) * 64 + ((c8 ^ ((r >> 1) & 7)) * 8)); }
    { const int r = 8 * (2 * w + 1) + l8; kn_o1 = (unsigned)((r * 8 + head) * 64 + ((c8 ^ ((r >> 1) & 7)) * 8)); }
    { const int r = 16 * w + (lane >> 2); kr_o = (unsigned)(r * 32 + (((lane & 3) ^ ((r >> 2) & 3)) * 8)); }
    { const int d = 8 * (2 * w) + l8; vt_o0 = (unsigned)((head * 64 + d) * KVR + ((c8 ^ ((d >> 1) & 7)) * 8)); }
    { const int d = 8 * (2 * w + 1) + l8; vt_o1 = (unsigned)((head * 64 + d) * KVR + ((c8 ^ ((d >> 1) & 7)) * 8)); }
#define GLDS16(G, Lp) __builtin_amdgcn_global_load_lds((const unsigned*)(G), (LAS3 unsigned*)(Lp), 16, 0, 0)
#define PDMA(TI, STG) { const int KR0 = sb * PT + ((TI) == 0 ? 0 : 16 + 64 * ((TI) - 1)); char* sb_ = lds + (STG) * 20480 + lane * 16; \
      const bf16_t* kn_ = p.Kn + (size_t)KR0 * 512; const bf16_t* kr_ = p.Kr + (size_t)KR0 * 32; const bf16_t* vt_ = p.Vt + KR0; \
      GLDS16(kn_ + kn_o0, sb_ + (2 * w) * 1024); GLDS16(kn_ + kn_o1, sb_ + (2 * w + 1) * 1024); GLDS16(kr_ + kr_o, sb_ + 8192 + w * 1024); \
      GLDS16(vt_ + vt_o0, sb_ + 12288 + (2 * w) * 1024); GLDS16(vt_ + vt_o1, sb_ + 12288 + (2 * w + 1) * 1024); }
    PDMA(0, 0)
    if (ntiles > 1) PDMA(1, 1)
    int stg = 0, stg2 = 2;
    for (int ti = 0; ti < ntiles; ++ti) {
      if (ti + 1 < ntiles) asm volatile("s_waitcnt vmcnt(5)" ::: "memory"); else asm volatile("s_waitcnt vmcnt(0)" ::: "memory");
      RAW_BARRIER()
      if (ti + 2 < ntiles) PDMA(ti + 2, stg2)
      const char* sp = lds + stg * 20480;
      if (ti == 0) { if (wact) compute_meta(sp); }
      else if (ti == 1) { compute_t(std::false_type{}, sp); freeze(); }
      else if (ti <= lastvis) compute_f(sp);
      stg = stg == 2 ? 0 : stg + 1; stg2 = stg2 == 2 ? 0 : stg2 + 1;
    }
    __syncthreads();
#undef PDMA
#undef GLDS16
  }
  int tk = 0x7fffffff; if (nctr && tid == 0) tk = (int)atomicAdd(nctr, 1u);
  const float lt = l_run + __shfl_xor(l_run, 32);
  if (rowvalid) {
    const float inv = 1.f / lt;
    const bf16_t* gbp = p.zL + (size_t)myrow * ZL + ZL_GB + 64 * head;
    bf16_t* op = mix + (size_t)myrow * D + 256 + 64 * head;
#pragma unroll
    for (int G = 0; G < 4; ++G) {
      const int d = 8 * G + 4 * hh;
      const uint2 g0 = *(const uint2*)(gbp + d), g1 = *(const uint2*)(gbp + 32 + d);
      *(uint2*)(op + d) = pk4(o0[4 * G] * inv * silu_(bflo(g0.x)), o0[4 * G + 1] * inv * silu_(bfhi(g0.x)), o0[4 * G + 2] * inv * silu_(bflo(g0.y)), o0[4 * G + 3] * inv * silu_(bfhi(g0.y)));
      *(uint2*)(op + 32 + d) = pk4(o1[4 * G] * inv * silu_(bflo(g1.x)), o1[4 * G + 1] * inv * silu_(bfhi(g1.x)), o1[4 * G + 2] * inv * silu_(bflo(g1.y)), o1[4 * G + 3] * inv * silu_(bfhi(g1.y)));
    }
  }
  return tk;
}
DEV void attn_item(const Prm& p, int L, int id, char* lds) {
  if (id < 1024) { const int qt = 31 - (id >> 5), sh = id & 31; attn_body<false>(p, L, sh >> 3, sh & 7, qt, lds); }
  else { const int j = id - 1280; attn_body<false>(p, L, j >> 3, j & 7, -1, lds); }
}

typedef short v4i16_t __attribute__((ext_vector_type(4)));
DEV uint2 lds_tr16(const char* pl) { const v4i16_t r = __builtin_amdgcn_ds_read_tr16_b64_v4i16((__attribute__((address_space(3))) v4i16_t*)pl); return __builtin_bit_cast(uint2, r); }
DEV void attn_sample(const Prm& p, int L, int b, int hp, char* lds) {
  int tid = threadIdx.x; LAUNDER(tid);
  const int lane = tid & 63, w = __builtin_amdgcn_readfirstlane(tid >> 6), l31 = lane & 31, hh = lane >> 5;
  const int head = 2 * hp + (w >> 1);
  const bf16_t* Qb = (const bf16_t*)p.y_prompt;
  bf16_t* mix = p.zE;
  const int myrow = NPR + 64 * b + 32 * (w & 1) + l31;
  bf16x8 qf[6];
  {
    const bf16_t* qp = Qb + (size_t)myrow * 768 + head * 96 + hh * 8;
#pragma unroll
    for (int ks = 0; ks < 6; ++ks) qf[ks] = *(const bf16x8*)(qp + 16 * ks);
  }
  unsigned kl_o0, kl_o1, kl_o2, kl_o3, kr_o;
  {
    const int l16 = lane >> 4, c16 = lane & 15;
#define KROW(i) (4 * (4 * w + (i)) + l16)
#define KLO(i) ((unsigned)(KROW(i) * 160 + ((c16 ^ (((KROW(i) & 3) << 2) | ((KROW(i) >> 2) & 3))) * 8)))
    kl_o0 = KLO(0); kl_o1 = KLO(1); kl_o2 = KLO(2); kl_o3 = KLO(3);
#undef KLO
#undef KROW
    const int r = 16 * w + (lane >> 2);
    kr_o = (unsigned)(r * 160 + 128 + (((lane & 3) ^ ((r >> 2) & 3)) * 8));
  }
  const bf16_t* klb = p.KL + (size_t)b * SKEYS * 160;
#define GLDS16(G, Lp) __builtin_amdgcn_global_load_lds((const unsigned*)(G), (LAS3 unsigned*)(Lp), 16, 0, 0)
#define SDMA(TI, STG) { char* sb_ = lds + (STG) * 20480 + lane * 16; const bf16_t* kl_ = klb + (size_t)(TI) * 64 * 160; \
    GLDS16(kl_ + kl_o0, sb_ + (4 * w) * 1024); GLDS16(kl_ + kl_o1, sb_ + (4 * w + 1) * 1024); GLDS16(kl_ + kl_o2, sb_ + (4 * w + 2) * 1024); GLDS16(kl_ + kl_o3, sb_ + (4 * w + 3) * 1024); \
    GLDS16(kl_ + kr_o, sb_ + 16384 + w * 1024); }
  SDMA(0, 0)
  SDMA(1, 1)
  bf16x8 qa0, qa1, qa2, qa3, qa4, qa5, qa6, qa7;
  {
    const float* wsrc = p.w_ukv + ((size_t)L * 128 + l31) * 1024 + head * 128 + 8 * hh;
#define QABS(CT, QA, QB) { f32x16 acc = zero16(); \
      _Pragma("unroll") for (int ks = 0; ks < 4; ++ks) { const float* s_ = wsrc + (size_t)(32 * (CT)) * 1024 + 16 * ks; const float4 a_ = *(const float4*)s_, c_ = *(const float4*)(s_ + 4); \
        acc = mfma32(mk8(pk2(a_.x, a_.y), pk2(a_.z, a_.w), pk2(c_.x, c_.y), pk2(c_.z, c_.w)), qf[ks], acc); } \
      QA = mk8(pk2(acc[0], acc[1]), pk2(acc[2], acc[3]), pk2(acc[4], acc[5]), pk2(acc[6], acc[7])); \
      QB = mk8(pk2(acc[8], acc[9]), pk2(acc[10], acc[11]), pk2(acc[12], acc[13]), pk2(acc[14], acc[15])); }
    QABS(0, qa0, qa1) QABS(1, qa2, qa3) QABS(2, qa4, qa5) QABS(3, qa6, qa7)
#undef QABS
  }
  float m_run = -1e30f, l_run = 0.f;
  f32x16 o0 = zero16(), o1 = zero16(), o2 = zero16(), o3 = zero16();
  bf16x8 qf7 = mk8(0u, 0u, 0u, 0u);
  const bf16x8 kone = mk8(hh == 0 ? 0x3F80u : 0u, 0u, 0u, 0u);
  const int xk = ((l31 & 3) << 2) | ((l31 >> 2) & 3), x3 = (l31 >> 2) & 3;
  int va0, va1;
  {
    const int g = l31 >> 4, q = (l31 >> 2) & 3, pp = l31 & 3;
    const int rowb = (4 * hh + q) * 256 + 8 * (pp & 1) + (q << 6);
    va0 = rowb + (((2 * g + (pp >> 1)) ^ hh) << 4);
    va1 = rowb + 2048 + (((2 * g + (pp >> 1)) ^ (hh + 2)) << 4);
  }
  int stg = 0, stg2 = 2;
  for (int ti = 0; ti < 17; ++ti) {
    if (ti + 1 < 17) asm volatile("s_waitcnt vmcnt(5)" ::: "memory"); else asm volatile("s_waitcnt vmcnt(0)" ::: "memory");
    RAW_BARRIER()
    if (ti + 2 < 17) SDMA(ti + 2, stg2)
    const char* sp = lds + stg * 20480;
    f32x16 s0 = mfma32(kone, qf7, zero16()), s1 = s0;
#define QKL(S, QA) { const bf16x8 k0 = *(const bf16x8*)(sp + l31 * 256 + (((2 * (S) + hh) ^ xk) << 4)), k1 = *(const bf16x8*)(sp + (l31 + 32) * 256 + (((2 * (S) + hh) ^ xk) << 4)); \
      s0 = mfma32(k0, QA, s0); s1 = mfma32(k1, QA, s1); }
    QKL(0, qa0) QKL(1, qa1) QKL(2, qa2) QKL(3, qa3) QKL(4, qa4) QKL(5, qa5) QKL(6, qa6) QKL(7, qa7)
#undef QKL
#pragma unroll
    for (int kr = 0; kr < 2; ++kr) {
      const bf16x8 k0 = *(const bf16x8*)(sp + 16384 + l31 * 64 + (((2 * kr + hh) ^ x3) << 4)), k1 = *(const bf16x8*)(sp + 16384 + (l31 + 32) * 64 + (((2 * kr + hh) ^ x3) << 4));
      s0 = mfma32(k0, qf[4 + kr], s0); s1 = mfma32(k1, qf[4 + kr], s1);
    }
    float ps = 0.f;
    if (ti == 0) {
      float mx = s0[0];
#pragma unroll
      for (int r = 1; r < 16; ++r) mx = fmaxf(mx, s0[r]);
#pragma unroll
      for (int r = 0; r < 16; ++r) mx = fmaxf(mx, s1[r]);
      mx = fmaxf(mx, __shfl_xor(mx, 32));
      m_run = bflo(pk2(mx, 0.f));
#pragma unroll
      for (int r = 0; r < 16; ++r) { s0[r] -= m_run; s1[r] -= m_run; }
      qf7 = mk8(hh == 0 ? (pk2(-m_run, 0.f) & 0xffffu) : 0u, 0u, 0u, 0u);
    }
#pragma unroll
    for (int r = 0; r < 16; ++r) { s0[r] = __builtin_amdgcn_exp2f(s0[r]); ps += s0[r]; }
#pragma unroll
    for (int r = 0; r < 16; ++r) { s1[r] = __builtin_amdgcn_exp2f(s1[r]); ps += s1[r]; }
    l_run += ps;
    const bf16x8 pf0 = mk8(pk2(s0[0], s0[1]), pk2(s0[2], s0[3]), pk2(s0[4], s0[5]), pk2(s0[6], s0[7]));
    const bf16x8 pf1 = mk8(pk2(s0[8], s0[9]), pk2(s0[10], s0[11]), pk2(s0[12], s0[13]), pk2(s0[14], s0[15]));
    const bf16x8 pf2 = mk8(pk2(s1[0], s1[1]), pk2(s1[2], s1[3]), pk2(s1[4], s1[5]), pk2(s1[6], s1[7]));
    const bf16x8 pf3 = mk8(pk2(s1[8], s1[9]), pk2(s1[10], s1[11]), pk2(s1[12], s1[13]), pk2(s1[14], s1[15]));
#define PVT(S, CT, PF, OT) { const uint2 a_ = lds_tr16(sp + (va0 ^ ((CT) << 6)) + (S) * 4096), b_ = lds_tr16(sp + (va1 ^ ((CT) << 6)) + (S) * 4096); \
      OT = mfma32(mk8(a_.x, a_.y, b_.x, b_.y), PF, OT); }
#define PVL(S, PF) PVT(S, 0, PF, o0) PVT(S, 1, PF, o1) PVT(S, 2, PF, o2) PVT(S, 3, PF, o3)
    PVL(0, pf0) PVL(1, pf1) PVL(2, pf2) PVL(3, pf3)
#undef PVL
#undef PVT
    stg = stg == 2 ? 0 : stg + 1; stg2 = stg2 == 2 ? 0 : stg2 + 1;
  }
#undef SDMA
#undef GLDS16
  __syncthreads();
  const float lt = l_run + __shfl_xor(l_run, 32);
  const float inv = 1.f / lt;
  f32x16 e0 = zero16(), e1 = zero16();
  const bf16_t* wv = p.Wb_ukv + ((size_t)L * 1024 + head * 128 + 64 + l31) * 128 + 8 * hh;
#define OEXP(S, OT, RB) { const bf16x8 ob = mk8(pk2(OT[RB] * inv, OT[RB + 1] * inv), pk2(OT[RB + 2] * inv, OT[RB + 3] * inv), pk2(OT[RB + 4] * inv, OT[RB + 5] * inv), pk2(OT[RB + 6] * inv, OT[RB + 7] * inv)); \
    e0 = mfma32(*(const bf16x8*)(wv + 16 * (S)), ob, e0); e1 = mfma32(*(const bf16x8*)(wv + 32 * 128 + 16 * (S)), ob, e1); }
  OEXP(0, o0, 0) OEXP(1, o0, 8) OEXP(2, o1, 0) OEXP(3, o1, 8) OEXP(4, o2, 0) OEXP(5, o2, 8) OEXP(6, o3, 0) OEXP(7, o3, 8)
#undef OEXP
  {
    const bf16_t* gbp = p.zL + (size_t)myrow * ZL + ZL_GB + 64 * head;
    bf16_t* op = mix + (size_t)myrow * D + 256 + 64 * head;
#pragma unroll
    for (int G = 0; G < 4; ++G) {
      const int d = 8 * G + 4 * hh;
      const uint2 g0 = *(const uint2*)(gbp + d), g1 = *(const uint2*)(gbp + 32 + d);
      *(uint2*)(op + d) = pk4(e0[4 * G] * silu_(bflo(g0.x)), e0[4 * G + 1] * silu_(bfhi(g0.x)), e0[4 * G + 2] * silu_(bflo(g0.y)), e0[4 * G + 3] * silu_(bfhi(g0.y)));
      *(uint2*)(op + 32 + d) = pk4(e1[4 * G] * silu_(bflo(g1.x)), e1[4 * G + 1] * silu_(bfhi(g1.x)), e1[4 * G + 2] * silu_(bflo(g1.y)), e1[4 * G + 3] * silu_(bfhi(g1.y)));
    }
  }
}

DEV void conv_item(const Prm& p, int L, int item) {
  int tid = threadIdx.x; LAUNDER(tid);
  bf16_t* mix = p.zE;
  const int c0 = (tid & 31) * 8;
  float w0[8], w1[8], w2[8];
#pragma unroll
  for (int e = 0; e < 8; ++e) { w0[e] = p.conv_w[(L * 3 + 0) * 256 + c0 + e]; w1[e] = p.conv_w[(L * 3 + 1) * 256 + c0 + e]; w2[e] = p.conv_w[(L * 3 + 2) * 256 + c0 + e]; }
  uint4 xiv[4][3], cgv[4][3], bgv[4], gav[4];
#pragma unroll
  for (int it = 0; it < 4; ++it) {
    const int R = item * 32 + it * 8 + (tid >> 5), Rc = R < NT ? R : NT - 1;
#pragma unroll
    for (int dlt = 0; dlt < 3; ++dlt) {
      const int rr = Rc - 2 + dlt;
      const bf16_t* zr = p.zL + (size_t)(rr > 0 ? rr : 0) * ZL;
      xiv[it][dlt] = *(const uint4*)(zr + ZL_XIN + c0); cgv[it][dlt] = *(const uint4*)(zr + ZL_CG + c0);
    }
    const bf16_t* zr = p.zL + (size_t)Rc * ZL;
    bgv[it] = *(const uint4*)(zr + ZL_BG + c0); gav[it] = *(const uint4*)(zr + ZL_GA + c0);
  }
  __builtin_amdgcn_sched_barrier(0);
#pragma unroll
  for (int it = 0; it < 4; ++it) {
    const int R = item * 32 + it * 8 + (tid >> 5);
    if (R >= NT) continue;
    int q, T; const float* st; float* so;
    if (R < NPR) { const int s = R / PT; q = R - s * PT; T = PT; st = nullptr; so = p.conv_p + ((size_t)L * 4 + s) * 512; }
    else { const int b = (R - NPR) >> 6; q = (R - NPR) & 63; T = 64; st = p.state_conv + ((size_t)L * 32 + b) * 512; so = p.conv_s + ((size_t)L * 32 + b) * 512; }
    float u[3][8];
#pragma unroll
    for (int dlt = 0; dlt < 3; ++dlt) {
      const int t = q - 2 + dlt;
      if (t >= 0) {
        const uint4 xi = xiv[it][dlt], cg = cgv[it][dlt];
        u[dlt][0] = bflo(xi.x) * bflo(cg.x); u[dlt][1] = bfhi(xi.x) * bfhi(cg.x); u[dlt][2] = bflo(xi.y) * bflo(cg.y); u[dlt][3] = bfhi(xi.y) * bfhi(cg.y);
        u[dlt][4] = bflo(xi.z) * bflo(cg.z); u[dlt][5] = bfhi(xi.z) * bfhi(cg.z); u[dlt][6] = bflo(xi.w) * bflo(cg.w); u[dlt][7] = bfhi(xi.w) * bfhi(cg.w);
      } else if (st) {
        const float* sr = st + (t + 2) * 256 + c0;
#pragma unroll
        for (int e = 0; e < 8; ++e) u[dlt][e] = sr[e];
      } else {
#pragma unroll
        for (int e = 0; e < 8; ++e) u[dlt][e] = 0.f;
      }
    }
    const uint4 bg = bgv[it], ga = gav[it];
    const float bgf[8] = {bflo(bg.x), bfhi(bg.x), bflo(bg.y), bfhi(bg.y), bflo(bg.z), bfhi(bg.z), bflo(bg.w), bfhi(bg.w)};
    const float gaf[8] = {bflo(ga.x), bfhi(ga.x), bflo(ga.y), bfhi(ga.y), bflo(ga.z), bfhi(ga.z), bflo(ga.w), bfhi(ga.w)};
    float y[8];
#pragma unroll
    for (int e = 0; e < 8; ++e) y[e] = bgf[e] * (w0[e] * u[0][e] + w1[e] * u[1][e] + w2[e] * u[2][e]) * silu_(gaf[e]);
    uint4 o; o.x = pk2(y[0], y[1]); o.y = pk2(y[2], y[3]); o.z = pk2(y[4], y[5]); o.w = pk2(y[6], y[7]);
    *(uint4*)(mix + (size_t)R * D + c0) = o;
    if (q >= T - 2) {
      float* d = so + (q - (T - 2)) * 256 + c0;
#pragma unroll
      for (int e = 0; e < 8; ++e) d[e] = u[2][e];
    }
  }
}

DEV int kperm_addr(int m, int kin) {
  const int mt = m >> 4, ml = m & 15, s = kin >> 5, q = (kin >> 4) & 1, g = (kin >> 2) & 3, e = kin & 3;
  return (((mt * 2 + s) * 64 + ml + 16 * g) * 8) + 4 * q + e;
}
DEV int clay_addr(int x, int v) {
  const int xt = x >> 4, g = (x >> 2) & 3, rr = x & 3, vt = v >> 4, l16 = v & 15;
  return ((xt * 4 + vt) * 64 + 16 * g + l16) * 4 + rr;
}
DEV void mm64(const bf16_t* first, const bf16_t* second, int l31, int hh, f32x16 (&acc)[2][2]) {
#pragma unroll
  for (int ks = 0; ks < 4; ++ks) {
    const bf16x8 f0 = *(const bf16x8*)(first + l31 * 72 + ks * 16 + hh * 8), f1 = *(const bf16x8*)(first + (32 + l31) * 72 + ks * 16 + hh * 8);
    const bf16x8 s0 = *(const bf16x8*)(second + l31 * 72 + ks * 16 + hh * 8), s1 = *(const bf16x8*)(second + (32 + l31) * 72 + ks * 16 + hh * 8);
    acc[0][0] = mfma32(f0, s0, acc[0][0]); acc[0][1] = mfma32(f0, s1, acc[0][1]);
    acc[1][0] = mfma32(f1, s0, acc[1][0]); acc[1][1] = mfma32(f1, s1, acc[1][1]);
  }
}
DEV void mm64x32(const bf16_t* first, const bf16_t* second_rows, int l31, int hh, f32x16 (&acc)[2]) {
#pragma unroll
  for (int ks = 0; ks < 4; ++ks) {
    const bf16x8 f0 = *(const bf16x8*)(first + l31 * 72 + ks * 16 + hh * 8), f1 = *(const bf16x8*)(first + (32 + l31) * 72 + ks * 16 + hh * 8);
    const bf16x8 s0 = *(const bf16x8*)(second_rows + l31 * 72 + ks * 16 + hh * 8);
    acc[0] = mfma32(f0, s0, acc[0]); acc[1] = mfma32(f1, s0, acc[1]);
  }
}

DEV void mmq(const bf16_t* first_rows, const bf16_t* second_rows, int l31, int hh, f32x16& acc) {
#pragma unroll
  for (int ks = 0; ks < 4; ++ks) {
    const bf16x8 f0 = *(const bf16x8*)(first_rows + l31 * 72 + ks * 16 + hh * 8);
    const bf16x8 s0 = *(const bf16x8*)(second_rows + l31 * 72 + ks * 16 + hh * 8);
    acc = mfma32(f0, s0, acc);
  }
}
enum { SH_FULL = 0, SH_UP = 1, SH_LO = 2 };
template <int SH> DEV constexpr bool tile_nz(int tx, int ty) { return SH == SH_FULL || (SH == SH_UP ? tx <= ty : tx >= ty); }
struct Acc64 { f32x16 t[2][2]; };
struct Frag64 { bf16x8 f[4][2]; };
template <int SS> DEV bf16x8 pack8(const f32x16& v) {
  return mk8(pk2(v[8 * SS], v[8 * SS + 1]), pk2(v[8 * SS + 2], v[8 * SS + 3]), pk2(v[8 * SS + 4], v[8 * SS + 5]), pk2(v[8 * SS + 6], v[8 * SS + 7]));
}
template <int SH> DEV void to_frag(const Acc64& X, Frag64& F) {
#pragma unroll
  for (int t = 0; t < 2; ++t) {
    if (tile_nz<SH>(0, t)) { F.f[0][t] = pack8<0>(X.t[0][t]); F.f[1][t] = pack8<1>(X.t[0][t]); }
    if (tile_nz<SH>(1, t)) { F.f[2][t] = pack8<0>(X.t[1][t]); F.f[3][t] = pack8<1>(X.t[1][t]); }
  }
}
template <int SH> DEV void zero_acc(Acc64& X) {
#pragma unroll
  for (int a = 0; a < 2; ++a)
#pragma unroll
    for (int b = 0; b < 2; ++b) if (tile_nz<SH>(a, b)) X.t[a][b] = zero16();
}
template <int SHA, int SHB> DEV void prod_ff(const Frag64& A, const Frag64& B, Acc64& D) {
#pragma unroll
  for (int tm = 0; tm < 2; ++tm)
#pragma unroll
    for (int tn = 0; tn < 2; ++tn)
#pragma unroll
      for (int s = 0; s < 4; ++s)
        if (tile_nz<SHA>(s >> 1, tm) && tile_nz<SHB>(s >> 1, tn)) D.t[tm][tn] = mfma32(A.f[s][tm], B.f[s][tn], D.t[tm][tn]);
}
template <int SHA, int SHB, int SHD> DEV void prod_ff_frag(const Frag64& A, const Frag64& B, Frag64& Fo) {
#pragma unroll
  for (int tm = 0; tm < 2; ++tm)
#pragma unroll
    for (int tn = 0; tn < 2; ++tn)
      if (tile_nz<SHD>(tm, tn)) {
        f32x16 acc = zero16();
#pragma unroll
        for (int s = 0; s < 4; ++s)
          if (tile_nz<SHA>(s >> 1, tm) && tile_nz<SHB>(s >> 1, tn)) acc = mfma32(A.f[s][tm], B.f[s][tn], acc);
        Fo.f[2 * tm][tn] = pack8<0>(acc); Fo.f[2 * tm + 1][tn] = pack8<1>(acc);
      }
}
DEV bf16x8 nat_frag(const bf16_t* S, int row, int s, int hh) { return *(const bf16x8*)(S + row * 72 + 16 * s + 8 * hh); }
DEV bf16x8 perm_frag(const bf16_t* S, int row, int s, int hh) {
  const uint2 a = *(const uint2*)(S + row * 72 + 16 * s + 4 * hh), b = *(const uint2*)(S + row * 72 + 16 * s + 8 + 4 * hh);
  return mk8(a.x, a.y, b.x, b.y);
}
template <int SH, int MODE> DEV void gram(const bf16_t* F, const bf16_t* G, int l31, int hh, Acc64& D) {
  zero_acc<SH>(D);
#pragma unroll
  for (int s = 0; s < 4; ++s) {
    bf16x8 ff[2], gg[2];
#pragma unroll
    for (int t = 0; t < 2; ++t) { ff[t] = nat_frag(F, 32 * t + l31, s, hh); gg[t] = nat_frag(G, 32 * t + l31, s, hh); }
#pragma unroll
    for (int tx = 0; tx < 2; ++tx)
#pragma unroll
      for (int ty = 0; ty < 2; ++ty) if (tile_nz<SH>(tx, ty)) D.t[tx][ty] = mfma32(ff[tx], gg[ty], D.t[tx][ty]);
  }
#pragma unroll
  for (int t = 0; t < 2; ++t)
#pragma unroll
    for (int r = 0; r < 16; ++r) {
      const int x = (r & 3) + 8 * (r >> 2) + 4 * hh, y = l31;
      const bool keep = MODE == 0 ? (x < y) : (MODE == 1 ? (y < x) : (x <= y));
      if (!keep) D.t[t][t][r] = 0.f;
    }
}
template <int SHA> DEV void prod_fm_frag(const Frag64& A, const bf16_t* Mem, int l31, int hh, Frag64& Fo) {
#pragma unroll
  for (int tm = 0; tm < 2; ++tm)
#pragma unroll
    for (int tn = 0; tn < 2; ++tn) {
      f32x16 acc = zero16();
#pragma unroll
      for (int s = 0; s < 4; ++s) if (tile_nz<SHA>(s >> 1, tm)) acc = mfma32(A.f[s][tm], perm_frag(Mem, 32 * tn + l31, s, hh), acc);
      Fo.f[2 * tm][tn] = pack8<0>(acc); Fo.f[2 * tm + 1][tn] = pack8<1>(acc);
    }
}
template <int SHA> DEV void prod_fm(const Frag64& A, const bf16_t* Mem, int l31, int hh, Acc64& D) {
#pragma unroll
  for (int s = 0; s < 4; ++s) {
    bf16x8 mm[2];
#pragma unroll
    for (int t = 0; t < 2; ++t) mm[t] = perm_frag(Mem, 32 * t + l31, s, hh);
#pragma unroll
    for (int tm = 0; tm < 2; ++tm)
#pragma unroll
      for (int tn = 0; tn < 2; ++tn) if (tile_nz<SHA>(s >> 1, tm)) D.t[tm][tn] = mfma32(A.f[s][tm], mm[tn], D.t[tm][tn]);
  }
}
DEV void r1_item(const Prm& p, int L, int idx, char* lds) {
  int tid = threadIdx.x; LAUNDER(tid);
  const int w = __builtin_amdgcn_readfirstlane(tid >> 6);
  int lane = tid & 63, l31 = lane & 31, hh = lane >> 5;
  const int cw = w & 1, tw = w >> 1;
  bf16_t* S0 = (bf16_t*)lds;
  bf16_t* S1 = S0 + 4608; bf16_t* S2 = S1 + 4608; bf16_t* S3 = S2 + 4608; bf16_t* S4 = S3 + 4608; bf16_t* S5 = S4 + 4608; bf16_t* S6 = S5 + 4608; bf16_t* S7 = S6 + 4608;
  float* misc = (float*)(S7 + 4608);
  float* Ef = (float*)S4;
  bool prompt; int st, c, hd;
  if (idx < NRW_P) { prompt = true; st = idx / 260; const int rem = idx - st * 260; c = rem >> 2; hd = rem & 3; }
  else { prompt = false; const int j = idx - NRW_P; st = j >> 2; hd = j & 3; c = 0; }
  char* rwp = p.rw + (size_t)idx * RW_BYTES;
  const float* mu = p.shift_mu + L * 896;
  const int i1 = tid >> 2, m0 = (tid & 3) * 16;
  int R1; bool valid1, hasprev1;
  if (prompt) { const int pp = 64 * c - 48 + i1; valid1 = pp >= 0; R1 = st * PT + (valid1 ? pp : 0); hasprev1 = pp >= 1; }
  else { R1 = NPR + 64 * st + i1; valid1 = true; hasprev1 = i1 >= 1; }
  const bf16_t* zr1 = p.zE + (size_t)R1 * ZE + ZE_ZC;
  const int ti0 = 32 * tw + l31;
  int R; bool valid, hasprev;
  if (prompt) { const int pp = 64 * c - 48 + ti0; valid = pp >= 0; R = st * PT + (valid ? pp : 0); hasprev = pp >= 1; }
  else { R = NPR + 64 * st + ti0; valid = true; hasprev = ti0 >= 1; }
  const bf16_t* zr = p.zE + (size_t)R * ZE + ZE_ZC;
  const int chb = 64 * hd + 32 * cw + 4 * hh;
  uint4 la[2][2], lap[2][2]; uint2 lb[3][4], lbp[3][4];
  {
    const bf16_t* sh0 = p.zE + (size_t)(NT + (prompt ? 32 : st)) * ZE + ZE_ZC;
    const bf16_t* zp1 = hasprev1 ? zr1 - ZE : sh0;
    const bf16_t* zp = hasprev ? zr - ZE : sh0;
#pragma unroll
    for (int part = 0; part < 2; ++part)
#pragma unroll
      for (int h8 = 0; h8 < 2; ++h8) { const int col = 768 + 64 * part + m0 + 8 * h8; la[part][h8] = *(const uint4*)(zr1 + col); lap[part][h8] = *(const uint4*)(zp1 + col); }
#pragma unroll
    for (int part = 0; part < 3; ++part)
#pragma unroll
      for (int G = 0; G < 4; ++G) { const int col = 256 * part + chb + 8 * G; lb[part][G] = *(const uint2*)(zr + col); lbp[part][G] = *(const uint2*)(zp + col); }
    const bf16_t* dsrc = p.dw2T + ((size_t)L * 256 + hd * 64 + i1) * 64 + m0;
    const bf16_t* isrc = p.ia2T + ((size_t)L * 256 + hd * 64 + i1) * 64 + m0;
    const uint4 d0 = *(const uint4*)dsrc, d1 = *(const uint4*)(dsrc + 8), e0 = *(const uint4*)isrc, e1 = *(const uint4*)(isrc + 8);
    __builtin_amdgcn_sched_barrier(0);
    *(uint4*)(S2 + i1 * 72 + m0) = d0; *(uint4*)(S2 + i1 * 72 + m0 + 8) = d1;
    *(uint4*)(S3 + i1 * 72 + m0) = e0; *(uint4*)(S3 + i1 * 72 + m0 + 8) = e1;
  }
  {
    float* prm = misc + 384;
#pragma unroll
    for (int q2 = 0; q2 < 2; ++q2) {
      const int ix = tid + 256 * q2, wh = ix >> 6, chp = ix & 63;
      const float* sp = wh == 0 ? p.decay_w0 : wh == 1 ? p.iclr_a0 : wh == 2 ? p.key_kk : wh == 3 ? p.key_ka : wh == 4 ? p.bonus_rk : nullptr;
      prm[ix] = sp ? sp[L * 256 + hd * 64 + chp] : mu[256 * (wh - 5) + 64 * hd + chp];
    }
  }
#pragma unroll
  for (int part = 0; part < 2; ++part) {
#pragma unroll
    for (int h8 = 0; h8 < 2; ++h8) {
      const int col = 768 + 64 * part + m0 + 8 * h8;
      const uint4 u = la[part][h8], v = lap[part][h8];
      const float cur[8] = {bflo(u.x), bfhi(u.x), bflo(u.y), bfhi(u.y), bflo(u.z), bfhi(u.z), bflo(u.w), bfhi(u.w)};
      float prv[8] = {bflo(v.x), bfhi(v.x), bflo(v.y), bfhi(v.y), bflo(v.z), bfhi(v.z), bflo(v.w), bfhi(v.w)};
      float o[8];
#pragma unroll
      for (int e = 0; e < 8; ++e) { float z = cur[e] + (prv[e] - cur[e]) * mu[col + e]; if (!valid1) z = 0.f; o[e] = part == 0 ? (1.f - 2.f / (__expf(2.f * z) + 1.f)) : z; }
      uint4 a; a.x = pk2(o[0], o[1]); a.y = pk2(o[2], o[3]); a.z = pk2(o[4], o[5]); a.w = pk2(o[6], o[7]);
      *(uint4*)((part == 0 ? S0 : S1) + i1 * 72 + m0 + 8 * h8) = a;
    }
  }
  __syncthreads();
  f32x16 accw = zero16(), acca = zero16();
#pragma unroll
  for (int ks = 0; ks < 4; ++ks) {
    const bf16x8 fw = *(const bf16x8*)(S2 + (32 * cw + l31) * 72 + ks * 16 + hh * 8), fa = *(const bf16x8*)(S3 + (32 * cw + l31) * 72 + ks * 16 + hh * 8);
    const bf16x8 sw = *(const bf16x8*)(S0 + (32 * tw + l31) * 72 + ks * 16 + hh * 8), sa = *(const bf16x8*)(S1 + (32 * tw + l31) * 72 + ks * 16 + hh * 8);
    accw = mfma32(fw, sw, accw); acca = mfma32(fa, sa, acca);
  }
  int ti = ti0;
  float e_[16];
  float ssq = 0.f;
#pragma unroll
  for (int G = 0; G < 4; ++G) {
    const int ch = chb + 8 * G, col = 256 + ch;
    const uint2 u = lb[1][G], v = lbp[1][G];
    const float cur[4] = {bflo(u.x), bfhi(u.x), bflo(u.y), bfhi(u.y)};
    float prv[4] = {bflo(v.x), bfhi(v.x), bflo(v.y), bfhi(v.y)};
    const int chq = 32 * cw + 8 * G + 4 * hh;
    const float4 kkw = *(const float4*)(misc + 384 + 128 + chq), w0 = *(const float4*)(misc + 384 + chq), m4 = *(const float4*)(misc + 384 + 384 + chq);
    const float kkv[4] = {kkw.x, kkw.y, kkw.z, kkw.w}, w0v[4] = {w0.x, w0.y, w0.z, w0.w}, muv[4] = {m4.x, m4.y, m4.z, m4.w};
#pragma unroll
    for (int e = 0; e < 4; ++e) {
      float z = cur[e] + (prv[e] - cur[e]) * muv[e];
      if (!valid) z = 0.f;
      const float kkr = z * kkv[e];
      ssq += kkr * kkr;
      e_[4 * G + e] = valid ? 0.6065306597126334f * sigmoid_(w0v[e] + accw[4 * G + e]) : 0.f;
    }
  }
  ssq += __shfl_xor(ssq, 32);
  if (hh == 0) misc[(cw * 64 + ti) * 2] = ssq;
#pragma unroll
  for (int G = 0; G < 4; ++G)
#pragma unroll
    for (int e = 0; e < 4; ++e) Ef[ti * 65 + 32 * cw + 8 * G + 4 * hh + e] = e_[4 * G + e];
  __syncthreads();
  {
    const int ch = tid & 63, seg = tid >> 6;
    float run = 0.f;
#pragma unroll
    for (int t = 0; t < 16; ++t) { run += Ef[(16 * seg + t) * 65 + ch]; Ef[(16 * seg + t) * 65 + ch] = run; }
    __syncthreads();
    float off = 0.f;
    for (int s2 = 0; s2 < seg; ++s2) off += Ef[(16 * s2 + 15) * 65 + ch];
    __syncthreads();
#pragma unroll
    for (int t = 0; t < 16; ++t) Ef[(16 * seg + t) * 65 + ch] += off;
    if (seg == 3) { const float cC = Ef[63 * 65 + ch]; misc[320 + ch] = cC; misc[256 + ch] = __expf(-cC); }
    __syncthreads();
  }
  float cc_[16];
#pragma unroll
  for (int G = 0; G < 4; ++G)
#pragma unroll
    for (int e = 0; e < 4; ++e) cc_[4 * G + e] = Ef[ti * 65 + 32 * cw + 8 * G + 4 * hh + e];
  const float kinv = 1.f / fmaxf(sqrtf(misc[ti * 2] + misc[(64 + ti) * 2]), 1e-12f);
  __syncthreads();
  LAUNDER(ti); LAUNDER(hh);
  uint2 vpk[4];
  float rk = 0.f;
#pragma unroll
  for (int G = 0; G < 4; ++G) {
    const int ch = chb + 8 * G, chl = 32 * cw + 8 * G + 4 * hh;
    float zs[3][4];
#pragma unroll
    for (int part = 0; part < 3; ++part) {
      const int col = 256 * part + ch;
      const uint2 u = lb[part][G], v = lbp[part][G];
      const float cur[4] = {bflo(u.x), bfhi(u.x), bflo(u.y), bfhi(u.y)};
      float prv[4] = {bflo(v.x), bfhi(v.x), bflo(v.y), bfhi(v.y)};
      const float4 m4 = *(const float4*)(misc + 384 + 320 + 64 * part + chl);
      const float muv[4] = {m4.x, m4.y, m4.z, m4.w};
#pragma unroll
      for (int e = 0; e < 4; ++e) { float z = cur[e] + (prv[e] - cur[e]) * muv[e]; zs[part][e] = valid ? z : 0.f; }
    }
    vpk[G] = pk4(zs[2][0], zs[2][1], zs[2][2], zs[2][3]);
    const float4 a04 = *(const float4*)(misc + 384 + 64 + chl), kk4 = *(const float4*)(misc + 384 + 128 + chl), ka4 = *(const float4*)(misc + 384 + 192 + chl), bo4 = *(const float4*)(misc + 384 + 256 + chl);
    const float a0v[4] = {a04.x, a04.y, a04.z, a04.w}, kkv[4] = {kk4.x, kk4.y, kk4.z, kk4.w}, kav[4] = {ka4.x, ka4.y, ka4.z, ka4.w}, bov[4] = {bo4.x, bo4.y, bo4.z, bo4.w};
    float at[4], rt[4], bt[4], kt[4], bh[4], kh[4];
#pragma unroll
    for (int e = 0; e < 4; ++e) {
      const int r = 4 * G + e;
      const float al = sigmoid_(a0v[e] + acca[r]);
      const float kk = zs[1][e] * kkv[e] * kinv;
      const float km = zs[1][e] * (1.f + (al - 1.f) * kav[e]);
      rk += zs[0][e] * km * bov[e];
      const float gC = misc[256 + chl + e];
      const float cprev = cc_[r] - e_[r];
      const float ea = __expf(-cprev), er = __expf(-cc_[r]), ek = __builtin_amdgcn_rcpf(er), eh = ek * gC;
      const float b = kk * al;
      at[e] = -kk * ea; rt[e] = zs[0][e] * er; bt[e] = b * ek; kt[e] = km * ek; bh[e] = b * eh; kh[e] = km * eh;
    }
    *(uint2*)(S0 + ti * 72 + chl) = pk4(at[0], at[1], at[2], at[3]);
    *(uint2*)(S1 + ti * 72 + chl) = pk4(rt[0], rt[1], rt[2], rt[3]);
    *(uint2*)(S2 + ti * 72 + chl) = pk4(bt[0], bt[1], bt[2], bt[3]);
    *(uint2*)(S3 + ti * 72 + chl) = pk4(kt[0], kt[1], kt[2], kt[3]);
#pragma unroll
    for (int e = 0; e < 4; ++e) { S4[(chl + e) * 72 + ti] = f2bf(at[e]); S5[(chl + e) * 72 + ti] = f2bf(bh[e]); S6[(chl + e) * 72 + ti] = f2bf(kh[e]); S7[(chl + e) * 72 + ti] = f2bf(zs[2][e]); }
    *(uint2*)(rwp + 40960 + (ti * 64 + chl) * 2) = vpk[G];
  }
  rk += __shfl_xor(rk, 32);
  if (hh == 0) misc[(cw * 64 + ti) * 2 + 1] = rk;
  __syncthreads();
  if (valid && cw == 0 && hh == 0) p.rkb[(size_t)R * 4 + hd] = misc[ti * 2 + 1] + misc[(64 + ti) * 2 + 1];
  LAUNDER(l31); LAUNDER(hh); LAUNDER(lane);
  {
    Acc64 T;
    {
      Acc64 Mx, MTx;
      gram<SH_UP, 0>(S2, S0, l31, hh, Mx);
      gram<SH_LO, 1>(S0, S2, l31, hh, MTx);
      Frag64 fM, fMT, fT;
      to_frag<SH_UP>(Mx, fM); to_frag<SH_LO>(MTx, fMT);
      __builtin_amdgcn_sched_barrier(0);
      T = Mx;
#pragma unroll
      for (int t = 0; t < 2; ++t)
#pragma unroll
        for (int r = 0; r < 16; ++r) if ((r & 3) + 8 * (r >> 2) + 4 * hh == l31) T.t[t][t][r] += 1.f;
      T.t[1][0] = zero16();
      for (int r = 0; r < 5; ++r) {
        Frag64 fM2, fMT2;
        prod_ff_frag<SH_LO, SH_UP, SH_UP>(fMT, fM, fM2);
        prod_ff_frag<SH_UP, SH_LO, SH_LO>(fM, fMT, fMT2);
#pragma unroll
        for (int s = 0; s < 4; ++s)
#pragma unroll
          for (int t = 0; t < 2; ++t) { if (tile_nz<SH_UP>(s >> 1, t)) fM.f[s][t] = fM2.f[s][t]; if (tile_nz<SH_LO>(s >> 1, t)) fMT.f[s][t] = fMT2.f[s][t]; }
        to_frag<SH_UP>(T, fT);
        prod_ff<SH_LO, SH_UP>(fMT, fT, T);
      }
    }
    Frag64 fT;
    to_frag<SH_UP>(T, fT);
    __builtin_amdgcn_sched_barrier(0);
    if (w < 2) {
      Frag64 fW;
      prod_fm_frag<SH_UP>(fT, S4, l31, hh, fW);
      __builtin_amdgcn_sched_barrier(0);
      Acc64 O; zero_acc<SH_FULL>(O);
      if (w == 0) {
        prod_fm<SH_FULL>(fW, S5, l31, hh, O);
#pragma unroll
        for (int tx = 0; tx < 2; ++tx)
#pragma unroll
          for (int ty = 0; ty < 2; ++ty)
#pragma unroll
            for (int G = 0; G < 4; ++G) {
              const int x0 = 32 * tx + 8 * G + 4 * hh, y = 32 * ty + l31;
              float v[4];
#pragma unroll
              for (int e = 0; e < 4; ++e) { v[e] = O.t[tx][ty][4 * G + e]; if (x0 + e == y) v[e] += misc[256 + y]; }
              *(uint2*)(rwp + 0 + kperm_addr(y, x0) * 2) = pk4(v[0], v[1], v[2], v[3]);
            }
      } else {
        Acc64 Nb; gram<SH_UP, 2>(S2, S1, l31, hh, Nb);
        Frag64 fN; to_frag<SH_UP>(Nb, fN);
        prod_ff<SH_FULL, SH_UP>(fW, fN, O);
#pragma unroll
        for (int tx = 0; tx < 2; ++tx)
#pragma unroll
          for (int ty = 0; ty < 2; ++ty)
#pragma unroll
            for (int G = 0; G < 4; ++G) {
              const int x0 = 32 * tx + 8 * G + 4 * hh, y = 32 * ty + l31;
              const uint2 rr = *(const uint2*)(S1 + y * 72 + x0);
              *(uint2*)(rwp + 8192 + kperm_addr(y, x0) * 2) = pk4(O.t[tx][ty][4 * G] + bflo(rr.x), O.t[tx][ty][4 * G + 1] + bfhi(rr.x), O.t[tx][ty][4 * G + 2] + bflo(rr.y), O.t[tx][ty][4 * G + 3] + bfhi(rr.y));
            }
      }
    } else {
      Frag64 fX;
      {
        Acc64 Nk; gram<SH_LO, 1>(S0, S3, l31, hh, Nk);
        Frag64 fNk; to_frag<SH_LO>(Nk, fNk);
        prod_ff_frag<SH_UP, SH_LO, SH_LO>(fT, fNk, fX);
      }
      __builtin_amdgcn_sched_barrier(0);
      if (w == 2) {
        Acc64 Z; zero_acc<SH_FULL>(Z);
        prod_fm<SH_LO>(fX, S5, l31, hh, Z);
#pragma unroll
        for (int tx = 0; tx < 2; ++tx)
#pragma unroll
          for (int ty = 0; ty < 2; ++ty)
#pragma unroll
            for (int G = 0; G < 4; ++G) {
              const int x0 = 32 * tx + 8 * G + 4 * hh, y = 32 * ty + l31;
              const uint2 kk2 = *(const uint2*)(S6 + y * 72 + x0);
              Z.t[tx][ty][4 * G] += bflo(kk2.x); Z.t[tx][ty][4 * G + 1] += bfhi(kk2.x); Z.t[tx][ty][4 * G + 2] += bflo(kk2.y); Z.t[tx][ty][4 * G + 3] += bfhi(kk2.y);
            }
        Frag64 fZ; to_frag<SH_FULL>(Z, fZ);
        __builtin_amdgcn_sched_barrier(0);
        Acc64 Q; zero_acc<SH_FULL>(Q);
        prod_fm<SH_FULL>(fZ, S7, l31, hh, Q);
#pragma unroll
        for (int tx = 0; tx < 2; ++tx)
#pragma unroll
          for (int ty = 0; ty < 2; ++ty)
#pragma unroll
            for (int G = 0; G < 4; ++G)
              *(uint2*)(rwp + 16384 + clay_addr(32 * tx + 8 * G + 4 * hh, 32 * ty + l31) * 2) = pk4(Q.t[tx][ty][4 * G], Q.t[tx][ty][4 * G + 1], Q.t[tx][ty][4 * G + 2], Q.t[tx][ty][4 * G + 3]);
      } else {
        Acc64 H; gram<SH_UP, 2>(S3, S1, l31, hh, H);
        {
          Acc64 Nb; gram<SH_UP, 2>(S2, S1, l31, hh, Nb);
          Frag64 fN; to_frag<SH_UP>(Nb, fN);
          prod_ff<SH_LO, SH_UP>(fX, fN, H);
        }
        Frag64 fH; to_frag<SH_UP>(H, fH);
        __builtin_amdgcn_sched_barrier(0);
        Acc64 Y; zero_acc<SH_FULL>(Y);
        prod_fm<SH_UP>(fH, S7, l31, hh, Y);
#pragma unroll
        for (int tx = 0; tx < 2; ++tx)
#pragma unroll
          for (int ty = 0; ty < 2; ++ty)
#pragma unroll
            for (int G = 0; G < 4; ++G)
              *(uint2*)(rwp + 24576 + clay_addr(32 * tx + 8 * G + 4 * hh, 32 * ty + l31) * 2) = pk4(Y.t[tx][ty][4 * G], Y.t[tx][ty][4 * G + 1], Y.t[tx][ty][4 * G + 2], Y.t[tx][ty][4 * G + 3]);
      }
    }
  }
  __syncthreads();
}

DEV void r2_wave(const Prm& p, int L, int wi, int lane) {
  bool prompt; int st, hd, vt;
  if (wi < 64) { prompt = true; st = wi >> 4; hd = (wi >> 2) & 3; vt = wi & 3; }
  else { prompt = false; const int j = wi - 64; st = j >> 4; hd = (j >> 2) & 3; vt = j & 3; }
  const int nch = prompt ? 65 : 1;
  const int idx0 = prompt ? st * 260 + hd : NRW_P + st * 4 + hd;
  const int l16 = lane & 15, g = lane >> 4;
  f32x4 acc[4];
  float* outp;
  if (prompt) {
#pragma unroll
    for (int mt = 0; mt < 4; ++mt) acc[mt] = (f32x4){0.f, 0.f, 0.f, 0.f};
    outp = p.wkv_p + ((((size_t)L * 4 + st) * 4 + hd) * 64 + 16 * vt + l16) * 64;
  } else {
    const float* sp = p.state_wkv + ((((size_t)L * 32 + st) * 4 + hd) * 64 + 16 * vt + l16) * 64;
#pragma unroll
    for (int mt = 0; mt < 4; ++mt) acc[mt] = *(const f32x4*)(sp + 16 * mt + 4 * g);
    outp = p.wkv_s + ((((size_t)L * 32 + st) * 4 + hd) * 64 + 16 * vt + l16) * 64;
  }
  const char* rw0 = p.rw + (size_t)idx0 * RW_BYTES;
  uint4 pf[3][8]; uint2 qv[3][4];
#pragma unroll
  for (int k = 0; k < 3; ++k) {
    const int cc = k < nch ? k : nch - 1;
    const char* src = rw0 + (size_t)cc * 4 * RW_BYTES;
#pragma unroll
    for (int i = 0; i < 8; ++i) pf[k][i] = *(const uint4*)(src + (i * 64 + lane) * 16);
#pragma unroll
    for (int mt = 0; mt < 4; ++mt) qv[k][mt] = *(const uint2*)(src + 16384 + ((mt * 4 + vt) * 64 + lane) * 8);
  }
  for (int c0 = 0; c0 < nch; c0 += 3) {
#pragma unroll
    for (int k = 0; k < 3; ++k) {
      const int c = c0 + k;
      if (c < nch) {
        char* cur = (char*)rw0 + (size_t)c * 4 * RW_BYTES;
        uint4 bfr[2];
#pragma unroll
        for (int s = 0; s < 2; ++s) {
          bfr[s].x = pk2(acc[2 * s][0], acc[2 * s][1]); bfr[s].y = pk2(acc[2 * s][2], acc[2 * s][3]);
          bfr[s].z = pk2(acc[2 * s + 1][0], acc[2 * s + 1][1]); bfr[s].w = pk2(acc[2 * s + 1][2], acc[2 * s + 1][3]);
          *(uint4*)(cur + 32768 + ((vt * 2 + s) * 64 + lane) * 16) = bfr[s];
        }
#pragma unroll
        for (int mt = 0; mt < 4; ++mt) {
          f32x4 a = {bflo(qv[k][mt].x), bfhi(qv[k][mt].x), bflo(qv[k][mt].y), bfhi(qv[k][mt].y)};
#pragma unroll
          for (int s = 0; s < 2; ++s) a = mfma16(mk8(pf[k][mt * 2 + s]), mk8(bfr[s]), a);
          acc[mt] = a;
        }
        const int cn = c + 3 < nch ? c + 3 : nch - 1;
        const char* src = rw0 + (size_t)cn * 4 * RW_BYTES;
#pragma unroll
        for (int i = 0; i < 8; ++i) pf[k][i] = *(const uint4*)(src + (i * 64 + lane) * 16);
#pragma unroll
        for (int mt = 0; mt < 4; ++mt) qv[k][mt] = *(const uint2*)(src + 16384 + ((mt * 4 + vt) * 64 + lane) * 8);
      }
    }
  }
#pragma unroll
  for (int mt = 0; mt < 4; ++mt) *(f32x4*)(outp + 16 * mt + 4 * g) = acc[mt];
}

DEV void r3_wave(const Prm& p, int L, int idx, int lane, float* Y  ) {
  LAUNDER(lane);
  bool prompt; int st, c, hd;
  if (idx < NRW_P) { prompt = true; st = idx / 260; const int rem = idx - st * 260; c = rem >> 2; hd = rem & 3; }
  else { prompt = false; const int j = idx - NRW_P; st = j >> 2; hd = j & 3; c = 0; }
  const char* rwp = p.rw + (size_t)idx * RW_BYTES;
  const int l16 = lane & 15, g = lane >> 4;
  bf16_t* mix = p.zE;
  uint4 sf[4][2], gf[4][2]; uint2 qv[4][4];
#pragma unroll
  for (int vt = 0; vt < 4; ++vt)
#pragma unroll
    for (int s = 0; s < 2; ++s) sf[vt][s] = *(const uint4*)(rwp + 32768 + ((vt * 2 + s) * 64 + lane) * 16);
#pragma unroll
  for (int it = 0; it < 4; ++it) {
    gf[it][0] = *(const uint4*)(rwp + 8192 + ((it * 2 + 0) * 64 + lane) * 16); gf[it][1] = *(const uint4*)(rwp + 8192 + ((it * 2 + 1) * 64 + lane) * 16);
#pragma unroll
    for (int vt = 0; vt < 4; ++vt) qv[it][vt] = *(const uint2*)(rwp + 24576 + ((it * 4 + vt) * 64 + lane) * 8);
  }
  const float lw[4] = {p.lnx_w[L * 256 + hd * 64 + l16], p.lnx_w[L * 256 + hd * 64 + 16 + l16], p.lnx_w[L * 256 + hd * 64 + 32 + l16], p.lnx_w[L * 256 + hd * 64 + 48 + l16]};
  const float lb[4] = {p.lnx_b[L * 256 + hd * 64 + l16], p.lnx_b[L * 256 + hd * 64 + 16 + l16], p.lnx_b[L * 256 + hd * 64 + 32 + l16], p.lnx_b[L * 256 + hd * 64 + 48 + l16]};
  const int vc = (lane & 7) * 8;
  float rkv[8]; uint4 vvv[8], gcv[8];
#pragma unroll
  for (int ps = 0; ps < 8; ++ps) {
    const int i = 8 * ps + (lane >> 3);
    int R;
    if (prompt) { const int pp = 64 * c - 48 + i; R = st * PT + (pp >= 0 ? pp : 0); }
    else R = NPR + 64 * st + i;
    rkv[ps] = p.rkb[(size_t)R * 4 + hd];
    vvv[ps] = *(const uint4*)(rwp + 40960 + (i * 64 + vc) * 2);
    gcv[ps] = *(const uint4*)(p.zL + (size_t)R * ZL + ZL_GC + hd * 64 + vc);
  }
  __builtin_amdgcn_sched_barrier(0);
#pragma unroll
  for (int it = 0; it < 4; ++it) {
    f32x4 y[4];
#pragma unroll
    for (int vt = 0; vt < 4; ++vt) {
      const uint2 q = qv[it][vt];
      f32x4 a = {bflo(q.x), bfhi(q.x), bflo(q.y), bfhi(q.y)};
      a = mfma16(mk8(gf[it][0]), mk8(sf[vt][0]), a);
      a = mfma16(mk8(gf[it][1]), mk8(sf[vt][1]), a);
      y[vt] = a;
    }
#pragma unroll
    for (int rr = 0; rr < 4; ++rr) {
      const int i = 16 * it + 4 * g + rr;
      float s1 = y[0][rr] + y[1][rr] + y[2][rr] + y[3][rr];
      s1 += __shfl_xor(s1, 1); s1 += __shfl_xor(s1, 2); s1 += __shfl_xor(s1, 4); s1 += __shfl_xor(s1, 8);
      const float mean = s1 * (1.f / 64.f);
      const float d0 = y[0][rr] - mean, d1 = y[1][rr] - mean, d2 = y[2][rr] - mean, d3 = y[3][rr] - mean;
      float s2 = d0 * d0 + d1 * d1 + d2 * d2 + d3 * d3;
      s2 += __shfl_xor(s2, 1); s2 += __shfl_xor(s2, 2); s2 += __shfl_xor(s2, 4); s2 += __shfl_xor(s2, 8);
      const float rstd = rsqrtf(s2 * (1.f / 64.f) + GN_EPS);
      Y[i * 68 + l16] = d0 * rstd * lw[0] + lb[0];
      Y[i * 68 + 16 + l16] = d1 * rstd * lw[1] + lb[1];
      Y[i * 68 + 32 + l16] = d2 * rstd * lw[2] + lb[2];
      Y[i * 68 + 48 + l16] = d3 * rstd * lw[3] + lb[3];
    }
  }
  asm volatile("s_waitcnt lgkmcnt(0)" ::: "memory");
  __builtin_amdgcn_wave_barrier();
#pragma unroll
  for (int ps = 0; ps < 8; ++ps) {
    const int i = 8 * ps + (lane >> 3);
    int R; bool valid;
    if (prompt) { const int pp = 64 * c - 48 + i; valid = pp >= 0; R = st * PT + (valid ? pp : 0); }
    else { R = NPR + 64 * st + i; valid = true; }
    if (valid) {
      const float4 y0 = *(const float4*)(Y + i * 68 + vc), y1 = *(const float4*)(Y + i * 68 + vc + 4);
      const float rkbv = rkv[ps];
      const uint4 vv = vvv[ps];
      const uint4 gc = gcv[ps];
      uint4 o;
      o.x = pk2((y0.x + rkbv * bflo(vv.x)) * silu_(bflo(gc.x)), (y0.y + rkbv * bfhi(vv.x)) * silu_(bfhi(gc.x)));
      o.y = pk2((y0.z + rkbv * bflo(vv.y)) * silu_(bflo(gc.y)), (y0.w + rkbv * bfhi(vv.y)) * silu_(bfhi(gc.y)));
      o.z = pk2((y1.x + rkbv * bflo(vv.z)) * silu_(bflo(gc.z)), (y1.y + rkbv * bfhi(vv.z)) * silu_(bfhi(gc.z)));
      o.w = pk2((y1.z + rkbv * bflo(vv.w)) * silu_(bflo(gc.w)), (y1.w + rkbv * bfhi(vv.w)) * silu_(bfhi(gc.w)));
      *(uint4*)(mix + (size_t)R * D + 768 + hd * 64 + vc) = o;
    }
  }
  asm volatile("s_waitcnt lgkmcnt(0)" ::: "memory");
  __builtin_amdgcn_wave_barrier();
}

DEV void final_norm(const Prm& p) {
  int tid_ = threadIdx.x; LAUNDER(tid_);
  const int lane = tid_ & 63, gw = blockIdx.x * 4 + (tid_ >> 6), NW = gridDim.x * 4;
  for (int R = gw; R < NT; R += NW) {
    if (R < NPR && (R % PT) < 16) continue;
    float* yr = xrow_ptr(p, R);
    const bf16_t* xr = p.xb + (size_t)R * D;
    const float rstd = rsqrtf(p.ssq_x[2 * NTP + R] * (1.f / 1024.f) + RMS_EPS);
#pragma unroll
    for (int j = 0; j < 2; ++j) {
      const uint4 u = ((const uint4*)xr)[lane + 64 * j];
      const float4 g0 = ((const float4*)p.final_g)[2 * (lane + 64 * j)], g1 = ((const float4*)p.final_g)[2 * (lane + 64 * j) + 1];
      float4 o0, o1;
      o0.x = bflo(u.x) * rstd * g0.x; o0.y = bfhi(u.x) * rstd * g0.y; o0.z = bflo(u.y) * rstd * g0.z; o0.w = bfhi(u.y) * rstd * g0.w;
      o1.x = bflo(u.z) * rstd * g1.x; o1.y = bfhi(u.z) * rstd * g1.y; o1.z = bflo(u.w) * rstd * g1.z; o1.w = bfhi(u.w) * rstd * g1.w;
      ((float4*)yr)[2 * (lane + 64 * j)] = o0; ((float4*)yr)[2 * (lane + 64 * j) + 1] = o1;
    }
  }
}

#define XB_TMO      128
#define XB_XCNT(j)  (256  + 64 * (j))
#define XB_XSUB(j)  (1280 + 64 * (j))
#define XB_XGEN(j)  (2304 + 64 * (j))
#define XB_TOP      3328
#define XB_TOPGEN   3392
#define XCD_BAR_WORDS 3456
#define XB_SPIN_CAP (1u << 20)
#define LAS __attribute__((address_space(3)))
DEV unsigned xb_ld(unsigned* p) { return __hip_atomic_load(p, __ATOMIC_RELAXED, __HIP_MEMORY_SCOPE_AGENT); }
DEV unsigned xb_add(unsigned* p, unsigned v) { return __hip_atomic_fetch_add(p, v, __ATOMIC_RELAXED, __HIP_MEMORY_SCOPE_AGENT); }
DEV unsigned xb_xcc_id() { return (unsigned)__builtin_amdgcn_s_getreg((3 << 11) | 20) & 0xFu; }
#define XB_SPIN(cond, bar) do { unsigned _sp = 0; while (cond) { __builtin_amdgcn_s_sleep(1); \
    if ((++_sp & 255u) == 0u) { if (xb_ld(&(bar)[XB_TMO])) break; if (_sp > XB_SPIN_CAP) { atomicAdd(&(bar)[XB_TMO], 1u); break; } } } } while (0)
struct XcdBarrier { unsigned* bar; unsigned x; volatile LAS unsigned* st; };
DEV XcdBarrier xcd_barrier_post(unsigned* bar, volatile LAS unsigned* st) {
  XcdBarrier b; b.bar = bar; b.x = xb_xcc_id(); b.st = st;
  if (threadIdx.x == 0) (void)xb_add(&bar[XB_XCNT(b.x)], 1u);
  return b;
}
DEV void xcd_barrier_complete(unsigned* bar, unsigned x, unsigned& nloc, unsigned& nx) {
  const unsigned G = gridDim.x * gridDim.y * gridDim.z;
  unsigned sum, cnt, mine, sp = 0u;
  for (;;) {
    sum = 0u; cnt = 0u; mine = 0u;
#pragma unroll
    for (unsigned j = 0; j < 16; ++j) { const unsigned c = xb_ld(&bar[XB_XCNT(j)]); sum += c; cnt += (c > 0u) ? 1u : 0u; mine = (j == x) ? c : mine; }
    if (sum == G) break;
    __builtin_amdgcn_s_sleep(1);
    if ((++sp & 255u) == 0u) { if (xb_ld(&bar[XB_TMO])) break; if (sp > XB_SPIN_CAP) { atomicAdd(&bar[XB_TMO], 1u); break; } }
  }
  nloc = mine > 0u ? mine : 1u; nx = cnt > 0u ? cnt : 1u;
}
DEV void xcd_barrier(const XcdBarrier& b) {
  asm volatile("s_waitcnt vmcnt(0)" ::: "memory");
  __syncthreads();
  if (threadIdx.x == 0) {
    unsigned* bar = b.bar;
    __builtin_amdgcn_s_waitcnt(0);
    unsigned nloc = b.st[0], nx = b.st[1];
    if (nloc == 0u) { xcd_barrier_complete(bar, b.x, nloc, nx); b.st[0] = nloc; b.st[1] = nx; }
    const unsigned old = xb_add(&bar[XB_XSUB(b.x)], 1u);
    const unsigned gen = old / nloc;
    if (old + 1u == (gen + 1u) * nloc) {
      __builtin_amdgcn_fence(__ATOMIC_RELEASE, "agent");
      asm volatile("s_waitcnt vmcnt(0)" ::: "memory");
      const unsigned og = xb_add(&bar[XB_TOP], 1u);
      const unsigned tg = og / nx;
      if (og + 1u == (tg + 1u) * nx) xb_add(&bar[XB_TOPGEN], 1u);
      else XB_SPIN(xb_ld(&bar[XB_TOPGEN]) == tg, bar);
      __builtin_amdgcn_fence(__ATOMIC_ACQUIRE, "agent");
      xb_add(&bar[XB_XGEN(b.x)], 1u);
      asm volatile("s_waitcnt vmcnt(0)" ::: "memory");
    } else {
      XB_SPIN(xb_ld(&bar[XB_XGEN(b.x)]) == gen, bar);
      __builtin_amdgcn_fence(__ATOMIC_ACQUIRE, "agent");
      asm volatile("s_waitcnt vmcnt(0)" ::: "memory");
    }
  }
  __syncthreads();
}

#define QCTR(ph, L) (3584 + 64 * (2 * (ph) + (L)))
#define R2DONE(L) (3520 + 16 * (L))
DEV int next_item(unsigned* ctr, char* lds) {
  volatile int* slot = (volatile int*)(lds + LDS_BYTES - 8);
  __syncthreads();
  if (threadIdx.x == 0) *slot = (int)atomicAdd(ctr, 1u);
  __syncthreads();
  return *slot;
}
#define QXC(ph, L, x) (4096 + (((ph) * 2 + (L)) * 8 + (x)) * 16)
DEV int xq_next(unsigned* ctl, int ph, int L, int C, int N, int& k, int home, char* lds) {
  volatile int* slot = (volatile int*)(lds + LDS_BYTES - 8);
  __syncthreads();
  if (threadIdx.x == 0) {
    int res = -1, kk = k;
    while (kk < 8) {
      const int x = (home + kk) & 7, base = x * C;
      int size = N - base; size = size < C ? size : C;
      if (size > 0) { const int idx = (int)atomicAdd(ctl + QXC(ph, L, x), 1u); if (idx < size) { res = base + idx; break; } }
      ++kk;
    }
    slot[0] = res; slot[1] = kk;
  }
  __syncthreads();
  k = slot[1];
  return slot[0];
}
DEV int q_publish(int ticket, char* lds) {
  volatile int* slot = (volatile int*)(lds + LDS_BYTES - 8);
  __syncthreads();
  if (threadIdx.x == 0) *slot = ticket;
  __syncthreads();
  return *slot;
}
DEV int xq_resolve(unsigned* ctl, int ph, int L, int C, int N, int& k, int home, int ticket, char* lds) {
  volatile int* slot = (volatile int*)(lds + LDS_BYTES - 8);
  __syncthreads();
  if (threadIdx.x == 0) {
    int res = -1, kk = k;
    if (kk < 8) {
      const int x = (home + kk) & 7, base = x * C;
      int size = N - base; size = size < C ? size : C;
      if (ticket < size) res = base + ticket;
      else {
        ++kk;
        while (kk < 8) {
          const int x2 = (home + kk) & 7, base2 = x2 * C;
          int size2 = N - base2; size2 = size2 < C ? size2 : C;
          if (size2 > 0) { const int idx = (int)atomicAdd(ctl + QXC(ph, L, x2), 1u); if (idx < size2) { res = base2 + idx; break; } }
          ++kk;
        }
      }
    }
    slot[0] = res; slot[1] = kk;
  }
  __syncthreads();
  k = slot[1];
  return slot[0];
}
DEV unsigned* xq_ctr(unsigned* ctl, int ph, int L, int k, int home) { return k < 8 ? ctl + QXC(ph, L, (home + k) & 7) : nullptr; }
DEV int take_ticket(unsigned* nctr) { int tk = 0x7fffffff; if (nctr && threadIdx.x == 0) tk = (int)atomicAdd(nctr, 1u); return tk; }
struct XQueue {
  unsigned* ctl; int ph, L, C, N, k, home, t;
  DEV void prefetch() { t = take_ticket(xq_ctr(ctl, ph, L, k, home)); }
  DEV int resolve(char* lds) { return xq_resolve(ctl, ph, L, C, N, k, home, t, lds); }
};
template <class Epi, class Map>
DEV void gemm_stream(const bf16_t* __restrict__ A, int lda, const bf16_t* __restrict__ Bt, int ldb, int K, char* lds, const Epi& epi, XQueue& q) {
  int tid = threadIdx.x; LAUNDER(tid);
  const int lane = tid & 63, w = __builtin_amdgcn_readfirstlane(tid >> 6), wr = w >> 1, wc = w & 1;
  const int fr = lane & 15, fq = lane >> 4;
  const int sb = lane * 16, swz = sb ^ (((sb >> 9) & 1) << 5), rl = swz >> 6, cl = (swz & 63) >> 1;
  const int nk = K / 64;
  int offA[2], offB[2];
#pragma unroll
  for (int kh = 0; kh < 2; ++kh) { offA[kh] = lds_byte(wr * 64 + fr, kh * 32 + fq * 8); offB[kh] = lds_byte(wc * 64 + fr, kh * 32 + fq * 8); }
  q.prefetch();
  int item = q.resolve(lds);
  if (item < 0) return;
  int m0, n0; Map::map(item, m0, n0);
  const bf16_t* ga[4]; const bf16_t* gb[4];
#define SETPTR(M0, N0) { _Pragma("unroll") for (int i = 0; i < 4; ++i) { const int st = 4 * w + i, r = (st >> 1) * 16 + rl, c = (st & 1) * 32 + cl; \
      ga[i] = A + (size_t)((M0) + r) * lda + c; gb[i] = Bt + (size_t)((N0) + r) * ldb + c; } }
#define GSTAGE(S, KT) { _Pragma("unroll") for (int i = 0; i < 4; ++i) { \
      __builtin_amdgcn_global_load_lds((const unsigned*)(ga[i] + (KT) * 64), (LAS3 unsigned*)(lds + (S) * 32768 + (4 * w + i) * 1024 + lane * 16), 16, 0, 0); \
      __builtin_amdgcn_global_load_lds((const unsigned*)(gb[i] + (KT) * 64), (LAS3 unsigned*)(lds + (S) * 32768 + 16384 + (4 * w + i) * 1024 + lane * 16), 16, 0, 0); } }
  SETPTR(m0, n0)
  GSTAGE(0, 0)
  GSTAGE(1, 1)
  for (;;) {
    f32x4 acc[4][4];
#pragma unroll
    for (int i = 0; i < 4; ++i)
#pragma unroll
      for (int j = 0; j < 4; ++j) acc[i][j] = (f32x4){0.f, 0.f, 0.f, 0.f};
    for (int kt = 0; kt < nk; ++kt) {
      const int s = kt & 1;
      if (kt + 1 < nk) asm volatile("s_waitcnt vmcnt(8)" ::: "memory"); else asm volatile("s_waitcnt vmcnt(0)" ::: "memory");
      RAW_BARRIER()
      const char* ia = lds + s * 32768;
      const char* ib = ia + 16384;
      bf16x8 af[2][4], bfv[2][4];
#pragma unroll
      for (int kh = 0; kh < 2; ++kh) {
#pragma unroll
        for (int mi = 0; mi < 4; ++mi) af[kh][mi] = *(const bf16x8*)(ia + offA[kh] + mi * 2048);
#pragma unroll
        for (int ni = 0; ni < 4; ++ni) bfv[kh][ni] = *(const bf16x8*)(ib + offB[kh] + ni * 2048);
      }
      asm volatile("s_waitcnt lgkmcnt(8)" ::: "memory");
      __builtin_amdgcn_sched_barrier(0);
#pragma unroll
      for (int mi = 0; mi < 4; ++mi)
#pragma unroll
        for (int ni = 0; ni < 4; ++ni) acc[mi][ni] = mfma16(bfv[0][ni], af[0][mi], acc[mi][ni]);
      __builtin_amdgcn_sched_barrier(0);
      asm volatile("s_waitcnt lgkmcnt(0)" ::: "memory");
      RAW_BARRIER()
      if (kt + 2 < nk) GSTAGE(s, kt + 2)
      if (kt == nk - 3) q.prefetch();
      __builtin_amdgcn_sched_barrier(0);
#pragma unroll
      for (int mi = 0; mi < 4; ++mi)
#pragma unroll
        for (int ni = 0; ni < 4; ++ni) acc[mi][ni] = mfma16(bfv[1][ni], af[1][mi], acc[mi][ni]);
    }
    const int nxt = q.resolve(lds);
    const typename Epi::Pre pre = epi.preload(m0 + wr * 64, n0 + wc * 64, fr, fq);
    __builtin_amdgcn_sched_barrier(0);
    int m1 = 0, n1 = 0;
    if (nxt >= 0) { Map::map(nxt, m1, n1); SETPTR(m1, n1) GSTAGE(0, 0) GSTAGE(1, 1) }
    __builtin_amdgcn_sched_barrier(0);
    epi.finish(acc, pre, m0 + wr * 64, n0 + wc * 64, fr, fq);
    if (nxt < 0) break;
    m0 = m1; n0 = n1;
  }
#undef GSTAGE
#undef SETPTR
}
struct MapP1 { static DEV void map(int i, int& m0, int& n0) { int mt, nt; if (i < 18 * 192) { const int b = i / 192, r = i - b * 192; nt = r >> 3; mt = 8 * b + (r & 7); } else { nt = i - 18 * 192; mt = 144; } m0 = mt * 128; n0 = nt * 128; } };
struct MapP4 { static DEV void map(int i, int& m0, int& n0) { m0 = (i >> 3) * 128; n0 = (i & 7) * 128; } };
DEV void shift_rows_item(const Prm& p, int L, int b) {
  int tid0 = threadIdx.x; LAUNDER(tid0);
  if (tid0 < 224) {
    float4 v = make_float4(0.f, 0.f, 0.f, 0.f);
    if (b < 32) v = *(const float4*)(p.state_shift + ((size_t)L * 32 + b) * 896 + 4 * tid0);
    *(uint2*)(p.zE + (size_t)(NT + b) * ZE + ZE_ZC + 4 * tid0) = pk4(v.x, v.y, v.z, v.w);
  }
}
constexpr int N_ATT = 1312;
DEV void run_p1(const Prm& p, int L, char* lds) {
  const EpiIn epi{p, L};
  const int home = (int)(xb_xcc_id() & 7u);
  constexpr int N = 145 * 24, C = (N + 7) / 8;
  {
    XQueue q{p.ctl, 0, L, C, N, 0, home, 0};
    gemm_stream<EpiIn, MapP1>(p.xb, D, p.Wb_in + (size_t)L * INP * 1024, 1024, 1024, lds, epi, q);
  }
  unsigned* ctr = p.ctl + QCTR(3, L);
  int t = take_ticket(ctr);
  for (;;) {
    const int mt = q_publish(t, lds);
    if (mt >= 145 + 33) break;
    if (mt >= 145) { t = take_ticket(ctr); shift_rows_item(p, L, mt - 145); continue; }
    t = gemm_tile<EpiIn, 2>(p.xb, D, p.Wb_in + (size_t)L * INP * 1024, 1024, 1024, mt * 128, 24 * 128, lds, epi, ctr);
  }
}
DEV void run_p2(const Prm& p, int L, char* lds) {
  const EpiQ epq{p, L};
  constexpr int N1 = NRW, N2 = N1 + 129, N3 = N2 + 145 * 6, N4 = N3 + 16, N4b = N4 + 512, N5 = N4b + 36;
  const int N6 = L == 0 ? N5 + NWT : N5;
  unsigned* ctr = p.ctl + QCTR(0, L);
  for (;;) {
    const int id = next_item(ctr, lds);
    if (id >= N6) break;
    if (id >= N5) { conv_weights_item(p, 1, id - N5, lds); continue; }
    if (id < N1) r1_item(p, L, id, lds);
    else if (id < N2) kvproj_item(p, L, id - N1, lds);
    else if (id < N3) { const int t = id - N2, mt = t / 6, nt = t - mt * 6; gemm_tile(p.zE + ZE_CQ, ZE, p.Wb_uq + (size_t)L * 768 * 256, 256, 256, mt * 128, nt * 128, lds, epq); }
    else if (id < N4) sample_prep_item(p, L, id - N3);
    else if (id < N4b) lat_item(p, L, id - N4);
    else shift_item(p, L, id - N4b);
  }
}
DEV void run_p3(const Prm& p, int L, char* lds) {
  int tid_ = threadIdx.x; LAUNDER(tid_);
  const int lane = tid_ & 63, w = __builtin_amdgcn_readfirstlane(tid_ >> 6);
  {
    int ndone = 0;
    for (int wi = blockIdx.x * 4 + w; wi < 576; wi += gridDim.x * 4) { r2_wave(p, L, wi, lane); ++ndone; }
    if (blockIdx.x * 4 < 576) {
      asm volatile("s_waitcnt vmcnt(0)" ::: "memory");
      __syncthreads();
      if (threadIdx.x == 0) {
        int tot = 0;
        for (int wi = blockIdx.x * 4; wi < 576; wi += gridDim.x * 4) tot += (576 - wi) < 4 ? (576 - wi) : 4;
        __builtin_amdgcn_fence(__ATOMIC_RELEASE, "agent");
        asm volatile("s_waitcnt vmcnt(0)" ::: "memory");
        __hip_atomic_fetch_add(p.ctl + R2DONE(L), (unsigned)tot, __ATOMIC_RELAXED, __HIP_MEMORY_SCOPE_AGENT);
      }
    }
    (void)ndone;
  }
  unsigned* ctr = p.ctl + QCTR(1, L);
  for (;;) {
    const int q = next_item(ctr, lds);
    if (q >= 128) break;
    attn_sample(p, L, q >> 2, q & 3, lds);
  }
  {
    const int home = (int)(xb_xcc_id() & 7u);
    int k = 0;
    int tx = take_ticket(xq_ctr(p.ctl, 2, L, k, home));
    for (;;) {
      const int i = xq_resolve(p.ctl, 2, L, 128, 1024, k, home, tx, lds);
      if (i < 0) break;
      const int x = i >> 7, j = i & 127, qt = 31 - (j >> 2), pair = 4 * x + (j & 3);
      tx = attn_body<false>(p, L, pair >> 3, pair & 7, qt, lds, xq_ctr(p.ctl, 2, L, k, home));
    }
  }
  unsigned* ctr2 = p.ctl + QCTR(2, L);
  constexpr int NC = (NT + 31) / 32, NQ2 = 32 + NC + NRW / 4;
  bool r2_seen = false;
  for (;;) {
    const int q = next_item(ctr2, lds);
    if (q >= NQ2) break;
    constexpr int NR3 = NRW / 4;
    if (q >= NR3 + 32) conv_item(p, L, q - NR3 - 32);
    else if (q >= NR3) attn_item(p, L, 1280 + q - NR3, lds);
    else {
      if (!r2_seen) {
        if (threadIdx.x == 0) {
          unsigned sp = 0;
          while (__hip_atomic_load(p.ctl + R2DONE(L), __ATOMIC_RELAXED, __HIP_MEMORY_SCOPE_AGENT) < 576u) {
            __builtin_amdgcn_s_sleep(2);
            if (++sp > (1u << 22)) { atomicAdd(&p.ctl[XB_TMO], 1u); break; }
          }
          __builtin_amdgcn_fence(__ATOMIC_ACQUIRE, "agent");
          asm volatile("s_waitcnt vmcnt(0)" ::: "memory");
        }
        __syncthreads();
        r2_seen = true;
      }
      r3_wave(p, L, q * 4 + w, lane, (float*)(lds + w * 17408));
    }
  }
}
DEV void run_p4(const Prm& p, int L, char* lds) {
  const EpiOut epo{p, L};
  const int home = (int)(xb_xcc_id() & 7u);
  {
    XQueue q{p.ctl, 1, L, 128, 1024, 0, home, 0};
    gemm_stream<EpiOut, MapP4>(p.zE  , D, p.Wb_out + (size_t)L * 1024 * 1024, 1024, 1024, lds, epo, q);
  }
  unsigned* ctr = p.ctl + QCTR(3, L) + 16;
  int t = take_ticket(ctr);
  for (;;) {
    const int h = q_publish(t, lds);
    if (h >= 17 * 16) break;
    const int mt = 128 + (h >> 4), r = h & 15;
    t = gemm_tile<EpiOut, 4>(p.zE, D, p.Wb_out + (size_t)L * 1024 * 1024, 1024, 1024, mt * 128, (r >> 1) * 128 + (r & 1) * 64, lds, epo, ctr);
  }
}

__global__ void __launch_bounds__(256, 2) mega(Prm p) {
  extern __shared__ __attribute__((aligned(16))) char lds[];
  volatile LAS unsigned* st = (volatile LAS unsigned*)(lds + LDS_BYTES - 16);
  if (threadIdx.x == 0) { st[0] = 0u; st[1] = 0u; st[2] = 0u; st[3] = 0u; }
  __syncthreads();
  const XcdBarrier xb = xcd_barrier_post(p.ctl, st);
  phase0(p, lds);
  xcd_barrier(xb);
  for (int L = 0; L < 2; ++L) {
    run_p1(p, L, lds); xcd_barrier(xb);
    run_p2(p, L, lds); xcd_barrier(xb);
    run_p3(p, L, lds); xcd_barrier(xb);
    run_p4(p, L, lds); xcd_barrier(xb);
  }
  final_norm(p);
}

static size_t al256(size_t x) { return (x + 255) & ~(size_t)255; }
extern "C" void kernel_launch(void* const* d_in, const int* in_sizes, int n_in, void* d_out, int out_size, void* d_ws, size_t ws_size, hipStream_t stream) {
  Prm p{};
  const float* const* in = (const float* const*)d_in;
  p.x_prompt = in[0]; p.x_sample = in[1]; p.cache_ckv = in[2]; p.cache_krope = in[3]; p.state_conv = in[4]; p.state_shift = in[5]; p.state_wkv = in[6];
  p.meta = in[7]; p.norm_g = in[8]; p.w_in = in[9]; p.conv_w = in[10]; p.q_norm_g = in[11]; p.w_uq = in[12]; p.kv_norm_g = in[13]; p.w_ukv = in[14];
  p.shift_mu = in[15]; p.decay_w0 = in[16]; p.decay_w2 = in[17]; p.iclr_a0 = in[18]; p.iclr_a2 = in[19]; p.key_kk = in[20]; p.key_ka = in[21];
  p.bonus_rk = in[22]; p.lnx_w = in[23]; p.lnx_b = in[24]; p.w_out = in[25]; p.final_g = in[26];
  float* o = (float*)d_out;
  p.y_prompt = o; o += (size_t)4 * 4096 * 1024;
  p.y_sample = o; o += (size_t)32 * 64 * 1024;
  p.ckv_p = o; o += (size_t)2 * 4 * PT * 128;
  p.kr_p = o; o += (size_t)2 * 4 * PT * 32;
  p.conv_p = o; o += 2 * 4 * 2 * 256;
  p.shift_p = o; o += 2 * 4 * 896;
  p.wkv_p = o; o += 2 * 4 * 4 * 64 * 64;
  p.ckv_s = o; o += (size_t)2 * 32 * 64 * 128;
  p.kr_s = o; o += 2 * 32 * 64 * 32;
  p.conv_s = o; o += 2 * 32 * 2 * 256;
  p.shift_s = o; o += 2 * 32 * 896;
  p.wkv_s = o; o += 2 * 32 * 4 * 64 * 64;
  char* w = (char*)d_ws; size_t off = 0;
  auto take = [&](size_t bytes) { char* r = w + off; off = al256(off + bytes); return r; };
  p.ctl = (unsigned*)take(65536);
  p.Wb_in = (bf16_t*)take((size_t)2 * INP * 1024 * 2);
  p.Wb_uq = (bf16_t*)take((size_t)2 * 768 * 256 * 2);
  p.Wb_ukv = (bf16_t*)take((size_t)2 * 1024 * 128 * 2);
  p.Wb_out = (bf16_t*)take((size_t)2 * 1024 * 1024 * 2);
  p.dw2T = (bf16_t*)take((size_t)2 * 256 * 64 * 2);
  p.ia2T = (bf16_t*)take((size_t)2 * 256 * 64 * 2);
  p.ropec = (float*)take((size_t)PT * 16 * 4);
  p.ropes = (float*)take((size_t)PT * 16 * 4);
  p.ssq_x = (float*)take((size_t)7 * NTP * 4);
  p.ssq_q = p.ssq_x + 3 * NTP; p.ssq_kv = p.ssq_x + 5 * NTP;
  p.rkb = (float*)take((size_t)NTP * 4 * 4);
  p.xmeta = (float*)take((size_t)64 * 1024 * 4);
  p.zE = (bf16_t*)take((size_t)NTP * ZE * 2);
  p.zL = (bf16_t*)take((size_t)NTP * ZL * 2);
  p.xb = (bf16_t*)take((size_t)(NTP + 128) * D * 2);
  p.Kn = (bf16_t*)take((size_t)KVR * 512 * 2);
  p.Vt = (bf16_t*)take((size_t)512 * KVR * 2);
  p.Kr = (bf16_t*)take((size_t)KVR * 32 * 2);
  p.rw = take((size_t)NRW * RW_BYTES);
  p.KL = (bf16_t*)((char*)p.y_prompt + ((size_t)32 << 20));
  p.VLT = p.KL + (size_t)32 * SKEYS * 160;
  static int grid = 0;
  if (grid == 0) {
    if (off > ws_size) { fprintf(stderr, "kernel_launch: workspace too small: need %zu have %zu\n", off, ws_size); grid = -1; return; }
    int dev = 0, cus = 0, per_cu = 0;
    (void)hipGetDevice(&dev);
    (void)hipDeviceGetAttribute(&cus, hipDeviceAttributeMultiprocessorCount, dev);
    (void)hipFuncSetAttribute((const void*)mega, hipFuncAttributeMaxDynamicSharedMemorySize, LDS_BYTES);
    (void)hipOccupancyMaxActiveBlocksPerMultiprocessor(&per_cu, (const void*)mega, 256, LDS_BYTES);
    if (per_cu > 2) per_cu = 2;
    if (per_cu < 1) { fprintf(stderr, "kernel_launch: occupancy query returned %d\n", per_cu); per_cu = 1; }
    grid = cus * per_cu;
  }
  if (grid < 0) return;
  (void)hipMemsetAsync(p.ctl, 0, 8192 * 4, stream);
  void* args[] = {&p};
  hipError_t e = hipLaunchCooperativeKernel((const void*)mega, dim3(grid), dim3(256), args, LDS_BYTES, stream);
  if (e != hipSuccess) fprintf(stderr, "cooperative launch failed: %s (grid %d)\n", hipGetErrorString(e), grid);
}
```

```cpp
#include <hip/hip_runtime.h>
#include <cstdio>
#include <cstdint>
#include <type_traits>

typedef unsigned short bf16_t;
typedef short bf16x8 __attribute__((ext_vector_type(8)));
typedef float f32x4 __attribute__((ext_vector_type(4)));
typedef float f32x16 __attribute__((ext_vector_type(16)));
#define DEV __device__ __forceinline__
#define LAUNDER(x) asm volatile("" : "+v"(x))

constexpr int D = 1024;
constexpr int PT = 4112;
constexpr int NPR = 4 * PT;
constexpr int NSM = 32 * 64;
constexpr int NT = NPR + NSM;
constexpr int NTP = 18560;
constexpr int ZL = 1792;
constexpr int ZE = 1312;
constexpr int ZE_CQ = 0, ZE_CKV = 256, ZE_KR = 384, ZE_ZC = 416;
constexpr int ZL_XIN = 0, ZL_BG = 256, ZL_CG = 512, ZL_GA = 768, ZL_GB = 1024, ZL_GC = 1536;
constexpr int INP = 3200;
constexpr int KVR = 16512;
constexpr int NRW_P = 4 * 65 * 4;
constexpr int NRW = NRW_P + 32 * 4;
constexpr int RW_BYTES = 49152;
constexpr float RMS_EPS = 1e-6f;
constexpr float GN_EPS = 64e-5f;
constexpr int LDS_BYTES = 79872;
constexpr int SKEYS = 1088;

struct Prm {
  const float *x_prompt, *x_sample, *cache_ckv, *cache_krope, *state_conv, *state_shift, *state_wkv, *meta, *norm_g, *w_in,
      *conv_w, *q_norm_g, *w_uq, *kv_norm_g, *w_ukv, *shift_mu, *decay_w0, *decay_w2, *iclr_a0, *iclr_a2, *key_kk, *key_ka,
      *bonus_rk, *lnx_w, *lnx_b, *w_out, *final_g;
  float *y_prompt, *y_sample, *ckv_p, *kr_p, *conv_p, *shift_p, *wkv_p, *ckv_s, *kr_s, *conv_s, *shift_s, *wkv_s;
  unsigned* ctl;
  bf16_t *Wb_in, *Wb_uq, *Wb_ukv, *Wb_out, *dw2T, *ia2T;
  float *ropec, *ropes, *ssq_x, *ssq_q, *ssq_kv, *rkb, *xmeta;
  bf16_t *KL, *VLT;
  bf16_t *zE, *zL, *xb, *Kn, *Vt, *Kr;
  char* rw;
};

DEV float bf2f(bf16_t b) { return __uint_as_float((unsigned)b << 16); }
DEV float bflo(unsigned u) { return __uint_as_float(u << 16); }
DEV float bfhi(unsigned u) { return __uint_as_float(u & 0xffff0000u); }
typedef __bf16 hbf16x2_t __attribute__((ext_vector_type(2)));
typedef float hf32x2_t __attribute__((ext_vector_type(2)));
DEV unsigned pk2(float a, float b) { hf32x2_t f = {a, b}; hbf16x2_t r = __builtin_convertvector(f, hbf16x2_t); return __builtin_bit_cast(unsigned, r); }
DEV bf16_t f2bf(float f) { return (bf16_t)(pk2(f, 0.f) & 0xffffu); }
DEV uint2 pk4(float a, float b, float c, float d) { uint2 r; r.x = pk2(a, b); r.y = pk2(c, d); return r; }
DEV float sigmoid_(float x) { return 1.f / (1.f + __expf(-x)); }
DEV float silu_(float x) { return x / (1.f + __expf(-x)); }
DEV float wave_sum(float v) {
#pragma unroll
  for (int o = 1; o < 64; o <<= 1) v += __shfl_xor(v, o);
  return v;
}
DEV f32x16 mfma32(bf16x8 a, bf16x8 b, f32x16 c) { return __builtin_amdgcn_mfma_f32_32x32x16_bf16(a, b, c, 0, 0, 0); }
DEV f32x4 mfma16(bf16x8 a, bf16x8 b, f32x4 c) { return __builtin_amdgcn_mfma_f32_16x16x32_bf16(a, b, c, 0, 0, 0); }
DEV bf16x8 mk8(unsigned a, unsigned b, unsigned c, unsigned d) { uint4 u; u.x = a; u.y = b; u.z = c; u.w = d; return __builtin_bit_cast(bf16x8, u); }
DEV bf16x8 mk8(uint4 u) { return __builtin_bit_cast(bf16x8, u); }
DEV f32x16 zero16() { f32x16 z; for (int i = 0; i < 16; ++i) z[i] = 0.f; return z; }

DEV float* xrow_ptr(const Prm& p, int R) {
  if (R < NPR) { int s = R / PT, q = R - s * PT; return q < 16 ? p.xmeta + (size_t)(s * 16 + q) * D : p.y_prompt + ((size_t)s * 4096 + (q - 16)) * D; }
  return p.y_sample + (size_t)(R - NPR) * D;
}
DEV const float* xin_ptr(const Prm& p, int R) {
  if (R < NPR) { int s = R / PT, q = R - s * PT; return q < 16 ? p.meta + (size_t)q * D : p.x_prompt + ((size_t)s * 4096 + (q - 16)) * D; }
  return p.x_sample + (size_t)(R - NPR) * D;
}
DEV int pos_of(int R) { return R < NPR ? R % PT : 1024 + ((R - NPR) & 63); }

DEV int win_src_col(int n) {
  if (n < 1024) return n;
  if (n < 1536) return 1440 + (n - 1024);
  if (n < 1792) return 2848 + (n - 1536);
  if (n < 2208) return 1024 + (n - 1792);
  if (n < 3104) return 1952 + (n - 2208);
  return -1;
}
DEV int perm32(int rho) { const int n = rho >> 4, i = rho & 15; return 8 * (i >> 2) + 4 * n + (i & 3); }
template <bool PERM, bool P32>
DEV void conv_weight_tile(const float* __restrict__ src, int K, int N, int Npad, bf16_t* __restrict__ dst, const float* __restrict__ sk, float cst, int l, int item, float* T  , int tid) {
  const int ntn = Npad / 64, ntk = K / 64;
  const int r = item, kt = r / ntn, nt = r - kt * ntn;
  const int k0 = kt * 64, n0 = nt * 64;
  {
    const int nslot = n0 + (tid & 15) * 4;
    const int nn = P32 ? (nslot & ~31) + perm32(nslot & 31) : nslot;
    const int sn = PERM ? win_src_col(nn) : (nn < N ? nn : -1);
#pragma unroll
    for (int i = 0; i < 4; ++i) {
      const int k = (tid >> 4) + 16 * i;
      float4 v = make_float4(0.f, 0.f, 0.f, 0.f);
      if (sn >= 0) {
        v = *(const float4*)(src + ((size_t)l * K + k0 + k) * N + sn);
        const float s = (sk ? sk[l * K + k0 + k] : 1.f) * cst;
        v.x *= s; v.y *= s; v.z *= s; v.w *= s;
      }
      float* t = T + k * 65 + (tid & 15) * 4;
      t[0] = v.x; t[1] = v.y; t[2] = v.z; t[3] = v.w;
    }
  }
  __syncthreads();
  {
    const int n = tid >> 2, kc = tid & 3;
    float v[16];
#pragma unroll
    for (int j = 0; j < 16; ++j) v[j] = T[(16 * kc + j) * 65 + n];
    uint4 o0, o1;
    o0.x = pk2(v[0], v[1]); o0.y = pk2(v[2], v[3]); o0.z = pk2(v[4], v[5]); o0.w = pk2(v[6], v[7]);
    o1.x = pk2(v[8], v[9]); o1.y = pk2(v[10], v[11]); o1.z = pk2(v[12], v[13]); o1.w = pk2(v[14], v[15]);
    bf16_t* d = dst + ((size_t)l * Npad + n0 + n) * K + k0 + 16 * kc;
    *(uint4*)d = o0; *(uint4*)(d + 8) = o1;
  }
  __syncthreads();
}
constexpr int WT0 = 16 * 50, WT1 = WT0 + 16 * 16, WT2 = WT1 + 4 * 12, WT3 = WT2 + 2 * 16, WT4 = WT3 + 4, NWT = WT4 + 4;
DEV void conv_weights_item(const Prm& p, int l, int it, char* lds) {
  float* T = (float*)lds;
  int tid = threadIdx.x; LAUNDER(tid);
  if (it < WT0) conv_weight_tile<true, true>(p.w_in, 1024, 3104, INP, p.Wb_in, p.norm_g, 1.f, l, it, T, tid);
  else if (it < WT1) conv_weight_tile<false, true>(p.w_out, 1024, 1024, 1024, p.Wb_out, nullptr, 1.f, l, it - WT0, T, tid);
  else if (it < WT2) conv_weight_tile<false, false>(p.w_uq, 256, 768, 768, p.Wb_uq, p.q_norm_g, 0.10206207261596575f * 1.4426950408889634f, l, it - WT1, T, tid);
  else if (it < WT3) conv_weight_tile<false, false>(p.w_ukv, 128, 1024, 1024, p.Wb_ukv, nullptr, 1.f, l, it - WT2, T, tid);
  else if (it < WT4) conv_weight_tile<false, false>(p.decay_w2, 64, 256, 256, p.dw2T, nullptr, 1.f, l, it - WT3, T, tid);
  else conv_weight_tile<false, false>(p.iclr_a2, 64, 256, 256, p.ia2T, nullptr, 1.f, l, it - WT4, T, tid);
}
DEV void phase0(const Prm& p, char* lds) {
  int tid = threadIdx.x; LAUNDER(tid);
  const int lane = tid & 63, wv = tid >> 6;
  const int gw = blockIdx.x * 4 + wv, NW = gridDim.x * 4;
  const int gt = blockIdx.x * 256 + tid, NTH = gridDim.x * 256;
  for (int R = gw; R < NT; R += NW) {
    const float* src = xin_ptr(p, R);
    float ss = 0.f;
#pragma unroll
    for (int j = 0; j < 4; ++j) {
      const float4 v = ((const float4*)src)[lane + 64 * j];
      ss += v.x * v.x + v.y * v.y + v.z * v.z + v.w * v.w;
      ((uint2*)(p.xb + (size_t)R * D))[lane + 64 * j] = pk4(v.x, v.y, v.z, v.w);
    }
    ss = wave_sum(ss);
    if (lane == 0) p.ssq_x[R] = ss;
  }
  for (int i = gt; i < 6 * NTP; i += NTH) p.ssq_x[NTP + i] = 0.f;
  for (int it = blockIdx.x; it < NWT; it += gridDim.x) conv_weights_item(p, 0, it, lds);
  for (int i = gt; i < PT * 16; i += NTH) {
    const int pos = i >> 4, j = i & 15;
    const float inv = powf(10000.f, -(float)j * 2.0f / 32.f);
    const float ang = (float)pos * inv;
    double a = (double)ang;
    a -= 6.283185307179586476925 * rint(a * 0.15915494309189533577);
    p.ropec[i] = (float)cos(a);
    p.ropes[i] = (float)sin(a);
  }
}

#define LAS3 __attribute__((address_space(3)))
#define RAW_BARRIER() { asm volatile("" ::: "memory"); __builtin_amdgcn_s_barrier(); asm volatile("" ::: "memory"); }
DEV int lds_byte(int r, int c) { const int st = (r >> 4) * 2 + (c >> 5), rr = r & 15, cc = c & 31, ob = rr * 64 + cc * 2; return st * 1024 + (ob ^ (((ob >> 9) & 1) << 5)); }
template <class Epi, int NB = 8>
DEV int gemm_tile(const bf16_t* __restrict__ A, int lda, const bf16_t* __restrict__ Bt, int ldb, int K, int m0, int n0, char* lds, const Epi& epi, unsigned* nctr = nullptr) {
  int tid = threadIdx.x; LAUNDER(tid);
  const int lane = tid & 63, w = __builtin_amdgcn_readfirstlane(tid >> 6), wr = w >> 1, wc = w & 1;
  const int fr = lane & 15, fq = lane >> 4;
  const int sb = lane * 16, swz = sb ^ (((sb >> 9) & 1) << 5), rl = swz >> 6, cl = (swz & 63) >> 1;
  const bf16_t* ga[4]; const bf16_t* gb[4];
#pragma unroll
  for (int i = 0; i < 4; ++i) {
    const int st = 4 * w + i, r = (st >> 1) * 16 + rl, c = (st & 1) * 32 + cl;
    ga[i] = A + (size_t)(m0 + r) * lda + c;
    gb[i] = Bt + (size_t)(n0 + r) * ldb + c;
  }
  const int nk = K / 64;
#define GSTAGE(S, KT) { _Pragma("unroll") for (int i = 0; i < 4; ++i) { \
      __builtin_amdgcn_global_load_lds((const unsigned*)(ga[i] + (KT) * 64), (LAS3 unsigned*)(lds + (S) * 32768 + (4 * w + i) * 1024 + lane * 16), 16, 0, 0); \
      if (2 * w + (i >> 1) < NB) __builtin_amdgcn_global_load_lds((const unsigned*)(gb[i] + (KT) * 64), (LAS3 unsigned*)(lds + (S) * 32768 + 16384 + (4 * w + i) * 1024 + lane * 16), 16, 0, 0); } }
  f32x4 acc[4][4];
#pragma unroll
  for (int i = 0; i < 4; ++i)
#pragma unroll
    for (int j = 0; j < 4; ++j) acc[i][j] = (f32x4){0.f, 0.f, 0.f, 0.f};
  int offA[2], offB[2];
#pragma unroll
  for (int kh = 0; kh < 2; ++kh) { offA[kh] = lds_byte(wr * 64 + fr, kh * 32 + fq * 8); offB[kh] = lds_byte(wc * 64 + fr, kh * 32 + fq * 8); }
  GSTAGE(0, 0)
  if (nk > 1) GSTAGE(1, 1)
  for (int kt = 0; kt < nk; ++kt) {
    const int s = kt & 1;
    if (kt + 1 < nk) { if (2 * w < NB) asm volatile("s_waitcnt vmcnt(8)" ::: "memory"); else asm volatile("s_waitcnt vmcnt(4)" ::: "memory"); }
    else asm volatile("s_waitcnt vmcnt(0)" ::: "memory");
    RAW_BARRIER()
    const char* ia = lds + s * 32768;
    const char* ib = ia + 16384;
    bf16x8 af[2][4], bfv[2][4];
#pragma unroll
    for (int kh = 0; kh < 2; ++kh) {
#pragma unroll
      for (int mi = 0; mi < 4; ++mi) af[kh][mi] = *(const bf16x8*)(ia + offA[kh] + mi * 2048);
#pragma unroll
      for (int ni = 0; ni < (NB < 4 ? NB : 4); ++ni) bfv[kh][ni] = *(const bf16x8*)(ib + offB[kh] + ni * 2048);
    }
    asm volatile("s_waitcnt lgkmcnt(%0)" :: "n"(4 + (NB < 4 ? NB : 4)) : "memory");
    __builtin_amdgcn_sched_barrier(0);
    if (NB == 8 || wc == 0) {
#pragma unroll
      for (int mi = 0; mi < 4; ++mi)
#pragma unroll
        for (int ni = 0; ni < (NB < 4 ? NB : 4); ++ni) acc[mi][ni] = mfma16(bfv[0][ni], af[0][mi], acc[mi][ni]);
    }
    __builtin_amdgcn_sched_barrier(0);
    asm volatile("s_waitcnt lgkmcnt(0)" ::: "memory");
    RAW_BARRIER()
    if (kt + 2 < nk) GSTAGE(s, kt + 2)
    __builtin_amdgcn_sched_barrier(0);
    if (NB == 8 || wc == 0) {
#pragma unroll
      for (int mi = 0; mi < 4; ++mi)
#pragma unroll
        for (int ni = 0; ni < (NB < 4 ? NB : 4); ++ni) acc[mi][ni] = mfma16(bfv[1][ni], af[1][mi], acc[mi][ni]);
    }
  }
  __syncthreads();
#undef GSTAGE
  int tk = 0x7fffffff; if (nctr && tid == 0) tk = (int)atomicAdd(nctr, 1u);
  if (NB == 8 || wc == 0) epi(acc, m0 + wr * 64, n0 + wc * 64, fr, fq);
  return tk;
}

struct EpiIn {
  const Prm& p; int L;
  struct Pre { float s[4]; };
  DEV Pre preload(int mb, int nb, int fr, int fq) const {
    Pre r;
#pragma unroll
    for (int mi = 0; mi < 4; ++mi) r.s[mi] = p.ssq_x[L * NTP + mb + 16 * mi + fr];
    return r;
  }
  DEV void operator()(f32x4 (&acc)[4][4], int mb, int nb, int fr, int fq) const { finish(acc, preload(mb, nb, fr, fq), mb, nb, fr, fq); }
  DEV void finish(f32x4 (&acc)[4][4], const Pre& pre, int mb, int nb, int fr, int fq) const {
#pragma unroll
    for (int mi = 0; mi < 4; ++mi) {
      const int m = mb + 16 * mi + fr;
      const bool ok = m < NT;
      const float rstd = rsqrtf(pre.s[mi] * (1.f / 1024.f) + RMS_EPS);
      float sq = 0.f;
#pragma unroll
      for (int g = 0; g < 2; ++g) {
        const int n0 = nb + 32 * g;
        if (n0 >= 3104) continue;
        bf16_t* dst = n0 < ZL ? p.zL + (size_t)m * ZL + n0 : p.zE + (size_t)m * ZE + (n0 - ZL);
        float v[8];
#pragma unroll
        for (int j = 0; j < 4; ++j) { v[j] = acc[mi][2 * g][j] * rstd; v[4 + j] = acc[mi][2 * g + 1][j] * rstd; }
#pragma unroll
        for (int j = 0; j < 8; ++j) sq += v[j] * v[j];
        if (ok) { uint4 o; o.x = pk2(v[0], v[1]); o.y = pk2(v[2], v[3]); o.z = pk2(v[4], v[5]); o.w = pk2(v[6], v[7]); *(uint4*)(dst + 8 * fq) = o; }
      }
      if (nb >= ZL && nb < ZL + 384) {
        sq += __shfl_xor(sq, 16); sq += __shfl_xor(sq, 32);
        if (fq == 0 && ok) atomicAdd((nb < ZL + 256 ? p.ssq_q : p.ssq_kv) + L * NTP + m, sq);
      }
    }
  }
};
struct EpiQ {
  const Prm& p; int L;
  DEV void operator()(f32x4 (&acc)[4][4], int mb, int nb, int fr, int fq) const {
    bf16_t* Qb = (bf16_t*)p.y_prompt;
#pragma unroll
    for (int mi = 0; mi < 4; ++mi) {
      const int m = mb + 16 * mi + fr;
      const bool ok = m < NT;
      const float rstd = rsqrtf(p.ssq_q[L * NTP + m] * (1.f / 256.f) + RMS_EPS);
      const int pos = pos_of(ok ? m : 0);
#pragma unroll
      for (int np = 0; np < 2; ++np) {
        const int n0 = nb + 32 * np;
        float v[2][4];
#pragma unroll
        for (int h2 = 0; h2 < 2; ++h2)
#pragma unroll
          for (int j = 0; j < 4; ++j) v[h2][j] = acc[mi][2 * np + h2][j] * rstd;
        if (((n0 >> 5) % 3) == 2) {
#pragma unroll
          for (int j = 0; j < 4; ++j) {
            const int c = 4 * fq + j;
            const float cs = p.ropec[pos * 16 + c], sn = p.ropes[pos * 16 + c];
            const float x1 = v[0][j], x2 = v[1][j];
            v[0][j] = x1 * cs - x2 * sn; v[1][j] = x1 * sn + x2 * cs;
          }
        }
        if (ok) {
          *(uint2*)(Qb + (size_t)m * 768 + n0 + 4 * fq) = pk4(v[0][0], v[0][1], v[0][2], v[0][3]);
          *(uint2*)(Qb + (size_t)m * 768 + n0 + 16 + 4 * fq) = pk4(v[1][0], v[1][1], v[1][2], v[1][3]);
        }
      }
    }
  }
};
struct EpiOut {
  const Prm& p; int L;
  struct Pre { uint4 x[4][2]; };
  DEV Pre preload(int mb, int nb, int fr, int fq) const {
    Pre r;
#pragma unroll
    for (int mi = 0; mi < 4; ++mi) {
      const int m = mb + 16 * mi + fr;
      const bf16_t* xr = p.xb + (size_t)(m < NT ? m : 0) * D;
#pragma unroll
      for (int g = 0; g < 2; ++g) r.x[mi][g] = *(const uint4*)(xr + nb + 32 * g + 8 * fq);
    }
    return r;
  }
  DEV void operator()(f32x4 (&acc)[4][4], int mb, int nb, int fr, int fq) const { finish(acc, preload(mb, nb, fr, fq), mb, nb, fr, fq); }
  DEV void finish(f32x4 (&acc)[4][4], const Pre& pre, int mb, int nb, int fr, int fq) const {
#pragma unroll
    for (int mi = 0; mi < 4; ++mi) {
      const int m = mb + 16 * mi + fr;
      const bool ok = m < NT;
      bf16_t* xr = p.xb + (size_t)(ok ? m : 0) * D;
      float ss = 0.f;
#pragma unroll
      for (int g = 0; g < 2; ++g) {
        const int col = nb + 32 * g + 8 * fq;
        const uint4 xi = pre.x[mi][g];
        float v[8] = {bflo(xi.x), bfhi(xi.x), bflo(xi.y), bfhi(xi.y), bflo(xi.z), bfhi(xi.z), bflo(xi.w), bfhi(xi.w)};
#pragma unroll
        for (int j = 0; j < 4; ++j) { v[j] += acc[mi][2 * g][j]; v[4 + j] += acc[mi][2 * g + 1][j]; }
#pragma unroll
        for (int j = 0; j < 8; ++j) ss += v[j] * v[j];
        if (ok) { uint4 o; o.x = pk2(v[0], v[1]); o.y = pk2(v[2], v[3]); o.z = pk2(v[4], v[5]); o.w = pk2(v[6], v[7]); *(uint4*)(xr + col) = o; }
      }
      ss += __shfl_xor(ss, 16); ss += __shfl_xor(ss, 32);
      if (fq == 0 && ok) atomicAdd(p.ssq_x + (L + 1) * NTP + m, ss);
    }
  }
};

DEV void kv_prep_row(const Prm& p, int L, int R, int half, bool valid, bf16_t* At_row  ) {
  const int Rl = valid ? R : 0;
  const bf16_t* zr = p.zE + (size_t)Rl * ZE;
  const float rstd = rsqrtf(p.ssq_kv[L * NTP + Rl] * (1.f / 128.f) + RMS_EPS);
  float* outc; float* outk;
  if (Rl < NPR) { const int s = Rl / PT, q = Rl - s * PT; outc = p.ckv_p + (((size_t)L * 4 + s) * PT + q) * 128; outk = p.kr_p + (((size_t)L * 4 + s) * PT + q) * 32; }
  else { const int j = Rl - NPR; outc = p.ckv_s + ((size_t)L * NSM + j) * 128; outk = p.kr_s + ((size_t)L * NSM + j) * 32; }
  const float* g = p.kv_norm_g + L * 128 + 64 * half;
  uint4 uu[8], kru[2], krv[2];
#pragma unroll
  for (int c8 = 0; c8 < 8; ++c8) uu[c8] = *(const uint4*)(zr + ZE_CKV + 64 * half + 8 * c8);
#pragma unroll
  for (int c8 = 0; c8 < 2; ++c8) { kru[c8] = *(const uint4*)(zr + ZE_KR + 8 * c8); krv[c8] = *(const uint4*)(zr + ZE_KR + 16 + 8 * c8); }
  __builtin_amdgcn_sched_barrier(0);
#pragma unroll
  for (int c8 = 0; c8 < 8; ++c8) {
    const uint4 u = uu[c8];
    const float4 g0 = *(const float4*)(g + 8 * c8), g1 = *(const float4*)(g + 8 * c8 + 4);
    float4 y0, y1;
    y0.x = bflo(u.x) * rstd * g0.x; y0.y = bfhi(u.x) * rstd * g0.y; y0.z = bflo(u.y) * rstd * g0.z; y0.w = bfhi(u.y) * rstd * g0.w;
    y1.x = bflo(u.z) * rstd * g1.x; y1.y = bfhi(u.z) * rstd * g1.y; y1.z = bflo(u.w) * rstd * g1.z; y1.w = bfhi(u.w) * rstd * g1.w;
    if (valid) { *(float4*)(outc + 64 * half + 8 * c8) = y0; *(float4*)(outc + 64 * half + 8 * c8 + 4) = y1; }
    if (At_row) { uint4 o; o.x = pk2(y0.x, y0.y); o.y = pk2(y0.z, y0.w); o.z = pk2(y1.x, y1.y); o.w = pk2(y1.z, y1.w); *(uint4*)(At_row + 64 * half + 8 * c8) = o; }
    if (valid && Rl >= NPR) {
      const int j = Rl - NPR, b = j >> 6, r = j & 63;
      bf16_t* kl = p.KL + ((size_t)b * SKEYS + 1024 + r) * 160 + 16 * (4 * half + (c8 >> 1)) + 4 * (c8 & 1);
      *(uint2*)kl = pk4(y0.x, y0.y, y0.z, y0.w); *(uint2*)(kl + 8) = pk4(y1.x, y1.y, y1.z, y1.w);
    }
    if (c8 & 1) __builtin_amdgcn_sched_barrier(0);
  }
  if (half == 0) {
    const int pos = pos_of(Rl);
#pragma unroll
    for (int c8 = 0; c8 < 2; ++c8) {
      const uint4 u = kru[c8], v = krv[c8];
      const float x1[8] = {bflo(u.x), bfhi(u.x), bflo(u.y), bfhi(u.y), bflo(u.z), bfhi(u.z), bflo(u.w), bfhi(u.w)};
      const float x2[8] = {bflo(v.x), bfhi(v.x), bflo(v.y), bfhi(v.y), bflo(v.z), bfhi(v.z), bflo(v.w), bfhi(v.w)};
      float y1[8], y2[8];
#pragma unroll
      for (int e = 0; e < 8; ++e) {
        const float cs = p.ropec[pos * 16 + 8 * c8 + e], sn = p.ropes[pos * 16 + 8 * c8 + e];
        y1[e] = x1[e] * cs - x2[e] * sn; y2[e] = x1[e] * sn + x2[e] * cs;
      }
      if (valid) {
        float4 o;
        o.x = y1[0]; o.y = y1[1]; o.z = y1[2]; o.w = y1[3]; *(float4*)(outk + 8 * c8) = o;
        o.x = y1[4]; o.y = y1[5]; o.z = y1[6]; o.w = y1[7]; *(float4*)(outk + 8 * c8 + 4) = o;
        o.x = y2[0]; o.y = y2[1]; o.z = y2[2]; o.w = y2[3]; *(float4*)(outk + 16 + 8 * c8) = o;
        o.x = y2[4]; o.y = y2[5]; o.z = y2[6]; o.w = y2[7]; *(float4*)(outk + 16 + 8 * c8 + 4) = o;
        {
          const int j = Rl - NPR;
          bf16_t* krd = Rl < NPR ? p.Kr + (size_t)Rl * 32 : p.KL + ((size_t)(j >> 6) * SKEYS + 1024 + (j & 63)) * 160 + 128;
          uint4 q; q.x = pk2(y1[0], y1[1]); q.y = pk2(y1[2], y1[3]); q.z = pk2(y1[4], y1[5]); q.w = pk2(y1[6], y1[7]); *(uint4*)(krd + 8 * c8) = q;
          q.x = pk2(y2[0], y2[1]); q.y = pk2(y2[2], y2[3]); q.z = pk2(y2[4], y2[5]); q.w = pk2(y2[6], y2[7]); *(uint4*)(krd + 16 + 8 * c8) = q;
        }
      }
    }
  }
}
DEV void kvproj_item(const Prm& p, int L, int mt, char* lds) {
  int tid = threadIdx.x; LAUNDER(tid);
  const int lane = tid & 63, w = __builtin_amdgcn_readfirstlane(tid >> 6), wr = w >> 1, wc = w & 1, l31 = lane & 31, hh = lane >> 5;
  bf16_t* At = (bf16_t*)lds;
  bf16_t* Bs = At + 128 * 136;
  {
    const int r = tid >> 1, half = tid & 1, R = mt * 128 + r;
    kv_prep_row(p, L, R, half, R < NPR, At + r * 136);
  }
  uint4 bp0, bp1, bp2, bp3, bp4, bp5, bp6, bp7;
  const int brow = tid >> 4, bcc = (tid & 15) * 8;
#define BLOAD(H) { const bf16_t* ws_ = p.Wb_ukv + ((size_t)L * 1024 + (H) * 128 + brow) * 128 + bcc; \
    bp0 = *(const uint4*)(ws_); bp1 = *(const uint4*)(ws_ + 16 * 128); bp2 = *(const uint4*)(ws_ + 32 * 128); bp3 = *(const uint4*)(ws_ + 48 * 128); \
    bp4 = *(const uint4*)(ws_ + 64 * 128); bp5 = *(const uint4*)(ws_ + 80 * 128); bp6 = *(const uint4*)(ws_ + 96 * 128); bp7 = *(const uint4*)(ws_ + 112 * 128); }
  BLOAD(0)
  for (int h = 0; h < 8; ++h) {
    __syncthreads();
    {
      bf16_t* bd_ = Bs + brow * 136 + bcc;
      *(uint4*)(bd_) = bp0; *(uint4*)(bd_ + 16 * 136) = bp1; *(uint4*)(bd_ + 32 * 136) = bp2; *(uint4*)(bd_ + 48 * 136) = bp3;
      *(uint4*)(bd_ + 64 * 136) = bp4; *(uint4*)(bd_ + 80 * 136) = bp5; *(uint4*)(bd_ + 96 * 136) = bp6; *(uint4*)(bd_ + 112 * 136) = bp7;
    }
    __syncthreads();
    BLOAD(h < 7 ? h + 1 : 7)
    __builtin_amdgcn_sched_barrier(0);
    f32x16 acc[2][2];
#pragma unroll
    for (int i = 0; i < 2; ++i)
#pragma unroll
      for (int j = 0; j < 2; ++j) acc[i][j] = zero16();
    const bf16_t* as = At + (wr * 64 + l31) * 136 + hh * 8;
    const bf16_t* bs = Bs + (wc * 64 + l31) * 136 + hh * 8;
    if (wc == 0) {
#pragma unroll 2
      for (int ks = 0; ks < 8; ++ks) {
        const bf16x8 a0 = *(const bf16x8*)(as + ks * 16), a1 = *(const bf16x8*)(as + 32 * 136 + ks * 16);
        const bf16x8 b0 = *(const bf16x8*)(bs + ks * 16), b1 = *(const bf16x8*)(bs + 32 * 136 + ks * 16);
        acc[0][0] = mfma32(b0, a0, acc[0][0]); acc[0][1] = mfma32(b1, a0, acc[0][1]);
        acc[1][0] = mfma32(b0, a1, acc[1][0]); acc[1][1] = mfma32(b1, a1, acc[1][1]);
      }
#pragma unroll
      for (int i = 0; i < 2; ++i) {
        const int KRr = mt * 128 + wr * 64 + 32 * i + l31;
#pragma unroll
        for (int j = 0; j < 2; ++j)
#pragma unroll
          for (int G = 0; G < 4; ++G)
            *(uint2*)(p.Kn + ((size_t)h * KVR + KRr) * 64 + 32 * j + 8 * G + 4 * hh) = pk4(acc[i][j][4 * G], acc[i][j][4 * G + 1], acc[i][j][4 * G + 2], acc[i][j][4 * G + 3]);
      }
    } else {
#pragma unroll 2
      for (int ks = 0; ks < 8; ++ks) {
        const bf16x8 a0 = *(const bf16x8*)(as + ks * 16), a1 = *(const bf16x8*)(as + 32 * 136 + ks * 16);
        const bf16x8 b0 = *(const bf16x8*)(bs + ks * 16), b1 = *(const bf16x8*)(bs + 32 * 136 + ks * 16);
        acc[0][0] = mfma32(a0, b0, acc[0][0]); acc[0][1] = mfma32(a0, b1, acc[0][1]);
        acc[1][0] = mfma32(a1, b0, acc[1][0]); acc[1][1] = mfma32(a1, b1, acc[1][1]);
      }
#pragma unroll
      for (int j = 0; j < 2; ++j) {
        const int d = 32 * j + l31;
#pragma unroll
        for (int i = 0; i < 2; ++i)
#pragma unroll
          for (int G = 0; G < 4; ++G) {
            const int kblk = (mt * 128 + wr * 64 + 32 * i + 16 * (G >> 1)) >> 4, kpos = 8 * hh + 4 * (G & 1);
            *(uint2*)(p.Vt + (((size_t)h * (KVR / 16) + kblk) * 64 + d) * 16 + kpos) = pk4(acc[i][j][4 * G], acc[i][j][4 * G + 1], acc[i][j][4 * G + 2], acc[i][j][4 * G + 3]);
          }
      }
    }
  }
  __syncthreads();
#undef BLOAD
}
DEV void qproj_item(const Prm& p, int L, int mt, char* lds) {
  int tid = threadIdx.x; LAUNDER(tid);
  const int lane = tid & 63, w = __builtin_amdgcn_readfirstlane(tid >> 6);
  const int fr = lane & 15, fq = lane >> 4;
  const int m0 = mt * 128;
  const bf16_t* Bt = p.Wb_uq + (size_t)L * 768 * 256;
  bf16_t* Qb = (bf16_t*)p.y_prompt;
  const int sb = lane * 16, swz = sb ^ (((sb >> 9) & 1) << 5), rl = swz >> 6, cl = (swz & 63) >> 1;
  const bf16_t* gb[4];
#pragma unroll
  for (int i = 0; i < 4; ++i) { const int st = 4 * w + i, r = (st >> 1) * 16 + rl, c = (st & 1) * 32 + cl; gb[i] = Bt + (size_t)r * 256 + c; }
#define BSTAGE(S, NT_, KT_) { _Pragma("unroll") for (int i = 0; i < 4; ++i) \
    __builtin_amdgcn_global_load_lds((const unsigned*)(gb[i] + (size_t)(NT_) * 128 * 256 + (KT_) * 64), (LAS3 unsigned*)(lds + (S) * 16384 + (4 * w + i) * 1024 + lane * 16), 16, 0, 0); }
  BSTAGE(0, 0, 0)
  BSTAGE(1, 0, 1)
  float* RC = (float*)(lds + 49152); float* RS = RC + 128 * 16;
  {
    const int r = tid >> 1, h8 = (tid & 1) * 8, m = m0 + r, pos = pos_of(m < NT ? m : 0);
    const float4 c0 = *(const float4*)(p.ropec + pos * 16 + h8), c1 = *(const float4*)(p.ropec + pos * 16 + h8 + 4);
    const float4 s0 = *(const float4*)(p.ropes + pos * 16 + h8), s1 = *(const float4*)(p.ropes + pos * 16 + h8 + 4);
    *(float4*)(RC + r * 16 + h8) = c0; *(float4*)(RC + r * 16 + h8 + 4) = c1; *(float4*)(RS + r * 16 + h8) = s0; *(float4*)(RS + r * 16 + h8 + 4) = s1;
  }
  bf16x8 af[8][2];
  {
    const bf16_t* ap = p.zE + (size_t)(m0 + 32 * w + fr) * ZE + ZE_CQ + 8 * fq;
#pragma unroll
    for (int kk = 0; kk < 8; ++kk)
#pragma unroll
      for (int mi = 0; mi < 2; ++mi) af[kk][mi] = *(const bf16x8*)(ap + (size_t)(16 * mi) * ZE + 32 * kk);
  }
  float rstd[2];
#pragma unroll
  for (int mi = 0; mi < 2; ++mi) rstd[mi] = rsqrtf(p.ssq_q[L * NTP + m0 + 32 * w + 16 * mi + fr] * (1.f / 256.f) + RMS_EPS);
  int offB[2];
#pragma unroll
  for (int kh = 0; kh < 2; ++kh) offB[kh] = lds_byte(fr, kh * 32 + fq * 8);
  int s = 0;
  for (int nt = 0; nt < 6; ++nt) {
    f32x4 acc[2][8];
#pragma unroll
    for (int i = 0; i < 2; ++i)
#pragma unroll
      for (int j = 0; j < 8; ++j) acc[i][j] = (f32x4){0.f, 0.f, 0.f, 0.f};
#pragma unroll
    for (int kt = 0; kt < 4; ++kt) {
      if (nt == 0 && kt == 0) asm volatile("s_waitcnt vmcnt(0)" ::: "memory");
      else if (nt == 5 && kt == 3) asm volatile("s_waitcnt vmcnt(0)" ::: "memory");
      else if (nt > 0 && kt < 2) asm volatile("s_waitcnt vmcnt(20)" ::: "memory");
      else asm volatile("s_waitcnt vmcnt(4)" ::: "memory");
      RAW_BARRIER()
      {
        const int j2 = nt * 4 + kt + 2, s2 = s + 2 >= 3 ? s - 1 : s + 2;
        if (j2 < 24) BSTAGE(s2, j2 >> 2, j2 & 3)
      }
      const char* ib = lds + s * 16384;
#pragma unroll
      for (int kh = 0; kh < 2; ++kh) {
        bf16x8 bfv[8];
#pragma unroll
        for (int ni = 0; ni < 8; ++ni) bfv[ni] = *(const bf16x8*)(ib + offB[kh] + ni * 2048);
        __builtin_amdgcn_sched_barrier(0);
#pragma unroll
        for (int mi = 0; mi < 2; ++mi)
#pragma unroll
          for (int ni = 0; ni < 8; ++ni) acc[mi][ni] = mfma16(bfv[ni], af[2 * kt + kh][mi], acc[mi][ni]);
        __builtin_amdgcn_sched_barrier(0);
      }
      s = s + 1 >= 3 ? 0 : s + 1;
    }
    const int nb = nt * 128;
#pragma unroll
    for (int mi = 0; mi < 2; ++mi) {
      const int rloc = 32 * w + 16 * mi + fr, m = m0 + rloc;
#pragma unroll
      for (int np = 0; np < 4; ++np) {
        const int n0 = nb + 32 * np;
        float v[2][4];
#pragma unroll
        for (int h2 = 0; h2 < 2; ++h2)
#pragma unroll
          for (int j = 0; j < 4; ++j) v[h2][j] = acc[mi][2 * np + h2][j] * rstd[mi];
        if (((n0 >> 5) % 3) == 2) {
          const float4 c4 = *(const float4*)(RC + rloc * 16 + 4 * fq), s4 = *(const float4*)(RS + rloc * 16 + 4 * fq);
          const float cs[4] = {c4.x, c4.y, c4.z, c4.w}, sn[4] = {s4.x, s4.y, s4.z, s4.w};
#pragma unroll
          for (int j = 0; j < 4; ++j) { const float x1 = v[0][j], x2 = v[1][j]; v[0][j] = x1 * cs[j] - x2 * sn[j]; v[1][j] = x1 * sn[j] + x2 * cs[j]; }
        }
        *(uint2*)(Qb + (size_t)m * 768 + n0 + 4 * fq) = pk4(v[0][0], v[0][1], v[0][2], v[0][3]);
        *(uint2*)(Qb + (size_t)m * 768 + n0 + 16 + 4 * fq) = pk4(v[1][0], v[1][1], v[1][2], v[1][3]);
      }
    }
  }
#undef BSTAGE
  __syncthreads();
}
DEV void sample_prep_item(const Prm& p, int L, int it) {
  int tid = threadIdx.x; LAUNDER(tid);
  const int R = NPR + it * 128 + (tid >> 1);
  kv_prep_row(p, L, R, tid & 1, true, nullptr);
}
DEV void shift_item(const Prm& p, int L, int st) {
  int tid0 = threadIdx.x; LAUNDER(tid0);
  if (tid0 < 224) {
    const int R = st < 4 ? st * PT + (PT - 1) : NPR + (st - 4) * 64 + 63;
    const uint2 u = *(const uint2*)(p.zE + (size_t)R * ZE + ZE_ZC + 4 * tid0);
    float4 v; v.x = bflo(u.x); v.y = bfhi(u.x); v.z = bflo(u.y); v.w = bfhi(u.y);
    float* dst = st < 4 ? p.shift_p + ((size_t)L * 4 + st) * 896 : p.shift_s + ((size_t)L * 32 + (st - 4)) * 896;
    *(float4*)(dst + 4 * tid0) = v;
  }
}

DEV void lat_item(const Prm& p, int L, int j) {
  int tid = threadIdx.x; LAUNDER(tid);
  const int b = j >> 4, t = j & 15;
  const float* csrc = p.cache_ckv + (((size_t)L * 32 + b) * 1024 + 64 * t) * 128;
  const float* ksrc = p.cache_krope + (((size_t)L * 32 + b) * 1024 + 64 * t) * 32;
  {
    const int row = tid >> 2, qd = tid & 3;
    const float* s = csrc + row * 128 + 32 * qd;
    bf16_t* d = p.KL + ((size_t)b * SKEYS + 64 * t + row) * 160;
    const float4 v0 = *(const float4*)(s), v1 = *(const float4*)(s + 4), v2 = *(const float4*)(s + 8), v3 = *(const float4*)(s + 12);
    const float4 v4 = *(const float4*)(s + 16), v5 = *(const float4*)(s + 20), v6 = *(const float4*)(s + 24), v7 = *(const float4*)(s + 28);
    const float4 k0 = *(const float4*)(ksrc + row * 32 + 8 * qd), k1 = *(const float4*)(ksrc + row * 32 + 8 * qd + 4);
    uint4 a;
    a.x = pk2(v0.x, v0.y); a.y = pk2(v0.z, v0.w); a.z = pk2(v2.x, v2.y); a.w = pk2(v2.z, v2.w); *(uint4*)(d + 32 * qd) = a;
    a.x = pk2(v1.x, v1.y); a.y = pk2(v1.z, v1.w); a.z = pk2(v3.x, v3.y); a.w = pk2(v3.z, v3.w); *(uint4*)(d + 32 * qd + 8) = a;
    a.x = pk2(v4.x, v4.y); a.y = pk2(v4.z, v4.w); a.z = pk2(v6.x, v6.y); a.w = pk2(v6.z, v6.w); *(uint4*)(d + 32 * qd + 16) = a;
    a.x = pk2(v5.x, v5.y); a.y = pk2(v5.z, v5.w); a.z = pk2(v7.x, v7.y); a.w = pk2(v7.z, v7.w); *(uint4*)(d + 32 * qd + 24) = a;
    a.x = pk2(k0.x, k0.y); a.y = pk2(k0.z, k0.w); a.z = pk2(k1.x, k1.y); a.w = pk2(k1.z, k1.w); *(uint4*)(d + 128 + 8 * qd) = a;
  }
}

template <bool SAMPLE>
DEV int attn_body(const Prm& p, int L, int sb, int head, int qt, char* lds, unsigned* nctr = nullptr) {
  int tid = threadIdx.x; LAUNDER(tid);
  const int lane = tid & 63, w = __builtin_amdgcn_readfirstlane(tid >> 6), l31 = lane & 31, hh = lane >> 5;
  bf16_t* Ks = (bf16_t*)lds;
  bf16_t* Vs = Ks + (SAMPLE ? 1 : 2) * 64 * 104;
  bf16_t* Cs = Vs + (SAMPLE ? 1 : 2) * 64 * 72;
  bf16_t* Wl = Cs + 64 * 136;
  const bf16_t* Qb = (const bf16_t*)p.y_prompt;
  bf16_t* mix = p.zE;
  int Rq0, ntiles, lastvis; bool wact, rowvalid;
  if (SAMPLE) { Rq0 = NPR + 64 * sb; ntiles = 17; lastvis = 16; wact = w < 2; rowvalid = wact; }
  else if (qt >= 0) { Rq0 = sb * PT + 16 + 128 * qt; ntiles = 2 * qt + 3; lastvis = 1 + 2 * qt + (w >> 1); wact = true; rowvalid = true; }
  else { Rq0 = sb * PT; ntiles = 1; lastvis = 0; wact = (w == 0); rowvalid = wact && l31 < 16; }
  const int myrow = Rq0 + 32 * w + l31;
  const int Rld = rowvalid ? myrow : Rq0;
  bf16x8 qf[6];
  {
    const bf16_t* qp = Qb + (size_t)Rld * 768 + head * 96 + hh * 8;
#pragma unroll
    for (int ks = 0; ks < 6; ++ks) qf[ks] = *(const bf16x8*)(qp + 16 * ks);
  }
  float m_run = -1e30f, l_run = 0.f;
  f32x16 o0 = zero16(), o1 = zero16();

  uint4 a_kn0, a_kn1, a_kr, a_vt0, a_vt1;
  a_kn0 = a_kn1 = a_kr = a_vt0 = a_vt1 = make_uint4(0, 0, 0, 0);
#define PLOADX(S, TI) { const int KR0 = sb * PT + ((TI) == 0 ? 0 : 16 + 64 * ((TI) - 1)); \
    S##_kn0 = *(const uint4*)(p.Kn + ((size_t)(KR0 + (tid >> 3)) * 8 + head) * 64 + (tid & 7) * 8); \
    S##_kn1 = *(const uint4*)(p.Kn + ((size_t)(KR0 + 32 + (tid >> 3)) * 8 + head) * 64 + (tid & 7) * 8); \
    S##_kr = *(const uint4*)(p.Kr + (size_t)(KR0 + (tid >> 2)) * 32 + (tid & 3) * 8); \
    S##_vt0 = *(const uint4*)(p.Vt + ((size_t)head * 64 + (tid >> 3)) * KVR + KR0 + (tid & 7) * 8); \
    S##_vt1 = *(const uint4*)(p.Vt + ((size_t)head * 64 + 32 + (tid >> 3)) * KVR + KR0 + (tid & 7) * 8); }
#define PWRITEX(S, BUF) { bf16_t* kb_ = Ks + (BUF) * 64 * 104; bf16_t* vb_ = Vs + (BUF) * 64 * 72; \
    *(uint4*)(kb_ + (tid >> 3) * 104 + (tid & 7) * 8) = S##_kn0; *(uint4*)(kb_ + (32 + (tid >> 3)) * 104 + (tid & 7) * 8) = S##_kn1; \
    *(uint4*)(kb_ + (tid >> 2) * 104 + 64 + (tid & 3) * 8) = S##_kr; \
    *(uint4*)(vb_ + (tid >> 3) * 72 + (tid & 7) * 8) = S##_vt0; *(uint4*)(vb_ + (32 + (tid >> 3)) * 72 + (tid & 7) * 8) = S##_vt1; }
  float4 pc0, pc1, pc2, pc3, pc4, pc5, pc6, pc7, pk0, pk1;
  pc0 = pc1 = pc2 = pc3 = pc4 = pc5 = pc6 = pc7 = pk0 = pk1 = make_float4(0.f, 0.f, 0.f, 0.f);
  if (SAMPLE) {
    const bf16_t* wsrc = p.Wb_ukv + ((size_t)L * 1024 + head * 128) * 128;
#pragma unroll
    for (int i = 0; i < 8; ++i) { const int id = tid + 256 * i, row = id >> 4, cc = id & 15; *(uint4*)(Wl + row * 136 + cc * 8) = *(const uint4*)(wsrc + row * 128 + cc * 8); }
  }
#define SLOAD(TI) { const float* csrc; const float* ksrc; \
    if ((TI) < 16) { csrc = p.cache_ckv + (((size_t)L * 32 + sb) * 1024 + 64 * (TI)) * 128; ksrc = p.cache_krope + (((size_t)L * 32 + sb) * 1024 + 64 * (TI)) * 32; } \
    else { csrc = p.ckv_s + ((size_t)L * NSM + 64 * sb) * 128; ksrc = p.kr_s + ((size_t)L * NSM + 64 * sb) * 32; } \
    const float* cb_ = csrc + (tid >> 5) * 128 + (tid & 31) * 4; \
    pc0 = *(const float4*)(cb_); pc1 = *(const float4*)(cb_ + 8 * 128); pc2 = *(const float4*)(cb_ + 16 * 128); pc3 = *(const float4*)(cb_ + 24 * 128); \
    pc4 = *(const float4*)(cb_ + 32 * 128); pc5 = *(const float4*)(cb_ + 40 * 128); pc6 = *(const float4*)(cb_ + 48 * 128); pc7 = *(const float4*)(cb_ + 56 * 128); \
    const float* kb2_ = ksrc + (tid >> 3) * 32 + (tid & 7) * 4; pk0 = *(const float4*)(kb2_); pk1 = *(const float4*)(kb2_ + 32 * 32); }
#define SWRITE(BUF) { bf16_t* cd_ = Cs + (tid >> 5) * 136 + (tid & 31) * 4; \
    *(uint2*)(cd_) = pk4(pc0.x, pc0.y, pc0.z, pc0.w); *(uint2*)(cd_ + 8 * 136) = pk4(pc1.x, pc1.y, pc1.z, pc1.w); \
    *(uint2*)(cd_ + 16 * 136) = pk4(pc2.x, pc2.y, pc2.z, pc2.w); *(uint2*)(cd_ + 24 * 136) = pk4(pc3.x, pc3.y, pc3.z, pc3.w); \
    *(uint2*)(cd_ + 32 * 136) = pk4(pc4.x, pc4.y, pc4.z, pc4.w); *(uint2*)(cd_ + 40 * 136) = pk4(pc5.x, pc5.y, pc5.z, pc5.w); \
    *(uint2*)(cd_ + 48 * 136) = pk4(pc6.x, pc6.y, pc6.z, pc6.w); *(uint2*)(cd_ + 56 * 136) = pk4(pc7.x, pc7.y, pc7.z, pc7.w); \
    }
#define SWRITEK(BUF) { bf16_t* kd_ = Ks + (BUF) * 64 * 104 + (tid >> 3) * 104 + 64 + (tid & 7) * 4; \
    *(uint2*)(kd_) = pk4(pk0.x, pk0.y, pk0.z, pk0.w); *(uint2*)(kd_ + 32 * 104) = pk4(pk1.x, pk1.y, pk1.z, pk1.w); }
  auto sexpand = [&](int buf) {
    const int a = w & 1, b = w >> 1;
    const bf16_t* cp = Cs + (32 * b + l31) * 136 + hh * 8;
    const bf16_t* wkp = Wl + (32 * a + l31) * 136 + hh * 8;
    const bf16_t* wvp = wkp + 64 * 136;
    f32x16 ka = zero16(), va = zero16();
#pragma unroll
    for (int ks = 0; ks < 8; ++ks) {
      const bf16x8 cf = *(const bf16x8*)(cp + 16 * ks);
      ka = mfma32(*(const bf16x8*)(wkp + 16 * ks), cf, ka);
      va = mfma32(cf, *(const bf16x8*)(wvp + 16 * ks), va);
    }
    bf16_t* kb = Ks + buf * 64 * 104; bf16_t* vb = Vs + buf * 64 * 72;
#pragma unroll
    for (int G = 0; G < 4; ++G) {
      *(uint2*)(kb + (32 * b + l31) * 104 + 32 * a + 8 * G + 4 * hh) = pk4(ka[4 * G], ka[4 * G + 1], ka[4 * G + 2], ka[4 * G + 3]);
      *(uint2*)(vb + (32 * a + l31) * 72 + 32 * b + 8 * G + 4 * hh) = pk4(va[4 * G], va[4 * G + 1], va[4 * G + 2], va[4 * G + 3]);
    }
  };
  const int x7 = (l31 >> 1) & 7, x3 = (l31 >> 2) & 3, xv = (l31 >> 1) & 7;
#define KFRAG(SP, KS, SUB) (SAMPLE ? *(const bf16x8*)((const bf16_t*)(SP) + (l31 + 32 * (SUB)) * 104 + hh * 8 + 16 * (KS)) \
    : ((KS) < 4 ? *(const bf16x8*)((SP) + (l31 + 32 * (SUB)) * 128 + (((2 * (KS) + hh) ^ x7) << 4)) \
                : *(const bf16x8*)((SP) + 8192 + (l31 + 32 * (SUB)) * 64 + (((2 * ((KS) - 4) + hh) ^ x3) << 4))))
#define VFR(S, SUB) (*(const bf16x8*)(sp + 12288 + (l31 + 32 * (SUB)) * 128 + (((2 * (S) + hh) ^ xv) << 4)))
#define VHALF(SP, C, SUB) (SAMPLE ? *(const uint2*)((const bf16_t*)(SP) + 64 * 104 + (l31 + 32 * (SUB)) * 72 + 4 * hh + 8 * (C)) \
    : *(const uint2*)((SP) + 12288 + (l31 + 32 * (SUB)) * 128 + 8 * hh + ((((C)) ^ xv) << 4)))
  auto compute_t = [&](auto masked_c, const char* sp) {
    constexpr bool MASKED = decltype(masked_c)::value;
    f32x16 s0 = zero16(), s1 = zero16();
    {
      bf16x8 kf[12];
#pragma unroll
      for (int ks = 0; ks < 6; ++ks) { kf[2 * ks] = KFRAG(sp, ks, 0); kf[2 * ks + 1] = KFRAG(sp, ks, 1); }
      __builtin_amdgcn_sched_barrier(0);
#pragma unroll
      for (int ks = 0; ks < 6; ++ks) { s0 = mfma32(kf[2 * ks], qf[ks], s0); s1 = mfma32(kf[2 * ks + 1], qf[ks], s1); }
    }
    bf16x8 vf[8];
    if (!SAMPLE) {
#pragma unroll
      for (int S = 0; S < 4; ++S) { vf[2 * S] = VFR(S, 0); vf[2 * S + 1] = VFR(S, 1); }
      __builtin_amdgcn_sched_barrier(0);
    }
    if (!SAMPLE && MASKED) {
#pragma unroll
      for (int r = 8; r < 16; ++r) s0[r] = -1e30f;
#pragma unroll
      for (int r = 0; r < 16; ++r) s1[r] = -1e30f;
    }
    float mx = s0[0];
#pragma unroll
    for (int r = 1; r < 16; ++r) mx = fmaxf(mx, s0[r]);
#pragma unroll
    for (int r = 0; r < 16; ++r) mx = fmaxf(mx, s1[r]);
    mx = fmaxf(mx, __shfl_xor(mx, 32));
    const float mnew = fmaxf(m_run, mx);
    const float alpha = __builtin_amdgcn_exp2f(m_run - mnew);
    m_run = mnew;
    float ps = 0.f;
#pragma unroll
    for (int r = 0; r < 16; ++r) { s0[r] = __builtin_amdgcn_exp2f(s0[r] - mnew); ps += s0[r]; }
#pragma unroll
    for (int r = 0; r < 16; ++r) { s1[r] = __builtin_amdgcn_exp2f(s1[r] - mnew); ps += s1[r]; }
    l_run = l_run * alpha + ps;
#pragma unroll
    for (int r = 0; r < 16; ++r) { o0[r] *= alpha; o1[r] *= alpha; }
    const bf16x8 pf0 = mk8(pk2(s0[0], s0[1]), pk2(s0[2], s0[3]), pk2(s0[4], s0[5]), pk2(s0[6], s0[7]));
    const bf16x8 pf1 = mk8(pk2(s0[8], s0[9]), pk2(s0[10], s0[11]), pk2(s0[12], s0[13]), pk2(s0[14], s0[15]));
    const bf16x8 pf2 = mk8(pk2(s1[0], s1[1]), pk2(s1[2], s1[3]), pk2(s1[4], s1[5]), pk2(s1[6], s1[7]));
    const bf16x8 pf3 = mk8(pk2(s1[8], s1[9]), pk2(s1[10], s1[11]), pk2(s1[12], s1[13]), pk2(s1[14], s1[15]));
#define PV_STEP(S, PF) { bf16x8 v0_, v1_; \
      if (SAMPLE) { const uint2 a0 = VHALF(sp, 2 * S, 0), b0 = VHALF(sp, 2 * S + 1, 0), a1 = VHALF(sp, 2 * S, 1), b1 = VHALF(sp, 2 * S + 1, 1); \
        v0_ = mk8(a0.x, a0.y, b0.x, b0.y); v1_ = mk8(a1.x, a1.y, b1.x, b1.y); } \
      else { v0_ = *(const bf16x8*)(sp + 12288 + l31 * 128 + (((2 * S + hh) ^ xv) << 4)); v1_ = *(const bf16x8*)(sp + 12288 + (l31 + 32) * 128 + (((2 * S + hh) ^ xv) << 4)); } \
      o0 = mfma32(v0_, PF, o0); o1 = mfma32(v1_, PF, o1); }
    if (SAMPLE) { PV_STEP(0, pf0) PV_STEP(1, pf1) PV_STEP(2, pf2) PV_STEP(3, pf3) }
    else {
      o0 = mfma32(vf[0], pf0, o0); o1 = mfma32(vf[1], pf0, o1); o0 = mfma32(vf[2], pf1, o0); o1 = mfma32(vf[3], pf1, o1);
      o0 = mfma32(vf[4], pf2, o0); o1 = mfma32(vf[5], pf2, o1); o0 = mfma32(vf[6], pf3, o0); o1 = mfma32(vf[7], pf3, o1);
    }
  };
  auto compute_meta = [&](const char* sp) {
    f32x16 s0 = zero16();
    {
      bf16x8 kf[6];
#pragma unroll
      for (int ks = 0; ks < 6; ++ks) kf[ks] = KFRAG(sp, ks, 0);
      __builtin_amdgcn_sched_barrier(0);
#pragma unroll
      for (int ks = 0; ks < 6; ++ks) s0 = mfma32(kf[ks], qf[ks], s0);
    }
    const bf16x8 v0 = VFR(0, 0), v1 = VFR(0, 1);
    float mx = s0[0];
#pragma unroll
    for (int r = 1; r < 8; ++r) mx = fmaxf(mx, s0[r]);
    mx = fmaxf(mx, __shfl_xor(mx, 32));
    m_run = mx;
    float ps = 0.f;
#pragma unroll
    for (int r = 0; r < 8; ++r) { s0[r] = __builtin_amdgcn_exp2f(s0[r] - mx); ps += s0[r]; }
    l_run = ps;
    const bf16x8 pf0 = mk8(pk2(s0[0], s0[1]), pk2(s0[2], s0[3]), pk2(s0[4], s0[5]), pk2(s0[6], s0[7]));
    o0 = mfma32(v0, pf0, zero16()); o1 = mfma32(v1, pf0, zero16());
  };
  bf16x8 qf7 = mk8(0u, 0u, 0u, 0u);
  const bf16x8 kone = mk8(hh == 0 ? 0x3F80u : 0u, 0u, 0u, 0u);
  auto freeze = [&]() {
    const float mf = bflo(pk2(m_run, 0.f));
    const float fac = __builtin_amdgcn_exp2f(m_run - mf);
    l_run *= fac;
#pragma unroll
    for (int r = 0; r < 16; ++r) { o0[r] *= fac; o1[r] *= fac; }
    qf7 = mk8(hh == 0 ? (pk2(-mf, 0.f) & 0xffffu) : 0u, 0u, 0u, 0u);
  };
  auto compute_f = [&](const char* sp) {
    f32x16 s0, s1;
    {
      bf16x8 kf[12];
#pragma unroll
      for (int ks = 0; ks < 6; ++ks) { kf[2 * ks] = KFRAG(sp, ks, 0); kf[2 * ks + 1] = KFRAG(sp, ks, 1); }
      __builtin_amdgcn_sched_barrier(0);
      s0 = mfma32(kone, qf7, zero16()); s1 = mfma32(kone, qf7, zero16());
#pragma unroll
      for (int ks = 0; ks < 6; ++ks) { s0 = mfma32(kf[2 * ks], qf[ks], s0); s1 = mfma32(kf[2 * ks + 1], qf[ks], s1); }
    }
    bf16x8 vf[8];
    if (!SAMPLE) {
#pragma unroll
      for (int S = 0; S < 4; ++S) { vf[2 * S] = VFR(S, 0); vf[2 * S + 1] = VFR(S, 1); }
      __builtin_amdgcn_sched_barrier(0);
    }
    float ps = 0.f;
#pragma unroll
    for (int r = 0; r < 16; ++r) { s0[r] = __builtin_amdgcn_exp2f(s0[r]); ps += s0[r]; }
#pragma unroll
    for (int r = 0; r < 16; ++r) { s1[r] = __builtin_amdgcn_exp2f(s1[r]); ps += s1[r]; }
    l_run += ps;
    const bf16x8 pf0 = mk8(pk2(s0[0], s0[1]), pk2(s0[2], s0[3]), pk2(s0[4], s0[5]), pk2(s0[6], s0[7]));
    const bf16x8 pf1 = mk8(pk2(s0[8], s0[9]), pk2(s0[10], s0[11]), pk2(s0[12], s0[13]), pk2(s0[14], s0[15]));
    const bf16x8 pf2 = mk8(pk2(s1[0], s1[1]), pk2(s1[2], s1[3]), pk2(s1[4], s1[5]), pk2(s1[6], s1[7]));
    const bf16x8 pf3 = mk8(pk2(s1[8], s1[9]), pk2(s1[10], s1[11]), pk2(s1[12], s1[13]), pk2(s1[14], s1[15]));
    if (SAMPLE) { PV_STEP(0, pf0) PV_STEP(1, pf1) PV_STEP(2, pf2) PV_STEP(3, pf3) }
    else {
      o0 = mfma32(vf[0], pf0, o0); o1 = mfma32(vf[1], pf0, o1); o0 = mfma32(vf[2], pf1, o0); o1 = mfma32(vf[3], pf1, o1);
      o0 = mfma32(vf[4], pf2, o0); o1 = mfma32(vf[5], pf2, o1); o0 = mfma32(vf[6], pf3, o0); o1 = mfma32(vf[7], pf3, o1);
    }
#undef PV_STEP
  };

  if (SAMPLE) {
    SLOAD(0)
    for (int ti = 0; ti < ntiles; ++ti) {
      const int buf = 0;
      SWRITE(buf)
      __syncthreads();
      SWRITEK(buf)
      { const int tn = ti + 1 < ntiles ? ti + 1 : ti; SLOAD(tn) }
      sexpand(buf);
      __syncthreads();
      if (wact) { if (ti == 0) { compute_t(std::false_type{}, (const char*)Ks); freeze(); } else compute_f((const char*)Ks); }
    }
    __syncthreads();
  } else {
    const int l8 = lane >> 3, c8 = lane & 7;
    unsigned kn_o0, kn_o1, kr_o, vt_o0, vt_o1;
    { const int r = 8 * (2 * w) + l8; kn_o0 = (unsigned)((head * KVR + r) * 64 + ((c8 ^ ((r >> 1) & 7)) * 8)); }
    { const int r = 8 * (2 * w + 1) + l8; kn_o1 = (unsigned)((head * KVR + r) * 64 + ((c8 ^ ((r >> 1) & 7)) * 8)); }
    { const int r = 16 * w + (lane >> 2); kr_o = (unsigned)(r * 32 + (((lane & 3) ^ ((r >> 2) & 3)) * 8)); }
    { const int d = 8 * (2 * w) + l8, c = c8 ^ ((d >> 1) & 7); vt_o0 = (unsigned)(((head * (KVR / 16) + (c >> 1)) * 64 + d) * 16 + (c & 1) * 8); }
    { const int d = 8 * (2 * w + 1) + l8, c = c8 ^ ((d >> 1) & 7); vt_o1 = (unsigned)(((head * (KVR / 16) + (c >> 1)) * 64 + d) * 16 + (c & 1) * 8); }
#define GLDS16(G, Lp) __builtin_amdgcn_global_load_lds((const unsigned*)(G), (LAS3 unsigned*)(Lp), 16, 0, 0)
#define PDMA(TI, STG) { const int KR0 = sb * PT + ((TI) == 0 ? 0 : 16 + 64 * ((TI) - 1)); char* sb_ = lds + (STG) * 20480 + lane * 16; \
      const bf16_t* kn_ = p.Kn + (size_t)KR0 * 64; const bf16_t* kr_ = p.Kr + (size_t)KR0 * 32; const bf16_t* vt_ = p.Vt + (size_t)KR0 * 64; \
      GLDS16(kn_ + kn_o0, sb_ + (2 * w) * 1024); GLDS16(kn_ + kn_o1, sb_ + (2 * w + 1) * 1024); GLDS16(kr_ + kr_o, sb_ + 8192 + w * 1024); \
      GLDS16(vt_ + vt_o0, sb_ + 12288 + (2 * w) * 1024); GLDS16(vt_ + vt_o1, sb_ + 12288 + (2 * w + 1) * 1024); }
    PDMA(0, 0)
    if (ntiles > 1) PDMA(1, 1)
    int stg = 0, stg2 = 2;
    for (int ti = 0; ti < ntiles; ++ti) {
      if (ti + 1 < ntiles) asm volatile("s_waitcnt vmcnt(5)" ::: "memory"); else asm volatile("s_waitcnt vmcnt(0)" ::: "memory");
      RAW_BARRIER()
      if (ti + 2 < ntiles) PDMA(ti + 2, stg2)
      const char* sp = lds + stg * 20480;
      if (ti == 0) { if (wact) compute_meta(sp); }
      else if (ti == 1) { compute_t(std::false_type{}, sp); freeze(); }
      else if (ti <= lastvis) compute_f(sp);
      stg = stg == 2 ? 0 : stg + 1; stg2 = stg2 == 2 ? 0 : stg2 + 1;
    }
    __syncthreads();
#undef PDMA
#undef GLDS16
  }
  int tk = 0x7fffffff; if (nctr && tid == 0) tk = (int)atomicAdd(nctr, 1u);
  const float lt = l_run + __shfl_xor(l_run, 32);
  if (rowvalid) {
    const float inv = 1.f / lt;
    const bf16_t* gbp = p.zL + (size_t)myrow * ZL + ZL_GB + 64 * head;
    bf16_t* op = mix + (size_t)myrow * D + 256 + 64 * head;
#pragma unroll
    for (int G = 0; G < 4; ++G) {
      const int d = 8 * G + 4 * hh;
      const uint2 g0 = *(const uint2*)(gbp + d), g1 = *(const uint2*)(gbp + 32 + d);
      *(uint2*)(op + d) = pk4(o0[4 * G] * inv * silu_(bflo(g0.x)), o0[4 * G + 1] * inv * silu_(bfhi(g0.x)), o0[4 * G + 2] * inv * silu_(bflo(g0.y)), o0[4 * G + 3] * inv * silu_(bfhi(g0.y)));
      *(uint2*)(op + 32 + d) = pk4(o1[4 * G] * inv * silu_(bflo(g1.x)), o1[4 * G + 1] * inv * silu_(bfhi(g1.x)), o1[4 * G + 2] * inv * silu_(bflo(g1.y)), o1[4 * G + 3] * inv * silu_(bfhi(g1.y)));
    }
  }
  return tk;
}
DEV void attn_item(const Prm& p, int L, int id, char* lds) {
  if (id < 1024) { const int qt = 31 - (id >> 5), sh = id & 31; attn_body<false>(p, L, sh >> 3, sh & 7, qt, lds); }
  else { const int j = id - 1280; attn_body<false>(p, L, j >> 3, j & 7, -1, lds); }
}

typedef short v4i16_t __attribute__((ext_vector_type(4)));
DEV uint2 lds_tr16(const char* pl) { const v4i16_t r = __builtin_amdgcn_ds_read_tr16_b64_v4i16((__attribute__((address_space(3))) v4i16_t*)pl); return __builtin_bit_cast(uint2, r); }
DEV void attn_sample(const Prm& p, int L, int b, int hp, char* lds) {
  int tid = threadIdx.x; LAUNDER(tid);
  const int lane = tid & 63, w = __builtin_amdgcn_readfirstlane(tid >> 6), l31 = lane & 31, hh = lane >> 5;
  const int head = 2 * hp + (w >> 1);
  const bf16_t* Qb = (const bf16_t*)p.y_prompt;
  bf16_t* mix = p.zE;
  const int myrow = NPR + 64 * b + 32 * (w & 1) + l31;
  bf16x8 qf[6];
  {
    const bf16_t* qp = Qb + (size_t)myrow * 768 + head * 96 + hh * 8;
#pragma unroll
    for (int ks = 0; ks < 6; ++ks) qf[ks] = *(const bf16x8*)(qp + 16 * ks);
  }
  unsigned kl_o0, kl_o1, kl_o2, kl_o3, kr_o;
  {
    const int l16 = lane >> 4, c16 = lane & 15;
#define KROW(i) (4 * (4 * w + (i)) + l16)
#define KLO(i) ((unsigned)(KROW(i) * 160 + ((c16 ^ (((KROW(i) & 3) << 2) | ((KROW(i) >> 2) & 3))) * 8)))
    kl_o0 = KLO(0); kl_o1 = KLO(1); kl_o2 = KLO(2); kl_o3 = KLO(3);
#undef KLO
#undef KROW
    const int r = 16 * w + (lane >> 2);
    kr_o = (unsigned)(r * 160 + 128 + (((lane & 3) ^ ((r >> 2) & 3)) * 8));
  }
  const bf16_t* klb = p.KL + (size_t)b * SKEYS * 160;
#define GLDS16(G, Lp) __builtin_amdgcn_global_load_lds((const unsigned*)(G), (LAS3 unsigned*)(Lp), 16, 0, 0)
#define SDMA(TI, STG) { char* sb_ = lds + (STG) * 20480 + lane * 16; const bf16_t* kl_ = klb + (size_t)(TI) * 64 * 160; \
    GLDS16(kl_ + kl_o0, sb_ + (4 * w) * 1024); GLDS16(kl_ + kl_o1, sb_ + (4 * w + 1) * 1024); GLDS16(kl_ + kl_o2, sb_ + (4 * w + 2) * 1024); GLDS16(kl_ + kl_o3, sb_ + (4 * w + 3) * 1024); \
    GLDS16(kl_ + kr_o, sb_ + 16384 + w * 1024); }
  SDMA(0, 0)
  SDMA(1, 1)
  bf16x8 qa0, qa1, qa2, qa3, qa4, qa5, qa6, qa7;
  {
    const float* wsrc = p.w_ukv + ((size_t)L * 128 + l31) * 1024 + head * 128 + 8 * hh;
#define QABS(CT, QA, QB) { f32x16 acc = zero16(); \
      _Pragma("unroll") for (int ks = 0; ks < 4; ++ks) { const float* s_ = wsrc + (size_t)(32 * (CT)) * 1024 + 16 * ks; const float4 a_ = *(const float4*)s_, c_ = *(const float4*)(s_ + 4); \
        acc = mfma32(mk8(pk2(a_.x, a_.y), pk2(a_.z, a_.w), pk2(c_.x, c_.y), pk2(c_.z, c_.w)), qf[ks], acc); } \
      QA = mk8(pk2(acc[0], acc[1]), pk2(acc[2], acc[3]), pk2(acc[4], acc[5]), pk2(acc[6], acc[7])); \
      QB = mk8(pk2(acc[8], acc[9]), pk2(acc[10], acc[11]), pk2(acc[12], acc[13]), pk2(acc[14], acc[15])); }
    QABS(0, qa0, qa1) QABS(1, qa2, qa3) QABS(2, qa4, qa5) QABS(3, qa6, qa7)
#undef QABS
  }
  float m_run = -1e30f, l_run = 0.f;
  f32x16 o0 = zero16(), o1 = zero16(), o2 = zero16(), o3 = zero16();
  bf16x8 qf7 = mk8(0u, 0u, 0u, 0u);
  const bf16x8 kone = mk8(hh == 0 ? 0x3F80u : 0u, 0u, 0u, 0u);
  const int xk = ((l31 & 3) << 2) | ((l31 >> 2) & 3), x3 = (l31 >> 2) & 3;
  int va0, va1;
  {
    const int g = l31 >> 4, q = (l31 >> 2) & 3, pp = l31 & 3;
    const int rowb = (4 * hh + q) * 256 + 8 * (pp & 1) + (q << 6);
    va0 = rowb + (((2 * g + (pp >> 1)) ^ hh) << 4);
    va1 = rowb + 2048 + (((2 * g + (pp >> 1)) ^ (hh + 2)) << 4);
  }
  int stg = 0, stg2 = 2;
  for (int ti = 0; ti < 17; ++ti) {
    if (ti + 1 < 17) asm volatile("s_waitcnt vmcnt(5)" ::: "memory"); else asm volatile("s_waitcnt vmcnt(0)" ::: "memory");
    RAW_BARRIER()
    if (ti + 2 < 17) SDMA(ti + 2, stg2)
    const char* sp = lds + stg * 20480;
    f32x16 s0 = mfma32(kone, qf7, zero16()), s1 = s0;
#define QKL(S, QA) { const bf16x8 k0 = *(const bf16x8*)(sp + l31 * 256 + (((2 * (S) + hh) ^ xk) << 4)), k1 = *(const bf16x8*)(sp + (l31 + 32) * 256 + (((2 * (S) + hh) ^ xk) << 4)); \
      s0 = mfma32(k0, QA, s0); s1 = mfma32(k1, QA, s1); }
    QKL(0, qa0) QKL(1, qa1) QKL(2, qa2) QKL(3, qa3) QKL(4, qa4) QKL(5, qa5) QKL(6, qa6) QKL(7, qa7)
#undef QKL
#pragma unroll
    for (int kr = 0; kr < 2; ++kr) {
      const bf16x8 k0 = *(const bf16x8*)(sp + 16384 + l31 * 64 + (((2 * kr + hh) ^ x3) << 4)), k1 = *(const bf16x8*)(sp + 16384 + (l31 + 32) * 64 + (((2 * kr + hh) ^ x3) << 4));
      s0 = mfma32(k0, qf[4 + kr], s0); s1 = mfma32(k1, qf[4 + kr], s1);
    }
    float ps = 0.f;
    if (ti == 0) {
      float mx = s0[0];
#pragma unroll
      for (int r = 1; r < 16; ++r) mx = fmaxf(mx, s0[r]);
#pragma unroll
      for (int r = 0; r < 16; ++r) mx = fmaxf(mx, s1[r]);
      mx = fmaxf(mx, __shfl_xor(mx, 32));
      m_run = bflo(pk2(mx, 0.f));
#pragma unroll
      for (int r = 0; r < 16; ++r) { s0[r] -= m_run; s1[r] -= m_run; }
      qf7 = mk8(hh == 0 ? (pk2(-m_run, 0.f) & 0xffffu) : 0u, 0u, 0u, 0u);
    }
#pragma unroll
    for (int r = 0; r < 16; ++r) { s0[r] = __builtin_amdgcn_exp2f(s0[r]); ps += s0[r]; }
#pragma unroll
    for (int r = 0; r < 16; ++r) { s1[r] = __builtin_amdgcn_exp2f(s1[r]); ps += s1[r]; }
    l_run += ps;
    const bf16x8 pf0 = mk8(pk2(s0[0], s0[1]), pk2(s0[2], s0[3]), pk2(s0[4], s0[5]), pk2(s0[6], s0[7]));
    const bf16x8 pf1 = mk8(pk2(s0[8], s0[9]), pk2(s0[10], s0[11]), pk2(s0[12], s0[13]), pk2(s0[14], s0[15]));
    const bf16x8 pf2 = mk8(pk2(s1[0], s1[1]), pk2(s1[2], s1[3]), pk2(s1[4], s1[5]), pk2(s1[6], s1[7]));
    const bf16x8 pf3 = mk8(pk2(s1[8], s1[9]), pk2(s1[10], s1[11]), pk2(s1[12], s1[13]), pk2(s1[14], s1[15]));
#define PVT(S, CT, PF, OT) { const uint2 a_ = lds_tr16(sp + (va0 ^ ((CT) << 6)) + (S) * 4096), b_ = lds_tr16(sp + (va1 ^ ((CT) << 6)) + (S) * 4096); \
      OT = mfma32(mk8(a_.x, a_.y, b_.x, b_.y), PF, OT); }
#define PVL(S, PF) PVT(S, 0, PF, o0) PVT(S, 1, PF, o1) PVT(S, 2, PF, o2) PVT(S, 3, PF, o3)
    PVL(0, pf0) PVL(1, pf1) PVL(2, pf2) PVL(3, pf3)
#undef PVL
#undef PVT
    stg = stg == 2 ? 0 : stg + 1; stg2 = stg2 == 2 ? 0 : stg2 + 1;
  }
#undef SDMA
#undef GLDS16
  __syncthreads();
  const float lt = l_run + __shfl_xor(l_run, 32);
  const float inv = 1.f / lt;
  f32x16 e0 = zero16(), e1 = zero16();
  const bf16_t* wv = p.Wb_ukv + ((size_t)L * 1024 + head * 128 + 64 + l31) * 128 + 8 * hh;
#define OEXP(S, OT, RB) { const bf16x8 ob = mk8(pk2(OT[RB] * inv, OT[RB + 1] * inv), pk2(OT[RB + 2] * inv, OT[RB + 3] * inv), pk2(OT[RB + 4] * inv, OT[RB + 5] * inv), pk2(OT[RB + 6] * inv, OT[RB + 7] * inv)); \
    e0 = mfma32(*(const bf16x8*)(wv + 16 * (S)), ob, e0); e1 = mfma32(*(const bf16x8*)(wv + 32 * 128 + 16 * (S)), ob, e1); }
  OEXP(0, o0, 0) OEXP(1, o0, 8) OEXP(2, o1, 0) OEXP(3, o1, 8) OEXP(4, o2, 0) OEXP(5, o2, 8) OEXP(6, o3, 0) OEXP(7, o3, 8)
#undef OEXP
  {
    const bf16_t* gbp = p.zL + (size_t)myrow * ZL + ZL_GB + 64 * head;
    bf16_t* op = mix + (size_t)myrow * D + 256 + 64 * head;
#pragma unroll
    for (int G = 0; G < 4; ++G) {
      const int d = 8 * G + 4 * hh;
      const uint2 g0 = *(const uint2*)(gbp + d), g1 = *(const uint2*)(gbp + 32 + d);
      *(uint2*)(op + d) = pk4(e0[4 * G] * silu_(bflo(g0.x)), e0[4 * G + 1] * silu_(bfhi(g0.x)), e0[4 * G + 2] * silu_(bflo(g0.y)), e0[4 * G + 3] * silu_(bfhi(g0.y)));
      *(uint2*)(op + 32 + d) = pk4(e1[4 * G] * silu_(bflo(g1.x)), e1[4 * G + 1] * silu_(bfhi(g1.x)), e1[4 * G + 2] * silu_(bflo(g1.y)), e1[4 * G + 3] * silu_(bfhi(g1.y)));
    }
  }
}

DEV void conv_item(const Prm& p, int L, int item) {
  int tid = threadIdx.x; LAUNDER(tid);
  bf16_t* mix = p.zE;
  const int c0 = (tid & 31) * 8;
  float w0[8], w1[8], w2[8];
#pragma unroll
  for (int e = 0; e < 8; ++e) { w0[e] = p.conv_w[(L * 3 + 0) * 256 + c0 + e]; w1[e] = p.conv_w[(L * 3 + 1) * 256 + c0 + e]; w2[e] = p.conv_w[(L * 3 + 2) * 256 + c0 + e]; }
  uint4 xiv[4][3], cgv[4][3], bgv[4], gav[4];
#pragma unroll
  for (int it = 0; it < 4; ++it) {
    const int R = item * 32 + it * 8 + (tid >> 5), Rc = R < NT ? R : NT - 1;
#pragma unroll
    for (int dlt = 0; dlt < 3; ++dlt) {
      const int rr = Rc - 2 + dlt;
      const bf16_t* zr = p.zL + (size_t)(rr > 0 ? rr : 0) * ZL;
      xiv[it][dlt] = *(const uint4*)(zr + ZL_XIN + c0); cgv[it][dlt] = *(const uint4*)(zr + ZL_CG + c0);
    }
    const bf16_t* zr = p.zL + (size_t)Rc * ZL;
    bgv[it] = *(const uint4*)(zr + ZL_BG + c0); gav[it] = *(const uint4*)(zr + ZL_GA + c0);
  }
  __builtin_amdgcn_sched_barrier(0);
#pragma unroll
  for (int it = 0; it < 4; ++it) {
    const int R = item * 32 + it * 8 + (tid >> 5);
    if (R >= NT) continue;
    int q, T; const float* st; float* so;
    if (R < NPR) { const int s = R / PT; q = R - s * PT; T = PT; st = nullptr; so = p.conv_p + ((size_t)L * 4 + s) * 512; }
    else { const int b = (R - NPR) >> 6; q = (R - NPR) & 63; T = 64; st = p.state_conv + ((size_t)L * 32 + b) * 512; so = p.conv_s + ((size_t)L * 32 + b) * 512; }
    float u[3][8];
#pragma unroll
    for (int dlt = 0; dlt < 3; ++dlt) {
      const int t = q - 2 + dlt;
      if (t >= 0) {
        const uint4 xi = xiv[it][dlt], cg = cgv[it][dlt];
        u[dlt][0] = bflo(xi.x) * bflo(cg.x); u[dlt][1] = bfhi(xi.x) * bfhi(cg.x); u[dlt][2] = bflo(xi.y) * bflo(cg.y); u[dlt][3] = bfhi(xi.y) * bfhi(cg.y);
        u[dlt][4] = bflo(xi.z) * bflo(cg.z); u[dlt][5] = bfhi(xi.z) * bfhi(cg.z); u[dlt][6] = bflo(xi.w) * bflo(cg.w); u[dlt][7] = bfhi(xi.w) * bfhi(cg.w);
      } else if (st) {
        const float* sr = st + (t + 2) * 256 + c0;
#pragma unroll
        for (int e = 0; e < 8; ++e) u[dlt][e] = sr[e];
      } else {
#pragma unroll
        for (int e = 0; e < 8; ++e) u[dlt][e] = 0.f;
      }
    }
    const uint4 bg = bgv[it], ga = gav[it];
    const float bgf[8] = {bflo(bg.x), bfhi(bg.x), bflo(bg.y), bfhi(bg.y), bflo(bg.z), bfhi(bg.z), bflo(bg.w), bfhi(bg.w)};
    const float gaf[8] = {bflo(ga.x), bfhi(ga.x), bflo(ga.y), bfhi(ga.y), bflo(ga.z), bfhi(ga.z), bflo(ga.w), bfhi(ga.w)};
    float y[8];
#pragma unroll
    for (int e = 0; e < 8; ++e) y[e] = bgf[e] * (w0[e] * u[0][e] + w1[e] * u[1][e] + w2[e] * u[2][e]) * silu_(gaf[e]);
    uint4 o; o.x = pk2(y[0], y[1]); o.y = pk2(y[2], y[3]); o.z = pk2(y[4], y[5]); o.w = pk2(y[6], y[7]);
    *(uint4*)(mix + (size_t)R * D + c0) = o;
    if (q >= T - 2) {
      float* d = so + (q - (T - 2)) * 256 + c0;
#pragma unroll
      for (int e = 0; e < 8; ++e) d[e] = u[2][e];
    }
  }
}

DEV int kperm_addr(int m, int kin) {
  const int mt = m >> 4, ml = m & 15, s = kin >> 5, q = (kin >> 4) & 1, g = (kin >> 2) & 3, e = kin & 3;
  return (((mt * 2 + s) * 64 + ml + 16 * g) * 8) + 4 * q + e;
}
DEV int clay_addr(int x, int v) {
  const int xt = x >> 4, g = (x >> 2) & 3, rr = x & 3, vt = v >> 4, l16 = v & 15;
  return ((xt * 4 + vt) * 64 + 16 * g + l16) * 4 + rr;
}
DEV void mm64(const bf16_t* first, const bf16_t* second, int l31, int hh, f32x16 (&acc)[2][2]) {
#pragma unroll
  for (int ks = 0; ks < 4; ++ks) {
    const bf16x8 f0 = *(const bf16x8*)(first + l31 * 72 + ks * 16 + hh * 8), f1 = *(const bf16x8*)(first + (32 + l31) * 72 + ks * 16 + hh * 8);
    const bf16x8 s0 = *(const bf16x8*)(second + l31 * 72 + ks * 16 + hh * 8), s1 = *(const bf16x8*)(second + (32 + l31) * 72 + ks * 16 + hh * 8);
    acc[0][0] = mfma32(f0, s0, acc[0][0]); acc[0][1] = mfma32(f0, s1, acc[0][1]);
    acc[1][0] = mfma32(f1, s0, acc[1][0]); acc[1][1] = mfma32(f1, s1, acc[1][1]);
  }
}
DEV void mm64x32(const bf16_t* first, const bf16_t* second_rows, int l31, int hh, f32x16 (&acc)[2]) {
#pragma unroll
  for (int ks = 0; ks < 4; ++ks) {
    const bf16x8 f0 = *(const bf16x8*)(first + l31 * 72 + ks * 16 + hh * 8), f1 = *(const bf16x8*)(first + (32 + l31) * 72 + ks * 16 + hh * 8);
    const bf16x8 s0 = *(const bf16x8*)(second_rows + l31 * 72 + ks * 16 + hh * 8);
    acc[0] = mfma32(f0, s0, acc[0]); acc[1] = mfma32(f1, s0, acc[1]);
  }
}

DEV void mmq(const bf16_t* first_rows, const bf16_t* second_rows, int l31, int hh, f32x16& acc) {
#pragma unroll
  for (int ks = 0; ks < 4; ++ks) {
    const bf16x8 f0 = *(const bf16x8*)(first_rows + l31 * 72 + ks * 16 + hh * 8);
    const bf16x8 s0 = *(const bf16x8*)(second_rows + l31 * 72 + ks * 16 + hh * 8);
    acc = mfma32(f0, s0, acc);
  }
}
enum { SH_FULL = 0, SH_UP = 1, SH_LO = 2 };
template <int SH> DEV constexpr bool tile_nz(int tx, int ty) { return SH == SH_FULL || (SH == SH_UP ? tx <= ty : tx >= ty); }
struct Acc64 { f32x16 t[2][2]; };
struct Frag64 { bf16x8 f[4][2]; };
template <int SS> DEV bf16x8 pack8(const f32x16& v) {
  return mk8(pk2(v[8 * SS], v[8 * SS + 1]), pk2(v[8 * SS + 2], v[8 * SS + 3]), pk2(v[8 * SS + 4], v[8 * SS + 5]), pk2(v[8 * SS + 6], v[8 * SS + 7]));
}
template <int SH> DEV void to_frag(const Acc64& X, Frag64& F) {
#pragma unroll
  for (int t = 0; t < 2; ++t) {
    if (tile_nz<SH>(0, t)) { F.f[0][t] = pack8<0>(X.t[0][t]); F.f[1][t] = pack8<1>(X.t[0][t]); }
    if (tile_nz<SH>(1, t)) { F.f[2][t] = pack8<0>(X.t[1][t]); F.f[3][t] = pack8<1>(X.t[1][t]); }
  }
}
template <int SH> DEV void zero_acc(Acc64& X) {
#pragma unroll
  for (int a = 0; a < 2; ++a)
#pragma unroll
    for (int b = 0; b < 2; ++b) if (tile_nz<SH>(a, b)) X.t[a][b] = zero16();
}
template <int SHA, int SHB> DEV void prod_ff(const Frag64& A, const Frag64& B, Acc64& D) {
#pragma unroll
  for (int tm = 0; tm < 2; ++tm)
#pragma unroll
    for (int tn = 0; tn < 2; ++tn)
#pragma unroll
      for (int s = 0; s < 4; ++s)
        if (tile_nz<SHA>(s >> 1, tm) && tile_nz<SHB>(s >> 1, tn)) D.t[tm][tn] = mfma32(A.f[s][tm], B.f[s][tn], D.t[tm][tn]);
}
template <int SHA, int SHB, int SHD> DEV void prod_ff_frag(const Frag64& A, const Frag64& B, Frag64& Fo) {
#pragma unroll
  for (int tm = 0; tm < 2; ++tm)
#pragma unroll
    for (int tn = 0; tn < 2; ++tn)
      if (tile_nz<SHD>(tm, tn)) {
        f32x16 acc = zero16();
#pragma unroll
        for (int s = 0; s < 4; ++s)
          if (tile_nz<SHA>(s >> 1, tm) && tile_nz<SHB>(s >> 1, tn)) acc = mfma32(A.f[s][tm], B.f[s][tn], acc);
        Fo.f[2 * tm][tn] = pack8<0>(acc); Fo.f[2 * tm + 1][tn] = pack8<1>(acc);
      }
}
DEV bf16x8 nat_frag(const bf16_t* S, int row, int s, int hh) { return *(const bf16x8*)(S + row * 72 + 16 * s + 8 * hh); }
DEV bf16x8 perm_frag(const bf16_t* S, int row, int s, int hh) {
  const uint2 a = *(const uint2*)(S + row * 72 + 16 * s + 4 * hh), b = *(const uint2*)(S + row * 72 + 16 * s + 8 + 4 * hh);
  return mk8(a.x, a.y, b.x, b.y);
}
template <int SH, int MODE> DEV void gram(const bf16_t* F, const bf16_t* G, int l31, int hh, Acc64& D) {
  zero_acc<SH>(D);
#pragma unroll
  for (int s = 0; s < 4; ++s) {
    bf16x8 ff[2], gg[2];
#pragma unroll
    for (int t = 0; t < 2; ++t) { ff[t] = nat_frag(F, 32 * t + l31, s, hh); gg[t] = nat_frag(G, 32 * t + l31, s, hh); }
#pragma unroll
    for (int tx = 0; tx < 2; ++tx)
#pragma unroll
      for (int ty = 0; ty < 2; ++ty) if (tile_nz<SH>(tx, ty)) D.t[tx][ty] = mfma32(ff[tx], gg[ty], D.t[tx][ty]);
  }
#pragma unroll
  for (int t = 0; t < 2; ++t)
#pragma unroll
    for (int r = 0; r < 16; ++r) {
      const int x = (r & 3) + 8 * (r >> 2) + 4 * hh, y = l31;
      const bool keep = MODE == 0 ? (x < y) : (MODE == 1 ? (y < x) : (x <= y));
      if (!keep) D.t[t][t][r] = 0.f;
    }
}
template <int SHA> DEV void prod_fm_frag(const Frag64& A, const bf16_t* Mem, int l31, int hh, Frag64& Fo) {
#pragma unroll
  for (int tm = 0; tm < 2; ++tm)
#pragma unroll
    for (int tn = 0; tn < 2; ++tn) {
      f32x16 acc = zero16();
#pragma unroll
      for (int s = 0; s < 4; ++s) if (tile_nz<SHA>(s >> 1, tm)) acc = mfma32(A.f[s][tm], perm_frag(Mem, 32 * tn + l31, s, hh), acc);
      Fo.f[2 * tm][tn] = pack8<0>(acc); Fo.f[2 * tm + 1][tn] = pack8<1>(acc);
    }
}
template <int SHA> DEV void prod_fm(const Frag64& A, const bf16_t* Mem, int l31, int hh, Acc64& D) {
#pragma unroll
  for (int s = 0; s < 4; ++s) {
    bf16x8 mm[2];
#pragma unroll
    for (int t = 0; t < 2; ++t) mm[t] = perm_frag(Mem, 32 * t + l31, s, hh);
#pragma unroll
    for (int tm = 0; tm < 2; ++tm)
#pragma unroll
      for (int tn = 0; tn < 2; ++tn) if (tile_nz<SHA>(s >> 1, tm)) D.t[tm][tn] = mfma32(A.f[s][tm], mm[tn], D.t[tm][tn]);
  }
}
DEV int r1_item(const Prm& p, int L, int idx, char* lds, unsigned* nctr = nullptr) {
  int tid = threadIdx.x; LAUNDER(tid);
  const int w = __builtin_amdgcn_readfirstlane(tid >> 6);
  int lane = tid & 63, l31 = lane & 31, hh = lane >> 5;
  const int cw = w & 1, tw = w >> 1;
  bf16_t* S0 = (bf16_t*)lds;
  bf16_t* S1 = S0 + 4608; bf16_t* S2 = S1 + 4608; bf16_t* S3 = S2 + 4608; bf16_t* S4 = S3 + 4608; bf16_t* S5 = S4 + 4608; bf16_t* S6 = S5 + 4608; bf16_t* S7 = S6 + 4608;
  float* misc = (float*)(S7 + 4608);
  float* Ef = (float*)S4;
  bool prompt; int st, c, hd;
  if (idx < NRW_P) { prompt = true; st = idx / 260; const int rem = idx - st * 260; c = rem >> 2; hd = rem & 3; }
  else { prompt = false; const int j = idx - NRW_P; st = j >> 2; hd = j & 3; c = 0; }
  char* rwp = p.rw + (size_t)idx * RW_BYTES;
  const float* mu = p.shift_mu + L * 896;
  const int i1 = tid >> 2, m0 = (tid & 3) * 16;
  int R1; bool valid1, hasprev1;
  if (prompt) { const int pp = 64 * c - 48 + i1; valid1 = pp >= 0; R1 = st * PT + (valid1 ? pp : 0); hasprev1 = pp >= 1; }
  else { R1 = NPR + 64 * st + i1; valid1 = true; hasprev1 = i1 >= 1; }
  const bf16_t* zr1 = p.zE + (size_t)R1 * ZE + ZE_ZC;
  const int ti0 = 32 * tw + l31;
  int R; bool valid, hasprev;
  if (prompt) { const int pp = 64 * c - 48 + ti0; valid = pp >= 0; R = st * PT + (valid ? pp : 0); hasprev = pp >= 1; }
  else { R = NPR + 64 * st + ti0; valid = true; hasprev = ti0 >= 1; }
  const bf16_t* zr = p.zE + (size_t)R * ZE + ZE_ZC;
  const int chb = 64 * hd + 32 * cw + 4 * hh;
  uint4 la[2][2], lap[2][2]; uint2 lb[3][4], lbp[3][4];
  {
    const bf16_t* sh0 = p.zE + (size_t)(NT + (prompt ? 32 : st)) * ZE + ZE_ZC;
    const bf16_t* zp1 = hasprev1 ? zr1 - ZE : sh0;
    const bf16_t* zp = hasprev ? zr - ZE : sh0;
#pragma unroll
    for (int part = 0; part < 2; ++part)
#pragma unroll
      for (int h8 = 0; h8 < 2; ++h8) { const int col = 768 + 64 * part + m0 + 8 * h8; la[part][h8] = *(const uint4*)(zr1 + col); lap[part][h8] = *(const uint4*)(zp1 + col); }
#pragma unroll
    for (int part = 0; part < 3; ++part)
#pragma unroll
      for (int G = 0; G < 4; ++G) { const int col = 256 * part + chb + 8 * G; lb[part][G] = *(const uint2*)(zr + col); lbp[part][G] = *(const uint2*)(zp + col); }
    const bf16_t* dsrc = p.dw2T + ((size_t)L * 256 + hd * 64 + i1) * 64 + m0;
    const bf16_t* isrc = p.ia2T + ((size_t)L * 256 + hd * 64 + i1) * 64 + m0;
    const uint4 d0 = *(const uint4*)dsrc, d1 = *(const uint4*)(dsrc + 8), e0 = *(const uint4*)isrc, e1 = *(const uint4*)(isrc + 8);
    __builtin_amdgcn_sched_barrier(0);
    *(uint4*)(S2 + i1 * 72 + m0) = d0; *(uint4*)(S2 + i1 * 72 + m0 + 8) = d1;
    *(uint4*)(S3 + i1 * 72 + m0) = e0; *(uint4*)(S3 + i1 * 72 + m0 + 8) = e1;
  }
  {
    float* prm = misc + 384;
#pragma unroll
    for (int q2 = 0; q2 < 2; ++q2) {
      const int ix = tid + 256 * q2, wh = ix >> 6, chp = ix & 63;
      const float* sp = wh == 0 ? p.decay_w0 : wh == 1 ? p.iclr_a0 : wh == 2 ? p.key_kk : wh == 3 ? p.key_ka : wh == 4 ? p.bonus_rk : nullptr;
      prm[ix] = sp ? sp[L * 256 + hd * 64 + chp] : mu[256 * (wh - 5) + 64 * hd + chp];
    }
  }
#pragma unroll
  for (int part = 0; part < 2; ++part) {
#pragma unroll
    for (int h8 = 0; h8 < 2; ++h8) {
      const int col = 768 + 64 * part + m0 + 8 * h8;
      const uint4 u = la[part][h8], v = lap[part][h8];
      const float cur[8] = {bflo(u.x), bfhi(u.x), bflo(u.y), bfhi(u.y), bflo(u.z), bfhi(u.z), bflo(u.w), bfhi(u.w)};
      float prv[8] = {bflo(v.x), bfhi(v.x), bflo(v.y), bfhi(v.y), bflo(v.z), bfhi(v.z), bflo(v.w), bfhi(v.w)};
      float o[8];
#pragma unroll
      for (int e = 0; e < 8; ++e) { float z = cur[e] + (prv[e] - cur[e]) * mu[col + e]; if (!valid1) z = 0.f; o[e] = part == 0 ? (1.f - 2.f / (__expf(2.f * z) + 1.f)) : z; }
      uint4 a; a.x = pk2(o[0], o[1]); a.y = pk2(o[2], o[3]); a.z = pk2(o[4], o[5]); a.w = pk2(o[6], o[7]);
      *(uint4*)((part == 0 ? S0 : S1) + i1 * 72 + m0 + 8 * h8) = a;
    }
  }
  __syncthreads();
  f32x16 accw = zero16(), acca = zero16();
#pragma unroll
  for (int ks = 0; ks < 4; ++ks) {
    const bf16x8 fw = *(const bf16x8*)(S2 + (32 * cw + l31) * 72 + ks * 16 + hh * 8), fa = *(const bf16x8*)(S3 + (32 * cw + l31) * 72 + ks * 16 + hh * 8);
    const bf16x8 sw = *(const bf16x8*)(S0 + (32 * tw + l31) * 72 + ks * 16 + hh * 8), sa = *(const bf16x8*)(S1 + (32 * tw + l31) * 72 + ks * 16 + hh * 8);
    accw = mfma32(fw, sw, accw); acca = mfma32(fa, sa, acca);
  }
  int ti = ti0;
  float e_[16];
  float ssq = 0.f;
#pragma unroll
  for (int G = 0; G < 4; ++G) {
    const int ch = chb + 8 * G, col = 256 + ch;
    const uint2 u = lb[1][G], v = lbp[1][G];
    const float cur[4] = {bflo(u.x), bfhi(u.x), bflo(u.y), bfhi(u.y)};
    float prv[4] = {bflo(v.x), bfhi(v.x), bflo(v.y), bfhi(v.y)};
    const int chq = 32 * cw + 8 * G + 4 * hh;
    const float4 kkw = *(const float4*)(misc + 384 + 128 + chq), w0 = *(const float4*)(misc + 384 + chq), m4 = *(const float4*)(misc + 384 + 384 + chq);
    const float kkv[4] = {kkw.x, kkw.y, kkw.z, kkw.w}, w0v[4] = {w0.x, w0.y, w0.z, w0.w}, muv[4] = {m4.x, m4.y, m4.z, m4.w};
#pragma unroll
    for (int e = 0; e < 4; ++e) {
      float z = cur[e] + (prv[e] - cur[e]) * muv[e];
      if (!valid) z = 0.f;
      const float kkr = z * kkv[e];
      ssq += kkr * kkr;
      e_[4 * G + e] = valid ? 0.6065306597126334f * sigmoid_(w0v[e] + accw[4 * G + e]) : 0.f;
    }
  }
  ssq += __shfl_xor(ssq, 32);
  if (hh == 0) misc[(cw * 64 + ti) * 2] = ssq;
#pragma unroll
  for (int G = 0; G < 4; ++G)
#pragma unroll
    for (int e = 0; e < 4; ++e) Ef[ti * 65 + 32 * cw + 8 * G + 4 * hh + e] = e_[4 * G + e];
  __syncthreads();
  {
    const int ch = tid & 63, seg = tid >> 6;
    float run = 0.f;
#pragma unroll
    for (int t = 0; t < 16; ++t) { run += Ef[(16 * seg + t) * 65 + ch]; Ef[(16 * seg + t) * 65 + ch] = run; }
    __syncthreads();
    float off = 0.f;
    for (int s2 = 0; s2 < seg; ++s2) off += Ef[(16 * s2 + 15) * 65 + ch];
    __syncthreads();
#pragma unroll
    for (int t = 0; t < 16; ++t) Ef[(16 * seg + t) * 65 + ch] += off;
    if (seg == 3) { const float cC = Ef[63 * 65 + ch]; misc[320 + ch] = cC; misc[256 + ch] = __expf(-cC); }
    __syncthreads();
  }
  float cc_[16];
#pragma unroll
  for (int G = 0; G < 4; ++G)
#pragma unroll
    for (int e = 0; e < 4; ++e) cc_[4 * G + e] = Ef[ti * 65 + 32 * cw + 8 * G + 4 * hh + e];
  const float kinv = 1.f / fmaxf(sqrtf(misc[ti * 2] + misc[(64 + ti) * 2]), 1e-12f);
  __syncthreads();
  LAUNDER(ti); LAUNDER(hh);
  uint2 vpk[4];
  float rk = 0.f;
#pragma unroll
  for (int G = 0; G < 4; ++G) {
    const int ch = chb + 8 * G, chl = 32 * cw + 8 * G + 4 * hh;
    float zs[3][4];
#pragma unroll
    for (int part = 0; part < 3; ++part) {
      const int col = 256 * part + ch;
      const uint2 u = lb[part][G], v = lbp[part][G];
      const float cur[4] = {bflo(u.x), bfhi(u.x), bflo(u.y), bfhi(u.y)};
      float prv[4] = {bflo(v.x), bfhi(v.x), bflo(v.y), bfhi(v.y)};
      const float4 m4 = *(const float4*)(misc + 384 + 320 + 64 * part + chl);
      const float muv[4] = {m4.x, m4.y, m4.z, m4.w};
#pragma unroll
      for (int e = 0; e < 4; ++e) { float z = cur[e] + (prv[e] - cur[e]) * muv[e]; zs[part][e] = valid ? z : 0.f; }
    }
    vpk[G] = pk4(zs[2][0], zs[2][1], zs[2][2], zs[2][3]);
    const float4 a04 = *(const float4*)(misc + 384 + 64 + chl), kk4 = *(const float4*)(misc + 384 + 128 + chl), ka4 = *(const float4*)(misc + 384 + 192 + chl), bo4 = *(const float4*)(misc + 384 + 256 + chl);
    const float a0v[4] = {a04.x, a04.y, a04.z, a04.w}, kkv[4] = {kk4.x, kk4.y, kk4.z, kk4.w}, kav[4] = {ka4.x, ka4.y, ka4.z, ka4.w}, bov[4] = {bo4.x, bo4.y, bo4.z, bo4.w};
    float at[4], rt[4], bt[4], kt[4], bh[4], kh[4];
#pragma unroll
    for (int e = 0; e < 4; ++e) {
      const int r = 4 * G + e;
      const float al = sigmoid_(a0v[e] + acca[r]);
      const float kk = zs[1][e] * kkv[e] * kinv;
      const float km = zs[1][e] * (1.f + (al - 1.f) * kav[e]);
      rk += zs[0][e] * km * bov[e];
      const float gC = misc[256 + chl + e];
      const float cprev = cc_[r] - e_[r];
      const float ea = __expf(-cprev), er = __expf(-cc_[r]), ek = __builtin_amdgcn_rcpf(er), eh = ek * gC;
      const float b = kk * al;
      at[e] = -kk * ea; rt[e] = zs[0][e] * er; bt[e] = b * ek; kt[e] = km * ek; bh[e] = b * eh; kh[e] = km * eh;
    }
    *(uint2*)(S0 + ti * 72 + chl) = pk4(at[0], at[1], at[2], at[3]);
    *(uint2*)(S1 + ti * 72 + chl) = pk4(rt[0], rt[1], rt[2], rt[3]);
    *(uint2*)(S2 + ti * 72 + chl) = pk4(bt[0], bt[1], bt[2], bt[3]);
    *(uint2*)(S3 + ti * 72 + chl) = pk4(kt[0], kt[1], kt[2], kt[3]);
#pragma unroll
    for (int e = 0; e < 4; ++e) { S4[(chl + e) * 72 + ti] = f2bf(at[e]); S5[(chl + e) * 72 + ti] = f2bf(bh[e]); S6[(chl + e) * 72 + ti] = f2bf(kh[e]); S7[(chl + e) * 72 + ti] = f2bf(zs[2][e]); }
    *(uint2*)(rwp + 40960 + (ti * 64 + chl) * 2) = vpk[G];
  }
  rk += __shfl_xor(rk, 32);
  if (hh == 0) misc[(cw * 64 + ti) * 2 + 1] = rk;
  __syncthreads();
  if (valid && cw == 0 && hh == 0) p.rkb[(size_t)R * 4 + hd] = misc[ti * 2 + 1] + misc[(64 + ti) * 2 + 1];
  int tk = 0x7fffffff; if (nctr && tid == 0) tk = (int)atomicAdd(nctr, 1u);
  LAUNDER(l31); LAUNDER(hh); LAUNDER(lane);
  {
    Acc64 T;
    {
      Acc64 Mx, MTx;
      gram<SH_UP, 0>(S2, S0, l31, hh, Mx);
      gram<SH_LO, 1>(S0, S2, l31, hh, MTx);
      Frag64 fM, fMT, fT;
      to_frag<SH_UP>(Mx, fM); to_frag<SH_LO>(MTx, fMT);
      __builtin_amdgcn_sched_barrier(0);
      T = Mx;
#pragma unroll
      for (int t = 0; t < 2; ++t)
#pragma unroll
        for (int r = 0; r < 16; ++r) if ((r & 3) + 8 * (r >> 2) + 4 * hh == l31) T.t[t][t][r] += 1.f;
      T.t[1][0] = zero16();
      for (int r = 0; r < 5; ++r) {
        Frag64 fM2, fMT2;
        prod_ff_frag<SH_LO, SH_UP, SH_UP>(fMT, fM, fM2);
        prod_ff_frag<SH_UP, SH_LO, SH_LO>(fM, fMT, fMT2);
#pragma unroll
        for (int s = 0; s < 4; ++s)
#pragma unroll
          for (int t = 0; t < 2; ++t) { if (tile_nz<SH_UP>(s >> 1, t)) fM.f[s][t] = fM2.f[s][t]; if (tile_nz<SH_LO>(s >> 1, t)) fMT.f[s][t] = fMT2.f[s][t]; }
        to_frag<SH_UP>(T, fT);
        prod_ff<SH_LO, SH_UP>(fMT, fT, T);
      }
    }
    Frag64 fT;
    to_frag<SH_UP>(T, fT);
    __builtin_amdgcn_sched_barrier(0);
    if (w < 2) {
      Frag64 fW;
      prod_fm_frag<SH_UP>(fT, S4, l31, hh, fW);
      __builtin_amdgcn_sched_barrier(0);
      Acc64 O; zero_acc<SH_FULL>(O);
      if (w == 0) {
        prod_fm<SH_FULL>(fW, S5, l31, hh, O);
#pragma unroll
        for (int tx = 0; tx < 2; ++tx)
#pragma unroll
          for (int ty = 0; ty < 2; ++ty)
#pragma unroll
            for (int G = 0; G < 4; ++G) {
              const int x0 = 32 * tx + 8 * G + 4 * hh, y = 32 * ty + l31;
              float v[4];
#pragma unroll
              for (int e = 0; e < 4; ++e) { v[e] = O.t[tx][ty][4 * G + e]; if (x0 + e == y) v[e] += misc[256 + y]; }
              *(uint2*)(rwp + 0 + kperm_addr(y, x0) * 2) = pk4(v[0], v[1], v[2], v[3]);
            }
      } else {
        Acc64 Nb; gram<SH_UP, 2>(S2, S1, l31, hh, Nb);
        Frag64 fN; to_frag<SH_UP>(Nb, fN);
        prod_ff<SH_FULL, SH_UP>(fW, fN, O);
#pragma unroll
        for (int tx = 0; tx < 2; ++tx)
#pragma unroll
          for (int ty = 0; ty < 2; ++ty)
#pragma unroll
            for (int G = 0; G < 4; ++G) {
              const int x0 = 32 * tx + 8 * G + 4 * hh, y = 32 * ty + l31;
              const uint2 rr = *(const uint2*)(S1 + y * 72 + x0);
              *(uint2*)(rwp + 8192 + kperm_addr(y, x0) * 2) = pk4(O.t[tx][ty][4 * G] + bflo(rr.x), O.t[tx][ty][4 * G + 1] + bfhi(rr.x), O.t[tx][ty][4 * G + 2] + bflo(rr.y), O.t[tx][ty][4 * G + 3] + bfhi(rr.y));
            }
      }
    } else {
      Frag64 fX;
      {
        Acc64 Nk; gram<SH_LO, 1>(S0, S3, l31, hh, Nk);
        Frag64 fNk; to_frag<SH_LO>(Nk, fNk);
        prod_ff_frag<SH_UP, SH_LO, SH_LO>(fT, fNk, fX);
      }
      __builtin_amdgcn_sched_barrier(0);
      if (w == 2) {
        Acc64 Z; zero_acc<SH_FULL>(Z);
        prod_fm<SH_LO>(fX, S5, l31, hh, Z);
#pragma unroll
        for (int tx = 0; tx < 2; ++tx)
#pragma unroll
          for (int ty = 0; ty < 2; ++ty)
#pragma unroll
            for (int G = 0; G < 4; ++G) {
              const int x0 = 32 * tx + 8 * G + 4 * hh, y = 32 * ty + l31;
              const uint2 kk2 = *(const uint2*)(S6 + y * 72 + x0);
              Z.t[tx][ty][4 * G] += bflo(kk2.x); Z.t[tx][ty][4 * G + 1] += bfhi(kk2.x); Z.t[tx][ty][4 * G + 2] += bflo(kk2.y); Z.t[tx][ty][4 * G + 3] += bfhi(kk2.y);
            }
        Frag64 fZ; to_frag<SH_FULL>(Z, fZ);
        __builtin_amdgcn_sched_barrier(0);
        Acc64 Q; zero_acc<SH_FULL>(Q);
        prod_fm<SH_FULL>(fZ, S7, l31, hh, Q);
#pragma unroll
        for (int tx = 0; tx < 2; ++tx)
#pragma unroll
          for (int ty = 0; ty < 2; ++ty)
#pragma unroll
            for (int G = 0; G < 4; ++G)
              *(uint2*)(rwp + 16384 + clay_addr(32 * tx + 8 * G + 4 * hh, 32 * ty + l31) * 2) = pk4(Q.t[tx][ty][4 * G], Q.t[tx][ty][4 * G + 1], Q.t[tx][ty][4 * G + 2], Q.t[tx][ty][4 * G + 3]);
      } else {
        Acc64 H; gram<SH_UP, 2>(S3, S1, l31, hh, H);
        {
          Acc64 Nb; gram<SH_UP, 2>(S2, S1, l31, hh, Nb);
          Frag64 fN; to_frag<SH_UP>(Nb, fN);
          prod_ff<SH_LO, SH_UP>(fX, fN, H);
        }
        Frag64 fH; to_frag<SH_UP>(H, fH);
        __builtin_amdgcn_sched_barrier(0);
        Acc64 Y; zero_acc<SH_FULL>(Y);
        prod_fm<SH_UP>(fH, S7, l31, hh, Y);
#pragma unroll
        for (int tx = 0; tx < 2; ++tx)
#pragma unroll
          for (int ty = 0; ty < 2; ++ty)
#pragma unroll
            for (int G = 0; G < 4; ++G)
              *(uint2*)(rwp + 24576 + clay_addr(32 * tx + 8 * G + 4 * hh, 32 * ty + l31) * 2) = pk4(Y.t[tx][ty][4 * G], Y.t[tx][ty][4 * G + 1], Y.t[tx][ty][4 * G + 2], Y.t[tx][ty][4 * G + 3]);
      }
    }
  }
  __syncthreads();
  return tk;
}

DEV void r2_wave(const Prm& p, int L, int wi, int lane) {
  bool prompt; int st, hd, vt;
  if (wi < 64) { prompt = true; st = wi >> 4; hd = (wi >> 2) & 3; vt = wi & 3; }
  else { prompt = false; const int j = wi - 64; st = j >> 4; hd = (j >> 2) & 3; vt = j & 3; }
  const int nch = prompt ? 65 : 1;
  const int idx0 = prompt ? st * 260 + hd : NRW_P + st * 4 + hd;
  const int l16 = lane & 15, g = lane >> 4;
  f32x4 acc[4];
  float* outp;
  if (prompt) {
#pragma unroll
    for (int mt = 0; mt < 4; ++mt) acc[mt] = (f32x4){0.f, 0.f, 0.f, 0.f};
    outp = p.wkv_p + ((((size_t)L * 4 + st) * 4 + hd) * 64 + 16 * vt + l16) * 64;
  } else {
    const float* sp = p.state_wkv + ((((size_t)L * 32 + st) * 4 + hd) * 64 + 16 * vt + l16) * 64;
#pragma unroll
    for (int mt = 0; mt < 4; ++mt) acc[mt] = *(const f32x4*)(sp + 16 * mt + 4 * g);
    outp = p.wkv_s + ((((size_t)L * 32 + st) * 4 + hd) * 64 + 16 * vt + l16) * 64;
  }
  const char* rw0 = p.rw + (size_t)idx0 * RW_BYTES;
  uint4 pf[4][8]; uint2 qv[4][4];
#pragma unroll
  for (int k = 0; k < 4; ++k) {
    const int cc = k < nch ? k : nch - 1;
    const char* src = rw0 + (size_t)cc * 4 * RW_BYTES;
#pragma unroll
    for (int i = 0; i < 8; ++i) pf[k][i] = *(const uint4*)(src + (i * 64 + lane) * 16);
#pragma unroll
    for (int mt = 0; mt < 4; ++mt) qv[k][mt] = *(const uint2*)(src + 16384 + ((mt * 4 + vt) * 64 + lane) * 8);
  }
  for (int c0 = 0; c0 < nch; c0 += 4) {
#pragma unroll
    for (int k = 0; k < 4; ++k) {
      const int c = c0 + k;
      if (c < nch) {
        char* cur = (char*)rw0 + (size_t)c * 4 * RW_BYTES;
        uint4 bfr[2];
#pragma unroll
        for (int s = 0; s < 2; ++s) {
          bfr[s].x = pk2(acc[2 * s][0], acc[2 * s][1]); bfr[s].y = pk2(acc[2 * s][2], acc[2 * s][3]);
          bfr[s].z = pk2(acc[2 * s + 1][0], acc[2 * s + 1][1]); bfr[s].w = pk2(acc[2 * s + 1][2], acc[2 * s + 1][3]);
          *(uint4*)(cur + 32768 + ((vt * 2 + s) * 64 + lane) * 16) = bfr[s];
        }
#pragma unroll
        for (int mt = 0; mt < 4; ++mt) {
          f32x4 a = {bflo(qv[k][mt].x), bfhi(qv[k][mt].x), bflo(qv[k][mt].y), bfhi(qv[k][mt].y)};
#pragma unroll
          for (int s = 0; s < 2; ++s) a = mfma16(mk8(pf[k][mt * 2 + s]), mk8(bfr[s]), a);
          acc[mt] = a;
        }
        const int cn = c + 4 < nch ? c + 4 : nch - 1;
        const char* src = rw0 + (size_t)cn * 4 * RW_BYTES;
#pragma unroll
        for (int i = 0; i < 8; ++i) pf[k][i] = *(const uint4*)(src + (i * 64 + lane) * 16);
#pragma unroll
        for (int mt = 0; mt < 4; ++mt) qv[k][mt] = *(const uint2*)(src + 16384 + ((mt * 4 + vt) * 64 + lane) * 8);
      }
    }
  }
#pragma unroll
  for (int mt = 0; mt < 4; ++mt) *(f32x4*)(outp + 16 * mt + 4 * g) = acc[mt];
}

DEV void r3_wave(const Prm& p, int L, int idx, int lane, float* Y  ) {
  LAUNDER(lane);
  bool prompt; int st, c, hd;
  if (idx < NRW_P) { prompt = true; st = idx / 260; const int rem = idx - st * 260; c = rem >> 2; hd = rem & 3; }
  else { prompt = false; const int j = idx - NRW_P; st = j >> 2; hd = j & 3; c = 0; }
  const char* rwp = p.rw + (size_t)idx * RW_BYTES;
  const int l16 = lane & 15, g = lane >> 4;
  bf16_t* mix = p.zE;
  uint4 sf[4][2], gf[4][2]; uint2 qv[4][4];
#pragma unroll
  for (int vt = 0; vt < 4; ++vt)
#pragma unroll
    for (int s = 0; s < 2; ++s) sf[vt][s] = *(const uint4*)(rwp + 32768 + ((vt * 2 + s) * 64 + lane) * 16);
#pragma unroll
  for (int it = 0; it < 4; ++it) {
    gf[it][0] = *(const uint4*)(rwp + 8192 + ((it * 2 + 0) * 64 + lane) * 16); gf[it][1] = *(const uint4*)(rwp + 8192 + ((it * 2 + 1) * 64 + lane) * 16);
#pragma unroll
    for (int vt = 0; vt < 4; ++vt) qv[it][vt] = *(const uint2*)(rwp + 24576 + ((it * 4 + vt) * 64 + lane) * 8);
  }
  const float lw[4] = {p.lnx_w[L * 256 + hd * 64 + l16], p.lnx_w[L * 256 + hd * 64 + 16 + l16], p.lnx_w[L * 256 + hd * 64 + 32 + l16], p.lnx_w[L * 256 + hd * 64 + 48 + l16]};
  const float lb[4] = {p.lnx_b[L * 256 + hd * 64 + l16], p.lnx_b[L * 256 + hd * 64 + 16 + l16], p.lnx_b[L * 256 + hd * 64 + 32 + l16], p.lnx_b[L * 256 + hd * 64 + 48 + l16]};
  const int vc = (lane & 7) * 8;
  float rkv[8]; uint4 vvv[8], gcv[8];
#pragma unroll
  for (int ps = 0; ps < 8; ++ps) {
    const int i = 8 * ps + (lane >> 3);
    int R;
    if (prompt) { const int pp = 64 * c - 48 + i; R = st * PT + (pp >= 0 ? pp : 0); }
    else R = NPR + 64 * st + i;
    rkv[ps] = p.rkb[(size_t)R * 4 + hd];
    vvv[ps] = *(const uint4*)(rwp + 40960 + (i * 64 + vc) * 2);
    gcv[ps] = *(const uint4*)(p.zL + (size_t)R * ZL + ZL_GC + hd * 64 + vc);
  }
  __builtin_amdgcn_sched_barrier(0);
#pragma unroll
  for (int it = 0; it < 4; ++it) {
    f32x4 y[4];
#pragma unroll
    for (int vt = 0; vt < 4; ++vt) {
      const uint2 q = qv[it][vt];
      f32x4 a = {bflo(q.x), bfhi(q.x), bflo(q.y), bfhi(q.y)};
      a = mfma16(mk8(gf[it][0]), mk8(sf[vt][0]), a);
      a = mfma16(mk8(gf[it][1]), mk8(sf[vt][1]), a);
      y[vt] = a;
    }
#pragma unroll
    for (int rr = 0; rr < 4; ++rr) {
      const int i = 16 * it + 4 * g + rr;
      float s1 = y[0][rr] + y[1][rr] + y[2][rr] + y[3][rr];
      s1 += __shfl_xor(s1, 1); s1 += __shfl_xor(s1, 2); s1 += __shfl_xor(s1, 4); s1 += __shfl_xor(s1, 8);
      const float mean = s1 * (1.f / 64.f);
      const float d0 = y[0][rr] - mean, d1 = y[1][rr] - mean, d2 = y[2][rr] - mean, d3 = y[3][rr] - mean;
      float s2 = d0 * d0 + d1 * d1 + d2 * d2 + d3 * d3;
      s2 += __shfl_xor(s2, 1); s2 += __shfl_xor(s2, 2); s2 += __shfl_xor(s2, 4); s2 += __shfl_xor(s2, 8);
      const float rstd = rsqrtf(s2 * (1.f / 64.f) + GN_EPS);
      Y[i * 68 + l16] = d0 * rstd * lw[0] + lb[0];
      Y[i * 68 + 16 + l16] = d1 * rstd * lw[1] + lb[1];
      Y[i * 68 + 32 + l16] = d2 * rstd * lw[2] + lb[2];
      Y[i * 68 + 48 + l16] = d3 * rstd * lw[3] + lb[3];
    }
  }
  asm volatile("s_waitcnt lgkmcnt(0)" ::: "memory");
  __builtin_amdgcn_wave_barrier();
#pragma unroll
  for (int ps = 0; ps < 8; ++ps) {
    const int i = 8 * ps + (lane >> 3);
    int R; bool valid;
    if (prompt) { const int pp = 64 * c - 48 + i; valid = pp >= 0; R = st * PT + (valid ? pp : 0); }
    else { R = NPR + 64 * st + i; valid = true; }
    if (valid) {
      const float4 y0 = *(const float4*)(Y + i * 68 + vc), y1 = *(const float4*)(Y + i * 68 + vc + 4);
      const float rkbv = rkv[ps];
      const uint4 vv = vvv[ps];
      const uint4 gc = gcv[ps];
      uint4 o;
      o.x = pk2((y0.x + rkbv * bflo(vv.x)) * silu_(bflo(gc.x)), (y0.y + rkbv * bfhi(vv.x)) * silu_(bfhi(gc.x)));
      o.y = pk2((y0.z + rkbv * bflo(vv.y)) * silu_(bflo(gc.y)), (y0.w + rkbv * bfhi(vv.y)) * silu_(bfhi(gc.y)));
      o.z = pk2((y1.x + rkbv * bflo(vv.z)) * silu_(bflo(gc.z)), (y1.y + rkbv * bfhi(vv.z)) * silu_(bfhi(gc.z)));
      o.w = pk2((y1.z + rkbv * bflo(vv.w)) * silu_(bflo(gc.w)), (y1.w + rkbv * bfhi(vv.w)) * silu_(bfhi(gc.w)));
      *(uint4*)(mix + (size_t)R * D + 768 + hd * 64 + vc) = o;
    }
  }
  asm volatile("s_waitcnt lgkmcnt(0)" ::: "memory");
  __builtin_amdgcn_wave_barrier();
}

DEV void final_norm(const Prm& p) {
  int tid_ = threadIdx.x; LAUNDER(tid_);
  const int lane = tid_ & 63, gw = blockIdx.x * 4 + (tid_ >> 6), NW = gridDim.x * 4;
  for (int R = gw; R < NT; R += NW) {
    if (R < NPR && (R % PT) < 16) continue;
    float* yr = xrow_ptr(p, R);
    const bf16_t* xr = p.xb + (size_t)R * D;
    const float rstd = rsqrtf(p.ssq_x[2 * NTP + R] * (1.f / 1024.f) + RMS_EPS);
#pragma unroll
    for (int j = 0; j < 2; ++j) {
      const uint4 u = ((const uint4*)xr)[lane + 64 * j];
      const float4 g0 = ((const float4*)p.final_g)[2 * (lane + 64 * j)], g1 = ((const float4*)p.final_g)[2 * (lane + 64 * j) + 1];
      float4 o0, o1;
      o0.x = bflo(u.x) * rstd * g0.x; o0.y = bfhi(u.x) * rstd * g0.y; o0.z = bflo(u.y) * rstd * g0.z; o0.w = bfhi(u.y) * rstd * g0.w;
      o1.x = bflo(u.z) * rstd * g1.x; o1.y = bfhi(u.z) * rstd * g1.y; o1.z = bflo(u.w) * rstd * g1.z; o1.w = bfhi(u.w) * rstd * g1.w;
      ((float4*)yr)[2 * (lane + 64 * j)] = o0; ((float4*)yr)[2 * (lane + 64 * j) + 1] = o1;
    }
  }
}

#define XB_TMO      128
#define XB_XCNT(j)  (256  + 64 * (j))
#define XB_XSUB(j)  (1280 + 64 * (j))
#define XB_XGEN(j)  (2304 + 64 * (j))
#define XB_TOP      3328
#define XB_TOPGEN   3392
#define XCD_BAR_WORDS 3456
#define XB_SPIN_CAP (1u << 20)
#define LAS __attribute__((address_space(3)))
DEV unsigned xb_ld(unsigned* p) { return __hip_atomic_load(p, __ATOMIC_RELAXED, __HIP_MEMORY_SCOPE_AGENT); }
DEV unsigned xb_add(unsigned* p, unsigned v) { return __hip_atomic_fetch_add(p, v, __ATOMIC_RELAXED, __HIP_MEMORY_SCOPE_AGENT); }
DEV unsigned xb_xcc_id() { return (unsigned)__builtin_amdgcn_s_getreg((3 << 11) | 20) & 0xFu; }
#define XB_SPIN(cond, bar) do { unsigned _sp = 0; while (cond) { __builtin_amdgcn_s_sleep(1); \
    if ((++_sp & 255u) == 0u) { if (xb_ld(&(bar)[XB_TMO])) break; if (_sp > XB_SPIN_CAP) { atomicAdd(&(bar)[XB_TMO], 1u); break; } } } } while (0)
struct XcdBarrier { unsigned* bar; unsigned x; volatile LAS unsigned* st; };
DEV XcdBarrier xcd_barrier_post(unsigned* bar, volatile LAS unsigned* st) {
  XcdBarrier b; b.bar = bar; b.x = xb_xcc_id(); b.st = st;
  if (threadIdx.x == 0) (void)xb_add(&bar[XB_XCNT(b.x)], 1u);
  return b;
}
DEV void xcd_barrier_complete(unsigned* bar, unsigned x, unsigned& nloc, unsigned& nx) {
  const unsigned G = gridDim.x * gridDim.y * gridDim.z;
  unsigned sum, cnt, mine, sp = 0u;
  for (;;) {
    sum = 0u; cnt = 0u; mine = 0u;
#pragma unroll
    for (unsigned j = 0; j < 16; ++j) { const unsigned c = xb_ld(&bar[XB_XCNT(j)]); sum += c; cnt += (c > 0u) ? 1u : 0u; mine = (j == x) ? c : mine; }
    if (sum == G) break;
    __builtin_amdgcn_s_sleep(1);
    if ((++sp & 255u) == 0u) { if (xb_ld(&bar[XB_TMO])) break; if (sp > XB_SPIN_CAP) { atomicAdd(&bar[XB_TMO], 1u); break; } }
  }
  nloc = mine > 0u ? mine : 1u; nx = cnt > 0u ? cnt : 1u;
}
DEV void xcd_barrier(const XcdBarrier& b) {
  asm volatile("s_waitcnt vmcnt(0)" ::: "memory");
  __syncthreads();
  if (threadIdx.x == 0) {
    unsigned* bar = b.bar;
    __builtin_amdgcn_s_waitcnt(0);
    unsigned nloc = b.st[0], nx = b.st[1];
    if (nloc == 0u) { xcd_barrier_complete(bar, b.x, nloc, nx); b.st[0] = nloc; b.st[1] = nx; }
    const unsigned old = xb_add(&bar[XB_XSUB(b.x)], 1u);
    const unsigned gen = old / nloc;
    if (old + 1u == (gen + 1u) * nloc) {
      __builtin_amdgcn_fence(__ATOMIC_RELEASE, "agent");
      asm volatile("s_waitcnt vmcnt(0)" ::: "memory");
      const unsigned og = xb_add(&bar[XB_TOP], 1u);
      const unsigned tg = og / nx;
      if (og + 1u == (tg + 1u) * nx) xb_add(&bar[XB_TOPGEN], 1u);
      else XB_SPIN(xb_ld(&bar[XB_TOPGEN]) == tg, bar);
      __builtin_amdgcn_fence(__ATOMIC_ACQUIRE, "agent");
      xb_add(&bar[XB_XGEN(b.x)], 1u);
      asm volatile("s_waitcnt vmcnt(0)" ::: "memory");
    } else {
      XB_SPIN(xb_ld(&bar[XB_XGEN(b.x)]) == gen, bar);
      __builtin_amdgcn_fence(__ATOMIC_ACQUIRE, "agent");
      asm volatile("s_waitcnt vmcnt(0)" ::: "memory");
    }
  }
  __syncthreads();
}

#define QCTR(ph, L) (3584 + 64 * (2 * (ph) + (L)))
#define R2DONE(L) (3520 + 16 * (L))
DEV int next_item(unsigned* ctr, char* lds) {
  volatile int* slot = (volatile int*)(lds + LDS_BYTES - 8);
  __syncthreads();
  if (threadIdx.x == 0) *slot = (int)atomicAdd(ctr, 1u);
  __syncthreads();
  return *slot;
}
#define QXC(ph, L, x) (4096 + (((ph) * 2 + (L)) * 8 + (x)) * 16)
DEV int xq_next(unsigned* ctl, int ph, int L, int C, int N, int& k, int home, char* lds) {
  volatile int* slot = (volatile int*)(lds + LDS_BYTES - 8);
  __syncthreads();
  if (threadIdx.x == 0) {
    int res = -1, kk = k;
    while (kk < 8) {
      const int x = (home + kk) & 7, base = x * C;
      int size = N - base; size = size < C ? size : C;
      if (size > 0) { const int idx = (int)atomicAdd(ctl + QXC(ph, L, x), 1u); if (idx < size) { res = base + idx; break; } }
      ++kk;
    }
    slot[0] = res; slot[1] = kk;
  }
  __syncthreads();
  k = slot[1];
  return slot[0];
}
DEV int q_publish(int ticket, char* lds) {
  volatile int* slot = (volatile int*)(lds + LDS_BYTES - 8);
  __syncthreads();
  if (threadIdx.x == 0) *slot = ticket;
  __syncthreads();
  return *slot;
}
DEV int xq_resolve(unsigned* ctl, int ph, int L, int C, int N, int& k, int home, int ticket, char* lds) {
  volatile int* slot = (volatile int*)(lds + LDS_BYTES - 8);
  __syncthreads();
  if (threadIdx.x == 0) {
    int res = -1, kk = k;
    if (kk < 8) {
      const int x = (home + kk) & 7, base = x * C;
      int size = N - base; size = size < C ? size : C;
      if (ticket < size) res = base + ticket;
      else {
        ++kk;
        while (kk < 8) {
          const int x2 = (home + kk) & 7, base2 = x2 * C;
          int size2 = N - base2; size2 = size2 < C ? size2 : C;
          if (size2 > 0) { const int idx = (int)atomicAdd(ctl + QXC(ph, L, x2), 1u); if (idx < size2) { res = base2 + idx; break; } }
          ++kk;
        }
      }
    }
    slot[0] = res; slot[1] = kk;
  }
  __syncthreads();
  k = slot[1];
  return slot[0];
}
DEV unsigned* xq_ctr(unsigned* ctl, int ph, int L, int k, int home) { return k < 8 ? ctl + QXC(ph, L, (home + k) & 7) : nullptr; }
DEV int take_ticket(unsigned* nctr) { int tk = 0x7fffffff; if (nctr && threadIdx.x == 0) tk = (int)atomicAdd(nctr, 1u); return tk; }
struct XQueue {
  unsigned* ctl; int ph, L, C, N, k, home, t;
  DEV void prefetch() { t = take_ticket(xq_ctr(ctl, ph, L, k, home)); }
  DEV int resolve(char* lds) { return xq_resolve(ctl, ph, L, C, N, k, home, t, lds); }
};
template <class Epi, class Map>
DEV void gemm_stream(const bf16_t* __restrict__ A, int lda, const bf16_t* __restrict__ Bt, int ldb, int K, char* lds, const Epi& epi, XQueue& q) {
  int tid = threadIdx.x; LAUNDER(tid);
  const int lane = tid & 63, w = __builtin_amdgcn_readfirstlane(tid >> 6), wr = w >> 1, wc = w & 1;
  const int fr = lane & 15, fq = lane >> 4;
  const int sb = lane * 16, swz = sb ^ (((sb >> 9) & 1) << 5), rl = swz >> 6, cl = (swz & 63) >> 1;
  const int nk = K / 64;
  int offA[2], offB[2];
#pragma unroll
  for (int kh = 0; kh < 2; ++kh) { offA[kh] = lds_byte(wr * 64 + fr, kh * 32 + fq * 8); offB[kh] = lds_byte(wc * 64 + fr, kh * 32 + fq * 8); }
  q.prefetch();
  int item = q.resolve(lds);
  if (item < 0) return;
  int m0, n0; Map::map(item, m0, n0);
  const bf16_t* ga[4]; const bf16_t* gb[4];
#define SETPTR(M0, N0) { _Pragma("unroll") for (int i = 0; i < 4; ++i) { const int st = 4 * w + i, r = (st >> 1) * 16 + rl, c = (st & 1) * 32 + cl; \
      ga[i] = A + (size_t)((M0) + r) * lda + c; gb[i] = Bt + (size_t)((N0) + r) * ldb + c; } }
#define GSTAGE(S, KT) { _Pragma("unroll") for (int i = 0; i < 4; ++i) { \
      __builtin_amdgcn_global_load_lds((const unsigned*)(ga[i] + (KT) * 64), (LAS3 unsigned*)(lds + (S) * 32768 + (4 * w + i) * 1024 + lane * 16), 16, 0, 0); \
      __builtin_amdgcn_global_load_lds((const unsigned*)(gb[i] + (KT) * 64), (LAS3 unsigned*)(lds + (S) * 32768 + 16384 + (4 * w + i) * 1024 + lane * 16), 16, 0, 0); } }
  SETPTR(m0, n0)
  GSTAGE(0, 0)
  GSTAGE(1, 1)
  for (;;) {
    f32x4 acc[4][4];
#pragma unroll
    for (int i = 0; i < 4; ++i)
#pragma unroll
      for (int j = 0; j < 4; ++j) acc[i][j] = (f32x4){0.f, 0.f, 0.f, 0.f};
    for (int kt = 0; kt < nk; ++kt) {
      const int s = kt & 1;
      if (kt + 1 < nk) asm volatile("s_waitcnt vmcnt(8)" ::: "memory"); else asm volatile("s_waitcnt vmcnt(0)" ::: "memory");
      RAW_BARRIER()
      const char* ia = lds + s * 32768;
      const char* ib = ia + 16384;
      bf16x8 af[2][4], bfv[2][4];
#pragma unroll
      for (int kh = 0; kh < 2; ++kh) {
#pragma unroll
        for (int mi = 0; mi < 4; ++mi) af[kh][mi] = *(const bf16x8*)(ia + offA[kh] + mi * 2048);
#pragma unroll
        for (int ni = 0; ni < 4; ++ni) bfv[kh][ni] = *(const bf16x8*)(ib + offB[kh] + ni * 2048);
      }
      asm volatile("s_waitcnt lgkmcnt(8)" ::: "memory");
      __builtin_amdgcn_sched_barrier(0);
#pragma unroll
      for (int mi = 0; mi < 4; ++mi)
#pragma unroll
        for (int ni = 0; ni < 4; ++ni) acc[mi][ni] = mfma16(bfv[0][ni], af[0][mi], acc[mi][ni]);
      __builtin_amdgcn_sched_barrier(0);
      asm volatile("s_waitcnt lgkmcnt(0)" ::: "memory");
      RAW_BARRIER()
      if (kt + 2 < nk) GSTAGE(s, kt + 2)
      if (kt == nk - 3) q.prefetch();
      __builtin_amdgcn_sched_barrier(0);
#pragma unroll
      for (int mi = 0; mi < 4; ++mi)
#pragma unroll
        for (int ni = 0; ni < 4; ++ni) acc[mi][ni] = mfma16(bfv[1][ni], af[1][mi], acc[mi][ni]);
    }
    const int nxt = q.resolve(lds);
    const typename Epi::Pre pre = epi.preload(m0 + wr * 64, n0 + wc * 64, fr, fq);
    __builtin_amdgcn_sched_barrier(0);
    int m1 = 0, n1 = 0;
    if (nxt >= 0) { Map::map(nxt, m1, n1); SETPTR(m1, n1) GSTAGE(0, 0) GSTAGE(1, 1) }
    __builtin_amdgcn_sched_barrier(0);
    epi.finish(acc, pre, m0 + wr * 64, n0 + wc * 64, fr, fq);
    if (nxt < 0) break;
    m0 = m1; n0 = n1;
  }
#undef GSTAGE
#undef SETPTR
}
struct MapP1 { static DEV void map(int i, int& m0, int& n0) { int mt, nt; if (i < 18 * 192) { const int b = i / 192, r = i - b * 192; nt = r >> 3; mt = 8 * b + (r & 7); } else { nt = i - 18 * 192; mt = 144; } m0 = mt * 128; n0 = nt * 128; } };
struct MapP4 { static DEV void map(int i, int& m0, int& n0) { m0 = (i >> 3) * 128; n0 = (i & 7) * 128; } };
DEV void shift_rows_item(const Prm& p, int L, int b) {
  int tid0 = threadIdx.x; LAUNDER(tid0);
  if (tid0 < 224) {
    float4 v = make_float4(0.f, 0.f, 0.f, 0.f);
    if (b < 32) v = *(const float4*)(p.state_shift + ((size_t)L * 32 + b) * 896 + 4 * tid0);
    *(uint2*)(p.zE + (size_t)(NT + b) * ZE + ZE_ZC + 4 * tid0) = pk4(v.x, v.y, v.z, v.w);
  }
}
constexpr int N_ATT = 1312;
DEV void run_p1(const Prm& p, int L, char* lds) {
  const EpiIn epi{p, L};
  const int home = (int)(xb_xcc_id() & 7u);
  constexpr int N = 145 * 24, C = (N + 7) / 8;
  {
    XQueue q{p.ctl, 0, L, C, N, 0, home, 0};
    gemm_stream<EpiIn, MapP1>(p.xb, D, p.Wb_in + (size_t)L * INP * 1024, 1024, 1024, lds, epi, q);
  }
  unsigned* ctr = p.ctl + QCTR(3, L);
  int t = take_ticket(ctr);
  for (;;) {
    const int mt = q_publish(t, lds);
    if (mt >= 145 + 33) break;
    if (mt >= 145) { t = take_ticket(ctr); shift_rows_item(p, L, mt - 145); continue; }
    t = gemm_tile<EpiIn, 2>(p.xb, D, p.Wb_in + (size_t)L * INP * 1024, 1024, 1024, mt * 128, 24 * 128, lds, epi, ctr);
  }
}
DEV void run_p2(const Prm& p, int L, char* lds) {
  const EpiQ epq{p, L};
  constexpr int N1 = NRW, N2 = N1 + 129, N3 = N2 + 145, N4 = N3 + 16, N4b = N4 + 512, N5 = N4b + 36;
  const int N6 = L == 0 ? N5 + NWT : N5;
  unsigned* ctr = p.ctl + QCTR(0, L);
  int tk = take_ticket(ctr);
  for (;;) {
    const int id = q_publish(tk, lds);
    if (id >= N6) break;
    if (id >= 145 + 129 && id < N3) { tk = r1_item(p, L, id - (145 + 129), lds, ctr); continue; }
    if (id >= N5) conv_weights_item(p, 1, id - N5, lds);
    else if (id < 145) qproj_item(p, L, id, lds);
    else if (id < 145 + 129) kvproj_item(p, L, id - 145, lds);
    else if (id < N4) sample_prep_item(p, L, id - N3);
    else if (id < N4b) lat_item(p, L, id - N4);
    else shift_item(p, L, id - N4b);
    tk = take_ticket(ctr);
  }
}
DEV void run_p3(const Prm& p, int L, char* lds) {
  int tid_ = threadIdx.x; LAUNDER(tid_);
  const int lane = tid_ & 63, w = __builtin_amdgcn_readfirstlane(tid_ >> 6);
  {
    int ndone = 0;
    for (int wi = blockIdx.x * 4 + w; wi < 576; wi += gridDim.x * 4) { r2_wave(p, L, wi, lane); ++ndone; }
    if (blockIdx.x * 4 < 576) {
      asm volatile("s_waitcnt vmcnt(0)" ::: "memory");
      __syncthreads();
      if (threadIdx.x == 0) {
        int tot = 0;
        for (int wi = blockIdx.x * 4; wi < 576; wi += gridDim.x * 4) tot += (576 - wi) < 4 ? (576 - wi) : 4;
        __builtin_amdgcn_fence(__ATOMIC_RELEASE, "agent");
        asm volatile("s_waitcnt vmcnt(0)" ::: "memory");
        __hip_atomic_fetch_add(p.ctl + R2DONE(L), (unsigned)tot, __ATOMIC_RELAXED, __HIP_MEMORY_SCOPE_AGENT);
      }
    }
    (void)ndone;
  }
  {
    const int home = (int)(xb_xcc_id() & 7u);
    constexpr int XC = 144, AH = 64;
    int k = 0;
    int tx = take_ticket(xq_ctr(p.ctl, 2, L, k, home));
    for (;;) {
      const int i = xq_resolve(p.ctl, 2, L, XC, 8 * XC, k, home, tx, lds);
      if (i < 0) break;
      const int x = i / XC, jj = i - x * XC;
      if (jj >= AH && jj < AH + 16) {
        const int q = x * 16 + (jj - AH);
        attn_sample(p, L, q >> 2, q & 3, lds);
        tx = take_ticket(xq_ctr(p.ctl, 2, L, k, home));
        continue;
      }
      const int j = jj < AH ? jj : jj - 16, qt = 31 - (j >> 2), pair = 4 * x + (j & 3);
      tx = attn_body<false>(p, L, pair >> 3, pair & 7, qt, lds, xq_ctr(p.ctl, 2, L, k, home));
    }
  }
  unsigned* ctr2 = p.ctl + QCTR(2, L);
  constexpr int NC = (NT + 31) / 32, NQ2 = 32 + NC + NRW / 4;
  bool r2_seen = false;
  for (;;) {
    const int q = next_item(ctr2, lds);
    if (q >= NQ2) break;
    constexpr int NR3 = NRW / 4;
    if (q >= NR3 + 32) conv_item(p, L, q - NR3 - 32);
    else if (q >= NR3) attn_item(p, L, 1280 + q - NR3, lds);
    else {
      if (!r2_seen) {
        if (threadIdx.x == 0) {
          unsigned sp = 0;
          while (__hip_atomic_load(p.ctl + R2DONE(L), __ATOMIC_RELAXED, __HIP_MEMORY_SCOPE_AGENT) < 576u) {
            __builtin_amdgcn_s_sleep(2);
            if (++sp > (1u << 22)) { atomicAdd(&p.ctl[XB_TMO], 1u); break; }
          }
          __builtin_amdgcn_fence(__ATOMIC_ACQUIRE, "agent");
          asm volatile("s_waitcnt vmcnt(0)" ::: "memory");
        }
        __syncthreads();
        r2_seen = true;
      }
      r3_wave(p, L, q * 4 + w, lane, (float*)(lds + w * 17408));
    }
  }
}
DEV void run_p4(const Prm& p, int L, char* lds) {
  const EpiOut epo{p, L};
  const int home = (int)(xb_xcc_id() & 7u);
  {
    XQueue q{p.ctl, 1, L, 128, 1024, 0, home, 0};
    gemm_stream<EpiOut, MapP4>(p.zE  , D, p.Wb_out + (size_t)L * 1024 * 1024, 1024, 1024, lds, epo, q);
  }
  unsigned* ctr = p.ctl + QCTR(3, L) + 16;
  int t = take_ticket(ctr);
  for (;;) {
    const int h = q_publish(t, lds);
    if (h >= 17 * 16) break;
    const int mt = 128 + (h >> 4), r = h & 15;
    t = gemm_tile<EpiOut, 4>(p.zE, D, p.Wb_out + (size_t)L * 1024 * 1024, 1024, 1024, mt * 128, (r >> 1) * 128 + (r & 1) * 64, lds, epo, ctr);
  }
}

__global__ void __launch_bounds__(256, 2) mega(Prm p) {
  extern __shared__ __attribute__((aligned(16))) char lds[];
  volatile LAS unsigned* st = (volatile LAS unsigned*)(lds + LDS_BYTES - 16);
  if (threadIdx.x == 0) { st[0] = 0u; st[1] = 0u; st[2] = 0u; st[3] = 0u; }
  __syncthreads();
  const XcdBarrier xb = xcd_barrier_post(p.ctl, st);
  phase0(p, lds);
  xcd_barrier(xb);
  for (int L = 0; L < 2; ++L) {
    run_p1(p, L, lds); xcd_barrier(xb);
    run_p2(p, L, lds); xcd_barrier(xb);
    run_p3(p, L, lds); xcd_barrier(xb);
    run_p4(p, L, lds); xcd_barrier(xb);
  }
  final_norm(p);
}

static size_t al256(size_t x) { return (x + 255) & ~(size_t)255; }
extern "C" void kernel_launch(void* const* d_in, const int* in_sizes, int n_in, void* d_out, int out_size, void* d_ws, size_t ws_size, hipStream_t stream) {
  Prm p{};
  const float* const* in = (const float* const*)d_in;
  p.x_prompt = in[0]; p.x_sample = in[1]; p.cache_ckv = in[2]; p.cache_krope = in[3]; p.state_conv = in[4]; p.state_shift = in[5]; p.state_wkv = in[6];
  p.meta = in[7]; p.norm_g = in[8]; p.w_in = in[9]; p.conv_w = in[10]; p.q_norm_g = in[11]; p.w_uq = in[12]; p.kv_norm_g = in[13]; p.w_ukv = in[14];
  p.shift_mu = in[15]; p.decay_w0 = in[16]; p.decay_w2 = in[17]; p.iclr_a0 = in[18]; p.iclr_a2 = in[19]; p.key_kk = in[20]; p.key_ka = in[21];
  p.bonus_rk = in[22]; p.lnx_w = in[23]; p.lnx_b = in[24]; p.w_out = in[25]; p.final_g = in[26];
  float* o = (float*)d_out;
  p.y_prompt = o; o += (size_t)4 * 4096 * 1024;
  p.y_sample = o; o += (size_t)32 * 64 * 1024;
  p.ckv_p = o; o += (size_t)2 * 4 * PT * 128;
  p.kr_p = o; o += (size_t)2 * 4 * PT * 32;
  p.conv_p = o; o += 2 * 4 * 2 * 256;
  p.shift_p = o; o += 2 * 4 * 896;
  p.wkv_p = o; o += 2 * 4 * 4 * 64 * 64;
  p.ckv_s = o; o += (size_t)2 * 32 * 64 * 128;
  p.kr_s = o; o += 2 * 32 * 64 * 32;
  p.conv_s = o; o += 2 * 32 * 2 * 256;
  p.shift_s = o; o += 2 * 32 * 896;
  p.wkv_s = o; o += 2 * 32 * 4 * 64 * 64;
  char* w = (char*)d_ws; size_t off = 0;
  auto take = [&](size_t bytes) { char* r = w + off; off = al256(off + bytes); return r; };
  p.ctl = (unsigned*)take(65536);
  p.Wb_in = (bf16_t*)take((size_t)2 * INP * 1024 * 2);
  p.Wb_uq = (bf16_t*)take((size_t)2 * 768 * 256 * 2);
  p.Wb_ukv = (bf16_t*)take((size_t)2 * 1024 * 128 * 2);
  p.Wb_out = (bf16_t*)take((size_t)2 * 1024 * 1024 * 2);
  p.dw2T = (bf16_t*)take((size_t)2 * 256 * 64 * 2);
  p.ia2T = (bf16_t*)take((size_t)2 * 256 * 64 * 2);
  p.ropec = (float*)take((size_t)PT * 16 * 4);
  p.ropes = (float*)take((size_t)PT * 16 * 4);
  p.ssq_x = (float*)take((size_t)7 * NTP * 4);
  p.ssq_q = p.ssq_x + 3 * NTP; p.ssq_kv = p.ssq_x + 5 * NTP;
  p.rkb = (float*)take((size_t)NTP * 4 * 4);
  p.xmeta = (float*)take((size_t)64 * 1024 * 4);
  p.zE = (bf16_t*)take((size_t)NTP * ZE * 2);
  p.zL = (bf16_t*)take((size_t)NTP * ZL * 2);
  p.xb = (bf16_t*)take((size_t)(NTP + 128) * D * 2);
  p.Kn = (bf16_t*)take((size_t)KVR * 512 * 2);
  p.Vt = (bf16_t*)take((size_t)512 * KVR * 2);
  p.Kr = (bf16_t*)take((size_t)KVR * 32 * 2);
  p.rw = take((size_t)NRW * RW_BYTES);
  p.KL = (bf16_t*)((char*)p.y_prompt + ((size_t)32 << 20));
  p.VLT = p.KL + (size_t)32 * SKEYS * 160;
  static int grid = 0;
  if (grid == 0) {
    if (off > ws_size) { fprintf(stderr, "kernel_launch: workspace too small: need %zu have %zu\n", off, ws_size); grid = -1; return; }
    int dev = 0, cus = 0, per_cu = 0;
    (void)hipGetDevice(&dev);
    (void)hipDeviceGetAttribute(&cus, hipDeviceAttributeMultiprocessorCount, dev);
    (void)hipFuncSetAttribute((const void*)mega, hipFuncAttributeMaxDynamicSharedMemorySize, LDS_BYTES);
    (void)hipOccupancyMaxActiveBlocksPerMultiprocessor(&per_cu, (const void*)mega, 256, LDS_BYTES);
    if (per_cu > 2) per_cu = 2;
    if (per_cu < 1) { fprintf(stderr, "kernel_launch: occupancy query returned %d\n", per_cu); per_cu = 1; }
    grid = cus * per_cu;
  }
  if (grid < 0) return;
  (void)hipMemsetAsync(p.ctl, 0, 8192 * 4, stream);
  void* args[] = {&p};
  hipError_t e = hipLaunchCooperativeKernel((const void*)mega, dim3(grid), dim3(256), args, LDS_BYTES, stream);
  if (e != hipSuccess) fprintf(stderr, "cooperative launch failed: %s (grid %d)\n", hipGetErrorString(e), grid);
}
```
